# Optimizing an MI355X kernel written in HIP

```python
import jax
import jax.numpy as jnp
from jax import lax
import numpy as np

D_MODEL = 1024
BATCH = 8
SEQ = 4096
DEPTH = 2

GRID_W = 64
CTX_LEN = 256
BLOCK_Q = 128
ROPE_THETA = 10000.0
EPS = 1e-6
NEG_INF = -1e30

N_BRANCH = 4
BRANCH_W = D_MODEL // N_BRANCH
HEAD_DIM = 64

A_HEADS = BRANCH_W // HEAD_DIM
A_Q_RANK = D_MODEL // 4
A_KV_RANK = D_MODEL // 8
A_NOPE = 64
A_ROPE = 32
A_V = BRANCH_W // A_HEADS

B_HEADS = BRANCH_W // HEAD_DIM
B_KV_HEADS = 2
WINDOW = 128

C_HEADS = BRANCH_W // HEAD_DIM
NA_KH = 8
NA_KW = 16
NA_QROWS = BLOCK_Q // GRID_W

D_HEADS = BRANCH_W // HEAD_DIM
D_KV_HEADS = 2

A_COLS = A_Q_RANK + A_KV_RANK + A_ROPE
B_COLS = (B_HEADS + 2 * B_KV_HEADS) * HEAD_DIM
C_COLS = 3 * C_HEADS * HEAD_DIM
D_COLS = (D_HEADS + 2 * D_KV_HEADS) * HEAD_DIM
IN_COLS = A_COLS + B_COLS + C_COLS + D_COLS

N_GROUPS = 4
EXPERTS_PER_GROUP = 8
N_EXPERTS = N_GROUPS * EXPERTS_PER_GROUP
TOP_K_IN_GROUP = 2
EXPERT_FF = D_MODEL // 4
MOE_BLOCK = 128

kernel_name = 'hybrid_gated_mixers_hier_moe_dit'


def rmsnorm(x, g):
    xf = x.astype(jnp.float32)
    y = xf * lax.rsqrt(jnp.mean(xf * xf, axis=-1, keepdims=True) + EPS)
    return (y * g.astype(jnp.float32)).astype(x.dtype)


def modulate(x, g, shift, scale):
    return rmsnorm(x, g) * (1 + scale) + shift


def rope_tables(n_tok, rot_dim):
    t = jnp.arange(n_tok, dtype=jnp.int32)
    rows = (t // GRID_W).astype(jnp.float32)
    cols = (t % GRID_W).astype(jnp.float32)
    half = rot_dim // 2
    inv = ROPE_THETA ** (-jnp.arange(0, half, 2, dtype=jnp.float32) / half)
    ang = jnp.concatenate([rows[:, None] * inv, cols[:, None] * inv], axis=-1)
    return jnp.cos(ang), jnp.sin(ang)


def _rot_half(x, cos, sin):
    x1, x2 = jnp.split(x, 2, axis=-1)
    return jnp.concatenate([x1 * cos - x2 * sin, x2 * cos + x1 * sin], axis=-1)


def apply_axial_rope(x, cos, sin):
    xr, xc = jnp.split(x, 2, axis=-1)
    cr, cc = jnp.split(cos.astype(x.dtype), 2, axis=-1)
    sr, sc = jnp.split(sin.astype(x.dtype), 2, axis=-1)
    return jnp.concatenate([_rot_half(xr, cr[:, None], sr[:, None]),
                            _rot_half(xc, cc[:, None], sc[:, None])], axis=-1)


def attend(q, k, v, scale, bias=None, mask=None, sink=None):
    s = jnp.einsum('bqhgd,blhd->bhgql', q, k, preferred_element_type=jnp.float32) * scale
    if bias is not None:
        s = s + bias.astype(jnp.float32)
    if mask is not None:
        s = jnp.where(mask, s, NEG_INF)
    if sink is None:
        p = jax.nn.softmax(s, axis=-1)
    else:
        sk = sink.astype(jnp.float32)[None, :, :, None, None]
        m = jnp.maximum(jnp.max(s, axis=-1, keepdims=True), sk)
        e = jnp.exp(s - m)
        p = e / (jnp.sum(e, axis=-1, keepdims=True) + jnp.exp(sk - m))
    return jnp.einsum('bhgql,blhd->bqhgd', p.astype(v.dtype), v)


def sweep_blocks(fn, q):
    b, s = q.shape[:2]
    nb = s // BLOCK_Q
    qb = jnp.moveaxis(q.reshape((b, nb, BLOCK_Q) + q.shape[2:]), 1, 0)
    out = lax.map(lambda args: fn(args[0], args[1]), (qb, jnp.arange(nb, dtype=jnp.int32)))
    out = jnp.moveaxis(out, 0, 1)
    return out.reshape((b, s) + out.shape[3:])


def mla_project(pa, g_q_a, w_q_b, g_kv_a, w_kv_b, rope, with_q):
    b, s, _ = pa.shape
    cq, ckv, kr = jnp.split(pa, [A_Q_RANK, A_Q_RANK + A_KV_RANK], axis=-1)
    kv = (rmsnorm(ckv, g_kv_a) @ w_kv_b).reshape(b, s, A_HEADS, A_NOPE + A_V)
    k_nope, v = jnp.split(kv, [A_NOPE], axis=-1)
    kr = kr[:, :, None, :]
    if rope is not None:
        kr = apply_axial_rope(kr, *rope)
    k = jnp.concatenate([k_nope, jnp.broadcast_to(kr, (b, s, A_HEADS, A_ROPE))], axis=-1)
    q = None
    if with_q:
        q = (rmsnorm(cq, g_q_a) @ w_q_b).reshape(b, s, A_HEADS, A_NOPE + A_ROPE)
        if rope is not None:
            q = jnp.concatenate([q[..., :A_NOPE], apply_axial_rope(q[..., A_NOPE:], *rope)], axis=-1)
        q = q[:, :, :, None, :]
    return q, k, v


def branch_mla(pa, pa_c, rope, g_q_a, w_q_b, g_kv_a, w_kv_b, with_ctx):
    b, s, _ = pa.shape
    n_ctx = pa_c.shape[1]
    scale = (A_NOPE + A_ROPE) ** -0.5
    q, k, v = mla_project(pa, g_q_a, w_q_b, g_kv_a, w_kv_b, rope, True)
    qc, kc, vc = mla_project(pa_c, g_q_a, w_q_b, g_kv_a, w_kv_b, None, with_ctx)
    k_all = jnp.concatenate([k, kc], axis=1)
    v_all = jnp.concatenate([v, vc], axis=1)
    o = sweep_blocks(lambda qb, i: attend(qb, k_all, v_all, scale), q).reshape(b, s, BRANCH_W)
    oc = attend(qc, kc, vc, scale).reshape(b, n_ctx, BRANCH_W) if with_ctx else None
    return o, oc


def branch_window(pb, pb_c, rope, sink, with_ctx):
    b, s, _ = pb.shape
    n_ctx = pb_c.shape[1]
    grp = B_HEADS // B_KV_HEADS
    scale = HEAD_DIM ** -0.5
    cuts = [B_HEADS * HEAD_DIM, (B_HEADS + B_KV_HEADS) * HEAD_DIM]
    q, k, v = jnp.split(pb, cuts, axis=-1)
    q = apply_axial_rope(q.reshape(b, s, B_HEADS, HEAD_DIM), *rope).reshape(b, s, B_KV_HEADS, grp, HEAD_DIM)
    k = apply_axial_rope(k.reshape(b, s, B_KV_HEADS, HEAD_DIM), *rope)
    v = v.reshape(b, s, B_KV_HEADS, HEAD_DIM)
    qc, kc, vc = jnp.split(pb_c, cuts, axis=-1)
    kc = kc.reshape(b, n_ctx, B_KV_HEADS, HEAD_DIM)
    vc = vc.reshape(b, n_ctx, B_KV_HEADS, HEAD_DIM)
    sink_g = sink.reshape(B_KV_HEADS, grp)
    pad = ((0, 0), (WINDOW, WINDOW), (0, 0), (0, 0))
    kp = jnp.pad(k, pad)
    vp = jnp.pad(v, pad)
    band = BLOCK_Q + 2 * WINDOW
    qi = jnp.arange(BLOCK_Q, dtype=jnp.int32)[:, None]
    kj = jnp.arange(band, dtype=jnp.int32)[None, :]
    in_window = jnp.abs(qi + WINDOW - kj) <= WINDOW
    ctx_ok = jnp.ones((BLOCK_Q, n_ctx), dtype=bool)

    def block(qb, i):
        start = i * BLOCK_Q
        kb = lax.dynamic_slice_in_dim(kp, start, band, axis=1)
        vb = lax.dynamic_slice_in_dim(vp, start, band, axis=1)
        kpos = start - WINDOW + kj
        mask = jnp.concatenate([in_window & (kpos >= 0) & (kpos < s), ctx_ok], axis=-1)
        return attend(qb, jnp.concatenate([kb, kc], axis=1), jnp.concatenate([vb, vc], axis=1),
                      scale, mask=mask, sink=sink_g)

    o = sweep_blocks(block, q).reshape(b, s, BRANCH_W)
    oc = None
    if with_ctx:
        qc = qc.reshape(b, n_ctx, B_KV_HEADS, grp, HEAD_DIM)
        oc = attend(qc, kc, vc, scale, sink=sink_g).reshape(b, n_ctx, BRANCH_W)
    return o, oc


def branch_neighbourhood(pn, pn_c, rows, rpb, with_ctx):
    b, s, _ = pn.shape
    n_ctx = pn_c.shape[1]
    scale = HEAD_DIM ** -0.5
    q, k, v = jnp.split(pn, 3, axis=-1)
    q = q.reshape(b, s, C_HEADS, 1, HEAD_DIM)
    kg = k.reshape(b, rows, GRID_W, C_HEADS, HEAD_DIM)
    vg = v.reshape(b, rows, GRID_W, C_HEADS, HEAD_DIM)
    qc, kc, vc = jnp.split(pn_c, 3, axis=-1)
    kc = kc.reshape(b, n_ctx, C_HEADS, HEAD_DIM)
    vc = vc.reshape(b, n_ctx, C_HEADS, HEAD_DIM)
    kh = min(NA_KH, rows)
    nbr = min(kh + NA_QROWS - 1, rows)
    a = jnp.arange(BLOCK_Q, dtype=jnp.int32)
    j = jnp.arange(nbr * GRID_W, dtype=jnp.int32)
    q_col = a % GRID_W
    k_col = j % GRID_W
    c_start = jnp.clip(q_col - NA_KW // 2, 0, GRID_W - NA_KW)
    col_ok = (k_col[None] >= c_start[:, None]) & (k_col[None] < c_start[:, None] + NA_KW)
    dc = jnp.clip(k_col[None] - q_col[:, None], -(NA_KW - 1), NA_KW - 1) + NA_KW - 1
    ctx_ok = jnp.ones((BLOCK_Q, n_ctx), dtype=bool)
    ctx_bias = jnp.zeros((C_HEADS, BLOCK_Q, n_ctx), dtype=rpb.dtype)

    def block(qb, i):
        r0 = i * NA_QROWS
        s0 = jnp.clip(r0 - kh // 2, 0, rows - kh)
        band_start = jnp.clip(s0, 0, rows - nbr)
        kb = lax.dynamic_slice_in_dim(kg, band_start, nbr, axis=1).reshape(b, nbr * GRID_W, C_HEADS, HEAD_DIM)
        vb = lax.dynamic_slice_in_dim(vg, band_start, nbr, axis=1).reshape(b, nbr * GRID_W, C_HEADS, HEAD_DIM)
        q_row = r0 + a // GRID_W
        k_row = band_start + j // GRID_W
        r_start = jnp.clip(q_row - kh // 2, 0, rows - kh)
        row_ok = (k_row[None] >= r_start[:, None]) & (k_row[None] < r_start[:, None] + kh)
        dr = jnp.clip(k_row[None] - q_row[:, None], -(NA_KH - 1), NA_KH - 1) + NA_KH - 1
        bias = jnp.concatenate([rpb[:, dr, dc], ctx_bias], axis=-1)[None, :, None]
        mask = jnp.concatenate([row_ok & col_ok, ctx_ok], axis=-1)
        return attend(qb, jnp.concatenate([kb, kc], axis=1), jnp.concatenate([vb, vc], axis=1),
                      scale, bias=bias, mask=mask)

    o = sweep_blocks(block, q).reshape(b, s, BRANCH_W)
    oc = None
    if with_ctx:
        qc = qc.reshape(b, n_ctx, C_HEADS, 1, HEAD_DIM)
        oc = attend(qc, kc, vc, scale).reshape(b, n_ctx, BRANCH_W)
    return o, oc


def branch_qknorm(pd, pd_c, rope, g_qn, g_kn, with_ctx):
    b, s, _ = pd.shape
    n_ctx = pd_c.shape[1]
    grp = D_HEADS // D_KV_HEADS
    scale = HEAD_DIM ** -0.5
    cuts = [D_HEADS * HEAD_DIM, (D_HEADS + D_KV_HEADS) * HEAD_DIM]
    q, k, v = jnp.split(pd, cuts, axis=-1)
    q = apply_axial_rope(rmsnorm(q.reshape(b, s, D_HEADS, HEAD_DIM), g_qn), *rope)
    q = q.reshape(b, s, D_KV_HEADS, grp, HEAD_DIM)
    k = apply_axial_rope(rmsnorm(k.reshape(b, s, D_KV_HEADS, HEAD_DIM), g_kn), *rope)
    v = v.reshape(b, s, D_KV_HEADS, HEAD_DIM)
    qc, kc, vc = jnp.split(pd_c, cuts, axis=-1)
    kc = rmsnorm(kc.reshape(b, n_ctx, D_KV_HEADS, HEAD_DIM), g_kn)
    vc = vc.reshape(b, n_ctx, D_KV_HEADS, HEAD_DIM)
    k_all = jnp.concatenate([k, kc], axis=1)
    v_all = jnp.concatenate([v, vc], axis=1)
    o = sweep_blocks(lambda qb, i: attend(qb, k_all, v_all, scale), q).reshape(b, s, BRANCH_W)
    oc = None
    if with_ctx:
        qc = rmsnorm(qc.reshape(b, n_ctx, D_HEADS, HEAD_DIM), g_qn).reshape(b, n_ctx, D_KV_HEADS, grp, HEAD_DIM)
        oc = attend(qc, kc, vc, scale).reshape(b, n_ctx, BRANCH_W)
    return o, oc


def merge_branches(h, outs, w_gate, b_gate, w_branch, w_out):
    y = None
    for n in range(N_BRANCH):
        t = jax.nn.sigmoid(h @ w_gate[n] + b_gate[n]) * (outs[n] @ w_branch[n])
        y = t if y is None else y + t
    return y @ w_out


def token_mixer(h, hc, rows, rope_a, rope_h, w_in, g_q_a, w_q_b, g_kv_a, w_kv_b,
                sink, rpb, g_qn, g_kn, w_gate, b_gate, w_branch, w_out, with_ctx):
    cuts = [A_COLS, A_COLS + B_COLS, A_COLS + B_COLS + C_COLS]
    pa, pb, pn, pd = jnp.split(h @ w_in, cuts, axis=-1)
    pa_c, pb_c, pn_c, pd_c = jnp.split(hc @ w_in, cuts, axis=-1)
    oa, oa_c = branch_mla(pa, pa_c, rope_a, g_q_a, w_q_b, g_kv_a, w_kv_b, with_ctx)
    ob, ob_c = branch_window(pb, pb_c, rope_h, sink, with_ctx)
    on, on_c = branch_neighbourhood(pn, pn_c, rows, rpb, with_ctx)
    od, od_c = branch_qknorm(pd, pd_c, rope_h, g_qn, g_kn, with_ctx)
    y = merge_branches(h, (oa, ob, on, od), w_gate, b_gate, w_branch, w_out)
    yc = None
    if with_ctx:
        yc = merge_branches(hc, (oa_c, ob_c, on_c, od_c), w_gate, b_gate, w_branch, w_out)
    return y, yc


def hier_moe(h, w_group, b_group, w_router, b_router, w_ff1, w_ff3, w_ff2):
    shape = h.shape
    x = h.reshape(-1, shape[-1])
    n_tok = x.shape[0]
    g_logit = (x @ w_group + b_group).astype(jnp.float32)
    g_prob = jax.nn.softmax(g_logit, axis=-1)
    g_sel = jnp.argmax(g_logit, axis=-1).astype(jnp.int32)
    g_w = jnp.take_along_axis(g_prob, g_sel[:, None], axis=-1)
    e_logit = (x @ w_router + b_router).astype(jnp.float32).reshape(n_tok, N_GROUPS, EXPERTS_PER_GROUP)
    e_logit = jnp.take_along_axis(e_logit, g_sel[:, None, None], axis=1)[:, 0]
    top_v, top_i = lax.top_k(e_logit, TOP_K_IN_GROUP)
    wts = (g_w * jax.nn.softmax(top_v, axis=-1)).reshape(-1)
    eid = (g_sel[:, None] * EXPERTS_PER_GROUP + top_i).reshape(-1).astype(jnp.int32)
    tok = jnp.repeat(jnp.arange(n_tok, dtype=jnp.int32), TOP_K_IN_GROUP)
    n_assign = n_tok * TOP_K_IN_GROUP
    order = jnp.argsort(eid)
    e_s, tok_s, w_s = eid[order], tok[order], wts[order]
    counts = jnp.zeros((N_EXPERTS,), jnp.int32).at[eid].add(1)
    padded = (counts + MOE_BLOCK - 1) // MOE_BLOCK * MOE_BLOCK
    starts = jnp.cumsum(counts) - counts
    p_ends = jnp.cumsum(padded)
    p_starts = p_ends - padded
    dest = p_starts[e_s] + jnp.arange(n_assign, dtype=jnp.int32) - starts[e_s]
    n_blocks = (n_assign + MOE_BLOCK - 1) // MOE_BLOCK + N_EXPERTS
    n_slots = n_blocks * MOE_BLOCK
    slot_tok = jnp.zeros((n_slots,), jnp.int32).at[dest].set(tok_s)
    slot_w = jnp.zeros((n_slots,), jnp.float32).at[dest].set(w_s)
    blk_start = jnp.arange(n_blocks, dtype=jnp.int32) * MOE_BLOCK
    blk_e = jnp.minimum(jnp.searchsorted(p_ends, blk_start, side='right'), N_EXPERTS - 1)
    xs = x[slot_tok].reshape(n_blocks, MOE_BLOCK, shape[-1])

    def expert_block(args):
        xb, e = args
        return (jax.nn.silu(xb @ w_ff1[e]) * (xb @ w_ff3[e])) @ w_ff2[e]

    ys = lax.map(expert_block, (xs, blk_e)).reshape(n_slots, shape[-1])
    out = jnp.zeros_like(x).at[slot_tok].add(ys * slot_w[:, None].astype(ys.dtype))
    return out.reshape(shape)


def setup_inputs(seed: int = 0) -> dict:
    key = jax.random.key(seed)
    keys = iter(jax.random.split(key, 40))
    L, D = DEPTH, D_MODEL

    def normal(shape, std=1.0):
        return std * jax.random.normal(next(keys), shape, jnp.float32)

    def dense(shape, fan_in, gain=1.0):
        return normal(shape, gain * fan_in ** -0.5)

    def norm_gain(shape):
        return 1.0 + normal(shape, 0.01)

    return {
        'x': normal((BATCH, SEQ, D)),
        'c': normal((BATCH, D)),
        'ctx': normal((BATCH, CTX_LEN, D)),
        'c_ctx': normal((D,)),
        'w_mod': dense((L, D, 6 * D), D, 0.5),
        'b_mod': normal((L, 6 * D), 0.01),
        'g_norm_mix': norm_gain((L, D)),
        'w_in': dense((L, D, IN_COLS), D),
        'g_q_a': norm_gain((L, A_Q_RANK)),
        'w_q_b': dense((L, A_Q_RANK, A_HEADS * (A_NOPE + A_ROPE)), A_Q_RANK),
        'g_kv_a': norm_gain((L, A_KV_RANK)),
        'w_kv_b': dense((L, A_KV_RANK, A_HEADS * (A_NOPE + A_V)), A_KV_RANK),
        'sink_b': normal((L, B_HEADS), 0.5),
        'rpb_c': normal((L, C_HEADS, 2 * NA_KH - 1, 2 * NA_KW - 1), 0.1),
        'g_q_d': norm_gain((L, HEAD_DIM)),
        'g_k_d': norm_gain((L, HEAD_DIM)),
        'w_gate': dense((L, N_BRANCH, D, D), D),
        'b_gate': normal((L, N_BRANCH, D), 0.01),
        'w_branch': dense((L, N_BRANCH, BRANCH_W, D), BRANCH_W),
        'w_out': dense((L, D, D), D),
        'g_norm_ffn': norm_gain((L, D)),
        'w_group': dense((L, D, N_GROUPS), D),
        'b_group': normal((L, N_GROUPS), 0.01),
        'w_router': dense((L, D, N_EXPERTS), D),
        'b_router': normal((L, N_EXPERTS), 0.01),
        'w_ff1': dense((L, N_EXPERTS, D, EXPERT_FF), D),
        'w_ff3': dense((L, N_EXPERTS, D, EXPERT_FF), D),
        'w_ff2': dense((L, N_EXPERTS, EXPERT_FF, D), EXPERT_FF),
        'g_final': norm_gain((D,)),
    }


def reference(x, c, ctx, c_ctx, w_mod, b_mod, g_norm_mix, w_in, g_q_a, w_q_b, g_kv_a, w_kv_b,
              sink_b, rpb_c, g_q_d, g_k_d, w_gate, b_gate, w_branch, w_out, g_norm_ffn,
              w_group, b_group, w_router, b_router, w_ff1, w_ff3, w_ff2, g_final):
    s = x.shape[1]
    n_ctx = ctx.shape[1]
    rows = s // GRID_W
    rope_a = rope_tables(s, A_ROPE)
    rope_h = rope_tables(s, HEAD_DIM)
    silu_c = jax.nn.silu(c)
    silu_cc = jax.nn.silu(c_ctx)
    for l in range(DEPTH):
        with_ctx = l < DEPTH - 1
        mod = (silu_c @ w_mod[l] + b_mod[l])[:, None, :]
        mod_c = silu_cc @ w_mod[l] + b_mod[l]
        sh1, sc1, gt1, sh2, sc2, gt2 = jnp.split(mod, 6, axis=-1)
        csh1, csc1, cgt1, csh2, csc2, cgt2 = jnp.split(mod_c, 6, axis=-1)
        h = modulate(x, g_norm_mix[l], sh1, sc1)
        hc = modulate(ctx, g_norm_mix[l], csh1, csc1)
        y, yc = token_mixer(h, hc, rows, rope_a, rope_h, w_in[l], g_q_a[l], w_q_b[l], g_kv_a[l], w_kv_b[l],
                            sink_b[l], rpb_c[l], g_q_d[l], g_k_d[l], w_gate[l], b_gate[l], w_branch[l],
                            w_out[l], with_ctx)
        x = x + gt1 * y
        h2 = modulate(x, g_norm_ffn[l], sh2, sc2)
        if with_ctx:
            ctx = ctx + cgt1 * yc
            h2c = modulate(ctx, g_norm_ffn[l], csh2, csc2)
            f = hier_moe(jnp.concatenate([h2c, h2], axis=1), w_group[l], b_group[l], w_router[l],
                         b_router[l], w_ff1[l], w_ff3[l], w_ff2[l])
            ctx = ctx + cgt2 * f[:, :n_ctx]
            x = x + gt2 * f[:, n_ctx:]
        else:
            x = x + gt2 * hier_moe(h2, w_group[l], b_group[l], w_router[l], b_router[l],
                                   w_ff1[l], w_ff3[l], w_ff2[l])
    return rmsnorm(x, g_final)
```

```cpp
#include <hip/hip_runtime.h>
#include <hip/hip_cooperative_groups.h>
#include <stdint.h>
#include <stdio.h>
namespace cg = cooperative_groups;

#ifndef N_LAUNCH_MODE
#define N_LAUNCH_MODE 1
#endif

#define DEVI __device__ __forceinline__
typedef unsigned short u16;
typedef __attribute__((ext_vector_type(2))) float f32x2;
typedef __attribute__((ext_vector_type(2))) __bf16 bf16x2_t;
typedef __attribute__((ext_vector_type(8))) short bf16x8;
typedef __attribute__((ext_vector_type(16))) float f32x16;
typedef __attribute__((ext_vector_type(4))) unsigned u32x4;
typedef __attribute__((ext_vector_type(2))) unsigned u32x2;
typedef __attribute__((ext_vector_type(4))) float f32x4;
#define MFMA(a, b, c) __builtin_amdgcn_mfma_f32_32x32x16_bf16((a), (b), (c), 0, 0, 0)

constexpr int DMODEL = 1024, NBATCH = 8, SEQ = 4096, NCTX = 256;
constexpr int TPB = SEQ + NCTX;
constexpr int NTOK = NBATCH * TPB;
constexpr int MT_PER_B = TPB / 128;
constexpr int NEXP = 32;
constexpr int INP = 2304;
constexpr float EPS = 1e-6f;
constexpr float LOG2E = 1.4426950408889634f;
constexpr int SMEM_BYTES = 73728;
constexpr int UROWS = 2 * NTOK + NEXP * 128;

constexpr size_t al(size_t x) { return (x + 255) & ~(size_t)255; }
constexpr size_t OFF_WIN = 0;
constexpr size_t OFF_WQB = OFF_WIN + al((size_t)INP * 1024 * 2);
constexpr size_t OFF_WKVB = OFF_WQB + al((size_t)384 * 256 * 2);
constexpr size_t OFF_WGATE = OFF_WKVB + al((size_t)512 * 128 * 2);
constexpr size_t OFF_WBR = OFF_WGATE + al((size_t)4 * 1024 * 1024 * 2);
constexpr size_t OFF_WOUT = OFF_WBR + al((size_t)4 * 1024 * 256 * 2);
constexpr size_t OFF_W13 = OFF_WOUT + al((size_t)1024 * 1024 * 2);
constexpr size_t OFF_W2 = OFF_W13 + al((size_t)32 * 512 * 1024 * 2);
constexpr size_t OFF_MODP = OFF_W2 + al((size_t)32 * 1024 * 256 * 2);
constexpr size_t OFF_MOD = OFF_MODP + al((size_t)8 * 2 * 9 * 6144 * 4);
constexpr size_t OFF_CS32 = OFF_MOD + al((size_t)2 * 9 * 6144 * 4);
constexpr size_t OFF_CS16 = OFF_CS32 + al((size_t)64 * 16 * 2 * 4);
constexpr size_t OFF_WRT = OFF_CS16 + al((size_t)64 * 8 * 2 * 4);
constexpr size_t OFF_CNT = OFF_WRT + al((size_t)2 * 36 * 1024 * 4);
constexpr size_t OFF_CTXRES = OFF_CNT + al(256);
constexpr size_t OFF_H = OFF_CTXRES + al((size_t)8 * 256 * 1024 * 4);
constexpr size_t OFF_O = OFF_H + al((size_t)NTOK * 1024 * 2);
constexpr size_t OFF_SSQ = OFF_O + al((size_t)NTOK * 1024 * 2);
constexpr size_t OFF_LIST = OFF_SSQ + al((size_t)NTOK * 8 * 4);
constexpr size_t OFF_WLIST = OFF_LIST + al((size_t)32 * NTOK * 4);
constexpr size_t OFF_QKV = OFF_WLIST + al((size_t)32 * NTOK * 4);
constexpr size_t OFF_PA = OFF_QKV;
constexpr size_t OFF_QA = OFF_PA + (size_t)NTOK * 384 * 2;
constexpr size_t OFF_KA = OFF_QA + (size_t)NTOK * 384 * 2;
constexpr size_t OFF_KR = OFF_KA + (size_t)NTOK * 256 * 2;
constexpr size_t OFF_VAT = OFF_KR + (size_t)NTOK * 32 * 2;
constexpr size_t OFF_QB = OFF_VAT + (size_t)NTOK * 256 * 2;
constexpr size_t OFF_KB = OFF_QB + (size_t)NTOK * 256 * 2;
constexpr size_t OFF_VBT = OFF_KB + (size_t)NTOK * 128 * 2;
constexpr size_t OFF_QC = OFF_VBT + (size_t)NTOK * 128 * 2;
constexpr size_t OFF_KC = OFF_QC + (size_t)NTOK * 256 * 2;
constexpr size_t OFF_VCT = OFF_KC + (size_t)NTOK * 256 * 2;
constexpr size_t OFF_QD = OFF_VCT + (size_t)NTOK * 256 * 2;
constexpr size_t OFF_KD = OFF_QD + (size_t)NTOK * 256 * 2;
constexpr size_t OFF_VDT = OFF_KD + (size_t)NTOK * 128 * 2;
constexpr size_t OFF_END = OFF_VDT + (size_t)NTOK * 128 * 2;
constexpr size_t OFF_YPRE = OFF_QKV;
constexpr size_t OFF_U = OFF_QKV;
constexpr size_t OFF_YS = OFF_QKV + al((size_t)UROWS * 256 * 2);
static_assert(OFF_YS + (size_t)2 * NTOK * 1024 * 2 <= OFF_END, "alias overflow");
static_assert(OFF_YPRE + (size_t)NTOK * 1024 * 2 <= OFF_END, "alias overflow");
constexpr size_t WS_NEEDED = OFF_END;

struct Params {
  const float *x, *c, *ctx, *c_ctx, *w_mod, *b_mod, *g_norm_mix, *w_in, *g_q_a, *w_q_b, *g_kv_a, *w_kv_b,
      *sink_b, *rpb_c, *g_q_d, *g_k_d, *w_gate, *b_gate, *w_branch, *w_out, *g_norm_ffn, *w_group, *b_group,
      *w_router, *b_router, *w_ff1, *w_ff3, *w_ff2, *g_final;
  float* out;
  char* ws;
  int ph_begin, ph_end;
};

DEVI int tid_fresh() { int t; asm volatile("v_mov_b32 %0, %1" : "=v"(t) : "v"(__builtin_amdgcn_workitem_id_x())); return t; }
DEVI int bid_fresh() { int t; asm volatile("s_mov_b32 %0, %1" : "=s"(t) : "s"(__builtin_amdgcn_workgroup_id_x())); return t; }
#define TIDX tid_fresh()
#define BIDX bid_fresh()
typedef const __attribute__((address_space(4))) Params* KP;
DEVI unsigned pk2(float a, float b) { f32x2 v = {a, b}; bf16x2_t r = __builtin_convertvector(v, bf16x2_t); return __builtin_bit_cast(unsigned, r); }
DEVI u16 f2bf(float a) { return (u16)(pk2(a, 0.f) & 0xffffu); }
DEVI float bf2f(u16 v) { return __uint_as_float(((unsigned)v) << 16); }
DEVI float wave_sum(float v) {
#pragma unroll
  for (int m = 32; m >= 1; m >>= 1) v += __shfl_xor(v, m);
  return v;
}
template <class T> DEVI T* wsp(KP p, size_t off) { return (T*)(p->ws + off); }
DEVI const float* xrow_in(KP p, int l, int b, int rr) {
  if (l == 0) return (rr < NCTX) ? p->ctx + ((size_t)b * NCTX + rr) * 1024 : p->x + ((size_t)b * SEQ + rr - NCTX) * 1024;
  return (rr < NCTX) ? wsp<float>(p, OFF_CTXRES) + ((size_t)b * NCTX + rr) * 1024 : p->out + ((size_t)b * SEQ + rr - NCTX) * 1024;
}
DEVI float* xrow_res(KP p, int b, int rr) {
  return (rr < NCTX) ? wsp<float>(p, OFF_CTXRES) + ((size_t)b * NCTX + rr) * 1024 : p->out + ((size_t)b * SEQ + rr - NCTX) * 1024;
}
DEVI int perm16(int k) { return (k & ~12) | ((k & 4) << 1) | ((k & 8) >> 1); }

struct ConvT { const float* src; const float* ks; u16* dst; int ld; int ldd; };
constexpr int CONV_ITEMS = 1152 + 48 + 32 + 2048 + 512 + 512 + 8192 + 4096;
DEVI ConvT conv_decode(KP p, int l, int idx) {
  ConvT c; c.ks = nullptr;
  if (idx < 1152) {
    int nt = idx >> 4, kt = idx & 15, n0 = nt * 32;
    int sc = (n0 < 416) ? n0 : ((n0 < 512) ? -1 : n0 - 96);
    c.ld = 2208; c.ldd = 1024;
    c.src = (sc < 0) ? nullptr : p->w_in + (size_t)l * 1024 * 2208 + (size_t)kt * 64 * 2208 + sc;
    c.dst = wsp<u16>(p, OFF_WIN) + (size_t)n0 * 1024 + kt * 64;
    return c;
  }
  idx -= 1152;
  if (idx < 48) {
    int nt = idx >> 2, kt = idx & 3;
    c.ld = 384; c.ldd = 256; c.ks = p->g_q_a + l * 256 + kt * 64;
    c.src = p->w_q_b + (size_t)l * 256 * 384 + (size_t)kt * 64 * 384 + nt * 32;
    c.dst = wsp<u16>(p, OFF_WQB) + (size_t)nt * 32 * 256 + kt * 64;
    return c;
  }
  idx -= 48;
  if (idx < 32) {
    int nt = idx >> 1, kt = idx & 1;
    c.ld = 512; c.ldd = 128; c.ks = p->g_kv_a + l * 128 + kt * 64;
    c.src = p->w_kv_b + (size_t)l * 128 * 512 + (size_t)kt * 64 * 512 + nt * 32;
    c.dst = wsp<u16>(p, OFF_WKVB) + (size_t)nt * 32 * 128 + kt * 64;
    return c;
  }
  idx -= 32;
  if (idx < 2048) {
    int br = idx >> 9, nt = (idx >> 4) & 31, kt = idx & 15;
    c.ld = 1024; c.ldd = 1024;
    c.src = p->w_gate + ((size_t)(l * 4 + br) * 1024 + kt * 64) * 1024 + nt * 32;
    c.dst = wsp<u16>(p, OFF_WGATE) + ((size_t)br * 1024 + nt * 32) * 1024 + kt * 64;
    return c;
  }
  idx -= 2048;
  if (idx < 512) {
    int br = idx >> 7, nt = (idx >> 2) & 31, kt = idx & 3;
    c.ld = 1024; c.ldd = 256;
    c.src = p->w_branch + ((size_t)(l * 4 + br) * 256 + kt * 64) * 1024 + nt * 32;
    c.dst = wsp<u16>(p, OFF_WBR) + ((size_t)br * 1024 + nt * 32) * 256 + kt * 64;
    return c;
  }
  idx -= 512;
  if (idx < 512) {
    int nt = idx >> 4, kt = idx & 15;
    c.ld = 1024; c.ldd = 1024;
    c.src = p->w_out + ((size_t)l * 1024 + kt * 64) * 1024 + nt * 32;
    c.dst = wsp<u16>(p, OFF_WOUT) + (size_t)nt * 32 * 1024 + kt * 64;
    return c;
  }
  idx -= 512;
  if (idx < 8192) {
    int e = idx >> 8, g32 = (idx >> 4) & 15, kt = idx & 15;
    const float* w = (g32 & 1) ? p->w_ff3 : p->w_ff1;
    c.ld = 256; c.ldd = 1024;
    c.src = w + ((size_t)(l * 32 + e) * 1024 + kt * 64) * 256 + (g32 >> 1) * 32;
    c.dst = wsp<u16>(p, OFF_W13) + ((size_t)e * 512 + g32 * 32) * 1024 + kt * 64;
    return c;
  }
  idx -= 8192;
  {
    int e = idx >> 7, nt = (idx >> 2) & 31, kt = idx & 3;
    c.ld = 1024; c.ldd = 256;
    c.src = p->w_ff2 + ((size_t)(l * 32 + e) * 256 + kt * 64) * 1024 + nt * 32;
    c.dst = wsp<u16>(p, OFF_W2) + ((size_t)e * 1024 + nt * 32) * 256 + kt * 64;
    return c;
  }
}
DEVI void conv_tile(const ConvT& c, char* lds) {
  float* t = (float*)lds;
  const int tid = TIDX;
  const int kk = tid >> 3, n4 = (tid & 7) * 4;
  __syncthreads();
#pragma unroll
  for (int i = 0; i < 2; ++i) {
    int k = kk + 32 * i;
    f32x4 v = f32x4{0.f, 0.f, 0.f, 0.f};
    if (c.src) v = *(const f32x4*)(c.src + (size_t)k * c.ld + n4);
    float s = c.ks ? c.ks[k] : 1.f;
    t[(n4 + 0) * 65 + k] = v.x * s; t[(n4 + 1) * 65 + k] = v.y * s;
    t[(n4 + 2) * 65 + k] = v.z * s; t[(n4 + 3) * 65 + k] = v.w * s;
  }
  __syncthreads();
  const int n = tid >> 3, k8 = (tid & 7) * 8;
  const float* r = t + n * 65 + k8;
  u32x4 o;
  o.x = pk2(r[0], r[1]); o.y = pk2(r[2], r[3]); o.z = pk2(r[4], r[5]); o.w = pk2(r[6], r[7]);
  *(u32x4*)(c.dst + (size_t)n * c.ldd + k8) = o;
}

DEVI void phase0(KP p, char* lds) {
  const int tid = TIDX;
  const int NITEM = 384 + 1 + 72 + CONV_ITEMS;
  for (int item = BIDX; item < NITEM; item += gridDim.x) {
    if (item < 384) {
      float* sc = (float*)lds;
      const int l = item / 192, rem = item % 192, cgp = rem >> 3, kc = rem & 7;
      __syncthreads();
      for (int i = tid; i < 9 * 128; i += 256) {
        int b = i >> 7, k = i & 127;
        float v = (b < 8) ? p->c[b * 1024 + kc * 128 + k] : p->c_ctx[kc * 128 + k];
        sc[i] = v / (1.f + expf(-v));
      }
      __syncthreads();
      float acc[9];
#pragma unroll
      for (int b = 0; b < 9; ++b) acc[b] = 0.f;
      const float* w = p->w_mod + ((size_t)l * 1024 + kc * 128) * 6144 + cgp * 256 + tid;
#pragma unroll 8
      for (int k = 0; k < 128; ++k) {
        float wv = w[(size_t)k * 6144];
#pragma unroll
        for (int b = 0; b < 9; ++b) acc[b] += sc[b * 128 + k] * wv;
      }
      float* dst = wsp<float>(p, OFF_MODP) + (size_t)((kc * 2 + l) * 9) * 6144 + cgp * 256 + tid;
#pragma unroll
      for (int b = 0; b < 9; ++b) dst[(size_t)b * 6144] = acc[b];
    } else if (item == 384) {
      float* cs32 = wsp<float>(p, OFF_CS32);
      float* cs16 = wsp<float>(p, OFF_CS16);
      for (int t = tid; t < 1024; t += 256) {
        int pos = t >> 4, i = t & 15;
        float ang = (float)pos * powf(10000.f, -(float)(2 * i) / 32.f);
        cs32[t * 2] = cosf(ang); cs32[t * 2 + 1] = sinf(ang);
      }
      for (int t = tid; t < 512; t += 256) {
        int pos = t >> 3, i = t & 7;
        float ang = (float)pos * powf(10000.f, -(float)(2 * i) / 16.f);
        cs16[t * 2] = cosf(ang); cs16[t * 2 + 1] = sinf(ang);
      }
    } else if (item < 385 + 72) {
      const int it = item - 385, l = it / 36, o = it % 36;
      float* dst = wsp<float>(p, OFF_WRT) + ((size_t)l * 36 + o) * 1024;
      for (int k = tid; k < 1024; k += 256)
        dst[k] = (o < 4) ? p->w_group[((size_t)l * 1024 + k) * 4 + o] : p->w_router[((size_t)l * 1024 + k) * 32 + (o - 4)];
    } else {
      ConvT c = conv_decode(p, 0, item - 457);
      conv_tile(c, lds);
    }
  }
}
DEVI void phase1(KP p) {
  const float* mp = wsp<float>(p, OFF_MODP);
  float* mo = wsp<float>(p, OFF_MOD);
  for (int i = BIDX * 256 + TIDX; i < 2 * 9 * 6144; i += gridDim.x * 256) {
    int l = i / (9 * 6144), o = i % 6144;
    float s = p->b_mod[l * 6144 + o];
#pragma unroll
    for (int kc = 0; kc < 8; ++kc) s += mp[(size_t)kc * 2 * 9 * 6144 + i];
    mo[i] = s;
  }
}

DEVI void modulate_row_store(KP p, int l, int which, const float (&xv)[16], int mrow, u16* hrow, float (&hv)[16]) {
  const int lane = TIDX & 63;
  float ss = 0.f;
#pragma unroll
  for (int i = 0; i < 16; ++i) ss += xv[i] * xv[i];
  ss = wave_sum(ss);
  const float rstd = rsqrtf(ss * (1.f / 1024.f) + EPS);
  const float* g = (which ? p->g_norm_ffn : p->g_norm_mix) + l * 1024;
  const float* mod = wsp<float>(p, OFF_MOD) + ((size_t)l * 9 + mrow) * 6144 + (which ? 3072 : 0);
#pragma unroll
  for (int i = 0; i < 4; ++i) {
    const int c = i * 256 + lane * 4;
    f32x4 gv = *(const f32x4*)(g + c);
    f32x4 sh = *(const f32x4*)(mod + c);
    f32x4 sc = *(const f32x4*)(mod + 1024 + c);
    hv[i * 4 + 0] = xv[i * 4 + 0] * rstd * gv.x * (1.f + sc.x) + sh.x;
    hv[i * 4 + 1] = xv[i * 4 + 1] * rstd * gv.y * (1.f + sc.y) + sh.y;
    hv[i * 4 + 2] = xv[i * 4 + 2] * rstd * gv.z * (1.f + sc.z) + sh.z;
    hv[i * 4 + 3] = xv[i * 4 + 3] * rstd * gv.w * (1.f + sc.w) + sh.w;
    u32x2 o; o.x = pk2(hv[i * 4 + 0], hv[i * 4 + 1]); o.y = pk2(hv[i * 4 + 2], hv[i * 4 + 3]);
    *(u32x2*)(hrow + c) = o;
  }
}
DEVI void load_row16(const float* xr, float (&xv)[16]) {
  const int lane = TIDX & 63;
#pragma unroll
  for (int i = 0; i < 4; ++i) {
    f32x4 v = *(const f32x4*)(xr + i * 256 + lane * 4);
    xv[i * 4 + 0] = v.x; xv[i * 4 + 1] = v.y; xv[i * 4 + 2] = v.z; xv[i * 4 + 3] = v.w;
  }
}
DEVI void phaseA(KP p) {
  const int gw = BIDX * 4 + (TIDX >> 6), nw = gridDim.x * 4;
  u16* H = wsp<u16>(p, OFF_H);
  for (int tok = gw; tok < NTOK; tok += nw) {
    const int b = tok / TPB, rr = tok % TPB;
    float xv[16], hv[16];
    load_row16(xrow_in(p, 0, b, rr), xv);
    modulate_row_store(p, 0, 0, xv, rr < NCTX ? 8 : b, H + (size_t)tok * 1024, hv);
  }
}

template <int BN, class AF>
DEVI void gemm_main(f32x16 (&acc)[2][BN / 64], AF arow, const u16* Bt, int ldb, int KT, char* lds) {
  constexpr int NI = BN / 64;
  constexpr int NBL = BN / 32;
  constexpr int STAGE = (128 + BN) * 144;
  const int tid = TIDX, lane = tid & 63, wave = tid >> 6;
  const int wm = wave >> 1, wn = wave & 1, r32 = lane & 31, hh = lane >> 5;
  const int srow = tid >> 3, scol = (tid & 7) * 8;
  const u16* ap[4];
#pragma unroll
  for (int i = 0; i < 4; ++i) ap[i] = arow(srow + 32 * i) + scol;
  const u16* bp = Bt + (size_t)srow * ldb + scol;
  u32x4 ra[4], rb[NBL];
  char* wA = lds + srow * 144 + scol * 2;
  char* wB = wA + 128 * 144;
  const char* rA = lds + (wm * 64 + r32) * 144 + hh * 16;
  const char* rB = lds + 128 * 144 + (wn * (BN / 2) + r32) * 144 + hh * 16;
#pragma unroll
  for (int i = 0; i < 4; ++i) ra[i] = *(const u32x4*)(ap[i]);
#pragma unroll
  for (int i = 0; i < NBL; ++i) rb[i] = *(const u32x4*)(bp + (size_t)32 * i * ldb);
  __syncthreads();
#pragma unroll
  for (int i = 0; i < 4; ++i) *(u32x4*)(wA + i * 32 * 144) = ra[i];
#pragma unroll
  for (int i = 0; i < NBL; ++i) *(u32x4*)(wB + i * 32 * 144) = rb[i];
  __syncthreads();
  for (int kt = 0; kt < KT; ++kt) {
    const int st = (kt & 1) * STAGE;
    const bool more = (kt + 1 < KT);
    if (more) {
#pragma unroll
      for (int i = 0; i < 4; ++i) ra[i] = *(const u32x4*)(ap[i] + (kt + 1) * 64);
#pragma unroll
      for (int i = 0; i < NBL; ++i) rb[i] = *(const u32x4*)(bp + (size_t)32 * i * ldb + (kt + 1) * 64);
    }
#pragma unroll
    for (int ks = 0; ks < 4; ++ks) {
      bf16x8 a[2], b[NI];
#pragma unroll
      for (int mi = 0; mi < 2; ++mi) a[mi] = *(const bf16x8*)(rA + st + mi * 32 * 144 + ks * 32);
#pragma unroll
      for (int ni = 0; ni < NI; ++ni) b[ni] = *(const bf16x8*)(rB + st + ni * 32 * 144 + ks * 32);
#pragma unroll
      for (int mi = 0; mi < 2; ++mi)
#pragma unroll
        for (int ni = 0; ni < NI; ++ni) acc[mi][ni] = MFMA(a[mi], b[ni], acc[mi][ni]);
    }
    if (more) {
      const int st2 = ((kt + 1) & 1) * STAGE;
#pragma unroll
      for (int i = 0; i < 4; ++i) *(u32x4*)(wA + st2 + i * 32 * 144) = ra[i];
#pragma unroll
      for (int i = 0; i < NBL; ++i) *(u32x4*)(wB + st2 + i * 32 * 144) = rb[i];
    }
    __syncthreads();
  }
}
template <int NI> DEVI void zero_acc(f32x16 (&acc)[2][NI]) {
#pragma unroll
  for (int mi = 0; mi < 2; ++mi)
#pragma unroll
    for (int ni = 0; ni < NI; ++ni)
#pragma unroll
      for (int i = 0; i < 16; ++i) acc[mi][ni][i] = 0.f;
}
DEVI void acc_to_lds(const f32x16 (&acc)[2][2], char* lds) {
  const int tid = TIDX, lane = tid & 63, wave = tid >> 6;
  const int wm = wave >> 1, wn = wave & 1, r32 = lane & 31, hh = lane >> 5;
  float* ct = (float*)lds;
#pragma unroll
  for (int mi = 0; mi < 2; ++mi)
#pragma unroll
    for (int ni = 0; ni < 2; ++ni)
#pragma unroll
      for (int i = 0; i < 16; ++i)
        ct[(wm * 64 + mi * 32 + (i & 3) + 8 * (i >> 2) + 4 * hh) * 132 + wn * 64 + ni * 32 + r32] = acc[mi][ni][i];
  __syncthreads();
}
DEVI void lds_row32(const float* rp, float (&v)[32]) {
#pragma unroll
  for (int j = 0; j < 8; ++j) {
    f32x4 t = *(const f32x4*)(rp + 4 * j);
    v[4 * j] = t.x; v[4 * j + 1] = t.y; v[4 * j + 2] = t.z; v[4 * j + 3] = t.w;
  }
}
DEVI float lds_ssq64(const float* rp) {
  float s = 0.f;
#pragma unroll
  for (int j = 0; j < 16; ++j) {
    f32x4 t = *(const f32x4*)(rp + 4 * j);
    s += t.x * t.x + t.y * t.y + t.z * t.z + t.w * t.w;
  }
  return s;
}
DEVI void store32(u16* dst, const float (&v)[32]) {
#pragma unroll
  for (int j = 0; j < 4; ++j) {
    u32x4 o;
    o.x = pk2(v[8 * j], v[8 * j + 1]); o.y = pk2(v[8 * j + 2], v[8 * j + 3]);
    o.z = pk2(v[8 * j + 4], v[8 * j + 5]); o.w = pk2(v[8 * j + 6], v[8 * j + 7]);
    *(u32x4*)(dst + 8 * j) = o;
  }
}
DEVI void storeT32(u16* vt, int pos, const float (&v)[32]) {
#pragma unroll
  for (int d = 0; d < 32; ++d) vt[(size_t)d * TPB + pos] = f2bf(v[d]);
}
DEVI void rope32(float (&v)[32], const float* cs32, int pos) {
  const f32x2* t = (const f32x2*)(cs32 + pos * 32);
#pragma unroll
  for (int i = 0; i < 16; ++i) {
    f32x2 cs = t[i];
    float x1 = v[i], x2 = v[16 + i];
    v[i] = x1 * cs.x - x2 * cs.y; v[16 + i] = x2 * cs.x + x1 * cs.y;
  }
}
DEVI void rope16x2(float (&v)[32], const float* cs16, int grow, int gcol) {
  const f32x2* tr = (const f32x2*)(cs16 + grow * 16);
  const f32x2* tc = (const f32x2*)(cs16 + gcol * 16);
#pragma unroll
  for (int i = 0; i < 8; ++i) {
    f32x2 cs = tr[i];
    float x1 = v[i], x2 = v[8 + i];
    v[i] = x1 * cs.x - x2 * cs.y; v[8 + i] = x2 * cs.x + x1 * cs.y;
    f32x2 cc = tc[i];
    float y1 = v[16 + i], y2 = v[24 + i];
    v[16 + i] = y1 * cc.x - y2 * cc.y; v[24 + i] = y2 * cc.x + y1 * cc.y;
  }
}

DEVI void phaseB(KP p, int l, char* lds) {
  const int G8 = gridDim.x >> 3, xcd = BIDX & 7, lb = BIDX >> 3;
  if (lb >= G8) return;
  const int tid = TIDX;
  const u16* H = wsp<u16>(p, OFF_H);
  const u16* W = wsp<u16>(p, OFF_WIN);
  const float* cs32 = wsp<float>(p, OFF_CS32);
  const float* cs16 = wsp<float>(p, OFF_CS16);
  const float QS = 0.125f * LOG2E;
  for (int n = lb; n < 34 * 18; n += G8) {
    const int nt = n % 18, mt = (n / 18) * 8 + xcd;
    const int b = mt / MT_PER_B, r0 = (mt % MT_PER_B) * 128;
    const bool ctxtile = r0 < NCTX;
    if (l == 1 && ctxtile && (nt == 0 || nt == 1 || nt == 4 || nt == 5 || nt == 8 || nt == 9 || nt == 14 || nt == 15)) continue;
    f32x16 acc[2][2];
    zero_acc<2>(acc);
    const u16* Ab = H + (size_t)mt * 128 * 1024;
    gemm_main<128>(acc, [&](int r) { return Ab + (size_t)r * 1024; }, W + (size_t)nt * 128 * 1024, 1024, 16, lds);
    acc_to_lds(acc, lds);
    const int row = tid & 127, half = tid >> 7;
    const float* rp = (const float*)lds + row * 132 + half * 64;
    const int rr = r0 + row;
    const size_t tok = (size_t)b * TPB + rr;
    const bool lat = rr >= NCTX;
    const int t = rr - NCTX, grow = (t >> 6) & 63, gcol = t & 63;
    const int pos = perm16(rr);
    const bool isnorm = (nt >= 14 && nt <= 16);
    const bool isrope = lat && (nt == 4 || nt == 5 || nt == 6 || isnorm);
    const bool isq = (nt == 4 || nt == 5 || nt == 8 || nt == 9 || nt == 14 || nt == 15);
    float mul = isq ? QS : 1.f;
    const float* gvec = ((nt == 16) ? p->g_k_d : p->g_q_d) + l * 64;
    if (nt < 3 || isnorm) {
      const float ss = lds_ssq64(rp);
      if (nt < 3) wsp<float>(p, OFF_SSQ)[tok * 8 + nt * 2 + half] = ss;
      else mul *= rsqrtf(ss * (1.f / 64.f) + EPS);
    }
    u16* dst = nullptr;
    u16* dstT = nullptr;
    if (nt < 3) dst = wsp<u16>(p, OFF_PA) + tok * 384 + nt * 128 + half * 64;
    else if (nt == 3) dst = wsp<u16>(p, OFF_KR) + tok * 32;
    else if (nt < 6) dst = wsp<u16>(p, OFF_QB) + tok * 256 + (nt - 4) * 128 + half * 64;
    else if (nt == 6) dst = wsp<u16>(p, OFF_KB) + tok * 128 + half * 64;
    else if (nt == 7) dstT = wsp<u16>(p, OFF_VBT) + (size_t)(b * 2 + half) * 64 * TPB;
    else if (nt < 10) dst = wsp<u16>(p, OFF_QC) + tok * 256 + (nt - 8) * 128 + half * 64;
    else if (nt < 12) dst = wsp<u16>(p, OFF_KC) + tok * 256 + (nt - 10) * 128 + half * 64;
    else if (nt < 14) dstT = wsp<u16>(p, OFF_VCT) + (size_t)(b * 4 + (nt - 12) * 2 + half) * 64 * TPB;
    else if (nt < 16) dst = wsp<u16>(p, OFF_QD) + tok * 256 + (nt - 14) * 128 + half * 64;
    else if (nt == 16) dst = wsp<u16>(p, OFF_KD) + tok * 128 + half * 64;
    else dstT = wsp<u16>(p, OFF_VDT) + (size_t)(b * 2 + half) * 64 * TPB;
#pragma unroll
    for (int g = 0; g < 2; ++g) {
      if (nt == 3 && (half == 1 || g == 1)) continue;
      float v[32];
      lds_row32(rp + 32 * g, v);
      if (isnorm) {
#pragma unroll
        for (int j = 0; j < 32; ++j) v[j] *= gvec[32 * g + j];
      }
#pragma unroll
      for (int j = 0; j < 32; ++j) v[j] *= mul;
      if (nt == 3) { if (lat) rope16x2(v, cs16, grow, gcol); }
      else if (isrope) rope32(v, cs32, g == 0 ? grow : gcol);
      if (dstT) storeT32(dstT + (size_t)(32 * g) * TPB, pos, v);
      else store32(dst + 32 * g, v);
    }
  }
}

DEVI void phaseC(KP p, int l, char* lds) {
  const int G8 = gridDim.x >> 3, xcd = BIDX & 7, lb = BIDX >> 3;
  if (lb >= G8) return;
  const int tid = TIDX;
  const u16* PA = wsp<u16>(p, OFF_PA);
  const float* cs16 = wsp<float>(p, OFF_CS16);
  const float QS = 0.10206207261596575f * LOG2E;
  for (int n = lb; n < 34 * 7; n += G8) {
    const int j = n % 7, mt = (n / 7) * 8 + xcd;
    const int b = mt / MT_PER_B, r0 = (mt % MT_PER_B) * 128;
    if (l == 1 && r0 < NCTX && j < 3) continue;
    f32x16 acc[2][2];
    zero_acc<2>(acc);
    const u16* Ab = PA + (size_t)mt * 128 * 384;
    if (j < 3) gemm_main<128>(acc, [&](int r) { return Ab + (size_t)r * 384; }, wsp<u16>(p, OFF_WQB) + (size_t)j * 128 * 256, 256, 4, lds);
    else gemm_main<128>(acc, [&](int r) { return Ab + (size_t)r * 384 + 256; }, wsp<u16>(p, OFF_WKVB) + (size_t)(j - 3) * 128 * 128, 128, 2, lds);
    acc_to_lds(acc, lds);
    const int row = tid & 127, half = tid >> 7;
    const float* rp = (const float*)lds + row * 132 + half * 64;
    const int rr = r0 + row;
    const size_t tok = (size_t)b * TPB + rr;
    const bool lat = rr >= NCTX;
    const int t = rr - NCTX, grow = (t >> 6) & 63, gcol = t & 63;
    const int pos = perm16(rr);
    const float* sq = wsp<float>(p, OFF_SSQ) + tok * 8;
    const float mul = (j < 3) ? rsqrtf((sq[0] + sq[1] + sq[2] + sq[3]) * (1.f / 256.f) + EPS) * QS
                              : rsqrtf((sq[4] + sq[5]) * (1.f / 128.f) + EPS);
#pragma unroll
    for (int g = 0; g < 2; ++g) {
      float v[32];
      lds_row32(rp + 32 * g, v);
#pragma unroll
      for (int jj = 0; jj < 32; ++jj) v[jj] *= mul;
      if (j < 3) {
        const int gc = j * 128 + half * 64 + 32 * g;
        if (lat && (gc % 96) == 64) rope16x2(v, cs16, grow, gcol);
        store32(wsp<u16>(p, OFF_QA) + tok * 384 + gc, v);
      } else {
        const int h = j - 3;
        if (half == 0) store32(wsp<u16>(p, OFF_KA) + tok * 256 + h * 64 + 32 * g, v);
        else storeT32(wsp<u16>(p, OFF_VAT) + ((size_t)(b * 4 + h) * 64 + 32 * g) * TPB, pos, v);
      }
    }
  }
}

template <int BR>
DEVI void attn_item(KP p, int l, int b, int hs, int qb, bool isctx, char* lds) {
  constexpr bool MLA = (BR == 0);
  constexpr bool GQA = (BR == 1 || BR == 3);
  constexpr int QBLK = GQA ? 64 : 128;
  constexpr int NKS = MLA ? 6 : 4;
  constexpr int STG = 9216 + 9216 + 5120;
  const int tid = TIDX, lane = tid & 63, wave = tid >> 6;
  const int r32 = lane & 31, hh = lane >> 5;
  const int hq = GQA ? (hs * 2 + (wave & 1)) : hs;
  const int woff = GQA ? 32 * (wave >> 1) : 32 * wave;
  const int q0 = (isctx ? 0 : NCTX) + qb * QBLK;
  const size_t tokq = (size_t)b * TPB + q0 + woff + r32;
  const u16* Qp; const u16* Kp; int ldk; const u16* Vt; int obase;
  if (BR == 0) { Qp = wsp<u16>(p, OFF_QA) + tokq * 384 + hq * 96; Kp = wsp<u16>(p, OFF_KA) + (size_t)b * TPB * 256 + hs * 64; ldk = 256; Vt = wsp<u16>(p, OFF_VAT) + (size_t)(b * 4 + hs) * 64 * TPB; obase = hq * 64; }
  else if (BR == 1) { Qp = wsp<u16>(p, OFF_QB) + tokq * 256 + hq * 64; Kp = wsp<u16>(p, OFF_KB) + (size_t)b * TPB * 128 + hs * 64; ldk = 128; Vt = wsp<u16>(p, OFF_VBT) + (size_t)(b * 2 + hs) * 64 * TPB; obase = 256 + hq * 64; }
  else if (BR == 2) { Qp = wsp<u16>(p, OFF_QC) + tokq * 256 + hq * 64; Kp = wsp<u16>(p, OFF_KC) + (size_t)b * TPB * 256 + hs * 64; ldk = 256; Vt = wsp<u16>(p, OFF_VCT) + (size_t)(b * 4 + hs) * 64 * TPB; obase = 512 + hq * 64; }
  else { Qp = wsp<u16>(p, OFF_QD) + tokq * 256 + hq * 64; Kp = wsp<u16>(p, OFF_KD) + (size_t)b * TPB * 128 + hs * 64; ldk = 128; Vt = wsp<u16>(p, OFF_VDT) + (size_t)(b * 2 + hs) * 64 * TPB; obase = 768 + hq * 64; }
  const u16* KRp = wsp<u16>(p, OFF_KR) + (size_t)b * TPB * 32;
  int lat_lo = 0, lat_n = 0;
  if (!isctx) {
    if (BR == 0 || BR == 3) { lat_lo = 0; lat_n = 64; }
    else if (BR == 1) { const int ql = qb * 64; const int lo = max(0, ql - 128) >> 6, hi = min(SEQ - 1, ql + 63 + 128) >> 6; lat_lo = lo; lat_n = hi - lo + 1; }
    else { const int lo = min(max(2 * qb - 4, 0), 56), hi = min(max(2 * qb + 1 - 4, 0), 56) + 7; lat_lo = lo; lat_n = hi - lo + 1; }
  }
  const int NT = 4 + lat_n;
  const int qlat = qb * QBLK + woff + r32;
  const int qrow = qlat >> 6, qcol = qlat & 63;
  bf16x8 qf[NKS];
#pragma unroll
  for (int ks = 0; ks < NKS; ++ks) qf[ks] = *(const bf16x8*)(Qp + ks * 16 + hh * 8);
  const int srow = tid >> 3, sc8 = (tid & 7) * 8;
  const int krow_ = tid >> 2, kc8 = (tid & 3) * 8;
  u32x4 rk[2], rv[2], rkr;
  auto keytile = [&](int j) { return (j < 4) ? j : (4 + lat_lo + (j - 4)); };
  auto gload = [&](int j) {
    const int key0 = keytile(j) * 64;
#pragma unroll
    for (int i = 0; i < 2; ++i) {
      rk[i] = *(const u32x4*)(Kp + (size_t)(key0 + srow + 32 * i) * ldk + sc8);
      rv[i] = *(const u32x4*)(Vt + (size_t)(srow + 32 * i) * TPB + key0 + sc8);
    }
    if (MLA) rkr = *(const u32x4*)(KRp + (size_t)(key0 + krow_) * 32 + kc8);
  };
  auto lwrite = [&](int st) {
    char* base = lds + st * STG;
#pragma unroll
    for (int i = 0; i < 2; ++i) {
      *(u32x4*)(base + (srow + 32 * i) * 144 + sc8 * 2) = rk[i];
      *(u32x4*)(base + 9216 + (srow + 32 * i) * 144 + sc8 * 2) = rv[i];
    }
    if (MLA) *(u32x4*)(base + 18432 + krow_ * 80 + kc8 * 2) = rkr;
  };
  float* rpb = (float*)(lds + 2 * STG);
  gload(0);
  __syncthreads();
  if (BR == 2 && !isctx) {
    const float* src = p->rpb_c + (size_t)(l * 4 + hs) * 465;
    for (int i = tid; i < 465; i += 256) rpb[i] = src[i] * LOG2E;
  }
  lwrite(0);
  __syncthreads();
  f32x16 o[2];
#pragma unroll
  for (int i = 0; i < 16; ++i) { o[0][i] = 0.f; o[1][i] = 0.f; }
  float m_run = -INFINITY, l_run = 0.f;
  if (BR == 1) { m_run = p->sink_b[l * 4 + hq] * LOG2E; l_run = (hh == 0) ? 1.f : 0.f; }
  const char* kfb = lds + r32 * 144 + hh * 16;
  const char* vfb = lds + 9216 + r32 * 144 + hh * 16;
  const char* krb = lds + 18432 + r32 * 80 + hh * 16;
  for (int j = 0; j < NT; ++j) {
    const int st = (j & 1) * STG;
    const bool more = (j + 1 < NT);
    if (more) gload(j + 1);
    f32x16 s[2];
#pragma unroll
    for (int kb = 0; kb < 2; ++kb) {
#pragma unroll
      for (int i = 0; i < 16; ++i) s[kb][i] = 0.f;
#pragma unroll
      for (int ks = 0; ks < 4; ++ks) {
        bf16x8 kf = *(const bf16x8*)(kfb + st + kb * 32 * 144 + ks * 32);
        s[kb] = MFMA(kf, qf[ks], s[kb]);
      }
      if (MLA) {
#pragma unroll
        for (int ks = 0; ks < 2; ++ks) {
          bf16x8 kf = *(const bf16x8*)(krb + st + kb * 32 * 80 + ks * 32);
          s[kb] = MFMA(kf, qf[4 + ks], s[kb]);
        }
      }
    }
    if ((BR == 1 || BR == 2) && j >= 4) {
      const int kt = lat_lo + (j - 4);
      if (BR == 1) {
#pragma unroll
        for (int kb = 0; kb < 2; ++kb)
#pragma unroll
          for (int i = 0; i < 16; ++i) {
            const int kpos = kt * 64 + kb * 32 + (i & 3) + 8 * (i >> 2) + 4 * hh;
            const int d = qlat - kpos;
            if (d > 128 || d < -128) s[kb][i] = -1e30f;
          }
      } else {
        const int rs = min(max(qrow - 4, 0), 56);
        const bool row_ok = (kt >= rs) && (kt < rs + 8);
        const int cst = min(max(qcol - 8, 0), 48);
        const int dr = kt - qrow + 7;
#pragma unroll
        for (int kb = 0; kb < 2; ++kb)
#pragma unroll
          for (int i = 0; i < 16; ++i) {
            const int kc = kb * 32 + (i & 3) + 8 * (i >> 2) + 4 * hh;
            const bool ok = row_ok && (kc >= cst) && (kc < cst + 16);
            const int idx = ok ? (dr * 31 + (kc - qcol + 15)) : 0;
            const float bias = rpb[idx];
            s[kb][i] = ok ? (s[kb][i] + bias) : -1e30f;
          }
      }
    }
    float mx = s[0][0];
#pragma unroll
    for (int i = 1; i < 16; ++i) mx = fmaxf(mx, s[0][i]);
#pragma unroll
    for (int i = 0; i < 16; ++i) mx = fmaxf(mx, s[1][i]);
    mx = fmaxf(mx, __shfl_xor(mx, 32));
    const float m_new = fmaxf(m_run, mx);
    const float alpha = exp2f(m_run - m_new);
    m_run = m_new;
    float ls = 0.f;
#pragma unroll
    for (int kb = 0; kb < 2; ++kb)
#pragma unroll
      for (int i = 0; i < 16; ++i) { const float e = exp2f(s[kb][i] - m_new); s[kb][i] = e; ls += e; }
    l_run = l_run * alpha + ls;
    if (__any(alpha != 1.f)) {
#pragma unroll
      for (int i = 0; i < 16; ++i) { o[0][i] *= alpha; o[1][i] *= alpha; }
    }
#pragma unroll
    for (int s4 = 0; s4 < 4; ++s4) {
      const int kb = s4 >> 1, rb = (s4 & 1) * 8;
      u32x4 pw;
      pw.x = pk2(s[kb][rb + 0], s[kb][rb + 1]); pw.y = pk2(s[kb][rb + 2], s[kb][rb + 3]);
      pw.z = pk2(s[kb][rb + 4], s[kb][rb + 5]); pw.w = pk2(s[kb][rb + 6], s[kb][rb + 7]);
      const bf16x8 pf = __builtin_bit_cast(bf16x8, pw);
#pragma unroll
      for (int db = 0; db < 2; ++db) {
        bf16x8 vf = *(const bf16x8*)(vfb + st + db * 32 * 144 + s4 * 32);
        o[db] = MFMA(vf, pf, o[db]);
      }
    }
    if (more) lwrite((j + 1) & 1);
    __syncthreads();
  }
  const float lt = l_run + __shfl_xor(l_run, 32);
  const float inv = 1.f / lt;
  u16* Op = wsp<u16>(p, OFF_O) + tokq * 1024 + obase;
#pragma unroll
  for (int db = 0; db < 2; ++db)
#pragma unroll
    for (int g = 0; g < 4; ++g) {
      u32x2 w;
      w.x = pk2(o[db][4 * g] * inv, o[db][4 * g + 1] * inv);
      w.y = pk2(o[db][4 * g + 2] * inv, o[db][4 * g + 3] * inv);
      *(u32x2*)(Op + db * 32 + 8 * g + 4 * hh) = w;
    }
}
DEVI void phaseD(KP p, int l, char* lds) {
  const int G8 = gridDim.x >> 3, xcd = BIDX & 7, lb = BIDX >> 3;
  if (lb >= G8) return;
  const int NLOC = 512 + (l == 0 ? 32 : 0);
  for (int n = lb; n < NLOC; n += G8) {
    int br, s, qb; bool isctx = false;
    if (n < 128) { br = 0; s = xcd + 8 * (n >> 5); qb = n & 31; }
    else if (n < 256) { const int m = n - 128; br = 3; s = xcd + 8 * (m >> 6); qb = m & 63; }
    else if (n < 384) { const int m = n - 256; br = 2; s = xcd + 8 * (m >> 5); qb = m & 31; }
    else if (n < 512) { const int m = n - 384; br = 1; s = xcd + 8 * (m >> 6); qb = m & 63; }
    else {
      const int m = n - 512; isctx = true;
      if (m < 8) { br = 0; s = xcd + 8 * (m >> 1); qb = m & 1; }
      else if (m < 16) { const int mm = m - 8; br = 3; s = xcd + 8 * (mm >> 2); qb = mm & 3; }
      else if (m < 24) { const int mm = m - 16; br = 2; s = xcd + 8 * (mm >> 1); qb = mm & 1; }
      else { const int mm = m - 24; br = 1; s = xcd + 8 * (mm >> 2); qb = mm & 3; }
    }
    if (br == 0) attn_item<0>(p, l, s >> 2, s & 3, qb, isctx, lds);
    else if (br == 1) attn_item<1>(p, l, s >> 1, s & 1, qb, isctx, lds);
    else if (br == 2) attn_item<2>(p, l, s >> 2, s & 3, qb, isctx, lds);
    else attn_item<3>(p, l, s >> 1, s & 1, qb, isctx, lds);
  }
}

DEVI void phaseE(KP p, int l, char* lds) {
  const int G8 = gridDim.x >> 3, xcd = BIDX & 7, lb = BIDX >> 3;
  if (BIDX == 0 && TIDX < 32) wsp<int>(p, OFF_CNT)[TIDX] = 0;
  if (lb >= G8) return;
  const int tid = TIDX, lane = tid & 63, wave = tid >> 6;
  const int wm = wave >> 1, wn = wave & 1, r32 = lane & 31, hh = lane >> 5;
  const u16* H = wsp<u16>(p, OFF_H);
  const u16* O = wsp<u16>(p, OFF_O);
  u16* Y = wsp<u16>(p, OFF_YPRE);
  for (int n = lb; n < 34 * 16; n += G8) {
    const int nt = n & 15, mt = (n >> 4) * 8 + xcd;
    if (l == 1 && (mt % MT_PER_B) < 2) continue;
    f32x16 y[2][1];
    zero_acc<1>(y);
    const int col = nt * 64 + wn * 32 + r32;
#pragma unroll 1
    for (int br = 0; br < 4; ++br) {
      f32x16 ag[2][1], ab[2][1];
      zero_acc<1>(ag); zero_acc<1>(ab);
      const u16* Ab = H + (size_t)mt * 128 * 1024;
      gemm_main<64>(ag, [&](int r) { return Ab + (size_t)r * 1024; }, wsp<u16>(p, OFF_WGATE) + ((size_t)br * 1024 + nt * 64) * 1024, 1024, 16, lds);
      const u16* Ob = O + (size_t)mt * 128 * 1024 + br * 256;
      gemm_main<64>(ab, [&](int r) { return Ob + (size_t)r * 1024; }, wsp<u16>(p, OFF_WBR) + ((size_t)br * 1024 + nt * 64) * 256, 256, 4, lds);
      const float bias = p->b_gate[(size_t)(l * 4 + br) * 1024 + col];
#pragma unroll
      for (int mi = 0; mi < 2; ++mi)
#pragma unroll
        for (int i = 0; i < 16; ++i) {
          const float g = 1.f / (1.f + __expf(-(ag[mi][0][i] + bias)));
          y[mi][0][i] += g * ab[mi][0][i];
        }
    }
#pragma unroll
    for (int mi = 0; mi < 2; ++mi)
#pragma unroll
      for (int i = 0; i < 16; ++i) {
        const int row = wm * 64 + mi * 32 + (i & 3) + 8 * (i >> 2) + 4 * hh;
        Y[((size_t)mt * 128 + row) * 1024 + col] = f2bf(y[mi][0][i]);
      }
  }
}
DEVI void phaseF(KP p, int l, char* lds) {
  const int G8 = gridDim.x >> 3, xcd = BIDX & 7, lb = BIDX >> 3;
  if (lb >= G8) return;
  const int tid = TIDX, lane = tid & 63, wave = tid >> 6;
  const int wm = wave >> 1, wn = wave & 1, r32 = lane & 31, hh = lane >> 5;
  const u16* Y = wsp<u16>(p, OFF_YPRE);
  for (int n = lb; n < 34 * 8; n += G8) {
    const int nt = n & 7, mt = (n >> 3) * 8 + xcd;
    const int b = mt / MT_PER_B, r0 = (mt % MT_PER_B) * 128;
    if (l == 1 && r0 < NCTX) continue;
    f32x16 acc[2][2];
    zero_acc<2>(acc);
    const u16* Ab = Y + (size_t)mt * 128 * 1024;
    gemm_main<128>(acc, [&](int r) { return Ab + (size_t)r * 1024; }, wsp<u16>(p, OFF_WOUT) + (size_t)nt * 128 * 1024, 1024, 16, lds);
    acc_to_lds(acc, lds);
    const int mrow = (r0 < NCTX) ? 8 : b;
    const int c4 = (tid & 31) * 4;
    const f32x4 g = *(const f32x4*)(wsp<float>(p, OFF_MOD) + ((size_t)l * 9 + mrow) * 6144 + 2048 + nt * 128 + c4);
    const float* xin = xrow_in(p, l, b, r0) + nt * 128 + c4;
    float* xout = xrow_res(p, b, r0) + nt * 128 + c4;
    const float* ct = (const float*)lds + c4;
#pragma unroll 4
    for (int it = 0; it < 16; ++it) {
      const int row = it * 8 + (tid >> 5);
      const f32x4 a = *(const f32x4*)(ct + row * 132);
      const f32x4 xo = *(const f32x4*)(xin + (size_t)row * 1024);
      *(f32x4*)(xout + (size_t)row * 1024) = f32x4{xo.x + g.x * a.x, xo.y + g.y * a.y, xo.z + g.z * a.z, xo.w + g.w * a.w};
    }
  }
}

DEVI float router_dot(const float (&hv)[4][16], const float* wrow) {
  const int lane = TIDX & 63;
  const float* w = wrow + lane * 4;
  float pr[4] = {0.f, 0.f, 0.f, 0.f};
#pragma unroll
  for (int i = 0; i < 4; ++i) {
    const f32x4 wv = *(const f32x4*)(w + i * 256);
#pragma unroll
    for (int r = 0; r < 4; ++r)
      pr[r] += hv[r][i * 4] * wv.x + hv[r][i * 4 + 1] * wv.y + hv[r][i * 4 + 2] * wv.z + hv[r][i * 4 + 3] * wv.w;
  }
  const bool up = (lane & 32) != 0;
  float s0 = up ? pr[0] : pr[2], s1 = up ? pr[1] : pr[3];
  float k0 = up ? pr[2] : pr[0], k1 = up ? pr[3] : pr[1];
  k0 += __shfl_xor(s0, 32); k1 += __shfl_xor(s1, 32);
  const bool up2 = (lane & 16) != 0;
  float sv = up2 ? k0 : k1, kv = up2 ? k1 : k0;
  kv += __shfl_xor(sv, 16);
  kv += __shfl_xor(kv, 8); kv += __shfl_xor(kv, 4); kv += __shfl_xor(kv, 2); kv += __shfl_xor(kv, 1);
  return kv;
}
DEVI void phaseG(KP p, int l) {
  const int lane = TIDX & 63;
  const int gw = BIDX * 4 + (TIDX >> 6), nw = gridDim.x * 4;
  u16* H = wsp<u16>(p, OFF_H);
  const float* WRT = wsp<float>(p, OFF_WRT) + (size_t)l * 36 * 1024;
  int* cnt = wsp<int>(p, OFF_CNT);
  int* list = wsp<int>(p, OFF_LIST);
  float* wlist = wsp<float>(p, OFF_WLIST);
  const int qd = lane >> 4;
  for (int task = gw; task < NTOK / 4; task += nw) {
    const int tok0 = task * 4;
    const int b = tok0 / TPB, rr0 = tok0 % TPB;
    if (l == 1 && rr0 < NCTX) continue;
    float hv[4][16];
#pragma unroll
    for (int r = 0; r < 4; ++r) {
      float xv[16];
      load_row16(xrow_res(p, b, rr0 + r), xv);
      modulate_row_store(p, l, 1, xv, (rr0 < NCTX) ? 8 : b, H + (size_t)(tok0 + r) * 1024, hv[r]);
    }
    float gl[4], e8[8];
    int gs = 0;
#pragma unroll
    for (int o = 0; o < 4; ++o) gl[o] = router_dot(hv, WRT + (size_t)o * 1024) + p->b_group[l * 4 + o];
    {
      float best = gl[0];
#pragma unroll
      for (int j = 1; j < 4; ++j) if (gl[j] > best) { best = gl[j]; gs = j; }
    }
    const unsigned gmask = (1u << __shfl(gs, 0)) | (1u << __shfl(gs, 16)) | (1u << __shfl(gs, 32)) | (1u << __shfl(gs, 48));
#pragma unroll
    for (int j = 0; j < 8; ++j) e8[j] = -INFINITY;
#pragma unroll 1
    for (int e = 0; e < 32; ++e) {
      if (!((gmask >> (e >> 3)) & 1u)) continue;
      const float kv = router_dot(hv, WRT + (size_t)(4 + e) * 1024) + p->b_router[l * 32 + e];
      const bool sel = (e >> 3) == gs;
#pragma unroll
      for (int j = 0; j < 8; ++j) e8[j] = (sel && (e & 7) == j) ? kv : e8[j];
    }
    float gmax = fmaxf(fmaxf(gl[0], gl[1]), fmaxf(gl[2], gl[3]));
    float gsum = 0.f;
#pragma unroll
    for (int j = 0; j < 4; ++j) gsum += expf(gl[j] - gmax);
    const float gw_ = 1.f / gsum;
    int i0 = 0; float v0 = e8[0];
#pragma unroll
    for (int j = 1; j < 8; ++j) if (e8[j] > v0) { v0 = e8[j]; i0 = j; }
    int i1 = -1; float v1 = -INFINITY;
#pragma unroll
    for (int j = 0; j < 8; ++j) if (j != i0 && e8[j] > v1) { v1 = e8[j]; i1 = j; }
    const float ex = expf(v1 - v0);
    const float w0 = gw_ / (1.f + ex), w1 = gw_ * ex / (1.f + ex);
    if ((lane & 15) == 0) {
      const int tok = tok0 + qd;
      const int ea = gs * 8 + i0, eb = gs * 8 + i1;
      int sa = atomicAdd(&cnt[ea], 1);
      list[(size_t)ea * NTOK + sa] = tok * 2; wlist[(size_t)ea * NTOK + sa] = w0;
      int sb = atomicAdd(&cnt[eb], 1);
      list[(size_t)eb * NTOK + sb] = tok * 2 + 1; wlist[(size_t)eb * NTOK + sb] = w1;
    }
  }
}

struct ExpInfo { int tiles[4], base[4], cnt[4]; };
DEVI ExpInfo exp_info(KP p, int xcd) {
  const int* cnt = wsp<int>(p, OFF_CNT);
  ExpInfo ei;
  int before = 0;
#pragma unroll
  for (int e = 0; e < 32; ++e) {
    const int c = cnt[e], t = (c + 127) >> 7;
    if ((e & 7) == xcd) { ei.tiles[e >> 3] = t; ei.base[e >> 3] = before; ei.cnt[e >> 3] = c; }
    before += t;
  }
  return ei;
}
DEVI void phaseI1(KP p, char* lds) {
  const int G8 = gridDim.x >> 3, xcd = BIDX & 7, lb = BIDX >> 3;
  if (lb >= G8) return;
  const int tid = TIDX, lane = tid & 63, wave = tid >> 6;
  const int wm = wave >> 1, wn = wave & 1, r32 = lane & 31, hh = lane >> 5;
  const ExpInfo ei = exp_info(p, xcd);
  const int tot = (ei.tiles[0] + ei.tiles[1] + ei.tiles[2] + ei.tiles[3]) * 4;
  const u16* H = wsp<u16>(p, OFF_H);
  const int* list = wsp<int>(p, OFF_LIST);
  u16* U = wsp<u16>(p, OFF_U);
  for (int n = lb; n < tot; n += G8) {
    int k = 0, m = n >> 2; const int nt = n & 3;
    int tb = ei.base[0], ce = ei.cnt[0];
#pragma unroll
    for (int kk = 0; kk < 3; ++kk) {
      if (k == kk && m >= ei.tiles[kk]) { m -= ei.tiles[kk]; k = kk + 1; tb = ei.base[kk + 1]; ce = ei.cnt[kk + 1]; }
    }
    const int e = xcd + 8 * k;
    const int* le = list + (size_t)e * NTOK + m * 128;
    const int nvalid = ce - m * 128;
    f32x16 acc[2][2];
    zero_acc<2>(acc);
    gemm_main<128>(acc, [&](int r) { const int t = (r < nvalid) ? (le[r] >> 1) : 0; return H + (size_t)t * 1024; },
                   wsp<u16>(p, OFF_W13) + ((size_t)e * 512 + nt * 128) * 1024, 1024, 16, lds);
    const size_t urow0 = (size_t)(tb + m) * 128;
    const int col = nt * 64 + wn * 32 + r32;
#pragma unroll
    for (int mi = 0; mi < 2; ++mi)
#pragma unroll
      for (int i = 0; i < 16; ++i) {
        const int row = wm * 64 + mi * 32 + (i & 3) + 8 * (i >> 2) + 4 * hh;
        const float g = acc[mi][0][i], u = acc[mi][1][i];
        const float sv = g / (1.f + __expf(-g)) * u;
        U[(urow0 + row) * 256 + col] = f2bf(sv);
      }
  }
}
DEVI void phaseI2(KP p, char* lds) {
  const int G8 = gridDim.x >> 3, xcd = BIDX & 7, lb = BIDX >> 3;
  if (lb >= G8) return;
  const int tid = TIDX, lane = tid & 63, wave = tid >> 6;
  const int wm = wave >> 1, wn = wave & 1, r32 = lane & 31, hh = lane >> 5;
  const ExpInfo ei = exp_info(p, xcd);
  const int tot = (ei.tiles[0] + ei.tiles[1] + ei.tiles[2] + ei.tiles[3]) * 8;
  const int* list = wsp<int>(p, OFF_LIST);
  const float* wlist = wsp<float>(p, OFF_WLIST);
  const u16* U = wsp<u16>(p, OFF_U);
  u16* YS = wsp<u16>(p, OFF_YS);
  for (int n = lb; n < tot; n += G8) {
    int k = 0, m = n >> 3; const int nt = n & 7;
    int tb = ei.base[0], ce = ei.cnt[0];
#pragma unroll
    for (int kk = 0; kk < 3; ++kk) {
      if (k == kk && m >= ei.tiles[kk]) { m -= ei.tiles[kk]; k = kk + 1; tb = ei.base[kk + 1]; ce = ei.cnt[kk + 1]; }
    }
    const int e = xcd + 8 * k;
    const int nvalid = ce - m * 128;
    f32x16 acc[2][2];
    zero_acc<2>(acc);
    const u16* Ab = U + (size_t)(tb + m) * 128 * 256;
    gemm_main<128>(acc, [&](int r) { return Ab + (size_t)r * 256; }, wsp<u16>(p, OFF_W2) + ((size_t)e * 1024 + nt * 128) * 256, 256, 4, lds);
    const int* le = list + (size_t)e * NTOK + m * 128;
    const float* we = wlist + (size_t)e * NTOK + m * 128;
#pragma unroll
    for (int mi = 0; mi < 2; ++mi)
#pragma unroll
      for (int i = 0; i < 16; ++i) {
        const int row = wm * 64 + mi * 32 + (i & 3) + 8 * (i >> 2) + 4 * hh;
        if (row < nvalid) {
          const int dest = le[row]; const float w = we[row];
#pragma unroll
          for (int ni = 0; ni < 2; ++ni)
            YS[(size_t)dest * 1024 + nt * 128 + wn * 64 + ni * 32 + r32] = f2bf(acc[mi][ni][i] * w);
        }
      }
  }
}
DEVI void phaseJ(KP p, int l, char* lds) {
  const int lane = TIDX & 63;
  const int gw = BIDX * 4 + (TIDX >> 6), nw = gridDim.x * 4;
  const u16* YS = wsp<u16>(p, OFF_YS);
  u16* H = wsp<u16>(p, OFF_H);
  for (int tok = gw; tok < NTOK; tok += nw) {
    const int b = tok / TPB, rr = tok % TPB;
    if (l == 1 && rr < NCTX) continue;
    const int mrow = (rr < NCTX) ? 8 : b;
    float* xr = xrow_res(p, b, rr);
    const float* gt = wsp<float>(p, OFF_MOD) + ((size_t)l * 9 + mrow) * 6144 + 5120;
    float xv[16];
    load_row16(xr, xv);
#pragma unroll
    for (int i = 0; i < 4; ++i) {
      const int c = i * 256 + lane * 4;
      const u32x2 y0 = *(const u32x2*)(YS + (size_t)(tok * 2) * 1024 + c);
      const u32x2 y1 = *(const u32x2*)(YS + (size_t)(tok * 2 + 1) * 1024 + c);
      const f32x4 g = *(const f32x4*)(gt + c);
      xv[i * 4 + 0] += g.x * (bf2f((u16)(y0.x & 0xffff)) + bf2f((u16)(y1.x & 0xffff)));
      xv[i * 4 + 1] += g.y * (bf2f((u16)(y0.x >> 16)) + bf2f((u16)(y1.x >> 16)));
      xv[i * 4 + 2] += g.z * (bf2f((u16)(y0.y & 0xffff)) + bf2f((u16)(y1.y & 0xffff)));
      xv[i * 4 + 3] += g.w * (bf2f((u16)(y0.y >> 16)) + bf2f((u16)(y1.y >> 16)));
    }
    if (l == 0) {
#pragma unroll
      for (int i = 0; i < 4; ++i)
        *(f32x4*)(xr + i * 256 + lane * 4) = f32x4{xv[i * 4], xv[i * 4 + 1], xv[i * 4 + 2], xv[i * 4 + 3]};
      float hv[16];
      modulate_row_store(p, 1, 0, xv, mrow, H + (size_t)tok * 1024, hv);
    } else {
      float ss = 0.f;
#pragma unroll
      for (int i = 0; i < 16; ++i) ss += xv[i] * xv[i];
      ss = wave_sum(ss);
      const float rstd = rsqrtf(ss * (1.f / 1024.f) + EPS);
#pragma unroll
      for (int i = 0; i < 4; ++i) {
        const int c = i * 256 + lane * 4;
        const f32x4 g = *(const f32x4*)(p->g_final + c);
        *(f32x4*)(xr + c) = f32x4{xv[i * 4] * rstd * g.x, xv[i * 4 + 1] * rstd * g.y, xv[i * 4 + 2] * rstd * g.z, xv[i * 4 + 3] * rstd * g.w};
      }
    }
  }
  if (l == 0) {
    for (int item = BIDX; item < CONV_ITEMS; item += gridDim.x) {
      ConvT c = conv_decode(p, 1, item);
      conv_tile(c, lds);
    }
  }
}

constexpr int N_PHASES = 21;
__global__ void __launch_bounds__(256, 2) fwd_megakernel(Params parg) {
  __shared__ __attribute__((aligned(16))) char smem[SMEM_BYTES];
  cg::grid_group grid = cg::this_grid();
  for (int ph = parg.ph_begin; ph < parg.ph_end; ++ph) {
    KP p = (KP)__builtin_amdgcn_kernarg_segment_ptr();
    asm volatile("" : "+s"(p));
    if (ph == 0) phase0(p, smem);
    else if (ph == 1) phase1(p);
    else if (ph == 2) phaseA(p);
    else {
      const int l = (ph >= 12) ? 1 : 0;
      const int k = (ph >= 12) ? (ph - 12) : (ph - 3);
      switch (k) {
        case 0: phaseB(p, l, smem); break;
        case 1: phaseC(p, l, smem); break;
        case 2: phaseD(p, l, smem); break;
        case 3: phaseE(p, l, smem); break;
        case 4: phaseF(p, l, smem); break;
        case 5: phaseG(p, l); break;
        case 6: phaseI1(p, smem); break;
        case 7: phaseI2(p, smem); break;
        default: phaseJ(p, l, smem); break;
      }
    }
    if (ph + 1 < parg.ph_end) grid.sync();
  }
}

extern "C" void kernel_launch(void* const* d_in, const int* in_sizes, int n_in, void* d_out, int out_size,
                              void* d_ws, size_t ws_size, hipStream_t stream) {
  static int grid_blocks = 0;
  if (!grid_blocks) {
    int dev = 0, cus = 0, per_cu = 0;
    hipGetDevice(&dev);
    hipDeviceGetAttribute(&cus, hipDeviceAttributeMultiprocessorCount, dev);
    hipOccupancyMaxActiveBlocksPerMultiprocessor(&per_cu, fwd_megakernel, 256, 0);
    if (per_cu > 2) per_cu = 2;
    if (per_cu < 1) per_cu = 1;
    grid_blocks = (cus * per_cu) & ~7;
  }
  if (ws_size < WS_NEEDED) { fprintf(stderr, "workspace too small: %zu < %zu\n", ws_size, (size_t)WS_NEEDED); return; }
  Params hp{};
  const float** f = (const float**)&hp;
  for (int i = 0; i < 29; ++i) f[i] = (const float*)d_in[i];
  hp.out = (float*)d_out;
  hp.ws = (char*)d_ws;
#if N_LAUNCH_MODE == 1
  for (int ph = 0; ph < N_PHASES; ++ph) {
    hp.ph_begin = ph; hp.ph_end = ph + 1;
    void* args[] = {&hp};
    hipError_t e = hipLaunchCooperativeKernel((void*)fwd_megakernel, dim3(grid_blocks), dim3(256), args, 0, stream);
    if (e != hipSuccess) fprintf(stderr, "launch failed: %s\n", hipGetErrorString(e));
  }
#else
  hp.ph_begin = 0; hp.ph_end = N_PHASES;
  void* args[] = {&hp};
  hipError_t e = hipLaunchCooperativeKernel((void*)fwd_megakernel, dim3(grid_blocks), dim3(256), args, 0, stream);
  if (e != hipSuccess) fprintf(stderr, "cooperative launch failed: %s (grid %d)\n", hipGetErrorString(e), grid_blocks);
#endif
}
```

```cpp
#include <hip/hip_runtime.h>
#include <hip/hip_cooperative_groups.h>
#include <stdint.h>
#include <stdio.h>
namespace cg = cooperative_groups;

#ifndef N_LAUNCH_MODE
#define N_LAUNCH_MODE 0
#endif

#ifndef PROBE_DUP
#define PROBE_DUP 0
#endif
#define DEVI __device__ __forceinline__
typedef unsigned short u16;
typedef __attribute__((ext_vector_type(2))) float f32x2;
typedef __attribute__((ext_vector_type(2))) __bf16 bf16x2_t;
typedef __attribute__((ext_vector_type(8))) short bf16x8;
typedef __attribute__((ext_vector_type(16))) float f32x16;
typedef __attribute__((ext_vector_type(4))) unsigned u32x4;
typedef __attribute__((ext_vector_type(2))) unsigned u32x2;
typedef __attribute__((ext_vector_type(4))) float f32x4;
#define MFMA(a, b, c) __builtin_amdgcn_mfma_f32_32x32x16_bf16((a), (b), (c), 0, 0, 0)

constexpr int DMODEL = 1024, NBATCH = 8, SEQ = 4096, NCTX = 256;
constexpr int TPB = SEQ + NCTX;
constexpr int NTOK = NBATCH * TPB;
constexpr int MT_PER_B = TPB / 128;
constexpr int NEXP = 32;
constexpr int INP = 2304;
constexpr float EPS = 1e-6f;
constexpr float LOG2E = 1.4426950408889634f;
constexpr int SMEM_BYTES = 73728;
constexpr int UROWS = 2 * NTOK + NEXP * 128;

constexpr size_t al(size_t x) { return (x + 255) & ~(size_t)255; }
constexpr size_t OFF_WIN = 0;
constexpr size_t OFF_WQB = OFF_WIN + al((size_t)INP * 1024 * 2);
constexpr size_t OFF_WKVB = OFF_WQB + al((size_t)384 * 256 * 2);
constexpr size_t OFF_WGATE = OFF_WKVB + al((size_t)512 * 128 * 2);
constexpr size_t OFF_WBR = OFF_WGATE + al((size_t)4 * 1024 * 1024 * 2);
constexpr size_t OFF_WOUT = OFF_WBR + al((size_t)4 * 1024 * 256 * 2);
constexpr size_t OFF_W13 = OFF_WOUT + al((size_t)1024 * 1024 * 2);
constexpr size_t OFF_W2 = OFF_W13 + al((size_t)32 * 512 * 1024 * 2);
constexpr size_t OFF_MODP = OFF_W2 + al((size_t)32 * 1024 * 256 * 2);
constexpr size_t OFF_MOD = OFF_MODP + al((size_t)8 * 2 * 9 * 6144 * 4);
constexpr size_t OFF_CS32 = OFF_MOD + al((size_t)2 * 9 * 6144 * 4);
constexpr size_t OFF_CS16 = OFF_CS32 + al((size_t)64 * 16 * 2 * 4);
constexpr size_t OFF_WRT = OFF_CS16 + al((size_t)64 * 8 * 2 * 4);
constexpr size_t OFF_CNT = OFF_WRT + al((size_t)2 * 36 * 1024 * 4);
constexpr size_t OFF_BAR = OFF_CNT + al(256);
constexpr int XCD_BAR_WORDS = 3456;
constexpr size_t OFF_CTXRES = OFF_BAR + al((size_t)XCD_BAR_WORDS * 4);
constexpr size_t OFF_H = OFF_CTXRES + al((size_t)8 * 256 * 1024 * 4);
constexpr size_t OFF_O = OFF_H + al((size_t)NTOK * 1024 * 2);
constexpr size_t OFF_SSQ = OFF_O + al((size_t)NTOK * 1024 * 2);
constexpr size_t OFF_LIST = OFF_SSQ + al((size_t)NTOK * 8 * 4);
constexpr size_t OFF_WLIST = OFF_LIST + al((size_t)32 * NTOK * 4);
constexpr size_t OFF_QKV = OFF_WLIST + al((size_t)32 * NTOK * 4);
constexpr size_t OFF_PA = OFF_QKV;
constexpr size_t OFF_QA = OFF_PA + (size_t)NTOK * 384 * 2;
constexpr size_t OFF_KA = OFF_QA + (size_t)NTOK * 384 * 2;
constexpr size_t OFF_KR = OFF_KA + (size_t)NTOK * 256 * 2;
constexpr size_t OFF_VAT = OFF_KR + (size_t)NTOK * 32 * 2;
constexpr size_t OFF_QB = OFF_VAT + (size_t)NTOK * 256 * 2;
constexpr size_t OFF_KB = OFF_QB + (size_t)NTOK * 256 * 2;
constexpr size_t OFF_VBT = OFF_KB + (size_t)NTOK * 128 * 2;
constexpr size_t OFF_QC = OFF_VBT + (size_t)NTOK * 128 * 2;
constexpr size_t OFF_KC = OFF_QC + (size_t)NTOK * 256 * 2;
constexpr size_t OFF_VCT = OFF_KC + (size_t)NTOK * 256 * 2;
constexpr size_t OFF_QD = OFF_VCT + (size_t)NTOK * 256 * 2;
constexpr size_t OFF_KD = OFF_QD + (size_t)NTOK * 256 * 2;
constexpr size_t OFF_VDT = OFF_KD + (size_t)NTOK * 128 * 2;
constexpr size_t OFF_END = OFF_VDT + (size_t)NTOK * 128 * 2;
constexpr size_t OFF_YPRE = OFF_QKV;
constexpr size_t OFF_U = OFF_QKV;
constexpr size_t OFF_YS = OFF_QKV + al((size_t)UROWS * 256 * 2);
static_assert(OFF_YS + (size_t)2 * NTOK * 1024 * 2 <= OFF_END, "alias overflow");
static_assert(OFF_YPRE + (size_t)NTOK * 1024 * 2 <= OFF_END, "alias overflow");
constexpr size_t WS_NEEDED = OFF_END;

struct Params {
  const float *x, *c, *ctx, *c_ctx, *w_mod, *b_mod, *g_norm_mix, *w_in, *g_q_a, *w_q_b, *g_kv_a, *w_kv_b,
      *sink_b, *rpb_c, *g_q_d, *g_k_d, *w_gate, *b_gate, *w_branch, *w_out, *g_norm_ffn, *w_group, *b_group,
      *w_router, *b_router, *w_ff1, *w_ff3, *w_ff2, *g_final;
  float* out;
  char* ws;
  int ph_begin, ph_end;
};

DEVI int tid_fresh() { int t; asm volatile("v_mov_b32 %0, %1" : "=v"(t) : "v"(__builtin_amdgcn_workitem_id_x())); return t; }
DEVI int bid_fresh() { int t; asm volatile("s_mov_b32 %0, %1" : "=s"(t) : "s"(__builtin_amdgcn_workgroup_id_x())); return t; }
#define TIDX tid_fresh()
#define BIDX bid_fresh()
typedef const __attribute__((address_space(4))) Params* KP;
DEVI unsigned pk2(float a, float b) { f32x2 v = {a, b}; bf16x2_t r = __builtin_convertvector(v, bf16x2_t); return __builtin_bit_cast(unsigned, r); }
DEVI u16 f2bf(float a) { return (u16)(pk2(a, 0.f) & 0xffffu); }
DEVI float bf2f(u16 v) { return __uint_as_float(((unsigned)v) << 16); }
DEVI float wave_sum(float v) {
#pragma unroll
  for (int m = 32; m >= 1; m >>= 1) v += __shfl_xor(v, m);
  return v;
}
template <class T> DEVI T* wsp(KP p, size_t off) { return (T*)(p->ws + off); }
DEVI const float* xrow_in(KP p, int l, int b, int rr) {
  if (l == 0) return (rr < NCTX) ? p->ctx + ((size_t)b * NCTX + rr) * 1024 : p->x + ((size_t)b * SEQ + rr - NCTX) * 1024;
  return (rr < NCTX) ? wsp<float>(p, OFF_CTXRES) + ((size_t)b * NCTX + rr) * 1024 : p->out + ((size_t)b * SEQ + rr - NCTX) * 1024;
}
DEVI float* xrow_res(KP p, int b, int rr) {
  return (rr < NCTX) ? wsp<float>(p, OFF_CTXRES) + ((size_t)b * NCTX + rr) * 1024 : p->out + ((size_t)b * SEQ + rr - NCTX) * 1024;
}
DEVI int perm16(int k) { return (k & ~12) | ((k & 4) << 1) | ((k & 8) >> 1); }

struct ConvT { const float* src; const float* ks; u16* dst; int ld; int ldd; };
constexpr int CONV_ITEMS = 1152 + 48 + 32 + 2048 + 512 + 512 + 8192 + 4096;
DEVI ConvT conv_decode(KP p, int l, int idx) {
  ConvT c; c.ks = nullptr;
  if (idx < 1152) {
    int nt = idx >> 4, kt = idx & 15, n0 = nt * 32;
    int sc = (n0 < 416) ? n0 : ((n0 < 512) ? -1 : n0 - 96);
    c.ld = 2208; c.ldd = 1024;
    c.src = (sc < 0) ? nullptr : p->w_in + (size_t)l * 1024 * 2208 + (size_t)kt * 64 * 2208 + sc;
    c.dst = wsp<u16>(p, OFF_WIN) + (size_t)n0 * 1024 + kt * 64;
    return c;
  }
  idx -= 1152;
  if (idx < 48) {
    int nt = idx >> 2, kt = idx & 3;
    c.ld = 384; c.ldd = 256; c.ks = p->g_q_a + l * 256 + kt * 64;
    c.src = p->w_q_b + (size_t)l * 256 * 384 + (size_t)kt * 64 * 384 + nt * 32;
    c.dst = wsp<u16>(p, OFF_WQB) + (size_t)nt * 32 * 256 + kt * 64;
    return c;
  }
  idx -= 48;
  if (idx < 32) {
    int nt = idx >> 1, kt = idx & 1;
    c.ld = 512; c.ldd = 128; c.ks = p->g_kv_a + l * 128 + kt * 64;
    c.src = p->w_kv_b + (size_t)l * 128 * 512 + (size_t)kt * 64 * 512 + nt * 32;
    c.dst = wsp<u16>(p, OFF_WKVB) + (size_t)nt * 32 * 128 + kt * 64;
    return c;
  }
  idx -= 32;
  if (idx < 2048) {
    int br = idx >> 9, nt = (idx >> 4) & 31, kt = idx & 15;
    c.ld = 1024; c.ldd = 1024;
    c.src = p->w_gate + ((size_t)(l * 4 + br) * 1024 + kt * 64) * 1024 + nt * 32;
    c.dst = wsp<u16>(p, OFF_WGATE) + ((size_t)br * 1024 + nt * 32) * 1024 + kt * 64;
    return c;
  }
  idx -= 2048;
  if (idx < 512) {
    int br = idx >> 7, nt = (idx >> 2) & 31, kt = idx & 3;
    c.ld = 1024; c.ldd = 256;
    c.src = p->w_branch + ((size_t)(l * 4 + br) * 256 + kt * 64) * 1024 + nt * 32;
    c.dst = wsp<u16>(p, OFF_WBR) + ((size_t)br * 1024 + nt * 32) * 256 + kt * 64;
    return c;
  }
  idx -= 512;
  if (idx < 512) {
    int nt = idx >> 4, kt = idx & 15;
    c.ld = 1024; c.ldd = 1024;
    c.src = p->w_out + ((size_t)l * 1024 + kt * 64) * 1024 + nt * 32;
    c.dst = wsp<u16>(p, OFF_WOUT) + (size_t)nt * 32 * 1024 + kt * 64;
    return c;
  }
  idx -= 512;
  if (idx < 8192) {
    int e = idx >> 8, g32 = (idx >> 4) & 15, kt = idx & 15;
    const float* w = (g32 & 1) ? p->w_ff3 : p->w_ff1;
    c.ld = 256; c.ldd = 1024;
    c.src = w + ((size_t)(l * 32 + e) * 1024 + kt * 64) * 256 + (g32 >> 1) * 32;
    c.dst = wsp<u16>(p, OFF_W13) + ((size_t)e * 512 + g32 * 32) * 1024 + kt * 64;
    return c;
  }
  idx -= 8192;
  {
    int e = idx >> 7, nt = (idx >> 2) & 31, kt = idx & 3;
    c.ld = 1024; c.ldd = 256;
    c.src = p->w_ff2 + ((size_t)(l * 32 + e) * 256 + kt * 64) * 1024 + nt * 32;
    c.dst = wsp<u16>(p, OFF_W2) + ((size_t)e * 1024 + nt * 32) * 256 + kt * 64;
    return c;
  }
}
DEVI void conv_tile(const ConvT& c, char* lds) {
  float* t = (float*)lds;
  const int tid = TIDX;
  const int kk = tid >> 3, n4 = (tid & 7) * 4;
  __syncthreads();
#pragma unroll
  for (int i = 0; i < 2; ++i) {
    int k = kk + 32 * i;
    f32x4 v = f32x4{0.f, 0.f, 0.f, 0.f};
    if (c.src) v = *(const f32x4*)(c.src + (size_t)k * c.ld + n4);
    float s = c.ks ? c.ks[k] : 1.f;
    t[(n4 + 0) * 65 + k] = v.x * s; t[(n4 + 1) * 65 + k] = v.y * s;
    t[(n4 + 2) * 65 + k] = v.z * s; t[(n4 + 3) * 65 + k] = v.w * s;
  }
  __syncthreads();
  const int n = tid >> 3, k8 = (tid & 7) * 8;
  const float* r = t + n * 65 + k8;
  u32x4 o;
  o.x = pk2(r[0], r[1]); o.y = pk2(r[2], r[3]); o.z = pk2(r[4], r[5]); o.w = pk2(r[6], r[7]);
  *(u32x4*)(c.dst + (size_t)n * c.ldd + k8) = o;
}

DEVI void phase0(KP p, char* lds) {
  const int tid = TIDX;
  const int NITEM = 384 + 1 + 72 + CONV_ITEMS;
  for (int item = BIDX; item < NITEM; item += gridDim.x) {
    if (item < 384) {
      float* sc = (float*)lds;
      const int l = item / 192, rem = item % 192, cgp = rem >> 3, kc = rem & 7;
      __syncthreads();
      for (int i = tid; i < 9 * 128; i += 256) {
        int b = i >> 7, k = i & 127;
        float v = (b < 8) ? p->c[b * 1024 + kc * 128 + k] : p->c_ctx[kc * 128 + k];
        sc[i] = v / (1.f + expf(-v));
      }
      __syncthreads();
      float acc[9];
#pragma unroll
      for (int b = 0; b < 9; ++b) acc[b] = 0.f;
      const float* w = p->w_mod + ((size_t)l * 1024 + kc * 128) * 6144 + cgp * 256 + tid;
#pragma unroll 8
      for (int k = 0; k < 128; ++k) {
        float wv = w[(size_t)k * 6144];
#pragma unroll
        for (int b = 0; b < 9; ++b) acc[b] += sc[b * 128 + k] * wv;
      }
      float* dst = wsp<float>(p, OFF_MODP) + (size_t)((kc * 2 + l) * 9) * 6144 + cgp * 256 + tid;
#pragma unroll
      for (int b = 0; b < 9; ++b) dst[(size_t)b * 6144] = acc[b];
    } else if (item == 384) {
      float* cs32 = wsp<float>(p, OFF_CS32);
      float* cs16 = wsp<float>(p, OFF_CS16);
      for (int t = tid; t < 1024; t += 256) {
        int pos = t >> 4, i = t & 15;
        float ang = (float)pos * powf(10000.f, -(float)(2 * i) / 32.f);
        cs32[t * 2] = cosf(ang); cs32[t * 2 + 1] = sinf(ang);
      }
      for (int t = tid; t < 512; t += 256) {
        int pos = t >> 3, i = t & 7;
        float ang = (float)pos * powf(10000.f, -(float)(2 * i) / 16.f);
        cs16[t * 2] = cosf(ang); cs16[t * 2 + 1] = sinf(ang);
      }
    } else if (item < 385 + 72) {
      const int it = item - 385, l = it / 36, o = it % 36;
      float* dst = wsp<float>(p, OFF_WRT) + ((size_t)l * 36 + o) * 1024;
      for (int k = tid; k < 1024; k += 256)
        dst[k] = (o < 4) ? p->w_group[((size_t)l * 1024 + k) * 4 + o] : p->w_router[((size_t)l * 1024 + k) * 32 + (o - 4)];
    } else {
      ConvT c = conv_decode(p, 0, item - 457);
      conv_tile(c, lds);
    }
  }
}
DEVI void phase1(KP p) {
  const float* mp = wsp<float>(p, OFF_MODP);
  float* mo = wsp<float>(p, OFF_MOD);
  for (int i = BIDX * 256 + TIDX; i < 2 * 9 * 6144; i += gridDim.x * 256) {
    int l = i / (9 * 6144), o = i % 6144;
    float s = p->b_mod[l * 6144 + o];
#pragma unroll
    for (int kc = 0; kc < 8; ++kc) s += mp[(size_t)kc * 2 * 9 * 6144 + i];
    mo[i] = s;
  }
}

DEVI void modulate_row_store(KP p, int l, int which, const float (&xv)[16], int mrow, u16* hrow, float (&hv)[16]) {
  const int lane = TIDX & 63;
  float ss = 0.f;
#pragma unroll
  for (int i = 0; i < 16; ++i) ss += xv[i] * xv[i];
  ss = wave_sum(ss);
  const float rstd = rsqrtf(ss * (1.f / 1024.f) + EPS);
  const float* g = (which ? p->g_norm_ffn : p->g_norm_mix) + l * 1024;
  const float* mod = wsp<float>(p, OFF_MOD) + ((size_t)l * 9 + mrow) * 6144 + (which ? 3072 : 0);
#pragma unroll
  for (int i = 0; i < 4; ++i) {
    const int c = i * 256 + lane * 4;
    f32x4 gv = *(const f32x4*)(g + c);
    f32x4 sh = *(const f32x4*)(mod + c);
    f32x4 sc = *(const f32x4*)(mod + 1024 + c);
    hv[i * 4 + 0] = xv[i * 4 + 0] * rstd * gv.x * (1.f + sc.x) + sh.x;
    hv[i * 4 + 1] = xv[i * 4 + 1] * rstd * gv.y * (1.f + sc.y) + sh.y;
    hv[i * 4 + 2] = xv[i * 4 + 2] * rstd * gv.z * (1.f + sc.z) + sh.z;
    hv[i * 4 + 3] = xv[i * 4 + 3] * rstd * gv.w * (1.f + sc.w) + sh.w;
    u32x2 o; o.x = pk2(hv[i * 4 + 0], hv[i * 4 + 1]); o.y = pk2(hv[i * 4 + 2], hv[i * 4 + 3]);
    *(u32x2*)(hrow + c) = o;
  }
}
DEVI void load_row16(const float* xr, float (&xv)[16]) {
  const int lane = TIDX & 63;
#pragma unroll
  for (int i = 0; i < 4; ++i) {
    f32x4 v = *(const f32x4*)(xr + i * 256 + lane * 4);
    xv[i * 4 + 0] = v.x; xv[i * 4 + 1] = v.y; xv[i * 4 + 2] = v.z; xv[i * 4 + 3] = v.w;
  }
}
DEVI void phaseA(KP p) {
  const int gw = BIDX * 4 + (TIDX >> 6), nw = gridDim.x * 4;
  u16* H = wsp<u16>(p, OFF_H);
  for (int tok = gw; tok < NTOK; tok += nw) {
    const int b = tok / TPB, rr = tok % TPB;
    float xv[16], hv[16];
    load_row16(xrow_in(p, 0, b, rr), xv);
    modulate_row_store(p, 0, 0, xv, rr < NCTX ? 8 : b, H + (size_t)tok * 1024, hv);
  }
}

template <int BN, class AF>
DEVI void gemm_main(f32x16 (&acc)[2][BN / 64], AF arow, const u16* Bt, int ldb, int KT, char* lds) {
  constexpr int NI = BN / 64;
  constexpr int NBL = BN / 32;
  constexpr int STAGE = (128 + BN) * 144;
  const int tid = TIDX, lane = tid & 63, wave = tid >> 6;
  const int wm = wave >> 1, wn = wave & 1, r32 = lane & 31, hh = lane >> 5;
  const int srow = tid >> 3, scol = (tid & 7) * 8;
  const u16* ap[4];
#pragma unroll
  for (int i = 0; i < 4; ++i) ap[i] = arow(srow + 32 * i) + scol;
  const u16* bp = Bt + (size_t)srow * ldb + scol;
  u32x4 ra[4], rb[NBL];
  char* wA = lds + srow * 144 + scol * 2;
  char* wB = wA + 128 * 144;
  const char* rA = lds + (wm * 64 + r32) * 144 + hh * 16;
  const char* rB = lds + 128 * 144 + (wn * (BN / 2) + r32) * 144 + hh * 16;
#pragma unroll
  for (int i = 0; i < 4; ++i) ra[i] = *(const u32x4*)(ap[i]);
#pragma unroll
  for (int i = 0; i < NBL; ++i) rb[i] = *(const u32x4*)(bp + (size_t)32 * i * ldb);
  __syncthreads();
#pragma unroll
  for (int i = 0; i < 4; ++i) *(u32x4*)(wA + i * 32 * 144) = ra[i];
#pragma unroll
  for (int i = 0; i < NBL; ++i) *(u32x4*)(wB + i * 32 * 144) = rb[i];
  __syncthreads();
  for (int kt = 0; kt < KT; ++kt) {
    const int st = (kt & 1) * STAGE;
    const bool more = (kt + 1 < KT);
    if (more) {
#pragma unroll
      for (int i = 0; i < 4; ++i) ra[i] = *(const u32x4*)(ap[i] + (kt + 1) * 64);
#pragma unroll
      for (int i = 0; i < NBL; ++i) rb[i] = *(const u32x4*)(bp + (size_t)32 * i * ldb + (kt + 1) * 64);
    }
#pragma unroll
    for (int ks = 0; ks < 4; ++ks) {
      bf16x8 a[2], b[NI];
#pragma unroll
      for (int mi = 0; mi < 2; ++mi) a[mi] = *(const bf16x8*)(rA + st + mi * 32 * 144 + ks * 32);
#pragma unroll
      for (int ni = 0; ni < NI; ++ni) b[ni] = *(const bf16x8*)(rB + st + ni * 32 * 144 + ks * 32);
#pragma unroll
      for (int mi = 0; mi < 2; ++mi)
#pragma unroll
        for (int ni = 0; ni < NI; ++ni) acc[mi][ni] = MFMA(a[mi], b[ni], acc[mi][ni]);
    }
    if (more) {
      const int st2 = ((kt + 1) & 1) * STAGE;
#pragma unroll
      for (int i = 0; i < 4; ++i) *(u32x4*)(wA + st2 + i * 32 * 144) = ra[i];
#pragma unroll
      for (int i = 0; i < NBL; ++i) *(u32x4*)(wB + st2 + i * 32 * 144) = rb[i];
    }
    __syncthreads();
  }
}
template <int NI> DEVI void zero_acc(f32x16 (&acc)[2][NI]) {
#pragma unroll
  for (int mi = 0; mi < 2; ++mi)
#pragma unroll
    for (int ni = 0; ni < NI; ++ni)
#pragma unroll
      for (int i = 0; i < 16; ++i) acc[mi][ni][i] = 0.f;
}
DEVI void acc_to_lds(const f32x16 (&acc)[2][2], char* lds) {
  const int tid = TIDX, lane = tid & 63, wave = tid >> 6;
  const int wm = wave >> 1, wn = wave & 1, r32 = lane & 31, hh = lane >> 5;
  float* ct = (float*)lds;
#pragma unroll
  for (int mi = 0; mi < 2; ++mi)
#pragma unroll
    for (int ni = 0; ni < 2; ++ni)
#pragma unroll
      for (int i = 0; i < 16; ++i)
        ct[(wm * 64 + mi * 32 + (i & 3) + 8 * (i >> 2) + 4 * hh) * 132 + wn * 64 + ni * 32 + r32] = acc[mi][ni][i];
  __syncthreads();
}
DEVI void lds_row32(const float* rp, float (&v)[32]) {
#pragma unroll
  for (int j = 0; j < 8; ++j) {
    f32x4 t = *(const f32x4*)(rp + 4 * j);
    v[4 * j] = t.x; v[4 * j + 1] = t.y; v[4 * j + 2] = t.z; v[4 * j + 3] = t.w;
  }
}
DEVI float lds_ssq64(const float* rp) {
  float s = 0.f;
#pragma unroll
  for (int j = 0; j < 16; ++j) {
    f32x4 t = *(const f32x4*)(rp + 4 * j);
    s += t.x * t.x + t.y * t.y + t.z * t.z + t.w * t.w;
  }
  return s;
}
DEVI void store32(u16* dst, const float (&v)[32]) {
#pragma unroll
  for (int j = 0; j < 4; ++j) {
    u32x4 o;
    o.x = pk2(v[8 * j], v[8 * j + 1]); o.y = pk2(v[8 * j + 2], v[8 * j + 3]);
    o.z = pk2(v[8 * j + 4], v[8 * j + 5]); o.w = pk2(v[8 * j + 6], v[8 * j + 7]);
    *(u32x4*)(dst + 8 * j) = o;
  }
}
DEVI void storeT32(u16* vt, int pos, const float (&v)[32]) {
#pragma unroll
  for (int d = 0; d < 32; ++d) vt[(size_t)d * TPB + pos] = f2bf(v[d]);
}
DEVI void rope32(float (&v)[32], const float* cs32, int pos) {
  const f32x2* t = (const f32x2*)(cs32 + pos * 32);
#pragma unroll
  for (int i = 0; i < 16; ++i) {
    f32x2 cs = t[i];
    float x1 = v[i], x2 = v[16 + i];
    v[i] = x1 * cs.x - x2 * cs.y; v[16 + i] = x2 * cs.x + x1 * cs.y;
  }
}
DEVI void rope16x2(float (&v)[32], const float* cs16, int grow, int gcol) {
  const f32x2* tr = (const f32x2*)(cs16 + grow * 16);
  const f32x2* tc = (const f32x2*)(cs16 + gcol * 16);
#pragma unroll
  for (int i = 0; i < 8; ++i) {
    f32x2 cs = tr[i];
    float x1 = v[i], x2 = v[8 + i];
    v[i] = x1 * cs.x - x2 * cs.y; v[8 + i] = x2 * cs.x + x1 * cs.y;
    f32x2 cc = tc[i];
    float y1 = v[16 + i], y2 = v[24 + i];
    v[16 + i] = y1 * cc.x - y2 * cc.y; v[24 + i] = y2 * cc.x + y1 * cc.y;
  }
}

DEVI void phaseB(KP p, int l, char* lds) {
  const int G8 = gridDim.x >> 3, xcd = BIDX & 7, lb = BIDX >> 3;
  if (lb >= G8) return;
  const int tid = TIDX;
  const u16* H = wsp<u16>(p, OFF_H);
  const u16* W = wsp<u16>(p, OFF_WIN);
  const float* cs32 = wsp<float>(p, OFF_CS32);
  const float* cs16 = wsp<float>(p, OFF_CS16);
  const float QS = 0.125f * LOG2E;
  for (int n = lb; n < 34 * 18; n += G8) {
    const int nt = n % 18, mt = (n / 18) * 8 + xcd;
    const int b = mt / MT_PER_B, r0 = (mt % MT_PER_B) * 128;
    const bool ctxtile = r0 < NCTX;
    if (l == 1 && ctxtile && (nt == 0 || nt == 1 || nt == 4 || nt == 5 || nt == 8 || nt == 9 || nt == 14 || nt == 15)) continue;
    f32x16 acc[2][2];
    zero_acc<2>(acc);
    const u16* Ab = H + (size_t)mt * 128 * 1024;
    gemm_main<128>(acc, [&](int r) { return Ab + (size_t)r * 1024; }, W + (size_t)nt * 128 * 1024, 1024, 16, lds);
    acc_to_lds(acc, lds);
    const int row = tid & 127, half = tid >> 7;
    const float* rp = (const float*)lds + row * 132 + half * 64;
    const int rr = r0 + row;
    const size_t tok = (size_t)b * TPB + rr;
    const bool lat = rr >= NCTX;
    const int t = rr - NCTX, grow = (t >> 6) & 63, gcol = t & 63;
    const int pos = perm16(rr);
    const bool isnorm = (nt >= 14 && nt <= 16);
    const bool isrope = lat && (nt == 4 || nt == 5 || nt == 6 || isnorm);
    const bool isq = (nt == 4 || nt == 5 || nt == 8 || nt == 9 || nt == 14 || nt == 15);
    float mul = isq ? QS : 1.f;
    const float* gvec = ((nt == 16) ? p->g_k_d : p->g_q_d) + l * 64;
    if (nt < 3 || isnorm) {
      const float ss = lds_ssq64(rp);
      if (nt < 3) wsp<float>(p, OFF_SSQ)[tok * 8 + nt * 2 + half] = ss;
      else mul *= rsqrtf(ss * (1.f / 64.f) + EPS);
    }
    u16* dst = nullptr;
    u16* dstT = nullptr;
    if (nt < 3) dst = wsp<u16>(p, OFF_PA) + tok * 384 + nt * 128 + half * 64;
    else if (nt == 3) dst = wsp<u16>(p, OFF_KR) + tok * 32;
    else if (nt < 6) dst = wsp<u16>(p, OFF_QB) + tok * 256 + (nt - 4) * 128 + half * 64;
    else if (nt == 6) dst = wsp<u16>(p, OFF_KB) + tok * 128 + half * 64;
    else if (nt == 7) dstT = wsp<u16>(p, OFF_VBT) + (size_t)(b * 2 + half) * 64 * TPB;
    else if (nt < 10) dst = wsp<u16>(p, OFF_QC) + tok * 256 + (nt - 8) * 128 + half * 64;
    else if (nt < 12) dst = wsp<u16>(p, OFF_KC) + tok * 256 + (nt - 10) * 128 + half * 64;
    else if (nt < 14) dstT = wsp<u16>(p, OFF_VCT) + (size_t)(b * 4 + (nt - 12) * 2 + half) * 64 * TPB;
    else if (nt < 16) dst = wsp<u16>(p, OFF_QD) + tok * 256 + (nt - 14) * 128 + half * 64;
    else if (nt == 16) dst = wsp<u16>(p, OFF_KD) + tok * 128 + half * 64;
    else dstT = wsp<u16>(p, OFF_VDT) + (size_t)(b * 2 + half) * 64 * TPB;
#pragma unroll
    for (int g = 0; g < 2; ++g) {
      if (nt == 3 && (half == 1 || g == 1)) continue;
      float v[32];
      lds_row32(rp + 32 * g, v);
      if (isnorm) {
#pragma unroll
        for (int j = 0; j < 32; ++j) v[j] *= gvec[32 * g + j];
      }
#pragma unroll
      for (int j = 0; j < 32; ++j) v[j] *= mul;
      if (nt == 3) { if (lat) rope16x2(v, cs16, grow, gcol); }
      else if (isrope) rope32(v, cs32, g == 0 ? grow : gcol);
      if (dstT) storeT32(dstT + (size_t)(32 * g) * TPB, pos, v);
      else store32(dst + 32 * g, v);
    }
  }
}

DEVI void phaseC(KP p, int l, char* lds) {
  const int G8 = gridDim.x >> 3, xcd = BIDX & 7, lb = BIDX >> 3;
  if (lb >= G8) return;
  const int tid = TIDX;
  const u16* PA = wsp<u16>(p, OFF_PA);
  const float* cs16 = wsp<float>(p, OFF_CS16);
  const float QS = 0.10206207261596575f * LOG2E;
  for (int n = lb; n < 34 * 7; n += G8) {
    const int j = n % 7, mt = (n / 7) * 8 + xcd;
    const int b = mt / MT_PER_B, r0 = (mt % MT_PER_B) * 128;
    if (l == 1 && r0 < NCTX && j < 3) continue;
    f32x16 acc[2][2];
    zero_acc<2>(acc);
    const u16* Ab = PA + (size_t)mt * 128 * 384;
    if (j < 3) gemm_main<128>(acc, [&](int r) { return Ab + (size_t)r * 384; }, wsp<u16>(p, OFF_WQB) + (size_t)j * 128 * 256, 256, 4, lds);
    else gemm_main<128>(acc, [&](int r) { return Ab + (size_t)r * 384 + 256; }, wsp<u16>(p, OFF_WKVB) + (size_t)(j - 3) * 128 * 128, 128, 2, lds);
    acc_to_lds(acc, lds);
    const int row = tid & 127, half = tid >> 7;
    const float* rp = (const float*)lds + row * 132 + half * 64;
    const int rr = r0 + row;
    const size_t tok = (size_t)b * TPB + rr;
    const bool lat = rr >= NCTX;
    const int t = rr - NCTX, grow = (t >> 6) & 63, gcol = t & 63;
    const int pos = perm16(rr);
    const float* sq = wsp<float>(p, OFF_SSQ) + tok * 8;
    const float mul = (j < 3) ? rsqrtf((sq[0] + sq[1] + sq[2] + sq[3]) * (1.f / 256.f) + EPS) * QS
                              : rsqrtf((sq[4] + sq[5]) * (1.f / 128.f) + EPS);
#pragma unroll
    for (int g = 0; g < 2; ++g) {
      float v[32];
      lds_row32(rp + 32 * g, v);
#pragma unroll
      for (int jj = 0; jj < 32; ++jj) v[jj] *= mul;
      if (j < 3) {
        const int gc = j * 128 + half * 64 + 32 * g;
        if (lat && (gc % 96) == 64) rope16x2(v, cs16, grow, gcol);
        store32(wsp<u16>(p, OFF_QA) + tok * 384 + gc, v);
      } else {
        const int h = j - 3;
        if (half == 0) store32(wsp<u16>(p, OFF_KA) + tok * 256 + h * 64 + 32 * g, v);
        else storeT32(wsp<u16>(p, OFF_VAT) + ((size_t)(b * 4 + h) * 64 + 32 * g) * TPB, pos, v);
      }
    }
  }
}

template <int BR>
DEVI void attn_item(KP p, int l, int b, int hs, int qb, bool isctx, char* lds) {
  constexpr bool MLA = (BR == 0);
  constexpr bool GQA = (BR == 1 || BR == 3);
  constexpr int QBLK = GQA ? 64 : 128;
  constexpr int NKS = MLA ? 6 : 4;
  constexpr int STG = 9216 + 9216 + 5120;
  const int tid = TIDX, lane = tid & 63, wave = tid >> 6;
  const int r32 = lane & 31, hh = lane >> 5;
  const int hq = GQA ? (hs * 2 + (wave & 1)) : hs;
  const int woff = GQA ? 32 * (wave >> 1) : 32 * wave;
  const int q0 = (isctx ? 0 : NCTX) + qb * QBLK;
  const size_t tokq = (size_t)b * TPB + q0 + woff + r32;
  const u16* Qp; const u16* Kp; int ldk; const u16* Vt; int obase;
  if (BR == 0) { Qp = wsp<u16>(p, OFF_QA) + tokq * 384 + hq * 96; Kp = wsp<u16>(p, OFF_KA) + (size_t)b * TPB * 256 + hs * 64; ldk = 256; Vt = wsp<u16>(p, OFF_VAT) + (size_t)(b * 4 + hs) * 64 * TPB; obase = hq * 64; }
  else if (BR == 1) { Qp = wsp<u16>(p, OFF_QB) + tokq * 256 + hq * 64; Kp = wsp<u16>(p, OFF_KB) + (size_t)b * TPB * 128 + hs * 64; ldk = 128; Vt = wsp<u16>(p, OFF_VBT) + (size_t)(b * 2 + hs) * 64 * TPB; obase = 256 + hq * 64; }
  else if (BR == 2) { Qp = wsp<u16>(p, OFF_QC) + tokq * 256 + hq * 64; Kp = wsp<u16>(p, OFF_KC) + (size_t)b * TPB * 256 + hs * 64; ldk = 256; Vt = wsp<u16>(p, OFF_VCT) + (size_t)(b * 4 + hs) * 64 * TPB; obase = 512 + hq * 64; }
  else { Qp = wsp<u16>(p, OFF_QD) + tokq * 256 + hq * 64; Kp = wsp<u16>(p, OFF_KD) + (size_t)b * TPB * 128 + hs * 64; ldk = 128; Vt = wsp<u16>(p, OFF_VDT) + (size_t)(b * 2 + hs) * 64 * TPB; obase = 768 + hq * 64; }
  const u16* KRp = wsp<u16>(p, OFF_KR) + (size_t)b * TPB * 32;
  int lat_lo = 0, lat_n = 0;
  if (!isctx) {
    if (BR == 0 || BR == 3) { lat_lo = 0; lat_n = 64; }
    else if (BR == 1) { const int ql = qb * 64; const int lo = max(0, ql - 128) >> 6, hi = min(SEQ - 1, ql + 63 + 128) >> 6; lat_lo = lo; lat_n = hi - lo + 1; }
    else { const int lo = min(max(2 * qb - 4, 0), 56), hi = min(max(2 * qb + 1 - 4, 0), 56) + 7; lat_lo = lo; lat_n = hi - lo + 1; }
  }
  const int NT = 4 + lat_n;
  const int qlat = qb * QBLK + woff + r32;
  const int qrow = qlat >> 6, qcol = qlat & 63;
  bf16x8 qf[NKS];
#pragma unroll
  for (int ks = 0; ks < NKS; ++ks) qf[ks] = *(const bf16x8*)(Qp + ks * 16 + hh * 8);
  const int srow = tid >> 3, sc8 = (tid & 7) * 8;
  const int krow_ = tid >> 2, kc8 = (tid & 3) * 8;
  u32x4 rk[2], rv[2], rkr;
  auto keytile = [&](int j) { return (j < 4) ? j : (4 + lat_lo + (j - 4)); };
  auto gload = [&](int j) {
    const int key0 = keytile(j) * 64;
#pragma unroll
    for (int i = 0; i < 2; ++i) {
      rk[i] = *(const u32x4*)(Kp + (size_t)(key0 + srow + 32 * i) * ldk + sc8);
      rv[i] = *(const u32x4*)(Vt + (size_t)(srow + 32 * i) * TPB + key0 + sc8);
    }
    if (MLA) rkr = *(const u32x4*)(KRp + (size_t)(key0 + krow_) * 32 + kc8);
  };
  auto lwrite = [&](int st) {
    char* base = lds + st * STG;
#pragma unroll
    for (int i = 0; i < 2; ++i) {
      *(u32x4*)(base + (srow + 32 * i) * 144 + sc8 * 2) = rk[i];
      *(u32x4*)(base + 9216 + (srow + 32 * i) * 144 + sc8 * 2) = rv[i];
    }
    if (MLA) *(u32x4*)(base + 18432 + krow_ * 80 + kc8 * 2) = rkr;
  };
  float* rpb = (float*)(lds + 2 * STG);
  gload(0);
  __syncthreads();
  if (BR == 2 && !isctx) {
    const float* src = p->rpb_c + (size_t)(l * 4 + hs) * 465;
    for (int i = tid; i < 465; i += 256) rpb[i] = src[i] * LOG2E;
  }
  lwrite(0);
  __syncthreads();
  f32x16 o[2];
#pragma unroll
  for (int i = 0; i < 16; ++i) { o[0][i] = 0.f; o[1][i] = 0.f; }
  float m_run = -INFINITY, l_run = 0.f;
  if (BR == 1) { m_run = p->sink_b[l * 4 + hq] * LOG2E; l_run = (hh == 0) ? 1.f : 0.f; }
  const char* kfb = lds + r32 * 144 + hh * 16;
  const char* vfb = lds + 9216 + r32 * 144 + hh * 16;
  const char* krb = lds + 18432 + r32 * 80 + hh * 16;
  for (int j = 0; j < NT; ++j) {
    const int st = (j & 1) * STG;
    const bool more = (j + 1 < NT);
    if (more) gload(j + 1);
    f32x16 s[2];
#pragma unroll
    for (int kb = 0; kb < 2; ++kb) {
#pragma unroll
      for (int i = 0; i < 16; ++i) s[kb][i] = 0.f;
#pragma unroll
      for (int ks = 0; ks < 4; ++ks) {
        bf16x8 kf = *(const bf16x8*)(kfb + st + kb * 32 * 144 + ks * 32);
        s[kb] = MFMA(kf, qf[ks], s[kb]);
      }
      if (MLA) {
#pragma unroll
        for (int ks = 0; ks < 2; ++ks) {
          bf16x8 kf = *(const bf16x8*)(krb + st + kb * 32 * 80 + ks * 32);
          s[kb] = MFMA(kf, qf[4 + ks], s[kb]);
        }
      }
    }
    if ((BR == 1 || BR == 2) && j >= 4) {
      const int kt = lat_lo + (j - 4);
      if (BR == 1) {
#pragma unroll
        for (int kb = 0; kb < 2; ++kb)
#pragma unroll
          for (int i = 0; i < 16; ++i) {
            const int kpos = kt * 64 + kb * 32 + (i & 3) + 8 * (i >> 2) + 4 * hh;
            const int d = qlat - kpos;
            if (d > 128 || d < -128) s[kb][i] = -1e30f;
          }
      } else {
        const int rs = min(max(qrow - 4, 0), 56);
        const bool row_ok = (kt >= rs) && (kt < rs + 8);
        const int cst = min(max(qcol - 8, 0), 48);
        const int dr = kt - qrow + 7;
#pragma unroll
        for (int kb = 0; kb < 2; ++kb)
#pragma unroll
          for (int i = 0; i < 16; ++i) {
            const int kc = kb * 32 + (i & 3) + 8 * (i >> 2) + 4 * hh;
            const bool ok = row_ok && (kc >= cst) && (kc < cst + 16);
            const int idx = ok ? (dr * 31 + (kc - qcol + 15)) : 0;
            const float bias = rpb[idx];
            s[kb][i] = ok ? (s[kb][i] + bias) : -1e30f;
          }
      }
    }
    float mx = s[0][0];
#pragma unroll
    for (int i = 1; i < 16; ++i) mx = fmaxf(mx, s[0][i]);
#pragma unroll
    for (int i = 0; i < 16; ++i) mx = fmaxf(mx, s[1][i]);
    mx = fmaxf(mx, __shfl_xor(mx, 32));
    const float m_new = fmaxf(m_run, mx);
    const float alpha = exp2f(m_run - m_new);
    m_run = m_new;
    float ls = 0.f;
#pragma unroll
    for (int kb = 0; kb < 2; ++kb)
#pragma unroll
      for (int i = 0; i < 16; ++i) { const float e = exp2f(s[kb][i] - m_new); s[kb][i] = e; ls += e; }
    l_run = l_run * alpha + ls;
    if (__any(alpha != 1.f)) {
#pragma unroll
      for (int i = 0; i < 16; ++i) { o[0][i] *= alpha; o[1][i] *= alpha; }
    }
#pragma unroll
    for (int s4 = 0; s4 < 4; ++s4) {
      const int kb = s4 >> 1, rb = (s4 & 1) * 8;
      u32x4 pw;
      pw.x = pk2(s[kb][rb + 0], s[kb][rb + 1]); pw.y = pk2(s[kb][rb + 2], s[kb][rb + 3]);
      pw.z = pk2(s[kb][rb + 4], s[kb][rb + 5]); pw.w = pk2(s[kb][rb + 6], s[kb][rb + 7]);
      const bf16x8 pf = __builtin_bit_cast(bf16x8, pw);
#pragma unroll
      for (int db = 0; db < 2; ++db) {
        bf16x8 vf = *(const bf16x8*)(vfb + st + db * 32 * 144 + s4 * 32);
        o[db] = MFMA(vf, pf, o[db]);
      }
    }
    if (more) lwrite((j + 1) & 1);
    __syncthreads();
  }
  const float lt = l_run + __shfl_xor(l_run, 32);
  const float inv = 1.f / lt;
  u16* Op = wsp<u16>(p, OFF_O) + tokq * 1024 + obase;
#pragma unroll
  for (int db = 0; db < 2; ++db)
#pragma unroll
    for (int g = 0; g < 4; ++g) {
      u32x2 w;
      w.x = pk2(o[db][4 * g] * inv, o[db][4 * g + 1] * inv);
      w.y = pk2(o[db][4 * g + 2] * inv, o[db][4 * g + 3] * inv);
      *(u32x2*)(Op + db * 32 + 8 * g + 4 * hh) = w;
    }
}
DEVI void phaseD(KP p, int l, char* lds) {
  const int G8 = gridDim.x >> 3, xcd = BIDX & 7, lb = BIDX >> 3;
  if (lb >= G8) return;
  const int NLOC = 512 + (l == 0 ? 32 : 0);
  for (int n = lb; n < NLOC; n += G8) {
    int br, s, qb; bool isctx = false;
    if (n < 128) { br = 0; s = xcd + 8 * (n >> 5); qb = n & 31; }
    else if (n < 256) { const int m = n - 128; br = 3; s = xcd + 8 * (m >> 6); qb = m & 63; }
    else if (n < 384) { const int m = n - 256; br = 2; s = xcd + 8 * (m >> 5); qb = m & 31; }
    else if (n < 512) { const int m = n - 384; br = 1; s = xcd + 8 * (m >> 6); qb = m & 63; }
    else {
      const int m = n - 512; isctx = true;
      if (m < 8) { br = 0; s = xcd + 8 * (m >> 1); qb = m & 1; }
      else if (m < 16) { const int mm = m - 8; br = 3; s = xcd + 8 * (mm >> 2); qb = mm & 3; }
      else if (m < 24) { const int mm = m - 16; br = 2; s = xcd + 8 * (mm >> 1); qb = mm & 1; }
      else { const int mm = m - 24; br = 1; s = xcd + 8 * (mm >> 2); qb = mm & 3; }
    }
    if (br == 0) attn_item<0>(p, l, s >> 2, s & 3, qb, isctx, lds);
    else if (br == 1) attn_item<1>(p, l, s >> 1, s & 1, qb, isctx, lds);
    else if (br == 2) attn_item<2>(p, l, s >> 2, s & 3, qb, isctx, lds);
    else attn_item<3>(p, l, s >> 1, s & 1, qb, isctx, lds);
  }
}

DEVI void phaseE(KP p, int l, char* lds) {
  const int G8 = gridDim.x >> 3, xcd = BIDX & 7, lb = BIDX >> 3;
  if (BIDX == 0 && TIDX < 32) wsp<int>(p, OFF_CNT)[TIDX] = 0;
  if (lb >= G8) return;
  const int tid = TIDX, lane = tid & 63, wave = tid >> 6;
  const int wm = wave >> 1, wn = wave & 1, r32 = lane & 31, hh = lane >> 5;
  const u16* H = wsp<u16>(p, OFF_H);
  const u16* O = wsp<u16>(p, OFF_O);
  u16* Y = wsp<u16>(p, OFF_YPRE);
  for (int n = lb; n < 34 * 16; n += G8) {
    const int nt = n & 15, mt = (n >> 4) * 8 + xcd;
    if (l == 1 && (mt % MT_PER_B) < 2) continue;
    f32x16 y[2][1];
    zero_acc<1>(y);
    const int col = nt * 64 + wn * 32 + r32;
#pragma unroll 1
    for (int br = 0; br < 4; ++br) {
      f32x16 ag[2][1], ab[2][1];
      zero_acc<1>(ag); zero_acc<1>(ab);
      const u16* Ab = H + (size_t)mt * 128 * 1024;
      gemm_main<64>(ag, [&](int r) { return Ab + (size_t)r * 1024; }, wsp<u16>(p, OFF_WGATE) + ((size_t)br * 1024 + nt * 64) * 1024, 1024, 16, lds);
      const u16* Ob = O + (size_t)mt * 128 * 1024 + br * 256;
      gemm_main<64>(ab, [&](int r) { return Ob + (size_t)r * 1024; }, wsp<u16>(p, OFF_WBR) + ((size_t)br * 1024 + nt * 64) * 256, 256, 4, lds);
      const float bias = p->b_gate[(size_t)(l * 4 + br) * 1024 + col];
#pragma unroll
      for (int mi = 0; mi < 2; ++mi)
#pragma unroll
        for (int i = 0; i < 16; ++i) {
          const float g = 1.f / (1.f + __expf(-(ag[mi][0][i] + bias)));
          y[mi][0][i] += g * ab[mi][0][i];
        }
    }
#pragma unroll
    for (int mi = 0; mi < 2; ++mi)
#pragma unroll
      for (int i = 0; i < 16; ++i) {
        const int row = wm * 64 + mi * 32 + (i & 3) + 8 * (i >> 2) + 4 * hh;
        Y[((size_t)mt * 128 + row) * 1024 + col] = f2bf(y[mi][0][i]);
      }
  }
}
DEVI void phaseF(KP p, int l, char* lds) {
  const int G8 = gridDim.x >> 3, xcd = BIDX & 7, lb = BIDX >> 3;
  if (lb >= G8) return;
  const int tid = TIDX, lane = tid & 63, wave = tid >> 6;
  const int wm = wave >> 1, wn = wave & 1, r32 = lane & 31, hh = lane >> 5;
  const u16* Y = wsp<u16>(p, OFF_YPRE);
  for (int n = lb; n < 34 * 8; n += G8) {
    const int nt = n & 7, mt = (n >> 3) * 8 + xcd;
    const int b = mt / MT_PER_B, r0 = (mt % MT_PER_B) * 128;
    if (l == 1 && r0 < NCTX) continue;
    f32x16 acc[2][2];
    zero_acc<2>(acc);
    const u16* Ab = Y + (size_t)mt * 128 * 1024;
    gemm_main<128>(acc, [&](int r) { return Ab + (size_t)r * 1024; }, wsp<u16>(p, OFF_WOUT) + (size_t)nt * 128 * 1024, 1024, 16, lds);
    acc_to_lds(acc, lds);
    const int mrow = (r0 < NCTX) ? 8 : b;
    const int c4 = (tid & 31) * 4;
    const f32x4 g = *(const f32x4*)(wsp<float>(p, OFF_MOD) + ((size_t)l * 9 + mrow) * 6144 + 2048 + nt * 128 + c4);
    const float* xin = xrow_in(p, l, b, r0) + nt * 128 + c4;
    float* xout = xrow_res(p, b, r0) + nt * 128 + c4;
    const float* ct = (const float*)lds + c4;
#pragma unroll 4
    for (int it = 0; it < 16; ++it) {
      const int row = it * 8 + (tid >> 5);
      const f32x4 a = *(const f32x4*)(ct + row * 132);
      const f32x4 xo = *(const f32x4*)(xin + (size_t)row * 1024);
      *(f32x4*)(xout + (size_t)row * 1024) = f32x4{xo.x + g.x * a.x, xo.y + g.y * a.y, xo.z + g.z * a.z, xo.w + g.w * a.w};
    }
  }
}

DEVI float router_dot(const float (&hv)[4][16], const float* wrow) {
  const int lane = TIDX & 63;
  const float* w = wrow + lane * 4;
  float pr[4] = {0.f, 0.f, 0.f, 0.f};
#pragma unroll
  for (int i = 0; i < 4; ++i) {
    const f32x4 wv = *(const f32x4*)(w + i * 256);
#pragma unroll
    for (int r = 0; r < 4; ++r)
      pr[r] += hv[r][i * 4] * wv.x + hv[r][i * 4 + 1] * wv.y + hv[r][i * 4 + 2] * wv.z + hv[r][i * 4 + 3] * wv.w;
  }
  const bool up = (lane & 32) != 0;
  float s0 = up ? pr[0] : pr[2], s1 = up ? pr[1] : pr[3];
  float k0 = up ? pr[2] : pr[0], k1 = up ? pr[3] : pr[1];
  k0 += __shfl_xor(s0, 32); k1 += __shfl_xor(s1, 32);
  const bool up2 = (lane & 16) != 0;
  float sv = up2 ? k0 : k1, kv = up2 ? k1 : k0;
  kv += __shfl_xor(sv, 16);
  kv += __shfl_xor(kv, 8); kv += __shfl_xor(kv, 4); kv += __shfl_xor(kv, 2); kv += __shfl_xor(kv, 1);
  return kv;
}
DEVI void phaseG(KP p, int l) {
  const int lane = TIDX & 63;
  const int gw = BIDX * 4 + (TIDX >> 6), nw = gridDim.x * 4;
  u16* H = wsp<u16>(p, OFF_H);
  const float* WRT = wsp<float>(p, OFF_WRT) + (size_t)l * 36 * 1024;
  int* cnt = wsp<int>(p, OFF_CNT);
  int* list = wsp<int>(p, OFF_LIST);
  float* wlist = wsp<float>(p, OFF_WLIST);
  const int qd = lane >> 4;
  for (int task = gw; task < NTOK / 4; task += nw) {
    const int tok0 = task * 4;
    const int b = tok0 / TPB, rr0 = tok0 % TPB;
    if (l == 1 && rr0 < NCTX) continue;
    float hv[4][16];
#pragma unroll
    for (int r = 0; r < 4; ++r) {
      float xv[16];
      load_row16(xrow_res(p, b, rr0 + r), xv);
      modulate_row_store(p, l, 1, xv, (rr0 < NCTX) ? 8 : b, H + (size_t)(tok0 + r) * 1024, hv[r]);
    }
    float gl[4], e8[8];
    int gs = 0;
#pragma unroll
    for (int o = 0; o < 4; ++o) gl[o] = router_dot(hv, WRT + (size_t)o * 1024) + p->b_group[l * 4 + o];
    {
      float best = gl[0];
#pragma unroll
      for (int j = 1; j < 4; ++j) if (gl[j] > best) { best = gl[j]; gs = j; }
    }
    const unsigned gmask = (1u << __shfl(gs, 0)) | (1u << __shfl(gs, 16)) | (1u << __shfl(gs, 32)) | (1u << __shfl(gs, 48));
#pragma unroll
    for (int j = 0; j < 8; ++j) e8[j] = -INFINITY;
#pragma unroll 1
    for (int e = 0; e < 32; ++e) {
      if (!((gmask >> (e >> 3)) & 1u)) continue;
      const float kv = router_dot(hv, WRT + (size_t)(4 + e) * 1024) + p->b_router[l * 32 + e];
      const bool sel = (e >> 3) == gs;
#pragma unroll
      for (int j = 0; j < 8; ++j) e8[j] = (sel && (e & 7) == j) ? kv : e8[j];
    }
    float gmax = fmaxf(fmaxf(gl[0], gl[1]), fmaxf(gl[2], gl[3]));
    float gsum = 0.f;
#pragma unroll
    for (int j = 0; j < 4; ++j) gsum += expf(gl[j] - gmax);
    const float gw_ = 1.f / gsum;
    int i0 = 0; float v0 = e8[0];
#pragma unroll
    for (int j = 1; j < 8; ++j) if (e8[j] > v0) { v0 = e8[j]; i0 = j; }
    int i1 = -1; float v1 = -INFINITY;
#pragma unroll
    for (int j = 0; j < 8; ++j) if (j != i0 && e8[j] > v1) { v1 = e8[j]; i1 = j; }
    const float ex = expf(v1 - v0);
    const float w0 = gw_ / (1.f + ex), w1 = gw_ * ex / (1.f + ex);
    if ((lane & 15) == 0) {
      const int tok = tok0 + qd;
      const int ea = gs * 8 + i0, eb = gs * 8 + i1;
      int sa = atomicAdd(&cnt[ea], 1);
      list[(size_t)ea * NTOK + sa] = tok * 2; wlist[(size_t)ea * NTOK + sa] = w0;
      int sb = atomicAdd(&cnt[eb], 1);
      list[(size_t)eb * NTOK + sb] = tok * 2 + 1; wlist[(size_t)eb * NTOK + sb] = w1;
    }
  }
}

struct ExpInfo { int tiles[4], base[4], cnt[4]; };
DEVI ExpInfo exp_info(KP p, int xcd) {
  const int* cnt = wsp<int>(p, OFF_CNT);
  ExpInfo ei;
  int before = 0;
#pragma unroll
  for (int e = 0; e < 32; ++e) {
    const int c = cnt[e], t = (c + 127) >> 7;
    if ((e & 7) == xcd) { ei.tiles[e >> 3] = t; ei.base[e >> 3] = before; ei.cnt[e >> 3] = c; }
    before += t;
  }
  return ei;
}
DEVI void phaseI1(KP p, char* lds) {
  const int G8 = gridDim.x >> 3, xcd = BIDX & 7, lb = BIDX >> 3;
  if (lb >= G8) return;
  const int tid = TIDX, lane = tid & 63, wave = tid >> 6;
  const int wm = wave >> 1, wn = wave & 1, r32 = lane & 31, hh = lane >> 5;
  const ExpInfo ei = exp_info(p, xcd);
  const int tot = (ei.tiles[0] + ei.tiles[1] + ei.tiles[2] + ei.tiles[3]) * 4;
  const u16* H = wsp<u16>(p, OFF_H);
  const int* list = wsp<int>(p, OFF_LIST);
  u16* U = wsp<u16>(p, OFF_U);
  for (int n = lb; n < tot; n += G8) {
    int k = 0, m = n >> 2; const int nt = n & 3;
    int tb = ei.base[0], ce = ei.cnt[0];
#pragma unroll
    for (int kk = 0; kk < 3; ++kk) {
      if (k == kk && m >= ei.tiles[kk]) { m -= ei.tiles[kk]; k = kk + 1; tb = ei.base[kk + 1]; ce = ei.cnt[kk + 1]; }
    }
    const int e = xcd + 8 * k;
    const int* le = list + (size_t)e * NTOK + m * 128;
    const int nvalid = ce - m * 128;
    f32x16 acc[2][2];
    zero_acc<2>(acc);
    gemm_main<128>(acc, [&](int r) { const int t = (r < nvalid) ? (le[r] >> 1) : 0; return H + (size_t)t * 1024; },
                   wsp<u16>(p, OFF_W13) + ((size_t)e * 512 + nt * 128) * 1024, 1024, 16, lds);
    const size_t urow0 = (size_t)(tb + m) * 128;
    const int col = nt * 64 + wn * 32 + r32;
#pragma unroll
    for (int mi = 0; mi < 2; ++mi)
#pragma unroll
      for (int i = 0; i < 16; ++i) {
        const int row = wm * 64 + mi * 32 + (i & 3) + 8 * (i >> 2) + 4 * hh;
        const float g = acc[mi][0][i], u = acc[mi][1][i];
        const float sv = g / (1.f + __expf(-g)) * u;
        U[(urow0 + row) * 256 + col] = f2bf(sv);
      }
  }
}
DEVI void phaseI2(KP p, char* lds) {
  const int G8 = gridDim.x >> 3, xcd = BIDX & 7, lb = BIDX >> 3;
  if (lb >= G8) return;
  const int tid = TIDX, lane = tid & 63, wave = tid >> 6;
  const int wm = wave >> 1, wn = wave & 1, r32 = lane & 31, hh = lane >> 5;
  const ExpInfo ei = exp_info(p, xcd);
  const int tot = (ei.tiles[0] + ei.tiles[1] + ei.tiles[2] + ei.tiles[3]) * 8;
  const int* list = wsp<int>(p, OFF_LIST);
  const float* wlist = wsp<float>(p, OFF_WLIST);
  const u16* U = wsp<u16>(p, OFF_U);
  u16* YS = wsp<u16>(p, OFF_YS);
  for (int n = lb; n < tot; n += G8) {
    int k = 0, m = n >> 3; const int nt = n & 7;
    int tb = ei.base[0], ce = ei.cnt[0];
#pragma unroll
    for (int kk = 0; kk < 3; ++kk) {
      if (k == kk && m >= ei.tiles[kk]) { m -= ei.tiles[kk]; k = kk + 1; tb = ei.base[kk + 1]; ce = ei.cnt[kk + 1]; }
    }
    const int e = xcd + 8 * k;
    const int nvalid = ce - m * 128;
    f32x16 acc[2][2];
    zero_acc<2>(acc);
    const u16* Ab = U + (size_t)(tb + m) * 128 * 256;
    gemm_main<128>(acc, [&](int r) { return Ab + (size_t)r * 256; }, wsp<u16>(p, OFF_W2) + ((size_t)e * 1024 + nt * 128) * 256, 256, 4, lds);
    const int* le = list + (size_t)e * NTOK + m * 128;
    const float* we = wlist + (size_t)e * NTOK + m * 128;
#pragma unroll
    for (int mi = 0; mi < 2; ++mi)
#pragma unroll
      for (int i = 0; i < 16; ++i) {
        const int row = wm * 64 + mi * 32 + (i & 3) + 8 * (i >> 2) + 4 * hh;
        if (row < nvalid) {
          const int dest = le[row]; const float w = we[row];
#pragma unroll
          for (int ni = 0; ni < 2; ++ni)
            YS[(size_t)dest * 1024 + nt * 128 + wn * 64 + ni * 32 + r32] = f2bf(acc[mi][ni][i] * w);
        }
      }
  }
}
DEVI void phaseJ(KP p, int l, char* lds) {
  const int lane = TIDX & 63;
  const int gw = BIDX * 4 + (TIDX >> 6), nw = gridDim.x * 4;
  const u16* YS = wsp<u16>(p, OFF_YS);
  u16* H = wsp<u16>(p, OFF_H);
  for (int tok = gw; tok < NTOK; tok += nw) {
    const int b = tok / TPB, rr = tok % TPB;
    if (l == 1 && rr < NCTX) continue;
    const int mrow = (rr < NCTX) ? 8 : b;
    float* xr = xrow_res(p, b, rr);
    const float* gt = wsp<float>(p, OFF_MOD) + ((size_t)l * 9 + mrow) * 6144 + 5120;
    float xv[16];
    load_row16(xr, xv);
#pragma unroll
    for (int i = 0; i < 4; ++i) {
      const int c = i * 256 + lane * 4;
      const u32x2 y0 = *(const u32x2*)(YS + (size_t)(tok * 2) * 1024 + c);
      const u32x2 y1 = *(const u32x2*)(YS + (size_t)(tok * 2 + 1) * 1024 + c);
      const f32x4 g = *(const f32x4*)(gt + c);
      xv[i * 4 + 0] += g.x * (bf2f((u16)(y0.x & 0xffff)) + bf2f((u16)(y1.x & 0xffff)));
      xv[i * 4 + 1] += g.y * (bf2f((u16)(y0.x >> 16)) + bf2f((u16)(y1.x >> 16)));
      xv[i * 4 + 2] += g.z * (bf2f((u16)(y0.y & 0xffff)) + bf2f((u16)(y1.y & 0xffff)));
      xv[i * 4 + 3] += g.w * (bf2f((u16)(y0.y >> 16)) + bf2f((u16)(y1.y >> 16)));
    }
    if (l == 0) {
#pragma unroll
      for (int i = 0; i < 4; ++i)
        *(f32x4*)(xr + i * 256 + lane * 4) = f32x4{xv[i * 4], xv[i * 4 + 1], xv[i * 4 + 2], xv[i * 4 + 3]};
      float hv[16];
      modulate_row_store(p, 1, 0, xv, mrow, H + (size_t)tok * 1024, hv);
    } else {
      float ss = 0.f;
#pragma unroll
      for (int i = 0; i < 16; ++i) ss += xv[i] * xv[i];
      ss = wave_sum(ss);
      const float rstd = rsqrtf(ss * (1.f / 1024.f) + EPS);
#pragma unroll
      for (int i = 0; i < 4; ++i) {
        const int c = i * 256 + lane * 4;
        const f32x4 g = *(const f32x4*)(p->g_final + c);
        *(f32x4*)(xr + c) = f32x4{xv[i * 4] * rstd * g.x, xv[i * 4 + 1] * rstd * g.y, xv[i * 4 + 2] * rstd * g.z, xv[i * 4 + 3] * rstd * g.w};
      }
    }
  }
  if (l == 0) {
    for (int item = BIDX; item < CONV_ITEMS; item += gridDim.x) {
      ConvT c = conv_decode(p, 1, item);
      conv_tile(c, lds);
    }
  }
}

#define XB_TMO      128
#define XB_XCNT(j)  (256  + 64 * (j))
#define XB_XSUB(j)  (1280 + 64 * (j))
#define XB_XGEN(j)  (2304 + 64 * (j))
#define XB_TOP      3328
#define XB_TOPGEN   3392
#define XB_SPIN_CAP (1u << 20)
#define LAS __attribute__((address_space(3)))
DEVI unsigned xb_ld(unsigned* p) { return __hip_atomic_load(p, __ATOMIC_RELAXED, __HIP_MEMORY_SCOPE_AGENT); }
DEVI unsigned xb_add(unsigned* p, unsigned v) { return __hip_atomic_fetch_add(p, v, __ATOMIC_RELAXED, __HIP_MEMORY_SCOPE_AGENT); }
DEVI unsigned xb_xcc_id() { return (unsigned)__builtin_amdgcn_s_getreg((3 << 11) | 20) & 0xFu; }
#define XB_SPIN(cond, bar) do { unsigned _sp = 0; while (cond) { __builtin_amdgcn_s_sleep(1); \
    if ((++_sp & 255u) == 0u) { if (xb_ld(&(bar)[XB_TMO])) break; if (_sp > XB_SPIN_CAP) { atomicAdd(&(bar)[XB_TMO], 1u); break; } } } } while (0)
DEVI void xcd_barrier_post(unsigned* bar) {
  if (TIDX == 0) (void)xb_add(&bar[XB_XCNT(xb_xcc_id())], 1u);
}
DEVI void xcd_barrier_complete(unsigned* bar, unsigned x, unsigned& nloc, unsigned& nx) {
  const unsigned G = gridDim.x * gridDim.y * gridDim.z;
  unsigned sum, cnt, mine, sp = 0u;
  for (;;) {
    sum = 0u; cnt = 0u; mine = 0u;
#pragma unroll
    for (unsigned j = 0; j < 16; ++j) { const unsigned c = xb_ld(&bar[XB_XCNT(j)]); sum += c; cnt += (c > 0u) ? 1u : 0u; mine = (j == x) ? c : mine; }
    if (sum == G) break;
    __builtin_amdgcn_s_sleep(1);
    if ((++sp & 255u) == 0u) { if (xb_ld(&bar[XB_TMO])) break; if (sp > XB_SPIN_CAP) { atomicAdd(&bar[XB_TMO], 1u); break; } }
  }
  nloc = mine > 0u ? mine : 1u; nx = cnt > 0u ? cnt : 1u;
}
DEVI void xcd_barrier(unsigned* bar, volatile LAS unsigned* st) {
  asm volatile("s_waitcnt vmcnt(0)" ::: "memory");
  __syncthreads();
  if (TIDX == 0) {
    const unsigned x = xb_xcc_id();
    __builtin_amdgcn_s_waitcnt(0);
    unsigned nloc = st[0], nx = st[1];
    if (nloc == 0u) { xcd_barrier_complete(bar, x, nloc, nx); st[0] = nloc; st[1] = nx; }
    const unsigned old = xb_add(&bar[XB_XSUB(x)], 1u);
    const unsigned gen = old / nloc;
    if (old + 1u == (gen + 1u) * nloc) {
      __builtin_amdgcn_fence(__ATOMIC_RELEASE, "agent");
      asm volatile("s_waitcnt vmcnt(0)" ::: "memory");
      const unsigned og = xb_add(&bar[XB_TOP], 1u);
      const unsigned tg = og / nx;
      if (og + 1u == (tg + 1u) * nx) xb_add(&bar[XB_TOPGEN], 1u);
      else XB_SPIN(xb_ld(&bar[XB_TOPGEN]) == tg, bar);
      __builtin_amdgcn_fence(__ATOMIC_ACQUIRE, "agent");
      xb_add(&bar[XB_XGEN(x)], 1u);
      asm volatile("s_waitcnt vmcnt(0)" ::: "memory");
    } else {
      XB_SPIN(xb_ld(&bar[XB_XGEN(x)]) == gen, bar);
      __builtin_amdgcn_fence(__ATOMIC_ACQUIRE, "agent");
      asm volatile("s_waitcnt vmcnt(0)" ::: "memory");
    }
  }
  __syncthreads();
}

constexpr int N_PHASES = 21;
__global__ void __launch_bounds__(256, 2) fwd_megakernel(Params parg) {
  __shared__ __attribute__((aligned(16))) char smem[SMEM_BYTES + 16];
  cg::grid_group grid = cg::this_grid();
  volatile LAS unsigned* xb_st = (volatile LAS unsigned*)(smem + SMEM_BYTES);
  if (TIDX < 4) xb_st[TIDX] = 0u;
  __syncthreads();
  if (parg.ph_end - parg.ph_begin > 1) xcd_barrier_post((unsigned*)(parg.ws + OFF_BAR));
  for (int ph = parg.ph_begin; ph < parg.ph_end; ++ph) {
    KP p = (KP)__builtin_amdgcn_kernarg_segment_ptr();
    asm volatile("" : "+s"(p));
    if (ph == 0) phase0(p, smem);
    else if (ph == 1) phase1(p);
    else if (ph == 2) phaseA(p);
    else {
      const int l = (ph >= 12) ? 1 : 0;
      const int k = (ph >= 12) ? (ph - 12) : (ph - 3);
#if PROBE_DUP
      if ((PROBE_DUP >> k) & 1) {
        switch (k) {
          case 0: phaseB(p, l, smem); break;
          case 1: phaseC(p, l, smem); break;
          case 2: phaseD(p, l, smem); break;
          case 3: phaseE(p, l, smem); break;
          case 6: phaseI1(p, smem); break;
          case 7: phaseI2(p, smem); break;
          default: break;
        }
        xcd_barrier((unsigned*)(p->ws + OFF_BAR), xb_st);
      }
#endif
      switch (k) {
        case 0: phaseB(p, l, smem); break;
        case 1: phaseC(p, l, smem); break;
        case 2: phaseD(p, l, smem); break;
        case 3: phaseE(p, l, smem); break;
        case 4: phaseF(p, l, smem); break;
        case 5: phaseG(p, l); break;
        case 6: phaseI1(p, smem); break;
        case 7: phaseI2(p, smem); break;
        default: phaseJ(p, l, smem); break;
      }
    }
    if (ph + 1 < parg.ph_end) {
      if (ph == parg.ph_begin) grid.sync();
      else xcd_barrier((unsigned*)(p->ws + OFF_BAR), xb_st);
    }
  }
}

extern "C" void kernel_launch(void* const* d_in, const int* in_sizes, int n_in, void* d_out, int out_size,
                              void* d_ws, size_t ws_size, hipStream_t stream) {
  static int grid_blocks = 0;
  if (!grid_blocks) {
    int dev = 0, cus = 0, per_cu = 0;
    hipGetDevice(&dev);
    hipDeviceGetAttribute(&cus, hipDeviceAttributeMultiprocessorCount, dev);
    hipOccupancyMaxActiveBlocksPerMultiprocessor(&per_cu, fwd_megakernel, 256, 0);
    if (per_cu > 2) per_cu = 2;
    if (per_cu < 1) per_cu = 1;
    grid_blocks = (cus * per_cu) & ~7;
  }
  if (ws_size < WS_NEEDED) { fprintf(stderr, "workspace too small: %zu < %zu\n", ws_size, (size_t)WS_NEEDED); return; }
  Params hp{};
  const float** f = (const float**)&hp;
  for (int i = 0; i < 29; ++i) f[i] = (const float*)d_in[i];
  hp.out = (float*)d_out;
  hp.ws = (char*)d_ws;
#if N_LAUNCH_MODE == 1
  for (int ph = 0; ph < N_PHASES; ++ph) {
    hp.ph_begin = ph; hp.ph_end = ph + 1;
    void* args[] = {&hp};
    hipError_t e = hipLaunchCooperativeKernel((void*)fwd_megakernel, dim3(grid_blocks), dim3(256), args, 0, stream);
    if (e != hipSuccess) fprintf(stderr, "launch failed: %s\n", hipGetErrorString(e));
  }
#else
  hp.ph_begin = 0; hp.ph_end = N_PHASES;
  hipMemsetAsync((char*)d_ws + OFF_BAR, 0, (size_t)XCD_BAR_WORDS * 4, stream);
  void* args[] = {&hp};
  hipError_t e = hipLaunchCooperativeKernel((void*)fwd_megakernel, dim3(grid_blocks), dim3(256), args, 0, stream);
  if (e != hipSuccess) fprintf(stderr, "cooperative launch failed: %s (grid %d)\n", hipGetErrorString(e), grid_blocks);
#endif
}
```

```cpp
#include <hip/hip_runtime.h>
#include <hip/hip_cooperative_groups.h>
#include <stdint.h>
#include <stdio.h>
namespace cg = cooperative_groups;

#ifndef N_LAUNCH_MODE
#define N_LAUNCH_MODE 0
#endif

#ifndef PROBE_DUP
#define PROBE_DUP 0
#endif
#define DEVI __device__ __forceinline__
typedef unsigned short u16;
typedef __attribute__((ext_vector_type(2))) float f32x2;
typedef __attribute__((ext_vector_type(2))) __bf16 bf16x2_t;
typedef __attribute__((ext_vector_type(8))) short bf16x8;
typedef __attribute__((ext_vector_type(16))) float f32x16;
typedef __attribute__((ext_vector_type(4))) unsigned u32x4;
typedef __attribute__((ext_vector_type(2))) unsigned u32x2;
typedef __attribute__((ext_vector_type(4))) float f32x4;
#define MFMA(a, b, c) __builtin_amdgcn_mfma_f32_32x32x16_bf16((a), (b), (c), 0, 0, 0)

constexpr int DMODEL = 1024, NBATCH = 8, SEQ = 4096, NCTX = 256;
constexpr int TPB = SEQ + NCTX;
constexpr int NTOK = NBATCH * TPB;
constexpr int MT_PER_B = TPB / 128;
constexpr int NEXP = 32;
constexpr int INP = 2304;
constexpr float EPS = 1e-6f;
constexpr float LOG2E = 1.4426950408889634f;
constexpr int SMEM_BYTES = 73728;
constexpr int UROWS = 2 * NTOK + NEXP * 256;

constexpr size_t al(size_t x) { return (x + 255) & ~(size_t)255; }
constexpr size_t OFF_WIN = 0;
constexpr size_t OFF_WQB = OFF_WIN + al((size_t)INP * 1024 * 2);
constexpr size_t OFF_WKVB = OFF_WQB + al((size_t)512 * 256 * 2);
constexpr size_t OFF_WGATE = OFF_WKVB + al((size_t)512 * 256 * 2);
constexpr size_t OFF_WBR = OFF_WGATE + al((size_t)4 * 1024 * 1024 * 2);
constexpr size_t OFF_WOUT = OFF_WBR + al((size_t)4 * 1024 * 256 * 2);
constexpr size_t OFF_W13 = OFF_WOUT + al((size_t)1024 * 1024 * 2);
constexpr size_t OFF_W2 = OFF_W13 + al((size_t)32 * 512 * 1024 * 2);
constexpr size_t OFF_MODP = OFF_W2 + al((size_t)32 * 1024 * 256 * 2);
constexpr size_t OFF_MOD = OFF_MODP + al((size_t)8 * 2 * 9 * 6144 * 4);
constexpr size_t OFF_CS32 = OFF_MOD + al((size_t)2 * 9 * 6144 * 4);
constexpr size_t OFF_CS16 = OFF_CS32 + al((size_t)64 * 16 * 2 * 4);
constexpr size_t OFF_WRT = OFF_CS16 + al((size_t)64 * 8 * 2 * 4);
constexpr size_t OFF_CNT = OFF_WRT + al((size_t)2 * 36 * 1024 * 4);
constexpr size_t OFF_BAR = OFF_CNT + al(256);
constexpr int XCD_BAR_WORDS = 3456;
constexpr size_t OFF_CTXRES = OFF_BAR + al((size_t)XCD_BAR_WORDS * 4);
constexpr size_t OFF_H = OFF_CTXRES + al((size_t)8 * 256 * 1024 * 4);
constexpr size_t OFF_O = OFF_H + al((size_t)NTOK * 1024 * 2);
constexpr size_t OFF_LIST = OFF_O + al((size_t)NTOK * 1024 * 2);
constexpr size_t OFF_WLIST = OFF_LIST + al((size_t)32 * NTOK * 4);
constexpr size_t OFF_R1 = OFF_WLIST + al((size_t)32 * NTOK * 4);
constexpr int PLD = INP;
constexpr size_t OFF_PRAW = OFF_R1;
constexpr size_t OFF_QARAW = OFF_PRAW + (size_t)NTOK * INP * 2;
constexpr size_t OFF_KVARAW = OFF_QARAW + (size_t)NTOK * 512 * 2;
constexpr size_t OFF_VAT = OFF_KVARAW + (size_t)NTOK * 512 * 2;
constexpr size_t OFF_VBT = OFF_VAT + (size_t)NTOK * 256 * 2;
constexpr size_t OFF_VCT = OFF_VBT + (size_t)NTOK * 128 * 2;
constexpr size_t OFF_VDT = OFF_VCT + (size_t)NTOK * 256 * 2;
constexpr size_t OFF_END = OFF_VDT + (size_t)NTOK * 128 * 2;
constexpr size_t OFF_Z = OFF_R1;
constexpr size_t OFF_YPART = OFF_R1 + (size_t)NTOK * 2048 * 2;
constexpr size_t OFF_YPRE = OFF_YPART + (size_t)NTOK * 1024 * 2;
constexpr size_t OFF_U = OFF_R1;
constexpr size_t OFF_YS = OFF_R1 + al((size_t)UROWS * 256 * 2);
static_assert(OFF_YPRE + (size_t)NTOK * 1024 * 2 <= OFF_END, "alias overflow");
static_assert(OFF_YS + (size_t)(2 * NTOK + 1) * 1024 * 2 <= OFF_END, "alias overflow");
constexpr size_t WS_NEEDED = OFF_END;
static_assert(WS_NEEDED <= (size_t)536870912, "workspace budget (4 x largest tensor)");

struct Params {
  const float *x, *c, *ctx, *c_ctx, *w_mod, *b_mod, *g_norm_mix, *w_in, *g_q_a, *w_q_b, *g_kv_a, *w_kv_b,
      *sink_b, *rpb_c, *g_q_d, *g_k_d, *w_gate, *b_gate, *w_branch, *w_out, *g_norm_ffn, *w_group, *b_group,
      *w_router, *b_router, *w_ff1, *w_ff3, *w_ff2, *g_final;
  float* out;
  char* ws;
  int ph_begin, ph_end;
};

DEVI int tid_fresh() { int t; asm volatile("v_mov_b32 %0, %1" : "=v"(t) : "v"(__builtin_amdgcn_workitem_id_x())); return t; }
DEVI int bid_fresh() { int t; asm volatile("s_mov_b32 %0, %1" : "=s"(t) : "s"(__builtin_amdgcn_workgroup_id_x())); return t; }
#define TIDX tid_fresh()
#define BIDX bid_fresh()
typedef const __attribute__((address_space(4))) Params* KP;
DEVI unsigned pk2(float a, float b) { f32x2 v = {a, b}; bf16x2_t r = __builtin_convertvector(v, bf16x2_t); return __builtin_bit_cast(unsigned, r); }
DEVI u16 f2bf(float a) { return (u16)(pk2(a, 0.f) & 0xffffu); }
DEVI float bf2f(u16 v) { return __uint_as_float(((unsigned)v) << 16); }
DEVI float wave_sum(float v) {
#pragma unroll
  for (int m = 32; m >= 1; m >>= 1) v += __shfl_xor(v, m);
  return v;
}
template <class T> DEVI T* wsp(KP p, size_t off) { return (T*)(p->ws + off); }
DEVI const float* xrow_in(KP p, int l, int b, int rr) {
  if (l == 0) return (rr < NCTX) ? p->ctx + ((size_t)b * NCTX + rr) * 1024 : p->x + ((size_t)b * SEQ + rr - NCTX) * 1024;
  return (rr < NCTX) ? wsp<float>(p, OFF_CTXRES) + ((size_t)b * NCTX + rr) * 1024 : p->out + ((size_t)b * SEQ + rr - NCTX) * 1024;
}
DEVI float* xrow_res(KP p, int b, int rr) {
  return (rr < NCTX) ? wsp<float>(p, OFF_CTXRES) + ((size_t)b * NCTX + rr) * 1024 : p->out + ((size_t)b * SEQ + rr - NCTX) * 1024;
}
DEVI int perm16(int k) { return (k & ~12) | ((k & 4) << 1) | ((k & 8) >> 1); }

struct ConvT { const float* src; const float* src2; const float* ks; u16* dst; int ld; int ldd; float mul; };
constexpr int CONV_ITEMS = 1152 + 64 + 64 + 2048 + 512 + 512 + 8192 + 4096;
DEVI ConvT conv_decode(KP p, int l, int idx) {
  ConvT c; c.ks = nullptr; c.mul = 1.f; c.src2 = nullptr;
  if (idx < 1152) {
    int nt = idx >> 4, kt = idx & 15, n0 = nt * 32;
    int sc = (n0 < 416) ? n0 : ((n0 < 512) ? -1 : n0 - 96);
    c.ld = 2208; c.ldd = 1024;
    if ((n0 >= 512 && n0 < 768) || (n0 >= 1024 && n0 < 1280)) c.mul = 0.125f * LOG2E;
    c.src = (sc < 0) ? nullptr : p->w_in + (size_t)l * 1024 * 2208 + (size_t)kt * 64 * 2208 + sc;
    c.dst = wsp<u16>(p, OFF_WIN) + (size_t)n0 * 1024 + kt * 64;
    return c;
  }
  idx -= 1152;
  if (idx < 64) {
    int nt = idx >> 2, kt = idx & 3;
    c.ld = 384; c.ldd = 256; c.ks = p->g_q_a + l * 256 + kt * 64;
    c.src = (nt >= 12) ? nullptr : p->w_q_b + (size_t)l * 256 * 384 + (size_t)kt * 64 * 384 + nt * 32;
    c.dst = wsp<u16>(p, OFF_WQB) + (size_t)nt * 32 * 256 + kt * 64;
    return c;
  }
  idx -= 64;
  if (idx < 64) {
    int nt = idx >> 2, kt = idx & 3;
    c.ld = 512; c.ldd = 256; c.ks = (kt < 2) ? p->g_kv_a + l * 128 + kt * 64 : nullptr;
    c.src = (kt >= 2) ? nullptr : p->w_kv_b + (size_t)l * 128 * 512 + (size_t)kt * 64 * 512 + nt * 32;
    c.dst = wsp<u16>(p, OFF_WKVB) + (size_t)nt * 32 * 256 + kt * 64;
    return c;
  }
  idx -= 64;
  if (idx < 2048) {
    int nt = idx >> 4, kt = idx & 15, R0 = nt * 32;
    int pr = R0 >> 11, cb = (R0 & 2047) >> 8, bj = (R0 & 255) >> 7, j0 = R0 & 127;
    c.ld = 1024; c.ldd = 1024;
    c.src = p->w_gate + ((size_t)(l * 4 + 2 * pr + bj) * 1024 + kt * 64) * 1024 + cb * 128 + j0;
    c.dst = wsp<u16>(p, OFF_WGATE) + (size_t)R0 * 1024 + kt * 64;
    return c;
  }
  idx -= 2048;
  if (idx < 512) {
    int br = idx >> 7, nt = (idx >> 2) & 31, kt = idx & 3;
    c.ld = 1024; c.ldd = 256;
    c.src = p->w_branch + ((size_t)(l * 4 + br) * 256 + kt * 64) * 1024 + nt * 32;
    c.dst = wsp<u16>(p, OFF_WBR) + ((size_t)br * 1024 + nt * 32) * 256 + kt * 64;
    return c;
  }
  idx -= 512;
  if (idx < 512) {
    int nt = idx >> 4, kt = idx & 15;
    c.ld = 1024; c.ldd = 1024;
    c.src = p->w_out + ((size_t)l * 1024 + kt * 64) * 1024 + nt * 32;
    c.dst = wsp<u16>(p, OFF_WOUT) + (size_t)nt * 32 * 1024 + kt * 64;
    return c;
  }
  idx -= 512;
  if (idx < 8192) {
    int e = idx >> 8, g32 = (idx >> 4) & 15, kt = idx & 15;
    c.ld = 256; c.ldd = 1024;
    c.src = p->w_ff1 + ((size_t)(l * 32 + e) * 1024 + kt * 64) * 256 + g32 * 16;
    c.src2 = p->w_ff3 + ((size_t)(l * 32 + e) * 1024 + kt * 64) * 256 + g32 * 16;
    c.dst = wsp<u16>(p, OFF_W13) + ((size_t)e * 512 + g32 * 32) * 1024 + kt * 64;
    return c;
  }
  idx -= 8192;
  {
    int e = idx >> 7, nt = (idx >> 2) & 31, kt = idx & 3;
    c.ld = 1024; c.ldd = 256;
    c.src = p->w_ff2 + ((size_t)(l * 32 + e) * 256 + kt * 64) * 1024 + nt * 32;
    c.dst = wsp<u16>(p, OFF_W2) + ((size_t)e * 1024 + nt * 32) * 256 + kt * 64;
    return c;
  }
}
DEVI void modulate_row_store(KP p, int l, int which, const float (&xv)[16], int mrow, u16* hrow, float (&hv)[16]) {
  const int lane = TIDX & 63;
  float ss = 0.f;
#pragma unroll
  for (int i = 0; i < 16; ++i) ss += xv[i] * xv[i];
  ss = wave_sum(ss);
  const float rstd = rsqrtf(ss * (1.f / 1024.f) + EPS);
  const float* g = (which ? p->g_norm_ffn : p->g_norm_mix) + l * 1024;
  const float* mod = wsp<float>(p, OFF_MOD) + ((size_t)l * 9 + mrow) * 6144 + (which ? 3072 : 0);
#pragma unroll
  for (int i = 0; i < 4; ++i) {
    const int c = i * 256 + lane * 4;
    f32x4 gv = *(const f32x4*)(g + c);
    f32x4 sh = *(const f32x4*)(mod + c);
    f32x4 sc = *(const f32x4*)(mod + 1024 + c);
    hv[i * 4 + 0] = xv[i * 4 + 0] * rstd * gv.x * (1.f + sc.x) + sh.x;
    hv[i * 4 + 1] = xv[i * 4 + 1] * rstd * gv.y * (1.f + sc.y) + sh.y;
    hv[i * 4 + 2] = xv[i * 4 + 2] * rstd * gv.z * (1.f + sc.z) + sh.z;
    hv[i * 4 + 3] = xv[i * 4 + 3] * rstd * gv.w * (1.f + sc.w) + sh.w;
    u32x2 o; o.x = pk2(hv[i * 4 + 0], hv[i * 4 + 1]); o.y = pk2(hv[i * 4 + 2], hv[i * 4 + 3]);
    *(u32x2*)(hrow + c) = o;
  }
}
DEVI void load_row16(const float* xr, float (&xv)[16]) {
  const int lane = TIDX & 63;
#pragma unroll
  for (int i = 0; i < 4; ++i) {
    f32x4 v = *(const f32x4*)(xr + i * 256 + lane * 4);
    xv[i * 4 + 0] = v.x; xv[i * 4 + 1] = v.y; xv[i * 4 + 2] = v.z; xv[i * 4 + 3] = v.w;
  }
}
DEVI float router_dot(const float (&hv)[4][16], const float* wrow) {
  const int lane = TIDX & 63;
  const float* w = wrow + lane * 4;
  float pr[4] = {0.f, 0.f, 0.f, 0.f};
#pragma unroll
  for (int i = 0; i < 4; ++i) {
    const f32x4 wv = *(const f32x4*)(w + i * 256);
#pragma unroll
    for (int r = 0; r < 4; ++r)
      pr[r] += hv[r][i * 4] * wv.x + hv[r][i * 4 + 1] * wv.y + hv[r][i * 4 + 2] * wv.z + hv[r][i * 4 + 3] * wv.w;
  }
  const bool up = (lane & 32) != 0;
  float s0 = up ? pr[0] : pr[2], s1 = up ? pr[1] : pr[3];
  float k0 = up ? pr[2] : pr[0], k1 = up ? pr[3] : pr[1];
  k0 += __shfl_xor(s0, 32); k1 += __shfl_xor(s1, 32);
  const bool up2 = (lane & 16) != 0;
  float sv = up2 ? k0 : k1, kv = up2 ? k1 : k0;
  kv += __shfl_xor(sv, 16);
  kv += __shfl_xor(kv, 8); kv += __shfl_xor(kv, 4); kv += __shfl_xor(kv, 2); kv += __shfl_xor(kv, 1);
  return kv;
}
#define XB_TMO      128
#define XB_XCNT(j)  (256  + 64 * (j))
#define XB_XSUB(j)  (1280 + 64 * (j))
#define XB_XGEN(j)  (2304 + 64 * (j))
#define XB_TOP      3328
#define XB_TOPGEN   3392
#define XB_SPIN_CAP (1u << 20)
#define LAS __attribute__((address_space(3)))
DEVI unsigned xb_ld(unsigned* p) { return __hip_atomic_load(p, __ATOMIC_RELAXED, __HIP_MEMORY_SCOPE_AGENT); }
DEVI unsigned xb_add(unsigned* p, unsigned v) { return __hip_atomic_fetch_add(p, v, __ATOMIC_RELAXED, __HIP_MEMORY_SCOPE_AGENT); }
DEVI unsigned xb_xcc_id() { return (unsigned)__builtin_amdgcn_s_getreg((3 << 11) | 20) & 0xFu; }
#define XB_SPIN(cond, bar) do { unsigned _sp = 0; while (cond) { __builtin_amdgcn_s_sleep(1); \
    if ((++_sp & 255u) == 0u) { if (xb_ld(&(bar)[XB_TMO])) break; if (_sp > XB_SPIN_CAP) { atomicAdd(&(bar)[XB_TMO], 1u); break; } } } } while (0)
DEVI void xcd_barrier_post(unsigned* bar) {
  if (TIDX == 0) (void)xb_add(&bar[XB_XCNT(xb_xcc_id())], 1u);
}
DEVI void xcd_barrier_complete(unsigned* bar, unsigned x, unsigned& nloc, unsigned& nx) {
  const unsigned G = gridDim.x * gridDim.y * gridDim.z;
  unsigned sum, cnt, mine, sp = 0u;
  for (;;) {
    sum = 0u; cnt = 0u; mine = 0u;
#pragma unroll
    for (unsigned j = 0; j < 16; ++j) { const unsigned c = xb_ld(&bar[XB_XCNT(j)]); sum += c; cnt += (c > 0u) ? 1u : 0u; mine = (j == x) ? c : mine; }
    if (sum == G) break;
    __builtin_amdgcn_s_sleep(1);
    if ((++sp & 255u) == 0u) { if (xb_ld(&bar[XB_TMO])) break; if (sp > XB_SPIN_CAP) { atomicAdd(&bar[XB_TMO], 1u); break; } }
  }
  nloc = mine > 0u ? mine : 1u; nx = cnt > 0u ? cnt : 1u;
}
DEVI void xcd_barrier(unsigned* bar, volatile LAS unsigned* st) {
  asm volatile("s_waitcnt vmcnt(0)" ::: "memory");
  __syncthreads();
  if (TIDX == 0) {
    const unsigned x = xb_xcc_id();
    __builtin_amdgcn_s_waitcnt(0);
    unsigned nloc = st[0], nx = st[1];
    if (nloc == 0u) { xcd_barrier_complete(bar, x, nloc, nx); st[0] = nloc; st[1] = nx; }
    const unsigned old = xb_add(&bar[XB_XSUB(x)], 1u);
    const unsigned gen = old / nloc;
    if (old + 1u == (gen + 1u) * nloc) {
      __builtin_amdgcn_fence(__ATOMIC_RELEASE, "agent");
      asm volatile("s_waitcnt vmcnt(0)" ::: "memory");
      const unsigned og = xb_add(&bar[XB_TOP], 1u);
      const unsigned tg = og / nx;
      if (og + 1u == (tg + 1u) * nx) xb_add(&bar[XB_TOPGEN], 1u);
      else XB_SPIN(xb_ld(&bar[XB_TOPGEN]) == tg, bar);
      __builtin_amdgcn_fence(__ATOMIC_ACQUIRE, "agent");
      xb_add(&bar[XB_XGEN(x)], 1u);
      asm volatile("s_waitcnt vmcnt(0)" ::: "memory");
    } else {
      XB_SPIN(xb_ld(&bar[XB_XGEN(x)]) == gen, bar);
      __builtin_amdgcn_fence(__ATOMIC_ACQUIRE, "agent");
      asm volatile("s_waitcnt vmcnt(0)" ::: "memory");
    }
  }
  __syncthreads();
}

namespace v2 {
typedef LAS unsigned char* ldsp_t;
constexpr int BM = 256, BK = 64, HALF = 128, HTB = HALF * BK * 2, STAGE_BYTES = 8 * HTB;
constexpr int NW = 8;
constexpr int LDS_XTRA = STAGE_BYTES;
constexpr int LDS_BARW = STAGE_BYTES + 16384;
constexpr int LDS_TOTAL = LDS_BARW + 16;

DEVI int lds_byte(int r, int c) { const int st = (r >> 4) * 2 + (c >> 5), rr = r & 15, cc = c & 31, ob = rr * 64 + cc * 2; return st * 1024 + (ob ^ (((ob >> 9) & 1) << 5)); }
DEVI void stage_rc(int b, int& R, int& C) { const int st = b / 1024, sb = b % 1024, swz = sb ^ (((sb >> 9) & 1) << 5); R = (st >> 1) * 16 + swz / 64; C = (st & 1) * 32 + (swz % 64) / 2; }
DEVI int perm32(int rho) { const int n = rho >> 4, i = rho & 15; return 8 * (i >> 2) + 4 * n + (i & 3); }

struct Unit { const char* A; const char* B; const int* rows; int nvalid; int u0, u1, u2, u3; };

template <bool PERM, bool GATHER, class Epi, class Sched>
DEVI void gemm_phase(ldsp_t lds, int lda_b, int ldb_b, int nt, const Sched& S, const Epi& E) {
  const int tid = TIDX, wid = __builtin_amdgcn_readfirstlane(tid >> 6), lane = tid & 63, wr = wid >> 2, wc = wid & 3, fr = lane & 15, fq = lane >> 4;
  unsigned voffA[2], voffB[2]; int RA[2], CA2[2];
#pragma unroll
  for (int i = 0; i < 2; ++i) {
    int R, C; stage_rc(tid * 16 + i * 8192, R, C);
    const int Rb = PERM ? ((R & ~31) + perm32(R & 31)) : R;
    RA[i] = R; CA2[i] = C * 2;
    voffA[i] = (unsigned)(R * lda_b + C * 2); voffB[i] = (unsigned)(Rb * ldb_b + C * 2);
  }
  const size_t kstep = (size_t)(BK * 2);
  const size_t hstepA = (size_t)HALF * lda_b, hstepB = (size_t)HALF * ldb_b;
  const unsigned ldsw = (unsigned)wid * 1024u;
  const int aoff = lds_byte(wr * 64 + fr, fq * 8), boff = lds_byte(wc * 32 + fr, fq * 8);
#define G_SA(b, h) (((b) * 2 + (h)) * HTB)
#define G_SB(b, h) ((4 + (b) * 2 + (h)) * HTB)
#define G_STAGE(bufoff, gbase, voff) do { _Pragma("unroll") for (int _i = 0; _i < 2; ++_i) \
    __builtin_amdgcn_global_load_lds((const unsigned*)((const char*)(gbase) + (voff)[_i]), (LAS unsigned*)(lds + (bufoff) + ldsw + _i * 8192), 16, 0, 0); } while (0)
#define G_STAGE_A(bufoff, abase, go, h, koff) do { if (GATHER) { _Pragma("unroll") for (int _i = 0; _i < 2; ++_i) \
    __builtin_amdgcn_global_load_lds((const unsigned*)((abase) + (go)[h][_i] + (koff)), (LAS unsigned*)(lds + (bufoff) + ldsw + _i * 8192), 16, 0, 0); } \
    else G_STAGE(bufoff, (abase) + (h) * hstepA + (koff), voffA); } while (0)
#define G_LDA(dst, b, h) do { _Pragma("unroll") for (int m = 0; m < 4; ++m) _Pragma("unroll") for (int k = 0; k < 2; ++k) dst[m][k] = *(const LAS bf16x8*)(lds + G_SA(b, h) + aoff + m * 2048 + k * 1024); } while (0)
#define G_LDB(dst, b, h) do { _Pragma("unroll") for (int n = 0; n < 2; ++n) _Pragma("unroll") for (int k = 0; k < 2; ++k) dst[n][k] = *(const LAS bf16x8*)(lds + G_SB(b, h) + boff + n * 2048 + k * 1024); } while (0)
#define G_MMA(ai, bj, At, Bt) do { __builtin_amdgcn_s_setprio(1); _Pragma("unroll") for (int m = 0; m < 4; ++m) _Pragma("unroll") for (int n = 0; n < 2; ++n) _Pragma("unroll") for (int k = 0; k < 2; ++k) \
    acc[ai][bj][m][n] = __builtin_amdgcn_mfma_f32_16x16x32_bf16(Bt[n][k], At[m][k], acc[ai][bj][m][n], 0, 0, 0); __builtin_amdgcn_s_setprio(0); } while (0)
#define G_WAIT_V(n) asm volatile("s_waitcnt vmcnt(" #n ")" ::: "memory")
#define G_WAIT_L(n) asm volatile("s_waitcnt lgkmcnt(" #n ")" ::: "memory")
#define G_BAR __builtin_amdgcn_s_barrier()
#define G_SCHED __builtin_amdgcn_sched_barrier(0)
  Unit cur, nxt; int ui = 0;
  if (!S.next(0, cur)) return;
  f32x4 acc[2][2][4][2];
#pragma unroll
  for (int a = 0; a < 2; ++a)
#pragma unroll
    for (int b = 0; b < 2; ++b)
#pragma unroll
      for (int m = 0; m < 4; ++m)
#pragma unroll
        for (int n = 0; n < 2; ++n) acc[a][b][m][n] = (f32x4){0.f, 0.f, 0.f, 0.f};
  bf16x8 At[4][2], B0[2][2], B1[2][2];
  unsigned gcur[2][2];
  auto gather_offs = [&](const Unit& u, unsigned (&go)[2][2]) {
#pragma unroll
    for (int h = 0; h < 2; ++h)
#pragma unroll
      for (int i = 0; i < 2; ++i) {
        const int r = h * HALF + RA[i];
        const int t = (r < u.nvalid) ? (u.rows[r] >> 1) : 0;
        go[h][i] = (unsigned)t * (unsigned)lda_b + (unsigned)CA2[i];
      }
  };
  if (GATHER) gather_offs(cur, gcur);
  const char* cA = cur.A; const char* cB = cur.B;
  G_STAGE(G_SB(0, 0), cB, voffB); G_STAGE_A(G_SA(0, 0), cA, gcur, 0, 0); G_STAGE(G_SB(0, 1), cB + hstepB, voffB); G_STAGE_A(G_SA(0, 1), cA, gcur, 1, 0);
  if (wr == 1) G_BAR;
  G_WAIT_V(4); G_BAR;
  G_STAGE(G_SB(1, 0), cB + kstep, voffB); G_STAGE_A(G_SA(1, 0), cA, gcur, 0, kstep); G_STAGE(G_SB(1, 1), cB + hstepB + kstep, voffB);
  G_WAIT_V(6); G_BAR;
  for (;;) {
    const bool has_next = S.next(ui + 1, nxt);
    const char* nA = has_next ? nxt.A : cA; const char* nB = has_next ? nxt.B : cB;
    for (int t = 0; t < nt; t += 2) {
      const bool last = (t == nt - 2);
      const size_t k1 = (size_t)(t + 1) * kstep;
      const char* a2 = last ? nA : cA; const char* b2 = last ? nB : cB + (size_t)(t + 2) * kstep;
      const size_t ka2 = last ? 0 : (size_t)(t + 2) * kstep;
      const char* b3 = b2 + kstep; const size_t ka3 = ka2 + kstep;
      unsigned gN[2][2];
      if (GATHER && last) {
        if (has_next) gather_offs(nxt, gN);
        else {
#pragma unroll
          for (int h = 0; h < 2; ++h)
#pragma unroll
            for (int i = 0; i < 2; ++i) gN[h][i] = gcur[h][i];
        }
      }
#define G_STAGE_A2(bufoff, h, koff) do { if (GATHER) { if (last) G_STAGE_A(bufoff, cA, gN, h, (koff) - ka2); else G_STAGE_A(bufoff, cA, gcur, h, koff); } \
        else G_STAGE_A(bufoff, a2, gcur, h, koff); } while (0)
      G_LDB(B0, 0, 0); G_SCHED; G_LDA(At, 0, 0); G_STAGE_A(G_SA(1, 1), cA, gcur, 1, k1);
      G_WAIT_L(8); G_BAR; G_WAIT_L(0); G_MMA(0, 0, At, B0); G_BAR; G_SCHED;
      G_LDB(B1, 0, 1); G_STAGE(G_SB(0, 0), b2, voffB);
      G_BAR; G_WAIT_L(0); G_MMA(0, 1, At, B1); G_BAR;
      G_LDA(At, 0, 1); G_STAGE_A2(G_SA(0, 0), 0, ka2);
      G_BAR; G_WAIT_L(0); G_MMA(1, 0, At, B0); G_BAR; G_SCHED;
      G_STAGE(G_SB(0, 1), b2 + hstepB, voffB);
      G_WAIT_V(6); G_BAR; G_MMA(1, 1, At, B1); G_BAR;
      G_LDB(B0, 1, 0); G_SCHED; G_LDA(At, 1, 0); G_STAGE_A2(G_SA(0, 1), 1, ka2);
      G_WAIT_L(8); G_BAR; G_WAIT_L(0); G_MMA(0, 0, At, B0); G_BAR; G_SCHED;
      G_LDB(B1, 1, 1); G_STAGE(G_SB(1, 0), b3, voffB);
      G_BAR; G_WAIT_L(0); G_MMA(0, 1, At, B1); G_BAR;
      G_LDA(At, 1, 1); G_STAGE_A2(G_SA(1, 0), 0, ka3);
      G_BAR; G_WAIT_L(0); G_MMA(1, 0, At, B0); G_BAR; G_SCHED;
      G_STAGE(G_SB(1, 1), b3 + hstepB, voffB);
      G_WAIT_V(6); G_BAR; G_MMA(1, 1, At, B1); G_BAR;
      if (GATHER && last) {
#pragma unroll
        for (int h = 0; h < 2; ++h)
#pragma unroll
          for (int i = 0; i < 2; ++i) gcur[h][i] = gN[h][i];
      }
#undef G_STAGE_A2
    }
    G_SCHED;
    E(acc, cur, wr, wc, fr, fq);
    G_SCHED;
    if (!has_next) break;
#pragma unroll
    for (int a = 0; a < 2; ++a)
#pragma unroll
      for (int b = 0; b < 2; ++b)
#pragma unroll
        for (int m = 0; m < 4; ++m)
#pragma unroll
          for (int n = 0; n < 2; ++n) acc[a][b][m][n] = (f32x4){0.f, 0.f, 0.f, 0.f};
    cur = nxt; cA = nA; cB = nB; ++ui;
  }
  G_WAIT_V(0);
  if (wr == 0) G_BAR;
  G_BAR;
#undef G_SA
#undef G_SB
#undef G_STAGE
#undef G_STAGE_A
#undef G_LDA
#undef G_LDB
#undef G_MMA
#undef G_WAIT_V
#undef G_WAIT_L
#undef G_BAR
#undef G_SCHED
}

DEVI bool tile_order(int i, int G, int c, int nM, int nN, int& pm, int& pn) {
  const int nwg = nM * nN;
  const long L = (long)i * G + c; if (L >= nwg) return false;
  int wgid = (int)L; { const int q = nwg / 8, r = nwg % 8, xcd = wgid % 8, off = wgid / 8; wgid = (xcd < r ? xcd * (q + 1) : r * (q + 1) + (xcd - r) * q) + off; }
  const int WGM = 8;
  const int nig = WGM * nN, gid = wgid / nig, fm = gid * WGM, gsz = (nM - fm) < WGM ? (nM - fm) : WGM;
  pm = fm + ((wgid % nig) % gsz); pn = (wgid % nig) / gsz; return true;
}
struct EpiRawBf16 {
  u16* O; int ldc;
  DEVI void operator()(const f32x4 (&acc)[2][2][4][2], const Unit& u, int wr, int wc, int fr, int fq) const {
    const int row0 = u.u0 + wr * 64 + fr, col0 = u.u1 + wc * 32 + 8 * fq;
#pragma unroll
    for (int ai = 0; ai < 2; ++ai)
#pragma unroll
      for (int m = 0; m < 4; ++m) {
        u16* rowp = O + (size_t)(row0 + ai * HALF + m * 16) * ldc + col0;
#pragma unroll
        for (int bj = 0; bj < 2; ++bj) {
          const f32x4 v0 = acc[ai][bj][m][0], v1 = acc[ai][bj][m][1];
          u32x4 w; w.x = pk2(v0[0], v0[1]); w.y = pk2(v0[2], v0[3]); w.z = pk2(v1[0], v1[1]); w.w = pk2(v1[2], v1[3]);
          *(u32x4*)(rowp + bj * HALF) = w;
        }
      }
  }
};

struct SchedB { const char* A; const char* B; int G, c;
  DEVI bool next(int i, Unit& u) const { int pm, pn; if (!tile_order(i, G, c, NTOK / 256, INP / 256, pm, pn)) return false;
    u.A = A + (size_t)pm * 256 * 2048; u.B = B + (size_t)pn * 256 * 2048; u.rows = nullptr; u.nvalid = 0; u.u0 = pm * 256; u.u1 = pn * 256; u.u2 = 0; u.u3 = 0; return true; } };
DEVI void phaseB2(KP p, ldsp_t lds) {
  SchedB S{(const char*)wsp<u16>(p, OFF_H), (const char*)wsp<u16>(p, OFF_WIN), (int)gridDim.x, BIDX};
  EpiRawBf16 E{wsp<u16>(p, OFF_PRAW), PLD};
  gemm_phase<true, false>(lds, 2048, 2048, 16, S, E);
}
struct SchedC { const char* P; const char* Wq; const char* Wkv; u16* Oq; u16* Okv; int G, c;
  DEVI bool next(int i, Unit& u) const { int pm, pn; if (!tile_order(i, G, c, NTOK / 256, 4, pm, pn)) return false;
    const bool kv = pn >= 2; const int pj = pn & 1;
    u.A = P + (size_t)pm * 256 * (PLD * 2) + (kv ? 512 : 0); u.B = (kv ? Wkv : Wq) + (size_t)pj * 256 * 512; u.rows = nullptr; u.nvalid = 0;
    u.u0 = pm * 256; u.u1 = pj * 256; u.u2 = kv; u.u3 = 0; return true; } };
struct EpiC { u16* Oq; u16* Okv;
  DEVI void operator()(const f32x4 (&acc)[2][2][4][2], const Unit& u, int wr, int wc, int fr, int fq) const {
    EpiRawBf16 E{u.u2 ? Okv : Oq, 512}; E(acc, u, wr, wc, fr, fq); } };
DEVI void phaseC2(KP p, ldsp_t lds) {
  SchedC S{(const char*)wsp<u16>(p, OFF_PRAW), (const char*)wsp<u16>(p, OFF_WQB), (const char*)wsp<u16>(p, OFF_WKVB), nullptr, nullptr, (int)gridDim.x, BIDX};
  EpiC E{wsp<u16>(p, OFF_QARAW), wsp<u16>(p, OFF_KVARAW)};
  gemm_phase<true, false>(lds, PLD * 2, 512, 4, S, E);
}

DEVI void ld16(const u16* src, float (&v)[16]) {
  const u32x4 a = *(const u32x4*)src, b = *(const u32x4*)(src + 8);
  const unsigned w[8] = {a.x, a.y, a.z, a.w, b.x, b.y, b.z, b.w};
#pragma unroll
  for (int i = 0; i < 8; ++i) { v[2 * i] = __uint_as_float(w[i] << 16); v[2 * i + 1] = __uint_as_float(w[i] & 0xffff0000u); }
}
DEVI void st16(u16* dst, const float (&v)[16]) {
  u32x4 a, b;
  a.x = pk2(v[0], v[1]); a.y = pk2(v[2], v[3]); a.z = pk2(v[4], v[5]); a.w = pk2(v[6], v[7]);
  b.x = pk2(v[8], v[9]); b.y = pk2(v[10], v[11]); b.z = pk2(v[12], v[13]); b.w = pk2(v[14], v[15]);
  *(u32x4*)dst = a; *(u32x4*)(dst + 8) = b;
}
DEVI void rope16c(float (&v)[16], const float* cs16, int pos) {
  const f32x2* t = (const f32x2*)(cs16 + pos * 16);
#pragma unroll
  for (int i = 0; i < 8; ++i) { const f32x2 cs = t[i]; const float x1 = v[i], x2 = v[8 + i]; v[i] = x1 * cs.x - x2 * cs.y; v[8 + i] = x2 * cs.x + x1 * cs.y; }
}
DEVI void rope32c(float (&lo)[16], float (&hi)[16], const float* cs32, int pos) {
  const f32x2* t = (const f32x2*)(cs32 + pos * 32);
#pragma unroll
  for (int i = 0; i < 16; ++i) { const f32x2 cs = t[i]; const float x1 = lo[i], x2 = hi[i]; lo[i] = x1 * cs.x - x2 * cs.y; hi[i] = x2 * cs.x + x1 * cs.y; }
}
DEVI float ssq16(const float (&v)[16]) { float s = 0.f;
#pragma unroll
  for (int i = 0; i < 16; ++i) s += v[i] * v[i];
  return s; }
DEVI void scale16(float (&v)[16], float s) {
#pragma unroll
  for (int i = 0; i < 16; ++i) v[i] *= s; }
DEVI void phaseP2(KP p, int l, ldsp_t lds) {
  const int tid = TIDX, tk = tid >> 3, pt = tid & 7;
  u16* PR = wsp<u16>(p, OFF_PRAW);
  u16* QA = wsp<u16>(p, OFF_QARAW);
  u16* KV = wsp<u16>(p, OFF_KVARAW);
  const float* cs32 = wsp<float>(p, OFF_CS32);
  const float* cs16 = wsp<float>(p, OFF_CS16);
  const float QSA = 0.10206207261596575f * LOG2E, QS = 0.125f * LOG2E;
  LAS u16* T = (LAS u16*)lds;
  for (int item = BIDX; item < NTOK / 64; item += gridDim.x) {
    const int tok0 = item * 64, b = tok0 / TPB, rr0 = tok0 % TPB;
    const bool lat = rr0 >= NCTX;
    const size_t tok = (size_t)tok0 + tk;
    const int t = rr0 + tk - NCTX, grow = (t >> 6) & 63, gcol = t & 63;
    u16* pr = PR + tok * PLD; u16* qa = QA + tok * 512; u16* kv = KV + tok * 512;
    float rq, rkv;
    {
      float a[16], c[16], d[16];
      ld16(pr + pt * 32, a); ld16(pr + pt * 32 + 16, c); ld16(pr + 256 + pt * 16, d);
      float sq = ssq16(a) + ssq16(c), sk = ssq16(d);
      sq += __shfl_xor(sq, 1); sq += __shfl_xor(sq, 2); sq += __shfl_xor(sq, 4);
      sk += __shfl_xor(sk, 1); sk += __shfl_xor(sk, 2); sk += __shfl_xor(sk, 4);
      rq = rsqrtf(sq * (1.f / 256.f) + EPS); rkv = rsqrtf(sk * (1.f / 128.f) + EPS);
    }
#pragma unroll
    for (int j = 0; j < 3; ++j) {
      const int c0 = 16 * (3 * pt + j), w = c0 % 96;
      float v[16]; ld16(qa + c0, v); scale16(v, rq * QSA);
      if (lat && w == 64) rope16c(v, cs16, grow);
      if (lat && w == 80) rope16c(v, cs16, gcol);
      st16(qa + c0, v);
    }
#pragma unroll
    for (int j = 0; j < 2; ++j) {
      u16* q = kv + (pt >> 1) * 128 + (pt & 1) * 32 + 16 * j;
      float v[16]; ld16(q, v); scale16(v, rkv); st16(q, v);
    }
    if (pt < 2) { float v[16]; ld16(pr + 384 + 16 * pt, v); if (lat) rope16c(v, cs16, pt == 0 ? grow : gcol); st16(pr + 384 + 16 * pt, v); }
    if (lat) {
      { float lo[16], hi[16]; u16* q = pr + 512 + 32 * pt; ld16(q, lo); ld16(q + 16, hi); rope32c(lo, hi, cs32, (pt & 1) ? gcol : grow); st16(q, lo); st16(q + 16, hi); }
      if (pt < 4) { float lo[16], hi[16]; u16* q = pr + 768 + 32 * pt; ld16(q, lo); ld16(q + 16, hi); rope32c(lo, hi, cs32, (pt & 1) ? gcol : grow); st16(q, lo); st16(q + 16, hi); }
    }
    {
      float lo[16], hi[16]; u16* q = pr + 1792 + 32 * pt; ld16(q, lo); ld16(q + 16, hi);
      float ss = ssq16(lo) + ssq16(hi); ss += __shfl_xor(ss, 1);
      const float rs = rsqrtf(ss * (1.f / 64.f) + EPS);
      const float* g = p->g_q_d + l * 64 + 32 * (pt & 1);
#pragma unroll
      for (int i = 0; i < 16; ++i) { lo[i] *= rs * g[i]; hi[i] *= rs * g[16 + i]; }
      if (lat) rope32c(lo, hi, cs32, (pt & 1) ? gcol : grow);
      scale16(lo, QS); scale16(hi, QS);
      st16(q, lo); st16(q + 16, hi);
    }
    {
      const int g4 = pt & 3;
      float lo[16], hi[16]; u16* q = pr + 2048 + 32 * g4; ld16(q, lo); ld16(q + 16, hi);
      float ss = ssq16(lo) + ssq16(hi); ss += __shfl_xor(ss, 1);
      const float rs = rsqrtf(ss * (1.f / 64.f) + EPS);
      const float* g = p->g_k_d + l * 64 + 32 * (g4 & 1);
#pragma unroll
      for (int i = 0; i < 16; ++i) { lo[i] *= rs * g[i]; hi[i] *= rs * g[16 + i]; }
      if (lat) rope32c(lo, hi, cs32, (g4 & 1) ? gcol : grow);
      if (pt < 4) { st16(q, lo); st16(q + 16, hi); }
    }
    __syncthreads();
    {
      const int pos = perm16(tk);
#pragma unroll
      for (int hd = 0; hd < 12; ++hd) {
        const u16* src = (hd < 2) ? pr + 896 + 64 * hd : (hd < 6) ? pr + 1536 + 64 * (hd - 2) : (hd < 8) ? pr + 2176 + 64 * (hd - 6) : kv + 128 * (hd - 8) + 64;
        const u32x4 raw = *(const u32x4*)(src + 8 * pt);
        const unsigned w[4] = {raw.x, raw.y, raw.z, raw.w};
        const float sc = (hd >= 8) ? rkv : 1.f;
#pragma unroll
        for (int i = 0; i < 4; ++i) {
          float e0 = __uint_as_float(w[i] << 16), e1 = __uint_as_float(w[i] & 0xffff0000u);
          if (hd >= 8) { e0 *= sc; e1 *= sc; }
          const unsigned pk = pk2(e0, e1);
          T[(hd * 64 + 8 * pt + 2 * i) * 72 + pos] = (u16)(pk & 0xffff);
          T[(hd * 64 + 8 * pt + 2 * i + 1) * 72 + pos] = (u16)(pk >> 16);
        }
      }
    }
    __syncthreads();
    {
      const int key0 = rr0;
#pragma unroll 1
      for (int pass = 0; pass < 12; ++pass) {
        const int row = pass * 64 + (tid >> 3), hd = row >> 6, dv = row & 63, c8 = (tid & 7) * 8;
        const u32x4 vv = *(const LAS u32x4*)(T + row * 72 + c8);
        u16* dst = (hd < 2) ? wsp<u16>(p, OFF_VBT) + ((size_t)(b * 2 + hd) * 64 + dv) * TPB
                 : (hd < 6) ? wsp<u16>(p, OFF_VCT) + ((size_t)(b * 4 + hd - 2) * 64 + dv) * TPB
                 : (hd < 8) ? wsp<u16>(p, OFF_VDT) + ((size_t)(b * 2 + hd - 6) * 64 + dv) * TPB
                            : wsp<u16>(p, OFF_VAT) + ((size_t)(b * 4 + hd - 8) * 64 + dv) * TPB;
        *(u32x4*)(dst + key0 + c8) = vv;
      }
    }
  }
}

template <int BR>
DEVI void attn_mask(f32x16 (&s)[2], int kt, int qlat, int qrow, int qcol, int hh, LAS float* rpb) {
  if (BR == 1) {
#pragma unroll
    for (int kb = 0; kb < 2; ++kb)
#pragma unroll
      for (int i = 0; i < 16; ++i) {
        const int kpos = kt * 64 + kb * 32 + (i & 3) + 8 * (i >> 2) + 4 * hh;
        const int d = qlat - kpos;
        if (d > 128 || d < -128) s[kb][i] = -1e30f;
      }
  } else {
    const int rs = min(max(qrow - 4, 0), 56);
    const bool row_ok = (kt >= rs) && (kt < rs + 8);
    const int cst = min(max(qcol - 8, 0), 48);
    const int dr = kt - qrow + 7;
#pragma unroll
    for (int kb = 0; kb < 2; ++kb)
#pragma unroll
      for (int i = 0; i < 16; ++i) {
        const int kc = kb * 32 + (i & 3) + 8 * (i >> 2) + 4 * hh;
        const bool ok = row_ok && (kc >= cst) && (kc < cst + 16);
        const int idx = ok ? (dr * 31 + (kc - qcol + 15)) : 0;
        const float bias = rpb[idx];
        s[kb][i] = ok ? (s[kb][i] + bias) : -1e30f;
      }
  }
}

template <int BR>
DEVI void attn_item2(KP p, int l, int b, int hs, int qb, bool isctx, ldsp_t lds) {
  constexpr bool MLA = (BR == 0);
  constexpr bool GQA = (BR == 1 || BR == 3);
  constexpr int QBLK = GQA ? 128 : 256;
  constexpr int NKS = MLA ? 6 : 4;
  constexpr int STG = 9216 + 9216 + 5120;
  const int tid = TIDX, lane = tid & 63, wave = __builtin_amdgcn_readfirstlane(tid >> 6);
  const int r32 = lane & 31, hh = lane >> 5;
  const int hq = GQA ? (hs * 2 + (wave & 1)) : hs;
  const int woff = GQA ? 32 * (wave >> 1) : 32 * wave;
  const int q0 = (isctx ? 0 : NCTX) + qb * QBLK;
  const size_t tokq = (size_t)b * TPB + q0 + woff + r32;
  const u16* Qp; const u16* Kp; int ldk; const u16* Vt; int obase;
  const u16* PR = wsp<u16>(p, OFF_PRAW);
  if (BR == 0) { Qp = wsp<u16>(p, OFF_QARAW) + tokq * 512 + hq * 96; Kp = wsp<u16>(p, OFF_KVARAW) + (size_t)b * TPB * 512 + hs * 128; ldk = 512; Vt = wsp<u16>(p, OFF_VAT) + (size_t)(b * 4 + hs) * 64 * TPB; obase = hq * 64; }
  else if (BR == 1) { Qp = PR + tokq * PLD + 512 + hq * 64; Kp = PR + (size_t)b * TPB * PLD + 768 + hs * 64; ldk = PLD; Vt = wsp<u16>(p, OFF_VBT) + (size_t)(b * 2 + hs) * 64 * TPB; obase = 256 + hq * 64; }
  else if (BR == 2) { Qp = PR + tokq * PLD + 1024 + hq * 64; Kp = PR + (size_t)b * TPB * PLD + 1280 + hs * 64; ldk = PLD; Vt = wsp<u16>(p, OFF_VCT) + (size_t)(b * 4 + hs) * 64 * TPB; obase = 512 + hq * 64; }
  else { Qp = PR + tokq * PLD + 1792 + hq * 64; Kp = PR + (size_t)b * TPB * PLD + 2048 + hs * 64; ldk = PLD; Vt = wsp<u16>(p, OFF_VDT) + (size_t)(b * 2 + hs) * 64 * TPB; obase = 768 + hq * 64; }
  const u16* KRp = PR + (size_t)b * TPB * PLD + 384;
  int lat_lo = 0, lat_n = 0;
  if (!isctx) {
    if (BR == 0 || BR == 3) { lat_lo = 0; lat_n = 64; }
    else if (BR == 1) { const int ql = qb * 128; const int lo = max(0, ql - 128) >> 6, hi = min(SEQ - 1, ql + 127 + 128) >> 6; lat_lo = lo; lat_n = hi - lo + 1; }
    else { const int lo = min(max(4 * qb - 4, 0), 56), hi = min(max(4 * qb + 3 - 4, 0), 56) + 7; lat_lo = lo; lat_n = hi - lo + 1; }
  }
  const int NT = 4 + lat_n;
  const int qlat = qb * QBLK + woff + r32;
  const int qrow = qlat >> 6, qcol = qlat & 63;
  bf16x8 qf[NKS];
#pragma unroll
  for (int ks = 0; ks < NKS; ++ks) qf[ks] = *(const bf16x8*)(Qp + ks * 16 + hh * 8);
  const int srow = tid >> 3, sc8 = (tid & 7) * 8;
  const int krow_ = (tid & 255) >> 2, kc8 = (tid & 3) * 8;
  const bool krt = tid < 256;
  u32x4 rk0, rv0, rr0, rk1, rv1, rr1;
  auto keytile = [&](int j) { return (j < 4) ? j : (4 + lat_lo + (j - 4)); };
#define A_GLOAD(j, rk, rv, rr) do { const int key0_ = keytile(j) * 64; \
    rk = *(const u32x4*)(Kp + (size_t)(key0_ + srow) * ldk + sc8); \
    rv = *(const u32x4*)(Vt + (size_t)srow * TPB + key0_ + sc8); \
    if (MLA && krt) rr = *(const u32x4*)(KRp + (size_t)(key0_ + krow_) * PLD + kc8); } while (0)
#define A_LWRITE(st, rk, rv, rr) do { ldsp_t base_ = lds + (st) * STG; \
    *(LAS u32x4*)(base_ + srow * 144 + sc8 * 2) = rk; \
    *(LAS u32x4*)(base_ + 9216 + srow * 144 + sc8 * 2) = rv; \
    if (MLA && krt) *(LAS u32x4*)(base_ + 18432 + krow_ * 80 + kc8 * 2) = rr; } while (0)
  LAS float* rpb = (LAS float*)(lds + 2 * STG);
  A_GLOAD(0, rk0, rv0, rr0);
  if (NT > 1) A_GLOAD(1, rk1, rv1, rr1);
  __syncthreads();
  if (BR == 2 && !isctx) {
    const float* src = p->rpb_c + (size_t)(l * 4 + hs) * 465;
    for (int i = tid; i < 465; i += 512) rpb[i] = src[i] * LOG2E;
  }
  A_LWRITE(0, rk0, rv0, rr0);
  __syncthreads();
  f32x16 o[2];
#pragma unroll
  for (int i = 0; i < 16; ++i) { o[0][i] = 0.f; o[1][i] = 0.f; }
  float m_run = -INFINITY, l_run = 0.f;
  if (BR == 1) { m_run = p->sink_b[l * 4 + hq] * LOG2E; l_run = (hh == 0) ? 1.f : 0.f; }
  const ldsp_t kfb = lds + r32 * 144 + hh * 16;
  const ldsp_t vfb = lds + 9216 + r32 * 144 + hh * 16;
  const ldsp_t krb = lds + 18432 + r32 * 80 + hh * 16;
#define A_STEP(j, rkA, rvA, rrA, rkB, rvB, rrB) do { \
    const int st = ((j) & 1) * STG; \
    if ((j) + 2 < NT) A_GLOAD((j) + 2, rkA, rvA, rrA); \
    f32x16 s[2]; \
    _Pragma("unroll") for (int kb = 0; kb < 2; ++kb) { \
      _Pragma("unroll") for (int i = 0; i < 16; ++i) s[kb][i] = 0.f; \
      _Pragma("unroll") for (int ks = 0; ks < 4; ++ks) { const bf16x8 kf = *(const LAS bf16x8*)(kfb + st + kb * 32 * 144 + ks * 32); s[kb] = MFMA(kf, qf[ks], s[kb]); } \
      if (MLA) { _Pragma("unroll") for (int ks = 0; ks < 2; ++ks) { const bf16x8 kf = *(const LAS bf16x8*)(krb + st + kb * 32 * 80 + ks * 32); s[kb] = MFMA(kf, qf[NKS - 2 + ks], s[kb]); } } \
    } \
    if ((BR == 1 || BR == 2) && (j) >= 4) attn_mask<BR>(s, lat_lo + (j) - 4, qlat, qrow, qcol, hh, rpb); \
    float mx = s[0][0]; \
    _Pragma("unroll") for (int i = 1; i < 16; ++i) mx = fmaxf(mx, s[0][i]); \
    _Pragma("unroll") for (int i = 0; i < 16; ++i) mx = fmaxf(mx, s[1][i]); \
    mx = fmaxf(mx, __shfl_xor(mx, 32)); \
    const float m_new = fmaxf(m_run, mx); \
    const float alpha = __builtin_amdgcn_exp2f(m_run - m_new); \
    m_run = m_new; \
    float ls = 0.f; \
    _Pragma("unroll") for (int kb = 0; kb < 2; ++kb) \
      _Pragma("unroll") for (int i = 0; i < 16; ++i) { const float e = __builtin_amdgcn_exp2f(s[kb][i] - m_new); s[kb][i] = e; ls += e; } \
    l_run = l_run * alpha + ls; \
    if (__any(alpha != 1.f)) { _Pragma("unroll") for (int i = 0; i < 16; ++i) { o[0][i] *= alpha; o[1][i] *= alpha; } } \
    _Pragma("unroll") for (int s4 = 0; s4 < 4; ++s4) { \
      const int kb = s4 >> 1, rb = (s4 & 1) * 8; \
      u32x4 pw; \
      pw.x = pk2(s[kb][rb + 0], s[kb][rb + 1]); pw.y = pk2(s[kb][rb + 2], s[kb][rb + 3]); \
      pw.z = pk2(s[kb][rb + 4], s[kb][rb + 5]); pw.w = pk2(s[kb][rb + 6], s[kb][rb + 7]); \
      const bf16x8 pf = __builtin_bit_cast(bf16x8, pw); \
      _Pragma("unroll") for (int db = 0; db < 2; ++db) { const bf16x8 vf = *(const LAS bf16x8*)(vfb + st + db * 32 * 144 + s4 * 32); o[db] = MFMA(vf, pf, o[db]); } \
    } \
    if ((j) + 1 < NT) A_LWRITE(((j) + 1) & 1, rkB, rvB, rrB); \
    __syncthreads(); \
  } while (0)
  for (int j = 0; j < NT; j += 2) {
    A_STEP(j, rk0, rv0, rr0, rk1, rv1, rr1);
    if (j + 1 < NT) A_STEP(j + 1, rk1, rv1, rr1, rk0, rv0, rr0);
  }
#undef A_STEP
#undef A_GLOAD
#undef A_LWRITE
  const float lt = l_run + __shfl_xor(l_run, 32);
  const float inv = 1.f / lt;
  u16* Op = wsp<u16>(p, OFF_O) + tokq * 1024 + obase;
#pragma unroll
  for (int db = 0; db < 2; ++db)
#pragma unroll
    for (int g = 0; g < 4; ++g) {
      u32x2 w;
      w.x = pk2(o[db][4 * g] * inv, o[db][4 * g + 1] * inv);
      w.y = pk2(o[db][4 * g + 2] * inv, o[db][4 * g + 3] * inv);
      *(u32x2*)(Op + db * 32 + 8 * g + 4 * hh) = w;
    }
}
DEVI void phaseD2(KP p, int l, ldsp_t lds) {
  const int G8 = gridDim.x >> 3, xcd = BIDX & 7, lb = BIDX >> 3;
  if (lb >= G8) return;
  const int NLOC = 256 + (l == 0 ? 16 : 0);
  for (int n = lb; n < NLOC; n += G8) {
    int br, s, qb; bool isctx = false;
    if (n < 64) { br = 0; s = xcd + 8 * (n >> 4); qb = n & 15; }
    else if (n < 128) { const int m = n - 64; br = 3; s = xcd + 8 * (m >> 5); qb = m & 31; }
    else if (n < 192) { const int m = n - 128; br = 2; s = xcd + 8 * (m >> 4); qb = m & 15; }
    else if (n < 256) { const int m = n - 192; br = 1; s = xcd + 8 * (m >> 5); qb = m & 31; }
    else {
      const int m = n - 256; isctx = true;
      if (m < 4) { br = 0; s = xcd + 8 * m; qb = 0; }
      else if (m < 8) { const int mm = m - 4; br = 3; s = xcd + 8 * (mm >> 1); qb = mm & 1; }
      else if (m < 12) { br = 2; s = xcd + 8 * (m - 8); qb = 0; }
      else { const int mm = m - 12; br = 1; s = xcd + 8 * (mm >> 1); qb = mm & 1; }
    }
    if (br == 0) attn_item2<0>(p, l, s >> 2, s & 3, qb, isctx, lds);
    else if (br == 1) attn_item2<1>(p, l, s >> 1, s & 1, qb, isctx, lds);
    else if (br == 2) attn_item2<2>(p, l, s >> 2, s & 3, qb, isctx, lds);
    else attn_item2<3>(p, l, s >> 1, s & 1, qb, isctx, lds);
  }
}


DEVI int pm_map(int pme, bool skipctx) { return skipctx ? (pme >> 4) * 17 + 1 + (pme & 15) : pme; }
struct SchedE1 { const char* O; const char* W; int pr; bool skipctx; int G, c;
  DEVI bool next(int i, Unit& u) const { int pm, pn; if (!tile_order(i, G, c, skipctx ? 128 : 136, 8, pm, pn)) return false;
    pm = pm_map(pm, skipctx); const int n = 2 * pr + (pn >> 2), cq = pn & 3;
    u.A = O + (size_t)pm * 256 * 2048 + n * 512; u.B = W + ((size_t)n * 1024 + cq * 256) * 512; u.rows = nullptr; u.nvalid = 0;
    u.u0 = pm * 256; u.u1 = pn * 256; u.u2 = 0; u.u3 = 0; return true; } };
DEVI void phaseE1(KP p, int l, int pr, ldsp_t lds) {
  if (pr == 0 && BIDX == 0 && TIDX < 32) wsp<int>(p, OFF_CNT)[TIDX] = 0;
  SchedE1 S{(const char*)wsp<u16>(p, OFF_O), (const char*)wsp<u16>(p, OFF_WBR), pr, l == 1, (int)gridDim.x, BIDX};
  EpiRawBf16 E{wsp<u16>(p, OFF_Z), 2048};
  gemm_phase<true, false>(lds, 2048, 512, 4, S, E);
}
struct SchedE2 { const char* H; const char* W; int pr; bool skipctx; int G, c;
  DEVI bool next(int i, Unit& u) const { int pm, pn; if (!tile_order(i, G, c, skipctx ? 128 : 136, 8, pm, pn)) return false;
    pm = pm_map(pm, skipctx);
    u.A = H + (size_t)pm * 256 * 2048; u.B = W + (size_t)(pr * 8 + pn) * 256 * 2048; u.rows = nullptr; u.nvalid = 0;
    u.u0 = pm * 256; u.u1 = pn * 128; u.u2 = 0; u.u3 = 0; return true; } };
struct EpiE2 { const u16* Z; const u16* Yin; u16* Yout; const float* bias0; const float* bias1;
  DEVI void operator()(const f32x4 (&acc)[2][2][4][2], const Unit& u, int wr, int wc, int fr, int fq) const {
    const int row0 = u.u0 + wr * 64 + fr, col0 = u.u1 + wc * 32 + 8 * fq;
    f32x4 bv[2][2];
#pragma unroll
    for (int nn = 0; nn < 2; ++nn) { bv[0][nn] = *(const f32x4*)(bias0 + col0 + 4 * nn); bv[1][nn] = *(const f32x4*)(bias1 + col0 + 4 * nn); }
#pragma unroll
    for (int ai = 0; ai < 2; ++ai)
#pragma unroll
      for (int m = 0; m < 4; ++m) {
        const size_t r = (size_t)(row0 + ai * HALF + m * 16);
        float t[8];
#pragma unroll
        for (int j = 0; j < 8; ++j) t[j] = 0.f;
        if (Yin) {
          const u32x4 y = *(const u32x4*)(Yin + r * 1024 + col0);
          const unsigned w[4] = {y.x, y.y, y.z, y.w};
#pragma unroll
          for (int i = 0; i < 4; ++i) { t[2 * i] = __uint_as_float(w[i] << 16); t[2 * i + 1] = __uint_as_float(w[i] & 0xffff0000u); }
        }
#pragma unroll
        for (int bj = 0; bj < 2; ++bj) {
          const u32x4 z = *(const u32x4*)(Z + r * 2048 + bj * 1024 + col0);
          const unsigned w[4] = {z.x, z.y, z.z, z.w};
#pragma unroll
          for (int nn = 0; nn < 2; ++nn)
#pragma unroll
            for (int j = 0; j < 4; ++j) {
              const int e = 4 * nn + j;
              const float zz = (e & 1) ? __uint_as_float(w[e >> 1] & 0xffff0000u) : __uint_as_float(w[e >> 1] << 16);
              const float g = 1.f / (1.f + __expf(-(acc[ai][bj][m][nn][j] + bv[bj][nn][j])));
              t[e] += g * zz;
            }
        }
        u32x4 o; o.x = pk2(t[0], t[1]); o.y = pk2(t[2], t[3]); o.z = pk2(t[4], t[5]); o.w = pk2(t[6], t[7]);
        *(u32x4*)(Yout + r * 1024 + col0) = o;
      }
  }
};
DEVI void phaseE2(KP p, int l, int pr, ldsp_t lds) {
  SchedE2 S{(const char*)wsp<u16>(p, OFF_H), (const char*)wsp<u16>(p, OFF_WGATE), pr, l == 1, (int)gridDim.x, BIDX};
  EpiE2 E{wsp<u16>(p, OFF_Z), pr ? wsp<u16>(p, OFF_YPART) : nullptr, pr ? wsp<u16>(p, OFF_YPRE) : wsp<u16>(p, OFF_YPART),
          p->b_gate + (size_t)(l * 4 + 2 * pr) * 1024, p->b_gate + (size_t)(l * 4 + 2 * pr + 1) * 1024};
  gemm_phase<true, false>(lds, 2048, 2048, 16, S, E);
}
struct SchedF { const char* Y; const char* W; bool skipctx; int G, c;
  DEVI bool next(int i, Unit& u) const { int pm, pn; if (!tile_order(i, G, c, skipctx ? 128 : 136, 4, pm, pn)) return false;
    pm = pm_map(pm, skipctx);
    u.A = Y + (size_t)pm * 256 * 2048; u.B = W + (size_t)pn * 256 * 2048; u.rows = nullptr; u.nvalid = 0;
    u.u0 = pm; u.u1 = pn * 256; u.u2 = 0; u.u3 = 0; return true; } };
struct EpiF { KP p; int l;
  DEVI void operator()(const f32x4 (&acc)[2][2][4][2], const Unit& u, int wr, int wc, int fr, int fq) const {
    const int pm = u.u0, b = pm / 17, rr0 = (pm % 17) * 256;
    const int mrow = (rr0 < NCTX) ? 8 : b;
    const int col0 = u.u1 + wc * 32 + 4 * fq;
    const float* gt = wsp<float>(p, OFF_MOD) + ((size_t)l * 9 + mrow) * 6144 + 2048 + col0;
    const float* xin = xrow_in(p, l, b, rr0) + col0;
    float* xout = xrow_res(p, b, rr0) + col0;
    f32x4 gv[2][2];
#pragma unroll
    for (int bj = 0; bj < 2; ++bj)
#pragma unroll
      for (int n = 0; n < 2; ++n) gv[bj][n] = *(const f32x4*)(gt + bj * HALF + n * 16);
#pragma unroll
    for (int ai = 0; ai < 2; ++ai)
#pragma unroll
      for (int m = 0; m < 4; ++m) {
        const size_t ro = (size_t)(wr * 64 + fr + ai * HALF + m * 16) * 1024;
#pragma unroll
        for (int bj = 0; bj < 2; ++bj)
#pragma unroll
          for (int n = 0; n < 2; ++n) {
            const f32x4 xo = *(const f32x4*)(xin + ro + bj * HALF + n * 16);
            *(f32x4*)(xout + ro + bj * HALF + n * 16) = xo + gv[bj][n] * acc[ai][bj][m][n];
          }
      }
  }
};
DEVI void phaseF2(KP p, int l, ldsp_t lds) {
  SchedF S{(const char*)wsp<u16>(p, OFF_YPRE), (const char*)wsp<u16>(p, OFF_WOUT), l == 1, (int)gridDim.x, BIDX};
  EpiF E{p, l};
  gemm_phase<false, false>(lds, 2048, 2048, 16, S, E);
}


DEVI void conv_tile2(const ConvT& c, LAS float* t, int htid) {
  const int kk = htid >> 3, n4 = (htid & 7) * 4;
  __syncthreads();
#pragma unroll
  for (int i = 0; i < 2; ++i) {
    const int k = kk + 32 * i;
    f32x4 v = f32x4{0.f, 0.f, 0.f, 0.f};
    const float* sp = (c.src2 && n4 >= 16) ? c.src2 + (n4 - 16) : (c.src ? c.src + n4 : nullptr);
    if (sp) v = *(const f32x4*)(sp + (size_t)k * c.ld);
    const float s = (c.ks ? c.ks[k] : 1.f) * c.mul;
    t[(n4 + 0) * 65 + k] = v.x * s; t[(n4 + 1) * 65 + k] = v.y * s;
    t[(n4 + 2) * 65 + k] = v.z * s; t[(n4 + 3) * 65 + k] = v.w * s;
  }
  __syncthreads();
  const int n = htid >> 3, k8 = (htid & 7) * 8;
  const LAS float* r = t + n * 65 + k8;
  u32x4 o;
  o.x = pk2(r[0], r[1]); o.y = pk2(r[2], r[3]); o.z = pk2(r[4], r[5]); o.w = pk2(r[6], r[7]);
  *(u32x4*)(c.dst + (size_t)n * c.ldd + k8) = o;
}
DEVI void conv_items2(KP p, int l, ldsp_t lds, int first_item, int total_items) {
  const int tid = TIDX, half = tid >> 8, htid = tid & 255;
  LAS float* t = (LAS float*)(lds + half * 16384);
  for (int it = BIDX * 2; it < total_items; it += gridDim.x * 2) {
    const int item = it + half;
    ConvT c = conv_decode(p, l, (item < total_items ? item : total_items - 1) - first_item);
    conv_tile2(c, t, htid);
  }
}
DEVI void phase0_2(KP p, ldsp_t lds) {
  const int tid = TIDX, half = tid >> 8, htid = tid & 255;
  for (int it = BIDX * 2; it < 458; it += gridDim.x * 2) {
    const int item = it + half;
    LAS float* sc = (LAS float*)(lds + half * 16384);
    const bool ismod = item < 384;
    const int l = item / 192, rem = item % 192, cgp = rem >> 3, kc = rem & 7;
    __syncthreads();
    if (ismod) {
      for (int i = htid; i < 9 * 128; i += 256) {
        int b = i >> 7, k = i & 127;
        float v = (b < 8) ? p->c[b * 1024 + kc * 128 + k] : p->c_ctx[kc * 128 + k];
        sc[i] = v / (1.f + expf(-v));
      }
    }
    __syncthreads();
    if (ismod) {
      float acc[9];
#pragma unroll
      for (int b = 0; b < 9; ++b) acc[b] = 0.f;
      const float* w = p->w_mod + ((size_t)l * 1024 + kc * 128) * 6144 + cgp * 256 + htid;
#pragma unroll 8
      for (int k = 0; k < 128; ++k) {
        float wv = w[(size_t)k * 6144];
#pragma unroll
        for (int b = 0; b < 9; ++b) acc[b] += sc[b * 128 + k] * wv;
      }
      float* dst = wsp<float>(p, OFF_MODP) + (size_t)((kc * 2 + l) * 9) * 6144 + cgp * 256 + htid;
#pragma unroll
      for (int b = 0; b < 9; ++b) dst[(size_t)b * 6144] = acc[b];
    } else if (item == 384) {
      float* cs32 = wsp<float>(p, OFF_CS32);
      float* cs16 = wsp<float>(p, OFF_CS16);
      for (int t = htid; t < 1024; t += 256) {
        int pos = t >> 4, i = t & 15;
        float ang = (float)pos * powf(10000.f, -(float)(2 * i) / 32.f);
        cs32[t * 2] = cosf(ang); cs32[t * 2 + 1] = sinf(ang);
      }
      for (int t = htid; t < 512; t += 256) {
        int pos = t >> 3, i = t & 7;
        float ang = (float)pos * powf(10000.f, -(float)(2 * i) / 16.f);
        cs16[t * 2] = cosf(ang); cs16[t * 2 + 1] = sinf(ang);
      }
    } else if (item < 457) {
      const int q = item - 385, ll = q / 36, o = q % 36;
      float* dst = wsp<float>(p, OFF_WRT) + ((size_t)ll * 36 + o) * 1024;
      for (int k = htid; k < 1024; k += 256)
        dst[k] = (o < 4) ? p->w_group[((size_t)ll * 1024 + k) * 4 + o] : p->w_router[((size_t)ll * 1024 + k) * 32 + (o - 4)];
    }
  }
  conv_items2(p, 0, lds, 0, CONV_ITEMS);
}
DEVI void phase1_2(KP p) {
  const float* mp = wsp<float>(p, OFF_MODP);
  float* mo = wsp<float>(p, OFF_MOD);
  for (int i = BIDX * 512 + TIDX; i < 2 * 9 * 6144; i += gridDim.x * 512) {
    int l = i / (9 * 6144), o = i % 6144;
    float s = p->b_mod[l * 6144 + o];
#pragma unroll
    for (int kc = 0; kc < 8; ++kc) s += mp[(size_t)kc * 2 * 9 * 6144 + i];
    mo[i] = s;
  }
}
DEVI void phaseA2(KP p) {
  const int gw = BIDX * NW + (TIDX >> 6), nw = gridDim.x * NW;
  u16* H = wsp<u16>(p, OFF_H);
  for (int tok = gw; tok < NTOK; tok += nw) {
    const int b = tok / TPB, rr = tok % TPB;
    float xv[16], hv[16];
    load_row16(xrow_in(p, 0, b, rr), xv);
    modulate_row_store(p, 0, 0, xv, rr < NCTX ? 8 : b, H + (size_t)tok * 1024, hv);
  }
}
DEVI void phaseG2(KP p, int l) {
  const int lane = TIDX & 63;
  const int gw = BIDX * NW + (TIDX >> 6), nw = gridDim.x * NW;
  u16* H = wsp<u16>(p, OFF_H);
  const float* WRT = wsp<float>(p, OFF_WRT) + (size_t)l * 36 * 1024;
  int* cnt = wsp<int>(p, OFF_CNT);
  int* list = wsp<int>(p, OFF_LIST);
  float* wlist = wsp<float>(p, OFF_WLIST);
  const int qd = lane >> 4;
  for (int task = gw; task < NTOK / 4; task += nw) {
    const int tok0 = task * 4;
    const int b = tok0 / TPB, rr0 = tok0 % TPB;
    if (l == 1 && rr0 < NCTX) continue;
    float hv[4][16];
#pragma unroll
    for (int r = 0; r < 4; ++r) {
      float xv[16];
      load_row16(xrow_res(p, b, rr0 + r), xv);
      modulate_row_store(p, l, 1, xv, (rr0 < NCTX) ? 8 : b, H + (size_t)(tok0 + r) * 1024, hv[r]);
    }
    float gl[4], e8[8];
    int gs = 0;
#pragma unroll
    for (int o = 0; o < 4; ++o) gl[o] = router_dot(hv, WRT + (size_t)o * 1024) + p->b_group[l * 4 + o];
    {
      float best = gl[0];
#pragma unroll
      for (int j = 1; j < 4; ++j) if (gl[j] > best) { best = gl[j]; gs = j; }
    }
    const unsigned gmask = (1u << __shfl(gs, 0)) | (1u << __shfl(gs, 16)) | (1u << __shfl(gs, 32)) | (1u << __shfl(gs, 48));
#pragma unroll
    for (int j = 0; j < 8; ++j) e8[j] = -INFINITY;
#pragma unroll 1
    for (int e = 0; e < 32; ++e) {
      if (!((gmask >> (e >> 3)) & 1u)) continue;
      const float kv = router_dot(hv, WRT + (size_t)(4 + e) * 1024) + p->b_router[l * 32 + e];
      const bool sel = (e >> 3) == gs;
#pragma unroll
      for (int j = 0; j < 8; ++j) e8[j] = (sel && (e & 7) == j) ? kv : e8[j];
    }
    float gmax = fmaxf(fmaxf(gl[0], gl[1]), fmaxf(gl[2], gl[3]));
    float gsum = 0.f;
#pragma unroll
    for (int j = 0; j < 4; ++j) gsum += expf(gl[j] - gmax);
    const float gw_ = 1.f / gsum;
    int i0 = 0; float v0 = e8[0];
#pragma unroll
    for (int j = 1; j < 8; ++j) if (e8[j] > v0) { v0 = e8[j]; i0 = j; }
    int i1 = -1; float v1 = -INFINITY;
#pragma unroll
    for (int j = 0; j < 8; ++j) if (j != i0 && e8[j] > v1) { v1 = e8[j]; i1 = j; }
    const float ex = expf(v1 - v0);
    const float w0 = gw_ / (1.f + ex), w1 = gw_ * ex / (1.f + ex);
    if ((lane & 15) == 0) {
      const int tok = tok0 + qd;
      const int ea = gs * 8 + i0, eb = gs * 8 + i1;
      int sa = atomicAdd(&cnt[ea], 1);
      list[(size_t)ea * NTOK + sa] = tok * 2; wlist[(size_t)ea * NTOK + sa] = w0;
      int sb = atomicAdd(&cnt[eb], 1);
      list[(size_t)eb * NTOK + sb] = tok * 2 + 1; wlist[(size_t)eb * NTOK + sb] = w1;
    }
  }
}
struct ExpInfo2 { int tiles[4], base[4], cnt[4]; };
DEVI ExpInfo2 exp_info2(KP p, int xcd) {
  const int* cnt = wsp<int>(p, OFF_CNT);
  ExpInfo2 ei;
  int before = 0;
#pragma unroll
  for (int e = 0; e < 32; ++e) {
    const int c = __builtin_amdgcn_readfirstlane(cnt[e]), t = (c + 255) >> 8;
    if ((e & 7) == xcd) { ei.tiles[e >> 3] = t; ei.base[e >> 3] = before; ei.cnt[e >> 3] = c; }
    before += t;
  }
  return ei;
}
template <int NN>
struct SchedX { ExpInfo2 ei; int xcd, lb, G8; const char* A; const char* W; const int* list; size_t wstride; int lda_b;
  DEVI bool next(int i, Unit& u) const {
    const int tot = (ei.tiles[0] + ei.tiles[1] + ei.tiles[2] + ei.tiles[3]) * NN;
    const int n = i * G8 + lb; if (n >= tot) return false;
    int k = 0, m = n / NN; const int pn = n % NN;
    int tb = ei.base[0], ce = ei.cnt[0];
#pragma unroll
    for (int kk = 0; kk < 3; ++kk) { if (k == kk && m >= ei.tiles[kk]) { m -= ei.tiles[kk]; k = kk + 1; tb = ei.base[kk + 1]; ce = ei.cnt[kk + 1]; } }
    const int e = xcd + 8 * k;
    u.rows = list + (size_t)e * NTOK + m * 256; u.nvalid = ce - m * 256;
    u.A = A + (NN == 2 ? (size_t)0 : (size_t)(tb + m) * 256 * lda_b);
    u.B = W + (size_t)e * wstride + (size_t)pn * 256 * (NN == 2 ? 2048 : 512);
    u.u0 = (tb + m) * 256; u.u1 = pn; u.u2 = e; u.u3 = m; return true; } };
struct EpiI1 { u16* U;
  DEVI void operator()(const f32x4 (&acc)[2][2][4][2], const Unit& u, int wr, int wc, int fr, int fq) const {
#pragma unroll
    for (int ai = 0; ai < 2; ++ai)
#pragma unroll
      for (int m = 0; m < 4; ++m) {
        u16* rowp = U + (size_t)(u.u0 + ai * HALF + wr * 64 + m * 16 + fr) * 256;
#pragma unroll
        for (int bj = 0; bj < 2; ++bj) {
          const int ff = 16 * (8 * u.u1 + 4 * bj + wc) + 4 * fq;
          const f32x4 g = acc[ai][bj][m][0], up = acc[ai][bj][m][1];
          float t[4];
#pragma unroll
          for (int j = 0; j < 4; ++j) t[j] = g[j] / (1.f + __expf(-g[j])) * up[j];
          u32x2 o; o.x = pk2(t[0], t[1]); o.y = pk2(t[2], t[3]);
          *(u32x2*)(rowp + ff) = o;
        }
      }
  }
};
DEVI void phaseI1_2(KP p, ldsp_t lds) {
  const int xcd = BIDX & 7, lb = BIDX >> 3, G8 = gridDim.x >> 3;
  if (lb >= G8) return;
  SchedX<2> S{exp_info2(p, xcd), xcd, lb, G8, (const char*)wsp<u16>(p, OFF_H), (const char*)wsp<u16>(p, OFF_W13), wsp<int>(p, OFF_LIST), (size_t)512 * 2048, 2048};
  EpiI1 E{wsp<u16>(p, OFF_U)};
  gemm_phase<false, true>(lds, 2048, 2048, 16, S, E);
}
struct EpiI2 { u16* YS; const float* wlist; const int* list;
  DEVI void operator()(const f32x4 (&acc)[2][2][4][2], const Unit& u, int wr, int wc, int fr, int fq) const {
    const unsigned colb = (unsigned)(u.u1 * 256 + wc * 32 + 8 * fq) * 2u;
    const float* we = wlist + (u.rows - list);
#pragma unroll
    for (int ai = 0; ai < 2; ++ai)
#pragma unroll
      for (int m = 0; m < 4; ++m) {
        const int r = ai * HALF + wr * 64 + m * 16 + fr;
        const unsigned dest = (r < u.nvalid) ? (unsigned)u.rows[r] : (unsigned)(2 * NTOK);
        const float w = we[r];
        char* rowp = (char*)YS + (dest * 2048u + colb);
#pragma unroll
        for (int bj = 0; bj < 2; ++bj) {
          const f32x4 v0 = acc[ai][bj][m][0] * w, v1 = acc[ai][bj][m][1] * w;
          u32x4 o; o.x = pk2(v0[0], v0[1]); o.y = pk2(v0[2], v0[3]); o.z = pk2(v1[0], v1[1]); o.w = pk2(v1[2], v1[3]);
          *(u32x4*)(rowp + bj * 256) = o;
        }
      }
  }
};
DEVI void phaseI2_2(KP p, ldsp_t lds) {
  const int xcd = BIDX & 7, lb = BIDX >> 3, G8 = gridDim.x >> 3;
  if (lb >= G8) return;
  SchedX<4> S{exp_info2(p, xcd), xcd, lb, G8, (const char*)wsp<u16>(p, OFF_U), (const char*)wsp<u16>(p, OFF_W2), wsp<int>(p, OFF_LIST), (size_t)1024 * 512, 512};
  EpiI2 E{wsp<u16>(p, OFF_YS), wsp<float>(p, OFF_WLIST), wsp<int>(p, OFF_LIST)};
  int nt = 4; asm volatile("" : "+s"(nt));
  gemm_phase<true, false>(lds, 512, 512, nt, S, E);
}
DEVI void phaseJ2(KP p, int l, ldsp_t lds) {
  const int lane = TIDX & 63;
  const int gw = BIDX * NW + (TIDX >> 6), nw = gridDim.x * NW;
  const u16* YS = wsp<u16>(p, OFF_YS);
  u16* H = wsp<u16>(p, OFF_H);
  for (int tok = gw; tok < NTOK; tok += nw) {
    const int b = tok / TPB, rr = tok % TPB;
    if (l == 1 && rr < NCTX) continue;
    const int mrow = (rr < NCTX) ? 8 : b;
    float* xr = xrow_res(p, b, rr);
    const float* gt = wsp<float>(p, OFF_MOD) + ((size_t)l * 9 + mrow) * 6144 + 5120;
    float xv[16];
    load_row16(xr, xv);
#pragma unroll
    for (int i = 0; i < 4; ++i) {
      const int c = i * 256 + lane * 4;
      const u32x2 y0 = *(const u32x2*)(YS + (size_t)(tok * 2) * 1024 + c);
      const u32x2 y1 = *(const u32x2*)(YS + (size_t)(tok * 2 + 1) * 1024 + c);
      const f32x4 g = *(const f32x4*)(gt + c);
      xv[i * 4 + 0] += g.x * (bf2f((u16)(y0.x & 0xffff)) + bf2f((u16)(y1.x & 0xffff)));
      xv[i * 4 + 1] += g.y * (bf2f((u16)(y0.x >> 16)) + bf2f((u16)(y1.x >> 16)));
      xv[i * 4 + 2] += g.z * (bf2f((u16)(y0.y & 0xffff)) + bf2f((u16)(y1.y & 0xffff)));
      xv[i * 4 + 3] += g.w * (bf2f((u16)(y0.y >> 16)) + bf2f((u16)(y1.y >> 16)));
    }
    if (l == 0) {
#pragma unroll
      for (int i = 0; i < 4; ++i)
        *(f32x4*)(xr + i * 256 + lane * 4) = f32x4{xv[i * 4], xv[i * 4 + 1], xv[i * 4 + 2], xv[i * 4 + 3]};
      float hv[16];
      modulate_row_store(p, 1, 0, xv, mrow, H + (size_t)tok * 1024, hv);
    } else {
      float ss = 0.f;
#pragma unroll
      for (int i = 0; i < 16; ++i) ss += xv[i] * xv[i];
      ss = wave_sum(ss);
      const float rstd = rsqrtf(ss * (1.f / 1024.f) + EPS);
#pragma unroll
      for (int i = 0; i < 4; ++i) {
        const int c = i * 256 + lane * 4;
        const f32x4 g = *(const f32x4*)(p->g_final + c);
        *(f32x4*)(xr + c) = f32x4{xv[i * 4] * rstd * g.x, xv[i * 4 + 1] * rstd * g.y, xv[i * 4 + 2] * rstd * g.z, xv[i * 4 + 3] * rstd * g.w};
      }
    }
  }
  if (l == 0) conv_items2(p, 1, lds, 0, CONV_ITEMS);
}

constexpr int N_PHASES = 3 + 2 * 13;
__global__ void __launch_bounds__(512, 2) fwd_v2(Params parg) {
  extern __shared__ __attribute__((aligned(16))) unsigned char dyn_lds[];
  const ldsp_t lds = (ldsp_t)dyn_lds;
  cg::grid_group grid = cg::this_grid();
  volatile LAS unsigned* xb_st = (volatile LAS unsigned*)(lds + LDS_BARW);
  if (TIDX < 4) xb_st[TIDX] = 0u;
  __syncthreads();
  if (parg.ph_end - parg.ph_begin > 1) xcd_barrier_post((unsigned*)(parg.ws + OFF_BAR));
  for (int ph = parg.ph_begin; ph < parg.ph_end; ++ph) {
    KP p = (KP)__builtin_amdgcn_kernarg_segment_ptr();
    asm volatile("" : "+s"(p));
    const int l = (ph >= 16) ? 1 : 0;
    const int k = (ph < 3) ? ph : 3 + (ph - 3) % 13;
    switch (k) {
      case 0: phase0_2(p, lds); break;
      case 1: phase1_2(p); break;
      case 2: phaseA2(p); break;
      case 3: phaseB2(p, lds); break;
      case 4: phaseC2(p, lds); break;
      case 5: phaseP2(p, l, lds); break;
      case 6: phaseD2(p, l, lds); break;
      case 7: phaseE1(p, l, 0, lds); break;
      case 8: phaseE2(p, l, 0, lds); break;
      case 9: phaseE1(p, l, 1, lds); break;
      case 10: phaseE2(p, l, 1, lds); break;
      case 11: phaseF2(p, l, lds); break;
      case 12: phaseG2(p, l); break;
      case 13: phaseI1_2(p, lds); break;
      case 14: phaseI2_2(p, lds); break;
      default: phaseJ2(p, l, lds); break;
    }
    if (ph + 1 < parg.ph_end) {
      if (ph == parg.ph_begin) grid.sync();
      else xcd_barrier((unsigned*)(p->ws + OFF_BAR), xb_st);
    }
  }
}
}

extern "C" void kernel_launch(void* const* d_in, const int* in_sizes, int n_in, void* d_out, int out_size,
                              void* d_ws, size_t ws_size, hipStream_t stream) {
  static int grid2 = 0;
  if (!grid2) {
    int dev = 0, cus = 0, per_cu = 0;
    (void)hipGetDevice(&dev);
    (void)hipDeviceGetAttribute(&cus, hipDeviceAttributeMultiprocessorCount, dev);
    (void)hipFuncSetAttribute((const void*)v2::fwd_v2, hipFuncAttributeMaxDynamicSharedMemorySize, v2::LDS_TOTAL);
    (void)hipOccupancyMaxActiveBlocksPerMultiprocessor(&per_cu, v2::fwd_v2, 512, v2::LDS_TOTAL);
    if (per_cu < 1) { fprintf(stderr, "kernel does not fit on a CU\n"); per_cu = 1; }
    grid2 = cus & ~7;
  }
  if (ws_size < WS_NEEDED) { fprintf(stderr, "workspace too small: %zu < %zu\n", ws_size, (size_t)WS_NEEDED); return; }
  Params hp{};
  const float** f = (const float**)&hp;
  for (int i = 0; i < 29; ++i) f[i] = (const float*)d_in[i];
  hp.out = (float*)d_out;
  hp.ws = (char*)d_ws;
#if N_LAUNCH_MODE == 1
  for (int ph = 0; ph < v2::N_PHASES; ++ph) {
    hp.ph_begin = ph; hp.ph_end = ph + 1;
    void* args[] = {&hp};
    hipError_t e = hipLaunchCooperativeKernel((void*)v2::fwd_v2, dim3(grid2), dim3(512), args, v2::LDS_TOTAL, stream);
    if (e != hipSuccess) fprintf(stderr, "launch failed: %s\n", hipGetErrorString(e));
  }
#else
  hp.ph_begin = 0; hp.ph_end = v2::N_PHASES;
  (void)hipMemsetAsync((char*)d_ws + OFF_BAR, 0, (size_t)XCD_BAR_WORDS * 4, stream);
  void* args[] = {&hp};
  hipError_t e = hipLaunchCooperativeKernel((void*)v2::fwd_v2, dim3(grid2), dim3(512), args, v2::LDS_TOTAL, stream);
  if (e != hipSuccess) fprintf(stderr, "cooperative launch failed: %s (grid %d)\n", hipGetErrorString(e), grid2);
#endif
}
```

```cpp
#include <hip/hip_runtime.h>
#include <hip/hip_cooperative_groups.h>
#include <stdint.h>
#include <stdio.h>
namespace cg = cooperative_groups;

#ifndef N_LAUNCH_MODE
#define N_LAUNCH_MODE 0
#endif

#ifndef PROBE_DUP
#define PROBE_DUP 0
#endif
#define DEVI __device__ __forceinline__
typedef unsigned short u16;
typedef __attribute__((ext_vector_type(2))) float f32x2;
typedef __attribute__((ext_vector_type(2))) __bf16 bf16x2_t;
typedef __attribute__((ext_vector_type(8))) short bf16x8;
typedef __attribute__((ext_vector_type(16))) float f32x16;
typedef __attribute__((ext_vector_type(4))) unsigned u32x4;
typedef __attribute__((ext_vector_type(2))) unsigned u32x2;
typedef __attribute__((ext_vector_type(4))) float f32x4;
#define MFMA(a, b, c) __builtin_amdgcn_mfma_f32_32x32x16_bf16((a), (b), (c), 0, 0, 0)

constexpr int DMODEL = 1024, NBATCH = 8, SEQ = 4096, NCTX = 256;
constexpr int TPB = SEQ + NCTX;
constexpr int NTOK = NBATCH * TPB;
constexpr int MT_PER_B = TPB / 128;
constexpr int NEXP = 32;
constexpr int INP = 2304;
constexpr float EPS = 1e-6f;
constexpr float LOG2E = 1.4426950408889634f;
constexpr int SMEM_BYTES = 73728;
constexpr int UROWS = 2 * NTOK + NEXP * 256;

constexpr size_t al(size_t x) { return (x + 255) & ~(size_t)255; }
constexpr size_t OFF_WIN = 0;
constexpr size_t OFF_WQB = OFF_WIN + al((size_t)INP * 1024 * 2);
constexpr size_t OFF_WKVB = OFF_WQB + al((size_t)512 * 256 * 2);
constexpr size_t OFF_WGATE = OFF_WKVB + al((size_t)512 * 256 * 2);
constexpr size_t OFF_WBR = OFF_WGATE + al((size_t)4 * 1024 * 1024 * 2);
constexpr size_t OFF_WOUT = OFF_WBR + al((size_t)4 * 1024 * 256 * 2);
constexpr size_t OFF_W13 = OFF_WOUT + al((size_t)1024 * 1024 * 2);
constexpr size_t OFF_W2 = OFF_W13 + al((size_t)32 * 512 * 1024 * 2);
constexpr size_t OFF_MODP = OFF_W2 + al((size_t)32 * 1024 * 256 * 2);
constexpr size_t OFF_MOD = OFF_MODP + al((size_t)8 * 2 * 9 * 6144 * 4);
constexpr size_t OFF_CS32 = OFF_MOD + al((size_t)2 * 9 * 6144 * 4);
constexpr size_t OFF_CS16 = OFF_CS32 + al((size_t)64 * 16 * 2 * 4);
constexpr size_t OFF_WRT = OFF_CS16 + al((size_t)64 * 8 * 2 * 4);
constexpr size_t OFF_CNT = OFF_WRT + al((size_t)2 * 36 * 1024 * 4);
constexpr int CNT_STRIDE = 64;
constexpr size_t OFF_BAR = OFF_CNT + al(32 * CNT_STRIDE * 4);
constexpr int XCD_BAR_WORDS = 3456;
constexpr size_t OFF_CTXRES = OFF_BAR + al((size_t)XCD_BAR_WORDS * 4);
constexpr size_t OFF_H = OFF_CTXRES + al((size_t)8 * 256 * 1024 * 4);
constexpr size_t OFF_O = OFF_H + al((size_t)NTOK * 1024 * 2);
constexpr size_t OFF_LIST = OFF_O + al((size_t)NTOK * 1024 * 2);
constexpr size_t OFF_WLIST = OFF_LIST + al((size_t)32 * NTOK * 4);
constexpr size_t OFF_R1 = OFF_WLIST + al((size_t)32 * NTOK * 4);
constexpr int PLD = INP;
constexpr size_t OFF_PRAW = OFF_R1;
constexpr size_t OFF_QARAW = OFF_PRAW + (size_t)NTOK * INP * 2;
constexpr size_t OFF_KVARAW = OFF_QARAW + (size_t)NTOK * 512 * 2;
constexpr size_t OFF_VAT = OFF_KVARAW + (size_t)NTOK * 512 * 2;
constexpr size_t OFF_VBT = OFF_VAT + (size_t)NTOK * 256 * 2;
constexpr size_t OFF_VCT = OFF_VBT + (size_t)NTOK * 128 * 2;
constexpr size_t OFF_VDT = OFF_VCT + (size_t)NTOK * 256 * 2;
constexpr size_t OFF_END = OFF_VDT + (size_t)NTOK * 128 * 2;
constexpr size_t OFF_Z = OFF_R1;
constexpr size_t OFF_YPART = OFF_R1 + (size_t)NTOK * 2048 * 2;
constexpr size_t OFF_YPRE = OFF_YPART + (size_t)NTOK * 1024 * 2;
constexpr size_t OFF_U = OFF_R1;
constexpr size_t OFF_YS = OFF_R1 + al((size_t)UROWS * 256 * 2);
static_assert(OFF_YPRE + (size_t)NTOK * 1024 * 2 <= OFF_END, "alias overflow");
static_assert(OFF_YS + (size_t)(2 * NTOK + 1) * 1024 * 2 <= OFF_END, "alias overflow");
constexpr size_t WS_NEEDED = OFF_END;
static_assert(WS_NEEDED <= (size_t)536870912, "workspace budget (4 x largest tensor)");

struct Params {
  const float *x, *c, *ctx, *c_ctx, *w_mod, *b_mod, *g_norm_mix, *w_in, *g_q_a, *w_q_b, *g_kv_a, *w_kv_b,
      *sink_b, *rpb_c, *g_q_d, *g_k_d, *w_gate, *b_gate, *w_branch, *w_out, *g_norm_ffn, *w_group, *b_group,
      *w_router, *b_router, *w_ff1, *w_ff3, *w_ff2, *g_final;
  float* out;
  char* ws;
  int ph_begin, ph_end;
};

DEVI int tid_fresh() { int t; asm volatile("v_mov_b32 %0, %1" : "=v"(t) : "v"(__builtin_amdgcn_workitem_id_x())); return t; }
DEVI int bid_fresh() { int t; asm volatile("s_mov_b32 %0, %1" : "=s"(t) : "s"(__builtin_amdgcn_workgroup_id_x())); return t; }
#define TIDX tid_fresh()
#define BIDX bid_fresh()
typedef const __attribute__((address_space(4))) Params* KP;
DEVI unsigned pk2(float a, float b) { f32x2 v = {a, b}; bf16x2_t r = __builtin_convertvector(v, bf16x2_t); return __builtin_bit_cast(unsigned, r); }
DEVI u16 f2bf(float a) { return (u16)(pk2(a, 0.f) & 0xffffu); }
DEVI float bf2f(u16 v) { return __uint_as_float(((unsigned)v) << 16); }
DEVI float wave_sum(float v) {
#pragma unroll
  for (int m = 32; m >= 1; m >>= 1) v += __shfl_xor(v, m);
  return v;
}
template <class T> DEVI T* wsp(KP p, size_t off) { return (T*)(p->ws + off); }
DEVI const float* xrow_in(KP p, int l, int b, int rr) {
  if (l == 0) return (rr < NCTX) ? p->ctx + ((size_t)b * NCTX + rr) * 1024 : p->x + ((size_t)b * SEQ + rr - NCTX) * 1024;
  return (rr < NCTX) ? wsp<float>(p, OFF_CTXRES) + ((size_t)b * NCTX + rr) * 1024 : p->out + ((size_t)b * SEQ + rr - NCTX) * 1024;
}
DEVI float* xrow_res(KP p, int b, int rr) {
  return (rr < NCTX) ? wsp<float>(p, OFF_CTXRES) + ((size_t)b * NCTX + rr) * 1024 : p->out + ((size_t)b * SEQ + rr - NCTX) * 1024;
}
DEVI int perm16(int k) { return (k & ~12) | ((k & 4) << 1) | ((k & 8) >> 1); }

struct ConvT { const float* src; const float* src2; const float* ks; u16* dst; int ld; int ldd; float mul; };
constexpr int CONV_ITEMS = 1152 + 64 + 64 + 2048 + 512 + 512 + 8192 + 4096;
DEVI ConvT conv_decode(KP p, int l, int idx) {
  ConvT c; c.ks = nullptr; c.mul = 1.f; c.src2 = nullptr;
  if (idx < 1152) {
    int nt = idx >> 4, kt = idx & 15, n0 = nt * 32;
    int sc = (n0 < 416) ? n0 : ((n0 < 512) ? -1 : n0 - 96);
    c.ld = 2208; c.ldd = 1024;
    if ((n0 >= 512 && n0 < 768) || (n0 >= 1024 && n0 < 1280)) c.mul = 0.125f * LOG2E;
    c.src = (sc < 0) ? nullptr : p->w_in + (size_t)l * 1024 * 2208 + (size_t)kt * 64 * 2208 + sc;
    c.dst = wsp<u16>(p, OFF_WIN) + (size_t)n0 * 1024 + kt * 64;
    return c;
  }
  idx -= 1152;
  if (idx < 64) {
    int nt = idx >> 2, kt = idx & 3;
    c.ld = 384; c.ldd = 256; c.ks = p->g_q_a + l * 256 + kt * 64;
    c.src = (nt >= 12) ? nullptr : p->w_q_b + (size_t)l * 256 * 384 + (size_t)kt * 64 * 384 + nt * 32;
    c.dst = wsp<u16>(p, OFF_WQB) + (size_t)nt * 32 * 256 + kt * 64;
    return c;
  }
  idx -= 64;
  if (idx < 64) {
    int nt = idx >> 2, kt = idx & 3;
    c.ld = 512; c.ldd = 256; c.ks = (kt < 2) ? p->g_kv_a + l * 128 + kt * 64 : nullptr;
    c.src = (kt >= 2) ? nullptr : p->w_kv_b + (size_t)l * 128 * 512 + (size_t)kt * 64 * 512 + nt * 32;
    c.dst = wsp<u16>(p, OFF_WKVB) + (size_t)nt * 32 * 256 + kt * 64;
    return c;
  }
  idx -= 64;
  if (idx < 2048) {
    int nt = idx >> 4, kt = idx & 15, R0 = nt * 32;
    int pr = R0 >> 11, cb = (R0 & 2047) >> 8, bj = (R0 & 255) >> 7, j0 = R0 & 127;
    c.ld = 1024; c.ldd = 1024;
    c.src = p->w_gate + ((size_t)(l * 4 + 2 * pr + bj) * 1024 + kt * 64) * 1024 + cb * 128 + j0;
    c.dst = wsp<u16>(p, OFF_WGATE) + (size_t)R0 * 1024 + kt * 64;
    return c;
  }
  idx -= 2048;
  if (idx < 512) {
    int br = idx >> 7, nt = (idx >> 2) & 31, kt = idx & 3;
    c.ld = 1024; c.ldd = 256;
    c.src = p->w_branch + ((size_t)(l * 4 + br) * 256 + kt * 64) * 1024 + nt * 32;
    c.dst = wsp<u16>(p, OFF_WBR) + ((size_t)br * 1024 + nt * 32) * 256 + kt * 64;
    return c;
  }
  idx -= 512;
  if (idx < 512) {
    int nt = idx >> 4, kt = idx & 15;
    c.ld = 1024; c.ldd = 1024;
    c.src = p->w_out + ((size_t)l * 1024 + kt * 64) * 1024 + nt * 32;
    c.dst = wsp<u16>(p, OFF_WOUT) + (size_t)nt * 32 * 1024 + kt * 64;
    return c;
  }
  idx -= 512;
  if (idx < 8192) {
    int e = idx >> 8, g32 = (idx >> 4) & 15, kt = idx & 15;
    c.ld = 256; c.ldd = 1024;
    c.src = p->w_ff1 + ((size_t)(l * 32 + e) * 1024 + kt * 64) * 256 + g32 * 16;
    c.src2 = p->w_ff3 + ((size_t)(l * 32 + e) * 1024 + kt * 64) * 256 + g32 * 16;
    c.dst = wsp<u16>(p, OFF_W13) + ((size_t)e * 512 + g32 * 32) * 1024 + kt * 64;
    return c;
  }
  idx -= 8192;
  {
    int e = idx >> 7, nt = (idx >> 2) & 31, kt = idx & 3;
    c.ld = 1024; c.ldd = 256;
    c.src = p->w_ff2 + ((size_t)(l * 32 + e) * 256 + kt * 64) * 1024 + nt * 32;
    c.dst = wsp<u16>(p, OFF_W2) + ((size_t)e * 1024 + nt * 32) * 256 + kt * 64;
    return c;
  }
}
DEVI void modulate_row_store(KP p, int l, int which, const float (&xv)[16], int mrow, u16* hrow, float (&hv)[16]) {
  const int lane = TIDX & 63;
  float ss = 0.f;
#pragma unroll
  for (int i = 0; i < 16; ++i) ss += xv[i] * xv[i];
  ss = wave_sum(ss);
  const float rstd = rsqrtf(ss * (1.f / 1024.f) + EPS);
  const float* g = (which ? p->g_norm_ffn : p->g_norm_mix) + l * 1024;
  const float* mod = wsp<float>(p, OFF_MOD) + ((size_t)l * 9 + mrow) * 6144 + (which ? 3072 : 0);
#pragma unroll
  for (int i = 0; i < 4; ++i) {
    const int c = i * 256 + lane * 4;
    f32x4 gv = *(const f32x4*)(g + c);
    f32x4 sh = *(const f32x4*)(mod + c);
    f32x4 sc = *(const f32x4*)(mod + 1024 + c);
    hv[i * 4 + 0] = xv[i * 4 + 0] * rstd * gv.x * (1.f + sc.x) + sh.x;
    hv[i * 4 + 1] = xv[i * 4 + 1] * rstd * gv.y * (1.f + sc.y) + sh.y;
    hv[i * 4 + 2] = xv[i * 4 + 2] * rstd * gv.z * (1.f + sc.z) + sh.z;
    hv[i * 4 + 3] = xv[i * 4 + 3] * rstd * gv.w * (1.f + sc.w) + sh.w;
    u32x2 o; o.x = pk2(hv[i * 4 + 0], hv[i * 4 + 1]); o.y = pk2(hv[i * 4 + 2], hv[i * 4 + 3]);
    *(u32x2*)(hrow + c) = o;
  }
}
DEVI void load_row16(const float* xr, float (&xv)[16]) {
  const int lane = TIDX & 63;
#pragma unroll
  for (int i = 0; i < 4; ++i) {
    f32x4 v = *(const f32x4*)(xr + i * 256 + lane * 4);
    xv[i * 4 + 0] = v.x; xv[i * 4 + 1] = v.y; xv[i * 4 + 2] = v.z; xv[i * 4 + 3] = v.w;
  }
}
DEVI float router_dot(const float (&hv)[4][16], const float* wrow) {
  const int lane = TIDX & 63;
  const float* w = wrow + lane * 4;
  float pr[4] = {0.f, 0.f, 0.f, 0.f};
#pragma unroll
  for (int i = 0; i < 4; ++i) {
    const f32x4 wv = *(const f32x4*)(w + i * 256);
#pragma unroll
    for (int r = 0; r < 4; ++r)
      pr[r] += hv[r][i * 4] * wv.x + hv[r][i * 4 + 1] * wv.y + hv[r][i * 4 + 2] * wv.z + hv[r][i * 4 + 3] * wv.w;
  }
  const bool up = (lane & 32) != 0;
  float s0 = up ? pr[0] : pr[2], s1 = up ? pr[1] : pr[3];
  float k0 = up ? pr[2] : pr[0], k1 = up ? pr[3] : pr[1];
  k0 += __shfl_xor(s0, 32); k1 += __shfl_xor(s1, 32);
  const bool up2 = (lane & 16) != 0;
  float sv = up2 ? k0 : k1, kv = up2 ? k1 : k0;
  kv += __shfl_xor(sv, 16);
  kv += __shfl_xor(kv, 8); kv += __shfl_xor(kv, 4); kv += __shfl_xor(kv, 2); kv += __shfl_xor(kv, 1);
  return kv;
}
#define XB_TMO      128
#define XB_XCNT(j)  (256  + 64 * (j))
#define XB_XSUB(j)  (1280 + 64 * (j))
#define XB_XGEN(j)  (2304 + 64 * (j))
#define XB_TOP      3328
#define XB_TOPGEN   3392
#define XB_SPIN_CAP (1u << 20)
#define LAS __attribute__((address_space(3)))
DEVI unsigned xb_ld(unsigned* p) { return __hip_atomic_load(p, __ATOMIC_RELAXED, __HIP_MEMORY_SCOPE_AGENT); }
DEVI unsigned xb_add(unsigned* p, unsigned v) { return __hip_atomic_fetch_add(p, v, __ATOMIC_RELAXED, __HIP_MEMORY_SCOPE_AGENT); }
DEVI unsigned xb_xcc_id() { return (unsigned)__builtin_amdgcn_s_getreg((3 << 11) | 20) & 0xFu; }
#define XB_SPIN(cond, bar) do { unsigned _sp = 0; while (cond) { __builtin_amdgcn_s_sleep(1); \
    if ((++_sp & 255u) == 0u) { if (xb_ld(&(bar)[XB_TMO])) break; if (_sp > XB_SPIN_CAP) { atomicAdd(&(bar)[XB_TMO], 1u); break; } } } } while (0)
DEVI void xcd_barrier_post(unsigned* bar) {
  if (TIDX == 0) (void)xb_add(&bar[XB_XCNT(xb_xcc_id())], 1u);
}
DEVI void xcd_barrier_complete(unsigned* bar, unsigned x, unsigned& nloc, unsigned& nx) {
  const unsigned G = gridDim.x * gridDim.y * gridDim.z;
  unsigned sum, cnt, mine, sp = 0u;
  for (;;) {
    sum = 0u; cnt = 0u; mine = 0u;
#pragma unroll
    for (unsigned j = 0; j < 16; ++j) { const unsigned c = xb_ld(&bar[XB_XCNT(j)]); sum += c; cnt += (c > 0u) ? 1u : 0u; mine = (j == x) ? c : mine; }
    if (sum == G) break;
    __builtin_amdgcn_s_sleep(1);
    if ((++sp & 255u) == 0u) { if (xb_ld(&bar[XB_TMO])) break; if (sp > XB_SPIN_CAP) { atomicAdd(&bar[XB_TMO], 1u); break; } }
  }
  nloc = mine > 0u ? mine : 1u; nx = cnt > 0u ? cnt : 1u;
}
DEVI void xcd_barrier(unsigned* bar, volatile LAS unsigned* st) {
  asm volatile("s_waitcnt vmcnt(0)" ::: "memory");
  __syncthreads();
  if (TIDX == 0) {
    const unsigned x = xb_xcc_id();
    __builtin_amdgcn_s_waitcnt(0);
    unsigned nloc = st[0], nx = st[1];
    if (nloc == 0u) { xcd_barrier_complete(bar, x, nloc, nx); st[0] = nloc; st[1] = nx; }
    const unsigned old = xb_add(&bar[XB_XSUB(x)], 1u);
    const unsigned gen = old / nloc;
    if (old + 1u == (gen + 1u) * nloc) {
      __builtin_amdgcn_fence(__ATOMIC_RELEASE, "agent");
      asm volatile("s_waitcnt vmcnt(0)" ::: "memory");
      const unsigned og = xb_add(&bar[XB_TOP], 1u);
      const unsigned tg = og / nx;
      if (og + 1u == (tg + 1u) * nx) xb_add(&bar[XB_TOPGEN], 1u);
      else XB_SPIN(xb_ld(&bar[XB_TOPGEN]) == tg, bar);
      __builtin_amdgcn_fence(__ATOMIC_ACQUIRE, "agent");
      xb_add(&bar[XB_XGEN(x)], 1u);
      asm volatile("s_waitcnt vmcnt(0)" ::: "memory");
    } else {
      XB_SPIN(xb_ld(&bar[XB_XGEN(x)]) == gen, bar);
      __builtin_amdgcn_fence(__ATOMIC_ACQUIRE, "agent");
      asm volatile("s_waitcnt vmcnt(0)" ::: "memory");
    }
  }
  __syncthreads();
}

namespace v2 {
typedef LAS unsigned char* ldsp_t;
constexpr int BM = 256, BK = 64, HALF = 128, HTB = HALF * BK * 2, STAGE_BYTES = 8 * HTB;
constexpr int NW = 8;
constexpr int LDS_XTRA = STAGE_BYTES;
constexpr int LDS_BARW = STAGE_BYTES + 16384;
constexpr int LDS_TOTAL = LDS_BARW + 16;

DEVI int lds_byte(int r, int c) { const int st = (r >> 4) * 2 + (c >> 5), rr = r & 15, cc = c & 31, ob = rr * 64 + cc * 2; return st * 1024 + (ob ^ (((ob >> 9) & 1) << 5)); }
DEVI void stage_rc(int b, int& R, int& C) { const int st = b / 1024, sb = b % 1024, swz = sb ^ (((sb >> 9) & 1) << 5); R = (st >> 1) * 16 + swz / 64; C = (st & 1) * 32 + (swz % 64) / 2; }
DEVI int perm32(int rho) { const int n = rho >> 4, i = rho & 15; return 8 * (i >> 2) + 4 * n + (i & 3); }

struct Unit { const char* A; const char* B; const int* rows; int nvalid; int u0, u1, u2, u3; };

template <bool PERM, bool GATHER, class Epi, class Sched>
DEVI void gemm_phase(ldsp_t lds, int lda_b, int ldb_b, int nt, const Sched& S, const Epi& E) {
  const int tid = TIDX, wid = __builtin_amdgcn_readfirstlane(tid >> 6), lane = tid & 63, wr = wid >> 2, wc = wid & 3, fr = lane & 15, fq = lane >> 4;
  unsigned voffA[2], voffB[2]; int RA[2], CA2[2];
#pragma unroll
  for (int i = 0; i < 2; ++i) {
    int R, C; stage_rc(tid * 16 + i * 8192, R, C);
    const int Rb = PERM ? ((R & ~31) + perm32(R & 31)) : R;
    RA[i] = R; CA2[i] = C * 2;
    voffA[i] = (unsigned)(R * lda_b + C * 2); voffB[i] = (unsigned)(Rb * ldb_b + C * 2);
  }
  const size_t kstep = (size_t)(BK * 2);
  const size_t hstepA = (size_t)HALF * lda_b, hstepB = (size_t)HALF * ldb_b;
  const unsigned ldsw = (unsigned)wid * 1024u;
  const int aoff = lds_byte(wr * 64 + fr, fq * 8), boff = lds_byte(wc * 32 + fr, fq * 8);
#define G_SA(b, h) (((b) * 2 + (h)) * HTB)
#define G_SB(b, h) ((4 + (b) * 2 + (h)) * HTB)
#define G_STAGE(bufoff, gbase, voff) do { _Pragma("unroll") for (int _i = 0; _i < 2; ++_i) \
    __builtin_amdgcn_global_load_lds((const unsigned*)((const char*)(gbase) + (voff)[_i]), (LAS unsigned*)(lds + (bufoff) + ldsw + _i * 8192), 16, 0, 0); } while (0)
#define G_STAGE_A(bufoff, abase, go, h, koff) do { if (GATHER) { _Pragma("unroll") for (int _i = 0; _i < 2; ++_i) \
    __builtin_amdgcn_global_load_lds((const unsigned*)((abase) + (go)[h][_i] + (koff)), (LAS unsigned*)(lds + (bufoff) + ldsw + _i * 8192), 16, 0, 0); } \
    else G_STAGE(bufoff, (abase) + (h) * hstepA + (koff), voffA); } while (0)
#define G_LDA(dst, b, h) do { _Pragma("unroll") for (int m = 0; m < 4; ++m) _Pragma("unroll") for (int k = 0; k < 2; ++k) dst[m][k] = *(const LAS bf16x8*)(lds + G_SA(b, h) + aoff + m * 2048 + k * 1024); } while (0)
#define G_LDB(dst, b, h) do { _Pragma("unroll") for (int n = 0; n < 2; ++n) _Pragma("unroll") for (int k = 0; k < 2; ++k) dst[n][k] = *(const LAS bf16x8*)(lds + G_SB(b, h) + boff + n * 2048 + k * 1024); } while (0)
#define G_MMA(ai, bj, At, Bt) do { __builtin_amdgcn_s_setprio(1); _Pragma("unroll") for (int m = 0; m < 4; ++m) _Pragma("unroll") for (int n = 0; n < 2; ++n) _Pragma("unroll") for (int k = 0; k < 2; ++k) \
    acc[ai][bj][m][n] = __builtin_amdgcn_mfma_f32_16x16x32_bf16(Bt[n][k], At[m][k], acc[ai][bj][m][n], 0, 0, 0); __builtin_amdgcn_s_setprio(0); } while (0)
#define G_WAIT_V(n) asm volatile("s_waitcnt vmcnt(" #n ")" ::: "memory")
#define G_WAIT_L(n) asm volatile("s_waitcnt lgkmcnt(" #n ")" ::: "memory")
#define G_BAR __builtin_amdgcn_s_barrier()
#define G_SCHED __builtin_amdgcn_sched_barrier(0)
  Unit cur, nxt; int ui = 0;
  if (!S.next(0, cur)) return;
  f32x4 acc[2][2][4][2];
#pragma unroll
  for (int a = 0; a < 2; ++a)
#pragma unroll
    for (int b = 0; b < 2; ++b)
#pragma unroll
      for (int m = 0; m < 4; ++m)
#pragma unroll
        for (int n = 0; n < 2; ++n) acc[a][b][m][n] = (f32x4){0.f, 0.f, 0.f, 0.f};
  bf16x8 At[4][2], B0[2][2], B1[2][2];
  unsigned gcur[2][2];
  auto gather_offs = [&](const Unit& u, unsigned (&go)[2][2]) {
#pragma unroll
    for (int h = 0; h < 2; ++h)
#pragma unroll
      for (int i = 0; i < 2; ++i) {
        const int r = h * HALF + RA[i];
        const int t = (r < u.nvalid) ? (u.rows[r] >> 1) : 0;
        go[h][i] = (unsigned)t * (unsigned)lda_b + (unsigned)CA2[i];
      }
  };
  if (GATHER) gather_offs(cur, gcur);
  const char* cA = cur.A; const char* cB = cur.B;
  G_STAGE(G_SB(0, 0), cB, voffB); G_STAGE_A(G_SA(0, 0), cA, gcur, 0, 0); G_STAGE(G_SB(0, 1), cB + hstepB, voffB); G_STAGE_A(G_SA(0, 1), cA, gcur, 1, 0);
  if (wr == 1) G_BAR;
  G_WAIT_V(4); G_BAR;
  G_STAGE(G_SB(1, 0), cB + kstep, voffB); G_STAGE_A(G_SA(1, 0), cA, gcur, 0, kstep); G_STAGE(G_SB(1, 1), cB + hstepB + kstep, voffB);
  G_WAIT_V(6); G_BAR;
  for (;;) {
    const bool has_next = S.next(ui + 1, nxt);
    const char* nA = has_next ? nxt.A : cA; const char* nB = has_next ? nxt.B : cB;
    for (int t = 0; t < nt; t += 2) {
      const bool last = (t == nt - 2);
      const size_t k1 = (size_t)(t + 1) * kstep;
      const char* a2 = last ? nA : cA; const char* b2 = last ? nB : cB + (size_t)(t + 2) * kstep;
      const size_t ka2 = last ? 0 : (size_t)(t + 2) * kstep;
      const char* b3 = b2 + kstep; const size_t ka3 = ka2 + kstep;
      unsigned gN[2][2];
      if (GATHER && last) {
        if (has_next) gather_offs(nxt, gN);
        else {
#pragma unroll
          for (int h = 0; h < 2; ++h)
#pragma unroll
            for (int i = 0; i < 2; ++i) gN[h][i] = gcur[h][i];
        }
      }
#define G_STAGE_A2(bufoff, h, koff) do { if (GATHER) { if (last) G_STAGE_A(bufoff, cA, gN, h, (koff) - ka2); else G_STAGE_A(bufoff, cA, gcur, h, koff); } \
        else G_STAGE_A(bufoff, a2, gcur, h, koff); } while (0)
      G_LDB(B0, 0, 0); G_SCHED; G_LDA(At, 0, 0); G_STAGE_A(G_SA(1, 1), cA, gcur, 1, k1);
      G_WAIT_L(8); G_BAR; G_WAIT_L(0); G_MMA(0, 0, At, B0); G_BAR; G_SCHED;
      G_LDB(B1, 0, 1); G_STAGE(G_SB(0, 0), b2, voffB);
      G_BAR; G_WAIT_L(0); G_MMA(0, 1, At, B1); G_BAR;
      G_LDA(At, 0, 1); G_STAGE_A2(G_SA(0, 0), 0, ka2);
      G_BAR; G_WAIT_L(0); G_MMA(1, 0, At, B0); G_BAR; G_SCHED;
      G_STAGE(G_SB(0, 1), b2 + hstepB, voffB);
      G_WAIT_V(6); G_BAR; G_MMA(1, 1, At, B1); G_BAR;
      G_LDB(B0, 1, 0); G_SCHED; G_LDA(At, 1, 0); G_STAGE_A2(G_SA(0, 1), 1, ka2);
      G_WAIT_L(8); G_BAR; G_WAIT_L(0); G_MMA(0, 0, At, B0); G_BAR; G_SCHED;
      G_LDB(B1, 1, 1); G_STAGE(G_SB(1, 0), b3, voffB);
      G_BAR; G_WAIT_L(0); G_MMA(0, 1, At, B1); G_BAR;
      G_LDA(At, 1, 1); G_STAGE_A2(G_SA(1, 0), 0, ka3);
      G_BAR; G_WAIT_L(0); G_MMA(1, 0, At, B0); G_BAR; G_SCHED;
      G_STAGE(G_SB(1, 1), b3 + hstepB, voffB);
      G_WAIT_V(6); G_BAR; G_MMA(1, 1, At, B1); G_BAR;
      if (GATHER && last) {
#pragma unroll
        for (int h = 0; h < 2; ++h)
#pragma unroll
          for (int i = 0; i < 2; ++i) gcur[h][i] = gN[h][i];
      }
#undef G_STAGE_A2
    }
    G_SCHED;
    E(acc, cur, wr, wc, fr, fq);
    G_SCHED;
    if (!has_next) break;
#pragma unroll
    for (int a = 0; a < 2; ++a)
#pragma unroll
      for (int b = 0; b < 2; ++b)
#pragma unroll
        for (int m = 0; m < 4; ++m)
#pragma unroll
          for (int n = 0; n < 2; ++n) acc[a][b][m][n] = (f32x4){0.f, 0.f, 0.f, 0.f};
    cur = nxt; cA = nA; cB = nB; ++ui;
  }
  G_WAIT_V(0);
  if (wr == 0) G_BAR;
  G_BAR;
#undef G_SA
#undef G_SB
#undef G_STAGE
#undef G_STAGE_A
#undef G_LDA
#undef G_LDB
#undef G_MMA
#undef G_WAIT_V
#undef G_WAIT_L
#undef G_BAR
#undef G_SCHED
}

DEVI bool tile_order(int i, int G, int c, int nM, int nN, int& pm, int& pn) {
  const int nwg = nM * nN;
  const long L = (long)i * G + c; if (L >= nwg) return false;
  int wgid = (int)L; { const int q = nwg / 8, r = nwg % 8, xcd = wgid % 8, off = wgid / 8; wgid = (xcd < r ? xcd * (q + 1) : r * (q + 1) + (xcd - r) * q) + off; }
  const int WGM = 8;
  const int nig = WGM * nN, gid = wgid / nig, fm = gid * WGM, gsz = (nM - fm) < WGM ? (nM - fm) : WGM;
  pm = fm + ((wgid % nig) % gsz); pn = (wgid % nig) / gsz; return true;
}
struct EpiRawBf16 {
  u16* O; int ldc;
  DEVI void operator()(const f32x4 (&acc)[2][2][4][2], const Unit& u, int wr, int wc, int fr, int fq) const {
    const int row0 = u.u0 + wr * 64 + fr, col0 = u.u1 + wc * 32 + 8 * fq;
#pragma unroll
    for (int ai = 0; ai < 2; ++ai)
#pragma unroll
      for (int m = 0; m < 4; ++m) {
        u16* rowp = O + (size_t)(row0 + ai * HALF + m * 16) * ldc + col0;
#pragma unroll
        for (int bj = 0; bj < 2; ++bj) {
          const f32x4 v0 = acc[ai][bj][m][0], v1 = acc[ai][bj][m][1];
          u32x4 w; w.x = pk2(v0[0], v0[1]); w.y = pk2(v0[2], v0[3]); w.z = pk2(v1[0], v1[1]); w.w = pk2(v1[2], v1[3]);
          *(u32x4*)(rowp + bj * HALF) = w;
        }
      }
  }
};

struct SchedB { const char* A; const char* B; int G, c;
  DEVI bool next(int i, Unit& u) const { int pm, pn; if (!tile_order(i, G, c, NTOK / 256, INP / 256, pm, pn)) return false;
    u.A = A + (size_t)pm * 256 * 2048; u.B = B + (size_t)pn * 256 * 2048; u.rows = nullptr; u.nvalid = 0; u.u0 = pm * 256; u.u1 = pn * 256; u.u2 = 0; u.u3 = 0; return true; } };
DEVI void phaseB2(KP p, ldsp_t lds) {
  SchedB S{(const char*)wsp<u16>(p, OFF_H), (const char*)wsp<u16>(p, OFF_WIN), (int)gridDim.x, BIDX};
  EpiRawBf16 E{wsp<u16>(p, OFF_PRAW), PLD};
  gemm_phase<true, false>(lds, 2048, 2048, 16, S, E);
}
struct SchedC { const char* P; const char* Wq; const char* Wkv; u16* Oq; u16* Okv; int G, c;
  DEVI bool next(int i, Unit& u) const { int pm, pn; if (!tile_order(i, G, c, NTOK / 256, 4, pm, pn)) return false;
    const bool kv = pn >= 2; const int pj = pn & 1;
    u.A = P + (size_t)pm * 256 * (PLD * 2) + (kv ? 512 : 0); u.B = (kv ? Wkv : Wq) + (size_t)pj * 256 * 512; u.rows = nullptr; u.nvalid = 0;
    u.u0 = pm * 256; u.u1 = pj * 256; u.u2 = kv; u.u3 = 0; return true; } };
struct EpiC { u16* Oq; u16* Okv;
  DEVI void operator()(const f32x4 (&acc)[2][2][4][2], const Unit& u, int wr, int wc, int fr, int fq) const {
    EpiRawBf16 E{u.u2 ? Okv : Oq, 512}; E(acc, u, wr, wc, fr, fq); } };
DEVI void phaseC2(KP p, ldsp_t lds) {
  SchedC S{(const char*)wsp<u16>(p, OFF_PRAW), (const char*)wsp<u16>(p, OFF_WQB), (const char*)wsp<u16>(p, OFF_WKVB), nullptr, nullptr, (int)gridDim.x, BIDX};
  EpiC E{wsp<u16>(p, OFF_QARAW), wsp<u16>(p, OFF_KVARAW)};
  gemm_phase<true, false>(lds, PLD * 2, 512, 4, S, E);
}

DEVI void ld16(const u16* src, float (&v)[16]) {
  const u32x4 a = *(const u32x4*)src, b = *(const u32x4*)(src + 8);
  const unsigned w[8] = {a.x, a.y, a.z, a.w, b.x, b.y, b.z, b.w};
#pragma unroll
  for (int i = 0; i < 8; ++i) { v[2 * i] = __uint_as_float(w[i] << 16); v[2 * i + 1] = __uint_as_float(w[i] & 0xffff0000u); }
}
DEVI void st16(u16* dst, const float (&v)[16]) {
  u32x4 a, b;
  a.x = pk2(v[0], v[1]); a.y = pk2(v[2], v[3]); a.z = pk2(v[4], v[5]); a.w = pk2(v[6], v[7]);
  b.x = pk2(v[8], v[9]); b.y = pk2(v[10], v[11]); b.z = pk2(v[12], v[13]); b.w = pk2(v[14], v[15]);
  *(u32x4*)dst = a; *(u32x4*)(dst + 8) = b;
}
DEVI void rope16c(float (&v)[16], const float* cs16, int pos) {
  const f32x2* t = (const f32x2*)(cs16 + pos * 16);
#pragma unroll
  for (int i = 0; i < 8; ++i) { const f32x2 cs = t[i]; const float x1 = v[i], x2 = v[8 + i]; v[i] = x1 * cs.x - x2 * cs.y; v[8 + i] = x2 * cs.x + x1 * cs.y; }
}
DEVI void rope32c(float (&lo)[16], float (&hi)[16], const float* cs32, int pos) {
  const f32x2* t = (const f32x2*)(cs32 + pos * 32);
#pragma unroll
  for (int i = 0; i < 16; ++i) { const f32x2 cs = t[i]; const float x1 = lo[i], x2 = hi[i]; lo[i] = x1 * cs.x - x2 * cs.y; hi[i] = x2 * cs.x + x1 * cs.y; }
}
DEVI float ssq16(const float (&v)[16]) { float s = 0.f;
#pragma unroll
  for (int i = 0; i < 16; ++i) s += v[i] * v[i];
  return s; }
DEVI void scale16(float (&v)[16], float s) {
#pragma unroll
  for (int i = 0; i < 16; ++i) v[i] *= s; }
DEVI void phaseP2(KP p, int l, ldsp_t lds) {
  const int tid = TIDX, tk = tid >> 3, pt = tid & 7;
  u16* PR = wsp<u16>(p, OFF_PRAW);
  u16* QA = wsp<u16>(p, OFF_QARAW);
  u16* KV = wsp<u16>(p, OFF_KVARAW);
  const float* cs32 = wsp<float>(p, OFF_CS32);
  const float* cs16 = wsp<float>(p, OFF_CS16);
  const float QSA = 0.10206207261596575f * LOG2E, QS = 0.125f * LOG2E;
  LAS u16* T = (LAS u16*)lds;
  for (int item = BIDX; item < NTOK / 64; item += gridDim.x) {
    const int tok0 = item * 64, b = tok0 / TPB, rr0 = tok0 % TPB;
    const bool lat = rr0 >= NCTX;
    const size_t tok = (size_t)tok0 + tk;
    const int t = rr0 + tk - NCTX, grow = (t >> 6) & 63, gcol = t & 63;
    u16* pr = PR + tok * PLD; u16* qa = QA + tok * 512; u16* kv = KV + tok * 512;
    float rq, rkv;
    {
      float a[16], c[16], d[16];
      ld16(pr + pt * 32, a); ld16(pr + pt * 32 + 16, c); ld16(pr + 256 + pt * 16, d);
      float sq = ssq16(a) + ssq16(c), sk = ssq16(d);
      sq += __shfl_xor(sq, 1); sq += __shfl_xor(sq, 2); sq += __shfl_xor(sq, 4);
      sk += __shfl_xor(sk, 1); sk += __shfl_xor(sk, 2); sk += __shfl_xor(sk, 4);
      rq = rsqrtf(sq * (1.f / 256.f) + EPS); rkv = rsqrtf(sk * (1.f / 128.f) + EPS);
    }
#pragma unroll
    for (int j = 0; j < 3; ++j) {
      const int c0 = 16 * (3 * pt + j), w = c0 % 96;
      float v[16]; ld16(qa + c0, v); scale16(v, rq * QSA);
      if (lat && w == 64) rope16c(v, cs16, grow);
      if (lat && w == 80) rope16c(v, cs16, gcol);
      st16(qa + c0, v);
    }
#pragma unroll
    for (int j = 0; j < 2; ++j) {
      u16* q = kv + (pt >> 1) * 128 + (pt & 1) * 32 + 16 * j;
      float v[16]; ld16(q, v); scale16(v, rkv); st16(q, v);
    }
    if (pt < 2) { float v[16]; ld16(pr + 384 + 16 * pt, v); if (lat) rope16c(v, cs16, pt == 0 ? grow : gcol); st16(pr + 384 + 16 * pt, v); }
    if (lat) {
      { float lo[16], hi[16]; u16* q = pr + 512 + 32 * pt; ld16(q, lo); ld16(q + 16, hi); rope32c(lo, hi, cs32, (pt & 1) ? gcol : grow); st16(q, lo); st16(q + 16, hi); }
      if (pt < 4) { float lo[16], hi[16]; u16* q = pr + 768 + 32 * pt; ld16(q, lo); ld16(q + 16, hi); rope32c(lo, hi, cs32, (pt & 1) ? gcol : grow); st16(q, lo); st16(q + 16, hi); }
    }
    {
      float lo[16], hi[16]; u16* q = pr + 1792 + 32 * pt; ld16(q, lo); ld16(q + 16, hi);
      float ss = ssq16(lo) + ssq16(hi); ss += __shfl_xor(ss, 1);
      const float rs = rsqrtf(ss * (1.f / 64.f) + EPS);
      const float* g = p->g_q_d + l * 64 + 32 * (pt & 1);
#pragma unroll
      for (int i = 0; i < 16; ++i) { lo[i] *= rs * g[i]; hi[i] *= rs * g[16 + i]; }
      if (lat) rope32c(lo, hi, cs32, (pt & 1) ? gcol : grow);
      scale16(lo, QS); scale16(hi, QS);
      st16(q, lo); st16(q + 16, hi);
    }
    {
      const int g4 = pt & 3;
      float lo[16], hi[16]; u16* q = pr + 2048 + 32 * g4; ld16(q, lo); ld16(q + 16, hi);
      float ss = ssq16(lo) + ssq16(hi); ss += __shfl_xor(ss, 1);
      const float rs = rsqrtf(ss * (1.f / 64.f) + EPS);
      const float* g = p->g_k_d + l * 64 + 32 * (g4 & 1);
#pragma unroll
      for (int i = 0; i < 16; ++i) { lo[i] *= rs * g[i]; hi[i] *= rs * g[16 + i]; }
      if (lat) rope32c(lo, hi, cs32, (g4 & 1) ? gcol : grow);
      if (pt < 4) { st16(q, lo); st16(q + 16, hi); }
    }
    __syncthreads();
    {
      const int pos = perm16(tk);
#pragma unroll
      for (int hd = 0; hd < 12; ++hd) {
        const u16* src = (hd < 2) ? pr + 896 + 64 * hd : (hd < 6) ? pr + 1536 + 64 * (hd - 2) : (hd < 8) ? pr + 2176 + 64 * (hd - 6) : kv + 128 * (hd - 8) + 64;
        const u32x4 raw = *(const u32x4*)(src + 8 * pt);
        const unsigned w[4] = {raw.x, raw.y, raw.z, raw.w};
        const float sc = (hd >= 8) ? rkv : 1.f;
#pragma unroll
        for (int i = 0; i < 4; ++i) {
          float e0 = __uint_as_float(w[i] << 16), e1 = __uint_as_float(w[i] & 0xffff0000u);
          if (hd >= 8) { e0 *= sc; e1 *= sc; }
          const unsigned pk = pk2(e0, e1);
          T[(hd * 64 + 8 * pt + 2 * i) * 72 + pos] = (u16)(pk & 0xffff);
          T[(hd * 64 + 8 * pt + 2 * i + 1) * 72 + pos] = (u16)(pk >> 16);
        }
      }
    }
    __syncthreads();
    {
      const int key0 = rr0;
#pragma unroll 1
      for (int pass = 0; pass < 12; ++pass) {
        const int row = pass * 64 + (tid >> 3), hd = row >> 6, dv = row & 63, c8 = (tid & 7) * 8;
        const u32x4 vv = *(const LAS u32x4*)(T + row * 72 + c8);
        u16* dst = (hd < 2) ? wsp<u16>(p, OFF_VBT) + ((size_t)(b * 2 + hd) * 64 + dv) * TPB
                 : (hd < 6) ? wsp<u16>(p, OFF_VCT) + ((size_t)(b * 4 + hd - 2) * 64 + dv) * TPB
                 : (hd < 8) ? wsp<u16>(p, OFF_VDT) + ((size_t)(b * 2 + hd - 6) * 64 + dv) * TPB
                            : wsp<u16>(p, OFF_VAT) + ((size_t)(b * 4 + hd - 8) * 64 + dv) * TPB;
        *(u32x4*)(dst + key0 + c8) = vv;
      }
    }
  }
}

template <int BR>
DEVI void attn_mask(f32x16 (&s)[2], int kt, int qlat, int qrow, int qcol, int hh, LAS float* rpb) {
  if (BR == 1) {
#pragma unroll
    for (int kb = 0; kb < 2; ++kb)
#pragma unroll
      for (int i = 0; i < 16; ++i) {
        const int kpos = kt * 64 + kb * 32 + (i & 3) + 8 * (i >> 2) + 4 * hh;
        const int d = qlat - kpos;
        if (d > 128 || d < -128) s[kb][i] = -1e30f;
      }
  } else {
    const int rs = min(max(qrow - 4, 0), 56);
    const bool row_ok = (kt >= rs) && (kt < rs + 8);
    const int cst = min(max(qcol - 8, 0), 48);
    const int dr = kt - qrow + 7;
#pragma unroll
    for (int kb = 0; kb < 2; ++kb)
#pragma unroll
      for (int i = 0; i < 16; ++i) {
        const int kc = kb * 32 + (i & 3) + 8 * (i >> 2) + 4 * hh;
        const bool ok = row_ok && (kc >= cst) && (kc < cst + 16);
        const int idx = ok ? (dr * 31 + (kc - qcol + 15)) : 0;
        const float bias = rpb[idx];
        s[kb][i] = ok ? (s[kb][i] + bias) : -1e30f;
      }
  }
}

template <int BR>
DEVI void attn_item2(KP p, int l, int b, int hs, int qb, bool isctx, ldsp_t lds) {
  constexpr bool MLA = (BR == 0);
  constexpr bool GQA = (BR == 1 || BR == 3);
  constexpr int QBLK = GQA ? 128 : 256;
  constexpr int NKS = MLA ? 6 : 4;
  constexpr int STG = 9216 + 9216 + 5120;
  const int tid = TIDX, lane = tid & 63, wave = __builtin_amdgcn_readfirstlane(tid >> 6);
  const int r32 = lane & 31, hh = lane >> 5;
  const int hq = GQA ? (hs * 2 + (wave & 1)) : hs;
  const int woff = GQA ? 32 * (wave >> 1) : 32 * wave;
  const int q0 = (isctx ? 0 : NCTX) + qb * QBLK;
  const size_t tokq = (size_t)b * TPB + q0 + woff + r32;
  const u16* Qp; const u16* Kp; int ldk; const u16* Vt; int obase;
  const u16* PR = wsp<u16>(p, OFF_PRAW);
  if (BR == 0) { Qp = wsp<u16>(p, OFF_QARAW) + tokq * 512 + hq * 96; Kp = wsp<u16>(p, OFF_KVARAW) + (size_t)b * TPB * 512 + hs * 128; ldk = 512; Vt = wsp<u16>(p, OFF_VAT) + (size_t)(b * 4 + hs) * 64 * TPB; obase = hq * 64; }
  else if (BR == 1) { Qp = PR + tokq * PLD + 512 + hq * 64; Kp = PR + (size_t)b * TPB * PLD + 768 + hs * 64; ldk = PLD; Vt = wsp<u16>(p, OFF_VBT) + (size_t)(b * 2 + hs) * 64 * TPB; obase = 256 + hq * 64; }
  else if (BR == 2) { Qp = PR + tokq * PLD + 1024 + hq * 64; Kp = PR + (size_t)b * TPB * PLD + 1280 + hs * 64; ldk = PLD; Vt = wsp<u16>(p, OFF_VCT) + (size_t)(b * 4 + hs) * 64 * TPB; obase = 512 + hq * 64; }
  else { Qp = PR + tokq * PLD + 1792 + hq * 64; Kp = PR + (size_t)b * TPB * PLD + 2048 + hs * 64; ldk = PLD; Vt = wsp<u16>(p, OFF_VDT) + (size_t)(b * 2 + hs) * 64 * TPB; obase = 768 + hq * 64; }
  const u16* KRp = PR + (size_t)b * TPB * PLD + 384;
  int lat_lo = 0, lat_n = 0;
  if (!isctx) {
    if (BR == 0 || BR == 3) { lat_lo = 0; lat_n = 64; }
    else if (BR == 1) { const int ql = qb * 128; const int lo = max(0, ql - 128) >> 6, hi = min(SEQ - 1, ql + 127 + 128) >> 6; lat_lo = lo; lat_n = hi - lo + 1; }
    else { const int lo = min(max(4 * qb - 4, 0), 56), hi = min(max(4 * qb + 3 - 4, 0), 56) + 7; lat_lo = lo; lat_n = hi - lo + 1; }
  }
  const int NT = 4 + lat_n;
  const int qlat = qb * QBLK + woff + r32;
  const int qrow = qlat >> 6, qcol = qlat & 63;
  bf16x8 qf[NKS];
#pragma unroll
  for (int ks = 0; ks < NKS; ++ks) qf[ks] = *(const bf16x8*)(Qp + ks * 16 + hh * 8);
  const int srow = tid >> 3, sc8 = (tid & 7) * 8;
  const int krow_ = (tid & 255) >> 2, kc8 = (tid & 3) * 8;
  const bool krt = tid < 256;
  u32x4 rk0, rv0, rr0, rk1, rv1, rr1;
  auto keytile = [&](int j) { return (j < 4) ? j : (4 + lat_lo + (j - 4)); };
#define A_GLOAD(j, rk, rv, rr) do { const int key0_ = keytile(j) * 64; \
    rk = *(const u32x4*)(Kp + (size_t)(key0_ + srow) * ldk + sc8); \
    rv = *(const u32x4*)(Vt + (size_t)srow * TPB + key0_ + sc8); \
    if (MLA && krt) rr = *(const u32x4*)(KRp + (size_t)(key0_ + krow_) * PLD + kc8); } while (0)
#define A_LWRITE(st, rk, rv, rr) do { ldsp_t base_ = lds + (st) * STG; \
    *(LAS u32x4*)(base_ + srow * 144 + sc8 * 2) = rk; \
    *(LAS u32x4*)(base_ + 9216 + srow * 144 + sc8 * 2) = rv; \
    if (MLA && krt) *(LAS u32x4*)(base_ + 18432 + krow_ * 80 + kc8 * 2) = rr; } while (0)
  LAS float* rpb = (LAS float*)(lds + 2 * STG);
  A_GLOAD(0, rk0, rv0, rr0);
  if (NT > 1) A_GLOAD(1, rk1, rv1, rr1);
  __syncthreads();
  if (BR == 2 && !isctx) {
    const float* src = p->rpb_c + (size_t)(l * 4 + hs) * 465;
    for (int i = tid; i < 465; i += 512) rpb[i] = src[i] * LOG2E;
  }
  A_LWRITE(0, rk0, rv0, rr0);
  __syncthreads();
  f32x16 o[2];
#pragma unroll
  for (int i = 0; i < 16; ++i) { o[0][i] = 0.f; o[1][i] = 0.f; }
  float m_run = -INFINITY, l_run = 0.f;
  if (BR == 1) { m_run = p->sink_b[l * 4 + hq] * LOG2E; l_run = (hh == 0) ? 1.f : 0.f; }
  const ldsp_t kfb = lds + r32 * 144 + hh * 16;
  const ldsp_t vfb = lds + 9216 + r32 * 144 + hh * 16;
  const ldsp_t krb = lds + 18432 + r32 * 80 + hh * 16;
#define A_STEP(j, rkA, rvA, rrA, rkB, rvB, rrB) do { \
    const int st = ((j) & 1) * STG; \
    if ((j) + 2 < NT) A_GLOAD((j) + 2, rkA, rvA, rrA); \
    f32x16 s[2]; \
    _Pragma("unroll") for (int kb = 0; kb < 2; ++kb) { \
      _Pragma("unroll") for (int i = 0; i < 16; ++i) s[kb][i] = 0.f; \
      _Pragma("unroll") for (int ks = 0; ks < 4; ++ks) { const bf16x8 kf = *(const LAS bf16x8*)(kfb + st + kb * 32 * 144 + ks * 32); s[kb] = MFMA(kf, qf[ks], s[kb]); } \
      if (MLA) { _Pragma("unroll") for (int ks = 0; ks < 2; ++ks) { const bf16x8 kf = *(const LAS bf16x8*)(krb + st + kb * 32 * 80 + ks * 32); s[kb] = MFMA(kf, qf[NKS - 2 + ks], s[kb]); } } \
    } \
    if ((BR == 1 || BR == 2) && (j) >= 4) attn_mask<BR>(s, lat_lo + (j) - 4, qlat, qrow, qcol, hh, rpb); \
    float mx = s[0][0]; \
    _Pragma("unroll") for (int i = 1; i < 16; ++i) mx = fmaxf(mx, s[0][i]); \
    _Pragma("unroll") for (int i = 0; i < 16; ++i) mx = fmaxf(mx, s[1][i]); \
    mx = fmaxf(mx, __shfl_xor(mx, 32)); \
    const float m_new = fmaxf(m_run, mx); \
    const float alpha = __builtin_amdgcn_exp2f(m_run - m_new); \
    m_run = m_new; \
    float ls = 0.f; \
    _Pragma("unroll") for (int kb = 0; kb < 2; ++kb) \
      _Pragma("unroll") for (int i = 0; i < 16; ++i) { const float e = __builtin_amdgcn_exp2f(s[kb][i] - m_new); s[kb][i] = e; ls += e; } \
    l_run = l_run * alpha + ls; \
    if (__any(alpha != 1.f)) { _Pragma("unroll") for (int i = 0; i < 16; ++i) { o[0][i] *= alpha; o[1][i] *= alpha; } } \
    _Pragma("unroll") for (int s4 = 0; s4 < 4; ++s4) { \
      const int kb = s4 >> 1, rb = (s4 & 1) * 8; \
      u32x4 pw; \
      pw.x = pk2(s[kb][rb + 0], s[kb][rb + 1]); pw.y = pk2(s[kb][rb + 2], s[kb][rb + 3]); \
      pw.z = pk2(s[kb][rb + 4], s[kb][rb + 5]); pw.w = pk2(s[kb][rb + 6], s[kb][rb + 7]); \
      const bf16x8 pf = __builtin_bit_cast(bf16x8, pw); \
      _Pragma("unroll") for (int db = 0; db < 2; ++db) { const bf16x8 vf = *(const LAS bf16x8*)(vfb + st + db * 32 * 144 + s4 * 32); o[db] = MFMA(vf, pf, o[db]); } \
    } \
    if ((j) + 1 < NT) A_LWRITE(((j) + 1) & 1, rkB, rvB, rrB); \
    __syncthreads(); \
  } while (0)
  for (int j = 0; j < NT; j += 2) {
    A_STEP(j, rk0, rv0, rr0, rk1, rv1, rr1);
    if (j + 1 < NT) A_STEP(j + 1, rk1, rv1, rr1, rk0, rv0, rr0);
  }
#undef A_STEP
#undef A_GLOAD
#undef A_LWRITE
  const float lt = l_run + __shfl_xor(l_run, 32);
  const float inv = 1.f / lt;
  u16* Op = wsp<u16>(p, OFF_O) + tokq * 1024 + obase;
#pragma unroll
  for (int db = 0; db < 2; ++db)
#pragma unroll
    for (int g = 0; g < 4; ++g) {
      u32x2 w;
      w.x = pk2(o[db][4 * g] * inv, o[db][4 * g + 1] * inv);
      w.y = pk2(o[db][4 * g + 2] * inv, o[db][4 * g + 3] * inv);
      *(u32x2*)(Op + db * 32 + 8 * g + 4 * hh) = w;
    }
}
DEVI void phaseD2(KP p, int l, ldsp_t lds) {
  const int G8 = gridDim.x >> 3, xcd = BIDX & 7, lb = BIDX >> 3;
  if (lb >= G8) return;
  const int NLOC = 256 + (l == 0 ? 16 : 0);
  for (int n = lb; n < NLOC; n += G8) {
    int br, s, qb; bool isctx = false;
    if (n < 64) { br = 0; s = xcd + 8 * (n >> 4); qb = n & 15; }
    else if (n < 128) { const int m = n - 64; br = 3; s = xcd + 8 * (m >> 5); qb = m & 31; }
    else if (n < 192) { const int m = n - 128; br = 2; s = xcd + 8 * (m >> 4); qb = m & 15; }
    else if (n < 256) { const int m = n - 192; br = 1; s = xcd + 8 * (m >> 5); qb = m & 31; }
    else {
      const int m = n - 256; isctx = true;
      if (m < 4) { br = 0; s = xcd + 8 * m; qb = 0; }
      else if (m < 8) { const int mm = m - 4; br = 3; s = xcd + 8 * (mm >> 1); qb = mm & 1; }
      else if (m < 12) { br = 2; s = xcd + 8 * (m - 8); qb = 0; }
      else { const int mm = m - 12; br = 1; s = xcd + 8 * (mm >> 1); qb = mm & 1; }
    }
    if (br == 0) attn_item2<0>(p, l, s >> 2, s & 3, qb, isctx, lds);
    else if (br == 1) attn_item2<1>(p, l, s >> 1, s & 1, qb, isctx, lds);
    else if (br == 2) attn_item2<2>(p, l, s >> 2, s & 3, qb, isctx, lds);
    else attn_item2<3>(p, l, s >> 1, s & 1, qb, isctx, lds);
  }
}


DEVI int pm_map(int pme, bool skipctx) { return skipctx ? (pme >> 4) * 17 + 1 + (pme & 15) : pme; }
struct SchedE1 { const char* O; const char* W; int pr; bool skipctx; int G, c;
  DEVI bool next(int i, Unit& u) const { int pm, pn; if (!tile_order(i, G, c, skipctx ? 128 : 136, 8, pm, pn)) return false;
    pm = pm_map(pm, skipctx); const int n = 2 * pr + (pn >> 2), cq = pn & 3;
    u.A = O + (size_t)pm * 256 * 2048 + n * 512; u.B = W + ((size_t)n * 1024 + cq * 256) * 512; u.rows = nullptr; u.nvalid = 0;
    u.u0 = pm * 256; u.u1 = pn * 256; u.u2 = 0; u.u3 = 0; return true; } };
DEVI void phaseE1(KP p, int l, int pr, ldsp_t lds) {
  if (pr == 0 && BIDX == 0 && TIDX < 32) wsp<int>(p, OFF_CNT)[TIDX * CNT_STRIDE] = 0;
  SchedE1 S{(const char*)wsp<u16>(p, OFF_O), (const char*)wsp<u16>(p, OFF_WBR), pr, l == 1, (int)gridDim.x, BIDX};
  EpiRawBf16 E{wsp<u16>(p, OFF_Z), 2048};
  gemm_phase<true, false>(lds, 2048, 512, 4, S, E);
}
struct SchedE2 { const char* H; const char* W; int pr; bool skipctx; int G, c;
  DEVI bool next(int i, Unit& u) const { int pm, pn; if (!tile_order(i, G, c, skipctx ? 128 : 136, 8, pm, pn)) return false;
    pm = pm_map(pm, skipctx);
    u.A = H + (size_t)pm * 256 * 2048; u.B = W + (size_t)(pr * 8 + pn) * 256 * 2048; u.rows = nullptr; u.nvalid = 0;
    u.u0 = pm * 256; u.u1 = pn * 128; u.u2 = 0; u.u3 = 0; return true; } };
struct EpiE2 { const u16* Z; const u16* Yin; u16* Yout; const float* bias0; const float* bias1;
  DEVI void operator()(const f32x4 (&acc)[2][2][4][2], const Unit& u, int wr, int wc, int fr, int fq) const {
    const int row0 = u.u0 + wr * 64 + fr, col0 = u.u1 + wc * 32 + 8 * fq;
    f32x4 bv[2][2];
#pragma unroll
    for (int nn = 0; nn < 2; ++nn) { bv[0][nn] = *(const f32x4*)(bias0 + col0 + 4 * nn); bv[1][nn] = *(const f32x4*)(bias1 + col0 + 4 * nn); }
#pragma unroll
    for (int ai = 0; ai < 2; ++ai)
#pragma unroll
      for (int m = 0; m < 4; ++m) {
        const size_t r = (size_t)(row0 + ai * HALF + m * 16);
        float t[8];
#pragma unroll
        for (int j = 0; j < 8; ++j) t[j] = 0.f;
        if (Yin) {
          const u32x4 y = *(const u32x4*)(Yin + r * 1024 + col0);
          const unsigned w[4] = {y.x, y.y, y.z, y.w};
#pragma unroll
          for (int i = 0; i < 4; ++i) { t[2 * i] = __uint_as_float(w[i] << 16); t[2 * i + 1] = __uint_as_float(w[i] & 0xffff0000u); }
        }
#pragma unroll
        for (int bj = 0; bj < 2; ++bj) {
          const u32x4 z = *(const u32x4*)(Z + r * 2048 + bj * 1024 + col0);
          const unsigned w[4] = {z.x, z.y, z.z, z.w};
#pragma unroll
          for (int nn = 0; nn < 2; ++nn)
#pragma unroll
            for (int j = 0; j < 4; ++j) {
              const int e = 4 * nn + j;
              const float zz = (e & 1) ? __uint_as_float(w[e >> 1] & 0xffff0000u) : __uint_as_float(w[e >> 1] << 16);
              const float g = 1.f / (1.f + __expf(-(acc[ai][bj][m][nn][j] + bv[bj][nn][j])));
              t[e] += g * zz;
            }
        }
        u32x4 o; o.x = pk2(t[0], t[1]); o.y = pk2(t[2], t[3]); o.z = pk2(t[4], t[5]); o.w = pk2(t[6], t[7]);
        *(u32x4*)(Yout + r * 1024 + col0) = o;
      }
  }
};
DEVI void phaseE2(KP p, int l, int pr, ldsp_t lds) {
  SchedE2 S{(const char*)wsp<u16>(p, OFF_H), (const char*)wsp<u16>(p, OFF_WGATE), pr, l == 1, (int)gridDim.x, BIDX};
  EpiE2 E{wsp<u16>(p, OFF_Z), pr ? wsp<u16>(p, OFF_YPART) : nullptr, pr ? wsp<u16>(p, OFF_YPRE) : wsp<u16>(p, OFF_YPART),
          p->b_gate + (size_t)(l * 4 + 2 * pr) * 1024, p->b_gate + (size_t)(l * 4 + 2 * pr + 1) * 1024};
  gemm_phase<true, false>(lds, 2048, 2048, 16, S, E);
}
struct SchedF { const char* Y; const char* W; bool skipctx; int G, c;
  DEVI bool next(int i, Unit& u) const { int pm, pn; if (!tile_order(i, G, c, skipctx ? 128 : 136, 4, pm, pn)) return false;
    pm = pm_map(pm, skipctx);
    u.A = Y + (size_t)pm * 256 * 2048; u.B = W + (size_t)pn * 256 * 2048; u.rows = nullptr; u.nvalid = 0;
    u.u0 = pm; u.u1 = pn * 256; u.u2 = 0; u.u3 = 0; return true; } };
struct EpiF { KP p; int l;
  DEVI void operator()(const f32x4 (&acc)[2][2][4][2], const Unit& u, int wr, int wc, int fr, int fq) const {
    const int pm = u.u0, b = pm / 17, rr0 = (pm % 17) * 256;
    const int mrow = (rr0 < NCTX) ? 8 : b;
    const int col0 = u.u1 + wc * 32 + 4 * fq;
    const float* gt = wsp<float>(p, OFF_MOD) + ((size_t)l * 9 + mrow) * 6144 + 2048 + col0;
    const float* xin = xrow_in(p, l, b, rr0) + col0;
    float* xout = xrow_res(p, b, rr0) + col0;
    f32x4 gv[2][2];
#pragma unroll
    for (int bj = 0; bj < 2; ++bj)
#pragma unroll
      for (int n = 0; n < 2; ++n) gv[bj][n] = *(const f32x4*)(gt + bj * HALF + n * 16);
#pragma unroll
    for (int ai = 0; ai < 2; ++ai)
#pragma unroll
      for (int m = 0; m < 4; ++m) {
        const size_t ro = (size_t)(wr * 64 + fr + ai * HALF + m * 16) * 1024;
#pragma unroll
        for (int bj = 0; bj < 2; ++bj)
#pragma unroll
          for (int n = 0; n < 2; ++n) {
            const f32x4 xo = *(const f32x4*)(xin + ro + bj * HALF + n * 16);
            *(f32x4*)(xout + ro + bj * HALF + n * 16) = xo + gv[bj][n] * acc[ai][bj][m][n];
          }
      }
  }
};
DEVI void phaseF2(KP p, int l, ldsp_t lds) {
  SchedF S{(const char*)wsp<u16>(p, OFF_YPRE), (const char*)wsp<u16>(p, OFF_WOUT), l == 1, (int)gridDim.x, BIDX};
  EpiF E{p, l};
  gemm_phase<false, false>(lds, 2048, 2048, 16, S, E);
}


DEVI void conv_tile2(const ConvT& c, LAS float* t, int htid) {
  const int kk = htid >> 3, n4 = (htid & 7) * 4;
  __syncthreads();
#pragma unroll
  for (int i = 0; i < 2; ++i) {
    const int k = kk + 32 * i;
    f32x4 v = f32x4{0.f, 0.f, 0.f, 0.f};
    const float* sp = (c.src2 && n4 >= 16) ? c.src2 + (n4 - 16) : (c.src ? c.src + n4 : nullptr);
    if (sp) v = *(const f32x4*)(sp + (size_t)k * c.ld);
    const float s = (c.ks ? c.ks[k] : 1.f) * c.mul;
    t[(n4 + 0) * 65 + k] = v.x * s; t[(n4 + 1) * 65 + k] = v.y * s;
    t[(n4 + 2) * 65 + k] = v.z * s; t[(n4 + 3) * 65 + k] = v.w * s;
  }
  __syncthreads();
  const int n = htid >> 3, k8 = (htid & 7) * 8;
  const LAS float* r = t + n * 65 + k8;
  u32x4 o;
  o.x = pk2(r[0], r[1]); o.y = pk2(r[2], r[3]); o.z = pk2(r[4], r[5]); o.w = pk2(r[6], r[7]);
  *(u32x4*)(c.dst + (size_t)n * c.ldd + k8) = o;
}
DEVI void conv_items2(KP p, int l, ldsp_t lds, int first_item, int total_items) {
  const int tid = TIDX, half = tid >> 8, htid = tid & 255;
  LAS float* t = (LAS float*)(lds + half * 16384);
  for (int it = BIDX * 2; it < total_items; it += gridDim.x * 2) {
    const int item = it + half;
    ConvT c = conv_decode(p, l, (item < total_items ? item : total_items - 1) - first_item);
    conv_tile2(c, t, htid);
  }
}
DEVI void phase0_2(KP p, ldsp_t lds) {
  const int tid = TIDX, half = tid >> 8, htid = tid & 255;
  for (int it = BIDX * 2; it < 458; it += gridDim.x * 2) {
    const int item = it + half;
    LAS float* sc = (LAS float*)(lds + half * 16384);
    const bool ismod = item < 384;
    const int l = item / 192, rem = item % 192, cgp = rem >> 3, kc = rem & 7;
    __syncthreads();
    if (ismod) {
      for (int i = htid; i < 9 * 128; i += 256) {
        int b = i >> 7, k = i & 127;
        float v = (b < 8) ? p->c[b * 1024 + kc * 128 + k] : p->c_ctx[kc * 128 + k];
        sc[i] = v / (1.f + expf(-v));
      }
    }
    __syncthreads();
    if (ismod) {
      float acc[9];
#pragma unroll
      for (int b = 0; b < 9; ++b) acc[b] = 0.f;
      const float* w = p->w_mod + ((size_t)l * 1024 + kc * 128) * 6144 + cgp * 256 + htid;
#pragma unroll 8
      for (int k = 0; k < 128; ++k) {
        float wv = w[(size_t)k * 6144];
#pragma unroll
        for (int b = 0; b < 9; ++b) acc[b] += sc[b * 128 + k] * wv;
      }
      float* dst = wsp<float>(p, OFF_MODP) + (size_t)((kc * 2 + l) * 9) * 6144 + cgp * 256 + htid;
#pragma unroll
      for (int b = 0; b < 9; ++b) dst[(size_t)b * 6144] = acc[b];
    } else if (item == 384) {
      float* cs32 = wsp<float>(p, OFF_CS32);
      float* cs16 = wsp<float>(p, OFF_CS16);
      for (int t = htid; t < 1024; t += 256) {
        int pos = t >> 4, i = t & 15;
        float ang = (float)pos * powf(10000.f, -(float)(2 * i) / 32.f);
        cs32[t * 2] = cosf(ang); cs32[t * 2 + 1] = sinf(ang);
      }
      for (int t = htid; t < 512; t += 256) {
        int pos = t >> 3, i = t & 7;
        float ang = (float)pos * powf(10000.f, -(float)(2 * i) / 16.f);
        cs16[t * 2] = cosf(ang); cs16[t * 2 + 1] = sinf(ang);
      }
    } else if (item < 457) {
      const int q = item - 385, ll = q / 36, o = q % 36;
      float* dst = wsp<float>(p, OFF_WRT) + ((size_t)ll * 36 + o) * 1024;
      for (int k = htid; k < 1024; k += 256)
        dst[k] = (o < 4) ? p->w_group[((size_t)ll * 1024 + k) * 4 + o] : p->w_router[((size_t)ll * 1024 + k) * 32 + (o - 4)];
    }
  }
  conv_items2(p, 0, lds, 0, CONV_ITEMS);
}
DEVI void phase1_2(KP p) {
  const float* mp = wsp<float>(p, OFF_MODP);
  float* mo = wsp<float>(p, OFF_MOD);
  for (int i = BIDX * 512 + TIDX; i < 2 * 9 * 6144; i += gridDim.x * 512) {
    int l = i / (9 * 6144), o = i % 6144;
    float s = p->b_mod[l * 6144 + o];
#pragma unroll
    for (int kc = 0; kc < 8; ++kc) s += mp[(size_t)kc * 2 * 9 * 6144 + i];
    mo[i] = s;
  }
}
DEVI void phaseA2(KP p) {
  const int gw = BIDX * NW + (TIDX >> 6), nw = gridDim.x * NW;
  u16* H = wsp<u16>(p, OFF_H);
  for (int tok = gw; tok < NTOK; tok += nw) {
    const int b = tok / TPB, rr = tok % TPB;
    float xv[16], hv[16];
    load_row16(xrow_in(p, 0, b, rr), xv);
    modulate_row_store(p, 0, 0, xv, rr < NCTX ? 8 : b, H + (size_t)tok * 1024, hv);
  }
}
DEVI void phaseG2(KP p, int l, ldsp_t lds) {
  constexpr int HS = 1026;
  const int tid = TIDX, lane = tid & 63, wave = __builtin_amdgcn_readfirstlane(tid >> 6);
  const int r32 = lane & 31, kh = lane >> 5, qd = lane >> 4;
  u16* H = wsp<u16>(p, OFF_H);
  const float* WRT = wsp<float>(p, OFF_WRT) + (size_t)l * 36 * 1024;
  int* cnt = wsp<int>(p, OFF_CNT);
  int* list = wsp<int>(p, OFF_LIST);
  float* wlist = wsp<float>(p, OFF_WLIST);
  LAS float* h2t = (LAS float*)lds;
  LAS float* part = (LAS float*)lds;
  LAS int* gsel = (LAS int*)(lds + 32 * HS * 4);
  LAS float* gwt = (LAS float*)(lds + 32 * HS * 4 + 128);
  float wreg[64];
  {
    const float* wr = p->w_router + (size_t)l * 1024 * 32 + r32;
#pragma unroll
    for (int t = 0; t < 32; ++t) {
      const int k = 128 * wave + 4 * t + 2 * kh;
      wreg[2 * t] = wr[(size_t)k * 32]; wreg[2 * t + 1] = wr[(size_t)(k + 1) * 32];
    }
  }
  for (int tile = BIDX; tile < NTOK / 32; tile += gridDim.x) {
    const int tok0 = tile * 32, b = tok0 / TPB, rr0 = tok0 % TPB;
    if (l == 1 && rr0 < NCTX) continue;
    {
      float hv[4][16];
#pragma unroll
      for (int r = 0; r < 4; ++r) {
        float xv[16];
        load_row16(xrow_res(p, b, rr0 + wave * 4 + r), xv);
        modulate_row_store(p, l, 1, xv, (rr0 < NCTX) ? 8 : b, H + (size_t)(tok0 + wave * 4 + r) * 1024, hv[r]);
        LAS float* dst = h2t + (wave * 4 + r) * HS + lane * 4;
#pragma unroll
        for (int i = 0; i < 4; ++i) {
          *(LAS f32x2*)(dst + i * 256) = f32x2{hv[r][i * 4], hv[r][i * 4 + 1]};
          *(LAS f32x2*)(dst + i * 256 + 2) = f32x2{hv[r][i * 4 + 2], hv[r][i * 4 + 3]};
        }
      }
      float gl[4];
#pragma unroll
      for (int o = 0; o < 4; ++o) gl[o] = router_dot(hv, WRT + (size_t)o * 1024) + p->b_group[l * 4 + o];
      int gs = 0; float best = gl[0];
#pragma unroll
      for (int j = 1; j < 4; ++j) if (gl[j] > best) { best = gl[j]; gs = j; }
      float gsum = 0.f;
#pragma unroll
      for (int j = 0; j < 4; ++j) gsum += expf(gl[j] - best);
      if ((lane & 15) == 0) { gsel[wave * 4 + qd] = gs; gwt[wave * 4 + qd] = 1.f / gsum; }
    }
    __syncthreads();
    f32x16 acc;
#pragma unroll
    for (int i = 0; i < 16; ++i) acc[i] = 0.f;
    {
      const LAS float* ap = h2t + r32 * HS + 128 * wave + 2 * kh;
#pragma unroll
      for (int t = 0; t < 32; ++t) {
        const f32x2 a = *(const LAS f32x2*)(ap + 4 * t);
        acc = __builtin_amdgcn_mfma_f32_32x32x2f32(a.x, wreg[2 * t], acc, 0, 0, 0);
        acc = __builtin_amdgcn_mfma_f32_32x32x2f32(a.y, wreg[2 * t + 1], acc, 0, 0, 0);
      }
    }
    __syncthreads();
#pragma unroll
    for (int i = 0; i < 16; ++i) part[(wave * 32 + (i & 3) + 8 * (i >> 2) + 4 * kh) * 33 + r32] = acc[i];
    __syncthreads();
    if (tid < 32) {
      const int gs = gsel[tid];
      const float gw_ = gwt[tid];
      float e8[8];
#pragma unroll
      for (int j = 0; j < 8; ++j) {
        float v = p->b_router[l * 32 + gs * 8 + j];
#pragma unroll
        for (int w = 0; w < 8; ++w) v += part[(w * 32 + tid) * 33 + gs * 8 + j];
        e8[j] = v;
      }
      int i0 = 0; float v0 = e8[0];
#pragma unroll
      for (int j = 1; j < 8; ++j) if (e8[j] > v0) { v0 = e8[j]; i0 = j; }
      int i1 = -1; float v1 = -INFINITY;
#pragma unroll
      for (int j = 0; j < 8; ++j) if (j != i0 && e8[j] > v1) { v1 = e8[j]; i1 = j; }
      const float ex = expf(v1 - v0);
      const float w0 = gw_ / (1.f + ex), w1 = gw_ * ex / (1.f + ex);
      const int tok = tok0 + tid;
      const int ea = gs * 8 + i0, eb = gs * 8 + i1;
      const int sa = atomicAdd(&cnt[ea * CNT_STRIDE], 1);
      const int sb = atomicAdd(&cnt[eb * CNT_STRIDE], 1);
      list[(size_t)ea * NTOK + sa] = tok * 2; wlist[(size_t)ea * NTOK + sa] = w0;
      list[(size_t)eb * NTOK + sb] = tok * 2 + 1; wlist[(size_t)eb * NTOK + sb] = w1;
    }
    __syncthreads();
  }
}
struct ExpInfo2 { int tiles[4], base[4], cnt[4]; };
DEVI ExpInfo2 exp_info2(KP p, int xcd) {
  const int* cnt = wsp<int>(p, OFF_CNT);
  ExpInfo2 ei;
  int before = 0;
#pragma unroll
  for (int e = 0; e < 32; ++e) {
    const int c = __builtin_amdgcn_readfirstlane(cnt[e * CNT_STRIDE]), t = (c + 255) >> 8;
    if ((e & 7) == xcd) { ei.tiles[e >> 3] = t; ei.base[e >> 3] = before; ei.cnt[e >> 3] = c; }
    before += t;
  }
  return ei;
}
template <int NN>
struct SchedX { ExpInfo2 ei; int xcd, lb, G8; const char* A; const char* W; const int* list; size_t wstride; int lda_b;
  DEVI bool next(int i, Unit& u) const {
    const int tot = (ei.tiles[0] + ei.tiles[1] + ei.tiles[2] + ei.tiles[3]) * NN;
    const int n = i * G8 + lb; if (n >= tot) return false;
    int k = 0, m = n / NN; const int pn = n % NN;
    int tb = ei.base[0], ce = ei.cnt[0];
#pragma unroll
    for (int kk = 0; kk < 3; ++kk) { if (k == kk && m >= ei.tiles[kk]) { m -= ei.tiles[kk]; k = kk + 1; tb = ei.base[kk + 1]; ce = ei.cnt[kk + 1]; } }
    const int e = xcd + 8 * k;
    u.rows = list + (size_t)e * NTOK + m * 256; u.nvalid = ce - m * 256;
    u.A = A + (NN == 2 ? (size_t)0 : (size_t)(tb + m) * 256 * lda_b);
    u.B = W + (size_t)e * wstride + (size_t)pn * 256 * (NN == 2 ? 2048 : 512);
    u.u0 = (tb + m) * 256; u.u1 = pn; u.u2 = e; u.u3 = m; return true; } };
struct EpiI1 { u16* U;
  DEVI void operator()(const f32x4 (&acc)[2][2][4][2], const Unit& u, int wr, int wc, int fr, int fq) const {
#pragma unroll
    for (int ai = 0; ai < 2; ++ai)
#pragma unroll
      for (int m = 0; m < 4; ++m) {
        u16* rowp = U + (size_t)(u.u0 + ai * HALF + wr * 64 + m * 16 + fr) * 256;
#pragma unroll
        for (int bj = 0; bj < 2; ++bj) {
          const int ff = 16 * (8 * u.u1 + 4 * bj + wc) + 4 * fq;
          const f32x4 g = acc[ai][bj][m][0], up = acc[ai][bj][m][1];
          float t[4];
#pragma unroll
          for (int j = 0; j < 4; ++j) t[j] = g[j] / (1.f + __expf(-g[j])) * up[j];
          u32x2 o; o.x = pk2(t[0], t[1]); o.y = pk2(t[2], t[3]);
          *(u32x2*)(rowp + ff) = o;
        }
      }
  }
};
DEVI void phaseI1_2(KP p, ldsp_t lds) {
  const int xcd = BIDX & 7, lb = BIDX >> 3, G8 = gridDim.x >> 3;
  if (lb >= G8) return;
  SchedX<2> S{exp_info2(p, xcd), xcd, lb, G8, (const char*)wsp<u16>(p, OFF_H), (const char*)wsp<u16>(p, OFF_W13), wsp<int>(p, OFF_LIST), (size_t)512 * 2048, 2048};
  EpiI1 E{wsp<u16>(p, OFF_U)};
  gemm_phase<false, true>(lds, 2048, 2048, 16, S, E);
}
struct EpiI2 { u16* YS; const float* wlist; const int* list;
  DEVI void operator()(const f32x4 (&acc)[2][2][4][2], const Unit& u, int wr, int wc, int fr, int fq) const {
    const unsigned colb = (unsigned)(u.u1 * 256 + wc * 32 + 8 * fq) * 2u;
    const float* we = wlist + (u.rows - list);
#pragma unroll
    for (int ai = 0; ai < 2; ++ai)
#pragma unroll
      for (int m = 0; m < 4; ++m) {
        const int r = ai * HALF + wr * 64 + m * 16 + fr;
        const unsigned dest = (r < u.nvalid) ? (unsigned)u.rows[r] : (unsigned)(2 * NTOK);
        const float w = we[r];
        char* rowp = (char*)YS + (dest * 2048u + colb);
#pragma unroll
        for (int bj = 0; bj < 2; ++bj) {
          const f32x4 v0 = acc[ai][bj][m][0] * w, v1 = acc[ai][bj][m][1] * w;
          u32x4 o; o.x = pk2(v0[0], v0[1]); o.y = pk2(v0[2], v0[3]); o.z = pk2(v1[0], v1[1]); o.w = pk2(v1[2], v1[3]);
          *(u32x4*)(rowp + bj * 256) = o;
        }
      }
  }
};
DEVI void phaseI2_2(KP p, ldsp_t lds) {
  const int xcd = BIDX & 7, lb = BIDX >> 3, G8 = gridDim.x >> 3;
  if (lb >= G8) return;
  SchedX<4> S{exp_info2(p, xcd), xcd, lb, G8, (const char*)wsp<u16>(p, OFF_U), (const char*)wsp<u16>(p, OFF_W2), wsp<int>(p, OFF_LIST), (size_t)1024 * 512, 512};
  EpiI2 E{wsp<u16>(p, OFF_YS), wsp<float>(p, OFF_WLIST), wsp<int>(p, OFF_LIST)};
  int nt = 4; asm volatile("" : "+s"(nt));
  gemm_phase<true, false>(lds, 512, 512, nt, S, E);
}
DEVI void phaseJ2(KP p, int l, ldsp_t lds) {
  const int lane = TIDX & 63;
  const int gw = BIDX * NW + (TIDX >> 6), nw = gridDim.x * NW;
  const u16* YS = wsp<u16>(p, OFF_YS);
  u16* H = wsp<u16>(p, OFF_H);
  for (int tok = gw; tok < NTOK; tok += nw) {
    const int b = tok / TPB, rr = tok % TPB;
    if (l == 1 && rr < NCTX) continue;
    const int mrow = (rr < NCTX) ? 8 : b;
    float* xr = xrow_res(p, b, rr);
    const float* gt = wsp<float>(p, OFF_MOD) + ((size_t)l * 9 + mrow) * 6144 + 5120;
    float xv[16];
    load_row16(xr, xv);
#pragma unroll
    for (int i = 0; i < 4; ++i) {
      const int c = i * 256 + lane * 4;
      const u32x2 y0 = *(const u32x2*)(YS + (size_t)(tok * 2) * 1024 + c);
      const u32x2 y1 = *(const u32x2*)(YS + (size_t)(tok * 2 + 1) * 1024 + c);
      const f32x4 g = *(const f32x4*)(gt + c);
      xv[i * 4 + 0] += g.x * (bf2f((u16)(y0.x & 0xffff)) + bf2f((u16)(y1.x & 0xffff)));
      xv[i * 4 + 1] += g.y * (bf2f((u16)(y0.x >> 16)) + bf2f((u16)(y1.x >> 16)));
      xv[i * 4 + 2] += g.z * (bf2f((u16)(y0.y & 0xffff)) + bf2f((u16)(y1.y & 0xffff)));
      xv[i * 4 + 3] += g.w * (bf2f((u16)(y0.y >> 16)) + bf2f((u16)(y1.y >> 16)));
    }
    if (l == 0) {
#pragma unroll
      for (int i = 0; i < 4; ++i)
        *(f32x4*)(xr + i * 256 + lane * 4) = f32x4{xv[i * 4], xv[i * 4 + 1], xv[i * 4 + 2], xv[i * 4 + 3]};
      float hv[16];
      modulate_row_store(p, 1, 0, xv, mrow, H + (size_t)tok * 1024, hv);
    } else {
      float ss = 0.f;
#pragma unroll
      for (int i = 0; i < 16; ++i) ss += xv[i] * xv[i];
      ss = wave_sum(ss);
      const float rstd = rsqrtf(ss * (1.f / 1024.f) + EPS);
#pragma unroll
      for (int i = 0; i < 4; ++i) {
        const int c = i * 256 + lane * 4;
        const f32x4 g = *(const f32x4*)(p->g_final + c);
        *(f32x4*)(xr + c) = f32x4{xv[i * 4] * rstd * g.x, xv[i * 4 + 1] * rstd * g.y, xv[i * 4 + 2] * rstd * g.z, xv[i * 4 + 3] * rstd * g.w};
      }
    }
  }
  if (l == 0) conv_items2(p, 1, lds, 0, CONV_ITEMS);
}

constexpr int N_PHASES = 3 + 2 * 13;
__global__ void __launch_bounds__(512, 2) fwd_v2(Params parg) {
  extern __shared__ __attribute__((aligned(16))) unsigned char dyn_lds[];
  const ldsp_t lds = (ldsp_t)dyn_lds;
  cg::grid_group grid = cg::this_grid();
  volatile LAS unsigned* xb_st = (volatile LAS unsigned*)(lds + LDS_BARW);
  if (TIDX < 4) xb_st[TIDX] = 0u;
  __syncthreads();
  if (parg.ph_end - parg.ph_begin > 1) xcd_barrier_post((unsigned*)(parg.ws + OFF_BAR));
  for (int ph = parg.ph_begin; ph < parg.ph_end; ++ph) {
    KP p = (KP)__builtin_amdgcn_kernarg_segment_ptr();
    asm volatile("" : "+s"(p));
    const int l = (ph >= 16) ? 1 : 0;
    const int k = (ph < 3) ? ph : 3 + (ph - 3) % 13;
    const int reps = ((PROBE_DUP >> k) & 1) ? 2 : 1;
    for (int rep = 0; rep < reps; ++rep) {
      if (rep) {
        xcd_barrier((unsigned*)(p->ws + OFF_BAR), xb_st);
        if (k == 12) { if (BIDX == 0 && TIDX < 32) wsp<int>(p, OFF_CNT)[TIDX * CNT_STRIDE] = 0; xcd_barrier((unsigned*)(p->ws + OFF_BAR), xb_st); }
      }
      switch (k) {
        case 0: phase0_2(p, lds); break;
        case 1: phase1_2(p); break;
        case 2: phaseA2(p); break;
        case 3: phaseB2(p, lds); break;
        case 4: phaseC2(p, lds); break;
        case 5: phaseP2(p, l, lds); break;
        case 6: phaseD2(p, l, lds); break;
        case 7: phaseE1(p, l, 0, lds); break;
        case 8: phaseE2(p, l, 0, lds); break;
        case 9: phaseE1(p, l, 1, lds); break;
        case 10: phaseE2(p, l, 1, lds); break;
        case 11: phaseF2(p, l, lds); break;
        case 12: phaseG2(p, l, lds); break;
        case 13: phaseI1_2(p, lds); break;
        case 14: phaseI2_2(p, lds); break;
        default: phaseJ2(p, l, lds); break;
      }
    }
    if (ph + 1 < parg.ph_end) {
      if (ph == parg.ph_begin) grid.sync();
      else xcd_barrier((unsigned*)(p->ws + OFF_BAR), xb_st);
    }
  }
}
}

extern "C" void kernel_launch(void* const* d_in, const int* in_sizes, int n_in, void* d_out, int out_size,
                              void* d_ws, size_t ws_size, hipStream_t stream) {
  static int grid2 = 0;
  if (!grid2) {
    int dev = 0, cus = 0, per_cu = 0;
    (void)hipGetDevice(&dev);
    (void)hipDeviceGetAttribute(&cus, hipDeviceAttributeMultiprocessorCount, dev);
    (void)hipFuncSetAttribute((const void*)v2::fwd_v2, hipFuncAttributeMaxDynamicSharedMemorySize, v2::LDS_TOTAL);
    (void)hipOccupancyMaxActiveBlocksPerMultiprocessor(&per_cu, v2::fwd_v2, 512, v2::LDS_TOTAL);
    if (per_cu < 1) { fprintf(stderr, "kernel does not fit on a CU\n"); per_cu = 1; }
    grid2 = cus & ~7;
  }
  if (ws_size < WS_NEEDED) { fprintf(stderr, "workspace too small: %zu < %zu\n", ws_size, (size_t)WS_NEEDED); return; }
  Params hp{};
  const float** f = (const float**)&hp;
  for (int i = 0; i < 29; ++i) f[i] = (const float*)d_in[i];
  hp.out = (float*)d_out;
  hp.ws = (char*)d_ws;
#if N_LAUNCH_MODE == 1
  for (int ph = 0; ph < v2::N_PHASES; ++ph) {
    hp.ph_begin = ph; hp.ph_end = ph + 1;
    void* args[] = {&hp};
    hipError_t e = hipLaunchCooperativeKernel((void*)v2::fwd_v2, dim3(grid2), dim3(512), args, v2::LDS_TOTAL, stream);
    if (e != hipSuccess) fprintf(stderr, "launch failed: %s\n", hipGetErrorString(e));
  }
#else
  hp.ph_begin = 0; hp.ph_end = v2::N_PHASES;
  (void)hipMemsetAsync((char*)d_ws + OFF_BAR, 0, (size_t)XCD_BAR_WORDS * 4, stream);
  void* args[] = {&hp};
  hipError_t e = hipLaunchCooperativeKernel((void*)v2::fwd_v2, dim3(grid2), dim3(512), args, v2::LDS_TOTAL, stream);
  if (e != hipSuccess) fprintf(stderr, "cooperative launch failed: %s (grid %d)\n", hipGetErrorString(e), grid2);
#endif
}
```

```cpp
#include <hip/hip_runtime.h>
#include <hip/hip_cooperative_groups.h>
#include <stdint.h>
#include <stdio.h>
namespace cg = cooperative_groups;

#ifndef N_LAUNCH_MODE
#define N_LAUNCH_MODE 0
#endif

#ifndef PROBE_DUP
#define PROBE_DUP 0
#endif
#define DEVI __device__ __forceinline__
typedef unsigned short u16;
typedef __attribute__((ext_vector_type(2))) float f32x2;
typedef __attribute__((ext_vector_type(2))) __bf16 bf16x2_t;
typedef __attribute__((ext_vector_type(8))) short bf16x8;
typedef __attribute__((ext_vector_type(16))) float f32x16;
typedef __attribute__((ext_vector_type(4))) unsigned u32x4;
typedef __attribute__((ext_vector_type(2))) unsigned u32x2;
typedef __attribute__((ext_vector_type(4))) float f32x4;
#define MFMA(a, b, c) __builtin_amdgcn_mfma_f32_32x32x16_bf16((a), (b), (c), 0, 0, 0)

constexpr int DMODEL = 1024, NBATCH = 8, SEQ = 4096, NCTX = 256;
constexpr int TPB = SEQ + NCTX;
constexpr int NTOK = NBATCH * TPB;
constexpr int MT_PER_B = TPB / 128;
constexpr int NEXP = 32;
constexpr int INP = 2304;
constexpr float EPS = 1e-6f;
constexpr float LOG2E = 1.4426950408889634f;
constexpr int SMEM_BYTES = 73728;
constexpr int UROWS = 2 * NTOK + NEXP * 256;

constexpr size_t al(size_t x) { return (x + 255) & ~(size_t)255; }
constexpr size_t OFF_WIN = 0;
constexpr size_t OFF_WQB = OFF_WIN + al((size_t)INP * 1024 * 2);
constexpr size_t OFF_WKVB = OFF_WQB + al((size_t)512 * 256 * 2);
constexpr size_t OFF_WGATE = OFF_WKVB + al((size_t)512 * 256 * 2);
constexpr size_t OFF_WBR = OFF_WGATE + al((size_t)4 * 1024 * 1024 * 2);
constexpr size_t OFF_WOUT = OFF_WBR + al((size_t)4 * 1024 * 256 * 2);
constexpr size_t OFF_W13 = OFF_WOUT + al((size_t)1024 * 1024 * 2);
constexpr size_t OFF_W2 = OFF_W13 + al((size_t)32 * 512 * 1024 * 2);
constexpr size_t OFF_MODP = OFF_W2 + al((size_t)32 * 1024 * 256 * 2);
constexpr size_t OFF_MOD = OFF_MODP + al((size_t)8 * 2 * 9 * 6144 * 4);
constexpr size_t OFF_CS32 = OFF_MOD + al((size_t)2 * 9 * 6144 * 4);
constexpr size_t OFF_CS16 = OFF_CS32 + al((size_t)64 * 16 * 2 * 4);
constexpr size_t OFF_WRT = OFF_CS16 + al((size_t)64 * 8 * 2 * 4);
constexpr size_t OFF_CNT = OFF_WRT + al((size_t)2 * 36 * 1024 * 4);
constexpr int CNT_STRIDE = 64;
constexpr size_t OFF_BAR = OFF_CNT + al(32 * CNT_STRIDE * 4);
constexpr int XCD_BAR_WORDS = 3456;
constexpr size_t OFF_CTXRES = OFF_BAR + al((size_t)XCD_BAR_WORDS * 4);
constexpr size_t OFF_H = OFF_CTXRES + al((size_t)8 * 256 * 1024 * 4);
constexpr size_t OFF_O = OFF_H + al((size_t)NTOK * 1024 * 2);
constexpr size_t OFF_SSQ = OFF_O + al((size_t)NTOK * 1024 * 2);
constexpr size_t OFF_LIST = OFF_SSQ + al((size_t)NTOK * 8 * 4);
constexpr size_t OFF_WLIST = OFF_LIST + al((size_t)32 * NTOK * 4);
constexpr size_t OFF_R1 = OFF_WLIST + al((size_t)32 * NTOK * 4);
constexpr int PLD = INP;
constexpr size_t OFF_PRAW = OFF_R1;
constexpr size_t OFF_QARAW = OFF_PRAW + (size_t)NTOK * INP * 2;
constexpr size_t OFF_KVARAW = OFF_QARAW + (size_t)NTOK * 512 * 2;
constexpr size_t OFF_VAT = OFF_KVARAW + (size_t)NTOK * 512 * 2;
constexpr size_t OFF_VBT = OFF_VAT + (size_t)NTOK * 256 * 2;
constexpr size_t OFF_VCT = OFF_VBT + (size_t)NTOK * 128 * 2;
constexpr size_t OFF_VDT = OFF_VCT + (size_t)NTOK * 256 * 2;
constexpr size_t OFF_END = OFF_VDT + (size_t)NTOK * 128 * 2;
constexpr size_t OFF_Z = OFF_R1;
constexpr size_t OFF_YPRE = OFF_O;
constexpr size_t OFF_U = OFF_R1;
constexpr size_t OFF_YS = OFF_R1 + al((size_t)UROWS * 256 * 2);
static_assert(OFF_Z + (size_t)NTOK * 4096 * 2 <= OFF_END, "alias overflow");
static_assert(OFF_YS + (size_t)(2 * NTOK + 1) * 1024 * 2 <= OFF_END, "alias overflow");
constexpr size_t WS_NEEDED = OFF_END;
static_assert(WS_NEEDED <= (size_t)536870912, "workspace budget (4 x largest tensor)");

struct Params {
  const float *x, *c, *ctx, *c_ctx, *w_mod, *b_mod, *g_norm_mix, *w_in, *g_q_a, *w_q_b, *g_kv_a, *w_kv_b,
      *sink_b, *rpb_c, *g_q_d, *g_k_d, *w_gate, *b_gate, *w_branch, *w_out, *g_norm_ffn, *w_group, *b_group,
      *w_router, *b_router, *w_ff1, *w_ff3, *w_ff2, *g_final;
  float* out;
  char* ws;
  int ph_begin, ph_end;
};

DEVI int tid_fresh() { int t; asm volatile("v_mov_b32 %0, %1" : "=v"(t) : "v"(__builtin_amdgcn_workitem_id_x())); return t; }
DEVI int bid_fresh() { int t; asm volatile("s_mov_b32 %0, %1" : "=s"(t) : "s"(__builtin_amdgcn_workgroup_id_x())); return t; }
#define TIDX tid_fresh()
#define BIDX bid_fresh()
typedef const __attribute__((address_space(4))) Params* KP;
DEVI unsigned pk2(float a, float b) { f32x2 v = {a, b}; bf16x2_t r = __builtin_convertvector(v, bf16x2_t); return __builtin_bit_cast(unsigned, r); }
DEVI u16 f2bf(float a) { return (u16)(pk2(a, 0.f) & 0xffffu); }
DEVI float bf2f(u16 v) { return __uint_as_float(((unsigned)v) << 16); }
DEVI float wave_sum(float v) {
#pragma unroll
  for (int m = 32; m >= 1; m >>= 1) v += __shfl_xor(v, m);
  return v;
}
template <class T> DEVI T* wsp(KP p, size_t off) { return (T*)(p->ws + off); }
DEVI const float* xrow_in(KP p, int l, int b, int rr) {
  if (l == 0) return (rr < NCTX) ? p->ctx + ((size_t)b * NCTX + rr) * 1024 : p->x + ((size_t)b * SEQ + rr - NCTX) * 1024;
  return (rr < NCTX) ? wsp<float>(p, OFF_CTXRES) + ((size_t)b * NCTX + rr) * 1024 : p->out + ((size_t)b * SEQ + rr - NCTX) * 1024;
}
DEVI float* xrow_res(KP p, int b, int rr) {
  return (rr < NCTX) ? wsp<float>(p, OFF_CTXRES) + ((size_t)b * NCTX + rr) * 1024 : p->out + ((size_t)b * SEQ + rr - NCTX) * 1024;
}
DEVI int perm16(int k) { return (k & ~12) | ((k & 4) << 1) | ((k & 8) >> 1); }

struct ConvT { const float* src; const float* src2; const float* ks; u16* dst; int ld; int ldd; float mul; };
constexpr int CONV_ITEMS = 1152 + 64 + 64 + 2048 + 512 + 512 + 8192 + 4096;
DEVI ConvT conv_decode(KP p, int l, int idx) {
  ConvT c; c.ks = nullptr; c.mul = 1.f; c.src2 = nullptr;
  if (idx < 1152) {
    int nt = idx >> 4, kt = idx & 15, n0 = nt * 32;
    int sc = (n0 < 416) ? n0 : ((n0 < 512) ? -1 : n0 - 96);
    c.ld = 2208; c.ldd = 1024;
    if ((n0 >= 512 && n0 < 768) || (n0 >= 1024 && n0 < 1280)) c.mul = 0.125f * LOG2E;
    c.src = (sc < 0) ? nullptr : p->w_in + (size_t)l * 1024 * 2208 + (size_t)kt * 64 * 2208 + sc;
    c.dst = wsp<u16>(p, OFF_WIN) + (size_t)n0 * 1024 + kt * 64;
    return c;
  }
  idx -= 1152;
  if (idx < 64) {
    int nt = idx >> 2, kt = idx & 3;
    c.ld = 384; c.ldd = 256; c.ks = p->g_q_a + l * 256 + kt * 64;
    c.src = (nt >= 12) ? nullptr : p->w_q_b + (size_t)l * 256 * 384 + (size_t)kt * 64 * 384 + nt * 32;
    c.dst = wsp<u16>(p, OFF_WQB) + (size_t)nt * 32 * 256 + kt * 64;
    return c;
  }
  idx -= 64;
  if (idx < 64) {
    int nt = idx >> 2, kt = idx & 3;
    c.ld = 512; c.ldd = 256; c.ks = (kt < 2) ? p->g_kv_a + l * 128 + kt * 64 : nullptr;
    c.src = (kt >= 2) ? nullptr : p->w_kv_b + (size_t)l * 128 * 512 + (size_t)kt * 64 * 512 + nt * 32;
    c.dst = wsp<u16>(p, OFF_WKVB) + (size_t)nt * 32 * 256 + kt * 64;
    return c;
  }
  idx -= 64;
  if (idx < 2048) {
    int nt = idx >> 4, kt = idx & 15, R0 = nt * 32;
    int pr = R0 >> 11, cb = (R0 & 2047) >> 8, bj = (R0 & 255) >> 7, j0 = R0 & 127;
    c.ld = 1024; c.ldd = 1024;
    c.src = p->w_gate + ((size_t)(l * 4 + 2 * pr + bj) * 1024 + kt * 64) * 1024 + cb * 128 + j0;
    c.dst = wsp<u16>(p, OFF_WGATE) + (size_t)R0 * 1024 + kt * 64;
    return c;
  }
  idx -= 2048;
  if (idx < 512) {
    int br = idx >> 7, nt = (idx >> 2) & 31, kt = idx & 3;
    c.ld = 1024; c.ldd = 256;
    c.src = p->w_branch + ((size_t)(l * 4 + br) * 256 + kt * 64) * 1024 + nt * 32;
    c.dst = wsp<u16>(p, OFF_WBR) + ((size_t)br * 1024 + nt * 32) * 256 + kt * 64;
    return c;
  }
  idx -= 512;
  if (idx < 512) {
    int nt = idx >> 4, kt = idx & 15;
    c.ld = 1024; c.ldd = 1024;
    c.src = p->w_out + ((size_t)l * 1024 + kt * 64) * 1024 + nt * 32;
    c.dst = wsp<u16>(p, OFF_WOUT) + (size_t)nt * 32 * 1024 + kt * 64;
    return c;
  }
  idx -= 512;
  if (idx < 8192) {
    int e = idx >> 8, g32 = (idx >> 4) & 15, kt = idx & 15;
    c.ld = 256; c.ldd = 1024;
    c.src = p->w_ff1 + ((size_t)(l * 32 + e) * 1024 + kt * 64) * 256 + g32 * 16;
    c.src2 = p->w_ff3 + ((size_t)(l * 32 + e) * 1024 + kt * 64) * 256 + g32 * 16;
    c.dst = wsp<u16>(p, OFF_W13) + ((size_t)e * 512 + g32 * 32) * 1024 + kt * 64;
    return c;
  }
  idx -= 8192;
  {
    int e = idx >> 7, nt = (idx >> 2) & 31, kt = idx & 3;
    c.ld = 1024; c.ldd = 256;
    c.src = p->w_ff2 + ((size_t)(l * 32 + e) * 256 + kt * 64) * 1024 + nt * 32;
    c.dst = wsp<u16>(p, OFF_W2) + ((size_t)e * 1024 + nt * 32) * 256 + kt * 64;
    return c;
  }
}
DEVI void modulate_row_store(KP p, int l, int which, const float (&xv)[16], int mrow, u16* hrow, float (&hv)[16]) {
  const int lane = TIDX & 63;
  float ss = 0.f;
#pragma unroll
  for (int i = 0; i < 16; ++i) ss += xv[i] * xv[i];
  ss = wave_sum(ss);
  const float rstd = rsqrtf(ss * (1.f / 1024.f) + EPS);
  const float* g = (which ? p->g_norm_ffn : p->g_norm_mix) + l * 1024;
  const float* mod = wsp<float>(p, OFF_MOD) + ((size_t)l * 9 + mrow) * 6144 + (which ? 3072 : 0);
#pragma unroll
  for (int i = 0; i < 4; ++i) {
    const int c = i * 256 + lane * 4;
    f32x4 gv = *(const f32x4*)(g + c);
    f32x4 sh = *(const f32x4*)(mod + c);
    f32x4 sc = *(const f32x4*)(mod + 1024 + c);
    hv[i * 4 + 0] = xv[i * 4 + 0] * rstd * gv.x * (1.f + sc.x) + sh.x;
    hv[i * 4 + 1] = xv[i * 4 + 1] * rstd * gv.y * (1.f + sc.y) + sh.y;
    hv[i * 4 + 2] = xv[i * 4 + 2] * rstd * gv.z * (1.f + sc.z) + sh.z;
    hv[i * 4 + 3] = xv[i * 4 + 3] * rstd * gv.w * (1.f + sc.w) + sh.w;
    u32x2 o; o.x = pk2(hv[i * 4 + 0], hv[i * 4 + 1]); o.y = pk2(hv[i * 4 + 2], hv[i * 4 + 3]);
    *(u32x2*)(hrow + c) = o;
  }
}
DEVI void load_row16(const float* xr, float (&xv)[16]) {
  const int lane = TIDX & 63;
#pragma unroll
  for (int i = 0; i < 4; ++i) {
    f32x4 v = *(const f32x4*)(xr + i * 256 + lane * 4);
    xv[i * 4 + 0] = v.x; xv[i * 4 + 1] = v.y; xv[i * 4 + 2] = v.z; xv[i * 4 + 3] = v.w;
  }
}
DEVI float router_dot(const float (&hv)[4][16], const float* wrow) {
  const int lane = TIDX & 63;
  const float* w = wrow + lane * 4;
  float pr[4] = {0.f, 0.f, 0.f, 0.f};
#pragma unroll
  for (int i = 0; i < 4; ++i) {
    const f32x4 wv = *(const f32x4*)(w + i * 256);
#pragma unroll
    for (int r = 0; r < 4; ++r)
      pr[r] += hv[r][i * 4] * wv.x + hv[r][i * 4 + 1] * wv.y + hv[r][i * 4 + 2] * wv.z + hv[r][i * 4 + 3] * wv.w;
  }
  const bool up = (lane & 32) != 0;
  float s0 = up ? pr[0] : pr[2], s1 = up ? pr[1] : pr[3];
  float k0 = up ? pr[2] : pr[0], k1 = up ? pr[3] : pr[1];
  k0 += __shfl_xor(s0, 32); k1 += __shfl_xor(s1, 32);
  const bool up2 = (lane & 16) != 0;
  float sv = up2 ? k0 : k1, kv = up2 ? k1 : k0;
  kv += __shfl_xor(sv, 16);
  kv += __shfl_xor(kv, 8); kv += __shfl_xor(kv, 4); kv += __shfl_xor(kv, 2); kv += __shfl_xor(kv, 1);
  return kv;
}
#define XB_TMO      128
#define XB_XCNT(j)  (256  + 64 * (j))
#define XB_XSUB(j)  (1280 + 64 * (j))
#define XB_XGEN(j)  (2304 + 64 * (j))
#define XB_TOP      3328
#define XB_TOPGEN   3392
#define XB_SPIN_CAP (1u << 20)
#define LAS __attribute__((address_space(3)))
DEVI unsigned xb_ld(unsigned* p) { return __hip_atomic_load(p, __ATOMIC_RELAXED, __HIP_MEMORY_SCOPE_AGENT); }
DEVI unsigned xb_add(unsigned* p, unsigned v) { return __hip_atomic_fetch_add(p, v, __ATOMIC_RELAXED, __HIP_MEMORY_SCOPE_AGENT); }
DEVI unsigned xb_xcc_id() { return (unsigned)__builtin_amdgcn_s_getreg((3 << 11) | 20) & 0xFu; }
#define XB_SPIN(cond, bar) do { unsigned _sp = 0; while (cond) { __builtin_amdgcn_s_sleep(1); \
    if ((++_sp & 255u) == 0u) { if (xb_ld(&(bar)[XB_TMO])) break; if (_sp > XB_SPIN_CAP) { atomicAdd(&(bar)[XB_TMO], 1u); break; } } } } while (0)
DEVI void xcd_barrier_post(unsigned* bar) {
  if (TIDX == 0) (void)xb_add(&bar[XB_XCNT(xb_xcc_id())], 1u);
}
DEVI void xcd_barrier_complete(unsigned* bar, unsigned x, unsigned& nloc, unsigned& nx) {
  const unsigned G = gridDim.x * gridDim.y * gridDim.z;
  unsigned sum, cnt, mine, sp = 0u;
  for (;;) {
    sum = 0u; cnt = 0u; mine = 0u;
#pragma unroll
    for (unsigned j = 0; j < 16; ++j) { const unsigned c = xb_ld(&bar[XB_XCNT(j)]); sum += c; cnt += (c > 0u) ? 1u : 0u; mine = (j == x) ? c : mine; }
    if (sum == G) break;
    __builtin_amdgcn_s_sleep(1);
    if ((++sp & 255u) == 0u) { if (xb_ld(&bar[XB_TMO])) break; if (sp > XB_SPIN_CAP) { atomicAdd(&bar[XB_TMO], 1u); break; } }
  }
  nloc = mine > 0u ? mine : 1u; nx = cnt > 0u ? cnt : 1u;
}
DEVI void xcd_barrier(unsigned* bar, volatile LAS unsigned* st) {
  asm volatile("s_waitcnt vmcnt(0)" ::: "memory");
  __syncthreads();
  if (TIDX == 0) {
    const unsigned x = xb_xcc_id();
    __builtin_amdgcn_s_waitcnt(0);
    unsigned nloc = st[0], nx = st[1];
    if (nloc == 0u) { xcd_barrier_complete(bar, x, nloc, nx); st[0] = nloc; st[1] = nx; }
    const unsigned old = xb_add(&bar[XB_XSUB(x)], 1u);
    const unsigned gen = old / nloc;
    if (old + 1u == (gen + 1u) * nloc) {
      __builtin_amdgcn_fence(__ATOMIC_RELEASE, "agent");
      asm volatile("s_waitcnt vmcnt(0)" ::: "memory");
      const unsigned og = xb_add(&bar[XB_TOP], 1u);
      const unsigned tg = og / nx;
      if (og + 1u == (tg + 1u) * nx) xb_add(&bar[XB_TOPGEN], 1u);
      else XB_SPIN(xb_ld(&bar[XB_TOPGEN]) == tg, bar);
      __builtin_amdgcn_fence(__ATOMIC_ACQUIRE, "agent");
      xb_add(&bar[XB_XGEN(x)], 1u);
      asm volatile("s_waitcnt vmcnt(0)" ::: "memory");
    } else {
      XB_SPIN(xb_ld(&bar[XB_XGEN(x)]) == gen, bar);
      __builtin_amdgcn_fence(__ATOMIC_ACQUIRE, "agent");
      asm volatile("s_waitcnt vmcnt(0)" ::: "memory");
    }
  }
  __syncthreads();
}

namespace v2 {
typedef LAS unsigned char* ldsp_t;
constexpr int BM = 256, BK = 64, HALF = 128, HTB = HALF * BK * 2, STAGE_BYTES = 8 * HTB;
constexpr int NW = 8;
constexpr int LDS_XTRA = STAGE_BYTES;
constexpr int LDS_BARW = STAGE_BYTES + 16384;
constexpr int LDS_TOTAL = LDS_BARW + 16;

DEVI int lds_byte(int r, int c) { const int st = (r >> 4) * 2 + (c >> 5), rr = r & 15, cc = c & 31, ob = rr * 64 + cc * 2; return st * 1024 + (ob ^ (((ob >> 9) & 1) << 5)); }
DEVI void stage_rc(int b, int& R, int& C) { const int st = b / 1024, sb = b % 1024, swz = sb ^ (((sb >> 9) & 1) << 5); R = (st >> 1) * 16 + swz / 64; C = (st & 1) * 32 + (swz % 64) / 2; }
DEVI int perm32(int rho) { const int n = rho >> 4, i = rho & 15; return 8 * (i >> 2) + 4 * n + (i & 3); }

struct Unit { const char* A; const char* B; const int* rows; int nvalid; int u0, u1, u2, u3; };

template <bool PERM, bool GATHER, class Epi, class Sched>
DEVI void gemm_phase(ldsp_t lds, int lda_b, int ldb_b, int nt, const Sched& S, const Epi& E) {
  const int tid = TIDX, wid = __builtin_amdgcn_readfirstlane(tid >> 6), lane = tid & 63, wr = wid >> 2, wc = wid & 3, fr = lane & 15, fq = lane >> 4;
  unsigned voffA[2], voffB[2]; int RA[2], CA2[2];
#pragma unroll
  for (int i = 0; i < 2; ++i) {
    int R, C; stage_rc(tid * 16 + i * 8192, R, C);
    const int Rb = PERM ? ((R & ~31) + perm32(R & 31)) : R;
    RA[i] = R; CA2[i] = C * 2;
    voffA[i] = (unsigned)(R * lda_b + C * 2); voffB[i] = (unsigned)(Rb * ldb_b + C * 2);
  }
  const size_t kstep = (size_t)(BK * 2);
  const size_t hstepA = (size_t)HALF * lda_b, hstepB = (size_t)HALF * ldb_b;
  const unsigned ldsw = (unsigned)wid * 1024u;
  const int aoff = lds_byte(wr * 64 + fr, fq * 8), boff = lds_byte(wc * 32 + fr, fq * 8);
#define G_SA(b, h) (((b) * 2 + (h)) * HTB)
#define G_SB(b, h) ((4 + (b) * 2 + (h)) * HTB)
#define G_STAGE(bufoff, gbase, voff) do { _Pragma("unroll") for (int _i = 0; _i < 2; ++_i) \
    __builtin_amdgcn_global_load_lds((const unsigned*)((const char*)(gbase) + (voff)[_i]), (LAS unsigned*)(lds + (bufoff) + ldsw + _i * 8192), 16, 0, 0); } while (0)
#define G_STAGE_A(bufoff, abase, go, h, koff) do { if (GATHER) { _Pragma("unroll") for (int _i = 0; _i < 2; ++_i) \
    __builtin_amdgcn_global_load_lds((const unsigned*)((abase) + (go)[h][_i] + (koff)), (LAS unsigned*)(lds + (bufoff) + ldsw + _i * 8192), 16, 0, 0); } \
    else G_STAGE(bufoff, (abase) + (h) * hstepA + (koff), voffA); } while (0)
#define G_LDA(dst, b, h) do { _Pragma("unroll") for (int m = 0; m < 4; ++m) _Pragma("unroll") for (int k = 0; k < 2; ++k) dst[m][k] = *(const LAS bf16x8*)(lds + G_SA(b, h) + aoff + m * 2048 + k * 1024); } while (0)
#define G_LDB(dst, b, h) do { _Pragma("unroll") for (int n = 0; n < 2; ++n) _Pragma("unroll") for (int k = 0; k < 2; ++k) dst[n][k] = *(const LAS bf16x8*)(lds + G_SB(b, h) + boff + n * 2048 + k * 1024); } while (0)
#define G_MMA(ai, bj, At, Bt) do { __builtin_amdgcn_s_setprio(1); _Pragma("unroll") for (int m = 0; m < 4; ++m) _Pragma("unroll") for (int n = 0; n < 2; ++n) _Pragma("unroll") for (int k = 0; k < 2; ++k) \
    acc[ai][bj][m][n] = __builtin_amdgcn_mfma_f32_16x16x32_bf16(Bt[n][k], At[m][k], acc[ai][bj][m][n], 0, 0, 0); __builtin_amdgcn_s_setprio(0); } while (0)
#define G_WAIT_V(n) asm volatile("s_waitcnt vmcnt(" #n ")" ::: "memory")
#define G_WAIT_L(n) asm volatile("s_waitcnt lgkmcnt(" #n ")" ::: "memory")
#define G_BAR __builtin_amdgcn_s_barrier()
#define G_SCHED __builtin_amdgcn_sched_barrier(0)
  Unit cur, nxt; int ui = 0;
  if (!S.next(0, cur)) return;
  f32x4 acc[2][2][4][2];
#pragma unroll
  for (int a = 0; a < 2; ++a)
#pragma unroll
    for (int b = 0; b < 2; ++b)
#pragma unroll
      for (int m = 0; m < 4; ++m)
#pragma unroll
        for (int n = 0; n < 2; ++n) acc[a][b][m][n] = (f32x4){0.f, 0.f, 0.f, 0.f};
  bf16x8 At[4][2], B0[2][2], B1[2][2];
  unsigned gcur[2][2];
  auto gather_offs = [&](const Unit& u, unsigned (&go)[2][2]) {
#pragma unroll
    for (int h = 0; h < 2; ++h)
#pragma unroll
      for (int i = 0; i < 2; ++i) {
        const int r = h * HALF + RA[i];
        const int t = (r < u.nvalid) ? (u.rows[r] >> 1) : 0;
        go[h][i] = (unsigned)t * (unsigned)lda_b + (unsigned)CA2[i];
      }
  };
  if (GATHER) gather_offs(cur, gcur);
  const char* cA = cur.A; const char* cB = cur.B;
  G_STAGE(G_SB(0, 0), cB, voffB); G_STAGE_A(G_SA(0, 0), cA, gcur, 0, 0); G_STAGE(G_SB(0, 1), cB + hstepB, voffB); G_STAGE_A(G_SA(0, 1), cA, gcur, 1, 0);
  if (wr == 1) G_BAR;
  G_WAIT_V(4); G_BAR;
  G_STAGE(G_SB(1, 0), cB + kstep, voffB); G_STAGE_A(G_SA(1, 0), cA, gcur, 0, kstep); G_STAGE(G_SB(1, 1), cB + hstepB + kstep, voffB);
  G_WAIT_V(6); G_BAR;
  for (;;) {
    const bool has_next = S.next(ui + 1, nxt);
    const char* nA = has_next ? nxt.A : cA; const char* nB = has_next ? nxt.B : cB;
    for (int t = 0; t < nt; t += 2) {
      const bool last = (t == nt - 2);
      const size_t k1 = (size_t)(t + 1) * kstep;
      const char* a2 = last ? nA : cA; const char* b2 = last ? nB : cB + (size_t)(t + 2) * kstep;
      const size_t ka2 = last ? 0 : (size_t)(t + 2) * kstep;
      const char* b3 = b2 + kstep; const size_t ka3 = ka2 + kstep;
      unsigned gN[2][2];
      if (GATHER && last) {
        if (has_next) gather_offs(nxt, gN);
        else {
#pragma unroll
          for (int h = 0; h < 2; ++h)
#pragma unroll
            for (int i = 0; i < 2; ++i) gN[h][i] = gcur[h][i];
        }
      }
#define G_STAGE_A2(bufoff, h, koff) do { if (GATHER) { if (last) G_STAGE_A(bufoff, cA, gN, h, (koff) - ka2); else G_STAGE_A(bufoff, cA, gcur, h, koff); } \
        else G_STAGE_A(bufoff, a2, gcur, h, koff); } while (0)
      G_LDB(B0, 0, 0); G_SCHED; G_LDA(At, 0, 0); G_STAGE_A(G_SA(1, 1), cA, gcur, 1, k1);
      G_WAIT_L(8); G_BAR; G_WAIT_L(0); G_MMA(0, 0, At, B0); G_BAR; G_SCHED;
      G_LDB(B1, 0, 1); G_STAGE(G_SB(0, 0), b2, voffB);
      G_BAR; G_WAIT_L(0); G_MMA(0, 1, At, B1); G_BAR;
      G_LDA(At, 0, 1); G_STAGE_A2(G_SA(0, 0), 0, ka2);
      G_BAR; G_WAIT_L(0); G_MMA(1, 0, At, B0); G_BAR; G_SCHED;
      G_STAGE(G_SB(0, 1), b2 + hstepB, voffB);
      G_WAIT_V(6); G_BAR; G_MMA(1, 1, At, B1); G_BAR;
      G_LDB(B0, 1, 0); G_SCHED; G_LDA(At, 1, 0); G_STAGE_A2(G_SA(0, 1), 1, ka2);
      G_WAIT_L(8); G_BAR; G_WAIT_L(0); G_MMA(0, 0, At, B0); G_BAR; G_SCHED;
      G_LDB(B1, 1, 1); G_STAGE(G_SB(1, 0), b3, voffB);
      G_BAR; G_WAIT_L(0); G_MMA(0, 1, At, B1); G_BAR;
      G_LDA(At, 1, 1); G_STAGE_A2(G_SA(1, 0), 0, ka3);
      G_BAR; G_WAIT_L(0); G_MMA(1, 0, At, B0); G_BAR; G_SCHED;
      G_STAGE(G_SB(1, 1), b3 + hstepB, voffB);
      G_WAIT_V(6); G_BAR; G_MMA(1, 1, At, B1); G_BAR;
      if (GATHER && last) {
#pragma unroll
        for (int h = 0; h < 2; ++h)
#pragma unroll
          for (int i = 0; i < 2; ++i) gcur[h][i] = gN[h][i];
      }
#undef G_STAGE_A2
    }
    G_SCHED;
    E(acc, cur, wr, wc, fr, fq);
    G_SCHED;
    if (!has_next) break;
#pragma unroll
    for (int a = 0; a < 2; ++a)
#pragma unroll
      for (int b = 0; b < 2; ++b)
#pragma unroll
        for (int m = 0; m < 4; ++m)
#pragma unroll
          for (int n = 0; n < 2; ++n) acc[a][b][m][n] = (f32x4){0.f, 0.f, 0.f, 0.f};
    cur = nxt; cA = nA; cB = nB; ++ui;
  }
  G_WAIT_V(0);
  if (wr == 0) G_BAR;
  G_BAR;
#undef G_SA
#undef G_SB
#undef G_STAGE
#undef G_STAGE_A
#undef G_LDA
#undef G_LDB
#undef G_MMA
#undef G_WAIT_V
#undef G_WAIT_L
#undef G_BAR
#undef G_SCHED
}

DEVI bool tile_order(int i, int G, int c, int nM, int nN, int& pm, int& pn) {
  const int nwg = nM * nN;
  const long L = (long)i * G + c; if (L >= nwg) return false;
  int wgid = (int)L; { const int q = nwg / 8, r = nwg % 8, xcd = wgid % 8, off = wgid / 8; wgid = (xcd < r ? xcd * (q + 1) : r * (q + 1) + (xcd - r) * q) + off; }
  const int WGM = 8;
  const int nig = WGM * nN, gid = wgid / nig, fm = gid * WGM, gsz = (nM - fm) < WGM ? (nM - fm) : WGM;
  pm = fm + ((wgid % nig) % gsz); pn = (wgid % nig) / gsz; return true;
}
struct EpiRawBf16 {
  u16* O; int ldc;
  DEVI void operator()(const f32x4 (&acc)[2][2][4][2], const Unit& u, int wr, int wc, int fr, int fq) const {
    const int row0 = u.u0 + wr * 64 + fr, col0 = u.u1 + wc * 32 + 8 * fq;
#pragma unroll
    for (int ai = 0; ai < 2; ++ai)
#pragma unroll
      for (int m = 0; m < 4; ++m) {
        u16* rowp = O + (size_t)(row0 + ai * HALF + m * 16) * ldc + col0;
#pragma unroll
        for (int bj = 0; bj < 2; ++bj) {
          const f32x4 v0 = acc[ai][bj][m][0], v1 = acc[ai][bj][m][1];
          u32x4 w; w.x = pk2(v0[0], v0[1]); w.y = pk2(v0[2], v0[3]); w.z = pk2(v1[0], v1[1]); w.w = pk2(v1[2], v1[3]);
          *(u32x4*)(rowp + bj * HALF) = w;
        }
      }
  }
};

struct SchedB { const char* A; const char* B; int G, c;
  DEVI bool next(int i, Unit& u) const { int pm, pn; if (!tile_order(i, G, c, NTOK / 256, INP / 256, pm, pn)) return false;
    u.A = A + (size_t)pm * 256 * 2048; u.B = B + (size_t)pn * 256 * 2048; u.rows = nullptr; u.nvalid = 0; u.u0 = pm * 256; u.u1 = pn * 256; u.u2 = 0; u.u3 = 0; return true; } };
struct EpiB { u16* O; float* ssq;
  DEVI void operator()(const f32x4 (&acc)[2][2][4][2], const Unit& u, int wr, int wc, int fr, int fq) const {
    EpiRawBf16 E{O, PLD}; E(acc, u, wr, wc, fr, fq);
    if (u.u1 < 512) {
      const bool iskv = u.u1 != 0;
#pragma unroll
      for (int ai = 0; ai < 2; ++ai)
#pragma unroll
        for (int m = 0; m < 4; ++m) {
          float ss = 0.f;
#pragma unroll
          for (int bj = 0; bj < 2; ++bj)
#pragma unroll
            for (int n = 0; n < 2; ++n)
#pragma unroll
              for (int j = 0; j < 4; ++j) { const float v = acc[ai][bj][m][n][j]; if (!(iskv && bj == 1)) ss += v * v; }
          ss += __shfl_xor(ss, 16); ss += __shfl_xor(ss, 32);
          if (fq == 0) ssq[(size_t)(u.u0 + ai * HALF + wr * 64 + m * 16 + fr) * 8 + (iskv ? 4 : 0) + wc] = ss;
        }
    }
  }
};
DEVI void phaseB2(KP p, ldsp_t lds) {
  SchedB S{(const char*)wsp<u16>(p, OFF_H), (const char*)wsp<u16>(p, OFF_WIN), (int)gridDim.x, BIDX};
  EpiB E{wsp<u16>(p, OFF_PRAW), wsp<float>(p, OFF_SSQ)};
  gemm_phase<true, false>(lds, 2048, 2048, 16, S, E);
}
struct SchedC { const char* P; const char* Wq; const char* Wkv; u16* Oq; u16* Okv; int G, c;
  DEVI bool next(int i, Unit& u) const { int pm, pn; if (!tile_order(i, G, c, NTOK / 256, 4, pm, pn)) return false;
    const bool kv = pn >= 2; const int pj = pn & 1;
    u.A = P + (size_t)pm * 256 * (PLD * 2) + (kv ? 512 : 0); u.B = (kv ? Wkv : Wq) + (size_t)pj * 256 * 512; u.rows = nullptr; u.nvalid = 0;
    u.u0 = pm * 256; u.u1 = pj * 256; u.u2 = kv; u.u3 = 0; return true; } };
struct EpiC { u16* Oq; u16* Okv; const float* ssq;
  DEVI void operator()(const f32x4 (&acc)[2][2][4][2], const Unit& u, int wr, int wc, int fr, int fq) const {
    const bool kv = u.u2 != 0;
    u16* O = kv ? Okv : Oq;
    const int row0 = u.u0 + wr * 64 + fr, col0 = u.u1 + wc * 32 + 8 * fq;
#pragma unroll
    for (int ai = 0; ai < 2; ++ai)
#pragma unroll
      for (int m = 0; m < 4; ++m) {
        const size_t r = (size_t)(row0 + ai * HALF + m * 16);
        const f32x4 sq = *(const f32x4*)(ssq + r * 8 + (kv ? 4 : 0));
        const float tot = sq.x + sq.y + sq.z + sq.w;
        const float sc = kv ? rsqrtf(tot * (1.f / 128.f) + EPS) : rsqrtf(tot * (1.f / 256.f) + EPS) * (0.10206207261596575f * LOG2E);
        u16* rowp = O + r * 512 + col0;
#pragma unroll
        for (int bj = 0; bj < 2; ++bj) {
          const f32x4 v0 = acc[ai][bj][m][0] * sc, v1 = acc[ai][bj][m][1] * sc;
          u32x4 w; w.x = pk2(v0[0], v0[1]); w.y = pk2(v0[2], v0[3]); w.z = pk2(v1[0], v1[1]); w.w = pk2(v1[2], v1[3]);
          *(u32x4*)(rowp + bj * HALF) = w;
        }
      }
  }
};
DEVI void phaseC2(KP p, ldsp_t lds) {
  SchedC S{(const char*)wsp<u16>(p, OFF_PRAW), (const char*)wsp<u16>(p, OFF_WQB), (const char*)wsp<u16>(p, OFF_WKVB), nullptr, nullptr, (int)gridDim.x, BIDX};
  EpiC E{wsp<u16>(p, OFF_QARAW), wsp<u16>(p, OFF_KVARAW), wsp<float>(p, OFF_SSQ)};
  int nt = 4; asm volatile("" : "+s"(nt));
  gemm_phase<true, false>(lds, PLD * 2, 512, nt, S, E);
}

DEVI void ld16(const u16* src, float (&v)[16]) {
  const u32x4 a = *(const u32x4*)src, b = *(const u32x4*)(src + 8);
  const unsigned w[8] = {a.x, a.y, a.z, a.w, b.x, b.y, b.z, b.w};
#pragma unroll
  for (int i = 0; i < 8; ++i) { v[2 * i] = __uint_as_float(w[i] << 16); v[2 * i + 1] = __uint_as_float(w[i] & 0xffff0000u); }
}
DEVI void st16(u16* dst, const float (&v)[16]) {
  u32x4 a, b;
  a.x = pk2(v[0], v[1]); a.y = pk2(v[2], v[3]); a.z = pk2(v[4], v[5]); a.w = pk2(v[6], v[7]);
  b.x = pk2(v[8], v[9]); b.y = pk2(v[10], v[11]); b.z = pk2(v[12], v[13]); b.w = pk2(v[14], v[15]);
  *(u32x4*)dst = a; *(u32x4*)(dst + 8) = b;
}
DEVI void rope16c(float (&v)[16], const float* cs16, int pos) {
  const f32x2* t = (const f32x2*)(cs16 + pos * 16);
#pragma unroll
  for (int i = 0; i < 8; ++i) { const f32x2 cs = t[i]; const float x1 = v[i], x2 = v[8 + i]; v[i] = x1 * cs.x - x2 * cs.y; v[8 + i] = x2 * cs.x + x1 * cs.y; }
}
DEVI void rope32c(float (&lo)[16], float (&hi)[16], const float* cs32, int pos) {
  const f32x2* t = (const f32x2*)(cs32 + pos * 32);
#pragma unroll
  for (int i = 0; i < 16; ++i) { const f32x2 cs = t[i]; const float x1 = lo[i], x2 = hi[i]; lo[i] = x1 * cs.x - x2 * cs.y; hi[i] = x2 * cs.x + x1 * cs.y; }
}
DEVI float ssq16(const float (&v)[16]) { float s = 0.f;
#pragma unroll
  for (int i = 0; i < 16; ++i) s += v[i] * v[i];
  return s; }
DEVI void scale16(float (&v)[16], float s) {
#pragma unroll
  for (int i = 0; i < 16; ++i) v[i] *= s; }
DEVI void cvt16(const u32x4 a, const u32x4 b, float (&v)[16]) {
  const unsigned w[8] = {a.x, a.y, a.z, a.w, b.x, b.y, b.z, b.w};
#pragma unroll
  for (int i = 0; i < 8; ++i) { v[2 * i] = __uint_as_float(w[i] << 16); v[2 * i + 1] = __uint_as_float(w[i] & 0xffff0000u); }
}
DEVI void phaseP2(KP p, int l, ldsp_t lds) {
  const int tid = TIDX, tk = tid >> 3, pt = tid & 7;
  u16* PR = wsp<u16>(p, OFF_PRAW);
  u16* QA = wsp<u16>(p, OFF_QARAW);
  const float* cs32 = wsp<float>(p, OFF_CS32);
  const float* cs16 = wsp<float>(p, OFF_CS16);
  const float QS = 0.125f * LOG2E;
  for (int item = BIDX; item < NTOK / 64; item += gridDim.x) {
    const int tok0 = item * 64, rr0 = tok0 % TPB;
    const bool lat = rr0 >= NCTX;
    const size_t tok = (size_t)tok0 + tk;
    const int t = rr0 + tk - NCTX, grow = (t >> 6) & 63, gcol = t & 63;
    u16* pr = PR + tok * PLD;
    u16* qar = QA + tok * 512 + 96 * (pt >> 1) + 64 + 16 * (pt & 1);
    const int g4 = pt & 3;
    u32x4 r_qa[2], r_kr[2], r_qb[4], r_kb[4], r_qd[4], r_kd[4];
#define LD8(ptr) (*(const u32x4*)(ptr))
    if (lat) {
#pragma unroll
      for (int i = 0; i < 2; ++i) { r_qa[i] = LD8(qar + 8 * i); r_kr[i] = LD8(pr + 384 + 16 * (pt & 1) + 8 * i); }
#pragma unroll
      for (int i = 0; i < 4; ++i) { r_qb[i] = LD8(pr + 512 + 32 * pt + 8 * i); r_kb[i] = LD8(pr + 768 + 32 * g4 + 8 * i); }
    }
#pragma unroll
    for (int i = 0; i < 4; ++i) { r_qd[i] = LD8(pr + 1792 + 32 * pt + 8 * i); r_kd[i] = LD8(pr + 2048 + 32 * g4 + 8 * i); }
#undef LD8
    if (lat) {
      { float v[16]; cvt16(r_qa[0], r_qa[1], v); rope16c(v, cs16, (pt & 1) ? gcol : grow); st16(qar, v); }
      if (pt < 2) { float v[16]; cvt16(r_kr[0], r_kr[1], v); rope16c(v, cs16, pt == 0 ? grow : gcol); st16(pr + 384 + 16 * pt, v); }
      { float lo[16], hi[16]; cvt16(r_qb[0], r_qb[1], lo); cvt16(r_qb[2], r_qb[3], hi); rope32c(lo, hi, cs32, (pt & 1) ? gcol : grow); st16(pr + 512 + 32 * pt, lo); st16(pr + 512 + 32 * pt + 16, hi); }
      if (pt < 4) { float lo[16], hi[16]; cvt16(r_kb[0], r_kb[1], lo); cvt16(r_kb[2], r_kb[3], hi); rope32c(lo, hi, cs32, (pt & 1) ? gcol : grow); st16(pr + 768 + 32 * pt, lo); st16(pr + 768 + 32 * pt + 16, hi); }
    }
    {
      float lo[16], hi[16]; cvt16(r_qd[0], r_qd[1], lo); cvt16(r_qd[2], r_qd[3], hi);
      float ss = ssq16(lo) + ssq16(hi); ss += __shfl_xor(ss, 1);
      const float rs = rsqrtf(ss * (1.f / 64.f) + EPS);
      const float* g = p->g_q_d + l * 64 + 32 * (pt & 1);
#pragma unroll
      for (int i = 0; i < 16; ++i) { lo[i] *= rs * g[i]; hi[i] *= rs * g[16 + i]; }
      if (lat) rope32c(lo, hi, cs32, (pt & 1) ? gcol : grow);
      scale16(lo, QS); scale16(hi, QS);
      st16(pr + 1792 + 32 * pt, lo); st16(pr + 1792 + 32 * pt + 16, hi);
    }
    {
      float lo[16], hi[16]; cvt16(r_kd[0], r_kd[1], lo); cvt16(r_kd[2], r_kd[3], hi);
      float ss = ssq16(lo) + ssq16(hi); ss += __shfl_xor(ss, 1);
      const float rs = rsqrtf(ss * (1.f / 64.f) + EPS);
      const float* g = p->g_k_d + l * 64 + 32 * (g4 & 1);
#pragma unroll
      for (int i = 0; i < 16; ++i) { lo[i] *= rs * g[i]; hi[i] *= rs * g[16 + i]; }
      if (lat) rope32c(lo, hi, cs32, (g4 & 1) ? gcol : grow);
      if (pt < 4) { st16(pr + 2048 + 32 * g4, lo); st16(pr + 2048 + 32 * g4 + 16, hi); }
    }
  }
}

template <int BR>
DEVI void attn_mask(f32x16 (&s)[2], int kt, int qlat, int qrow, int qcol, int hh, LAS float* rpb) {
  if (BR == 1) {
#pragma unroll
    for (int kb = 0; kb < 2; ++kb)
#pragma unroll
      for (int i = 0; i < 16; ++i) {
        const int kpos = kt * 64 + kb * 32 + (i & 3) + 8 * (i >> 2) + 4 * hh;
        const int d = qlat - kpos;
        if (d > 128 || d < -128) s[kb][i] = -1e30f;
      }
  } else {
    const int rs = min(max(qrow - 4, 0), 56);
    const bool row_ok = (kt >= rs) && (kt < rs + 8);
    const int cst = min(max(qcol - 8, 0), 48);
    const int dr = kt - qrow + 7;
#pragma unroll
    for (int kb = 0; kb < 2; ++kb)
#pragma unroll
      for (int i = 0; i < 16; ++i) {
        const int kc = kb * 32 + (i & 3) + 8 * (i >> 2) + 4 * hh;
        const bool ok = row_ok && (kc >= cst) && (kc < cst + 16);
        const int idx = ok ? (dr * 31 + (kc - qcol + 15)) : 0;
        const float bias = rpb[idx];
        s[kb][i] = ok ? (s[kb][i] + bias) : -1e30f;
      }
  }
}

typedef short v4i16_t __attribute__((ext_vector_type(4)));
DEVI bf16x8 vtr2(ldsp_t a) {
  const v4i16_t lo = __builtin_amdgcn_ds_read_tr16_b64_v4i16((LAS v4i16_t*)a);
  const v4i16_t hi = __builtin_amdgcn_ds_read_tr16_b64_v4i16((LAS v4i16_t*)(a + 8 * 144));
  return __builtin_shufflevector(lo, hi, 0, 1, 2, 3, 4, 5, 6, 7);
}
template <int BR>
DEVI void attn_item2(KP p, int l, int b, int hs, int qb, bool isctx, ldsp_t lds) {
  constexpr bool MLA = (BR == 0);
  constexpr bool GQA = (BR == 1 || BR == 3);
  constexpr int QBLK = GQA ? 256 : 512;
  constexpr int NKS = MLA ? 6 : 4;
  constexpr int STG = 9216 + 9216 + 5120;
  const int tid = TIDX, lane = tid & 63, wave = __builtin_amdgcn_readfirstlane(tid >> 6);
  const int r32 = lane & 31, hh = lane >> 5;
  const int hq = GQA ? (hs * 2 + (wave & 1)) : hs;
  const int woff = GQA ? 64 * (wave >> 1) : 64 * wave;
  const int q0 = (isctx ? 0 : NCTX) + qb * QBLK;
  const bool active = !isctx || (woff < NCTX);
  const size_t tokq = (size_t)b * TPB + q0 + (active ? woff : 0) + r32;
  const u16* Qp; const u16* Kp; int ldk; const u16* Vp; int ldv; int obase; int ldq;
  const u16* PR = wsp<u16>(p, OFF_PRAW);
  if (BR == 0) { Qp = wsp<u16>(p, OFF_QARAW) + tokq * 512 + hq * 96; ldq = 512; Kp = wsp<u16>(p, OFF_KVARAW) + (size_t)b * TPB * 512 + hs * 128; ldk = 512; Vp = wsp<u16>(p, OFF_KVARAW) + (size_t)b * TPB * 512 + hs * 128 + 64; ldv = 512; obase = hq * 64; }
  else if (BR == 1) { Qp = PR + tokq * PLD + 512 + hq * 64; ldq = PLD; Kp = PR + (size_t)b * TPB * PLD + 768 + hs * 64; ldk = PLD; Vp = PR + (size_t)b * TPB * PLD + 896 + hs * 64; ldv = PLD; obase = 256 + hq * 64; }
  else if (BR == 2) { Qp = PR + tokq * PLD + 1024 + hq * 64; ldq = PLD; Kp = PR + (size_t)b * TPB * PLD + 1280 + hs * 64; ldk = PLD; Vp = PR + (size_t)b * TPB * PLD + 1536 + hs * 64; ldv = PLD; obase = 512 + hq * 64; }
  else { Qp = PR + tokq * PLD + 1792 + hq * 64; ldq = PLD; Kp = PR + (size_t)b * TPB * PLD + 2048 + hs * 64; ldk = PLD; Vp = PR + (size_t)b * TPB * PLD + 2176 + hs * 64; ldv = PLD; obase = 768 + hq * 64; }
  const u16* KRp = PR + (size_t)b * TPB * PLD + 384;
  int lat_lo = 0, lat_n = 0, wlo = 0, whi = 63;
  if (!isctx) {
    if (BR == 0 || BR == 3) { lat_lo = 0; lat_n = 64; }
    else if (BR == 1) {
      const int ql = qb * QBLK; const int lo = max(0, ql - 128) >> 6, hi = min(SEQ - 1, ql + QBLK - 1 + 128) >> 6; lat_lo = lo; lat_n = hi - lo + 1;
      const int wq = ql + woff; wlo = max(0, wq - 128) >> 6; whi = min(SEQ - 1, wq + 63 + 128) >> 6;
    } else {
      const int r0 = 8 * qb; const int lo = min(max(r0 - 4, 0), 56), hi = min(max(r0 + 7 - 4, 0), 56) + 7; lat_lo = lo; lat_n = hi - lo + 1;
      const int wr_ = r0 + wave; wlo = min(max(wr_ - 4, 0), 56); whi = wlo + 7;
    }
  }
  const int NT = 4 + lat_n;
  const int qlat0 = qb * QBLK + woff + r32;
  bf16x8 qf[2][NKS];
#pragma unroll
  for (int qi = 0; qi < 2; ++qi)
#pragma unroll
    for (int ks = 0; ks < NKS; ++ks) qf[qi][ks] = *(const bf16x8*)(Qp + (size_t)qi * 32 * ldq + ks * 16 + hh * 8);
  const int srow = tid >> 3, sc8 = (tid & 7) * 8;
  const int krow_ = (tid & 255) >> 2, kc8 = (tid & 3) * 8;
  const bool krt = tid < 256;
  u32x4 rk0, rv0, rr0, rk1, rv1, rr1;
  auto keytile = [&](int j) { return (j < 4) ? j : (4 + lat_lo + (j - 4)); };
#define A_GLOAD(j, rk, rv, rr) do { const int key0_ = keytile(j) * 64; \
    rk = *(const u32x4*)(Kp + (size_t)(key0_ + srow) * ldk + sc8); \
    rv = *(const u32x4*)(Vp + (size_t)(key0_ + srow) * ldv + sc8); \
    if (MLA && krt) rr = *(const u32x4*)(KRp + (size_t)(key0_ + krow_) * PLD + kc8); } while (0)
#define A_LWRITE(st, rk, rv, rr) do { ldsp_t base_ = lds + (st) * STG; \
    *(LAS u32x4*)(base_ + srow * 144 + sc8 * 2) = rk; \
    *(LAS u32x4*)(base_ + 9216 + srow * 144 + sc8 * 2) = rv; \
    if (MLA && krt) *(LAS u32x4*)(base_ + 18432 + krow_ * 80 + kc8 * 2) = rr; } while (0)
  LAS float* rpb = (LAS float*)(lds + 2 * STG);
  A_GLOAD(0, rk0, rv0, rr0);
  if (NT > 1) A_GLOAD(1, rk1, rv1, rr1);
  __syncthreads();
  if (BR == 2 && !isctx) {
    const float* src = p->rpb_c + (size_t)(l * 4 + hs) * 465;
    for (int i = tid; i < 465; i += 512) rpb[i] = src[i] * LOG2E;
  }
  A_LWRITE(0, rk0, rv0, rr0);
  __syncthreads();
  f32x16 o[2][2];
#pragma unroll
  for (int qi = 0; qi < 2; ++qi)
#pragma unroll
    for (int i = 0; i < 16; ++i) { o[qi][0][i] = 0.f; o[qi][1][i] = 0.f; }
  float m_run[2], l_run[2];
#pragma unroll
  for (int qi = 0; qi < 2; ++qi) { m_run[qi] = -INFINITY; l_run[qi] = 0.f; }
  if (BR == 1) { const float sk = p->sink_b[l * 4 + hq] * LOG2E; m_run[0] = sk; m_run[1] = sk; l_run[0] = (hh == 0) ? 1.f : 0.f; l_run[1] = l_run[0]; }
  const ldsp_t kfb = lds + r32 * 144 + hh * 16;
  const ldsp_t vfb = lds + 9216 + (4 * hh + ((lane & 15) >> 2)) * 144 + (16 * ((lane >> 4) & 1) + 4 * (lane & 3)) * 2;
  const ldsp_t krb = lds + 18432 + r32 * 80 + hh * 16;
#define A_STEP(j, rkA, rvA, rrA, rkB, rvB, rrB) do { \
    const int st = ((j) & 1) * STG; \
    if ((j) + 2 < NT) A_GLOAD((j) + 2, rkA, rvA, rrA); \
    const int kt_ = lat_lo + (j) - 4; \
    const bool need = active && ((j) < 4 || (kt_ >= wlo && kt_ <= whi)); \
    if (need) { \
      f32x16 s[2][2]; \
      _Pragma("unroll") for (int kb = 0; kb < 2; ++kb) { \
        _Pragma("unroll") for (int ks = 0; ks < 4; ++ks) { const bf16x8 kf = *(const LAS bf16x8*)(kfb + st + kb * 32 * 144 + ks * 32); \
          _Pragma("unroll") for (int qi = 0; qi < 2; ++qi) { if (ks == 0) { _Pragma("unroll") for (int i = 0; i < 16; ++i) s[qi][kb][i] = 0.f; } s[qi][kb] = MFMA(kf, qf[qi][ks], s[qi][kb]); } } \
        if (MLA) { _Pragma("unroll") for (int ks = 0; ks < 2; ++ks) { const bf16x8 kf = *(const LAS bf16x8*)(krb + st + kb * 32 * 80 + ks * 32); \
          _Pragma("unroll") for (int qi = 0; qi < 2; ++qi) s[qi][kb] = MFMA(kf, qf[qi][NKS - 2 + ks], s[qi][kb]); } } \
      } \
      _Pragma("unroll") for (int qi = 0; qi < 2; ++qi) { \
        if ((BR == 1 || BR == 2) && (j) >= 4) { const int ql_ = qlat0 + 32 * qi; attn_mask<BR>(s[qi], kt_, ql_, ql_ >> 6, ql_ & 63, hh, rpb); } \
        float mx = s[qi][0][0]; \
        _Pragma("unroll") for (int i = 1; i < 16; ++i) mx = fmaxf(mx, s[qi][0][i]); \
        _Pragma("unroll") for (int i = 0; i < 16; ++i) mx = fmaxf(mx, s[qi][1][i]); \
        mx = fmaxf(mx, __shfl_xor(mx, 32)); \
        const float m_new = fmaxf(m_run[qi], mx); \
        const float alpha = __builtin_amdgcn_exp2f(m_run[qi] - m_new); \
        m_run[qi] = m_new; \
        float ls0 = 0.f, ls1 = 0.f; \
        _Pragma("unroll") for (int i = 0; i < 16; ++i) { \
          const float e0 = __builtin_amdgcn_exp2f(s[qi][0][i] - m_new), e1 = __builtin_amdgcn_exp2f(s[qi][1][i] - m_new); \
          s[qi][0][i] = e0; s[qi][1][i] = e1; ls0 += e0; ls1 += e1; } \
        l_run[qi] = l_run[qi] * alpha + (ls0 + ls1); \
        if (__any(alpha != 1.f)) { _Pragma("unroll") for (int i = 0; i < 16; ++i) { o[qi][0][i] *= alpha; o[qi][1][i] *= alpha; } } \
      } \
      _Pragma("unroll") for (int s4 = 0; s4 < 4; ++s4) { \
        const int kb = s4 >> 1, rb = (s4 & 1) * 8; \
        bf16x8 pf[2]; \
        _Pragma("unroll") for (int qi = 0; qi < 2; ++qi) { u32x4 pw; \
          pw.x = pk2(s[qi][kb][rb + 0], s[qi][kb][rb + 1]); pw.y = pk2(s[qi][kb][rb + 2], s[qi][kb][rb + 3]); \
          pw.z = pk2(s[qi][kb][rb + 4], s[qi][kb][rb + 5]); pw.w = pk2(s[qi][kb][rb + 6], s[qi][kb][rb + 7]); \
          pf[qi] = __builtin_bit_cast(bf16x8, pw); } \
        _Pragma("unroll") for (int db = 0; db < 2; ++db) { const bf16x8 vf = vtr2(vfb + st + s4 * 16 * 144 + db * 64); \
          o[0][db] = MFMA(vf, pf[0], o[0][db]); o[1][db] = MFMA(vf, pf[1], o[1][db]); } \
      } \
    } \
    if ((j) + 1 < NT) A_LWRITE(((j) + 1) & 1, rkB, rvB, rrB); \
    __syncthreads(); \
  } while (0)
  for (int j = 0; j < NT; j += 2) {
    A_STEP(j, rk0, rv0, rr0, rk1, rv1, rr1);
    if (j + 1 < NT) A_STEP(j + 1, rk1, rv1, rr1, rk0, rv0, rr0);
  }
#undef A_STEP
#undef A_GLOAD
#undef A_LWRITE
  if (active) {
#pragma unroll
    for (int qi = 0; qi < 2; ++qi) {
      const float lt = l_run[qi] + __shfl_xor(l_run[qi], 32);
      const float inv = 1.f / lt;
      u16* Op = wsp<u16>(p, OFF_O) + (tokq + 32 * qi) * 1024 + obase;
#pragma unroll
      for (int db = 0; db < 2; ++db)
#pragma unroll
        for (int g = 0; g < 4; ++g) {
          u32x2 w;
          w.x = pk2(o[qi][db][4 * g] * inv, o[qi][db][4 * g + 1] * inv);
          w.y = pk2(o[qi][db][4 * g + 2] * inv, o[qi][db][4 * g + 3] * inv);
          *(u32x2*)(Op + db * 32 + 8 * g + 4 * hh) = w;
        }
    }
  }
}
DEVI void phaseD2(KP p, int l, ldsp_t lds) {
  const int G8 = gridDim.x >> 3, xcd = BIDX & 7, lb = BIDX >> 3;
  if (lb >= G8) return;
  const int NLOC = 128 + (l == 0 ? 12 : 0);
  for (int n = lb; n < NLOC; n += G8) {
    int br, s, qb; bool isctx = false;
    if (n < 32) { br = 0; s = xcd + 8 * (n >> 3); qb = n & 7; }
    else if (n < 64) { const int m = n - 32; br = 3; s = xcd + 8 * (m >> 4); qb = m & 15; }
    else if (n < 96) { const int m = n - 64; br = 2; s = xcd + 8 * (m >> 3); qb = m & 7; }
    else if (n < 128) { const int m = n - 96; br = 1; s = xcd + 8 * (m >> 4); qb = m & 15; }
    else {
      const int m = n - 128; isctx = true; qb = 0;
      if (m < 4) { br = 0; s = xcd + 8 * m; }
      else if (m < 6) { br = 3; s = xcd + 8 * (m - 4); }
      else if (m < 10) { br = 2; s = xcd + 8 * (m - 6); }
      else { br = 1; s = xcd + 8 * (m - 10); }
    }
    if (br == 0) attn_item2<0>(p, l, s >> 2, s & 3, qb, isctx, lds);
    else if (br == 1) attn_item2<1>(p, l, s >> 1, s & 1, qb, isctx, lds);
    else if (br == 2) attn_item2<2>(p, l, s >> 2, s & 3, qb, isctx, lds);
    else attn_item2<3>(p, l, s >> 1, s & 1, qb, isctx, lds);
  }
}

DEVI int pm_map(int pme, bool skipctx) { return skipctx ? (pme >> 4) * 17 + 1 + (pme & 15) : pme; }
struct SchedE1 { const char* O; const char* W; bool skipctx; int G, c;
  DEVI bool next(int i, Unit& u) const { int pm, pn; if (!tile_order(i, G, c, skipctx ? 128 : 136, 16, pm, pn)) return false;
    pm = pm_map(pm, skipctx); const int n = pn >> 2, cq = pn & 3;
    u.A = O + (size_t)pm * 256 * 2048 + n * 512; u.B = W + ((size_t)n * 1024 + cq * 256) * 512; u.rows = nullptr; u.nvalid = 0;
    u.u0 = pm * 256; u.u1 = pn * 256; u.u2 = 0; u.u3 = 0; return true; } };
DEVI void phaseE1(KP p, int l, ldsp_t lds) {
  if (BIDX == 0 && TIDX < 32) wsp<int>(p, OFF_CNT)[TIDX * CNT_STRIDE] = 0;
  SchedE1 S{(const char*)wsp<u16>(p, OFF_O), (const char*)wsp<u16>(p, OFF_WBR), l == 1, (int)gridDim.x, BIDX};
  EpiRawBf16 E{wsp<u16>(p, OFF_Z), 4096};
  int nt = 4; asm volatile("" : "+s"(nt));
  gemm_phase<true, false>(lds, 2048, 512, nt, S, E);
}
struct SchedE2 { const char* H; const char* W; bool skipctx; int G, c;
  DEVI bool next(int i, Unit& u) const { int pm, pn; if (!tile_order(i >> 1, G, c, skipctx ? 128 : 136, 8, pm, pn)) return false;
    pm = pm_map(pm, skipctx); const int pr = i & 1;
    u.A = H + (size_t)pm * 256 * 2048; u.B = W + (size_t)(pr * 8 + pn) * 256 * 2048; u.rows = nullptr; u.nvalid = 0;
    u.u0 = pm * 256; u.u1 = pn * 128; u.u2 = pr; u.u3 = 0; return true; } };
struct EpiE2 { const u16* Z; u16* Y; const float* bias;
  DEVI void operator()(const f32x4 (&acc)[2][2][4][2], const Unit& u, int wr, int wc, int fr, int fq) const {
    const int row0 = u.u0 + wr * 64 + fr, col0 = u.u1 + wc * 32 + 8 * fq, pr = u.u2;
    f32x4 bv[2][2];
#pragma unroll
    for (int bj = 0; bj < 2; ++bj)
#pragma unroll
      for (int nn = 0; nn < 2; ++nn) bv[bj][nn] = *(const f32x4*)(bias + (2 * pr + bj) * 1024 + col0 + 4 * nn);
#pragma unroll
    for (int ai = 0; ai < 2; ++ai)
#pragma unroll
      for (int m = 0; m < 4; ++m) {
        const size_t r = (size_t)(row0 + ai * HALF + m * 16);
        float t[8];
#pragma unroll
        for (int j = 0; j < 8; ++j) t[j] = 0.f;
        if (pr) {
          const u32x4 y = *(const u32x4*)(Y + r * 1024 + col0);
          const unsigned w[4] = {y.x, y.y, y.z, y.w};
#pragma unroll
          for (int i = 0; i < 4; ++i) { t[2 * i] = __uint_as_float(w[i] << 16); t[2 * i + 1] = __uint_as_float(w[i] & 0xffff0000u); }
        }
#pragma unroll
        for (int bj = 0; bj < 2; ++bj) {
          const u32x4 z = *(const u32x4*)(Z + r * 4096 + (2 * pr + bj) * 1024 + col0);
          const unsigned w[4] = {z.x, z.y, z.z, z.w};
#pragma unroll
          for (int nn = 0; nn < 2; ++nn)
#pragma unroll
            for (int j = 0; j < 4; ++j) {
              const int e = 4 * nn + j;
              const float zz = (e & 1) ? __uint_as_float(w[e >> 1] & 0xffff0000u) : __uint_as_float(w[e >> 1] << 16);
              const float g = 1.f / (1.f + __expf(-(acc[ai][bj][m][nn][j] + bv[bj][nn][j])));
              t[e] += g * zz;
            }
        }
        u32x4 o; o.x = pk2(t[0], t[1]); o.y = pk2(t[2], t[3]); o.z = pk2(t[4], t[5]); o.w = pk2(t[6], t[7]);
        *(u32x4*)(Y + r * 1024 + col0) = o;
      }
  }
};
DEVI void phaseE2(KP p, int l, ldsp_t lds) {
  SchedE2 S{(const char*)wsp<u16>(p, OFF_H), (const char*)wsp<u16>(p, OFF_WGATE), l == 1, (int)gridDim.x, BIDX};
  EpiE2 E{wsp<u16>(p, OFF_Z), wsp<u16>(p, OFF_YPRE), p->b_gate + (size_t)l * 4 * 1024};
  gemm_phase<true, false>(lds, 2048, 2048, 16, S, E);
}
struct SchedF { const char* Y; const char* W; bool skipctx; int G, c;
  DEVI bool next(int i, Unit& u) const { int pm, pn; if (!tile_order(i, G, c, skipctx ? 128 : 136, 4, pm, pn)) return false;
    pm = pm_map(pm, skipctx);
    u.A = Y + (size_t)pm * 256 * 2048; u.B = W + (size_t)pn * 256 * 2048; u.rows = nullptr; u.nvalid = 0;
    u.u0 = pm; u.u1 = pn * 256; u.u2 = 0; u.u3 = 0; return true; } };
struct EpiF { KP p; int l;
  DEVI void operator()(const f32x4 (&acc)[2][2][4][2], const Unit& u, int wr, int wc, int fr, int fq) const {
    const int pm = u.u0, b = pm / 17, rr0 = (pm % 17) * 256;
    const int mrow = (rr0 < NCTX) ? 8 : b;
    const int col0 = u.u1 + wc * 32 + 4 * fq;
    const float* gt = wsp<float>(p, OFF_MOD) + ((size_t)l * 9 + mrow) * 6144 + 2048 + col0;
    const float* xin = xrow_in(p, l, b, rr0) + col0;
    float* xout = xrow_res(p, b, rr0) + col0;
    f32x4 gv[2][2];
#pragma unroll
    for (int bj = 0; bj < 2; ++bj)
#pragma unroll
      for (int n = 0; n < 2; ++n) gv[bj][n] = *(const f32x4*)(gt + bj * HALF + n * 16);
#pragma unroll
    for (int ai = 0; ai < 2; ++ai)
#pragma unroll
      for (int m = 0; m < 4; ++m) {
        const size_t ro = (size_t)(wr * 64 + fr + ai * HALF + m * 16) * 1024;
#pragma unroll
        for (int bj = 0; bj < 2; ++bj)
#pragma unroll
          for (int n = 0; n < 2; ++n) {
            const f32x4 xo = *(const f32x4*)(xin + ro + bj * HALF + n * 16);
            *(f32x4*)(xout + ro + bj * HALF + n * 16) = xo + gv[bj][n] * acc[ai][bj][m][n];
          }
      }
  }
};
DEVI void phaseF2(KP p, int l, ldsp_t lds) {
  SchedF S{(const char*)wsp<u16>(p, OFF_YPRE), (const char*)wsp<u16>(p, OFF_WOUT), l == 1, (int)gridDim.x, BIDX};
  EpiF E{p, l};
  gemm_phase<false, false>(lds, 2048, 2048, 16, S, E);
}


DEVI void conv_tile_wave(const ConvT& c, LAS float* t, int lane) {
  const int kk = lane >> 3, n4 = (lane & 7) * 4;
  const float* sp = (c.src2 && n4 >= 16) ? c.src2 + (n4 - 16) : (c.src ? c.src + n4 : nullptr);
  f32x4 v[8];
#pragma unroll
  for (int i = 0; i < 8; ++i) v[i] = sp ? *(const f32x4*)(sp + (size_t)(kk + 8 * i) * c.ld) : f32x4{0.f, 0.f, 0.f, 0.f};
#pragma unroll
  for (int i = 0; i < 8; ++i) {
    const int k = kk + 8 * i;
    const float s = (c.ks ? c.ks[k] : 1.f) * c.mul;
    t[(n4 + 0) * 65 + k] = v[i].x * s; t[(n4 + 1) * 65 + k] = v[i].y * s;
    t[(n4 + 2) * 65 + k] = v[i].z * s; t[(n4 + 3) * 65 + k] = v[i].w * s;
  }
  asm volatile("s_waitcnt lgkmcnt(0)" ::: "memory");
  const int n = lane >> 1, k0 = (lane & 1) * 32;
  const LAS float* r = t + n * 65 + k0;
  u16* d = c.dst + (size_t)n * c.ldd + k0;
#pragma unroll
  for (int q = 0; q < 4; ++q) {
    u32x4 o;
    o.x = pk2(r[8 * q], r[8 * q + 1]); o.y = pk2(r[8 * q + 2], r[8 * q + 3]); o.z = pk2(r[8 * q + 4], r[8 * q + 5]); o.w = pk2(r[8 * q + 6], r[8 * q + 7]);
    *(u32x4*)(d + 8 * q) = o;
  }
  asm volatile("s_waitcnt lgkmcnt(0)" ::: "memory");
}
DEVI void conv_items2(KP p, int l, ldsp_t lds, int first_item, int total_items) {
  const int tid = TIDX, wave = __builtin_amdgcn_readfirstlane(tid >> 6), lane = tid & 63;
  LAS float* t = (LAS float*)(lds + wave * 8448);
  __syncthreads();
  for (int item = BIDX * NW + wave; item < total_items; item += gridDim.x * NW) {
    ConvT c = conv_decode(p, l, item - first_item);
    conv_tile_wave(c, t, lane);
  }
}
DEVI void phase0_2(KP p, ldsp_t lds) {
  const int tid = TIDX, half = tid >> 8, htid = tid & 255;
  for (int it = BIDX * 2; it < 458; it += gridDim.x * 2) {
    const int item = it + half;
    LAS float* sc = (LAS float*)(lds + half * 16384);
    const bool ismod = item < 384;
    const int l = item / 192, rem = item % 192, cgp = rem >> 3, kc = rem & 7;
    __syncthreads();
    if (ismod) {
      for (int i = htid; i < 9 * 128; i += 256) {
        int b = i >> 7, k = i & 127;
        float v = (b < 8) ? p->c[b * 1024 + kc * 128 + k] : p->c_ctx[kc * 128 + k];
        sc[i] = v / (1.f + expf(-v));
      }
    }
    __syncthreads();
    if (ismod) {
      float acc[9];
#pragma unroll
      for (int b = 0; b < 9; ++b) acc[b] = 0.f;
      const float* w = p->w_mod + ((size_t)l * 1024 + kc * 128) * 6144 + cgp * 256 + htid;
#pragma unroll 8
      for (int k = 0; k < 128; ++k) {
        float wv = w[(size_t)k * 6144];
#pragma unroll
        for (int b = 0; b < 9; ++b) acc[b] += sc[b * 128 + k] * wv;
      }
      float* dst = wsp<float>(p, OFF_MODP) + (size_t)((kc * 2 + l) * 9) * 6144 + cgp * 256 + htid;
#pragma unroll
      for (int b = 0; b < 9; ++b) dst[(size_t)b * 6144] = acc[b];
    } else if (item == 384) {
      float* cs32 = wsp<float>(p, OFF_CS32);
      float* cs16 = wsp<float>(p, OFF_CS16);
      for (int t = htid; t < 1024; t += 256) {
        int pos = t >> 4, i = t & 15;
        float ang = (float)pos * powf(10000.f, -(float)(2 * i) / 32.f);
        cs32[t * 2] = cosf(ang); cs32[t * 2 + 1] = sinf(ang);
      }
      for (int t = htid; t < 512; t += 256) {
        int pos = t >> 3, i = t & 7;
        float ang = (float)pos * powf(10000.f, -(float)(2 * i) / 16.f);
        cs16[t * 2] = cosf(ang); cs16[t * 2 + 1] = sinf(ang);
      }
    } else if (item < 457) {
      const int q = item - 385, ll = q / 36, o = q % 36;
      float* dst = wsp<float>(p, OFF_WRT) + ((size_t)ll * 36 + o) * 1024;
      for (int k = htid; k < 1024; k += 256)
        dst[k] = (o < 4) ? p->w_group[((size_t)ll * 1024 + k) * 4 + o] : p->w_router[((size_t)ll * 1024 + k) * 32 + (o - 4)];
    }
  }
  conv_items2(p, 0, lds, 0, CONV_ITEMS);
}
DEVI void phase1_2(KP p) {
  const float* mp = wsp<float>(p, OFF_MODP);
  float* mo = wsp<float>(p, OFF_MOD);
  for (int i = BIDX * 512 + TIDX; i < 2 * 9 * 6144; i += gridDim.x * 512) {
    int l = i / (9 * 6144), o = i % 6144;
    float s = p->b_mod[l * 6144 + o];
#pragma unroll
    for (int kc = 0; kc < 8; ++kc) s += mp[(size_t)kc * 2 * 9 * 6144 + i];
    mo[i] = s;
  }
}
DEVI void phaseA2(KP p) {
  const int gw = BIDX * NW + (TIDX >> 6), nw = gridDim.x * NW;
  u16* H = wsp<u16>(p, OFF_H);
  for (int tok0 = gw; tok0 < NTOK; tok0 += 2 * nw) {
    float xv[2][16];
#pragma unroll
    for (int r = 0; r < 2; ++r) { const int tok = tok0 + r * nw; if (tok < NTOK) load_row16(xrow_in(p, 0, tok / TPB, tok % TPB), xv[r]); }
#pragma unroll
    for (int r = 0; r < 2; ++r) {
      const int tok = tok0 + r * nw;
      if (tok < NTOK) { float hv[16]; modulate_row_store(p, 0, 0, xv[r], (tok % TPB) < NCTX ? 8 : tok / TPB, H + (size_t)tok * 1024, hv); }
    }
  }
}
DEVI void phaseG2(KP p, int l, ldsp_t lds) {
  constexpr int HS = 1026;
  const int tid = TIDX, lane = tid & 63, wave = __builtin_amdgcn_readfirstlane(tid >> 6);
  const int r32 = lane & 31, kh = lane >> 5, qd = lane >> 4;
  u16* H = wsp<u16>(p, OFF_H);
  const float* WRT = wsp<float>(p, OFF_WRT) + (size_t)l * 36 * 1024;
  int* cnt = wsp<int>(p, OFF_CNT);
  int* list = wsp<int>(p, OFF_LIST);
  float* wlist = wsp<float>(p, OFF_WLIST);
  LAS float* h2t = (LAS float*)lds;
  LAS float* part = (LAS float*)lds;
  LAS int* gsel = (LAS int*)(lds + 32 * HS * 4);
  LAS float* gwt = (LAS float*)(lds + 32 * HS * 4 + 128);
  float wreg[64];
  {
    const float* wr = p->w_router + (size_t)l * 1024 * 32 + r32;
#pragma unroll
    for (int t = 0; t < 32; ++t) {
      const int k = 128 * wave + 4 * t + 2 * kh;
      wreg[2 * t] = wr[(size_t)k * 32]; wreg[2 * t + 1] = wr[(size_t)(k + 1) * 32];
    }
  }
  for (int tile = BIDX; tile < NTOK / 32; tile += gridDim.x) {
    const int tok0 = tile * 32, b = tok0 / TPB, rr0 = tok0 % TPB;
    if (l == 1 && rr0 < NCTX) continue;
    {
      float hv[4][16];
#pragma unroll
      for (int r = 0; r < 4; ++r) {
        float xv[16];
        load_row16(xrow_res(p, b, rr0 + wave * 4 + r), xv);
        modulate_row_store(p, l, 1, xv, (rr0 < NCTX) ? 8 : b, H + (size_t)(tok0 + wave * 4 + r) * 1024, hv[r]);
        LAS float* dst = h2t + (wave * 4 + r) * HS + lane * 4;
#pragma unroll
        for (int i = 0; i < 4; ++i) {
          *(LAS f32x2*)(dst + i * 256) = f32x2{hv[r][i * 4], hv[r][i * 4 + 1]};
          *(LAS f32x2*)(dst + i * 256 + 2) = f32x2{hv[r][i * 4 + 2], hv[r][i * 4 + 3]};
        }
      }
      float gl[4];
#pragma unroll
      for (int o = 0; o < 4; ++o) gl[o] = router_dot(hv, WRT + (size_t)o * 1024) + p->b_group[l * 4 + o];
      int gs = 0; float best = gl[0];
#pragma unroll
      for (int j = 1; j < 4; ++j) if (gl[j] > best) { best = gl[j]; gs = j; }
      float gsum = 0.f;
#pragma unroll
      for (int j = 0; j < 4; ++j) gsum += expf(gl[j] - best);
      if ((lane & 15) == 0) { gsel[wave * 4 + qd] = gs; gwt[wave * 4 + qd] = 1.f / gsum; }
    }
    __syncthreads();
    f32x16 acc;
#pragma unroll
    for (int i = 0; i < 16; ++i) acc[i] = 0.f;
    {
      const LAS float* ap = h2t + r32 * HS + 128 * wave + 2 * kh;
#pragma unroll
      for (int t = 0; t < 32; ++t) {
        const f32x2 a = *(const LAS f32x2*)(ap + 4 * t);
        acc = __builtin_amdgcn_mfma_f32_32x32x2f32(a.x, wreg[2 * t], acc, 0, 0, 0);
        acc = __builtin_amdgcn_mfma_f32_32x32x2f32(a.y, wreg[2 * t + 1], acc, 0, 0, 0);
      }
    }
    __syncthreads();
#pragma unroll
    for (int i = 0; i < 16; ++i) part[(wave * 32 + (i & 3) + 8 * (i >> 2) + 4 * kh) * 33 + r32] = acc[i];
    __syncthreads();
    if (tid < 32) {
      const int gs = gsel[tid];
      const float gw_ = gwt[tid];
      float e8[8];
#pragma unroll
      for (int j = 0; j < 8; ++j) {
        float v = p->b_router[l * 32 + gs * 8 + j];
#pragma unroll
        for (int w = 0; w < 8; ++w) v += part[(w * 32 + tid) * 33 + gs * 8 + j];
        e8[j] = v;
      }
      int i0 = 0; float v0 = e8[0];
#pragma unroll
      for (int j = 1; j < 8; ++j) if (e8[j] > v0) { v0 = e8[j]; i0 = j; }
      int i1 = -1; float v1 = -INFINITY;
#pragma unroll
      for (int j = 0; j < 8; ++j) if (j != i0 && e8[j] > v1) { v1 = e8[j]; i1 = j; }
      const float ex = expf(v1 - v0);
      const float w0 = gw_ / (1.f + ex), w1 = gw_ * ex / (1.f + ex);
      const int tok = tok0 + tid;
      const int ea = gs * 8 + i0, eb = gs * 8 + i1;
      const int sa = atomicAdd(&cnt[ea * CNT_STRIDE], 1);
      const int sb = atomicAdd(&cnt[eb * CNT_STRIDE], 1);
      list[(size_t)ea * NTOK + sa] = tok * 2; wlist[(size_t)ea * NTOK + sa] = w0;
      list[(size_t)eb * NTOK + sb] = tok * 2 + 1; wlist[(size_t)eb * NTOK + sb] = w1;
    }
    __syncthreads();
  }
}
struct ExpInfo2 { int tiles[4], base[4], cnt[4]; };
DEVI ExpInfo2 exp_info2(KP p, int xcd) {
  const int* cnt = wsp<int>(p, OFF_CNT);
  ExpInfo2 ei;
  int before = 0;
#pragma unroll
  for (int e = 0; e < 32; ++e) {
    const int c = __builtin_amdgcn_readfirstlane(cnt[e * CNT_STRIDE]), t = (c + 255) >> 8;
    if ((e & 7) == xcd) { ei.tiles[e >> 3] = t; ei.base[e >> 3] = before; ei.cnt[e >> 3] = c; }
    before += t;
  }
  return ei;
}
template <int NN>
struct SchedX { ExpInfo2 ei; int xcd, lb, G8; const char* A; const char* W; const int* list; size_t wstride; int lda_b;
  DEVI bool next(int i, Unit& u) const {
    const int tot = (ei.tiles[0] + ei.tiles[1] + ei.tiles[2] + ei.tiles[3]) * NN;
    const int n = i * G8 + lb; if (n >= tot) return false;
    int k = 0, m = n / NN; const int pn = n % NN;
    int tb = ei.base[0], ce = ei.cnt[0];
#pragma unroll
    for (int kk = 0; kk < 3; ++kk) { if (k == kk && m >= ei.tiles[kk]) { m -= ei.tiles[kk]; k = kk + 1; tb = ei.base[kk + 1]; ce = ei.cnt[kk + 1]; } }
    const int e = xcd + 8 * k;
    u.rows = list + (size_t)e * NTOK + m * 256; u.nvalid = ce - m * 256;
    u.A = A + (NN == 2 ? (size_t)0 : (size_t)(tb + m) * 256 * lda_b);
    u.B = W + (size_t)e * wstride + (size_t)pn * 256 * (NN == 2 ? 2048 : 512);
    u.u0 = (tb + m) * 256; u.u1 = pn; u.u2 = e; u.u3 = m; return true; } };
struct EpiI1 { u16* U;
  DEVI void operator()(const f32x4 (&acc)[2][2][4][2], const Unit& u, int wr, int wc, int fr, int fq) const {
#pragma unroll
    for (int ai = 0; ai < 2; ++ai)
#pragma unroll
      for (int m = 0; m < 4; ++m) {
        u16* rowp = U + (size_t)(u.u0 + ai * HALF + wr * 64 + m * 16 + fr) * 256;
#pragma unroll
        for (int bj = 0; bj < 2; ++bj) {
          const int ff = 16 * (8 * u.u1 + 4 * bj + wc) + 4 * fq;
          const f32x4 g = acc[ai][bj][m][0], up = acc[ai][bj][m][1];
          float t[4];
#pragma unroll
          for (int j = 0; j < 4; ++j) t[j] = g[j] / (1.f + __expf(-g[j])) * up[j];
          u32x2 o; o.x = pk2(t[0], t[1]); o.y = pk2(t[2], t[3]);
          *(u32x2*)(rowp + ff) = o;
        }
      }
  }
};
DEVI void phaseI1_2(KP p, ldsp_t lds) {
  const int xcd = BIDX & 7, lb = BIDX >> 3, G8 = gridDim.x >> 3;
  if (lb >= G8) return;
  SchedX<2> S{exp_info2(p, xcd), xcd, lb, G8, (const char*)wsp<u16>(p, OFF_H), (const char*)wsp<u16>(p, OFF_W13), wsp<int>(p, OFF_LIST), (size_t)512 * 2048, 2048};
  EpiI1 E{wsp<u16>(p, OFF_U)};
  int nt = 16; asm volatile("" : "+s"(nt));
  gemm_phase<false, true>(lds, 2048, 2048, nt, S, E);
}
struct EpiI2 { u16* YS; const float* wlist; const int* list;
  DEVI void operator()(const f32x4 (&acc)[2][2][4][2], const Unit& u, int wr, int wc, int fr, int fq) const {
    const unsigned colb = (unsigned)(u.u1 * 256 + wc * 32 + 8 * fq) * 2u;
    const float* we = wlist + (u.rows - list);
#pragma unroll
    for (int ai = 0; ai < 2; ++ai)
#pragma unroll
      for (int m = 0; m < 4; ++m) {
        const int r = ai * HALF + wr * 64 + m * 16 + fr;
        const unsigned dest = (r < u.nvalid) ? (unsigned)u.rows[r] : (unsigned)(2 * NTOK);
        const float w = we[r];
        char* rowp = (char*)YS + (dest * 2048u + colb);
#pragma unroll
        for (int bj = 0; bj < 2; ++bj) {
          const f32x4 v0 = acc[ai][bj][m][0] * w, v1 = acc[ai][bj][m][1] * w;
          u32x4 o; o.x = pk2(v0[0], v0[1]); o.y = pk2(v0[2], v0[3]); o.z = pk2(v1[0], v1[1]); o.w = pk2(v1[2], v1[3]);
          *(u32x4*)(rowp + bj * 256) = o;
        }
      }
  }
};
DEVI void phaseI2_2(KP p, ldsp_t lds) {
  const int xcd = BIDX & 7, lb = BIDX >> 3, G8 = gridDim.x >> 3;
  if (lb >= G8) return;
  SchedX<4> S{exp_info2(p, xcd), xcd, lb, G8, (const char*)wsp<u16>(p, OFF_U), (const char*)wsp<u16>(p, OFF_W2), wsp<int>(p, OFF_LIST), (size_t)1024 * 512, 512};
  EpiI2 E{wsp<u16>(p, OFF_YS), wsp<float>(p, OFF_WLIST), wsp<int>(p, OFF_LIST)};
  int nt = 4; asm volatile("" : "+s"(nt));
  gemm_phase<true, false>(lds, 512, 512, nt, S, E);
}
DEVI void phaseJ2(KP p, int l, ldsp_t lds) {
  const int lane = TIDX & 63;
  const int gw = BIDX * NW + (TIDX >> 6), nw = gridDim.x * NW;
  const u16* YS = wsp<u16>(p, OFF_YS);
  u16* H = wsp<u16>(p, OFF_H);
  for (int tok0 = gw; tok0 < NTOK; tok0 += 2 * nw) {
    float xv[2][16]; u32x2 y0[2][4], y1[2][4]; bool ok[2]; int tk[2];
#pragma unroll
    for (int r = 0; r < 2; ++r) {
      const int tok = tok0 + r * nw;
      tk[r] = tok;
      ok[r] = (tok < NTOK) && !(l == 1 && (tok % TPB) < NCTX);
      if (ok[r]) {
        const int b = tok / TPB, rr = tok % TPB;
        load_row16(xrow_res(p, b, rr), xv[r]);
#pragma unroll
        for (int i = 0; i < 4; ++i) {
          const int c = i * 256 + lane * 4;
          y0[r][i] = *(const u32x2*)(YS + (size_t)(tok * 2) * 1024 + c);
          y1[r][i] = *(const u32x2*)(YS + (size_t)(tok * 2 + 1) * 1024 + c);
        }
      }
    }
#pragma unroll
    for (int r = 0; r < 2; ++r) {
      if (!ok[r]) continue;
      const int tok = tk[r];
      const int b = tok / TPB, rr = tok % TPB;
      const int mrow = (rr < NCTX) ? 8 : b;
      float* xr = xrow_res(p, b, rr);
      const float* gt = wsp<float>(p, OFF_MOD) + ((size_t)l * 9 + mrow) * 6144 + 5120;
#pragma unroll
      for (int i = 0; i < 4; ++i) {
        const int c = i * 256 + lane * 4;
        const f32x4 g = *(const f32x4*)(gt + c);
        xv[r][i * 4 + 0] += g.x * (bf2f((u16)(y0[r][i].x & 0xffff)) + bf2f((u16)(y1[r][i].x & 0xffff)));
        xv[r][i * 4 + 1] += g.y * (bf2f((u16)(y0[r][i].x >> 16)) + bf2f((u16)(y1[r][i].x >> 16)));
        xv[r][i * 4 + 2] += g.z * (bf2f((u16)(y0[r][i].y & 0xffff)) + bf2f((u16)(y1[r][i].y & 0xffff)));
        xv[r][i * 4 + 3] += g.w * (bf2f((u16)(y0[r][i].y >> 16)) + bf2f((u16)(y1[r][i].y >> 16)));
      }
      if (l == 0) {
#pragma unroll
        for (int i = 0; i < 4; ++i)
          *(f32x4*)(xr + i * 256 + lane * 4) = f32x4{xv[r][i * 4], xv[r][i * 4 + 1], xv[r][i * 4 + 2], xv[r][i * 4 + 3]};
        float hv[16];
        modulate_row_store(p, 1, 0, xv[r], mrow, H + (size_t)tok * 1024, hv);
      } else {
        float ss = 0.f;
#pragma unroll
        for (int i = 0; i < 16; ++i) ss += xv[r][i] * xv[r][i];
        ss = wave_sum(ss);
        const float rstd = rsqrtf(ss * (1.f / 1024.f) + EPS);
#pragma unroll
        for (int i = 0; i < 4; ++i) {
          const int c = i * 256 + lane * 4;
          const f32x4 g = *(const f32x4*)(p->g_final + c);
          *(f32x4*)(xr + c) = f32x4{xv[r][i * 4] * rstd * g.x, xv[r][i * 4 + 1] * rstd * g.y, xv[r][i * 4 + 2] * rstd * g.z, xv[r][i * 4 + 3] * rstd * g.w};
        }
      }
    }
  }
  if (l == 0) conv_items2(p, 1, lds, 0, CONV_ITEMS);
}

constexpr int N_PHASES = 3 + 2 * 11;
__global__ void __launch_bounds__(512, 2) fwd_v2(Params parg) {
  extern __shared__ __attribute__((aligned(16))) unsigned char dyn_lds[];
  const ldsp_t lds = (ldsp_t)dyn_lds;
  cg::grid_group grid = cg::this_grid();
  volatile LAS unsigned* xb_st = (volatile LAS unsigned*)(lds + LDS_BARW);
  if (TIDX < 4) xb_st[TIDX] = 0u;
  __syncthreads();
  if (parg.ph_end - parg.ph_begin > 1) xcd_barrier_post((unsigned*)(parg.ws + OFF_BAR));
  for (int ph = parg.ph_begin; ph < parg.ph_end; ++ph) {
    KP p = (KP)__builtin_amdgcn_kernarg_segment_ptr();
    asm volatile("" : "+s"(p));
    const int l = (ph >= 14) ? 1 : 0;
    const int k = (ph < 3) ? ph : 3 + (ph - 3) % 11;
    const int reps = (((PROBE_DUP >> k) & 1) && (!(PROBE_DUP & 0x10000) || l == 0)) ? 2 : 1;
    for (int rep = 0; rep < reps; ++rep) {
      if (rep) {
        xcd_barrier((unsigned*)(p->ws + OFF_BAR), xb_st);
        if (k == 10) { if (BIDX == 0 && TIDX < 32) wsp<int>(p, OFF_CNT)[TIDX * CNT_STRIDE] = 0; xcd_barrier((unsigned*)(p->ws + OFF_BAR), xb_st); }
      }
      switch (k) {
        case 0: phase0_2(p, lds); break;
        case 1: phase1_2(p); break;
        case 2: phaseA2(p); break;
        case 3: phaseB2(p, lds); break;
        case 4: phaseC2(p, lds); break;
        case 5: phaseP2(p, l, lds); break;
        case 6: phaseD2(p, l, lds); break;
        case 7: phaseE1(p, l, lds); break;
        case 8: phaseE2(p, l, lds); break;
        case 9: phaseF2(p, l, lds); break;
        case 10: phaseG2(p, l, lds); break;
        case 11: phaseI1_2(p, lds); break;
        case 12: phaseI2_2(p, lds); break;
        default: phaseJ2(p, l, lds); break;
      }
    }
    if (ph + 1 < parg.ph_end) {
      if (ph == parg.ph_begin) grid.sync();
      else xcd_barrier((unsigned*)(p->ws + OFF_BAR), xb_st);
    }
  }
}
}

extern "C" void kernel_launch(void* const* d_in, const int* in_sizes, int n_in, void* d_out, int out_size,
                              void* d_ws, size_t ws_size, hipStream_t stream) {
  static int grid2 = 0;
  if (!grid2) {
    int dev = 0, cus = 0, per_cu = 0;
    (void)hipGetDevice(&dev);
    (void)hipDeviceGetAttribute(&cus, hipDeviceAttributeMultiprocessorCount, dev);
    (void)hipFuncSetAttribute((const void*)v2::fwd_v2, hipFuncAttributeMaxDynamicSharedMemorySize, v2::LDS_TOTAL);
    (void)hipOccupancyMaxActiveBlocksPerMultiprocessor(&per_cu, v2::fwd_v2, 512, v2::LDS_TOTAL);
    if (per_cu < 1) { fprintf(stderr, "kernel does not fit on a CU\n"); per_cu = 1; }
    grid2 = cus & ~7;
  }
  if (ws_size < WS_NEEDED) { fprintf(stderr, "workspace too small: %zu < %zu\n", ws_size, (size_t)WS_NEEDED); return; }
  Params hp{};
  const float** f = (const float**)&hp;
  for (int i = 0; i < 29; ++i) f[i] = (const float*)d_in[i];
  hp.out = (float*)d_out;
  hp.ws = (char*)d_ws;
#if N_LAUNCH_MODE == 1
  for (int ph = 0; ph < v2::N_PHASES; ++ph) {
    hp.ph_begin = ph; hp.ph_end = ph + 1;
    void* args[] = {&hp};
    hipError_t e = hipLaunchCooperativeKernel((void*)v2::fwd_v2, dim3(grid2), dim3(512), args, v2::LDS_TOTAL, stream);
    if (e != hipSuccess) fprintf(stderr, "launch failed: %s\n", hipGetErrorString(e));
  }
#else
  hp.ph_begin = 0; hp.ph_end = v2::N_PHASES;
  (void)hipMemsetAsync((char*)d_ws + OFF_BAR, 0, (size_t)XCD_BAR_WORDS * 4, stream);
  void* args[] = {&hp};
  hipError_t e = hipLaunchCooperativeKernel((void*)v2::fwd_v2, dim3(grid2), dim3(512), args, v2::LDS_TOTAL, stream);
  if (e != hipSuccess) fprintf(stderr, "cooperative launch failed: %s (grid %d)\n", hipGetErrorString(e), grid2);
#endif
}
```

```cpp
#include <hip/hip_runtime.h>
#include <hip/hip_cooperative_groups.h>
#include <stdint.h>
#include <stdio.h>
namespace cg = cooperative_groups;

#ifndef N_LAUNCH_MODE
#define N_LAUNCH_MODE 0
#endif

#ifndef PROBE_DUP
#define PROBE_DUP 0
#endif
#define DEVI __device__ __forceinline__
typedef unsigned short u16;
typedef __attribute__((ext_vector_type(2))) float f32x2;
typedef __attribute__((ext_vector_type(2))) __bf16 bf16x2_t;
typedef __attribute__((ext_vector_type(8))) short bf16x8;
typedef __attribute__((ext_vector_type(16))) float f32x16;
typedef __attribute__((ext_vector_type(4))) unsigned u32x4;
typedef __attribute__((ext_vector_type(2))) unsigned u32x2;
typedef __attribute__((ext_vector_type(4))) float f32x4;
#define MFMA(a, b, c) __builtin_amdgcn_mfma_f32_32x32x16_bf16((a), (b), (c), 0, 0, 0)

constexpr int DMODEL = 1024, NBATCH = 8, SEQ = 4096, NCTX = 256;
constexpr int TPB = SEQ + NCTX;
constexpr int NTOK = NBATCH * TPB;
constexpr int MT_PER_B = TPB / 128;
constexpr int NEXP = 32;
constexpr int INP = 2304;
constexpr float EPS = 1e-6f;
constexpr float LOG2E = 1.4426950408889634f;
constexpr int SMEM_BYTES = 73728;
constexpr int UROWS = 2 * NTOK + NEXP * 256;

constexpr size_t al(size_t x) { return (x + 255) & ~(size_t)255; }
constexpr size_t OFF_WIN = 0;
constexpr size_t OFF_WQB = OFF_WIN + al((size_t)INP * 1024 * 2);
constexpr size_t OFF_WKVB = OFF_WQB + al((size_t)512 * 256 * 2);
constexpr size_t OFF_WGATE = OFF_WKVB + al((size_t)512 * 256 * 2);
constexpr size_t OFF_WBR = OFF_WGATE + al((size_t)4 * 1024 * 1024 * 2);
constexpr size_t OFF_WOUT = OFF_WBR + al((size_t)4 * 1024 * 256 * 2);
constexpr size_t OFF_W13 = OFF_WOUT + al((size_t)1024 * 1024 * 2);
constexpr size_t OFF_W2 = OFF_W13 + al((size_t)32 * 512 * 1024 * 2);
constexpr size_t OFF_MODP = OFF_W2 + al((size_t)32 * 1024 * 256 * 2);
constexpr size_t OFF_MOD = OFF_MODP + al((size_t)8 * 2 * 9 * 6144 * 4);
constexpr size_t OFF_CS32 = OFF_MOD + al((size_t)2 * 9 * 6144 * 4);
constexpr size_t OFF_CS16 = OFF_CS32 + al((size_t)64 * 16 * 2 * 4);
constexpr size_t OFF_WRT = OFF_CS16 + al((size_t)64 * 8 * 2 * 4);
constexpr size_t OFF_CNT = OFF_WRT + al((size_t)2 * 36 * 1024 * 4);
constexpr int CNT_STRIDE = 64;
constexpr size_t OFF_BAR = OFF_CNT + al(32 * CNT_STRIDE * 4);
constexpr int XCD_BAR_WORDS = 3456;
constexpr size_t OFF_CTXRES = OFF_BAR + al((size_t)XCD_BAR_WORDS * 4);
constexpr size_t OFF_H = OFF_CTXRES + al((size_t)8 * 256 * 1024 * 4);
constexpr size_t OFF_O = OFF_H + al((size_t)NTOK * 1024 * 2);
constexpr size_t OFF_SSQ = OFF_O + al((size_t)NTOK * 1024 * 2);
constexpr size_t OFF_LIST = OFF_SSQ + al((size_t)NTOK * 8 * 4);
constexpr size_t OFF_WLIST = OFF_LIST + al((size_t)32 * NTOK * 4);
constexpr size_t OFF_R1 = OFF_WLIST + al((size_t)32 * NTOK * 4);
constexpr int PLD = INP;
constexpr size_t OFF_PRAW = OFF_R1;
constexpr size_t OFF_QARAW = OFF_PRAW + (size_t)NTOK * INP * 2;
constexpr size_t OFF_KVARAW = OFF_QARAW + (size_t)NTOK * 512 * 2;
constexpr size_t OFF_VAT = OFF_KVARAW + (size_t)NTOK * 512 * 2;
constexpr size_t OFF_VBT = OFF_VAT + (size_t)NTOK * 256 * 2;
constexpr size_t OFF_VCT = OFF_VBT + (size_t)NTOK * 128 * 2;
constexpr size_t OFF_VDT = OFF_VCT + (size_t)NTOK * 256 * 2;
constexpr size_t OFF_END = OFF_VDT + (size_t)NTOK * 128 * 2;
constexpr size_t OFF_Z = OFF_R1;
constexpr size_t OFF_YPRE = OFF_O;
constexpr size_t OFF_U = OFF_R1;
constexpr size_t OFF_YS = OFF_R1 + al((size_t)UROWS * 256 * 2);
static_assert(OFF_Z + (size_t)NTOK * 4096 * 2 <= OFF_END, "alias overflow");
static_assert(OFF_YS + (size_t)(2 * NTOK + 1) * 1024 * 2 <= OFF_END, "alias overflow");
constexpr size_t WS_NEEDED = OFF_END;
static_assert(WS_NEEDED <= (size_t)536870912, "workspace budget (4 x largest tensor)");

struct Params {
  const float *x, *c, *ctx, *c_ctx, *w_mod, *b_mod, *g_norm_mix, *w_in, *g_q_a, *w_q_b, *g_kv_a, *w_kv_b,
      *sink_b, *rpb_c, *g_q_d, *g_k_d, *w_gate, *b_gate, *w_branch, *w_out, *g_norm_ffn, *w_group, *b_group,
      *w_router, *b_router, *w_ff1, *w_ff3, *w_ff2, *g_final;
  float* out;
  char* ws;
  int ph_begin, ph_end;
};

DEVI int tid_fresh() { int t; asm volatile("v_mov_b32 %0, %1" : "=v"(t) : "v"(__builtin_amdgcn_workitem_id_x())); return t; }
DEVI int bid_fresh() { int t; asm volatile("s_mov_b32 %0, %1" : "=s"(t) : "s"(__builtin_amdgcn_workgroup_id_x())); return t; }
#define TIDX tid_fresh()
#define BIDX bid_fresh()
typedef const __attribute__((address_space(4))) Params* KP;
DEVI unsigned pk2(float a, float b) { f32x2 v = {a, b}; bf16x2_t r = __builtin_convertvector(v, bf16x2_t); return __builtin_bit_cast(unsigned, r); }
DEVI u16 f2bf(float a) { return (u16)(pk2(a, 0.f) & 0xffffu); }
DEVI float bf2f(u16 v) { return __uint_as_float(((unsigned)v) << 16); }
DEVI float wave_sum(float v) {
#pragma unroll
  for (int m = 32; m >= 1; m >>= 1) v += __shfl_xor(v, m);
  return v;
}
template <class T> DEVI T* wsp(KP p, size_t off) { return (T*)(p->ws + off); }
DEVI const float* xrow_in(KP p, int l, int b, int rr) {
  if (l == 0) return (rr < NCTX) ? p->ctx + ((size_t)b * NCTX + rr) * 1024 : p->x + ((size_t)b * SEQ + rr - NCTX) * 1024;
  return (rr < NCTX) ? wsp<float>(p, OFF_CTXRES) + ((size_t)b * NCTX + rr) * 1024 : p->out + ((size_t)b * SEQ + rr - NCTX) * 1024;
}
DEVI float* xrow_res(KP p, int b, int rr) {
  return (rr < NCTX) ? wsp<float>(p, OFF_CTXRES) + ((size_t)b * NCTX + rr) * 1024 : p->out + ((size_t)b * SEQ + rr - NCTX) * 1024;
}
DEVI int perm16(int k) { return (k & ~12) | ((k & 4) << 1) | ((k & 8) >> 1); }

struct ConvT { const float* src; const float* src2; const float* ks; u16* dst; int ld; int ldd; float mul; };
constexpr int CONV_ITEMS = 1152 + 64 + 64 + 2048 + 512 + 512 + 8192 + 4096;
DEVI ConvT conv_decode(KP p, int l, int idx) {
  ConvT c; c.ks = nullptr; c.mul = 1.f; c.src2 = nullptr;
  if (idx < 1152) {
    int nt = idx >> 4, kt = idx & 15, n0 = nt * 32;
    int sc = (n0 < 416) ? n0 : ((n0 < 512) ? -1 : n0 - 96);
    c.ld = 2208; c.ldd = 1024;
    if ((n0 >= 512 && n0 < 768) || (n0 >= 1024 && n0 < 1280)) c.mul = 0.125f * LOG2E;
    c.src = (sc < 0) ? nullptr : p->w_in + (size_t)l * 1024 * 2208 + (size_t)kt * 64 * 2208 + sc;
    c.dst = wsp<u16>(p, OFF_WIN) + (size_t)n0 * 1024 + kt * 64;
    return c;
  }
  idx -= 1152;
  if (idx < 64) {
    int nt = idx >> 2, kt = idx & 3;
    c.ld = 384; c.ldd = 256; c.ks = p->g_q_a + l * 256 + kt * 64;
    c.src = (nt >= 12) ? nullptr : p->w_q_b + (size_t)l * 256 * 384 + (size_t)kt * 64 * 384 + nt * 32;
    c.dst = wsp<u16>(p, OFF_WQB) + (size_t)nt * 32 * 256 + kt * 64;
    return c;
  }
  idx -= 64;
  if (idx < 64) {
    int nt = idx >> 2, kt = idx & 3;
    c.ld = 512; c.ldd = 256; c.ks = (kt < 2) ? p->g_kv_a + l * 128 + kt * 64 : nullptr;
    c.src = (kt >= 2) ? nullptr : p->w_kv_b + (size_t)l * 128 * 512 + (size_t)kt * 64 * 512 + nt * 32;
    c.dst = wsp<u16>(p, OFF_WKVB) + (size_t)nt * 32 * 256 + kt * 64;
    return c;
  }
  idx -= 64;
  if (idx < 2048) {
    int nt = idx >> 4, kt = idx & 15, R0 = nt * 32;
    int pr = R0 >> 11, cb = (R0 & 2047) >> 8, bj = (R0 & 255) >> 7, j0 = R0 & 127;
    c.ld = 1024; c.ldd = 1024;
    c.src = p->w_gate + ((size_t)(l * 4 + 2 * pr + bj) * 1024 + kt * 64) * 1024 + cb * 128 + j0;
    c.dst = wsp<u16>(p, OFF_WGATE) + (size_t)R0 * 1024 + kt * 64;
    return c;
  }
  idx -= 2048;
  if (idx < 512) {
    int br = idx >> 7, nt = (idx >> 2) & 31, kt = idx & 3;
    c.ld = 1024; c.ldd = 256;
    c.src = p->w_branch + ((size_t)(l * 4 + br) * 256 + kt * 64) * 1024 + nt * 32;
    c.dst = wsp<u16>(p, OFF_WBR) + ((size_t)br * 1024 + nt * 32) * 256 + kt * 64;
    return c;
  }
  idx -= 512;
  if (idx < 512) {
    int nt = idx >> 4, kt = idx & 15;
    c.ld = 1024; c.ldd = 1024;
    c.src = p->w_out + ((size_t)l * 1024 + kt * 64) * 1024 + nt * 32;
    c.dst = wsp<u16>(p, OFF_WOUT) + (size_t)nt * 32 * 1024 + kt * 64;
    return c;
  }
  idx -= 512;
  if (idx < 8192) {
    int e = idx >> 8, g32 = (idx >> 4) & 15, kt = idx & 15;
    c.ld = 256; c.ldd = 1024;
    c.src = p->w_ff1 + ((size_t)(l * 32 + e) * 1024 + kt * 64) * 256 + g32 * 16;
    c.src2 = p->w_ff3 + ((size_t)(l * 32 + e) * 1024 + kt * 64) * 256 + g32 * 16;
    c.dst = wsp<u16>(p, OFF_W13) + ((size_t)e * 512 + g32 * 32) * 1024 + kt * 64;
    return c;
  }
  idx -= 8192;
  {
    int e = idx >> 7, nt = (idx >> 2) & 31, kt = idx & 3;
    c.ld = 1024; c.ldd = 256;
    c.src = p->w_ff2 + ((size_t)(l * 32 + e) * 256 + kt * 64) * 1024 + nt * 32;
    c.dst = wsp<u16>(p, OFF_W2) + ((size_t)e * 1024 + nt * 32) * 256 + kt * 64;
    return c;
  }
}
DEVI void modulate_row_store(KP p, int l, int which, const float (&xv)[16], int mrow, u16* hrow, float (&hv)[16]) {
  const int lane = TIDX & 63;
  float ss = 0.f;
#pragma unroll
  for (int i = 0; i < 16; ++i) ss += xv[i] * xv[i];
  ss = wave_sum(ss);
  const float rstd = rsqrtf(ss * (1.f / 1024.f) + EPS);
  const float* g = (which ? p->g_norm_ffn : p->g_norm_mix) + l * 1024;
  const float* mod = wsp<float>(p, OFF_MOD) + ((size_t)l * 9 + mrow) * 6144 + (which ? 3072 : 0);
#pragma unroll
  for (int i = 0; i < 4; ++i) {
    const int c = i * 256 + lane * 4;
    f32x4 gv = *(const f32x4*)(g + c);
    f32x4 sh = *(const f32x4*)(mod + c);
    f32x4 sc = *(const f32x4*)(mod + 1024 + c);
    hv[i * 4 + 0] = xv[i * 4 + 0] * rstd * gv.x * (1.f + sc.x) + sh.x;
    hv[i * 4 + 1] = xv[i * 4 + 1] * rstd * gv.y * (1.f + sc.y) + sh.y;
    hv[i * 4 + 2] = xv[i * 4 + 2] * rstd * gv.z * (1.f + sc.z) + sh.z;
    hv[i * 4 + 3] = xv[i * 4 + 3] * rstd * gv.w * (1.f + sc.w) + sh.w;
    u32x2 o; o.x = pk2(hv[i * 4 + 0], hv[i * 4 + 1]); o.y = pk2(hv[i * 4 + 2], hv[i * 4 + 3]);
    *(u32x2*)(hrow + c) = o;
  }
}
DEVI void load_row16(const float* xr, float (&xv)[16]) {
  const int lane = TIDX & 63;
#pragma unroll
  for (int i = 0; i < 4; ++i) {
    f32x4 v = *(const f32x4*)(xr + i * 256 + lane * 4);
    xv[i * 4 + 0] = v.x; xv[i * 4 + 1] = v.y; xv[i * 4 + 2] = v.z; xv[i * 4 + 3] = v.w;
  }
}
DEVI float router_dot(const float (&hv)[4][16], const float* wrow) {
  const int lane = TIDX & 63;
  const float* w = wrow + lane * 4;
  float pr[4] = {0.f, 0.f, 0.f, 0.f};
#pragma unroll
  for (int i = 0; i < 4; ++i) {
    const f32x4 wv = *(const f32x4*)(w + i * 256);
#pragma unroll
    for (int r = 0; r < 4; ++r)
      pr[r] += hv[r][i * 4] * wv.x + hv[r][i * 4 + 1] * wv.y + hv[r][i * 4 + 2] * wv.z + hv[r][i * 4 + 3] * wv.w;
  }
  const bool up = (lane & 32) != 0;
  float s0 = up ? pr[0] : pr[2], s1 = up ? pr[1] : pr[3];
  float k0 = up ? pr[2] : pr[0], k1 = up ? pr[3] : pr[1];
  k0 += __shfl_xor(s0, 32); k1 += __shfl_xor(s1, 32);
  const bool up2 = (lane & 16) != 0;
  float sv = up2 ? k0 : k1, kv = up2 ? k1 : k0;
  kv += __shfl_xor(sv, 16);
  kv += __shfl_xor(kv, 8); kv += __shfl_xor(kv, 4); kv += __shfl_xor(kv, 2); kv += __shfl_xor(kv, 1);
  return kv;
}
#define XB_TMO      128
#define XB_XCNT(j)  (256  + 64 * (j))
#define XB_XSUB(j)  (1280 + 64 * (j))
#define XB_XGEN(j)  (2304 + 64 * (j))
#define XB_TOP      3328
#define XB_TOPGEN   3392
#define XB_SPIN_CAP (1u << 20)
#define LAS __attribute__((address_space(3)))
DEVI unsigned xb_ld(unsigned* p) { return __hip_atomic_load(p, __ATOMIC_RELAXED, __HIP_MEMORY_SCOPE_AGENT); }
DEVI unsigned xb_add(unsigned* p, unsigned v) { return __hip_atomic_fetch_add(p, v, __ATOMIC_RELAXED, __HIP_MEMORY_SCOPE_AGENT); }
DEVI unsigned xb_xcc_id() { return (unsigned)__builtin_amdgcn_s_getreg((3 << 11) | 20) & 0xFu; }
#define XB_SPIN(cond, bar) do { unsigned _sp = 0; while (cond) { __builtin_amdgcn_s_sleep(1); \
    if ((++_sp & 255u) == 0u) { if (xb_ld(&(bar)[XB_TMO])) break; if (_sp > XB_SPIN_CAP) { atomicAdd(&(bar)[XB_TMO], 1u); break; } } } } while (0)
DEVI void xcd_barrier_post(unsigned* bar) {
  if (TIDX == 0) (void)xb_add(&bar[XB_XCNT(xb_xcc_id())], 1u);
}
DEVI void xcd_barrier_complete(unsigned* bar, unsigned x, unsigned& nloc, unsigned& nx) {
  const unsigned G = gridDim.x * gridDim.y * gridDim.z;
  unsigned sum, cnt, mine, sp = 0u;
  for (;;) {
    sum = 0u; cnt = 0u; mine = 0u;
#pragma unroll
    for (unsigned j = 0; j < 16; ++j) { const unsigned c = xb_ld(&bar[XB_XCNT(j)]); sum += c; cnt += (c > 0u) ? 1u : 0u; mine = (j == x) ? c : mine; }
    if (sum == G) break;
    __builtin_amdgcn_s_sleep(1);
    if ((++sp & 255u) == 0u) { if (xb_ld(&bar[XB_TMO])) break; if (sp > XB_SPIN_CAP) { atomicAdd(&bar[XB_TMO], 1u); break; } }
  }
  nloc = mine > 0u ? mine : 1u; nx = cnt > 0u ? cnt : 1u;
}
DEVI void xcd_barrier(unsigned* bar, volatile LAS unsigned* st) {
  asm volatile("s_waitcnt vmcnt(0)" ::: "memory");
  __syncthreads();
  if (TIDX == 0) {
    const unsigned x = xb_xcc_id();
    __builtin_amdgcn_s_waitcnt(0);
    unsigned nloc = st[0], nx = st[1];
    if (nloc == 0u) { xcd_barrier_complete(bar, x, nloc, nx); st[0] = nloc; st[1] = nx; }
    const unsigned old = xb_add(&bar[XB_XSUB(x)], 1u);
    const unsigned gen = old / nloc;
    if (old + 1u == (gen + 1u) * nloc) {
      __builtin_amdgcn_fence(__ATOMIC_RELEASE, "agent");
      asm volatile("s_waitcnt vmcnt(0)" ::: "memory");
      const unsigned og = xb_add(&bar[XB_TOP], 1u);
      const unsigned tg = og / nx;
      if (og + 1u == (tg + 1u) * nx) xb_add(&bar[XB_TOPGEN], 1u);
      else XB_SPIN(xb_ld(&bar[XB_TOPGEN]) == tg, bar);
      __builtin_amdgcn_fence(__ATOMIC_ACQUIRE, "agent");
      xb_add(&bar[XB_XGEN(x)], 1u);
      asm volatile("s_waitcnt vmcnt(0)" ::: "memory");
    } else {
      XB_SPIN(xb_ld(&bar[XB_XGEN(x)]) == gen, bar);
      __builtin_amdgcn_fence(__ATOMIC_ACQUIRE, "agent");
      asm volatile("s_waitcnt vmcnt(0)" ::: "memory");
    }
  }
  __syncthreads();
}

namespace v2 {
typedef LAS unsigned char* ldsp_t;
constexpr int BM = 256, BK = 64, HALF = 128, HTB = HALF * BK * 2, STAGE_BYTES = 8 * HTB;
constexpr int NW = 8;
constexpr int LDS_XTRA = STAGE_BYTES;
constexpr int LDS_BARW = STAGE_BYTES + 16384;
constexpr int LDS_TOTAL = LDS_BARW + 16;

DEVI int lds_byte(int r, int c) { const int st = (r >> 4) * 2 + (c >> 5), rr = r & 15, cc = c & 31, ob = rr * 64 + cc * 2; return st * 1024 + (ob ^ (((ob >> 9) & 1) << 5)); }
DEVI void stage_rc(int b, int& R, int& C) { const int st = b / 1024, sb = b % 1024, swz = sb ^ (((sb >> 9) & 1) << 5); R = (st >> 1) * 16 + swz / 64; C = (st & 1) * 32 + (swz % 64) / 2; }
DEVI int perm32(int rho) { const int n = rho >> 4, i = rho & 15; return 8 * (i >> 2) + 4 * n + (i & 3); }

DEVI void acc_zero(f32x4 (&acc)[2][2][4][2]) {
#pragma unroll
  for (int a = 0; a < 2; ++a)
#pragma unroll
    for (int b = 0; b < 2; ++b)
#pragma unroll
      for (int m = 0; m < 4; ++m)
#pragma unroll
        for (int n = 0; n < 2; ++n) acc[a][b][m][n] = (f32x4){0.f, 0.f, 0.f, 0.f};
}
struct Unit { const char* A; const char* B; const int* rows; int nvalid; int u0, u1, u2, u3; };

template <bool PERM, bool GATHER, class Epi, class Sched>
DEVI void gemm_phase(ldsp_t lds, int lda_b, int ldb_b, int nt, const Sched& S, const Epi& E) {
  const int tid = TIDX, wid = __builtin_amdgcn_readfirstlane(tid >> 6), lane = tid & 63, wr = wid >> 2, wc = wid & 3, fr = lane & 15, fq = lane >> 4;
  unsigned voffA[2], voffB[2]; int RA[2], CA2[2];
#pragma unroll
  for (int i = 0; i < 2; ++i) {
    int R, C; stage_rc(tid * 16 + i * 8192, R, C);
    const int Rb = PERM ? ((R & ~31) + perm32(R & 31)) : R;
    RA[i] = R; CA2[i] = C * 2;
    voffA[i] = (unsigned)(R * lda_b + C * 2); voffB[i] = (unsigned)(Rb * ldb_b + C * 2);
  }
  const size_t kstep = (size_t)(BK * 2);
  const size_t hstepA = (size_t)HALF * lda_b, hstepB = (size_t)HALF * ldb_b;
  const unsigned ldsw = (unsigned)wid * 1024u;
  const int aoff = lds_byte(wr * 64 + fr, fq * 8), boff = lds_byte(wc * 32 + fr, fq * 8);
#define G_SA(b, h) (((b) * 2 + (h)) * HTB)
#define G_SB(b, h) ((4 + (b) * 2 + (h)) * HTB)
#define G_STAGE(bufoff, gbase, voff) do { _Pragma("unroll") for (int _i = 0; _i < 2; ++_i) \
    __builtin_amdgcn_global_load_lds((const unsigned*)((const char*)(gbase) + (voff)[_i]), (LAS unsigned*)(lds + (bufoff) + ldsw + _i * 8192), 16, 0, 0); } while (0)
#define G_STAGE_A(bufoff, abase, go, h, koff) do { if (GATHER) { _Pragma("unroll") for (int _i = 0; _i < 2; ++_i) \
    __builtin_amdgcn_global_load_lds((const unsigned*)((abase) + (go)[h][_i] + (koff)), (LAS unsigned*)(lds + (bufoff) + ldsw + _i * 8192), 16, 0, 0); } \
    else G_STAGE(bufoff, (abase) + (h) * hstepA + (koff), voffA); } while (0)
#define G_LDA(dst, b, h) do { _Pragma("unroll") for (int m = 0; m < 4; ++m) _Pragma("unroll") for (int k = 0; k < 2; ++k) dst[m][k] = *(const LAS bf16x8*)(lds + G_SA(b, h) + aoff + m * 2048 + k * 1024); } while (0)
#define G_LDB(dst, b, h) do { _Pragma("unroll") for (int n = 0; n < 2; ++n) _Pragma("unroll") for (int k = 0; k < 2; ++k) dst[n][k] = *(const LAS bf16x8*)(lds + G_SB(b, h) + boff + n * 2048 + k * 1024); } while (0)
#define G_MMA(ai, bj, At, Bt) do { __builtin_amdgcn_s_setprio(1); _Pragma("unroll") for (int m = 0; m < 4; ++m) _Pragma("unroll") for (int n = 0; n < 2; ++n) _Pragma("unroll") for (int k = 0; k < 2; ++k) \
    acc[ai][bj][m][n] = __builtin_amdgcn_mfma_f32_16x16x32_bf16(Bt[n][k], At[m][k], acc[ai][bj][m][n], 0, 0, 0); __builtin_amdgcn_s_setprio(0); } while (0)
#define G_WAIT_V(n) asm volatile("s_waitcnt vmcnt(" #n ")" ::: "memory")
#define G_WAIT_L(n) asm volatile("s_waitcnt lgkmcnt(" #n ")" ::: "memory")
#define G_BAR __builtin_amdgcn_s_barrier()
#define G_SCHED __builtin_amdgcn_sched_barrier(0)
  Unit cur, nxt; int ui = 0;
  if (!S.next(0, cur)) return;
  f32x4 acc[2][2][4][2];
  E.init(acc, cur, wr, wc, fr, fq);
  bf16x8 At[4][2], B0[2][2], B1[2][2];
  unsigned gcur[2][2];
  auto gather_offs = [&](const Unit& u, unsigned (&go)[2][2]) {
#pragma unroll
    for (int h = 0; h < 2; ++h)
#pragma unroll
      for (int i = 0; i < 2; ++i) {
        const int r = h * HALF + RA[i];
        const int t = (r < u.nvalid) ? (u.rows[r] >> 1) : 0;
        go[h][i] = (unsigned)t * (unsigned)lda_b + (unsigned)CA2[i];
      }
  };
  if (GATHER) gather_offs(cur, gcur);
  const char* cA = cur.A; const char* cB = cur.B;
  G_STAGE(G_SB(0, 0), cB, voffB); G_STAGE_A(G_SA(0, 0), cA, gcur, 0, 0); G_STAGE(G_SB(0, 1), cB + hstepB, voffB); G_STAGE_A(G_SA(0, 1), cA, gcur, 1, 0);
  if (wr == 1) G_BAR;
  G_WAIT_V(4); G_BAR;
  G_STAGE(G_SB(1, 0), cB + kstep, voffB); G_STAGE_A(G_SA(1, 0), cA, gcur, 0, kstep); G_STAGE(G_SB(1, 1), cB + hstepB + kstep, voffB);
  G_WAIT_V(6); G_BAR;
  for (;;) {
    const bool has_next = S.next(ui + 1, nxt);
    const char* nA = has_next ? nxt.A : cA; const char* nB = has_next ? nxt.B : cB;
    for (int t = 0; t < nt; t += 2) {
      const bool last = (t == nt - 2);
      const size_t k1 = (size_t)(t + 1) * kstep;
      const char* a2 = last ? nA : cA; const char* b2 = last ? nB : cB + (size_t)(t + 2) * kstep;
      const size_t ka2 = last ? 0 : (size_t)(t + 2) * kstep;
      const char* b3 = b2 + kstep; const size_t ka3 = ka2 + kstep;
      unsigned gN[2][2];
      if (GATHER && last) {
        if (has_next) gather_offs(nxt, gN);
        else {
#pragma unroll
          for (int h = 0; h < 2; ++h)
#pragma unroll
            for (int i = 0; i < 2; ++i) gN[h][i] = gcur[h][i];
        }
      }
#define G_STAGE_A2(bufoff, h, koff) do { if (GATHER) { if (last) G_STAGE_A(bufoff, cA, gN, h, (koff) - ka2); else G_STAGE_A(bufoff, cA, gcur, h, koff); } \
        else G_STAGE_A(bufoff, a2, gcur, h, koff); } while (0)
      G_LDB(B0, 0, 0); G_SCHED; G_LDA(At, 0, 0); G_STAGE_A(G_SA(1, 1), cA, gcur, 1, k1);
      G_WAIT_L(8); G_BAR; G_WAIT_L(0); G_MMA(0, 0, At, B0); G_BAR; G_SCHED;
      G_LDB(B1, 0, 1); G_STAGE(G_SB(0, 0), b2, voffB);
      G_BAR; G_WAIT_L(0); G_MMA(0, 1, At, B1); G_BAR;
      G_LDA(At, 0, 1); G_STAGE_A2(G_SA(0, 0), 0, ka2);
      G_BAR; G_WAIT_L(0); G_MMA(1, 0, At, B0); G_BAR; G_SCHED;
      G_STAGE(G_SB(0, 1), b2 + hstepB, voffB);
      G_WAIT_V(6); G_BAR; G_MMA(1, 1, At, B1); G_BAR;
      G_LDB(B0, 1, 0); G_SCHED; G_LDA(At, 1, 0); G_STAGE_A2(G_SA(0, 1), 1, ka2);
      G_WAIT_L(8); G_BAR; G_WAIT_L(0); G_MMA(0, 0, At, B0); G_BAR; G_SCHED;
      G_LDB(B1, 1, 1); G_STAGE(G_SB(1, 0), b3, voffB);
      G_BAR; G_WAIT_L(0); G_MMA(0, 1, At, B1); G_BAR;
      G_LDA(At, 1, 1); G_STAGE_A2(G_SA(1, 0), 0, ka3);
      G_BAR; G_WAIT_L(0); G_MMA(1, 0, At, B0); G_BAR; G_SCHED;
      G_STAGE(G_SB(1, 1), b3 + hstepB, voffB);
      G_WAIT_V(6); G_BAR; G_MMA(1, 1, At, B1); G_BAR;
      if (GATHER && last) {
#pragma unroll
        for (int h = 0; h < 2; ++h)
#pragma unroll
          for (int i = 0; i < 2; ++i) gcur[h][i] = gN[h][i];
      }
#undef G_STAGE_A2
    }
    G_SCHED;
    E(acc, cur, wr, wc, fr, fq);
    G_SCHED;
    if (!has_next) break;
    cur = nxt; cA = nA; cB = nB; ++ui;
    E.init(acc, cur, wr, wc, fr, fq);
  }
  G_WAIT_V(0);
  if (wr == 0) G_BAR;
  G_BAR;
#undef G_SA
#undef G_SB
#undef G_STAGE
#undef G_STAGE_A
#undef G_LDA
#undef G_LDB
#undef G_MMA
#undef G_WAIT_V
#undef G_WAIT_L
#undef G_BAR
#undef G_SCHED
}

DEVI unsigned uoff(unsigned x) { return (unsigned)__builtin_amdgcn_readfirstlane((int)x); }
DEVI bool tile_order(int i, int G, int c, int nM, int nN, int& pm, int& pn) {
  const int nwg = nM * nN;
  const long L = (long)i * G + c; if (L >= nwg) return false;
  int wgid = (int)L; { const int q = nwg / 8, r = nwg % 8, xcd = wgid % 8, off = wgid / 8; wgid = (xcd < r ? xcd * (q + 1) : r * (q + 1) + (xcd - r) * q) + off; }
  const int WGM = 8;
  const int nig = WGM * nN, gid = wgid / nig, fm = gid * WGM, gsz = (nM - fm) < WGM ? (nM - fm) : WGM;
  pm = fm + ((wgid % nig) % gsz); pn = (wgid % nig) / gsz;
  pm = __builtin_amdgcn_readfirstlane(pm); pn = __builtin_amdgcn_readfirstlane(pn);
  return true;
}
struct EpiRawBf16 {
  u16* O; int ldc;
  DEVI void init(f32x4 (&acc)[2][2][4][2], const Unit&, int, int, int, int) const { acc_zero(acc); }
  DEVI void operator()(const f32x4 (&acc)[2][2][4][2], const Unit& u, int wr, int wc, int fr, int fq) const {
    const unsigned off0 = ((unsigned)(u.u0 + wr * 64 + fr) * (unsigned)ldc + (unsigned)(u.u1 + wc * 32 + 8 * fq)) * 2u;
#pragma unroll
    for (int ai = 0; ai < 2; ++ai)
#pragma unroll
      for (int m = 0; m < 4; ++m) {
        char* rowp = (char*)O + (off0 + (unsigned)(ai * HALF + m * 16) * (unsigned)ldc * 2u);
#pragma unroll
        for (int bj = 0; bj < 2; ++bj) {
          const f32x4 v0 = acc[ai][bj][m][0], v1 = acc[ai][bj][m][1];
          u32x4 w; w.x = pk2(v0[0], v0[1]); w.y = pk2(v0[2], v0[3]); w.z = pk2(v1[0], v1[1]); w.w = pk2(v1[2], v1[3]);
          *(u32x4*)(rowp + bj * HALF * 2) = w;
        }
      }
  }
};

struct SchedB { const char* ws; int G, c;
  DEVI bool next(int i, Unit& u) const { int pm, pn; if (!tile_order(i, G, c, NTOK / 256, INP / 256, pm, pn)) return false;
    u.A = ws + OFF_H + uoff((unsigned)pm * 256u * 2048u); u.B = ws + OFF_WIN + uoff((unsigned)pn * 256u * 2048u); u.rows = nullptr; u.nvalid = 0; u.u0 = pm * 256; u.u1 = pn * 256; u.u2 = 0; u.u3 = 0; return true; } };
struct EpiB { u16* O; float* ssq;
  DEVI void init(f32x4 (&acc)[2][2][4][2], const Unit&, int, int, int, int) const { acc_zero(acc); }
  DEVI void operator()(const f32x4 (&acc)[2][2][4][2], const Unit& u, int wr, int wc, int fr, int fq) const {
    EpiRawBf16 E{O, PLD}; E(acc, u, wr, wc, fr, fq);
    if (u.u1 < 512) {
      const bool iskv = u.u1 != 0;
#pragma unroll
      for (int ai = 0; ai < 2; ++ai)
#pragma unroll
        for (int m = 0; m < 4; ++m) {
          float ss = 0.f;
#pragma unroll
          for (int bj = 0; bj < 2; ++bj)
#pragma unroll
            for (int n = 0; n < 2; ++n)
#pragma unroll
              for (int j = 0; j < 4; ++j) { const float v = acc[ai][bj][m][n][j]; if (!(iskv && bj == 1)) ss += v * v; }
          ss += __shfl_xor(ss, 16); ss += __shfl_xor(ss, 32);
          if (fq == 0) ssq[(size_t)(u.u0 + ai * HALF + wr * 64 + m * 16 + fr) * 8 + (iskv ? 4 : 0) + wc] = ss;
        }
    }
  }
};
DEVI void phaseB2(KP p, ldsp_t lds) {
  SchedB S{(const char*)p->ws, (int)gridDim.x, BIDX};
  EpiB E{wsp<u16>(p, OFF_PRAW), wsp<float>(p, OFF_SSQ)};
  gemm_phase<true, false>(lds, 2048, 2048, 16, S, E);
}
struct SchedC { const char* ws; int G, c;
  DEVI bool next(int i, Unit& u) const { int pm, pn; if (!tile_order(i, G, c, NTOK / 256, 4, pm, pn)) return false;
    const bool kv = pn >= 2; const int pj = pn & 1;
    u.A = ws + OFF_PRAW + uoff((unsigned)pm * 256u * (unsigned)(PLD * 2) + (kv ? 512u : 0u)); u.B = ws + (kv ? OFF_WKVB : OFF_WQB) + uoff((unsigned)pj * 256u * 512u); u.rows = nullptr; u.nvalid = 0;
    u.u0 = pm * 256; u.u1 = pj * 256; u.u2 = kv; u.u3 = 0; return true; } };
struct EpiC { u16* Oq; u16* Okv; const float* ssq;
  DEVI void init(f32x4 (&acc)[2][2][4][2], const Unit&, int, int, int, int) const { acc_zero(acc); }
  DEVI void operator()(const f32x4 (&acc)[2][2][4][2], const Unit& u, int wr, int wc, int fr, int fq) const {
    const bool kv = u.u2 != 0;
    u16* O = kv ? Okv : Oq;
    const int row0 = u.u0 + wr * 64 + fr, col0 = u.u1 + wc * 32 + 8 * fq;
    f32x4 sq[2][4];
#pragma unroll
    for (int ai = 0; ai < 2; ++ai)
#pragma unroll
      for (int m = 0; m < 4; ++m) sq[ai][m] = *(const f32x4*)(ssq + (size_t)(row0 + ai * HALF + m * 16) * 8 + (kv ? 4 : 0));
#pragma unroll
    for (int ai = 0; ai < 2; ++ai)
#pragma unroll
      for (int m = 0; m < 4; ++m) {
        const size_t r = (size_t)(row0 + ai * HALF + m * 16);
        const float tot = sq[ai][m].x + sq[ai][m].y + sq[ai][m].z + sq[ai][m].w;
        const float sc = kv ? rsqrtf(tot * (1.f / 128.f) + EPS) : rsqrtf(tot * (1.f / 256.f) + EPS) * (0.10206207261596575f * LOG2E);
        u16* rowp = O + r * 512 + col0;
#pragma unroll
        for (int bj = 0; bj < 2; ++bj) {
          const f32x4 v0 = acc[ai][bj][m][0] * sc, v1 = acc[ai][bj][m][1] * sc;
          u32x4 w; w.x = pk2(v0[0], v0[1]); w.y = pk2(v0[2], v0[3]); w.z = pk2(v1[0], v1[1]); w.w = pk2(v1[2], v1[3]);
          *(u32x4*)(rowp + bj * HALF) = w;
        }
      }
  }
};
DEVI void phaseC2(KP p, ldsp_t lds) {
  SchedC S{(const char*)p->ws, (int)gridDim.x, BIDX};
  EpiC E{wsp<u16>(p, OFF_QARAW), wsp<u16>(p, OFF_KVARAW), wsp<float>(p, OFF_SSQ)};
  int nt = 4; asm volatile("" : "+s"(nt));
  gemm_phase<true, false>(lds, PLD * 2, 512, nt, S, E);
}

DEVI void ld16(const u16* src, float (&v)[16]) {
  const u32x4 a = *(const u32x4*)src, b = *(const u32x4*)(src + 8);
  const unsigned w[8] = {a.x, a.y, a.z, a.w, b.x, b.y, b.z, b.w};
#pragma unroll
  for (int i = 0; i < 8; ++i) { v[2 * i] = __uint_as_float(w[i] << 16); v[2 * i + 1] = __uint_as_float(w[i] & 0xffff0000u); }
}
DEVI void st16(u16* dst, const float (&v)[16]) {
  u32x4 a, b;
  a.x = pk2(v[0], v[1]); a.y = pk2(v[2], v[3]); a.z = pk2(v[4], v[5]); a.w = pk2(v[6], v[7]);
  b.x = pk2(v[8], v[9]); b.y = pk2(v[10], v[11]); b.z = pk2(v[12], v[13]); b.w = pk2(v[14], v[15]);
  *(u32x4*)dst = a; *(u32x4*)(dst + 8) = b;
}
DEVI void rope16c(float (&v)[16], const float* cs16, int pos) {
  const f32x2* t = (const f32x2*)(cs16 + pos * 16);
#pragma unroll
  for (int i = 0; i < 8; ++i) { const f32x2 cs = t[i]; const float x1 = v[i], x2 = v[8 + i]; v[i] = x1 * cs.x - x2 * cs.y; v[8 + i] = x2 * cs.x + x1 * cs.y; }
}
DEVI void rope32c(float (&lo)[16], float (&hi)[16], const float* cs32, int pos) {
  const f32x2* t = (const f32x2*)(cs32 + pos * 32);
#pragma unroll
  for (int i = 0; i < 16; ++i) { const f32x2 cs = t[i]; const float x1 = lo[i], x2 = hi[i]; lo[i] = x1 * cs.x - x2 * cs.y; hi[i] = x2 * cs.x + x1 * cs.y; }
}
DEVI float ssq16(const float (&v)[16]) { float s = 0.f;
#pragma unroll
  for (int i = 0; i < 16; ++i) s += v[i] * v[i];
  return s; }
DEVI void scale16(float (&v)[16], float s) {
#pragma unroll
  for (int i = 0; i < 16; ++i) v[i] *= s; }
DEVI void cvt16(const u32x4 a, const u32x4 b, float (&v)[16]) {
  const unsigned w[8] = {a.x, a.y, a.z, a.w, b.x, b.y, b.z, b.w};
#pragma unroll
  for (int i = 0; i < 8; ++i) { v[2 * i] = __uint_as_float(w[i] << 16); v[2 * i + 1] = __uint_as_float(w[i] & 0xffff0000u); }
}
DEVI void phaseP2(KP p, int l, ldsp_t lds) {
  const int tid = TIDX, tk = tid >> 3, pt = tid & 7;
  u16* PR = wsp<u16>(p, OFF_PRAW);
  u16* QA = wsp<u16>(p, OFF_QARAW);
  const float* cs32 = wsp<float>(p, OFF_CS32);
  const float* cs16 = wsp<float>(p, OFF_CS16);
  const float QS = 0.125f * LOG2E;
  for (int item = BIDX; item < NTOK / 64; item += gridDim.x) {
    const int tok0 = item * 64, rr0 = tok0 % TPB;
    const bool lat = rr0 >= NCTX;
    const size_t tok = (size_t)tok0 + tk;
    const int t = rr0 + tk - NCTX, grow = (t >> 6) & 63, gcol = t & 63;
    u16* pr = PR + tok * PLD;
    u16* qar = QA + tok * 512 + 96 * (pt >> 1) + 64 + 16 * (pt & 1);
    const int g4 = pt & 3;
    u32x4 r_qa[2], r_kr[2], r_qb[4], r_kb[4], r_qd[4], r_kd[4];
#define LD8(ptr) (*(const u32x4*)(ptr))
    if (lat) {
#pragma unroll
      for (int i = 0; i < 2; ++i) { r_qa[i] = LD8(qar + 8 * i); r_kr[i] = LD8(pr + 384 + 16 * (pt & 1) + 8 * i); }
#pragma unroll
      for (int i = 0; i < 4; ++i) { r_qb[i] = LD8(pr + 512 + 32 * pt + 8 * i); r_kb[i] = LD8(pr + 768 + 32 * g4 + 8 * i); }
    }
#pragma unroll
    for (int i = 0; i < 4; ++i) { r_qd[i] = LD8(pr + 1792 + 32 * pt + 8 * i); r_kd[i] = LD8(pr + 2048 + 32 * g4 + 8 * i); }
#undef LD8
    if (lat) {
      { float v[16]; cvt16(r_qa[0], r_qa[1], v); rope16c(v, cs16, (pt & 1) ? gcol : grow); st16(qar, v); }
      if (pt < 2) { float v[16]; cvt16(r_kr[0], r_kr[1], v); rope16c(v, cs16, pt == 0 ? grow : gcol); st16(pr + 384 + 16 * pt, v); }
      { float lo[16], hi[16]; cvt16(r_qb[0], r_qb[1], lo); cvt16(r_qb[2], r_qb[3], hi); rope32c(lo, hi, cs32, (pt & 1) ? gcol : grow); st16(pr + 512 + 32 * pt, lo); st16(pr + 512 + 32 * pt + 16, hi); }
      if (pt < 4) { float lo[16], hi[16]; cvt16(r_kb[0], r_kb[1], lo); cvt16(r_kb[2], r_kb[3], hi); rope32c(lo, hi, cs32, (pt & 1) ? gcol : grow); st16(pr + 768 + 32 * pt, lo); st16(pr + 768 + 32 * pt + 16, hi); }
    }
    {
      float lo[16], hi[16]; cvt16(r_qd[0], r_qd[1], lo); cvt16(r_qd[2], r_qd[3], hi);
      float ss = ssq16(lo) + ssq16(hi); ss += __shfl_xor(ss, 1);
      const float rs = rsqrtf(ss * (1.f / 64.f) + EPS);
      const float* g = p->g_q_d + l * 64 + 32 * (pt & 1);
#pragma unroll
      for (int i = 0; i < 16; ++i) { lo[i] *= rs * g[i]; hi[i] *= rs * g[16 + i]; }
      if (lat) rope32c(lo, hi, cs32, (pt & 1) ? gcol : grow);
      scale16(lo, QS); scale16(hi, QS);
      st16(pr + 1792 + 32 * pt, lo); st16(pr + 1792 + 32 * pt + 16, hi);
    }
    {
      float lo[16], hi[16]; cvt16(r_kd[0], r_kd[1], lo); cvt16(r_kd[2], r_kd[3], hi);
      float ss = ssq16(lo) + ssq16(hi); ss += __shfl_xor(ss, 1);
      const float rs = rsqrtf(ss * (1.f / 64.f) + EPS);
      const float* g = p->g_k_d + l * 64 + 32 * (g4 & 1);
#pragma unroll
      for (int i = 0; i < 16; ++i) { lo[i] *= rs * g[i]; hi[i] *= rs * g[16 + i]; }
      if (lat) rope32c(lo, hi, cs32, (g4 & 1) ? gcol : grow);
      if (pt < 4) { st16(pr + 2048 + 32 * g4, lo); st16(pr + 2048 + 32 * g4 + 16, hi); }
    }
  }
}

template <int BR>
DEVI void attn_mask(f32x16 (&s)[2], int kt, int qlat, int qrow, int qcol, int hh, LAS float* rpb) {
  if (BR == 1) {
#pragma unroll
    for (int kb = 0; kb < 2; ++kb)
#pragma unroll
      for (int i = 0; i < 16; ++i) {
        const int kpos = kt * 64 + kb * 32 + (i & 3) + 8 * (i >> 2) + 4 * hh;
        const int d = qlat - kpos;
        if (d > 128 || d < -128) s[kb][i] = -1e30f;
      }
  } else {
    const int rs = min(max(qrow - 4, 0), 56);
    const bool row_ok = (kt >= rs) && (kt < rs + 8);
    const int cst = min(max(qcol - 8, 0), 48);
    const int dr = kt - qrow + 7;
#pragma unroll
    for (int kb = 0; kb < 2; ++kb)
#pragma unroll
      for (int i = 0; i < 16; ++i) {
        const int kc = kb * 32 + (i & 3) + 8 * (i >> 2) + 4 * hh;
        const bool ok = row_ok && (kc >= cst) && (kc < cst + 16);
        const int idx = ok ? (dr * 31 + (kc - qcol + 15)) : 0;
        const float bias = rpb[idx];
        s[kb][i] = ok ? (s[kb][i] + bias) : -1e30f;
      }
  }
}

typedef short v4i16_t __attribute__((ext_vector_type(4)));
DEVI bf16x8 vtr2(ldsp_t a) {
  const v4i16_t lo = __builtin_amdgcn_ds_read_tr16_b64_v4i16((LAS v4i16_t*)a);
  const v4i16_t hi = __builtin_amdgcn_ds_read_tr16_b64_v4i16((LAS v4i16_t*)(a + 8 * 144));
  return __builtin_shufflevector(lo, hi, 0, 1, 2, 3, 4, 5, 6, 7);
}
template <int BR>
DEVI void attn_item2(KP p, int l, int b, int hs, int qb, bool isctx, ldsp_t lds) {
  constexpr bool MLA = (BR == 0);
  constexpr bool GQA = (BR == 1 || BR == 3);
  constexpr int QBLK = GQA ? 256 : 512;
  constexpr int NKS = MLA ? 6 : 4;
  constexpr int STG = 9216 + 9216 + 5120;
  const int tid = TIDX, lane = tid & 63, wave = __builtin_amdgcn_readfirstlane(tid >> 6);
  const int r32 = lane & 31, hh = lane >> 5;
  const int hq = GQA ? (hs * 2 + (wave & 1)) : hs;
  const int woff = GQA ? 64 * (wave >> 1) : 64 * wave;
  const int q0 = (isctx ? 0 : NCTX) + qb * QBLK;
  const bool active = !isctx || (woff < NCTX);
  const size_t tokq = (size_t)b * TPB + q0 + (active ? woff : 0) + r32;
  const u16* Qp; const u16* Kp; int ldk; const u16* Vp; int ldv; int obase; int ldq;
  const u16* PR = wsp<u16>(p, OFF_PRAW);
  if (BR == 0) { Qp = wsp<u16>(p, OFF_QARAW) + tokq * 512 + hq * 96; ldq = 512; Kp = wsp<u16>(p, OFF_KVARAW) + (size_t)b * TPB * 512 + hs * 128; ldk = 512; Vp = wsp<u16>(p, OFF_KVARAW) + (size_t)b * TPB * 512 + hs * 128 + 64; ldv = 512; obase = hq * 64; }
  else if (BR == 1) { Qp = PR + tokq * PLD + 512 + hq * 64; ldq = PLD; Kp = PR + (size_t)b * TPB * PLD + 768 + hs * 64; ldk = PLD; Vp = PR + (size_t)b * TPB * PLD + 896 + hs * 64; ldv = PLD; obase = 256 + hq * 64; }
  else if (BR == 2) { Qp = PR + tokq * PLD + 1024 + hq * 64; ldq = PLD; Kp = PR + (size_t)b * TPB * PLD + 1280 + hs * 64; ldk = PLD; Vp = PR + (size_t)b * TPB * PLD + 1536 + hs * 64; ldv = PLD; obase = 512 + hq * 64; }
  else { Qp = PR + tokq * PLD + 1792 + hq * 64; ldq = PLD; Kp = PR + (size_t)b * TPB * PLD + 2048 + hs * 64; ldk = PLD; Vp = PR + (size_t)b * TPB * PLD + 2176 + hs * 64; ldv = PLD; obase = 768 + hq * 64; }
  const u16* KRp = PR + (size_t)b * TPB * PLD + 384;
  int lat_lo = 0, lat_n = 0, wlo = 0, whi = 63;
  if (!isctx) {
    if (BR == 0 || BR == 3) { lat_lo = 0; lat_n = 64; }
    else if (BR == 1) {
      const int ql = qb * QBLK; const int lo = max(0, ql - 128) >> 6, hi = min(SEQ - 1, ql + QBLK - 1 + 128) >> 6; lat_lo = lo; lat_n = hi - lo + 1;
      const int wq = ql + woff; wlo = max(0, wq - 128) >> 6; whi = min(SEQ - 1, wq + 63 + 128) >> 6;
    } else {
      const int r0 = 8 * qb; const int lo = min(max(r0 - 4, 0), 56), hi = min(max(r0 + 7 - 4, 0), 56) + 7; lat_lo = lo; lat_n = hi - lo + 1;
      const int wr_ = r0 + wave; wlo = min(max(wr_ - 4, 0), 56); whi = wlo + 7;
    }
  }
  const int NT = 4 + lat_n;
  const int qlat0 = qb * QBLK + woff + r32;
  bf16x8 qf[2][NKS];
#pragma unroll
  for (int qi = 0; qi < 2; ++qi)
#pragma unroll
    for (int ks = 0; ks < NKS; ++ks) qf[qi][ks] = *(const bf16x8*)(Qp + (size_t)qi * 32 * ldq + ks * 16 + hh * 8);
  const int srow = tid >> 3, sc8 = (tid & 7) * 8;
  const int krow_ = (tid & 255) >> 2, kc8 = (tid & 3) * 8;
  const bool krt = tid < 256;
  u32x4 rk0, rv0, rr0, rk1, rv1, rr1;
  auto keytile = [&](int j) { return (j < 4) ? j : (4 + lat_lo + (j - 4)); };
#define A_GLOAD(j, rk, rv, rr) do { const int key0_ = keytile(j) * 64; \
    rk = *(const u32x4*)(Kp + (size_t)(key0_ + srow) * ldk + sc8); \
    rv = *(const u32x4*)(Vp + (size_t)(key0_ + srow) * ldv + sc8); \
    if (MLA && krt) rr = *(const u32x4*)(KRp + (size_t)(key0_ + krow_) * PLD + kc8); } while (0)
#define A_LWRITE(st, rk, rv, rr) do { ldsp_t base_ = lds + (st) * STG; \
    *(LAS u32x4*)(base_ + srow * 144 + sc8 * 2) = rk; \
    *(LAS u32x4*)(base_ + 9216 + srow * 144 + sc8 * 2) = rv; \
    if (MLA && krt) *(LAS u32x4*)(base_ + 18432 + krow_ * 80 + kc8 * 2) = rr; } while (0)
  LAS float* rpb = (LAS float*)(lds + 2 * STG);
  A_GLOAD(0, rk0, rv0, rr0);
  if (NT > 1) A_GLOAD(1, rk1, rv1, rr1);
  __syncthreads();
  if (BR == 2 && !isctx) {
    const float* src = p->rpb_c + (size_t)(l * 4 + hs) * 465;
    for (int i = tid; i < 465; i += 512) rpb[i] = src[i] * LOG2E;
  }
  A_LWRITE(0, rk0, rv0, rr0);
  __syncthreads();
  f32x16 o[2][2];
#pragma unroll
  for (int qi = 0; qi < 2; ++qi)
#pragma unroll
    for (int i = 0; i < 16; ++i) { o[qi][0][i] = 0.f; o[qi][1][i] = 0.f; }
  float m_run[2], l_run[2];
#pragma unroll
  for (int qi = 0; qi < 2; ++qi) { m_run[qi] = -INFINITY; l_run[qi] = 0.f; }
  if (BR == 1) { const float sk = p->sink_b[l * 4 + hq] * LOG2E; m_run[0] = sk; m_run[1] = sk; l_run[0] = (hh == 0) ? 1.f : 0.f; l_run[1] = l_run[0]; }
  const ldsp_t kfb = lds + r32 * 144 + hh * 16;
  const ldsp_t vfb = lds + 9216 + (4 * hh + ((lane & 15) >> 2)) * 144 + (16 * ((lane >> 4) & 1) + 4 * (lane & 3)) * 2;
  const ldsp_t krb = lds + 18432 + r32 * 80 + hh * 16;
#define A_STEP(j, rkA, rvA, rrA, rkB, rvB, rrB) do { \
    const int st = ((j) & 1) * STG; \
    if ((j) + 2 < NT) A_GLOAD((j) + 2, rkA, rvA, rrA); \
    const int kt_ = lat_lo + (j) - 4; \
    const bool need = active && ((j) < 4 || (kt_ >= wlo && kt_ <= whi)); \
    if (need) { \
      f32x16 s[2][2]; \
      _Pragma("unroll") for (int kb = 0; kb < 2; ++kb) { \
        _Pragma("unroll") for (int ks = 0; ks < 4; ++ks) { const bf16x8 kf = *(const LAS bf16x8*)(kfb + st + kb * 32 * 144 + ks * 32); \
          _Pragma("unroll") for (int qi = 0; qi < 2; ++qi) { if (ks == 0) { _Pragma("unroll") for (int i = 0; i < 16; ++i) s[qi][kb][i] = 0.f; } s[qi][kb] = MFMA(kf, qf[qi][ks], s[qi][kb]); } } \
        if (MLA) { _Pragma("unroll") for (int ks = 0; ks < 2; ++ks) { const bf16x8 kf = *(const LAS bf16x8*)(krb + st + kb * 32 * 80 + ks * 32); \
          _Pragma("unroll") for (int qi = 0; qi < 2; ++qi) s[qi][kb] = MFMA(kf, qf[qi][NKS - 2 + ks], s[qi][kb]); } } \
      } \
      _Pragma("unroll") for (int qi = 0; qi < 2; ++qi) { \
        if ((BR == 1 || BR == 2) && (j) >= 4) { const int ql_ = qlat0 + 32 * qi; attn_mask<BR>(s[qi], kt_, ql_, ql_ >> 6, ql_ & 63, hh, rpb); } \
        float mx = s[qi][0][0]; \
        _Pragma("unroll") for (int i = 1; i < 16; ++i) mx = fmaxf(mx, s[qi][0][i]); \
        _Pragma("unroll") for (int i = 0; i < 16; ++i) mx = fmaxf(mx, s[qi][1][i]); \
        mx = fmaxf(mx, __shfl_xor(mx, 32)); \
        const float m_new = fmaxf(m_run[qi], mx); \
        const float alpha = __builtin_amdgcn_exp2f(m_run[qi] - m_new); \
        m_run[qi] = m_new; \
        float ls0 = 0.f, ls1 = 0.f; \
        _Pragma("unroll") for (int i = 0; i < 16; ++i) { \
          const float e0 = __builtin_amdgcn_exp2f(s[qi][0][i] - m_new), e1 = __builtin_amdgcn_exp2f(s[qi][1][i] - m_new); \
          s[qi][0][i] = e0; s[qi][1][i] = e1; ls0 += e0; ls1 += e1; } \
        l_run[qi] = l_run[qi] * alpha + (ls0 + ls1); \
        if (__any(alpha != 1.f)) { _Pragma("unroll") for (int i = 0; i < 16; ++i) { o[qi][0][i] *= alpha; o[qi][1][i] *= alpha; } } \
      } \
      _Pragma("unroll") for (int s4 = 0; s4 < 4; ++s4) { \
        const int kb = s4 >> 1, rb = (s4 & 1) * 8; \
        bf16x8 pf[2]; \
        _Pragma("unroll") for (int qi = 0; qi < 2; ++qi) { u32x4 pw; \
          pw.x = pk2(s[qi][kb][rb + 0], s[qi][kb][rb + 1]); pw.y = pk2(s[qi][kb][rb + 2], s[qi][kb][rb + 3]); \
          pw.z = pk2(s[qi][kb][rb + 4], s[qi][kb][rb + 5]); pw.w = pk2(s[qi][kb][rb + 6], s[qi][kb][rb + 7]); \
          pf[qi] = __builtin_bit_cast(bf16x8, pw); } \
        _Pragma("unroll") for (int db = 0; db < 2; ++db) { const bf16x8 vf = vtr2(vfb + st + s4 * 16 * 144 + db * 64); \
          o[0][db] = MFMA(vf, pf[0], o[0][db]); o[1][db] = MFMA(vf, pf[1], o[1][db]); } \
      } \
    } \
    if ((j) + 1 < NT) A_LWRITE(((j) + 1) & 1, rkB, rvB, rrB); \
    __syncthreads(); \
  } while (0)
  for (int j = 0; j < NT; j += 2) {
    A_STEP(j, rk0, rv0, rr0, rk1, rv1, rr1);
    if (j + 1 < NT) A_STEP(j + 1, rk1, rv1, rr1, rk0, rv0, rr0);
  }
#undef A_STEP
#undef A_GLOAD
#undef A_LWRITE
  if (active) {
#pragma unroll
    for (int qi = 0; qi < 2; ++qi) {
      const float lt = l_run[qi] + __shfl_xor(l_run[qi], 32);
      const float inv = 1.f / lt;
      u16* Op = wsp<u16>(p, OFF_O) + (tokq + 32 * qi) * 1024 + obase;
#pragma unroll
      for (int db = 0; db < 2; ++db)
#pragma unroll
        for (int g = 0; g < 4; ++g) {
          u32x2 w;
          w.x = pk2(o[qi][db][4 * g] * inv, o[qi][db][4 * g + 1] * inv);
          w.y = pk2(o[qi][db][4 * g + 2] * inv, o[qi][db][4 * g + 3] * inv);
          *(u32x2*)(Op + db * 32 + 8 * g + 4 * hh) = w;
        }
    }
  }
}
DEVI void phaseD2(KP p, int l, ldsp_t lds) {
  const int G8 = gridDim.x >> 3, xcd = BIDX & 7, lb = BIDX >> 3;
  if (lb >= G8) return;
  const int NLOC = 128 + (l == 0 ? 12 : 0);
  for (int n = lb; n < NLOC; n += G8) {
    int br, s, qb; bool isctx = false;
    if (n < 32) { br = 0; s = xcd + 8 * (n >> 3); qb = n & 7; }
    else if (n < 64) { const int m = n - 32; br = 3; s = xcd + 8 * (m >> 4); qb = m & 15; }
    else if (n < 96) { const int m = n - 64; br = 2; s = xcd + 8 * (m >> 3); qb = m & 7; }
    else if (n < 128) { const int m = n - 96; br = 1; s = xcd + 8 * (m >> 4); qb = m & 15; }
    else {
      const int m = n - 128; isctx = true; qb = 0;
      if (m < 4) { br = 0; s = xcd + 8 * m; }
      else if (m < 6) { br = 3; s = xcd + 8 * (m - 4); }
      else if (m < 10) { br = 2; s = xcd + 8 * (m - 6); }
      else { br = 1; s = xcd + 8 * (m - 10); }
    }
    if (br == 0) attn_item2<0>(p, l, s >> 2, s & 3, qb, isctx, lds);
    else if (br == 1) attn_item2<1>(p, l, s >> 1, s & 1, qb, isctx, lds);
    else if (br == 2) attn_item2<2>(p, l, s >> 2, s & 3, qb, isctx, lds);
    else attn_item2<3>(p, l, s >> 1, s & 1, qb, isctx, lds);
  }
}

DEVI int pm_map(int pme, bool skipctx) { return skipctx ? (pme >> 4) * 17 + 1 + (pme & 15) : pme; }
struct SchedE1 { const char* ws; bool skipctx; int G, c;
  DEVI bool next(int i, Unit& u) const { int pm, pn; if (!tile_order(i, G, c, skipctx ? 128 : 136, 16, pm, pn)) return false;
    pm = pm_map(pm, skipctx); const int n = pn >> 2, cq = pn & 3;
    u.A = ws + OFF_O + uoff((unsigned)pm * 256u * 2048u + (unsigned)n * 512u); u.B = ws + OFF_WBR + uoff(((unsigned)n * 1024u + (unsigned)cq * 256u) * 512u); u.rows = nullptr; u.nvalid = 0;
    u.u0 = pm * 256; u.u1 = pn * 256; u.u2 = 0; u.u3 = 0; return true; } };
DEVI void phaseE1(KP p, int l, ldsp_t lds) {
  if (BIDX == 0 && TIDX < 32) wsp<int>(p, OFF_CNT)[TIDX * CNT_STRIDE] = 0;
  SchedE1 S{(const char*)p->ws, l == 1, (int)gridDim.x, BIDX};
  EpiRawBf16 E{wsp<u16>(p, OFF_Z), 4096};
  gemm_phase<true, false>(lds, 2048, 512, 4, S, E);
}
struct SchedE2 { const char* ws; bool skipctx; int G, c;
  DEVI bool next(int i, Unit& u) const { int pm, pn; if (!tile_order(i >> 1, G, c, skipctx ? 128 : 136, 8, pm, pn)) return false;
    pm = pm_map(pm, skipctx); const int pr = i & 1;
    u.A = ws + OFF_H + uoff((unsigned)pm * 256u * 2048u); u.B = ws + OFF_WGATE + uoff((unsigned)(pr * 8 + pn) * 256u * 2048u); u.rows = nullptr; u.nvalid = 0;
    u.u0 = pm * 256; u.u1 = pn * 128; u.u2 = pr; u.u3 = 0; return true; } };
struct EpiE2 { const u16* Z; u16* Y; const float* bias;
  DEVI void init(f32x4 (&acc)[2][2][4][2], const Unit& u, int wr, int wc, int fr, int fq) const {
    const int col0 = u.u1 + wc * 32 + 8 * fq;
#pragma unroll
    for (int bj = 0; bj < 2; ++bj)
#pragma unroll
      for (int nn = 0; nn < 2; ++nn) {
        const f32x4 b = *(const f32x4*)(bias + (2 * u.u2 + bj) * 1024 + col0 + 4 * nn);
#pragma unroll
        for (int a = 0; a < 2; ++a)
#pragma unroll
          for (int m = 0; m < 4; ++m) acc[a][bj][m][nn] = b;
      }
  }
  DEVI void operator()(const f32x4 (&acc)[2][2][4][2], const Unit& u, int wr, int wc, int fr, int fq) const {
    const int row0 = u.u0 + wr * 64 + fr, col0 = u.u1 + wc * 32 + 8 * fq, pr = u.u2;
    u32x4 zc[2], yc, zn[2], yn;
    auto ldrow = [&](int g, u32x4 (&z)[2], u32x4& y) {
      const size_t r = (size_t)(row0 + (g >> 2) * HALF + (g & 3) * 16);
#pragma unroll
      for (int bj = 0; bj < 2; ++bj) z[bj] = *(const u32x4*)(Z + r * 4096 + (2 * pr + bj) * 1024 + col0);
      y = pr ? *(const u32x4*)(Y + r * 1024 + col0) : u32x4{0u, 0u, 0u, 0u};
    };
    ldrow(0, zc, yc);
#pragma unroll
    for (int g = 0; g < 8; ++g) {
      const int ai = g >> 2, m = g & 3;
      if (g + 1 < 8) ldrow(g + 1, zn, yn);
      const size_t r = (size_t)(row0 + ai * HALF + m * 16);
      float t[8];
      {
        const unsigned w[4] = {yc.x, yc.y, yc.z, yc.w};
#pragma unroll
        for (int i = 0; i < 4; ++i) { t[2 * i] = __uint_as_float(w[i] << 16); t[2 * i + 1] = __uint_as_float(w[i] & 0xffff0000u); }
      }
#pragma unroll
      for (int bj = 0; bj < 2; ++bj) {
        const unsigned w[4] = {zc[bj].x, zc[bj].y, zc[bj].z, zc[bj].w};
#pragma unroll
        for (int nn = 0; nn < 2; ++nn)
#pragma unroll
          for (int j = 0; j < 4; ++j) {
            const int e = 4 * nn + j;
            const float zz = (e & 1) ? __uint_as_float(w[e >> 1] & 0xffff0000u) : __uint_as_float(w[e >> 1] << 16);
            const float gte = __builtin_amdgcn_rcpf(1.f + __expf(-acc[ai][bj][m][nn][j]));
            t[e] += gte * zz;
          }
      }
      u32x4 o; o.x = pk2(t[0], t[1]); o.y = pk2(t[2], t[3]); o.z = pk2(t[4], t[5]); o.w = pk2(t[6], t[7]);
      *(u32x4*)(Y + r * 1024 + col0) = o;
      zc[0] = zn[0]; zc[1] = zn[1]; yc = yn;
    }
  }
};
DEVI void phaseE2(KP p, int l, ldsp_t lds) {
  SchedE2 S{(const char*)p->ws, l == 1, (int)gridDim.x, BIDX};
  EpiE2 E{wsp<u16>(p, OFF_Z), wsp<u16>(p, OFF_YPRE), p->b_gate + (size_t)l * 4 * 1024};
  gemm_phase<true, false>(lds, 2048, 2048, 16, S, E);
}
struct SchedF { const char* ws; bool skipctx; int G, c;
  DEVI bool next(int i, Unit& u) const { int pm, pn; if (!tile_order(i, G, c, skipctx ? 128 : 136, 4, pm, pn)) return false;
    pm = pm_map(pm, skipctx);
    u.A = ws + OFF_YPRE + uoff((unsigned)pm * 256u * 2048u); u.B = ws + OFF_WOUT + uoff((unsigned)pn * 256u * 2048u); u.rows = nullptr; u.nvalid = 0;
    u.u0 = pm; u.u1 = pn * 256; u.u2 = 0; u.u3 = 0; return true; } };
struct EpiF { KP p; int l;
  DEVI void init(f32x4 (&acc)[2][2][4][2], const Unit&, int, int, int, int) const { acc_zero(acc); }
  DEVI void operator()(const f32x4 (&acc)[2][2][4][2], const Unit& u, int wr, int wc, int fr, int fq) const {
    const int pm = u.u0, b = pm / 17, rr0 = (pm % 17) * 256;
    const int mrow = (rr0 < NCTX) ? 8 : b;
    const int col0 = u.u1 + wc * 32 + 4 * fq;
    const float* gt = wsp<float>(p, OFF_MOD) + ((size_t)l * 9 + mrow) * 6144 + 2048 + col0;
    const float* xin = xrow_in(p, l, b, rr0) + col0;
    float* xout = xrow_res(p, b, rr0) + col0;
    f32x4 gv[2][2];
#pragma unroll
    for (int bj = 0; bj < 2; ++bj)
#pragma unroll
      for (int n = 0; n < 2; ++n) gv[bj][n] = *(const f32x4*)(gt + bj * HALF + n * 16);
#pragma unroll
    for (int ai = 0; ai < 2; ++ai)
#pragma unroll
      for (int mp = 0; mp < 2; ++mp) {
        f32x4 xo[2][2][2];
#pragma unroll
        for (int mm = 0; mm < 2; ++mm) {
          const size_t ro = (size_t)(wr * 64 + fr + ai * HALF + (2 * mp + mm) * 16) * 1024;
#pragma unroll
          for (int bj = 0; bj < 2; ++bj)
#pragma unroll
            for (int n = 0; n < 2; ++n) xo[mm][bj][n] = *(const f32x4*)(xin + ro + bj * HALF + n * 16);
        }
#pragma unroll
        for (int mm = 0; mm < 2; ++mm) {
          const int m = 2 * mp + mm;
          const size_t ro = (size_t)(wr * 64 + fr + ai * HALF + m * 16) * 1024;
#pragma unroll
          for (int bj = 0; bj < 2; ++bj)
#pragma unroll
            for (int n = 0; n < 2; ++n) *(f32x4*)(xout + ro + bj * HALF + n * 16) = xo[mm][bj][n] + gv[bj][n] * acc[ai][bj][m][n];
        }
      }
  }
};
DEVI void phaseF2(KP p, int l, ldsp_t lds) {
  SchedF S{(const char*)p->ws, l == 1, (int)gridDim.x, BIDX};
  EpiF E{p, l};
  gemm_phase<false, false>(lds, 2048, 2048, 16, S, E);
}


DEVI void conv_tile_wave(const ConvT& c, LAS float* t, int lane) {
  const int kk = lane >> 3, n4 = (lane & 7) * 4;
  const float* sp = (c.src2 && n4 >= 16) ? c.src2 + (n4 - 16) : (c.src ? c.src + n4 : nullptr);
  f32x4 v[8];
#pragma unroll
  for (int i = 0; i < 8; ++i) v[i] = sp ? *(const f32x4*)(sp + (size_t)(kk + 8 * i) * c.ld) : f32x4{0.f, 0.f, 0.f, 0.f};
#pragma unroll
  for (int i = 0; i < 8; ++i) {
    const int k = kk + 8 * i;
    const float s = (c.ks ? c.ks[k] : 1.f) * c.mul;
    t[(n4 + 0) * 65 + k] = v[i].x * s; t[(n4 + 1) * 65 + k] = v[i].y * s;
    t[(n4 + 2) * 65 + k] = v[i].z * s; t[(n4 + 3) * 65 + k] = v[i].w * s;
  }
  asm volatile("s_waitcnt lgkmcnt(0)" ::: "memory");
  const int n = lane >> 1, k0 = (lane & 1) * 32;
  const LAS float* r = t + n * 65 + k0;
  u16* d = c.dst + (size_t)n * c.ldd + k0;
#pragma unroll
  for (int q = 0; q < 4; ++q) {
    u32x4 o;
    o.x = pk2(r[8 * q], r[8 * q + 1]); o.y = pk2(r[8 * q + 2], r[8 * q + 3]); o.z = pk2(r[8 * q + 4], r[8 * q + 5]); o.w = pk2(r[8 * q + 6], r[8 * q + 7]);
    *(u32x4*)(d + 8 * q) = o;
  }
  asm volatile("s_waitcnt lgkmcnt(0)" ::: "memory");
}
DEVI void conv_items2(KP p, int l, ldsp_t lds, int first_item, int total_items) {
  const int tid = TIDX, wave = __builtin_amdgcn_readfirstlane(tid >> 6), lane = tid & 63;
  LAS float* t = (LAS float*)(lds + wave * 8448);
  __syncthreads();
  for (int item = BIDX * NW + wave; item < total_items; item += gridDim.x * NW) {
    ConvT c = conv_decode(p, l, item - first_item);
    conv_tile_wave(c, t, lane);
  }
}
DEVI void phase0_2(KP p, ldsp_t lds) {
  const int tid = TIDX, half = tid >> 8, htid = tid & 255;
  for (int it = BIDX * 2; it < 458; it += gridDim.x * 2) {
    const int item = it + half;
    LAS float* sc = (LAS float*)(lds + half * 16384);
    const bool ismod = item < 384;
    const int l = item / 192, rem = item % 192, cgp = rem >> 3, kc = rem & 7;
    __syncthreads();
    if (ismod) {
      for (int i = htid; i < 9 * 128; i += 256) {
        int b = i >> 7, k = i & 127;
        float v = (b < 8) ? p->c[b * 1024 + kc * 128 + k] : p->c_ctx[kc * 128 + k];
        sc[i] = v / (1.f + expf(-v));
      }
    }
    __syncthreads();
    if (ismod) {
      float acc[9];
#pragma unroll
      for (int b = 0; b < 9; ++b) acc[b] = 0.f;
      const float* w = p->w_mod + ((size_t)l * 1024 + kc * 128) * 6144 + cgp * 256 + htid;
#pragma unroll 8
      for (int k = 0; k < 128; ++k) {
        float wv = w[(size_t)k * 6144];
#pragma unroll
        for (int b = 0; b < 9; ++b) acc[b] += sc[b * 128 + k] * wv;
      }
      float* dst = wsp<float>(p, OFF_MODP) + (size_t)((kc * 2 + l) * 9) * 6144 + cgp * 256 + htid;
#pragma unroll
      for (int b = 0; b < 9; ++b) dst[(size_t)b * 6144] = acc[b];
    } else if (item == 384) {
      float* cs32 = wsp<float>(p, OFF_CS32);
      float* cs16 = wsp<float>(p, OFF_CS16);
      for (int t = htid; t < 1024; t += 256) {
        int pos = t >> 4, i = t & 15;
        float ang = (float)pos * powf(10000.f, -(float)(2 * i) / 32.f);
        cs32[t * 2] = cosf(ang); cs32[t * 2 + 1] = sinf(ang);
      }
      for (int t = htid; t < 512; t += 256) {
        int pos = t >> 3, i = t & 7;
        float ang = (float)pos * powf(10000.f, -(float)(2 * i) / 16.f);
        cs16[t * 2] = cosf(ang); cs16[t * 2 + 1] = sinf(ang);
      }
    } else if (item < 457) {
      const int q = item - 385, ll = q / 36, o = q % 36;
      float* dst = wsp<float>(p, OFF_WRT) + ((size_t)ll * 36 + o) * 1024;
      for (int k = htid; k < 1024; k += 256)
        dst[k] = (o < 4) ? p->w_group[((size_t)ll * 1024 + k) * 4 + o] : p->w_router[((size_t)ll * 1024 + k) * 32 + (o - 4)];
    }
  }
  conv_items2(p, 0, lds, 0, CONV_ITEMS);
}
DEVI void phase1_2(KP p) {
  const float* mp = wsp<float>(p, OFF_MODP);
  float* mo = wsp<float>(p, OFF_MOD);
  for (int i = BIDX * 512 + TIDX; i < 2 * 9 * 6144; i += gridDim.x * 512) {
    int l = i / (9 * 6144), o = i % 6144;
    float s = p->b_mod[l * 6144 + o];
#pragma unroll
    for (int kc = 0; kc < 8; ++kc) s += mp[(size_t)kc * 2 * 9 * 6144 + i];
    mo[i] = s;
  }
}
DEVI void phaseA2(KP p) {
  const int gw = BIDX * NW + (TIDX >> 6), nw = gridDim.x * NW;
  u16* H = wsp<u16>(p, OFF_H);
  for (int tok0 = gw; tok0 < NTOK; tok0 += 2 * nw) {
    float xv[2][16];
#pragma unroll
    for (int r = 0; r < 2; ++r) { const int tok = tok0 + r * nw; if (tok < NTOK) load_row16(xrow_in(p, 0, tok / TPB, tok % TPB), xv[r]); }
#pragma unroll
    for (int r = 0; r < 2; ++r) {
      const int tok = tok0 + r * nw;
      if (tok < NTOK) { float hv[16]; modulate_row_store(p, 0, 0, xv[r], (tok % TPB) < NCTX ? 8 : tok / TPB, H + (size_t)tok * 1024, hv); }
    }
  }
}
DEVI void phaseG2(KP p, int l, ldsp_t lds) {
  constexpr int HS = 1026;
  const int tid = TIDX, lane = tid & 63, wave = __builtin_amdgcn_readfirstlane(tid >> 6);
  const int r32 = lane & 31, kh = lane >> 5, qd = lane >> 4;
  u16* H = wsp<u16>(p, OFF_H);
  const float* WRT = wsp<float>(p, OFF_WRT) + (size_t)l * 36 * 1024;
  int* cnt = wsp<int>(p, OFF_CNT);
  int* list = wsp<int>(p, OFF_LIST);
  float* wlist = wsp<float>(p, OFF_WLIST);
  LAS float* h2t = (LAS float*)lds;
  LAS float* part = (LAS float*)lds;
  LAS int* gsel = (LAS int*)(lds + 32 * HS * 4);
  LAS float* gwt = (LAS float*)(lds + 32 * HS * 4 + 128);
  float wreg[64];
  {
    const float* wr = p->w_router + (size_t)l * 1024 * 32 + r32;
#pragma unroll
    for (int t = 0; t < 32; ++t) {
      const int k = 128 * wave + 4 * t + 2 * kh;
      wreg[2 * t] = wr[(size_t)k * 32]; wreg[2 * t + 1] = wr[(size_t)(k + 1) * 32];
    }
  }
  for (int tile = BIDX; tile < NTOK / 32; tile += gridDim.x) {
    const int tok0 = tile * 32, b = tok0 / TPB, rr0 = tok0 % TPB;
    if (l == 1 && rr0 < NCTX) continue;
    {
      float hv[4][16];
#pragma unroll
      for (int r = 0; r < 4; ++r) {
        float xv[16];
        load_row16(xrow_res(p, b, rr0 + wave * 4 + r), xv);
        modulate_row_store(p, l, 1, xv, (rr0 < NCTX) ? 8 : b, H + (size_t)(tok0 + wave * 4 + r) * 1024, hv[r]);
        LAS float* dst = h2t + (wave * 4 + r) * HS + lane * 4;
#pragma unroll
        for (int i = 0; i < 4; ++i) {
          *(LAS f32x2*)(dst + i * 256) = f32x2{hv[r][i * 4], hv[r][i * 4 + 1]};
          *(LAS f32x2*)(dst + i * 256 + 2) = f32x2{hv[r][i * 4 + 2], hv[r][i * 4 + 3]};
        }
      }
      float gl[4];
#pragma unroll
      for (int o = 0; o < 4; ++o) gl[o] = router_dot(hv, WRT + (size_t)o * 1024) + p->b_group[l * 4 + o];
      int gs = 0; float best = gl[0];
#pragma unroll
      for (int j = 1; j < 4; ++j) if (gl[j] > best) { best = gl[j]; gs = j; }
      float gsum = 0.f;
#pragma unroll
      for (int j = 0; j < 4; ++j) gsum += expf(gl[j] - best);
      if ((lane & 15) == 0) { gsel[wave * 4 + qd] = gs; gwt[wave * 4 + qd] = 1.f / gsum; }
    }
    __syncthreads();
    f32x16 acc;
#pragma unroll
    for (int i = 0; i < 16; ++i) acc[i] = 0.f;
    {
      const LAS float* ap = h2t + r32 * HS + 128 * wave + 2 * kh;
#pragma unroll
      for (int t = 0; t < 32; ++t) {
        const f32x2 a = *(const LAS f32x2*)(ap + 4 * t);
        acc = __builtin_amdgcn_mfma_f32_32x32x2f32(a.x, wreg[2 * t], acc, 0, 0, 0);
        acc = __builtin_amdgcn_mfma_f32_32x32x2f32(a.y, wreg[2 * t + 1], acc, 0, 0, 0);
      }
    }
    __syncthreads();
#pragma unroll
    for (int i = 0; i < 16; ++i) part[(wave * 32 + (i & 3) + 8 * (i >> 2) + 4 * kh) * 33 + r32] = acc[i];
    __syncthreads();
    if (tid < 32) {
      const int gs = gsel[tid];
      const float gw_ = gwt[tid];
      float e8[8];
#pragma unroll
      for (int j = 0; j < 8; ++j) {
        float v = p->b_router[l * 32 + gs * 8 + j];
#pragma unroll
        for (int w = 0; w < 8; ++w) v += part[(w * 32 + tid) * 33 + gs * 8 + j];
        e8[j] = v;
      }
      int i0 = 0; float v0 = e8[0];
#pragma unroll
      for (int j = 1; j < 8; ++j) if (e8[j] > v0) { v0 = e8[j]; i0 = j; }
      int i1 = -1; float v1 = -INFINITY;
#pragma unroll
      for (int j = 0; j < 8; ++j) if (j != i0 && e8[j] > v1) { v1 = e8[j]; i1 = j; }
      const float ex = expf(v1 - v0);
      const float w0 = gw_ / (1.f + ex), w1 = gw_ * ex / (1.f + ex);
      const int tok = tok0 + tid;
      const int ea = gs * 8 + i0, eb = gs * 8 + i1;
      const int sa = atomicAdd(&cnt[ea * CNT_STRIDE], 1);
      const int sb = atomicAdd(&cnt[eb * CNT_STRIDE], 1);
      list[(size_t)ea * NTOK + sa] = tok * 2; wlist[(size_t)ea * NTOK + sa] = w0;
      list[(size_t)eb * NTOK + sb] = tok * 2 + 1; wlist[(size_t)eb * NTOK + sb] = w1;
    }
    __syncthreads();
  }
}
struct ExpInfo2 { int tiles[4], base[4], cnt[4]; };
DEVI ExpInfo2 exp_info2(KP p, int xcd) {
  const int* cnt = wsp<int>(p, OFF_CNT);
  ExpInfo2 ei;
  int before = 0;
#pragma unroll
  for (int e = 0; e < 32; ++e) {
    const int c = __builtin_amdgcn_readfirstlane(cnt[e * CNT_STRIDE]), t = (c + 255) >> 8;
    if ((e & 7) == xcd) { ei.tiles[e >> 3] = t; ei.base[e >> 3] = before; ei.cnt[e >> 3] = c; }
    before += t;
  }
  return ei;
}
template <int NN>
struct SchedX { ExpInfo2 ei; int xcd, lb, G8; const char* A; const char* W; const int* list; size_t wstride; int lda_b;
  DEVI bool next(int i, Unit& u) const {
    const int tot = (ei.tiles[0] + ei.tiles[1] + ei.tiles[2] + ei.tiles[3]) * NN;
    const int n = i * G8 + lb; if (n >= tot) return false;
    int k = 0, m = n / NN; const int pn = n % NN;
    int tb = ei.base[0], ce = ei.cnt[0];
#pragma unroll
    for (int kk = 0; kk < 3; ++kk) { if (k == kk && m >= ei.tiles[kk]) { m -= ei.tiles[kk]; k = kk + 1; tb = ei.base[kk + 1]; ce = ei.cnt[kk + 1]; } }
    const int e = xcd + 8 * k;
    u.rows = list + (size_t)e * NTOK + m * 256; u.nvalid = ce - m * 256;
    u.A = A + (NN == 2 ? 0u : uoff((unsigned)(tb + m) * 256u * (unsigned)lda_b));
    u.B = W + uoff((unsigned)e * (unsigned)wstride + (unsigned)pn * 256u * (NN == 2 ? 2048u : 512u));
    u.u0 = (tb + m) * 256; u.u1 = pn; u.u2 = e; u.u3 = m; return true; } };
struct EpiI1 { u16* U;
  DEVI void init(f32x4 (&acc)[2][2][4][2], const Unit&, int, int, int, int) const { acc_zero(acc); }
  DEVI void operator()(const f32x4 (&acc)[2][2][4][2], const Unit& u, int wr, int wc, int fr, int fq) const {
#pragma unroll
    for (int ai = 0; ai < 2; ++ai)
#pragma unroll
      for (int m = 0; m < 4; ++m) {
        u16* rowp = U + (size_t)(u.u0 + ai * HALF + wr * 64 + m * 16 + fr) * 256;
#pragma unroll
        for (int bj = 0; bj < 2; ++bj) {
          const int ff = 16 * (8 * u.u1 + 4 * bj + wc) + 4 * fq;
          const f32x4 g = acc[ai][bj][m][0], up = acc[ai][bj][m][1];
          float t[4];
#pragma unroll
          for (int j = 0; j < 4; ++j) t[j] = g[j] / (1.f + __expf(-g[j])) * up[j];
          u32x2 o; o.x = pk2(t[0], t[1]); o.y = pk2(t[2], t[3]);
          *(u32x2*)(rowp + ff) = o;
        }
      }
  }
};
DEVI void phaseI1_2(KP p, ldsp_t lds) {
  const int xcd = BIDX & 7, lb = BIDX >> 3, G8 = gridDim.x >> 3;
  if (lb >= G8) return;
  SchedX<2> S{exp_info2(p, xcd), xcd, lb, G8, (const char*)wsp<u16>(p, OFF_H), (const char*)wsp<u16>(p, OFF_W13), wsp<int>(p, OFF_LIST), (size_t)512 * 2048, 2048};
  EpiI1 E{wsp<u16>(p, OFF_U)};
  int nt = 16; asm volatile("" : "+s"(nt));
  gemm_phase<false, true>(lds, 2048, 2048, nt, S, E);
}
struct EpiI2 { u16* YS; const float* wlist; const int* list;
  DEVI void init(f32x4 (&acc)[2][2][4][2], const Unit&, int, int, int, int) const { acc_zero(acc); }
  DEVI void operator()(const f32x4 (&acc)[2][2][4][2], const Unit& u, int wr, int wc, int fr, int fq) const {
    const unsigned colb = (unsigned)(u.u1 * 256 + wc * 32 + 8 * fq) * 2u;
    const float* we = wlist + (u.rows - list);
    unsigned dest[2][4]; float w[2][4];
#pragma unroll
    for (int ai = 0; ai < 2; ++ai)
#pragma unroll
      for (int m = 0; m < 4; ++m) {
        const int r = ai * HALF + wr * 64 + m * 16 + fr;
        dest[ai][m] = (r < u.nvalid) ? (unsigned)u.rows[r] : (unsigned)(2 * NTOK);
        w[ai][m] = we[r];
      }
#pragma unroll
    for (int ai = 0; ai < 2; ++ai)
#pragma unroll
      for (int m = 0; m < 4; ++m) {
        char* rowp = (char*)YS + (dest[ai][m] * 2048u + colb);
#pragma unroll
        for (int bj = 0; bj < 2; ++bj) {
          const f32x4 v0 = acc[ai][bj][m][0] * w[ai][m], v1 = acc[ai][bj][m][1] * w[ai][m];
          u32x4 o; o.x = pk2(v0[0], v0[1]); o.y = pk2(v0[2], v0[3]); o.z = pk2(v1[0], v1[1]); o.w = pk2(v1[2], v1[3]);
          *(u32x4*)(rowp + bj * 256) = o;
        }
      }
  }
};
DEVI void phaseI2_2(KP p, ldsp_t lds) {
  const int xcd = BIDX & 7, lb = BIDX >> 3, G8 = gridDim.x >> 3;
  if (lb >= G8) return;
  SchedX<4> S{exp_info2(p, xcd), xcd, lb, G8, (const char*)wsp<u16>(p, OFF_U), (const char*)wsp<u16>(p, OFF_W2), wsp<int>(p, OFF_LIST), (size_t)1024 * 512, 512};
  EpiI2 E{wsp<u16>(p, OFF_YS), wsp<float>(p, OFF_WLIST), wsp<int>(p, OFF_LIST)};
  int nt = 4; asm volatile("" : "+s"(nt));
  gemm_phase<true, false>(lds, 512, 512, nt, S, E);
}
DEVI void phaseJ2(KP p, int l, ldsp_t lds) {
  const int lane = TIDX & 63;
  const int gw = BIDX * NW + (TIDX >> 6), nw = gridDim.x * NW;
  const u16* YS = wsp<u16>(p, OFF_YS);
  u16* H = wsp<u16>(p, OFF_H);
  for (int tok0 = gw; tok0 < NTOK; tok0 += 2 * nw) {
    float xv[2][16]; u32x2 y0[2][4], y1[2][4]; bool ok[2]; int tk[2];
#pragma unroll
    for (int r = 0; r < 2; ++r) {
      const int tok = tok0 + r * nw;
      tk[r] = tok;
      ok[r] = (tok < NTOK) && !(l == 1 && (tok % TPB) < NCTX);
      if (ok[r]) {
        const int b = tok / TPB, rr = tok % TPB;
        load_row16(xrow_res(p, b, rr), xv[r]);
#pragma unroll
        for (int i = 0; i < 4; ++i) {
          const int c = i * 256 + lane * 4;
          y0[r][i] = *(const u32x2*)(YS + (size_t)(tok * 2) * 1024 + c);
          y1[r][i] = *(const u32x2*)(YS + (size_t)(tok * 2 + 1) * 1024 + c);
        }
      }
    }
#pragma unroll
    for (int r = 0; r < 2; ++r) {
      if (!ok[r]) continue;
      const int tok = tk[r];
      const int b = tok / TPB, rr = tok % TPB;
      const int mrow = (rr < NCTX) ? 8 : b;
      float* xr = xrow_res(p, b, rr);
      const float* gt = wsp<float>(p, OFF_MOD) + ((size_t)l * 9 + mrow) * 6144 + 5120;
#pragma unroll
      for (int i = 0; i < 4; ++i) {
        const int c = i * 256 + lane * 4;
        const f32x4 g = *(const f32x4*)(gt + c);
        xv[r][i * 4 + 0] += g.x * (bf2f((u16)(y0[r][i].x & 0xffff)) + bf2f((u16)(y1[r][i].x & 0xffff)));
        xv[r][i * 4 + 1] += g.y * (bf2f((u16)(y0[r][i].x >> 16)) + bf2f((u16)(y1[r][i].x >> 16)));
        xv[r][i * 4 + 2] += g.z * (bf2f((u16)(y0[r][i].y & 0xffff)) + bf2f((u16)(y1[r][i].y & 0xffff)));
        xv[r][i * 4 + 3] += g.w * (bf2f((u16)(y0[r][i].y >> 16)) + bf2f((u16)(y1[r][i].y >> 16)));
      }
      if (l == 0) {
#pragma unroll
        for (int i = 0; i < 4; ++i)
          *(f32x4*)(xr + i * 256 + lane * 4) = f32x4{xv[r][i * 4], xv[r][i * 4 + 1], xv[r][i * 4 + 2], xv[r][i * 4 + 3]};
        float hv[16];
        modulate_row_store(p, 1, 0, xv[r], mrow, H + (size_t)tok * 1024, hv);
      } else {
        float ss = 0.f;
#pragma unroll
        for (int i = 0; i < 16; ++i) ss += xv[r][i] * xv[r][i];
        ss = wave_sum(ss);
        const float rstd = rsqrtf(ss * (1.f / 1024.f) + EPS);
#pragma unroll
        for (int i = 0; i < 4; ++i) {
          const int c = i * 256 + lane * 4;
          const f32x4 g = *(const f32x4*)(p->g_final + c);
          *(f32x4*)(xr + c) = f32x4{xv[r][i * 4] * rstd * g.x, xv[r][i * 4 + 1] * rstd * g.y, xv[r][i * 4 + 2] * rstd * g.z, xv[r][i * 4 + 3] * rstd * g.w};
        }
      }
    }
  }
  if (l == 0) conv_items2(p, 1, lds, 0, CONV_ITEMS);
}

constexpr int N_PHASES = 3 + 2 * 11;
__global__ void __launch_bounds__(512, 2) fwd_v2(Params parg) {
  extern __shared__ __attribute__((aligned(16))) unsigned char dyn_lds[];
  const ldsp_t lds = (ldsp_t)dyn_lds;
  cg::grid_group grid = cg::this_grid();
  volatile LAS unsigned* xb_st = (volatile LAS unsigned*)(lds + LDS_BARW);
  if (TIDX < 4) xb_st[TIDX] = 0u;
  __syncthreads();
  if (parg.ph_end - parg.ph_begin > 1) xcd_barrier_post((unsigned*)(parg.ws + OFF_BAR));
  for (int ph = parg.ph_begin; ph < parg.ph_end; ++ph) {
    KP p = (KP)__builtin_amdgcn_kernarg_segment_ptr();
    asm volatile("" : "+s"(p));
    const int l = (ph >= 14) ? 1 : 0;
    const int k = (ph < 3) ? ph : 3 + (ph - 3) % 11;
    const int reps = (((PROBE_DUP >> k) & 1) && (!(PROBE_DUP & 0x10000) || l == 0)) ? 2 : 1;
    for (int rep = 0; rep < reps; ++rep) {
      if (rep) {
        xcd_barrier((unsigned*)(p->ws + OFF_BAR), xb_st);
        if (k == 10) { if (BIDX == 0 && TIDX < 32) wsp<int>(p, OFF_CNT)[TIDX * CNT_STRIDE] = 0; xcd_barrier((unsigned*)(p->ws + OFF_BAR), xb_st); }
      }
      switch (k) {
        case 0: phase0_2(p, lds); break;
        case 1: phase1_2(p); break;
        case 2: phaseA2(p); break;
        case 3: phaseB2(p, lds); break;
        case 4: phaseC2(p, lds); break;
        case 5: phaseP2(p, l, lds); break;
        case 6: phaseD2(p, l, lds); break;
        case 7: phaseE1(p, l, lds); break;
        case 8: phaseE2(p, l, lds); break;
        case 9: phaseF2(p, l, lds); break;
        case 10: phaseG2(p, l, lds); break;
        case 11: phaseI1_2(p, lds); break;
        case 12: phaseI2_2(p, lds); break;
        default: phaseJ2(p, l, lds); break;
      }
    }
    if (ph + 1 < parg.ph_end) {
      if (ph == parg.ph_begin) grid.sync();
      else xcd_barrier((unsigned*)(p->ws + OFF_BAR), xb_st);
    }
  }
}
}

extern "C" void kernel_launch(void* const* d_in, const int* in_sizes, int n_in, void* d_out, int out_size,
                              void* d_ws, size_t ws_size, hipStream_t stream) {
  static int grid2 = 0;
  if (!grid2) {
    int dev = 0, cus = 0, per_cu = 0;
    (void)hipGetDevice(&dev);
    (void)hipDeviceGetAttribute(&cus, hipDeviceAttributeMultiprocessorCount, dev);
    (void)hipFuncSetAttribute((const void*)v2::fwd_v2, hipFuncAttributeMaxDynamicSharedMemorySize, v2::LDS_TOTAL);
    (void)hipOccupancyMaxActiveBlocksPerMultiprocessor(&per_cu, v2::fwd_v2, 512, v2::LDS_TOTAL);
    if (per_cu < 1) { fprintf(stderr, "kernel does not fit on a CU\n"); per_cu = 1; }
    grid2 = cus & ~7;
  }
  if (ws_size < WS_NEEDED) { fprintf(stderr, "workspace too small: %zu < %zu\n", ws_size, (size_t)WS_NEEDED); return; }
  Params hp{};
  const float** f = (const float**)&hp;
  for (int i = 0; i < 29; ++i) f[i] = (const float*)d_in[i];
  hp.out = (float*)d_out;
  hp.ws = (char*)d_ws;
#if N_LAUNCH_MODE == 1
  for (int ph = 0; ph < v2::N_PHASES; ++ph) {
    hp.ph_begin = ph; hp.ph_end = ph + 1;
    void* args[] = {&hp};
    hipError_t e = hipLaunchCooperativeKernel((void*)v2::fwd_v2, dim3(grid2), dim3(512), args, v2::LDS_TOTAL, stream);
    if (e != hipSuccess) fprintf(stderr, "launch failed: %s\n", hipGetErrorString(e));
  }
#else
  hp.ph_begin = 0; hp.ph_end = v2::N_PHASES;
  (void)hipMemsetAsync((char*)d_ws + OFF_BAR, 0, (size_t)XCD_BAR_WORDS * 4, stream);
  void* args[] = {&hp};
  hipError_t e = hipLaunchCooperativeKernel((void*)v2::fwd_v2, dim3(grid2), dim3(512), args, v2::LDS_TOTAL, stream);
  if (e != hipSuccess) fprintf(stderr, "cooperative launch failed: %s (grid %d)\n", hipGetErrorString(e), grid2);
#endif
}
```

```cpp
#include <hip/hip_runtime.h>
#include <hip/hip_cooperative_groups.h>
#include <stdint.h>
#include <stdio.h>
namespace cg = cooperative_groups;

#ifndef N_LAUNCH_MODE
#define N_LAUNCH_MODE 0
#endif

#ifndef PROBE_DUP
#define PROBE_DUP 0
#endif
#define DEVI __device__ __forceinline__
typedef unsigned short u16;
typedef __attribute__((ext_vector_type(2))) float f32x2;
typedef __attribute__((ext_vector_type(2))) __bf16 bf16x2_t;
typedef __attribute__((ext_vector_type(8))) short bf16x8;
typedef __attribute__((ext_vector_type(16))) float f32x16;
typedef __attribute__((ext_vector_type(4))) unsigned u32x4;
typedef __attribute__((ext_vector_type(2))) unsigned u32x2;
typedef __attribute__((ext_vector_type(4))) float f32x4;
#define MFMA(a, b, c) __builtin_amdgcn_mfma_f32_32x32x16_bf16((a), (b), (c), 0, 0, 0)

constexpr int DMODEL = 1024, NBATCH = 8, SEQ = 4096, NCTX = 256;
constexpr int TPB = SEQ + NCTX;
constexpr int NTOK = NBATCH * TPB;
constexpr int MT_PER_B = TPB / 128;
constexpr int NEXP = 32;
constexpr int INP = 2304;
constexpr float EPS = 1e-6f;
constexpr float LOG2E = 1.4426950408889634f;
constexpr int SMEM_BYTES = 73728;
constexpr int UROWS = 2 * NTOK + NEXP * 256;

constexpr size_t al(size_t x) { return (x + 255) & ~(size_t)255; }
constexpr size_t OFF_WIN = 0;
constexpr size_t OFF_WQB = OFF_WIN + al((size_t)INP * 1024 * 2);
constexpr size_t OFF_WKVB = OFF_WQB + al((size_t)512 * 256 * 2);
constexpr size_t OFF_WGATE = OFF_WKVB + al((size_t)512 * 256 * 2);
constexpr size_t OFF_WBR = OFF_WGATE + al((size_t)4 * 1024 * 1024 * 2);
constexpr size_t OFF_WOUT = OFF_WBR + al((size_t)4 * 1024 * 256 * 2);
constexpr size_t OFF_W13 = OFF_WOUT + al((size_t)1024 * 1024 * 2);
constexpr size_t OFF_W2 = OFF_W13 + al((size_t)32 * 512 * 1024 * 2);
constexpr size_t OFF_MODP = OFF_W2 + al((size_t)32 * 1024 * 256 * 2);
constexpr size_t OFF_MOD = OFF_MODP + al((size_t)8 * 2 * 9 * 6144 * 4);
constexpr size_t OFF_CS32 = OFF_MOD + al((size_t)2 * 9 * 6144 * 4);
constexpr size_t OFF_CS16 = OFF_CS32 + al((size_t)64 * 16 * 2 * 4);
constexpr size_t OFF_WRT = OFF_CS16 + al((size_t)64 * 8 * 2 * 4);
constexpr size_t OFF_CNT = OFF_WRT + al((size_t)2 * 36 * 1024 * 4);
constexpr int CNT_STRIDE = 64;
constexpr size_t OFF_BAR = OFF_CNT + al(32 * CNT_STRIDE * 4);
constexpr int XCD_BAR_WORDS = 3456;
constexpr size_t OFF_CTXRES = OFF_BAR + al((size_t)XCD_BAR_WORDS * 4);
constexpr size_t OFF_H = OFF_CTXRES + al((size_t)8 * 256 * 1024 * 4);
constexpr size_t OFF_O = OFF_H + al((size_t)NTOK * 1024 * 2);
constexpr size_t OFF_SSQ = OFF_O + al((size_t)NTOK * 1024 * 2);
constexpr size_t OFF_LIST = OFF_SSQ + al((size_t)NTOK * 8 * 4);
constexpr size_t OFF_WLIST = OFF_LIST + al((size_t)32 * NTOK * 4);
constexpr size_t OFF_R1 = OFF_WLIST + al((size_t)32 * NTOK * 4);
constexpr int PLD = INP;
constexpr size_t OFF_PRAW = OFF_R1;
constexpr size_t OFF_QARAW = OFF_PRAW + (size_t)NTOK * INP * 2;
constexpr size_t OFF_KVARAW = OFF_QARAW + (size_t)NTOK * 512 * 2;
constexpr size_t OFF_VAT = OFF_KVARAW + (size_t)NTOK * 512 * 2;
constexpr size_t OFF_VBT = OFF_VAT + (size_t)NTOK * 256 * 2;
constexpr size_t OFF_VCT = OFF_VBT + (size_t)NTOK * 128 * 2;
constexpr size_t OFF_VDT = OFF_VCT + (size_t)NTOK * 256 * 2;
constexpr size_t OFF_END = OFF_VDT + (size_t)NTOK * 128 * 2;
constexpr size_t OFF_Z = OFF_R1;
constexpr size_t OFF_YPRE = OFF_O;
constexpr size_t OFF_U = OFF_R1;
constexpr size_t OFF_YS = OFF_R1 + al((size_t)UROWS * 256 * 2);
static_assert(OFF_Z + (size_t)NTOK * 4096 * 2 <= OFF_END, "alias overflow");
static_assert(OFF_YS + (size_t)(2 * NTOK + 1) * 1024 * 2 <= OFF_END, "alias overflow");
constexpr size_t WS_NEEDED = OFF_END;
static_assert(WS_NEEDED <= (size_t)536870912, "workspace budget (4 x largest tensor)");

struct Params {
  const float *x, *c, *ctx, *c_ctx, *w_mod, *b_mod, *g_norm_mix, *w_in, *g_q_a, *w_q_b, *g_kv_a, *w_kv_b,
      *sink_b, *rpb_c, *g_q_d, *g_k_d, *w_gate, *b_gate, *w_branch, *w_out, *g_norm_ffn, *w_group, *b_group,
      *w_router, *b_router, *w_ff1, *w_ff3, *w_ff2, *g_final;
  float* out;
  char* ws;
  int ph_begin, ph_end;
};

DEVI int tid_fresh() { int t; asm volatile("v_mov_b32 %0, %1" : "=v"(t) : "v"(__builtin_amdgcn_workitem_id_x())); return t; }
DEVI int bid_fresh() { int t; asm volatile("s_mov_b32 %0, %1" : "=s"(t) : "s"(__builtin_amdgcn_workgroup_id_x())); return t; }
#define TIDX tid_fresh()
#define BIDX bid_fresh()
typedef const __attribute__((address_space(4))) Params* KP;
DEVI unsigned pk2(float a, float b) { f32x2 v = {a, b}; bf16x2_t r = __builtin_convertvector(v, bf16x2_t); return __builtin_bit_cast(unsigned, r); }
DEVI u16 f2bf(float a) { return (u16)(pk2(a, 0.f) & 0xffffu); }
DEVI float bf2f(u16 v) { return __uint_as_float(((unsigned)v) << 16); }
DEVI float wave_sum(float v) {
#pragma unroll
  for (int m = 32; m >= 1; m >>= 1) v += __shfl_xor(v, m);
  return v;
}
template <class T> DEVI T* wsp(KP p, size_t off) { return (T*)(p->ws + off); }
DEVI const float* xrow_in(KP p, int l, int b, int rr) {
  if (l == 0) return (rr < NCTX) ? p->ctx + ((size_t)b * NCTX + rr) * 1024 : p->x + ((size_t)b * SEQ + rr - NCTX) * 1024;
  return (rr < NCTX) ? wsp<float>(p, OFF_CTXRES) + ((size_t)b * NCTX + rr) * 1024 : p->out + ((size_t)b * SEQ + rr - NCTX) * 1024;
}
DEVI float* xrow_res(KP p, int b, int rr) {
  return (rr < NCTX) ? wsp<float>(p, OFF_CTXRES) + ((size_t)b * NCTX + rr) * 1024 : p->out + ((size_t)b * SEQ + rr - NCTX) * 1024;
}
DEVI int perm16(int k) { return (k & ~12) | ((k & 4) << 1) | ((k & 8) >> 1); }

struct ConvT { const float* src; const float* src2; const float* ks; u16* dst; int ld; int ldd; float mul; };
constexpr int CONV_ITEMS = 1152 + 64 + 64 + 2048 + 512 + 512 + 8192 + 4096;
DEVI ConvT conv_decode(KP p, int l, int idx) {
  ConvT c; c.ks = nullptr; c.mul = 1.f; c.src2 = nullptr;
  if (idx < 1152) {
    int nt = idx >> 4, kt = idx & 15, n0 = nt * 32;
    int sc = (n0 < 416) ? n0 : ((n0 < 512) ? -1 : n0 - 96);
    c.ld = 2208; c.ldd = 1024;
    if ((n0 >= 512 && n0 < 768) || (n0 >= 1024 && n0 < 1280)) c.mul = 0.125f * LOG2E;
    c.src = (sc < 0) ? nullptr : p->w_in + (size_t)l * 1024 * 2208 + (size_t)kt * 64 * 2208 + sc;
    c.dst = wsp<u16>(p, OFF_WIN) + (size_t)n0 * 1024 + kt * 64;
    return c;
  }
  idx -= 1152;
  if (idx < 64) {
    int nt = idx >> 2, kt = idx & 3;
    c.ld = 384; c.ldd = 256; c.ks = p->g_q_a + l * 256 + kt * 64;
    c.src = (nt >= 12) ? nullptr : p->w_q_b + (size_t)l * 256 * 384 + (size_t)kt * 64 * 384 + nt * 32;
    c.dst = wsp<u16>(p, OFF_WQB) + (size_t)nt * 32 * 256 + kt * 64;
    return c;
  }
  idx -= 64;
  if (idx < 64) {
    int nt = idx >> 2, kt = idx & 3;
    c.ld = 512; c.ldd = 256; c.ks = (kt < 2) ? p->g_kv_a + l * 128 + kt * 64 : nullptr;
    c.src = (kt >= 2) ? nullptr : p->w_kv_b + (size_t)l * 128 * 512 + (size_t)kt * 64 * 512 + nt * 32;
    c.dst = wsp<u16>(p, OFF_WKVB) + (size_t)nt * 32 * 256 + kt * 64;
    return c;
  }
  idx -= 64;
  if (idx < 2048) {
    int nt = idx >> 4, kt = idx & 15, R0 = nt * 32;
    int pr = R0 >> 11, cb = (R0 & 2047) >> 8, bj = (R0 & 255) >> 7, j0 = R0 & 127;
    c.ld = 1024; c.ldd = 1024;
    c.src = p->w_gate + ((size_t)(l * 4 + 2 * pr + bj) * 1024 + kt * 64) * 1024 + cb * 128 + j0;
    c.dst = wsp<u16>(p, OFF_WGATE) + (size_t)R0 * 1024 + kt * 64;
    return c;
  }
  idx -= 2048;
  if (idx < 512) {
    int br = idx >> 7, nt = (idx >> 2) & 31, kt = idx & 3;
    c.ld = 1024; c.ldd = 256;
    c.src = p->w_branch + ((size_t)(l * 4 + br) * 256 + kt * 64) * 1024 + nt * 32;
    c.dst = wsp<u16>(p, OFF_WBR) + ((size_t)br * 1024 + nt * 32) * 256 + kt * 64;
    return c;
  }
  idx -= 512;
  if (idx < 512) {
    int nt = idx >> 4, kt = idx & 15;
    c.ld = 1024; c.ldd = 1024;
    c.src = p->w_out + ((size_t)l * 1024 + kt * 64) * 1024 + nt * 32;
    c.dst = wsp<u16>(p, OFF_WOUT) + (size_t)nt * 32 * 1024 + kt * 64;
    return c;
  }
  idx -= 512;
  if (idx < 8192) {
    int e = idx >> 8, g32 = (idx >> 4) & 15, kt = idx & 15;
    c.ld = 256; c.ldd = 1024;
    c.src = p->w_ff1 + ((size_t)(l * 32 + e) * 1024 + kt * 64) * 256 + g32 * 16;
    c.src2 = p->w_ff3 + ((size_t)(l * 32 + e) * 1024 + kt * 64) * 256 + g32 * 16;
    c.dst = wsp<u16>(p, OFF_W13) + ((size_t)e * 512 + g32 * 32) * 1024 + kt * 64;
    return c;
  }
  idx -= 8192;
  {
    int e = idx >> 7, nt = (idx >> 2) & 31, kt = idx & 3;
    c.ld = 1024; c.ldd = 256;
    c.src = p->w_ff2 + ((size_t)(l * 32 + e) * 256 + kt * 64) * 1024 + nt * 32;
    c.dst = wsp<u16>(p, OFF_W2) + ((size_t)e * 1024 + nt * 32) * 256 + kt * 64;
    return c;
  }
}
DEVI void modulate_row_store(KP p, int l, int which, const float (&xv)[16], int mrow, u16* hrow, float (&hv)[16]) {
  const int lane = TIDX & 63;
  float ss = 0.f;
#pragma unroll
  for (int i = 0; i < 16; ++i) ss += xv[i] * xv[i];
  ss = wave_sum(ss);
  const float rstd = rsqrtf(ss * (1.f / 1024.f) + EPS);
  const float* g = (which ? p->g_norm_ffn : p->g_norm_mix) + l * 1024;
  const float* mod = wsp<float>(p, OFF_MOD) + ((size_t)l * 9 + mrow) * 6144 + (which ? 3072 : 0);
#pragma unroll
  for (int i = 0; i < 4; ++i) {
    const int c = i * 256 + lane * 4;
    f32x4 gv = *(const f32x4*)(g + c);
    f32x4 sh = *(const f32x4*)(mod + c);
    f32x4 sc = *(const f32x4*)(mod + 1024 + c);
    hv[i * 4 + 0] = xv[i * 4 + 0] * rstd * gv.x * (1.f + sc.x) + sh.x;
    hv[i * 4 + 1] = xv[i * 4 + 1] * rstd * gv.y * (1.f + sc.y) + sh.y;
    hv[i * 4 + 2] = xv[i * 4 + 2] * rstd * gv.z * (1.f + sc.z) + sh.z;
    hv[i * 4 + 3] = xv[i * 4 + 3] * rstd * gv.w * (1.f + sc.w) + sh.w;
    u32x2 o; o.x = pk2(hv[i * 4 + 0], hv[i * 4 + 1]); o.y = pk2(hv[i * 4 + 2], hv[i * 4 + 3]);
    *(u32x2*)(hrow + c) = o;
  }
}
DEVI void load_row16(const float* xr, float (&xv)[16]) {
  const int lane = TIDX & 63;
#pragma unroll
  for (int i = 0; i < 4; ++i) {
    f32x4 v = *(const f32x4*)(xr + i * 256 + lane * 4);
    xv[i * 4 + 0] = v.x; xv[i * 4 + 1] = v.y; xv[i * 4 + 2] = v.z; xv[i * 4 + 3] = v.w;
  }
}
DEVI float router_dot(const float (&hv)[4][16], const float* wrow) {
  const int lane = TIDX & 63;
  const float* w = wrow + lane * 4;
  float pr[4] = {0.f, 0.f, 0.f, 0.f};
#pragma unroll
  for (int i = 0; i < 4; ++i) {
    const f32x4 wv = *(const f32x4*)(w + i * 256);
#pragma unroll
    for (int r = 0; r < 4; ++r)
      pr[r] += hv[r][i * 4] * wv.x + hv[r][i * 4 + 1] * wv.y + hv[r][i * 4 + 2] * wv.z + hv[r][i * 4 + 3] * wv.w;
  }
  const bool up = (lane & 32) != 0;
  float s0 = up ? pr[0] : pr[2], s1 = up ? pr[1] : pr[3];
  float k0 = up ? pr[2] : pr[0], k1 = up ? pr[3] : pr[1];
  k0 += __shfl_xor(s0, 32); k1 += __shfl_xor(s1, 32);
  const bool up2 = (lane & 16) != 0;
  float sv = up2 ? k0 : k1, kv = up2 ? k1 : k0;
  kv += __shfl_xor(sv, 16);
  kv += __shfl_xor(kv, 8); kv += __shfl_xor(kv, 4); kv += __shfl_xor(kv, 2); kv += __shfl_xor(kv, 1);
  return kv;
}
#define XB_TMO      128
#define XB_XCNT(j)  (256  + 64 * (j))
#define XB_XSUB(j)  (1280 + 64 * (j))
#define XB_XGEN(j)  (2304 + 64 * (j))
#define XB_TOP      3328
#define XB_TOPGEN   3392
#define XB_SPIN_CAP (1u << 20)
#define LAS __attribute__((address_space(3)))
DEVI unsigned xb_ld(unsigned* p) { return __hip_atomic_load(p, __ATOMIC_RELAXED, __HIP_MEMORY_SCOPE_AGENT); }
DEVI unsigned xb_add(unsigned* p, unsigned v) { return __hip_atomic_fetch_add(p, v, __ATOMIC_RELAXED, __HIP_MEMORY_SCOPE_AGENT); }
DEVI unsigned xb_xcc_id() { return (unsigned)__builtin_amdgcn_s_getreg((3 << 11) | 20) & 0xFu; }
#define XB_SPIN(cond, bar) do { unsigned _sp = 0; while (cond) { __builtin_amdgcn_s_sleep(1); \
    if ((++_sp & 255u) == 0u) { if (xb_ld(&(bar)[XB_TMO])) break; if (_sp > XB_SPIN_CAP) { atomicAdd(&(bar)[XB_TMO], 1u); break; } } } } while (0)
DEVI void xcd_barrier_post(unsigned* bar) {
  if (TIDX == 0) (void)xb_add(&bar[XB_XCNT(xb_xcc_id())], 1u);
}
DEVI void xcd_barrier_complete(unsigned* bar, unsigned x, unsigned& nloc, unsigned& nx) {
  const unsigned G = gridDim.x * gridDim.y * gridDim.z;
  unsigned sum, cnt, mine, sp = 0u;
  for (;;) {
    sum = 0u; cnt = 0u; mine = 0u;
#pragma unroll
    for (unsigned j = 0; j < 16; ++j) { const unsigned c = xb_ld(&bar[XB_XCNT(j)]); sum += c; cnt += (c > 0u) ? 1u : 0u; mine = (j == x) ? c : mine; }
    if (sum == G) break;
    __builtin_amdgcn_s_sleep(1);
    if ((++sp & 255u) == 0u) { if (xb_ld(&bar[XB_TMO])) break; if (sp > XB_SPIN_CAP) { atomicAdd(&bar[XB_TMO], 1u); break; } }
  }
  nloc = mine > 0u ? mine : 1u; nx = cnt > 0u ? cnt : 1u;
}
DEVI void xcd_barrier(unsigned* bar, volatile LAS unsigned* st) {
  asm volatile("s_waitcnt vmcnt(0)" ::: "memory");
  __syncthreads();
  if (TIDX == 0) {
    const unsigned x = xb_xcc_id();
    __builtin_amdgcn_s_waitcnt(0);
    unsigned nloc = st[0], nx = st[1];
    if (nloc == 0u) { xcd_barrier_complete(bar, x, nloc, nx); st[0] = nloc; st[1] = nx; }
    const unsigned old = xb_add(&bar[XB_XSUB(x)], 1u);
    const unsigned gen = old / nloc;
    if (old + 1u == (gen + 1u) * nloc) {
      __builtin_amdgcn_fence(__ATOMIC_RELEASE, "agent");
      asm volatile("s_waitcnt vmcnt(0)" ::: "memory");
      const unsigned og = xb_add(&bar[XB_TOP], 1u);
      const unsigned tg = og / nx;
      if (og + 1u == (tg + 1u) * nx) xb_add(&bar[XB_TOPGEN], 1u);
      else XB_SPIN(xb_ld(&bar[XB_TOPGEN]) == tg, bar);
      __builtin_amdgcn_fence(__ATOMIC_ACQUIRE, "agent");
      xb_add(&bar[XB_XGEN(x)], 1u);
      asm volatile("s_waitcnt vmcnt(0)" ::: "memory");
    } else {
      XB_SPIN(xb_ld(&bar[XB_XGEN(x)]) == gen, bar);
      __builtin_amdgcn_fence(__ATOMIC_ACQUIRE, "agent");
      asm volatile("s_waitcnt vmcnt(0)" ::: "memory");
    }
  }
  __syncthreads();
}

namespace v2 {
typedef LAS unsigned char* ldsp_t;
constexpr int BM = 256, BK = 64, HALF = 128, HTB = HALF * BK * 2, STAGE_BYTES = 8 * HTB;
constexpr int NW = 8;
constexpr int LDS_XTRA = STAGE_BYTES;
constexpr int LDS_BARW = STAGE_BYTES + 16384;
constexpr int LDS_TOTAL = LDS_BARW + 16;

DEVI int lds_byte(int r, int c) { const int st = (r >> 4) * 2 + (c >> 5), rr = r & 15, cc = c & 31, ob = rr * 64 + cc * 2; return st * 1024 + (ob ^ (((ob >> 9) & 1) << 5)); }
DEVI void stage_rc(int b, int& R, int& C) { const int st = b / 1024, sb = b % 1024, swz = sb ^ (((sb >> 9) & 1) << 5); R = (st >> 1) * 16 + swz / 64; C = (st & 1) * 32 + (swz % 64) / 2; }
DEVI int perm32(int rho) { const int n = rho >> 4, i = rho & 15; return 8 * (i >> 2) + 4 * n + (i & 3); }

DEVI void acc_zero(f32x4 (&acc)[2][2][4][2]) {
#pragma unroll
  for (int a = 0; a < 2; ++a)
#pragma unroll
    for (int b = 0; b < 2; ++b)
#pragma unroll
      for (int m = 0; m < 4; ++m)
#pragma unroll
        for (int n = 0; n < 2; ++n) acc[a][b][m][n] = (f32x4){0.f, 0.f, 0.f, 0.f};
}
struct Unit { const char* A; const char* B; const int* rows; int nvalid; int u0, u1, u2, u3; };

template <bool PERM, bool GATHER, class Epi, class Sched>
DEVI void gemm_phase(ldsp_t lds, int lda_b, int ldb_b, int nt, const Sched& S, const Epi& E) {
  const int tid = TIDX, wid = __builtin_amdgcn_readfirstlane(tid >> 6), lane = tid & 63, wr = wid >> 2, wc = wid & 3, fr = lane & 15, fq = lane >> 4;
  unsigned voffA[2], voffB[2]; int RA[2], CA2[2];
#pragma unroll
  for (int i = 0; i < 2; ++i) {
    int R, C; stage_rc(tid * 16 + i * 8192, R, C);
    const int Rb = PERM ? ((R & ~31) + perm32(R & 31)) : R;
    RA[i] = R; CA2[i] = C * 2;
    voffA[i] = (unsigned)(R * lda_b + C * 2); voffB[i] = (unsigned)(Rb * ldb_b + C * 2);
  }
  const size_t kstep = (size_t)(BK * 2);
  const size_t hstepA = (size_t)HALF * lda_b, hstepB = (size_t)HALF * ldb_b;
  const unsigned ldsw = (unsigned)wid * 1024u;
  const int aoff = lds_byte(wr * 64 + fr, fq * 8), boff = lds_byte(wc * 32 + fr, fq * 8);
#define G_SA(b, h) (((b) * 2 + (h)) * HTB)
#define G_SB(b, h) ((4 + (b) * 2 + (h)) * HTB)
#define G_STAGE(bufoff, gbase, voff) do { _Pragma("unroll") for (int _i = 0; _i < 2; ++_i) \
    __builtin_amdgcn_global_load_lds((const unsigned*)((const char*)(gbase) + (voff)[_i]), (LAS unsigned*)(lds + (bufoff) + ldsw + _i * 8192), 16, 0, 0); } while (0)
#define G_STAGE_A(bufoff, abase, go, h, koff) do { if (GATHER) { _Pragma("unroll") for (int _i = 0; _i < 2; ++_i) \
    __builtin_amdgcn_global_load_lds((const unsigned*)((abase) + (go)[h][_i] + (koff)), (LAS unsigned*)(lds + (bufoff) + ldsw + _i * 8192), 16, 0, 0); } \
    else G_STAGE(bufoff, (abase) + (h) * hstepA + (koff), voffA); } while (0)
#define G_LDA(dst, b, h) do { _Pragma("unroll") for (int m = 0; m < 4; ++m) _Pragma("unroll") for (int k = 0; k < 2; ++k) dst[m][k] = *(const LAS bf16x8*)(lds + G_SA(b, h) + aoff + m * 2048 + k * 1024); } while (0)
#define G_LDB(dst, b, h) do { _Pragma("unroll") for (int n = 0; n < 2; ++n) _Pragma("unroll") for (int k = 0; k < 2; ++k) dst[n][k] = *(const LAS bf16x8*)(lds + G_SB(b, h) + boff + n * 2048 + k * 1024); } while (0)
#define G_MMA(ai, bj, At, Bt) do { __builtin_amdgcn_s_setprio(1); _Pragma("unroll") for (int m = 0; m < 4; ++m) _Pragma("unroll") for (int n = 0; n < 2; ++n) _Pragma("unroll") for (int k = 0; k < 2; ++k) \
    acc[ai][bj][m][n] = __builtin_amdgcn_mfma_f32_16x16x32_bf16(Bt[n][k], At[m][k], acc[ai][bj][m][n], 0, 0, 0); __builtin_amdgcn_s_setprio(0); } while (0)
#define G_WAIT_V(n) asm volatile("s_waitcnt vmcnt(" #n ")" ::: "memory")
#define G_WAIT_L(n) asm volatile("s_waitcnt lgkmcnt(" #n ")" ::: "memory")
#define G_BAR __builtin_amdgcn_s_barrier()
#define G_SCHED __builtin_amdgcn_sched_barrier(0)
  Unit cur, nxt; int ui = 0;
  if (!S.next(0, cur)) return;
  f32x4 acc[2][2][4][2];
  E.init(acc, cur, wr, wc, fr, fq);
  bf16x8 At[4][2], B0[2][2], B1[2][2];
  unsigned gcur[2][2];
  auto gather_offs = [&](const Unit& u, unsigned (&go)[2][2]) {
#pragma unroll
    for (int h = 0; h < 2; ++h)
#pragma unroll
      for (int i = 0; i < 2; ++i) {
        const int r = h * HALF + RA[i];
        const int t = (r < u.nvalid) ? (u.rows[r] >> 1) : 0;
        go[h][i] = (unsigned)t * (unsigned)lda_b + (unsigned)CA2[i];
      }
  };
  if (GATHER) gather_offs(cur, gcur);
  const char* cA = cur.A; const char* cB = cur.B;
  G_STAGE(G_SB(0, 0), cB, voffB); G_STAGE_A(G_SA(0, 0), cA, gcur, 0, 0); G_STAGE(G_SB(0, 1), cB + hstepB, voffB); G_STAGE_A(G_SA(0, 1), cA, gcur, 1, 0);
  if (wr == 1) G_BAR;
  G_WAIT_V(4); G_BAR;
  G_STAGE(G_SB(1, 0), cB + kstep, voffB); G_STAGE_A(G_SA(1, 0), cA, gcur, 0, kstep); G_STAGE(G_SB(1, 1), cB + hstepB + kstep, voffB);
  G_WAIT_V(6); G_BAR;
  for (;;) {
    const bool has_next = S.next(ui + 1, nxt);
    const char* nA = has_next ? nxt.A : cA; const char* nB = has_next ? nxt.B : cB;
    for (int t = 0; t < nt; t += 2) {
      const bool last = (t == nt - 2);
      const size_t k1 = (size_t)(t + 1) * kstep;
      const char* a2 = last ? nA : cA; const char* b2 = last ? nB : cB + (size_t)(t + 2) * kstep;
      const size_t ka2 = last ? 0 : (size_t)(t + 2) * kstep;
      const char* b3 = b2 + kstep; const size_t ka3 = ka2 + kstep;
      unsigned gN[2][2];
      if (GATHER && last) {
        if (has_next) gather_offs(nxt, gN);
        else {
#pragma unroll
          for (int h = 0; h < 2; ++h)
#pragma unroll
            for (int i = 0; i < 2; ++i) gN[h][i] = gcur[h][i];
        }
      }
#define G_STAGE_A2(bufoff, h, koff) do { if (GATHER) { if (last) G_STAGE_A(bufoff, cA, gN, h, (koff) - ka2); else G_STAGE_A(bufoff, cA, gcur, h, koff); } \
        else G_STAGE_A(bufoff, a2, gcur, h, koff); } while (0)
      G_LDB(B0, 0, 0); G_SCHED; G_LDA(At, 0, 0); G_STAGE_A(G_SA(1, 1), cA, gcur, 1, k1);
      G_WAIT_L(8); G_BAR; G_WAIT_L(0); G_MMA(0, 0, At, B0); G_BAR; G_SCHED;
      G_LDB(B1, 0, 1); G_STAGE(G_SB(0, 0), b2, voffB);
      G_BAR; G_WAIT_L(0); G_MMA(0, 1, At, B1); G_BAR;
      G_LDA(At, 0, 1); G_STAGE_A2(G_SA(0, 0), 0, ka2);
      G_BAR; G_WAIT_L(0); G_MMA(1, 0, At, B0); G_BAR; G_SCHED;
      G_STAGE(G_SB(0, 1), b2 + hstepB, voffB);
      G_WAIT_V(6); G_BAR; G_MMA(1, 1, At, B1); G_BAR;
      G_LDB(B0, 1, 0); G_SCHED; G_LDA(At, 1, 0); G_STAGE_A2(G_SA(0, 1), 1, ka2);
      G_WAIT_L(8); G_BAR; G_WAIT_L(0); G_MMA(0, 0, At, B0); G_BAR; G_SCHED;
      G_LDB(B1, 1, 1); G_STAGE(G_SB(1, 0), b3, voffB);
      G_BAR; G_WAIT_L(0); G_MMA(0, 1, At, B1); G_BAR;
      G_LDA(At, 1, 1); G_STAGE_A2(G_SA(1, 0), 0, ka3);
      G_BAR; G_WAIT_L(0); G_MMA(1, 0, At, B0); G_BAR; G_SCHED;
      G_STAGE(G_SB(1, 1), b3 + hstepB, voffB);
      G_WAIT_V(6); G_BAR; G_MMA(1, 1, At, B1); G_BAR;
      if (GATHER && last) {
#pragma unroll
        for (int h = 0; h < 2; ++h)
#pragma unroll
          for (int i = 0; i < 2; ++i) gcur[h][i] = gN[h][i];
      }
#undef G_STAGE_A2
    }
    G_SCHED;
    E(acc, cur, wr, wc, fr, fq);
    G_SCHED;
    if (!has_next) break;
    cur = nxt; cA = nA; cB = nB; ++ui;
    E.init(acc, cur, wr, wc, fr, fq);
  }
  G_WAIT_V(0);
  if (wr == 0) G_BAR;
  G_BAR;
#undef G_SA
#undef G_SB
#undef G_STAGE
#undef G_STAGE_A
#undef G_LDA
#undef G_LDB
#undef G_MMA
#undef G_WAIT_V
#undef G_WAIT_L
#undef G_BAR
#undef G_SCHED
}

DEVI unsigned uoff(unsigned x) { return (unsigned)__builtin_amdgcn_readfirstlane((int)x); }
DEVI bool tile_order(int i, int G, int c, int nM, int nN, int& pm, int& pn) {
  const int nwg = nM * nN;
  const long L = (long)i * G + c; if (L >= nwg) return false;
  int wgid = (int)L; { const int q = nwg / 8, r = nwg % 8, xcd = wgid % 8, off = wgid / 8; wgid = (xcd < r ? xcd * (q + 1) : r * (q + 1) + (xcd - r) * q) + off; }
  const int WGM = 8;
  const int nig = WGM * nN, gid = wgid / nig, fm = gid * WGM, gsz = (nM - fm) < WGM ? (nM - fm) : WGM;
  pm = fm + ((wgid % nig) % gsz); pn = (wgid % nig) / gsz;
  pm = __builtin_amdgcn_readfirstlane(pm); pn = __builtin_amdgcn_readfirstlane(pn);
  return true;
}
struct EpiRawBf16 {
  u16* O; int ldc;
  DEVI void init(f32x4 (&acc)[2][2][4][2], const Unit&, int, int, int, int) const { acc_zero(acc); }
  DEVI void operator()(const f32x4 (&acc)[2][2][4][2], const Unit& u, int wr, int wc, int fr, int fq) const {
    const unsigned off0 = ((unsigned)(u.u0 + wr * 64 + fr) * (unsigned)ldc + (unsigned)(u.u1 + wc * 32 + 8 * fq)) * 2u;
#pragma unroll
    for (int ai = 0; ai < 2; ++ai)
#pragma unroll
      for (int m = 0; m < 4; ++m) {
        char* rowp = (char*)O + (off0 + (unsigned)(ai * HALF + m * 16) * (unsigned)ldc * 2u);
#pragma unroll
        for (int bj = 0; bj < 2; ++bj) {
          const f32x4 v0 = acc[ai][bj][m][0], v1 = acc[ai][bj][m][1];
          u32x4 w; w.x = pk2(v0[0], v0[1]); w.y = pk2(v0[2], v0[3]); w.z = pk2(v1[0], v1[1]); w.w = pk2(v1[2], v1[3]);
          *(u32x4*)(rowp + bj * HALF * 2) = w;
        }
      }
  }
};

struct SchedB { const char* ws; int G, c;
  DEVI bool next(int i, Unit& u) const { int pm, pn; if (!tile_order(i, G, c, NTOK / 256, INP / 256, pm, pn)) return false;
    u.A = ws + OFF_H + uoff((unsigned)pm * 256u * 2048u); u.B = ws + OFF_WIN + uoff((unsigned)pn * 256u * 2048u); u.rows = nullptr; u.nvalid = 0; u.u0 = pm * 256; u.u1 = pn * 256; u.u2 = 0; u.u3 = 0; return true; } };
struct EpiB { u16* O; float* ssq;
  DEVI void init(f32x4 (&acc)[2][2][4][2], const Unit&, int, int, int, int) const { acc_zero(acc); }
  DEVI void operator()(const f32x4 (&acc)[2][2][4][2], const Unit& u, int wr, int wc, int fr, int fq) const {
    EpiRawBf16 E{O, PLD}; E(acc, u, wr, wc, fr, fq);
    if (u.u1 < 512) {
      const bool iskv = u.u1 != 0;
#pragma unroll
      for (int ai = 0; ai < 2; ++ai)
#pragma unroll
        for (int m = 0; m < 4; ++m) {
          float ss = 0.f;
#pragma unroll
          for (int bj = 0; bj < 2; ++bj)
#pragma unroll
            for (int n = 0; n < 2; ++n)
#pragma unroll
              for (int j = 0; j < 4; ++j) { const float v = acc[ai][bj][m][n][j]; if (!(iskv && bj == 1)) ss += v * v; }
          ss += __shfl_xor(ss, 16); ss += __shfl_xor(ss, 32);
          if (fq == 0) ssq[(size_t)(u.u0 + ai * HALF + wr * 64 + m * 16 + fr) * 8 + (iskv ? 4 : 0) + wc] = ss;
        }
    }
  }
};
DEVI void phaseB2(KP p, ldsp_t lds) {
  SchedB S{(const char*)p->ws, (int)gridDim.x, BIDX};
  EpiB E{wsp<u16>(p, OFF_PRAW), wsp<float>(p, OFF_SSQ)};
  gemm_phase<true, false>(lds, 2048, 2048, 16, S, E);
}
struct SchedC { const char* ws; int G, c;
  DEVI bool next(int i, Unit& u) const { int pm, pn; if (!tile_order(i, G, c, NTOK / 256, 4, pm, pn)) return false;
    const bool kv = pn >= 2; const int pj = pn & 1;
    u.A = ws + OFF_PRAW + uoff((unsigned)pm * 256u * (unsigned)(PLD * 2) + (kv ? 512u : 0u)); u.B = ws + (kv ? OFF_WKVB : OFF_WQB) + uoff((unsigned)pj * 256u * 512u); u.rows = nullptr; u.nvalid = 0;
    u.u0 = pm * 256; u.u1 = pj * 256; u.u2 = kv; u.u3 = 0; return true; } };
struct EpiC { u16* Oq; u16* Okv; const float* ssq;
  DEVI void init(f32x4 (&acc)[2][2][4][2], const Unit&, int, int, int, int) const { acc_zero(acc); }
  DEVI void operator()(const f32x4 (&acc)[2][2][4][2], const Unit& u, int wr, int wc, int fr, int fq) const {
    const bool kv = u.u2 != 0;
    u16* O = kv ? Okv : Oq;
    const int row0 = u.u0 + wr * 64 + fr, col0 = u.u1 + wc * 32 + 8 * fq;
    f32x4 sq[2][4];
#pragma unroll
    for (int ai = 0; ai < 2; ++ai)
#pragma unroll
      for (int m = 0; m < 4; ++m) sq[ai][m] = *(const f32x4*)(ssq + (size_t)(row0 + ai * HALF + m * 16) * 8 + (kv ? 4 : 0));
#pragma unroll
    for (int ai = 0; ai < 2; ++ai)
#pragma unroll
      for (int m = 0; m < 4; ++m) {
        const size_t r = (size_t)(row0 + ai * HALF + m * 16);
        const float tot = sq[ai][m].x + sq[ai][m].y + sq[ai][m].z + sq[ai][m].w;
        const float sc = kv ? rsqrtf(tot * (1.f / 128.f) + EPS) : rsqrtf(tot * (1.f / 256.f) + EPS) * (0.10206207261596575f * LOG2E);
        u16* rowp = O + r * 512 + col0;
#pragma unroll
        for (int bj = 0; bj < 2; ++bj) {
          const f32x4 v0 = acc[ai][bj][m][0] * sc, v1 = acc[ai][bj][m][1] * sc;
          u32x4 w; w.x = pk2(v0[0], v0[1]); w.y = pk2(v0[2], v0[3]); w.z = pk2(v1[0], v1[1]); w.w = pk2(v1[2], v1[3]);
          *(u32x4*)(rowp + bj * HALF) = w;
        }
      }
  }
};
DEVI void phaseC2(KP p, ldsp_t lds) {
  SchedC S{(const char*)p->ws, (int)gridDim.x, BIDX};
  EpiC E{wsp<u16>(p, OFF_QARAW), wsp<u16>(p, OFF_KVARAW), wsp<float>(p, OFF_SSQ)};
  int nt = 4; asm volatile("" : "+s"(nt));
  gemm_phase<true, false>(lds, PLD * 2, 512, nt, S, E);
}

DEVI void ld16(const u16* src, float (&v)[16]) {
  const u32x4 a = *(const u32x4*)src, b = *(const u32x4*)(src + 8);
  const unsigned w[8] = {a.x, a.y, a.z, a.w, b.x, b.y, b.z, b.w};
#pragma unroll
  for (int i = 0; i < 8; ++i) { v[2 * i] = __uint_as_float(w[i] << 16); v[2 * i + 1] = __uint_as_float(w[i] & 0xffff0000u); }
}
DEVI void st16(u16* dst, const float (&v)[16]) {
  u32x4 a, b;
  a.x = pk2(v[0], v[1]); a.y = pk2(v[2], v[3]); a.z = pk2(v[4], v[5]); a.w = pk2(v[6], v[7]);
  b.x = pk2(v[8], v[9]); b.y = pk2(v[10], v[11]); b.z = pk2(v[12], v[13]); b.w = pk2(v[14], v[15]);
  *(u32x4*)dst = a; *(u32x4*)(dst + 8) = b;
}
DEVI void rope16c(float (&v)[16], const float* cs16, int pos) {
  const f32x2* t = (const f32x2*)(cs16 + pos * 16);
#pragma unroll
  for (int i = 0; i < 8; ++i) { const f32x2 cs = t[i]; const float x1 = v[i], x2 = v[8 + i]; v[i] = x1 * cs.x - x2 * cs.y; v[8 + i] = x2 * cs.x + x1 * cs.y; }
}
DEVI void rope32c(float (&lo)[16], float (&hi)[16], const float* cs32, int pos) {
  const f32x2* t = (const f32x2*)(cs32 + pos * 32);
#pragma unroll
  for (int i = 0; i < 16; ++i) { const f32x2 cs = t[i]; const float x1 = lo[i], x2 = hi[i]; lo[i] = x1 * cs.x - x2 * cs.y; hi[i] = x2 * cs.x + x1 * cs.y; }
}
DEVI float ssq16(const float (&v)[16]) { float s = 0.f;
#pragma unroll
  for (int i = 0; i < 16; ++i) s += v[i] * v[i];
  return s; }
DEVI void scale16(float (&v)[16], float s) {
#pragma unroll
  for (int i = 0; i < 16; ++i) v[i] *= s; }
DEVI void cvt16(const u32x4 a, const u32x4 b, float (&v)[16]) {
  const unsigned w[8] = {a.x, a.y, a.z, a.w, b.x, b.y, b.z, b.w};
#pragma unroll
  for (int i = 0; i < 8; ++i) { v[2 * i] = __uint_as_float(w[i] << 16); v[2 * i + 1] = __uint_as_float(w[i] & 0xffff0000u); }
}
DEVI void phaseP2(KP p, int l, ldsp_t lds) {
  const int tid = TIDX, tk = tid >> 3, pt = tid & 7;
  u16* PR = wsp<u16>(p, OFF_PRAW);
  u16* QA = wsp<u16>(p, OFF_QARAW);
  const float* cs32 = wsp<float>(p, OFF_CS32);
  const float* cs16 = wsp<float>(p, OFF_CS16);
  const float QS = 0.125f * LOG2E;
  for (int item = BIDX; item < NTOK / 64; item += gridDim.x) {
    const int tok0 = item * 64, rr0 = tok0 % TPB;
    const bool lat = rr0 >= NCTX;
    const size_t tok = (size_t)tok0 + tk;
    const int t = rr0 + tk - NCTX, grow = (t >> 6) & 63, gcol = t & 63;
    u16* pr = PR + tok * PLD;
    u16* qar = QA + tok * 512 + 96 * (pt >> 1) + 64 + 16 * (pt & 1);
    const int g4 = pt & 3;
    u32x4 r_qa[2], r_kr[2], r_qb[4], r_kb[4], r_qd[4], r_kd[4];
#define LD8(ptr) (*(const u32x4*)(ptr))
    if (lat) {
#pragma unroll
      for (int i = 0; i < 2; ++i) { r_qa[i] = LD8(qar + 8 * i); r_kr[i] = LD8(pr + 384 + 16 * (pt & 1) + 8 * i); }
#pragma unroll
      for (int i = 0; i < 4; ++i) { r_qb[i] = LD8(pr + 512 + 32 * pt + 8 * i); r_kb[i] = LD8(pr + 768 + 32 * g4 + 8 * i); }
    }
#pragma unroll
    for (int i = 0; i < 4; ++i) { r_qd[i] = LD8(pr + 1792 + 32 * pt + 8 * i); r_kd[i] = LD8(pr + 2048 + 32 * g4 + 8 * i); }
#undef LD8
    if (lat) {
      { float v[16]; cvt16(r_qa[0], r_qa[1], v); rope16c(v, cs16, (pt & 1) ? gcol : grow); st16(qar, v); }
      if (pt < 2) { float v[16]; cvt16(r_kr[0], r_kr[1], v); rope16c(v, cs16, pt == 0 ? grow : gcol); st16(pr + 384 + 16 * pt, v); }
      { float lo[16], hi[16]; cvt16(r_qb[0], r_qb[1], lo); cvt16(r_qb[2], r_qb[3], hi); rope32c(lo, hi, cs32, (pt & 1) ? gcol : grow); st16(pr + 512 + 32 * pt, lo); st16(pr + 512 + 32 * pt + 16, hi); }
      if (pt < 4) { float lo[16], hi[16]; cvt16(r_kb[0], r_kb[1], lo); cvt16(r_kb[2], r_kb[3], hi); rope32c(lo, hi, cs32, (pt & 1) ? gcol : grow); st16(pr + 768 + 32 * pt, lo); st16(pr + 768 + 32 * pt + 16, hi); }
    }
    {
      float lo[16], hi[16]; cvt16(r_qd[0], r_qd[1], lo); cvt16(r_qd[2], r_qd[3], hi);
      float ss = ssq16(lo) + ssq16(hi); ss += __shfl_xor(ss, 1);
      const float rs = rsqrtf(ss * (1.f / 64.f) + EPS);
      const float* g = p->g_q_d + l * 64 + 32 * (pt & 1);
#pragma unroll
      for (int i = 0; i < 16; ++i) { lo[i] *= rs * g[i]; hi[i] *= rs * g[16 + i]; }
      if (lat) rope32c(lo, hi, cs32, (pt & 1) ? gcol : grow);
      scale16(lo, QS); scale16(hi, QS);
      st16(pr + 1792 + 32 * pt, lo); st16(pr + 1792 + 32 * pt + 16, hi);
    }
    {
      float lo[16], hi[16]; cvt16(r_kd[0], r_kd[1], lo); cvt16(r_kd[2], r_kd[3], hi);
      float ss = ssq16(lo) + ssq16(hi); ss += __shfl_xor(ss, 1);
      const float rs = rsqrtf(ss * (1.f / 64.f) + EPS);
      const float* g = p->g_k_d + l * 64 + 32 * (g4 & 1);
#pragma unroll
      for (int i = 0; i < 16; ++i) { lo[i] *= rs * g[i]; hi[i] *= rs * g[16 + i]; }
      if (lat) rope32c(lo, hi, cs32, (g4 & 1) ? gcol : grow);
      if (pt < 4) { st16(pr + 2048 + 32 * g4, lo); st16(pr + 2048 + 32 * g4 + 16, hi); }
    }
  }
}

DEVI void conv_load(const ConvT& c, int lane, f32x4 (&v)[8]) {
  const int kk = lane >> 3, n4 = (lane & 7) * 4;
  const float* sp = (c.src2 && n4 >= 16) ? c.src2 + (n4 - 16) : (c.src ? c.src + n4 : nullptr);
#pragma unroll
  for (int i = 0; i < 8; ++i) v[i] = sp ? *(const f32x4*)(sp + (size_t)(kk + 8 * i) * c.ld) : f32x4{0.f, 0.f, 0.f, 0.f};
}
DEVI void conv_store(const ConvT& c, LAS float* t, int lane, const f32x4 (&v)[8]) {
  const int kk = lane >> 3, n4 = (lane & 7) * 4;
#pragma unroll
  for (int i = 0; i < 8; ++i) {
    const int k = kk + 8 * i;
    const float s = (c.ks ? c.ks[k] : 1.f) * c.mul;
    t[(n4 + 0) * 65 + k] = v[i].x * s; t[(n4 + 1) * 65 + k] = v[i].y * s;
    t[(n4 + 2) * 65 + k] = v[i].z * s; t[(n4 + 3) * 65 + k] = v[i].w * s;
  }
  asm volatile("s_waitcnt lgkmcnt(0)" ::: "memory");
  const int n = lane >> 1, k0 = (lane & 1) * 32;
  const LAS float* r = t + n * 65 + k0;
  u16* d = c.dst + (size_t)n * c.ldd + k0;
#pragma unroll
  for (int q = 0; q < 4; ++q) {
    u32x4 o;
    o.x = pk2(r[8 * q], r[8 * q + 1]); o.y = pk2(r[8 * q + 2], r[8 * q + 3]); o.z = pk2(r[8 * q + 4], r[8 * q + 5]); o.w = pk2(r[8 * q + 6], r[8 * q + 7]);
    *(u32x4*)(d + 8 * q) = o;
  }
  asm volatile("s_waitcnt lgkmcnt(0)" ::: "memory");
}
constexpr int CONV_EARLY = 1152 + 64 + 64;
DEVI void conv_items2(KP p, int l, ldsp_t lds, int first_item, int total_items) {
  const int tid = TIDX, wave = __builtin_amdgcn_readfirstlane(tid >> 6), lane = tid & 63;
  LAS float* t = (LAS float*)(lds + wave * 8448);
  __syncthreads();
  const int stride = gridDim.x * NW;
  int item = first_item + BIDX * NW + wave;
  if (item >= total_items) return;
  ConvT c = conv_decode(p, l, item);
  f32x4 v[8];
  conv_load(c, lane, v);
  for (;;) {
    const int nitem = item + stride;
    const bool more = nitem < total_items;
    ConvT cn = c; f32x4 vn[8];
    if (more) { cn = conv_decode(p, l, nitem); conv_load(cn, lane, vn); }
    conv_store(c, t, lane, v);
    if (!more) break;
    c = cn; item = nitem;
#pragma unroll
    for (int i = 0; i < 8; ++i) v[i] = vn[i];
  }
}
template <int BR>
DEVI void attn_mask(f32x16 (&s)[2], int kt, int qlat, int qrow, int qcol, int hh, LAS float* rpb) {
  if (BR == 1) {
#pragma unroll
    for (int kb = 0; kb < 2; ++kb)
#pragma unroll
      for (int i = 0; i < 16; ++i) {
        const int kpos = kt * 64 + kb * 32 + (i & 3) + 8 * (i >> 2) + 4 * hh;
        const int d = qlat - kpos;
        if (d > 128 || d < -128) s[kb][i] = -1e30f;
      }
  } else {
    const int rs = min(max(qrow - 4, 0), 56);
    const bool row_ok = (kt >= rs) && (kt < rs + 8);
    const int cst = min(max(qcol - 8, 0), 48);
    const int dr = kt - qrow + 7;
#pragma unroll
    for (int kb = 0; kb < 2; ++kb)
#pragma unroll
      for (int i = 0; i < 16; ++i) {
        const int kc = kb * 32 + (i & 3) + 8 * (i >> 2) + 4 * hh;
        const bool ok = row_ok && (kc >= cst) && (kc < cst + 16);
        const int idx = ok ? (dr * 31 + (kc - qcol + 15)) : 0;
        const float bias = rpb[idx];
        s[kb][i] = ok ? (s[kb][i] + bias) : -1e30f;
      }
  }
}

typedef short v4i16_t __attribute__((ext_vector_type(4)));
DEVI bf16x8 vtr2(ldsp_t a) {
  const v4i16_t lo = __builtin_amdgcn_ds_read_tr16_b64_v4i16((LAS v4i16_t*)a);
  const v4i16_t hi = __builtin_amdgcn_ds_read_tr16_b64_v4i16((LAS v4i16_t*)(a + 8 * 144));
  return __builtin_shufflevector(lo, hi, 0, 1, 2, 3, 4, 5, 6, 7);
}
template <int BR>
DEVI void attn_item2(KP p, int l, int b, int hs, int qb, bool isctx, ldsp_t lds) {
  constexpr bool MLA = (BR == 0);
  constexpr bool GQA = (BR == 1 || BR == 3);
  constexpr int QBLK = GQA ? 256 : 512;
  constexpr int NKS = MLA ? 6 : 4;
  constexpr int STG = 9216 + 9216 + 5120;
  const int tid = TIDX, lane = tid & 63, wave = __builtin_amdgcn_readfirstlane(tid >> 6);
  const int r32 = lane & 31, hh = lane >> 5;
  const int hq = GQA ? (hs * 2 + (wave & 1)) : hs;
  const int woff = GQA ? 64 * (wave >> 1) : 64 * wave;
  const int q0 = (isctx ? 0 : NCTX) + qb * QBLK;
  const bool active = !isctx || (woff < NCTX);
  const size_t tokq = (size_t)b * TPB + q0 + (active ? woff : 0) + r32;
  const u16* Qp; const u16* Kp; int ldk; const u16* Vp; int ldv; int obase; int ldq;
  const u16* PR = wsp<u16>(p, OFF_PRAW);
  if (BR == 0) { Qp = wsp<u16>(p, OFF_QARAW) + tokq * 512 + hq * 96; ldq = 512; Kp = wsp<u16>(p, OFF_KVARAW) + (size_t)b * TPB * 512 + hs * 128; ldk = 512; Vp = wsp<u16>(p, OFF_KVARAW) + (size_t)b * TPB * 512 + hs * 128 + 64; ldv = 512; obase = hq * 64; }
  else if (BR == 1) { Qp = PR + tokq * PLD + 512 + hq * 64; ldq = PLD; Kp = PR + (size_t)b * TPB * PLD + 768 + hs * 64; ldk = PLD; Vp = PR + (size_t)b * TPB * PLD + 896 + hs * 64; ldv = PLD; obase = 256 + hq * 64; }
  else if (BR == 2) { Qp = PR + tokq * PLD + 1024 + hq * 64; ldq = PLD; Kp = PR + (size_t)b * TPB * PLD + 1280 + hs * 64; ldk = PLD; Vp = PR + (size_t)b * TPB * PLD + 1536 + hs * 64; ldv = PLD; obase = 512 + hq * 64; }
  else { Qp = PR + tokq * PLD + 1792 + hq * 64; ldq = PLD; Kp = PR + (size_t)b * TPB * PLD + 2048 + hs * 64; ldk = PLD; Vp = PR + (size_t)b * TPB * PLD + 2176 + hs * 64; ldv = PLD; obase = 768 + hq * 64; }
  const u16* KRp = PR + (size_t)b * TPB * PLD + 384;
  int lat_lo = 0, lat_n = 0, wlo = 0, whi = 63;
  if (!isctx) {
    if (BR == 0 || BR == 3) { lat_lo = 0; lat_n = 64; }
    else if (BR == 1) {
      const int ql = qb * QBLK; const int lo = max(0, ql - 128) >> 6, hi = min(SEQ - 1, ql + QBLK - 1 + 128) >> 6; lat_lo = lo; lat_n = hi - lo + 1;
      const int wq = ql + woff; wlo = max(0, wq - 128) >> 6; whi = min(SEQ - 1, wq + 63 + 128) >> 6;
    } else {
      const int r0 = 8 * qb; const int lo = min(max(r0 - 4, 0), 56), hi = min(max(r0 + 7 - 4, 0), 56) + 7; lat_lo = lo; lat_n = hi - lo + 1;
      const int wr_ = r0 + wave; wlo = min(max(wr_ - 4, 0), 56); whi = wlo + 7;
    }
  }
  const int NT = 4 + lat_n;
  const int qlat0 = qb * QBLK + woff + r32;
  bf16x8 qf[2][NKS];
#pragma unroll
  for (int qi = 0; qi < 2; ++qi)
#pragma unroll
    for (int ks = 0; ks < NKS; ++ks) qf[qi][ks] = *(const bf16x8*)(Qp + (size_t)qi * 32 * ldq + ks * 16 + hh * 8);
  const int srow = tid >> 3, sc8 = (tid & 7) * 8;
  const int krow_ = (tid & 255) >> 2, kc8 = (tid & 3) * 8;
  const bool krt = tid < 256;
  u32x4 rk0, rv0, rr0, rk1, rv1, rr1;
  auto keytile = [&](int j) { return (j < 4) ? j : (4 + lat_lo + (j - 4)); };
#define A_GLOAD(j, rk, rv, rr) do { const int key0_ = keytile(j) * 64; \
    rk = *(const u32x4*)(Kp + (size_t)(key0_ + srow) * ldk + sc8); \
    rv = *(const u32x4*)(Vp + (size_t)(key0_ + srow) * ldv + sc8); \
    if (MLA && krt) rr = *(const u32x4*)(KRp + (size_t)(key0_ + krow_) * PLD + kc8); } while (0)
#define A_LWRITE(st, rk, rv, rr) do { ldsp_t base_ = lds + (st) * STG; \
    *(LAS u32x4*)(base_ + srow * 144 + sc8 * 2) = rk; \
    *(LAS u32x4*)(base_ + 9216 + srow * 144 + sc8 * 2) = rv; \
    if (MLA && krt) *(LAS u32x4*)(base_ + 18432 + krow_ * 80 + kc8 * 2) = rr; } while (0)
  LAS float* rpb = (LAS float*)(lds + 2 * STG);
  A_GLOAD(0, rk0, rv0, rr0);
  if (NT > 1) A_GLOAD(1, rk1, rv1, rr1);
  __syncthreads();
  if (BR == 2 && !isctx) {
    const float* src = p->rpb_c + (size_t)(l * 4 + hs) * 465;
    for (int i = tid; i < 465; i += 512) rpb[i] = src[i] * LOG2E;
  }
  A_LWRITE(0, rk0, rv0, rr0);
  __syncthreads();
  f32x16 o[2][2];
#pragma unroll
  for (int qi = 0; qi < 2; ++qi)
#pragma unroll
    for (int i = 0; i < 16; ++i) { o[qi][0][i] = 0.f; o[qi][1][i] = 0.f; }
  float m_run[2], l_run[2];
#pragma unroll
  for (int qi = 0; qi < 2; ++qi) { m_run[qi] = -INFINITY; l_run[qi] = 0.f; }
  if (BR == 1) { const float sk = p->sink_b[l * 4 + hq] * LOG2E; m_run[0] = sk; m_run[1] = sk; l_run[0] = (hh == 0) ? 1.f : 0.f; l_run[1] = l_run[0]; }
  const ldsp_t kfb = lds + r32 * 144 + hh * 16;
  const ldsp_t vfb = lds + 9216 + (4 * hh + ((lane & 15) >> 2)) * 144 + (16 * ((lane >> 4) & 1) + 4 * (lane & 3)) * 2;
  const ldsp_t krb = lds + 18432 + r32 * 80 + hh * 16;
#define A_STEP(j, rkA, rvA, rrA, rkB, rvB, rrB) do { \
    const int st = ((j) & 1) * STG; \
    if ((j) + 2 < NT) A_GLOAD((j) + 2, rkA, rvA, rrA); \
    const int kt_ = lat_lo + (j) - 4; \
    const bool need = active && ((j) < 4 || (kt_ >= wlo && kt_ <= whi)); \
    if (need) { \
      f32x16 s[2][2]; \
      _Pragma("unroll") for (int kb = 0; kb < 2; ++kb) { \
        _Pragma("unroll") for (int ks = 0; ks < 4; ++ks) { const bf16x8 kf = *(const LAS bf16x8*)(kfb + st + kb * 32 * 144 + ks * 32); \
          _Pragma("unroll") for (int qi = 0; qi < 2; ++qi) { if (ks == 0) { _Pragma("unroll") for (int i = 0; i < 16; ++i) s[qi][kb][i] = 0.f; } s[qi][kb] = MFMA(kf, qf[qi][ks], s[qi][kb]); } } \
        if (MLA) { _Pragma("unroll") for (int ks = 0; ks < 2; ++ks) { const bf16x8 kf = *(const LAS bf16x8*)(krb + st + kb * 32 * 80 + ks * 32); \
          _Pragma("unroll") for (int qi = 0; qi < 2; ++qi) s[qi][kb] = MFMA(kf, qf[qi][NKS - 2 + ks], s[qi][kb]); } } \
      } \
      _Pragma("unroll") for (int qi = 0; qi < 2; ++qi) { \
        if ((BR == 1 || BR == 2) && (j) >= 4) { const int ql_ = qlat0 + 32 * qi; attn_mask<BR>(s[qi], kt_, ql_, ql_ >> 6, ql_ & 63, hh, rpb); } \
        float mx = s[qi][0][0]; \
        _Pragma("unroll") for (int i = 1; i < 16; ++i) mx = fmaxf(mx, s[qi][0][i]); \
        _Pragma("unroll") for (int i = 0; i < 16; ++i) mx = fmaxf(mx, s[qi][1][i]); \
        mx = fmaxf(mx, __shfl_xor(mx, 32)); \
        const float m_new = fmaxf(m_run[qi], mx); \
        const float alpha = __builtin_amdgcn_exp2f(m_run[qi] - m_new); \
        m_run[qi] = m_new; \
        float ls0 = 0.f, ls1 = 0.f; \
        _Pragma("unroll") for (int i = 0; i < 16; ++i) { \
          const float e0 = __builtin_amdgcn_exp2f(s[qi][0][i] - m_new), e1 = __builtin_amdgcn_exp2f(s[qi][1][i] - m_new); \
          s[qi][0][i] = e0; s[qi][1][i] = e1; ls0 += e0; ls1 += e1; } \
        l_run[qi] = l_run[qi] * alpha + (ls0 + ls1); \
        if (__any(alpha != 1.f)) { _Pragma("unroll") for (int i = 0; i < 16; ++i) { o[qi][0][i] *= alpha; o[qi][1][i] *= alpha; } } \
      } \
      _Pragma("unroll") for (int s4 = 0; s4 < 4; ++s4) { \
        const int kb = s4 >> 1, rb = (s4 & 1) * 8; \
        bf16x8 pf[2]; \
        _Pragma("unroll") for (int qi = 0; qi < 2; ++qi) { u32x4 pw; \
          pw.x = pk2(s[qi][kb][rb + 0], s[qi][kb][rb + 1]); pw.y = pk2(s[qi][kb][rb + 2], s[qi][kb][rb + 3]); \
          pw.z = pk2(s[qi][kb][rb + 4], s[qi][kb][rb + 5]); pw.w = pk2(s[qi][kb][rb + 6], s[qi][kb][rb + 7]); \
          pf[qi] = __builtin_bit_cast(bf16x8, pw); } \
        _Pragma("unroll") for (int db = 0; db < 2; ++db) { const bf16x8 vf = vtr2(vfb + st + s4 * 16 * 144 + db * 64); \
          o[0][db] = MFMA(vf, pf[0], o[0][db]); o[1][db] = MFMA(vf, pf[1], o[1][db]); } \
      } \
    } \
    if ((j) + 1 < NT) A_LWRITE(((j) + 1) & 1, rkB, rvB, rrB); \
    __syncthreads(); \
  } while (0)
  for (int j = 0; j < NT; j += 2) {
    A_STEP(j, rk0, rv0, rr0, rk1, rv1, rr1);
    if (j + 1 < NT) A_STEP(j + 1, rk1, rv1, rr1, rk0, rv0, rr0);
  }
#undef A_STEP
#undef A_GLOAD
#undef A_LWRITE
  if (active) {
#pragma unroll
    for (int qi = 0; qi < 2; ++qi) {
      const float lt = l_run[qi] + __shfl_xor(l_run[qi], 32);
      const float inv = 1.f / lt;
      u16* Op = wsp<u16>(p, OFF_O) + (tokq + 32 * qi) * 1024 + obase;
#pragma unroll
      for (int db = 0; db < 2; ++db)
#pragma unroll
        for (int g = 0; g < 4; ++g) {
          u32x2 w;
          w.x = pk2(o[qi][db][4 * g] * inv, o[qi][db][4 * g + 1] * inv);
          w.y = pk2(o[qi][db][4 * g + 2] * inv, o[qi][db][4 * g + 3] * inv);
          *(u32x2*)(Op + db * 32 + 8 * g + 4 * hh) = w;
        }
    }
  }
}
DEVI void phaseD2(KP p, int l, ldsp_t lds) {
  const int G8 = gridDim.x >> 3, xcd = BIDX & 7, lb = BIDX >> 3;
  if (lb >= G8) return;
  const int NLOC = 128 + (l == 0 ? 12 : 0);
  const int nmine = (NLOC - lb + G8 - 1) / G8;
  const int cslot = min((int)(BIDX & 3), nmine - 1);
  int it = 0;
  for (int n = lb; n < NLOC; n += G8, ++it) {
    if (it == cslot) conv_items2(p, l, lds, CONV_EARLY, CONV_ITEMS);
    int br, s, qb; bool isctx = false;
    if (n < 32) { br = 0; s = xcd + 8 * (n >> 3); qb = n & 7; }
    else if (n < 64) { const int m = n - 32; br = 3; s = xcd + 8 * (m >> 4); qb = m & 15; }
    else if (n < 96) { const int m = n - 64; br = 2; s = xcd + 8 * (m >> 3); qb = m & 7; }
    else if (n < 128) { const int m = n - 96; br = 1; s = xcd + 8 * (m >> 4); qb = m & 15; }
    else {
      const int m = n - 128; isctx = true; qb = 0;
      if (m < 4) { br = 0; s = xcd + 8 * m; }
      else if (m < 6) { br = 3; s = xcd + 8 * (m - 4); }
      else if (m < 10) { br = 2; s = xcd + 8 * (m - 6); }
      else { br = 1; s = xcd + 8 * (m - 10); }
    }
    if (br == 0) attn_item2<0>(p, l, s >> 2, s & 3, qb, isctx, lds);
    else if (br == 1) attn_item2<1>(p, l, s >> 1, s & 1, qb, isctx, lds);
    else if (br == 2) attn_item2<2>(p, l, s >> 2, s & 3, qb, isctx, lds);
    else attn_item2<3>(p, l, s >> 1, s & 1, qb, isctx, lds);
  }
}

DEVI int pm_map(int pme, bool skipctx) { return skipctx ? (pme >> 4) * 17 + 1 + (pme & 15) : pme; }
struct SchedE1 { const char* ws; bool skipctx; int G, c;
  DEVI bool next(int i, Unit& u) const { int pm, pn; if (!tile_order(i, G, c, skipctx ? 128 : 136, 16, pm, pn)) return false;
    pm = pm_map(pm, skipctx); const int n = pn >> 2, cq = pn & 3;
    u.A = ws + OFF_O + uoff((unsigned)pm * 256u * 2048u + (unsigned)n * 512u); u.B = ws + OFF_WBR + uoff(((unsigned)n * 1024u + (unsigned)cq * 256u) * 512u); u.rows = nullptr; u.nvalid = 0;
    u.u0 = pm * 256; u.u1 = pn * 256; u.u2 = 0; u.u3 = 0; return true; } };
DEVI void phaseE1(KP p, int l, ldsp_t lds) {
  if (BIDX == 0 && TIDX < 32) wsp<int>(p, OFF_CNT)[TIDX * CNT_STRIDE] = 0;
  SchedE1 S{(const char*)p->ws, l == 1, (int)gridDim.x, BIDX};
  EpiRawBf16 E{wsp<u16>(p, OFF_Z), 4096};
  gemm_phase<true, false>(lds, 2048, 512, 4, S, E);
}
struct SchedE2 { const char* ws; bool skipctx; int G, c;
  DEVI bool next(int i, Unit& u) const { int pm, pn; if (!tile_order(i >> 1, G, c, skipctx ? 128 : 136, 8, pm, pn)) return false;
    pm = pm_map(pm, skipctx); const int pr = i & 1;
    u.A = ws + OFF_H + uoff((unsigned)pm * 256u * 2048u); u.B = ws + OFF_WGATE + uoff((unsigned)(pr * 8 + pn) * 256u * 2048u); u.rows = nullptr; u.nvalid = 0;
    u.u0 = pm * 256; u.u1 = pn * 128; u.u2 = pr; u.u3 = 0; return true; } };
struct EpiE2 { const u16* Z; u16* Y; const float* bias;
  DEVI void init(f32x4 (&acc)[2][2][4][2], const Unit& u, int wr, int wc, int fr, int fq) const {
    const int col0 = u.u1 + wc * 32 + 8 * fq;
#pragma unroll
    for (int bj = 0; bj < 2; ++bj)
#pragma unroll
      for (int nn = 0; nn < 2; ++nn) {
        const f32x4 b = *(const f32x4*)(bias + (2 * u.u2 + bj) * 1024 + col0 + 4 * nn);
#pragma unroll
        for (int a = 0; a < 2; ++a)
#pragma unroll
          for (int m = 0; m < 4; ++m) acc[a][bj][m][nn] = b;
      }
  }
  DEVI void operator()(const f32x4 (&acc)[2][2][4][2], const Unit& u, int wr, int wc, int fr, int fq) const {
    const int row0 = u.u0 + wr * 64 + fr, col0 = u.u1 + wc * 32 + 8 * fq, pr = u.u2;
    u32x4 zq[3][2], yq[3];
    auto ldrow = [&](int g, u32x4 (&z)[2], u32x4& y) {
      const size_t r = (size_t)(row0 + (g >> 2) * HALF + (g & 3) * 16);
#pragma unroll
      for (int bj = 0; bj < 2; ++bj) z[bj] = *(const u32x4*)(Z + r * 4096 + (2 * pr + bj) * 1024 + col0);
      y = pr ? *(const u32x4*)(Y + r * 1024 + col0) : u32x4{0u, 0u, 0u, 0u};
    };
    ldrow(0, zq[0], yq[0]);
    ldrow(1, zq[1], yq[1]);
#pragma unroll
    for (int g = 0; g < 8; ++g) {
      const int ai = g >> 2, m = g & 3, c = g % 3;
      if (g + 2 < 8) ldrow(g + 2, zq[(g + 2) % 3], yq[(g + 2) % 3]);
      const size_t r = (size_t)(row0 + ai * HALF + m * 16);
      float t[8];
      {
        const unsigned w[4] = {yq[c].x, yq[c].y, yq[c].z, yq[c].w};
#pragma unroll
        for (int i = 0; i < 4; ++i) { t[2 * i] = __uint_as_float(w[i] << 16); t[2 * i + 1] = __uint_as_float(w[i] & 0xffff0000u); }
      }
#pragma unroll
      for (int bj = 0; bj < 2; ++bj) {
        const unsigned w[4] = {zq[c][bj].x, zq[c][bj].y, zq[c][bj].z, zq[c][bj].w};
#pragma unroll
        for (int nn = 0; nn < 2; ++nn)
#pragma unroll
          for (int j = 0; j < 4; ++j) {
            const int e = 4 * nn + j;
            const float zz = (e & 1) ? __uint_as_float(w[e >> 1] & 0xffff0000u) : __uint_as_float(w[e >> 1] << 16);
            const float gte = __builtin_amdgcn_rcpf(1.f + __expf(-acc[ai][bj][m][nn][j]));
            t[e] += gte * zz;
          }
      }
      u32x4 o; o.x = pk2(t[0], t[1]); o.y = pk2(t[2], t[3]); o.z = pk2(t[4], t[5]); o.w = pk2(t[6], t[7]);
      *(u32x4*)(Y + r * 1024 + col0) = o;
    }
  }
};
DEVI void phaseE2(KP p, int l, ldsp_t lds) {
  SchedE2 S{(const char*)p->ws, l == 1, (int)gridDim.x, BIDX};
  EpiE2 E{wsp<u16>(p, OFF_Z), wsp<u16>(p, OFF_YPRE), p->b_gate + (size_t)l * 4 * 1024};
  gemm_phase<true, false>(lds, 2048, 2048, 16, S, E);
}
struct SchedF { const char* ws; bool skipctx; int G, c;
  DEVI bool next(int i, Unit& u) const { int pm, pn; if (!tile_order(i, G, c, skipctx ? 128 : 136, 4, pm, pn)) return false;
    pm = pm_map(pm, skipctx);
    u.A = ws + OFF_YPRE + uoff((unsigned)pm * 256u * 2048u); u.B = ws + OFF_WOUT + uoff((unsigned)pn * 256u * 2048u); u.rows = nullptr; u.nvalid = 0;
    u.u0 = pm; u.u1 = pn * 256; u.u2 = 0; u.u3 = 0; return true; } };
struct EpiF { KP p; int l;
  DEVI void init(f32x4 (&acc)[2][2][4][2], const Unit&, int, int, int, int) const { acc_zero(acc); }
  DEVI void operator()(const f32x4 (&acc)[2][2][4][2], const Unit& u, int wr, int wc, int fr, int fq) const {
    const int pm = u.u0, b = pm / 17, rr0 = (pm % 17) * 256;
    const int mrow = (rr0 < NCTX) ? 8 : b;
    const int col0 = u.u1 + wc * 32 + 4 * fq;
    const float* gt = wsp<float>(p, OFF_MOD) + ((size_t)l * 9 + mrow) * 6144 + 2048 + col0;
    const float* xin = xrow_in(p, l, b, rr0) + col0;
    float* xout = xrow_res(p, b, rr0) + col0;
    f32x4 gv[2][2];
#pragma unroll
    for (int bj = 0; bj < 2; ++bj)
#pragma unroll
      for (int n = 0; n < 2; ++n) gv[bj][n] = *(const f32x4*)(gt + bj * HALF + n * 16);
#pragma unroll
    for (int ai = 0; ai < 2; ++ai)
#pragma unroll
      for (int mp = 0; mp < 2; ++mp) {
        f32x4 xo[2][2][2];
#pragma unroll
        for (int mm = 0; mm < 2; ++mm) {
          const size_t ro = (size_t)(wr * 64 + fr + ai * HALF + (2 * mp + mm) * 16) * 1024;
#pragma unroll
          for (int bj = 0; bj < 2; ++bj)
#pragma unroll
            for (int n = 0; n < 2; ++n) xo[mm][bj][n] = *(const f32x4*)(xin + ro + bj * HALF + n * 16);
        }
#pragma unroll
        for (int mm = 0; mm < 2; ++mm) {
          const int m = 2 * mp + mm;
          const size_t ro = (size_t)(wr * 64 + fr + ai * HALF + m * 16) * 1024;
#pragma unroll
          for (int bj = 0; bj < 2; ++bj)
#pragma unroll
            for (int n = 0; n < 2; ++n) *(f32x4*)(xout + ro + bj * HALF + n * 16) = xo[mm][bj][n] + gv[bj][n] * acc[ai][bj][m][n];
        }
      }
  }
};
DEVI void phaseF2(KP p, int l, ldsp_t lds) {
  SchedF S{(const char*)p->ws, l == 1, (int)gridDim.x, BIDX};
  EpiF E{p, l};
  gemm_phase<false, false>(lds, 2048, 2048, 16, S, E);
}


DEVI void phase0_2(KP p, ldsp_t lds) {
  const int tid = TIDX, half = tid >> 8, htid = tid & 255;
  for (int it = BIDX * 2; it < 458; it += gridDim.x * 2) {
    const int item = it + half;
    LAS float* sc = (LAS float*)(lds + half * 16384);
    const bool ismod = item < 384;
    const int l = item / 192, rem = item % 192, cgp = rem >> 3, kc = rem & 7;
    __syncthreads();
    if (ismod) {
      for (int i = htid; i < 9 * 128; i += 256) {
        int b = i >> 7, k = i & 127;
        float v = (b < 8) ? p->c[b * 1024 + kc * 128 + k] : p->c_ctx[kc * 128 + k];
        sc[i] = v / (1.f + expf(-v));
      }
    }
    __syncthreads();
    if (ismod) {
      float acc[9];
#pragma unroll
      for (int b = 0; b < 9; ++b) acc[b] = 0.f;
      const float* w = p->w_mod + ((size_t)l * 1024 + kc * 128) * 6144 + cgp * 256 + htid;
#pragma unroll 8
      for (int k = 0; k < 128; ++k) {
        float wv = w[(size_t)k * 6144];
#pragma unroll
        for (int b = 0; b < 9; ++b) acc[b] += sc[b * 128 + k] * wv;
      }
      float* dst = wsp<float>(p, OFF_MODP) + (size_t)((kc * 2 + l) * 9) * 6144 + cgp * 256 + htid;
#pragma unroll
      for (int b = 0; b < 9; ++b) dst[(size_t)b * 6144] = acc[b];
    } else if (item == 384) {
      float* cs32 = wsp<float>(p, OFF_CS32);
      float* cs16 = wsp<float>(p, OFF_CS16);
      for (int t = htid; t < 1024; t += 256) {
        int pos = t >> 4, i = t & 15;
        float ang = (float)pos * powf(10000.f, -(float)(2 * i) / 32.f);
        cs32[t * 2] = cosf(ang); cs32[t * 2 + 1] = sinf(ang);
      }
      for (int t = htid; t < 512; t += 256) {
        int pos = t >> 3, i = t & 7;
        float ang = (float)pos * powf(10000.f, -(float)(2 * i) / 16.f);
        cs16[t * 2] = cosf(ang); cs16[t * 2 + 1] = sinf(ang);
      }
    } else if (item < 457) {
      const int q = item - 385, ll = q / 36, o = q % 36;
      float* dst = wsp<float>(p, OFF_WRT) + ((size_t)ll * 36 + o) * 1024;
      for (int k = htid; k < 1024; k += 256)
        dst[k] = (o < 4) ? p->w_group[((size_t)ll * 1024 + k) * 4 + o] : p->w_router[((size_t)ll * 1024 + k) * 32 + (o - 4)];
    }
  }
}
DEVI void phase1_2(KP p) {
  const float* mp = wsp<float>(p, OFF_MODP);
  float* mo = wsp<float>(p, OFF_MOD);
  for (int i = BIDX * 512 + TIDX; i < 2 * 9 * 6144; i += gridDim.x * 512) {
    int l = i / (9 * 6144), o = i % 6144;
    float s = p->b_mod[l * 6144 + o];
#pragma unroll
    for (int kc = 0; kc < 8; ++kc) s += mp[(size_t)kc * 2 * 9 * 6144 + i];
    mo[i] = s;
  }
}
DEVI void phaseA2(KP p) {
  const int gw = BIDX * NW + (TIDX >> 6), nw = gridDim.x * NW;
  u16* H = wsp<u16>(p, OFF_H);
  for (int tok0 = gw; tok0 < NTOK; tok0 += 2 * nw) {
    float xv[2][16];
#pragma unroll
    for (int r = 0; r < 2; ++r) { const int tok = tok0 + r * nw; if (tok < NTOK) load_row16(xrow_in(p, 0, tok / TPB, tok % TPB), xv[r]); }
#pragma unroll
    for (int r = 0; r < 2; ++r) {
      const int tok = tok0 + r * nw;
      if (tok < NTOK) { float hv[16]; modulate_row_store(p, 0, 0, xv[r], (tok % TPB) < NCTX ? 8 : tok / TPB, H + (size_t)tok * 1024, hv); }
    }
  }
}
DEVI void phaseG2(KP p, int l, ldsp_t lds) {
  constexpr int HS = 1026;
  const int tid = TIDX, lane = tid & 63, wave = __builtin_amdgcn_readfirstlane(tid >> 6);
  const int r32 = lane & 31, kh = lane >> 5, qd = lane >> 4;
  u16* H = wsp<u16>(p, OFF_H);
  const float* WRT = wsp<float>(p, OFF_WRT) + (size_t)l * 36 * 1024;
  int* cnt = wsp<int>(p, OFF_CNT);
  int* list = wsp<int>(p, OFF_LIST);
  float* wlist = wsp<float>(p, OFF_WLIST);
  LAS float* h2t = (LAS float*)lds;
  LAS float* part = (LAS float*)lds;
  LAS int* gsel = (LAS int*)(lds + 32 * HS * 4);
  LAS float* gwt = (LAS float*)(lds + 32 * HS * 4 + 128);
  float wreg[64];
  {
    const float* wr = p->w_router + (size_t)l * 1024 * 32 + r32;
#pragma unroll
    for (int t = 0; t < 32; ++t) {
      const int k = 128 * wave + 4 * t + 2 * kh;
      wreg[2 * t] = wr[(size_t)k * 32]; wreg[2 * t + 1] = wr[(size_t)(k + 1) * 32];
    }
  }
  for (int tile = BIDX; tile < NTOK / 32; tile += gridDim.x) {
    const int tok0 = tile * 32, b = tok0 / TPB, rr0 = tok0 % TPB;
    if (l == 1 && rr0 < NCTX) continue;
    {
      float hv[4][16], xv4[4][16];
#pragma unroll
      for (int r = 0; r < 4; ++r) load_row16(xrow_res(p, b, rr0 + wave * 4 + r), xv4[r]);
#pragma unroll
      for (int r = 0; r < 4; ++r) {
        modulate_row_store(p, l, 1, xv4[r], (rr0 < NCTX) ? 8 : b, H + (size_t)(tok0 + wave * 4 + r) * 1024, hv[r]);
        LAS float* dst = h2t + (wave * 4 + r) * HS + lane * 4;
#pragma unroll
        for (int i = 0; i < 4; ++i) {
          *(LAS f32x2*)(dst + i * 256) = f32x2{hv[r][i * 4], hv[r][i * 4 + 1]};
          *(LAS f32x2*)(dst + i * 256 + 2) = f32x2{hv[r][i * 4 + 2], hv[r][i * 4 + 3]};
        }
      }
      float gl[4];
#pragma unroll
      for (int o = 0; o < 4; ++o) gl[o] = router_dot(hv, WRT + (size_t)o * 1024) + p->b_group[l * 4 + o];
      int gs = 0; float best = gl[0];
#pragma unroll
      for (int j = 1; j < 4; ++j) if (gl[j] > best) { best = gl[j]; gs = j; }
      float gsum = 0.f;
#pragma unroll
      for (int j = 0; j < 4; ++j) gsum += expf(gl[j] - best);
      if ((lane & 15) == 0) { gsel[wave * 4 + qd] = gs; gwt[wave * 4 + qd] = 1.f / gsum; }
    }
    __syncthreads();
    f32x16 acc;
#pragma unroll
    for (int i = 0; i < 16; ++i) acc[i] = 0.f;
    {
      const LAS float* ap = h2t + r32 * HS + 128 * wave + 2 * kh;
#pragma unroll
      for (int t = 0; t < 32; ++t) {
        const f32x2 a = *(const LAS f32x2*)(ap + 4 * t);
        acc = __builtin_amdgcn_mfma_f32_32x32x2f32(a.x, wreg[2 * t], acc, 0, 0, 0);
        acc = __builtin_amdgcn_mfma_f32_32x32x2f32(a.y, wreg[2 * t + 1], acc, 0, 0, 0);
      }
    }
    __syncthreads();
#pragma unroll
    for (int i = 0; i < 16; ++i) part[(wave * 32 + (i & 3) + 8 * (i >> 2) + 4 * kh) * 33 + r32] = acc[i];
    __syncthreads();
    if (tid < 32) {
      const int gs = gsel[tid];
      const float gw_ = gwt[tid];
      float e8[8];
#pragma unroll
      for (int j = 0; j < 8; ++j) {
        float v = p->b_router[l * 32 + gs * 8 + j];
#pragma unroll
        for (int w = 0; w < 8; ++w) v += part[(w * 32 + tid) * 33 + gs * 8 + j];
        e8[j] = v;
      }
      int i0 = 0; float v0 = e8[0];
#pragma unroll
      for (int j = 1; j < 8; ++j) if (e8[j] > v0) { v0 = e8[j]; i0 = j; }
      int i1 = -1; float v1 = -INFINITY;
#pragma unroll
      for (int j = 0; j < 8; ++j) if (j != i0 && e8[j] > v1) { v1 = e8[j]; i1 = j; }
      const float ex = expf(v1 - v0);
      const float w0 = gw_ / (1.f + ex), w1 = gw_ * ex / (1.f + ex);
      const int tok = tok0 + tid;
      const int ea = gs * 8 + i0, eb = gs * 8 + i1;
      const int sa = atomicAdd(&cnt[ea * CNT_STRIDE], 1);
      const int sb = atomicAdd(&cnt[eb * CNT_STRIDE], 1);
      list[(size_t)ea * NTOK + sa] = tok * 2; wlist[(size_t)ea * NTOK + sa] = w0;
      list[(size_t)eb * NTOK + sb] = tok * 2 + 1; wlist[(size_t)eb * NTOK + sb] = w1;
    }
    __syncthreads();
  }
}
struct ExpInfo2 { int tiles[4], base[4], cnt[4]; };
DEVI ExpInfo2 exp_info2(KP p, int xcd) {
  const int* cnt = wsp<int>(p, OFF_CNT);
  ExpInfo2 ei;
  int before = 0;
#pragma unroll
  for (int e = 0; e < 32; ++e) {
    const int c = __builtin_amdgcn_readfirstlane(cnt[e * CNT_STRIDE]), t = (c + 255) >> 8;
    if ((e & 7) == xcd) { ei.tiles[e >> 3] = t; ei.base[e >> 3] = before; ei.cnt[e >> 3] = c; }
    before += t;
  }
  return ei;
}
template <int NN>
struct SchedX { ExpInfo2 ei; int xcd, lb, G8; const char* A; const char* W; const int* list; size_t wstride; int lda_b;
  DEVI bool next(int i, Unit& u) const {
    const int tot = (ei.tiles[0] + ei.tiles[1] + ei.tiles[2] + ei.tiles[3]) * NN;
    const int n = i * G8 + lb; if (n >= tot) return false;
    int k = 0, m = n / NN; const int pn = n % NN;
    int tb = ei.base[0], ce = ei.cnt[0];
#pragma unroll
    for (int kk = 0; kk < 3; ++kk) { if (k == kk && m >= ei.tiles[kk]) { m -= ei.tiles[kk]; k = kk + 1; tb = ei.base[kk + 1]; ce = ei.cnt[kk + 1]; } }
    const int e = xcd + 8 * k;
    u.rows = list + (size_t)e * NTOK + m * 256; u.nvalid = ce - m * 256;
    u.A = A + (NN == 2 ? 0u : uoff((unsigned)(tb + m) * 256u * (unsigned)lda_b));
    u.B = W + uoff((unsigned)e * (unsigned)wstride + (unsigned)pn * 256u * (NN == 2 ? 2048u : 512u));
    u.u0 = (tb + m) * 256; u.u1 = pn; u.u2 = e; u.u3 = m; return true; } };
struct EpiI1 { u16* U;
  DEVI void init(f32x4 (&acc)[2][2][4][2], const Unit&, int, int, int, int) const { acc_zero(acc); }
  DEVI void operator()(const f32x4 (&acc)[2][2][4][2], const Unit& u, int wr, int wc, int fr, int fq) const {
#pragma unroll
    for (int ai = 0; ai < 2; ++ai)
#pragma unroll
      for (int m = 0; m < 4; ++m) {
        u16* rowp = U + (size_t)(u.u0 + ai * HALF + wr * 64 + m * 16 + fr) * 256;
#pragma unroll
        for (int bj = 0; bj < 2; ++bj) {
          const int ff = 16 * (8 * u.u1 + 4 * bj + wc) + 4 * fq;
          const f32x4 g = acc[ai][bj][m][0], up = acc[ai][bj][m][1];
          float t[4];
#pragma unroll
          for (int j = 0; j < 4; ++j) t[j] = g[j] / (1.f + __expf(-g[j])) * up[j];
          u32x2 o; o.x = pk2(t[0], t[1]); o.y = pk2(t[2], t[3]);
          *(u32x2*)(rowp + ff) = o;
        }
      }
  }
};
DEVI void phaseI1_2(KP p, ldsp_t lds) {
  const int xcd = BIDX & 7, lb = BIDX >> 3, G8 = gridDim.x >> 3;
  if (lb >= G8) return;
  SchedX<2> S{exp_info2(p, xcd), xcd, lb, G8, (const char*)wsp<u16>(p, OFF_H), (const char*)wsp<u16>(p, OFF_W13), wsp<int>(p, OFF_LIST), (size_t)512 * 2048, 2048};
  EpiI1 E{wsp<u16>(p, OFF_U)};
  int nt = 16; asm volatile("" : "+s"(nt));
  gemm_phase<false, true>(lds, 2048, 2048, nt, S, E);
}
struct EpiI2 { u16* YS; const float* wlist; const int* list;
  DEVI void init(f32x4 (&acc)[2][2][4][2], const Unit&, int, int, int, int) const { acc_zero(acc); }
  DEVI void operator()(const f32x4 (&acc)[2][2][4][2], const Unit& u, int wr, int wc, int fr, int fq) const {
    const unsigned colb = (unsigned)(u.u1 * 256 + wc * 32 + 8 * fq) * 2u;
    const float* we = wlist + (u.rows - list);
    unsigned dest[2][4]; float w[2][4];
#pragma unroll
    for (int ai = 0; ai < 2; ++ai)
#pragma unroll
      for (int m = 0; m < 4; ++m) {
        const int r = ai * HALF + wr * 64 + m * 16 + fr;
        dest[ai][m] = (r < u.nvalid) ? (unsigned)u.rows[r] : (unsigned)(2 * NTOK);
        w[ai][m] = we[r];
      }
#pragma unroll
    for (int ai = 0; ai < 2; ++ai)
#pragma unroll
      for (int m = 0; m < 4; ++m) {
        char* rowp = (char*)YS + (dest[ai][m] * 2048u + colb);
#pragma unroll
        for (int bj = 0; bj < 2; ++bj) {
          const f32x4 v0 = acc[ai][bj][m][0] * w[ai][m], v1 = acc[ai][bj][m][1] * w[ai][m];
          u32x4 o; o.x = pk2(v0[0], v0[1]); o.y = pk2(v0[2], v0[3]); o.z = pk2(v1[0], v1[1]); o.w = pk2(v1[2], v1[3]);
          *(u32x4*)(rowp + bj * 256) = o;
        }
      }
  }
};
DEVI void phaseI2_2(KP p, ldsp_t lds) {
  const int xcd = BIDX & 7, lb = BIDX >> 3, G8 = gridDim.x >> 3;
  if (lb >= G8) return;
  SchedX<4> S{exp_info2(p, xcd), xcd, lb, G8, (const char*)wsp<u16>(p, OFF_U), (const char*)wsp<u16>(p, OFF_W2), wsp<int>(p, OFF_LIST), (size_t)1024 * 512, 512};
  EpiI2 E{wsp<u16>(p, OFF_YS), wsp<float>(p, OFF_WLIST), wsp<int>(p, OFF_LIST)};
  int nt = 4; asm volatile("" : "+s"(nt));
  gemm_phase<true, false>(lds, 512, 512, nt, S, E);
}
DEVI void phaseJ2(KP p, int l, ldsp_t lds) {
  const int lane = TIDX & 63;
  const int gw = BIDX * NW + (TIDX >> 6), nw = gridDim.x * NW;
  const u16* YS = wsp<u16>(p, OFF_YS);
  u16* H = wsp<u16>(p, OFF_H);
  for (int tok0 = gw; tok0 < NTOK; tok0 += 2 * nw) {
    float xv[2][16]; u32x2 y0[2][4], y1[2][4]; bool ok[2]; int tk[2];
#pragma unroll
    for (int r = 0; r < 2; ++r) {
      const int tok = tok0 + r * nw;
      tk[r] = tok;
      ok[r] = (tok < NTOK) && !(l == 1 && (tok % TPB) < NCTX);
      if (ok[r]) {
        const int b = tok / TPB, rr = tok % TPB;
        load_row16(xrow_res(p, b, rr), xv[r]);
#pragma unroll
        for (int i = 0; i < 4; ++i) {
          const int c = i * 256 + lane * 4;
          y0[r][i] = *(const u32x2*)(YS + (size_t)(tok * 2) * 1024 + c);
          y1[r][i] = *(const u32x2*)(YS + (size_t)(tok * 2 + 1) * 1024 + c);
        }
      }
    }
#pragma unroll
    for (int r = 0; r < 2; ++r) {
      if (!ok[r]) continue;
      const int tok = tk[r];
      const int b = tok / TPB, rr = tok % TPB;
      const int mrow = (rr < NCTX) ? 8 : b;
      float* xr = xrow_res(p, b, rr);
      const float* gt = wsp<float>(p, OFF_MOD) + ((size_t)l * 9 + mrow) * 6144 + 5120;
#pragma unroll
      for (int i = 0; i < 4; ++i) {
        const int c = i * 256 + lane * 4;
        const f32x4 g = *(const f32x4*)(gt + c);
        xv[r][i * 4 + 0] += g.x * (bf2f((u16)(y0[r][i].x & 0xffff)) + bf2f((u16)(y1[r][i].x & 0xffff)));
        xv[r][i * 4 + 1] += g.y * (bf2f((u16)(y0[r][i].x >> 16)) + bf2f((u16)(y1[r][i].x >> 16)));
        xv[r][i * 4 + 2] += g.z * (bf2f((u16)(y0[r][i].y & 0xffff)) + bf2f((u16)(y1[r][i].y & 0xffff)));
        xv[r][i * 4 + 3] += g.w * (bf2f((u16)(y0[r][i].y >> 16)) + bf2f((u16)(y1[r][i].y >> 16)));
      }
      if (l == 0) {
#pragma unroll
        for (int i = 0; i < 4; ++i)
          *(f32x4*)(xr + i * 256 + lane * 4) = f32x4{xv[r][i * 4], xv[r][i * 4 + 1], xv[r][i * 4 + 2], xv[r][i * 4 + 3]};
        float hv[16];
        modulate_row_store(p, 1, 0, xv[r], mrow, H + (size_t)tok * 1024, hv);
      } else {
        float ss = 0.f;
#pragma unroll
        for (int i = 0; i < 16; ++i) ss += xv[r][i] * xv[r][i];
        ss = wave_sum(ss);
        const float rstd = rsqrtf(ss * (1.f / 1024.f) + EPS);
#pragma unroll
        for (int i = 0; i < 4; ++i) {
          const int c = i * 256 + lane * 4;
          const f32x4 g = *(const f32x4*)(p->g_final + c);
          *(f32x4*)(xr + c) = f32x4{xv[r][i * 4] * rstd * g.x, xv[r][i * 4 + 1] * rstd * g.y, xv[r][i * 4 + 2] * rstd * g.z, xv[r][i * 4 + 3] * rstd * g.w};
        }
      }
    }
  }
}

constexpr int N_PHASES = 3 + 2 * 11;
__global__ void __launch_bounds__(512, 2) fwd_v2(Params parg) {
  extern __shared__ __attribute__((aligned(16))) unsigned char dyn_lds[];
  const ldsp_t lds = (ldsp_t)dyn_lds;
  cg::grid_group grid = cg::this_grid();
  volatile LAS unsigned* xb_st = (volatile LAS unsigned*)(lds + LDS_BARW);
  if (TIDX < 4) xb_st[TIDX] = 0u;
  __syncthreads();
  if (parg.ph_end - parg.ph_begin > 1) xcd_barrier_post((unsigned*)(parg.ws + OFF_BAR));
  for (int ph = parg.ph_begin; ph < parg.ph_end; ++ph) {
    KP p = (KP)__builtin_amdgcn_kernarg_segment_ptr();
    asm volatile("" : "+s"(p));
    const int l = (ph >= 14) ? 1 : 0;
    const int k = (ph < 3) ? ph : 3 + (ph - 3) % 11;
    const int reps = (((PROBE_DUP >> k) & 1) && (!(PROBE_DUP & 0x10000) || l == 0)) ? 2 : 1;
    for (int rep = 0; rep < reps; ++rep) {
      if (rep) {
        xcd_barrier((unsigned*)(p->ws + OFF_BAR), xb_st);
        if (k == 10) { if (BIDX == 0 && TIDX < 32) wsp<int>(p, OFF_CNT)[TIDX * CNT_STRIDE] = 0; xcd_barrier((unsigned*)(p->ws + OFF_BAR), xb_st); }
      }
      switch (k) {
        case 0: phase0_2(p, lds); break;
        case 1: phase1_2(p); break;
        case 2: phaseA2(p); break;
        case 3: phaseB2(p, lds); break;
        case 4: phaseC2(p, lds); break;
        case 5: phaseP2(p, l, lds); break;
        case 6: phaseD2(p, l, lds); break;
        case 7: phaseE1(p, l, lds); break;
        case 8: phaseE2(p, l, lds); break;
        case 9: phaseF2(p, l, lds); break;
        case 10: phaseG2(p, l, lds); break;
        case 11: phaseI1_2(p, lds); break;
        case 12: phaseI2_2(p, lds); break;
        default: phaseJ2(p, l, lds); break;
      }
    }
    if (k == 0 || (k == 13 && l == 0)) conv_items2(p, k == 0 ? 0 : 1, lds, 0, CONV_EARLY);
    if (ph + 1 < parg.ph_end) {
      if (ph == parg.ph_begin) grid.sync();
      else xcd_barrier((unsigned*)(p->ws + OFF_BAR), xb_st);
    }
  }
}
}

extern "C" void kernel_launch(void* const* d_in, const int* in_sizes, int n_in, void* d_out, int out_size,
                              void* d_ws, size_t ws_size, hipStream_t stream) {
  static int grid2 = 0;
  if (!grid2) {
    int dev = 0, cus = 0, per_cu = 0;
    (void)hipGetDevice(&dev);
    (void)hipDeviceGetAttribute(&cus, hipDeviceAttributeMultiprocessorCount, dev);
    (void)hipFuncSetAttribute((const void*)v2::fwd_v2, hipFuncAttributeMaxDynamicSharedMemorySize, v2::LDS_TOTAL);
    (void)hipOccupancyMaxActiveBlocksPerMultiprocessor(&per_cu, v2::fwd_v2, 512, v2::LDS_TOTAL);
    if (per_cu < 1) { fprintf(stderr, "kernel does not fit on a CU\n"); per_cu = 1; }
    grid2 = cus & ~7;
  }
  if (ws_size < WS_NEEDED) { fprintf(stderr, "workspace too small: %zu < %zu\n", ws_size, (size_t)WS_NEEDED); return; }
  Params hp{};
  const float** f = (const float**)&hp;
  for (int i = 0; i < 29; ++i) f[i] = (const float*)d_in[i];
  hp.out = (float*)d_out;
  hp.ws = (char*)d_ws;
#if N_LAUNCH_MODE == 1
  for (int ph = 0; ph < v2::N_PHASES; ++ph) {
    hp.ph_begin = ph; hp.ph_end = ph + 1;
    void* args[] = {&hp};
    hipError_t e = hipLaunchCooperativeKernel((void*)v2::fwd_v2, dim3(grid2), dim3(512), args, v2::LDS_TOTAL, stream);
    if (e != hipSuccess) fprintf(stderr, "launch failed: %s\n", hipGetErrorString(e));
  }
#else
  hp.ph_begin = 0; hp.ph_end = v2::N_PHASES;
  (void)hipMemsetAsync((char*)d_ws + OFF_BAR, 0, (size_t)XCD_BAR_WORDS * 4, stream);
  void* args[] = {&hp};
  hipError_t e = hipLaunchCooperativeKernel((void*)v2::fwd_v2, dim3(grid2), dim3(512), args, v2::LDS_TOTAL, stream);
  if (e != hipSuccess) fprintf(stderr, "cooperative launch failed: %s (grid %d)\n", hipGetErrorString(e), grid2);
#endif
}
```

```cpp
#include <hip/hip_runtime.h>
#include <hip/hip_cooperative_groups.h>
#include <stdint.h>
#include <stdio.h>
namespace cg = cooperative_groups;

#ifndef N_LAUNCH_MODE
#define N_LAUNCH_MODE 0
#endif

#ifndef PROBE_DUP
#define PROBE_DUP 0
#endif
#define DEVI __device__ __forceinline__
typedef unsigned short u16;
typedef __attribute__((ext_vector_type(2))) float f32x2;
typedef __attribute__((ext_vector_type(2))) __bf16 bf16x2_t;
typedef __attribute__((ext_vector_type(8))) short bf16x8;
typedef __attribute__((ext_vector_type(16))) float f32x16;
typedef __attribute__((ext_vector_type(4))) unsigned u32x4;
typedef __attribute__((ext_vector_type(2))) unsigned u32x2;
typedef __attribute__((ext_vector_type(4))) float f32x4;
#define MFMA(a, b, c) __builtin_amdgcn_mfma_f32_32x32x16_bf16((a), (b), (c), 0, 0, 0)

constexpr int DMODEL = 1024, NBATCH = 8, SEQ = 4096, NCTX = 256;
constexpr int TPB = SEQ + NCTX;
constexpr int NTOK = NBATCH * TPB;
constexpr int MT_PER_B = TPB / 128;
constexpr int NEXP = 32;
constexpr int INP = 2304;
constexpr float EPS = 1e-6f;
constexpr float LOG2E = 1.4426950408889634f;
constexpr int SMEM_BYTES = 73728;
constexpr int UROWS = 2 * NTOK + NEXP * 256;

constexpr size_t al(size_t x) { return (x + 255) & ~(size_t)255; }
constexpr size_t OFF_WIN = 0;
constexpr size_t OFF_WQB = OFF_WIN + al((size_t)INP * 1024 * 2);
constexpr size_t OFF_WKVB = OFF_WQB + al((size_t)512 * 256 * 2);
constexpr size_t OFF_WGATE = OFF_WKVB + al((size_t)512 * 256 * 2);
constexpr size_t OFF_WBR = OFF_WGATE + al((size_t)4 * 1024 * 1024 * 2);
constexpr size_t OFF_WOUT = OFF_WBR + al((size_t)4 * 1024 * 256 * 2);
constexpr size_t OFF_W13 = OFF_WOUT + al((size_t)1024 * 1024 * 2);
constexpr size_t OFF_W2 = OFF_W13 + al((size_t)32 * 512 * 1024 * 2);
constexpr size_t OFF_MODP = OFF_W2 + al((size_t)32 * 1024 * 256 * 2);
constexpr size_t OFF_MOD = OFF_MODP + al((size_t)8 * 2 * 9 * 6144 * 4);
constexpr size_t OFF_CS32 = OFF_MOD + al((size_t)2 * 9 * 6144 * 4);
constexpr size_t OFF_CS16 = OFF_CS32 + al((size_t)64 * 16 * 2 * 4);
constexpr size_t OFF_WRT = OFF_CS16 + al((size_t)64 * 8 * 2 * 4);
constexpr size_t OFF_CNT = OFF_WRT + al((size_t)2 * 36 * 1024 * 4);
constexpr int CNT_STRIDE = 64;
constexpr size_t OFF_BAR = OFF_CNT + al(32 * CNT_STRIDE * 4);
constexpr int XCD_BAR_WORDS = 3456;
constexpr size_t OFF_CTXRES = OFF_BAR + al((size_t)XCD_BAR_WORDS * 4);
constexpr size_t OFF_H = OFF_CTXRES + al((size_t)8 * 256 * 1024 * 4);
constexpr size_t OFF_O = OFF_H + al((size_t)NTOK * 1024 * 2);
constexpr size_t OFF_SSQ = OFF_O + al((size_t)NTOK * 1024 * 2);
constexpr size_t OFF_LIST = OFF_SSQ + al((size_t)NTOK * 8 * 4);
constexpr size_t OFF_WLIST = OFF_LIST + al((size_t)32 * NTOK * 4);
constexpr size_t OFF_R1 = OFF_WLIST + al((size_t)32 * NTOK * 4);
constexpr int PLD = INP;
constexpr size_t OFF_PRAW = OFF_R1;
constexpr size_t OFF_QARAW = OFF_PRAW + (size_t)NTOK * INP * 2;
constexpr size_t OFF_KVARAW = OFF_QARAW + (size_t)NTOK * 512 * 2;
constexpr size_t OFF_VAT = OFF_KVARAW + (size_t)NTOK * 512 * 2;
constexpr size_t OFF_VBT = OFF_VAT + (size_t)NTOK * 256 * 2;
constexpr size_t OFF_VCT = OFF_VBT + (size_t)NTOK * 128 * 2;
constexpr size_t OFF_VDT = OFF_VCT + (size_t)NTOK * 256 * 2;
constexpr size_t OFF_END = OFF_VDT + (size_t)NTOK * 128 * 2;
constexpr size_t OFF_Z = OFF_R1;
constexpr size_t OFF_YPRE = OFF_O;
constexpr size_t OFF_U = OFF_R1;
constexpr size_t OFF_YS = OFF_R1 + al((size_t)UROWS * 256 * 2);
static_assert(OFF_Z + (size_t)NTOK * 4096 * 2 <= OFF_END, "alias overflow");
static_assert(OFF_YS + (size_t)(2 * NTOK + 1) * 1024 * 2 <= OFF_END, "alias overflow");
constexpr size_t WS_NEEDED = OFF_END;
static_assert(WS_NEEDED <= (size_t)536870912, "workspace budget (4 x largest tensor)");

struct Params {
  const float *x, *c, *ctx, *c_ctx, *w_mod, *b_mod, *g_norm_mix, *w_in, *g_q_a, *w_q_b, *g_kv_a, *w_kv_b,
      *sink_b, *rpb_c, *g_q_d, *g_k_d, *w_gate, *b_gate, *w_branch, *w_out, *g_norm_ffn, *w_group, *b_group,
      *w_router, *b_router, *w_ff1, *w_ff3, *w_ff2, *g_final;
  float* out;
  char* ws;
  int ph_begin, ph_end;
};

DEVI int tid_fresh() { int t; asm volatile("v_mov_b32 %0, %1" : "=v"(t) : "v"(__builtin_amdgcn_workitem_id_x())); return t; }
DEVI int bid_fresh() { int t; asm volatile("s_mov_b32 %0, %1" : "=s"(t) : "s"(__builtin_amdgcn_workgroup_id_x())); return t; }
#define TIDX tid_fresh()
#define BIDX bid_fresh()
typedef const __attribute__((address_space(4))) Params* KP;
DEVI unsigned pk2(float a, float b) { f32x2 v = {a, b}; bf16x2_t r = __builtin_convertvector(v, bf16x2_t); return __builtin_bit_cast(unsigned, r); }
DEVI u16 f2bf(float a) { return (u16)(pk2(a, 0.f) & 0xffffu); }
DEVI float bf2f(u16 v) { return __uint_as_float(((unsigned)v) << 16); }
DEVI float wave_sum(float v) {
#pragma unroll
  for (int m = 32; m >= 1; m >>= 1) v += __shfl_xor(v, m);
  return v;
}
template <class T> DEVI T* wsp(KP p, size_t off) { return (T*)(p->ws + off); }
DEVI const float* xrow_in(KP p, int l, int b, int rr) {
  if (l == 0) return (rr < NCTX) ? p->ctx + ((size_t)b * NCTX + rr) * 1024 : p->x + ((size_t)b * SEQ + rr - NCTX) * 1024;
  return (rr < NCTX) ? wsp<float>(p, OFF_CTXRES) + ((size_t)b * NCTX + rr) * 1024 : p->out + ((size_t)b * SEQ + rr - NCTX) * 1024;
}
DEVI float* xrow_res(KP p, int b, int rr) {
  return (rr < NCTX) ? wsp<float>(p, OFF_CTXRES) + ((size_t)b * NCTX + rr) * 1024 : p->out + ((size_t)b * SEQ + rr - NCTX) * 1024;
}
DEVI int perm16(int k) { return (k & ~12) | ((k & 4) << 1) | ((k & 8) >> 1); }

struct ConvT { const float* src; const float* src2; const float* ks; u16* dst; int ld; int ldd; float mul; };
constexpr int CONV_ITEMS = 1152 + 64 + 64 + 2048 + 512 + 512 + 8192 + 4096;
DEVI ConvT conv_decode(KP p, int l, int idx) {
  ConvT c; c.ks = nullptr; c.mul = 1.f; c.src2 = nullptr;
  if (idx < 1152) {
    int nt = idx >> 4, kt = idx & 15, n0 = nt * 32;
    int sc = (n0 < 416) ? n0 : ((n0 < 512) ? -1 : n0 - 96);
    c.ld = 2208; c.ldd = 1024;
    if ((n0 >= 512 && n0 < 768) || (n0 >= 1024 && n0 < 1280)) c.mul = 0.125f * LOG2E;
    c.src = (sc < 0) ? nullptr : p->w_in + (size_t)l * 1024 * 2208 + (size_t)kt * 64 * 2208 + sc;
    c.dst = wsp<u16>(p, OFF_WIN) + (size_t)n0 * 1024 + kt * 64;
    return c;
  }
  idx -= 1152;
  if (idx < 64) {
    int nt = idx >> 2, kt = idx & 3;
    c.ld = 384; c.ldd = 256; c.ks = p->g_q_a + l * 256 + kt * 64;
    c.src = (nt >= 12) ? nullptr : p->w_q_b + (size_t)l * 256 * 384 + (size_t)kt * 64 * 384 + nt * 32;
    c.dst = wsp<u16>(p, OFF_WQB) + (size_t)nt * 32 * 256 + kt * 64;
    return c;
  }
  idx -= 64;
  if (idx < 64) {
    int nt = idx >> 2, kt = idx & 3;
    c.ld = 512; c.ldd = 256; c.ks = (kt < 2) ? p->g_kv_a + l * 128 + kt * 64 : nullptr;
    c.src = (kt >= 2) ? nullptr : p->w_kv_b + (size_t)l * 128 * 512 + (size_t)kt * 64 * 512 + nt * 32;
    c.dst = wsp<u16>(p, OFF_WKVB) + (size_t)nt * 32 * 256 + kt * 64;
    return c;
  }
  idx -= 64;
  if (idx < 2048) {
    int nt = idx >> 4, kt = idx & 15, R0 = nt * 32;
    int pr = R0 >> 11, cb = (R0 & 2047) >> 8, bj = (R0 & 255) >> 7, j0 = R0 & 127;
    c.ld = 1024; c.ldd = 1024;
    c.src = p->w_gate + ((size_t)(l * 4 + 2 * pr + bj) * 1024 + kt * 64) * 1024 + cb * 128 + j0;
    c.dst = wsp<u16>(p, OFF_WGATE) + (size_t)R0 * 1024 + kt * 64;
    return c;
  }
  idx -= 2048;
  if (idx < 512) {
    int br = idx >> 7, nt = (idx >> 2) & 31, kt = idx & 3;
    c.ld = 1024; c.ldd = 256;
    c.src = p->w_branch + ((size_t)(l * 4 + br) * 256 + kt * 64) * 1024 + nt * 32;
    c.dst = wsp<u16>(p, OFF_WBR) + ((size_t)br * 1024 + nt * 32) * 256 + kt * 64;
    return c;
  }
  idx -= 512;
  if (idx < 512) {
    int nt = idx >> 4, kt = idx & 15;
    c.ld = 1024; c.ldd = 1024;
    c.src = p->w_out + ((size_t)l * 1024 + kt * 64) * 1024 + nt * 32;
    c.dst = wsp<u16>(p, OFF_WOUT) + (size_t)nt * 32 * 1024 + kt * 64;
    return c;
  }
  idx -= 512;
  if (idx < 8192) {
    int e = idx >> 8, g32 = (idx >> 4) & 15, kt = idx & 15;
    c.ld = 256; c.ldd = 1024;
    c.src = p->w_ff1 + ((size_t)(l * 32 + e) * 1024 + kt * 64) * 256 + g32 * 16;
    c.src2 = p->w_ff3 + ((size_t)(l * 32 + e) * 1024 + kt * 64) * 256 + g32 * 16;
    c.dst = wsp<u16>(p, OFF_W13) + ((size_t)e * 512 + g32 * 32) * 1024 + kt * 64;
    return c;
  }
  idx -= 8192;
  {
    int e = idx >> 7, nt = (idx >> 2) & 31, kt = idx & 3;
    c.ld = 1024; c.ldd = 256;
    c.src = p->w_ff2 + ((size_t)(l * 32 + e) * 256 + kt * 64) * 1024 + nt * 32;
    c.dst = wsp<u16>(p, OFF_W2) + ((size_t)e * 1024 + nt * 32) * 256 + kt * 64;
    return c;
  }
}
DEVI void modulate_row_store(KP p, int l, int which, const float (&xv)[16], int mrow, u16* hrow, float (&hv)[16]) {
  const int lane = TIDX & 63;
  float ss = 0.f;
#pragma unroll
  for (int i = 0; i < 16; ++i) ss += xv[i] * xv[i];
  ss = wave_sum(ss);
  const float rstd = rsqrtf(ss * (1.f / 1024.f) + EPS);
  const float* g = (which ? p->g_norm_ffn : p->g_norm_mix) + l * 1024;
  const float* mod = wsp<float>(p, OFF_MOD) + ((size_t)l * 9 + mrow) * 6144 + (which ? 3072 : 0);
#pragma unroll
  for (int i = 0; i < 4; ++i) {
    const int c = i * 256 + lane * 4;
    f32x4 gv = *(const f32x4*)(g + c);
    f32x4 sh = *(const f32x4*)(mod + c);
    f32x4 sc = *(const f32x4*)(mod + 1024 + c);
    hv[i * 4 + 0] = xv[i * 4 + 0] * rstd * gv.x * (1.f + sc.x) + sh.x;
    hv[i * 4 + 1] = xv[i * 4 + 1] * rstd * gv.y * (1.f + sc.y) + sh.y;
    hv[i * 4 + 2] = xv[i * 4 + 2] * rstd * gv.z * (1.f + sc.z) + sh.z;
    hv[i * 4 + 3] = xv[i * 4 + 3] * rstd * gv.w * (1.f + sc.w) + sh.w;
    u32x2 o; o.x = pk2(hv[i * 4 + 0], hv[i * 4 + 1]); o.y = pk2(hv[i * 4 + 2], hv[i * 4 + 3]);
    *(u32x2*)(hrow + c) = o;
  }
}
DEVI void load_row16(const float* xr, float (&xv)[16]) {
  const int lane = TIDX & 63;
#pragma unroll
  for (int i = 0; i < 4; ++i) {
    f32x4 v = *(const f32x4*)(xr + i * 256 + lane * 4);
    xv[i * 4 + 0] = v.x; xv[i * 4 + 1] = v.y; xv[i * 4 + 2] = v.z; xv[i * 4 + 3] = v.w;
  }
}
DEVI float router_dot(const float (&hv)[4][16], const float* wrow) {
  const int lane = TIDX & 63;
  const float* w = wrow + lane * 4;
  float pr[4] = {0.f, 0.f, 0.f, 0.f};
#pragma unroll
  for (int i = 0; i < 4; ++i) {
    const f32x4 wv = *(const f32x4*)(w + i * 256);
#pragma unroll
    for (int r = 0; r < 4; ++r)
      pr[r] += hv[r][i * 4] * wv.x + hv[r][i * 4 + 1] * wv.y + hv[r][i * 4 + 2] * wv.z + hv[r][i * 4 + 3] * wv.w;
  }
  const bool up = (lane & 32) != 0;
  float s0 = up ? pr[0] : pr[2], s1 = up ? pr[1] : pr[3];
  float k0 = up ? pr[2] : pr[0], k1 = up ? pr[3] : pr[1];
  k0 += __shfl_xor(s0, 32); k1 += __shfl_xor(s1, 32);
  const bool up2 = (lane & 16) != 0;
  float sv = up2 ? k0 : k1, kv = up2 ? k1 : k0;
  kv += __shfl_xor(sv, 16);
  kv += __shfl_xor(kv, 8); kv += __shfl_xor(kv, 4); kv += __shfl_xor(kv, 2); kv += __shfl_xor(kv, 1);
  return kv;
}
#define XB_TMO      128
#define XB_XCNT(j)  (256  + 64 * (j))
#define XB_XSUB(j)  (1280 + 64 * (j))
#define XB_XGEN(j)  (2304 + 64 * (j))
#define XB_TOP      3328
#define XB_TOPGEN   3392
#define XB_SPIN_CAP (1u << 20)
#define LAS __attribute__((address_space(3)))
DEVI unsigned xb_ld(unsigned* p) { return __hip_atomic_load(p, __ATOMIC_RELAXED, __HIP_MEMORY_SCOPE_AGENT); }
DEVI unsigned xb_add(unsigned* p, unsigned v) { return __hip_atomic_fetch_add(p, v, __ATOMIC_RELAXED, __HIP_MEMORY_SCOPE_AGENT); }
DEVI unsigned xb_xcc_id() { return (unsigned)__builtin_amdgcn_s_getreg((3 << 11) | 20) & 0xFu; }
#define XB_SPIN(cond, bar) do { unsigned _sp = 0; while (cond) { __builtin_amdgcn_s_sleep(1); \
    if ((++_sp & 255u) == 0u) { if (xb_ld(&(bar)[XB_TMO])) break; if (_sp > XB_SPIN_CAP) { atomicAdd(&(bar)[XB_TMO], 1u); break; } } } } while (0)
DEVI void xcd_barrier_post(unsigned* bar) {
  if (TIDX == 0) (void)xb_add(&bar[XB_XCNT(xb_xcc_id())], 1u);
}
DEVI void xcd_barrier_complete(unsigned* bar, unsigned x, unsigned& nloc, unsigned& nx) {
  const unsigned G = gridDim.x * gridDim.y * gridDim.z;
  unsigned sum, cnt, mine, sp = 0u;
  for (;;) {
    sum = 0u; cnt = 0u; mine = 0u;
#pragma unroll
    for (unsigned j = 0; j < 16; ++j) { const unsigned c = xb_ld(&bar[XB_XCNT(j)]); sum += c; cnt += (c > 0u) ? 1u : 0u; mine = (j == x) ? c : mine; }
    if (sum == G) break;
    __builtin_amdgcn_s_sleep(1);
    if ((++sp & 255u) == 0u) { if (xb_ld(&bar[XB_TMO])) break; if (sp > XB_SPIN_CAP) { atomicAdd(&bar[XB_TMO], 1u); break; } }
  }
  nloc = mine > 0u ? mine : 1u; nx = cnt > 0u ? cnt : 1u;
}
DEVI void xcd_barrier(unsigned* bar, volatile LAS unsigned* st) {
  asm volatile("s_waitcnt vmcnt(0)" ::: "memory");
  __syncthreads();
  if (TIDX == 0) {
    const unsigned x = xb_xcc_id();
    __builtin_amdgcn_s_waitcnt(0);
    unsigned nloc = st[0], nx = st[1];
    if (nloc == 0u) { xcd_barrier_complete(bar, x, nloc, nx); st[0] = nloc; st[1] = nx; }
    const unsigned old = xb_add(&bar[XB_XSUB(x)], 1u);
    const unsigned gen = old / nloc;
    if (old + 1u == (gen + 1u) * nloc) {
      __builtin_amdgcn_fence(__ATOMIC_RELEASE, "agent");
      asm volatile("s_waitcnt vmcnt(0)" ::: "memory");
      const unsigned og = xb_add(&bar[XB_TOP], 1u);
      const unsigned tg = og / nx;
      if (og + 1u == (tg + 1u) * nx) xb_add(&bar[XB_TOPGEN], 1u);
      else XB_SPIN(xb_ld(&bar[XB_TOPGEN]) == tg, bar);
      __builtin_amdgcn_fence(__ATOMIC_ACQUIRE, "agent");
      xb_add(&bar[XB_XGEN(x)], 1u);
      asm volatile("s_waitcnt vmcnt(0)" ::: "memory");
    } else {
      XB_SPIN(xb_ld(&bar[XB_XGEN(x)]) == gen, bar);
      __builtin_amdgcn_fence(__ATOMIC_ACQUIRE, "agent");
      asm volatile("s_waitcnt vmcnt(0)" ::: "memory");
    }
  }
  __syncthreads();
}

namespace v2 {
typedef LAS unsigned char* ldsp_t;
constexpr int BM = 256, BK = 64, HALF = 128, HTB = HALF * BK * 2, STAGE_BYTES = 8 * HTB;
constexpr int NW = 8;
constexpr int LDS_XTRA = STAGE_BYTES;
constexpr int LDS_BARW = STAGE_BYTES + 16384;
constexpr int LDS_TOTAL = LDS_BARW + 16;

DEVI int lds_byte(int r, int c) { const int st = (r >> 4) * 2 + (c >> 5), rr = r & 15, cc = c & 31, ob = rr * 64 + cc * 2; return st * 1024 + (ob ^ (((ob >> 9) & 1) << 5)); }
DEVI void stage_rc(int b, int& R, int& C) { const int st = b / 1024, sb = b % 1024, swz = sb ^ (((sb >> 9) & 1) << 5); R = (st >> 1) * 16 + swz / 64; C = (st & 1) * 32 + (swz % 64) / 2; }
DEVI int perm32(int rho) { const int n = rho >> 4, i = rho & 15; return 8 * (i >> 2) + 4 * n + (i & 3); }

DEVI void acc_zero(f32x4 (&acc)[2][2][4][2]) {
#pragma unroll
  for (int a = 0; a < 2; ++a)
#pragma unroll
    for (int b = 0; b < 2; ++b)
#pragma unroll
      for (int m = 0; m < 4; ++m)
#pragma unroll
        for (int n = 0; n < 2; ++n) acc[a][b][m][n] = (f32x4){0.f, 0.f, 0.f, 0.f};
}
struct Unit { const char* A; const char* B; const int* rows; int nvalid; int u0, u1, u2, u3; };

template <bool PERM, bool GATHER, class Epi, class Sched>
DEVI void gemm_phase(ldsp_t lds, int lda_b, int ldb_b, int nt, const Sched& S, const Epi& E) {
  const int tid = TIDX, wid = __builtin_amdgcn_readfirstlane(tid >> 6), lane = tid & 63, wr = wid >> 2, wc = wid & 3, fr = lane & 15, fq = lane >> 4;
  unsigned voffA[2], voffB[2]; int RA[2], CA2[2];
#pragma unroll
  for (int i = 0; i < 2; ++i) {
    int R, C; stage_rc(tid * 16 + i * 8192, R, C);
    const int Rb = PERM ? ((R & ~31) + perm32(R & 31)) : R;
    RA[i] = R; CA2[i] = C * 2;
    voffA[i] = (unsigned)(R * lda_b + C * 2); voffB[i] = (unsigned)(Rb * ldb_b + C * 2);
  }
  const size_t kstep = (size_t)(BK * 2);
  const size_t hstepA = (size_t)HALF * lda_b, hstepB = (size_t)HALF * ldb_b;
  const unsigned ldsw = (unsigned)wid * 1024u;
  const int aoff = lds_byte(wr * 64 + fr, fq * 8), boff = lds_byte(wc * 32 + fr, fq * 8);
#define G_SA(b, h) (((b) * 2 + (h)) * HTB)
#define G_SB(b, h) ((4 + (b) * 2 + (h)) * HTB)
#define G_STAGE(bufoff, gbase, voff) do { _Pragma("unroll") for (int _i = 0; _i < 2; ++_i) \
    __builtin_amdgcn_global_load_lds((const unsigned*)((const char*)(gbase) + (voff)[_i]), (LAS unsigned*)(lds + (bufoff) + ldsw + _i * 8192), 16, 0, 0); } while (0)
#define G_STAGE_A(bufoff, abase, go, h, koff) do { if (GATHER) { _Pragma("unroll") for (int _i = 0; _i < 2; ++_i) \
    __builtin_amdgcn_global_load_lds((const unsigned*)((abase) + (go)[h][_i] + (koff)), (LAS unsigned*)(lds + (bufoff) + ldsw + _i * 8192), 16, 0, 0); } \
    else G_STAGE(bufoff, (abase) + (h) * hstepA + (koff), voffA); } while (0)
#define G_LDA(dst, b, h) do { _Pragma("unroll") for (int m = 0; m < 4; ++m) _Pragma("unroll") for (int k = 0; k < 2; ++k) dst[m][k] = *(const LAS bf16x8*)(lds + G_SA(b, h) + aoff + m * 2048 + k * 1024); } while (0)
#define G_LDB(dst, b, h) do { _Pragma("unroll") for (int n = 0; n < 2; ++n) _Pragma("unroll") for (int k = 0; k < 2; ++k) dst[n][k] = *(const LAS bf16x8*)(lds + G_SB(b, h) + boff + n * 2048 + k * 1024); } while (0)
#define G_MMA(ai, bj, At, Bt) do { __builtin_amdgcn_s_setprio(1); _Pragma("unroll") for (int m = 0; m < 4; ++m) _Pragma("unroll") for (int n = 0; n < 2; ++n) _Pragma("unroll") for (int k = 0; k < 2; ++k) \
    acc[ai][bj][m][n] = __builtin_amdgcn_mfma_f32_16x16x32_bf16(Bt[n][k], At[m][k], acc[ai][bj][m][n], 0, 0, 0); __builtin_amdgcn_s_setprio(0); } while (0)
#define G_WAIT_V(n) asm volatile("s_waitcnt vmcnt(" #n ")" ::: "memory")
#define G_WAIT_L(n) asm volatile("s_waitcnt lgkmcnt(" #n ")" ::: "memory")
#define G_BAR __builtin_amdgcn_s_barrier()
#define G_SCHED __builtin_amdgcn_sched_barrier(0)
  Unit cur, nxt; int ui = 0;
  if (!S.next(0, cur)) return;
  f32x4 acc[2][2][4][2];
  E.init(acc, cur, wr, wc, fr, fq);
  bf16x8 At[4][2], B0[2][2], B1[2][2];
  unsigned gcur[2][2];
  auto gather_offs = [&](const Unit& u, unsigned (&go)[2][2]) {
#pragma unroll
    for (int h = 0; h < 2; ++h)
#pragma unroll
      for (int i = 0; i < 2; ++i) {
        const int r = h * HALF + RA[i];
        const int t = (r < u.nvalid) ? (u.rows[r] >> 1) : 0;
        go[h][i] = (unsigned)t * (unsigned)lda_b + (unsigned)CA2[i];
      }
  };
  if (GATHER) gather_offs(cur, gcur);
  const char* cA = cur.A; const char* cB = cur.B;
  G_STAGE(G_SB(0, 0), cB, voffB); G_STAGE_A(G_SA(0, 0), cA, gcur, 0, 0); G_STAGE(G_SB(0, 1), cB + hstepB, voffB); G_STAGE_A(G_SA(0, 1), cA, gcur, 1, 0);
  if (wr == 1) G_BAR;
  G_WAIT_V(4); G_BAR;
  G_STAGE(G_SB(1, 0), cB + kstep, voffB); G_STAGE_A(G_SA(1, 0), cA, gcur, 0, kstep); G_STAGE(G_SB(1, 1), cB + hstepB + kstep, voffB);
  G_WAIT_V(6); G_BAR;
  for (;;) {
    const bool has_next = S.next(ui + 1, nxt);
    const char* nA = has_next ? nxt.A : cA; const char* nB = has_next ? nxt.B : cB;
    for (int t = 0; t < nt; t += 2) {
      const bool last = (t == nt - 2);
      const size_t k1 = (size_t)(t + 1) * kstep;
      const char* a2 = last ? nA : cA; const char* b2 = last ? nB : cB + (size_t)(t + 2) * kstep;
      const size_t ka2 = last ? 0 : (size_t)(t + 2) * kstep;
      const char* b3 = b2 + kstep; const size_t ka3 = ka2 + kstep;
      unsigned gN[2][2];
      if (GATHER && last) {
        if (has_next) gather_offs(nxt, gN);
        else {
#pragma unroll
          for (int h = 0; h < 2; ++h)
#pragma unroll
            for (int i = 0; i < 2; ++i) gN[h][i] = gcur[h][i];
        }
      }
#define G_STAGE_A2(bufoff, h, koff) do { if (GATHER) { if (last) G_STAGE_A(bufoff, cA, gN, h, (koff) - ka2); else G_STAGE_A(bufoff, cA, gcur, h, koff); } \
        else G_STAGE_A(bufoff, a2, gcur, h, koff); } while (0)
      G_LDB(B0, 0, 0); G_SCHED; G_LDA(At, 0, 0); G_STAGE_A(G_SA(1, 1), cA, gcur, 1, k1);
      G_WAIT_L(8); G_BAR; G_WAIT_L(0); G_MMA(0, 0, At, B0); G_BAR; G_SCHED;
      G_LDB(B1, 0, 1); G_STAGE(G_SB(0, 0), b2, voffB);
      G_BAR; G_WAIT_L(0); G_MMA(0, 1, At, B1); G_BAR;
      G_LDA(At, 0, 1); G_STAGE_A2(G_SA(0, 0), 0, ka2);
      G_BAR; G_WAIT_L(0); G_MMA(1, 0, At, B0); G_BAR; G_SCHED;
      G_STAGE(G_SB(0, 1), b2 + hstepB, voffB);
      G_WAIT_V(6); G_BAR; G_MMA(1, 1, At, B1); G_BAR;
      G_LDB(B0, 1, 0); G_SCHED; G_LDA(At, 1, 0); G_STAGE_A2(G_SA(0, 1), 1, ka2);
      G_WAIT_L(8); G_BAR; G_WAIT_L(0); G_MMA(0, 0, At, B0); G_BAR; G_SCHED;
      G_LDB(B1, 1, 1); G_STAGE(G_SB(1, 0), b3, voffB);
      G_BAR; G_WAIT_L(0); G_MMA(0, 1, At, B1); G_BAR;
      G_LDA(At, 1, 1); G_STAGE_A2(G_SA(1, 0), 0, ka3);
      G_BAR; G_WAIT_L(0); G_MMA(1, 0, At, B0); G_BAR; G_SCHED;
      G_STAGE(G_SB(1, 1), b3 + hstepB, voffB);
      G_WAIT_V(6); G_BAR; G_MMA(1, 1, At, B1); G_BAR;
      if (GATHER && last) {
#pragma unroll
        for (int h = 0; h < 2; ++h)
#pragma unroll
          for (int i = 0; i < 2; ++i) gcur[h][i] = gN[h][i];
      }
#undef G_STAGE_A2
    }
    G_SCHED;
    E(acc, cur, wr, wc, fr, fq);
    G_SCHED;
    if (!has_next) break;
    cur = nxt; cA = nA; cB = nB; ++ui;
    E.init(acc, cur, wr, wc, fr, fq);
  }
  G_WAIT_V(0);
  if (wr == 0) G_BAR;
  G_BAR;
#undef G_SA
#undef G_SB
#undef G_STAGE
#undef G_STAGE_A
#undef G_LDA
#undef G_LDB
#undef G_MMA
#undef G_WAIT_V
#undef G_WAIT_L
#undef G_BAR
#undef G_SCHED
}

DEVI unsigned uoff(unsigned x) { return (unsigned)__builtin_amdgcn_readfirstlane((int)x); }
DEVI bool tile_order(int i, int G, int c, int nM, int nN, int& pm, int& pn) {
  const int nwg = nM * nN;
  const long L = (long)i * G + c; if (L >= nwg) return false;
  int wgid = (int)L; { const int q = nwg / 8, r = nwg % 8, xcd = wgid % 8, off = wgid / 8; wgid = (xcd < r ? xcd * (q + 1) : r * (q + 1) + (xcd - r) * q) + off; }
  const int WGM = 8;
  const int nig = WGM * nN, gid = wgid / nig, fm = gid * WGM, gsz = (nM - fm) < WGM ? (nM - fm) : WGM;
  pm = fm + ((wgid % nig) % gsz); pn = (wgid % nig) / gsz;
  pm = __builtin_amdgcn_readfirstlane(pm); pn = __builtin_amdgcn_readfirstlane(pn);
  return true;
}
struct EpiRawBf16 {
  u16* O; int ldc;
  DEVI void init(f32x4 (&acc)[2][2][4][2], const Unit&, int, int, int, int) const { acc_zero(acc); }
  DEVI void operator()(const f32x4 (&acc)[2][2][4][2], const Unit& u, int wr, int wc, int fr, int fq) const {
    const unsigned off0 = ((unsigned)(u.u0 + wr * 64 + fr) * (unsigned)ldc + (unsigned)(u.u1 + wc * 32 + 8 * fq)) * 2u;
#pragma unroll
    for (int ai = 0; ai < 2; ++ai)
#pragma unroll
      for (int m = 0; m < 4; ++m) {
        char* rowp = (char*)O + (off0 + (unsigned)(ai * HALF + m * 16) * (unsigned)ldc * 2u);
#pragma unroll
        for (int bj = 0; bj < 2; ++bj) {
          const f32x4 v0 = acc[ai][bj][m][0], v1 = acc[ai][bj][m][1];
          u32x4 w; w.x = pk2(v0[0], v0[1]); w.y = pk2(v0[2], v0[3]); w.z = pk2(v1[0], v1[1]); w.w = pk2(v1[2], v1[3]);
          *(u32x4*)(rowp + bj * HALF * 2) = w;
        }
      }
  }
};

struct SchedB { const char* ws; int G, c;
  DEVI bool next(int i, Unit& u) const { int pm, pn; if (!tile_order(i, G, c, NTOK / 256, INP / 256, pm, pn)) return false;
    u.A = ws + OFF_H + uoff((unsigned)pm * 256u * 2048u); u.B = ws + OFF_WIN + uoff((unsigned)pn * 256u * 2048u); u.rows = nullptr; u.nvalid = 0; u.u0 = pm * 256; u.u1 = pn * 256; u.u2 = 0; u.u3 = 0; return true; } };
struct EpiB { u16* O; float* ssq;
  DEVI void init(f32x4 (&acc)[2][2][4][2], const Unit&, int, int, int, int) const { acc_zero(acc); }
  DEVI void operator()(const f32x4 (&acc)[2][2][4][2], const Unit& u, int wr, int wc, int fr, int fq) const {
    EpiRawBf16 E{O, PLD}; E(acc, u, wr, wc, fr, fq);
    if (u.u1 < 512) {
      const bool iskv = u.u1 != 0;
#pragma unroll
      for (int ai = 0; ai < 2; ++ai)
#pragma unroll
        for (int m = 0; m < 4; ++m) {
          float ss = 0.f;
#pragma unroll
          for (int bj = 0; bj < 2; ++bj)
#pragma unroll
            for (int n = 0; n < 2; ++n)
#pragma unroll
              for (int j = 0; j < 4; ++j) { const float v = acc[ai][bj][m][n][j]; if (!(iskv && bj == 1)) ss += v * v; }
          ss += __shfl_xor(ss, 16); ss += __shfl_xor(ss, 32);
          if (fq == 0) ssq[(size_t)(u.u0 + ai * HALF + wr * 64 + m * 16 + fr) * 8 + (iskv ? 4 : 0) + wc] = ss;
        }
    }
  }
};
DEVI void phaseB2(KP p, ldsp_t lds) {
  SchedB S{(const char*)p->ws, (int)gridDim.x, BIDX};
  EpiB E{wsp<u16>(p, OFF_PRAW), wsp<float>(p, OFF_SSQ)};
  gemm_phase<true, false>(lds, 2048, 2048, 16, S, E);
}
struct SchedC { const char* ws; int G, c;
  DEVI bool next(int i, Unit& u) const { int pm, pn; if (!tile_order(i, G, c, NTOK / 256, 4, pm, pn)) return false;
    const bool kv = pn >= 2; const int pj = pn & 1;
    u.A = ws + OFF_PRAW + uoff((unsigned)pm * 256u * (unsigned)(PLD * 2) + (kv ? 512u : 0u)); u.B = ws + (kv ? OFF_WKVB : OFF_WQB) + uoff((unsigned)pj * 256u * 512u); u.rows = nullptr; u.nvalid = 0;
    u.u0 = pm * 256; u.u1 = pj * 256; u.u2 = kv; u.u3 = 0; return true; } };
struct EpiC { u16* Oq; u16* Okv; const float* ssq;
  DEVI void init(f32x4 (&acc)[2][2][4][2], const Unit&, int, int, int, int) const { acc_zero(acc); }
  DEVI void operator()(const f32x4 (&acc)[2][2][4][2], const Unit& u, int wr, int wc, int fr, int fq) const {
    const bool kv = u.u2 != 0;
    u16* O = kv ? Okv : Oq;
    const int row0 = u.u0 + wr * 64 + fr, col0 = u.u1 + wc * 32 + 8 * fq;
    f32x4 sq[2][4];
#pragma unroll
    for (int ai = 0; ai < 2; ++ai)
#pragma unroll
      for (int m = 0; m < 4; ++m) sq[ai][m] = *(const f32x4*)(ssq + (size_t)(row0 + ai * HALF + m * 16) * 8 + (kv ? 4 : 0));
#pragma unroll
    for (int ai = 0; ai < 2; ++ai)
#pragma unroll
      for (int m = 0; m < 4; ++m) {
        const size_t r = (size_t)(row0 + ai * HALF + m * 16);
        const float tot = sq[ai][m].x + sq[ai][m].y + sq[ai][m].z + sq[ai][m].w;
        const float sc = kv ? rsqrtf(tot * (1.f / 128.f) + EPS) : rsqrtf(tot * (1.f / 256.f) + EPS) * (0.10206207261596575f * LOG2E);
        u16* rowp = O + r * 512 + col0;
#pragma unroll
        for (int bj = 0; bj < 2; ++bj) {
          const f32x4 v0 = acc[ai][bj][m][0] * sc, v1 = acc[ai][bj][m][1] * sc;
          u32x4 w; w.x = pk2(v0[0], v0[1]); w.y = pk2(v0[2], v0[3]); w.z = pk2(v1[0], v1[1]); w.w = pk2(v1[2], v1[3]);
          *(u32x4*)(rowp + bj * HALF) = w;
        }
      }
  }
};
DEVI void phaseC2(KP p, ldsp_t lds) {
  SchedC S{(const char*)p->ws, (int)gridDim.x, BIDX};
  EpiC E{wsp<u16>(p, OFF_QARAW), wsp<u16>(p, OFF_KVARAW), wsp<float>(p, OFF_SSQ)};
  int nt = 4; asm volatile("" : "+s"(nt));
  gemm_phase<true, false>(lds, PLD * 2, 512, nt, S, E);
}

DEVI void ld16(const u16* src, float (&v)[16]) {
  const u32x4 a = *(const u32x4*)src, b = *(const u32x4*)(src + 8);
  const unsigned w[8] = {a.x, a.y, a.z, a.w, b.x, b.y, b.z, b.w};
#pragma unroll
  for (int i = 0; i < 8; ++i) { v[2 * i] = __uint_as_float(w[i] << 16); v[2 * i + 1] = __uint_as_float(w[i] & 0xffff0000u); }
}
DEVI void st16(u16* dst, const float (&v)[16]) {
  u32x4 a, b;
  a.x = pk2(v[0], v[1]); a.y = pk2(v[2], v[3]); a.z = pk2(v[4], v[5]); a.w = pk2(v[6], v[7]);
  b.x = pk2(v[8], v[9]); b.y = pk2(v[10], v[11]); b.z = pk2(v[12], v[13]); b.w = pk2(v[14], v[15]);
  *(u32x4*)dst = a; *(u32x4*)(dst + 8) = b;
}
DEVI void rope16c(float (&v)[16], const float* cs16, int pos) {
  const f32x2* t = (const f32x2*)(cs16 + pos * 16);
#pragma unroll
  for (int i = 0; i < 8; ++i) { const f32x2 cs = t[i]; const float x1 = v[i], x2 = v[8 + i]; v[i] = x1 * cs.x - x2 * cs.y; v[8 + i] = x2 * cs.x + x1 * cs.y; }
}
DEVI void rope32c(float (&lo)[16], float (&hi)[16], const float* cs32, int pos) {
  const f32x2* t = (const f32x2*)(cs32 + pos * 32);
#pragma unroll
  for (int i = 0; i < 16; ++i) { const f32x2 cs = t[i]; const float x1 = lo[i], x2 = hi[i]; lo[i] = x1 * cs.x - x2 * cs.y; hi[i] = x2 * cs.x + x1 * cs.y; }
}
DEVI float ssq16(const float (&v)[16]) { float s = 0.f;
#pragma unroll
  for (int i = 0; i < 16; ++i) s += v[i] * v[i];
  return s; }
DEVI void scale16(float (&v)[16], float s) {
#pragma unroll
  for (int i = 0; i < 16; ++i) v[i] *= s; }
DEVI void cvt16(const u32x4 a, const u32x4 b, float (&v)[16]) {
  const unsigned w[8] = {a.x, a.y, a.z, a.w, b.x, b.y, b.z, b.w};
#pragma unroll
  for (int i = 0; i < 8; ++i) { v[2 * i] = __uint_as_float(w[i] << 16); v[2 * i + 1] = __uint_as_float(w[i] & 0xffff0000u); }
}
DEVI void phaseP2(KP p, int l, ldsp_t lds) {
  const int tid = TIDX, tk = tid >> 3, pt = tid & 7;
  u16* PR = wsp<u16>(p, OFF_PRAW);
  u16* QA = wsp<u16>(p, OFF_QARAW);
  const float* cs32 = wsp<float>(p, OFF_CS32);
  const float* cs16 = wsp<float>(p, OFF_CS16);
  const float QS = 0.125f * LOG2E;
  for (int item = BIDX; item < NTOK / 64; item += gridDim.x) {
    const int tok0 = item * 64, rr0 = tok0 % TPB;
    const bool lat = rr0 >= NCTX;
    const size_t tok = (size_t)tok0 + tk;
    const int t = rr0 + tk - NCTX, grow = (t >> 6) & 63, gcol = t & 63;
    u16* pr = PR + tok * PLD;
    u16* qar = QA + tok * 512 + 96 * (pt >> 1) + 64 + 16 * (pt & 1);
    const int g4 = pt & 3;
    u32x4 r_qa[2], r_kr[2], r_qb[4], r_kb[4], r_qd[4], r_kd[4];
#define LD8(ptr) (*(const u32x4*)(ptr))
    if (lat) {
#pragma unroll
      for (int i = 0; i < 2; ++i) { r_qa[i] = LD8(qar + 8 * i); r_kr[i] = LD8(pr + 384 + 16 * (pt & 1) + 8 * i); }
#pragma unroll
      for (int i = 0; i < 4; ++i) { r_qb[i] = LD8(pr + 512 + 32 * pt + 8 * i); r_kb[i] = LD8(pr + 768 + 32 * g4 + 8 * i); }
    }
#pragma unroll
    for (int i = 0; i < 4; ++i) { r_qd[i] = LD8(pr + 1792 + 32 * pt + 8 * i); r_kd[i] = LD8(pr + 2048 + 32 * g4 + 8 * i); }
#undef LD8
    if (lat) {
      { float v[16]; cvt16(r_qa[0], r_qa[1], v); rope16c(v, cs16, (pt & 1) ? gcol : grow); st16(qar, v); }
      if (pt < 2) { float v[16]; cvt16(r_kr[0], r_kr[1], v); rope16c(v, cs16, pt == 0 ? grow : gcol); st16(pr + 384 + 16 * pt, v); }
      { float lo[16], hi[16]; cvt16(r_qb[0], r_qb[1], lo); cvt16(r_qb[2], r_qb[3], hi); rope32c(lo, hi, cs32, (pt & 1) ? gcol : grow); st16(pr + 512 + 32 * pt, lo); st16(pr + 512 + 32 * pt + 16, hi); }
      if (pt < 4) { float lo[16], hi[16]; cvt16(r_kb[0], r_kb[1], lo); cvt16(r_kb[2], r_kb[3], hi); rope32c(lo, hi, cs32, (pt & 1) ? gcol : grow); st16(pr + 768 + 32 * pt, lo); st16(pr + 768 + 32 * pt + 16, hi); }
    }
    {
      float lo[16], hi[16]; cvt16(r_qd[0], r_qd[1], lo); cvt16(r_qd[2], r_qd[3], hi);
      float ss = ssq16(lo) + ssq16(hi); ss += __shfl_xor(ss, 1);
      const float rs = rsqrtf(ss * (1.f / 64.f) + EPS);
      const float* g = p->g_q_d + l * 64 + 32 * (pt & 1);
#pragma unroll
      for (int i = 0; i < 16; ++i) { lo[i] *= rs * g[i]; hi[i] *= rs * g[16 + i]; }
      if (lat) rope32c(lo, hi, cs32, (pt & 1) ? gcol : grow);
      scale16(lo, QS); scale16(hi, QS);
      st16(pr + 1792 + 32 * pt, lo); st16(pr + 1792 + 32 * pt + 16, hi);
    }
    {
      float lo[16], hi[16]; cvt16(r_kd[0], r_kd[1], lo); cvt16(r_kd[2], r_kd[3], hi);
      float ss = ssq16(lo) + ssq16(hi); ss += __shfl_xor(ss, 1);
      const float rs = rsqrtf(ss * (1.f / 64.f) + EPS);
      const float* g = p->g_k_d + l * 64 + 32 * (g4 & 1);
#pragma unroll
      for (int i = 0; i < 16; ++i) { lo[i] *= rs * g[i]; hi[i] *= rs * g[16 + i]; }
      if (lat) rope32c(lo, hi, cs32, (g4 & 1) ? gcol : grow);
      if (pt < 4) { st16(pr + 2048 + 32 * g4, lo); st16(pr + 2048 + 32 * g4 + 16, hi); }
    }
  }
}

DEVI void conv_load(const ConvT& c, int lane, f32x4 (&v)[8]) {
  const int kk = lane >> 3, n4 = (lane & 7) * 4;
  const float* sp = (c.src2 && n4 >= 16) ? c.src2 + (n4 - 16) : (c.src ? c.src + n4 : nullptr);
#pragma unroll
  for (int i = 0; i < 8; ++i) v[i] = sp ? *(const f32x4*)(sp + (size_t)(kk + 8 * i) * c.ld) : f32x4{0.f, 0.f, 0.f, 0.f};
}
DEVI void conv_store(const ConvT& c, LAS float* t, int lane, const f32x4 (&v)[8]) {
  const int kk = lane >> 3, n4 = (lane & 7) * 4;
#pragma unroll
  for (int i = 0; i < 8; ++i) {
    const int k = kk + 8 * i;
    const float s = (c.ks ? c.ks[k] : 1.f) * c.mul;
    t[(n4 + 0) * 65 + k] = v[i].x * s; t[(n4 + 1) * 65 + k] = v[i].y * s;
    t[(n4 + 2) * 65 + k] = v[i].z * s; t[(n4 + 3) * 65 + k] = v[i].w * s;
  }
  asm volatile("s_waitcnt lgkmcnt(0)" ::: "memory");
  const int n = lane >> 1, k0 = (lane & 1) * 32;
  const LAS float* r = t + n * 65 + k0;
  u16* d = c.dst + (size_t)n * c.ldd + k0;
#pragma unroll
  for (int q = 0; q < 4; ++q) {
    u32x4 o;
    o.x = pk2(r[8 * q], r[8 * q + 1]); o.y = pk2(r[8 * q + 2], r[8 * q + 3]); o.z = pk2(r[8 * q + 4], r[8 * q + 5]); o.w = pk2(r[8 * q + 6], r[8 * q + 7]);
    *(u32x4*)(d + 8 * q) = o;
  }
  asm volatile("s_waitcnt lgkmcnt(0)" ::: "memory");
}
constexpr int CONV_EARLY = 1152 + 64 + 64;
DEVI void conv_items2(KP p, int l, ldsp_t lds, int first_item, int total_items) {
  const int tid = TIDX, wave = __builtin_amdgcn_readfirstlane(tid >> 6), lane = tid & 63;
  LAS float* t = (LAS float*)(lds + wave * 8448);
  __syncthreads();
  const int stride = gridDim.x * NW;
  int item = first_item + BIDX * NW + wave;
  if (item >= total_items) return;
  ConvT c = conv_decode(p, l, item);
  f32x4 v[8];
  conv_load(c, lane, v);
  for (;;) {
    const int nitem = item + stride;
    const bool more = nitem < total_items;
    ConvT cn = c; f32x4 vn[8];
    if (more) { cn = conv_decode(p, l, nitem); conv_load(cn, lane, vn); }
    conv_store(c, t, lane, v);
    if (!more) break;
    c = cn; item = nitem;
#pragma unroll
    for (int i = 0; i < 8; ++i) v[i] = vn[i];
  }
}
template <int BR>
DEVI void attn_mask(f32x16 (&s)[2], int kt, int qlat, int qrow, int qcol, int hh, LAS float* rpb) {
  if (BR == 1) {
#pragma unroll
    for (int kb = 0; kb < 2; ++kb)
#pragma unroll
      for (int i = 0; i < 16; ++i) {
        const int kpos = kt * 64 + kb * 32 + (i & 3) + 8 * (i >> 2) + 4 * hh;
        const int d = qlat - kpos;
        if (d > 128 || d < -128) s[kb][i] = -1e30f;
      }
  } else {
    const int rs = min(max(qrow - 4, 0), 56);
    const bool row_ok = (kt >= rs) && (kt < rs + 8);
    const int cst = min(max(qcol - 8, 0), 48);
    const int dr = kt - qrow + 7;
#pragma unroll
    for (int kb = 0; kb < 2; ++kb)
#pragma unroll
      for (int i = 0; i < 16; ++i) {
        const int kc = kb * 32 + (i & 3) + 8 * (i >> 2) + 4 * hh;
        const bool ok = row_ok && (kc >= cst) && (kc < cst + 16);
        const int idx = ok ? (dr * 31 + (kc - qcol + 15)) : 0;
        const float bias = rpb[idx];
        s[kb][i] = ok ? (s[kb][i] + bias) : -1e30f;
      }
  }
}

typedef short v4i16_t __attribute__((ext_vector_type(4)));
DEVI bf16x8 vtr2(ldsp_t a) {
  const v4i16_t lo = __builtin_amdgcn_ds_read_tr16_b64_v4i16((LAS v4i16_t*)a);
  const v4i16_t hi = __builtin_amdgcn_ds_read_tr16_b64_v4i16((LAS v4i16_t*)(a + 8 * 144));
  return __builtin_shufflevector(lo, hi, 0, 1, 2, 3, 4, 5, 6, 7);
}
template <int BR>
DEVI void attn_item2(KP p, int l, int b, int hs, int qb, bool isctx, ldsp_t lds) {
  constexpr bool MLA = (BR == 0);
  constexpr bool GQA = (BR == 1 || BR == 3);
  constexpr int QBLK = GQA ? 256 : 512;
  constexpr int NKS = MLA ? 6 : 4;
  constexpr int STG = 9216 + 9216 + 5120;
  const int tid = TIDX, lane = tid & 63, wave = __builtin_amdgcn_readfirstlane(tid >> 6);
  const int r32 = lane & 31, hh = lane >> 5;
  const int hq = GQA ? (hs * 2 + (wave & 1)) : hs;
  const int woff = GQA ? 64 * (wave >> 1) : 64 * wave;
  const int q0 = (isctx ? 0 : NCTX) + qb * QBLK;
  const bool active = !isctx || (woff < NCTX);
  const size_t tokq = (size_t)b * TPB + q0 + (active ? woff : 0) + r32;
  const u16* Qp; const u16* Kp; int ldk; const u16* Vp; int ldv; int obase; int ldq;
  const u16* PR = wsp<u16>(p, OFF_PRAW);
  if (BR == 0) { Qp = wsp<u16>(p, OFF_QARAW) + tokq * 512 + hq * 96; ldq = 512; Kp = wsp<u16>(p, OFF_KVARAW) + (size_t)b * TPB * 512 + hs * 128; ldk = 512; Vp = wsp<u16>(p, OFF_KVARAW) + (size_t)b * TPB * 512 + hs * 128 + 64; ldv = 512; obase = hq * 64; }
  else if (BR == 1) { Qp = PR + tokq * PLD + 512 + hq * 64; ldq = PLD; Kp = PR + (size_t)b * TPB * PLD + 768 + hs * 64; ldk = PLD; Vp = PR + (size_t)b * TPB * PLD + 896 + hs * 64; ldv = PLD; obase = 256 + hq * 64; }
  else if (BR == 2) { Qp = PR + tokq * PLD + 1024 + hq * 64; ldq = PLD; Kp = PR + (size_t)b * TPB * PLD + 1280 + hs * 64; ldk = PLD; Vp = PR + (size_t)b * TPB * PLD + 1536 + hs * 64; ldv = PLD; obase = 512 + hq * 64; }
  else { Qp = PR + tokq * PLD + 1792 + hq * 64; ldq = PLD; Kp = PR + (size_t)b * TPB * PLD + 2048 + hs * 64; ldk = PLD; Vp = PR + (size_t)b * TPB * PLD + 2176 + hs * 64; ldv = PLD; obase = 768 + hq * 64; }
  const u16* KRp = PR + (size_t)b * TPB * PLD + 384;
  int lat_lo = 0, lat_n = 0, wlo = 0, whi = 63;
  if (!isctx) {
    if (BR == 0 || BR == 3) { lat_lo = 0; lat_n = 64; }
    else if (BR == 1) {
      const int ql = qb * QBLK; const int lo = max(0, ql - 128) >> 6, hi = min(SEQ - 1, ql + QBLK - 1 + 128) >> 6; lat_lo = lo; lat_n = hi - lo + 1;
      const int wq = ql + woff; wlo = max(0, wq - 128) >> 6; whi = min(SEQ - 1, wq + 63 + 128) >> 6;
    } else {
      const int r0 = 8 * qb; const int lo = min(max(r0 - 4, 0), 56), hi = min(max(r0 + 7 - 4, 0), 56) + 7; lat_lo = lo; lat_n = hi - lo + 1;
      const int wr_ = r0 + wave; wlo = min(max(wr_ - 4, 0), 56); whi = wlo + 7;
    }
  }
  const int NT = 4 + lat_n;
  const int qlat0 = qb * QBLK + woff + r32;
  bf16x8 qf[2][NKS];
#pragma unroll
  for (int qi = 0; qi < 2; ++qi)
#pragma unroll
    for (int ks = 0; ks < NKS; ++ks) qf[qi][ks] = *(const bf16x8*)(Qp + (size_t)qi * 32 * ldq + ks * 16 + hh * 8);
  const int srow = tid >> 3, sc8 = (tid & 7) * 8;
  const int krow_ = (tid & 255) >> 2, kc8 = (tid & 3) * 8;
  const bool krt = tid < 256;
  u32x4 rk0, rv0, rr0, rk1, rv1, rr1;
  auto keytile = [&](int j) { return (j < 4) ? j : (4 + lat_lo + (j - 4)); };
#define A_GLOAD(j, rk, rv, rr) do { const int key0_ = keytile(j) * 64; \
    rk = *(const u32x4*)(Kp + (size_t)(key0_ + srow) * ldk + sc8); \
    rv = *(const u32x4*)(Vp + (size_t)(key0_ + srow) * ldv + sc8); \
    if (MLA && krt) rr = *(const u32x4*)(KRp + (size_t)(key0_ + krow_) * PLD + kc8); } while (0)
#define A_LWRITE(st, rk, rv, rr) do { ldsp_t base_ = lds + (st) * STG; \
    *(LAS u32x4*)(base_ + srow * 144 + sc8 * 2) = rk; \
    *(LAS u32x4*)(base_ + 9216 + srow * 144 + sc8 * 2) = rv; \
    if (MLA && krt) *(LAS u32x4*)(base_ + 18432 + krow_ * 80 + kc8 * 2) = rr; } while (0)
  LAS float* rpb = (LAS float*)(lds + 2 * STG);
  A_GLOAD(0, rk0, rv0, rr0);
  if (NT > 1) A_GLOAD(1, rk1, rv1, rr1);
  __syncthreads();
  if (BR == 2 && !isctx) {
    const float* src = p->rpb_c + (size_t)(l * 4 + hs) * 465;
    for (int i = tid; i < 465; i += 512) rpb[i] = src[i] * LOG2E;
  }
  A_LWRITE(0, rk0, rv0, rr0);
  __syncthreads();
  f32x16 o[2][2];
#pragma unroll
  for (int qi = 0; qi < 2; ++qi)
#pragma unroll
    for (int i = 0; i < 16; ++i) { o[qi][0][i] = 0.f; o[qi][1][i] = 0.f; }
  float m_run[2], l_run[2];
#pragma unroll
  for (int qi = 0; qi < 2; ++qi) { m_run[qi] = -INFINITY; l_run[qi] = 0.f; }
  if (BR == 1) { const float sk = p->sink_b[l * 4 + hq] * LOG2E; m_run[0] = sk; m_run[1] = sk; l_run[0] = (hh == 0) ? 1.f : 0.f; l_run[1] = l_run[0]; }
  const ldsp_t kfb = lds + r32 * 144 + hh * 16;
  const ldsp_t vfb = lds + 9216 + (4 * hh + ((lane & 15) >> 2)) * 144 + (16 * ((lane >> 4) & 1) + 4 * (lane & 3)) * 2;
  const ldsp_t krb = lds + 18432 + r32 * 80 + hh * 16;
#define A_STEP(j, rkA, rvA, rrA, rkB, rvB, rrB) do { \
    const int st = ((j) & 1) * STG; \
    if ((j) + 2 < NT) A_GLOAD((j) + 2, rkA, rvA, rrA); \
    const int kt_ = lat_lo + (j) - 4; \
    const bool need = active && ((j) < 4 || (kt_ >= wlo && kt_ <= whi)); \
    if (need) { \
      f32x16 s[2][2]; \
      _Pragma("unroll") for (int kb = 0; kb < 2; ++kb) { \
        _Pragma("unroll") for (int ks = 0; ks < 4; ++ks) { const bf16x8 kf = *(const LAS bf16x8*)(kfb + st + kb * 32 * 144 + ks * 32); \
          _Pragma("unroll") for (int qi = 0; qi < 2; ++qi) { if (ks == 0) { _Pragma("unroll") for (int i = 0; i < 16; ++i) s[qi][kb][i] = 0.f; } s[qi][kb] = MFMA(kf, qf[qi][ks], s[qi][kb]); } } \
        if (MLA) { _Pragma("unroll") for (int ks = 0; ks < 2; ++ks) { const bf16x8 kf = *(const LAS bf16x8*)(krb + st + kb * 32 * 80 + ks * 32); \
          _Pragma("unroll") for (int qi = 0; qi < 2; ++qi) s[qi][kb] = MFMA(kf, qf[qi][NKS - 2 + ks], s[qi][kb]); } } \
      } \
      _Pragma("unroll") for (int qi = 0; qi < 2; ++qi) { \
        if ((BR == 1 || BR == 2) && (j) >= 4) { const int ql_ = qlat0 + 32 * qi; attn_mask<BR>(s[qi], kt_, ql_, ql_ >> 6, ql_ & 63, hh, rpb); } \
        float mx = s[qi][0][0]; \
        _Pragma("unroll") for (int i = 1; i < 16; ++i) mx = fmaxf(mx, s[qi][0][i]); \
        _Pragma("unroll") for (int i = 0; i < 16; ++i) mx = fmaxf(mx, s[qi][1][i]); \
        mx = fmaxf(mx, __shfl_xor(mx, 32)); \
        const float m_new = fmaxf(m_run[qi], mx); \
        const float alpha = __builtin_amdgcn_exp2f(m_run[qi] - m_new); \
        m_run[qi] = m_new; \
        float ls0 = 0.f, ls1 = 0.f; \
        _Pragma("unroll") for (int i = 0; i < 16; ++i) { \
          const float e0 = __builtin_amdgcn_exp2f(s[qi][0][i] - m_new), e1 = __builtin_amdgcn_exp2f(s[qi][1][i] - m_new); \
          s[qi][0][i] = e0; s[qi][1][i] = e1; ls0 += e0; ls1 += e1; } \
        l_run[qi] = l_run[qi] * alpha + (ls0 + ls1); \
        if (__any(alpha != 1.f)) { _Pragma("unroll") for (int i = 0; i < 16; ++i) { o[qi][0][i] *= alpha; o[qi][1][i] *= alpha; } } \
      } \
      _Pragma("unroll") for (int s4 = 0; s4 < 4; ++s4) { \
        const int kb = s4 >> 1, rb = (s4 & 1) * 8; \
        bf16x8 pf[2]; \
        _Pragma("unroll") for (int qi = 0; qi < 2; ++qi) { u32x4 pw; \
          pw.x = pk2(s[qi][kb][rb + 0], s[qi][kb][rb + 1]); pw.y = pk2(s[qi][kb][rb + 2], s[qi][kb][rb + 3]); \
          pw.z = pk2(s[qi][kb][rb + 4], s[qi][kb][rb + 5]); pw.w = pk2(s[qi][kb][rb + 6], s[qi][kb][rb + 7]); \
          pf[qi] = __builtin_bit_cast(bf16x8, pw); } \
        _Pragma("unroll") for (int db = 0; db < 2; ++db) { const bf16x8 vf = vtr2(vfb + st + s4 * 16 * 144 + db * 64); \
          o[0][db] = MFMA(vf, pf[0], o[0][db]); o[1][db] = MFMA(vf, pf[1], o[1][db]); } \
      } \
    } \
    if ((j) + 1 < NT) A_LWRITE(((j) + 1) & 1, rkB, rvB, rrB); \
    __syncthreads(); \
  } while (0)
  for (int j = 0; j < NT; j += 2) {
    A_STEP(j, rk0, rv0, rr0, rk1, rv1, rr1);
    if (j + 1 < NT) A_STEP(j + 1, rk1, rv1, rr1, rk0, rv0, rr0);
  }
#undef A_STEP
#undef A_GLOAD
#undef A_LWRITE
  if (active) {
#pragma unroll
    for (int qi = 0; qi < 2; ++qi) {
      const float lt = l_run[qi] + __shfl_xor(l_run[qi], 32);
      const float inv = 1.f / lt;
      u16* Op = wsp<u16>(p, OFF_O) + (tokq + 32 * qi) * 1024 + obase;
#pragma unroll
      for (int db = 0; db < 2; ++db)
#pragma unroll
        for (int g = 0; g < 4; ++g) {
          u32x2 w;
          w.x = pk2(o[qi][db][4 * g] * inv, o[qi][db][4 * g + 1] * inv);
          w.y = pk2(o[qi][db][4 * g + 2] * inv, o[qi][db][4 * g + 3] * inv);
          *(u32x2*)(Op + db * 32 + 8 * g + 4 * hh) = w;
        }
    }
  }
}
DEVI void phaseD2(KP p, int l, ldsp_t lds) {
  const int G8 = gridDim.x >> 3, xcd = BIDX & 7, lb = BIDX >> 3;
  if (lb >= G8) return;
  const int NLOC = 128 + (l == 0 ? 12 : 0);
  const int nmine = (NLOC - lb + G8 - 1) / G8;
  const int cslot = min((int)(BIDX & 3), nmine - 1);
  int it = 0;
  for (int n = lb; n < NLOC; n += G8, ++it) {
    if (it == cslot) conv_items2(p, l, lds, CONV_EARLY, CONV_ITEMS);
    int br, s, qb; bool isctx = false;
    if (n < 32) { br = 0; s = xcd + 8 * (n >> 3); qb = n & 7; }
    else if (n < 64) { const int m = n - 32; br = 3; s = xcd + 8 * (m >> 4); qb = m & 15; }
    else if (n < 96) { const int m = n - 64; br = 2; s = xcd + 8 * (m >> 3); qb = m & 7; }
    else if (n < 128) { const int m = n - 96; br = 1; s = xcd + 8 * (m >> 4); qb = m & 15; }
    else {
      const int m = n - 128; isctx = true; qb = 0;
      if (m < 4) { br = 0; s = xcd + 8 * m; }
      else if (m < 6) { br = 3; s = xcd + 8 * (m - 4); }
      else if (m < 10) { br = 2; s = xcd + 8 * (m - 6); }
      else { br = 1; s = xcd + 8 * (m - 10); }
    }
    if (br == 0) attn_item2<0>(p, l, s >> 2, s & 3, qb, isctx, lds);
    else if (br == 1) attn_item2<1>(p, l, s >> 1, s & 1, qb, isctx, lds);
    else if (br == 2) attn_item2<2>(p, l, s >> 2, s & 3, qb, isctx, lds);
    else attn_item2<3>(p, l, s >> 1, s & 1, qb, isctx, lds);
  }
}

DEVI int pm_map(int pme, bool skipctx) { return skipctx ? (pme >> 4) * 17 + 1 + (pme & 15) : pme; }
struct SchedE1 { const char* ws; bool skipctx; int G, c;
  DEVI bool next(int i, Unit& u) const { int pm, pn; if (!tile_order(i, G, c, skipctx ? 128 : 136, 16, pm, pn)) return false;
    pm = pm_map(pm, skipctx); const int n = pn >> 2, cq = pn & 3;
    u.A = ws + OFF_O + uoff((unsigned)pm * 256u * 2048u + (unsigned)n * 512u); u.B = ws + OFF_WBR + uoff(((unsigned)n * 1024u + (unsigned)cq * 256u) * 512u); u.rows = nullptr; u.nvalid = 0;
    u.u0 = pm * 256; u.u1 = pn * 256; u.u2 = 0; u.u3 = 0; return true; } };
DEVI void phaseE1(KP p, int l, ldsp_t lds) {
  if (BIDX == 0 && TIDX < 32) wsp<int>(p, OFF_CNT)[TIDX * CNT_STRIDE] = 0;
  SchedE1 S{(const char*)p->ws, l == 1, (int)gridDim.x, BIDX};
  EpiRawBf16 E{wsp<u16>(p, OFF_Z), 4096};
  gemm_phase<true, false>(lds, 2048, 512, 4, S, E);
}
struct SchedE2 { const char* ws; bool skipctx; int G, c;
  DEVI bool next(int i, Unit& u) const { int pm, pn; if (!tile_order(i >> 1, G, c, skipctx ? 128 : 136, 8, pm, pn)) return false;
    pm = pm_map(pm, skipctx); const int pr = i & 1;
    u.A = ws + OFF_H + uoff((unsigned)pm * 256u * 2048u); u.B = ws + OFF_WGATE + uoff((unsigned)(pr * 8 + pn) * 256u * 2048u); u.rows = nullptr; u.nvalid = 0;
    u.u0 = pm * 256; u.u1 = pn * 128; u.u2 = pr; u.u3 = 0; return true; } };
struct EpiE2 { const u16* Z; u16* Y; const float* bias;
  DEVI void init(f32x4 (&acc)[2][2][4][2], const Unit& u, int wr, int wc, int fr, int fq) const {
    const int col0 = u.u1 + wc * 32 + 8 * fq;
#pragma unroll
    for (int bj = 0; bj < 2; ++bj)
#pragma unroll
      for (int nn = 0; nn < 2; ++nn) {
        const f32x4 b = *(const f32x4*)(bias + (2 * u.u2 + bj) * 1024 + col0 + 4 * nn);
#pragma unroll
        for (int a = 0; a < 2; ++a)
#pragma unroll
          for (int m = 0; m < 4; ++m) acc[a][bj][m][nn] = b;
      }
  }
  DEVI void operator()(const f32x4 (&acc)[2][2][4][2], const Unit& u, int wr, int wc, int fr, int fq) const {
    const int row0 = u.u0 + wr * 64 + fr, col0 = u.u1 + wc * 32 + 8 * fq, pr = u.u2;
    u32x4 zq[3][2], yq[3];
    auto ldrow = [&](int g, u32x4 (&z)[2], u32x4& y) {
      const size_t r = (size_t)(row0 + (g >> 2) * HALF + (g & 3) * 16);
#pragma unroll
      for (int bj = 0; bj < 2; ++bj) z[bj] = *(const u32x4*)(Z + r * 4096 + (2 * pr + bj) * 1024 + col0);
      y = pr ? *(const u32x4*)(Y + r * 1024 + col0) : u32x4{0u, 0u, 0u, 0u};
    };
    ldrow(0, zq[0], yq[0]);
    ldrow(1, zq[1], yq[1]);
#pragma unroll
    for (int g = 0; g < 8; ++g) {
      const int ai = g >> 2, m = g & 3, c = g % 3;
      if (g + 2 < 8) ldrow(g + 2, zq[(g + 2) % 3], yq[(g + 2) % 3]);
      const size_t r = (size_t)(row0 + ai * HALF + m * 16);
      float t[8];
      {
        const unsigned w[4] = {yq[c].x, yq[c].y, yq[c].z, yq[c].w};
#pragma unroll
        for (int i = 0; i < 4; ++i) { t[2 * i] = __uint_as_float(w[i] << 16); t[2 * i + 1] = __uint_as_float(w[i] & 0xffff0000u); }
      }
#pragma unroll
      for (int bj = 0; bj < 2; ++bj) {
        const unsigned w[4] = {zq[c][bj].x, zq[c][bj].y, zq[c][bj].z, zq[c][bj].w};
#pragma unroll
        for (int nn = 0; nn < 2; ++nn)
#pragma unroll
          for (int j = 0; j < 4; ++j) {
            const int e = 4 * nn + j;
            const float zz = (e & 1) ? __uint_as_float(w[e >> 1] & 0xffff0000u) : __uint_as_float(w[e >> 1] << 16);
            const float gte = __builtin_amdgcn_rcpf(1.f + __expf(-acc[ai][bj][m][nn][j]));
            t[e] += gte * zz;
          }
      }
      u32x4 o; o.x = pk2(t[0], t[1]); o.y = pk2(t[2], t[3]); o.z = pk2(t[4], t[5]); o.w = pk2(t[6], t[7]);
      *(u32x4*)(Y + r * 1024 + col0) = o;
    }
  }
};
DEVI void phaseE2(KP p, int l, ldsp_t lds) {
  SchedE2 S{(const char*)p->ws, l == 1, (int)gridDim.x, BIDX};
  EpiE2 E{wsp<u16>(p, OFF_Z), wsp<u16>(p, OFF_YPRE), p->b_gate + (size_t)l * 4 * 1024};
  gemm_phase<true, false>(lds, 2048, 2048, 16, S, E);
}
struct SchedF { const char* ws; bool skipctx; int G, c;
  DEVI bool next(int i, Unit& u) const { int pm, pn; if (!tile_order(i, G, c, skipctx ? 128 : 136, 4, pm, pn)) return false;
    pm = pm_map(pm, skipctx);
    u.A = ws + OFF_YPRE + uoff((unsigned)pm * 256u * 2048u); u.B = ws + OFF_WOUT + uoff((unsigned)pn * 256u * 2048u); u.rows = nullptr; u.nvalid = 0;
    u.u0 = pm; u.u1 = pn * 256; u.u2 = 0; u.u3 = 0; return true; } };
struct EpiF { KP p; int l;
  DEVI void init(f32x4 (&acc)[2][2][4][2], const Unit&, int, int, int, int) const { acc_zero(acc); }
  DEVI void operator()(const f32x4 (&acc)[2][2][4][2], const Unit& u, int wr, int wc, int fr, int fq) const {
    const int pm = u.u0, b = pm / 17, rr0 = (pm % 17) * 256;
    const int mrow = (rr0 < NCTX) ? 8 : b;
    const int col0 = u.u1 + wc * 32 + 4 * fq;
    const float* gt = wsp<float>(p, OFF_MOD) + ((size_t)l * 9 + mrow) * 6144 + 2048 + col0;
    const float* xin = xrow_in(p, l, b, rr0) + col0;
    float* xout = xrow_res(p, b, rr0) + col0;
    f32x4 gv[2][2];
#pragma unroll
    for (int bj = 0; bj < 2; ++bj)
#pragma unroll
      for (int n = 0; n < 2; ++n) gv[bj][n] = *(const f32x4*)(gt + bj * HALF + n * 16);
#pragma unroll
    for (int ai = 0; ai < 2; ++ai)
#pragma unroll
      for (int mp = 0; mp < 2; ++mp) {
        f32x4 xo[2][2][2];
#pragma unroll
        for (int mm = 0; mm < 2; ++mm) {
          const size_t ro = (size_t)(wr * 64 + fr + ai * HALF + (2 * mp + mm) * 16) * 1024;
#pragma unroll
          for (int bj = 0; bj < 2; ++bj)
#pragma unroll
            for (int n = 0; n < 2; ++n) xo[mm][bj][n] = *(const f32x4*)(xin + ro + bj * HALF + n * 16);
        }
#pragma unroll
        for (int mm = 0; mm < 2; ++mm) {
          const int m = 2 * mp + mm;
          const size_t ro = (size_t)(wr * 64 + fr + ai * HALF + m * 16) * 1024;
#pragma unroll
          for (int bj = 0; bj < 2; ++bj)
#pragma unroll
            for (int n = 0; n < 2; ++n) *(f32x4*)(xout + ro + bj * HALF + n * 16) = xo[mm][bj][n] + gv[bj][n] * acc[ai][bj][m][n];
        }
      }
  }
};
DEVI void phaseF2(KP p, int l, ldsp_t lds) {
  SchedF S{(const char*)p->ws, l == 1, (int)gridDim.x, BIDX};
  EpiF E{p, l};
  gemm_phase<false, false>(lds, 2048, 2048, 16, S, E);
}


DEVI void phase0_2(KP p, ldsp_t lds) {
  const int tid = TIDX, half = tid >> 8, htid = tid & 255;
  for (int it = BIDX * 2; it < 458; it += gridDim.x * 2) {
    const int item = it + half;
    LAS float* sc = (LAS float*)(lds + half * 16384);
    const bool ismod = item < 384;
    const int l = item / 192, rem = item % 192, cgp = rem >> 3, kc = rem & 7;
    __syncthreads();
    if (ismod) {
      for (int i = htid; i < 9 * 128; i += 256) {
        int b = i >> 7, k = i & 127;
        float v = (b < 8) ? p->c[b * 1024 + kc * 128 + k] : p->c_ctx[kc * 128 + k];
        sc[i] = v / (1.f + expf(-v));
      }
    }
    __syncthreads();
    if (ismod) {
      float acc[9];
#pragma unroll
      for (int b = 0; b < 9; ++b) acc[b] = 0.f;
      const float* w = p->w_mod + ((size_t)l * 1024 + kc * 128) * 6144 + cgp * 256 + htid;
#pragma unroll 32
      for (int k = 0; k < 128; ++k) {
        float wv = w[(size_t)k * 6144];
#pragma unroll
        for (int b = 0; b < 9; ++b) acc[b] += sc[b * 128 + k] * wv;
      }
      float* dst = wsp<float>(p, OFF_MODP) + (size_t)((kc * 2 + l) * 9) * 6144 + cgp * 256 + htid;
#pragma unroll
      for (int b = 0; b < 9; ++b) dst[(size_t)b * 6144] = acc[b];
    } else if (item == 384) {
      float* cs32 = wsp<float>(p, OFF_CS32);
      float* cs16 = wsp<float>(p, OFF_CS16);
      for (int t = htid; t < 1024; t += 256) {
        int pos = t >> 4, i = t & 15;
        float ang = (float)pos * powf(10000.f, -(float)(2 * i) / 32.f);
        cs32[t * 2] = cosf(ang); cs32[t * 2 + 1] = sinf(ang);
      }
      for (int t = htid; t < 512; t += 256) {
        int pos = t >> 3, i = t & 7;
        float ang = (float)pos * powf(10000.f, -(float)(2 * i) / 16.f);
        cs16[t * 2] = cosf(ang); cs16[t * 2 + 1] = sinf(ang);
      }
    } else if (item < 457) {
      const int q = item - 385, ll = q / 36, o = q % 36;
      float* dst = wsp<float>(p, OFF_WRT) + ((size_t)ll * 36 + o) * 1024;
      for (int k = htid; k < 1024; k += 256)
        dst[k] = (o < 4) ? p->w_group[((size_t)ll * 1024 + k) * 4 + o] : p->w_router[((size_t)ll * 1024 + k) * 32 + (o - 4)];
    }
  }
}
DEVI void phase1_2(KP p) {
  const float* mp = wsp<float>(p, OFF_MODP);
  float* mo = wsp<float>(p, OFF_MOD);
  for (int i = BIDX * 512 + TIDX; i < 2 * 9 * 6144; i += gridDim.x * 512) {
    int l = i / (9 * 6144), o = i % 6144;
    float s = p->b_mod[l * 6144 + o];
#pragma unroll
    for (int kc = 0; kc < 8; ++kc) s += mp[(size_t)kc * 2 * 9 * 6144 + i];
    mo[i] = s;
  }
}
DEVI void phaseA2(KP p) {
  const int gw = BIDX * NW + (TIDX >> 6), nw = gridDim.x * NW;
  u16* H = wsp<u16>(p, OFF_H);
  for (int tok0 = gw; tok0 < NTOK; tok0 += 2 * nw) {
    float xv[2][16];
#pragma unroll
    for (int r = 0; r < 2; ++r) { const int tok = tok0 + r * nw; if (tok < NTOK) load_row16(xrow_in(p, 0, tok / TPB, tok % TPB), xv[r]); }
#pragma unroll
    for (int r = 0; r < 2; ++r) {
      const int tok = tok0 + r * nw;
      if (tok < NTOK) { float hv[16]; modulate_row_store(p, 0, 0, xv[r], (tok % TPB) < NCTX ? 8 : tok / TPB, H + (size_t)tok * 1024, hv); }
    }
  }
}
DEVI void phaseG2(KP p, int l, ldsp_t lds) {
  constexpr int HS = 1026;
  const int tid = TIDX, lane = tid & 63, wave = __builtin_amdgcn_readfirstlane(tid >> 6);
  const int r32 = lane & 31, kh = lane >> 5, qd = lane >> 4;
  u16* H = wsp<u16>(p, OFF_H);
  const float* WRT = wsp<float>(p, OFF_WRT) + (size_t)l * 36 * 1024;
  int* cnt = wsp<int>(p, OFF_CNT);
  int* list = wsp<int>(p, OFF_LIST);
  float* wlist = wsp<float>(p, OFF_WLIST);
  LAS float* h2t = (LAS float*)lds;
  LAS float* part = (LAS float*)lds;
  LAS int* gsel = (LAS int*)(lds + 32 * HS * 4);
  LAS float* gwt = (LAS float*)(lds + 32 * HS * 4 + 128);
  float wreg[64];
  {
    const float* wr = p->w_router + (size_t)l * 1024 * 32 + r32;
#pragma unroll
    for (int t = 0; t < 32; ++t) {
      const int k = 128 * wave + 4 * t + 2 * kh;
      wreg[2 * t] = wr[(size_t)k * 32]; wreg[2 * t + 1] = wr[(size_t)(k + 1) * 32];
    }
  }
  for (int tile = BIDX; tile < NTOK / 32; tile += gridDim.x) {
    const int tok0 = tile * 32, b = tok0 / TPB, rr0 = tok0 % TPB;
    if (l == 1 && rr0 < NCTX) continue;
    {
      float hv[4][16], xv4[4][16];
#pragma unroll
      for (int r = 0; r < 4; ++r) load_row16(xrow_res(p, b, rr0 + wave * 4 + r), xv4[r]);
#pragma unroll
      for (int r = 0; r < 4; ++r) {
        modulate_row_store(p, l, 1, xv4[r], (rr0 < NCTX) ? 8 : b, H + (size_t)(tok0 + wave * 4 + r) * 1024, hv[r]);
        LAS float* dst = h2t + (wave * 4 + r) * HS + lane * 4;
#pragma unroll
        for (int i = 0; i < 4; ++i) {
          *(LAS f32x2*)(dst + i * 256) = f32x2{hv[r][i * 4], hv[r][i * 4 + 1]};
          *(LAS f32x2*)(dst + i * 256 + 2) = f32x2{hv[r][i * 4 + 2], hv[r][i * 4 + 3]};
        }
      }
      float gl[4];
#pragma unroll
      for (int o = 0; o < 4; ++o) gl[o] = router_dot(hv, WRT + (size_t)o * 1024) + p->b_group[l * 4 + o];
      int gs = 0; float best = gl[0];
#pragma unroll
      for (int j = 1; j < 4; ++j) if (gl[j] > best) { best = gl[j]; gs = j; }
      float gsum = 0.f;
#pragma unroll
      for (int j = 0; j < 4; ++j) gsum += expf(gl[j] - best);
      if ((lane & 15) == 0) { gsel[wave * 4 + qd] = gs; gwt[wave * 4 + qd] = 1.f / gsum; }
    }
    __syncthreads();
    f32x16 acc;
#pragma unroll
    for (int i = 0; i < 16; ++i) acc[i] = 0.f;
    {
      const LAS float* ap = h2t + r32 * HS + 128 * wave + 2 * kh;
#pragma unroll
      for (int t = 0; t < 32; ++t) {
        const f32x2 a = *(const LAS f32x2*)(ap + 4 * t);
        acc = __builtin_amdgcn_mfma_f32_32x32x2f32(a.x, wreg[2 * t], acc, 0, 0, 0);
        acc = __builtin_amdgcn_mfma_f32_32x32x2f32(a.y, wreg[2 * t + 1], acc, 0, 0, 0);
      }
    }
    __syncthreads();
#pragma unroll
    for (int i = 0; i < 16; ++i) part[(wave * 32 + (i & 3) + 8 * (i >> 2) + 4 * kh) * 33 + r32] = acc[i];
    __syncthreads();
    if (tid < 32) {
      const int gs = gsel[tid];
      const float gw_ = gwt[tid];
      float e8[8];
#pragma unroll
      for (int j = 0; j < 8; ++j) {
        float v = p->b_router[l * 32 + gs * 8 + j];
#pragma unroll
        for (int w = 0; w < 8; ++w) v += part[(w * 32 + tid) * 33 + gs * 8 + j];
        e8[j] = v;
      }
      int i0 = 0; float v0 = e8[0];
#pragma unroll
      for (int j = 1; j < 8; ++j) if (e8[j] > v0) { v0 = e8[j]; i0 = j; }
      int i1 = -1; float v1 = -INFINITY;
#pragma unroll
      for (int j = 0; j < 8; ++j) if (j != i0 && e8[j] > v1) { v1 = e8[j]; i1 = j; }
      const float ex = expf(v1 - v0);
      const float w0 = gw_ / (1.f + ex), w1 = gw_ * ex / (1.f + ex);
      const int tok = tok0 + tid;
      const int ea = gs * 8 + i0, eb = gs * 8 + i1;
      const int sa = atomicAdd(&cnt[ea * CNT_STRIDE], 1);
      const int sb = atomicAdd(&cnt[eb * CNT_STRIDE], 1);
      list[(size_t)ea * NTOK + sa] = tok * 2; wlist[(size_t)ea * NTOK + sa] = w0;
      list[(size_t)eb * NTOK + sb] = tok * 2 + 1; wlist[(size_t)eb * NTOK + sb] = w1;
    }
    __syncthreads();
  }
}
struct ExpInfo2 { int tiles[4], base[4], cnt[4]; };
DEVI ExpInfo2 exp_info2(KP p, int xcd) {
  const int* cnt = wsp<int>(p, OFF_CNT);
  ExpInfo2 ei;
  int before = 0;
#pragma unroll
  for (int e = 0; e < 32; ++e) {
    const int c = __builtin_amdgcn_readfirstlane(cnt[e * CNT_STRIDE]), t = (c + 255) >> 8;
    if ((e & 7) == xcd) { ei.tiles[e >> 3] = t; ei.base[e >> 3] = before; ei.cnt[e >> 3] = c; }
    before += t;
  }
  return ei;
}
template <int NN>
struct SchedX { ExpInfo2 ei; int xcd, lb, G8; const char* A; const char* W; const int* list; size_t wstride; int lda_b;
  DEVI bool next(int i, Unit& u) const {
    const int tot = (ei.tiles[0] + ei.tiles[1] + ei.tiles[2] + ei.tiles[3]) * NN;
    const int n = i * G8 + lb; if (n >= tot) return false;
    int k = 0, m = n / NN; const int pn = n % NN;
    int tb = ei.base[0], ce = ei.cnt[0];
#pragma unroll
    for (int kk = 0; kk < 3; ++kk) { if (k == kk && m >= ei.tiles[kk]) { m -= ei.tiles[kk]; k = kk + 1; tb = ei.base[kk + 1]; ce = ei.cnt[kk + 1]; } }
    const int e = xcd + 8 * k;
    u.rows = list + (size_t)e * NTOK + m * 256; u.nvalid = ce - m * 256;
    u.A = A + (NN == 2 ? 0u : uoff((unsigned)(tb + m) * 256u * (unsigned)lda_b));
    u.B = W + uoff((unsigned)e * (unsigned)wstride + (unsigned)pn * 256u * (NN == 2 ? 2048u : 512u));
    u.u0 = (tb + m) * 256; u.u1 = pn; u.u2 = e; u.u3 = m; return true; } };
struct EpiI1 { u16* U;
  DEVI void init(f32x4 (&acc)[2][2][4][2], const Unit&, int, int, int, int) const { acc_zero(acc); }
  DEVI void operator()(const f32x4 (&acc)[2][2][4][2], const Unit& u, int wr, int wc, int fr, int fq) const {
#pragma unroll
    for (int ai = 0; ai < 2; ++ai)
#pragma unroll
      for (int m = 0; m < 4; ++m) {
        u16* rowp = U + (size_t)(u.u0 + ai * HALF + wr * 64 + m * 16 + fr) * 256;
#pragma unroll
        for (int bj = 0; bj < 2; ++bj) {
          const int ff = 16 * (8 * u.u1 + 4 * bj + wc) + 4 * fq;
          const f32x4 g = acc[ai][bj][m][0], up = acc[ai][bj][m][1];
          float t[4];
#pragma unroll
          for (int j = 0; j < 4; ++j) t[j] = g[j] / (1.f + __expf(-g[j])) * up[j];
          u32x2 o; o.x = pk2(t[0], t[1]); o.y = pk2(t[2], t[3]);
          *(u32x2*)(rowp + ff) = o;
        }
      }
  }
};
DEVI void phaseI1_2(KP p, ldsp_t lds) {
  const int xcd = BIDX & 7, lb = BIDX >> 3, G8 = gridDim.x >> 3;
  if (lb >= G8) return;
  SchedX<2> S{exp_info2(p, xcd), xcd, lb, G8, (const char*)wsp<u16>(p, OFF_H), (const char*)wsp<u16>(p, OFF_W13), wsp<int>(p, OFF_LIST), (size_t)512 * 2048, 2048};
  EpiI1 E{wsp<u16>(p, OFF_U)};
  int nt = 16; asm volatile("" : "+s"(nt));
  gemm_phase<false, true>(lds, 2048, 2048, nt, S, E);
}
struct EpiI2 { u16* YS; const float* wlist; const int* list;
  DEVI void init(f32x4 (&acc)[2][2][4][2], const Unit&, int, int, int, int) const { acc_zero(acc); }
  DEVI void operator()(const f32x4 (&acc)[2][2][4][2], const Unit& u, int wr, int wc, int fr, int fq) const {
    const unsigned colb = (unsigned)(u.u1 * 256 + wc * 32 + 8 * fq) * 2u;
    const float* we = wlist + (u.rows - list);
    unsigned dest[2][4]; float w[2][4];
#pragma unroll
    for (int ai = 0; ai < 2; ++ai)
#pragma unroll
      for (int m = 0; m < 4; ++m) {
        const int r = ai * HALF + wr * 64 + m * 16 + fr;
        dest[ai][m] = (r < u.nvalid) ? (unsigned)u.rows[r] : (unsigned)(2 * NTOK);
        w[ai][m] = we[r];
      }
#pragma unroll
    for (int ai = 0; ai < 2; ++ai)
#pragma unroll
      for (int m = 0; m < 4; ++m) {
        char* rowp = (char*)YS + (dest[ai][m] * 2048u + colb);
#pragma unroll
        for (int bj = 0; bj < 2; ++bj) {
          const f32x4 v0 = acc[ai][bj][m][0] * w[ai][m], v1 = acc[ai][bj][m][1] * w[ai][m];
          u32x4 o; o.x = pk2(v0[0], v0[1]); o.y = pk2(v0[2], v0[3]); o.z = pk2(v1[0], v1[1]); o.w = pk2(v1[2], v1[3]);
          *(u32x4*)(rowp + bj * 256) = o;
        }
      }
  }
};
DEVI void phaseI2_2(KP p, ldsp_t lds) {
  const int xcd = BIDX & 7, lb = BIDX >> 3, G8 = gridDim.x >> 3;
  if (lb >= G8) return;
  SchedX<4> S{exp_info2(p, xcd), xcd, lb, G8, (const char*)wsp<u16>(p, OFF_U), (const char*)wsp<u16>(p, OFF_W2), wsp<int>(p, OFF_LIST), (size_t)1024 * 512, 512};
  EpiI2 E{wsp<u16>(p, OFF_YS), wsp<float>(p, OFF_WLIST), wsp<int>(p, OFF_LIST)};
  int nt = 4; asm volatile("" : "+s"(nt));
  gemm_phase<true, false>(lds, 512, 512, nt, S, E);
}
DEVI void phaseJ2(KP p, int l, ldsp_t lds) {
  const int lane = TIDX & 63;
  const int gw = BIDX * NW + (TIDX >> 6), nw = gridDim.x * NW;
  const u16* YS = wsp<u16>(p, OFF_YS);
  u16* H = wsp<u16>(p, OFF_H);
  for (int tok0 = gw; tok0 < NTOK; tok0 += 2 * nw) {
    float xv[2][16]; u32x2 y0[2][4], y1[2][4]; bool ok[2]; int tk[2];
#pragma unroll
    for (int r = 0; r < 2; ++r) {
      const int tok = tok0 + r * nw;
      tk[r] = tok;
      ok[r] = (tok < NTOK) && !(l == 1 && (tok % TPB) < NCTX);
      if (ok[r]) {
        const int b = tok / TPB, rr = tok % TPB;
        load_row16(xrow_res(p, b, rr), xv[r]);
#pragma unroll
        for (int i = 0; i < 4; ++i) {
          const int c = i * 256 + lane * 4;
          y0[r][i] = *(const u32x2*)(YS + (size_t)(tok * 2) * 1024 + c);
          y1[r][i] = *(const u32x2*)(YS + (size_t)(tok * 2 + 1) * 1024 + c);
        }
      }
    }
#pragma unroll
    for (int r = 0; r < 2; ++r) {
      if (!ok[r]) continue;
      const int tok = tk[r];
      const int b = tok / TPB, rr = tok % TPB;
      const int mrow = (rr < NCTX) ? 8 : b;
      float* xr = xrow_res(p, b, rr);
      const float* gt = wsp<float>(p, OFF_MOD) + ((size_t)l * 9 + mrow) * 6144 + 5120;
#pragma unroll
      for (int i = 0; i < 4; ++i) {
        const int c = i * 256 + lane * 4;
        const f32x4 g = *(const f32x4*)(gt + c);
        xv[r][i * 4 + 0] += g.x * (bf2f((u16)(y0[r][i].x & 0xffff)) + bf2f((u16)(y1[r][i].x & 0xffff)));
        xv[r][i * 4 + 1] += g.y * (bf2f((u16)(y0[r][i].x >> 16)) + bf2f((u16)(y1[r][i].x >> 16)));
        xv[r][i * 4 + 2] += g.z * (bf2f((u16)(y0[r][i].y & 0xffff)) + bf2f((u16)(y1[r][i].y & 0xffff)));
        xv[r][i * 4 + 3] += g.w * (bf2f((u16)(y0[r][i].y >> 16)) + bf2f((u16)(y1[r][i].y >> 16)));
      }
      if (l == 0) {
#pragma unroll
        for (int i = 0; i < 4; ++i)
          *(f32x4*)(xr + i * 256 + lane * 4) = f32x4{xv[r][i * 4], xv[r][i * 4 + 1], xv[r][i * 4 + 2], xv[r][i * 4 + 3]};
        float hv[16];
        modulate_row_store(p, 1, 0, xv[r], mrow, H + (size_t)tok * 1024, hv);
      } else {
        float ss = 0.f;
#pragma unroll
        for (int i = 0; i < 16; ++i) ss += xv[r][i] * xv[r][i];
        ss = wave_sum(ss);
        const float rstd = rsqrtf(ss * (1.f / 1024.f) + EPS);
#pragma unroll
        for (int i = 0; i < 4; ++i) {
          const int c = i * 256 + lane * 4;
          const f32x4 g = *(const f32x4*)(p->g_final + c);
          *(f32x4*)(xr + c) = f32x4{xv[r][i * 4] * rstd * g.x, xv[r][i * 4 + 1] * rstd * g.y, xv[r][i * 4 + 2] * rstd * g.z, xv[r][i * 4 + 3] * rstd * g.w};
        }
      }
    }
  }
}

constexpr int N_PHASES = 3 + 2 * 11;
__global__ void __launch_bounds__(512, 2) fwd_v2(Params parg) {
  extern __shared__ __attribute__((aligned(16))) unsigned char dyn_lds[];
  const ldsp_t lds = (ldsp_t)dyn_lds;
  cg::grid_group grid = cg::this_grid();
  volatile LAS unsigned* xb_st = (volatile LAS unsigned*)(lds + LDS_BARW);
  if (TIDX < 4) xb_st[TIDX] = 0u;
  __syncthreads();
  if (parg.ph_end - parg.ph_begin > 1) xcd_barrier_post((unsigned*)(parg.ws + OFF_BAR));
  for (int ph = parg.ph_begin; ph < parg.ph_end; ++ph) {
    KP p = (KP)__builtin_amdgcn_kernarg_segment_ptr();
    asm volatile("" : "+s"(p));
    const int l = (ph >= 14) ? 1 : 0;
    const int k = (ph < 3) ? ph : 3 + (ph - 3) % 11;
    const int reps = (((PROBE_DUP >> k) & 1) && (!(PROBE_DUP & 0x10000) || l == 0)) ? 2 : 1;
    for (int rep = 0; rep < reps; ++rep) {
      if (rep) {
        xcd_barrier((unsigned*)(p->ws + OFF_BAR), xb_st);
        if (k == 10) { if (BIDX == 0 && TIDX < 32) wsp<int>(p, OFF_CNT)[TIDX * CNT_STRIDE] = 0; xcd_barrier((unsigned*)(p->ws + OFF_BAR), xb_st); }
      }
      switch (k) {
        case 0: phase0_2(p, lds); break;
        case 1: phase1_2(p); break;
        case 2: phaseA2(p); break;
        case 3: phaseB2(p, lds); break;
        case 4: phaseC2(p, lds); break;
        case 5: phaseP2(p, l, lds); break;
        case 6: phaseD2(p, l, lds); break;
        case 7: phaseE1(p, l, lds); break;
        case 8: phaseE2(p, l, lds); break;
        case 9: phaseF2(p, l, lds); break;
        case 10: phaseG2(p, l, lds); break;
        case 11: phaseI1_2(p, lds); break;
        case 12: phaseI2_2(p, lds); break;
        default: phaseJ2(p, l, lds); break;
      }
    }
    if (k == 0 || (k == 13 && l == 0)) conv_items2(p, k == 0 ? 0 : 1, lds, 0, CONV_EARLY);
    if (ph + 1 < parg.ph_end) {
      if (ph == parg.ph_begin) grid.sync();
      else xcd_barrier((unsigned*)(p->ws + OFF_BAR), xb_st);
    }
  }
}
}

extern "C" void kernel_launch(void* const* d_in, const int* in_sizes, int n_in, void* d_out, int out_size,
                              void* d_ws, size_t ws_size, hipStream_t stream) {
  static int grid2 = 0;
  if (!grid2) {
    int dev = 0, cus = 0, per_cu = 0;
    (void)hipGetDevice(&dev);
    (void)hipDeviceGetAttribute(&cus, hipDeviceAttributeMultiprocessorCount, dev);
    (void)hipFuncSetAttribute((const void*)v2::fwd_v2, hipFuncAttributeMaxDynamicSharedMemorySize, v2::LDS_TOTAL);
    (void)hipOccupancyMaxActiveBlocksPerMultiprocessor(&per_cu, v2::fwd_v2, 512, v2::LDS_TOTAL);
    if (per_cu < 1) { fprintf(stderr, "kernel does not fit on a CU\n"); per_cu = 1; }
    grid2 = cus & ~7;
  }
  if (ws_size < WS_NEEDED) { fprintf(stderr, "workspace too small: %zu < %zu\n", ws_size, (size_t)WS_NEEDED); return; }
  Params hp{};
  const float** f = (const float**)&hp;
  for (int i = 0; i < 29; ++i) f[i] = (const float*)d_in[i];
  hp.out = (float*)d_out;
  hp.ws = (char*)d_ws;
#if N_LAUNCH_MODE == 1
  for (int ph = 0; ph < v2::N_PHASES; ++ph) {
    hp.ph_begin = ph; hp.ph_end = ph + 1;
    void* args[] = {&hp};
    hipError_t e = hipLaunchCooperativeKernel((void*)v2::fwd_v2, dim3(grid2), dim3(512), args, v2::LDS_TOTAL, stream);
    if (e != hipSuccess) fprintf(stderr, "launch failed: %s\n", hipGetErrorString(e));
  }
#else
  hp.ph_begin = 0; hp.ph_end = v2::N_PHASES;
  (void)hipMemsetAsync((char*)d_ws + OFF_BAR, 0, (size_t)XCD_BAR_WORDS * 4, stream);
  void* args[] = {&hp};
  hipError_t e = hipLaunchCooperativeKernel((void*)v2::fwd_v2, dim3(grid2), dim3(512), args, v2::LDS_TOTAL, stream);
  if (e != hipSuccess) fprintf(stderr, "cooperative launch failed: %s (grid %d)\n", hipGetErrorString(e), grid2);
#endif
}
```

```cpp
#include <hip/hip_runtime.h>
#include <hip/hip_cooperative_groups.h>
#include <stdint.h>
#include <stdio.h>
namespace cg = cooperative_groups;

#ifndef N_LAUNCH_MODE
#define N_LAUNCH_MODE 0
#endif

#ifndef PROBE_DUP
#define PROBE_DUP 0
#endif
#define DEVI __device__ __forceinline__
typedef unsigned short u16;
typedef __attribute__((ext_vector_type(2))) float f32x2;
typedef __attribute__((ext_vector_type(2))) __bf16 bf16x2_t;
typedef __attribute__((ext_vector_type(8))) short bf16x8;
typedef __attribute__((ext_vector_type(16))) float f32x16;
typedef __attribute__((ext_vector_type(4))) unsigned u32x4;
typedef __attribute__((ext_vector_type(2))) unsigned u32x2;
typedef __attribute__((ext_vector_type(4))) float f32x4;
#define MFMA(a, b, c) __builtin_amdgcn_mfma_f32_32x32x16_bf16((a), (b), (c), 0, 0, 0)

constexpr int DMODEL = 1024, NBATCH = 8, SEQ = 4096, NCTX = 256;
constexpr int TPB = SEQ + NCTX;
constexpr int NTOK = NBATCH * TPB;
constexpr int MT_PER_B = TPB / 128;
constexpr int NEXP = 32;
constexpr int INP = 2304;
constexpr float EPS = 1e-6f;
constexpr float LOG2E = 1.4426950408889634f;
constexpr int SMEM_BYTES = 73728;
constexpr int UROWS = 2 * NTOK + NEXP * 256;

constexpr size_t al(size_t x) { return (x + 255) & ~(size_t)255; }
constexpr size_t OFF_WIN = 0;
constexpr size_t OFF_WQB = OFF_WIN + al((size_t)INP * 1024 * 2);
constexpr size_t OFF_WKVB = OFF_WQB + al((size_t)512 * 256 * 2);
constexpr size_t OFF_WGATE = OFF_WKVB + al((size_t)512 * 256 * 2);
constexpr size_t OFF_WBR = OFF_WGATE + al((size_t)4 * 1024 * 1024 * 2);
constexpr size_t OFF_WOUT = OFF_WBR + al((size_t)4 * 1024 * 256 * 2);
constexpr size_t OFF_W13 = OFF_WOUT + al((size_t)1024 * 1024 * 2);
constexpr size_t OFF_W2 = OFF_W13 + al((size_t)32 * 512 * 1024 * 2);
constexpr size_t OFF_MODP = OFF_W2 + al((size_t)32 * 1024 * 256 * 2);
constexpr size_t OFF_MOD = OFF_MODP + al((size_t)8 * 2 * 9 * 6144 * 4);
constexpr size_t OFF_CS32 = OFF_MOD + al((size_t)2 * 9 * 6144 * 4);
constexpr size_t OFF_CS16 = OFF_CS32 + al((size_t)64 * 16 * 2 * 4);
constexpr size_t OFF_WRT = OFF_CS16 + al((size_t)64 * 8 * 2 * 4);
constexpr size_t OFF_CNT = OFF_WRT + al((size_t)2 * 36 * 1024 * 4);
constexpr int CNT_STRIDE = 64;
constexpr size_t OFF_BAR = OFF_CNT + al(32 * CNT_STRIDE * 4);
constexpr int XCD_BAR_WORDS = 3456;
constexpr size_t OFF_CTXRES = OFF_BAR + al((size_t)XCD_BAR_WORDS * 4);
constexpr size_t OFF_H = OFF_CTXRES + al((size_t)8 * 256 * 1024 * 4);
constexpr size_t OFF_O = OFF_H + al((size_t)NTOK * 1024 * 2);
constexpr size_t OFF_SSQ = OFF_O + al((size_t)NTOK * 1024 * 2);
constexpr size_t OFF_LIST = OFF_SSQ + al((size_t)NTOK * 8 * 4);
constexpr size_t OFF_WLIST = OFF_LIST + al((size_t)32 * NTOK * 4);
constexpr size_t OFF_R1 = OFF_WLIST + al((size_t)32 * NTOK * 4);
constexpr int PLD = INP;
constexpr size_t OFF_PRAW = OFF_R1;
constexpr size_t OFF_QARAW = OFF_PRAW + (size_t)NTOK * INP * 2;
constexpr size_t OFF_KVARAW = OFF_QARAW + (size_t)NTOK * 512 * 2;
constexpr size_t OFF_VAT = OFF_KVARAW + (size_t)NTOK * 512 * 2;
constexpr size_t OFF_VBT = OFF_VAT + (size_t)NTOK * 256 * 2;
constexpr size_t OFF_VCT = OFF_VBT + (size_t)NTOK * 128 * 2;
constexpr size_t OFF_VDT = OFF_VCT + (size_t)NTOK * 256 * 2;
constexpr size_t OFF_END = OFF_VDT + (size_t)NTOK * 128 * 2;
constexpr size_t OFF_Z = OFF_R1;
constexpr size_t OFF_YPRE = OFF_O;
constexpr size_t OFF_U = OFF_R1;
constexpr size_t OFF_YS = OFF_R1 + al((size_t)UROWS * 256 * 2);
static_assert(OFF_Z + (size_t)NTOK * 4096 * 2 <= OFF_END, "alias overflow");
static_assert(OFF_YS + (size_t)(2 * NTOK + 1) * 1024 * 2 <= OFF_END, "alias overflow");
constexpr size_t WS_NEEDED = OFF_END;
static_assert(WS_NEEDED <= (size_t)536870912, "workspace budget (4 x largest tensor)");

struct Params {
  const float *x, *c, *ctx, *c_ctx, *w_mod, *b_mod, *g_norm_mix, *w_in, *g_q_a, *w_q_b, *g_kv_a, *w_kv_b,
      *sink_b, *rpb_c, *g_q_d, *g_k_d, *w_gate, *b_gate, *w_branch, *w_out, *g_norm_ffn, *w_group, *b_group,
      *w_router, *b_router, *w_ff1, *w_ff3, *w_ff2, *g_final;
  float* out;
  char* ws;
  int ph_begin, ph_end;
};

DEVI int tid_fresh() { int t; asm volatile("v_mov_b32 %0, %1" : "=v"(t) : "v"(__builtin_amdgcn_workitem_id_x())); return t; }
DEVI int bid_fresh() { int t; asm volatile("s_mov_b32 %0, %1" : "=s"(t) : "s"(__builtin_amdgcn_workgroup_id_x())); return t; }
#define TIDX tid_fresh()
#define BIDX bid_fresh()
typedef const __attribute__((address_space(4))) Params* KP;
DEVI unsigned pk2(float a, float b) { f32x2 v = {a, b}; bf16x2_t r = __builtin_convertvector(v, bf16x2_t); return __builtin_bit_cast(unsigned, r); }
DEVI u16 f2bf(float a) { return (u16)(pk2(a, 0.f) & 0xffffu); }
DEVI float bf2f(u16 v) { return __uint_as_float(((unsigned)v) << 16); }
DEVI float wave_sum(float v) {
#pragma unroll
  for (int m = 32; m >= 1; m >>= 1) v += __shfl_xor(v, m);
  return v;
}
template <class T> DEVI T* wsp(KP p, size_t off) { return (T*)(p->ws + off); }
DEVI const float* xrow_in(KP p, int l, int b, int rr) {
  if (l == 0) return (rr < NCTX) ? p->ctx + ((size_t)b * NCTX + rr) * 1024 : p->x + ((size_t)b * SEQ + rr - NCTX) * 1024;
  return (rr < NCTX) ? wsp<float>(p, OFF_CTXRES) + ((size_t)b * NCTX + rr) * 1024 : p->out + ((size_t)b * SEQ + rr - NCTX) * 1024;
}
DEVI float* xrow_res(KP p, int b, int rr) {
  return (rr < NCTX) ? wsp<float>(p, OFF_CTXRES) + ((size_t)b * NCTX + rr) * 1024 : p->out + ((size_t)b * SEQ + rr - NCTX) * 1024;
}
DEVI int perm16(int k) { return (k & ~12) | ((k & 4) << 1) | ((k & 8) >> 1); }

struct ConvT { const float* src; const float* src2; const float* ks; u16* dst; int ld; int ldd; float mul; };
constexpr int CONV_ITEMS = 1152 + 64 + 64 + 2048 + 512 + 512 + 8192 + 4096;
DEVI ConvT conv_decode(KP p, int l, int idx) {
  ConvT c; c.ks = nullptr; c.mul = 1.f; c.src2 = nullptr;
  if (idx < 1152) {
    int nt = idx >> 4, kt = idx & 15, n0 = nt * 32;
    int sc = (n0 < 416) ? n0 : ((n0 < 512) ? -1 : n0 - 96);
    c.ld = 2208; c.ldd = 1024;
    if ((n0 >= 512 && n0 < 768) || (n0 >= 1024 && n0 < 1280)) c.mul = 0.125f * LOG2E;
    c.src = (sc < 0) ? nullptr : p->w_in + (size_t)l * 1024 * 2208 + (size_t)kt * 64 * 2208 + sc;
    c.dst = wsp<u16>(p, OFF_WIN) + (size_t)n0 * 1024 + kt * 64;
    return c;
  }
  idx -= 1152;
  if (idx < 64) {
    int nt = idx >> 2, kt = idx & 3;
    c.ld = 384; c.ldd = 256; c.ks = p->g_q_a + l * 256 + kt * 64;
    c.src = (nt >= 12) ? nullptr : p->w_q_b + (size_t)l * 256 * 384 + (size_t)kt * 64 * 384 + nt * 32;
    c.dst = wsp<u16>(p, OFF_WQB) + (size_t)nt * 32 * 256 + kt * 64;
    return c;
  }
  idx -= 64;
  if (idx < 64) {
    int nt = idx >> 2, kt = idx & 3;
    c.ld = 512; c.ldd = 256; c.ks = (kt < 2) ? p->g_kv_a + l * 128 + kt * 64 : nullptr;
    c.src = (kt >= 2) ? nullptr : p->w_kv_b + (size_t)l * 128 * 512 + (size_t)kt * 64 * 512 + nt * 32;
    c.dst = wsp<u16>(p, OFF_WKVB) + (size_t)nt * 32 * 256 + kt * 64;
    return c;
  }
  idx -= 64;
  if (idx < 2048) {
    int nt = idx >> 4, kt = idx & 15, R0 = nt * 32;
    int pr = R0 >> 11, cb = (R0 & 2047) >> 8, bj = (R0 & 255) >> 7, j0 = R0 & 127;
    c.ld = 1024; c.ldd = 1024;
    c.src = p->w_gate + ((size_t)(l * 4 + 2 * pr + bj) * 1024 + kt * 64) * 1024 + cb * 128 + j0;
    c.dst = wsp<u16>(p, OFF_WGATE) + (size_t)R0 * 1024 + kt * 64;
    return c;
  }
  idx -= 2048;
  if (idx < 512) {
    int br = idx >> 7, nt = (idx >> 2) & 31, kt = idx & 3;
    c.ld = 1024; c.ldd = 256;
    c.src = p->w_branch + ((size_t)(l * 4 + br) * 256 + kt * 64) * 1024 + nt * 32;
    c.dst = wsp<u16>(p, OFF_WBR) + ((size_t)br * 1024 + nt * 32) * 256 + kt * 64;
    return c;
  }
  idx -= 512;
  if (idx < 512) {
    int nt = idx >> 4, kt = idx & 15;
    c.ld = 1024; c.ldd = 1024;
    c.src = p->w_out + ((size_t)l * 1024 + kt * 64) * 1024 + nt * 32;
    c.dst = wsp<u16>(p, OFF_WOUT) + (size_t)nt * 32 * 1024 + kt * 64;
    return c;
  }
  idx -= 512;
  if (idx < 8192) {
    int e = idx >> 8, g32 = (idx >> 4) & 15, kt = idx & 15;
    c.ld = 256; c.ldd = 1024;
    c.src = p->w_ff1 + ((size_t)(l * 32 + e) * 1024 + kt * 64) * 256 + g32 * 16;
    c.src2 = p->w_ff3 + ((size_t)(l * 32 + e) * 1024 + kt * 64) * 256 + g32 * 16;
    c.dst = wsp<u16>(p, OFF_W13) + ((size_t)e * 512 + g32 * 32) * 1024 + kt * 64;
    return c;
  }
  idx -= 8192;
  {
    int e = idx >> 7, nt = (idx >> 2) & 31, kt = idx & 3;
    c.ld = 1024; c.ldd = 256;
    c.src = p->w_ff2 + ((size_t)(l * 32 + e) * 256 + kt * 64) * 1024 + nt * 32;
    c.dst = wsp<u16>(p, OFF_W2) + ((size_t)e * 1024 + nt * 32) * 256 + kt * 64;
    return c;
  }
}
DEVI void modulate_row_store(KP p, int l, int which, const float (&xv)[16], int mrow, u16* hrow, float (&hv)[16]) {
  const int lane = TIDX & 63;
  float ss = 0.f;
#pragma unroll
  for (int i = 0; i < 16; ++i) ss += xv[i] * xv[i];
  ss = wave_sum(ss);
  const float rstd = rsqrtf(ss * (1.f / 1024.f) + EPS);
  const float* g = (which ? p->g_norm_ffn : p->g_norm_mix) + l * 1024;
  const float* mod = wsp<float>(p, OFF_MOD) + ((size_t)l * 9 + mrow) * 6144 + (which ? 3072 : 0);
#pragma unroll
  for (int i = 0; i < 4; ++i) {
    const int c = i * 256 + lane * 4;
    f32x4 gv = *(const f32x4*)(g + c);
    f32x4 sh = *(const f32x4*)(mod + c);
    f32x4 sc = *(const f32x4*)(mod + 1024 + c);
    hv[i * 4 + 0] = xv[i * 4 + 0] * rstd * gv.x * (1.f + sc.x) + sh.x;
    hv[i * 4 + 1] = xv[i * 4 + 1] * rstd * gv.y * (1.f + sc.y) + sh.y;
    hv[i * 4 + 2] = xv[i * 4 + 2] * rstd * gv.z * (1.f + sc.z) + sh.z;
    hv[i * 4 + 3] = xv[i * 4 + 3] * rstd * gv.w * (1.f + sc.w) + sh.w;
    u32x2 o; o.x = pk2(hv[i * 4 + 0], hv[i * 4 + 1]); o.y = pk2(hv[i * 4 + 2], hv[i * 4 + 3]);
    *(u32x2*)(hrow + c) = o;
  }
}
DEVI void load_row16(const float* xr, float (&xv)[16]) {
  const int lane = TIDX & 63;
#pragma unroll
  for (int i = 0; i < 4; ++i) {
    f32x4 v = *(const f32x4*)(xr + i * 256 + lane * 4);
    xv[i * 4 + 0] = v.x; xv[i * 4 + 1] = v.y; xv[i * 4 + 2] = v.z; xv[i * 4 + 3] = v.w;
  }
}
DEVI float router_dot(const float (&hv)[4][16], const float* wrow) {
  const int lane = TIDX & 63;
  const float* w = wrow + lane * 4;
  float pr[4] = {0.f, 0.f, 0.f, 0.f};
#pragma unroll
  for (int i = 0; i < 4; ++i) {
    const f32x4 wv = *(const f32x4*)(w + i * 256);
#pragma unroll
    for (int r = 0; r < 4; ++r)
      pr[r] += hv[r][i * 4] * wv.x + hv[r][i * 4 + 1] * wv.y + hv[r][i * 4 + 2] * wv.z + hv[r][i * 4 + 3] * wv.w;
  }
  const bool up = (lane & 32) != 0;
  float s0 = up ? pr[0] : pr[2], s1 = up ? pr[1] : pr[3];
  float k0 = up ? pr[2] : pr[0], k1 = up ? pr[3] : pr[1];
  k0 += __shfl_xor(s0, 32); k1 += __shfl_xor(s1, 32);
  const bool up2 = (lane & 16) != 0;
  float sv = up2 ? k0 : k1, kv = up2 ? k1 : k0;
  kv += __shfl_xor(sv, 16);
  kv += __shfl_xor(kv, 8); kv += __shfl_xor(kv, 4); kv += __shfl_xor(kv, 2); kv += __shfl_xor(kv, 1);
  return kv;
}
#define XB_TMO      128
#define XB_XCNT(j)  (256  + 64 * (j))
#define XB_XSUB(j)  (1280 + 64 * (j))
#define XB_XGEN(j)  (2304 + 64 * (j))
#define XB_TOP      3328
#define XB_TOPGEN   3392
#define XB_SPIN_CAP (1u << 20)
#define LAS __attribute__((address_space(3)))
DEVI unsigned xb_ld(unsigned* p) { return __hip_atomic_load(p, __ATOMIC_RELAXED, __HIP_MEMORY_SCOPE_AGENT); }
DEVI unsigned xb_add(unsigned* p, unsigned v) { return __hip_atomic_fetch_add(p, v, __ATOMIC_RELAXED, __HIP_MEMORY_SCOPE_AGENT); }
DEVI unsigned xb_xcc_id() { return (unsigned)__builtin_amdgcn_s_getreg((3 << 11) | 20) & 0xFu; }
#define XB_SPIN(cond, bar) do { unsigned _sp = 0; while (cond) { __builtin_amdgcn_s_sleep(1); \
    if ((++_sp & 255u) == 0u) { if (xb_ld(&(bar)[XB_TMO])) break; if (_sp > XB_SPIN_CAP) { atomicAdd(&(bar)[XB_TMO], 1u); break; } } } } while (0)
DEVI void xcd_barrier_post(unsigned* bar) {
  if (TIDX == 0) (void)xb_add(&bar[XB_XCNT(xb_xcc_id())], 1u);
}
DEVI void xcd_barrier_complete(unsigned* bar, unsigned x, unsigned& nloc, unsigned& nx) {
  const unsigned G = gridDim.x * gridDim.y * gridDim.z;
  unsigned sum, cnt, mine, sp = 0u;
  for (;;) {
    sum = 0u; cnt = 0u; mine = 0u;
#pragma unroll
    for (unsigned j = 0; j < 16; ++j) { const unsigned c = xb_ld(&bar[XB_XCNT(j)]); sum += c; cnt += (c > 0u) ? 1u : 0u; mine = (j == x) ? c : mine; }
    if (sum == G) break;
    __builtin_amdgcn_s_sleep(1);
    if ((++sp & 255u) == 0u) { if (xb_ld(&bar[XB_TMO])) break; if (sp > XB_SPIN_CAP) { atomicAdd(&bar[XB_TMO], 1u); break; } }
  }
  nloc = mine > 0u ? mine : 1u; nx = cnt > 0u ? cnt : 1u;
}
DEVI void xcd_barrier(unsigned* bar, volatile LAS unsigned* st) {
  asm volatile("s_waitcnt vmcnt(0)" ::: "memory");
  __syncthreads();
  if (TIDX == 0) {
    const unsigned x = xb_xcc_id();
    __builtin_amdgcn_s_waitcnt(0);
    unsigned nloc = st[0], nx = st[1];
    if (nloc == 0u) { xcd_barrier_complete(bar, x, nloc, nx); st[0] = nloc; st[1] = nx; }
    const unsigned old = xb_add(&bar[XB_XSUB(x)], 1u);
    const unsigned gen = old / nloc;
    if (old + 1u == (gen + 1u) * nloc) {
      __builtin_amdgcn_fence(__ATOMIC_RELEASE, "agent");
      asm volatile("s_waitcnt vmcnt(0)" ::: "memory");
      const unsigned og = xb_add(&bar[XB_TOP], 1u);
      const unsigned tg = og / nx;
      if (og + 1u == (tg + 1u) * nx) xb_add(&bar[XB_TOPGEN], 1u);
      else XB_SPIN(xb_ld(&bar[XB_TOPGEN]) == tg, bar);
      __builtin_amdgcn_fence(__ATOMIC_ACQUIRE, "agent");
      xb_add(&bar[XB_XGEN(x)], 1u);
      asm volatile("s_waitcnt vmcnt(0)" ::: "memory");
    } else {
      XB_SPIN(xb_ld(&bar[XB_XGEN(x)]) == gen, bar);
      __builtin_amdgcn_fence(__ATOMIC_ACQUIRE, "agent");
      asm volatile("s_waitcnt vmcnt(0)" ::: "memory");
    }
  }
  __syncthreads();
}

namespace v2 {
typedef LAS unsigned char* ldsp_t;
constexpr int BM = 256, BK = 64, HALF = 128, HTB = HALF * BK * 2, STAGE_BYTES = 8 * HTB;
constexpr int NW = 8;
constexpr int LDS_XTRA = STAGE_BYTES;
constexpr int LDS_BARW = STAGE_BYTES + 16384;
constexpr int LDS_TOTAL = LDS_BARW + 16;

DEVI int lds_byte(int r, int c) { const int st = (r >> 4) * 2 + (c >> 5), rr = r & 15, cc = c & 31, ob = rr * 64 + cc * 2; return st * 1024 + (ob ^ (((ob >> 9) & 1) << 5)); }
DEVI void stage_rc(int b, int& R, int& C) { const int st = b / 1024, sb = b % 1024, swz = sb ^ (((sb >> 9) & 1) << 5); R = (st >> 1) * 16 + swz / 64; C = (st & 1) * 32 + (swz % 64) / 2; }
DEVI int perm32(int rho) { const int n = rho >> 4, i = rho & 15; return 8 * (i >> 2) + 4 * n + (i & 3); }

DEVI void acc_zero(f32x4 (&acc)[2][2][4][2]) {
#pragma unroll
  for (int a = 0; a < 2; ++a)
#pragma unroll
    for (int b = 0; b < 2; ++b)
#pragma unroll
      for (int m = 0; m < 4; ++m)
#pragma unroll
        for (int n = 0; n < 2; ++n) acc[a][b][m][n] = (f32x4){0.f, 0.f, 0.f, 0.f};
}
struct Unit { const char* A; const char* B; const int* rows; int nvalid; int u0, u1, u2, u3; };

template <bool PERM, bool GATHER, class Epi, class Sched>
DEVI void gemm_phase(ldsp_t lds, int lda_b, int ldb_b, int nt, const Sched& S, const Epi& E) {
  const int tid = TIDX, wid = __builtin_amdgcn_readfirstlane(tid >> 6), lane = tid & 63, wr = wid >> 2, wc = wid & 3, fr = lane & 15, fq = lane >> 4;
  unsigned voffA[2], voffB[2]; int RA[2], CA2[2];
#pragma unroll
  for (int i = 0; i < 2; ++i) {
    int R, C; stage_rc(tid * 16 + i * 8192, R, C);
    const int Rb = PERM ? ((R & ~31) + perm32(R & 31)) : R;
    RA[i] = R; CA2[i] = C * 2;
    voffA[i] = (unsigned)(R * lda_b + C * 2); voffB[i] = (unsigned)(Rb * ldb_b + C * 2);
  }
  const size_t kstep = (size_t)(BK * 2);
  const size_t hstepA = (size_t)HALF * lda_b, hstepB = (size_t)HALF * ldb_b;
  const unsigned ldsw = (unsigned)wid * 1024u;
  const int aoff = lds_byte(wr * 64 + fr, fq * 8), boff = lds_byte(wc * 32 + fr, fq * 8);
#define G_SA(b, h) (((b) * 2 + (h)) * HTB)
#define G_SB(b, h) ((4 + (b) * 2 + (h)) * HTB)
#define G_STAGE(bufoff, gbase, voff) do { _Pragma("unroll") for (int _i = 0; _i < 2; ++_i) \
    __builtin_amdgcn_global_load_lds((const unsigned*)((const char*)(gbase) + (voff)[_i]), (LAS unsigned*)(lds + (bufoff) + ldsw + _i * 8192), 16, 0, 0); } while (0)
#define G_STAGE_A(bufoff, abase, go, h, koff) do { if (GATHER) { _Pragma("unroll") for (int _i = 0; _i < 2; ++_i) \
    __builtin_amdgcn_global_load_lds((const unsigned*)((abase) + (go)[h][_i] + (koff)), (LAS unsigned*)(lds + (bufoff) + ldsw + _i * 8192), 16, 0, 0); } \
    else G_STAGE(bufoff, (abase) + (h) * hstepA + (koff), voffA); } while (0)
#define G_LDA(dst, b, h) do { _Pragma("unroll") for (int m = 0; m < 4; ++m) _Pragma("unroll") for (int k = 0; k < 2; ++k) dst[m][k] = *(const LAS bf16x8*)(lds + G_SA(b, h) + aoff + m * 2048 + k * 1024); } while (0)
#define G_LDB(dst, b, h) do { _Pragma("unroll") for (int n = 0; n < 2; ++n) _Pragma("unroll") for (int k = 0; k < 2; ++k) dst[n][k] = *(const LAS bf16x8*)(lds + G_SB(b, h) + boff + n * 2048 + k * 1024); } while (0)
#define G_MMA(ai, bj, At, Bt) do { __builtin_amdgcn_s_setprio(1); _Pragma("unroll") for (int m = 0; m < 4; ++m) _Pragma("unroll") for (int n = 0; n < 2; ++n) _Pragma("unroll") for (int k = 0; k < 2; ++k) \
    acc[ai][bj][m][n] = __builtin_amdgcn_mfma_f32_16x16x32_bf16(Bt[n][k], At[m][k], acc[ai][bj][m][n], 0, 0, 0); __builtin_amdgcn_s_setprio(0); } while (0)
#define G_WAIT_V(n) asm volatile("s_waitcnt vmcnt(" #n ")" ::: "memory")
#define G_WAIT_L(n) asm volatile("s_waitcnt lgkmcnt(" #n ")" ::: "memory")
#define G_BAR __builtin_amdgcn_s_barrier()
#define G_SCHED __builtin_amdgcn_sched_barrier(0)
  Unit cur, nxt; int ui = 0;
  if (!S.next(0, cur)) return;
  f32x4 acc[2][2][4][2];
  E.init(acc, cur, wr, wc, fr, fq);
  bf16x8 At[4][2], B0[2][2], B1[2][2];
  unsigned gcur[2][2];
  auto gather_offs = [&](const Unit& u, unsigned (&go)[2][2]) {
#pragma unroll
    for (int h = 0; h < 2; ++h)
#pragma unroll
      for (int i = 0; i < 2; ++i) {
        const int r = h * HALF + RA[i];
        const int t = (r < u.nvalid) ? (u.rows[r] >> 1) : 0;
        go[h][i] = (unsigned)t * (unsigned)lda_b + (unsigned)CA2[i];
      }
  };
  if (GATHER) gather_offs(cur, gcur);
  const char* cA = cur.A; const char* cB = cur.B;
  G_STAGE(G_SB(0, 0), cB, voffB); G_STAGE_A(G_SA(0, 0), cA, gcur, 0, 0); G_STAGE(G_SB(0, 1), cB + hstepB, voffB); G_STAGE_A(G_SA(0, 1), cA, gcur, 1, 0);
  if (wr == 1) G_BAR;
  G_WAIT_V(4); G_BAR;
  G_STAGE(G_SB(1, 0), cB + kstep, voffB); G_STAGE_A(G_SA(1, 0), cA, gcur, 0, kstep); G_STAGE(G_SB(1, 1), cB + hstepB + kstep, voffB);
  G_WAIT_V(6); G_BAR;
  for (;;) {
    const bool has_next = S.next(ui + 1, nxt);
    const char* nA = has_next ? nxt.A : cA; const char* nB = has_next ? nxt.B : cB;
    for (int t = 0; t < nt; t += 2) {
      const bool last = (t == nt - 2);
      const size_t k1 = (size_t)(t + 1) * kstep;
      const char* a2 = last ? nA : cA; const char* b2 = last ? nB : cB + (size_t)(t + 2) * kstep;
      const size_t ka2 = last ? 0 : (size_t)(t + 2) * kstep;
      const char* b3 = b2 + kstep; const size_t ka3 = ka2 + kstep;
      unsigned gN[2][2];
      if (GATHER && last) {
        if (has_next) gather_offs(nxt, gN);
        else {
#pragma unroll
          for (int h = 0; h < 2; ++h)
#pragma unroll
            for (int i = 0; i < 2; ++i) gN[h][i] = gcur[h][i];
        }
      }
#define G_STAGE_A2(bufoff, h, koff) do { if (GATHER) { if (last) G_STAGE_A(bufoff, cA, gN, h, (koff) - ka2); else G_STAGE_A(bufoff, cA, gcur, h, koff); } \
        else G_STAGE_A(bufoff, a2, gcur, h, koff); } while (0)
      G_LDB(B0, 0, 0); G_SCHED; G_LDA(At, 0, 0); G_STAGE_A(G_SA(1, 1), cA, gcur, 1, k1);
      G_WAIT_L(8); G_BAR; G_WAIT_L(0); G_MMA(0, 0, At, B0); G_BAR; G_SCHED;
      G_LDB(B1, 0, 1); G_STAGE(G_SB(0, 0), b2, voffB);
      G_BAR; G_WAIT_L(0); G_MMA(0, 1, At, B1); G_BAR;
      G_LDA(At, 0, 1); G_STAGE_A2(G_SA(0, 0), 0, ka2);
      G_BAR; G_WAIT_L(0); G_MMA(1, 0, At, B0); G_BAR; G_SCHED;
      G_STAGE(G_SB(0, 1), b2 + hstepB, voffB);
      G_WAIT_V(6); G_BAR; G_MMA(1, 1, At, B1); G_BAR;
      G_LDB(B0, 1, 0); G_SCHED; G_LDA(At, 1, 0); G_STAGE_A2(G_SA(0, 1), 1, ka2);
      G_WAIT_L(8); G_BAR; G_WAIT_L(0); G_MMA(0, 0, At, B0); G_BAR; G_SCHED;
      G_LDB(B1, 1, 1); G_STAGE(G_SB(1, 0), b3, voffB);
      G_BAR; G_WAIT_L(0); G_MMA(0, 1, At, B1); G_BAR;
      G_LDA(At, 1, 1); G_STAGE_A2(G_SA(1, 0), 0, ka3);
      G_BAR; G_WAIT_L(0); G_MMA(1, 0, At, B0); G_BAR; G_SCHED;
      G_STAGE(G_SB(1, 1), b3 + hstepB, voffB);
      G_WAIT_V(6); G_BAR; G_MMA(1, 1, At, B1); G_BAR;
      if (GATHER && last) {
#pragma unroll
        for (int h = 0; h < 2; ++h)
#pragma unroll
          for (int i = 0; i < 2; ++i) gcur[h][i] = gN[h][i];
      }
#undef G_STAGE_A2
    }
    G_SCHED;
    E(acc, cur, wr, wc, fr, fq);
    G_SCHED;
    if (!has_next) break;
    cur = nxt; cA = nA; cB = nB; ++ui;
    E.init(acc, cur, wr, wc, fr, fq);
  }
  G_WAIT_V(0);
  if (wr == 0) G_BAR;
  G_BAR;
#undef G_SA
#undef G_SB
#undef G_STAGE
#undef G_STAGE_A
#undef G_LDA
#undef G_LDB
#undef G_MMA
#undef G_WAIT_V
#undef G_WAIT_L
#undef G_BAR
#undef G_SCHED
}

DEVI unsigned uoff(unsigned x) { return (unsigned)__builtin_amdgcn_readfirstlane((int)x); }
DEVI bool tile_order(int i, int G, int c, int nM, int nN, int& pm, int& pn) {
  const int nwg = nM * nN;
  const long L = (long)i * G + c; if (L >= nwg) return false;
  int wgid = (int)L; { const int q = nwg / 8, r = nwg % 8, xcd = wgid % 8, off = wgid / 8; wgid = (xcd < r ? xcd * (q + 1) : r * (q + 1) + (xcd - r) * q) + off; }
  const int WGM = 8;
  const int nig = WGM * nN, gid = wgid / nig, fm = gid * WGM, gsz = (nM - fm) < WGM ? (nM - fm) : WGM;
  pm = fm + ((wgid % nig) % gsz); pn = (wgid % nig) / gsz;
  pm = __builtin_amdgcn_readfirstlane(pm); pn = __builtin_amdgcn_readfirstlane(pn);
  return true;
}
struct EpiRawBf16 {
  u16* O; int ldc;
  DEVI void init(f32x4 (&acc)[2][2][4][2], const Unit&, int, int, int, int) const { acc_zero(acc); }
  DEVI void operator()(const f32x4 (&acc)[2][2][4][2], const Unit& u, int wr, int wc, int fr, int fq) const {
    const unsigned off0 = ((unsigned)(u.u0 + wr * 64 + fr) * (unsigned)ldc + (unsigned)(u.u1 + wc * 32 + 8 * fq)) * 2u;
#pragma unroll
    for (int ai = 0; ai < 2; ++ai)
#pragma unroll
      for (int m = 0; m < 4; ++m) {
        char* rowp = (char*)O + (off0 + (unsigned)(ai * HALF + m * 16) * (unsigned)ldc * 2u);
#pragma unroll
        for (int bj = 0; bj < 2; ++bj) {
          const f32x4 v0 = acc[ai][bj][m][0], v1 = acc[ai][bj][m][1];
          u32x4 w; w.x = pk2(v0[0], v0[1]); w.y = pk2(v0[2], v0[3]); w.z = pk2(v1[0], v1[1]); w.w = pk2(v1[2], v1[3]);
          *(u32x4*)(rowp + bj * HALF * 2) = w;
        }
      }
  }
};

struct SchedB { const char* ws; int G, c;
  DEVI bool next(int i, Unit& u) const { int pm, pn; if (!tile_order(i, G, c, NTOK / 256, INP / 256, pm, pn)) return false;
    u.A = ws + OFF_H + uoff((unsigned)pm * 256u * 2048u); u.B = ws + OFF_WIN + uoff((unsigned)pn * 256u * 2048u); u.rows = nullptr; u.nvalid = 0; u.u0 = pm * 256; u.u1 = pn * 256; u.u2 = 0; u.u3 = 0; return true; } };
struct EpiB { u16* O; float* ssq;
  DEVI void init(f32x4 (&acc)[2][2][4][2], const Unit&, int, int, int, int) const { acc_zero(acc); }
  DEVI void operator()(const f32x4 (&acc)[2][2][4][2], const Unit& u, int wr, int wc, int fr, int fq) const {
    EpiRawBf16 E{O, PLD}; E(acc, u, wr, wc, fr, fq);
    if (u.u1 < 512) {
      const bool iskv = u.u1 != 0;
#pragma unroll
      for (int ai = 0; ai < 2; ++ai)
#pragma unroll
        for (int m = 0; m < 4; ++m) {
          float ss = 0.f;
#pragma unroll
          for (int bj = 0; bj < 2; ++bj)
#pragma unroll
            for (int n = 0; n < 2; ++n)
#pragma unroll
              for (int j = 0; j < 4; ++j) { const float v = acc[ai][bj][m][n][j]; if (!(iskv && bj == 1)) ss += v * v; }
          ss += __shfl_xor(ss, 16); ss += __shfl_xor(ss, 32);
          if (fq == 0) ssq[(size_t)(u.u0 + ai * HALF + wr * 64 + m * 16 + fr) * 8 + (iskv ? 4 : 0) + wc] = ss;
        }
    }
  }
};
DEVI void phaseB2(KP p, ldsp_t lds) {
  SchedB S{(const char*)p->ws, (int)gridDim.x, BIDX};
  EpiB E{wsp<u16>(p, OFF_PRAW), wsp<float>(p, OFF_SSQ)};
  gemm_phase<true, false>(lds, 2048, 2048, 16, S, E);
}
struct SchedC { const char* ws; int G, c;
  DEVI bool next(int i, Unit& u) const { int pm, pn; if (!tile_order(i, G, c, NTOK / 256, 4, pm, pn)) return false;
    const bool kv = pn >= 2; const int pj = pn & 1;
    u.A = ws + OFF_PRAW + uoff((unsigned)pm * 256u * (unsigned)(PLD * 2) + (kv ? 512u : 0u)); u.B = ws + (kv ? OFF_WKVB : OFF_WQB) + uoff((unsigned)pj * 256u * 512u); u.rows = nullptr; u.nvalid = 0;
    u.u0 = pm * 256; u.u1 = pj * 256; u.u2 = kv; u.u3 = 0; return true; } };
struct EpiC { u16* Oq; u16* Okv; const float* ssq;
  DEVI void init(f32x4 (&acc)[2][2][4][2], const Unit&, int, int, int, int) const { acc_zero(acc); }
  DEVI void operator()(const f32x4 (&acc)[2][2][4][2], const Unit& u, int wr, int wc, int fr, int fq) const {
    const bool kv = u.u2 != 0;
    u16* O = kv ? Okv : Oq;
    const int row0 = u.u0 + wr * 64 + fr, col0 = u.u1 + wc * 32 + 8 * fq;
    f32x4 sq[2][4];
#pragma unroll
    for (int ai = 0; ai < 2; ++ai)
#pragma unroll
      for (int m = 0; m < 4; ++m) sq[ai][m] = *(const f32x4*)(ssq + (size_t)(row0 + ai * HALF + m * 16) * 8 + (kv ? 4 : 0));
#pragma unroll
    for (int ai = 0; ai < 2; ++ai)
#pragma unroll
      for (int m = 0; m < 4; ++m) {
        const size_t r = (size_t)(row0 + ai * HALF + m * 16);
        const float tot = sq[ai][m].x + sq[ai][m].y + sq[ai][m].z + sq[ai][m].w;
        const float sc = kv ? rsqrtf(tot * (1.f / 128.f) + EPS) : rsqrtf(tot * (1.f / 256.f) + EPS) * (0.10206207261596575f * LOG2E);
        u16* rowp = O + r * 512 + col0;
#pragma unroll
        for (int bj = 0; bj < 2; ++bj) {
          const f32x4 v0 = acc[ai][bj][m][0] * sc, v1 = acc[ai][bj][m][1] * sc;
          u32x4 w; w.x = pk2(v0[0], v0[1]); w.y = pk2(v0[2], v0[3]); w.z = pk2(v1[0], v1[1]); w.w = pk2(v1[2], v1[3]);
          *(u32x4*)(rowp + bj * HALF) = w;
        }
      }
  }
};
DEVI void phaseC2(KP p, ldsp_t lds) {
  SchedC S{(const char*)p->ws, (int)gridDim.x, BIDX};
  EpiC E{wsp<u16>(p, OFF_QARAW), wsp<u16>(p, OFF_KVARAW), wsp<float>(p, OFF_SSQ)};
  int nt = 4; asm volatile("" : "+s"(nt));
  gemm_phase<true, false>(lds, PLD * 2, 512, nt, S, E);
}

DEVI void ld16(const u16* src, float (&v)[16]) {
  const u32x4 a = *(const u32x4*)src, b = *(const u32x4*)(src + 8);
  const unsigned w[8] = {a.x, a.y, a.z, a.w, b.x, b.y, b.z, b.w};
#pragma unroll
  for (int i = 0; i < 8; ++i) { v[2 * i] = __uint_as_float(w[i] << 16); v[2 * i + 1] = __uint_as_float(w[i] & 0xffff0000u); }
}
DEVI void st16(u16* dst, const float (&v)[16]) {
  u32x4 a, b;
  a.x = pk2(v[0], v[1]); a.y = pk2(v[2], v[3]); a.z = pk2(v[4], v[5]); a.w = pk2(v[6], v[7]);
  b.x = pk2(v[8], v[9]); b.y = pk2(v[10], v[11]); b.z = pk2(v[12], v[13]); b.w = pk2(v[14], v[15]);
  *(u32x4*)dst = a; *(u32x4*)(dst + 8) = b;
}
DEVI void rope16c(float (&v)[16], const float* cs16, int pos) {
  const f32x2* t = (const f32x2*)(cs16 + pos * 16);
#pragma unroll
  for (int i = 0; i < 8; ++i) { const f32x2 cs = t[i]; const float x1 = v[i], x2 = v[8 + i]; v[i] = x1 * cs.x - x2 * cs.y; v[8 + i] = x2 * cs.x + x1 * cs.y; }
}
DEVI void rope32c(float (&lo)[16], float (&hi)[16], const float* cs32, int pos) {
  const f32x2* t = (const f32x2*)(cs32 + pos * 32);
#pragma unroll
  for (int i = 0; i < 16; ++i) { const f32x2 cs = t[i]; const float x1 = lo[i], x2 = hi[i]; lo[i] = x1 * cs.x - x2 * cs.y; hi[i] = x2 * cs.x + x1 * cs.y; }
}
DEVI float ssq16(const float (&v)[16]) { float s = 0.f;
#pragma unroll
  for (int i = 0; i < 16; ++i) s += v[i] * v[i];
  return s; }
DEVI void scale16(float (&v)[16], float s) {
#pragma unroll
  for (int i = 0; i < 16; ++i) v[i] *= s; }
DEVI void cvt16(const u32x4 a, const u32x4 b, float (&v)[16]) {
  const unsigned w[8] = {a.x, a.y, a.z, a.w, b.x, b.y, b.z, b.w};
#pragma unroll
  for (int i = 0; i < 8; ++i) { v[2 * i] = __uint_as_float(w[i] << 16); v[2 * i + 1] = __uint_as_float(w[i] & 0xffff0000u); }
}
DEVI void phaseP2(KP p, int l, ldsp_t lds) {
  const int tid = TIDX, tk = tid >> 3, pt = tid & 7;
  u16* PR = wsp<u16>(p, OFF_PRAW);
  u16* QA = wsp<u16>(p, OFF_QARAW);
  const float* cs32 = wsp<float>(p, OFF_CS32);
  const float* cs16 = wsp<float>(p, OFF_CS16);
  const float QS = 0.125f * LOG2E;
  for (int item = BIDX; item < NTOK / 64; item += gridDim.x) {
    const int tok0 = item * 64, rr0 = tok0 % TPB;
    const bool lat = rr0 >= NCTX;
    const size_t tok = (size_t)tok0 + tk;
    const int t = rr0 + tk - NCTX, grow = (t >> 6) & 63, gcol = t & 63;
    u16* pr = PR + tok * PLD;
    u16* qar = QA + tok * 512 + 96 * (pt >> 1) + 64 + 16 * (pt & 1);
    const int g4 = pt & 3;
    u32x4 r_qa[2], r_kr[2], r_qb[4], r_kb[4], r_qd[4], r_kd[4];
#define LD8(ptr) (*(const u32x4*)(ptr))
    if (lat) {
#pragma unroll
      for (int i = 0; i < 2; ++i) { r_qa[i] = LD8(qar + 8 * i); r_kr[i] = LD8(pr + 384 + 16 * (pt & 1) + 8 * i); }
#pragma unroll
      for (int i = 0; i < 4; ++i) { r_qb[i] = LD8(pr + 512 + 32 * pt + 8 * i); r_kb[i] = LD8(pr + 768 + 32 * g4 + 8 * i); }
    }
#pragma unroll
    for (int i = 0; i < 4; ++i) { r_qd[i] = LD8(pr + 1792 + 32 * pt + 8 * i); r_kd[i] = LD8(pr + 2048 + 32 * g4 + 8 * i); }
#undef LD8
    if (lat) {
      { float v[16]; cvt16(r_qa[0], r_qa[1], v); rope16c(v, cs16, (pt & 1) ? gcol : grow); st16(qar, v); }
      if (pt < 2) { float v[16]; cvt16(r_kr[0], r_kr[1], v); rope16c(v, cs16, pt == 0 ? grow : gcol); st16(pr + 384 + 16 * pt, v); }
      { float lo[16], hi[16]; cvt16(r_qb[0], r_qb[1], lo); cvt16(r_qb[2], r_qb[3], hi); rope32c(lo, hi, cs32, (pt & 1) ? gcol : grow); st16(pr + 512 + 32 * pt, lo); st16(pr + 512 + 32 * pt + 16, hi); }
      if (pt < 4) { float lo[16], hi[16]; cvt16(r_kb[0], r_kb[1], lo); cvt16(r_kb[2], r_kb[3], hi); rope32c(lo, hi, cs32, (pt & 1) ? gcol : grow); st16(pr + 768 + 32 * pt, lo); st16(pr + 768 + 32 * pt + 16, hi); }
    }
    {
      float lo[16], hi[16]; cvt16(r_qd[0], r_qd[1], lo); cvt16(r_qd[2], r_qd[3], hi);
      float ss = ssq16(lo) + ssq16(hi); ss += __shfl_xor(ss, 1);
      const float rs = rsqrtf(ss * (1.f / 64.f) + EPS);
      const float* g = p->g_q_d + l * 64 + 32 * (pt & 1);
#pragma unroll
      for (int i = 0; i < 16; ++i) { lo[i] *= rs * g[i]; hi[i] *= rs * g[16 + i]; }
      if (lat) rope32c(lo, hi, cs32, (pt & 1) ? gcol : grow);
      scale16(lo, QS); scale16(hi, QS);
      st16(pr + 1792 + 32 * pt, lo); st16(pr + 1792 + 32 * pt + 16, hi);
    }
    {
      float lo[16], hi[16]; cvt16(r_kd[0], r_kd[1], lo); cvt16(r_kd[2], r_kd[3], hi);
      float ss = ssq16(lo) + ssq16(hi); ss += __shfl_xor(ss, 1);
      const float rs = rsqrtf(ss * (1.f / 64.f) + EPS);
      const float* g = p->g_k_d + l * 64 + 32 * (g4 & 1);
#pragma unroll
      for (int i = 0; i < 16; ++i) { lo[i] *= rs * g[i]; hi[i] *= rs * g[16 + i]; }
      if (lat) rope32c(lo, hi, cs32, (g4 & 1) ? gcol : grow);
      if (pt < 4) { st16(pr + 2048 + 32 * g4, lo); st16(pr + 2048 + 32 * g4 + 16, hi); }
    }
  }
}

DEVI void conv_load(const ConvT& c, int lane, f32x4 (&v)[8]) {
  const int kk = lane >> 3, n4 = (lane & 7) * 4;
  const float* sp = (c.src2 && n4 >= 16) ? c.src2 + (n4 - 16) : (c.src ? c.src + n4 : nullptr);
#pragma unroll
  for (int i = 0; i < 8; ++i) v[i] = sp ? *(const f32x4*)(sp + (size_t)(kk + 8 * i) * c.ld) : f32x4{0.f, 0.f, 0.f, 0.f};
}
DEVI void conv_store(const ConvT& c, LAS float* t, int lane, const f32x4 (&v)[8]) {
  const int kk = lane >> 3, n4 = (lane & 7) * 4;
#pragma unroll
  for (int i = 0; i < 8; ++i) {
    const int k = kk + 8 * i;
    const float s = (c.ks ? c.ks[k] : 1.f) * c.mul;
    t[(n4 + 0) * 65 + k] = v[i].x * s; t[(n4 + 1) * 65 + k] = v[i].y * s;
    t[(n4 + 2) * 65 + k] = v[i].z * s; t[(n4 + 3) * 65 + k] = v[i].w * s;
  }
  asm volatile("s_waitcnt lgkmcnt(0)" ::: "memory");
  const int n = lane >> 1, k0 = (lane & 1) * 32;
  const LAS float* r = t + n * 65 + k0;
  u16* d = c.dst + (size_t)n * c.ldd + k0;
#pragma unroll
  for (int q = 0; q < 4; ++q) {
    u32x4 o;
    o.x = pk2(r[8 * q], r[8 * q + 1]); o.y = pk2(r[8 * q + 2], r[8 * q + 3]); o.z = pk2(r[8 * q + 4], r[8 * q + 5]); o.w = pk2(r[8 * q + 6], r[8 * q + 7]);
    *(u32x4*)(d + 8 * q) = o;
  }
  asm volatile("s_waitcnt lgkmcnt(0)" ::: "memory");
}
constexpr int CONV_EARLY = 1152 + 64 + 64;
DEVI void conv_items2(KP p, int l, ldsp_t lds, int first_item, int total_items) {
  const int tid = TIDX, wave = __builtin_amdgcn_readfirstlane(tid >> 6), lane = tid & 63;
  LAS float* t = (LAS float*)(lds + wave * 8448);
  __syncthreads();
  const int stride = gridDim.x * NW;
  int item = first_item + BIDX * NW + wave;
  if (item >= total_items) return;
  ConvT c = conv_decode(p, l, item);
  f32x4 v[8];
  conv_load(c, lane, v);
  for (;;) {
    const int nitem = item + stride;
    const bool more = nitem < total_items;
    ConvT cn = c; f32x4 vn[8];
    if (more) { cn = conv_decode(p, l, nitem); conv_load(cn, lane, vn); }
    conv_store(c, t, lane, v);
    if (!more) break;
    c = cn; item = nitem;
#pragma unroll
    for (int i = 0; i < 8; ++i) v[i] = vn[i];
  }
}
template <int BR>
DEVI void attn_mask(f32x16 (&s)[2], int kt, int qlat, int qrow, int qcol, int hh, LAS float* rpb) {
  if (BR == 1) {
#pragma unroll
    for (int kb = 0; kb < 2; ++kb)
#pragma unroll
      for (int i = 0; i < 16; ++i) {
        const int kpos = kt * 64 + kb * 32 + (i & 3) + 8 * (i >> 2) + 4 * hh;
        const int d = qlat - kpos;
        if (d > 128 || d < -128) s[kb][i] = -1e30f;
      }
  } else {
    const int rs = min(max(qrow - 4, 0), 56);
    const bool row_ok = (kt >= rs) && (kt < rs + 8);
    const int cst = min(max(qcol - 8, 0), 48);
    const int dr = kt - qrow + 7;
#pragma unroll
    for (int kb = 0; kb < 2; ++kb)
#pragma unroll
      for (int i = 0; i < 16; ++i) {
        const int kc = kb * 32 + (i & 3) + 8 * (i >> 2) + 4 * hh;
        const bool ok = row_ok && (kc >= cst) && (kc < cst + 16);
        const int idx = ok ? (dr * 31 + (kc - qcol + 15)) : 0;
        const float bias = rpb[idx];
        s[kb][i] = ok ? (s[kb][i] + bias) : -1e30f;
      }
  }
}

typedef short v4i16_t __attribute__((ext_vector_type(4)));
DEVI bf16x8 vtr2(ldsp_t a) {
  const v4i16_t lo = __builtin_amdgcn_ds_read_tr16_b64_v4i16((LAS v4i16_t*)a);
  const v4i16_t hi = __builtin_amdgcn_ds_read_tr16_b64_v4i16((LAS v4i16_t*)(a + 8 * 144));
  return __builtin_shufflevector(lo, hi, 0, 1, 2, 3, 4, 5, 6, 7);
}
template <int BR>
DEVI void attn_item2(KP p, int l, int b, int hs, int qb, bool isctx, ldsp_t lds) {
  constexpr bool MLA = (BR == 0);
  constexpr bool GQA = (BR == 1 || BR == 3);
  constexpr int QBLK = GQA ? 256 : 512;
  constexpr int NKS = MLA ? 6 : 4;
  constexpr int STG = 9216 + 9216 + 5120;
  const int tid = TIDX, lane = tid & 63, wave = __builtin_amdgcn_readfirstlane(tid >> 6);
  const int r32 = lane & 31, hh = lane >> 5;
  const int hq = GQA ? (hs * 2 + (wave & 1)) : hs;
  const int woff = GQA ? 64 * (wave >> 1) : 64 * wave;
  const int q0 = (isctx ? 0 : NCTX) + qb * QBLK;
  const bool active = !isctx || (woff < NCTX);
  const size_t tokq = (size_t)b * TPB + q0 + (active ? woff : 0) + r32;
  const u16* Qp; const u16* Kp; int ldk; const u16* Vp; int ldv; int obase; int ldq;
  const u16* PR = wsp<u16>(p, OFF_PRAW);
  if (BR == 0) { Qp = wsp<u16>(p, OFF_QARAW) + tokq * 512 + hq * 96; ldq = 512; Kp = wsp<u16>(p, OFF_KVARAW) + (size_t)b * TPB * 512 + hs * 128; ldk = 512; Vp = wsp<u16>(p, OFF_KVARAW) + (size_t)b * TPB * 512 + hs * 128 + 64; ldv = 512; obase = hq * 64; }
  else if (BR == 1) { Qp = PR + tokq * PLD + 512 + hq * 64; ldq = PLD; Kp = PR + (size_t)b * TPB * PLD + 768 + hs * 64; ldk = PLD; Vp = PR + (size_t)b * TPB * PLD + 896 + hs * 64; ldv = PLD; obase = 256 + hq * 64; }
  else if (BR == 2) { Qp = PR + tokq * PLD + 1024 + hq * 64; ldq = PLD; Kp = PR + (size_t)b * TPB * PLD + 1280 + hs * 64; ldk = PLD; Vp = PR + (size_t)b * TPB * PLD + 1536 + hs * 64; ldv = PLD; obase = 512 + hq * 64; }
  else { Qp = PR + tokq * PLD + 1792 + hq * 64; ldq = PLD; Kp = PR + (size_t)b * TPB * PLD + 2048 + hs * 64; ldk = PLD; Vp = PR + (size_t)b * TPB * PLD + 2176 + hs * 64; ldv = PLD; obase = 768 + hq * 64; }
  const u16* KRp = PR + (size_t)b * TPB * PLD + 384;
  int lat_lo = 0, lat_n = 0, wlo = 0, whi = 63;
  if (!isctx) {
    if (BR == 0 || BR == 3) { lat_lo = 0; lat_n = 64; }
    else if (BR == 1) {
      const int ql = qb * QBLK; const int lo = max(0, ql - 128) >> 6, hi = min(SEQ - 1, ql + QBLK - 1 + 128) >> 6; lat_lo = lo; lat_n = hi - lo + 1;
      const int wq = ql + woff; wlo = max(0, wq - 128) >> 6; whi = min(SEQ - 1, wq + 63 + 128) >> 6;
    } else {
      const int r0 = 8 * qb; const int lo = min(max(r0 - 4, 0), 56), hi = min(max(r0 + 7 - 4, 0), 56) + 7; lat_lo = lo; lat_n = hi - lo + 1;
      const int wr_ = r0 + wave; wlo = min(max(wr_ - 4, 0), 56); whi = wlo + 7;
    }
  }
  const int NT = 4 + lat_n;
  const int qlat0 = qb * QBLK + woff + r32;
  bf16x8 qf[2][NKS];
#pragma unroll
  for (int qi = 0; qi < 2; ++qi)
#pragma unroll
    for (int ks = 0; ks < NKS; ++ks) qf[qi][ks] = *(const bf16x8*)(Qp + (size_t)qi * 32 * ldq + ks * 16 + hh * 8);
  const int srow = tid >> 3, sc8 = (tid & 7) * 8;
  const int krow_ = (tid & 255) >> 2, kc8 = (tid & 3) * 8;
  const bool krt = tid < 256;
  u32x4 rk0, rv0, rr0, rk1, rv1, rr1;
  auto keytile = [&](int j) { return (j < 4) ? j : (4 + lat_lo + (j - 4)); };
#define A_GLOAD(j, rk, rv, rr) do { const int key0_ = keytile(j) * 64; \
    rk = *(const u32x4*)(Kp + (size_t)(key0_ + srow) * ldk + sc8); \
    rv = *(const u32x4*)(Vp + (size_t)(key0_ + srow) * ldv + sc8); \
    if (MLA && krt) rr = *(const u32x4*)(KRp + (size_t)(key0_ + krow_) * PLD + kc8); } while (0)
#define A_LWRITE(st, rk, rv, rr) do { ldsp_t base_ = lds + (st) * STG; \
    *(LAS u32x4*)(base_ + srow * 144 + sc8 * 2) = rk; \
    *(LAS u32x4*)(base_ + 9216 + srow * 144 + sc8 * 2) = rv; \
    if (MLA && krt) *(LAS u32x4*)(base_ + 18432 + krow_ * 80 + kc8 * 2) = rr; } while (0)
  LAS float* rpb = (LAS float*)(lds + 2 * STG);
  A_GLOAD(0, rk0, rv0, rr0);
  if (NT > 1) A_GLOAD(1, rk1, rv1, rr1);
  __syncthreads();
  if (BR == 2 && !isctx) {
    const float* src = p->rpb_c + (size_t)(l * 4 + hs) * 465;
    for (int i = tid; i < 465; i += 512) rpb[i] = src[i] * LOG2E;
  }
  A_LWRITE(0, rk0, rv0, rr0);
  __syncthreads();
  f32x16 o[2][2];
#pragma unroll
  for (int qi = 0; qi < 2; ++qi)
#pragma unroll
    for (int i = 0; i < 16; ++i) { o[qi][0][i] = 0.f; o[qi][1][i] = 0.f; }
  float m_run[2], l_run[2];
#pragma unroll
  for (int qi = 0; qi < 2; ++qi) { m_run[qi] = -INFINITY; l_run[qi] = 0.f; }
  if (BR == 1) { const float sk = p->sink_b[l * 4 + hq] * LOG2E; m_run[0] = sk; m_run[1] = sk; l_run[0] = (hh == 0) ? 1.f : 0.f; l_run[1] = l_run[0]; }
  const ldsp_t kfb = lds + r32 * 144 + hh * 16;
  const ldsp_t vfb = lds + 9216 + (4 * hh + ((lane & 15) >> 2)) * 144 + (16 * ((lane >> 4) & 1) + 4 * (lane & 3)) * 2;
  const ldsp_t krb = lds + 18432 + r32 * 80 + hh * 16;
#define A_STEP(j, rkA, rvA, rrA, rkB, rvB, rrB) do { \
    const int st = ((j) & 1) * STG; \
    if ((j) + 2 < NT) A_GLOAD((j) + 2, rkA, rvA, rrA); \
    const int kt_ = lat_lo + (j) - 4; \
    const bool need = active && ((j) < 4 || (kt_ >= wlo && kt_ <= whi)); \
    if (need) { \
      f32x16 s[2][2]; \
      _Pragma("unroll") for (int kb = 0; kb < 2; ++kb) { \
        _Pragma("unroll") for (int ks = 0; ks < 4; ++ks) { const bf16x8 kf = *(const LAS bf16x8*)(kfb + st + kb * 32 * 144 + ks * 32); \
          _Pragma("unroll") for (int qi = 0; qi < 2; ++qi) { if (ks == 0) { _Pragma("unroll") for (int i = 0; i < 16; ++i) s[qi][kb][i] = 0.f; } s[qi][kb] = MFMA(kf, qf[qi][ks], s[qi][kb]); } } \
        if (MLA) { _Pragma("unroll") for (int ks = 0; ks < 2; ++ks) { const bf16x8 kf = *(const LAS bf16x8*)(krb + st + kb * 32 * 80 + ks * 32); \
          _Pragma("unroll") for (int qi = 0; qi < 2; ++qi) s[qi][kb] = MFMA(kf, qf[qi][NKS - 2 + ks], s[qi][kb]); } } \
      } \
      _Pragma("unroll") for (int qi = 0; qi < 2; ++qi) { \
        if ((BR == 1 || BR == 2) && (j) >= 4) { const int ql_ = qlat0 + 32 * qi; attn_mask<BR>(s[qi], kt_, ql_, ql_ >> 6, ql_ & 63, hh, rpb); } \
        float mx = s[qi][0][0]; \
        _Pragma("unroll") for (int i = 1; i < 16; ++i) mx = fmaxf(mx, s[qi][0][i]); \
        _Pragma("unroll") for (int i = 0; i < 16; ++i) mx = fmaxf(mx, s[qi][1][i]); \
        mx = fmaxf(mx, __shfl_xor(mx, 32)); \
        const float m_new = fmaxf(m_run[qi], mx); \
        const float alpha = __builtin_amdgcn_exp2f(m_run[qi] - m_new); \
        m_run[qi] = m_new; \
        float ls0 = 0.f, ls1 = 0.f; \
        _Pragma("unroll") for (int i = 0; i < 16; ++i) { \
          const float e0 = __builtin_amdgcn_exp2f(s[qi][0][i] - m_new), e1 = __builtin_amdgcn_exp2f(s[qi][1][i] - m_new); \
          s[qi][0][i] = e0; s[qi][1][i] = e1; ls0 += e0; ls1 += e1; } \
        l_run[qi] = l_run[qi] * alpha + (ls0 + ls1); \
        if (__any(alpha != 1.f)) { _Pragma("unroll") for (int i = 0; i < 16; ++i) { o[qi][0][i] *= alpha; o[qi][1][i] *= alpha; } } \
      } \
      _Pragma("unroll") for (int s4 = 0; s4 < 4; ++s4) { \
        const int kb = s4 >> 1, rb = (s4 & 1) * 8; \
        bf16x8 pf[2]; \
        _Pragma("unroll") for (int qi = 0; qi < 2; ++qi) { u32x4 pw; \
          pw.x = pk2(s[qi][kb][rb + 0], s[qi][kb][rb + 1]); pw.y = pk2(s[qi][kb][rb + 2], s[qi][kb][rb + 3]); \
          pw.z = pk2(s[qi][kb][rb + 4], s[qi][kb][rb + 5]); pw.w = pk2(s[qi][kb][rb + 6], s[qi][kb][rb + 7]); \
          pf[qi] = __builtin_bit_cast(bf16x8, pw); } \
        _Pragma("unroll") for (int db = 0; db < 2; ++db) { const bf16x8 vf = vtr2(vfb + st + s4 * 16 * 144 + db * 64); \
          o[0][db] = MFMA(vf, pf[0], o[0][db]); o[1][db] = MFMA(vf, pf[1], o[1][db]); } \
      } \
    } \
    if ((j) + 1 < NT) A_LWRITE(((j) + 1) & 1, rkB, rvB, rrB); \
    __syncthreads(); \
  } while (0)
  for (int j = 0; j < NT; j += 2) {
    A_STEP(j, rk0, rv0, rr0, rk1, rv1, rr1);
    if (j + 1 < NT) A_STEP(j + 1, rk1, rv1, rr1, rk0, rv0, rr0);
  }
#undef A_STEP
#undef A_GLOAD
#undef A_LWRITE
  if (active) {
#pragma unroll
    for (int qi = 0; qi < 2; ++qi) {
      const float lt = l_run[qi] + __shfl_xor(l_run[qi], 32);
      const float inv = 1.f / lt;
      u16* Op = wsp<u16>(p, OFF_O) + (tokq + 32 * qi) * 1024 + obase;
#pragma unroll
      for (int db = 0; db < 2; ++db)
#pragma unroll
        for (int g = 0; g < 4; ++g) {
          u32x2 w;
          w.x = pk2(o[qi][db][4 * g] * inv, o[qi][db][4 * g + 1] * inv);
          w.y = pk2(o[qi][db][4 * g + 2] * inv, o[qi][db][4 * g + 3] * inv);
          *(u32x2*)(Op + db * 32 + 8 * g + 4 * hh) = w;
        }
    }
  }
}
DEVI void phaseD2(KP p, int l, ldsp_t lds) {
  const int G8 = gridDim.x >> 3, xcd = BIDX & 7, lb = BIDX >> 3;
  if (lb >= G8) return;
  const int NLOC = 128 + (l == 0 ? 12 : 0);
  const int nmine = (NLOC - lb + G8 - 1) / G8;
  const int cslot = min((int)(BIDX & 3), nmine - 1);
  int it = 0;
  for (int n = lb; n < NLOC; n += G8, ++it) {
    if (it == cslot) conv_items2(p, l, lds, CONV_EARLY, CONV_ITEMS);
    int br, s, qb; bool isctx = false;
    if (n < 32) { br = 0; s = xcd + 8 * (n >> 3); qb = n & 7; }
    else if (n < 64) { const int m = n - 32; br = 3; s = xcd + 8 * (m >> 4); qb = m & 15; }
    else if (n < 96) { const int m = n - 64; br = 2; s = xcd + 8 * (m >> 3); qb = m & 7; }
    else if (n < 128) { const int m = n - 96; br = 1; s = xcd + 8 * (m >> 4); qb = m & 15; }
    else {
      const int m = n - 128; isctx = true; qb = 0;
      if (m < 4) { br = 0; s = xcd + 8 * m; }
      else if (m < 6) { br = 3; s = xcd + 8 * (m - 4); }
      else if (m < 10) { br = 2; s = xcd + 8 * (m - 6); }
      else { br = 1; s = xcd + 8 * (m - 10); }
    }
    if (br == 0) attn_item2<0>(p, l, s >> 2, s & 3, qb, isctx, lds);
    else if (br == 1) attn_item2<1>(p, l, s >> 1, s & 1, qb, isctx, lds);
    else if (br == 2) attn_item2<2>(p, l, s >> 2, s & 3, qb, isctx, lds);
    else attn_item2<3>(p, l, s >> 1, s & 1, qb, isctx, lds);
  }
}

DEVI int pm_map(int pme, bool skipctx) { return skipctx ? (pme >> 4) * 17 + 1 + (pme & 15) : pme; }
struct SchedE1 { const char* ws; bool skipctx; int G, c;
  DEVI bool next(int i, Unit& u) const { int pm, pn; if (!tile_order(i, G, c, skipctx ? 128 : 136, 16, pm, pn)) return false;
    pm = pm_map(pm, skipctx); const int n = pn >> 2, cq = pn & 3;
    u.A = ws + OFF_O + uoff((unsigned)pm * 256u * 2048u + (unsigned)n * 512u); u.B = ws + OFF_WBR + uoff(((unsigned)n * 1024u + (unsigned)cq * 256u) * 512u); u.rows = nullptr; u.nvalid = 0;
    u.u0 = pm * 256; u.u1 = pn * 256; u.u2 = 0; u.u3 = 0; return true; } };
DEVI void phaseE1(KP p, int l, ldsp_t lds) {
  if (BIDX == 0 && TIDX < 32) wsp<int>(p, OFF_CNT)[TIDX * CNT_STRIDE] = 0;
  SchedE1 S{(const char*)p->ws, l == 1, (int)gridDim.x, BIDX};
  EpiRawBf16 E{wsp<u16>(p, OFF_Z), 4096};
  gemm_phase<true, false>(lds, 2048, 512, 4, S, E);
}
struct SchedE2 { const char* ws; bool skipctx; int G, c;
  DEVI bool next(int i, Unit& u) const { int pm, pn; if (!tile_order(i >> 1, G, c, skipctx ? 128 : 136, 8, pm, pn)) return false;
    pm = pm_map(pm, skipctx); const int pr = i & 1;
    u.A = ws + OFF_H + uoff((unsigned)pm * 256u * 2048u); u.B = ws + OFF_WGATE + uoff((unsigned)(pr * 8 + pn) * 256u * 2048u); u.rows = nullptr; u.nvalid = 0;
    u.u0 = pm * 256; u.u1 = pn * 128; u.u2 = pr; u.u3 = 0; return true; } };
struct EpiE2 { const u16* Z; u16* Y; const float* bias;
  DEVI void init(f32x4 (&acc)[2][2][4][2], const Unit& u, int wr, int wc, int fr, int fq) const {
    const int col0 = u.u1 + wc * 32 + 8 * fq;
#pragma unroll
    for (int bj = 0; bj < 2; ++bj)
#pragma unroll
      for (int nn = 0; nn < 2; ++nn) {
        const f32x4 b = *(const f32x4*)(bias + (2 * u.u2 + bj) * 1024 + col0 + 4 * nn);
#pragma unroll
        for (int a = 0; a < 2; ++a)
#pragma unroll
          for (int m = 0; m < 4; ++m) acc[a][bj][m][nn] = b;
      }
  }
  DEVI void operator()(const f32x4 (&acc)[2][2][4][2], const Unit& u, int wr, int wc, int fr, int fq) const {
    const int row0 = u.u0 + wr * 64 + fr, col0 = u.u1 + wc * 32 + 8 * fq, pr = u.u2;
    u32x4 zq[3][2], yq[3];
    auto ldrow = [&](int g, u32x4 (&z)[2], u32x4& y) {
      const size_t r = (size_t)(row0 + (g >> 2) * HALF + (g & 3) * 16);
#pragma unroll
      for (int bj = 0; bj < 2; ++bj) z[bj] = *(const u32x4*)(Z + r * 4096 + (2 * pr + bj) * 1024 + col0);
      y = pr ? *(const u32x4*)(Y + r * 1024 + col0) : u32x4{0u, 0u, 0u, 0u};
    };
    ldrow(0, zq[0], yq[0]);
    ldrow(1, zq[1], yq[1]);
#pragma unroll
    for (int g = 0; g < 8; ++g) {
      const int ai = g >> 2, m = g & 3, c = g % 3;
      if (g + 2 < 8) ldrow(g + 2, zq[(g + 2) % 3], yq[(g + 2) % 3]);
      const size_t r = (size_t)(row0 + ai * HALF + m * 16);
      float t[8];
      {
        const unsigned w[4] = {yq[c].x, yq[c].y, yq[c].z, yq[c].w};
#pragma unroll
        for (int i = 0; i < 4; ++i) { t[2 * i] = __uint_as_float(w[i] << 16); t[2 * i + 1] = __uint_as_float(w[i] & 0xffff0000u); }
      }
#pragma unroll
      for (int bj = 0; bj < 2; ++bj) {
        const unsigned w[4] = {zq[c][bj].x, zq[c][bj].y, zq[c][bj].z, zq[c][bj].w};
#pragma unroll
        for (int nn = 0; nn < 2; ++nn)
#pragma unroll
          for (int j = 0; j < 4; ++j) {
            const int e = 4 * nn + j;
            const float zz = (e & 1) ? __uint_as_float(w[e >> 1] & 0xffff0000u) : __uint_as_float(w[e >> 1] << 16);
            const float gte = __builtin_amdgcn_rcpf(1.f + __expf(-acc[ai][bj][m][nn][j]));
            t[e] += gte * zz;
          }
      }
      u32x4 o; o.x = pk2(t[0], t[1]); o.y = pk2(t[2], t[3]); o.z = pk2(t[4], t[5]); o.w = pk2(t[6], t[7]);
      *(u32x4*)(Y + r * 1024 + col0) = o;
    }
  }
};
DEVI void phaseE2(KP p, int l, ldsp_t lds) {
  SchedE2 S{(const char*)p->ws, l == 1, (int)gridDim.x, BIDX};
  EpiE2 E{wsp<u16>(p, OFF_Z), wsp<u16>(p, OFF_YPRE), p->b_gate + (size_t)l * 4 * 1024};
  gemm_phase<true, false>(lds, 2048, 2048, 16, S, E);
}
struct SchedF { const char* ws; bool skipctx; int G, c;
  DEVI bool next(int i, Unit& u) const { int pm, pn; if (!tile_order(i, G, c, skipctx ? 128 : 136, 4, pm, pn)) return false;
    pm = pm_map(pm, skipctx);
    u.A = ws + OFF_YPRE + uoff((unsigned)pm * 256u * 2048u); u.B = ws + OFF_WOUT + uoff((unsigned)pn * 256u * 2048u); u.rows = nullptr; u.nvalid = 0;
    u.u0 = pm; u.u1 = pn * 256; u.u2 = 0; u.u3 = 0; return true; } };
struct EpiF { KP p; int l;
  DEVI void init(f32x4 (&acc)[2][2][4][2], const Unit&, int, int, int, int) const { acc_zero(acc); }
  DEVI void operator()(const f32x4 (&acc)[2][2][4][2], const Unit& u, int wr, int wc, int fr, int fq) const {
    const int pm = u.u0, b = pm / 17, rr0 = (pm % 17) * 256;
    const int mrow = (rr0 < NCTX) ? 8 : b;
    const int col0 = u.u1 + wc * 32 + 4 * fq;
    const float* gt = wsp<float>(p, OFF_MOD) + ((size_t)l * 9 + mrow) * 6144 + 2048 + col0;
    const float* xin = xrow_in(p, l, b, rr0) + col0;
    float* xout = xrow_res(p, b, rr0) + col0;
    f32x4 gv[2][2];
#pragma unroll
    for (int bj = 0; bj < 2; ++bj)
#pragma unroll
      for (int n = 0; n < 2; ++n) gv[bj][n] = *(const f32x4*)(gt + bj * HALF + n * 16);
#pragma unroll
    for (int ai = 0; ai < 2; ++ai)
#pragma unroll
      for (int mp = 0; mp < 2; ++mp) {
        f32x4 xo[2][2][2];
#pragma unroll
        for (int mm = 0; mm < 2; ++mm) {
          const size_t ro = (size_t)(wr * 64 + fr + ai * HALF + (2 * mp + mm) * 16) * 1024;
#pragma unroll
          for (int bj = 0; bj < 2; ++bj)
#pragma unroll
            for (int n = 0; n < 2; ++n) xo[mm][bj][n] = *(const f32x4*)(xin + ro + bj * HALF + n * 16);
        }
#pragma unroll
        for (int mm = 0; mm < 2; ++mm) {
          const int m = 2 * mp + mm;
          const size_t ro = (size_t)(wr * 64 + fr + ai * HALF + m * 16) * 1024;
#pragma unroll
          for (int bj = 0; bj < 2; ++bj)
#pragma unroll
            for (int n = 0; n < 2; ++n) *(f32x4*)(xout + ro + bj * HALF + n * 16) = xo[mm][bj][n] + gv[bj][n] * acc[ai][bj][m][n];
        }
      }
  }
};
DEVI void phaseF2(KP p, int l, ldsp_t lds) {
  SchedF S{(const char*)p->ws, l == 1, (int)gridDim.x, BIDX};
  EpiF E{p, l};
  gemm_phase<false, false>(lds, 2048, 2048, 16, S, E);
}


DEVI void phase0_2(KP p, ldsp_t lds) {
  const int tid = TIDX, half = tid >> 8, htid = tid & 255;
  for (int it = BIDX * 2; it < 458; it += gridDim.x * 2) {
    const int item = it + half;
    LAS float* sc = (LAS float*)(lds + half * 16384);
    const bool ismod = item < 384;
    const int l = item / 192, rem = item % 192, cgp = rem >> 3, kc = rem & 7;
    __syncthreads();
    if (ismod) {
      for (int i = htid; i < 9 * 128; i += 256) {
        int b = i >> 7, k = i & 127;
        float v = (b < 8) ? p->c[b * 1024 + kc * 128 + k] : p->c_ctx[kc * 128 + k];
        sc[i] = v / (1.f + __expf(-v));
      }
    }
    __syncthreads();
    if (ismod) {
      float acc[9];
#pragma unroll
      for (int b = 0; b < 9; ++b) acc[b] = 0.f;
      const float* w = p->w_mod + ((size_t)l * 1024 + kc * 128) * 6144 + cgp * 256 + htid;
#pragma unroll 32
      for (int k = 0; k < 128; ++k) {
        float wv = w[(size_t)k * 6144];
#pragma unroll
        for (int b = 0; b < 9; ++b) acc[b] += sc[b * 128 + k] * wv;
      }
      float* dst = wsp<float>(p, OFF_MODP) + (size_t)((kc * 2 + l) * 9) * 6144 + cgp * 256 + htid;
#pragma unroll
      for (int b = 0; b < 9; ++b) dst[(size_t)b * 6144] = acc[b];
    } else if (item == 384) {
      float* cs32 = wsp<float>(p, OFF_CS32);
      float* cs16 = wsp<float>(p, OFF_CS16);
      for (int t = htid; t < 1024; t += 256) {
        int pos = t >> 4, i = t & 15;
        float ang = (float)pos * __builtin_amdgcn_exp2f(-(float)(2 * i) * (13.287712379549449f / 32.f));
        cs32[t * 2] = __cosf(ang); cs32[t * 2 + 1] = __sinf(ang);
      }
      for (int t = htid; t < 512; t += 256) {
        int pos = t >> 3, i = t & 7;
        float ang = (float)pos * __builtin_amdgcn_exp2f(-(float)(2 * i) * (13.287712379549449f / 16.f));
        cs16[t * 2] = __cosf(ang); cs16[t * 2 + 1] = __sinf(ang);
      }
    } else if (item < 457) {
      const int q = item - 385, ll = q / 36, o = q % 36;
      float* dst = wsp<float>(p, OFF_WRT) + ((size_t)ll * 36 + o) * 1024;
      for (int k = htid; k < 1024; k += 256)
        dst[k] = (o < 4) ? p->w_group[((size_t)ll * 1024 + k) * 4 + o] : p->w_router[((size_t)ll * 1024 + k) * 32 + (o - 4)];
    }
  }
}
DEVI void phase1_2(KP p) {
  const float* mp = wsp<float>(p, OFF_MODP);
  float* mo = wsp<float>(p, OFF_MOD);
  for (int i = BIDX * 512 + TIDX; i < 2 * 9 * 6144; i += gridDim.x * 512) {
    int l = i / (9 * 6144), o = i % 6144;
    float s = p->b_mod[l * 6144 + o];
#pragma unroll
    for (int kc = 0; kc < 8; ++kc) s += mp[(size_t)kc * 2 * 9 * 6144 + i];
    mo[i] = s;
  }
}
DEVI void phaseA2(KP p) {
  const int gw = BIDX * NW + (TIDX >> 6), nw = gridDim.x * NW;
  u16* H = wsp<u16>(p, OFF_H);
  for (int tok0 = gw; tok0 < NTOK; tok0 += 2 * nw) {
    float xv[2][16];
#pragma unroll
    for (int r = 0; r < 2; ++r) { const int tok = tok0 + r * nw; if (tok < NTOK) load_row16(xrow_in(p, 0, tok / TPB, tok % TPB), xv[r]); }
#pragma unroll
    for (int r = 0; r < 2; ++r) {
      const int tok = tok0 + r * nw;
      if (tok < NTOK) { float hv[16]; modulate_row_store(p, 0, 0, xv[r], (tok % TPB) < NCTX ? 8 : tok / TPB, H + (size_t)tok * 1024, hv); }
    }
  }
}
DEVI void phaseG2(KP p, int l, ldsp_t lds) {
  constexpr int HS = 1026;
  const int tid = TIDX, lane = tid & 63, wave = __builtin_amdgcn_readfirstlane(tid >> 6);
  const int r32 = lane & 31, kh = lane >> 5, qd = lane >> 4;
  u16* H = wsp<u16>(p, OFF_H);
  const float* WRT = wsp<float>(p, OFF_WRT) + (size_t)l * 36 * 1024;
  int* cnt = wsp<int>(p, OFF_CNT);
  int* list = wsp<int>(p, OFF_LIST);
  float* wlist = wsp<float>(p, OFF_WLIST);
  LAS float* h2t = (LAS float*)lds;
  LAS float* part = (LAS float*)lds;
  LAS int* gsel = (LAS int*)(lds + 32 * HS * 4);
  LAS float* gwt = (LAS float*)(lds + 32 * HS * 4 + 128);
  float wreg[64];
  {
    const float* wr = p->w_router + (size_t)l * 1024 * 32 + r32;
#pragma unroll
    for (int t = 0; t < 32; ++t) {
      const int k = 128 * wave + 4 * t + 2 * kh;
      wreg[2 * t] = wr[(size_t)k * 32]; wreg[2 * t + 1] = wr[(size_t)(k + 1) * 32];
    }
  }
  for (int tile = BIDX; tile < NTOK / 32; tile += gridDim.x) {
    const int tok0 = tile * 32, b = tok0 / TPB, rr0 = tok0 % TPB;
    if (l == 1 && rr0 < NCTX) continue;
    {
      float hv[4][16], xv4[4][16];
#pragma unroll
      for (int r = 0; r < 4; ++r) load_row16(xrow_res(p, b, rr0 + wave * 4 + r), xv4[r]);
#pragma unroll
      for (int r = 0; r < 4; ++r) {
        modulate_row_store(p, l, 1, xv4[r], (rr0 < NCTX) ? 8 : b, H + (size_t)(tok0 + wave * 4 + r) * 1024, hv[r]);
        LAS float* dst = h2t + (wave * 4 + r) * HS + lane * 4;
#pragma unroll
        for (int i = 0; i < 4; ++i) {
          *(LAS f32x2*)(dst + i * 256) = f32x2{hv[r][i * 4], hv[r][i * 4 + 1]};
          *(LAS f32x2*)(dst + i * 256 + 2) = f32x2{hv[r][i * 4 + 2], hv[r][i * 4 + 3]};
        }
      }
      float gl[4];
#pragma unroll
      for (int o = 0; o < 4; ++o) gl[o] = router_dot(hv, WRT + (size_t)o * 1024) + p->b_group[l * 4 + o];
      int gs = 0; float best = gl[0];
#pragma unroll
      for (int j = 1; j < 4; ++j) if (gl[j] > best) { best = gl[j]; gs = j; }
      float gsum = 0.f;
#pragma unroll
      for (int j = 0; j < 4; ++j) gsum += __expf(gl[j] - best);
      if ((lane & 15) == 0) { gsel[wave * 4 + qd] = gs; gwt[wave * 4 + qd] = 1.f / gsum; }
    }
    __syncthreads();
    f32x16 acc;
#pragma unroll
    for (int i = 0; i < 16; ++i) acc[i] = 0.f;
    {
      const LAS float* ap = h2t + r32 * HS + 128 * wave + 2 * kh;
#pragma unroll
      for (int t = 0; t < 32; ++t) {
        const f32x2 a = *(const LAS f32x2*)(ap + 4 * t);
        acc = __builtin_amdgcn_mfma_f32_32x32x2f32(a.x, wreg[2 * t], acc, 0, 0, 0);
        acc = __builtin_amdgcn_mfma_f32_32x32x2f32(a.y, wreg[2 * t + 1], acc, 0, 0, 0);
      }
    }
    __syncthreads();
#pragma unroll
    for (int i = 0; i < 16; ++i) part[(wave * 32 + (i & 3) + 8 * (i >> 2) + 4 * kh) * 33 + r32] = acc[i];
    __syncthreads();
    if (tid < 32) {
      const int gs = gsel[tid];
      const float gw_ = gwt[tid];
      float e8[8];
#pragma unroll
      for (int j = 0; j < 8; ++j) {
        float v = p->b_router[l * 32 + gs * 8 + j];
#pragma unroll
        for (int w = 0; w < 8; ++w) v += part[(w * 32 + tid) * 33 + gs * 8 + j];
        e8[j] = v;
      }
      int i0 = 0; float v0 = e8[0];
#pragma unroll
      for (int j = 1; j < 8; ++j) if (e8[j] > v0) { v0 = e8[j]; i0 = j; }
      int i1 = -1; float v1 = -INFINITY;
#pragma unroll
      for (int j = 0; j < 8; ++j) if (j != i0 && e8[j] > v1) { v1 = e8[j]; i1 = j; }
      const float ex = __expf(v1 - v0);
      const float w0 = gw_ / (1.f + ex), w1 = gw_ * ex / (1.f + ex);
      const int tok = tok0 + tid;
      const int ea = gs * 8 + i0, eb = gs * 8 + i1;
      const int sa = atomicAdd(&cnt[ea * CNT_STRIDE], 1);
      const int sb = atomicAdd(&cnt[eb * CNT_STRIDE], 1);
      list[(size_t)ea * NTOK + sa] = tok * 2; wlist[(size_t)ea * NTOK + sa] = w0;
      list[(size_t)eb * NTOK + sb] = tok * 2 + 1; wlist[(size_t)eb * NTOK + sb] = w1;
    }
    __syncthreads();
  }
}
struct ExpInfo2 { int tiles[4], base[4], cnt[4]; };
DEVI ExpInfo2 exp_info2(KP p, int xcd) {
  const int* cnt = wsp<int>(p, OFF_CNT);
  ExpInfo2 ei;
  int before = 0;
#pragma unroll
  for (int e = 0; e < 32; ++e) {
    const int c = __builtin_amdgcn_readfirstlane(cnt[e * CNT_STRIDE]), t = (c + 255) >> 8;
    if ((e & 7) == xcd) { ei.tiles[e >> 3] = t; ei.base[e >> 3] = before; ei.cnt[e >> 3] = c; }
    before += t;
  }
  return ei;
}
template <int NN>
struct SchedX { ExpInfo2 ei; int xcd, lb, G8; const char* A; const char* W; const int* list; size_t wstride; int lda_b;
  DEVI bool next(int i, Unit& u) const {
    const int tot = (ei.tiles[0] + ei.tiles[1] + ei.tiles[2] + ei.tiles[3]) * NN;
    const int n = i * G8 + lb; if (n >= tot) return false;
    int k = 0, m = n / NN; const int pn = n % NN;
    int tb = ei.base[0], ce = ei.cnt[0];
#pragma unroll
    for (int kk = 0; kk < 3; ++kk) { if (k == kk && m >= ei.tiles[kk]) { m -= ei.tiles[kk]; k = kk + 1; tb = ei.base[kk + 1]; ce = ei.cnt[kk + 1]; } }
    const int e = xcd + 8 * k;
    u.rows = list + (size_t)e * NTOK + m * 256; u.nvalid = ce - m * 256;
    u.A = A + (NN == 2 ? 0u : uoff((unsigned)(tb + m) * 256u * (unsigned)lda_b));
    u.B = W + uoff((unsigned)e * (unsigned)wstride + (unsigned)pn * 256u * (NN == 2 ? 2048u : 512u));
    u.u0 = (tb + m) * 256; u.u1 = pn; u.u2 = e; u.u3 = m; return true; } };
struct EpiI1 { u16* U;
  DEVI void init(f32x4 (&acc)[2][2][4][2], const Unit&, int, int, int, int) const { acc_zero(acc); }
  DEVI void operator()(const f32x4 (&acc)[2][2][4][2], const Unit& u, int wr, int wc, int fr, int fq) const {
#pragma unroll
    for (int ai = 0; ai < 2; ++ai)
#pragma unroll
      for (int m = 0; m < 4; ++m) {
        u16* rowp = U + (size_t)(u.u0 + ai * HALF + wr * 64 + m * 16 + fr) * 256;
#pragma unroll
        for (int bj = 0; bj < 2; ++bj) {
          const int ff = 16 * (8 * u.u1 + 4 * bj + wc) + 4 * fq;
          const f32x4 g = acc[ai][bj][m][0], up = acc[ai][bj][m][1];
          float t[4];
#pragma unroll
          for (int j = 0; j < 4; ++j) t[j] = g[j] / (1.f + __expf(-g[j])) * up[j];
          u32x2 o; o.x = pk2(t[0], t[1]); o.y = pk2(t[2], t[3]);
          *(u32x2*)(rowp + ff) = o;
        }
      }
  }
};
DEVI void phaseI1_2(KP p, ldsp_t lds) {
  const int xcd = BIDX & 7, lb = BIDX >> 3, G8 = gridDim.x >> 3;
  if (lb >= G8) return;
  SchedX<2> S{exp_info2(p, xcd), xcd, lb, G8, (const char*)wsp<u16>(p, OFF_H), (const char*)wsp<u16>(p, OFF_W13), wsp<int>(p, OFF_LIST), (size_t)512 * 2048, 2048};
  EpiI1 E{wsp<u16>(p, OFF_U)};
  int nt = 16; asm volatile("" : "+s"(nt));
  gemm_phase<false, true>(lds, 2048, 2048, nt, S, E);
}
struct EpiI2 { u16* YS; const float* wlist; const int* list;
  DEVI void init(f32x4 (&acc)[2][2][4][2], const Unit&, int, int, int, int) const { acc_zero(acc); }
  DEVI void operator()(const f32x4 (&acc)[2][2][4][2], const Unit& u, int wr, int wc, int fr, int fq) const {
    const unsigned colb = (unsigned)(u.u1 * 256 + wc * 32 + 8 * fq) * 2u;
    const float* we = wlist + (u.rows - list);
    unsigned dest[2][4]; float w[2][4];
#pragma unroll
    for (int ai = 0; ai < 2; ++ai)
#pragma unroll
      for (int m = 0; m < 4; ++m) {
        const int r = ai * HALF + wr * 64 + m * 16 + fr;
        dest[ai][m] = (r < u.nvalid) ? (unsigned)u.rows[r] : (unsigned)(2 * NTOK);
        w[ai][m] = we[r];
      }
#pragma unroll
    for (int ai = 0; ai < 2; ++ai)
#pragma unroll
      for (int m = 0; m < 4; ++m) {
        char* rowp = (char*)YS + (dest[ai][m] * 2048u + colb);
#pragma unroll
        for (int bj = 0; bj < 2; ++bj) {
          const f32x4 v0 = acc[ai][bj][m][0] * w[ai][m], v1 = acc[ai][bj][m][1] * w[ai][m];
          u32x4 o; o.x = pk2(v0[0], v0[1]); o.y = pk2(v0[2], v0[3]); o.z = pk2(v1[0], v1[1]); o.w = pk2(v1[2], v1[3]);
          *(u32x4*)(rowp + bj * 256) = o;
        }
      }
  }
};
DEVI void phaseI2_2(KP p, ldsp_t lds) {
  const int xcd = BIDX & 7, lb = BIDX >> 3, G8 = gridDim.x >> 3;
  if (lb >= G8) return;
  SchedX<4> S{exp_info2(p, xcd), xcd, lb, G8, (const char*)wsp<u16>(p, OFF_U), (const char*)wsp<u16>(p, OFF_W2), wsp<int>(p, OFF_LIST), (size_t)1024 * 512, 512};
  EpiI2 E{wsp<u16>(p, OFF_YS), wsp<float>(p, OFF_WLIST), wsp<int>(p, OFF_LIST)};
  int nt = 4; asm volatile("" : "+s"(nt));
  gemm_phase<true, false>(lds, 512, 512, nt, S, E);
}
DEVI void phaseJ2(KP p, int l, ldsp_t lds) {
  const int lane = TIDX & 63;
  const int gw = BIDX * NW + (TIDX >> 6), nw = gridDim.x * NW;
  const u16* YS = wsp<u16>(p, OFF_YS);
  u16* H = wsp<u16>(p, OFF_H);
  for (int tok0 = gw; tok0 < NTOK; tok0 += 2 * nw) {
    float xv[2][16]; u32x2 y0[2][4], y1[2][4]; bool ok[2]; int tk[2];
#pragma unroll
    for (int r = 0; r < 2; ++r) {
      const int tok = tok0 + r * nw;
      tk[r] = tok;
      ok[r] = (tok < NTOK) && !(l == 1 && (tok % TPB) < NCTX);
      if (ok[r]) {
        const int b = tok / TPB, rr = tok % TPB;
        load_row16(xrow_res(p, b, rr), xv[r]);
#pragma unroll
        for (int i = 0; i < 4; ++i) {
          const int c = i * 256 + lane * 4;
          y0[r][i] = *(const u32x2*)(YS + (size_t)(tok * 2) * 1024 + c);
          y1[r][i] = *(const u32x2*)(YS + (size_t)(tok * 2 + 1) * 1024 + c);
        }
      }
    }
#pragma unroll
    for (int r = 0; r < 2; ++r) {
      if (!ok[r]) continue;
      const int tok = tk[r];
      const int b = tok / TPB, rr = tok % TPB;
      const int mrow = (rr < NCTX) ? 8 : b;
      float* xr = xrow_res(p, b, rr);
      const float* gt = wsp<float>(p, OFF_MOD) + ((size_t)l * 9 + mrow) * 6144 + 5120;
#pragma unroll
      for (int i = 0; i < 4; ++i) {
        const int c = i * 256 + lane * 4;
        const f32x4 g = *(const f32x4*)(gt + c);
        xv[r][i * 4 + 0] += g.x * (bf2f((u16)(y0[r][i].x & 0xffff)) + bf2f((u16)(y1[r][i].x & 0xffff)));
        xv[r][i * 4 + 1] += g.y * (bf2f((u16)(y0[r][i].x >> 16)) + bf2f((u16)(y1[r][i].x >> 16)));
        xv[r][i * 4 + 2] += g.z * (bf2f((u16)(y0[r][i].y & 0xffff)) + bf2f((u16)(y1[r][i].y & 0xffff)));
        xv[r][i * 4 + 3] += g.w * (bf2f((u16)(y0[r][i].y >> 16)) + bf2f((u16)(y1[r][i].y >> 16)));
      }
      if (l == 0) {
#pragma unroll
        for (int i = 0; i < 4; ++i)
          *(f32x4*)(xr + i * 256 + lane * 4) = f32x4{xv[r][i * 4], xv[r][i * 4 + 1], xv[r][i * 4 + 2], xv[r][i * 4 + 3]};
        float hv[16];
        modulate_row_store(p, 1, 0, xv[r], mrow, H + (size_t)tok * 1024, hv);
      } else {
        float ss = 0.f;
#pragma unroll
        for (int i = 0; i < 16; ++i) ss += xv[r][i] * xv[r][i];
        ss = wave_sum(ss);
        const float rstd = rsqrtf(ss * (1.f / 1024.f) + EPS);
#pragma unroll
        for (int i = 0; i < 4; ++i) {
          const int c = i * 256 + lane * 4;
          const f32x4 g = *(const f32x4*)(p->g_final + c);
          *(f32x4*)(xr + c) = f32x4{xv[r][i * 4] * rstd * g.x, xv[r][i * 4 + 1] * rstd * g.y, xv[r][i * 4 + 2] * rstd * g.z, xv[r][i * 4 + 3] * rstd * g.w};
        }
      }
    }
  }
}

constexpr int N_PHASES = 3 + 2 * 11;
__global__ void __launch_bounds__(512, 2) fwd_v2(Params parg) {
  extern __shared__ __attribute__((aligned(16))) unsigned char dyn_lds[];
  const ldsp_t lds = (ldsp_t)dyn_lds;
  cg::grid_group grid = cg::this_grid();
  volatile LAS unsigned* xb_st = (volatile LAS unsigned*)(lds + LDS_BARW);
  if (TIDX < 4) xb_st[TIDX] = 0u;
  __syncthreads();
  if (parg.ph_end - parg.ph_begin > 1) xcd_barrier_post((unsigned*)(parg.ws + OFF_BAR));
  for (int ph = parg.ph_begin; ph < parg.ph_end; ++ph) {
    KP p = (KP)__builtin_amdgcn_kernarg_segment_ptr();
    asm volatile("" : "+s"(p));
    const int l = (ph >= 14) ? 1 : 0;
    const int k = (ph < 3) ? ph : 3 + (ph - 3) % 11;
    const int reps = (((PROBE_DUP >> k) & 1) && (!(PROBE_DUP & 0x10000) || l == 0)) ? 2 : 1;
    for (int rep = 0; rep < reps; ++rep) {
      if (rep) {
        xcd_barrier((unsigned*)(p->ws + OFF_BAR), xb_st);
        if (k == 10) { if (BIDX == 0 && TIDX < 32) wsp<int>(p, OFF_CNT)[TIDX * CNT_STRIDE] = 0; xcd_barrier((unsigned*)(p->ws + OFF_BAR), xb_st); }
      }
      switch (k) {
        case 0: phase0_2(p, lds); break;
        case 1: phase1_2(p); break;
        case 2: phaseA2(p); break;
        case 3: phaseB2(p, lds); break;
        case 4: phaseC2(p, lds); break;
        case 5: phaseP2(p, l, lds); break;
        case 6: phaseD2(p, l, lds); break;
        case 7: phaseE1(p, l, lds); break;
        case 8: phaseE2(p, l, lds); break;
        case 9: phaseF2(p, l, lds); break;
        case 10: phaseG2(p, l, lds); break;
        case 11: phaseI1_2(p, lds); break;
        case 12: phaseI2_2(p, lds); break;
        default: phaseJ2(p, l, lds); break;
      }
    }
    if (k == 0 || (k == 13 && l == 0)) conv_items2(p, k == 0 ? 0 : 1, lds, 0, CONV_EARLY);
    if (ph + 1 < parg.ph_end) {
      if (ph == parg.ph_begin) grid.sync();
      else xcd_barrier((unsigned*)(p->ws + OFF_BAR), xb_st);
    }
  }
}
}

extern "C" void kernel_launch(void* const* d_in, const int* in_sizes, int n_in, void* d_out, int out_size,
                              void* d_ws, size_t ws_size, hipStream_t stream) {
  static int grid2 = 0;
  if (!grid2) {
    int dev = 0, cus = 0, per_cu = 0;
    (void)hipGetDevice(&dev);
    (void)hipDeviceGetAttribute(&cus, hipDeviceAttributeMultiprocessorCount, dev);
    (void)hipFuncSetAttribute((const void*)v2::fwd_v2, hipFuncAttributeMaxDynamicSharedMemorySize, v2::LDS_TOTAL);
    (void)hipOccupancyMaxActiveBlocksPerMultiprocessor(&per_cu, v2::fwd_v2, 512, v2::LDS_TOTAL);
    if (per_cu < 1) { fprintf(stderr, "kernel does not fit on a CU\n"); per_cu = 1; }
    grid2 = cus & ~7;
  }
  if (ws_size < WS_NEEDED) { fprintf(stderr, "workspace too small: %zu < %zu\n", ws_size, (size_t)WS_NEEDED); return; }
  Params hp{};
  const float** f = (const float**)&hp;
  for (int i = 0; i < 29; ++i) f[i] = (const float*)d_in[i];
  hp.out = (float*)d_out;
  hp.ws = (char*)d_ws;
#if N_LAUNCH_MODE == 1
  for (int ph = 0; ph < v2::N_PHASES; ++ph) {
    hp.ph_begin = ph; hp.ph_end = ph + 1;
    void* args[] = {&hp};
    hipError_t e = hipLaunchCooperativeKernel((void*)v2::fwd_v2, dim3(grid2), dim3(512), args, v2::LDS_TOTAL, stream);
    if (e != hipSuccess) fprintf(stderr, "launch failed: %s\n", hipGetErrorString(e));
  }
#else
  hp.ph_begin = 0; hp.ph_end = v2::N_PHASES;
  (void)hipMemsetAsync((char*)d_ws + OFF_BAR, 0, (size_t)XCD_BAR_WORDS * 4, stream);
  void* args[] = {&hp};
  hipError_t e = hipLaunchCooperativeKernel((void*)v2::fwd_v2, dim3(grid2), dim3(512), args, v2::LDS_TOTAL, stream);
  if (e != hipSuccess) fprintf(stderr, "cooperative launch failed: %s (grid %d)\n", hipGetErrorString(e), grid2);
#endif
}
```

```cpp
#include <hip/hip_runtime.h>
#include <hip/hip_cooperative_groups.h>
#include <stdint.h>
#include <stdio.h>
namespace cg = cooperative_groups;

#ifndef N_LAUNCH_MODE
#define N_LAUNCH_MODE 0
#endif

#ifndef PROBE_DUP
#define PROBE_DUP 0
#endif
#define DEVI __device__ __forceinline__
typedef unsigned short u16;
typedef __attribute__((ext_vector_type(2))) float f32x2;
typedef __attribute__((ext_vector_type(2))) __bf16 bf16x2_t;
typedef __attribute__((ext_vector_type(8))) short bf16x8;
typedef __attribute__((ext_vector_type(16))) float f32x16;
typedef __attribute__((ext_vector_type(4))) unsigned u32x4;
typedef __attribute__((ext_vector_type(2))) unsigned u32x2;
typedef __attribute__((ext_vector_type(4))) float f32x4;
#define MFMA(a, b, c) __builtin_amdgcn_mfma_f32_32x32x16_bf16((a), (b), (c), 0, 0, 0)

constexpr int DMODEL = 1024, NBATCH = 8, SEQ = 4096, NCTX = 256;
constexpr int TPB = SEQ + NCTX;
constexpr int NTOK = NBATCH * TPB;
constexpr int MT_PER_B = TPB / 128;
constexpr int NEXP = 32;
constexpr int INP = 2304;
constexpr float EPS = 1e-6f;
constexpr float LOG2E = 1.4426950408889634f;
constexpr int SMEM_BYTES = 73728;
constexpr int UROWS = 2 * NTOK + NEXP * 256;

constexpr size_t al(size_t x) { return (x + 255) & ~(size_t)255; }
constexpr size_t OFF_WIN = 0;
constexpr size_t OFF_WQB = OFF_WIN + al((size_t)INP * 1024 * 2);
constexpr size_t OFF_WKVB = OFF_WQB + al((size_t)512 * 256 * 2);
constexpr size_t OFF_WGATE = OFF_WKVB + al((size_t)512 * 256 * 2);
constexpr size_t OFF_WBR = OFF_WGATE + al((size_t)4 * 1024 * 1024 * 2);
constexpr size_t OFF_WOUT = OFF_WBR + al((size_t)4 * 1024 * 256 * 2);
constexpr size_t OFF_W13 = OFF_WOUT + al((size_t)1024 * 1024 * 2);
constexpr size_t OFF_W2 = OFF_W13 + al((size_t)32 * 512 * 1024 * 2);
constexpr size_t OFF_MODP = OFF_W2 + al((size_t)32 * 1024 * 256 * 2);
constexpr size_t OFF_MOD = OFF_MODP + al((size_t)8 * 2 * 9 * 6144 * 4);
constexpr size_t OFF_CS32 = OFF_MOD + al((size_t)2 * 9 * 6144 * 4);
constexpr size_t OFF_CS16 = OFF_CS32 + al((size_t)64 * 16 * 2 * 4);
constexpr size_t OFF_WRT = OFF_CS16 + al((size_t)64 * 8 * 2 * 4);
constexpr size_t OFF_CNT = OFF_WRT + al((size_t)2 * 36 * 1024 * 4);
constexpr int CNT_STRIDE = 64;
constexpr size_t OFF_BAR = OFF_CNT + al(32 * CNT_STRIDE * 4);
constexpr int XCD_BAR_WORDS = 3456;
constexpr size_t OFF_CTXRES = OFF_BAR + al((size_t)XCD_BAR_WORDS * 4);
constexpr size_t OFF_H = OFF_CTXRES + al((size_t)8 * 256 * 1024 * 4);
constexpr size_t OFF_O = OFF_H + al((size_t)NTOK * 1024 * 2);
constexpr size_t OFF_SSQ = OFF_O + al((size_t)NTOK * 1024 * 2);
constexpr size_t OFF_LIST = OFF_SSQ + al((size_t)NTOK * 8 * 4);
constexpr size_t OFF_WLIST = OFF_LIST + al((size_t)32 * NTOK * 4);
constexpr size_t OFF_R1 = OFF_WLIST + al((size_t)32 * NTOK * 4);
constexpr int PLD = INP;
constexpr size_t OFF_PRAW = OFF_R1;
constexpr size_t OFF_QARAW = OFF_PRAW + (size_t)NTOK * INP * 2;
constexpr size_t OFF_KVARAW = OFF_QARAW + (size_t)NTOK * 512 * 2;
constexpr size_t OFF_VAT = OFF_KVARAW + (size_t)NTOK * 512 * 2;
constexpr size_t OFF_VBT = OFF_VAT + (size_t)NTOK * 256 * 2;
constexpr size_t OFF_VCT = OFF_VBT + (size_t)NTOK * 128 * 2;
constexpr size_t OFF_VDT = OFF_VCT + (size_t)NTOK * 256 * 2;
constexpr size_t OFF_END = OFF_VDT + (size_t)NTOK * 128 * 2;
constexpr size_t OFF_Z = OFF_R1;
constexpr size_t OFF_YPRE = OFF_O;
constexpr size_t OFF_U = OFF_R1;
constexpr size_t OFF_YS = OFF_R1 + al((size_t)UROWS * 256 * 2);
static_assert(OFF_Z + (size_t)NTOK * 4096 * 2 <= OFF_END, "alias overflow");
static_assert(OFF_YS + (size_t)(2 * NTOK + 1) * 1024 * 2 <= OFF_END, "alias overflow");
constexpr size_t WS_NEEDED = OFF_END;
static_assert(WS_NEEDED <= (size_t)536870912, "workspace budget (4 x largest tensor)");

struct Params {
  const float *x, *c, *ctx, *c_ctx, *w_mod, *b_mod, *g_norm_mix, *w_in, *g_q_a, *w_q_b, *g_kv_a, *w_kv_b,
      *sink_b, *rpb_c, *g_q_d, *g_k_d, *w_gate, *b_gate, *w_branch, *w_out, *g_norm_ffn, *w_group, *b_group,
      *w_router, *b_router, *w_ff1, *w_ff3, *w_ff2, *g_final;
  float* out;
  char* ws;
  int ph_begin, ph_end;
};

DEVI int tid_fresh() { int t; asm volatile("v_mov_b32 %0, %1" : "=v"(t) : "v"(__builtin_amdgcn_workitem_id_x())); return t; }
DEVI int bid_fresh() { int t; asm volatile("s_mov_b32 %0, %1" : "=s"(t) : "s"(__builtin_amdgcn_workgroup_id_x())); return t; }
#define TIDX tid_fresh()
#define BIDX bid_fresh()
typedef const __attribute__((address_space(4))) Params* KP;
DEVI unsigned pk2(float a, float b) { f32x2 v = {a, b}; bf16x2_t r = __builtin_convertvector(v, bf16x2_t); return __builtin_bit_cast(unsigned, r); }
DEVI u16 f2bf(float a) { return (u16)(pk2(a, 0.f) & 0xffffu); }
DEVI float bf2f(u16 v) { return __uint_as_float(((unsigned)v) << 16); }
DEVI float wave_sum(float v) {
#pragma unroll
  for (int m = 32; m >= 1; m >>= 1) v += __shfl_xor(v, m);
  return v;
}
template <class T> DEVI T* wsp(KP p, size_t off) { return (T*)(p->ws + off); }
DEVI const float* xrow_in(KP p, int l, int b, int rr) {
  if (l == 0) return (rr < NCTX) ? p->ctx + ((size_t)b * NCTX + rr) * 1024 : p->x + ((size_t)b * SEQ + rr - NCTX) * 1024;
  return (rr < NCTX) ? wsp<float>(p, OFF_CTXRES) + ((size_t)b * NCTX + rr) * 1024 : p->out + ((size_t)b * SEQ + rr - NCTX) * 1024;
}
DEVI float* xrow_res(KP p, int b, int rr) {
  return (rr < NCTX) ? wsp<float>(p, OFF_CTXRES) + ((size_t)b * NCTX + rr) * 1024 : p->out + ((size_t)b * SEQ + rr - NCTX) * 1024;
}
DEVI int perm16(int k) { return (k & ~12) | ((k & 4) << 1) | ((k & 8) >> 1); }

struct ConvT { const float* src; const float* src2; const float* ks; u16* dst; int ld; int ldd; float mul; };
constexpr int CONV_ITEMS = 1152 + 64 + 64 + 2048 + 512 + 512 + 8192 + 4096;
DEVI ConvT conv_decode(KP p, int l, int idx) {
  ConvT c; c.ks = nullptr; c.mul = 1.f; c.src2 = nullptr;
  if (idx < 1152) {
    int nt = idx >> 4, kt = idx & 15, n0 = nt * 32;
    int sc = (n0 < 416) ? n0 : ((n0 < 512) ? -1 : n0 - 96);
    c.ld = 2208; c.ldd = 1024;
    if ((n0 >= 512 && n0 < 768) || (n0 >= 1024 && n0 < 1280)) c.mul = 0.125f * LOG2E;
    c.src = (sc < 0) ? nullptr : p->w_in + (size_t)l * 1024 * 2208 + (size_t)kt * 64 * 2208 + sc;
    c.dst = wsp<u16>(p, OFF_WIN) + (size_t)n0 * 1024 + kt * 64;
    return c;
  }
  idx -= 1152;
  if (idx < 64) {
    int nt = idx >> 2, kt = idx & 3;
    c.ld = 384; c.ldd = 256; c.ks = p->g_q_a + l * 256 + kt * 64;
    c.src = (nt >= 12) ? nullptr : p->w_q_b + (size_t)l * 256 * 384 + (size_t)kt * 64 * 384 + nt * 32;
    c.dst = wsp<u16>(p, OFF_WQB) + (size_t)nt * 32 * 256 + kt * 64;
    return c;
  }
  idx -= 64;
  if (idx < 64) {
    int nt = idx >> 2, kt = idx & 3;
    c.ld = 512; c.ldd = 256; c.ks = (kt < 2) ? p->g_kv_a + l * 128 + kt * 64 : nullptr;
    c.src = (kt >= 2) ? nullptr : p->w_kv_b + (size_t)l * 128 * 512 + (size_t)kt * 64 * 512 + nt * 32;
    c.dst = wsp<u16>(p, OFF_WKVB) + (size_t)nt * 32 * 256 + kt * 64;
    return c;
  }
  idx -= 64;
  if (idx < 2048) {
    int nt = idx >> 4, kt = idx & 15, R0 = nt * 32;
    int pr = R0 >> 11, cb = (R0 & 2047) >> 8, bj = (R0 & 255) >> 7, j0 = R0 & 127;
    c.ld = 1024; c.ldd = 1024;
    c.src = p->w_gate + ((size_t)(l * 4 + 2 * pr + bj) * 1024 + kt * 64) * 1024 + cb * 128 + j0;
    c.dst = wsp<u16>(p, OFF_WGATE) + (size_t)R0 * 1024 + kt * 64;
    return c;
  }
  idx -= 2048;
  if (idx < 512) {
    int br = idx >> 7, nt = (idx >> 2) & 31, kt = idx & 3;
    c.ld = 1024; c.ldd = 256;
    c.src = p->w_branch + ((size_t)(l * 4 + br) * 256 + kt * 64) * 1024 + nt * 32;
    c.dst = wsp<u16>(p, OFF_WBR) + ((size_t)br * 1024 + nt * 32) * 256 + kt * 64;
    return c;
  }
  idx -= 512;
  if (idx < 512) {
    int nt = idx >> 4, kt = idx & 15;
    c.ld = 1024; c.ldd = 1024;
    c.src = p->w_out + ((size_t)l * 1024 + kt * 64) * 1024 + nt * 32;
    c.dst = wsp<u16>(p, OFF_WOUT) + (size_t)nt * 32 * 1024 + kt * 64;
    return c;
  }
  idx -= 512;
  if (idx < 8192) {
    int e = idx >> 8, g32 = (idx >> 4) & 15, kt = idx & 15;
    c.ld = 256; c.ldd = 1024;
    c.src = p->w_ff1 + ((size_t)(l * 32 + e) * 1024 + kt * 64) * 256 + g32 * 16;
    c.src2 = p->w_ff3 + ((size_t)(l * 32 + e) * 1024 + kt * 64) * 256 + g32 * 16;
    c.dst = wsp<u16>(p, OFF_W13) + ((size_t)e * 512 + g32 * 32) * 1024 + kt * 64;
    return c;
  }
  idx -= 8192;
  {
    int e = idx >> 7, nt = (idx >> 2) & 31, kt = idx & 3;
    c.ld = 1024; c.ldd = 256;
    c.src = p->w_ff2 + ((size_t)(l * 32 + e) * 256 + kt * 64) * 1024 + nt * 32;
    c.dst = wsp<u16>(p, OFF_W2) + ((size_t)e * 1024 + nt * 32) * 256 + kt * 64;
    return c;
  }
}
DEVI void modulate_row_store(KP p, int l, int which, const float (&xv)[16], int mrow, u16* hrow, float (&hv)[16]) {
  const int lane = TIDX & 63;
  float ss = 0.f;
#pragma unroll
  for (int i = 0; i < 16; ++i) ss += xv[i] * xv[i];
  ss = wave_sum(ss);
  const float rstd = rsqrtf(ss * (1.f / 1024.f) + EPS);
  const float* g = (which ? p->g_norm_ffn : p->g_norm_mix) + l * 1024;
  const float* mod = wsp<float>(p, OFF_MOD) + ((size_t)l * 9 + mrow) * 6144 + (which ? 3072 : 0);
#pragma unroll
  for (int i = 0; i < 4; ++i) {
    const int c = i * 256 + lane * 4;
    f32x4 gv = *(const f32x4*)(g + c);
    f32x4 sh = *(const f32x4*)(mod + c);
    f32x4 sc = *(const f32x4*)(mod + 1024 + c);
    hv[i * 4 + 0] = xv[i * 4 + 0] * rstd * gv.x * (1.f + sc.x) + sh.x;
    hv[i * 4 + 1] = xv[i * 4 + 1] * rstd * gv.y * (1.f + sc.y) + sh.y;
    hv[i * 4 + 2] = xv[i * 4 + 2] * rstd * gv.z * (1.f + sc.z) + sh.z;
    hv[i * 4 + 3] = xv[i * 4 + 3] * rstd * gv.w * (1.f + sc.w) + sh.w;
    u32x2 o; o.x = pk2(hv[i * 4 + 0], hv[i * 4 + 1]); o.y = pk2(hv[i * 4 + 2], hv[i * 4 + 3]);
    *(u32x2*)(hrow + c) = o;
  }
}
DEVI void load_row16(const float* xr, float (&xv)[16]) {
  const int lane = TIDX & 63;
#pragma unroll
  for (int i = 0; i < 4; ++i) {
    f32x4 v = *(const f32x4*)(xr + i * 256 + lane * 4);
    xv[i * 4 + 0] = v.x; xv[i * 4 + 1] = v.y; xv[i * 4 + 2] = v.z; xv[i * 4 + 3] = v.w;
  }
}
DEVI float router_dot(const float (&hv)[4][16], const float* wrow) {
  const int lane = TIDX & 63;
  const float* w = wrow + lane * 4;
  float pr[4] = {0.f, 0.f, 0.f, 0.f};
#pragma unroll
  for (int i = 0; i < 4; ++i) {
    const f32x4 wv = *(const f32x4*)(w + i * 256);
#pragma unroll
    for (int r = 0; r < 4; ++r)
      pr[r] += hv[r][i * 4] * wv.x + hv[r][i * 4 + 1] * wv.y + hv[r][i * 4 + 2] * wv.z + hv[r][i * 4 + 3] * wv.w;
  }
  const bool up = (lane & 32) != 0;
  float s0 = up ? pr[0] : pr[2], s1 = up ? pr[1] : pr[3];
  float k0 = up ? pr[2] : pr[0], k1 = up ? pr[3] : pr[1];
  k0 += __shfl_xor(s0, 32); k1 += __shfl_xor(s1, 32);
  const bool up2 = (lane & 16) != 0;
  float sv = up2 ? k0 : k1, kv = up2 ? k1 : k0;
  kv += __shfl_xor(sv, 16);
  kv += __shfl_xor(kv, 8); kv += __shfl_xor(kv, 4); kv += __shfl_xor(kv, 2); kv += __shfl_xor(kv, 1);
  return kv;
}
#define XB_TMO      128
#define XB_XCNT(j)  (256  + 64 * (j))
#define XB_XSUB(j)  (1280 + 64 * (j))
#define XB_XGEN(j)  (2304 + 64 * (j))
#define XB_TOP      3328
#define XB_TOPGEN   3392
#define XB_SPIN_CAP (1u << 20)
#define LAS __attribute__((address_space(3)))
DEVI unsigned xb_ld(unsigned* p) { return __hip_atomic_load(p, __ATOMIC_RELAXED, __HIP_MEMORY_SCOPE_AGENT); }
DEVI unsigned xb_add(unsigned* p, unsigned v) { return __hip_atomic_fetch_add(p, v, __ATOMIC_RELAXED, __HIP_MEMORY_SCOPE_AGENT); }
DEVI unsigned xb_xcc_id() { return (unsigned)__builtin_amdgcn_s_getreg((3 << 11) | 20) & 0xFu; }
#define XB_SPIN(cond, bar) do { unsigned _sp = 0; while (cond) { __builtin_amdgcn_s_sleep(1); \
    if ((++_sp & 255u) == 0u) { if (xb_ld(&(bar)[XB_TMO])) break; if (_sp > XB_SPIN_CAP) { atomicAdd(&(bar)[XB_TMO], 1u); break; } } } } while (0)
DEVI void xcd_barrier_post(unsigned* bar) {
  if (TIDX == 0) (void)xb_add(&bar[XB_XCNT(xb_xcc_id())], 1u);
}
DEVI void xcd_barrier_complete(unsigned* bar, unsigned x, unsigned& nloc, unsigned& nx) {
  const unsigned G = gridDim.x * gridDim.y * gridDim.z;
  unsigned sum, cnt, mine, sp = 0u;
  for (;;) {
    sum = 0u; cnt = 0u; mine = 0u;
#pragma unroll
    for (unsigned j = 0; j < 16; ++j) { const unsigned c = xb_ld(&bar[XB_XCNT(j)]); sum += c; cnt += (c > 0u) ? 1u : 0u; mine = (j == x) ? c : mine; }
    if (sum == G) break;
    __builtin_amdgcn_s_sleep(1);
    if ((++sp & 255u) == 0u) { if (xb_ld(&bar[XB_TMO])) break; if (sp > XB_SPIN_CAP) { atomicAdd(&bar[XB_TMO], 1u); break; } }
  }
  nloc = mine > 0u ? mine : 1u; nx = cnt > 0u ? cnt : 1u;
}
DEVI void xcd_barrier(unsigned* bar, volatile LAS unsigned* st) {
  asm volatile("s_waitcnt vmcnt(0)" ::: "memory");
  __syncthreads();
  if (TIDX == 0) {
    const unsigned x = xb_xcc_id();
    __builtin_amdgcn_s_waitcnt(0);
    unsigned nloc = st[0], nx = st[1];
    if (nloc == 0u) { xcd_barrier_complete(bar, x, nloc, nx); st[0] = nloc; st[1] = nx; }
    const unsigned old = xb_add(&bar[XB_XSUB(x)], 1u);
    const unsigned gen = old / nloc;
    if (old + 1u == (gen + 1u) * nloc) {
      __builtin_amdgcn_fence(__ATOMIC_RELEASE, "agent");
      asm volatile("s_waitcnt vmcnt(0)" ::: "memory");
      const unsigned og = xb_add(&bar[XB_TOP], 1u);
      const unsigned tg = og / nx;
      if (og + 1u == (tg + 1u) * nx) xb_add(&bar[XB_TOPGEN], 1u);
      else XB_SPIN(xb_ld(&bar[XB_TOPGEN]) == tg, bar);
      __builtin_amdgcn_fence(__ATOMIC_ACQUIRE, "agent");
      xb_add(&bar[XB_XGEN(x)], 1u);
      asm volatile("s_waitcnt vmcnt(0)" ::: "memory");
    } else {
      XB_SPIN(xb_ld(&bar[XB_XGEN(x)]) == gen, bar);
      __builtin_amdgcn_fence(__ATOMIC_ACQUIRE, "agent");
      asm volatile("s_waitcnt vmcnt(0)" ::: "memory");
    }
  }
  __syncthreads();
}

namespace v2 {
typedef LAS unsigned char* ldsp_t;
constexpr int BM = 256, BK = 64, HALF = 128, HTB = HALF * BK * 2, STAGE_BYTES = 8 * HTB;
constexpr int NW = 8;
constexpr int LDS_XTRA = STAGE_BYTES;
constexpr int LDS_BARW = STAGE_BYTES + 16384;
constexpr int LDS_TOTAL = LDS_BARW + 16;

DEVI int lds_byte(int r, int c) { const int st = (r >> 4) * 2 + (c >> 5), rr = r & 15, cc = c & 31, ob = rr * 64 + cc * 2; return st * 1024 + (ob ^ (((ob >> 9) & 1) << 5)); }
DEVI void stage_rc(int b, int& R, int& C) { const int st = b / 1024, sb = b % 1024, swz = sb ^ (((sb >> 9) & 1) << 5); R = (st >> 1) * 16 + swz / 64; C = (st & 1) * 32 + (swz % 64) / 2; }
DEVI int perm32(int rho) { const int n = rho >> 4, i = rho & 15; return 8 * (i >> 2) + 4 * n + (i & 3); }

DEVI void acc_zero(f32x4 (&acc)[2][2][4][2]) {
#pragma unroll
  for (int a = 0; a < 2; ++a)
#pragma unroll
    for (int b = 0; b < 2; ++b)
#pragma unroll
      for (int m = 0; m < 4; ++m)
#pragma unroll
        for (int n = 0; n < 2; ++n) acc[a][b][m][n] = (f32x4){0.f, 0.f, 0.f, 0.f};
}
struct Unit { const char* A; const char* B; const int* rows; int nvalid; int u0, u1, u2, u3; };

template <bool PERM, bool GATHER, class Epi, class Sched>
DEVI void gemm_phase(ldsp_t lds, int lda_b, int ldb_b, int nt, const Sched& S, const Epi& E) {
  const int tid = TIDX, wid = __builtin_amdgcn_readfirstlane(tid >> 6), lane = tid & 63, wr = wid >> 2, wc = wid & 3, fr = lane & 15, fq = lane >> 4;
  unsigned voffA[2], voffB[2]; int RA[2], CA2[2];
#pragma unroll
  for (int i = 0; i < 2; ++i) {
    int R, C; stage_rc(tid * 16 + i * 8192, R, C);
    const int Rb = PERM ? ((R & ~31) + perm32(R & 31)) : R;
    RA[i] = R; CA2[i] = C * 2;
    voffA[i] = (unsigned)(R * lda_b + C * 2); voffB[i] = (unsigned)(Rb * ldb_b + C * 2);
  }
  const size_t kstep = (size_t)(BK * 2);
  const size_t hstepA = (size_t)HALF * lda_b, hstepB = (size_t)HALF * ldb_b;
  const unsigned ldsw = (unsigned)wid * 1024u;
  const int aoff = lds_byte(wr * 64 + fr, fq * 8), boff = lds_byte(wc * 32 + fr, fq * 8);
#define G_SA(b, h) (((b) * 2 + (h)) * HTB)
#define G_SB(b, h) ((4 + (b) * 2 + (h)) * HTB)
#define G_STAGE(bufoff, gbase, voff) do { _Pragma("unroll") for (int _i = 0; _i < 2; ++_i) \
    __builtin_amdgcn_global_load_lds((const unsigned*)((const char*)(gbase) + (voff)[_i]), (LAS unsigned*)(lds + (bufoff) + ldsw + _i * 8192), 16, 0, 0); } while (0)
#define G_STAGE_A(bufoff, abase, go, h, koff) do { if (GATHER) { _Pragma("unroll") for (int _i = 0; _i < 2; ++_i) \
    __builtin_amdgcn_global_load_lds((const unsigned*)((abase) + (go)[h][_i] + (koff)), (LAS unsigned*)(lds + (bufoff) + ldsw + _i * 8192), 16, 0, 0); } \
    else G_STAGE(bufoff, (abase) + (h) * hstepA + (koff), voffA); } while (0)
#define G_LDA(dst, b, h) do { _Pragma("unroll") for (int m = 0; m < 4; ++m) _Pragma("unroll") for (int k = 0; k < 2; ++k) dst[m][k] = *(const LAS bf16x8*)(lds + G_SA(b, h) + aoff + m * 2048 + k * 1024); } while (0)
#define G_LDB(dst, b, h) do { _Pragma("unroll") for (int n = 0; n < 2; ++n) _Pragma("unroll") for (int k = 0; k < 2; ++k) dst[n][k] = *(const LAS bf16x8*)(lds + G_SB(b, h) + boff + n * 2048 + k * 1024); } while (0)
#define G_MMA(ai, bj, At, Bt) do { __builtin_amdgcn_s_setprio(1); _Pragma("unroll") for (int m = 0; m < 4; ++m) _Pragma("unroll") for (int n = 0; n < 2; ++n) _Pragma("unroll") for (int k = 0; k < 2; ++k) \
    acc[ai][bj][m][n] = __builtin_amdgcn_mfma_f32_16x16x32_bf16(Bt[n][k], At[m][k], acc[ai][bj][m][n], 0, 0, 0); __builtin_amdgcn_s_setprio(0); } while (0)
#define G_WAIT_V(n) asm volatile("s_waitcnt vmcnt(" #n ")" ::: "memory")
#define G_WAIT_L(n) asm volatile("s_waitcnt lgkmcnt(" #n ")" ::: "memory")
#define G_BAR __builtin_amdgcn_s_barrier()
#define G_SCHED __builtin_amdgcn_sched_barrier(0)
  Unit cur, nxt; int ui = 0;
  if (!S.next(0, cur)) return;
  f32x4 acc[2][2][4][2];
  E.init(acc, cur, wr, wc, fr, fq);
  bf16x8 At[4][2], B0[2][2], B1[2][2];
  unsigned gcur[2][2];
  auto gather_offs = [&](const Unit& u, unsigned (&go)[2][2]) {
#pragma unroll
    for (int h = 0; h < 2; ++h)
#pragma unroll
      for (int i = 0; i < 2; ++i) {
        const int r = h * HALF + RA[i];
        const int t = (r < u.nvalid) ? (u.rows[r] >> 1) : 0;
        go[h][i] = (unsigned)t * (unsigned)lda_b + (unsigned)CA2[i];
      }
  };
  if (GATHER) gather_offs(cur, gcur);
  const char* cA = cur.A; const char* cB = cur.B;
  G_STAGE(G_SB(0, 0), cB, voffB); G_STAGE_A(G_SA(0, 0), cA, gcur, 0, 0); G_STAGE(G_SB(0, 1), cB + hstepB, voffB); G_STAGE_A(G_SA(0, 1), cA, gcur, 1, 0);
  if (wr == 1) G_BAR;
  G_WAIT_V(4); G_BAR;
  G_STAGE(G_SB(1, 0), cB + kstep, voffB); G_STAGE_A(G_SA(1, 0), cA, gcur, 0, kstep); G_STAGE(G_SB(1, 1), cB + hstepB + kstep, voffB);
  G_WAIT_V(6); G_BAR;
  for (;;) {
    const bool has_next = S.next(ui + 1, nxt);
    const char* nA = has_next ? nxt.A : cA; const char* nB = has_next ? nxt.B : cB;
    for (int t = 0; t < nt; t += 2) {
      const bool last = (t == nt - 2);
      const size_t k1 = (size_t)(t + 1) * kstep;
      const char* a2 = last ? nA : cA; const char* b2 = last ? nB : cB + (size_t)(t + 2) * kstep;
      const size_t ka2 = last ? 0 : (size_t)(t + 2) * kstep;
      const char* b3 = b2 + kstep; const size_t ka3 = ka2 + kstep;
      unsigned gN[2][2];
      if (GATHER && last) {
        if (has_next) gather_offs(nxt, gN);
        else {
#pragma unroll
          for (int h = 0; h < 2; ++h)
#pragma unroll
            for (int i = 0; i < 2; ++i) gN[h][i] = gcur[h][i];
        }
      }
#define G_STAGE_A2(bufoff, h, koff) do { if (GATHER) { if (last) G_STAGE_A(bufoff, cA, gN, h, (koff) - ka2); else G_STAGE_A(bufoff, cA, gcur, h, koff); } \
        else G_STAGE_A(bufoff, a2, gcur, h, koff); } while (0)
      G_LDB(B0, 0, 0); G_SCHED; G_LDA(At, 0, 0); G_STAGE_A(G_SA(1, 1), cA, gcur, 1, k1);
      G_WAIT_L(8); G_BAR; G_WAIT_L(0); G_MMA(0, 0, At, B0); G_BAR; G_SCHED;
      G_LDB(B1, 0, 1); G_STAGE(G_SB(0, 0), b2, voffB);
      G_BAR; G_WAIT_L(0); G_MMA(0, 1, At, B1); G_BAR;
      G_LDA(At, 0, 1); G_STAGE_A2(G_SA(0, 0), 0, ka2);
      G_BAR; G_WAIT_L(0); G_MMA(1, 0, At, B0); G_BAR; G_SCHED;
      G_STAGE(G_SB(0, 1), b2 + hstepB, voffB);
      G_WAIT_V(6); G_BAR; G_MMA(1, 1, At, B1); G_BAR;
      G_LDB(B0, 1, 0); G_SCHED; G_LDA(At, 1, 0); G_STAGE_A2(G_SA(0, 1), 1, ka2);
      G_WAIT_L(8); G_BAR; G_WAIT_L(0); G_MMA(0, 0, At, B0); G_BAR; G_SCHED;
      G_LDB(B1, 1, 1); G_STAGE(G_SB(1, 0), b3, voffB);
      G_BAR; G_WAIT_L(0); G_MMA(0, 1, At, B1); G_BAR;
      G_LDA(At, 1, 1); G_STAGE_A2(G_SA(1, 0), 0, ka3);
      G_BAR; G_WAIT_L(0); G_MMA(1, 0, At, B0); G_BAR; G_SCHED;
      G_STAGE(G_SB(1, 1), b3 + hstepB, voffB);
      G_WAIT_V(6); G_BAR; G_MMA(1, 1, At, B1); G_BAR;
      if (GATHER && last) {
#pragma unroll
        for (int h = 0; h < 2; ++h)
#pragma unroll
          for (int i = 0; i < 2; ++i) gcur[h][i] = gN[h][i];
      }
#undef G_STAGE_A2
    }
    G_SCHED;
    E(acc, cur, wr, wc, fr, fq);
    G_SCHED;
    if (!has_next) break;
    cur = nxt; cA = nA; cB = nB; ++ui;
    E.init(acc, cur, wr, wc, fr, fq);
  }
  G_WAIT_V(0);
  if (wr == 0) G_BAR;
  G_BAR;
#undef G_SA
#undef G_SB
#undef G_STAGE
#undef G_STAGE_A
#undef G_LDA
#undef G_LDB
#undef G_MMA
#undef G_WAIT_V
#undef G_WAIT_L
#undef G_BAR
#undef G_SCHED
}

DEVI unsigned uoff(unsigned x) { return (unsigned)__builtin_amdgcn_readfirstlane((int)x); }
DEVI bool tile_order(int i, int G, int c, int nM, int nN, int& pm, int& pn) {
  const int nwg = nM * nN;
  const long L = (long)i * G + c; if (L >= nwg) return false;
  int wgid = (int)L; { const int q = nwg / 8, r = nwg % 8, xcd = wgid % 8, off = wgid / 8; wgid = (xcd < r ? xcd * (q + 1) : r * (q + 1) + (xcd - r) * q) + off; }
  const int WGM = 8;
  const int nig = WGM * nN, gid = wgid / nig, fm = gid * WGM, gsz = (nM - fm) < WGM ? (nM - fm) : WGM;
  pm = fm + ((wgid % nig) % gsz); pn = (wgid % nig) / gsz;
  pm = __builtin_amdgcn_readfirstlane(pm); pn = __builtin_amdgcn_readfirstlane(pn);
  return true;
}
struct EpiRawBf16 {
  u16* O; int ldc;
  DEVI void init(f32x4 (&acc)[2][2][4][2], const Unit&, int, int, int, int) const { acc_zero(acc); }
  DEVI void operator()(const f32x4 (&acc)[2][2][4][2], const Unit& u, int wr, int wc, int fr, int fq) const {
    const unsigned off0 = ((unsigned)(u.u0 + wr * 64 + fr) * (unsigned)ldc + (unsigned)(u.u1 + wc * 32 + 8 * fq)) * 2u;
#pragma unroll
    for (int ai = 0; ai < 2; ++ai)
#pragma unroll
      for (int m = 0; m < 4; ++m) {
        char* rowp = (char*)O + (off0 + (unsigned)(ai * HALF + m * 16) * (unsigned)ldc * 2u);
#pragma unroll
        for (int bj = 0; bj < 2; ++bj) {
          const f32x4 v0 = acc[ai][bj][m][0], v1 = acc[ai][bj][m][1];
          u32x4 w; w.x = pk2(v0[0], v0[1]); w.y = pk2(v0[2], v0[3]); w.z = pk2(v1[0], v1[1]); w.w = pk2(v1[2], v1[3]);
          *(u32x4*)(rowp + bj * HALF * 2) = w;
        }
      }
  }
};

struct SchedB { const char* ws; int G, c;
  DEVI bool next(int i, Unit& u) const { int pm, pn; if (!tile_order(i, G, c, NTOK / 256, INP / 256, pm, pn)) return false;
    u.A = ws + OFF_H + uoff((unsigned)pm * 256u * 2048u); u.B = ws + OFF_WIN + uoff((unsigned)pn * 256u * 2048u); u.rows = nullptr; u.nvalid = 0; u.u0 = pm * 256; u.u1 = pn * 256; u.u2 = 0; u.u3 = 0; return true; } };
struct EpiB { u16* O; float* ssq;
  DEVI void init(f32x4 (&acc)[2][2][4][2], const Unit&, int, int, int, int) const { acc_zero(acc); }
  DEVI void operator()(const f32x4 (&acc)[2][2][4][2], const Unit& u, int wr, int wc, int fr, int fq) const {
    EpiRawBf16 E{O, PLD}; E(acc, u, wr, wc, fr, fq);
    if (u.u1 < 512) {
      const bool iskv = u.u1 != 0;
#pragma unroll
      for (int ai = 0; ai < 2; ++ai)
#pragma unroll
        for (int m = 0; m < 4; ++m) {
          float ss = 0.f;
#pragma unroll
          for (int bj = 0; bj < 2; ++bj)
#pragma unroll
            for (int n = 0; n < 2; ++n)
#pragma unroll
              for (int j = 0; j < 4; ++j) { const float v = acc[ai][bj][m][n][j]; if (!(iskv && bj == 1)) ss += v * v; }
          ss += __shfl_xor(ss, 16); ss += __shfl_xor(ss, 32);
          if (fq == 0) ssq[(size_t)(u.u0 + ai * HALF + wr * 64 + m * 16 + fr) * 8 + (iskv ? 4 : 0) + wc] = ss;
        }
    }
  }
};
DEVI void phaseB2(KP p, ldsp_t lds) {
  SchedB S{(const char*)p->ws, (int)gridDim.x, BIDX};
  EpiB E{wsp<u16>(p, OFF_PRAW), wsp<float>(p, OFF_SSQ)};
  gemm_phase<true, false>(lds, 2048, 2048, 16, S, E);
}
struct SchedC { const char* ws; int G, c;
  DEVI bool next(int i, Unit& u) const { int pm, pn; if (!tile_order(i, G, c, NTOK / 256, 4, pm, pn)) return false;
    const bool kv = pn >= 2; const int pj = pn & 1;
    u.A = ws + OFF_PRAW + uoff((unsigned)pm * 256u * (unsigned)(PLD * 2) + (kv ? 512u : 0u)); u.B = ws + (kv ? OFF_WKVB : OFF_WQB) + uoff((unsigned)pj * 256u * 512u); u.rows = nullptr; u.nvalid = 0;
    u.u0 = pm * 256; u.u1 = pj * 256; u.u2 = kv; u.u3 = 0; return true; } };
struct EpiC { u16* Oq; u16* Okv; const float* ssq;
  DEVI void init(f32x4 (&acc)[2][2][4][2], const Unit&, int, int, int, int) const { acc_zero(acc); }
  DEVI void operator()(const f32x4 (&acc)[2][2][4][2], const Unit& u, int wr, int wc, int fr, int fq) const {
    const bool kv = u.u2 != 0;
    u16* O = kv ? Okv : Oq;
    const int row0 = u.u0 + wr * 64 + fr, col0 = u.u1 + wc * 32 + 8 * fq;
    f32x4 sq[2][4];
#pragma unroll
    for (int ai = 0; ai < 2; ++ai)
#pragma unroll
      for (int m = 0; m < 4; ++m) sq[ai][m] = *(const f32x4*)(ssq + (size_t)(row0 + ai * HALF + m * 16) * 8 + (kv ? 4 : 0));
#pragma unroll
    for (int ai = 0; ai < 2; ++ai)
#pragma unroll
      for (int m = 0; m < 4; ++m) {
        const size_t r = (size_t)(row0 + ai * HALF + m * 16);
        const float tot = sq[ai][m].x + sq[ai][m].y + sq[ai][m].z + sq[ai][m].w;
        const float sc = kv ? rsqrtf(tot * (1.f / 128.f) + EPS) : rsqrtf(tot * (1.f / 256.f) + EPS) * (0.10206207261596575f * LOG2E);
        u16* rowp = O + r * 512 + col0;
#pragma unroll
        for (int bj = 0; bj < 2; ++bj) {
          const f32x4 v0 = acc[ai][bj][m][0] * sc, v1 = acc[ai][bj][m][1] * sc;
          u32x4 w; w.x = pk2(v0[0], v0[1]); w.y = pk2(v0[2], v0[3]); w.z = pk2(v1[0], v1[1]); w.w = pk2(v1[2], v1[3]);
          *(u32x4*)(rowp + bj * HALF) = w;
        }
      }
  }
};
DEVI void phaseC2(KP p, ldsp_t lds) {
  SchedC S{(const char*)p->ws, (int)gridDim.x, BIDX};
  EpiC E{wsp<u16>(p, OFF_QARAW), wsp<u16>(p, OFF_KVARAW), wsp<float>(p, OFF_SSQ)};
  int nt = 4; asm volatile("" : "+s"(nt));
  gemm_phase<true, false>(lds, PLD * 2, 512, nt, S, E);
}

DEVI void ld16(const u16* src, float (&v)[16]) {
  const u32x4 a = *(const u32x4*)src, b = *(const u32x4*)(src + 8);
  const unsigned w[8] = {a.x, a.y, a.z, a.w, b.x, b.y, b.z, b.w};
#pragma unroll
  for (int i = 0; i < 8; ++i) { v[2 * i] = __uint_as_float(w[i] << 16); v[2 * i + 1] = __uint_as_float(w[i] & 0xffff0000u); }
}
DEVI void st16(u16* dst, const float (&v)[16]) {
  u32x4 a, b;
  a.x = pk2(v[0], v[1]); a.y = pk2(v[2], v[3]); a.z = pk2(v[4], v[5]); a.w = pk2(v[6], v[7]);
  b.x = pk2(v[8], v[9]); b.y = pk2(v[10], v[11]); b.z = pk2(v[12], v[13]); b.w = pk2(v[14], v[15]);
  *(u32x4*)dst = a; *(u32x4*)(dst + 8) = b;
}
DEVI void rope16c(float (&v)[16], const float* cs16, int pos) {
  const f32x2* t = (const f32x2*)(cs16 + pos * 16);
#pragma unroll
  for (int i = 0; i < 8; ++i) { const f32x2 cs = t[i]; const float x1 = v[i], x2 = v[8 + i]; v[i] = x1 * cs.x - x2 * cs.y; v[8 + i] = x2 * cs.x + x1 * cs.y; }
}
DEVI void rope32c(float (&lo)[16], float (&hi)[16], const float* cs32, int pos) {
  const f32x2* t = (const f32x2*)(cs32 + pos * 32);
#pragma unroll
  for (int i = 0; i < 16; ++i) { const f32x2 cs = t[i]; const float x1 = lo[i], x2 = hi[i]; lo[i] = x1 * cs.x - x2 * cs.y; hi[i] = x2 * cs.x + x1 * cs.y; }
}
DEVI float ssq16(const float (&v)[16]) { float s = 0.f;
#pragma unroll
  for (int i = 0; i < 16; ++i) s += v[i] * v[i];
  return s; }
DEVI void scale16(float (&v)[16], float s) {
#pragma unroll
  for (int i = 0; i < 16; ++i) v[i] *= s; }
DEVI void cvt16(const u32x4 a, const u32x4 b, float (&v)[16]) {
  const unsigned w[8] = {a.x, a.y, a.z, a.w, b.x, b.y, b.z, b.w};
#pragma unroll
  for (int i = 0; i < 8; ++i) { v[2 * i] = __uint_as_float(w[i] << 16); v[2 * i + 1] = __uint_as_float(w[i] & 0xffff0000u); }
}
DEVI void phaseP2(KP p, int l, ldsp_t lds) {
  const int tid = TIDX, tk = tid >> 3, pt = tid & 7;
  u16* PR = wsp<u16>(p, OFF_PRAW);
  u16* QA = wsp<u16>(p, OFF_QARAW);
  const float* cs32 = wsp<float>(p, OFF_CS32);
  const float* cs16 = wsp<float>(p, OFF_CS16);
  const float QS = 0.125f * LOG2E;
  for (int item = BIDX; item < NTOK / 64; item += gridDim.x) {
    const int tok0 = item * 64, rr0 = tok0 % TPB;
    const bool lat = rr0 >= NCTX;
    const size_t tok = (size_t)tok0 + tk;
    const int t = rr0 + tk - NCTX, grow = (t >> 6) & 63, gcol = t & 63;
    u16* pr = PR + tok * PLD;
    u16* qar = QA + tok * 512 + 96 * (pt >> 1) + 64 + 16 * (pt & 1);
    const int g4 = pt & 3;
    u32x4 r_qa[2], r_kr[2], r_qb[4], r_kb[4], r_qd[4], r_kd[4];
#define LD8(ptr) (*(const u32x4*)(ptr))
    if (lat) {
#pragma unroll
      for (int i = 0; i < 2; ++i) { r_qa[i] = LD8(qar + 8 * i); r_kr[i] = LD8(pr + 384 + 16 * (pt & 1) + 8 * i); }
#pragma unroll
      for (int i = 0; i < 4; ++i) { r_qb[i] = LD8(pr + 512 + 32 * pt + 8 * i); r_kb[i] = LD8(pr + 768 + 32 * g4 + 8 * i); }
    }
#pragma unroll
    for (int i = 0; i < 4; ++i) { r_qd[i] = LD8(pr + 1792 + 32 * pt + 8 * i); r_kd[i] = LD8(pr + 2048 + 32 * g4 + 8 * i); }
#undef LD8
    if (lat) {
      { float v[16]; cvt16(r_qa[0], r_qa[1], v); rope16c(v, cs16, (pt & 1) ? gcol : grow); st16(qar, v); }
      if (pt < 2) { float v[16]; cvt16(r_kr[0], r_kr[1], v); rope16c(v, cs16, pt == 0 ? grow : gcol); st16(pr + 384 + 16 * pt, v); }
      { float lo[16], hi[16]; cvt16(r_qb[0], r_qb[1], lo); cvt16(r_qb[2], r_qb[3], hi); rope32c(lo, hi, cs32, (pt & 1) ? gcol : grow); st16(pr + 512 + 32 * pt, lo); st16(pr + 512 + 32 * pt + 16, hi); }
      if (pt < 4) { float lo[16], hi[16]; cvt16(r_kb[0], r_kb[1], lo); cvt16(r_kb[2], r_kb[3], hi); rope32c(lo, hi, cs32, (pt & 1) ? gcol : grow); st16(pr + 768 + 32 * pt, lo); st16(pr + 768 + 32 * pt + 16, hi); }
    }
    {
      float lo[16], hi[16]; cvt16(r_qd[0], r_qd[1], lo); cvt16(r_qd[2], r_qd[3], hi);
      float ss = ssq16(lo) + ssq16(hi); ss += __shfl_xor(ss, 1);
      const float rs = rsqrtf(ss * (1.f / 64.f) + EPS);
      const float* g = p->g_q_d + l * 64 + 32 * (pt & 1);
#pragma unroll
      for (int i = 0; i < 16; ++i) { lo[i] *= rs * g[i]; hi[i] *= rs * g[16 + i]; }
      if (lat) rope32c(lo, hi, cs32, (pt & 1) ? gcol : grow);
      scale16(lo, QS); scale16(hi, QS);
      st16(pr + 1792 + 32 * pt, lo); st16(pr + 1792 + 32 * pt + 16, hi);
    }
    {
      float lo[16], hi[16]; cvt16(r_kd[0], r_kd[1], lo); cvt16(r_kd[2], r_kd[3], hi);
      float ss = ssq16(lo) + ssq16(hi); ss += __shfl_xor(ss, 1);
      const float rs = rsqrtf(ss * (1.f / 64.f) + EPS);
      const float* g = p->g_k_d + l * 64 + 32 * (g4 & 1);
#pragma unroll
      for (int i = 0; i < 16; ++i) { lo[i] *= rs * g[i]; hi[i] *= rs * g[16 + i]; }
      if (lat) rope32c(lo, hi, cs32, (g4 & 1) ? gcol : grow);
      if (pt < 4) { st16(pr + 2048 + 32 * g4, lo); st16(pr + 2048 + 32 * g4 + 16, hi); }
    }
  }
}

DEVI void conv_load(const ConvT& c, int lane, f32x4 (&v)[8]) {
  const int kk = lane >> 3, n4 = (lane & 7) * 4;
  const float* sp = (c.src2 && n4 >= 16) ? c.src2 + (n4 - 16) : (c.src ? c.src + n4 : nullptr);
#pragma unroll
  for (int i = 0; i < 8; ++i) v[i] = sp ? *(const f32x4*)(sp + (size_t)(kk + 8 * i) * c.ld) : f32x4{0.f, 0.f, 0.f, 0.f};
}
DEVI void conv_store(const ConvT& c, LAS float* t, int lane, const f32x4 (&v)[8]) {
  const int kk = lane >> 3, n4 = (lane & 7) * 4;
#pragma unroll
  for (int i = 0; i < 8; ++i) {
    const int k = kk + 8 * i;
    const float s = (c.ks ? c.ks[k] : 1.f) * c.mul;
    t[(n4 + 0) * 65 + k] = v[i].x * s; t[(n4 + 1) * 65 + k] = v[i].y * s;
    t[(n4 + 2) * 65 + k] = v[i].z * s; t[(n4 + 3) * 65 + k] = v[i].w * s;
  }
  asm volatile("s_waitcnt lgkmcnt(0)" ::: "memory");
  const int n = lane >> 1, k0 = (lane & 1) * 32;
  const LAS float* r = t + n * 65 + k0;
  u16* d = c.dst + (size_t)n * c.ldd + k0;
#pragma unroll
  for (int q = 0; q < 4; ++q) {
    u32x4 o;
    o.x = pk2(r[8 * q], r[8 * q + 1]); o.y = pk2(r[8 * q + 2], r[8 * q + 3]); o.z = pk2(r[8 * q + 4], r[8 * q + 5]); o.w = pk2(r[8 * q + 6], r[8 * q + 7]);
    *(u32x4*)(d + 8 * q) = o;
  }
  asm volatile("s_waitcnt lgkmcnt(0)" ::: "memory");
}
constexpr int CONV_EARLY = 1152 + 64 + 64;
DEVI void conv_items2(KP p, int l, ldsp_t lds, int first_item, int total_items) {
  const int tid = TIDX, wave = __builtin_amdgcn_readfirstlane(tid >> 6), lane = tid & 63;
  LAS float* t = (LAS float*)(lds + wave * 8448);
  __syncthreads();
  const int stride = gridDim.x * NW;
  int item = first_item + BIDX * NW + wave;
  if (item >= total_items) return;
  ConvT c = conv_decode(p, l, item);
  f32x4 v[8];
  conv_load(c, lane, v);
  for (;;) {
    const int nitem = item + stride;
    const bool more = nitem < total_items;
    ConvT cn = c; f32x4 vn[8];
    if (more) { cn = conv_decode(p, l, nitem); conv_load(cn, lane, vn); }
    conv_store(c, t, lane, v);
    if (!more) break;
    c = cn; item = nitem;
#pragma unroll
    for (int i = 0; i < 8; ++i) v[i] = vn[i];
  }
}
template <int BR>
DEVI void attn_mask(f32x16 (&s)[2], int kt, int qlat, int qrow, int qcol, int hh, LAS float* rpb) {
  if (BR == 1) {
#pragma unroll
    for (int kb = 0; kb < 2; ++kb)
#pragma unroll
      for (int i = 0; i < 16; ++i) {
        const int kpos = kt * 64 + kb * 32 + (i & 3) + 8 * (i >> 2) + 4 * hh;
        const int d = qlat - kpos;
        if (d > 128 || d < -128) s[kb][i] = -1e30f;
      }
  } else {
    const int rs = min(max(qrow - 4, 0), 56);
    const bool row_ok = (kt >= rs) && (kt < rs + 8);
    const int cst = min(max(qcol - 8, 0), 48);
    const int dr = kt - qrow + 7;
#pragma unroll
    for (int kb = 0; kb < 2; ++kb)
#pragma unroll
      for (int i = 0; i < 16; ++i) {
        const int kc = kb * 32 + (i & 3) + 8 * (i >> 2) + 4 * hh;
        const bool ok = row_ok && (kc >= cst) && (kc < cst + 16);
        const int idx = ok ? (dr * 31 + (kc - qcol + 15)) : 0;
        const float bias = rpb[idx];
        s[kb][i] = ok ? (s[kb][i] + bias) : -1e30f;
      }
  }
}

typedef short v4i16_t __attribute__((ext_vector_type(4)));
DEVI bf16x8 vtr2(ldsp_t a) {
  const v4i16_t lo = __builtin_amdgcn_ds_read_tr16_b64_v4i16((LAS v4i16_t*)a);
  const v4i16_t hi = __builtin_amdgcn_ds_read_tr16_b64_v4i16((LAS v4i16_t*)(a + 8 * 144));
  return __builtin_shufflevector(lo, hi, 0, 1, 2, 3, 4, 5, 6, 7);
}
template <int BR>
DEVI void attn_item2(KP p, int l, int b, int hs, int qb, bool isctx, ldsp_t lds) {
  constexpr bool MLA = (BR == 0);
  constexpr bool GQA = (BR == 1 || BR == 3);
  constexpr int QBLK = GQA ? 256 : 512;
  constexpr int NKS = MLA ? 6 : 4;
  constexpr int STG = 9216 + 9216 + 5120;
  const int tid = TIDX, lane = tid & 63, wave = __builtin_amdgcn_readfirstlane(tid >> 6);
  const int r32 = lane & 31, hh = lane >> 5;
  const int hq = GQA ? (hs * 2 + (wave & 1)) : hs;
  const int woff = GQA ? 64 * (wave >> 1) : 64 * wave;
  const int q0 = (isctx ? 0 : NCTX) + qb * QBLK;
  const bool active = !isctx || (woff < NCTX);
  const size_t tokq = (size_t)b * TPB + q0 + (active ? woff : 0) + r32;
  const u16* Qp; const u16* Kp; int ldk; const u16* Vp; int ldv; int obase; int ldq;
  const u16* PR = wsp<u16>(p, OFF_PRAW);
  if (BR == 0) { Qp = wsp<u16>(p, OFF_QARAW) + tokq * 512 + hq * 96; ldq = 512; Kp = wsp<u16>(p, OFF_KVARAW) + (size_t)b * TPB * 512 + hs * 128; ldk = 512; Vp = wsp<u16>(p, OFF_KVARAW) + (size_t)b * TPB * 512 + hs * 128 + 64; ldv = 512; obase = hq * 64; }
  else if (BR == 1) { Qp = PR + tokq * PLD + 512 + hq * 64; ldq = PLD; Kp = PR + (size_t)b * TPB * PLD + 768 + hs * 64; ldk = PLD; Vp = PR + (size_t)b * TPB * PLD + 896 + hs * 64; ldv = PLD; obase = 256 + hq * 64; }
  else if (BR == 2) { Qp = PR + tokq * PLD + 1024 + hq * 64; ldq = PLD; Kp = PR + (size_t)b * TPB * PLD + 1280 + hs * 64; ldk = PLD; Vp = PR + (size_t)b * TPB * PLD + 1536 + hs * 64; ldv = PLD; obase = 512 + hq * 64; }
  else { Qp = PR + tokq * PLD + 1792 + hq * 64; ldq = PLD; Kp = PR + (size_t)b * TPB * PLD + 2048 + hs * 64; ldk = PLD; Vp = PR + (size_t)b * TPB * PLD + 2176 + hs * 64; ldv = PLD; obase = 768 + hq * 64; }
  const u16* KRp = PR + (size_t)b * TPB * PLD + 384;
  int lat_lo = 0, lat_n = 0, wlo = 0, whi = 63;
  if (!isctx) {
    if (BR == 0 || BR == 3) { lat_lo = 0; lat_n = 64; }
    else if (BR == 1) {
      const int ql = qb * QBLK; const int lo = max(0, ql - 128) >> 6, hi = min(SEQ - 1, ql + QBLK - 1 + 128) >> 6; lat_lo = lo; lat_n = hi - lo + 1;
      const int wq = ql + woff; wlo = max(0, wq - 128) >> 6; whi = min(SEQ - 1, wq + 63 + 128) >> 6;
    } else {
      const int r0 = 8 * qb; const int lo = min(max(r0 - 4, 0), 56), hi = min(max(r0 + 7 - 4, 0), 56) + 7; lat_lo = lo; lat_n = hi - lo + 1;
      const int wr_ = r0 + wave; wlo = min(max(wr_ - 4, 0), 56); whi = wlo + 7;
    }
  }
  const int NT = 4 + lat_n;
  const int qlat0 = qb * QBLK + woff + r32;
  bf16x8 qf[2][NKS];
#pragma unroll
  for (int qi = 0; qi < 2; ++qi)
#pragma unroll
    for (int ks = 0; ks < NKS; ++ks) qf[qi][ks] = *(const bf16x8*)(Qp + (size_t)qi * 32 * ldq + ks * 16 + hh * 8);
  const int srow = tid >> 3, sc8 = (tid & 7) * 8;
  const int krow_ = (tid & 255) >> 2, kc8 = (tid & 3) * 8;
  const bool krt = tid < 256;
  u32x4 rk0, rv0, rr0, rk1, rv1, rr1;
  auto keytile = [&](int j) { return (j < 4) ? j : (4 + lat_lo + (j - 4)); };
#define A_GLOAD(j, rk, rv, rr) do { const int key0_ = keytile(j) * 64; \
    rk = *(const u32x4*)(Kp + (size_t)(key0_ + srow) * ldk + sc8); \
    rv = *(const u32x4*)(Vp + (size_t)(key0_ + srow) * ldv + sc8); \
    if (MLA && krt) rr = *(const u32x4*)(KRp + (size_t)(key0_ + krow_) * PLD + kc8); } while (0)
#define A_LWRITE(st, rk, rv, rr) do { ldsp_t base_ = lds + (st) * STG; \
    *(LAS u32x4*)(base_ + srow * 144 + sc8 * 2) = rk; \
    *(LAS u32x4*)(base_ + 9216 + srow * 144 + sc8 * 2) = rv; \
    if (MLA && krt) *(LAS u32x4*)(base_ + 18432 + krow_ * 80 + kc8 * 2) = rr; } while (0)
  LAS float* rpb = (LAS float*)(lds + 2 * STG);
  A_GLOAD(0, rk0, rv0, rr0);
  if (NT > 1) A_GLOAD(1, rk1, rv1, rr1);
  __syncthreads();
  if (BR == 2 && !isctx) {
    const float* src = p->rpb_c + (size_t)(l * 4 + hs) * 465;
    for (int i = tid; i < 465; i += 512) rpb[i] = src[i] * LOG2E;
  }
  A_LWRITE(0, rk0, rv0, rr0);
  __syncthreads();
  f32x16 o[2][2];
#pragma unroll
  for (int qi = 0; qi < 2; ++qi)
#pragma unroll
    for (int i = 0; i < 16; ++i) { o[qi][0][i] = 0.f; o[qi][1][i] = 0.f; }
  float m_run[2], l_run[2];
#pragma unroll
  for (int qi = 0; qi < 2; ++qi) { m_run[qi] = -INFINITY; l_run[qi] = 0.f; }
  if (BR == 1) { const float sk = p->sink_b[l * 4 + hq] * LOG2E; m_run[0] = sk; m_run[1] = sk; l_run[0] = (hh == 0) ? 1.f : 0.f; l_run[1] = l_run[0]; }
  const ldsp_t kfb = lds + r32 * 144 + hh * 16;
  const ldsp_t vfb = lds + 9216 + (4 * hh + ((lane & 15) >> 2)) * 144 + (16 * ((lane >> 4) & 1) + 4 * (lane & 3)) * 2;
  const ldsp_t krb = lds + 18432 + r32 * 80 + hh * 16;
#define A_STEP(j, rkA, rvA, rrA, rkB, rvB, rrB) do { \
    const int st = ((j) & 1) * STG; \
    if ((j) + 2 < NT) A_GLOAD((j) + 2, rkA, rvA, rrA); \
    const int kt_ = lat_lo + (j) - 4; \
    const bool need = active && ((j) < 4 || (kt_ >= wlo && kt_ <= whi)); \
    if (need) { \
      f32x16 s[2][2]; \
      _Pragma("unroll") for (int kb = 0; kb < 2; ++kb) { \
        _Pragma("unroll") for (int ks = 0; ks < 4; ++ks) { const bf16x8 kf = *(const LAS bf16x8*)(kfb + st + kb * 32 * 144 + ks * 32); \
          _Pragma("unroll") for (int qi = 0; qi < 2; ++qi) { if (ks == 0) { _Pragma("unroll") for (int i = 0; i < 16; ++i) s[qi][kb][i] = 0.f; } s[qi][kb] = MFMA(kf, qf[qi][ks], s[qi][kb]); } } \
        if (MLA) { _Pragma("unroll") for (int ks = 0; ks < 2; ++ks) { const bf16x8 kf = *(const LAS bf16x8*)(krb + st + kb * 32 * 80 + ks * 32); \
          _Pragma("unroll") for (int qi = 0; qi < 2; ++qi) s[qi][kb] = MFMA(kf, qf[qi][NKS - 2 + ks], s[qi][kb]); } } \
      } \
      _Pragma("unroll") for (int qi = 0; qi < 2; ++qi) { \
        if ((BR == 1 || BR == 2) && (j) >= 4) { const int ql_ = qlat0 + 32 * qi; attn_mask<BR>(s[qi], kt_, ql_, ql_ >> 6, ql_ & 63, hh, rpb); } \
        float mx = s[qi][0][0]; \
        _Pragma("unroll") for (int i = 1; i < 16; ++i) mx = fmaxf(mx, s[qi][0][i]); \
        _Pragma("unroll") for (int i = 0; i < 16; ++i) mx = fmaxf(mx, s[qi][1][i]); \
        mx = fmaxf(mx, __shfl_xor(mx, 32)); \
        const float m_new = fmaxf(m_run[qi], mx); \
        const float alpha = __builtin_amdgcn_exp2f(m_run[qi] - m_new); \
        m_run[qi] = m_new; \
        float ls0 = 0.f, ls1 = 0.f; \
        _Pragma("unroll") for (int i = 0; i < 16; ++i) { \
          const float e0 = __builtin_amdgcn_exp2f(s[qi][0][i] - m_new), e1 = __builtin_amdgcn_exp2f(s[qi][1][i] - m_new); \
          s[qi][0][i] = e0; s[qi][1][i] = e1; ls0 += e0; ls1 += e1; } \
        l_run[qi] = l_run[qi] * alpha + (ls0 + ls1); \
        if (__any(alpha != 1.f)) { _Pragma("unroll") for (int i = 0; i < 16; ++i) { o[qi][0][i] *= alpha; o[qi][1][i] *= alpha; } } \
      } \
      _Pragma("unroll") for (int s4 = 0; s4 < 4; ++s4) { \
        const int kb = s4 >> 1, rb = (s4 & 1) * 8; \
        bf16x8 pf[2]; \
        _Pragma("unroll") for (int qi = 0; qi < 2; ++qi) { u32x4 pw; \
          pw.x = pk2(s[qi][kb][rb + 0], s[qi][kb][rb + 1]); pw.y = pk2(s[qi][kb][rb + 2], s[qi][kb][rb + 3]); \
          pw.z = pk2(s[qi][kb][rb + 4], s[qi][kb][rb + 5]); pw.w = pk2(s[qi][kb][rb + 6], s[qi][kb][rb + 7]); \
          pf[qi] = __builtin_bit_cast(bf16x8, pw); } \
        _Pragma("unroll") for (int db = 0; db < 2; ++db) { const bf16x8 vf = vtr2(vfb + st + s4 * 16 * 144 + db * 64); \
          o[0][db] = MFMA(vf, pf[0], o[0][db]); o[1][db] = MFMA(vf, pf[1], o[1][db]); } \
      } \
    } \
    if ((j) + 1 < NT) A_LWRITE(((j) + 1) & 1, rkB, rvB, rrB); \
    __syncthreads(); \
  } while (0)
  for (int j = 0; j < NT; j += 2) {
    A_STEP(j, rk0, rv0, rr0, rk1, rv1, rr1);
    if (j + 1 < NT) A_STEP(j + 1, rk1, rv1, rr1, rk0, rv0, rr0);
  }
#undef A_STEP
#undef A_GLOAD
#undef A_LWRITE
  if (active) {
#pragma unroll
    for (int qi = 0; qi < 2; ++qi) {
      const float lt = l_run[qi] + __shfl_xor(l_run[qi], 32);
      const float inv = 1.f / lt;
      u16* Op = wsp<u16>(p, OFF_O) + (tokq + 32 * qi) * 1024 + obase;
#pragma unroll
      for (int db = 0; db < 2; ++db)
#pragma unroll
        for (int g = 0; g < 4; ++g) {
          u32x2 w;
          w.x = pk2(o[qi][db][4 * g] * inv, o[qi][db][4 * g + 1] * inv);
          w.y = pk2(o[qi][db][4 * g + 2] * inv, o[qi][db][4 * g + 3] * inv);
          *(u32x2*)(Op + db * 32 + 8 * g + 4 * hh) = w;
        }
    }
  }
}
DEVI void phaseD2(KP p, int l, ldsp_t lds) {
  const int G8 = gridDim.x >> 3, xcd = BIDX & 7, lb = BIDX >> 3;
  if (lb >= G8) return;
  const int NLOC = 128 + (l == 0 ? 12 : 0);
  const int nmine = (NLOC - lb + G8 - 1) / G8;
  const int cslot = min((int)(BIDX & 3), nmine - 1);
  int it = 0;
  for (int n = lb; n < NLOC; n += G8, ++it) {
    if (it == cslot) conv_items2(p, l, lds, CONV_EARLY, CONV_ITEMS);
    int br, s, qb; bool isctx = false;
    if (n < 32) { br = 0; s = xcd + 8 * (n >> 3); qb = n & 7; }
    else if (n < 64) { const int m = n - 32; br = 3; s = xcd + 8 * (m >> 4); qb = m & 15; }
    else if (n < 96) { const int m = n - 64; br = 2; s = xcd + 8 * (m >> 3); qb = m & 7; }
    else if (n < 128) { const int m = n - 96; br = 1; s = xcd + 8 * (m >> 4); qb = m & 15; }
    else {
      const int m = n - 128; isctx = true; qb = 0;
      if (m < 4) { br = 0; s = xcd + 8 * m; }
      else if (m < 6) { br = 3; s = xcd + 8 * (m - 4); }
      else if (m < 10) { br = 2; s = xcd + 8 * (m - 6); }
      else { br = 1; s = xcd + 8 * (m - 10); }
    }
    if (br == 0) attn_item2<0>(p, l, s >> 2, s & 3, qb, isctx, lds);
    else if (br == 1) attn_item2<1>(p, l, s >> 1, s & 1, qb, isctx, lds);
    else if (br == 2) attn_item2<2>(p, l, s >> 2, s & 3, qb, isctx, lds);
    else attn_item2<3>(p, l, s >> 1, s & 1, qb, isctx, lds);
  }
}

DEVI int pm_map(int pme, bool skipctx) { return skipctx ? (pme >> 4) * 17 + 1 + (pme & 15) : pme; }
struct SchedE1 { const char* ws; bool skipctx; int G, c;
  DEVI bool next(int i, Unit& u) const { int pm, pn; if (!tile_order(i, G, c, skipctx ? 128 : 136, 16, pm, pn)) return false;
    pm = pm_map(pm, skipctx); const int n = pn >> 2, cq = pn & 3;
    u.A = ws + OFF_O + uoff((unsigned)pm * 256u * 2048u + (unsigned)n * 512u); u.B = ws + OFF_WBR + uoff(((unsigned)n * 1024u + (unsigned)cq * 256u) * 512u); u.rows = nullptr; u.nvalid = 0;
    u.u0 = pm * 256; u.u1 = pn * 256; u.u2 = 0; u.u3 = 0; return true; } };
DEVI void phaseE1(KP p, int l, ldsp_t lds) {
  if (BIDX == 0 && TIDX < 32) wsp<int>(p, OFF_CNT)[TIDX * CNT_STRIDE] = 0;
  SchedE1 S{(const char*)p->ws, l == 1, (int)gridDim.x, BIDX};
  EpiRawBf16 E{wsp<u16>(p, OFF_Z), 4096};
  gemm_phase<true, false>(lds, 2048, 512, 4, S, E);
}
struct SchedE2 { const char* ws; bool skipctx; int G, c;
  DEVI bool next(int i, Unit& u) const { int pm, pn; if (!tile_order(i >> 1, G, c, skipctx ? 128 : 136, 8, pm, pn)) return false;
    pm = pm_map(pm, skipctx); const int pr = i & 1;
    u.A = ws + OFF_H + uoff((unsigned)pm * 256u * 2048u); u.B = ws + OFF_WGATE + uoff((unsigned)(pr * 8 + pn) * 256u * 2048u); u.rows = nullptr; u.nvalid = 0;
    u.u0 = pm * 256; u.u1 = pn * 128; u.u2 = pr; u.u3 = 0; return true; } };
struct EpiE2 { const u16* Z; u16* Y; const float* bias;
  DEVI void init(f32x4 (&acc)[2][2][4][2], const Unit& u, int wr, int wc, int fr, int fq) const {
    const int col0 = u.u1 + wc * 32 + 8 * fq;
#pragma unroll
    for (int bj = 0; bj < 2; ++bj)
#pragma unroll
      for (int nn = 0; nn < 2; ++nn) {
        const f32x4 b = *(const f32x4*)(bias + (2 * u.u2 + bj) * 1024 + col0 + 4 * nn);
#pragma unroll
        for (int a = 0; a < 2; ++a)
#pragma unroll
          for (int m = 0; m < 4; ++m) acc[a][bj][m][nn] = b;
      }
  }
  DEVI void operator()(const f32x4 (&acc)[2][2][4][2], const Unit& u, int wr, int wc, int fr, int fq) const {
    const int row0 = u.u0 + wr * 64 + fr, col0 = u.u1 + wc * 32 + 8 * fq, pr = u.u2;
    u32x4 zq[3][2], yq[3];
    auto ldrow = [&](int g, u32x4 (&z)[2], u32x4& y) {
      const size_t r = (size_t)(row0 + (g >> 2) * HALF + (g & 3) * 16);
#pragma unroll
      for (int bj = 0; bj < 2; ++bj) z[bj] = *(const u32x4*)(Z + r * 4096 + (2 * pr + bj) * 1024 + col0);
      y = pr ? *(const u32x4*)(Y + r * 1024 + col0) : u32x4{0u, 0u, 0u, 0u};
    };
    ldrow(0, zq[0], yq[0]);
    ldrow(1, zq[1], yq[1]);
#pragma unroll
    for (int g = 0; g < 8; ++g) {
      const int ai = g >> 2, m = g & 3, c = g % 3;
      if (g + 2 < 8) ldrow(g + 2, zq[(g + 2) % 3], yq[(g + 2) % 3]);
      const size_t r = (size_t)(row0 + ai * HALF + m * 16);
      float t[8];
      {
        const unsigned w[4] = {yq[c].x, yq[c].y, yq[c].z, yq[c].w};
#pragma unroll
        for (int i = 0; i < 4; ++i) { t[2 * i] = __uint_as_float(w[i] << 16); t[2 * i + 1] = __uint_as_float(w[i] & 0xffff0000u); }
      }
#pragma unroll
      for (int bj = 0; bj < 2; ++bj) {
        const unsigned w[4] = {zq[c][bj].x, zq[c][bj].y, zq[c][bj].z, zq[c][bj].w};
#pragma unroll
        for (int nn = 0; nn < 2; ++nn)
#pragma unroll
          for (int j = 0; j < 4; ++j) {
            const int e = 4 * nn + j;
            const float zz = (e & 1) ? __uint_as_float(w[e >> 1] & 0xffff0000u) : __uint_as_float(w[e >> 1] << 16);
            const float gte = __builtin_amdgcn_rcpf(1.f + __expf(-acc[ai][bj][m][nn][j]));
            t[e] += gte * zz;
          }
      }
      u32x4 o; o.x = pk2(t[0], t[1]); o.y = pk2(t[2], t[3]); o.z = pk2(t[4], t[5]); o.w = pk2(t[6], t[7]);
      *(u32x4*)(Y + r * 1024 + col0) = o;
    }
  }
};
DEVI void phaseE2(KP p, int l, ldsp_t lds) {
  SchedE2 S{(const char*)p->ws, l == 1, (int)gridDim.x, BIDX};
  EpiE2 E{wsp<u16>(p, OFF_Z), wsp<u16>(p, OFF_YPRE), p->b_gate + (size_t)l * 4 * 1024};
  gemm_phase<true, false>(lds, 2048, 2048, 16, S, E);
}
struct SchedF { const char* ws; bool skipctx; int G, c;
  DEVI bool next(int i, Unit& u) const { int pm, pn; if (!tile_order(i, G, c, skipctx ? 128 : 136, 4, pm, pn)) return false;
    pm = pm_map(pm, skipctx);
    u.A = ws + OFF_YPRE + uoff((unsigned)pm * 256u * 2048u); u.B = ws + OFF_WOUT + uoff((unsigned)pn * 256u * 2048u); u.rows = nullptr; u.nvalid = 0;
    u.u0 = pm; u.u1 = pn * 256; u.u2 = 0; u.u3 = 0; return true; } };
struct EpiF { KP p; int l;
  DEVI void init(f32x4 (&acc)[2][2][4][2], const Unit&, int, int, int, int) const { acc_zero(acc); }
  DEVI void operator()(const f32x4 (&acc)[2][2][4][2], const Unit& u, int wr, int wc, int fr, int fq) const {
    const int pm = u.u0, b = pm / 17, rr0 = (pm % 17) * 256;
    const int mrow = (rr0 < NCTX) ? 8 : b;
    const int col0 = u.u1 + wc * 32 + 4 * fq;
    const float* gt = wsp<float>(p, OFF_MOD) + ((size_t)l * 9 + mrow) * 6144 + 2048 + col0;
    const float* xin = xrow_in(p, l, b, rr0) + col0;
    float* xout = xrow_res(p, b, rr0) + col0;
    f32x4 gv[2][2];
#pragma unroll
    for (int bj = 0; bj < 2; ++bj)
#pragma unroll
      for (int n = 0; n < 2; ++n) gv[bj][n] = *(const f32x4*)(gt + bj * HALF + n * 16);
#pragma unroll
    for (int ai = 0; ai < 2; ++ai)
#pragma unroll
      for (int mp = 0; mp < 2; ++mp) {
        f32x4 xo[2][2][2];
#pragma unroll
        for (int mm = 0; mm < 2; ++mm) {
          const size_t ro = (size_t)(wr * 64 + fr + ai * HALF + (2 * mp + mm) * 16) * 1024;
#pragma unroll
          for (int bj = 0; bj < 2; ++bj)
#pragma unroll
            for (int n = 0; n < 2; ++n) xo[mm][bj][n] = *(const f32x4*)(xin + ro + bj * HALF + n * 16);
        }
#pragma unroll
        for (int mm = 0; mm < 2; ++mm) {
          const int m = 2 * mp + mm;
          const size_t ro = (size_t)(wr * 64 + fr + ai * HALF + m * 16) * 1024;
#pragma unroll
          for (int bj = 0; bj < 2; ++bj)
#pragma unroll
            for (int n = 0; n < 2; ++n) *(f32x4*)(xout + ro + bj * HALF + n * 16) = xo[mm][bj][n] + gv[bj][n] * acc[ai][bj][m][n];
        }
      }
  }
};
DEVI void phaseF2(KP p, int l, ldsp_t lds) {
  SchedF S{(const char*)p->ws, l == 1, (int)gridDim.x, BIDX};
  EpiF E{p, l};
  gemm_phase<false, false>(lds, 2048, 2048, 16, S, E);
}


DEVI void phase0_2(KP p, ldsp_t lds) {
  const int tid = TIDX, half = tid >> 8, htid = tid & 255;
  for (int it = BIDX * 2; it < 458; it += gridDim.x * 2) {
    const int item = it + half;
    LAS float* sc = (LAS float*)(lds + half * 16384);
    const bool ismod = item < 384;
    const int l = item / 192, rem = item % 192, cgp = rem >> 3, kc = rem & 7;
    __syncthreads();
    if (ismod) {
      for (int i = htid; i < 9 * 128; i += 256) {
        int b = i >> 7, k = i & 127;
        float v = (b < 8) ? p->c[b * 1024 + kc * 128 + k] : p->c_ctx[kc * 128 + k];
        sc[i] = v / (1.f + __expf(-v));
      }
    }
    __syncthreads();
    if (ismod) {
      float acc[9];
#pragma unroll
      for (int b = 0; b < 9; ++b) acc[b] = 0.f;
      const float* w = p->w_mod + ((size_t)l * 1024 + kc * 128) * 6144 + cgp * 256 + htid;
#pragma unroll 32
      for (int k = 0; k < 128; ++k) {
        float wv = w[(size_t)k * 6144];
#pragma unroll
        for (int b = 0; b < 9; ++b) acc[b] += sc[b * 128 + k] * wv;
      }
      float* dst = wsp<float>(p, OFF_MODP) + (size_t)((kc * 2 + l) * 9) * 6144 + cgp * 256 + htid;
#pragma unroll
      for (int b = 0; b < 9; ++b) dst[(size_t)b * 6144] = acc[b];
    } else if (item == 384) {
      float* cs32 = wsp<float>(p, OFF_CS32);
      float* cs16 = wsp<float>(p, OFF_CS16);
      for (int t = htid; t < 1024; t += 256) {
        int pos = t >> 4, i = t & 15;
        float ang = (float)pos * __builtin_amdgcn_exp2f(-(float)(2 * i) * (13.287712379549449f / 32.f));
        cs32[t * 2] = __cosf(ang); cs32[t * 2 + 1] = __sinf(ang);
      }
      for (int t = htid; t < 512; t += 256) {
        int pos = t >> 3, i = t & 7;
        float ang = (float)pos * __builtin_amdgcn_exp2f(-(float)(2 * i) * (13.287712379549449f / 16.f));
        cs16[t * 2] = __cosf(ang); cs16[t * 2 + 1] = __sinf(ang);
      }
    } else if (item < 457) {
      const int q = item - 385, ll = q / 36, o = q % 36;
      float* dst = wsp<float>(p, OFF_WRT) + ((size_t)ll * 36 + o) * 1024;
      for (int k = htid; k < 1024; k += 256)
        dst[k] = (o < 4) ? p->w_group[((size_t)ll * 1024 + k) * 4 + o] : p->w_router[((size_t)ll * 1024 + k) * 32 + (o - 4)];
    }
  }
}
DEVI void phase1_2(KP p) {
  const float* mp = wsp<float>(p, OFF_MODP);
  float* mo = wsp<float>(p, OFF_MOD);
  for (int i = BIDX * 512 + TIDX; i < 2 * 9 * 6144; i += gridDim.x * 512) {
    int l = i / (9 * 6144), o = i % 6144;
    float s = p->b_mod[l * 6144 + o];
#pragma unroll
    for (int kc = 0; kc < 8; ++kc) s += mp[(size_t)kc * 2 * 9 * 6144 + i];
    mo[i] = s;
  }
}
DEVI void phaseA2(KP p) {
  const int gw = BIDX * NW + (TIDX >> 6), nw = gridDim.x * NW;
  u16* H = wsp<u16>(p, OFF_H);
  for (int tok0 = gw; tok0 < NTOK; tok0 += 2 * nw) {
    float xv[2][16];
#pragma unroll
    for (int r = 0; r < 2; ++r) { const int tok = tok0 + r * nw; if (tok < NTOK) load_row16(xrow_in(p, 0, tok / TPB, tok % TPB), xv[r]); }
#pragma unroll
    for (int r = 0; r < 2; ++r) {
      const int tok = tok0 + r * nw;
      if (tok < NTOK) { float hv[16]; modulate_row_store(p, 0, 0, xv[r], (tok % TPB) < NCTX ? 8 : tok / TPB, H + (size_t)tok * 1024, hv); }
    }
  }
}
DEVI void phaseG2(KP p, int l, ldsp_t lds) {
  constexpr int HS = 1026;
  const int tid = TIDX, lane = tid & 63, wave = __builtin_amdgcn_readfirstlane(tid >> 6);
  const int r32 = lane & 31, kh = lane >> 5, qd = lane >> 4;
  u16* H = wsp<u16>(p, OFF_H);
  const float* WRT = wsp<float>(p, OFF_WRT) + (size_t)l * 36 * 1024;
  int* cnt = wsp<int>(p, OFF_CNT);
  int* list = wsp<int>(p, OFF_LIST);
  float* wlist = wsp<float>(p, OFF_WLIST);
  LAS float* h2t = (LAS float*)lds;
  LAS float* part = (LAS float*)lds;
  LAS int* gsel = (LAS int*)(lds + 32 * HS * 4);
  LAS float* gwt = (LAS float*)(lds + 32 * HS * 4 + 128);
  float wreg[64];
  {
    const float* wr = p->w_router + (size_t)l * 1024 * 32 + r32;
#pragma unroll
    for (int t = 0; t < 32; ++t) {
      const int k = 128 * wave + 4 * t + 2 * kh;
      wreg[2 * t] = wr[(size_t)k * 32]; wreg[2 * t + 1] = wr[(size_t)(k + 1) * 32];
    }
  }
  for (int tile = BIDX; tile < NTOK / 32; tile += gridDim.x) {
    const int tok0 = tile * 32, b = tok0 / TPB, rr0 = tok0 % TPB;
    if (l == 1 && rr0 < NCTX) continue;
    {
      float hv[4][16], xv4[4][16];
#pragma unroll
      for (int r = 0; r < 4; ++r) load_row16(xrow_res(p, b, rr0 + wave * 4 + r), xv4[r]);
#pragma unroll
      for (int r = 0; r < 4; ++r) {
        modulate_row_store(p, l, 1, xv4[r], (rr0 < NCTX) ? 8 : b, H + (size_t)(tok0 + wave * 4 + r) * 1024, hv[r]);
        LAS float* dst = h2t + (wave * 4 + r) * HS + lane * 4;
#pragma unroll
        for (int i = 0; i < 4; ++i) {
          *(LAS f32x2*)(dst + i * 256) = f32x2{hv[r][i * 4], hv[r][i * 4 + 1]};
          *(LAS f32x2*)(dst + i * 256 + 2) = f32x2{hv[r][i * 4 + 2], hv[r][i * 4 + 3]};
        }
      }
      float gl[4];
#pragma unroll
      for (int o = 0; o < 4; ++o) gl[o] = router_dot(hv, WRT + (size_t)o * 1024) + p->b_group[l * 4 + o];
      int gs = 0; float best = gl[0];
#pragma unroll
      for (int j = 1; j < 4; ++j) if (gl[j] > best) { best = gl[j]; gs = j; }
      float gsum = 0.f;
#pragma unroll
      for (int j = 0; j < 4; ++j) gsum += __expf(gl[j] - best);
      if ((lane & 15) == 0) { gsel[wave * 4 + qd] = gs; gwt[wave * 4 + qd] = 1.f / gsum; }
    }
    __syncthreads();
    f32x16 acc;
#pragma unroll
    for (int i = 0; i < 16; ++i) acc[i] = 0.f;
    {
      const LAS float* ap = h2t + r32 * HS + 128 * wave + 2 * kh;
#pragma unroll
      for (int t = 0; t < 32; ++t) {
        const f32x2 a = *(const LAS f32x2*)(ap + 4 * t);
        acc = __builtin_amdgcn_mfma_f32_32x32x2f32(a.x, wreg[2 * t], acc, 0, 0, 0);
        acc = __builtin_amdgcn_mfma_f32_32x32x2f32(a.y, wreg[2 * t + 1], acc, 0, 0, 0);
      }
    }
    __syncthreads();
#pragma unroll
    for (int i = 0; i < 16; ++i) part[(wave * 32 + (i & 3) + 8 * (i >> 2) + 4 * kh) * 33 + r32] = acc[i];
    __syncthreads();
    if (tid < 32) {
      const int gs = gsel[tid];
      const float gw_ = gwt[tid];
      float e8[8];
#pragma unroll
      for (int j = 0; j < 8; ++j) {
        float v = p->b_router[l * 32 + gs * 8 + j];
#pragma unroll
        for (int w = 0; w < 8; ++w) v += part[(w * 32 + tid) * 33 + gs * 8 + j];
        e8[j] = v;
      }
      int i0 = 0; float v0 = e8[0];
#pragma unroll
      for (int j = 1; j < 8; ++j) if (e8[j] > v0) { v0 = e8[j]; i0 = j; }
      int i1 = -1; float v1 = -INFINITY;
#pragma unroll
      for (int j = 0; j < 8; ++j) if (j != i0 && e8[j] > v1) { v1 = e8[j]; i1 = j; }
      const float ex = __expf(v1 - v0);
      const float w0 = gw_ / (1.f + ex), w1 = gw_ * ex / (1.f + ex);
      const int tok = tok0 + tid;
      const int ea = gs * 8 + i0, eb = gs * 8 + i1;
      const int sa = atomicAdd(&cnt[ea * CNT_STRIDE], 1);
      const int sb = atomicAdd(&cnt[eb * CNT_STRIDE], 1);
      list[(size_t)ea * NTOK + sa] = tok * 2; wlist[(size_t)ea * NTOK + sa] = w0;
      list[(size_t)eb * NTOK + sb] = tok * 2 + 1; wlist[(size_t)eb * NTOK + sb] = w1;
    }
    __syncthreads();
  }
}
struct ExpInfo2 { int tiles[4], base[4], cnt[4]; };
DEVI ExpInfo2 exp_info2(KP p, int xcd) {
  const int* cnt = wsp<int>(p, OFF_CNT);
  ExpInfo2 ei;
  int before = 0;
#pragma unroll
  for (int e = 0; e < 32; ++e) {
    const int c = __builtin_amdgcn_readfirstlane(cnt[e * CNT_STRIDE]), t = (c + 255) >> 8;
    if ((e & 7) == xcd) { ei.tiles[e >> 3] = t; ei.base[e >> 3] = before; ei.cnt[e >> 3] = c; }
    before += t;
  }
  return ei;
}
template <int NN>
struct SchedX { ExpInfo2 ei; int xcd, lb, G8; const char* A; const char* W; const int* list; size_t wstride; int lda_b;
  DEVI bool next(int i, Unit& u) const {
    const int tot = (ei.tiles[0] + ei.tiles[1] + ei.tiles[2] + ei.tiles[3]) * NN;
    const int n = i * G8 + lb; if (n >= tot) return false;
    int k = 0, m = n / NN; const int pn = n % NN;
    int tb = ei.base[0], ce = ei.cnt[0];
#pragma unroll
    for (int kk = 0; kk < 3; ++kk) { if (k == kk && m >= ei.tiles[kk]) { m -= ei.tiles[kk]; k = kk + 1; tb = ei.base[kk + 1]; ce = ei.cnt[kk + 1]; } }
    const int e = xcd + 8 * k;
    u.rows = list + (size_t)e * NTOK + m * 256; u.nvalid = ce - m * 256;
    u.A = A + (NN == 2 ? 0u : uoff((unsigned)(tb + m) * 256u * (unsigned)lda_b));
    u.B = W + uoff((unsigned)e * (unsigned)wstride + (unsigned)pn * 256u * (NN == 2 ? 2048u : 512u));
    u.u0 = (tb + m) * 256; u.u1 = pn; u.u2 = e; u.u3 = m; return true; } };
struct EpiI1 { u16* U;
  DEVI void init(f32x4 (&acc)[2][2][4][2], const Unit&, int, int, int, int) const { acc_zero(acc); }
  DEVI void operator()(const f32x4 (&acc)[2][2][4][2], const Unit& u, int wr, int wc, int fr, int fq) const {
#pragma unroll
    for (int ai = 0; ai < 2; ++ai)
#pragma unroll
      for (int m = 0; m < 4; ++m) {
        u16* rowp = U + (size_t)(u.u0 + ai * HALF + wr * 64 + m * 16 + fr) * 256;
#pragma unroll
        for (int bj = 0; bj < 2; ++bj) {
          const int ff = 16 * (8 * u.u1 + 4 * bj + wc) + 4 * fq;
          const f32x4 g = acc[ai][bj][m][0], up = acc[ai][bj][m][1];
          float t[4];
#pragma unroll
          for (int j = 0; j < 4; ++j) t[j] = g[j] / (1.f + __expf(-g[j])) * up[j];
          u32x2 o; o.x = pk2(t[0], t[1]); o.y = pk2(t[2], t[3]);
          *(u32x2*)(rowp + ff) = o;
        }
      }
  }
};
DEVI void phaseI1_2(KP p, ldsp_t lds) {
  const int xcd = BIDX & 7, lb = BIDX >> 3, G8 = gridDim.x >> 3;
  if (lb >= G8) return;
  SchedX<2> S{exp_info2(p, xcd), xcd, lb, G8, (const char*)wsp<u16>(p, OFF_H), (const char*)wsp<u16>(p, OFF_W13), wsp<int>(p, OFF_LIST), (size_t)512 * 2048, 2048};
  EpiI1 E{wsp<u16>(p, OFF_U)};
  int nt = 16; asm volatile("" : "+s"(nt));
  gemm_phase<false, true>(lds, 2048, 2048, nt, S, E);
}
struct EpiI2 { u16* YS; const float* wlist; const int* list;
  DEVI void init(f32x4 (&acc)[2][2][4][2], const Unit&, int, int, int, int) const { acc_zero(acc); }
  DEVI void operator()(const f32x4 (&acc)[2][2][4][2], const Unit& u, int wr, int wc, int fr, int fq) const {
    const unsigned colb = (unsigned)(u.u1 * 256 + wc * 32 + 8 * fq) * 2u;
    const float* we = wlist + (u.rows - list);
    unsigned dest[2][4]; float w[2][4];
#pragma unroll
    for (int ai = 0; ai < 2; ++ai)
#pragma unroll
      for (int m = 0; m < 4; ++m) {
        const int r = ai * HALF + wr * 64 + m * 16 + fr;
        dest[ai][m] = (r < u.nvalid) ? (unsigned)u.rows[r] : (unsigned)(2 * NTOK);
        w[ai][m] = we[r];
      }
#pragma unroll
    for (int ai = 0; ai < 2; ++ai)
#pragma unroll
      for (int m = 0; m < 4; ++m) {
        char* rowp = (char*)YS + (dest[ai][m] * 2048u + colb);
#pragma unroll
        for (int bj = 0; bj < 2; ++bj) {
          const f32x4 v0 = acc[ai][bj][m][0] * w[ai][m], v1 = acc[ai][bj][m][1] * w[ai][m];
          u32x4 o; o.x = pk2(v0[0], v0[1]); o.y = pk2(v0[2], v0[3]); o.z = pk2(v1[0], v1[1]); o.w = pk2(v1[2], v1[3]);
          *(u32x4*)(rowp + bj * 256) = o;
        }
      }
  }
};
DEVI void phaseI2_2(KP p, ldsp_t lds) {
  const int xcd = BIDX & 7, lb = BIDX >> 3, G8 = gridDim.x >> 3;
  if (lb >= G8) return;
  SchedX<4> S{exp_info2(p, xcd), xcd, lb, G8, (const char*)wsp<u16>(p, OFF_U), (const char*)wsp<u16>(p, OFF_W2), wsp<int>(p, OFF_LIST), (size_t)1024 * 512, 512};
  EpiI2 E{wsp<u16>(p, OFF_YS), wsp<float>(p, OFF_WLIST), wsp<int>(p, OFF_LIST)};
  int nt = 4; asm volatile("" : "+s"(nt));
  gemm_phase<true, false>(lds, 512, 512, nt, S, E);
}
DEVI void phaseJ2(KP p, int l, ldsp_t lds) {
  const int lane = TIDX & 63;
  const int gw = BIDX * NW + (TIDX >> 6), nw = gridDim.x * NW;
  const u16* YS = wsp<u16>(p, OFF_YS);
  u16* H = wsp<u16>(p, OFF_H);
  for (int tok0 = gw; tok0 < NTOK; tok0 += 2 * nw) {
    float xv[2][16]; u32x2 y0[2][4], y1[2][4]; bool ok[2]; int tk[2];
#pragma unroll
    for (int r = 0; r < 2; ++r) {
      const int tok = tok0 + r * nw;
      tk[r] = tok;
      ok[r] = (tok < NTOK) && !(l == 1 && (tok % TPB) < NCTX);
      if (ok[r]) {
        const int b = tok / TPB, rr = tok % TPB;
        load_row16(xrow_res(p, b, rr), xv[r]);
#pragma unroll
        for (int i = 0; i < 4; ++i) {
          const int c = i * 256 + lane * 4;
          y0[r][i] = *(const u32x2*)(YS + (size_t)(tok * 2) * 1024 + c);
          y1[r][i] = *(const u32x2*)(YS + (size_t)(tok * 2 + 1) * 1024 + c);
        }
      }
    }
#pragma unroll
    for (int r = 0; r < 2; ++r) {
      if (!ok[r]) continue;
      const int tok = tk[r];
      const int b = tok / TPB, rr = tok % TPB;
      const int mrow = (rr < NCTX) ? 8 : b;
      float* xr = xrow_res(p, b, rr);
      const float* gt = wsp<float>(p, OFF_MOD) + ((size_t)l * 9 + mrow) * 6144 + 5120;
#pragma unroll
      for (int i = 0; i < 4; ++i) {
        const int c = i * 256 + lane * 4;
        const f32x4 g = *(const f32x4*)(gt + c);
        xv[r][i * 4 + 0] += g.x * (bf2f((u16)(y0[r][i].x & 0xffff)) + bf2f((u16)(y1[r][i].x & 0xffff)));
        xv[r][i * 4 + 1] += g.y * (bf2f((u16)(y0[r][i].x >> 16)) + bf2f((u16)(y1[r][i].x >> 16)));
        xv[r][i * 4 + 2] += g.z * (bf2f((u16)(y0[r][i].y & 0xffff)) + bf2f((u16)(y1[r][i].y & 0xffff)));
        xv[r][i * 4 + 3] += g.w * (bf2f((u16)(y0[r][i].y >> 16)) + bf2f((u16)(y1[r][i].y >> 16)));
      }
      if (l == 0) {
#pragma unroll
        for (int i = 0; i < 4; ++i)
          *(f32x4*)(xr + i * 256 + lane * 4) = f32x4{xv[r][i * 4], xv[r][i * 4 + 1], xv[r][i * 4 + 2], xv[r][i * 4 + 3]};
        float hv[16];
        modulate_row_store(p, 1, 0, xv[r], mrow, H + (size_t)tok * 1024, hv);
      } else {
        float ss = 0.f;
#pragma unroll
        for (int i = 0; i < 16; ++i) ss += xv[r][i] * xv[r][i];
        ss = wave_sum(ss);
        const float rstd = rsqrtf(ss * (1.f / 1024.f) + EPS);
#pragma unroll
        for (int i = 0; i < 4; ++i) {
          const int c = i * 256 + lane * 4;
          const f32x4 g = *(const f32x4*)(p->g_final + c);
          *(f32x4*)(xr + c) = f32x4{xv[r][i * 4] * rstd * g.x, xv[r][i * 4 + 1] * rstd * g.y, xv[r][i * 4 + 2] * rstd * g.z, xv[r][i * 4 + 3] * rstd * g.w};
        }
      }
    }
  }
}

constexpr int N_PHASES = 3 + 2 * 11;
__global__ void __launch_bounds__(512, 2) fwd_v2(Params parg) {
  extern __shared__ __attribute__((aligned(16))) unsigned char dyn_lds[];
  const ldsp_t lds = (ldsp_t)dyn_lds;
  cg::grid_group grid = cg::this_grid();
  volatile LAS unsigned* xb_st = (volatile LAS unsigned*)(lds + LDS_BARW);
  if (TIDX < 4) xb_st[TIDX] = 0u;
  __syncthreads();
  if (parg.ph_end - parg.ph_begin > 1) xcd_barrier_post((unsigned*)(parg.ws + OFF_BAR));
  for (int ph = parg.ph_begin; ph < parg.ph_end; ++ph) {
    KP p = (KP)__builtin_amdgcn_kernarg_segment_ptr();
    asm volatile("" : "+s"(p));
    const int l = (ph >= 14) ? 1 : 0;
    const int k = (ph < 3) ? ph : 3 + (ph - 3) % 11;
    const int reps = (((PROBE_DUP >> k) & 1) && (!(PROBE_DUP & 0x10000) || l == 0)) ? 2 : 1;
    for (int rep = 0; rep < reps; ++rep) {
      if (rep) {
        xcd_barrier((unsigned*)(p->ws + OFF_BAR), xb_st);
        if (k == 10) { if (BIDX == 0 && TIDX < 32) wsp<int>(p, OFF_CNT)[TIDX * CNT_STRIDE] = 0; xcd_barrier((unsigned*)(p->ws + OFF_BAR), xb_st); }
      }
      switch (k) {
        case 0: phase0_2(p, lds); break;
        case 1: phase1_2(p); break;
        case 2: phaseA2(p); break;
        case 3: phaseB2(p, lds); break;
        case 4: phaseC2(p, lds); break;
        case 5: phaseP2(p, l, lds); break;
        case 6: phaseD2(p, l, lds); break;
        case 7: phaseE1(p, l, lds); break;
        case 8: phaseE2(p, l, lds); break;
        case 9: phaseF2(p, l, lds); break;
        case 10: phaseG2(p, l, lds); break;
        case 11: phaseI1_2(p, lds); break;
        case 12: phaseI2_2(p, lds); break;
        default: phaseJ2(p, l, lds); break;
      }
    }
    if (k == 0 || (k == 13 && l == 0)) conv_items2(p, k == 0 ? 0 : 1, lds, 0, CONV_EARLY);
    if (ph + 1 < parg.ph_end) {
      if (parg.ph_begin >= 1000) grid.sync();
      else xcd_barrier((unsigned*)(p->ws + OFF_BAR), xb_st);
    }
  }
}
}

extern "C" void kernel_launch(void* const* d_in, const int* in_sizes, int n_in, void* d_out, int out_size,
                              void* d_ws, size_t ws_size, hipStream_t stream) {
  static int grid2 = 0;
  if (!grid2) {
    int dev = 0, cus = 0, per_cu = 0;
    (void)hipGetDevice(&dev);
    (void)hipDeviceGetAttribute(&cus, hipDeviceAttributeMultiprocessorCount, dev);
    (void)hipFuncSetAttribute((const void*)v2::fwd_v2, hipFuncAttributeMaxDynamicSharedMemorySize, v2::LDS_TOTAL);
    (void)hipOccupancyMaxActiveBlocksPerMultiprocessor(&per_cu, v2::fwd_v2, 512, v2::LDS_TOTAL);
    if (per_cu < 1) { fprintf(stderr, "kernel does not fit on a CU\n"); per_cu = 1; }
    grid2 = cus & ~7;
  }
  if (ws_size < WS_NEEDED) { fprintf(stderr, "workspace too small: %zu < %zu\n", ws_size, (size_t)WS_NEEDED); return; }
  Params hp{};
  const float** f = (const float**)&hp;
  for (int i = 0; i < 29; ++i) f[i] = (const float*)d_in[i];
  hp.out = (float*)d_out;
  hp.ws = (char*)d_ws;
#if N_LAUNCH_MODE == 1
  for (int ph = 0; ph < v2::N_PHASES; ++ph) {
    hp.ph_begin = ph; hp.ph_end = ph + 1;
    void* args[] = {&hp};
    hipError_t e = hipLaunchCooperativeKernel((void*)v2::fwd_v2, dim3(grid2), dim3(512), args, v2::LDS_TOTAL, stream);
    if (e != hipSuccess) fprintf(stderr, "launch failed: %s\n", hipGetErrorString(e));
  }
#else
  hp.ph_begin = 0; hp.ph_end = v2::N_PHASES;
  (void)hipMemsetAsync((char*)d_ws + OFF_BAR, 0, (size_t)XCD_BAR_WORDS * 4, stream);
  void* args[] = {&hp};
  hipError_t e = hipLaunchCooperativeKernel((void*)v2::fwd_v2, dim3(grid2), dim3(512), args, v2::LDS_TOTAL, stream);
  if (e != hipSuccess) fprintf(stderr, "cooperative launch failed: %s (grid %d)\n", hipGetErrorString(e), grid2);
#endif
}
```

```cpp
#include <hip/hip_runtime.h>
#include <hip/hip_cooperative_groups.h>
#include <stdint.h>
#include <stdio.h>
namespace cg = cooperative_groups;

#ifndef N_LAUNCH_MODE
#define N_LAUNCH_MODE 0
#endif

#ifndef PROBE_DUP
#define PROBE_DUP 0
#endif
#define DEVI __device__ __forceinline__
typedef unsigned short u16;
typedef __attribute__((ext_vector_type(2))) float f32x2;
typedef __attribute__((ext_vector_type(2))) __bf16 bf16x2_t;
typedef __attribute__((ext_vector_type(8))) short bf16x8;
typedef __attribute__((ext_vector_type(16))) float f32x16;
typedef __attribute__((ext_vector_type(4))) unsigned u32x4;
typedef __attribute__((ext_vector_type(2))) unsigned u32x2;
typedef __attribute__((ext_vector_type(4))) float f32x4;
#define MFMA(a, b, c) __builtin_amdgcn_mfma_f32_32x32x16_bf16((a), (b), (c), 0, 0, 0)

constexpr int DMODEL = 1024, NBATCH = 8, SEQ = 4096, NCTX = 256;
constexpr int TPB = SEQ + NCTX;
constexpr int NTOK = NBATCH * TPB;
constexpr int MT_PER_B = TPB / 128;
constexpr int NEXP = 32;
constexpr int INP = 2304;
constexpr float EPS = 1e-6f;
constexpr float LOG2E = 1.4426950408889634f;
constexpr int SMEM_BYTES = 73728;
constexpr int UROWS = 2 * NTOK + NEXP * 256;

constexpr size_t al(size_t x) { return (x + 255) & ~(size_t)255; }
constexpr size_t OFF_WIN = 0;
constexpr size_t OFF_WQB = OFF_WIN + al((size_t)INP * 1024 * 2);
constexpr size_t OFF_WKVB = OFF_WQB + al((size_t)512 * 256 * 2);
constexpr size_t OFF_WGATE = OFF_WKVB + al((size_t)512 * 256 * 2);
constexpr size_t OFF_WBR = OFF_WGATE + al((size_t)4 * 1024 * 1024 * 2);
constexpr size_t OFF_WOUT = OFF_WBR + al((size_t)4 * 1024 * 256 * 2);
constexpr size_t OFF_W13 = OFF_WOUT + al((size_t)1024 * 1024 * 2);
constexpr size_t OFF_W2 = OFF_W13 + al((size_t)32 * 512 * 1024 * 2);
constexpr size_t OFF_MODP = OFF_W2 + al((size_t)32 * 1024 * 256 * 2);
constexpr size_t OFF_MOD = OFF_MODP + al((size_t)8 * 2 * 9 * 6144 * 4);
constexpr size_t OFF_CS32 = OFF_MOD + al((size_t)2 * 9 * 6144 * 4);
constexpr size_t OFF_CS16 = OFF_CS32 + al((size_t)64 * 16 * 2 * 4);
constexpr size_t OFF_WRT = OFF_CS16 + al((size_t)64 * 8 * 2 * 4);
constexpr size_t OFF_CNT = OFF_WRT + al((size_t)2 * 36 * 1024 * 4);
constexpr int CNT_STRIDE = 64;
constexpr size_t OFF_BAR = OFF_CNT + al(32 * CNT_STRIDE * 4);
constexpr int XCD_BAR_WORDS = 3456;
constexpr size_t OFF_CTXRES = OFF_BAR + al((size_t)XCD_BAR_WORDS * 4);
constexpr size_t OFF_DEP = OFF_CTXRES;
constexpr int DEP_STRIDE = 16, DEP_TILECTR = 2 * 136 * DEP_STRIDE, DEP_WORDS = DEP_TILECTR + 2 * DEP_STRIDE;
constexpr size_t OFF_H = OFF_CTXRES + al((size_t)8 * 256 * 1024 * 4);
constexpr size_t OFF_O = OFF_H + al((size_t)NTOK * 1024 * 2);
constexpr size_t OFF_SSQ = OFF_O + al((size_t)NTOK * 1024 * 2);
constexpr size_t OFF_LIST = OFF_SSQ + al((size_t)NTOK * 8 * 4);
constexpr size_t OFF_WLIST = OFF_LIST + al((size_t)32 * NTOK * 4);
constexpr size_t OFF_R1 = OFF_WLIST + al((size_t)32 * NTOK * 4);
constexpr int PLD = INP;
constexpr size_t OFF_PRAW = OFF_R1;
constexpr size_t OFF_QARAW = OFF_PRAW + (size_t)NTOK * INP * 2;
constexpr size_t OFF_KVARAW = OFF_QARAW + (size_t)NTOK * 512 * 2;
constexpr size_t OFF_VAT = OFF_KVARAW + (size_t)NTOK * 512 * 2;
constexpr size_t OFF_VBT = OFF_VAT + (size_t)NTOK * 256 * 2;
constexpr size_t OFF_VCT = OFF_VBT + (size_t)NTOK * 128 * 2;
constexpr size_t OFF_VDT = OFF_VCT + (size_t)NTOK * 256 * 2;
constexpr size_t OFF_END = OFF_VDT + (size_t)NTOK * 128 * 2;
constexpr size_t OFF_Z = OFF_R1;
constexpr size_t OFF_Y8 = OFF_H;
constexpr size_t OFF_H2 = OFF_O;
constexpr size_t OFF_YPRE = OFF_O;
constexpr size_t OFF_U = OFF_R1;
constexpr size_t OFF_YS = OFF_R1 + al((size_t)UROWS * 256 * 2);
constexpr size_t OFF_XM = OFF_YS + al((size_t)(2 * NTOK + 1) * 1024 * 2);
static_assert(OFF_XM + (size_t)NTOK * 1024 * 2 <= OFF_END, "alias overflow");
static_assert(OFF_Z + (size_t)NTOK * 4096 * 2 <= OFF_END, "alias overflow");
static_assert(OFF_YS + (size_t)(2 * NTOK + 1) * 1024 * 2 <= OFF_END, "alias overflow");
constexpr size_t WS_NEEDED = OFF_END;
static_assert(WS_NEEDED <= (size_t)536870912, "workspace budget (4 x largest tensor)");

struct Params {
  const float *x, *c, *ctx, *c_ctx, *w_mod, *b_mod, *g_norm_mix, *w_in, *g_q_a, *w_q_b, *g_kv_a, *w_kv_b,
      *sink_b, *rpb_c, *g_q_d, *g_k_d, *w_gate, *b_gate, *w_branch, *w_out, *g_norm_ffn, *w_group, *b_group,
      *w_router, *b_router, *w_ff1, *w_ff3, *w_ff2, *g_final;
  float* out;
  char* ws;
  int ph_begin, ph_end;
};

DEVI int tid_fresh() { int t; asm volatile("v_mov_b32 %0, %1" : "=v"(t) : "v"(__builtin_amdgcn_workitem_id_x())); return t; }
DEVI int bid_fresh() { int t; asm volatile("s_mov_b32 %0, %1" : "=s"(t) : "s"(__builtin_amdgcn_workgroup_id_x())); return t; }
#define TIDX tid_fresh()
#define BIDX bid_fresh()
typedef const __attribute__((address_space(4))) Params* KP;
DEVI unsigned pk2(float a, float b) { f32x2 v = {a, b}; bf16x2_t r = __builtin_convertvector(v, bf16x2_t); return __builtin_bit_cast(unsigned, r); }
DEVI u16 f2bf(float a) { return (u16)(pk2(a, 0.f) & 0xffffu); }
DEVI float bf2f(u16 v) { return __uint_as_float(((unsigned)v) << 16); }
DEVI float wave_sum(float v) {
#pragma unroll
  for (int m = 32; m >= 1; m >>= 1) v += __shfl_xor(v, m);
  return v;
}
template <class T> DEVI T* wsp(KP p, size_t off) { return (T*)(p->ws + off); }
DEVI const float* xrow_in(KP p, int l, int b, int rr) {
  if (l == 0) return (rr < NCTX) ? p->ctx + ((size_t)b * NCTX + rr) * 1024 : p->x + ((size_t)b * SEQ + rr - NCTX) * 1024;
  return (rr < NCTX) ? wsp<float>(p, OFF_CTXRES) + ((size_t)b * NCTX + rr) * 1024 : p->out + ((size_t)b * SEQ + rr - NCTX) * 1024;
}
DEVI float* xrow_res(KP p, int b, int rr) {
  return (rr < NCTX) ? wsp<float>(p, OFF_CTXRES) + ((size_t)b * NCTX + rr) * 1024 : p->out + ((size_t)b * SEQ + rr - NCTX) * 1024;
}
DEVI int perm16(int k) { return (k & ~12) | ((k & 4) << 1) | ((k & 8) >> 1); }

struct ConvT { const float* src; const float* src2; const float* ks; u16* dst; int ld; int ldd; float mul; };
constexpr float Z8_SCALE = 16.f, O8_SCALE = 32.f;
constexpr float F8_WSCALE = 64.f, GATE_WSCALE = F8_WSCALE;
constexpr int CONV_ITEMS = 1152 + 64 + 64 + 2048 + 512 + 512 + 8192 + 4096;
DEVI ConvT conv_decode(KP p, int l, int idx) {
  ConvT c; c.ks = nullptr; c.mul = 1.f; c.src2 = nullptr;
  if (idx < 1152) {
    int nt = idx >> 4, kt = idx & 15, n0 = nt * 32;
    int sc = (n0 < 416) ? n0 : ((n0 < 512) ? -1 : n0 - 96);
    c.ld = 2208; c.ldd = -1024;
    c.mul = F8_WSCALE;
    if ((n0 >= 512 && n0 < 768) || (n0 >= 1024 && n0 < 1280)) c.mul = 0.125f * LOG2E * F8_WSCALE;
    c.src = (sc < 0) ? nullptr : p->w_in + (size_t)l * 1024 * 2208 + (size_t)kt * 64 * 2208 + sc;
    c.dst = (u16*)(p->ws + OFF_WIN + (size_t)n0 * 1024 + kt * 64);
    return c;
  }
  idx -= 1152;
  if (idx < 64) {
    int nt = idx >> 2, kt = idx & 3;
    c.ld = 384; c.ldd = 256; c.ks = p->g_q_a + l * 256 + kt * 64;
    c.src = (nt >= 12) ? nullptr : p->w_q_b + (size_t)l * 256 * 384 + (size_t)kt * 64 * 384 + nt * 32;
    c.dst = wsp<u16>(p, OFF_WQB) + (size_t)nt * 32 * 256 + kt * 64;
    return c;
  }
  idx -= 64;
  if (idx < 64) {
    int nt = idx >> 2, kt = idx & 3;
    c.ld = 512; c.ldd = 256; c.ks = (kt < 2) ? p->g_kv_a + l * 128 + kt * 64 : nullptr;
    c.src = (kt >= 2) ? nullptr : p->w_kv_b + (size_t)l * 128 * 512 + (size_t)kt * 64 * 512 + nt * 32;
    c.dst = wsp<u16>(p, OFF_WKVB) + (size_t)nt * 32 * 256 + kt * 64;
    return c;
  }
  idx -= 64;
  if (idx < 2048) {
    int nt = idx >> 4, kt = idx & 15, R0 = nt * 32;
    int pr = R0 >> 11, cb = (R0 & 2047) >> 8, bj = (R0 & 255) >> 7, j0 = R0 & 127;
    c.ld = 1024; c.ldd = -1024; c.mul = F8_WSCALE;
    c.src = p->w_gate + ((size_t)(l * 4 + 2 * pr + bj) * 1024 + kt * 64) * 1024 + cb * 128 + j0;
    c.dst = (u16*)(p->ws + OFF_WGATE + (size_t)R0 * 1024 + kt * 64);
    return c;
  }
  idx -= 2048;
  if (idx < 512) {
    int br = idx >> 7, nt = (idx >> 2) & 31, kt = idx & 3;
    c.ld = 1024; c.ldd = -256; c.mul = F8_WSCALE;
    c.src = p->w_branch + ((size_t)(l * 4 + br) * 256 + kt * 64) * 1024 + nt * 32;
    c.dst = (u16*)(p->ws + OFF_WBR + ((size_t)br * 1024 + nt * 32) * 256 + kt * 64);
    return c;
  }
  idx -= 512;
  if (idx < 512) {
    int nt = idx >> 4, kt = idx & 15;
    c.ld = 1024; c.ldd = -1024; c.mul = F8_WSCALE;
    c.src = p->w_out + ((size_t)l * 1024 + kt * 64) * 1024 + nt * 32;
    c.dst = (u16*)(p->ws + OFF_WOUT + (size_t)nt * 32 * 1024 + kt * 64);
    return c;
  }
  idx -= 512;
  if (idx < 8192) {
    int e = idx >> 8, g32 = (idx >> 4) & 15, kt = idx & 15;
    c.ld = 256; c.ldd = -1024; c.mul = F8_WSCALE;
    c.src = p->w_ff1 + ((size_t)(l * 32 + e) * 1024 + kt * 64) * 256 + g32 * 16;
    c.src2 = p->w_ff3 + ((size_t)(l * 32 + e) * 1024 + kt * 64) * 256 + g32 * 16;
    c.dst = (u16*)(p->ws + OFF_W13 + ((size_t)e * 512 + g32 * 32) * 1024 + kt * 64);
    return c;
  }
  idx -= 8192;
  {
    int e = idx >> 7, nt = (idx >> 2) & 31, kt = idx & 3;
    c.ld = 1024; c.ldd = -256; c.mul = F8_WSCALE;
    c.src = p->w_ff2 + ((size_t)(l * 32 + e) * 256 + kt * 64) * 1024 + nt * 32;
    c.dst = (u16*)(p->ws + OFF_W2 + ((size_t)e * 1024 + nt * 32) * 256 + kt * 64);
    return c;
  }
}
DEVI void modulate_row_store(KP p, int l, int which, const float (&xv)[16], int mrow, u16* hrow, float (&hv)[16]) {
  const int lane = TIDX & 63;
  float ss = 0.f;
#pragma unroll
  for (int i = 0; i < 16; ++i) ss += xv[i] * xv[i];
  ss = wave_sum(ss);
  const float rstd = rsqrtf(ss * (1.f / 1024.f) + EPS);
  const float* g = (which ? p->g_norm_ffn : p->g_norm_mix) + l * 1024;
  const float* mod = wsp<float>(p, OFF_MOD) + ((size_t)l * 9 + mrow) * 6144 + (which ? 3072 : 0);
#pragma unroll
  for (int i = 0; i < 4; ++i) {
    const int c = i * 256 + lane * 4;
    f32x4 gv = *(const f32x4*)(g + c);
    f32x4 sh = *(const f32x4*)(mod + c);
    f32x4 sc = *(const f32x4*)(mod + 1024 + c);
    hv[i * 4 + 0] = xv[i * 4 + 0] * rstd * gv.x * (1.f + sc.x) + sh.x;
    hv[i * 4 + 1] = xv[i * 4 + 1] * rstd * gv.y * (1.f + sc.y) + sh.y;
    hv[i * 4 + 2] = xv[i * 4 + 2] * rstd * gv.z * (1.f + sc.z) + sh.z;
    hv[i * 4 + 3] = xv[i * 4 + 3] * rstd * gv.w * (1.f + sc.w) + sh.w;
    u32x2 o; o.x = pk2(hv[i * 4 + 0], hv[i * 4 + 1]); o.y = pk2(hv[i * 4 + 2], hv[i * 4 + 3]);
    *(u32x2*)(hrow + c) = o;
  }
}
struct ModVec { f32x4 a[4], b[4]; };
DEVI void load_modvec(KP p, int l, int which, int mrow, ModVec& mv) {
  const int lane = TIDX & 63;
  const float* g = (which ? p->g_norm_ffn : p->g_norm_mix) + l * 1024;
  const float* mod = wsp<float>(p, OFF_MOD) + ((size_t)l * 9 + mrow) * 6144 + (which ? 3072 : 0);
#pragma unroll
  for (int i = 0; i < 4; ++i) {
    const int c = i * 256 + lane * 4;
    const f32x4 gv = *(const f32x4*)(g + c), sh = *(const f32x4*)(mod + c), sc = *(const f32x4*)(mod + 1024 + c);
    mv.a[i] = gv * (1.f + sc); mv.b[i] = sh;
  }
}
DEVI unsigned char* h8base(KP p) { return (unsigned char*)p->out + (size_t)NTOK * 2048; }
template <bool F8COPY = false, bool BF16 = true>
DEVI void modulate_row_store2(const ModVec& mv, const float (&xv)[16], u16* hrow, float (&hv)[16], unsigned char* h8row = nullptr) {
  const int lane = TIDX & 63;
  float ss = 0.f;
#pragma unroll
  for (int i = 0; i < 16; ++i) ss += xv[i] * xv[i];
  ss = wave_sum(ss);
  const float rstd = rsqrtf(ss * (1.f / 1024.f) + EPS);
#pragma unroll
  for (int i = 0; i < 4; ++i) {
    const int c = i * 256 + lane * 4;
#pragma unroll
    for (int j = 0; j < 4; ++j) hv[i * 4 + j] = xv[i * 4 + j] * rstd * mv.a[i][j] + mv.b[i][j];
    if (BF16) { u32x2 o; o.x = pk2(hv[i * 4 + 0], hv[i * 4 + 1]); o.y = pk2(hv[i * 4 + 2], hv[i * 4 + 3]);
      *(u32x2*)(hrow + c) = o; }
    if (F8COPY) {
      float q[4];
#pragma unroll
      for (int j = 0; j < 4; ++j) q[j] = __builtin_amdgcn_fmed3f(hv[i * 4 + j], -448.f, 448.f);
      int v = __builtin_amdgcn_cvt_pk_fp8_f32(q[0], q[1], 0, false);
      v = __builtin_amdgcn_cvt_pk_fp8_f32(q[2], q[3], v, true);
      *(int*)(h8row + c) = v;
    }
  }
}
DEVI void load_row16(const float* xr, float (&xv)[16]) {
  const int lane = TIDX & 63;
#pragma unroll
  for (int i = 0; i < 4; ++i) {
    f32x4 v = *(const f32x4*)(xr + i * 256 + lane * 4);
    xv[i * 4 + 0] = v.x; xv[i * 4 + 1] = v.y; xv[i * 4 + 2] = v.z; xv[i * 4 + 3] = v.w;
  }
}
DEVI void load_row16_bf(const u16* xr, float (&xv)[16]) {
  const int lane = TIDX & 63;
#pragma unroll
  for (int i = 0; i < 4; ++i) {
    const u32x2 v = *(const u32x2*)(xr + i * 256 + lane * 4);
    xv[i * 4 + 0] = __uint_as_float(v.x << 16); xv[i * 4 + 1] = __uint_as_float(v.x & 0xffff0000u);
    xv[i * 4 + 2] = __uint_as_float(v.y << 16); xv[i * 4 + 3] = __uint_as_float(v.y & 0xffff0000u);
  }
}
DEVI float router_dot(const float (&hv)[4][16], const float* wrow) {
  const int lane = TIDX & 63;
  const float* w = wrow + lane * 4;
  float pr[4] = {0.f, 0.f, 0.f, 0.f};
#pragma unroll
  for (int i = 0; i < 4; ++i) {
    const f32x4 wv = *(const f32x4*)(w + i * 256);
#pragma unroll
    for (int r = 0; r < 4; ++r)
      pr[r] += hv[r][i * 4] * wv.x + hv[r][i * 4 + 1] * wv.y + hv[r][i * 4 + 2] * wv.z + hv[r][i * 4 + 3] * wv.w;
  }
  const bool up = (lane & 32) != 0;
  float s0 = up ? pr[0] : pr[2], s1 = up ? pr[1] : pr[3];
  float k0 = up ? pr[2] : pr[0], k1 = up ? pr[3] : pr[1];
  k0 += __shfl_xor(s0, 32); k1 += __shfl_xor(s1, 32);
  const bool up2 = (lane & 16) != 0;
  float sv = up2 ? k0 : k1, kv = up2 ? k1 : k0;
  kv += __shfl_xor(sv, 16);
  kv += __shfl_xor(kv, 8); kv += __shfl_xor(kv, 4); kv += __shfl_xor(kv, 2); kv += __shfl_xor(kv, 1);
  return kv;
}
#define XB_TMO      128
#define XB_XCNT(j)  (256  + 64 * (j))
#define XB_XSUB(j)  (1280 + 64 * (j))
#define XB_XGEN(j)  (2304 + 64 * (j))
#define XB_TOP      3328
#define XB_TOPGEN   3392
#define XB_SPIN_CAP (1u << 20)
#define LAS __attribute__((address_space(3)))
DEVI unsigned xb_ld(unsigned* p) { return __hip_atomic_load(p, __ATOMIC_RELAXED, __HIP_MEMORY_SCOPE_AGENT); }
DEVI unsigned xb_add(unsigned* p, unsigned v) { return __hip_atomic_fetch_add(p, v, __ATOMIC_RELAXED, __HIP_MEMORY_SCOPE_AGENT); }
DEVI unsigned xb_xcc_id() { return (unsigned)__builtin_amdgcn_s_getreg((3 << 11) | 20) & 0xFu; }
#define XB_SPIN(cond, bar) do { unsigned _sp = 0; while (cond) { __builtin_amdgcn_s_sleep(1); \
    if ((++_sp & 255u) == 0u) { if (xb_ld(&(bar)[XB_TMO])) break; if (_sp > XB_SPIN_CAP) { atomicAdd(&(bar)[XB_TMO], 1u); break; } } } } while (0)
DEVI void xcd_barrier_post(unsigned* bar) {
  if (TIDX == 0) (void)xb_add(&bar[XB_XCNT(xb_xcc_id())], 1u);
}
DEVI void xcd_barrier_complete(unsigned* bar, unsigned x, unsigned& nloc, unsigned& nx) {
  const unsigned G = gridDim.x * gridDim.y * gridDim.z;
  unsigned sum, cnt, mine, sp = 0u;
  for (;;) {
    sum = 0u; cnt = 0u; mine = 0u;
#pragma unroll
    for (unsigned j = 0; j < 16; ++j) { const unsigned c = xb_ld(&bar[XB_XCNT(j)]); sum += c; cnt += (c > 0u) ? 1u : 0u; mine = (j == x) ? c : mine; }
    if (sum == G) break;
    __builtin_amdgcn_s_sleep(1);
    if ((++sp & 255u) == 0u) { if (xb_ld(&bar[XB_TMO])) break; if (sp > XB_SPIN_CAP) { atomicAdd(&bar[XB_TMO], 1u); break; } }
  }
  nloc = mine > 0u ? mine : 1u; nx = cnt > 0u ? cnt : 1u;
}
DEVI void xcd_barrier(unsigned* bar, volatile LAS unsigned* st) {
  asm volatile("s_waitcnt vmcnt(0)" ::: "memory");
  __syncthreads();
  if (TIDX == 0) {
    const unsigned x = xb_xcc_id();
    __builtin_amdgcn_s_waitcnt(0);
    unsigned nloc = st[0], nx = st[1];
    if (nloc == 0u) { xcd_barrier_complete(bar, x, nloc, nx); st[0] = nloc; st[1] = nx; }
    const unsigned old = xb_add(&bar[XB_XSUB(x)], 1u);
    const unsigned gen = old / nloc;
    if (old + 1u == (gen + 1u) * nloc) {
      __builtin_amdgcn_fence(__ATOMIC_RELEASE, "agent");
      asm volatile("s_waitcnt vmcnt(0)" ::: "memory");
      const unsigned og = xb_add(&bar[XB_TOP], 1u);
      const unsigned tg = og / nx;
      if (og + 1u == (tg + 1u) * nx) xb_add(&bar[XB_TOPGEN], 1u);
      else XB_SPIN(xb_ld(&bar[XB_TOPGEN]) == tg, bar);
      __builtin_amdgcn_fence(__ATOMIC_ACQUIRE, "agent");
      xb_add(&bar[XB_XGEN(x)], 1u);
      asm volatile("s_waitcnt vmcnt(0)" ::: "memory");
    } else {
      XB_SPIN(xb_ld(&bar[XB_XGEN(x)]) == gen, bar);
      __builtin_amdgcn_fence(__ATOMIC_ACQUIRE, "agent");
      asm volatile("s_waitcnt vmcnt(0)" ::: "memory");
    }
  }
  __syncthreads();
}

namespace v2 {
typedef LAS unsigned char* ldsp_t;
constexpr int BM = 256, BK = 64, HALF = 128, HTB = HALF * BK * 2, STAGE_BYTES = 8 * HTB;
constexpr int NW = 8;
constexpr int LDS_XTRA = STAGE_BYTES;
constexpr int LDS_BARW = STAGE_BYTES + 16384;
constexpr int LDS_TOTAL = LDS_BARW + 16;

DEVI int lds_byte(int r, int c) { const int st = (r >> 4) * 2 + (c >> 5), rr = r & 15, cc = c & 31, ob = rr * 64 + cc * 2; return st * 1024 + (ob ^ (((ob >> 9) & 1) << 5)); }
DEVI void stage_rc(int b, int& R, int& C) { const int st = b / 1024, sb = b % 1024, swz = sb ^ (((sb >> 9) & 1) << 5); R = (st >> 1) * 16 + swz / 64; C = (st & 1) * 32 + (swz % 64) / 2; }
DEVI int perm32(int rho) { const int n = rho >> 4, i = rho & 15; return 8 * (i >> 2) + 4 * n + (i & 3); }

DEVI void acc_zero(f32x4 (&acc)[2][2][4][2]) {
#pragma unroll
  for (int a = 0; a < 2; ++a)
#pragma unroll
    for (int b = 0; b < 2; ++b)
#pragma unroll
      for (int m = 0; m < 4; ++m)
#pragma unroll
        for (int n = 0; n < 2; ++n) acc[a][b][m][n] = (f32x4){0.f, 0.f, 0.f, 0.f};
}
struct Unit { const char* A; const char* B; const int* rows; int nvalid; int u0, u1, u2, u3; };

typedef int i32x8 __attribute__((ext_vector_type(8)));
typedef int i32x4v __attribute__((ext_vector_type(4)));
DEVI i32x8 cat8(bf16x8 lo, bf16x8 hi) { return __builtin_shufflevector(__builtin_bit_cast(i32x4v, lo), __builtin_bit_cast(i32x4v, hi), 0, 1, 2, 3, 4, 5, 6, 7); }
DEVI const char* sptr(const char* p) {
  const unsigned long long v = (unsigned long long)p;
  const unsigned lo = (unsigned)__builtin_amdgcn_readfirstlane((int)(unsigned)v), hi = (unsigned)__builtin_amdgcn_readfirstlane((int)(unsigned)(v >> 32));
  return (const char*)(((unsigned long long)hi << 32) | lo);
}
template <bool PERM, bool GATHER, bool F8, class Epi, class Sched>
DEVI void gemm_phase(ldsp_t lds, int lda_b, int ldb_b, int nt, const Sched& S, const Epi& E) {
  const int tid = TIDX, wid = __builtin_amdgcn_readfirstlane(tid >> 6), lane = tid & 63, wr = wid >> 2, wc = wid & 3, fr = lane & 15, fq = lane >> 4;
  unsigned voffA[2], voffB[2]; int RA[2], CA2[2];
#pragma unroll
  for (int i = 0; i < 2; ++i) {
    int R, C; stage_rc(tid * 16 + i * 8192, R, C);
    const int Rb = PERM ? ((R & ~31) + perm32(R & 31)) : R;
    RA[i] = R; CA2[i] = C * 2;
    voffA[i] = (unsigned)(R * lda_b + C * 2); voffB[i] = (unsigned)(Rb * ldb_b + C * 2);
  }
  const size_t kstep = (size_t)(BK * 2);
  const size_t hstepA = (size_t)HALF * lda_b, hstepB = (size_t)HALF * ldb_b;
  const unsigned ldsw = (unsigned)wid * 1024u, ldsbase = (unsigned)(size_t)lds;
  const int aoff = lds_byte(wr * 64 + fr, fq * 8), boff = lds_byte(wc * 32 + fr, fq * 8);
#define G_SA(b, h) (((b) * 2 + (h)) * HTB)
#define G_SB(b, h) ((4 + (b) * 2 + (h)) * HTB)
#define G_DMA(sbase, voff, ldsaddr) asm volatile("s_mov_b32 m0, %2\n\ts_nop 0\n\tglobal_load_lds_dwordx4 %0, %1" :: "v"(voff), "s"(sbase), "s"(ldsaddr) : "memory", "m0")
#define G_STAGE(bufoff, gbase, voff) do { const char* sb_ = sptr((const char*)(gbase)); _Pragma("unroll") for (int _i = 0; _i < 2; ++_i) \
    G_DMA(sb_, (voff)[_i], (unsigned)__builtin_amdgcn_readfirstlane((int)(ldsbase + (unsigned)(bufoff) + ldsw + (unsigned)_i * 8192u))); } while (0)
#define G_STAGE_A(bufoff, abase, go, h, koff) do { if (GATHER) { const char* sb_ = sptr((const char*)(abase) + (koff)); _Pragma("unroll") for (int _i = 0; _i < 2; ++_i) \
    G_DMA(sb_, (go)[h][_i], (unsigned)__builtin_amdgcn_readfirstlane((int)(ldsbase + (unsigned)(bufoff) + ldsw + (unsigned)_i * 8192u))); } \
    else G_STAGE(bufoff, (abase) + (h) * hstepA + (koff), voffA); } while (0)
#define G_LDA(dst, b, h) do { _Pragma("unroll") for (int m = 0; m < 4; ++m) { if (F8) dst##8[m] = cat8(*(const LAS bf16x8*)(lds + G_SA(b, h) + aoff + m * 2048), *(const LAS bf16x8*)(lds + G_SA(b, h) + aoff + m * 2048 + 1024)); \
    else { _Pragma("unroll") for (int k = 0; k < 2; ++k) dst[m][k] = *(const LAS bf16x8*)(lds + G_SA(b, h) + aoff + m * 2048 + k * 1024); } } } while (0)
#define G_LDB(dst, b, h) do { _Pragma("unroll") for (int n = 0; n < 2; ++n) { if (F8) dst##8[n] = cat8(*(const LAS bf16x8*)(lds + G_SB(b, h) + boff + n * 2048), *(const LAS bf16x8*)(lds + G_SB(b, h) + boff + n * 2048 + 1024)); \
    else { _Pragma("unroll") for (int k = 0; k < 2; ++k) dst[n][k] = *(const LAS bf16x8*)(lds + G_SB(b, h) + boff + n * 2048 + k * 1024); } } } while (0)
#define G_MMA(ai, bj, At, Bt) do { __builtin_amdgcn_s_setprio(1); _Pragma("unroll") for (int m = 0; m < 4; ++m) _Pragma("unroll") for (int n = 0; n < 2; ++n) { \
    if (F8) asm("v_mfma_scale_f32_16x16x128_f8f6f4 %0, %1, %2, %0, %3, %3 op_sel_hi:[0,0,0]" : "+v"(acc[ai][bj][m][n]) : "v"(Bt##8[n]), "v"(At##8[m]), "v"(f8scale)); \
    else { _Pragma("unroll") for (int k = 0; k < 2; ++k) acc[ai][bj][m][n] = __builtin_amdgcn_mfma_f32_16x16x32_bf16(Bt[n][k], At[m][k], acc[ai][bj][m][n], 0, 0, 0); } } \
    __builtin_amdgcn_s_setprio(0); } while (0)
#define G_WAIT_V(n) asm volatile("s_waitcnt vmcnt(" #n ")" ::: "memory")
#define G_WAIT_L(n) asm volatile("s_waitcnt lgkmcnt(" #n ")" ::: "memory")
#define G_BAR __builtin_amdgcn_s_barrier()
#define G_SCHED __builtin_amdgcn_sched_barrier(0)
  Unit cur, nxt; int ui = 0;
  if (!S.next(0, cur)) return;
  f32x4 acc[2][2][4][2];
  E.init(acc, cur, wr, wc, fr, fq);
  bf16x8 At[4][2], B0[2][2], B1[2][2];
  i32x8 At8[4], B08[2], B18[2];
  const int f8scale = 0x7f7f7f7f;
  unsigned gcur[2][2];
  auto gather_offs = [&](const Unit& u, unsigned (&go)[2][2]) {
#pragma unroll
    for (int h = 0; h < 2; ++h)
#pragma unroll
      for (int i = 0; i < 2; ++i) {
        const int r = h * HALF + RA[i];
        const int t = (r < u.nvalid) ? (u.rows[r] >> 1) : 0;
        go[h][i] = (unsigned)t * (unsigned)lda_b + (unsigned)CA2[i];
      }
  };
  if (GATHER) gather_offs(cur, gcur);
  const char* cA = cur.A; const char* cB = cur.B;
  G_STAGE(G_SB(0, 0), cB, voffB); G_STAGE_A(G_SA(0, 0), cA, gcur, 0, 0); G_STAGE(G_SB(0, 1), cB + hstepB, voffB); G_STAGE_A(G_SA(0, 1), cA, gcur, 1, 0);
  if (wr == 1) G_BAR;
  G_WAIT_V(4); G_BAR;
  G_STAGE(G_SB(1, 0), cB + kstep, voffB); G_STAGE_A(G_SA(1, 0), cA, gcur, 0, kstep); G_STAGE(G_SB(1, 1), cB + hstepB + kstep, voffB);
  G_WAIT_V(6); G_BAR;
  for (;;) {
    const bool has_next = S.next(ui + 1, nxt);
    const char* nA = has_next ? nxt.A : cA; const char* nB = has_next ? nxt.B : cB;
#pragma clang loop unroll(disable)
    for (int t = 0; t < nt; t += 2) {
      const bool last = (t == nt - 2);
      const size_t k1 = (size_t)(t + 1) * kstep;
      const char* a2 = last ? nA : cA; const char* b2 = last ? nB : cB + (size_t)(t + 2) * kstep;
      const size_t ka2 = last ? 0 : (size_t)(t + 2) * kstep;
      const char* b3 = b2 + kstep; const size_t ka3 = ka2 + kstep;
      unsigned gN[2][2];
      if (GATHER && last) {
        if (has_next) gather_offs(nxt, gN);
        else {
#pragma unroll
          for (int h = 0; h < 2; ++h)
#pragma unroll
            for (int i = 0; i < 2; ++i) gN[h][i] = gcur[h][i];
        }
      }
#define G_STAGE_A2(bufoff, h, koff) do { if (GATHER) { if (last) G_STAGE_A(bufoff, cA, gN, h, (koff) - ka2); else G_STAGE_A(bufoff, cA, gcur, h, koff); } \
        else G_STAGE_A(bufoff, a2, gcur, h, koff); } while (0)
      G_LDB(B0, 0, 0); G_SCHED; G_LDA(At, 0, 0); G_STAGE_A(G_SA(1, 1), cA, gcur, 1, k1);
      G_WAIT_L(8); G_BAR; G_WAIT_L(0); G_MMA(0, 0, At, B0); G_BAR; G_SCHED;
      G_LDB(B1, 0, 1); G_STAGE(G_SB(0, 0), b2, voffB);
      G_BAR; G_WAIT_L(0); G_MMA(0, 1, At, B1); G_BAR;
      G_LDA(At, 0, 1); G_STAGE_A2(G_SA(0, 0), 0, ka2);
      G_BAR; G_WAIT_L(0); G_MMA(1, 0, At, B0); G_BAR; G_SCHED;
      G_STAGE(G_SB(0, 1), b2 + hstepB, voffB);
      G_WAIT_V(6); G_BAR; G_MMA(1, 1, At, B1); G_BAR;
      G_LDB(B0, 1, 0); G_SCHED; G_LDA(At, 1, 0); G_STAGE_A2(G_SA(0, 1), 1, ka2);
      G_WAIT_L(8); G_BAR; G_WAIT_L(0); G_MMA(0, 0, At, B0); G_BAR; G_SCHED;
      G_LDB(B1, 1, 1); G_STAGE(G_SB(1, 0), b3, voffB);
      G_BAR; G_WAIT_L(0); G_MMA(0, 1, At, B1); G_BAR;
      G_LDA(At, 1, 1); G_STAGE_A2(G_SA(1, 0), 0, ka3);
      G_BAR; G_WAIT_L(0); G_MMA(1, 0, At, B0); G_BAR; G_SCHED;
      G_STAGE(G_SB(1, 1), b3 + hstepB, voffB);
      G_WAIT_V(6); G_BAR; G_MMA(1, 1, At, B1); G_BAR;
      if (GATHER && last) {
#pragma unroll
        for (int h = 0; h < 2; ++h)
#pragma unroll
          for (int i = 0; i < 2; ++i) gcur[h][i] = gN[h][i];
      }
#undef G_STAGE_A2
    }
    G_SCHED;
    if (F8) {
      asm volatile("s_nop 15\n\ts_nop 15" ::: "memory");
#pragma unroll
      for (int a_ = 0; a_ < 2; ++a_)
#pragma unroll
        for (int b_ = 0; b_ < 2; ++b_)
#pragma unroll
          for (int m_ = 0; m_ < 4; ++m_)
#pragma unroll
            for (int n_ = 0; n_ < 2; ++n_) asm volatile("" : "+v"(acc[a_][b_][m_][n_]));
    }
    E(acc, cur, wr, wc, fr, fq);
    G_SCHED;
    if (!has_next) break;
    cur = nxt; cA = nA; cB = nB; ++ui;
    E.init(acc, cur, wr, wc, fr, fq);
  }
  G_WAIT_V(0);
  if (wr == 0) G_BAR;
  G_BAR;
#undef G_SA
#undef G_SB
#undef G_STAGE
#undef G_DMA
#undef G_STAGE_A
#undef G_LDA
#undef G_LDB
#undef G_MMA
#undef G_WAIT_V
#undef G_WAIT_L
#undef G_BAR
#undef G_SCHED
}

DEVI unsigned uoff(unsigned x) { return (unsigned)__builtin_amdgcn_readfirstlane((int)x); }
DEVI bool tile_order(int i, int G, int c, int nM, int nN, int& pm, int& pn) {
  const int nwg = nM * nN;
  const long L = (long)i * G + c; if (L >= nwg) return false;
  int wgid = (int)L; { const int q = nwg / 8, r = nwg % 8, xcd = wgid % 8, off = wgid / 8; wgid = (xcd < r ? xcd * (q + 1) : r * (q + 1) + (xcd - r) * q) + off; }
  const int WGM = 8;
  const int nig = WGM * nN, gid = wgid / nig, fm = gid * WGM, gsz = (nM - fm) < WGM ? (nM - fm) : WGM;
  pm = fm + ((wgid % nig) % gsz); pn = (wgid % nig) / gsz;
  pm = __builtin_amdgcn_readfirstlane(pm); pn = __builtin_amdgcn_readfirstlane(pn);
  return true;
}
struct EpiRawBf16 {
  u16* O; int ldc; float sc;
  DEVI void init(f32x4 (&acc)[2][2][4][2], const Unit&, int, int, int, int) const { acc_zero(acc); }
  DEVI void operator()(const f32x4 (&acc)[2][2][4][2], const Unit& u, int wr, int wc, int fr, int fq) const {
    const unsigned off0 = ((unsigned)(u.u0 + wr * 64 + fr) * (unsigned)ldc + (unsigned)(u.u1 + wc * 32 + 8 * fq)) * 2u;
#pragma unroll
    for (int ai = 0; ai < 2; ++ai)
#pragma unroll
      for (int m = 0; m < 4; ++m) {
        char* rowp = (char*)O + (off0 + (unsigned)(ai * HALF + m * 16) * (unsigned)ldc * 2u);
#pragma unroll
        for (int bj = 0; bj < 2; ++bj) {
          const f32x4 v0 = acc[ai][bj][m][0] * sc, v1 = acc[ai][bj][m][1] * sc;
          u32x4 w; w.x = pk2(v0[0], v0[1]); w.y = pk2(v0[2], v0[3]); w.z = pk2(v1[0], v1[1]); w.w = pk2(v1[2], v1[3]);
          *(u32x4*)(rowp + bj * HALF * 2) = w;
        }
      }
  }
};

struct EpiRawF8 {
  unsigned char* O; int ldc; float sc;
  DEVI void init(f32x4 (&acc)[2][2][4][2], const Unit&, int, int, int, int) const { acc_zero(acc); }
  DEVI void operator()(const f32x4 (&acc)[2][2][4][2], const Unit& u, int wr, int wc, int fr, int fq) const {
    const unsigned off0 = (unsigned)(u.u0 + wr * 64 + fr) * (unsigned)ldc + (unsigned)(u.u1 + wc * 32 + 8 * fq);
#pragma unroll
    for (int ai = 0; ai < 2; ++ai)
#pragma unroll
      for (int m = 0; m < 4; ++m) {
        unsigned char* rowp = O + (off0 + (unsigned)(ai * HALF + m * 16) * (unsigned)ldc);
#pragma unroll
        for (int bj = 0; bj < 2; ++bj) {
          u32x2 w;
#pragma unroll
          for (int n = 0; n < 2; ++n) {
            const f32x4 v = acc[ai][bj][m][n] * sc;
            int q = __builtin_amdgcn_cvt_pk_fp8_f32(__builtin_amdgcn_fmed3f(v[0], -448.f, 448.f), __builtin_amdgcn_fmed3f(v[1], -448.f, 448.f), 0, false);
            q = __builtin_amdgcn_cvt_pk_fp8_f32(__builtin_amdgcn_fmed3f(v[2], -448.f, 448.f), __builtin_amdgcn_fmed3f(v[3], -448.f, 448.f), q, true);
            w[n] = (unsigned)q;
          }
          *(u32x2*)(rowp + bj * HALF) = w;
        }
      }
  }
};
DEVI size_t z8_block(int pm, int branch, int cb) { return (size_t)((pm * 4 + branch) * 8 + cb) * 32768; }
struct EpiZ8 {
  unsigned char* O;
  DEVI void init(f32x4 (&acc)[2][2][4][2], const Unit&, int, int, int, int) const { acc_zero(acc); }
  DEVI void operator()(const f32x4 (&acc)[2][2][4][2], const Unit& u, int wr, int wc, int fr, int fq) const {
    const int pm = u.u0 >> 8, pn = u.u1 >> 8, n = pn >> 2, cq = pn & 3;
    const unsigned lw16 = (unsigned)((wr * 4 + wc) * 64 + fr + 16 * fq) * 16u;
#pragma unroll
    for (int bj = 0; bj < 2; ++bj) {
      unsigned char* blk = O + z8_block(pm, n, cq * 2 + bj) + lw16;
#pragma unroll
      for (int P = 0; P < 4; ++P) {
        u32x4 w;
#pragma unroll
        for (int h = 0; h < 2; ++h)
#pragma unroll
          for (int nn = 0; nn < 2; ++nn) {
            const int g = 2 * P + h;
            const f32x4 v = acc[g >> 2][bj][g & 3][nn] * (Z8_SCALE / (O8_SCALE * F8_WSCALE));
            int q = __builtin_amdgcn_cvt_pk_fp8_f32(__builtin_amdgcn_fmed3f(v[0], -448.f, 448.f), __builtin_amdgcn_fmed3f(v[1], -448.f, 448.f), 0, false);
            q = __builtin_amdgcn_cvt_pk_fp8_f32(__builtin_amdgcn_fmed3f(v[2], -448.f, 448.f), __builtin_amdgcn_fmed3f(v[3], -448.f, 448.f), q, true);
            w[2 * h + nn] = (unsigned)q;
          }
        *(u32x4*)(blk + P * 8192) = w;
      }
    }
  }
};
struct SchedB { const char* ws; const char* h8; int G, c;
  DEVI bool next(int i, Unit& u) const { int pm, pn; if (!tile_order(i, G, c, NTOK / 256, INP / 256, pm, pn)) return false;
    u.A = h8 + uoff((unsigned)pm * 256u * 1024u); u.B = ws + OFF_WIN + uoff((unsigned)pn * 256u * 1024u);        u.rows = nullptr; u.nvalid = 0; u.u0 = pm * 256; u.u1 = pn * 256; u.u2 = 0; u.u3 = 0; return true; } };
struct EpiB { u16* O; float* ssq;
  DEVI void init(f32x4 (&acc)[2][2][4][2], const Unit&, int, int, int, int) const { acc_zero(acc); }
  DEVI void operator()(const f32x4 (&acc)[2][2][4][2], const Unit& u, int wr, int wc, int fr, int fq) const {
    EpiRawBf16 E{O, PLD, 1.f / F8_WSCALE}; E(acc, u, wr, wc, fr, fq);
    if (u.u1 < 512) {
      const bool iskv = u.u1 != 0;
#pragma unroll
      for (int ai = 0; ai < 2; ++ai)
#pragma unroll
        for (int m = 0; m < 4; ++m) {
          float ss = 0.f;
#pragma unroll
          for (int bj = 0; bj < 2; ++bj)
#pragma unroll
            for (int n = 0; n < 2; ++n)
#pragma unroll
              for (int j = 0; j < 4; ++j) { const float v = acc[ai][bj][m][n][j] * (1.f / F8_WSCALE); if (!(iskv && bj == 1)) ss += v * v; }
          ss += __shfl_xor(ss, 16); ss += __shfl_xor(ss, 32);
          if (fq == 0) ssq[(size_t)(u.u0 + ai * HALF + wr * 64 + m * 16 + fr) * 8 + (iskv ? 4 : 0) + wc] = ss;
        }
    }
  }
};
DEVI void phaseB2(KP p, ldsp_t lds) {
  SchedB S{(const char*)p->ws, (const char*)h8base(p), (int)gridDim.x, BIDX};
  EpiB E{wsp<u16>(p, OFF_PRAW), wsp<float>(p, OFF_SSQ)};
  gemm_phase<true, false, true>(lds, 1024, 1024, 8, S, E);
}
struct SchedC { const char* ws; int G, c;
  DEVI bool next(int i, Unit& u) const { int pm, pn; if (!tile_order(i, G, c, NTOK / 256, 4, pm, pn)) return false;
    const bool kv = pn >= 2; const int pj = pn & 1;
    u.A = ws + OFF_PRAW + uoff((unsigned)pm * 256u * (unsigned)(PLD * 2) + (kv ? 512u : 0u)); u.B = ws + (kv ? OFF_WKVB : OFF_WQB) + uoff((unsigned)pj * 256u * 512u); u.rows = nullptr; u.nvalid = 0;
    u.u0 = pm * 256; u.u1 = pj * 256; u.u2 = kv; u.u3 = 0; return true; } };
struct EpiC { u16* Oq; u16* Okv; const float* ssq;
  DEVI void init(f32x4 (&acc)[2][2][4][2], const Unit&, int, int, int, int) const { acc_zero(acc); }
  DEVI void operator()(const f32x4 (&acc)[2][2][4][2], const Unit& u, int wr, int wc, int fr, int fq) const {
    const bool kv = u.u2 != 0;
    u16* O = kv ? Okv : Oq;
    const int row0 = u.u0 + wr * 64 + fr, col0 = u.u1 + wc * 32 + 8 * fq;
    f32x4 sq[2][4];
#pragma unroll
    for (int ai = 0; ai < 2; ++ai)
#pragma unroll
      for (int m = 0; m < 4; ++m) sq[ai][m] = *(const f32x4*)(ssq + (size_t)(row0 + ai * HALF + m * 16) * 8 + (kv ? 4 : 0));
#pragma unroll
    for (int ai = 0; ai < 2; ++ai)
#pragma unroll
      for (int m = 0; m < 4; ++m) {
        const size_t r = (size_t)(row0 + ai * HALF + m * 16);
        const float tot = sq[ai][m].x + sq[ai][m].y + sq[ai][m].z + sq[ai][m].w;
        const float sc = kv ? rsqrtf(tot * (1.f / 128.f) + EPS) : rsqrtf(tot * (1.f / 256.f) + EPS) * (0.10206207261596575f * LOG2E);
        u16* rowp = O + r * 512 + col0;
#pragma unroll
        for (int bj = 0; bj < 2; ++bj) {
          const f32x4 v0 = acc[ai][bj][m][0] * sc, v1 = acc[ai][bj][m][1] * sc;
          u32x4 w; w.x = pk2(v0[0], v0[1]); w.y = pk2(v0[2], v0[3]); w.z = pk2(v1[0], v1[1]); w.w = pk2(v1[2], v1[3]);
          *(u32x4*)(rowp + bj * HALF) = w;
        }
      }
  }
};
DEVI void phaseC2(KP p, ldsp_t lds) {
  SchedC S{(const char*)p->ws, (int)gridDim.x, BIDX};
  EpiC E{wsp<u16>(p, OFF_QARAW), wsp<u16>(p, OFF_KVARAW), wsp<float>(p, OFF_SSQ)};
  int nt = 4; asm volatile("" : "+s"(nt));
  gemm_phase<true, false, false>(lds, PLD * 2, 512, nt, S, E);
}

DEVI void ld16(const u16* src, float (&v)[16]) {
  const u32x4 a = *(const u32x4*)src, b = *(const u32x4*)(src + 8);
  const unsigned w[8] = {a.x, a.y, a.z, a.w, b.x, b.y, b.z, b.w};
#pragma unroll
  for (int i = 0; i < 8; ++i) { v[2 * i] = __uint_as_float(w[i] << 16); v[2 * i + 1] = __uint_as_float(w[i] & 0xffff0000u); }
}
DEVI void st16(u16* dst, const float (&v)[16]) {
  u32x4 a, b;
  a.x = pk2(v[0], v[1]); a.y = pk2(v[2], v[3]); a.z = pk2(v[4], v[5]); a.w = pk2(v[6], v[7]);
  b.x = pk2(v[8], v[9]); b.y = pk2(v[10], v[11]); b.z = pk2(v[12], v[13]); b.w = pk2(v[14], v[15]);
  *(u32x4*)dst = a; *(u32x4*)(dst + 8) = b;
}
DEVI void rope16c(float (&v)[16], const float* cs16, int pos) {
  const f32x2* t = (const f32x2*)(cs16 + pos * 16);
#pragma unroll
  for (int i = 0; i < 8; ++i) { const f32x2 cs = t[i]; const float x1 = v[i], x2 = v[8 + i]; v[i] = x1 * cs.x - x2 * cs.y; v[8 + i] = x2 * cs.x + x1 * cs.y; }
}
DEVI void rope32c(float (&lo)[16], float (&hi)[16], const float* cs32, int pos) {
  const f32x2* t = (const f32x2*)(cs32 + pos * 32);
#pragma unroll
  for (int i = 0; i < 16; ++i) { const f32x2 cs = t[i]; const float x1 = lo[i], x2 = hi[i]; lo[i] = x1 * cs.x - x2 * cs.y; hi[i] = x2 * cs.x + x1 * cs.y; }
}
DEVI float ssq16(const float (&v)[16]) { float s = 0.f;
#pragma unroll
  for (int i = 0; i < 16; ++i) s += v[i] * v[i];
  return s; }
DEVI void scale16(float (&v)[16], float s) {
#pragma unroll
  for (int i = 0; i < 16; ++i) v[i] *= s; }
DEVI void cvt16(const u32x4 a, const u32x4 b, float (&v)[16]) {
  const unsigned w[8] = {a.x, a.y, a.z, a.w, b.x, b.y, b.z, b.w};
#pragma unroll
  for (int i = 0; i < 8; ++i) { v[2 * i] = __uint_as_float(w[i] << 16); v[2 * i + 1] = __uint_as_float(w[i] & 0xffff0000u); }
}
DEVI void phaseP2(KP p, int l, ldsp_t lds) {
  const int tid = TIDX, tk = tid >> 3, pt = tid & 7;
  u16* PR = wsp<u16>(p, OFF_PRAW);
  u16* QA = wsp<u16>(p, OFF_QARAW);
  const float* cs32 = wsp<float>(p, OFF_CS32);
  const float* cs16 = wsp<float>(p, OFF_CS16);
  const float QS = 0.125f * LOG2E;
  for (int item = BIDX; item < NTOK / 64; item += gridDim.x) {
    const int tok0 = item * 64, rr0 = tok0 % TPB;
    const bool lat = rr0 >= NCTX;
    const size_t tok = (size_t)tok0 + tk;
    const int t = rr0 + tk - NCTX, grow = (t >> 6) & 63, gcol = t & 63;
    u16* pr = PR + tok * PLD;
    u16* qar = QA + tok * 512 + 96 * (pt >> 1) + 64 + 16 * (pt & 1);
    const int g4 = pt & 3;
    u32x4 r_qa[2], r_kr[2], r_qb[4], r_kb[4], r_qd[4], r_kd[4];
#define LD8(ptr) (*(const u32x4*)(ptr))
    if (lat) {
#pragma unroll
      for (int i = 0; i < 2; ++i) { r_qa[i] = LD8(qar + 8 * i); r_kr[i] = LD8(pr + 384 + 16 * (pt & 1) + 8 * i); }
#pragma unroll
      for (int i = 0; i < 4; ++i) { r_qb[i] = LD8(pr + 512 + 32 * pt + 8 * i); r_kb[i] = LD8(pr + 768 + 32 * g4 + 8 * i); }
    }
#pragma unroll
    for (int i = 0; i < 4; ++i) { r_qd[i] = LD8(pr + 1792 + 32 * pt + 8 * i); r_kd[i] = LD8(pr + 2048 + 32 * g4 + 8 * i); }
#undef LD8
    if (lat) {
      { float v[16]; cvt16(r_qa[0], r_qa[1], v); rope16c(v, cs16, (pt & 1) ? gcol : grow); st16(qar, v); }
      if (pt < 2) { float v[16]; cvt16(r_kr[0], r_kr[1], v); rope16c(v, cs16, pt == 0 ? grow : gcol); st16(pr + 384 + 16 * pt, v); }
      { float lo[16], hi[16]; cvt16(r_qb[0], r_qb[1], lo); cvt16(r_qb[2], r_qb[3], hi); rope32c(lo, hi, cs32, (pt & 1) ? gcol : grow); st16(pr + 512 + 32 * pt, lo); st16(pr + 512 + 32 * pt + 16, hi); }
      if (pt < 4) { float lo[16], hi[16]; cvt16(r_kb[0], r_kb[1], lo); cvt16(r_kb[2], r_kb[3], hi); rope32c(lo, hi, cs32, (pt & 1) ? gcol : grow); st16(pr + 768 + 32 * pt, lo); st16(pr + 768 + 32 * pt + 16, hi); }
    }
    {
      float lo[16], hi[16]; cvt16(r_qd[0], r_qd[1], lo); cvt16(r_qd[2], r_qd[3], hi);
      float ss = ssq16(lo) + ssq16(hi); ss += __shfl_xor(ss, 1);
      const float rs = rsqrtf(ss * (1.f / 64.f) + EPS);
      const float* g = p->g_q_d + l * 64 + 32 * (pt & 1);
#pragma unroll
      for (int i = 0; i < 16; ++i) { lo[i] *= rs * g[i]; hi[i] *= rs * g[16 + i]; }
      if (lat) rope32c(lo, hi, cs32, (pt & 1) ? gcol : grow);
      scale16(lo, QS); scale16(hi, QS);
      st16(pr + 1792 + 32 * pt, lo); st16(pr + 1792 + 32 * pt + 16, hi);
    }
    {
      float lo[16], hi[16]; cvt16(r_kd[0], r_kd[1], lo); cvt16(r_kd[2], r_kd[3], hi);
      float ss = ssq16(lo) + ssq16(hi); ss += __shfl_xor(ss, 1);
      const float rs = rsqrtf(ss * (1.f / 64.f) + EPS);
      const float* g = p->g_k_d + l * 64 + 32 * (g4 & 1);
#pragma unroll
      for (int i = 0; i < 16; ++i) { lo[i] *= rs * g[i]; hi[i] *= rs * g[16 + i]; }
      if (lat) rope32c(lo, hi, cs32, (g4 & 1) ? gcol : grow);
      if (pt < 4) { st16(pr + 2048 + 32 * g4, lo); st16(pr + 2048 + 32 * g4 + 16, hi); }
    }
  }
}

DEVI void conv_load(const ConvT& c, int lane, f32x4 (&v)[8]) {
  const int kk = lane >> 3, n4 = (lane & 7) * 4;
  const float* sp = (c.src2 && n4 >= 16) ? c.src2 + (n4 - 16) : (c.src ? c.src + n4 : nullptr);
#pragma unroll
  for (int i = 0; i < 8; ++i) v[i] = sp ? *(const f32x4*)(sp + (size_t)(kk + 8 * i) * c.ld) : f32x4{0.f, 0.f, 0.f, 0.f};
}
DEVI void conv_store(const ConvT& c, LAS float* t, int lane, const f32x4 (&v)[8]) {
  const int kk = lane >> 3, n4 = (lane & 7) * 4;
#pragma unroll
  for (int i = 0; i < 8; ++i) {
    const int k = kk + 8 * i;
    const float s = (c.ks ? c.ks[k] : 1.f) * c.mul;
    t[(n4 + 0) * 65 + k] = v[i].x * s; t[(n4 + 1) * 65 + k] = v[i].y * s;
    t[(n4 + 2) * 65 + k] = v[i].z * s; t[(n4 + 3) * 65 + k] = v[i].w * s;
  }
  asm volatile("s_waitcnt lgkmcnt(0)" ::: "memory");
  const int n = lane >> 1, k0 = (lane & 1) * 32;
  const LAS float* r = t + n * 65 + k0;
  if (c.ldd < 0) {
    unsigned char* d8 = (unsigned char*)c.dst + (size_t)n * (size_t)(-c.ldd) + k0;
#pragma unroll
    for (int q = 0; q < 2; ++q) {
      u32x4 o;
#pragma unroll
      for (int w = 0; w < 4; ++w) {
        float f[4];
#pragma unroll
        for (int j = 0; j < 4; ++j) f[j] = __builtin_amdgcn_fmed3f(r[16 * q + 4 * w + j], -448.f, 448.f);
        int v = __builtin_amdgcn_cvt_pk_fp8_f32(f[0], f[1], 0, false);
        v = __builtin_amdgcn_cvt_pk_fp8_f32(f[2], f[3], v, true);
        o[w] = (unsigned)v;
      }
      *(u32x4*)(d8 + 16 * q) = o;
    }
    asm volatile("s_waitcnt lgkmcnt(0)" ::: "memory");
    return;
  }
  u16* d = c.dst + (size_t)n * c.ldd + k0;
#pragma unroll
  for (int q = 0; q < 4; ++q) {
    u32x4 o;
    o.x = pk2(r[8 * q], r[8 * q + 1]); o.y = pk2(r[8 * q + 2], r[8 * q + 3]); o.z = pk2(r[8 * q + 4], r[8 * q + 5]); o.w = pk2(r[8 * q + 6], r[8 * q + 7]);
    *(u32x4*)(d + 8 * q) = o;
  }
  asm volatile("s_waitcnt lgkmcnt(0)" ::: "memory");
}
constexpr int CONV_EARLY = 1152 + 64 + 64;
DEVI void conv_items2(KP p, int l, ldsp_t lds, int first_item, int total_items) {
  const int tid = TIDX, wave = __builtin_amdgcn_readfirstlane(tid >> 6), lane = tid & 63;
  LAS float* t = (LAS float*)(lds + wave * 8448);
  __syncthreads();
  const int stride = gridDim.x * NW;
  int item = first_item + BIDX * NW + wave;
  if (item >= total_items) return;
  ConvT c = conv_decode(p, l, item);
  f32x4 v[8];
  conv_load(c, lane, v);
  for (;;) {
    const int nitem = item + stride;
    const bool more = nitem < total_items;
    ConvT cn = c; f32x4 vn[8];
    if (more) { cn = conv_decode(p, l, nitem); conv_load(cn, lane, vn); }
    conv_store(c, t, lane, v);
    if (!more) break;
    c = cn; item = nitem;
#pragma unroll
    for (int i = 0; i < 8; ++i) v[i] = vn[i];
  }
}
template <int BR>
DEVI void attn_mask(f32x16 (&s)[2], int kt, int qlat, int qrow, int qcol, int hh, LAS float* rpb) {
  if (BR == 1) {
#pragma unroll
    for (int kb = 0; kb < 2; ++kb)
#pragma unroll
      for (int i = 0; i < 16; ++i) {
        const int kpos = kt * 64 + kb * 32 + (i & 3) + 8 * (i >> 2) + 4 * hh;
        const int d = qlat - kpos;
        if (d > 128 || d < -128) s[kb][i] = -1e30f;
      }
  } else {
    const int rs = min(max(qrow - 4, 0), 56);
    const bool row_ok = (kt >= rs) && (kt < rs + 8);
    const int cst = min(max(qcol - 8, 0), 48);
    const int dr = kt - qrow + 7;
#pragma unroll
    for (int kb = 0; kb < 2; ++kb)
#pragma unroll
      for (int i = 0; i < 16; ++i) {
        const int kc = kb * 32 + (i & 3) + 8 * (i >> 2) + 4 * hh;
        const bool ok = row_ok && (kc >= cst) && (kc < cst + 16);
        const int idx = ok ? (dr * 31 + (kc - qcol + 15)) : 0;
        const float bias = rpb[idx];
        s[kb][i] = ok ? (s[kb][i] + bias) : -1e30f;
      }
  }
}

template <int BR>
DEVI void attn_mask1(f32x16& sb, int kb, int kt, int qlat, int qrow, int qcol, int hh, LAS float* rpb) {
  if (BR == 1) {
#pragma unroll
    for (int i = 0; i < 16; ++i) {
      const int kpos = kt * 64 + kb * 32 + (i & 3) + 8 * (i >> 2) + 4 * hh;
      const int d = qlat - kpos;
      if (d > 128 || d < -128) sb[i] = -1e30f;
    }
  } else {
    const int rs = min(max(qrow - 4, 0), 56);
    const bool row_ok = (kt >= rs) && (kt < rs + 8);
    const int cst = min(max(qcol - 8, 0), 48);
    const int dr = kt - qrow + 7;
#pragma unroll
    for (int i = 0; i < 16; ++i) {
      const int kc = kb * 32 + (i & 3) + 8 * (i >> 2) + 4 * hh;
      const bool ok = row_ok && (kc >= cst) && (kc < cst + 16);
      const int idx = ok ? (dr * 31 + (kc - qcol + 15)) : 0;
      const float bias = rpb[idx];
      sb[i] = ok ? (sb[i] + bias) : -1e30f;
    }
  }
}
#define FADD(a, b) do { (a) += (b); asm("" : "+v"(a)); } while (0)
typedef short v4i16_t __attribute__((ext_vector_type(4)));
DEVI bf16x8 vtr2(ldsp_t a) {
  const v4i16_t lo = __builtin_amdgcn_ds_read_tr16_b64_v4i16((LAS v4i16_t*)a);
  const v4i16_t hi = __builtin_amdgcn_ds_read_tr16_b64_v4i16((LAS v4i16_t*)(a + 8 * 144));
  return __builtin_shufflevector(lo, hi, 0, 1, 2, 3, 4, 5, 6, 7);
}
DEVI bf16x8 vtr2s(ldsp_t a, int o0, int o1) {
  const v4i16_t lo = __builtin_amdgcn_ds_read_tr16_b64_v4i16((LAS v4i16_t*)(a + o0));
  const v4i16_t hi = __builtin_amdgcn_ds_read_tr16_b64_v4i16((LAS v4i16_t*)(a + 8 * 128 + o1));
  return __builtin_shufflevector(lo, hi, 0, 1, 2, 3, 4, 5, 6, 7);
}
template <int BR, bool FAST>
DEVI bool attn_item2(KP p, int l, int b, int hs, int qb, bool isctx, ldsp_t lds) {
  constexpr bool MLA = (BR == 0);
  constexpr bool GQA = (BR == 1 || BR == 3);
  constexpr int QBLK = GQA ? 256 : 512;
  constexpr int NKS = MLA ? 6 : 4;
  constexpr int STG = 8192 + 8192 + 4096;
  const int tid = TIDX, lane = tid & 63, wave = __builtin_amdgcn_readfirstlane(tid >> 6);
  const int r32 = lane & 31, hh = lane >> 5;
  const int hq = GQA ? (hs * 2 + (wave & 1)) : hs;
  const int woff = GQA ? 64 * (wave >> 1) : 64 * wave;
  const int q0 = (isctx ? 0 : NCTX) + qb * QBLK;
  const bool active = !isctx || (woff < NCTX);
  const size_t tokq = (size_t)b * TPB + q0 + (active ? woff : 0) + r32;
  const u16* Qp; const u16* Kp; int ldk; const u16* Vp; int ldv; int obase; int ldq;
  const u16* PR = wsp<u16>(p, OFF_PRAW);
  if (BR == 0) { Qp = wsp<u16>(p, OFF_QARAW) + tokq * 512 + hq * 96; ldq = 512; Kp = wsp<u16>(p, OFF_KVARAW) + (size_t)b * TPB * 512 + hs * 128; ldk = 512; Vp = wsp<u16>(p, OFF_KVARAW) + (size_t)b * TPB * 512 + hs * 128 + 64; ldv = 512; obase = hq * 64; }
  else if (BR == 1) { Qp = PR + tokq * PLD + 512 + hq * 64; ldq = PLD; Kp = PR + (size_t)b * TPB * PLD + 768 + hs * 64; ldk = PLD; Vp = PR + (size_t)b * TPB * PLD + 896 + hs * 64; ldv = PLD; obase = 256 + hq * 64; }
  else if (BR == 2) { Qp = PR + tokq * PLD + 1024 + hq * 64; ldq = PLD; Kp = PR + (size_t)b * TPB * PLD + 1280 + hs * 64; ldk = PLD; Vp = PR + (size_t)b * TPB * PLD + 1536 + hs * 64; ldv = PLD; obase = 512 + hq * 64; }
  else { Qp = PR + tokq * PLD + 1792 + hq * 64; ldq = PLD; Kp = PR + (size_t)b * TPB * PLD + 2048 + hs * 64; ldk = PLD; Vp = PR + (size_t)b * TPB * PLD + 2176 + hs * 64; ldv = PLD; obase = 768 + hq * 64; }
  const u16* KRp = PR + (size_t)b * TPB * PLD + 384;
  int lat_lo = 0, lat_n = 0, wlo = 0, whi = 63;
  if (!isctx) {
    if (BR == 0 || BR == 3) { lat_lo = 0; lat_n = 64; }
    else if (BR == 1) {
      const int ql = qb * QBLK; const int lo = max(0, ql - 128) >> 6, hi = min(SEQ - 1, ql + QBLK - 1 + 128) >> 6; lat_lo = lo; lat_n = hi - lo + 1;
      const int wq = ql + woff; wlo = max(0, wq - 128) >> 6; whi = min(SEQ - 1, wq + 63 + 128) >> 6;
    } else {
      const int r0 = 8 * qb; const int lo = min(max(r0 - 4, 0), 56), hi = min(max(r0 + 7 - 4, 0), 56) + 7; lat_lo = lo; lat_n = hi - lo + 1;
      const int wr_ = r0 + wave; wlo = min(max(wr_ - 4, 0), 56); whi = wlo + 7;
    }
  }
  const int NT = 4 + lat_n;
  const int qlat0 = qb * QBLK + woff + r32;
  bf16x8 qf[2][NKS];
#pragma unroll
  for (int qi = 0; qi < 2; ++qi)
#pragma unroll
    for (int ks = 0; ks < NKS; ++ks) qf[qi][ks] = *(const bf16x8*)(Qp + (size_t)qi * 32 * ldq + ks * 16 + hh * 8);
  const int drow = 8 * wave + (lane >> 3), dch = (lane & 7) ^ ((drow >> 1) & 7);
  const int rrow = 16 * (wave & 3) + (lane >> 2), rch = (lane & 3) ^ ((rrow >> 2) & 3);
  auto keytile = [&](int j) { return (j < 4) ? j : (4 + lat_lo + (j - 4)); };
#define DMA16(sbase, voff, ldsaddr) asm volatile("s_mov_b32 m0, %2\n\ts_nop 0\n\tglobal_load_lds_dwordx4 %0, %1" :: "v"(voff), "s"(sbase), "s"(ldsaddr) : "memory", "m0")
#define A_DMA(j, st) do { const int key0_ = keytile(j) * 64; const unsigned base_ = __builtin_amdgcn_readfirstlane((unsigned)(size_t)(lds + (st) * STG) + wave * 1024); \
    DMA16(Kp, (unsigned)(((key0_ + drow) * ldk + dch * 8) * 2), base_); \
    DMA16(Vp, (unsigned)(((key0_ + drow) * ldv + dch * 8) * 2), base_ + 8192u); \
    if (MLA && wave < 4) DMA16(KRp, (unsigned)(((key0_ + rrow) * PLD + rch * 8) * 2), __builtin_amdgcn_readfirstlane(base_ + 16384u)); \
  } while (0)
  LAS float* rpb = (LAS float*)(lds + 2 * STG);
  __syncthreads();
  if (FAST && tid == 0) *(LAS int*)(lds + 2 * STG + 2048) = 0;
  A_DMA(0, 0);
  if (BR == 2 && !isctx) {
    const float* src = p->rpb_c + (size_t)(l * 4 + hs) * 465;
    for (int i = tid; i < 465; i += 512) rpb[i] = src[i] * LOG2E;
  }
  asm volatile("s_waitcnt vmcnt(0)" ::: "memory");
#pragma unroll
  for (int qi = 0; qi < 2; ++qi)
#pragma unroll
    for (int ks = 0; ks < NKS; ++ks) asm volatile("" : "+v"(qf[qi][ks]));
  __syncthreads();
  f32x16 o[2][2];
#pragma unroll
  for (int qi = 0; qi < 2; ++qi)
#pragma unroll
    for (int i = 0; i < 16; ++i) { o[qi][0][i] = 0.f; o[qi][1][i] = 0.f; }
  float m_run[2], l_run[2];
#pragma unroll
  for (int qi = 0; qi < 2; ++qi) { m_run[qi] = -INFINITY; l_run[qi] = 0.f; }
  if (BR == 1) { const float sk = p->sink_b[l * 4 + hq] * LOG2E; m_run[0] = sk; m_run[1] = sk; l_run[0] = (hh == 0) ? (FAST ? __builtin_amdgcn_exp2f(sk) : 1.f) : 0.f; l_run[1] = l_run[0]; }
  float l2[2][2];
#pragma unroll
  for (int qi = 0; qi < 2; ++qi) { l2[qi][0] = l_run[qi]; l2[qi][1] = 0.f; }
  const int kkey = (r32 >> 1) & 7, rkey = (r32 >> 2) & 3;
  const ldsp_t kfb = lds + r32 * 128;
  const ldsp_t krb = lds + 16384 + r32 * 64;
  const int vq = (lane & 15) >> 2, vkey = 2 * hh + (vq >> 1);
  const int vch = 2 * ((lane >> 4) & 1) + ((lane & 3) >> 1);
  const ldsp_t vfb = lds + 8192 + (4 * hh + vq) * 128 + 8 * (lane & 1);
#define SB() __builtin_amdgcn_sched_barrier(0)
#define KLOAD(kb, ks) (((ks) < 4) ? *(const LAS bf16x8*)(kfb + st + (kb) * 4096 + (((2 * (ks) + hh) ^ kkey) << 4)) : *(const LAS bf16x8*)(krb + st + (kb) * 2048 + (((2 * ((ks) - 4) + hh) ^ rkey) << 4)))
#define VLOAD(s4, db) vtr2s(vfb + st + (s4) * 2048, ((4 * (db) + vch) ^ vkey) << 4, ((4 * (db) + vch) ^ vkey ^ 4) << 4)
#define SM_EL(kb, e) do { const int qi_ = (e) >> 4, i_ = (e) & 15; \
    const float x_ = __builtin_amdgcn_exp2f(s[qi_][kb][i_]); s[qi_][kb][i_] = x_; FADD(l2[qi_][i_ & 1], x_); \
    if (i_ & 1) pw[kb][qi_][i_ >> 3][(i_ & 7) >> 1] = pk2(s[qi_][kb][i_ - 1], x_); } while (0)
#define F_STEP(j) do { \
    const int st = ((j) & 1) * STG; \
    if ((j) + 1 < NT) A_DMA((j) + 1, ((j) + 1) & 1); \
    const int kt_ = lat_lo + (j) - 4; \
    const bool need = active && ((j) < 4 || (kt_ >= wlo && kt_ <= whi)); \
    if (need) { \
      f32x16 s[2][2]; bf16x8 kf[NKS]; bf16x8 vf[4]; u32x4 pw[2][2][2]; \
      const f32x16 zero16 = {0.f, 0.f, 0.f, 0.f, 0.f, 0.f, 0.f, 0.f, 0.f, 0.f, 0.f, 0.f, 0.f, 0.f, 0.f, 0.f}; \
      const bool domask = (BR == 1 || BR == 2) && (j) >= 4; \
      _Pragma("unroll") for (int ks = 0; ks < NKS; ++ks) kf[ks] = KLOAD(0, ks); \
      _Pragma("unroll") for (int ks = 0; ks < NKS; ++ks) { \
        s[0][0] = MFMA(kf[ks], qf[0][ks], ks == 0 ? zero16 : s[0][0]); s[1][0] = MFMA(kf[ks], qf[1][ks], ks == 0 ? zero16 : s[1][0]); \
        SB(); kf[ks] = KLOAD(1, ks); SB(); } \
      if (domask) { _Pragma("unroll") for (int qi = 0; qi < 2; ++qi) { const int ql_ = qlat0 + 32 * qi; attn_mask1<BR>(s[qi][0], 0, kt_, ql_, ql_ >> 6, ql_ & 63, hh, rpb); } } \
      _Pragma("unroll") for (int m = 0; m < 2 * NKS; ++m) { \
        s[m & 1][1] = MFMA(kf[m >> 1], qf[m & 1][m >> 1], (m >> 1) == 0 ? zero16 : s[m & 1][1]); \
        if (m < 4) vf[m] = VLOAD(m >> 1, m & 1); \
        _Pragma("unroll") for (int e = (m * 32) / (2 * NKS); e < ((m + 1) * 32) / (2 * NKS); ++e) SM_EL(0, e); \
        SB(); } \
      if (domask) { _Pragma("unroll") for (int qi = 0; qi < 2; ++qi) { const int ql_ = qlat0 + 32 * qi; attn_mask1<BR>(s[qi][1], 1, kt_, ql_, ql_ >> 6, ql_ & 63, hh, rpb); } } \
      _Pragma("unroll") for (int m = 0; m < 8; ++m) { \
        o[m & 1][(m >> 1) & 1] = MFMA(vf[m >> 1], __builtin_bit_cast(bf16x8, pw[0][m & 1][m >> 2]), o[m & 1][(m >> 1) & 1]); \
        if (m & 1) { SB(); vf[m >> 1] = VLOAD(2 + (m >> 2), (m >> 1) & 1); } \
        _Pragma("unroll") for (int e = 4 * m; e < 4 * m + 4; ++e) SM_EL(1, e); \
        SB(); } \
      _Pragma("unroll") for (int m = 0; m < 8; ++m) \
        o[m & 1][(m >> 1) & 1] = MFMA(vf[m >> 1], __builtin_bit_cast(bf16x8, pw[1][m & 1][m >> 2]), o[m & 1][(m >> 1) & 1]); \
    } \
    asm volatile("s_waitcnt vmcnt(0)" ::: "memory"); \
    __syncthreads(); \
  } while (0)
#define A_STEP(j) do { \
    const int st = ((j) & 1) * STG; \
    if ((j) + 1 < NT) A_DMA((j) + 1, ((j) + 1) & 1); \
    const int kt_ = lat_lo + (j) - 4; \
    const bool need = active && ((j) < 4 || (kt_ >= wlo && kt_ <= whi)); \
    if (need) { \
      f32x16 s[2][2]; \
      _Pragma("unroll") for (int kb = 0; kb < 2; ++kb) { \
        _Pragma("unroll") for (int ks = 0; ks < 4; ++ks) { const bf16x8 kf = *(const LAS bf16x8*)(kfb + st + kb * 4096 + (((2 * ks + hh) ^ kkey) << 4)); \
          _Pragma("unroll") for (int qi = 0; qi < 2; ++qi) { if (ks == 0) { _Pragma("unroll") for (int i = 0; i < 16; ++i) s[qi][kb][i] = 0.f; } s[qi][kb] = MFMA(kf, qf[qi][ks], s[qi][kb]); } } \
        if (MLA) { _Pragma("unroll") for (int ks = 0; ks < 2; ++ks) { const bf16x8 kf = *(const LAS bf16x8*)(krb + st + kb * 2048 + (((2 * ks + hh) ^ rkey) << 4)); \
          _Pragma("unroll") for (int qi = 0; qi < 2; ++qi) s[qi][kb] = MFMA(kf, qf[qi][NKS - 2 + ks], s[qi][kb]); } } \
      } \
      if (FAST) __builtin_amdgcn_sched_barrier(0); \
      _Pragma("unroll") for (int qi = 0; qi < 2; ++qi) { \
        if ((BR == 1 || BR == 2) && (j) >= 4) { const int ql_ = qlat0 + 32 * qi; attn_mask<BR>(s[qi], kt_, ql_, ql_ >> 6, ql_ & 63, hh, rpb); } \
        if (FAST) { \
          float ls0 = 0.f, ls1 = 0.f; \
          _Pragma("unroll") for (int i = 0; i < 16; ++i) { \
            const float e0 = __builtin_amdgcn_exp2f(s[qi][0][i]), e1 = __builtin_amdgcn_exp2f(s[qi][1][i]); \
            s[qi][0][i] = e0; s[qi][1][i] = e1; FADD(ls0, e0); FADD(ls1, e1); } \
          l_run[qi] += ls0 + ls1; \
        } else { \
        float mx = s[qi][0][0]; \
        _Pragma("unroll") for (int i = 1; i < 16; ++i) mx = fmaxf(mx, s[qi][0][i]); \
        _Pragma("unroll") for (int i = 0; i < 16; ++i) mx = fmaxf(mx, s[qi][1][i]); \
        mx = fmaxf(mx, __shfl_xor(mx, 32)); \
        const float m_new = fmaxf(m_run[qi], mx); \
        const float alpha = __builtin_amdgcn_exp2f(m_run[qi] - m_new); \
        m_run[qi] = m_new; \
        float ls0 = 0.f, ls1 = 0.f; \
        _Pragma("unroll") for (int i = 0; i < 16; ++i) { \
          const float e0 = __builtin_amdgcn_exp2f(s[qi][0][i] - m_new), e1 = __builtin_amdgcn_exp2f(s[qi][1][i] - m_new); \
          s[qi][0][i] = e0; s[qi][1][i] = e1; ls0 += e0; ls1 += e1; } \
        l_run[qi] = l_run[qi] * alpha + (ls0 + ls1); \
        if (__any(alpha != 1.f)) { _Pragma("unroll") for (int i = 0; i < 16; ++i) { o[qi][0][i] *= alpha; o[qi][1][i] *= alpha; } } \
        } \
      } \
      _Pragma("unroll") for (int s4 = 0; s4 < 4; ++s4) { \
        const int kb = s4 >> 1, rb = (s4 & 1) * 8; \
        bf16x8 pf[2]; \
        _Pragma("unroll") for (int qi = 0; qi < 2; ++qi) { u32x4 pw; \
          pw.x = pk2(s[qi][kb][rb + 0], s[qi][kb][rb + 1]); pw.y = pk2(s[qi][kb][rb + 2], s[qi][kb][rb + 3]); \
          pw.z = pk2(s[qi][kb][rb + 4], s[qi][kb][rb + 5]); pw.w = pk2(s[qi][kb][rb + 6], s[qi][kb][rb + 7]); \
          pf[qi] = __builtin_bit_cast(bf16x8, pw); } \
        _Pragma("unroll") for (int db = 0; db < 2; ++db) { const bf16x8 vf = vtr2s(vfb + st + s4 * 2048, ((4 * db + vch) ^ vkey) << 4, ((4 * db + vch) ^ vkey ^ 4) << 4); \
          o[0][db] = MFMA(vf, pf[0], o[0][db]); o[1][db] = MFMA(vf, pf[1], o[1][db]); } \
      } \
    } \
    asm volatile("s_waitcnt vmcnt(0)" ::: "memory");        \
    __syncthreads(); \
  } while (0)
  if (FAST) {
    if (wave >= 4) __builtin_amdgcn_s_setprio(1);
    for (int j = 0; j < NT; j += 2) {
      F_STEP(j);
      if (j + 1 < NT) F_STEP(j + 1);
    }
    __builtin_amdgcn_s_setprio(0);
  } else {
    for (int j = 0; j < NT; j += 2) {
      A_STEP(j);
      if (j + 1 < NT) A_STEP(j + 1);
    }
  }
#undef F_STEP
#undef SM_EL
#undef A_STEP
#undef A_DMA
#undef DMA16
  bool bad = false;
  if (active) {
#pragma unroll
    for (int qi = 0; qi < 2; ++qi) {
      if (FAST) l_run[qi] = l2[qi][0] + l2[qi][1];
      const float lt = l_run[qi] + __shfl_xor(l_run[qi], 32);
      const float inv = 1.f / lt;
      if (FAST) bad = bad || !(lt > 1e-25f && lt < 1e25f);
      unsigned char* Op = wsp<unsigned char>(p, OFF_O) + (tokq + 32 * qi) * 1024 + obase;
#pragma unroll
      for (int db = 0; db < 2; ++db)
#pragma unroll
        for (int gp = 0; gp < 2; ++gp) {
          float q[8];
#pragma unroll
          for (int j = 0; j < 8; ++j) q[j] = __builtin_amdgcn_fmed3f(o[qi][db][8 * gp + j] * (inv * O8_SCALE), -448.f, 448.f);
          int wa = __builtin_amdgcn_cvt_pk_fp8_f32(q[0], q[1], 0, false); wa = __builtin_amdgcn_cvt_pk_fp8_f32(q[2], q[3], wa, true);
          int wb = __builtin_amdgcn_cvt_pk_fp8_f32(q[4], q[5], 0, false); wb = __builtin_amdgcn_cvt_pk_fp8_f32(q[6], q[7], wb, true);
          const u32x2 sx = __builtin_amdgcn_permlane32_swap((unsigned)wa, (unsigned)wb, false, false);
          *(u32x2*)(Op + db * 32 + 16 * gp + 8 * hh) = sx;
        }
    }
  }
  if (!FAST) return false;
  LAS int* flag = (LAS int*)(lds + 2 * STG + 2048);
  if (__any(bad) && lane == 0) *flag = 1;
  __syncthreads();
  return __builtin_amdgcn_readfirstlane(*flag) != 0;
}
template <bool FAST>
DEVI bool attn_dispatch(KP p, int l, int n, int xcd, ldsp_t lds) {
  int br, s, qb; bool isctx = false;
  if (n < 32) { br = 0; s = xcd + 8 * (n >> 3); qb = n & 7; }
  else if (n < 64) { const int m = n - 32; br = 3; s = xcd + 8 * (m >> 4); qb = m & 15; }
  else if (n < 96) { const int m = n - 64; br = 2; s = xcd + 8 * (m >> 3); qb = m & 7; }
  else if (n < 128) { const int m = n - 96; br = 1; s = xcd + 8 * (m >> 4); qb = m & 15; }
  else {
    const int m = n - 128; isctx = true; qb = 0;
    if (m < 4) { br = 0; s = xcd + 8 * m; }
    else if (m < 6) { br = 3; s = xcd + 8 * (m - 4); }
    else if (m < 10) { br = 2; s = xcd + 8 * (m - 6); }
    else { br = 1; s = xcd + 8 * (m - 10); }
  }
  if (br == 0) return attn_item2<0, FAST>(p, l, s >> 2, s & 3, qb, isctx, lds);
  else if (br == 1) return attn_item2<1, FAST>(p, l, s >> 1, s & 1, qb, isctx, lds);
  else if (br == 2) return attn_item2<2, FAST>(p, l, s >> 2, s & 3, qb, isctx, lds);
  else return attn_item2<3, FAST>(p, l, s >> 1, s & 1, qb, isctx, lds);
}
DEVI void phaseD2(KP p, int l, ldsp_t lds) {
  const int G8 = gridDim.x >> 3, xcd = BIDX & 7, lb = BIDX >> 3;
  if (lb >= G8) return;
  const int NLOC = 128 + (l == 0 ? 12 : 0);
  const int nmine = (NLOC - lb + G8 - 1) / G8;
  const int cslot = min((int)(BIDX & 3), nmine - 1);
  int it = 0; unsigned redo = 0;
  for (int n = lb; n < NLOC; n += G8, ++it) {
    if (it == cslot) conv_items2(p, l, lds, CONV_EARLY, CONV_ITEMS);
    if (attn_dispatch<true>(p, l, n, xcd, lds)) redo |= 1u << it;
  }
  if (redo) {
    it = 0;
    for (int n = lb; n < NLOC; n += G8, ++it)
      if ((redo >> it) & 1) attn_dispatch<false>(p, l, n, xcd, lds);
  }
}

DEVI int pm_map(int pme, bool skipctx) { return skipctx ? (pme >> 4) * 17 + 1 + (pme & 15) : pme; }
struct SchedE1 { const char* ws; bool skipctx; int G, c;
  DEVI bool next(int i, Unit& u) const { int pm, pn; if (!tile_order(i, G, c, skipctx ? 128 : 136, 16, pm, pn)) return false;
    pm = pm_map(pm, skipctx); const int n = pn >> 2, cq = pn & 3;
    u.A = ws + OFF_O + uoff((unsigned)pm * 256u * 1024u + (unsigned)n * 256u); u.B = ws + OFF_WBR + uoff(((unsigned)n * 1024u + (unsigned)cq * 256u) * 256u); u.rows = nullptr; u.nvalid = 0;
    u.u0 = pm * 256; u.u1 = pn * 256; u.u2 = 0; u.u3 = 0; return true; } };
DEVI void phaseE1(KP p, int l, ldsp_t lds) {
  if (BIDX == 0 && TIDX < 32) wsp<int>(p, OFF_CNT)[TIDX * CNT_STRIDE] = 0;
  SchedE1 S{(const char*)p->ws, l == 1, (int)gridDim.x, BIDX};
  EpiZ8 E{wsp<unsigned char>(p, OFF_Z)};
  gemm_phase<true, false, true>(lds, 1024, 256, 2, S, E);
}
struct SchedE2 { const char* ws; const char* h8; bool skipctx; int G, c;
  DEVI bool next(int i, Unit& u) const { int pm, pn; if (!tile_order(i >> 1, G, c, skipctx ? 128 : 136, 8, pm, pn)) return false;
    pm = pm_map(pm, skipctx); const int pr = i & 1;
    u.A = h8 + uoff((unsigned)pm * 256u * 1024u); u.B = ws + OFF_WGATE + uoff((unsigned)(pr * 8 + pn) * 256u * 1024u); u.rows = nullptr; u.nvalid = 0;
    u.u0 = pm * 256; u.u1 = pn * 128; u.u2 = pr; u.u3 = 0; return true; } };
constexpr float Y8_SCALE = 16.f;
struct EpiE2 { const unsigned char* Z; u16* Y; unsigned char* Y8; const float* bias;
  DEVI void init(f32x4 (&acc)[2][2][4][2], const Unit& u, int wr, int wc, int fr, int fq) const {
    const int col0 = u.u1 + wc * 32 + 8 * fq;
#pragma unroll
    for (int bj = 0; bj < 2; ++bj)
#pragma unroll
      for (int nn = 0; nn < 2; ++nn) {
        const f32x4 b = *(const f32x4*)(bias + (2 * u.u2 + bj) * 1024 + col0 + 4 * nn) * GATE_WSCALE;
#pragma unroll
        for (int a = 0; a < 2; ++a)
#pragma unroll
          for (int m = 0; m < 4; ++m) acc[a][bj][m][nn] = b;
      }
  }
  DEVI void operator()(const f32x4 (&acc)[2][2][4][2], const Unit& u, int wr, int wc, int fr, int fq) const {
    const int row0 = u.u0 + wr * 64 + fr, col0 = u.u1 + wc * 32 + 8 * fq, pr = u.u2;
    const unsigned lw16 = (unsigned)((wr * 4 + wc) * 64 + fr + 16 * fq) * 16u;
    const unsigned char* zb0 = Z + z8_block(u.u0 >> 8, 2 * pr, u.u1 >> 7) + lw16;
    char* yb = (char*)Y + (size_t)((u.u0 >> 8) * 8 + (u.u1 >> 7)) * 65536 + lw16;
    u32x4 zq[2][2], yq[2][2];
    auto ldpair = [&](int P, u32x4 (&z)[2], u32x4 (&y)[2]) {
#pragma unroll
      for (int bj = 0; bj < 2; ++bj) z[bj] = *(const u32x4*)(zb0 + (size_t)bj * 8 * 32768 + P * 8192);
#pragma unroll
      for (int h = 0; h < 2; ++h) y[h] = pr ? *(const u32x4*)(yb + (2 * P + h) * 8192) : u32x4{0u, 0u, 0u, 0u};
    };
    ldpair(0, zq[0], yq[0]);
#pragma unroll
    for (int P = 0; P < 4; ++P) {
      const int c = P & 1;
      if (P + 1 < 4) ldpair(P + 1, zq[c ^ 1], yq[c ^ 1]);
#pragma unroll
      for (int h = 0; h < 2; ++h) {
        const int g = 2 * P + h, ai = g >> 2, m = g & 3;
        const size_t r = (size_t)(row0 + ai * HALF + m * 16);
        float t[8];
        {
          const unsigned w[4] = {yq[c][h].x, yq[c][h].y, yq[c][h].z, yq[c][h].w};
#pragma unroll
          for (int i = 0; i < 4; ++i) { t[2 * i] = __uint_as_float(w[i] << 16); t[2 * i + 1] = __uint_as_float(w[i] & 0xffff0000u); }
        }
#pragma unroll
        for (int bj = 0; bj < 2; ++bj) {
#pragma unroll
          for (int nn = 0; nn < 2; ++nn) {
            const int zw = (int)zq[c][bj][2 * h + nn];
            const f32x2 zlo = __builtin_amdgcn_cvt_pk_f32_fp8(zw, false), zhi = __builtin_amdgcn_cvt_pk_f32_fp8(zw, true);
            const float zz4[4] = {zlo.x, zlo.y, zhi.x, zhi.y};
#pragma unroll
            for (int j = 0; j < 4; ++j) {
              const int e = 4 * nn + j;
              const float gte = __builtin_amdgcn_rcpf(1.f + __builtin_amdgcn_exp2f(acc[ai][bj][m][nn][j] * (-LOG2E / GATE_WSCALE)));
              t[e] += gte * (zz4[j] * (1.f / Z8_SCALE));
            }
          }
        }
        if (pr == 0) {
          u32x4 o; o.x = pk2(t[0], t[1]); o.y = pk2(t[2], t[3]); o.z = pk2(t[4], t[5]); o.w = pk2(t[6], t[7]);
          *(u32x4*)(yb + g * 8192) = o;
        } else {
          u32x2 o8;
#pragma unroll
          for (int w = 0; w < 2; ++w) {
            float q[4];
#pragma unroll
            for (int j = 0; j < 4; ++j) q[j] = __builtin_amdgcn_fmed3f(t[4 * w + j] * Y8_SCALE, -448.f, 448.f);
            int v = __builtin_amdgcn_cvt_pk_fp8_f32(q[0], q[1], 0, false);
            v = __builtin_amdgcn_cvt_pk_fp8_f32(q[2], q[3], v, true);
            o8[w] = (unsigned)v;
          }
          *(u32x2*)(Y8 + r * 1024 + col0) = o8;
        }
      }
    }
  }
};
DEVI void phaseE2(KP p, int l, ldsp_t lds) {
  SchedE2 S{(const char*)p->ws, (const char*)h8base(p), l == 1, (int)gridDim.x, BIDX};
  EpiE2 E{wsp<unsigned char>(p, OFF_Z), wsp<u16>(p, OFF_YPRE), wsp<unsigned char>(p, OFF_Y8), p->b_gate + (size_t)l * 4 * 1024};
  gemm_phase<true, false, true>(lds, 1024, 1024, 8, S, E);
}
struct SchedF { const char* ws; bool skipctx; int G, c;
  DEVI bool next(int i, Unit& u) const { int pm, pn;
    if (skipctx || G != 256) { if (!tile_order(i, G, c, skipctx ? 128 : 136, 4, pm, pn)) return false; }
    else if (i < 2) { if (!tile_order(i, G, c, 128, 4, pm, pn)) return false; }
    else { if (i > 2 || c >= 32) return false; pm = 128 + (c >> 2); pn = c & 3; }
    pm = pm_map(pm, skipctx);
    u.A = ws + OFF_Y8 + uoff((unsigned)pm * 256u * 1024u); u.B = ws + OFF_WOUT + uoff((unsigned)pn * 256u * 1024u); u.rows = nullptr; u.nvalid = 0;
    u.u0 = pm; u.u1 = pn * 256; u.u2 = 0; u.u3 = 0; return true; } };
struct EpiF { KP p; int l;
  DEVI void init(f32x4 (&acc)[2][2][4][2], const Unit&, int, int, int, int) const { acc_zero(acc); }
  DEVI void operator()(const f32x4 (&acc)[2][2][4][2], const Unit& u, int wr, int wc, int fr, int fq) const {
    const int pm = u.u0, b = pm / 17, rr0 = (pm % 17) * 256;
    const int mrow = (rr0 < NCTX) ? 8 : b;
    const int col0 = u.u1 + wc * 32 + 8 * fq;
    const float* gt = wsp<float>(p, OFF_MOD) + ((size_t)l * 9 + mrow) * 6144 + 2048 + col0;
    const u16* xinb = (const u16*)p->out + (size_t)(b * TPB + rr0) * 1024 + col0;
    const __amdgpu_buffer_rsrc_t xrs = __builtin_amdgcn_make_buffer_rsrc((void*)wsp<u16>(p, OFF_XM), 0, NTOK * 1024 * 2, 0x00020000);
    const unsigned xoff = (unsigned)((b * TPB + rr0) * 1024 + col0) * 2u;
    f32x4 gv[2][2];
#pragma unroll
    for (int bj = 0; bj < 2; ++bj)
#pragma unroll
      for (int n = 0; n < 2; ++n) gv[bj][n] = *(const f32x4*)(gt + bj * HALF + n * 4) * (1.f / (F8_WSCALE * Y8_SCALE));
#pragma unroll
    for (int ai = 0; ai < 2; ++ai)
#pragma unroll
      for (int mp = 0; mp < 2; ++mp) {
        u32x4 xo[2][2];
#pragma unroll
        for (int mm = 0; mm < 2; ++mm) {
          const size_t ro = (size_t)(wr * 64 + fr + ai * HALF + (2 * mp + mm) * 16) * 1024;
#pragma unroll
          for (int bj = 0; bj < 2; ++bj) xo[mm][bj] = *(const u32x4*)(xinb + ro + bj * HALF);
        }
#pragma unroll
        for (int mm = 0; mm < 2; ++mm) {
          const int m = 2 * mp + mm;
          const size_t ro = (size_t)(wr * 64 + fr + ai * HALF + m * 16) * 1024;
#pragma unroll
          for (int bj = 0; bj < 2; ++bj) {
            const u32x4 v = xo[mm][bj];
            const f32x4 x0 = f32x4{__uint_as_float(v.x << 16), __uint_as_float(v.x & 0xffff0000u), __uint_as_float(v.y << 16), __uint_as_float(v.y & 0xffff0000u)};
            const f32x4 x1 = f32x4{__uint_as_float(v.z << 16), __uint_as_float(v.z & 0xffff0000u), __uint_as_float(v.w << 16), __uint_as_float(v.w & 0xffff0000u)};
            const f32x4 r0 = x0 + gv[bj][0] * acc[ai][bj][m][0], r1 = x1 + gv[bj][1] * acc[ai][bj][m][1];
            __builtin_amdgcn_raw_buffer_store_b128(u32x4{pk2(r0.x, r0.y), pk2(r0.z, r0.w), pk2(r1.x, r1.y), pk2(r1.z, r1.w)}, xrs,
                                                   (int)(xoff + (unsigned)(ro + bj * HALF) * 2u), 0, 16);
          }
        }
      }
    asm volatile("s_waitcnt vmcnt(0)" ::: "memory");
    if ((TIDX & 63) == 0) __hip_atomic_fetch_add(wsp<int>(p, OFF_DEP) + (l * 136 + pm) * DEP_STRIDE, 1, __ATOMIC_RELAXED, __HIP_MEMORY_SCOPE_AGENT);
  }
};
DEVI void phaseF2(KP p, int l, ldsp_t lds) {
  SchedF S{(const char*)p->ws, l == 1, (int)gridDim.x, BIDX};
  EpiF E{p, l};
  gemm_phase<true, false, true>(lds, 1024, 1024, 8, S, E);
}


DEVI void phase0_2(KP p, ldsp_t lds) {
  const int tid = TIDX, half = tid >> 8, htid = tid & 255;
  for (int it = BIDX * 2; it < 458; it += gridDim.x * 2) {
    const int item = it + half;
    LAS float* sc = (LAS float*)(lds + half * 16384);
    const bool ismod = item < 384;
    const int l = item / 192, rem = item % 192, cgp = rem >> 3, kc = rem & 7;
    __syncthreads();
    if (ismod) {
      for (int i = htid; i < 9 * 128; i += 256) {
        int b = i >> 7, k = i & 127;
        float v = (b < 8) ? p->c[b * 1024 + kc * 128 + k] : p->c_ctx[kc * 128 + k];
        sc[i] = v / (1.f + __expf(-v));
      }
    }
    __syncthreads();
    if (ismod) {
      float acc[9];
#pragma unroll
      for (int b = 0; b < 9; ++b) acc[b] = 0.f;
      const float* w = p->w_mod + ((size_t)l * 1024 + kc * 128) * 6144 + cgp * 256 + htid;
#pragma unroll 32
      for (int k = 0; k < 128; ++k) {
        float wv = w[(size_t)k * 6144];
#pragma unroll
        for (int b = 0; b < 9; ++b) acc[b] += sc[b * 128 + k] * wv;
      }
      float* dst = wsp<float>(p, OFF_MODP) + (size_t)((kc * 2 + l) * 9) * 6144 + cgp * 256 + htid;
#pragma unroll
      for (int b = 0; b < 9; ++b) dst[(size_t)b * 6144] = acc[b];
    } else if (item == 384) {
      float* cs32 = wsp<float>(p, OFF_CS32);
      float* cs16 = wsp<float>(p, OFF_CS16);
      for (int t = htid; t < 1024; t += 256) {
        int pos = t >> 4, i = t & 15;
        float ang = (float)pos * __builtin_amdgcn_exp2f(-(float)(2 * i) * (13.287712379549449f / 32.f));
        cs32[t * 2] = __cosf(ang); cs32[t * 2 + 1] = __sinf(ang);
      }
      for (int t = htid; t < 512; t += 256) {
        int pos = t >> 3, i = t & 7;
        float ang = (float)pos * __builtin_amdgcn_exp2f(-(float)(2 * i) * (13.287712379549449f / 16.f));
        cs16[t * 2] = __cosf(ang); cs16[t * 2 + 1] = __sinf(ang);
      }
    } else if (item < 457) {
      const int q = item - 385, ll = q / 36, o = q % 36;
      float* dst = wsp<float>(p, OFF_WRT) + ((size_t)ll * 36 + o) * 1024;
      for (int k = htid; k < 1024; k += 256)
        dst[k] = (o < 4) ? p->w_group[((size_t)ll * 1024 + k) * 4 + o] : p->w_router[((size_t)ll * 1024 + k) * 32 + (o - 4)];
    }
  }
}
DEVI void phase1_2(KP p) {
  const float* mp = wsp<float>(p, OFF_MODP);
  float* mo = wsp<float>(p, OFF_MOD);
  for (int i = BIDX * 512 + TIDX; i < 2 * 9 * 6144; i += gridDim.x * 512) {
    int l = i / (9 * 6144), o = i % 6144;
    float s = p->b_mod[l * 6144 + o];
#pragma unroll
    for (int kc = 0; kc < 8; ++kc) s += mp[(size_t)kc * 2 * 9 * 6144 + i];
    mo[i] = s;
  }
}
DEVI void phaseA2(KP p) {
  const int gw = BIDX * NW + (TIDX >> 6), nw = gridDim.x * NW;
  u16* H = wsp<u16>(p, OFF_H);
  const int per = (NTOK + nw - 1) / nw;
  const int t0 = gw * per, t1 = min(t0 + per, NTOK);
  int cur = -1; ModVec mv;
  for (int tok0 = t0; tok0 < t1; tok0 += 2) {
    float xv[2][16];
#pragma unroll
    for (int r = 0; r < 2; ++r) { const int tok = tok0 + r; if (tok < t1) load_row16(xrow_in(p, 0, tok / TPB, tok % TPB), xv[r]); }
#pragma unroll
    for (int r = 0; r < 2; ++r) {
      const int tok = tok0 + r;
      if (tok < t1) {
        const int mrow = (tok % TPB) < NCTX ? 8 : tok / TPB;
        if (mrow != cur) { load_modvec(p, 0, 0, mrow, mv); cur = mrow; }
        float hv[16]; modulate_row_store2<true, false>(mv, xv[r], nullptr, hv, h8base(p) + (size_t)tok * 1024);
        u16* xb = (u16*)p->out + (size_t)tok * 1024 + (TIDX & 63) * 4;
#pragma unroll
        for (int i = 0; i < 4; ++i) *(u32x2*)(xb + i * 256) = u32x2{pk2(xv[r][i * 4], xv[r][i * 4 + 1]), pk2(xv[r][i * 4 + 2], xv[r][i * 4 + 3])}; }
    }
  }
}
DEVI void phaseG2(KP p, int l, ldsp_t lds) {
  constexpr int HS = 1026;
  const int tid = TIDX, lane = tid & 63, wave = __builtin_amdgcn_readfirstlane(tid >> 6);
  const int r32 = lane & 31, kh = lane >> 5, qd = lane >> 4;
  u16* H = wsp<u16>(p, OFF_H2);
  const float* WRT = wsp<float>(p, OFF_WRT) + (size_t)l * 36 * 1024;
  int* cnt = wsp<int>(p, OFF_CNT);
  int* list = wsp<int>(p, OFF_LIST);
  float* wlist = wsp<float>(p, OFF_WLIST);
  LAS float* h2t = (LAS float*)lds;
  LAS float* part = (LAS float*)lds;
  LAS int* gsel = (LAS int*)(lds + 32 * HS * 4);
  LAS float* gwt = (LAS float*)(lds + 32 * HS * 4 + 128);
  LAS int* lcnt = (LAS int*)(lds + 32 * HS * 4 + 256);
  LAS int* gbase = lcnt + 32;
  LAS int* tinfo = lcnt + 64;
  if (tid < 32) lcnt[tid] = 0;
  int nloc = 0;
  float wreg[64];
  {
    const float* wr = p->w_router + (size_t)l * 1024 * 32 + r32;
#pragma unroll
    for (int t = 0; t < 32; ++t) {
      const int k = 128 * wave + 4 * t + 2 * kh;
      wreg[2 * t] = wr[(size_t)k * 32]; wreg[2 * t + 1] = wr[(size_t)(k + 1) * 32];
    }
  }
  int* tctr = wsp<int>(p, OFF_DEP) + DEP_TILECTR + l * DEP_STRIDE;
  LAS int* tnext = lcnt + 64 + 512 * 6;
  const int ntile = (l == 1) ? 8 * SEQ / 32 : NTOK / 32;
  if (tid == 0) *tnext = atomicAdd(tctr, 1);
  __syncthreads();
  for (;;) {
    const int tix = *tnext;
    if (tix >= ntile) break;
    int tclaim = 0;
    if (tid == 0) tclaim = atomicAdd(tctr, 1);
    const int tile = (l == 1) ? (tix >> 7) * 136 + 8 + (tix & 127) : tix;
    const int tok0 = tile * 32, b = tok0 / TPB, rr0 = tok0 % TPB;
    if (wave == 0) {
      const int* dep = wsp<int>(p, OFF_DEP) + (l * 136 + (tok0 >> 8)) * DEP_STRIDE;
      while (__hip_atomic_load(dep, __ATOMIC_RELAXED, __HIP_MEMORY_SCOPE_AGENT) < 32) __builtin_amdgcn_s_sleep(2);
      __builtin_amdgcn_fence(__ATOMIC_ACQUIRE, "agent");
      asm volatile("s_waitcnt vmcnt(0)" ::: "memory");
    }
    __syncthreads();
    {
      float hv[4][16], xv4[4][16];
#pragma unroll
      for (int r = 0; r < 4; ++r) load_row16_bf(wsp<u16>(p, OFF_XM) + (size_t)(tok0 + wave * 4 + r) * 1024, xv4[r]);
      ModVec mv; load_modvec(p, l, 1, (rr0 < NCTX) ? 8 : b, mv);
#pragma unroll
      for (int r = 0; r < 4; ++r) {
        modulate_row_store2<true, false>(mv, xv4[r], nullptr, hv[r], (unsigned char*)H + (size_t)(tok0 + wave * 4 + r) * 1024);
        LAS float* dst = h2t + (wave * 4 + r) * HS + lane * 4;
#pragma unroll
        for (int i = 0; i < 4; ++i) {
          *(LAS f32x2*)(dst + i * 256) = f32x2{hv[r][i * 4], hv[r][i * 4 + 1]};
          *(LAS f32x2*)(dst + i * 256 + 2) = f32x2{hv[r][i * 4 + 2], hv[r][i * 4 + 3]};
        }
      }
      float gl[4];
#pragma unroll
      for (int o = 0; o < 4; ++o) gl[o] = router_dot(hv, WRT + (size_t)o * 1024) + p->b_group[l * 4 + o];
      int gs = 0; float best = gl[0];
#pragma unroll
      for (int j = 1; j < 4; ++j) if (gl[j] > best) { best = gl[j]; gs = j; }
      float gsum = 0.f;
#pragma unroll
      for (int j = 0; j < 4; ++j) gsum += __expf(gl[j] - best);
      if ((lane & 15) == 0) { gsel[wave * 4 + qd] = gs; gwt[wave * 4 + qd] = 1.f / gsum; }
    }
    __syncthreads();
    f32x16 acc;
#pragma unroll
    for (int i = 0; i < 16; ++i) acc[i] = 0.f;
    {
      const LAS float* ap = h2t + r32 * HS + 128 * wave + 2 * kh;
#pragma unroll
      for (int t = 0; t < 32; ++t) {
        const f32x2 a = *(const LAS f32x2*)(ap + 4 * t);
        acc = __builtin_amdgcn_mfma_f32_32x32x2f32(a.x, wreg[2 * t], acc, 0, 0, 0);
        acc = __builtin_amdgcn_mfma_f32_32x32x2f32(a.y, wreg[2 * t + 1], acc, 0, 0, 0);
      }
    }
    __syncthreads();
#pragma unroll
    for (int i = 0; i < 16; ++i) part[(wave * 32 + (i & 3) + 8 * (i >> 2) + 4 * kh) * 33 + r32] = acc[i];
    __syncthreads();
    if (tid < 32) {
      const int gs = gsel[tid];
      const float gw_ = gwt[tid];
      float e8[8];
#pragma unroll
      for (int j = 0; j < 8; ++j) {
        float v = p->b_router[l * 32 + gs * 8 + j];
#pragma unroll
        for (int w = 0; w < 8; ++w) v += part[(w * 32 + tid) * 33 + gs * 8 + j];
        e8[j] = v;
      }
      int i0 = 0; float v0 = e8[0];
#pragma unroll
      for (int j = 1; j < 8; ++j) if (e8[j] > v0) { v0 = e8[j]; i0 = j; }
      int i1 = -1; float v1 = -INFINITY;
#pragma unroll
      for (int j = 0; j < 8; ++j) if (j != i0 && e8[j] > v1) { v1 = e8[j]; i1 = j; }
      const float ex = __expf(v1 - v0);
      const float w0 = gw_ / (1.f + ex), w1 = gw_ * ex / (1.f + ex);
      const int tok = tok0 + tid;
      const int ea = gs * 8 + i0, eb = gs * 8 + i1;
      const int ra = __hip_atomic_fetch_add(&lcnt[ea], 1, __ATOMIC_RELAXED, __HIP_MEMORY_SCOPE_WORKGROUP);
      const int rb = __hip_atomic_fetch_add(&lcnt[eb], 1, __ATOMIC_RELAXED, __HIP_MEMORY_SCOPE_WORKGROUP);
      LAS int* ti = tinfo + (nloc + tid) * 6;
      ti[0] = tok; ti[1] = ea | (eb << 8); ti[2] = ra; ti[3] = rb; ti[4] = __float_as_int(w0); ti[5] = __float_as_int(w1);
    }
    if (tid == 0) *tnext = tclaim;
    nloc += 32;
    __syncthreads();
    const bool last = *tnext >= ntile;
    if (last || nloc == 512) {
      if (tid < 32) { const int c = lcnt[tid]; gbase[tid] = c ? atomicAdd(&cnt[tid * CNT_STRIDE], c) : 0; }
      __syncthreads();
      for (int i = tid; i < nloc; i += 512) {
        const LAS int* ti = tinfo + i * 6;
        const int tok = ti[0], ea = ti[1] & 255, eb = ti[1] >> 8;
        const int sa = gbase[ea] + ti[2], sb = gbase[eb] + ti[3];
        list[(size_t)ea * NTOK + sa] = tok * 2; wlist[(size_t)ea * NTOK + sa] = __int_as_float(ti[4]);
        list[(size_t)eb * NTOK + sb] = tok * 2 + 1; wlist[(size_t)eb * NTOK + sb] = __int_as_float(ti[5]);
      }
      __syncthreads();
      if (tid < 32) lcnt[tid] = 0;
      nloc = 0;
      __syncthreads();
    }
  }
}
struct ExpInfo2 { int tiles[4], base[4], cnt[4]; };
DEVI ExpInfo2 exp_info2(KP p, int xcd) {
  const int* cnt = wsp<int>(p, OFF_CNT);
  ExpInfo2 ei;
  int before = 0;
#pragma unroll
  for (int e = 0; e < 32; ++e) {
    const int c = __builtin_amdgcn_readfirstlane(cnt[e * CNT_STRIDE]), t = (c + 255) >> 8;
    if ((e & 7) == xcd) { ei.tiles[e >> 3] = t; ei.base[e >> 3] = before; ei.cnt[e >> 3] = c; }
    before += t;
  }
  return ei;
}
template <int NN>
struct SchedX { ExpInfo2 ei; int xcd, lb, G8; const char* A; const char* W; const int* list; size_t wstride; int lda_b; int ldw_b;
  DEVI bool next(int i, Unit& u) const {
    const int tot = (ei.tiles[0] + ei.tiles[1] + ei.tiles[2] + ei.tiles[3]) * NN;
    const int n = i * G8 + lb; if (n >= tot) return false;
    int k = 0, m = n / NN; const int pn = n % NN;
    int tb = ei.base[0], ce = ei.cnt[0];
#pragma unroll
    for (int kk = 0; kk < 3; ++kk) { if (k == kk && m >= ei.tiles[kk]) { m -= ei.tiles[kk]; k = kk + 1; tb = ei.base[kk + 1]; ce = ei.cnt[kk + 1]; } }
    const int e = xcd + 8 * k;
    u.rows = list + (size_t)e * NTOK + m * 256; u.nvalid = ce - m * 256;
    u.A = A + (NN == 2 ? 0u : uoff((unsigned)(tb + m) * 256u * (unsigned)lda_b));
    u.B = W + uoff((unsigned)e * (unsigned)wstride + (unsigned)pn * 256u * (unsigned)ldw_b);
    u.u0 = (tb + m) * 256; u.u1 = pn; u.u2 = e; u.u3 = m; return true; } };
constexpr float U8_SCALE = 16.f;
struct EpiI1 { unsigned char* U;
  DEVI void init(f32x4 (&acc)[2][2][4][2], const Unit&, int, int, int, int) const { acc_zero(acc); }
  DEVI void operator()(const f32x4 (&acc)[2][2][4][2], const Unit& u, int wr, int wc, int fr, int fq) const {
#pragma unroll
    for (int ai = 0; ai < 2; ++ai)
#pragma unroll
      for (int m = 0; m < 4; ++m) {
        unsigned char* rowp = U + (size_t)(u.u0 + ai * HALF + wr * 64 + m * 16 + fr) * 256;
#pragma unroll
        for (int bj = 0; bj < 2; ++bj) {
          const int ff = 16 * (8 * u.u1 + 4 * bj + wc) + 4 * fq;
          const f32x4 g = acc[ai][bj][m][0] * (1.f / F8_WSCALE), up = acc[ai][bj][m][1] * (1.f / F8_WSCALE);
          float t[4];
#pragma unroll
          for (int j = 0; j < 4; ++j) t[j] = __builtin_amdgcn_fmed3f(g[j] / (1.f + __expf(-g[j])) * up[j] * U8_SCALE, -448.f, 448.f);
          int o = __builtin_amdgcn_cvt_pk_fp8_f32(t[0], t[1], 0, false);
          o = __builtin_amdgcn_cvt_pk_fp8_f32(t[2], t[3], o, true);
          *(int*)(rowp + ff) = o;
        }
      }
  }
};
DEVI void phaseI1_2(KP p, ldsp_t lds) {
  const int xcd = BIDX & 7, lb = BIDX >> 3, G8 = gridDim.x >> 3;
  if (lb >= G8) return;
  SchedX<2> S{exp_info2(p, xcd), xcd, lb, G8, (const char*)wsp<u16>(p, OFF_H2), (const char*)wsp<u16>(p, OFF_W13), wsp<int>(p, OFF_LIST), (size_t)512 * 1024, 1024, 1024};
  EpiI1 E{wsp<unsigned char>(p, OFF_U)};
  int nt = 8; asm volatile("" : "+s"(nt));
  gemm_phase<false, true, true>(lds, 1024, 1024, nt, S, E);
}
struct EpiI2 { u16* YS; const float* wlist; const int* list;
  DEVI void init(f32x4 (&acc)[2][2][4][2], const Unit&, int, int, int, int) const { acc_zero(acc); }
  DEVI void operator()(const f32x4 (&acc)[2][2][4][2], const Unit& u, int wr, int wc, int fr, int fq) const {
    const unsigned colb = (unsigned)(u.u1 * 256 + wc * 32 + 8 * fq) * 2u;
    const float* we = wlist + (u.rows - list);
    unsigned dest[2][4]; float w[2][4];
#pragma unroll
    for (int ai = 0; ai < 2; ++ai)
#pragma unroll
      for (int m = 0; m < 4; ++m) {
        const int r = ai * HALF + wr * 64 + m * 16 + fr;
        dest[ai][m] = (r < u.nvalid) ? (unsigned)u.rows[r] : (unsigned)(2 * NTOK);
        w[ai][m] = we[r] * (1.f / (U8_SCALE * F8_WSCALE));
      }
#pragma unroll
    for (int ai = 0; ai < 2; ++ai)
#pragma unroll
      for (int m = 0; m < 4; ++m) {
        char* rowp = (char*)YS + (dest[ai][m] * 2048u + colb);
#pragma unroll
        for (int bj = 0; bj < 2; ++bj) {
          const f32x4 v0 = acc[ai][bj][m][0] * w[ai][m], v1 = acc[ai][bj][m][1] * w[ai][m];
          u32x4 o; o.x = pk2(v0[0], v0[1]); o.y = pk2(v0[2], v0[3]); o.z = pk2(v1[0], v1[1]); o.w = pk2(v1[2], v1[3]);
          *(u32x4*)(rowp + bj * 256) = o;
        }
      }
  }
};
DEVI void phaseI2_2(KP p, ldsp_t lds) {
  const int xcd = BIDX & 7, lb = BIDX >> 3, G8 = gridDim.x >> 3;
  if (lb >= G8) return;
  SchedX<4> S{exp_info2(p, xcd), xcd, lb, G8, (const char*)wsp<u16>(p, OFF_U), (const char*)wsp<u16>(p, OFF_W2), wsp<int>(p, OFF_LIST), (size_t)1024 * 256, 256, 256};
  EpiI2 E{wsp<u16>(p, OFF_YS), wsp<float>(p, OFF_WLIST), wsp<int>(p, OFF_LIST)};
  int nt = 2; asm volatile("" : "+s"(nt));
  gemm_phase<true, false, true>(lds, 256, 256, nt, S, E);
}
DEVI void phaseJ2(KP p, int l, ldsp_t lds) {
  const int lane = TIDX & 63;
  const int gw = BIDX * NW + (TIDX >> 6), nw = gridDim.x * NW;
  const u16* YS = wsp<u16>(p, OFF_YS);
  u16* H = wsp<u16>(p, OFF_H);
  const int ntot = (l == 1) ? 8 * SEQ : NTOK;
  const int per = (ntot + nw - 1) / nw;
  const int i0 = gw * per, i1 = min(i0 + per, ntot);
  int cur = -1; ModVec mv; f32x4 gtv[4];
  for (int ii = i0; ii < i1; ii += 2) {
    float xv[2][16]; u32x2 y0[2][4], y1[2][4]; bool ok[2]; int tk[2];
#pragma unroll
    for (int r = 0; r < 2; ++r) {
      const int idx = ii + r;
      const int tok = (l == 1) ? (idx / SEQ) * TPB + NCTX + idx % SEQ : idx;
      tk[r] = tok;
      ok[r] = idx < i1;
      if (ok[r]) {
        load_row16_bf(wsp<u16>(p, OFF_XM) + (size_t)tok * 1024, xv[r]);
#pragma unroll
        for (int i = 0; i < 4; ++i) {
          const int c = i * 256 + lane * 4;
          y0[r][i] = *(const u32x2*)(YS + (size_t)(tok * 2) * 1024 + c);
          y1[r][i] = *(const u32x2*)(YS + (size_t)(tok * 2 + 1) * 1024 + c);
        }
      }
    }
#pragma unroll
    for (int r = 0; r < 2; ++r) {
      if (!ok[r]) continue;
      const int tok = tk[r];
      const int b = tok / TPB, rr = tok % TPB;
      const int mrow = (rr < NCTX) ? 8 : b;
      if (mrow != cur) {
        cur = mrow;
        const float* gt = wsp<float>(p, OFF_MOD) + ((size_t)l * 9 + mrow) * 6144 + 5120;
#pragma unroll
        for (int i = 0; i < 4; ++i) gtv[i] = *(const f32x4*)(gt + i * 256 + lane * 4);
        if (l == 0) load_modvec(p, 1, 0, mrow, mv);
      }
#pragma unroll
      for (int i = 0; i < 4; ++i) {
        const f32x4 g = gtv[i];
        xv[r][i * 4 + 0] += g.x * (bf2f((u16)(y0[r][i].x & 0xffff)) + bf2f((u16)(y1[r][i].x & 0xffff)));
        xv[r][i * 4 + 1] += g.y * (bf2f((u16)(y0[r][i].x >> 16)) + bf2f((u16)(y1[r][i].x >> 16)));
        xv[r][i * 4 + 2] += g.z * (bf2f((u16)(y0[r][i].y & 0xffff)) + bf2f((u16)(y1[r][i].y & 0xffff)));
        xv[r][i * 4 + 3] += g.w * (bf2f((u16)(y0[r][i].y >> 16)) + bf2f((u16)(y1[r][i].y >> 16)));
      }
      if (l == 0) {
        u16* xr = (u16*)p->out + (size_t)tok * 1024;
#pragma unroll
        for (int i = 0; i < 4; ++i)
          *(u32x2*)(xr + i * 256 + lane * 4) = u32x2{pk2(xv[r][i * 4], xv[r][i * 4 + 1]), pk2(xv[r][i * 4 + 2], xv[r][i * 4 + 3])};
        float hv[16];
        modulate_row_store2<true, false>(mv, xv[r], nullptr, hv, h8base(p) + (size_t)tok * 1024);
      } else {
        float ss = 0.f;
#pragma unroll
        for (int i = 0; i < 16; ++i) ss += xv[r][i] * xv[r][i];
        ss = wave_sum(ss);
        const float rstd = rsqrtf(ss * (1.f / 1024.f) + EPS);
        float* xr = p->out + ((size_t)b * SEQ + rr - NCTX) * 1024;
#pragma unroll
        for (int i = 0; i < 4; ++i) {
          const int c = i * 256 + lane * 4;
          const f32x4 g = *(const f32x4*)(p->g_final + c);
          *(f32x4*)(xr + c) = f32x4{xv[r][i * 4] * rstd * g.x, xv[r][i * 4 + 1] * rstd * g.y, xv[r][i * 4 + 2] * rstd * g.z, xv[r][i * 4 + 3] * rstd * g.w};
        }
      }
    }
  }
}

constexpr int N_PHASES = 3 + 2 * 11;
__global__ void __launch_bounds__(512, 2) fwd_v2(Params parg) {
  extern __shared__ __attribute__((aligned(16))) unsigned char dyn_lds[];
  const ldsp_t lds = (ldsp_t)dyn_lds;
  cg::grid_group grid = cg::this_grid();
  volatile LAS unsigned* xb_st = (volatile LAS unsigned*)(lds + LDS_BARW);
  if (TIDX < 4) xb_st[TIDX] = 0u;
  __syncthreads();
  if (parg.ph_end - parg.ph_begin > 1) xcd_barrier_post((unsigned*)(parg.ws + OFF_BAR));
  for (int ph = parg.ph_begin; ph < parg.ph_end; ++ph) {
    KP p = (KP)__builtin_amdgcn_kernarg_segment_ptr();
    asm volatile("" : "+s"(p));
    const int l = (ph >= 14) ? 1 : 0;
    const int k = (ph < 3) ? ph : 3 + (ph - 3) % 11;
    const int reps = (((PROBE_DUP >> k) & 1) && (!(PROBE_DUP & 0x10000) || l == 0)) ? 2 : 1;
    for (int rep = 0; rep < reps; ++rep) {
      if (rep) {
        xcd_barrier((unsigned*)(p->ws + OFF_BAR), xb_st);
        if (k == 10) { if (BIDX == 0 && TIDX < 32) wsp<int>(p, OFF_CNT)[TIDX * CNT_STRIDE] = 0; xcd_barrier((unsigned*)(p->ws + OFF_BAR), xb_st); }
      }
      switch (k) {
        case 0: phase0_2(p, lds); break;
        case 1: phase1_2(p); break;
        case 2: phaseA2(p); break;
        case 3: phaseB2(p, lds); break;
        case 4: phaseC2(p, lds); break;
        case 5: phaseP2(p, l, lds); break;
        case 6: phaseD2(p, l, lds); break;
        case 7: phaseE1(p, l, lds); break;
        case 8: phaseE2(p, l, lds); break;
        case 9: phaseF2(p, l, lds); break;
        case 10: phaseG2(p, l, lds); break;
        case 11: phaseI1_2(p, lds); break;
        case 12: phaseI2_2(p, lds); break;
        default: phaseJ2(p, l, lds); break;
      }
    }
    if (k == 0 || (k == 13 && l == 0)) conv_items2(p, k == 0 ? 0 : 1, lds, 0, CONV_EARLY);
    if (ph + 1 < parg.ph_end && k != 9) {
      if (parg.ph_begin >= 1000) grid.sync();
      else xcd_barrier((unsigned*)(p->ws + OFF_BAR), xb_st);
    }
  }
}
}

extern "C" void kernel_launch(void* const* d_in, const int* in_sizes, int n_in, void* d_out, int out_size,
                              void* d_ws, size_t ws_size, hipStream_t stream) {
  static int grid2 = 0;
  if (!grid2) {
    int dev = 0, cus = 0, per_cu = 0;
    (void)hipGetDevice(&dev);
    (void)hipDeviceGetAttribute(&cus, hipDeviceAttributeMultiprocessorCount, dev);
    (void)hipFuncSetAttribute((const void*)v2::fwd_v2, hipFuncAttributeMaxDynamicSharedMemorySize, v2::LDS_TOTAL);
    (void)hipOccupancyMaxActiveBlocksPerMultiprocessor(&per_cu, v2::fwd_v2, 512, v2::LDS_TOTAL);
    if (per_cu < 1) { fprintf(stderr, "kernel does not fit on a CU\n"); per_cu = 1; }
    grid2 = cus & ~7;
  }
  if (ws_size < WS_NEEDED) { fprintf(stderr, "workspace too small: %zu < %zu\n", ws_size, (size_t)WS_NEEDED); return; }
  Params hp{};
  const float** f = (const float**)&hp;
  for (int i = 0; i < 29; ++i) f[i] = (const float*)d_in[i];
  hp.out = (float*)d_out;
  hp.ws = (char*)d_ws;
#if N_LAUNCH_MODE == 1
  for (int ph = 0; ph < v2::N_PHASES; ++ph) {
    hp.ph_begin = ph; hp.ph_end = ph + 1;
    void* args[] = {&hp};
    hipError_t e = hipLaunchCooperativeKernel((void*)v2::fwd_v2, dim3(grid2), dim3(512), args, v2::LDS_TOTAL, stream);
    if (e != hipSuccess) fprintf(stderr, "launch failed: %s\n", hipGetErrorString(e));
  }
#else
  hp.ph_begin = 0; hp.ph_end = v2::N_PHASES;
  (void)hipMemsetAsync((char*)d_ws + OFF_BAR, 0, (size_t)(OFF_DEP - OFF_BAR) + (size_t)DEP_WORDS * 4, stream);
  void* args[] = {&hp};
  hipError_t e = hipLaunchCooperativeKernel((void*)v2::fwd_v2, dim3(grid2), dim3(512), args, v2::LDS_TOTAL, stream);
  if (e != hipSuccess) fprintf(stderr, "cooperative launch failed: %s (grid %d)\n", hipGetErrorString(e), grid2);
#endif
}
```

```cpp
#include <hip/hip_runtime.h>
#include <hip/hip_cooperative_groups.h>
#include <stdint.h>
#include <stdio.h>
namespace cg = cooperative_groups;

#ifndef N_LAUNCH_MODE
#define N_LAUNCH_MODE 0
#endif

#ifndef PROBE_DUP
#define PROBE_DUP 0
#endif
#define DEVI __device__ __forceinline__
typedef unsigned short u16;
typedef __attribute__((ext_vector_type(2))) float f32x2;
typedef __attribute__((ext_vector_type(2))) __bf16 bf16x2_t;
typedef __attribute__((ext_vector_type(8))) short bf16x8;
typedef __attribute__((ext_vector_type(16))) float f32x16;
typedef __attribute__((ext_vector_type(4))) unsigned u32x4;
typedef __attribute__((ext_vector_type(2))) unsigned u32x2;
typedef __attribute__((ext_vector_type(4))) float f32x4;
#define MFMA(a, b, c) __builtin_amdgcn_mfma_f32_32x32x16_bf16((a), (b), (c), 0, 0, 0)

constexpr int DMODEL = 1024, NBATCH = 8, SEQ = 4096, NCTX = 256;
constexpr int TPB = SEQ + NCTX;
constexpr int NTOK = NBATCH * TPB;
constexpr int MT_PER_B = TPB / 128;
constexpr int NEXP = 32;
constexpr int INP = 2304;
constexpr float EPS = 1e-6f;
constexpr float LOG2E = 1.4426950408889634f;
constexpr int SMEM_BYTES = 73728;
constexpr int UROWS = 2 * NTOK + NEXP * 256;

constexpr size_t al(size_t x) { return (x + 255) & ~(size_t)255; }
constexpr size_t OFF_WIN = 0;
constexpr size_t OFF_WQB = OFF_WIN + al((size_t)INP * 1024 * 2);
constexpr size_t OFF_WKVB = OFF_WQB + al((size_t)512 * 256 * 2);
constexpr size_t OFF_WGATE = OFF_WKVB + al((size_t)512 * 256 * 2);
constexpr size_t OFF_WBR = OFF_WGATE + al((size_t)4 * 1024 * 1024 * 2);
constexpr size_t OFF_WOUT = OFF_WBR + al((size_t)4 * 1024 * 256 * 2);
constexpr size_t OFF_W13 = OFF_WOUT + al((size_t)1024 * 1024 * 2);
constexpr size_t OFF_W2 = OFF_W13 + al((size_t)32 * 512 * 1024 * 2);
constexpr size_t OFF_MODP = OFF_W2 + al((size_t)32 * 1024 * 256 * 2);
constexpr size_t OFF_MOD = OFF_MODP + al((size_t)8 * 2 * 9 * 6144 * 4);
constexpr size_t OFF_CS32 = OFF_MOD + al((size_t)2 * 9 * 6144 * 4);
constexpr size_t OFF_CS16 = OFF_CS32 + al((size_t)64 * 16 * 2 * 4);
constexpr size_t OFF_WRT = OFF_CS16 + al((size_t)64 * 8 * 2 * 4);
constexpr size_t OFF_CNT = OFF_WRT + al((size_t)2 * 36 * 1024 * 4);
constexpr int CNT_STRIDE = 64;
constexpr size_t OFF_BAR = OFF_CNT + al(32 * CNT_STRIDE * 4);
constexpr int XCD_BAR_WORDS = 3456;
constexpr size_t OFF_CTXRES = OFF_BAR + al((size_t)XCD_BAR_WORDS * 4);
constexpr size_t OFF_DEP = OFF_CTXRES;
constexpr int DEP_STRIDE = 16, DEP_TILECTR = 2 * 136 * DEP_STRIDE, DEP_WORDS = DEP_TILECTR + 2 * DEP_STRIDE;
constexpr size_t OFF_H = OFF_CTXRES + al((size_t)8 * 256 * 1024 * 4);
constexpr size_t OFF_O = OFF_H + al((size_t)NTOK * 1024 * 2);
constexpr size_t OFF_SSQ = OFF_O + al((size_t)NTOK * 1024 * 2);
constexpr size_t OFF_LIST = OFF_SSQ + al((size_t)NTOK * 8 * 4);
constexpr size_t OFF_WLIST = OFF_LIST + al((size_t)32 * NTOK * 4);
constexpr size_t OFF_R1 = OFF_WLIST + al((size_t)32 * NTOK * 4);
constexpr int PLD = INP;
constexpr size_t OFF_PRAW = OFF_R1;
constexpr size_t OFF_QARAW = OFF_PRAW + (size_t)NTOK * INP * 2;
constexpr size_t OFF_KVARAW = OFF_QARAW + (size_t)NTOK * 512 * 2;
constexpr size_t OFF_VAT = OFF_KVARAW + (size_t)NTOK * 512 * 2;
constexpr size_t OFF_VBT = OFF_VAT + (size_t)NTOK * 256 * 2;
constexpr size_t OFF_VCT = OFF_VBT + (size_t)NTOK * 128 * 2;
constexpr size_t OFF_VDT = OFF_VCT + (size_t)NTOK * 256 * 2;
constexpr size_t OFF_END = OFF_VDT + (size_t)NTOK * 128 * 2;
constexpr size_t OFF_Z = OFF_R1;
constexpr size_t OFF_Y8 = OFF_H;
constexpr size_t OFF_H2 = OFF_O;
constexpr size_t OFF_YPRE = OFF_O;
constexpr size_t OFF_U = OFF_R1;
constexpr size_t OFF_YS = OFF_R1 + al((size_t)UROWS * 256 * 2);
constexpr size_t OFF_XM = OFF_YS + al((size_t)(2 * NTOK + 1) * 1024 * 2);
static_assert(OFF_XM + (size_t)NTOK * 1024 * 2 <= OFF_END, "alias overflow");
static_assert(OFF_Z + (size_t)NTOK * 4096 * 2 <= OFF_END, "alias overflow");
static_assert(OFF_YS + (size_t)(2 * NTOK + 1) * 1024 * 2 <= OFF_END, "alias overflow");
constexpr size_t WS_NEEDED = OFF_END;
static_assert(WS_NEEDED <= (size_t)536870912, "workspace budget (4 x largest tensor)");

struct Params {
  const float *x, *c, *ctx, *c_ctx, *w_mod, *b_mod, *g_norm_mix, *w_in, *g_q_a, *w_q_b, *g_kv_a, *w_kv_b,
      *sink_b, *rpb_c, *g_q_d, *g_k_d, *w_gate, *b_gate, *w_branch, *w_out, *g_norm_ffn, *w_group, *b_group,
      *w_router, *b_router, *w_ff1, *w_ff3, *w_ff2, *g_final;
  float* out;
  char* ws;
  int ph_begin, ph_end;
};

DEVI int tid_fresh() { int t; asm volatile("v_mov_b32 %0, %1" : "=v"(t) : "v"(__builtin_amdgcn_workitem_id_x())); return t; }
DEVI int bid_fresh() { int t; asm volatile("s_mov_b32 %0, %1" : "=s"(t) : "s"(__builtin_amdgcn_workgroup_id_x())); return t; }
#define TIDX tid_fresh()
#define BIDX bid_fresh()
typedef const __attribute__((address_space(4))) Params* KP;
DEVI unsigned pk2(float a, float b) { f32x2 v = {a, b}; bf16x2_t r = __builtin_convertvector(v, bf16x2_t); return __builtin_bit_cast(unsigned, r); }
DEVI u16 f2bf(float a) { return (u16)(pk2(a, 0.f) & 0xffffu); }
DEVI float bf2f(u16 v) { return __uint_as_float(((unsigned)v) << 16); }
DEVI float wave_sum(float v) {
#pragma unroll
  for (int m = 32; m >= 1; m >>= 1) v += __shfl_xor(v, m);
  return v;
}
template <class T> DEVI T* wsp(KP p, size_t off) { return (T*)(p->ws + off); }
DEVI const float* xrow_in(KP p, int l, int b, int rr) {
  if (l == 0) return (rr < NCTX) ? p->ctx + ((size_t)b * NCTX + rr) * 1024 : p->x + ((size_t)b * SEQ + rr - NCTX) * 1024;
  return (rr < NCTX) ? wsp<float>(p, OFF_CTXRES) + ((size_t)b * NCTX + rr) * 1024 : p->out + ((size_t)b * SEQ + rr - NCTX) * 1024;
}
DEVI float* xrow_res(KP p, int b, int rr) {
  return (rr < NCTX) ? wsp<float>(p, OFF_CTXRES) + ((size_t)b * NCTX + rr) * 1024 : p->out + ((size_t)b * SEQ + rr - NCTX) * 1024;
}
DEVI int perm16(int k) { return (k & ~12) | ((k & 4) << 1) | ((k & 8) >> 1); }

struct ConvT { const float* src; const float* src2; const float* ks; u16* dst; int ld; int ldd; float mul; };
constexpr float Z8_SCALE = 16.f, O8_SCALE = 32.f;
constexpr float F8_WSCALE = 64.f, GATE_WSCALE = F8_WSCALE;
constexpr int CONV_ITEMS = 1152 + 64 + 64 + 2048 + 512 + 512 + 8192 + 4096;
DEVI ConvT conv_decode(KP p, int l, int idx) {
  ConvT c; c.ks = nullptr; c.mul = 1.f; c.src2 = nullptr;
  if (idx < 1152) {
    int nt = idx >> 4, kt = idx & 15, n0 = nt * 32;
    int sc = (n0 < 416) ? n0 : ((n0 < 512) ? -1 : n0 - 96);
    c.ld = 2208; c.ldd = -1024;
    c.mul = F8_WSCALE;
    if ((n0 >= 512 && n0 < 768) || (n0 >= 1024 && n0 < 1280)) c.mul = 0.125f * LOG2E * F8_WSCALE;
    c.src = (sc < 0) ? nullptr : p->w_in + (size_t)l * 1024 * 2208 + (size_t)kt * 64 * 2208 + sc;
    c.dst = (u16*)(p->ws + OFF_WIN + (size_t)n0 * 1024 + kt * 64);
    return c;
  }
  idx -= 1152;
  if (idx < 64) {
    int nt = idx >> 2, kt = idx & 3;
    c.ld = 384; c.ldd = 256; c.ks = p->g_q_a + l * 256 + kt * 64;
    c.src = (nt >= 12) ? nullptr : p->w_q_b + (size_t)l * 256 * 384 + (size_t)kt * 64 * 384 + nt * 32;
    c.dst = wsp<u16>(p, OFF_WQB) + (size_t)nt * 32 * 256 + kt * 64;
    return c;
  }
  idx -= 64;
  if (idx < 64) {
    int nt = idx >> 2, kt = idx & 3;
    c.ld = 512; c.ldd = 256; c.ks = (kt < 2) ? p->g_kv_a + l * 128 + kt * 64 : nullptr;
    c.src = (kt >= 2) ? nullptr : p->w_kv_b + (size_t)l * 128 * 512 + (size_t)kt * 64 * 512 + nt * 32;
    c.dst = wsp<u16>(p, OFF_WKVB) + (size_t)nt * 32 * 256 + kt * 64;
    return c;
  }
  idx -= 64;
  if (idx < 2048) {
    int nt = idx >> 4, kt = idx & 15, R0 = nt * 32;
    int pr = R0 >> 11, cb = (R0 & 2047) >> 8, bj = (R0 & 255) >> 7, j0 = R0 & 127;
    c.ld = 1024; c.ldd = -1024; c.mul = F8_WSCALE;
    c.src = p->w_gate + ((size_t)(l * 4 + 2 * pr + bj) * 1024 + kt * 64) * 1024 + cb * 128 + j0;
    c.dst = (u16*)(p->ws + OFF_WGATE + (size_t)R0 * 1024 + kt * 64);
    return c;
  }
  idx -= 2048;
  if (idx < 512) {
    int br = idx >> 7, nt = (idx >> 2) & 31, kt = idx & 3;
    c.ld = 1024; c.ldd = -256; c.mul = F8_WSCALE;
    c.src = p->w_branch + ((size_t)(l * 4 + br) * 256 + kt * 64) * 1024 + nt * 32;
    c.dst = (u16*)(p->ws + OFF_WBR + ((size_t)br * 1024 + nt * 32) * 256 + kt * 64);
    return c;
  }
  idx -= 512;
  if (idx < 512) {
    int nt = idx >> 4, kt = idx & 15;
    c.ld = 1024; c.ldd = -1024; c.mul = F8_WSCALE;
    c.src = p->w_out + ((size_t)l * 1024 + kt * 64) * 1024 + nt * 32;
    c.dst = (u16*)(p->ws + OFF_WOUT + (size_t)nt * 32 * 1024 + kt * 64);
    return c;
  }
  idx -= 512;
  if (idx < 8192) {
    int e = idx >> 8, g32 = (idx >> 4) & 15, kt = idx & 15;
    c.ld = 256; c.ldd = -1024; c.mul = F8_WSCALE;
    c.src = p->w_ff1 + ((size_t)(l * 32 + e) * 1024 + kt * 64) * 256 + g32 * 16;
    c.src2 = p->w_ff3 + ((size_t)(l * 32 + e) * 1024 + kt * 64) * 256 + g32 * 16;
    c.dst = (u16*)(p->ws + OFF_W13 + ((size_t)e * 512 + g32 * 32) * 1024 + kt * 64);
    return c;
  }
  idx -= 8192;
  {
    int e = idx >> 7, nt = (idx >> 2) & 31, kt = idx & 3;
    c.ld = 1024; c.ldd = -256; c.mul = F8_WSCALE;
    c.src = p->w_ff2 + ((size_t)(l * 32 + e) * 256 + kt * 64) * 1024 + nt * 32;
    c.dst = (u16*)(p->ws + OFF_W2 + ((size_t)e * 1024 + nt * 32) * 256 + kt * 64);
    return c;
  }
}
DEVI void modulate_row_store(KP p, int l, int which, const float (&xv)[16], int mrow, u16* hrow, float (&hv)[16]) {
  const int lane = TIDX & 63;
  float ss = 0.f;
#pragma unroll
  for (int i = 0; i < 16; ++i) ss += xv[i] * xv[i];
  ss = wave_sum(ss);
  const float rstd = rsqrtf(ss * (1.f / 1024.f) + EPS);
  const float* g = (which ? p->g_norm_ffn : p->g_norm_mix) + l * 1024;
  const float* mod = wsp<float>(p, OFF_MOD) + ((size_t)l * 9 + mrow) * 6144 + (which ? 3072 : 0);
#pragma unroll
  for (int i = 0; i < 4; ++i) {
    const int c = i * 256 + lane * 4;
    f32x4 gv = *(const f32x4*)(g + c);
    f32x4 sh = *(const f32x4*)(mod + c);
    f32x4 sc = *(const f32x4*)(mod + 1024 + c);
    hv[i * 4 + 0] = xv[i * 4 + 0] * rstd * gv.x * (1.f + sc.x) + sh.x;
    hv[i * 4 + 1] = xv[i * 4 + 1] * rstd * gv.y * (1.f + sc.y) + sh.y;
    hv[i * 4 + 2] = xv[i * 4 + 2] * rstd * gv.z * (1.f + sc.z) + sh.z;
    hv[i * 4 + 3] = xv[i * 4 + 3] * rstd * gv.w * (1.f + sc.w) + sh.w;
    u32x2 o; o.x = pk2(hv[i * 4 + 0], hv[i * 4 + 1]); o.y = pk2(hv[i * 4 + 2], hv[i * 4 + 3]);
    *(u32x2*)(hrow + c) = o;
  }
}
struct ModVec { f32x4 a[4], b[4]; };
DEVI void load_modvec(KP p, int l, int which, int mrow, ModVec& mv) {
  const int lane = TIDX & 63;
  const float* g = (which ? p->g_norm_ffn : p->g_norm_mix) + l * 1024;
  const float* mod = wsp<float>(p, OFF_MOD) + ((size_t)l * 9 + mrow) * 6144 + (which ? 3072 : 0);
#pragma unroll
  for (int i = 0; i < 4; ++i) {
    const int c = i * 256 + lane * 4;
    const f32x4 gv = *(const f32x4*)(g + c), sh = *(const f32x4*)(mod + c), sc = *(const f32x4*)(mod + 1024 + c);
    mv.a[i] = gv * (1.f + sc); mv.b[i] = sh;
  }
}
DEVI unsigned char* h8base(KP p) { return (unsigned char*)p->out + (size_t)NTOK * 2048; }
template <bool F8COPY = false, bool BF16 = true>
DEVI void modulate_row_store2(const ModVec& mv, const float (&xv)[16], u16* hrow, float (&hv)[16], unsigned char* h8row = nullptr) {
  const int lane = TIDX & 63;
  float ss = 0.f;
#pragma unroll
  for (int i = 0; i < 16; ++i) ss += xv[i] * xv[i];
  ss = wave_sum(ss);
  const float rstd = rsqrtf(ss * (1.f / 1024.f) + EPS);
#pragma unroll
  for (int i = 0; i < 4; ++i) {
    const int c = i * 256 + lane * 4;
#pragma unroll
    for (int j = 0; j < 4; ++j) hv[i * 4 + j] = xv[i * 4 + j] * rstd * mv.a[i][j] + mv.b[i][j];
    if (BF16) { u32x2 o; o.x = pk2(hv[i * 4 + 0], hv[i * 4 + 1]); o.y = pk2(hv[i * 4 + 2], hv[i * 4 + 3]);
      *(u32x2*)(hrow + c) = o; }
    if (F8COPY) {
      float q[4];
#pragma unroll
      for (int j = 0; j < 4; ++j) q[j] = __builtin_amdgcn_fmed3f(hv[i * 4 + j], -448.f, 448.f);
      int v = __builtin_amdgcn_cvt_pk_fp8_f32(q[0], q[1], 0, false);
      v = __builtin_amdgcn_cvt_pk_fp8_f32(q[2], q[3], v, true);
      *(int*)(h8row + c) = v;
    }
  }
}
DEVI void load_row16(const float* xr, float (&xv)[16]) {
  const int lane = TIDX & 63;
#pragma unroll
  for (int i = 0; i < 4; ++i) {
    f32x4 v = *(const f32x4*)(xr + i * 256 + lane * 4);
    xv[i * 4 + 0] = v.x; xv[i * 4 + 1] = v.y; xv[i * 4 + 2] = v.z; xv[i * 4 + 3] = v.w;
  }
}
DEVI void load_row16_bf(const u16* xr, float (&xv)[16]) {
  const int lane = TIDX & 63;
#pragma unroll
  for (int i = 0; i < 4; ++i) {
    const u32x2 v = *(const u32x2*)(xr + i * 256 + lane * 4);
    xv[i * 4 + 0] = __uint_as_float(v.x << 16); xv[i * 4 + 1] = __uint_as_float(v.x & 0xffff0000u);
    xv[i * 4 + 2] = __uint_as_float(v.y << 16); xv[i * 4 + 3] = __uint_as_float(v.y & 0xffff0000u);
  }
}
DEVI float router_dot(const float (&hv)[4][16], const float* wrow) {
  const int lane = TIDX & 63;
  const float* w = wrow + lane * 4;
  float pr[4] = {0.f, 0.f, 0.f, 0.f};
#pragma unroll
  for (int i = 0; i < 4; ++i) {
    const f32x4 wv = *(const f32x4*)(w + i * 256);
#pragma unroll
    for (int r = 0; r < 4; ++r)
      pr[r] += hv[r][i * 4] * wv.x + hv[r][i * 4 + 1] * wv.y + hv[r][i * 4 + 2] * wv.z + hv[r][i * 4 + 3] * wv.w;
  }
  const bool up = (lane & 32) != 0;
  float s0 = up ? pr[0] : pr[2], s1 = up ? pr[1] : pr[3];
  float k0 = up ? pr[2] : pr[0], k1 = up ? pr[3] : pr[1];
  k0 += __shfl_xor(s0, 32); k1 += __shfl_xor(s1, 32);
  const bool up2 = (lane & 16) != 0;
  float sv = up2 ? k0 : k1, kv = up2 ? k1 : k0;
  kv += __shfl_xor(sv, 16);
  kv += __shfl_xor(kv, 8); kv += __shfl_xor(kv, 4); kv += __shfl_xor(kv, 2); kv += __shfl_xor(kv, 1);
  return kv;
}
#define XB_TMO      128
#define XB_XCNT(j)  (256  + 64 * (j))
#define XB_XSUB(j)  (1280 + 64 * (j))
#define XB_XGEN(j)  (2304 + 64 * (j))
#define XB_TOP      3328
#define XB_TOPGEN   3392
#define XB_SPIN_CAP (1u << 20)
#define LAS __attribute__((address_space(3)))
DEVI unsigned xb_ld(unsigned* p) { return __hip_atomic_load(p, __ATOMIC_RELAXED, __HIP_MEMORY_SCOPE_AGENT); }
DEVI unsigned xb_add(unsigned* p, unsigned v) { return __hip_atomic_fetch_add(p, v, __ATOMIC_RELAXED, __HIP_MEMORY_SCOPE_AGENT); }
DEVI unsigned xb_xcc_id() { return (unsigned)__builtin_amdgcn_s_getreg((3 << 11) | 20) & 0xFu; }
#define XB_SPIN(cond, bar) do { unsigned _sp = 0; while (cond) { __builtin_amdgcn_s_sleep(1); \
    if ((++_sp & 255u) == 0u) { if (xb_ld(&(bar)[XB_TMO])) break; if (_sp > XB_SPIN_CAP) { atomicAdd(&(bar)[XB_TMO], 1u); break; } } } } while (0)
DEVI void xcd_barrier_post(unsigned* bar) {
  if (TIDX == 0) (void)xb_add(&bar[XB_XCNT(xb_xcc_id())], 1u);
}
DEVI void xcd_barrier_complete(unsigned* bar, unsigned x, unsigned& nloc, unsigned& nx) {
  const unsigned G = gridDim.x * gridDim.y * gridDim.z;
  unsigned sum, cnt, mine, sp = 0u;
  for (;;) {
    sum = 0u; cnt = 0u; mine = 0u;
#pragma unroll
    for (unsigned j = 0; j < 16; ++j) { const unsigned c = xb_ld(&bar[XB_XCNT(j)]); sum += c; cnt += (c > 0u) ? 1u : 0u; mine = (j == x) ? c : mine; }
    if (sum == G) break;
    __builtin_amdgcn_s_sleep(1);
    if ((++sp & 255u) == 0u) { if (xb_ld(&bar[XB_TMO])) break; if (sp > XB_SPIN_CAP) { atomicAdd(&bar[XB_TMO], 1u); break; } }
  }
  nloc = mine > 0u ? mine : 1u; nx = cnt > 0u ? cnt : 1u;
}
DEVI void xcd_barrier(unsigned* bar, volatile LAS unsigned* st) {
  asm volatile("s_waitcnt vmcnt(0)" ::: "memory");
  __syncthreads();
  if (TIDX == 0) {
    const unsigned x = xb_xcc_id();
    __builtin_amdgcn_s_waitcnt(0);
    unsigned nloc = st[0], nx = st[1];
    if (nloc == 0u) { xcd_barrier_complete(bar, x, nloc, nx); st[0] = nloc; st[1] = nx; }
    const unsigned old = xb_add(&bar[XB_XSUB(x)], 1u);
    const unsigned gen = old / nloc;
    if (old + 1u == (gen + 1u) * nloc) {
      __builtin_amdgcn_fence(__ATOMIC_RELEASE, "agent");
      asm volatile("s_waitcnt vmcnt(0)" ::: "memory");
      const unsigned og = xb_add(&bar[XB_TOP], 1u);
      const unsigned tg = og / nx;
      if (og + 1u == (tg + 1u) * nx) xb_add(&bar[XB_TOPGEN], 1u);
      else XB_SPIN(xb_ld(&bar[XB_TOPGEN]) == tg, bar);
      __builtin_amdgcn_fence(__ATOMIC_ACQUIRE, "agent");
      xb_add(&bar[XB_XGEN(x)], 1u);
      asm volatile("s_waitcnt vmcnt(0)" ::: "memory");
    } else {
      XB_SPIN(xb_ld(&bar[XB_XGEN(x)]) == gen, bar);
      __builtin_amdgcn_fence(__ATOMIC_ACQUIRE, "agent");
      asm volatile("s_waitcnt vmcnt(0)" ::: "memory");
    }
  }
  __syncthreads();
}

namespace v2 {
typedef LAS unsigned char* ldsp_t;
constexpr int BM = 256, BK = 64, HALF = 128, HTB = HALF * BK * 2, STAGE_BYTES = 8 * HTB;
constexpr int NW = 8;
constexpr int LDS_XTRA = STAGE_BYTES;
constexpr int LDS_BARW = STAGE_BYTES + 16384;
constexpr int LDS_TOTAL = LDS_BARW + 16;

DEVI int lds_byte(int r, int c) { const int st = (r >> 4) * 2 + (c >> 5), rr = r & 15, cc = c & 31, ob = rr * 64 + cc * 2; return st * 1024 + (ob ^ (((ob >> 9) & 1) << 5)); }
DEVI void stage_rc(int b, int& R, int& C) { const int st = b / 1024, sb = b % 1024, swz = sb ^ (((sb >> 9) & 1) << 5); R = (st >> 1) * 16 + swz / 64; C = (st & 1) * 32 + (swz % 64) / 2; }
DEVI int perm32(int rho) { const int n = rho >> 4, i = rho & 15; return 8 * (i >> 2) + 4 * n + (i & 3); }

DEVI void acc_zero(f32x4 (&acc)[2][2][4][2]) {
#pragma unroll
  for (int a = 0; a < 2; ++a)
#pragma unroll
    for (int b = 0; b < 2; ++b)
#pragma unroll
      for (int m = 0; m < 4; ++m)
#pragma unroll
        for (int n = 0; n < 2; ++n) acc[a][b][m][n] = (f32x4){0.f, 0.f, 0.f, 0.f};
}
struct Unit { const char* A; const char* B; const int* rows; int nvalid; int u0, u1, u2, u3; };

typedef int i32x8 __attribute__((ext_vector_type(8)));
typedef int i32x4v __attribute__((ext_vector_type(4)));
DEVI i32x8 cat8(bf16x8 lo, bf16x8 hi) { return __builtin_shufflevector(__builtin_bit_cast(i32x4v, lo), __builtin_bit_cast(i32x4v, hi), 0, 1, 2, 3, 4, 5, 6, 7); }
DEVI const char* sptr(const char* p) {
  const unsigned long long v = (unsigned long long)p;
  const unsigned lo = (unsigned)__builtin_amdgcn_readfirstlane((int)(unsigned)v), hi = (unsigned)__builtin_amdgcn_readfirstlane((int)(unsigned)(v >> 32));
  return (const char*)(((unsigned long long)hi << 32) | lo);
}
template <bool PERM, bool GATHER, bool F8, class Epi, class Sched>
DEVI void gemm_phase(ldsp_t lds, int lda_b, int ldb_b, int nt, const Sched& S, const Epi& E) {
  const int tid = TIDX, wid = __builtin_amdgcn_readfirstlane(tid >> 6), lane = tid & 63, wr = wid >> 2, wc = wid & 3, fr = lane & 15, fq = lane >> 4;
  unsigned voffA[2], voffB[2]; int RA[2], CA2[2];
#pragma unroll
  for (int i = 0; i < 2; ++i) {
    int R, C; stage_rc(tid * 16 + i * 8192, R, C);
    const int Rb = PERM ? ((R & ~31) + perm32(R & 31)) : R;
    RA[i] = R; CA2[i] = C * 2;
    voffA[i] = (unsigned)(R * lda_b + C * 2); voffB[i] = (unsigned)(Rb * ldb_b + C * 2);
  }
  const size_t kstep = (size_t)(BK * 2);
  const size_t hstepA = (size_t)HALF * lda_b, hstepB = (size_t)HALF * ldb_b;
  const unsigned ldsw = (unsigned)wid * 1024u, ldsbase = (unsigned)(size_t)lds;
  const int aoff = lds_byte(wr * 64 + fr, fq * 8), boff = lds_byte(wc * 32 + fr, fq * 8);
#define G_SA(b, h) (((b) * 2 + (h)) * HTB)
#define G_SB(b, h) ((4 + (b) * 2 + (h)) * HTB)
#define G_DMA(sbase, voff, ldsaddr) asm volatile("s_mov_b32 m0, %2\n\ts_nop 0\n\tglobal_load_lds_dwordx4 %0, %1" :: "v"(voff), "s"(sbase), "s"(ldsaddr) : "memory", "m0")
#define G_STAGE(bufoff, gbase, voff) do { const char* sb_ = sptr((const char*)(gbase)); _Pragma("unroll") for (int _i = 0; _i < 2; ++_i) \
    G_DMA(sb_, (voff)[_i], (unsigned)__builtin_amdgcn_readfirstlane((int)(ldsbase + (unsigned)(bufoff) + ldsw + (unsigned)_i * 8192u))); } while (0)
#define G_STAGE_A(bufoff, abase, go, h, koff) do { if (GATHER) { const char* sb_ = sptr((const char*)(abase) + (koff)); _Pragma("unroll") for (int _i = 0; _i < 2; ++_i) \
    G_DMA(sb_, (go)[h][_i], (unsigned)__builtin_amdgcn_readfirstlane((int)(ldsbase + (unsigned)(bufoff) + ldsw + (unsigned)_i * 8192u))); } \
    else G_STAGE(bufoff, (abase) + (h) * hstepA + (koff), voffA); } while (0)
#define G_LDA(dst, b, h) do { _Pragma("unroll") for (int m = 0; m < 4; ++m) { if (F8) dst##8[m] = cat8(*(const LAS bf16x8*)(lds + G_SA(b, h) + aoff + m * 2048), *(const LAS bf16x8*)(lds + G_SA(b, h) + aoff + m * 2048 + 1024)); \
    else { _Pragma("unroll") for (int k = 0; k < 2; ++k) dst[m][k] = *(const LAS bf16x8*)(lds + G_SA(b, h) + aoff + m * 2048 + k * 1024); } } } while (0)
#define G_LDB(dst, b, h) do { _Pragma("unroll") for (int n = 0; n < 2; ++n) { if (F8) dst##8[n] = cat8(*(const LAS bf16x8*)(lds + G_SB(b, h) + boff + n * 2048), *(const LAS bf16x8*)(lds + G_SB(b, h) + boff + n * 2048 + 1024)); \
    else { _Pragma("unroll") for (int k = 0; k < 2; ++k) dst[n][k] = *(const LAS bf16x8*)(lds + G_SB(b, h) + boff + n * 2048 + k * 1024); } } } while (0)
#define G_MMA(ai, bj, At, Bt) do { __builtin_amdgcn_s_setprio(1); _Pragma("unroll") for (int m = 0; m < 4; ++m) _Pragma("unroll") for (int n = 0; n < 2; ++n) { \
    if (F8) asm("v_mfma_scale_f32_16x16x128_f8f6f4 %0, %1, %2, %0, %3, %3 op_sel_hi:[0,0,0]" : "+v"(acc[ai][bj][m][n]) : "v"(Bt##8[n]), "v"(At##8[m]), "v"(f8scale)); \
    else { _Pragma("unroll") for (int k = 0; k < 2; ++k) acc[ai][bj][m][n] = __builtin_amdgcn_mfma_f32_16x16x32_bf16(Bt[n][k], At[m][k], acc[ai][bj][m][n], 0, 0, 0); } } \
    __builtin_amdgcn_s_setprio(0); } while (0)
#define G_WAIT_V(n) asm volatile("s_waitcnt vmcnt(" #n ")" ::: "memory")
#define G_WAIT_L(n) asm volatile("s_waitcnt lgkmcnt(" #n ")" ::: "memory")
#define G_BAR __builtin_amdgcn_s_barrier()
#define G_SCHED __builtin_amdgcn_sched_barrier(0)
  Unit cur, nxt; int ui = 0;
  if (!S.next(0, cur)) return;
  f32x4 acc[2][2][4][2];
  E.init(acc, cur, wr, wc, fr, fq);
  bf16x8 At[4][2], B0[2][2], B1[2][2];
  i32x8 At8[4], B08[2], B18[2];
  const int f8scale = 0x7f7f7f7f;
  unsigned gcur[2][2];
  auto gather_offs = [&](const Unit& u, unsigned (&go)[2][2]) {
#pragma unroll
    for (int h = 0; h < 2; ++h)
#pragma unroll
      for (int i = 0; i < 2; ++i) {
        const int r = h * HALF + RA[i];
        const int t = (r < u.nvalid) ? (u.rows[r] >> 1) : 0;
        go[h][i] = (unsigned)t * (unsigned)lda_b + (unsigned)CA2[i];
      }
  };
  if (GATHER) gather_offs(cur, gcur);
  const char* cA = cur.A; const char* cB = cur.B;
  G_STAGE(G_SB(0, 0), cB, voffB); G_STAGE_A(G_SA(0, 0), cA, gcur, 0, 0); G_STAGE(G_SB(0, 1), cB + hstepB, voffB); G_STAGE_A(G_SA(0, 1), cA, gcur, 1, 0);
  if (wr == 1) G_BAR;
  G_WAIT_V(4); G_BAR;
  G_STAGE(G_SB(1, 0), cB + kstep, voffB); G_STAGE_A(G_SA(1, 0), cA, gcur, 0, kstep); G_STAGE(G_SB(1, 1), cB + hstepB + kstep, voffB);
  G_WAIT_V(6); G_BAR;
  for (;;) {
    const bool has_next = S.next(ui + 1, nxt);
    const char* nA = has_next ? nxt.A : cA; const char* nB = has_next ? nxt.B : cB;
#pragma clang loop unroll(disable)
    for (int t = 0; t < nt; t += 2) {
      const bool last = (t == nt - 2);
      const size_t k1 = (size_t)(t + 1) * kstep;
      const char* a2 = last ? nA : cA; const char* b2 = last ? nB : cB + (size_t)(t + 2) * kstep;
      const size_t ka2 = last ? 0 : (size_t)(t + 2) * kstep;
      const char* b3 = b2 + kstep; const size_t ka3 = ka2 + kstep;
      unsigned gN[2][2];
      if (GATHER && last) {
        if (has_next) gather_offs(nxt, gN);
        else {
#pragma unroll
          for (int h = 0; h < 2; ++h)
#pragma unroll
            for (int i = 0; i < 2; ++i) gN[h][i] = gcur[h][i];
        }
      }
#define G_STAGE_A2(bufoff, h, koff) do { if (GATHER) { if (last) G_STAGE_A(bufoff, cA, gN, h, (koff) - ka2); else G_STAGE_A(bufoff, cA, gcur, h, koff); } \
        else G_STAGE_A(bufoff, a2, gcur, h, koff); } while (0)
      G_LDB(B0, 0, 0); G_SCHED; G_LDA(At, 0, 0); G_STAGE_A(G_SA(1, 1), cA, gcur, 1, k1);
      G_WAIT_L(8); G_BAR; G_WAIT_L(0); G_MMA(0, 0, At, B0); G_BAR; G_SCHED;
      G_LDB(B1, 0, 1); G_STAGE(G_SB(0, 0), b2, voffB);
      G_BAR; G_WAIT_L(0); G_MMA(0, 1, At, B1); G_BAR;
      G_LDA(At, 0, 1); G_STAGE_A2(G_SA(0, 0), 0, ka2);
      G_BAR; G_WAIT_L(0); G_MMA(1, 0, At, B0); G_BAR; G_SCHED;
      G_STAGE(G_SB(0, 1), b2 + hstepB, voffB);
      G_WAIT_V(6); G_BAR; G_MMA(1, 1, At, B1); G_BAR;
      G_LDB(B0, 1, 0); G_SCHED; G_LDA(At, 1, 0); G_STAGE_A2(G_SA(0, 1), 1, ka2);
      G_WAIT_L(8); G_BAR; G_WAIT_L(0); G_MMA(0, 0, At, B0); G_BAR; G_SCHED;
      G_LDB(B1, 1, 1); G_STAGE(G_SB(1, 0), b3, voffB);
      G_BAR; G_WAIT_L(0); G_MMA(0, 1, At, B1); G_BAR;
      G_LDA(At, 1, 1); G_STAGE_A2(G_SA(1, 0), 0, ka3);
      G_BAR; G_WAIT_L(0); G_MMA(1, 0, At, B0); G_BAR; G_SCHED;
      G_STAGE(G_SB(1, 1), b3 + hstepB, voffB);
      G_WAIT_V(6); G_BAR; G_MMA(1, 1, At, B1); G_BAR;
      if (GATHER && last) {
#pragma unroll
        for (int h = 0; h < 2; ++h)
#pragma unroll
          for (int i = 0; i < 2; ++i) gcur[h][i] = gN[h][i];
      }
#undef G_STAGE_A2
    }
    G_SCHED;
    if (F8) {
      asm volatile("s_nop 15\n\ts_nop 15" ::: "memory");
#pragma unroll
      for (int a_ = 0; a_ < 2; ++a_)
#pragma unroll
        for (int b_ = 0; b_ < 2; ++b_)
#pragma unroll
          for (int m_ = 0; m_ < 4; ++m_)
#pragma unroll
            for (int n_ = 0; n_ < 2; ++n_) asm volatile("" : "+v"(acc[a_][b_][m_][n_]));
    }
    E(acc, cur, wr, wc, fr, fq);
    G_SCHED;
    if (!has_next) break;
    cur = nxt; cA = nA; cB = nB; ++ui;
    E.init(acc, cur, wr, wc, fr, fq);
  }
  G_WAIT_V(0);
  if (wr == 0) G_BAR;
  G_BAR;
#undef G_SA
#undef G_SB
#undef G_STAGE
#undef G_DMA
#undef G_STAGE_A
#undef G_LDA
#undef G_LDB
#undef G_MMA
#undef G_WAIT_V
#undef G_WAIT_L
#undef G_BAR
#undef G_SCHED
}

DEVI unsigned uoff(unsigned x) { return (unsigned)__builtin_amdgcn_readfirstlane((int)x); }
DEVI bool tile_order(int i, int G, int c, int nM, int nN, int& pm, int& pn) {
  const int nwg = nM * nN;
  const long L = (long)i * G + c; if (L >= nwg) return false;
  int wgid = (int)L; { const int q = nwg / 8, r = nwg % 8, xcd = wgid % 8, off = wgid / 8; wgid = (xcd < r ? xcd * (q + 1) : r * (q + 1) + (xcd - r) * q) + off; }
  const int WGM = 8;
  const int nig = WGM * nN, gid = wgid / nig, fm = gid * WGM, gsz = (nM - fm) < WGM ? (nM - fm) : WGM;
  pm = fm + ((wgid % nig) % gsz); pn = (wgid % nig) / gsz;
  pm = __builtin_amdgcn_readfirstlane(pm); pn = __builtin_amdgcn_readfirstlane(pn);
  return true;
}
struct EpiRawBf16 {
  u16* O; int ldc; float sc;
  DEVI void init(f32x4 (&acc)[2][2][4][2], const Unit&, int, int, int, int) const { acc_zero(acc); }
  DEVI void operator()(const f32x4 (&acc)[2][2][4][2], const Unit& u, int wr, int wc, int fr, int fq) const {
    const unsigned off0 = ((unsigned)(u.u0 + wr * 64 + fr) * (unsigned)ldc + (unsigned)(u.u1 + wc * 32 + 8 * fq)) * 2u;
#pragma unroll
    for (int ai = 0; ai < 2; ++ai)
#pragma unroll
      for (int m = 0; m < 4; ++m) {
        char* rowp = (char*)O + (off0 + (unsigned)(ai * HALF + m * 16) * (unsigned)ldc * 2u);
#pragma unroll
        for (int bj = 0; bj < 2; ++bj) {
          const f32x4 v0 = acc[ai][bj][m][0] * sc, v1 = acc[ai][bj][m][1] * sc;
          u32x4 w; w.x = pk2(v0[0], v0[1]); w.y = pk2(v0[2], v0[3]); w.z = pk2(v1[0], v1[1]); w.w = pk2(v1[2], v1[3]);
          *(u32x4*)(rowp + bj * HALF * 2) = w;
        }
      }
  }
};

struct EpiRawF8 {
  unsigned char* O; int ldc; float sc;
  DEVI void init(f32x4 (&acc)[2][2][4][2], const Unit&, int, int, int, int) const { acc_zero(acc); }
  DEVI void operator()(const f32x4 (&acc)[2][2][4][2], const Unit& u, int wr, int wc, int fr, int fq) const {
    const unsigned off0 = (unsigned)(u.u0 + wr * 64 + fr) * (unsigned)ldc + (unsigned)(u.u1 + wc * 32 + 8 * fq);
#pragma unroll
    for (int ai = 0; ai < 2; ++ai)
#pragma unroll
      for (int m = 0; m < 4; ++m) {
        unsigned char* rowp = O + (off0 + (unsigned)(ai * HALF + m * 16) * (unsigned)ldc);
#pragma unroll
        for (int bj = 0; bj < 2; ++bj) {
          u32x2 w;
#pragma unroll
          for (int n = 0; n < 2; ++n) {
            const f32x4 v = acc[ai][bj][m][n] * sc;
            int q = __builtin_amdgcn_cvt_pk_fp8_f32(__builtin_amdgcn_fmed3f(v[0], -448.f, 448.f), __builtin_amdgcn_fmed3f(v[1], -448.f, 448.f), 0, false);
            q = __builtin_amdgcn_cvt_pk_fp8_f32(__builtin_amdgcn_fmed3f(v[2], -448.f, 448.f), __builtin_amdgcn_fmed3f(v[3], -448.f, 448.f), q, true);
            w[n] = (unsigned)q;
          }
          *(u32x2*)(rowp + bj * HALF) = w;
        }
      }
  }
};
DEVI size_t z8_block(int pm, int branch, int cb) { return (size_t)((pm * 4 + branch) * 8 + cb) * 32768; }
struct EpiZ8 {
  unsigned char* O;
  DEVI void init(f32x4 (&acc)[2][2][4][2], const Unit&, int, int, int, int) const { acc_zero(acc); }
  DEVI void operator()(const f32x4 (&acc)[2][2][4][2], const Unit& u, int wr, int wc, int fr, int fq) const {
    const int pm = u.u0 >> 8, pn = u.u1 >> 8, n = pn >> 2, cq = pn & 3;
    const unsigned lw16 = (unsigned)((wr * 4 + wc) * 64 + fr + 16 * fq) * 16u;
#pragma unroll
    for (int bj = 0; bj < 2; ++bj) {
      unsigned char* blk = O + z8_block(pm, n, cq * 2 + bj) + lw16;
#pragma unroll
      for (int P = 0; P < 4; ++P) {
        u32x4 w;
#pragma unroll
        for (int h = 0; h < 2; ++h)
#pragma unroll
          for (int nn = 0; nn < 2; ++nn) {
            const int g = 2 * P + h;
            const f32x4 v = acc[g >> 2][bj][g & 3][nn] * (Z8_SCALE / (O8_SCALE * F8_WSCALE));
            int q = __builtin_amdgcn_cvt_pk_fp8_f32(__builtin_amdgcn_fmed3f(v[0], -448.f, 448.f), __builtin_amdgcn_fmed3f(v[1], -448.f, 448.f), 0, false);
            q = __builtin_amdgcn_cvt_pk_fp8_f32(__builtin_amdgcn_fmed3f(v[2], -448.f, 448.f), __builtin_amdgcn_fmed3f(v[3], -448.f, 448.f), q, true);
            w[2 * h + nn] = (unsigned)q;
          }
        *(u32x4*)(blk + P * 8192) = w;
      }
    }
  }
};
struct SchedB { const char* ws; const char* h8; int G, c;
  DEVI bool next(int i, Unit& u) const { int pm, pn; if (!tile_order(i, G, c, NTOK / 256, INP / 256, pm, pn)) return false;
    u.A = h8 + uoff((unsigned)pm * 256u * 1024u); u.B = ws + OFF_WIN + uoff((unsigned)pn * 256u * 1024u);        u.rows = nullptr; u.nvalid = 0; u.u0 = pm * 256; u.u1 = pn * 256; u.u2 = 0; u.u3 = 0; return true; } };
struct EpiB { u16* O; float* ssq;
  DEVI void init(f32x4 (&acc)[2][2][4][2], const Unit&, int, int, int, int) const { acc_zero(acc); }
  DEVI void operator()(const f32x4 (&acc)[2][2][4][2], const Unit& u, int wr, int wc, int fr, int fq) const {
    EpiRawBf16 E{O, PLD, 1.f / F8_WSCALE}; E(acc, u, wr, wc, fr, fq);
    if (u.u1 < 512) {
      const bool iskv = u.u1 != 0;
#pragma unroll
      for (int ai = 0; ai < 2; ++ai)
#pragma unroll
        for (int m = 0; m < 4; ++m) {
          float ss = 0.f;
#pragma unroll
          for (int bj = 0; bj < 2; ++bj)
#pragma unroll
            for (int n = 0; n < 2; ++n)
#pragma unroll
              for (int j = 0; j < 4; ++j) { const float v = acc[ai][bj][m][n][j] * (1.f / F8_WSCALE); if (!(iskv && bj == 1)) ss += v * v; }
          ss += __shfl_xor(ss, 16); ss += __shfl_xor(ss, 32);
          if (fq == 0) ssq[(size_t)(u.u0 + ai * HALF + wr * 64 + m * 16 + fr) * 8 + (iskv ? 4 : 0) + wc] = ss;
        }
    }
  }
};
DEVI void phaseB2(KP p, ldsp_t lds) {
  SchedB S{(const char*)p->ws, (const char*)h8base(p), (int)gridDim.x, BIDX};
  EpiB E{wsp<u16>(p, OFF_PRAW), wsp<float>(p, OFF_SSQ)};
  gemm_phase<true, false, true>(lds, 1024, 1024, 8, S, E);
}
struct SchedC { const char* ws; int G, c;
  DEVI bool next(int i, Unit& u) const { int pm, pn; if (!tile_order(i, G, c, NTOK / 256, 4, pm, pn)) return false;
    const bool kv = pn >= 2; const int pj = pn & 1;
    u.A = ws + OFF_PRAW + uoff((unsigned)pm * 256u * (unsigned)(PLD * 2) + (kv ? 512u : 0u)); u.B = ws + (kv ? OFF_WKVB : OFF_WQB) + uoff((unsigned)pj * 256u * 512u); u.rows = nullptr; u.nvalid = 0;
    u.u0 = pm * 256; u.u1 = pj * 256; u.u2 = kv; u.u3 = 0; return true; } };
struct EpiC { u16* Oq; u16* Okv; const float* ssq;
  DEVI void init(f32x4 (&acc)[2][2][4][2], const Unit&, int, int, int, int) const { acc_zero(acc); }
  DEVI void operator()(const f32x4 (&acc)[2][2][4][2], const Unit& u, int wr, int wc, int fr, int fq) const {
    const bool kv = u.u2 != 0;
    u16* O = kv ? Okv : Oq;
    const int row0 = u.u0 + wr * 64 + fr, col0 = u.u1 + wc * 32 + 8 * fq;
    f32x4 sq[2][4];
#pragma unroll
    for (int ai = 0; ai < 2; ++ai)
#pragma unroll
      for (int m = 0; m < 4; ++m) sq[ai][m] = *(const f32x4*)(ssq + (size_t)(row0 + ai * HALF + m * 16) * 8 + (kv ? 4 : 0));
#pragma unroll
    for (int ai = 0; ai < 2; ++ai)
#pragma unroll
      for (int m = 0; m < 4; ++m) {
        const size_t r = (size_t)(row0 + ai * HALF + m * 16);
        const float tot = sq[ai][m].x + sq[ai][m].y + sq[ai][m].z + sq[ai][m].w;
        const float sc = kv ? rsqrtf(tot * (1.f / 128.f) + EPS) : rsqrtf(tot * (1.f / 256.f) + EPS) * (0.10206207261596575f * LOG2E);
        u16* rowp = O + r * 512 + col0;
#pragma unroll
        for (int bj = 0; bj < 2; ++bj) {
          const f32x4 v0 = acc[ai][bj][m][0] * sc, v1 = acc[ai][bj][m][1] * sc;
          u32x4 w; w.x = pk2(v0[0], v0[1]); w.y = pk2(v0[2], v0[3]); w.z = pk2(v1[0], v1[1]); w.w = pk2(v1[2], v1[3]);
          *(u32x4*)(rowp + bj * HALF) = w;
        }
      }
  }
};
DEVI void phaseC2(KP p, ldsp_t lds) {
  SchedC S{(const char*)p->ws, (int)gridDim.x, BIDX};
  EpiC E{wsp<u16>(p, OFF_QARAW), wsp<u16>(p, OFF_KVARAW), wsp<float>(p, OFF_SSQ)};
  int nt = 4; asm volatile("" : "+s"(nt));
  gemm_phase<true, false, false>(lds, PLD * 2, 512, nt, S, E);
}

DEVI void ld16(const u16* src, float (&v)[16]) {
  const u32x4 a = *(const u32x4*)src, b = *(const u32x4*)(src + 8);
  const unsigned w[8] = {a.x, a.y, a.z, a.w, b.x, b.y, b.z, b.w};
#pragma unroll
  for (int i = 0; i < 8; ++i) { v[2 * i] = __uint_as_float(w[i] << 16); v[2 * i + 1] = __uint_as_float(w[i] & 0xffff0000u); }
}
DEVI void st16(u16* dst, const float (&v)[16]) {
  u32x4 a, b;
  a.x = pk2(v[0], v[1]); a.y = pk2(v[2], v[3]); a.z = pk2(v[4], v[5]); a.w = pk2(v[6], v[7]);
  b.x = pk2(v[8], v[9]); b.y = pk2(v[10], v[11]); b.z = pk2(v[12], v[13]); b.w = pk2(v[14], v[15]);
  *(u32x4*)dst = a; *(u32x4*)(dst + 8) = b;
}
DEVI void rope16c(float (&v)[16], const float* cs16, int pos) {
  const f32x2* t = (const f32x2*)(cs16 + pos * 16);
#pragma unroll
  for (int i = 0; i < 8; ++i) { const f32x2 cs = t[i]; const float x1 = v[i], x2 = v[8 + i]; v[i] = x1 * cs.x - x2 * cs.y; v[8 + i] = x2 * cs.x + x1 * cs.y; }
}
DEVI void rope32c(float (&lo)[16], float (&hi)[16], const float* cs32, int pos) {
  const f32x2* t = (const f32x2*)(cs32 + pos * 32);
#pragma unroll
  for (int i = 0; i < 16; ++i) { const f32x2 cs = t[i]; const float x1 = lo[i], x2 = hi[i]; lo[i] = x1 * cs.x - x2 * cs.y; hi[i] = x2 * cs.x + x1 * cs.y; }
}
DEVI float ssq16(const float (&v)[16]) { float s = 0.f;
#pragma unroll
  for (int i = 0; i < 16; ++i) s += v[i] * v[i];
  return s; }
DEVI void scale16(float (&v)[16], float s) {
#pragma unroll
  for (int i = 0; i < 16; ++i) v[i] *= s; }
DEVI void cvt16(const u32x4 a, const u32x4 b, float (&v)[16]) {
  const unsigned w[8] = {a.x, a.y, a.z, a.w, b.x, b.y, b.z, b.w};
#pragma unroll
  for (int i = 0; i < 8; ++i) { v[2 * i] = __uint_as_float(w[i] << 16); v[2 * i + 1] = __uint_as_float(w[i] & 0xffff0000u); }
}
DEVI void phaseP2(KP p, int l, ldsp_t lds) {
  const int tid = TIDX, tk = tid >> 3, pt = tid & 7;
  u16* PR = wsp<u16>(p, OFF_PRAW);
  u16* QA = wsp<u16>(p, OFF_QARAW);
  const float* cs32 = wsp<float>(p, OFF_CS32);
  const float* cs16 = wsp<float>(p, OFF_CS16);
  const float QS = 0.125f * LOG2E;
  for (int item = BIDX; item < NTOK / 64; item += gridDim.x) {
    const int tok0 = item * 64, rr0 = tok0 % TPB;
    const bool lat = rr0 >= NCTX;
    const size_t tok = (size_t)tok0 + tk;
    const int t = rr0 + tk - NCTX, grow = (t >> 6) & 63, gcol = t & 63;
    u16* pr = PR + tok * PLD;
    u16* qar = QA + tok * 512 + 96 * (pt >> 1) + 64 + 16 * (pt & 1);
    const int g4 = pt & 3;
    u32x4 r_qa[2], r_kr[2], r_qb[4], r_kb[4], r_qd[4], r_kd[4];
#define LD8(ptr) (*(const u32x4*)(ptr))
    if (lat) {
#pragma unroll
      for (int i = 0; i < 2; ++i) { r_qa[i] = LD8(qar + 8 * i); r_kr[i] = LD8(pr + 384 + 16 * (pt & 1) + 8 * i); }
#pragma unroll
      for (int i = 0; i < 4; ++i) { r_qb[i] = LD8(pr + 512 + 32 * pt + 8 * i); r_kb[i] = LD8(pr + 768 + 32 * g4 + 8 * i); }
    }
#pragma unroll
    for (int i = 0; i < 4; ++i) { r_qd[i] = LD8(pr + 1792 + 32 * pt + 8 * i); r_kd[i] = LD8(pr + 2048 + 32 * g4 + 8 * i); }
#undef LD8
    if (lat) {
      { float v[16]; cvt16(r_qa[0], r_qa[1], v); rope16c(v, cs16, (pt & 1) ? gcol : grow); st16(qar, v); }
      if (pt < 2) { float v[16]; cvt16(r_kr[0], r_kr[1], v); rope16c(v, cs16, pt == 0 ? grow : gcol); st16(pr + 384 + 16 * pt, v); }
      { float lo[16], hi[16]; cvt16(r_qb[0], r_qb[1], lo); cvt16(r_qb[2], r_qb[3], hi); rope32c(lo, hi, cs32, (pt & 1) ? gcol : grow); st16(pr + 512 + 32 * pt, lo); st16(pr + 512 + 32 * pt + 16, hi); }
      if (pt < 4) { float lo[16], hi[16]; cvt16(r_kb[0], r_kb[1], lo); cvt16(r_kb[2], r_kb[3], hi); rope32c(lo, hi, cs32, (pt & 1) ? gcol : grow); st16(pr + 768 + 32 * pt, lo); st16(pr + 768 + 32 * pt + 16, hi); }
    }
    {
      float lo[16], hi[16]; cvt16(r_qd[0], r_qd[1], lo); cvt16(r_qd[2], r_qd[3], hi);
      float ss = ssq16(lo) + ssq16(hi); ss += __shfl_xor(ss, 1);
      const float rs = rsqrtf(ss * (1.f / 64.f) + EPS);
      const float* g = p->g_q_d + l * 64 + 32 * (pt & 1);
#pragma unroll
      for (int i = 0; i < 16; ++i) { lo[i] *= rs * g[i]; hi[i] *= rs * g[16 + i]; }
      if (lat) rope32c(lo, hi, cs32, (pt & 1) ? gcol : grow);
      scale16(lo, QS); scale16(hi, QS);
      st16(pr + 1792 + 32 * pt, lo); st16(pr + 1792 + 32 * pt + 16, hi);
    }
    {
      float lo[16], hi[16]; cvt16(r_kd[0], r_kd[1], lo); cvt16(r_kd[2], r_kd[3], hi);
      float ss = ssq16(lo) + ssq16(hi); ss += __shfl_xor(ss, 1);
      const float rs = rsqrtf(ss * (1.f / 64.f) + EPS);
      const float* g = p->g_k_d + l * 64 + 32 * (g4 & 1);
#pragma unroll
      for (int i = 0; i < 16; ++i) { lo[i] *= rs * g[i]; hi[i] *= rs * g[16 + i]; }
      if (lat) rope32c(lo, hi, cs32, (g4 & 1) ? gcol : grow);
      if (pt < 4) { st16(pr + 2048 + 32 * g4, lo); st16(pr + 2048 + 32 * g4 + 16, hi); }
    }
  }
}

DEVI void conv_load(const ConvT& c, int lane, f32x4 (&v)[8]) {
  const int kk = lane >> 3, n4 = (lane & 7) * 4;
  const float* sp = (c.src2 && n4 >= 16) ? c.src2 + (n4 - 16) : (c.src ? c.src + n4 : nullptr);
#pragma unroll
  for (int i = 0; i < 8; ++i) v[i] = sp ? *(const f32x4*)(sp + (size_t)(kk + 8 * i) * c.ld) : f32x4{0.f, 0.f, 0.f, 0.f};
}
DEVI void conv_store(const ConvT& c, LAS float* t, int lane, const f32x4 (&v)[8]) {
  const int kk = lane >> 3, n4 = (lane & 7) * 4;
#pragma unroll
  for (int i = 0; i < 8; ++i) {
    const int k = kk + 8 * i;
    const float s = (c.ks ? c.ks[k] : 1.f) * c.mul;
    t[(n4 + 0) * 65 + k] = v[i].x * s; t[(n4 + 1) * 65 + k] = v[i].y * s;
    t[(n4 + 2) * 65 + k] = v[i].z * s; t[(n4 + 3) * 65 + k] = v[i].w * s;
  }
  asm volatile("s_waitcnt lgkmcnt(0)" ::: "memory");
  const int n = lane >> 1, k0 = (lane & 1) * 32;
  const LAS float* r = t + n * 65 + k0;
  if (c.ldd < 0) {
    unsigned char* d8 = (unsigned char*)c.dst + (size_t)n * (size_t)(-c.ldd) + k0;
#pragma unroll
    for (int q = 0; q < 2; ++q) {
      u32x4 o;
#pragma unroll
      for (int w = 0; w < 4; ++w) {
        float f[4];
#pragma unroll
        for (int j = 0; j < 4; ++j) f[j] = __builtin_amdgcn_fmed3f(r[16 * q + 4 * w + j], -448.f, 448.f);
        int v = __builtin_amdgcn_cvt_pk_fp8_f32(f[0], f[1], 0, false);
        v = __builtin_amdgcn_cvt_pk_fp8_f32(f[2], f[3], v, true);
        o[w] = (unsigned)v;
      }
      *(u32x4*)(d8 + 16 * q) = o;
    }
    asm volatile("s_waitcnt lgkmcnt(0)" ::: "memory");
    return;
  }
  u16* d = c.dst + (size_t)n * c.ldd + k0;
#pragma unroll
  for (int q = 0; q < 4; ++q) {
    u32x4 o;
    o.x = pk2(r[8 * q], r[8 * q + 1]); o.y = pk2(r[8 * q + 2], r[8 * q + 3]); o.z = pk2(r[8 * q + 4], r[8 * q + 5]); o.w = pk2(r[8 * q + 6], r[8 * q + 7]);
    *(u32x4*)(d + 8 * q) = o;
  }
  asm volatile("s_waitcnt lgkmcnt(0)" ::: "memory");
}
constexpr int CONV_EARLY = 1152 + 64 + 64;
DEVI void conv_items2(KP p, int l, ldsp_t lds, int first_item, int total_items) {
  const int tid = TIDX, wave = __builtin_amdgcn_readfirstlane(tid >> 6), lane = tid & 63;
  LAS float* t = (LAS float*)(lds + wave * 8448);
  __syncthreads();
  const int stride = gridDim.x * NW;
  int item = first_item + BIDX * NW + wave;
  if (item >= total_items) return;
  ConvT c = conv_decode(p, l, item);
  f32x4 v[8];
  conv_load(c, lane, v);
  for (;;) {
    const int nitem = item + stride;
    const bool more = nitem < total_items;
    ConvT cn = c; f32x4 vn[8];
    if (more) { cn = conv_decode(p, l, nitem); conv_load(cn, lane, vn); }
    conv_store(c, t, lane, v);
    if (!more) break;
    c = cn; item = nitem;
#pragma unroll
    for (int i = 0; i < 8; ++i) v[i] = vn[i];
  }
}
template <int BR>
DEVI void attn_mask(f32x16 (&s)[2], int kt, int qlat, int qrow, int qcol, int hh, LAS float* rpb) {
  if (BR == 1) {
#pragma unroll
    for (int kb = 0; kb < 2; ++kb)
#pragma unroll
      for (int i = 0; i < 16; ++i) {
        const int kpos = kt * 64 + kb * 32 + (i & 3) + 8 * (i >> 2) + 4 * hh;
        const int d = qlat - kpos;
        if (d > 128 || d < -128) s[kb][i] = -1e30f;
      }
  } else {
    const int rs = min(max(qrow - 4, 0), 56);
    const bool row_ok = (kt >= rs) && (kt < rs + 8);
    const int cst = min(max(qcol - 8, 0), 48);
    const int dr = kt - qrow + 7;
#pragma unroll
    for (int kb = 0; kb < 2; ++kb)
#pragma unroll
      for (int i = 0; i < 16; ++i) {
        const int kc = kb * 32 + (i & 3) + 8 * (i >> 2) + 4 * hh;
        const bool ok = row_ok && (kc >= cst) && (kc < cst + 16);
        const int idx = ok ? (dr * 31 + (kc - qcol + 15)) : 0;
        const float bias = rpb[idx];
        s[kb][i] = ok ? (s[kb][i] + bias) : -1e30f;
      }
  }
}

template <int BR>
DEVI void attn_mask1(f32x16& sb, int kb, int kt, int qlat, int qrow, int qcol, int hh, LAS float* rpb) {
  if (BR == 1) {
#pragma unroll
    for (int i = 0; i < 16; ++i) {
      const int kpos = kt * 64 + kb * 32 + (i & 3) + 8 * (i >> 2) + 4 * hh;
      const int d = qlat - kpos;
      if (d > 128 || d < -128) sb[i] = -1e30f;
    }
  } else {
    const int rs = min(max(qrow - 4, 0), 56);
    const bool row_ok = (kt >= rs) && (kt < rs + 8);
    const int cst = min(max(qcol - 8, 0), 48);
    const int dr = kt - qrow + 7;
#pragma unroll
    for (int i = 0; i < 16; ++i) {
      const int kc = kb * 32 + (i & 3) + 8 * (i >> 2) + 4 * hh;
      const bool ok = row_ok && (kc >= cst) && (kc < cst + 16);
      const int idx = ok ? (dr * 31 + (kc - qcol + 15)) : 0;
      const float bias = rpb[idx];
      sb[i] = ok ? (sb[i] + bias) : -1e30f;
    }
  }
}
#define FADD(a, b) do { (a) += (b); asm("" : "+v"(a)); } while (0)
typedef short v4i16_t __attribute__((ext_vector_type(4)));
DEVI bf16x8 vtr2(ldsp_t a) {
  const v4i16_t lo = __builtin_amdgcn_ds_read_tr16_b64_v4i16((LAS v4i16_t*)a);
  const v4i16_t hi = __builtin_amdgcn_ds_read_tr16_b64_v4i16((LAS v4i16_t*)(a + 8 * 144));
  return __builtin_shufflevector(lo, hi, 0, 1, 2, 3, 4, 5, 6, 7);
}
DEVI bf16x8 vtr2s(ldsp_t a, int o0, int o1) {
  const v4i16_t lo = __builtin_amdgcn_ds_read_tr16_b64_v4i16((LAS v4i16_t*)(a + o0));
  const v4i16_t hi = __builtin_amdgcn_ds_read_tr16_b64_v4i16((LAS v4i16_t*)(a + 8 * 128 + o1));
  return __builtin_shufflevector(lo, hi, 0, 1, 2, 3, 4, 5, 6, 7);
}
template <int BR, bool FAST>
DEVI bool attn_item2(KP p, int l, int b, int hs, int qb, bool isctx, ldsp_t lds) {
  constexpr bool MLA = (BR == 0);
  constexpr bool GQA = (BR == 1 || BR == 3);
  constexpr int QBLK = GQA ? 256 : 512;
  constexpr int NKS = MLA ? 6 : 4;
  constexpr int STG = 8192 + 8192 + 4096;
  const int tid = TIDX, lane = tid & 63, wave = __builtin_amdgcn_readfirstlane(tid >> 6);
  const int r32 = lane & 31, hh = lane >> 5;
  const int hq = GQA ? (hs * 2 + (wave & 1)) : hs;
  const int woff = GQA ? 64 * (wave >> 1) : 64 * wave;
  const int q0 = (isctx ? 0 : NCTX) + qb * QBLK;
  const bool active = !isctx || (woff < NCTX);
  const size_t tokq = (size_t)b * TPB + q0 + (active ? woff : 0) + r32;
  const u16* Qp; const u16* Kp; int ldk; const u16* Vp; int ldv; int obase; int ldq;
  const u16* PR = wsp<u16>(p, OFF_PRAW);
  if (BR == 0) { Qp = wsp<u16>(p, OFF_QARAW) + tokq * 512 + hq * 96; ldq = 512; Kp = wsp<u16>(p, OFF_KVARAW) + (size_t)b * TPB * 512 + hs * 128; ldk = 512; Vp = wsp<u16>(p, OFF_KVARAW) + (size_t)b * TPB * 512 + hs * 128 + 64; ldv = 512; obase = hq * 64; }
  else if (BR == 1) { Qp = PR + tokq * PLD + 512 + hq * 64; ldq = PLD; Kp = PR + (size_t)b * TPB * PLD + 768 + hs * 64; ldk = PLD; Vp = PR + (size_t)b * TPB * PLD + 896 + hs * 64; ldv = PLD; obase = 256 + hq * 64; }
  else if (BR == 2) { Qp = PR + tokq * PLD + 1024 + hq * 64; ldq = PLD; Kp = PR + (size_t)b * TPB * PLD + 1280 + hs * 64; ldk = PLD; Vp = PR + (size_t)b * TPB * PLD + 1536 + hs * 64; ldv = PLD; obase = 512 + hq * 64; }
  else { Qp = PR + tokq * PLD + 1792 + hq * 64; ldq = PLD; Kp = PR + (size_t)b * TPB * PLD + 2048 + hs * 64; ldk = PLD; Vp = PR + (size_t)b * TPB * PLD + 2176 + hs * 64; ldv = PLD; obase = 768 + hq * 64; }
  const u16* KRp = PR + (size_t)b * TPB * PLD + 384;
  int lat_lo = 0, lat_n = 0, wlo = 0, whi = 63;
  if (!isctx) {
    if (BR == 0 || BR == 3) { lat_lo = 0; lat_n = 64; }
    else if (BR == 1) {
      const int ql = qb * QBLK; const int lo = max(0, ql - 128) >> 6, hi = min(SEQ - 1, ql + QBLK - 1 + 128) >> 6; lat_lo = lo; lat_n = hi - lo + 1;
      const int wq = ql + woff; wlo = max(0, wq - 128) >> 6; whi = min(SEQ - 1, wq + 63 + 128) >> 6;
    } else {
      const int r0 = 8 * qb; const int lo = min(max(r0 - 4, 0), 56), hi = min(max(r0 + 7 - 4, 0), 56) + 7; lat_lo = lo; lat_n = hi - lo + 1;
      const int wr_ = r0 + wave; wlo = min(max(wr_ - 4, 0), 56); whi = wlo + 7;
    }
  }
  const int NT = 4 + lat_n;
  const int qlat0 = qb * QBLK + woff + r32;
  bf16x8 qf[2][NKS];
#pragma unroll
  for (int qi = 0; qi < 2; ++qi)
#pragma unroll
    for (int ks = 0; ks < NKS; ++ks) qf[qi][ks] = *(const bf16x8*)(Qp + (size_t)qi * 32 * ldq + ks * 16 + hh * 8);
  const int drow = 8 * wave + (lane >> 3), dch = (lane & 7) ^ ((drow >> 1) & 7);
  const int rrow = 16 * (wave & 3) + (lane >> 2), rch = (lane & 3) ^ ((rrow >> 2) & 3);
  auto keytile = [&](int j) { return (j < 4) ? j : (4 + lat_lo + (j - 4)); };
#define DMA16(sbase, voff, ldsaddr) asm volatile("s_mov_b32 m0, %2\n\ts_nop 0\n\tglobal_load_lds_dwordx4 %0, %1" :: "v"(voff), "s"(sbase), "s"(ldsaddr) : "memory", "m0")
#define A_DMA(j, st) do { const int key0_ = keytile(j) * 64; const unsigned base_ = __builtin_amdgcn_readfirstlane((unsigned)(size_t)(lds + (st) * STG) + wave * 1024); \
    DMA16(Kp, (unsigned)(((key0_ + drow) * ldk + dch * 8) * 2), base_); \
    DMA16(Vp, (unsigned)(((key0_ + drow) * ldv + dch * 8) * 2), base_ + 8192u); \
    if (MLA && wave < 4) DMA16(KRp, (unsigned)(((key0_ + rrow) * PLD + rch * 8) * 2), __builtin_amdgcn_readfirstlane(base_ + 16384u)); \
  } while (0)
  LAS float* rpb = (LAS float*)(lds + 2 * STG);
  __syncthreads();
  if (FAST && tid == 0) *(LAS int*)(lds + 2 * STG + 2048) = 0;
  A_DMA(0, 0);
  if (BR == 2 && !isctx) {
    const float* src = p->rpb_c + (size_t)(l * 4 + hs) * 465;
    for (int i = tid; i < 465; i += 512) rpb[i] = src[i] * LOG2E;
  }
  asm volatile("s_waitcnt vmcnt(0)" ::: "memory");
#pragma unroll
  for (int qi = 0; qi < 2; ++qi)
#pragma unroll
    for (int ks = 0; ks < NKS; ++ks) asm volatile("" : "+v"(qf[qi][ks]));
  __syncthreads();
  f32x16 o[2][2];
#pragma unroll
  for (int qi = 0; qi < 2; ++qi)
#pragma unroll
    for (int i = 0; i < 16; ++i) { o[qi][0][i] = 0.f; o[qi][1][i] = 0.f; }
  float m_run[2], l_run[2];
#pragma unroll
  for (int qi = 0; qi < 2; ++qi) { m_run[qi] = -INFINITY; l_run[qi] = 0.f; }
  if (BR == 1) { const float sk = p->sink_b[l * 4 + hq] * LOG2E; m_run[0] = sk; m_run[1] = sk; l_run[0] = (hh == 0) ? (FAST ? __builtin_amdgcn_exp2f(sk) : 1.f) : 0.f; l_run[1] = l_run[0]; }
  float l2[2][2];
#pragma unroll
  for (int qi = 0; qi < 2; ++qi) { l2[qi][0] = l_run[qi]; l2[qi][1] = 0.f; }
  const int kkey = (r32 >> 1) & 7, rkey = (r32 >> 2) & 3;
  const ldsp_t kfb = lds + r32 * 128;
  const ldsp_t krb = lds + 16384 + r32 * 64;
  const int vq = (lane & 15) >> 2, vkey = 2 * hh + (vq >> 1);
  const int vch = 2 * ((lane >> 4) & 1) + ((lane & 3) >> 1);
  const ldsp_t vfb = lds + 8192 + (4 * hh + vq) * 128 + 8 * (lane & 1);
#define SB() __builtin_amdgcn_sched_barrier(0)
#define KLOAD(kb, ks) (((ks) < 4) ? *(const LAS bf16x8*)(kfb + st + (kb) * 4096 + (((2 * (ks) + hh) ^ kkey) << 4)) : *(const LAS bf16x8*)(krb + st + (kb) * 2048 + (((2 * ((ks) - 4) + hh) ^ rkey) << 4)))
#define VLOAD(s4, db) vtr2s(vfb + st + (s4) * 2048, ((4 * (db) + vch) ^ vkey) << 4, ((4 * (db) + vch) ^ vkey ^ 4) << 4)
#define SM_EL(kb, e) do { const int qi_ = (e) >> 4, i_ = (e) & 15; \
    const float x_ = __builtin_amdgcn_exp2f(s[qi_][kb][i_]); s[qi_][kb][i_] = x_; FADD(l2[qi_][i_ & 1], x_); \
    if (i_ & 1) pw[kb][qi_][i_ >> 3][(i_ & 7) >> 1] = pk2(s[qi_][kb][i_ - 1], x_); } while (0)
#define F_STEP(j) do { \
    const int st = ((j) & 1) * STG; \
    if ((j) + 1 < NT) A_DMA((j) + 1, ((j) + 1) & 1); \
    const int kt_ = lat_lo + (j) - 4; \
    const bool need = active && ((j) < 4 || (kt_ >= wlo && kt_ <= whi)); \
    if (need) { \
      f32x16 s[2][2]; bf16x8 kf[NKS]; bf16x8 vf[4]; u32x4 pw[2][2][2]; \
      const f32x16 zero16 = {0.f, 0.f, 0.f, 0.f, 0.f, 0.f, 0.f, 0.f, 0.f, 0.f, 0.f, 0.f, 0.f, 0.f, 0.f, 0.f}; \
      const bool domask = (BR == 1 || BR == 2) && (j) >= 4; \
      _Pragma("unroll") for (int ks = 0; ks < NKS; ++ks) kf[ks] = KLOAD(0, ks); \
      _Pragma("unroll") for (int ks = 0; ks < NKS; ++ks) { \
        s[0][0] = MFMA(kf[ks], qf[0][ks], ks == 0 ? zero16 : s[0][0]); s[1][0] = MFMA(kf[ks], qf[1][ks], ks == 0 ? zero16 : s[1][0]); \
        SB(); kf[ks] = KLOAD(1, ks); SB(); } \
      if (domask) { _Pragma("unroll") for (int qi = 0; qi < 2; ++qi) { const int ql_ = qlat0 + 32 * qi; attn_mask1<BR>(s[qi][0], 0, kt_, ql_, ql_ >> 6, ql_ & 63, hh, rpb); } } \
      _Pragma("unroll") for (int m = 0; m < 2 * NKS; ++m) { \
        s[m & 1][1] = MFMA(kf[m >> 1], qf[m & 1][m >> 1], (m >> 1) == 0 ? zero16 : s[m & 1][1]); \
        if (m < 4) vf[m] = VLOAD(m >> 1, m & 1); \
        _Pragma("unroll") for (int e = (m * 32) / (2 * NKS); e < ((m + 1) * 32) / (2 * NKS); ++e) SM_EL(0, e); \
        SB(); } \
      if (domask) { _Pragma("unroll") for (int qi = 0; qi < 2; ++qi) { const int ql_ = qlat0 + 32 * qi; attn_mask1<BR>(s[qi][1], 1, kt_, ql_, ql_ >> 6, ql_ & 63, hh, rpb); } } \
      _Pragma("unroll") for (int m = 0; m < 8; ++m) { \
        o[m & 1][(m >> 1) & 1] = MFMA(vf[m >> 1], __builtin_bit_cast(bf16x8, pw[0][m & 1][m >> 2]), o[m & 1][(m >> 1) & 1]); \
        if (m & 1) { SB(); vf[m >> 1] = VLOAD(2 + (m >> 2), (m >> 1) & 1); } \
        _Pragma("unroll") for (int e = 4 * m; e < 4 * m + 4; ++e) SM_EL(1, e); \
        SB(); } \
      _Pragma("unroll") for (int m = 0; m < 8; ++m) \
        o[m & 1][(m >> 1) & 1] = MFMA(vf[m >> 1], __builtin_bit_cast(bf16x8, pw[1][m & 1][m >> 2]), o[m & 1][(m >> 1) & 1]); \
    } \
    asm volatile("s_waitcnt vmcnt(0)" ::: "memory"); \
    __syncthreads(); \
  } while (0)
#define A_STEP(j) do { \
    const int st = ((j) & 1) * STG; \
    if ((j) + 1 < NT) A_DMA((j) + 1, ((j) + 1) & 1); \
    const int kt_ = lat_lo + (j) - 4; \
    const bool need = active && ((j) < 4 || (kt_ >= wlo && kt_ <= whi)); \
    if (need) { \
      f32x16 s[2][2]; \
      _Pragma("unroll") for (int kb = 0; kb < 2; ++kb) { \
        _Pragma("unroll") for (int ks = 0; ks < 4; ++ks) { const bf16x8 kf = *(const LAS bf16x8*)(kfb + st + kb * 4096 + (((2 * ks + hh) ^ kkey) << 4)); \
          _Pragma("unroll") for (int qi = 0; qi < 2; ++qi) { if (ks == 0) { _Pragma("unroll") for (int i = 0; i < 16; ++i) s[qi][kb][i] = 0.f; } s[qi][kb] = MFMA(kf, qf[qi][ks], s[qi][kb]); } } \
        if (MLA) { _Pragma("unroll") for (int ks = 0; ks < 2; ++ks) { const bf16x8 kf = *(const LAS bf16x8*)(krb + st + kb * 2048 + (((2 * ks + hh) ^ rkey) << 4)); \
          _Pragma("unroll") for (int qi = 0; qi < 2; ++qi) s[qi][kb] = MFMA(kf, qf[qi][NKS - 2 + ks], s[qi][kb]); } } \
      } \
      if (FAST) __builtin_amdgcn_sched_barrier(0); \
      _Pragma("unroll") for (int qi = 0; qi < 2; ++qi) { \
        if ((BR == 1 || BR == 2) && (j) >= 4) { const int ql_ = qlat0 + 32 * qi; attn_mask<BR>(s[qi], kt_, ql_, ql_ >> 6, ql_ & 63, hh, rpb); } \
        if (FAST) { \
          float ls0 = 0.f, ls1 = 0.f; \
          _Pragma("unroll") for (int i = 0; i < 16; ++i) { \
            const float e0 = __builtin_amdgcn_exp2f(s[qi][0][i]), e1 = __builtin_amdgcn_exp2f(s[qi][1][i]); \
            s[qi][0][i] = e0; s[qi][1][i] = e1; FADD(ls0, e0); FADD(ls1, e1); } \
          l_run[qi] += ls0 + ls1; \
        } else { \
        float mx = s[qi][0][0]; \
        _Pragma("unroll") for (int i = 1; i < 16; ++i) mx = fmaxf(mx, s[qi][0][i]); \
        _Pragma("unroll") for (int i = 0; i < 16; ++i) mx = fmaxf(mx, s[qi][1][i]); \
        mx = fmaxf(mx, __shfl_xor(mx, 32)); \
        const float m_new = fmaxf(m_run[qi], mx); \
        const float alpha = __builtin_amdgcn_exp2f(m_run[qi] - m_new); \
        m_run[qi] = m_new; \
        float ls0 = 0.f, ls1 = 0.f; \
        _Pragma("unroll") for (int i = 0; i < 16; ++i) { \
          const float e0 = __builtin_amdgcn_exp2f(s[qi][0][i] - m_new), e1 = __builtin_amdgcn_exp2f(s[qi][1][i] - m_new); \
          s[qi][0][i] = e0; s[qi][1][i] = e1; ls0 += e0; ls1 += e1; } \
        l_run[qi] = l_run[qi] * alpha + (ls0 + ls1); \
        if (__any(alpha != 1.f)) { _Pragma("unroll") for (int i = 0; i < 16; ++i) { o[qi][0][i] *= alpha; o[qi][1][i] *= alpha; } } \
        } \
      } \
      _Pragma("unroll") for (int s4 = 0; s4 < 4; ++s4) { \
        const int kb = s4 >> 1, rb = (s4 & 1) * 8; \
        bf16x8 pf[2]; \
        _Pragma("unroll") for (int qi = 0; qi < 2; ++qi) { u32x4 pw; \
          pw.x = pk2(s[qi][kb][rb + 0], s[qi][kb][rb + 1]); pw.y = pk2(s[qi][kb][rb + 2], s[qi][kb][rb + 3]); \
          pw.z = pk2(s[qi][kb][rb + 4], s[qi][kb][rb + 5]); pw.w = pk2(s[qi][kb][rb + 6], s[qi][kb][rb + 7]); \
          pf[qi] = __builtin_bit_cast(bf16x8, pw); } \
        _Pragma("unroll") for (int db = 0; db < 2; ++db) { const bf16x8 vf = vtr2s(vfb + st + s4 * 2048, ((4 * db + vch) ^ vkey) << 4, ((4 * db + vch) ^ vkey ^ 4) << 4); \
          o[0][db] = MFMA(vf, pf[0], o[0][db]); o[1][db] = MFMA(vf, pf[1], o[1][db]); } \
      } \
    } \
    asm volatile("s_waitcnt vmcnt(0)" ::: "memory");        \
    __syncthreads(); \
  } while (0)
  if (FAST) {
    if (wave >= 4) __builtin_amdgcn_s_setprio(1);
    for (int j = 0; j < NT; j += 2) {
      F_STEP(j);
      if (j + 1 < NT) F_STEP(j + 1);
    }
    __builtin_amdgcn_s_setprio(0);
  } else {
    for (int j = 0; j < NT; j += 2) {
      A_STEP(j);
      if (j + 1 < NT) A_STEP(j + 1);
    }
  }
#undef F_STEP
#undef SM_EL
#undef A_STEP
#undef A_DMA
#undef DMA16
  bool bad = false;
  if (active) {
#pragma unroll
    for (int qi = 0; qi < 2; ++qi) {
      if (FAST) l_run[qi] = l2[qi][0] + l2[qi][1];
      const float lt = l_run[qi] + __shfl_xor(l_run[qi], 32);
      const float inv = 1.f / lt;
      if (FAST) bad = bad || !(lt > 1e-25f && lt < 1e25f);
      unsigned char* Op = wsp<unsigned char>(p, OFF_O) + (tokq + 32 * qi) * 1024 + obase;
#pragma unroll
      for (int db = 0; db < 2; ++db)
#pragma unroll
        for (int gp = 0; gp < 2; ++gp) {
          float q[8];
#pragma unroll
          for (int j = 0; j < 8; ++j) q[j] = __builtin_amdgcn_fmed3f(o[qi][db][8 * gp + j] * (inv * O8_SCALE), -448.f, 448.f);
          int wa = __builtin_amdgcn_cvt_pk_fp8_f32(q[0], q[1], 0, false); wa = __builtin_amdgcn_cvt_pk_fp8_f32(q[2], q[3], wa, true);
          int wb = __builtin_amdgcn_cvt_pk_fp8_f32(q[4], q[5], 0, false); wb = __builtin_amdgcn_cvt_pk_fp8_f32(q[6], q[7], wb, true);
          const u32x2 sx = __builtin_amdgcn_permlane32_swap((unsigned)wa, (unsigned)wb, false, false);
          *(u32x2*)(Op + db * 32 + 16 * gp + 8 * hh) = sx;
        }
    }
  }
  if (!FAST) return false;
  LAS int* flag = (LAS int*)(lds + 2 * STG + 2048);
  if (__any(bad) && lane == 0) *flag = 1;
  __syncthreads();
  return __builtin_amdgcn_readfirstlane(*flag) != 0;
}
template <bool FAST>
DEVI bool attn_dispatch(KP p, int l, int n, int xcd, ldsp_t lds) {
  int br, s, qb; bool isctx = false;
  if (n < 32) { br = 0; s = xcd + 8 * (n >> 3); qb = n & 7; }
  else if (n < 64) { const int m = n - 32; br = 3; s = xcd + 8 * (m >> 4); qb = m & 15; }
  else if (n < 96) { const int m = n - 64; br = 2; s = xcd + 8 * (m >> 3); qb = m & 7; }
  else if (n < 128) { const int m = n - 96; br = 1; s = xcd + 8 * (m >> 4); qb = m & 15; }
  else {
    const int m = n - 128; isctx = true; qb = 0;
    if (m < 4) { br = 0; s = xcd + 8 * m; }
    else if (m < 6) { br = 3; s = xcd + 8 * (m - 4); }
    else if (m < 10) { br = 2; s = xcd + 8 * (m - 6); }
    else { br = 1; s = xcd + 8 * (m - 10); }
  }
  if (br == 0) return attn_item2<0, FAST>(p, l, s >> 2, s & 3, qb, isctx, lds);
  else if (br == 1) return attn_item2<1, FAST>(p, l, s >> 1, s & 1, qb, isctx, lds);
  else if (br == 2) return attn_item2<2, FAST>(p, l, s >> 2, s & 3, qb, isctx, lds);
  else return attn_item2<3, FAST>(p, l, s >> 1, s & 1, qb, isctx, lds);
}
DEVI void phaseD2(KP p, int l, ldsp_t lds) {
  const int G8 = gridDim.x >> 3, xcd = BIDX & 7, lb = BIDX >> 3;
  if (lb >= G8) return;
  const int NLOC = 128 + (l == 0 ? 12 : 0);
  const int nmine = (NLOC - lb + G8 - 1) / G8;
  const int cslot = min((int)(BIDX & 3), nmine - 1);
  int it = 0; unsigned redo = 0;
  for (int n = lb; n < NLOC; n += G8, ++it) {
    if (it == cslot) conv_items2(p, l, lds, CONV_EARLY, CONV_ITEMS);
    if (attn_dispatch<true>(p, l, n, xcd, lds)) redo |= 1u << it;
  }
  if (redo) {
    it = 0;
    for (int n = lb; n < NLOC; n += G8, ++it)
      if ((redo >> it) & 1) attn_dispatch<false>(p, l, n, xcd, lds);
  }
}

DEVI int pm_map(int pme, bool skipctx) { return skipctx ? (pme >> 4) * 17 + 1 + (pme & 15) : pme; }
struct SchedE1 { const char* ws; bool skipctx; int G, c;
  DEVI bool next(int i, Unit& u) const { int pm, pn; if (!tile_order(i, G, c, skipctx ? 128 : 136, 16, pm, pn)) return false;
    pm = pm_map(pm, skipctx); const int n = pn >> 2, cq = pn & 3;
    u.A = ws + OFF_O + uoff((unsigned)pm * 256u * 1024u + (unsigned)n * 256u); u.B = ws + OFF_WBR + uoff(((unsigned)n * 1024u + (unsigned)cq * 256u) * 256u); u.rows = nullptr; u.nvalid = 0;
    u.u0 = pm * 256; u.u1 = pn * 256; u.u2 = 0; u.u3 = 0; return true; } };
DEVI void phaseE1(KP p, int l, ldsp_t lds) {
  if (BIDX == 0 && TIDX < 32) wsp<int>(p, OFF_CNT)[TIDX * CNT_STRIDE] = 0;
  SchedE1 S{(const char*)p->ws, l == 1, (int)gridDim.x, BIDX};
  EpiZ8 E{wsp<unsigned char>(p, OFF_Z)};
  gemm_phase<true, false, true>(lds, 1024, 256, 2, S, E);
}
struct SchedE2 { const char* ws; const char* h8; bool skipctx; int G, c;
  DEVI bool next(int i, Unit& u) const { int pm, pn; if (!tile_order(i >> 1, G, c, skipctx ? 128 : 136, 8, pm, pn)) return false;
    pm = pm_map(pm, skipctx); const int pr = i & 1;
    u.A = h8 + uoff((unsigned)pm * 256u * 1024u); u.B = ws + OFF_WGATE + uoff((unsigned)(pr * 8 + pn) * 256u * 1024u); u.rows = nullptr; u.nvalid = 0;
    u.u0 = pm * 256; u.u1 = pn * 128; u.u2 = pr; u.u3 = 0; return true; } };
constexpr float Y8_SCALE = 16.f;
struct EpiE2 { const unsigned char* Z; u16* Y; unsigned char* Y8; const float* bias;
  DEVI void init(f32x4 (&acc)[2][2][4][2], const Unit& u, int wr, int wc, int fr, int fq) const {
    const int col0 = u.u1 + wc * 32 + 8 * fq;
#pragma unroll
    for (int bj = 0; bj < 2; ++bj)
#pragma unroll
      for (int nn = 0; nn < 2; ++nn) {
        const f32x4 b = *(const f32x4*)(bias + (2 * u.u2 + bj) * 1024 + col0 + 4 * nn) * GATE_WSCALE;
#pragma unroll
        for (int a = 0; a < 2; ++a)
#pragma unroll
          for (int m = 0; m < 4; ++m) acc[a][bj][m][nn] = b;
      }
  }
  DEVI void operator()(const f32x4 (&acc)[2][2][4][2], const Unit& u, int wr, int wc, int fr, int fq) const {
    const int row0 = u.u0 + wr * 64 + fr, col0 = u.u1 + wc * 32 + 8 * fq, pr = u.u2;
    const unsigned lw16 = (unsigned)((wr * 4 + wc) * 64 + fr + 16 * fq) * 16u;
    const unsigned char* zb0 = Z + z8_block(u.u0 >> 8, 2 * pr, u.u1 >> 7) + lw16;
    char* yb = (char*)Y + (size_t)((u.u0 >> 8) * 8 + (u.u1 >> 7)) * 65536 + lw16;
    u32x4 zq[2][2], yq[2][2];
    auto ldpair = [&](int P, u32x4 (&z)[2], u32x4 (&y)[2]) {
#pragma unroll
      for (int bj = 0; bj < 2; ++bj) z[bj] = *(const u32x4*)(zb0 + (size_t)bj * 8 * 32768 + P * 8192);
#pragma unroll
      for (int h = 0; h < 2; ++h) y[h] = pr ? *(const u32x4*)(yb + (2 * P + h) * 8192) : u32x4{0u, 0u, 0u, 0u};
    };
    ldpair(0, zq[0], yq[0]);
#pragma unroll
    for (int P = 0; P < 4; ++P) {
      const int c = P & 1;
      if (P + 1 < 4) ldpair(P + 1, zq[c ^ 1], yq[c ^ 1]);
#pragma unroll
      for (int h = 0; h < 2; ++h) {
        const int g = 2 * P + h, ai = g >> 2, m = g & 3;
        const size_t r = (size_t)(row0 + ai * HALF + m * 16);
        float t[8];
        {
          const unsigned w[4] = {yq[c][h].x, yq[c][h].y, yq[c][h].z, yq[c][h].w};
#pragma unroll
          for (int i = 0; i < 4; ++i) { t[2 * i] = __uint_as_float(w[i] << 16); t[2 * i + 1] = __uint_as_float(w[i] & 0xffff0000u); }
        }
#pragma unroll
        for (int bj = 0; bj < 2; ++bj) {
#pragma unroll
          for (int nn = 0; nn < 2; ++nn) {
            const int zw = (int)zq[c][bj][2 * h + nn];
            const f32x2 zlo = __builtin_amdgcn_cvt_pk_f32_fp8(zw, false), zhi = __builtin_amdgcn_cvt_pk_f32_fp8(zw, true);
            const float zz4[4] = {zlo.x, zlo.y, zhi.x, zhi.y};
#pragma unroll
            for (int j = 0; j < 4; ++j) {
              const int e = 4 * nn + j;
              const float gte = __builtin_amdgcn_rcpf(1.f + __builtin_amdgcn_exp2f(acc[ai][bj][m][nn][j] * (-LOG2E / GATE_WSCALE)));
              t[e] += gte * (zz4[j] * (1.f / Z8_SCALE));
            }
          }
        }
        if (pr == 0) {
          u32x4 o; o.x = pk2(t[0], t[1]); o.y = pk2(t[2], t[3]); o.z = pk2(t[4], t[5]); o.w = pk2(t[6], t[7]);
          *(u32x4*)(yb + g * 8192) = o;
        } else {
          u32x2 o8;
#pragma unroll
          for (int w = 0; w < 2; ++w) {
            float q[4];
#pragma unroll
            for (int j = 0; j < 4; ++j) q[j] = __builtin_amdgcn_fmed3f(t[4 * w + j] * Y8_SCALE, -448.f, 448.f);
            int v = __builtin_amdgcn_cvt_pk_fp8_f32(q[0], q[1], 0, false);
            v = __builtin_amdgcn_cvt_pk_fp8_f32(q[2], q[3], v, true);
            o8[w] = (unsigned)v;
          }
          *(u32x2*)(Y8 + r * 1024 + col0) = o8;
        }
      }
    }
  }
};
DEVI void phaseE2(KP p, int l, ldsp_t lds) {
  SchedE2 S{(const char*)p->ws, (const char*)h8base(p), l == 1, (int)gridDim.x, BIDX};
  EpiE2 E{wsp<unsigned char>(p, OFF_Z), wsp<u16>(p, OFF_YPRE), wsp<unsigned char>(p, OFF_Y8), p->b_gate + (size_t)l * 4 * 1024};
  gemm_phase<true, false, true>(lds, 1024, 1024, 8, S, E);
}
struct SchedF { const char* ws; bool skipctx; int G, c;
  DEVI bool next(int i, Unit& u) const { int pm, pn;
    if (skipctx || G != 256) { if (!tile_order(i, G, c, skipctx ? 128 : 136, 4, pm, pn)) return false; }
    else if (i < 2) { if (!tile_order(i, G, c, 128, 4, pm, pn)) return false; }
    else { if (i > 2 || c >= 32) return false; pm = 128 + (c >> 2); pn = c & 3; }
    pm = pm_map(pm, skipctx);
    u.A = ws + OFF_Y8 + uoff((unsigned)pm * 256u * 1024u); u.B = ws + OFF_WOUT + uoff((unsigned)pn * 256u * 1024u); u.rows = nullptr; u.nvalid = 0;
    u.u0 = pm; u.u1 = pn * 256; u.u2 = 0; u.u3 = 0; return true; } };
struct EpiF { KP p; int l;
  DEVI void init(f32x4 (&acc)[2][2][4][2], const Unit&, int, int, int, int) const { acc_zero(acc); }
  DEVI void operator()(const f32x4 (&acc)[2][2][4][2], const Unit& u, int wr, int wc, int fr, int fq) const {
    const int pm = u.u0, b = pm / 17, rr0 = (pm % 17) * 256;
    const int mrow = (rr0 < NCTX) ? 8 : b;
    const int col0 = u.u1 + wc * 32 + 8 * fq;
    const float* gt = wsp<float>(p, OFF_MOD) + ((size_t)l * 9 + mrow) * 6144 + 2048 + col0;
    const u16* xinb = (const u16*)p->out + (size_t)(b * TPB + rr0) * 1024 + col0;
    const __amdgpu_buffer_rsrc_t xrs = __builtin_amdgcn_make_buffer_rsrc((void*)wsp<u16>(p, OFF_XM), 0, NTOK * 1024 * 2, 0x00020000);
    const unsigned xoff = (unsigned)((b * TPB + rr0) * 1024 + col0) * 2u;
    f32x4 gv[2][2];
#pragma unroll
    for (int bj = 0; bj < 2; ++bj)
#pragma unroll
      for (int n = 0; n < 2; ++n) gv[bj][n] = *(const f32x4*)(gt + bj * HALF + n * 4) * (1.f / (F8_WSCALE * Y8_SCALE));
#pragma unroll
    for (int ai = 0; ai < 2; ++ai)
#pragma unroll
      for (int mp = 0; mp < 2; ++mp) {
        u32x4 xo[2][2];
#pragma unroll
        for (int mm = 0; mm < 2; ++mm) {
          const size_t ro = (size_t)(wr * 64 + fr + ai * HALF + (2 * mp + mm) * 16) * 1024;
#pragma unroll
          for (int bj = 0; bj < 2; ++bj) xo[mm][bj] = *(const u32x4*)(xinb + ro + bj * HALF);
        }
#pragma unroll
        for (int mm = 0; mm < 2; ++mm) {
          const int m = 2 * mp + mm;
          const size_t ro = (size_t)(wr * 64 + fr + ai * HALF + m * 16) * 1024;
#pragma unroll
          for (int bj = 0; bj < 2; ++bj) {
            const u32x4 v = xo[mm][bj];
            const f32x4 x0 = f32x4{__uint_as_float(v.x << 16), __uint_as_float(v.x & 0xffff0000u), __uint_as_float(v.y << 16), __uint_as_float(v.y & 0xffff0000u)};
            const f32x4 x1 = f32x4{__uint_as_float(v.z << 16), __uint_as_float(v.z & 0xffff0000u), __uint_as_float(v.w << 16), __uint_as_float(v.w & 0xffff0000u)};
            const f32x4 r0 = x0 + gv[bj][0] * acc[ai][bj][m][0], r1 = x1 + gv[bj][1] * acc[ai][bj][m][1];
            __builtin_amdgcn_raw_buffer_store_b128(u32x4{pk2(r0.x, r0.y), pk2(r0.z, r0.w), pk2(r1.x, r1.y), pk2(r1.z, r1.w)}, xrs,
                                                   (int)(xoff + (unsigned)(ro + bj * HALF) * 2u), 0, 16);
          }
        }
      }
    asm volatile("s_waitcnt vmcnt(0)" ::: "memory");
    if ((TIDX & 63) == 0) __hip_atomic_fetch_add(wsp<int>(p, OFF_DEP) + (l * 136 + pm) * DEP_STRIDE, 1, __ATOMIC_RELAXED, __HIP_MEMORY_SCOPE_AGENT);
  }
};
DEVI void phaseF2(KP p, int l, ldsp_t lds) {
  SchedF S{(const char*)p->ws, l == 1, (int)gridDim.x, BIDX};
  EpiF E{p, l};
  gemm_phase<true, false, true>(lds, 1024, 1024, 8, S, E);
}


DEVI void phase0_2(KP p, ldsp_t lds) {
  const int tid = TIDX, half = tid >> 8, htid = tid & 255;
  for (int it = BIDX * 2; it < 458; it += gridDim.x * 2) {
    const int item = it + half;
    LAS float* sc = (LAS float*)(lds + half * 16384);
    const bool ismod = item < 384;
    const int l = item / 192, rem = item % 192, cgp = rem >> 3, kc = rem & 7;
    __syncthreads();
    if (ismod) {
      for (int i = htid; i < 9 * 128; i += 256) {
        int b = i >> 7, k = i & 127;
        float v = (b < 8) ? p->c[b * 1024 + kc * 128 + k] : p->c_ctx[kc * 128 + k];
        sc[i] = v / (1.f + __expf(-v));
      }
    }
    __syncthreads();
    if (ismod) {
      float acc[9];
#pragma unroll
      for (int b = 0; b < 9; ++b) acc[b] = 0.f;
      const float* w = p->w_mod + ((size_t)l * 1024 + kc * 128) * 6144 + cgp * 256 + htid;
#pragma unroll 32
      for (int k = 0; k < 128; ++k) {
        float wv = w[(size_t)k * 6144];
#pragma unroll
        for (int b = 0; b < 9; ++b) acc[b] += sc[b * 128 + k] * wv;
      }
      float* dst = wsp<float>(p, OFF_MODP) + (size_t)((kc * 2 + l) * 9) * 6144 + cgp * 256 + htid;
#pragma unroll
      for (int b = 0; b < 9; ++b) dst[(size_t)b * 6144] = acc[b];
    } else if (item == 384) {
      float* cs32 = wsp<float>(p, OFF_CS32);
      float* cs16 = wsp<float>(p, OFF_CS16);
      for (int t = htid; t < 1024; t += 256) {
        int pos = t >> 4, i = t & 15;
        float ang = (float)pos * __builtin_amdgcn_exp2f(-(float)(2 * i) * (13.287712379549449f / 32.f));
        cs32[t * 2] = __cosf(ang); cs32[t * 2 + 1] = __sinf(ang);
      }
      for (int t = htid; t < 512; t += 256) {
        int pos = t >> 3, i = t & 7;
        float ang = (float)pos * __builtin_amdgcn_exp2f(-(float)(2 * i) * (13.287712379549449f / 16.f));
        cs16[t * 2] = __cosf(ang); cs16[t * 2 + 1] = __sinf(ang);
      }
    } else if (item < 457) {
      const int q = item - 385, ll = q / 36, o = q % 36;
      float* dst = wsp<float>(p, OFF_WRT) + ((size_t)ll * 36 + o) * 1024;
      for (int k = htid; k < 1024; k += 256)
        dst[k] = (o < 4) ? p->w_group[((size_t)ll * 1024 + k) * 4 + o] : p->w_router[((size_t)ll * 1024 + k) * 32 + (o - 4)];
    }
  }
}
DEVI void phase1_2(KP p) {
  const float* mp = wsp<float>(p, OFF_MODP);
  float* mo = wsp<float>(p, OFF_MOD);
  for (int i = BIDX * 512 + TIDX; i < 2 * 9 * 6144; i += gridDim.x * 512) {
    int l = i / (9 * 6144), o = i % 6144;
    float s = p->b_mod[l * 6144 + o];
#pragma unroll
    for (int kc = 0; kc < 8; ++kc) s += mp[(size_t)kc * 2 * 9 * 6144 + i];
    mo[i] = s;
  }
}
DEVI void phaseA2(KP p) {
  const int gw = BIDX * NW + (TIDX >> 6), nw = gridDim.x * NW;
  u16* H = wsp<u16>(p, OFF_H);
  const int per = (NTOK + nw - 1) / nw;
  const int t0 = gw * per, t1 = min(t0 + per, NTOK);
  int cur = -1; ModVec mv;
  for (int tok0 = t0; tok0 < t1; tok0 += 2) {
    float xv[2][16];
#pragma unroll
    for (int r = 0; r < 2; ++r) { const int tok = tok0 + r; if (tok < t1) load_row16(xrow_in(p, 0, tok / TPB, tok % TPB), xv[r]); }
#pragma unroll
    for (int r = 0; r < 2; ++r) {
      const int tok = tok0 + r;
      if (tok < t1) {
        const int mrow = (tok % TPB) < NCTX ? 8 : tok / TPB;
        if (mrow != cur) { load_modvec(p, 0, 0, mrow, mv); cur = mrow; }
        float hv[16]; modulate_row_store2<true, false>(mv, xv[r], nullptr, hv, h8base(p) + (size_t)tok * 1024);
        u16* xb = (u16*)p->out + (size_t)tok * 1024 + (TIDX & 63) * 4;
#pragma unroll
        for (int i = 0; i < 4; ++i) *(u32x2*)(xb + i * 256) = u32x2{pk2(xv[r][i * 4], xv[r][i * 4 + 1]), pk2(xv[r][i * 4 + 2], xv[r][i * 4 + 3])}; }
    }
  }
}
DEVI void phaseG2(KP p, int l, ldsp_t lds) {
  constexpr int RP = 2064;
  constexpr int GX = 2 * 32 * RP;
  const int tid = TIDX, lane = tid & 63, wave = __builtin_amdgcn_readfirstlane(tid >> 6);
  const int r32 = lane & 31, kh = lane >> 5, qd = lane >> 4;
  u16* H = wsp<u16>(p, OFF_H2);
  const float* WRT = wsp<float>(p, OFF_WRT) + (size_t)l * 36 * 1024;
  int* cnt = wsp<int>(p, OFF_CNT);
  int* list = wsp<int>(p, OFF_LIST);
  float* wlist = wsp<float>(p, OFF_WLIST);
  const ldsp_t hiP = lds, loP = lds + 32 * RP;
  LAS float* part = (LAS float*)lds;
  LAS int* gsel = (LAS int*)(lds + GX);
  LAS float* gwt = (LAS float*)(lds + GX + 128);
  LAS int* lcnt = (LAS int*)(lds + GX + 256);
  LAS int* gbase = lcnt + 32;
  LAS int* tinfo = lcnt + 64;
  if (tid < 32) lcnt[tid] = 0;
  int nloc = 0;
  bf16x8 whi[8], wlo[8];
  {
    const float* wr = p->w_router + (size_t)l * 1024 * 32 + r32;
#pragma unroll
    for (int s8 = 0; s8 < 8; ++s8) {
      u32x4 h, lo4;
#pragma unroll
      for (int jj = 0; jj < 4; ++jj) {
        const int k = 128 * wave + 16 * s8 + 8 * kh + 2 * jj;
        const float a = wr[(size_t)k * 32], b2 = wr[(size_t)(k + 1) * 32];
        const unsigned hp = pk2(a, b2);
        h[jj] = hp; lo4[jj] = pk2(a - __uint_as_float(hp << 16), b2 - __uint_as_float(hp & 0xffff0000u));
      }
      whi[s8] = __builtin_bit_cast(bf16x8, h); wlo[s8] = __builtin_bit_cast(bf16x8, lo4);
    }
  }
  int* tctr = wsp<int>(p, OFF_DEP) + DEP_TILECTR + l * DEP_STRIDE;
  LAS int* tnext = lcnt + 64 + 512 * 6;
  const int ntile = (l == 1) ? 8 * SEQ / 32 : NTOK / 32;
  if (tid == 0) *tnext = atomicAdd(tctr, 1);
  __syncthreads();
  for (;;) {
    const int tix = *tnext;
    if (tix >= ntile) break;
    int tclaim = 0;
    if (tid == 0) tclaim = atomicAdd(tctr, 1);
    const int tile = (l == 1) ? (tix >> 7) * 136 + 8 + (tix & 127) : tix;
    const int tok0 = tile * 32, b = tok0 / TPB, rr0 = tok0 % TPB;
    if (wave == 0) {
      const int* dep = wsp<int>(p, OFF_DEP) + (l * 136 + (tok0 >> 8)) * DEP_STRIDE;
      while (__hip_atomic_load(dep, __ATOMIC_RELAXED, __HIP_MEMORY_SCOPE_AGENT) < 32) __builtin_amdgcn_s_sleep(2);
      __builtin_amdgcn_fence(__ATOMIC_ACQUIRE, "agent");
      asm volatile("s_waitcnt vmcnt(0)" ::: "memory");
    }
    __syncthreads();
    {
      float hv[4][16], xv4[4][16];
#pragma unroll
      for (int r = 0; r < 4; ++r) load_row16_bf(wsp<u16>(p, OFF_XM) + (size_t)(tok0 + wave * 4 + r) * 1024, xv4[r]);
      ModVec mv; load_modvec(p, l, 1, (rr0 < NCTX) ? 8 : b, mv);
#pragma unroll
      for (int r = 0; r < 4; ++r) {
        modulate_row_store2<true, false>(mv, xv4[r], nullptr, hv[r], (unsigned char*)H + (size_t)(tok0 + wave * 4 + r) * 1024);
        const int ro = (wave * 4 + r) * RP + lane * 8;
#pragma unroll
        for (int i = 0; i < 4; ++i) {
          const unsigned h01 = pk2(hv[r][i * 4], hv[r][i * 4 + 1]), h23 = pk2(hv[r][i * 4 + 2], hv[r][i * 4 + 3]);
          const unsigned l01 = pk2(hv[r][i * 4] - __uint_as_float(h01 << 16), hv[r][i * 4 + 1] - __uint_as_float(h01 & 0xffff0000u));
          const unsigned l23 = pk2(hv[r][i * 4 + 2] - __uint_as_float(h23 << 16), hv[r][i * 4 + 3] - __uint_as_float(h23 & 0xffff0000u));
          *(LAS u32x2*)(hiP + ro + i * 512) = u32x2{h01, h23};
          *(LAS u32x2*)(loP + ro + i * 512) = u32x2{l01, l23};
        }
      }
      float gl[4];
#pragma unroll
      for (int o = 0; o < 4; ++o) gl[o] = router_dot(hv, WRT + (size_t)o * 1024) + p->b_group[l * 4 + o];
      int gs = 0; float best = gl[0];
#pragma unroll
      for (int j = 1; j < 4; ++j) if (gl[j] > best) { best = gl[j]; gs = j; }
      float gsum = 0.f;
#pragma unroll
      for (int j = 0; j < 4; ++j) gsum += __expf(gl[j] - best);
      if ((lane & 15) == 0) { gsel[wave * 4 + qd] = gs; gwt[wave * 4 + qd] = 1.f / gsum; }
    }
    __syncthreads();
    f32x16 acc;
#pragma unroll
    for (int i = 0; i < 16; ++i) acc[i] = 0.f;
    {
      const int ao = r32 * RP + (128 * wave + 8 * kh) * 2;
#pragma unroll
      for (int s8 = 0; s8 < 8; ++s8) {
        const bf16x8 ah = *(const LAS bf16x8*)(hiP + ao + s8 * 32), al = *(const LAS bf16x8*)(loP + ao + s8 * 32);
        acc = MFMA(ah, whi[s8], acc);
        acc = MFMA(ah, wlo[s8], acc);
        acc = MFMA(al, whi[s8], acc);
      }
    }
    __syncthreads();
#pragma unroll
    for (int i = 0; i < 16; ++i) part[(wave * 32 + (i & 3) + 8 * (i >> 2) + 4 * kh) * 33 + r32] = acc[i];
    __syncthreads();
    if (tid < 32) {
      const int gs = gsel[tid];
      const float gw_ = gwt[tid];
      float e8[8];
#pragma unroll
      for (int j = 0; j < 8; ++j) {
        float v = p->b_router[l * 32 + gs * 8 + j];
#pragma unroll
        for (int w = 0; w < 8; ++w) v += part[(w * 32 + tid) * 33 + gs * 8 + j];
        e8[j] = v;
      }
      int i0 = 0; float v0 = e8[0];
#pragma unroll
      for (int j = 1; j < 8; ++j) if (e8[j] > v0) { v0 = e8[j]; i0 = j; }
      int i1 = -1; float v1 = -INFINITY;
#pragma unroll
      for (int j = 0; j < 8; ++j) if (j != i0 && e8[j] > v1) { v1 = e8[j]; i1 = j; }
      const float ex = __expf(v1 - v0);
      const float w0 = gw_ / (1.f + ex), w1 = gw_ * ex / (1.f + ex);
      const int tok = tok0 + tid;
      const int ea = gs * 8 + i0, eb = gs * 8 + i1;
      const int ra = __hip_atomic_fetch_add(&lcnt[ea], 1, __ATOMIC_RELAXED, __HIP_MEMORY_SCOPE_WORKGROUP);
      const int rb = __hip_atomic_fetch_add(&lcnt[eb], 1, __ATOMIC_RELAXED, __HIP_MEMORY_SCOPE_WORKGROUP);
      LAS int* ti = tinfo + (nloc + tid) * 6;
      ti[0] = tok; ti[1] = ea | (eb << 8); ti[2] = ra; ti[3] = rb; ti[4] = __float_as_int(w0); ti[5] = __float_as_int(w1);
    }
    if (tid == 0) *tnext = tclaim;
    nloc += 32;
    __syncthreads();
    const bool last = *tnext >= ntile;
    if (last || nloc == 512) {
      if (tid < 32) { const int c = lcnt[tid]; gbase[tid] = c ? atomicAdd(&cnt[tid * CNT_STRIDE], c) : 0; }
      __syncthreads();
      for (int i = tid; i < nloc; i += 512) {
        const LAS int* ti = tinfo + i * 6;
        const int tok = ti[0], ea = ti[1] & 255, eb = ti[1] >> 8;
        const int sa = gbase[ea] + ti[2], sb = gbase[eb] + ti[3];
        list[(size_t)ea * NTOK + sa] = tok * 2; wlist[(size_t)ea * NTOK + sa] = __int_as_float(ti[4]);
        list[(size_t)eb * NTOK + sb] = tok * 2 + 1; wlist[(size_t)eb * NTOK + sb] = __int_as_float(ti[5]);
      }
      __syncthreads();
      if (tid < 32) lcnt[tid] = 0;
      nloc = 0;
      __syncthreads();
    }
  }
}
struct ExpInfo2 { int tiles[4], base[4], cnt[4]; };
DEVI ExpInfo2 exp_info2(KP p, int xcd) {
  const int* cnt = wsp<int>(p, OFF_CNT);
  ExpInfo2 ei;
  int before = 0;
#pragma unroll
  for (int e = 0; e < 32; ++e) {
    const int c = __builtin_amdgcn_readfirstlane(cnt[e * CNT_STRIDE]), t = (c + 255) >> 8;
    if ((e & 7) == xcd) { ei.tiles[e >> 3] = t; ei.base[e >> 3] = before; ei.cnt[e >> 3] = c; }
    before += t;
  }
  return ei;
}
template <int NN>
struct SchedX { ExpInfo2 ei; int xcd, lb, G8; const char* A; const char* W; const int* list; size_t wstride; int lda_b; int ldw_b;
  DEVI bool next(int i, Unit& u) const {
    const int tot = (ei.tiles[0] + ei.tiles[1] + ei.tiles[2] + ei.tiles[3]) * NN;
    const int n = i * G8 + lb; if (n >= tot) return false;
    int k = 0, m = n / NN; const int pn = n % NN;
    int tb = ei.base[0], ce = ei.cnt[0];
#pragma unroll
    for (int kk = 0; kk < 3; ++kk) { if (k == kk && m >= ei.tiles[kk]) { m -= ei.tiles[kk]; k = kk + 1; tb = ei.base[kk + 1]; ce = ei.cnt[kk + 1]; } }
    const int e = xcd + 8 * k;
    u.rows = list + (size_t)e * NTOK + m * 256; u.nvalid = ce - m * 256;
    u.A = A + (NN == 2 ? 0u : uoff((unsigned)(tb + m) * 256u * (unsigned)lda_b));
    u.B = W + uoff((unsigned)e * (unsigned)wstride + (unsigned)pn * 256u * (unsigned)ldw_b);
    u.u0 = (tb + m) * 256; u.u1 = pn; u.u2 = e; u.u3 = m; return true; } };
constexpr float U8_SCALE = 16.f;
struct EpiI1 { unsigned char* U;
  DEVI void init(f32x4 (&acc)[2][2][4][2], const Unit&, int, int, int, int) const { acc_zero(acc); }
  DEVI void operator()(const f32x4 (&acc)[2][2][4][2], const Unit& u, int wr, int wc, int fr, int fq) const {
#pragma unroll
    for (int ai = 0; ai < 2; ++ai)
#pragma unroll
      for (int m = 0; m < 4; ++m) {
        unsigned char* rowp = U + (size_t)(u.u0 + ai * HALF + wr * 64 + m * 16 + fr) * 256;
#pragma unroll
        for (int bj = 0; bj < 2; ++bj) {
          const int ff = 16 * (8 * u.u1 + 4 * bj + wc) + 4 * fq;
          const f32x4 g = acc[ai][bj][m][0] * (1.f / F8_WSCALE), up = acc[ai][bj][m][1] * (1.f / F8_WSCALE);
          float t[4];
#pragma unroll
          for (int j = 0; j < 4; ++j) t[j] = __builtin_amdgcn_fmed3f(g[j] / (1.f + __expf(-g[j])) * up[j] * U8_SCALE, -448.f, 448.f);
          int o = __builtin_amdgcn_cvt_pk_fp8_f32(t[0], t[1], 0, false);
          o = __builtin_amdgcn_cvt_pk_fp8_f32(t[2], t[3], o, true);
          *(int*)(rowp + ff) = o;
        }
      }
  }
};
DEVI void phaseI1_2(KP p, ldsp_t lds) {
  const int xcd = BIDX & 7, lb = BIDX >> 3, G8 = gridDim.x >> 3;
  if (lb >= G8) return;
  SchedX<2> S{exp_info2(p, xcd), xcd, lb, G8, (const char*)wsp<u16>(p, OFF_H2), (const char*)wsp<u16>(p, OFF_W13), wsp<int>(p, OFF_LIST), (size_t)512 * 1024, 1024, 1024};
  EpiI1 E{wsp<unsigned char>(p, OFF_U)};
  int nt = 8; asm volatile("" : "+s"(nt));
  gemm_phase<false, true, true>(lds, 1024, 1024, nt, S, E);
}
struct EpiI2 { u16* YS; const float* wlist; const int* list;
  DEVI void init(f32x4 (&acc)[2][2][4][2], const Unit&, int, int, int, int) const { acc_zero(acc); }
  DEVI void operator()(const f32x4 (&acc)[2][2][4][2], const Unit& u, int wr, int wc, int fr, int fq) const {
    const unsigned colb = (unsigned)(u.u1 * 256 + wc * 32 + 8 * fq) * 2u;
    const float* we = wlist + (u.rows - list);
    unsigned dest[2][4]; float w[2][4];
#pragma unroll
    for (int ai = 0; ai < 2; ++ai)
#pragma unroll
      for (int m = 0; m < 4; ++m) {
        const int r = ai * HALF + wr * 64 + m * 16 + fr;
        dest[ai][m] = (r < u.nvalid) ? (unsigned)u.rows[r] : (unsigned)(2 * NTOK);
        w[ai][m] = we[r] * (1.f / (U8_SCALE * F8_WSCALE));
      }
#pragma unroll
    for (int ai = 0; ai < 2; ++ai)
#pragma unroll
      for (int m = 0; m < 4; ++m) {
        char* rowp = (char*)YS + (dest[ai][m] * 2048u + colb);
#pragma unroll
        for (int bj = 0; bj < 2; ++bj) {
          const f32x4 v0 = acc[ai][bj][m][0] * w[ai][m], v1 = acc[ai][bj][m][1] * w[ai][m];
          u32x4 o; o.x = pk2(v0[0], v0[1]); o.y = pk2(v0[2], v0[3]); o.z = pk2(v1[0], v1[1]); o.w = pk2(v1[2], v1[3]);
          *(u32x4*)(rowp + bj * 256) = o;
        }
      }
  }
};
DEVI void phaseI2_2(KP p, ldsp_t lds) {
  const int xcd = BIDX & 7, lb = BIDX >> 3, G8 = gridDim.x >> 3;
  if (lb >= G8) return;
  SchedX<4> S{exp_info2(p, xcd), xcd, lb, G8, (const char*)wsp<u16>(p, OFF_U), (const char*)wsp<u16>(p, OFF_W2), wsp<int>(p, OFF_LIST), (size_t)1024 * 256, 256, 256};
  EpiI2 E{wsp<u16>(p, OFF_YS), wsp<float>(p, OFF_WLIST), wsp<int>(p, OFF_LIST)};
  int nt = 2; asm volatile("" : "+s"(nt));
  gemm_phase<true, false, true>(lds, 256, 256, nt, S, E);
}
DEVI void phaseJ2(KP p, int l, ldsp_t lds) {
  const int lane = TIDX & 63;
  const int gw = BIDX * NW + (TIDX >> 6), nw = gridDim.x * NW;
  const u16* YS = wsp<u16>(p, OFF_YS);
  u16* H = wsp<u16>(p, OFF_H);
  const int ntot = (l == 1) ? 8 * SEQ : NTOK;
  const int per = (ntot + nw - 1) / nw;
  const int i0 = gw * per, i1 = min(i0 + per, ntot);
  int cur = -1; ModVec mv; f32x4 gtv[4];
  for (int ii = i0; ii < i1; ii += 2) {
    float xv[2][16]; u32x2 y0[2][4], y1[2][4]; bool ok[2]; int tk[2];
#pragma unroll
    for (int r = 0; r < 2; ++r) {
      const int idx = ii + r;
      const int tok = (l == 1) ? (idx / SEQ) * TPB + NCTX + idx % SEQ : idx;
      tk[r] = tok;
      ok[r] = idx < i1;
      if (ok[r]) {
        load_row16_bf(wsp<u16>(p, OFF_XM) + (size_t)tok * 1024, xv[r]);
#pragma unroll
        for (int i = 0; i < 4; ++i) {
          const int c = i * 256 + lane * 4;
          y0[r][i] = *(const u32x2*)(YS + (size_t)(tok * 2) * 1024 + c);
          y1[r][i] = *(const u32x2*)(YS + (size_t)(tok * 2 + 1) * 1024 + c);
        }
      }
    }
#pragma unroll
    for (int r = 0; r < 2; ++r) {
      if (!ok[r]) continue;
      const int tok = tk[r];
      const int b = tok / TPB, rr = tok % TPB;
      const int mrow = (rr < NCTX) ? 8 : b;
      if (mrow != cur) {
        cur = mrow;
        const float* gt = wsp<float>(p, OFF_MOD) + ((size_t)l * 9 + mrow) * 6144 + 5120;
#pragma unroll
        for (int i = 0; i < 4; ++i) gtv[i] = *(const f32x4*)(gt + i * 256 + lane * 4);
        if (l == 0) load_modvec(p, 1, 0, mrow, mv);
      }
#pragma unroll
      for (int i = 0; i < 4; ++i) {
        const f32x4 g = gtv[i];
        xv[r][i * 4 + 0] += g.x * (bf2f((u16)(y0[r][i].x & 0xffff)) + bf2f((u16)(y1[r][i].x & 0xffff)));
        xv[r][i * 4 + 1] += g.y * (bf2f((u16)(y0[r][i].x >> 16)) + bf2f((u16)(y1[r][i].x >> 16)));
        xv[r][i * 4 + 2] += g.z * (bf2f((u16)(y0[r][i].y & 0xffff)) + bf2f((u16)(y1[r][i].y & 0xffff)));
        xv[r][i * 4 + 3] += g.w * (bf2f((u16)(y0[r][i].y >> 16)) + bf2f((u16)(y1[r][i].y >> 16)));
      }
      if (l == 0) {
        u16* xr = (u16*)p->out + (size_t)tok * 1024;
#pragma unroll
        for (int i = 0; i < 4; ++i)
          *(u32x2*)(xr + i * 256 + lane * 4) = u32x2{pk2(xv[r][i * 4], xv[r][i * 4 + 1]), pk2(xv[r][i * 4 + 2], xv[r][i * 4 + 3])};
        float hv[16];
        modulate_row_store2<true, false>(mv, xv[r], nullptr, hv, h8base(p) + (size_t)tok * 1024);
      } else {
        float ss = 0.f;
#pragma unroll
        for (int i = 0; i < 16; ++i) ss += xv[r][i] * xv[r][i];
        ss = wave_sum(ss);
        const float rstd = rsqrtf(ss * (1.f / 1024.f) + EPS);
        float* xr = p->out + ((size_t)b * SEQ + rr - NCTX) * 1024;
#pragma unroll
        for (int i = 0; i < 4; ++i) {
          const int c = i * 256 + lane * 4;
          const f32x4 g = *(const f32x4*)(p->g_final + c);
          *(f32x4*)(xr + c) = f32x4{xv[r][i * 4] * rstd * g.x, xv[r][i * 4 + 1] * rstd * g.y, xv[r][i * 4 + 2] * rstd * g.z, xv[r][i * 4 + 3] * rstd * g.w};
        }
      }
    }
  }
}

constexpr int N_PHASES = 3 + 2 * 11;
__global__ void __launch_bounds__(512, 2) fwd_v2(Params parg) {
  extern __shared__ __attribute__((aligned(16))) unsigned char dyn_lds[];
  const ldsp_t lds = (ldsp_t)dyn_lds;
  cg::grid_group grid = cg::this_grid();
  volatile LAS unsigned* xb_st = (volatile LAS unsigned*)(lds + LDS_BARW);
  if (TIDX < 4) xb_st[TIDX] = 0u;
  __syncthreads();
  if (parg.ph_end - parg.ph_begin > 1) xcd_barrier_post((unsigned*)(parg.ws + OFF_BAR));
  for (int ph = parg.ph_begin; ph < parg.ph_end; ++ph) {
    KP p = (KP)__builtin_amdgcn_kernarg_segment_ptr();
    asm volatile("" : "+s"(p));
    const int l = (ph >= 14) ? 1 : 0;
    const int k = (ph < 3) ? ph : 3 + (ph - 3) % 11;
    const int reps = (((PROBE_DUP >> k) & 1) && (!(PROBE_DUP & 0x10000) || l == 0)) ? 2 : 1;
    for (int rep = 0; rep < reps; ++rep) {
      if (rep) {
        xcd_barrier((unsigned*)(p->ws + OFF_BAR), xb_st);
        if (k == 10) { if (BIDX == 0 && TIDX < 32) wsp<int>(p, OFF_CNT)[TIDX * CNT_STRIDE] = 0; xcd_barrier((unsigned*)(p->ws + OFF_BAR), xb_st); }
      }
      switch (k) {
        case 0: phase0_2(p, lds); break;
        case 1: phase1_2(p); break;
        case 2: phaseA2(p); break;
        case 3: phaseB2(p, lds); break;
        case 4: phaseC2(p, lds); break;
        case 5: phaseP2(p, l, lds); break;
        case 6: phaseD2(p, l, lds); break;
        case 7: phaseE1(p, l, lds); break;
        case 8: phaseE2(p, l, lds); break;
        case 9: phaseF2(p, l, lds); break;
        case 10: phaseG2(p, l, lds); break;
        case 11: phaseI1_2(p, lds); break;
        case 12: phaseI2_2(p, lds); break;
        default: phaseJ2(p, l, lds); break;
      }
    }
    if (k == 0 || (k == 13 && l == 0)) conv_items2(p, k == 0 ? 0 : 1, lds, 0, CONV_EARLY);
    if (ph + 1 < parg.ph_end && k != 9) {
      if (parg.ph_begin >= 1000) grid.sync();
      else xcd_barrier((unsigned*)(p->ws + OFF_BAR), xb_st);
    }
  }
}
}

extern "C" void kernel_launch(void* const* d_in, const int* in_sizes, int n_in, void* d_out, int out_size,
                              void* d_ws, size_t ws_size, hipStream_t stream) {
  static int grid2 = 0;
  if (!grid2) {
    int dev = 0, cus = 0, per_cu = 0;
    (void)hipGetDevice(&dev);
    (void)hipDeviceGetAttribute(&cus, hipDeviceAttributeMultiprocessorCount, dev);
    (void)hipFuncSetAttribute((const void*)v2::fwd_v2, hipFuncAttributeMaxDynamicSharedMemorySize, v2::LDS_TOTAL);
    (void)hipOccupancyMaxActiveBlocksPerMultiprocessor(&per_cu, v2::fwd_v2, 512, v2::LDS_TOTAL);
    if (per_cu < 1) { fprintf(stderr, "kernel does not fit on a CU\n"); per_cu = 1; }
    grid2 = cus & ~7;
  }
  if (ws_size < WS_NEEDED) { fprintf(stderr, "workspace too small: %zu < %zu\n", ws_size, (size_t)WS_NEEDED); return; }
  Params hp{};
  const float** f = (const float**)&hp;
  for (int i = 0; i < 29; ++i) f[i] = (const float*)d_in[i];
  hp.out = (float*)d_out;
  hp.ws = (char*)d_ws;
#if N_LAUNCH_MODE == 1
  for (int ph = 0; ph < v2::N_PHASES; ++ph) {
    hp.ph_begin = ph; hp.ph_end = ph + 1;
    void* args[] = {&hp};
    hipError_t e = hipLaunchCooperativeKernel((void*)v2::fwd_v2, dim3(grid2), dim3(512), args, v2::LDS_TOTAL, stream);
    if (e != hipSuccess) fprintf(stderr, "launch failed: %s\n", hipGetErrorString(e));
  }
#else
  hp.ph_begin = 0; hp.ph_end = v2::N_PHASES;
  (void)hipMemsetAsync((char*)d_ws + OFF_BAR, 0, (size_t)(OFF_DEP - OFF_BAR) + (size_t)DEP_WORDS * 4, stream);
  void* args[] = {&hp};
  hipError_t e = hipLaunchCooperativeKernel((void*)v2::fwd_v2, dim3(grid2), dim3(512), args, v2::LDS_TOTAL, stream);
  if (e != hipSuccess) fprintf(stderr, "cooperative launch failed: %s (grid %d)\n", hipGetErrorString(e), grid2);
#endif
}
```

```cpp
#include <hip/hip_runtime.h>
#include <hip/hip_cooperative_groups.h>
#include <stdint.h>
#include <stdio.h>
namespace cg = cooperative_groups;

#ifndef N_LAUNCH_MODE
#define N_LAUNCH_MODE 0
#endif

#ifndef PROBE_DUP
#define PROBE_DUP 0
#endif
#define DEVI __device__ __forceinline__
typedef unsigned short u16;
typedef __attribute__((ext_vector_type(2))) float f32x2;
typedef __attribute__((ext_vector_type(2))) __bf16 bf16x2_t;
typedef __attribute__((ext_vector_type(8))) short bf16x8;
typedef __attribute__((ext_vector_type(16))) float f32x16;
typedef __attribute__((ext_vector_type(4))) unsigned u32x4;
typedef __attribute__((ext_vector_type(2))) unsigned u32x2;
typedef __attribute__((ext_vector_type(4))) float f32x4;
#define MFMA(a, b, c) __builtin_amdgcn_mfma_f32_32x32x16_bf16((a), (b), (c), 0, 0, 0)

constexpr int DMODEL = 1024, NBATCH = 8, SEQ = 4096, NCTX = 256;
constexpr int TPB = SEQ + NCTX;
constexpr int NTOK = NBATCH * TPB;
constexpr int MT_PER_B = TPB / 128;
constexpr int NEXP = 32;
constexpr int INP = 2304;
constexpr float EPS = 1e-6f;
constexpr float LOG2E = 1.4426950408889634f;
constexpr int SMEM_BYTES = 73728;
constexpr int UROWS = 2 * NTOK + NEXP * 256;

constexpr size_t al(size_t x) { return (x + 255) & ~(size_t)255; }
constexpr size_t OFF_WIN = 0;
constexpr size_t OFF_WQB = OFF_WIN + al((size_t)INP * 1024 * 2);
constexpr size_t OFF_WKVB = OFF_WQB + al((size_t)512 * 256 * 2);
constexpr size_t OFF_WGATE = OFF_WKVB + al((size_t)512 * 256 * 2);
constexpr size_t OFF_WBR = OFF_WGATE + al((size_t)4 * 1024 * 1024 * 2);
constexpr size_t OFF_WOUT = OFF_WBR + al((size_t)4 * 1024 * 256 * 2);
constexpr size_t OFF_W13 = OFF_WOUT + al((size_t)1024 * 1024 * 2);
constexpr size_t OFF_W2 = OFF_W13 + al((size_t)32 * 512 * 1024 * 2);
constexpr size_t OFF_MODP = OFF_W2 + al((size_t)32 * 1024 * 256 * 2);
constexpr size_t OFF_MOD = OFF_MODP + al((size_t)8 * 2 * 9 * 6144 * 4);
constexpr size_t OFF_CS32 = OFF_MOD + al((size_t)2 * 9 * 6144 * 4);
constexpr size_t OFF_CS16 = OFF_CS32 + al((size_t)64 * 16 * 2 * 4);
constexpr size_t OFF_WRT = OFF_CS16 + al((size_t)64 * 8 * 2 * 4);
constexpr size_t OFF_CNT = OFF_WRT + al((size_t)2 * 36 * 1024 * 4);
constexpr int CNT_STRIDE = 64;
constexpr size_t OFF_BAR = OFF_CNT + al(32 * CNT_STRIDE * 4);
constexpr int XCD_BAR_WORDS = 3456;
constexpr size_t OFF_CTXRES = OFF_BAR + al((size_t)XCD_BAR_WORDS * 4);
constexpr size_t OFF_DEP = OFF_CTXRES;
constexpr int DEP_STRIDE = 16, DEP_TILECTR = 2 * 136 * DEP_STRIDE, DEP_WORDS = DEP_TILECTR + 2 * DEP_STRIDE;
constexpr size_t OFF_H = OFF_CTXRES + al((size_t)8 * 256 * 1024 * 4);
constexpr size_t OFF_O = OFF_H + al((size_t)NTOK * 1024 * 2);
constexpr size_t OFF_SSQ = OFF_O + al((size_t)NTOK * 1024 * 2);
constexpr size_t OFF_LIST = OFF_SSQ + al((size_t)NTOK * 8 * 4);
constexpr size_t OFF_WLIST = OFF_LIST + al((size_t)32 * NTOK * 4);
constexpr size_t OFF_R1 = OFF_WLIST + al((size_t)32 * NTOK * 4);
constexpr int PLD = INP;
constexpr size_t OFF_PRAW = OFF_R1;
constexpr size_t OFF_QARAW = OFF_PRAW + (size_t)NTOK * INP * 2;
constexpr size_t OFF_KVARAW = OFF_QARAW + (size_t)NTOK * 512 * 2;
constexpr size_t OFF_VAT = OFF_KVARAW + (size_t)NTOK * 512 * 2;
constexpr size_t OFF_VBT = OFF_VAT + (size_t)NTOK * 256 * 2;
constexpr size_t OFF_VCT = OFF_VBT + (size_t)NTOK * 128 * 2;
constexpr size_t OFF_VDT = OFF_VCT + (size_t)NTOK * 256 * 2;
constexpr size_t OFF_END = OFF_VDT + (size_t)NTOK * 128 * 2;
constexpr size_t OFF_Z = OFF_R1;
constexpr size_t OFF_Y8 = OFF_H;
constexpr size_t OFF_H2 = OFF_O;
constexpr size_t OFF_YPRE = OFF_O;
constexpr size_t OFF_U = OFF_R1;
constexpr size_t OFF_YS = OFF_R1 + al((size_t)UROWS * 256 * 2);
constexpr size_t OFF_XM = OFF_YS + al((size_t)(2 * NTOK + 1) * 1024 * 2);
static_assert(OFF_XM + (size_t)NTOK * 1024 * 2 <= OFF_END, "alias overflow");
static_assert(OFF_Z + (size_t)NTOK * 4096 * 2 <= OFF_END, "alias overflow");
static_assert(OFF_YS + (size_t)(2 * NTOK + 1) * 1024 * 2 <= OFF_END, "alias overflow");
constexpr size_t WS_NEEDED = OFF_END;
static_assert(WS_NEEDED <= (size_t)536870912, "workspace budget (4 x largest tensor)");

struct Params {
  const float *x, *c, *ctx, *c_ctx, *w_mod, *b_mod, *g_norm_mix, *w_in, *g_q_a, *w_q_b, *g_kv_a, *w_kv_b,
      *sink_b, *rpb_c, *g_q_d, *g_k_d, *w_gate, *b_gate, *w_branch, *w_out, *g_norm_ffn, *w_group, *b_group,
      *w_router, *b_router, *w_ff1, *w_ff3, *w_ff2, *g_final;
  float* out;
  char* ws;
  int ph_begin, ph_end;
};

DEVI int tid_fresh() { int t; asm volatile("v_mov_b32 %0, %1" : "=v"(t) : "v"(__builtin_amdgcn_workitem_id_x())); return t; }
DEVI int bid_fresh() { int t; asm volatile("s_mov_b32 %0, %1" : "=s"(t) : "s"(__builtin_amdgcn_workgroup_id_x())); return t; }
#define TIDX tid_fresh()
#define BIDX bid_fresh()
typedef const __attribute__((address_space(4))) Params* KP;
DEVI unsigned pk2(float a, float b) { f32x2 v = {a, b}; bf16x2_t r = __builtin_convertvector(v, bf16x2_t); return __builtin_bit_cast(unsigned, r); }
DEVI u16 f2bf(float a) { return (u16)(pk2(a, 0.f) & 0xffffu); }
DEVI float bf2f(u16 v) { return __uint_as_float(((unsigned)v) << 16); }
DEVI float wave_sum(float v) {
#pragma unroll
  for (int m = 32; m >= 1; m >>= 1) v += __shfl_xor(v, m);
  return v;
}
template <class T> DEVI T* wsp(KP p, size_t off) { return (T*)(p->ws + off); }
DEVI const float* xrow_in(KP p, int l, int b, int rr) {
  if (l == 0) return (rr < NCTX) ? p->ctx + ((size_t)b * NCTX + rr) * 1024 : p->x + ((size_t)b * SEQ + rr - NCTX) * 1024;
  return (rr < NCTX) ? wsp<float>(p, OFF_CTXRES) + ((size_t)b * NCTX + rr) * 1024 : p->out + ((size_t)b * SEQ + rr - NCTX) * 1024;
}
DEVI float* xrow_res(KP p, int b, int rr) {
  return (rr < NCTX) ? wsp<float>(p, OFF_CTXRES) + ((size_t)b * NCTX + rr) * 1024 : p->out + ((size_t)b * SEQ + rr - NCTX) * 1024;
}
DEVI int perm16(int k) { return (k & ~12) | ((k & 4) << 1) | ((k & 8) >> 1); }

struct ConvT { const float* src; const float* src2; const float* ks; u16* dst; int ld; int ldd; float mul; };
constexpr float Z8_SCALE = 16.f, O8_SCALE = 32.f;
constexpr float F8_WSCALE = 64.f, GATE_WSCALE = F8_WSCALE;
constexpr int CONV_ITEMS = 1152 + 64 + 64 + 2048 + 512 + 512 + 8192 + 4096;
DEVI ConvT conv_decode(KP p, int l, int idx) {
  ConvT c; c.ks = nullptr; c.mul = 1.f; c.src2 = nullptr;
  if (idx < 1152) {
    int nt = idx >> 4, kt = idx & 15, n0 = nt * 32;
    int sc = (n0 < 416) ? n0 : ((n0 < 512) ? -1 : n0 - 96);
    c.ld = 2208; c.ldd = -1024;
    c.mul = F8_WSCALE;
    if ((n0 >= 512 && n0 < 768) || (n0 >= 1024 && n0 < 1280)) c.mul = 0.125f * LOG2E * F8_WSCALE;
    c.src = (sc < 0) ? nullptr : p->w_in + (size_t)l * 1024 * 2208 + (size_t)kt * 64 * 2208 + sc;
    c.dst = (u16*)(p->ws + OFF_WIN + (size_t)n0 * 1024 + kt * 64);
    return c;
  }
  idx -= 1152;
  if (idx < 64) {
    int nt = idx >> 2, kt = idx & 3;
    c.ld = 384; c.ldd = 256; c.ks = p->g_q_a + l * 256 + kt * 64;
    c.src = (nt >= 12) ? nullptr : p->w_q_b + (size_t)l * 256 * 384 + (size_t)kt * 64 * 384 + nt * 32;
    c.dst = wsp<u16>(p, OFF_WQB) + (size_t)nt * 32 * 256 + kt * 64;
    return c;
  }
  idx -= 64;
  if (idx < 64) {
    int nt = idx >> 2, kt = idx & 3;
    c.ld = 512; c.ldd = 256; c.ks = (kt < 2) ? p->g_kv_a + l * 128 + kt * 64 : nullptr;
    c.src = (kt >= 2) ? nullptr : p->w_kv_b + (size_t)l * 128 * 512 + (size_t)kt * 64 * 512 + nt * 32;
    c.dst = wsp<u16>(p, OFF_WKVB) + (size_t)nt * 32 * 256 + kt * 64;
    return c;
  }
  idx -= 64;
  if (idx < 2048) {
    int nt = idx >> 4, kt = idx & 15, R0 = nt * 32;
    int pr = R0 >> 11, cb = (R0 & 2047) >> 8, bj = (R0 & 255) >> 7, j0 = R0 & 127;
    c.ld = 1024; c.ldd = -1024; c.mul = F8_WSCALE;
    c.src = p->w_gate + ((size_t)(l * 4 + 2 * pr + bj) * 1024 + kt * 64) * 1024 + cb * 128 + j0;
    c.dst = (u16*)(p->ws + OFF_WGATE + (size_t)R0 * 1024 + kt * 64);
    return c;
  }
  idx -= 2048;
  if (idx < 512) {
    int br = idx >> 7, nt = (idx >> 2) & 31, kt = idx & 3;
    c.ld = 1024; c.ldd = -256; c.mul = F8_WSCALE;
    c.src = p->w_branch + ((size_t)(l * 4 + br) * 256 + kt * 64) * 1024 + nt * 32;
    c.dst = (u16*)(p->ws + OFF_WBR + ((size_t)br * 1024 + nt * 32) * 256 + kt * 64);
    return c;
  }
  idx -= 512;
  if (idx < 512) {
    int nt = idx >> 4, kt = idx & 15;
    c.ld = 1024; c.ldd = -1024; c.mul = F8_WSCALE;
    c.src = p->w_out + ((size_t)l * 1024 + kt * 64) * 1024 + nt * 32;
    c.dst = (u16*)(p->ws + OFF_WOUT + (size_t)nt * 32 * 1024 + kt * 64);
    return c;
  }
  idx -= 512;
  if (idx < 8192) {
    int e = idx >> 8, g32 = (idx >> 4) & 15, kt = idx & 15;
    c.ld = 256; c.ldd = -1024; c.mul = F8_WSCALE;
    c.src = p->w_ff1 + ((size_t)(l * 32 + e) * 1024 + kt * 64) * 256 + g32 * 16;
    c.src2 = p->w_ff3 + ((size_t)(l * 32 + e) * 1024 + kt * 64) * 256 + g32 * 16;
    c.dst = (u16*)(p->ws + OFF_W13 + ((size_t)e * 512 + g32 * 32) * 1024 + kt * 64);
    return c;
  }
  idx -= 8192;
  {
    int e = idx >> 7, nt = (idx >> 2) & 31, kt = idx & 3;
    c.ld = 1024; c.ldd = -256; c.mul = F8_WSCALE;
    c.src = p->w_ff2 + ((size_t)(l * 32 + e) * 256 + kt * 64) * 1024 + nt * 32;
    c.dst = (u16*)(p->ws + OFF_W2 + ((size_t)e * 1024 + nt * 32) * 256 + kt * 64);
    return c;
  }
}
DEVI void modulate_row_store(KP p, int l, int which, const float (&xv)[16], int mrow, u16* hrow, float (&hv)[16]) {
  const int lane = TIDX & 63;
  float ss = 0.f;
#pragma unroll
  for (int i = 0; i < 16; ++i) ss += xv[i] * xv[i];
  ss = wave_sum(ss);
  const float rstd = rsqrtf(ss * (1.f / 1024.f) + EPS);
  const float* g = (which ? p->g_norm_ffn : p->g_norm_mix) + l * 1024;
  const float* mod = wsp<float>(p, OFF_MOD) + ((size_t)l * 9 + mrow) * 6144 + (which ? 3072 : 0);
#pragma unroll
  for (int i = 0; i < 4; ++i) {
    const int c = i * 256 + lane * 4;
    f32x4 gv = *(const f32x4*)(g + c);
    f32x4 sh = *(const f32x4*)(mod + c);
    f32x4 sc = *(const f32x4*)(mod + 1024 + c);
    hv[i * 4 + 0] = xv[i * 4 + 0] * rstd * gv.x * (1.f + sc.x) + sh.x;
    hv[i * 4 + 1] = xv[i * 4 + 1] * rstd * gv.y * (1.f + sc.y) + sh.y;
    hv[i * 4 + 2] = xv[i * 4 + 2] * rstd * gv.z * (1.f + sc.z) + sh.z;
    hv[i * 4 + 3] = xv[i * 4 + 3] * rstd * gv.w * (1.f + sc.w) + sh.w;
    u32x2 o; o.x = pk2(hv[i * 4 + 0], hv[i * 4 + 1]); o.y = pk2(hv[i * 4 + 2], hv[i * 4 + 3]);
    *(u32x2*)(hrow + c) = o;
  }
}
struct ModVec { f32x4 a[4], b[4]; };
DEVI void load_modvec(KP p, int l, int which, int mrow, ModVec& mv) {
  const int lane = TIDX & 63;
  const float* g = (which ? p->g_norm_ffn : p->g_norm_mix) + l * 1024;
  const float* mod = wsp<float>(p, OFF_MOD) + ((size_t)l * 9 + mrow) * 6144 + (which ? 3072 : 0);
#pragma unroll
  for (int i = 0; i < 4; ++i) {
    const int c = i * 256 + lane * 4;
    const f32x4 gv = *(const f32x4*)(g + c), sh = *(const f32x4*)(mod + c), sc = *(const f32x4*)(mod + 1024 + c);
    mv.a[i] = gv * (1.f + sc); mv.b[i] = sh;
  }
}
DEVI unsigned char* h8base(KP p) { return (unsigned char*)p->out + (size_t)NTOK * 2048; }
template <bool F8COPY = false, bool BF16 = true>
DEVI void modulate_row_store2(const ModVec& mv, const float (&xv)[16], u16* hrow, float (&hv)[16], unsigned char* h8row = nullptr) {
  const int lane = TIDX & 63;
  float ss = 0.f;
#pragma unroll
  for (int i = 0; i < 16; ++i) ss += xv[i] * xv[i];
  ss = wave_sum(ss);
  const float rstd = rsqrtf(ss * (1.f / 1024.f) + EPS);
#pragma unroll
  for (int i = 0; i < 4; ++i) {
    const int c = i * 256 + lane * 4;
#pragma unroll
    for (int j = 0; j < 4; ++j) hv[i * 4 + j] = xv[i * 4 + j] * rstd * mv.a[i][j] + mv.b[i][j];
    if (BF16) { u32x2 o; o.x = pk2(hv[i * 4 + 0], hv[i * 4 + 1]); o.y = pk2(hv[i * 4 + 2], hv[i * 4 + 3]);
      *(u32x2*)(hrow + c) = o; }
    if (F8COPY) {
      float q[4];
#pragma unroll
      for (int j = 0; j < 4; ++j) q[j] = __builtin_amdgcn_fmed3f(hv[i * 4 + j], -448.f, 448.f);
      int v = __builtin_amdgcn_cvt_pk_fp8_f32(q[0], q[1], 0, false);
      v = __builtin_amdgcn_cvt_pk_fp8_f32(q[2], q[3], v, true);
      *(int*)(h8row + c) = v;
    }
  }
}
DEVI void load_row16(const float* xr, float (&xv)[16]) {
  const int lane = TIDX & 63;
#pragma unroll
  for (int i = 0; i < 4; ++i) {
    f32x4 v = *(const f32x4*)(xr + i * 256 + lane * 4);
    xv[i * 4 + 0] = v.x; xv[i * 4 + 1] = v.y; xv[i * 4 + 2] = v.z; xv[i * 4 + 3] = v.w;
  }
}
DEVI void load_row16_bf(const u16* xr, float (&xv)[16]) {
  const int lane = TIDX & 63;
#pragma unroll
  for (int i = 0; i < 4; ++i) {
    const u32x2 v = *(const u32x2*)(xr + i * 256 + lane * 4);
    xv[i * 4 + 0] = __uint_as_float(v.x << 16); xv[i * 4 + 1] = __uint_as_float(v.x & 0xffff0000u);
    xv[i * 4 + 2] = __uint_as_float(v.y << 16); xv[i * 4 + 3] = __uint_as_float(v.y & 0xffff0000u);
  }
}
DEVI float router_dot(const float (&hv)[4][16], const float* wrow) {
  const int lane = TIDX & 63;
  const float* w = wrow + lane * 4;
  float pr[4] = {0.f, 0.f, 0.f, 0.f};
#pragma unroll
  for (int i = 0; i < 4; ++i) {
    const f32x4 wv = *(const f32x4*)(w + i * 256);
#pragma unroll
    for (int r = 0; r < 4; ++r)
      pr[r] += hv[r][i * 4] * wv.x + hv[r][i * 4 + 1] * wv.y + hv[r][i * 4 + 2] * wv.z + hv[r][i * 4 + 3] * wv.w;
  }
  const bool up = (lane & 32) != 0;
  float s0 = up ? pr[0] : pr[2], s1 = up ? pr[1] : pr[3];
  float k0 = up ? pr[2] : pr[0], k1 = up ? pr[3] : pr[1];
  k0 += __shfl_xor(s0, 32); k1 += __shfl_xor(s1, 32);
  const bool up2 = (lane & 16) != 0;
  float sv = up2 ? k0 : k1, kv = up2 ? k1 : k0;
  kv += __shfl_xor(sv, 16);
  kv += __shfl_xor(kv, 8); kv += __shfl_xor(kv, 4); kv += __shfl_xor(kv, 2); kv += __shfl_xor(kv, 1);
  return kv;
}
#define XB_TMO      128
#define XB_XCNT(j)  (256  + 64 * (j))
#define XB_XSUB(j)  (1280 + 64 * (j))
#define XB_XGEN(j)  (2304 + 64 * (j))
#define XB_TOP      3328
#define XB_TOPGEN   3392
#define XB_SPIN_CAP (1u << 20)
#define LAS __attribute__((address_space(3)))
DEVI unsigned xb_ld(unsigned* p) { return __hip_atomic_load(p, __ATOMIC_RELAXED, __HIP_MEMORY_SCOPE_AGENT); }
DEVI unsigned xb_add(unsigned* p, unsigned v) { return __hip_atomic_fetch_add(p, v, __ATOMIC_RELAXED, __HIP_MEMORY_SCOPE_AGENT); }
DEVI unsigned xb_xcc_id() { return (unsigned)__builtin_amdgcn_s_getreg((3 << 11) | 20) & 0xFu; }
#define XB_SPIN(cond, bar) do { unsigned _sp = 0; while (cond) { __builtin_amdgcn_s_sleep(1); \
    if ((++_sp & 255u) == 0u) { if (xb_ld(&(bar)[XB_TMO])) break; if (_sp > XB_SPIN_CAP) { atomicAdd(&(bar)[XB_TMO], 1u); break; } } } } while (0)
DEVI void xcd_barrier_post(unsigned* bar) {
  if (TIDX == 0) (void)xb_add(&bar[XB_XCNT(xb_xcc_id())], 1u);
}
DEVI void xcd_barrier_complete(unsigned* bar, unsigned x, unsigned& nloc, unsigned& nx) {
  const unsigned G = gridDim.x * gridDim.y * gridDim.z;
  unsigned sum, cnt, mine, sp = 0u;
  for (;;) {
    sum = 0u; cnt = 0u; mine = 0u;
#pragma unroll
    for (unsigned j = 0; j < 16; ++j) { const unsigned c = xb_ld(&bar[XB_XCNT(j)]); sum += c; cnt += (c > 0u) ? 1u : 0u; mine = (j == x) ? c : mine; }
    if (sum == G) break;
    __builtin_amdgcn_s_sleep(1);
    if ((++sp & 255u) == 0u) { if (xb_ld(&bar[XB_TMO])) break; if (sp > XB_SPIN_CAP) { atomicAdd(&bar[XB_TMO], 1u); break; } }
  }
  nloc = mine > 0u ? mine : 1u; nx = cnt > 0u ? cnt : 1u;
}
DEVI void xcd_barrier(unsigned* bar, volatile LAS unsigned* st) {
  asm volatile("s_waitcnt vmcnt(0)" ::: "memory");
  __syncthreads();
  if (TIDX == 0) {
    const unsigned x = xb_xcc_id();
    __builtin_amdgcn_s_waitcnt(0);
    unsigned nloc = st[0], nx = st[1];
    if (nloc == 0u) { xcd_barrier_complete(bar, x, nloc, nx); st[0] = nloc; st[1] = nx; }
    const unsigned old = xb_add(&bar[XB_XSUB(x)], 1u);
    const unsigned gen = old / nloc;
    if (old + 1u == (gen + 1u) * nloc) {
      __builtin_amdgcn_fence(__ATOMIC_RELEASE, "agent");
      asm volatile("s_waitcnt vmcnt(0)" ::: "memory");
      const unsigned og = xb_add(&bar[XB_TOP], 1u);
      const unsigned tg = og / nx;
      if (og + 1u == (tg + 1u) * nx) xb_add(&bar[XB_TOPGEN], 1u);
      else XB_SPIN(xb_ld(&bar[XB_TOPGEN]) == tg, bar);
      __builtin_amdgcn_fence(__ATOMIC_ACQUIRE, "agent");
      xb_add(&bar[XB_XGEN(x)], 1u);
      asm volatile("s_waitcnt vmcnt(0)" ::: "memory");
    } else {
      XB_SPIN(xb_ld(&bar[XB_XGEN(x)]) == gen, bar);
      __builtin_amdgcn_fence(__ATOMIC_ACQUIRE, "agent");
      asm volatile("s_waitcnt vmcnt(0)" ::: "memory");
    }
  }
  __syncthreads();
}

namespace v2 {
typedef LAS unsigned char* ldsp_t;
constexpr int BM = 256, BK = 64, HALF = 128, HTB = HALF * BK * 2, STAGE_BYTES = 8 * HTB;
constexpr int NW = 8;
constexpr int LDS_XTRA = STAGE_BYTES;
constexpr int LDS_BARW = STAGE_BYTES + 16384;
constexpr int LDS_TOTAL = LDS_BARW + 16;

DEVI int lds_byte(int r, int c) { const int st = (r >> 4) * 2 + (c >> 5), rr = r & 15, cc = c & 31, ob = rr * 64 + cc * 2; return st * 1024 + (ob ^ (((ob >> 9) & 1) << 5)); }
DEVI void stage_rc(int b, int& R, int& C) { const int st = b / 1024, sb = b % 1024, swz = sb ^ (((sb >> 9) & 1) << 5); R = (st >> 1) * 16 + swz / 64; C = (st & 1) * 32 + (swz % 64) / 2; }
DEVI int perm32(int rho) { const int n = rho >> 4, i = rho & 15; return 8 * (i >> 2) + 4 * n + (i & 3); }

DEVI void acc_zero(f32x4 (&acc)[2][2][4][2]) {
#pragma unroll
  for (int a = 0; a < 2; ++a)
#pragma unroll
    for (int b = 0; b < 2; ++b)
#pragma unroll
      for (int m = 0; m < 4; ++m)
#pragma unroll
        for (int n = 0; n < 2; ++n) acc[a][b][m][n] = (f32x4){0.f, 0.f, 0.f, 0.f};
}
struct Unit { const char* A; const char* B; const int* rows; int nvalid; int u0, u1, u2, u3; };

typedef int i32x8 __attribute__((ext_vector_type(8)));
typedef int i32x4v __attribute__((ext_vector_type(4)));
DEVI i32x8 cat8(bf16x8 lo, bf16x8 hi) { return __builtin_shufflevector(__builtin_bit_cast(i32x4v, lo), __builtin_bit_cast(i32x4v, hi), 0, 1, 2, 3, 4, 5, 6, 7); }
DEVI const char* sptr(const char* p) {
  const unsigned long long v = (unsigned long long)p;
  const unsigned lo = (unsigned)__builtin_amdgcn_readfirstlane((int)(unsigned)v), hi = (unsigned)__builtin_amdgcn_readfirstlane((int)(unsigned)(v >> 32));
  return (const char*)(((unsigned long long)hi << 32) | lo);
}
template <bool PERM, bool GATHER, bool F8, class Epi, class Sched>
DEVI void gemm_phase(ldsp_t lds, int lda_b, int ldb_b, int nt, const Sched& S, const Epi& E) {
  const int tid = TIDX, wid = __builtin_amdgcn_readfirstlane(tid >> 6), lane = tid & 63, wr = wid >> 2, wc = wid & 3, fr = lane & 15, fq = lane >> 4;
  unsigned voffA[2], voffB[2]; int RA[2], CA2[2];
#pragma unroll
  for (int i = 0; i < 2; ++i) {
    int R, C; stage_rc(tid * 16 + i * 8192, R, C);
    const int Rb = PERM ? ((R & ~31) + perm32(R & 31)) : R;
    RA[i] = R; CA2[i] = C * 2;
    voffA[i] = (unsigned)(R * lda_b + C * 2); voffB[i] = (unsigned)(Rb * ldb_b + C * 2);
  }
  const size_t kstep = (size_t)(BK * 2);
  const size_t hstepA = (size_t)HALF * lda_b, hstepB = (size_t)HALF * ldb_b;
  const unsigned ldsw = (unsigned)wid * 1024u, ldsbase = (unsigned)(size_t)lds;
  const int aoff = lds_byte(wr * 64 + fr, fq * 8), boff = lds_byte(wc * 32 + fr, fq * 8);
#define G_SA(b, h) (((b) * 2 + (h)) * HTB)
#define G_SB(b, h) ((4 + (b) * 2 + (h)) * HTB)
#define G_DMA(sbase, voff, ldsaddr) asm volatile("s_mov_b32 m0, %2\n\ts_nop 0\n\tglobal_load_lds_dwordx4 %0, %1" :: "v"(voff), "s"(sbase), "s"(ldsaddr) : "memory", "m0")
#define G_STAGE(bufoff, gbase, voff) do { const char* sb_ = sptr((const char*)(gbase)); _Pragma("unroll") for (int _i = 0; _i < 2; ++_i) \
    G_DMA(sb_, (voff)[_i], (unsigned)__builtin_amdgcn_readfirstlane((int)(ldsbase + (unsigned)(bufoff) + ldsw + (unsigned)_i * 8192u))); } while (0)
#define G_STAGE_A(bufoff, abase, go, h, koff) do { if (GATHER) { const char* sb_ = sptr((const char*)(abase) + (koff)); _Pragma("unroll") for (int _i = 0; _i < 2; ++_i) \
    G_DMA(sb_, (go)[h][_i], (unsigned)__builtin_amdgcn_readfirstlane((int)(ldsbase + (unsigned)(bufoff) + ldsw + (unsigned)_i * 8192u))); } \
    else G_STAGE(bufoff, (abase) + (h) * hstepA + (koff), voffA); } while (0)
#define G_LDA(dst, b, h) do { _Pragma("unroll") for (int m = 0; m < 4; ++m) { if (F8) dst##8[m] = cat8(*(const LAS bf16x8*)(lds + G_SA(b, h) + aoff + m * 2048), *(const LAS bf16x8*)(lds + G_SA(b, h) + aoff + m * 2048 + 1024)); \
    else { _Pragma("unroll") for (int k = 0; k < 2; ++k) dst[m][k] = *(const LAS bf16x8*)(lds + G_SA(b, h) + aoff + m * 2048 + k * 1024); } } } while (0)
#define G_LDB(dst, b, h) do { _Pragma("unroll") for (int n = 0; n < 2; ++n) { if (F8) dst##8[n] = cat8(*(const LAS bf16x8*)(lds + G_SB(b, h) + boff + n * 2048), *(const LAS bf16x8*)(lds + G_SB(b, h) + boff + n * 2048 + 1024)); \
    else { _Pragma("unroll") for (int k = 0; k < 2; ++k) dst[n][k] = *(const LAS bf16x8*)(lds + G_SB(b, h) + boff + n * 2048 + k * 1024); } } } while (0)
#define G_MMA(ai, bj, At, Bt) do { __builtin_amdgcn_s_setprio(1); _Pragma("unroll") for (int m = 0; m < 4; ++m) _Pragma("unroll") for (int n = 0; n < 2; ++n) { \
    if (F8) asm("v_mfma_scale_f32_16x16x128_f8f6f4 %0, %1, %2, %0, %3, %3 op_sel_hi:[0,0,0]" : "+v"(acc[ai][bj][m][n]) : "v"(Bt##8[n]), "v"(At##8[m]), "v"(f8scale)); \
    else { _Pragma("unroll") for (int k = 0; k < 2; ++k) acc[ai][bj][m][n] = __builtin_amdgcn_mfma_f32_16x16x32_bf16(Bt[n][k], At[m][k], acc[ai][bj][m][n], 0, 0, 0); } } \
    __builtin_amdgcn_s_setprio(0); } while (0)
#define G_WAIT_V(n) asm volatile("s_waitcnt vmcnt(" #n ")" ::: "memory")
#define G_WAIT_L(n) asm volatile("s_waitcnt lgkmcnt(" #n ")" ::: "memory")
#define G_BAR __builtin_amdgcn_s_barrier()
#define G_SCHED __builtin_amdgcn_sched_barrier(0)
  Unit cur, nxt; int ui = 0;
  if (!S.next(0, cur)) return;
  f32x4 acc[2][2][4][2];
  E.init(acc, cur, wr, wc, fr, fq);
  bf16x8 At[4][2], B0[2][2], B1[2][2];
  i32x8 At8[4], B08[2], B18[2];
  const int f8scale = 0x7f7f7f7f;
  unsigned gcur[2][2];
  auto gather_offs = [&](const Unit& u, unsigned (&go)[2][2]) {
#pragma unroll
    for (int h = 0; h < 2; ++h)
#pragma unroll
      for (int i = 0; i < 2; ++i) {
        const int r = h * HALF + RA[i];
        const int t = (r < u.nvalid) ? (u.rows[r] >> 1) : 0;
        go[h][i] = (unsigned)t * (unsigned)lda_b + (unsigned)CA2[i];
      }
  };
  if (GATHER) gather_offs(cur, gcur);
  const char* cA = cur.A; const char* cB = cur.B;
  G_STAGE(G_SB(0, 0), cB, voffB); G_STAGE_A(G_SA(0, 0), cA, gcur, 0, 0); G_STAGE(G_SB(0, 1), cB + hstepB, voffB); G_STAGE_A(G_SA(0, 1), cA, gcur, 1, 0);
  if (wr == 1) G_BAR;
  G_WAIT_V(4); G_BAR;
  G_STAGE(G_SB(1, 0), cB + kstep, voffB); G_STAGE_A(G_SA(1, 0), cA, gcur, 0, kstep); G_STAGE(G_SB(1, 1), cB + hstepB + kstep, voffB);
  G_WAIT_V(6); G_BAR;
  for (;;) {
    const bool has_next = S.next(ui + 1, nxt);
    const char* nA = has_next ? nxt.A : cA; const char* nB = has_next ? nxt.B : cB;
#pragma clang loop unroll(disable)
    for (int t = 0; t < nt; t += 2) {
      const bool last = (t == nt - 2);
      const size_t k1 = (size_t)(t + 1) * kstep;
      const char* a2 = last ? nA : cA; const char* b2 = last ? nB : cB + (size_t)(t + 2) * kstep;
      const size_t ka2 = last ? 0 : (size_t)(t + 2) * kstep;
      const char* b3 = b2 + kstep; const size_t ka3 = ka2 + kstep;
      unsigned gN[2][2];
      if (GATHER && last) {
        if (has_next) gather_offs(nxt, gN);
        else {
#pragma unroll
          for (int h = 0; h < 2; ++h)
#pragma unroll
            for (int i = 0; i < 2; ++i) gN[h][i] = gcur[h][i];
        }
      }
#define G_STAGE_A2(bufoff, h, koff) do { if (GATHER) { if (last) G_STAGE_A(bufoff, cA, gN, h, (koff) - ka2); else G_STAGE_A(bufoff, cA, gcur, h, koff); } \
        else G_STAGE_A(bufoff, a2, gcur, h, koff); } while (0)
      G_LDB(B0, 0, 0); G_SCHED; G_LDA(At, 0, 0); G_STAGE_A(G_SA(1, 1), cA, gcur, 1, k1);
      G_WAIT_L(8); G_BAR; G_WAIT_L(0); G_MMA(0, 0, At, B0); G_BAR; G_SCHED;
      G_LDB(B1, 0, 1); G_STAGE(G_SB(0, 0), b2, voffB);
      G_BAR; G_WAIT_L(0); G_MMA(0, 1, At, B1); G_BAR;
      G_LDA(At, 0, 1); G_STAGE_A2(G_SA(0, 0), 0, ka2);
      G_BAR; G_WAIT_L(0); G_MMA(1, 0, At, B0); G_BAR; G_SCHED;
      G_STAGE(G_SB(0, 1), b2 + hstepB, voffB);
      G_WAIT_V(6); G_BAR; G_MMA(1, 1, At, B1); G_BAR;
      G_LDB(B0, 1, 0); G_SCHED; G_LDA(At, 1, 0); G_STAGE_A2(G_SA(0, 1), 1, ka2);
      G_WAIT_L(8); G_BAR; G_WAIT_L(0); G_MMA(0, 0, At, B0); G_BAR; G_SCHED;
      G_LDB(B1, 1, 1); G_STAGE(G_SB(1, 0), b3, voffB);
      G_BAR; G_WAIT_L(0); G_MMA(0, 1, At, B1); G_BAR;
      G_LDA(At, 1, 1); G_STAGE_A2(G_SA(1, 0), 0, ka3);
      G_BAR; G_WAIT_L(0); G_MMA(1, 0, At, B0); G_BAR; G_SCHED;
      G_STAGE(G_SB(1, 1), b3 + hstepB, voffB);
      G_WAIT_V(6); G_BAR; G_MMA(1, 1, At, B1); G_BAR;
      if (GATHER && last) {
#pragma unroll
        for (int h = 0; h < 2; ++h)
#pragma unroll
          for (int i = 0; i < 2; ++i) gcur[h][i] = gN[h][i];
      }
#undef G_STAGE_A2
    }
    G_SCHED;
    if (F8) {
      asm volatile("s_nop 15\n\ts_nop 15" ::: "memory");
#pragma unroll
      for (int a_ = 0; a_ < 2; ++a_)
#pragma unroll
        for (int b_ = 0; b_ < 2; ++b_)
#pragma unroll
          for (int m_ = 0; m_ < 4; ++m_)
#pragma unroll
            for (int n_ = 0; n_ < 2; ++n_) asm volatile("" : "+v"(acc[a_][b_][m_][n_]));
    }
    E(acc, cur, wr, wc, fr, fq);
    G_SCHED;
    if (!has_next) break;
    cur = nxt; cA = nA; cB = nB; ++ui;
    E.init(acc, cur, wr, wc, fr, fq);
  }
  G_WAIT_V(0);
  if (wr == 0) G_BAR;
  G_BAR;
#undef G_SA
#undef G_SB
#undef G_STAGE
#undef G_DMA
#undef G_STAGE_A
#undef G_LDA
#undef G_LDB
#undef G_MMA
#undef G_WAIT_V
#undef G_WAIT_L
#undef G_BAR
#undef G_SCHED
}

DEVI unsigned uoff(unsigned x) { return (unsigned)__builtin_amdgcn_readfirstlane((int)x); }
DEVI bool tile_order(int i, int G, int c, int nM, int nN, int& pm, int& pn) {
  const int nwg = nM * nN;
  const long L = (long)i * G + c; if (L >= nwg) return false;
  int wgid = (int)L; { const int q = nwg / 8, r = nwg % 8, xcd = wgid % 8, off = wgid / 8; wgid = (xcd < r ? xcd * (q + 1) : r * (q + 1) + (xcd - r) * q) + off; }
  const int WGM = 8;
  const int nig = WGM * nN, gid = wgid / nig, fm = gid * WGM, gsz = (nM - fm) < WGM ? (nM - fm) : WGM;
  pm = fm + ((wgid % nig) % gsz); pn = (wgid % nig) / gsz;
  pm = __builtin_amdgcn_readfirstlane(pm); pn = __builtin_amdgcn_readfirstlane(pn);
  return true;
}
struct EpiRawBf16 {
  u16* O; int ldc; float sc;
  DEVI void init(f32x4 (&acc)[2][2][4][2], const Unit&, int, int, int, int) const { acc_zero(acc); }
  DEVI void operator()(const f32x4 (&acc)[2][2][4][2], const Unit& u, int wr, int wc, int fr, int fq) const {
    const unsigned off0 = ((unsigned)(u.u0 + wr * 64 + fr) * (unsigned)ldc + (unsigned)(u.u1 + wc * 32 + 8 * fq)) * 2u;
#pragma unroll
    for (int ai = 0; ai < 2; ++ai)
#pragma unroll
      for (int m = 0; m < 4; ++m) {
        char* rowp = (char*)O + (off0 + (unsigned)(ai * HALF + m * 16) * (unsigned)ldc * 2u);
#pragma unroll
        for (int bj = 0; bj < 2; ++bj) {
          const f32x4 v0 = acc[ai][bj][m][0] * sc, v1 = acc[ai][bj][m][1] * sc;
          u32x4 w; w.x = pk2(v0[0], v0[1]); w.y = pk2(v0[2], v0[3]); w.z = pk2(v1[0], v1[1]); w.w = pk2(v1[2], v1[3]);
          *(u32x4*)(rowp + bj * HALF * 2) = w;
        }
      }
  }
};

struct EpiRawF8 {
  unsigned char* O; int ldc; float sc;
  DEVI void init(f32x4 (&acc)[2][2][4][2], const Unit&, int, int, int, int) const { acc_zero(acc); }
  DEVI void operator()(const f32x4 (&acc)[2][2][4][2], const Unit& u, int wr, int wc, int fr, int fq) const {
    const unsigned off0 = (unsigned)(u.u0 + wr * 64 + fr) * (unsigned)ldc + (unsigned)(u.u1 + wc * 32 + 8 * fq);
#pragma unroll
    for (int ai = 0; ai < 2; ++ai)
#pragma unroll
      for (int m = 0; m < 4; ++m) {
        unsigned char* rowp = O + (off0 + (unsigned)(ai * HALF + m * 16) * (unsigned)ldc);
#pragma unroll
        for (int bj = 0; bj < 2; ++bj) {
          u32x2 w;
#pragma unroll
          for (int n = 0; n < 2; ++n) {
            const f32x4 v = acc[ai][bj][m][n] * sc;
            int q = __builtin_amdgcn_cvt_pk_fp8_f32(__builtin_amdgcn_fmed3f(v[0], -448.f, 448.f), __builtin_amdgcn_fmed3f(v[1], -448.f, 448.f), 0, false);
            q = __builtin_amdgcn_cvt_pk_fp8_f32(__builtin_amdgcn_fmed3f(v[2], -448.f, 448.f), __builtin_amdgcn_fmed3f(v[3], -448.f, 448.f), q, true);
            w[n] = (unsigned)q;
          }
          *(u32x2*)(rowp + bj * HALF) = w;
        }
      }
  }
};
DEVI size_t z8_block(int pm, int branch, int cb) { return (size_t)((pm * 4 + branch) * 8 + cb) * 32768; }
struct EpiZ8 {
  unsigned char* O;
  DEVI void init(f32x4 (&acc)[2][2][4][2], const Unit&, int, int, int, int) const { acc_zero(acc); }
  DEVI void operator()(const f32x4 (&acc)[2][2][4][2], const Unit& u, int wr, int wc, int fr, int fq) const {
    const int pm = u.u0 >> 8, pn = u.u1 >> 8, n = pn >> 2, cq = pn & 3;
    const unsigned lw16 = (unsigned)((wr * 4 + wc) * 64 + fr + 16 * fq) * 16u;
#pragma unroll
    for (int bj = 0; bj < 2; ++bj) {
      unsigned char* blk = O + z8_block(pm, n, cq * 2 + bj) + lw16;
#pragma unroll
      for (int P = 0; P < 4; ++P) {
        u32x4 w;
#pragma unroll
        for (int h = 0; h < 2; ++h)
#pragma unroll
          for (int nn = 0; nn < 2; ++nn) {
            const int g = 2 * P + h;
            const f32x4 v = acc[g >> 2][bj][g & 3][nn] * (Z8_SCALE / (O8_SCALE * F8_WSCALE));
            int q = __builtin_amdgcn_cvt_pk_fp8_f32(__builtin_amdgcn_fmed3f(v[0], -448.f, 448.f), __builtin_amdgcn_fmed3f(v[1], -448.f, 448.f), 0, false);
            q = __builtin_amdgcn_cvt_pk_fp8_f32(__builtin_amdgcn_fmed3f(v[2], -448.f, 448.f), __builtin_amdgcn_fmed3f(v[3], -448.f, 448.f), q, true);
            w[2 * h + nn] = (unsigned)q;
          }
        *(u32x4*)(blk + P * 8192) = w;
      }
    }
  }
};
struct SchedB { const char* ws; const char* h8; int G, c;
  DEVI bool next(int i, Unit& u) const { int pm, pn; if (!tile_order(i, G, c, NTOK / 256, INP / 256, pm, pn)) return false;
    u.A = h8 + uoff((unsigned)pm * 256u * 1024u); u.B = ws + OFF_WIN + uoff((unsigned)pn * 256u * 1024u);        u.rows = nullptr; u.nvalid = 0; u.u0 = pm * 256; u.u1 = pn * 256; u.u2 = 0; u.u3 = 0; return true; } };
struct EpiB { u16* O; float* ssq;
  DEVI void init(f32x4 (&acc)[2][2][4][2], const Unit&, int, int, int, int) const { acc_zero(acc); }
  DEVI void operator()(const f32x4 (&acc)[2][2][4][2], const Unit& u, int wr, int wc, int fr, int fq) const {
    EpiRawBf16 E{O, PLD, 1.f / F8_WSCALE}; E(acc, u, wr, wc, fr, fq);
    if (u.u1 < 512) {
      const bool iskv = u.u1 != 0;
#pragma unroll
      for (int ai = 0; ai < 2; ++ai)
#pragma unroll
        for (int m = 0; m < 4; ++m) {
          float ss = 0.f;
#pragma unroll
          for (int bj = 0; bj < 2; ++bj)
#pragma unroll
            for (int n = 0; n < 2; ++n)
#pragma unroll
              for (int j = 0; j < 4; ++j) { const float v = acc[ai][bj][m][n][j] * (1.f / F8_WSCALE); if (!(iskv && bj == 1)) ss += v * v; }
          ss += __shfl_xor(ss, 16); ss += __shfl_xor(ss, 32);
          if (fq == 0) ssq[(size_t)(u.u0 + ai * HALF + wr * 64 + m * 16 + fr) * 8 + (iskv ? 4 : 0) + wc] = ss;
        }
    }
  }
};
DEVI void phaseB2(KP p, ldsp_t lds) {
  SchedB S{(const char*)p->ws, (const char*)h8base(p), (int)gridDim.x, BIDX};
  EpiB E{wsp<u16>(p, OFF_PRAW), wsp<float>(p, OFF_SSQ)};
  gemm_phase<true, false, true>(lds, 1024, 1024, 8, S, E);
}
struct SchedC { const char* ws; int G, c;
  DEVI bool next(int i, Unit& u) const { int pm, pn; if (!tile_order(i, G, c, NTOK / 256, 4, pm, pn)) return false;
    const bool kv = pn >= 2; const int pj = pn & 1;
    u.A = ws + OFF_PRAW + uoff((unsigned)pm * 256u * (unsigned)(PLD * 2) + (kv ? 512u : 0u)); u.B = ws + (kv ? OFF_WKVB : OFF_WQB) + uoff((unsigned)pj * 256u * 512u); u.rows = nullptr; u.nvalid = 0;
    u.u0 = pm * 256; u.u1 = pj * 256; u.u2 = kv; u.u3 = 0; return true; } };
struct EpiC { u16* Oq; u16* Okv; const float* ssq;
  DEVI void init(f32x4 (&acc)[2][2][4][2], const Unit&, int, int, int, int) const { acc_zero(acc); }
  DEVI void operator()(const f32x4 (&acc)[2][2][4][2], const Unit& u, int wr, int wc, int fr, int fq) const {
    const bool kv = u.u2 != 0;
    u16* O = kv ? Okv : Oq;
    const int row0 = u.u0 + wr * 64 + fr, col0 = u.u1 + wc * 32 + 8 * fq;
    f32x4 sq[2][4];
#pragma unroll
    for (int ai = 0; ai < 2; ++ai)
#pragma unroll
      for (int m = 0; m < 4; ++m) sq[ai][m] = *(const f32x4*)(ssq + (size_t)(row0 + ai * HALF + m * 16) * 8 + (kv ? 4 : 0));
#pragma unroll
    for (int ai = 0; ai < 2; ++ai)
#pragma unroll
      for (int m = 0; m < 4; ++m) {
        const size_t r = (size_t)(row0 + ai * HALF + m * 16);
        const float tot = sq[ai][m].x + sq[ai][m].y + sq[ai][m].z + sq[ai][m].w;
        const float sc = kv ? rsqrtf(tot * (1.f / 128.f) + EPS) : rsqrtf(tot * (1.f / 256.f) + EPS) * (0.10206207261596575f * LOG2E);
        u16* rowp = O + r * 512 + col0;
#pragma unroll
        for (int bj = 0; bj < 2; ++bj) {
          const f32x4 v0 = acc[ai][bj][m][0] * sc, v1 = acc[ai][bj][m][1] * sc;
          u32x4 w; w.x = pk2(v0[0], v0[1]); w.y = pk2(v0[2], v0[3]); w.z = pk2(v1[0], v1[1]); w.w = pk2(v1[2], v1[3]);
          *(u32x4*)(rowp + bj * HALF) = w;
        }
      }
  }
};
DEVI void phaseC2(KP p, ldsp_t lds) {
  SchedC S{(const char*)p->ws, (int)gridDim.x, BIDX};
  EpiC E{wsp<u16>(p, OFF_QARAW), wsp<u16>(p, OFF_KVARAW), wsp<float>(p, OFF_SSQ)};
  int nt = 4; asm volatile("" : "+s"(nt));
  gemm_phase<true, false, false>(lds, PLD * 2, 512, nt, S, E);
}

DEVI void ld16(const u16* src, float (&v)[16]) {
  const u32x4 a = *(const u32x4*)src, b = *(const u32x4*)(src + 8);
  const unsigned w[8] = {a.x, a.y, a.z, a.w, b.x, b.y, b.z, b.w};
#pragma unroll
  for (int i = 0; i < 8; ++i) { v[2 * i] = __uint_as_float(w[i] << 16); v[2 * i + 1] = __uint_as_float(w[i] & 0xffff0000u); }
}
DEVI void st16(u16* dst, const float (&v)[16]) {
  u32x4 a, b;
  a.x = pk2(v[0], v[1]); a.y = pk2(v[2], v[3]); a.z = pk2(v[4], v[5]); a.w = pk2(v[6], v[7]);
  b.x = pk2(v[8], v[9]); b.y = pk2(v[10], v[11]); b.z = pk2(v[12], v[13]); b.w = pk2(v[14], v[15]);
  *(u32x4*)dst = a; *(u32x4*)(dst + 8) = b;
}
DEVI void rope16c(float (&v)[16], const float* cs16, int pos) {
  const f32x2* t = (const f32x2*)(cs16 + pos * 16);
#pragma unroll
  for (int i = 0; i < 8; ++i) { const f32x2 cs = t[i]; const float x1 = v[i], x2 = v[8 + i]; v[i] = x1 * cs.x - x2 * cs.y; v[8 + i] = x2 * cs.x + x1 * cs.y; }
}
DEVI void rope32c(float (&lo)[16], float (&hi)[16], const float* cs32, int pos) {
  const f32x2* t = (const f32x2*)(cs32 + pos * 32);
#pragma unroll
  for (int i = 0; i < 16; ++i) { const f32x2 cs = t[i]; const float x1 = lo[i], x2 = hi[i]; lo[i] = x1 * cs.x - x2 * cs.y; hi[i] = x2 * cs.x + x1 * cs.y; }
}
DEVI float ssq16(const float (&v)[16]) { float s = 0.f;
#pragma unroll
  for (int i = 0; i < 16; ++i) s += v[i] * v[i];
  return s; }
DEVI void scale16(float (&v)[16], float s) {
#pragma unroll
  for (int i = 0; i < 16; ++i) v[i] *= s; }
DEVI void cvt16(const u32x4 a, const u32x4 b, float (&v)[16]) {
  const unsigned w[8] = {a.x, a.y, a.z, a.w, b.x, b.y, b.z, b.w};
#pragma unroll
  for (int i = 0; i < 8; ++i) { v[2 * i] = __uint_as_float(w[i] << 16); v[2 * i + 1] = __uint_as_float(w[i] & 0xffff0000u); }
}
DEVI void phaseP2(KP p, int l, ldsp_t lds) {
  const int tid = TIDX, tk = tid >> 3, pt = tid & 7;
  u16* PR = wsp<u16>(p, OFF_PRAW);
  u16* QA = wsp<u16>(p, OFF_QARAW);
  const float* cs32 = wsp<float>(p, OFF_CS32);
  const float* cs16 = wsp<float>(p, OFF_CS16);
  const float QS = 0.125f * LOG2E;
  for (int item = BIDX; item < NTOK / 64; item += gridDim.x) {
    const int tok0 = item * 64, rr0 = tok0 % TPB;
    const bool lat = rr0 >= NCTX;
    const size_t tok = (size_t)tok0 + tk;
    const int t = rr0 + tk - NCTX, grow = (t >> 6) & 63, gcol = t & 63;
    u16* pr = PR + tok * PLD;
    u16* qar = QA + tok * 512 + 96 * (pt >> 1) + 64 + 16 * (pt & 1);
    const int g4 = pt & 3;
    u32x4 r_qa[2], r_kr[2], r_qb[4], r_kb[4], r_qd[4], r_kd[4];
#define LD8(ptr) (*(const u32x4*)(ptr))
    if (lat) {
#pragma unroll
      for (int i = 0; i < 2; ++i) { r_qa[i] = LD8(qar + 8 * i); r_kr[i] = LD8(pr + 384 + 16 * (pt & 1) + 8 * i); }
#pragma unroll
      for (int i = 0; i < 4; ++i) { r_qb[i] = LD8(pr + 512 + 32 * pt + 8 * i); r_kb[i] = LD8(pr + 768 + 32 * g4 + 8 * i); }
    }
#pragma unroll
    for (int i = 0; i < 4; ++i) { r_qd[i] = LD8(pr + 1792 + 32 * pt + 8 * i); r_kd[i] = LD8(pr + 2048 + 32 * g4 + 8 * i); }
#undef LD8
    if (lat) {
      { float v[16]; cvt16(r_qa[0], r_qa[1], v); rope16c(v, cs16, (pt & 1) ? gcol : grow); st16(qar, v); }
      if (pt < 2) { float v[16]; cvt16(r_kr[0], r_kr[1], v); rope16c(v, cs16, pt == 0 ? grow : gcol); st16(pr + 384 + 16 * pt, v); }
      { float lo[16], hi[16]; cvt16(r_qb[0], r_qb[1], lo); cvt16(r_qb[2], r_qb[3], hi); rope32c(lo, hi, cs32, (pt & 1) ? gcol : grow); st16(pr + 512 + 32 * pt, lo); st16(pr + 512 + 32 * pt + 16, hi); }
      if (pt < 4) { float lo[16], hi[16]; cvt16(r_kb[0], r_kb[1], lo); cvt16(r_kb[2], r_kb[3], hi); rope32c(lo, hi, cs32, (pt & 1) ? gcol : grow); st16(pr + 768 + 32 * pt, lo); st16(pr + 768 + 32 * pt + 16, hi); }
    }
    {
      float lo[16], hi[16]; cvt16(r_qd[0], r_qd[1], lo); cvt16(r_qd[2], r_qd[3], hi);
      float ss = ssq16(lo) + ssq16(hi); ss += __shfl_xor(ss, 1);
      const float rs = rsqrtf(ss * (1.f / 64.f) + EPS);
      const float* g = p->g_q_d + l * 64 + 32 * (pt & 1);
#pragma unroll
      for (int i = 0; i < 16; ++i) { lo[i] *= rs * g[i]; hi[i] *= rs * g[16 + i]; }
      if (lat) rope32c(lo, hi, cs32, (pt & 1) ? gcol : grow);
      scale16(lo, QS); scale16(hi, QS);
      st16(pr + 1792 + 32 * pt, lo); st16(pr + 1792 + 32 * pt + 16, hi);
    }
    {
      float lo[16], hi[16]; cvt16(r_kd[0], r_kd[1], lo); cvt16(r_kd[2], r_kd[3], hi);
      float ss = ssq16(lo) + ssq16(hi); ss += __shfl_xor(ss, 1);
      const float rs = rsqrtf(ss * (1.f / 64.f) + EPS);
      const float* g = p->g_k_d + l * 64 + 32 * (g4 & 1);
#pragma unroll
      for (int i = 0; i < 16; ++i) { lo[i] *= rs * g[i]; hi[i] *= rs * g[16 + i]; }
      if (lat) rope32c(lo, hi, cs32, (g4 & 1) ? gcol : grow);
      if (pt < 4) { st16(pr + 2048 + 32 * g4, lo); st16(pr + 2048 + 32 * g4 + 16, hi); }
    }
  }
}

DEVI void conv_load(const ConvT& c, int lane, f32x4 (&v)[8]) {
  const int kk = lane >> 3, n4 = (lane & 7) * 4;
  const float* sp = (c.src2 && n4 >= 16) ? c.src2 + (n4 - 16) : (c.src ? c.src + n4 : nullptr);
#pragma unroll
  for (int i = 0; i < 8; ++i) v[i] = sp ? *(const f32x4*)(sp + (size_t)(kk + 8 * i) * c.ld) : f32x4{0.f, 0.f, 0.f, 0.f};
}
DEVI void conv_store(const ConvT& c, LAS float* t, int lane, const f32x4 (&v)[8]) {
  const int kk = lane >> 3, n4 = (lane & 7) * 4;
#pragma unroll
  for (int i = 0; i < 8; ++i) {
    const int k = kk + 8 * i;
    const float s = (c.ks ? c.ks[k] : 1.f) * c.mul;
    t[(n4 + 0) * 65 + k] = v[i].x * s; t[(n4 + 1) * 65 + k] = v[i].y * s;
    t[(n4 + 2) * 65 + k] = v[i].z * s; t[(n4 + 3) * 65 + k] = v[i].w * s;
  }
  asm volatile("s_waitcnt lgkmcnt(0)" ::: "memory");
  const int n = lane >> 1, k0 = (lane & 1) * 32;
  const LAS float* r = t + n * 65 + k0;
  if (c.ldd < 0) {
    unsigned char* d8 = (unsigned char*)c.dst + (size_t)n * (size_t)(-c.ldd) + k0;
#pragma unroll
    for (int q = 0; q < 2; ++q) {
      u32x4 o;
#pragma unroll
      for (int w = 0; w < 4; ++w) {
        float f[4];
#pragma unroll
        for (int j = 0; j < 4; ++j) f[j] = __builtin_amdgcn_fmed3f(r[16 * q + 4 * w + j], -448.f, 448.f);
        int v = __builtin_amdgcn_cvt_pk_fp8_f32(f[0], f[1], 0, false);
        v = __builtin_amdgcn_cvt_pk_fp8_f32(f[2], f[3], v, true);
        o[w] = (unsigned)v;
      }
      *(u32x4*)(d8 + 16 * q) = o;
    }
    asm volatile("s_waitcnt lgkmcnt(0)" ::: "memory");
    return;
  }
  u16* d = c.dst + (size_t)n * c.ldd + k0;
#pragma unroll
  for (int q = 0; q < 4; ++q) {
    u32x4 o;
    o.x = pk2(r[8 * q], r[8 * q + 1]); o.y = pk2(r[8 * q + 2], r[8 * q + 3]); o.z = pk2(r[8 * q + 4], r[8 * q + 5]); o.w = pk2(r[8 * q + 6], r[8 * q + 7]);
    *(u32x4*)(d + 8 * q) = o;
  }
  asm volatile("s_waitcnt lgkmcnt(0)" ::: "memory");
}
constexpr int CONV_EARLY = 1152 + 64 + 64;
DEVI void conv_items2(KP p, int l, ldsp_t lds, int first_item, int total_items) {
  const int tid = TIDX, wave = __builtin_amdgcn_readfirstlane(tid >> 6), lane = tid & 63;
  LAS float* t = (LAS float*)(lds + wave * 8448);
  __syncthreads();
  const int stride = gridDim.x * NW;
  int item = first_item + BIDX * NW + wave;
  if (item >= total_items) return;
  ConvT c = conv_decode(p, l, item);
  f32x4 v[8];
  conv_load(c, lane, v);
  for (;;) {
    const int nitem = item + stride;
    const bool more = nitem < total_items;
    ConvT cn = c; f32x4 vn[8];
    if (more) { cn = conv_decode(p, l, nitem); conv_load(cn, lane, vn); }
    conv_store(c, t, lane, v);
    if (!more) break;
    c = cn; item = nitem;
#pragma unroll
    for (int i = 0; i < 8; ++i) v[i] = vn[i];
  }
}
template <int BR>
DEVI void attn_mask(f32x16 (&s)[2], int kt, int qlat, int qrow, int qcol, int hh, LAS float* rpb) {
  if (BR == 1) {
#pragma unroll
    for (int kb = 0; kb < 2; ++kb)
#pragma unroll
      for (int i = 0; i < 16; ++i) {
        const int kpos = kt * 64 + kb * 32 + (i & 3) + 8 * (i >> 2) + 4 * hh;
        const int d = qlat - kpos;
        if (d > 128 || d < -128) s[kb][i] = -1e30f;
      }
  } else {
    const int rs = min(max(qrow - 4, 0), 56);
    const bool row_ok = (kt >= rs) && (kt < rs + 8);
    const int cst = min(max(qcol - 8, 0), 48);
    const int dr = kt - qrow + 7;
#pragma unroll
    for (int kb = 0; kb < 2; ++kb)
#pragma unroll
      for (int i = 0; i < 16; ++i) {
        const int kc = kb * 32 + (i & 3) + 8 * (i >> 2) + 4 * hh;
        const bool ok = row_ok && (kc >= cst) && (kc < cst + 16);
        const int idx = ok ? (dr * 31 + (kc - qcol + 15)) : 0;
        const float bias = rpb[idx];
        s[kb][i] = ok ? (s[kb][i] + bias) : -1e30f;
      }
  }
}

template <int BR>
DEVI void attn_mask1(f32x16& sb, int kb, int kt, int qlat, int qrow, int qcol, int hh, LAS float* rpb) {
  if (BR == 1) {
#pragma unroll
    for (int i = 0; i < 16; ++i) {
      const int kpos = kt * 64 + kb * 32 + (i & 3) + 8 * (i >> 2) + 4 * hh;
      const int d = qlat - kpos;
      if (d > 128 || d < -128) sb[i] = -1e30f;
    }
  } else {
    const int rs = min(max(qrow - 4, 0), 56);
    const bool row_ok = (kt >= rs) && (kt < rs + 8);
    const int cst = min(max(qcol - 8, 0), 48);
    const int dr = kt - qrow + 7;
#pragma unroll
    for (int i = 0; i < 16; ++i) {
      const int kc = kb * 32 + (i & 3) + 8 * (i >> 2) + 4 * hh;
      const bool ok = row_ok && (kc >= cst) && (kc < cst + 16);
      const int idx = ok ? (dr * 31 + (kc - qcol + 15)) : 0;
      const float bias = rpb[idx];
      sb[i] = ok ? (sb[i] + bias) : -1e30f;
    }
  }
}
#define FADD(a, b) do { (a) += (b); asm("" : "+v"(a)); } while (0)
typedef short v4i16_t __attribute__((ext_vector_type(4)));
DEVI bf16x8 vtr2(ldsp_t a) {
  const v4i16_t lo = __builtin_amdgcn_ds_read_tr16_b64_v4i16((LAS v4i16_t*)a);
  const v4i16_t hi = __builtin_amdgcn_ds_read_tr16_b64_v4i16((LAS v4i16_t*)(a + 8 * 144));
  return __builtin_shufflevector(lo, hi, 0, 1, 2, 3, 4, 5, 6, 7);
}
DEVI bf16x8 vtr2s(ldsp_t a, int o0, int o1) {
  const v4i16_t lo = __builtin_amdgcn_ds_read_tr16_b64_v4i16((LAS v4i16_t*)(a + o0));
  const v4i16_t hi = __builtin_amdgcn_ds_read_tr16_b64_v4i16((LAS v4i16_t*)(a + 8 * 128 + o1));
  return __builtin_shufflevector(lo, hi, 0, 1, 2, 3, 4, 5, 6, 7);
}
template <int BR, bool FAST>
DEVI bool attn_item2(KP p, int l, int b, int hs, int qb, bool isctx, ldsp_t lds) {
  constexpr bool MLA = (BR == 0);
  constexpr bool GQA = (BR == 1 || BR == 3);
  constexpr int QBLK = GQA ? 256 : 512;
  constexpr int NKS = MLA ? 6 : 4;
  constexpr int STG = 8192 + 8192 + 4096;
  const int tid = TIDX, lane = tid & 63, wave = __builtin_amdgcn_readfirstlane(tid >> 6);
  const int r32 = lane & 31, hh = lane >> 5;
  const int hq = GQA ? (hs * 2 + (wave & 1)) : hs;
  const int woff = GQA ? 64 * (wave >> 1) : 64 * wave;
  const int q0 = (isctx ? 0 : NCTX) + qb * QBLK;
  const bool active = !isctx || (woff < NCTX);
  const size_t tokq = (size_t)b * TPB + q0 + (active ? woff : 0) + r32;
  const u16* Qp; const u16* Kp; int ldk; const u16* Vp; int ldv; int obase; int ldq;
  const u16* PR = wsp<u16>(p, OFF_PRAW);
  if (BR == 0) { Qp = wsp<u16>(p, OFF_QARAW) + tokq * 512 + hq * 96; ldq = 512; Kp = wsp<u16>(p, OFF_KVARAW) + (size_t)b * TPB * 512 + hs * 128; ldk = 512; Vp = wsp<u16>(p, OFF_KVARAW) + (size_t)b * TPB * 512 + hs * 128 + 64; ldv = 512; obase = hq * 64; }
  else if (BR == 1) { Qp = PR + tokq * PLD + 512 + hq * 64; ldq = PLD; Kp = PR + (size_t)b * TPB * PLD + 768 + hs * 64; ldk = PLD; Vp = PR + (size_t)b * TPB * PLD + 896 + hs * 64; ldv = PLD; obase = 256 + hq * 64; }
  else if (BR == 2) { Qp = PR + tokq * PLD + 1024 + hq * 64; ldq = PLD; Kp = PR + (size_t)b * TPB * PLD + 1280 + hs * 64; ldk = PLD; Vp = PR + (size_t)b * TPB * PLD + 1536 + hs * 64; ldv = PLD; obase = 512 + hq * 64; }
  else { Qp = PR + tokq * PLD + 1792 + hq * 64; ldq = PLD; Kp = PR + (size_t)b * TPB * PLD + 2048 + hs * 64; ldk = PLD; Vp = PR + (size_t)b * TPB * PLD + 2176 + hs * 64; ldv = PLD; obase = 768 + hq * 64; }
  const u16* KRp = PR + (size_t)b * TPB * PLD + 384;
  int lat_lo = 0, lat_n = 0, wlo = 0, whi = 63;
  if (!isctx) {
    if (BR == 0 || BR == 3) { lat_lo = 0; lat_n = 64; }
    else if (BR == 1) {
      const int ql = qb * QBLK; const int lo = max(0, ql - 128) >> 6, hi = min(SEQ - 1, ql + QBLK - 1 + 128) >> 6; lat_lo = lo; lat_n = hi - lo + 1;
      const int wq = ql + woff; wlo = max(0, wq - 128) >> 6; whi = min(SEQ - 1, wq + 63 + 128) >> 6;
    } else {
      const int r0 = 8 * qb; const int lo = min(max(r0 - 4, 0), 56), hi = min(max(r0 + 7 - 4, 0), 56) + 7; lat_lo = lo; lat_n = hi - lo + 1;
      const int wr_ = r0 + wave; wlo = min(max(wr_ - 4, 0), 56); whi = wlo + 7;
    }
  }
  const int NT = 4 + lat_n;
  const int qlat0 = qb * QBLK + woff + r32;
  bf16x8 qf[2][NKS];
#pragma unroll
  for (int qi = 0; qi < 2; ++qi)
#pragma unroll
    for (int ks = 0; ks < NKS; ++ks) qf[qi][ks] = *(const bf16x8*)(Qp + (size_t)qi * 32 * ldq + ks * 16 + hh * 8);
  const int drow = 8 * wave + (lane >> 3), dch = (lane & 7) ^ ((drow >> 1) & 7);
  const int rrow = 16 * (wave & 3) + (lane >> 2), rch = (lane & 3) ^ ((rrow >> 2) & 3);
  auto keytile = [&](int j) { return (j < 4) ? j : (4 + lat_lo + (j - 4)); };
#define DMA16(sbase, voff, ldsaddr) asm volatile("s_mov_b32 m0, %2\n\ts_nop 0\n\tglobal_load_lds_dwordx4 %0, %1" :: "v"(voff), "s"(sbase), "s"(ldsaddr) : "memory", "m0")
#define A_DMA(j, st) do { const int key0_ = keytile(j) * 64; const unsigned base_ = __builtin_amdgcn_readfirstlane((unsigned)(size_t)(lds + (st) * STG) + wave * 1024); \
    DMA16(Kp, (unsigned)(((key0_ + drow) * ldk + dch * 8) * 2), base_); \
    DMA16(Vp, (unsigned)(((key0_ + drow) * ldv + dch * 8) * 2), base_ + 8192u); \
    if (MLA && wave < 4) DMA16(KRp, (unsigned)(((key0_ + rrow) * PLD + rch * 8) * 2), __builtin_amdgcn_readfirstlane(base_ + 16384u)); \
  } while (0)
  LAS float* rpb = (LAS float*)(lds + 2 * STG);
  __syncthreads();
  if (FAST && tid == 0) *(LAS int*)(lds + 2 * STG + 2048) = 0;
  A_DMA(0, 0);
  if (BR == 2 && !isctx) {
    const float* src = p->rpb_c + (size_t)(l * 4 + hs) * 465;
    for (int i = tid; i < 465; i += 512) rpb[i] = src[i] * LOG2E;
  }
  asm volatile("s_waitcnt vmcnt(0)" ::: "memory");
#pragma unroll
  for (int qi = 0; qi < 2; ++qi)
#pragma unroll
    for (int ks = 0; ks < NKS; ++ks) asm volatile("" : "+v"(qf[qi][ks]));
  __syncthreads();
  f32x16 o[2][2];
#pragma unroll
  for (int qi = 0; qi < 2; ++qi)
#pragma unroll
    for (int i = 0; i < 16; ++i) { o[qi][0][i] = 0.f; o[qi][1][i] = 0.f; }
  float m_run[2], l_run[2];
#pragma unroll
  for (int qi = 0; qi < 2; ++qi) { m_run[qi] = -INFINITY; l_run[qi] = 0.f; }
  if (BR == 1) { const float sk = p->sink_b[l * 4 + hq] * LOG2E; m_run[0] = sk; m_run[1] = sk; l_run[0] = (hh == 0) ? (FAST ? __builtin_amdgcn_exp2f(sk) : 1.f) : 0.f; l_run[1] = l_run[0]; }
  float l2[2][2];
#pragma unroll
  for (int qi = 0; qi < 2; ++qi) { l2[qi][0] = l_run[qi]; l2[qi][1] = 0.f; }
  const int kkey = (r32 >> 1) & 7, rkey = (r32 >> 2) & 3;
  const ldsp_t kfb = lds + r32 * 128;
  const ldsp_t krb = lds + 16384 + r32 * 64;
  const int vq = (lane & 15) >> 2, vkey = 2 * hh + (vq >> 1);
  const int vch = 2 * ((lane >> 4) & 1) + ((lane & 3) >> 1);
  const ldsp_t vfb = lds + 8192 + (4 * hh + vq) * 128 + 8 * (lane & 1);
#define SB() __builtin_amdgcn_sched_barrier(0)
#define KLOAD(kb, ks) (((ks) < 4) ? *(const LAS bf16x8*)(kfb + st + (kb) * 4096 + (((2 * (ks) + hh) ^ kkey) << 4)) : *(const LAS bf16x8*)(krb + st + (kb) * 2048 + (((2 * ((ks) - 4) + hh) ^ rkey) << 4)))
#define VLOAD(s4, db) vtr2s(vfb + st + (s4) * 2048, ((4 * (db) + vch) ^ vkey) << 4, ((4 * (db) + vch) ^ vkey ^ 4) << 4)
#define SM_EL(kb, e) do { const int qi_ = (e) >> 4, i_ = (e) & 15; \
    const float x_ = __builtin_amdgcn_exp2f(s[qi_][kb][i_]); s[qi_][kb][i_] = x_; FADD(l2[qi_][i_ & 1], x_); \
    if (i_ & 1) pw[kb][qi_][i_ >> 3][(i_ & 7) >> 1] = pk2(s[qi_][kb][i_ - 1], x_); } while (0)
#define F_STEP(j) do { \
    const int st = ((j) & 1) * STG; \
    if ((j) + 1 < NT) A_DMA((j) + 1, ((j) + 1) & 1); \
    const int kt_ = lat_lo + (j) - 4; \
    const bool need = active && ((j) < 4 || (kt_ >= wlo && kt_ <= whi)); \
    if (need) { \
      f32x16 s[2][2]; bf16x8 kf[NKS]; bf16x8 vf[4]; u32x4 pw[2][2][2]; \
      const f32x16 zero16 = {0.f, 0.f, 0.f, 0.f, 0.f, 0.f, 0.f, 0.f, 0.f, 0.f, 0.f, 0.f, 0.f, 0.f, 0.f, 0.f}; \
      const bool domask = (BR == 1 || BR == 2) && (j) >= 4; \
      _Pragma("unroll") for (int ks = 0; ks < NKS; ++ks) kf[ks] = KLOAD(0, ks); \
      _Pragma("unroll") for (int ks = 0; ks < NKS; ++ks) { \
        s[0][0] = MFMA(kf[ks], qf[0][ks], ks == 0 ? zero16 : s[0][0]); s[1][0] = MFMA(kf[ks], qf[1][ks], ks == 0 ? zero16 : s[1][0]); \
        SB(); kf[ks] = KLOAD(1, ks); SB(); } \
      if (domask) { _Pragma("unroll") for (int qi = 0; qi < 2; ++qi) { const int ql_ = qlat0 + 32 * qi; attn_mask1<BR>(s[qi][0], 0, kt_, ql_, ql_ >> 6, ql_ & 63, hh, rpb); } } \
      _Pragma("unroll") for (int m = 0; m < 2 * NKS; ++m) { \
        s[m & 1][1] = MFMA(kf[m >> 1], qf[m & 1][m >> 1], (m >> 1) == 0 ? zero16 : s[m & 1][1]); \
        if (m < 4) vf[m] = VLOAD(m >> 1, m & 1); \
        _Pragma("unroll") for (int e = (m * 32) / (2 * NKS); e < ((m + 1) * 32) / (2 * NKS); ++e) SM_EL(0, e); \
        SB(); } \
      if (domask) { _Pragma("unroll") for (int qi = 0; qi < 2; ++qi) { const int ql_ = qlat0 + 32 * qi; attn_mask1<BR>(s[qi][1], 1, kt_, ql_, ql_ >> 6, ql_ & 63, hh, rpb); } } \
      _Pragma("unroll") for (int m = 0; m < 8; ++m) { \
        o[m & 1][(m >> 1) & 1] = MFMA(vf[m >> 1], __builtin_bit_cast(bf16x8, pw[0][m & 1][m >> 2]), o[m & 1][(m >> 1) & 1]); \
        if (m & 1) { SB(); vf[m >> 1] = VLOAD(2 + (m >> 2), (m >> 1) & 1); } \
        _Pragma("unroll") for (int e = 4 * m; e < 4 * m + 4; ++e) SM_EL(1, e); \
        SB(); } \
      _Pragma("unroll") for (int m = 0; m < 8; ++m) \
        o[m & 1][(m >> 1) & 1] = MFMA(vf[m >> 1], __builtin_bit_cast(bf16x8, pw[1][m & 1][m >> 2]), o[m & 1][(m >> 1) & 1]); \
    } \
    asm volatile("s_waitcnt vmcnt(0)" ::: "memory"); \
    __syncthreads(); \
  } while (0)
#define A_STEP(j) do { \
    const int st = ((j) & 1) * STG; \
    if ((j) + 1 < NT) A_DMA((j) + 1, ((j) + 1) & 1); \
    const int kt_ = lat_lo + (j) - 4; \
    const bool need = active && ((j) < 4 || (kt_ >= wlo && kt_ <= whi)); \
    if (need) { \
      f32x16 s[2][2]; \
      _Pragma("unroll") for (int kb = 0; kb < 2; ++kb) { \
        _Pragma("unroll") for (int ks = 0; ks < 4; ++ks) { const bf16x8 kf = *(const LAS bf16x8*)(kfb + st + kb * 4096 + (((2 * ks + hh) ^ kkey) << 4)); \
          _Pragma("unroll") for (int qi = 0; qi < 2; ++qi) { if (ks == 0) { _Pragma("unroll") for (int i = 0; i < 16; ++i) s[qi][kb][i] = 0.f; } s[qi][kb] = MFMA(kf, qf[qi][ks], s[qi][kb]); } } \
        if (MLA) { _Pragma("unroll") for (int ks = 0; ks < 2; ++ks) { const bf16x8 kf = *(const LAS bf16x8*)(krb + st + kb * 2048 + (((2 * ks + hh) ^ rkey) << 4)); \
          _Pragma("unroll") for (int qi = 0; qi < 2; ++qi) s[qi][kb] = MFMA(kf, qf[qi][NKS - 2 + ks], s[qi][kb]); } } \
      } \
      if (FAST) __builtin_amdgcn_sched_barrier(0); \
      _Pragma("unroll") for (int qi = 0; qi < 2; ++qi) { \
        if ((BR == 1 || BR == 2) && (j) >= 4) { const int ql_ = qlat0 + 32 * qi; attn_mask<BR>(s[qi], kt_, ql_, ql_ >> 6, ql_ & 63, hh, rpb); } \
        if (FAST) { \
          float ls0 = 0.f, ls1 = 0.f; \
          _Pragma("unroll") for (int i = 0; i < 16; ++i) { \
            const float e0 = __builtin_amdgcn_exp2f(s[qi][0][i]), e1 = __builtin_amdgcn_exp2f(s[qi][1][i]); \
            s[qi][0][i] = e0; s[qi][1][i] = e1; FADD(ls0, e0); FADD(ls1, e1); } \
          l_run[qi] += ls0 + ls1; \
        } else { \
        float mx = s[qi][0][0]; \
        _Pragma("unroll") for (int i = 1; i < 16; ++i) mx = fmaxf(mx, s[qi][0][i]); \
        _Pragma("unroll") for (int i = 0; i < 16; ++i) mx = fmaxf(mx, s[qi][1][i]); \
        mx = fmaxf(mx, __shfl_xor(mx, 32)); \
        const float m_new = fmaxf(m_run[qi], mx); \
        const float alpha = __builtin_amdgcn_exp2f(m_run[qi] - m_new); \
        m_run[qi] = m_new; \
        float ls0 = 0.f, ls1 = 0.f; \
        _Pragma("unroll") for (int i = 0; i < 16; ++i) { \
          const float e0 = __builtin_amdgcn_exp2f(s[qi][0][i] - m_new), e1 = __builtin_amdgcn_exp2f(s[qi][1][i] - m_new); \
          s[qi][0][i] = e0; s[qi][1][i] = e1; ls0 += e0; ls1 += e1; } \
        l_run[qi] = l_run[qi] * alpha + (ls0 + ls1); \
        if (__any(alpha != 1.f)) { _Pragma("unroll") for (int i = 0; i < 16; ++i) { o[qi][0][i] *= alpha; o[qi][1][i] *= alpha; } } \
        } \
      } \
      _Pragma("unroll") for (int s4 = 0; s4 < 4; ++s4) { \
        const int kb = s4 >> 1, rb = (s4 & 1) * 8; \
        bf16x8 pf[2]; \
        _Pragma("unroll") for (int qi = 0; qi < 2; ++qi) { u32x4 pw; \
          pw.x = pk2(s[qi][kb][rb + 0], s[qi][kb][rb + 1]); pw.y = pk2(s[qi][kb][rb + 2], s[qi][kb][rb + 3]); \
          pw.z = pk2(s[qi][kb][rb + 4], s[qi][kb][rb + 5]); pw.w = pk2(s[qi][kb][rb + 6], s[qi][kb][rb + 7]); \
          pf[qi] = __builtin_bit_cast(bf16x8, pw); } \
        _Pragma("unroll") for (int db = 0; db < 2; ++db) { const bf16x8 vf = vtr2s(vfb + st + s4 * 2048, ((4 * db + vch) ^ vkey) << 4, ((4 * db + vch) ^ vkey ^ 4) << 4); \
          o[0][db] = MFMA(vf, pf[0], o[0][db]); o[1][db] = MFMA(vf, pf[1], o[1][db]); } \
      } \
    } \
    asm volatile("s_waitcnt vmcnt(0)" ::: "memory");        \
    __syncthreads(); \
  } while (0)
  if (FAST) {
    if (wave >= 4) __builtin_amdgcn_s_setprio(1);
    for (int j = 0; j < NT; j += 2) {
      F_STEP(j);
      if (j + 1 < NT) F_STEP(j + 1);
    }
    __builtin_amdgcn_s_setprio(0);
  } else {
    for (int j = 0; j < NT; j += 2) {
      A_STEP(j);
      if (j + 1 < NT) A_STEP(j + 1);
    }
  }
#undef F_STEP
#undef SM_EL
#undef A_STEP
#undef A_DMA
#undef DMA16
  bool bad = false;
  if (active) {
#pragma unroll
    for (int qi = 0; qi < 2; ++qi) {
      if (FAST) l_run[qi] = l2[qi][0] + l2[qi][1];
      const float lt = l_run[qi] + __shfl_xor(l_run[qi], 32);
      const float inv = 1.f / lt;
      if (FAST) bad = bad || !(lt > 1e-25f && lt < 1e25f);
      unsigned char* Op = wsp<unsigned char>(p, OFF_O) + (tokq + 32 * qi) * 1024 + obase;
#pragma unroll
      for (int db = 0; db < 2; ++db)
#pragma unroll
        for (int gp = 0; gp < 2; ++gp) {
          float q[8];
#pragma unroll
          for (int j = 0; j < 8; ++j) q[j] = __builtin_amdgcn_fmed3f(o[qi][db][8 * gp + j] * (inv * O8_SCALE), -448.f, 448.f);
          int wa = __builtin_amdgcn_cvt_pk_fp8_f32(q[0], q[1], 0, false); wa = __builtin_amdgcn_cvt_pk_fp8_f32(q[2], q[3], wa, true);
          int wb = __builtin_amdgcn_cvt_pk_fp8_f32(q[4], q[5], 0, false); wb = __builtin_amdgcn_cvt_pk_fp8_f32(q[6], q[7], wb, true);
          const u32x2 sx = __builtin_amdgcn_permlane32_swap((unsigned)wa, (unsigned)wb, false, false);
          *(u32x2*)(Op + db * 32 + 16 * gp + 8 * hh) = sx;
        }
    }
  }
  if (!FAST) return false;
  LAS int* flag = (LAS int*)(lds + 2 * STG + 2048);
  if (__any(bad) && lane == 0) *flag = 1;
  __syncthreads();
  return __builtin_amdgcn_readfirstlane(*flag) != 0;
}
template <bool FAST>
DEVI bool attn_dispatch(KP p, int l, int n, int xcd, ldsp_t lds) {
  int br, s, qb; bool isctx = false;
  if (n < 32) { br = 0; s = xcd + 8 * (n >> 3); qb = n & 7; }
  else if (n < 64) { const int m = n - 32; br = 3; s = xcd + 8 * (m >> 4); qb = m & 15; }
  else if (n < 96) { const int m = n - 64; br = 2; s = xcd + 8 * (m >> 3); qb = m & 7; }
  else if (n < 128) { const int m = n - 96; br = 1; s = xcd + 8 * (m >> 4); qb = m & 15; }
  else {
    const int m = n - 128; isctx = true; qb = 0;
    if (m < 4) { br = 0; s = xcd + 8 * m; }
    else if (m < 6) { br = 3; s = xcd + 8 * (m - 4); }
    else if (m < 10) { br = 2; s = xcd + 8 * (m - 6); }
    else { br = 1; s = xcd + 8 * (m - 10); }
  }
  if (br == 0) return attn_item2<0, FAST>(p, l, s >> 2, s & 3, qb, isctx, lds);
  else if (br == 1) return attn_item2<1, FAST>(p, l, s >> 1, s & 1, qb, isctx, lds);
  else if (br == 2) return attn_item2<2, FAST>(p, l, s >> 2, s & 3, qb, isctx, lds);
  else return attn_item2<3, FAST>(p, l, s >> 1, s & 1, qb, isctx, lds);
}
DEVI void phaseD2(KP p, int l, ldsp_t lds) {
  const int G8 = gridDim.x >> 3, xcd = BIDX & 7, lb = BIDX >> 3;
  if (lb >= G8) return;
  const int NLOC = 128 + (l == 0 ? 12 : 0);
  const int nmine = (NLOC - lb + G8 - 1) / G8;
  const int cslot = min((int)(BIDX & 3), nmine - 1);
  int it = 0; unsigned redo = 0;
  for (int n = lb; n < NLOC; n += G8, ++it) {
    if (it == cslot) conv_items2(p, l, lds, CONV_EARLY, CONV_ITEMS);
    if (attn_dispatch<true>(p, l, n, xcd, lds)) redo |= 1u << it;
  }
  if (redo) {
    it = 0;
    for (int n = lb; n < NLOC; n += G8, ++it)
      if ((redo >> it) & 1) attn_dispatch<false>(p, l, n, xcd, lds);
  }
}

DEVI int pm_map(int pme, bool skipctx) { return skipctx ? (pme >> 4) * 17 + 1 + (pme & 15) : pme; }
struct SchedE1 { const char* ws; bool skipctx; int G, c;
  DEVI bool next(int i, Unit& u) const { int pm, pn; if (!tile_order(i, G, c, skipctx ? 128 : 136, 16, pm, pn)) return false;
    pm = pm_map(pm, skipctx); const int n = pn >> 2, cq = pn & 3;
    u.A = ws + OFF_O + uoff((unsigned)pm * 256u * 1024u + (unsigned)n * 256u); u.B = ws + OFF_WBR + uoff(((unsigned)n * 1024u + (unsigned)cq * 256u) * 256u); u.rows = nullptr; u.nvalid = 0;
    u.u0 = pm * 256; u.u1 = pn * 256; u.u2 = 0; u.u3 = 0; return true; } };
DEVI void phaseE1(KP p, int l, ldsp_t lds) {
  if (BIDX == 0 && TIDX < 32) wsp<int>(p, OFF_CNT)[TIDX * CNT_STRIDE] = 0;
  SchedE1 S{(const char*)p->ws, l == 1, (int)gridDim.x, BIDX};
  EpiZ8 E{wsp<unsigned char>(p, OFF_Z)};
  gemm_phase<true, false, true>(lds, 1024, 256, 2, S, E);
}
struct SchedE2 { const char* ws; const char* h8; bool skipctx; int G, c;
  DEVI bool next(int i, Unit& u) const { int pm, pn; if (!tile_order(i >> 1, G, c, skipctx ? 128 : 136, 8, pm, pn)) return false;
    pm = pm_map(pm, skipctx); const int pr = i & 1;
    u.A = h8 + uoff((unsigned)pm * 256u * 1024u); u.B = ws + OFF_WGATE + uoff((unsigned)(pr * 8 + pn) * 256u * 1024u); u.rows = nullptr; u.nvalid = 0;
    u.u0 = pm * 256; u.u1 = pn * 128; u.u2 = pr; u.u3 = 0; return true; } };
constexpr float Y8_SCALE = 16.f;
struct EpiE2 { const unsigned char* Z; u16* Y; unsigned char* Y8; const float* bias;
  DEVI void init(f32x4 (&acc)[2][2][4][2], const Unit& u, int wr, int wc, int fr, int fq) const {
    const int col0 = u.u1 + wc * 32 + 8 * fq;
#pragma unroll
    for (int bj = 0; bj < 2; ++bj)
#pragma unroll
      for (int nn = 0; nn < 2; ++nn) {
        const f32x4 b = *(const f32x4*)(bias + (2 * u.u2 + bj) * 1024 + col0 + 4 * nn) * GATE_WSCALE;
#pragma unroll
        for (int a = 0; a < 2; ++a)
#pragma unroll
          for (int m = 0; m < 4; ++m) acc[a][bj][m][nn] = b;
      }
  }
  DEVI void operator()(const f32x4 (&acc)[2][2][4][2], const Unit& u, int wr, int wc, int fr, int fq) const {
    const int row0 = u.u0 + wr * 64 + fr, col0 = u.u1 + wc * 32 + 8 * fq, pr = u.u2;
    const unsigned lw16 = (unsigned)((wr * 4 + wc) * 64 + fr + 16 * fq) * 16u;
    const unsigned char* zb0 = Z + z8_block(u.u0 >> 8, 2 * pr, u.u1 >> 7) + lw16;
    char* yb = (char*)Y + (size_t)((u.u0 >> 8) * 8 + (u.u1 >> 7)) * 65536 + lw16;
    u32x4 zq[2][2], yq[2][2];
    auto ldpair = [&](int P, u32x4 (&z)[2], u32x4 (&y)[2]) {
#pragma unroll
      for (int bj = 0; bj < 2; ++bj) z[bj] = *(const u32x4*)(zb0 + (size_t)bj * 8 * 32768 + P * 8192);
#pragma unroll
      for (int h = 0; h < 2; ++h) y[h] = pr ? *(const u32x4*)(yb + (2 * P + h) * 8192) : u32x4{0u, 0u, 0u, 0u};
    };
    ldpair(0, zq[0], yq[0]);
#pragma unroll
    for (int P = 0; P < 4; ++P) {
      const int c = P & 1;
      if (P + 1 < 4) ldpair(P + 1, zq[c ^ 1], yq[c ^ 1]);
#pragma unroll
      for (int h = 0; h < 2; ++h) {
        const int g = 2 * P + h, ai = g >> 2, m = g & 3;
        const size_t r = (size_t)(row0 + ai * HALF + m * 16);
        float t[8];
        {
          const unsigned w[4] = {yq[c][h].x, yq[c][h].y, yq[c][h].z, yq[c][h].w};
#pragma unroll
          for (int i = 0; i < 4; ++i) { t[2 * i] = __uint_as_float(w[i] << 16); t[2 * i + 1] = __uint_as_float(w[i] & 0xffff0000u); }
        }
#pragma unroll
        for (int bj = 0; bj < 2; ++bj) {
#pragma unroll
          for (int nn = 0; nn < 2; ++nn) {
            const int zw = (int)zq[c][bj][2 * h + nn];
            const f32x2 zlo = __builtin_amdgcn_cvt_pk_f32_fp8(zw, false), zhi = __builtin_amdgcn_cvt_pk_f32_fp8(zw, true);
            const float zz4[4] = {zlo.x, zlo.y, zhi.x, zhi.y};
#pragma unroll
            for (int j = 0; j < 4; ++j) {
              const int e = 4 * nn + j;
              const float gte = __builtin_amdgcn_rcpf(1.f + __builtin_amdgcn_exp2f(acc[ai][bj][m][nn][j] * (-LOG2E / GATE_WSCALE)));
              t[e] += gte * (zz4[j] * (1.f / Z8_SCALE));
            }
          }
        }
        if (pr == 0) {
          u32x4 o; o.x = pk2(t[0], t[1]); o.y = pk2(t[2], t[3]); o.z = pk2(t[4], t[5]); o.w = pk2(t[6], t[7]);
          *(u32x4*)(yb + g * 8192) = o;
        } else {
          u32x2 o8;
#pragma unroll
          for (int w = 0; w < 2; ++w) {
            float q[4];
#pragma unroll
            for (int j = 0; j < 4; ++j) q[j] = __builtin_amdgcn_fmed3f(t[4 * w + j] * Y8_SCALE, -448.f, 448.f);
            int v = __builtin_amdgcn_cvt_pk_fp8_f32(q[0], q[1], 0, false);
            v = __builtin_amdgcn_cvt_pk_fp8_f32(q[2], q[3], v, true);
            o8[w] = (unsigned)v;
          }
          *(u32x2*)(Y8 + r * 1024 + col0) = o8;
        }
      }
    }
  }
};
DEVI void phaseE2(KP p, int l, ldsp_t lds) {
  SchedE2 S{(const char*)p->ws, (const char*)h8base(p), l == 1, (int)gridDim.x, BIDX};
  EpiE2 E{wsp<unsigned char>(p, OFF_Z), wsp<u16>(p, OFF_YPRE), wsp<unsigned char>(p, OFF_Y8), p->b_gate + (size_t)l * 4 * 1024};
  gemm_phase<true, false, true>(lds, 1024, 1024, 8, S, E);
}
struct SchedF { const char* ws; bool skipctx; int G, c;
  DEVI bool next(int i, Unit& u) const { int pm, pn;
    if (skipctx || G != 256) { if (!tile_order(i, G, c, skipctx ? 128 : 136, 4, pm, pn)) return false; }
    else if (i < 2) { if (!tile_order(i, G, c, 128, 4, pm, pn)) return false; }
    else { if (i > 2 || c >= 32) return false; pm = 128 + (c >> 2); pn = c & 3; }
    pm = pm_map(pm, skipctx);
    u.A = ws + OFF_Y8 + uoff((unsigned)pm * 256u * 1024u); u.B = ws + OFF_WOUT + uoff((unsigned)pn * 256u * 1024u); u.rows = nullptr; u.nvalid = 0;
    u.u0 = pm; u.u1 = pn * 256; u.u2 = 0; u.u3 = 0; return true; } };
struct EpiF { KP p; int l;
  DEVI void init(f32x4 (&acc)[2][2][4][2], const Unit&, int, int, int, int) const { acc_zero(acc); }
  DEVI void operator()(const f32x4 (&acc)[2][2][4][2], const Unit& u, int wr, int wc, int fr, int fq) const {
    const int pm = u.u0, b = pm / 17, rr0 = (pm % 17) * 256;
    const int mrow = (rr0 < NCTX) ? 8 : b;
    const int col0 = u.u1 + wc * 32 + 8 * fq;
    const float* gt = wsp<float>(p, OFF_MOD) + ((size_t)l * 9 + mrow) * 6144 + 2048 + col0;
    const u16* xinb = (const u16*)p->out + (size_t)(b * TPB + rr0) * 1024 + col0;
    const __amdgpu_buffer_rsrc_t xrs = __builtin_amdgcn_make_buffer_rsrc((void*)wsp<u16>(p, OFF_XM), 0, NTOK * 1024 * 2, 0x00020000);
    const unsigned xoff = (unsigned)((b * TPB + rr0) * 1024 + col0) * 2u;
    f32x4 gv[2][2];
#pragma unroll
    for (int bj = 0; bj < 2; ++bj)
#pragma unroll
      for (int n = 0; n < 2; ++n) gv[bj][n] = *(const f32x4*)(gt + bj * HALF + n * 4) * (1.f / (F8_WSCALE * Y8_SCALE));
#pragma unroll
    for (int ai = 0; ai < 2; ++ai)
#pragma unroll
      for (int mp = 0; mp < 2; ++mp) {
        u32x4 xo[2][2];
#pragma unroll
        for (int mm = 0; mm < 2; ++mm) {
          const size_t ro = (size_t)(wr * 64 + fr + ai * HALF + (2 * mp + mm) * 16) * 1024;
#pragma unroll
          for (int bj = 0; bj < 2; ++bj) xo[mm][bj] = *(const u32x4*)(xinb + ro + bj * HALF);
        }
#pragma unroll
        for (int mm = 0; mm < 2; ++mm) {
          const int m = 2 * mp + mm;
          const size_t ro = (size_t)(wr * 64 + fr + ai * HALF + m * 16) * 1024;
#pragma unroll
          for (int bj = 0; bj < 2; ++bj) {
            const u32x4 v = xo[mm][bj];
            const f32x4 x0 = f32x4{__uint_as_float(v.x << 16), __uint_as_float(v.x & 0xffff0000u), __uint_as_float(v.y << 16), __uint_as_float(v.y & 0xffff0000u)};
            const f32x4 x1 = f32x4{__uint_as_float(v.z << 16), __uint_as_float(v.z & 0xffff0000u), __uint_as_float(v.w << 16), __uint_as_float(v.w & 0xffff0000u)};
            const f32x4 r0 = x0 + gv[bj][0] * acc[ai][bj][m][0], r1 = x1 + gv[bj][1] * acc[ai][bj][m][1];
            __builtin_amdgcn_raw_buffer_store_b128(u32x4{pk2(r0.x, r0.y), pk2(r0.z, r0.w), pk2(r1.x, r1.y), pk2(r1.z, r1.w)}, xrs,
                                                   (int)(xoff + (unsigned)(ro + bj * HALF) * 2u), 0, 16);
          }
        }
      }
    asm volatile("s_waitcnt vmcnt(0)" ::: "memory");
    if ((TIDX & 63) == 0) __hip_atomic_fetch_add(wsp<int>(p, OFF_DEP) + (l * 136 + pm) * DEP_STRIDE, 1, __ATOMIC_RELAXED, __HIP_MEMORY_SCOPE_AGENT);
  }
};
DEVI void phaseF2(KP p, int l, ldsp_t lds) {
  SchedF S{(const char*)p->ws, l == 1, (int)gridDim.x, BIDX};
  EpiF E{p, l};
  gemm_phase<true, false, true>(lds, 1024, 1024, 8, S, E);
}


DEVI void phase0_2(KP p, ldsp_t lds) {
  const int tid = TIDX, half = tid >> 8, htid = tid & 255;
  for (int it = BIDX * 2; it < 458; it += gridDim.x * 2) {
    const int item = it + half;
    LAS float* sc = (LAS float*)(lds + half * 16384);
    const bool ismod = item < 384;
    const int l = item / 192, rem = item % 192, cgp = rem >> 3, kc = rem & 7;
    __syncthreads();
    if (ismod) {
      for (int i = htid; i < 9 * 128; i += 256) {
        int b = i >> 7, k = i & 127;
        float v = (b < 8) ? p->c[b * 1024 + kc * 128 + k] : p->c_ctx[kc * 128 + k];
        sc[i] = v / (1.f + __expf(-v));
      }
    }
    __syncthreads();
    if (ismod) {
      float acc[9];
#pragma unroll
      for (int b = 0; b < 9; ++b) acc[b] = 0.f;
      const float* w = p->w_mod + ((size_t)l * 1024 + kc * 128) * 6144 + cgp * 256 + htid;
#pragma unroll 32
      for (int k = 0; k < 128; ++k) {
        float wv = w[(size_t)k * 6144];
#pragma unroll
        for (int b = 0; b < 9; ++b) acc[b] += sc[b * 128 + k] * wv;
      }
      float* dst = wsp<float>(p, OFF_MODP) + (size_t)((kc * 2 + l) * 9) * 6144 + cgp * 256 + htid;
#pragma unroll
      for (int b = 0; b < 9; ++b) dst[(size_t)b * 6144] = acc[b];
    } else if (item == 384) {
      float* cs32 = wsp<float>(p, OFF_CS32);
      float* cs16 = wsp<float>(p, OFF_CS16);
      for (int t = htid; t < 1024; t += 256) {
        int pos = t >> 4, i = t & 15;
        float ang = (float)pos * __builtin_amdgcn_exp2f(-(float)(2 * i) * (13.287712379549449f / 32.f));
        cs32[t * 2] = __cosf(ang); cs32[t * 2 + 1] = __sinf(ang);
      }
      for (int t = htid; t < 512; t += 256) {
        int pos = t >> 3, i = t & 7;
        float ang = (float)pos * __builtin_amdgcn_exp2f(-(float)(2 * i) * (13.287712379549449f / 16.f));
        cs16[t * 2] = __cosf(ang); cs16[t * 2 + 1] = __sinf(ang);
      }
    } else if (item < 457) {
      const int q = item - 385, ll = q / 36, o = q % 36;
      float* dst = wsp<float>(p, OFF_WRT) + ((size_t)ll * 36 + o) * 1024;
      for (int k = htid; k < 1024; k += 256)
        dst[k] = (o < 4) ? p->w_group[((size_t)ll * 1024 + k) * 4 + o] : p->w_router[((size_t)ll * 1024 + k) * 32 + (o - 4)];
    }
  }
}
DEVI void phase1_2(KP p) {
  const float* mp = wsp<float>(p, OFF_MODP);
  float* mo = wsp<float>(p, OFF_MOD);
  for (int i = BIDX * 512 + TIDX; i < 2 * 9 * 6144; i += gridDim.x * 512) {
    int l = i / (9 * 6144), o = i % 6144;
    float s = p->b_mod[l * 6144 + o];
#pragma unroll
    for (int kc = 0; kc < 8; ++kc) s += mp[(size_t)kc * 2 * 9 * 6144 + i];
    mo[i] = s;
  }
}
DEVI void phaseA2(KP p) {
  const int gw = BIDX * NW + (TIDX >> 6), nw = gridDim.x * NW;
  u16* H = wsp<u16>(p, OFF_H);
  const int per = (NTOK + nw - 1) / nw;
  const int t0 = gw * per, t1 = min(t0 + per, NTOK);
  int cur = -1; ModVec mv;
  for (int tok0 = t0; tok0 < t1; tok0 += 2) {
    float xv[2][16];
#pragma unroll
    for (int r = 0; r < 2; ++r) { const int tok = tok0 + r; if (tok < t1) load_row16(xrow_in(p, 0, tok / TPB, tok % TPB), xv[r]); }
#pragma unroll
    for (int r = 0; r < 2; ++r) {
      const int tok = tok0 + r;
      if (tok < t1) {
        const int mrow = (tok % TPB) < NCTX ? 8 : tok / TPB;
        if (mrow != cur) { load_modvec(p, 0, 0, mrow, mv); cur = mrow; }
        float hv[16]; modulate_row_store2<true, false>(mv, xv[r], nullptr, hv, h8base(p) + (size_t)tok * 1024);
        u16* xb = (u16*)p->out + (size_t)tok * 1024 + (TIDX & 63) * 4;
#pragma unroll
        for (int i = 0; i < 4; ++i) *(u32x2*)(xb + i * 256) = u32x2{pk2(xv[r][i * 4], xv[r][i * 4 + 1]), pk2(xv[r][i * 4 + 2], xv[r][i * 4 + 3])}; }
    }
  }
}
DEVI void phaseG2(KP p, int l, ldsp_t lds) {
  constexpr int RP = 2064;
  constexpr int GX = 2 * 32 * RP;
  const int tid = TIDX, lane = tid & 63, wave = __builtin_amdgcn_readfirstlane(tid >> 6);
  const int r32 = lane & 31, kh = lane >> 5, qd = lane >> 4;
  u16* H = wsp<u16>(p, OFF_H2);
  const float* WRT = wsp<float>(p, OFF_WRT) + (size_t)l * 36 * 1024;
  int* cnt = wsp<int>(p, OFF_CNT);
  int* list = wsp<int>(p, OFF_LIST);
  float* wlist = wsp<float>(p, OFF_WLIST);
  const ldsp_t hiP = lds, loP = lds + 32 * RP;
  LAS float* part = (LAS float*)lds;
  LAS int* gsel = (LAS int*)(lds + GX);
  LAS float* gwt = (LAS float*)(lds + GX + 128);
  LAS int* lcnt = (LAS int*)(lds + GX + 256);
  LAS int* gbase = lcnt + 32;
  LAS int* tinfo = lcnt + 64;
  if (tid < 32) lcnt[tid] = 0;
  int nloc = 0;
  bf16x8 whi[8], wlo[8];
  {
    const float* wr = p->w_router + (size_t)l * 1024 * 32 + r32;
#pragma unroll
    for (int s8 = 0; s8 < 8; ++s8) {
      u32x4 h, lo4;
#pragma unroll
      for (int jj = 0; jj < 4; ++jj) {
        const int k = 128 * wave + 16 * s8 + 8 * kh + 2 * jj;
        const float a = wr[(size_t)k * 32], b2 = wr[(size_t)(k + 1) * 32];
        const unsigned hp = pk2(a, b2);
        h[jj] = hp; lo4[jj] = pk2(a - __uint_as_float(hp << 16), b2 - __uint_as_float(hp & 0xffff0000u));
      }
      whi[s8] = __builtin_bit_cast(bf16x8, h); wlo[s8] = __builtin_bit_cast(bf16x8, lo4);
    }
  }
  int* tctr = wsp<int>(p, OFF_DEP) + DEP_TILECTR + l * DEP_STRIDE;
  LAS int* tnext = lcnt + 64 + 512 * 6;
  const int ntile = (l == 1) ? 8 * SEQ / 32 : NTOK / 32;
  if (tid == 0) *tnext = atomicAdd(tctr, 1);
  __syncthreads();
  for (;;) {
    const int tix = *tnext;
    if (tix >= ntile) break;
    int tclaim = 0;
    if (tid == 0) tclaim = atomicAdd(tctr, 1);
    const int tile = (l == 1) ? (tix >> 7) * 136 + 8 + (tix & 127) : tix;
    const int tok0 = tile * 32, b = tok0 / TPB, rr0 = tok0 % TPB;
    if (wave == 0) {
      const int* dep = wsp<int>(p, OFF_DEP) + (l * 136 + (tok0 >> 8)) * DEP_STRIDE;
      while (__hip_atomic_load(dep, __ATOMIC_RELAXED, __HIP_MEMORY_SCOPE_AGENT) < 32) __builtin_amdgcn_s_sleep(2);
      __builtin_amdgcn_fence(__ATOMIC_ACQUIRE, "agent");
      asm volatile("s_waitcnt vmcnt(0)" ::: "memory");
    }
    __syncthreads();
    {
      float hv[4][16], xv4[4][16];
#pragma unroll
      for (int r = 0; r < 4; ++r) load_row16_bf(wsp<u16>(p, OFF_XM) + (size_t)(tok0 + wave * 4 + r) * 1024, xv4[r]);
      ModVec mv; load_modvec(p, l, 1, (rr0 < NCTX) ? 8 : b, mv);
#pragma unroll
      for (int r = 0; r < 4; ++r) {
        modulate_row_store2<true, false>(mv, xv4[r], nullptr, hv[r], (unsigned char*)H + (size_t)(tok0 + wave * 4 + r) * 1024);
        const int ro = (wave * 4 + r) * RP + lane * 8;
#pragma unroll
        for (int i = 0; i < 4; ++i) {
          const unsigned h01 = pk2(hv[r][i * 4], hv[r][i * 4 + 1]), h23 = pk2(hv[r][i * 4 + 2], hv[r][i * 4 + 3]);
          const unsigned l01 = pk2(hv[r][i * 4] - __uint_as_float(h01 << 16), hv[r][i * 4 + 1] - __uint_as_float(h01 & 0xffff0000u));
          const unsigned l23 = pk2(hv[r][i * 4 + 2] - __uint_as_float(h23 << 16), hv[r][i * 4 + 3] - __uint_as_float(h23 & 0xffff0000u));
          *(LAS u32x2*)(hiP + ro + i * 512) = u32x2{h01, h23};
          *(LAS u32x2*)(loP + ro + i * 512) = u32x2{l01, l23};
        }
      }
      float gl[4];
#pragma unroll
      for (int o = 0; o < 4; ++o) gl[o] = router_dot(hv, WRT + (size_t)o * 1024) + p->b_group[l * 4 + o];
      int gs = 0; float best = gl[0];
#pragma unroll
      for (int j = 1; j < 4; ++j) if (gl[j] > best) { best = gl[j]; gs = j; }
      float gsum = 0.f;
#pragma unroll
      for (int j = 0; j < 4; ++j) gsum += __expf(gl[j] - best);
      if ((lane & 15) == 0) { gsel[wave * 4 + qd] = gs; gwt[wave * 4 + qd] = 1.f / gsum; }
    }
    __syncthreads();
    f32x16 acc;
#pragma unroll
    for (int i = 0; i < 16; ++i) acc[i] = 0.f;
    {
      const int ao = r32 * RP + (128 * wave + 8 * kh) * 2;
#pragma unroll
      for (int s8 = 0; s8 < 8; ++s8) {
        const bf16x8 ah = *(const LAS bf16x8*)(hiP + ao + s8 * 32), al = *(const LAS bf16x8*)(loP + ao + s8 * 32);
        acc = MFMA(ah, whi[s8], acc);
        acc = MFMA(ah, wlo[s8], acc);
        acc = MFMA(al, whi[s8], acc);
      }
    }
    __syncthreads();
#pragma unroll
    for (int i = 0; i < 16; ++i) part[(wave * 32 + (i & 3) + 8 * (i >> 2) + 4 * kh) * 33 + r32] = acc[i];
    __syncthreads();
    if (tid < 32) {
      const int gs = gsel[tid];
      const float gw_ = gwt[tid];
      float e8[8];
#pragma unroll
      for (int j = 0; j < 8; ++j) {
        float v = p->b_router[l * 32 + gs * 8 + j];
#pragma unroll
        for (int w = 0; w < 8; ++w) v += part[(w * 32 + tid) * 33 + gs * 8 + j];
        e8[j] = v;
      }
      int i0 = 0; float v0 = e8[0];
#pragma unroll
      for (int j = 1; j < 8; ++j) if (e8[j] > v0) { v0 = e8[j]; i0 = j; }
      int i1 = -1; float v1 = -INFINITY;
#pragma unroll
      for (int j = 0; j < 8; ++j) if (j != i0 && e8[j] > v1) { v1 = e8[j]; i1 = j; }
      const float ex = __expf(v1 - v0);
      const float w0 = gw_ / (1.f + ex), w1 = gw_ * ex / (1.f + ex);
      const int tok = tok0 + tid;
      const int ea = gs * 8 + i0, eb = gs * 8 + i1;
      const int ra = __hip_atomic_fetch_add(&lcnt[ea], 1, __ATOMIC_RELAXED, __HIP_MEMORY_SCOPE_WORKGROUP);
      const int rb = __hip_atomic_fetch_add(&lcnt[eb], 1, __ATOMIC_RELAXED, __HIP_MEMORY_SCOPE_WORKGROUP);
      LAS int* ti = tinfo + (nloc + tid) * 6;
      ti[0] = tok; ti[1] = ea | (eb << 8); ti[2] = ra; ti[3] = rb; ti[4] = __float_as_int(w0); ti[5] = __float_as_int(w1);
    }
    if (tid == 0) *tnext = tclaim;
    nloc += 32;
    __syncthreads();
    const bool last = *tnext >= ntile;
    if (last || nloc == 512) {
      if (tid < 32) { const int c = lcnt[tid]; gbase[tid] = c ? atomicAdd(&cnt[tid * CNT_STRIDE], c) : 0; }
      __syncthreads();
      for (int i = tid; i < nloc; i += 512) {
        const LAS int* ti = tinfo + i * 6;
        const int tok = ti[0], ea = ti[1] & 255, eb = ti[1] >> 8;
        const int sa = gbase[ea] + ti[2], sb = gbase[eb] + ti[3];
        list[(size_t)ea * NTOK + sa] = tok * 2; wlist[(size_t)ea * NTOK + sa] = __int_as_float(ti[4]);
        list[(size_t)eb * NTOK + sb] = tok * 2 + 1; wlist[(size_t)eb * NTOK + sb] = __int_as_float(ti[5]);
      }
      __syncthreads();
      if (tid < 32) lcnt[tid] = 0;
      nloc = 0;
      __syncthreads();
    }
  }
}
struct ExpInfo2 { int tiles[4], base[4], cnt[4]; };
DEVI ExpInfo2 exp_info2(KP p, int xcd) {
  const int* cnt = wsp<int>(p, OFF_CNT);
  ExpInfo2 ei;
  int before = 0;
#pragma unroll
  for (int e = 0; e < 32; ++e) {
    const int c = __builtin_amdgcn_readfirstlane(cnt[e * CNT_STRIDE]), t = (c + 255) >> 8;
    if ((e & 7) == xcd) { ei.tiles[e >> 3] = t; ei.base[e >> 3] = before; ei.cnt[e >> 3] = c; }
    before += t;
  }
  return ei;
}
template <int NN>
struct SchedX { ExpInfo2 ei; int xcd, lb, G8; const char* A; const char* W; const int* list; size_t wstride; int lda_b; int ldw_b;
  DEVI bool next(int i, Unit& u) const {
    const int tot = (ei.tiles[0] + ei.tiles[1] + ei.tiles[2] + ei.tiles[3]) * NN;
    const int n = i * G8 + lb; if (n >= tot) return false;
    int k = 0, m = n / NN; const int pn = n % NN;
    int tb = ei.base[0], ce = ei.cnt[0];
#pragma unroll
    for (int kk = 0; kk < 3; ++kk) { if (k == kk && m >= ei.tiles[kk]) { m -= ei.tiles[kk]; k = kk + 1; tb = ei.base[kk + 1]; ce = ei.cnt[kk + 1]; } }
    const int e = xcd + 8 * k;
    u.rows = list + (size_t)e * NTOK + m * 256; u.nvalid = ce - m * 256;
    u.A = A + (NN == 2 ? 0u : uoff((unsigned)(tb + m) * 256u * (unsigned)lda_b));
    u.B = W + uoff((unsigned)e * (unsigned)wstride + (unsigned)pn * 256u * (unsigned)ldw_b);
    u.u0 = (tb + m) * 256; u.u1 = pn; u.u2 = e; u.u3 = m; return true; } };
constexpr float U8_SCALE = 16.f;
struct EpiI1 { unsigned char* U;
  DEVI void init(f32x4 (&acc)[2][2][4][2], const Unit&, int, int, int, int) const { acc_zero(acc); }
  DEVI void operator()(const f32x4 (&acc)[2][2][4][2], const Unit& u, int wr, int wc, int fr, int fq) const {
#pragma unroll
    for (int ai = 0; ai < 2; ++ai)
#pragma unroll
      for (int m = 0; m < 4; ++m) {
        unsigned char* rowp = U + (size_t)(u.u0 + ai * HALF + wr * 64 + m * 16 + fr) * 256;
#pragma unroll
        for (int bj = 0; bj < 2; ++bj) {
          const int ff = 16 * (8 * u.u1 + 4 * bj + wc) + 4 * fq;
          const f32x4 g = acc[ai][bj][m][0] * (1.f / F8_WSCALE), up = acc[ai][bj][m][1] * (1.f / F8_WSCALE);
          float t[4];
#pragma unroll
          for (int j = 0; j < 4; ++j) t[j] = __builtin_amdgcn_fmed3f(g[j] / (1.f + __expf(-g[j])) * up[j] * U8_SCALE, -448.f, 448.f);
          int o = __builtin_amdgcn_cvt_pk_fp8_f32(t[0], t[1], 0, false);
          o = __builtin_amdgcn_cvt_pk_fp8_f32(t[2], t[3], o, true);
          *(int*)(rowp + ff) = o;
        }
      }
  }
};
DEVI void phaseI1_2(KP p, ldsp_t lds) {
  const int xcd = BIDX & 7, lb = BIDX >> 3, G8 = gridDim.x >> 3;
  if (lb >= G8) return;
  SchedX<2> S{exp_info2(p, xcd), xcd, lb, G8, (const char*)wsp<u16>(p, OFF_H2), (const char*)wsp<u16>(p, OFF_W13), wsp<int>(p, OFF_LIST), (size_t)512 * 1024, 1024, 1024};
  EpiI1 E{wsp<unsigned char>(p, OFF_U)};
  int nt = 8; asm volatile("" : "+s"(nt));
  gemm_phase<false, true, true>(lds, 1024, 1024, nt, S, E);
}
constexpr float YS8_SCALE = 32.f;
struct EpiI2 { unsigned char* YS; const float* wlist; const int* list;
  DEVI void init(f32x4 (&acc)[2][2][4][2], const Unit&, int, int, int, int) const { acc_zero(acc); }
  DEVI void operator()(const f32x4 (&acc)[2][2][4][2], const Unit& u, int wr, int wc, int fr, int fq) const {
    const unsigned colb = (unsigned)(u.u1 * 256 + wc * 32 + 8 * fq);
    const float* we = wlist + (u.rows - list);
    unsigned dest[2][4]; float w[2][4];
#pragma unroll
    for (int ai = 0; ai < 2; ++ai)
#pragma unroll
      for (int m = 0; m < 4; ++m) {
        const int r = ai * HALF + wr * 64 + m * 16 + fr;
        dest[ai][m] = (r < u.nvalid) ? (unsigned)u.rows[r] : (unsigned)(2 * NTOK);
        w[ai][m] = we[r] * (YS8_SCALE / (U8_SCALE * F8_WSCALE));
      }
#pragma unroll
    for (int ai = 0; ai < 2; ++ai)
#pragma unroll
      for (int m = 0; m < 4; ++m) {
        unsigned char* rowp = YS + (dest[ai][m] * 1024u + colb);
#pragma unroll
        for (int bj = 0; bj < 2; ++bj) {
          u32x2 o;
#pragma unroll
          for (int nn = 0; nn < 2; ++nn) {
            const f32x4 v = acc[ai][bj][m][nn] * w[ai][m];
            int q = __builtin_amdgcn_cvt_pk_fp8_f32(__builtin_amdgcn_fmed3f(v[0], -448.f, 448.f), __builtin_amdgcn_fmed3f(v[1], -448.f, 448.f), 0, false);
            q = __builtin_amdgcn_cvt_pk_fp8_f32(__builtin_amdgcn_fmed3f(v[2], -448.f, 448.f), __builtin_amdgcn_fmed3f(v[3], -448.f, 448.f), q, true);
            o[nn] = (unsigned)q;
          }
          *(u32x2*)(rowp + bj * 128) = o;
        }
      }
  }
};
DEVI void phaseI2_2(KP p, ldsp_t lds) {
  const int xcd = BIDX & 7, lb = BIDX >> 3, G8 = gridDim.x >> 3;
  if (lb >= G8) return;
  SchedX<4> S{exp_info2(p, xcd), xcd, lb, G8, (const char*)wsp<u16>(p, OFF_U), (const char*)wsp<u16>(p, OFF_W2), wsp<int>(p, OFF_LIST), (size_t)1024 * 256, 256, 256};
  EpiI2 E{wsp<unsigned char>(p, OFF_YS), wsp<float>(p, OFF_WLIST), wsp<int>(p, OFF_LIST)};
  int nt = 2; asm volatile("" : "+s"(nt));
  gemm_phase<true, false, true>(lds, 256, 256, nt, S, E);
}
DEVI void phaseJ2(KP p, int l, ldsp_t lds) {
  const int lane = TIDX & 63;
  const int gw = BIDX * NW + (TIDX >> 6), nw = gridDim.x * NW;
  const unsigned char* YS = wsp<unsigned char>(p, OFF_YS);
  u16* H = wsp<u16>(p, OFF_H);
  const int ntot = (l == 1) ? 8 * SEQ : NTOK;
  const int per = (ntot + nw - 1) / nw;
  const int i0 = gw * per, i1 = min(i0 + per, ntot);
  int cur = -1; ModVec mv; f32x4 gtv[4];
  for (int ii = i0; ii < i1; ii += 2) {
    float xv[2][16]; int y0[2][4], y1[2][4]; bool ok[2]; int tk[2];
#pragma unroll
    for (int r = 0; r < 2; ++r) {
      const int idx = ii + r;
      const int tok = (l == 1) ? (idx / SEQ) * TPB + NCTX + idx % SEQ : idx;
      tk[r] = tok;
      ok[r] = idx < i1;
      if (ok[r]) {
        load_row16_bf(wsp<u16>(p, OFF_XM) + (size_t)tok * 1024, xv[r]);
#pragma unroll
        for (int i = 0; i < 4; ++i) {
          const int c = i * 256 + lane * 4;
          y0[r][i] = *(const int*)(YS + (size_t)(tok * 2) * 1024 + c);
          y1[r][i] = *(const int*)(YS + (size_t)(tok * 2 + 1) * 1024 + c);
        }
      }
    }
#pragma unroll
    for (int r = 0; r < 2; ++r) {
      if (!ok[r]) continue;
      const int tok = tk[r];
      const int b = tok / TPB, rr = tok % TPB;
      const int mrow = (rr < NCTX) ? 8 : b;
      if (mrow != cur) {
        cur = mrow;
        const float* gt = wsp<float>(p, OFF_MOD) + ((size_t)l * 9 + mrow) * 6144 + 5120;
#pragma unroll
        for (int i = 0; i < 4; ++i) gtv[i] = *(const f32x4*)(gt + i * 256 + lane * 4);
        if (l == 0) load_modvec(p, 1, 0, mrow, mv);
      }
#pragma unroll
      for (int i = 0; i < 4; ++i) {
        const f32x4 g = gtv[i] * (1.f / YS8_SCALE);
        const f32x2 a0 = __builtin_amdgcn_cvt_pk_f32_fp8(y0[r][i], false), a1 = __builtin_amdgcn_cvt_pk_f32_fp8(y0[r][i], true);
        const f32x2 b0 = __builtin_amdgcn_cvt_pk_f32_fp8(y1[r][i], false), b1 = __builtin_amdgcn_cvt_pk_f32_fp8(y1[r][i], true);
        xv[r][i * 4 + 0] += g.x * (a0.x + b0.x);
        xv[r][i * 4 + 1] += g.y * (a0.y + b0.y);
        xv[r][i * 4 + 2] += g.z * (a1.x + b1.x);
        xv[r][i * 4 + 3] += g.w * (a1.y + b1.y);
      }
      if (l == 0) {
        u16* xr = (u16*)p->out + (size_t)tok * 1024;
#pragma unroll
        for (int i = 0; i < 4; ++i)
          *(u32x2*)(xr + i * 256 + lane * 4) = u32x2{pk2(xv[r][i * 4], xv[r][i * 4 + 1]), pk2(xv[r][i * 4 + 2], xv[r][i * 4 + 3])};
        float hv[16];
        modulate_row_store2<true, false>(mv, xv[r], nullptr, hv, h8base(p) + (size_t)tok * 1024);
      } else {
        float ss = 0.f;
#pragma unroll
        for (int i = 0; i < 16; ++i) ss += xv[r][i] * xv[r][i];
        ss = wave_sum(ss);
        const float rstd = rsqrtf(ss * (1.f / 1024.f) + EPS);
        float* xr = p->out + ((size_t)b * SEQ + rr - NCTX) * 1024;
#pragma unroll
        for (int i = 0; i < 4; ++i) {
          const int c = i * 256 + lane * 4;
          const f32x4 g = *(const f32x4*)(p->g_final + c);
          *(f32x4*)(xr + c) = f32x4{xv[r][i * 4] * rstd * g.x, xv[r][i * 4 + 1] * rstd * g.y, xv[r][i * 4 + 2] * rstd * g.z, xv[r][i * 4 + 3] * rstd * g.w};
        }
      }
    }
  }
}

constexpr int N_PHASES = 3 + 2 * 11;
__global__ void __launch_bounds__(512, 2) fwd_v2(Params parg) {
  extern __shared__ __attribute__((aligned(16))) unsigned char dyn_lds[];
  const ldsp_t lds = (ldsp_t)dyn_lds;
  cg::grid_group grid = cg::this_grid();
  volatile LAS unsigned* xb_st = (volatile LAS unsigned*)(lds + LDS_BARW);
  if (TIDX < 4) xb_st[TIDX] = 0u;
  __syncthreads();
  if (parg.ph_end - parg.ph_begin > 1) xcd_barrier_post((unsigned*)(parg.ws + OFF_BAR));
  for (int ph = parg.ph_begin; ph < parg.ph_end; ++ph) {
    KP p = (KP)__builtin_amdgcn_kernarg_segment_ptr();
    asm volatile("" : "+s"(p));
    const int l = (ph >= 14) ? 1 : 0;
    const int k = (ph < 3) ? ph : 3 + (ph - 3) % 11;
    const int reps = (((PROBE_DUP >> k) & 1) && (!(PROBE_DUP & 0x10000) || l == 0)) ? 2 : 1;
    for (int rep = 0; rep < reps; ++rep) {
      if (rep) {
        xcd_barrier((unsigned*)(p->ws + OFF_BAR), xb_st);
        if (k == 10) { if (BIDX == 0 && TIDX < 32) wsp<int>(p, OFF_CNT)[TIDX * CNT_STRIDE] = 0; xcd_barrier((unsigned*)(p->ws + OFF_BAR), xb_st); }
      }
      switch (k) {
        case 0: phase0_2(p, lds); break;
        case 1: phase1_2(p); break;
        case 2: phaseA2(p); break;
        case 3: phaseB2(p, lds); break;
        case 4: phaseC2(p, lds); break;
        case 5: phaseP2(p, l, lds); break;
        case 6: phaseD2(p, l, lds); break;
        case 7: phaseE1(p, l, lds); break;
        case 8: phaseE2(p, l, lds); break;
        case 9: phaseF2(p, l, lds); break;
        case 10: phaseG2(p, l, lds); break;
        case 11: phaseI1_2(p, lds); break;
        case 12: phaseI2_2(p, lds); break;
        default: phaseJ2(p, l, lds); break;
      }
    }
    if (k == 0 || (k == 13 && l == 0)) conv_items2(p, k == 0 ? 0 : 1, lds, 0, CONV_EARLY);
    if (ph + 1 < parg.ph_end && k != 9) {
      if (parg.ph_begin >= 1000) grid.sync();
      else xcd_barrier((unsigned*)(p->ws + OFF_BAR), xb_st);
    }
  }
}
}

extern "C" void kernel_launch(void* const* d_in, const int* in_sizes, int n_in, void* d_out, int out_size,
                              void* d_ws, size_t ws_size, hipStream_t stream) {
  static int grid2 = 0;
  if (!grid2) {
    int dev = 0, cus = 0, per_cu = 0;
    (void)hipGetDevice(&dev);
    (void)hipDeviceGetAttribute(&cus, hipDeviceAttributeMultiprocessorCount, dev);
    (void)hipFuncSetAttribute((const void*)v2::fwd_v2, hipFuncAttributeMaxDynamicSharedMemorySize, v2::LDS_TOTAL);
    (void)hipOccupancyMaxActiveBlocksPerMultiprocessor(&per_cu, v2::fwd_v2, 512, v2::LDS_TOTAL);
    if (per_cu < 1) { fprintf(stderr, "kernel does not fit on a CU\n"); per_cu = 1; }
    grid2 = cus & ~7;
  }
  if (ws_size < WS_NEEDED) { fprintf(stderr, "workspace too small: %zu < %zu\n", ws_size, (size_t)WS_NEEDED); return; }
  Params hp{};
  const float** f = (const float**)&hp;
  for (int i = 0; i < 29; ++i) f[i] = (const float*)d_in[i];
  hp.out = (float*)d_out;
  hp.ws = (char*)d_ws;
#if N_LAUNCH_MODE == 1
  for (int ph = 0; ph < v2::N_PHASES; ++ph) {
    hp.ph_begin = ph; hp.ph_end = ph + 1;
    void* args[] = {&hp};
    hipError_t e = hipLaunchCooperativeKernel((void*)v2::fwd_v2, dim3(grid2), dim3(512), args, v2::LDS_TOTAL, stream);
    if (e != hipSuccess) fprintf(stderr, "launch failed: %s\n", hipGetErrorString(e));
  }
#else
  hp.ph_begin = 0; hp.ph_end = v2::N_PHASES;
  (void)hipMemsetAsync((char*)d_ws + OFF_BAR, 0, (size_t)(OFF_DEP - OFF_BAR) + (size_t)DEP_WORDS * 4, stream);
  void* args[] = {&hp};
  hipError_t e = hipLaunchCooperativeKernel((void*)v2::fwd_v2, dim3(grid2), dim3(512), args, v2::LDS_TOTAL, stream);
  if (e != hipSuccess) fprintf(stderr, "cooperative launch failed: %s (grid %d)\n", hipGetErrorString(e), grid2);
#endif
}
```

```cpp
#include <hip/hip_runtime.h>
#include <hip/hip_cooperative_groups.h>
#include <stdint.h>
#include <stdio.h>
namespace cg = cooperative_groups;

#ifndef N_LAUNCH_MODE
#define N_LAUNCH_MODE 0
#endif

#ifndef PROBE_DUP
#define PROBE_DUP 0
#endif
#define DEVI __device__ __forceinline__
typedef unsigned short u16;
typedef __attribute__((ext_vector_type(2))) float f32x2;
typedef __attribute__((ext_vector_type(2))) __bf16 bf16x2_t;
typedef __attribute__((ext_vector_type(8))) short bf16x8;
typedef __attribute__((ext_vector_type(16))) float f32x16;
typedef __attribute__((ext_vector_type(4))) unsigned u32x4;
typedef __attribute__((ext_vector_type(2))) unsigned u32x2;
typedef __attribute__((ext_vector_type(4))) float f32x4;
#define MFMA(a, b, c) __builtin_amdgcn_mfma_f32_32x32x16_bf16((a), (b), (c), 0, 0, 0)

constexpr int DMODEL = 1024, NBATCH = 8, SEQ = 4096, NCTX = 256;
constexpr int TPB = SEQ + NCTX;
constexpr int NTOK = NBATCH * TPB;
constexpr int MT_PER_B = TPB / 128;
constexpr int NEXP = 32;
constexpr int INP = 2304;
constexpr float EPS = 1e-6f;
constexpr float LOG2E = 1.4426950408889634f;
constexpr int SMEM_BYTES = 73728;
constexpr int UROWS = 2 * NTOK + NEXP * 256;

constexpr size_t al(size_t x) { return (x + 255) & ~(size_t)255; }
constexpr size_t OFF_WIN = 0;
constexpr size_t OFF_WQB = OFF_WIN + al((size_t)INP * 1024 * 2);
constexpr size_t OFF_WKVB = OFF_WQB + al((size_t)512 * 256 * 2);
constexpr size_t OFF_WGATE = OFF_WKVB + al((size_t)512 * 256 * 2);
constexpr size_t OFF_WBR = OFF_WGATE + al((size_t)4 * 1024 * 1024 * 2);
constexpr size_t OFF_WOUT = OFF_WBR + al((size_t)4 * 1024 * 256 * 2);
constexpr size_t OFF_W13 = OFF_WOUT + al((size_t)1024 * 1024 * 2);
constexpr size_t OFF_W2 = OFF_W13 + al((size_t)32 * 512 * 1024 * 2);
constexpr size_t OFF_MODP = OFF_W2 + al((size_t)32 * 1024 * 256 * 2);
constexpr size_t OFF_MOD = OFF_MODP + al((size_t)8 * 2 * 9 * 6144 * 4);
constexpr size_t OFF_CS32 = OFF_MOD + al((size_t)2 * 9 * 6144 * 4);
constexpr size_t OFF_CS16 = OFF_CS32 + al((size_t)64 * 16 * 2 * 4);
constexpr size_t OFF_WRT = OFF_CS16 + al((size_t)64 * 8 * 2 * 4);
constexpr size_t OFF_CNT = OFF_WRT + al((size_t)2 * 36 * 1024 * 4);
constexpr int CNT_STRIDE = 64;
constexpr size_t OFF_BAR = OFF_CNT + al(32 * CNT_STRIDE * 4);
constexpr int XCD_BAR_WORDS = 3456;
constexpr size_t OFF_CTXRES = OFF_BAR + al((size_t)XCD_BAR_WORDS * 4);
constexpr size_t OFF_DEP = OFF_CTXRES;
constexpr int DEP_STRIDE = 16, DEP_TILECTR = 2 * 136 * DEP_STRIDE, DEP_WORDS = DEP_TILECTR + 2 * DEP_STRIDE;
constexpr size_t OFF_H = OFF_CTXRES + al((size_t)8 * 256 * 1024 * 4);
constexpr size_t OFF_O = OFF_H + al((size_t)NTOK * 1024 * 2);
constexpr size_t OFF_SSQ = OFF_O + al((size_t)NTOK * 1024 * 2);
constexpr size_t OFF_LIST = OFF_SSQ + al((size_t)NTOK * 8 * 4);
constexpr size_t OFF_WLIST = OFF_LIST + al((size_t)32 * NTOK * 4);
constexpr size_t OFF_R1 = OFF_WLIST + al((size_t)32 * NTOK * 4);
constexpr int PLD = INP;
constexpr size_t OFF_PRAW = OFF_R1;
constexpr size_t OFF_QARAW = OFF_PRAW + (size_t)NTOK * INP * 2;
constexpr size_t OFF_KVARAW = OFF_QARAW + (size_t)NTOK * 512 * 2;
constexpr size_t OFF_VAT = OFF_KVARAW + (size_t)NTOK * 512 * 2;
constexpr size_t OFF_VBT = OFF_VAT + (size_t)NTOK * 256 * 2;
constexpr size_t OFF_VCT = OFF_VBT + (size_t)NTOK * 128 * 2;
constexpr size_t OFF_VDT = OFF_VCT + (size_t)NTOK * 256 * 2;
constexpr size_t OFF_END = OFF_VDT + (size_t)NTOK * 128 * 2;
constexpr size_t OFF_Z = OFF_R1;
constexpr size_t OFF_Y8 = OFF_H;
constexpr size_t OFF_H2 = OFF_O;
constexpr size_t OFF_YPRE = OFF_O;
constexpr size_t OFF_U = OFF_R1;
constexpr size_t OFF_YS = OFF_R1 + al((size_t)UROWS * 256 * 2);
constexpr size_t OFF_XM = OFF_YS + al((size_t)(2 * NTOK + 1) * 1024 * 2);
static_assert(OFF_XM + (size_t)NTOK * 1024 * 2 <= OFF_END, "alias overflow");
static_assert(OFF_Z + (size_t)NTOK * 4096 * 2 <= OFF_END, "alias overflow");
static_assert(OFF_YS + (size_t)(2 * NTOK + 1) * 1024 * 2 <= OFF_END, "alias overflow");
constexpr size_t WS_NEEDED = OFF_END;
static_assert(WS_NEEDED <= (size_t)536870912, "workspace budget (4 x largest tensor)");

struct Params {
  const float *x, *c, *ctx, *c_ctx, *w_mod, *b_mod, *g_norm_mix, *w_in, *g_q_a, *w_q_b, *g_kv_a, *w_kv_b,
      *sink_b, *rpb_c, *g_q_d, *g_k_d, *w_gate, *b_gate, *w_branch, *w_out, *g_norm_ffn, *w_group, *b_group,
      *w_router, *b_router, *w_ff1, *w_ff3, *w_ff2, *g_final;
  float* out;
  char* ws;
  int ph_begin, ph_end;
};

DEVI int tid_fresh() { int t; asm volatile("v_mov_b32 %0, %1" : "=v"(t) : "v"(__builtin_amdgcn_workitem_id_x())); return t; }
DEVI int bid_fresh() { int t; asm volatile("s_mov_b32 %0, %1" : "=s"(t) : "s"(__builtin_amdgcn_workgroup_id_x())); return t; }
#define TIDX tid_fresh()
#define BIDX bid_fresh()
typedef const __attribute__((address_space(4))) Params* KP;
DEVI unsigned pk2(float a, float b) { f32x2 v = {a, b}; bf16x2_t r = __builtin_convertvector(v, bf16x2_t); return __builtin_bit_cast(unsigned, r); }
DEVI u16 f2bf(float a) { return (u16)(pk2(a, 0.f) & 0xffffu); }
DEVI float bf2f(u16 v) { return __uint_as_float(((unsigned)v) << 16); }
DEVI float wave_sum(float v) {
#pragma unroll
  for (int m = 32; m >= 1; m >>= 1) v += __shfl_xor(v, m);
  return v;
}
template <class T> DEVI T* wsp(KP p, size_t off) { return (T*)(p->ws + off); }
DEVI const float* xrow_in(KP p, int l, int b, int rr) {
  if (l == 0) return (rr < NCTX) ? p->ctx + ((size_t)b * NCTX + rr) * 1024 : p->x + ((size_t)b * SEQ + rr - NCTX) * 1024;
  return (rr < NCTX) ? wsp<float>(p, OFF_CTXRES) + ((size_t)b * NCTX + rr) * 1024 : p->out + ((size_t)b * SEQ + rr - NCTX) * 1024;
}
DEVI float* xrow_res(KP p, int b, int rr) {
  return (rr < NCTX) ? wsp<float>(p, OFF_CTXRES) + ((size_t)b * NCTX + rr) * 1024 : p->out + ((size_t)b * SEQ + rr - NCTX) * 1024;
}
DEVI int perm16(int k) { return (k & ~12) | ((k & 4) << 1) | ((k & 8) >> 1); }

struct ConvT { const float* src; const float* src2; const float* ks; u16* dst; int ld; int ldd; float mul; };
constexpr float Z8_SCALE = 16.f, O8_SCALE = 32.f;
constexpr float F8_WSCALE = 64.f, GATE_WSCALE = F8_WSCALE;
constexpr int CONV_ITEMS = 1152 + 64 + 64 + 2048 + 512 + 512 + 8192 + 4096;
DEVI ConvT conv_decode(KP p, int l, int idx) {
  ConvT c; c.ks = nullptr; c.mul = 1.f; c.src2 = nullptr;
  if (idx < 1152) {
    int nt = idx >> 4, kt = idx & 15, n0 = nt * 32;
    int sc = (n0 < 416) ? n0 : ((n0 < 512) ? -1 : n0 - 96);
    c.ld = 2208; c.ldd = -1024;
    c.mul = F8_WSCALE;
    if ((n0 >= 512 && n0 < 768) || (n0 >= 1024 && n0 < 1280)) c.mul = 0.125f * LOG2E * F8_WSCALE;
    c.src = (sc < 0) ? nullptr : p->w_in + (size_t)l * 1024 * 2208 + (size_t)kt * 64 * 2208 + sc;
    c.dst = (u16*)(p->ws + OFF_WIN + (size_t)n0 * 1024 + kt * 64);
    return c;
  }
  idx -= 1152;
  if (idx < 64) {
    int nt = idx >> 2, kt = idx & 3;
    c.ld = 384; c.ldd = 256; c.ks = p->g_q_a + l * 256 + kt * 64;
    c.src = (nt >= 12) ? nullptr : p->w_q_b + (size_t)l * 256 * 384 + (size_t)kt * 64 * 384 + nt * 32;
    c.dst = wsp<u16>(p, OFF_WQB) + (size_t)nt * 32 * 256 + kt * 64;
    return c;
  }
  idx -= 64;
  if (idx < 64) {
    int nt = idx >> 2, kt = idx & 3;
    c.ld = 512; c.ldd = 256; c.ks = (kt < 2) ? p->g_kv_a + l * 128 + kt * 64 : nullptr;
    c.src = (kt >= 2) ? nullptr : p->w_kv_b + (size_t)l * 128 * 512 + (size_t)kt * 64 * 512 + nt * 32;
    c.dst = wsp<u16>(p, OFF_WKVB) + (size_t)nt * 32 * 256 + kt * 64;
    return c;
  }
  idx -= 64;
  if (idx < 2048) {
    int nt = idx >> 4, kt = idx & 15, R0 = nt * 32;
    int pr = R0 >> 11, cb = (R0 & 2047) >> 8, bj = (R0 & 255) >> 7, j0 = R0 & 127;
    c.ld = 1024; c.ldd = -1024; c.mul = -LOG2E * F8_WSCALE;
    c.src = p->w_gate + ((size_t)(l * 4 + 2 * pr + bj) * 1024 + kt * 64) * 1024 + cb * 128 + j0;
    c.dst = (u16*)(p->ws + OFF_WGATE + (size_t)R0 * 1024 + kt * 64);
    return c;
  }
  idx -= 2048;
  if (idx < 512) {
    int br = idx >> 7, nt = (idx >> 2) & 31, kt = idx & 3;
    c.ld = 1024; c.ldd = -256; c.mul = F8_WSCALE;
    c.src = p->w_branch + ((size_t)(l * 4 + br) * 256 + kt * 64) * 1024 + nt * 32;
    c.dst = (u16*)(p->ws + OFF_WBR + ((size_t)br * 1024 + nt * 32) * 256 + kt * 64);
    return c;
  }
  idx -= 512;
  if (idx < 512) {
    int nt = idx >> 4, kt = idx & 15;
    c.ld = 1024; c.ldd = -1024; c.mul = F8_WSCALE;
    c.src = p->w_out + ((size_t)l * 1024 + kt * 64) * 1024 + nt * 32;
    c.dst = (u16*)(p->ws + OFF_WOUT + (size_t)nt * 32 * 1024 + kt * 64);
    return c;
  }
  idx -= 512;
  if (idx < 8192) {
    int e = idx >> 8, g32 = (idx >> 4) & 15, kt = idx & 15;
    c.ld = 256; c.ldd = -1024; c.mul = F8_WSCALE;
    c.src = p->w_ff1 + ((size_t)(l * 32 + e) * 1024 + kt * 64) * 256 + g32 * 16;
    c.src2 = p->w_ff3 + ((size_t)(l * 32 + e) * 1024 + kt * 64) * 256 + g32 * 16;
    c.dst = (u16*)(p->ws + OFF_W13 + ((size_t)e * 512 + g32 * 32) * 1024 + kt * 64);
    return c;
  }
  idx -= 8192;
  {
    int e = idx >> 7, nt = (idx >> 2) & 31, kt = idx & 3;
    c.ld = 1024; c.ldd = -256; c.mul = F8_WSCALE;
    c.src = p->w_ff2 + ((size_t)(l * 32 + e) * 256 + kt * 64) * 1024 + nt * 32;
    c.dst = (u16*)(p->ws + OFF_W2 + ((size_t)e * 1024 + nt * 32) * 256 + kt * 64);
    return c;
  }
}
DEVI void modulate_row_store(KP p, int l, int which, const float (&xv)[16], int mrow, u16* hrow, float (&hv)[16]) {
  const int lane = TIDX & 63;
  float ss = 0.f;
#pragma unroll
  for (int i = 0; i < 16; ++i) ss += xv[i] * xv[i];
  ss = wave_sum(ss);
  const float rstd = rsqrtf(ss * (1.f / 1024.f) + EPS);
  const float* g = (which ? p->g_norm_ffn : p->g_norm_mix) + l * 1024;
  const float* mod = wsp<float>(p, OFF_MOD) + ((size_t)l * 9 + mrow) * 6144 + (which ? 3072 : 0);
#pragma unroll
  for (int i = 0; i < 4; ++i) {
    const int c = i * 256 + lane * 4;
    f32x4 gv = *(const f32x4*)(g + c);
    f32x4 sh = *(const f32x4*)(mod + c);
    f32x4 sc = *(const f32x4*)(mod + 1024 + c);
    hv[i * 4 + 0] = xv[i * 4 + 0] * rstd * gv.x * (1.f + sc.x) + sh.x;
    hv[i * 4 + 1] = xv[i * 4 + 1] * rstd * gv.y * (1.f + sc.y) + sh.y;
    hv[i * 4 + 2] = xv[i * 4 + 2] * rstd * gv.z * (1.f + sc.z) + sh.z;
    hv[i * 4 + 3] = xv[i * 4 + 3] * rstd * gv.w * (1.f + sc.w) + sh.w;
    u32x2 o; o.x = pk2(hv[i * 4 + 0], hv[i * 4 + 1]); o.y = pk2(hv[i * 4 + 2], hv[i * 4 + 3]);
    *(u32x2*)(hrow + c) = o;
  }
}
struct ModVec { f32x4 a[4], b[4]; };
DEVI void load_modvec(KP p, int l, int which, int mrow, ModVec& mv) {
  const int lane = TIDX & 63;
  const float* g = (which ? p->g_norm_ffn : p->g_norm_mix) + l * 1024;
  const float* mod = wsp<float>(p, OFF_MOD) + ((size_t)l * 9 + mrow) * 6144 + (which ? 3072 : 0);
#pragma unroll
  for (int i = 0; i < 4; ++i) {
    const int c = i * 256 + lane * 4;
    const f32x4 gv = *(const f32x4*)(g + c), sh = *(const f32x4*)(mod + c), sc = *(const f32x4*)(mod + 1024 + c);
    mv.a[i] = gv * (1.f + sc); mv.b[i] = sh;
  }
}
DEVI unsigned char* h8base(KP p) { return (unsigned char*)p->out + (size_t)NTOK * 2048; }
template <bool F8COPY = false, bool BF16 = true>
DEVI void modulate_row_store2(const ModVec& mv, const float (&xv)[16], u16* hrow, float (&hv)[16], unsigned char* h8row = nullptr) {
  const int lane = TIDX & 63;
  float ss = 0.f;
#pragma unroll
  for (int i = 0; i < 16; ++i) ss += xv[i] * xv[i];
  ss = wave_sum(ss);
  const float rstd = rsqrtf(ss * (1.f / 1024.f) + EPS);
#pragma unroll
  for (int i = 0; i < 4; ++i) {
    const int c = i * 256 + lane * 4;
#pragma unroll
    for (int j = 0; j < 4; ++j) hv[i * 4 + j] = xv[i * 4 + j] * rstd * mv.a[i][j] + mv.b[i][j];
    if (BF16) { u32x2 o; o.x = pk2(hv[i * 4 + 0], hv[i * 4 + 1]); o.y = pk2(hv[i * 4 + 2], hv[i * 4 + 3]);
      *(u32x2*)(hrow + c) = o; }
    if (F8COPY) {
      float q[4];
#pragma unroll
      for (int j = 0; j < 4; ++j) q[j] = __builtin_amdgcn_fmed3f(hv[i * 4 + j], -448.f, 448.f);
      int v = __builtin_amdgcn_cvt_pk_fp8_f32(q[0], q[1], 0, false);
      v = __builtin_amdgcn_cvt_pk_fp8_f32(q[2], q[3], v, true);
      *(int*)(h8row + c) = v;
    }
  }
}
DEVI void load_row16(const float* xr, float (&xv)[16]) {
  const int lane = TIDX & 63;
#pragma unroll
  for (int i = 0; i < 4; ++i) {
    f32x4 v = *(const f32x4*)(xr + i * 256 + lane * 4);
    xv[i * 4 + 0] = v.x; xv[i * 4 + 1] = v.y; xv[i * 4 + 2] = v.z; xv[i * 4 + 3] = v.w;
  }
}
DEVI void load_row16_bf(const u16* xr, float (&xv)[16]) {
  const int lane = TIDX & 63;
#pragma unroll
  for (int i = 0; i < 4; ++i) {
    const u32x2 v = *(const u32x2*)(xr + i * 256 + lane * 4);
    xv[i * 4 + 0] = __uint_as_float(v.x << 16); xv[i * 4 + 1] = __uint_as_float(v.x & 0xffff0000u);
    xv[i * 4 + 2] = __uint_as_float(v.y << 16); xv[i * 4 + 3] = __uint_as_float(v.y & 0xffff0000u);
  }
}
DEVI float router_dot(const float (&hv)[4][16], const float* wrow) {
  const int lane = TIDX & 63;
  const float* w = wrow + lane * 4;
  float pr[4] = {0.f, 0.f, 0.f, 0.f};
#pragma unroll
  for (int i = 0; i < 4; ++i) {
    const f32x4 wv = *(const f32x4*)(w + i * 256);
#pragma unroll
    for (int r = 0; r < 4; ++r)
      pr[r] += hv[r][i * 4] * wv.x + hv[r][i * 4 + 1] * wv.y + hv[r][i * 4 + 2] * wv.z + hv[r][i * 4 + 3] * wv.w;
  }
  const bool up = (lane & 32) != 0;
  float s0 = up ? pr[0] : pr[2], s1 = up ? pr[1] : pr[3];
  float k0 = up ? pr[2] : pr[0], k1 = up ? pr[3] : pr[1];
  k0 += __shfl_xor(s0, 32); k1 += __shfl_xor(s1, 32);
  const bool up2 = (lane & 16) != 0;
  float sv = up2 ? k0 : k1, kv = up2 ? k1 : k0;
  kv += __shfl_xor(sv, 16);
  kv += __shfl_xor(kv, 8); kv += __shfl_xor(kv, 4); kv += __shfl_xor(kv, 2); kv += __shfl_xor(kv, 1);
  return kv;
}
#define XB_TMO      128
#define XB_XCNT(j)  (256  + 64 * (j))
#define XB_XSUB(j)  (1280 + 64 * (j))
#define XB_XGEN(j)  (2304 + 64 * (j))
#define XB_TOP      3328
#define XB_TOPGEN   3392
#define XB_SPIN_CAP (1u << 20)
#define LAS __attribute__((address_space(3)))
DEVI unsigned xb_ld(unsigned* p) { return __hip_atomic_load(p, __ATOMIC_RELAXED, __HIP_MEMORY_SCOPE_AGENT); }
DEVI unsigned xb_add(unsigned* p, unsigned v) { return __hip_atomic_fetch_add(p, v, __ATOMIC_RELAXED, __HIP_MEMORY_SCOPE_AGENT); }
DEVI unsigned xb_xcc_id() { return (unsigned)__builtin_amdgcn_s_getreg((3 << 11) | 20) & 0xFu; }
#define XB_SPIN(cond, bar) do { unsigned _sp = 0; while (cond) { __builtin_amdgcn_s_sleep(1); \
    if ((++_sp & 255u) == 0u) { if (xb_ld(&(bar)[XB_TMO])) break; if (_sp > XB_SPIN_CAP) { atomicAdd(&(bar)[XB_TMO], 1u); break; } } } } while (0)
DEVI void xcd_barrier_post(unsigned* bar) {
  if (TIDX == 0) (void)xb_add(&bar[XB_XCNT(xb_xcc_id())], 1u);
}
DEVI void xcd_barrier_complete(unsigned* bar, unsigned x, unsigned& nloc, unsigned& nx) {
  const unsigned G = gridDim.x * gridDim.y * gridDim.z;
  unsigned sum, cnt, mine, sp = 0u;
  for (;;) {
    sum = 0u; cnt = 0u; mine = 0u;
#pragma unroll
    for (unsigned j = 0; j < 16; ++j) { const unsigned c = xb_ld(&bar[XB_XCNT(j)]); sum += c; cnt += (c > 0u) ? 1u : 0u; mine = (j == x) ? c : mine; }
    if (sum == G) break;
    __builtin_amdgcn_s_sleep(1);
    if ((++sp & 255u) == 0u) { if (xb_ld(&bar[XB_TMO])) break; if (sp > XB_SPIN_CAP) { atomicAdd(&bar[XB_TMO], 1u); break; } }
  }
  nloc = mine > 0u ? mine : 1u; nx = cnt > 0u ? cnt : 1u;
}
DEVI void xcd_barrier(unsigned* bar, volatile LAS unsigned* st) {
  asm volatile("s_waitcnt vmcnt(0)" ::: "memory");
  __syncthreads();
  if (TIDX == 0) {
    const unsigned x = xb_xcc_id();
    __builtin_amdgcn_s_waitcnt(0);
    unsigned nloc = st[0], nx = st[1];
    if (nloc == 0u) { xcd_barrier_complete(bar, x, nloc, nx); st[0] = nloc; st[1] = nx; }
    const unsigned old = xb_add(&bar[XB_XSUB(x)], 1u);
    const unsigned gen = old / nloc;
    if (old + 1u == (gen + 1u) * nloc) {
      __builtin_amdgcn_fence(__ATOMIC_RELEASE, "agent");
      asm volatile("s_waitcnt vmcnt(0)" ::: "memory");
      const unsigned og = xb_add(&bar[XB_TOP], 1u);
      const unsigned tg = og / nx;
      if (og + 1u == (tg + 1u) * nx) xb_add(&bar[XB_TOPGEN], 1u);
      else XB_SPIN(xb_ld(&bar[XB_TOPGEN]) == tg, bar);
      __builtin_amdgcn_fence(__ATOMIC_ACQUIRE, "agent");
      xb_add(&bar[XB_XGEN(x)], 1u);
      asm volatile("s_waitcnt vmcnt(0)" ::: "memory");
    } else {
      XB_SPIN(xb_ld(&bar[XB_XGEN(x)]) == gen, bar);
      __builtin_amdgcn_fence(__ATOMIC_ACQUIRE, "agent");
      asm volatile("s_waitcnt vmcnt(0)" ::: "memory");
    }
  }
  __syncthreads();
}

namespace v2 {
typedef LAS unsigned char* ldsp_t;
constexpr int BM = 256, BK = 64, HALF = 128, HTB = HALF * BK * 2, STAGE_BYTES = 8 * HTB;
constexpr int NW = 8;
constexpr int LDS_XTRA = STAGE_BYTES;
constexpr int LDS_BARW = STAGE_BYTES + 16384;
constexpr int LDS_TOTAL = LDS_BARW + 16;

DEVI int lds_byte(int r, int c) { const int st = (r >> 4) * 2 + (c >> 5), rr = r & 15, cc = c & 31, ob = rr * 64 + cc * 2; return st * 1024 + (ob ^ (((ob >> 9) & 1) << 5)); }
DEVI void stage_rc(int b, int& R, int& C) { const int st = b / 1024, sb = b % 1024, swz = sb ^ (((sb >> 9) & 1) << 5); R = (st >> 1) * 16 + swz / 64; C = (st & 1) * 32 + (swz % 64) / 2; }
DEVI int perm32(int rho) { const int n = rho >> 4, i = rho & 15; return 8 * (i >> 2) + 4 * n + (i & 3); }

DEVI void acc_zero(f32x4 (&acc)[2][2][4][2]) {
#pragma unroll
  for (int a = 0; a < 2; ++a)
#pragma unroll
    for (int b = 0; b < 2; ++b)
#pragma unroll
      for (int m = 0; m < 4; ++m)
#pragma unroll
        for (int n = 0; n < 2; ++n) acc[a][b][m][n] = (f32x4){0.f, 0.f, 0.f, 0.f};
}
struct Unit { const char* A; const char* B; const int* rows; int nvalid; int u0, u1, u2, u3; };

typedef int i32x8 __attribute__((ext_vector_type(8)));
typedef int i32x4v __attribute__((ext_vector_type(4)));
DEVI i32x8 cat8(bf16x8 lo, bf16x8 hi) { return __builtin_shufflevector(__builtin_bit_cast(i32x4v, lo), __builtin_bit_cast(i32x4v, hi), 0, 1, 2, 3, 4, 5, 6, 7); }
DEVI const char* sptr(const char* p) {
  const unsigned long long v = (unsigned long long)p;
  const unsigned lo = (unsigned)__builtin_amdgcn_readfirstlane((int)(unsigned)v), hi = (unsigned)__builtin_amdgcn_readfirstlane((int)(unsigned)(v >> 32));
  return (const char*)(((unsigned long long)hi << 32) | lo);
}
template <bool PERM, bool GATHER, bool F8, class Epi, class Sched>
DEVI void gemm_phase(ldsp_t lds, int lda_b, int ldb_b, int nt, const Sched& S, const Epi& E) {
  const int tid = TIDX, wid = __builtin_amdgcn_readfirstlane(tid >> 6), lane = tid & 63, wr = wid >> 2, wc = wid & 3, fr = lane & 15, fq = lane >> 4;
  unsigned voffA[2], voffB[2]; int RA[2], CA2[2];
#pragma unroll
  for (int i = 0; i < 2; ++i) {
    int R, C; stage_rc(tid * 16 + i * 8192, R, C);
    const int Rb = PERM ? ((R & ~31) + perm32(R & 31)) : R;
    RA[i] = R; CA2[i] = C * 2;
    voffA[i] = (unsigned)(R * lda_b + C * 2); voffB[i] = (unsigned)(Rb * ldb_b + C * 2);
  }
  const size_t kstep = (size_t)(BK * 2);
  const size_t hstepA = (size_t)HALF * lda_b, hstepB = (size_t)HALF * ldb_b;
  const unsigned ldsw = (unsigned)wid * 1024u, ldsbase = (unsigned)(size_t)lds;
  const int aoff = lds_byte(wr * 64 + fr, fq * 8), boff = lds_byte(wc * 32 + fr, fq * 8);
#define G_SA(b, h) (((b) * 2 + (h)) * HTB)
#define G_SB(b, h) ((4 + (b) * 2 + (h)) * HTB)
#define G_DMA(sbase, voff, ldsaddr) asm volatile("s_mov_b32 m0, %2\n\ts_nop 0\n\tglobal_load_lds_dwordx4 %0, %1" :: "v"(voff), "s"(sbase), "s"(ldsaddr) : "memory", "m0")
#define G_STAGE(bufoff, gbase, voff) do { const char* sb_ = sptr((const char*)(gbase)); _Pragma("unroll") for (int _i = 0; _i < 2; ++_i) \
    G_DMA(sb_, (voff)[_i], (unsigned)__builtin_amdgcn_readfirstlane((int)(ldsbase + (unsigned)(bufoff) + ldsw + (unsigned)_i * 8192u))); } while (0)
#define G_STAGE_A(bufoff, abase, go, h, koff) do { if (GATHER) { const char* sb_ = sptr((const char*)(abase) + (koff)); _Pragma("unroll") for (int _i = 0; _i < 2; ++_i) \
    G_DMA(sb_, (go)[h][_i], (unsigned)__builtin_amdgcn_readfirstlane((int)(ldsbase + (unsigned)(bufoff) + ldsw + (unsigned)_i * 8192u))); } \
    else G_STAGE(bufoff, (abase) + (h) * hstepA + (koff), voffA); } while (0)
#define G_LDA(dst, b, h) do { _Pragma("unroll") for (int m = 0; m < 4; ++m) { if (F8) dst##8[m] = cat8(*(const LAS bf16x8*)(lds + G_SA(b, h) + aoff + m * 2048), *(const LAS bf16x8*)(lds + G_SA(b, h) + aoff + m * 2048 + 1024)); \
    else { _Pragma("unroll") for (int k = 0; k < 2; ++k) dst[m][k] = *(const LAS bf16x8*)(lds + G_SA(b, h) + aoff + m * 2048 + k * 1024); } } } while (0)
#define G_LDB(dst, b, h) do { _Pragma("unroll") for (int n = 0; n < 2; ++n) { if (F8) dst##8[n] = cat8(*(const LAS bf16x8*)(lds + G_SB(b, h) + boff + n * 2048), *(const LAS bf16x8*)(lds + G_SB(b, h) + boff + n * 2048 + 1024)); \
    else { _Pragma("unroll") for (int k = 0; k < 2; ++k) dst[n][k] = *(const LAS bf16x8*)(lds + G_SB(b, h) + boff + n * 2048 + k * 1024); } } } while (0)
#define G_MMA(ai, bj, At, Bt) do { __builtin_amdgcn_s_setprio(1); _Pragma("unroll") for (int m = 0; m < 4; ++m) _Pragma("unroll") for (int n = 0; n < 2; ++n) { \
    if (F8) asm("v_mfma_scale_f32_16x16x128_f8f6f4 %0, %1, %2, %0, %3, %4 op_sel_hi:[0,0,0]" : "+v"(acc[ai][bj][m][n]) : "v"(Bt##8[n]), "v"(At##8[m]), "v"(f8wscale), "v"(f8ascale)); \
    else { _Pragma("unroll") for (int k = 0; k < 2; ++k) acc[ai][bj][m][n] = __builtin_amdgcn_mfma_f32_16x16x32_bf16(Bt[n][k], At[m][k], acc[ai][bj][m][n], 0, 0, 0); } } \
    __builtin_amdgcn_s_setprio(0); } while (0)
#define G_WAIT_V(n) asm volatile("s_waitcnt vmcnt(" #n ")" ::: "memory")
#define G_WAIT_L(n) asm volatile("s_waitcnt lgkmcnt(" #n ")" ::: "memory")
#define G_BAR __builtin_amdgcn_s_barrier()
#define G_SCHED __builtin_amdgcn_sched_barrier(0)
  Unit cur, nxt; int ui = 0;
  if (!S.next(0, cur)) return;
  f32x4 acc[2][2][4][2];
  E.init(acc, cur, wr, wc, fr, fq);
  bf16x8 At[4][2], B0[2][2], B1[2][2];
  i32x8 At8[4], B08[2], B18[2];
  const int f8wscale = 0x79797979, f8ascale = 0x7f7f7f7f;
  unsigned gcur[2][2];
  auto gather_offs = [&](const Unit& u, unsigned (&go)[2][2]) {
#pragma unroll
    for (int h = 0; h < 2; ++h)
#pragma unroll
      for (int i = 0; i < 2; ++i) {
        const int r = h * HALF + RA[i];
        const int t = (r < u.nvalid) ? (u.rows[r] >> 1) : 0;
        go[h][i] = (unsigned)t * (unsigned)lda_b + (unsigned)CA2[i];
      }
  };
  if (GATHER) gather_offs(cur, gcur);
  const char* cA = cur.A; const char* cB = cur.B;
  G_STAGE(G_SB(0, 0), cB, voffB); G_STAGE_A(G_SA(0, 0), cA, gcur, 0, 0); G_STAGE(G_SB(0, 1), cB + hstepB, voffB); G_STAGE_A(G_SA(0, 1), cA, gcur, 1, 0);
  if (wr == 1) G_BAR;
  G_WAIT_V(4); G_BAR;
  G_STAGE(G_SB(1, 0), cB + kstep, voffB); G_STAGE_A(G_SA(1, 0), cA, gcur, 0, kstep); G_STAGE(G_SB(1, 1), cB + hstepB + kstep, voffB);
  G_WAIT_V(6); G_BAR;
  for (;;) {
    const bool has_next = S.next(ui + 1, nxt);
    const char* nA = has_next ? nxt.A : cA; const char* nB = has_next ? nxt.B : cB;
#pragma clang loop unroll(disable)
    for (int t = 0; t < nt; t += 2) {
      const bool last = (t == nt - 2);
      const size_t k1 = (size_t)(t + 1) * kstep;
      const char* a2 = last ? nA : cA; const char* b2 = last ? nB : cB + (size_t)(t + 2) * kstep;
      const size_t ka2 = last ? 0 : (size_t)(t + 2) * kstep;
      const char* b3 = b2 + kstep; const size_t ka3 = ka2 + kstep;
      unsigned gN[2][2];
      if (GATHER && last) {
        if (has_next) gather_offs(nxt, gN);
        else {
#pragma unroll
          for (int h = 0; h < 2; ++h)
#pragma unroll
            for (int i = 0; i < 2; ++i) gN[h][i] = gcur[h][i];
        }
      }
#define G_STAGE_A2(bufoff, h, koff) do { if (GATHER) { if (last) G_STAGE_A(bufoff, cA, gN, h, (koff) - ka2); else G_STAGE_A(bufoff, cA, gcur, h, koff); } \
        else G_STAGE_A(bufoff, a2, gcur, h, koff); } while (0)
      G_LDB(B0, 0, 0); G_SCHED; G_LDA(At, 0, 0); G_STAGE_A(G_SA(1, 1), cA, gcur, 1, k1);
      G_WAIT_L(8); G_BAR; G_WAIT_L(0); G_MMA(0, 0, At, B0); G_BAR; G_SCHED;
      G_LDB(B1, 0, 1); G_STAGE(G_SB(0, 0), b2, voffB);
      G_BAR; G_WAIT_L(0); G_MMA(0, 1, At, B1); G_BAR;
      G_LDA(At, 0, 1); G_STAGE_A2(G_SA(0, 0), 0, ka2);
      G_BAR; G_WAIT_L(0); G_MMA(1, 0, At, B0); G_BAR; G_SCHED;
      G_STAGE(G_SB(0, 1), b2 + hstepB, voffB);
      G_WAIT_V(6); G_BAR; G_MMA(1, 1, At, B1); G_BAR;
      G_LDB(B0, 1, 0); G_SCHED; G_LDA(At, 1, 0); G_STAGE_A2(G_SA(0, 1), 1, ka2);
      G_WAIT_L(8); G_BAR; G_WAIT_L(0); G_MMA(0, 0, At, B0); G_BAR; G_SCHED;
      G_LDB(B1, 1, 1); G_STAGE(G_SB(1, 0), b3, voffB);
      G_BAR; G_WAIT_L(0); G_MMA(0, 1, At, B1); G_BAR;
      G_LDA(At, 1, 1); G_STAGE_A2(G_SA(1, 0), 0, ka3);
      G_BAR; G_WAIT_L(0); G_MMA(1, 0, At, B0); G_BAR; G_SCHED;
      G_STAGE(G_SB(1, 1), b3 + hstepB, voffB);
      G_WAIT_V(6); G_BAR; G_MMA(1, 1, At, B1); G_BAR;
      if (GATHER && last) {
#pragma unroll
        for (int h = 0; h < 2; ++h)
#pragma unroll
          for (int i = 0; i < 2; ++i) gcur[h][i] = gN[h][i];
      }
#undef G_STAGE_A2
    }
    G_SCHED;
    if (F8) {
      asm volatile("s_nop 15\n\ts_nop 15" ::: "memory");
#pragma unroll
      for (int a_ = 0; a_ < 2; ++a_)
#pragma unroll
        for (int b_ = 0; b_ < 2; ++b_)
#pragma unroll
          for (int m_ = 0; m_ < 4; ++m_)
#pragma unroll
            for (int n_ = 0; n_ < 2; ++n_) asm volatile("" : "+v"(acc[a_][b_][m_][n_]));
    }
    E(acc, cur, wr, wc, fr, fq);
    G_SCHED;
    if (!has_next) break;
    cur = nxt; cA = nA; cB = nB; ++ui;
    E.init(acc, cur, wr, wc, fr, fq);
  }
  G_WAIT_V(0);
  if (wr == 0) G_BAR;
  G_BAR;
#undef G_SA
#undef G_SB
#undef G_STAGE
#undef G_DMA
#undef G_STAGE_A
#undef G_LDA
#undef G_LDB
#undef G_MMA
#undef G_WAIT_V
#undef G_WAIT_L
#undef G_BAR
#undef G_SCHED
}

DEVI unsigned uoff(unsigned x) { return (unsigned)__builtin_amdgcn_readfirstlane((int)x); }
DEVI bool tile_order(int i, int G, int c, int nM, int nN, int& pm, int& pn) {
  const int nwg = nM * nN;
  const long L = (long)i * G + c; if (L >= nwg) return false;
  int wgid = (int)L; { const int q = nwg / 8, r = nwg % 8, xcd = wgid % 8, off = wgid / 8; wgid = (xcd < r ? xcd * (q + 1) : r * (q + 1) + (xcd - r) * q) + off; }
  const int WGM = 8;
  const int nig = WGM * nN, gid = wgid / nig, fm = gid * WGM, gsz = (nM - fm) < WGM ? (nM - fm) : WGM;
  pm = fm + ((wgid % nig) % gsz); pn = (wgid % nig) / gsz;
  pm = __builtin_amdgcn_readfirstlane(pm); pn = __builtin_amdgcn_readfirstlane(pn);
  return true;
}
struct EpiRawBf16 {
  u16* O; int ldc; float sc;
  DEVI void init(f32x4 (&acc)[2][2][4][2], const Unit&, int, int, int, int) const { acc_zero(acc); }
  DEVI void operator()(const f32x4 (&acc)[2][2][4][2], const Unit& u, int wr, int wc, int fr, int fq) const {
    const unsigned off0 = ((unsigned)(u.u0 + wr * 64 + fr) * (unsigned)ldc + (unsigned)(u.u1 + wc * 32 + 8 * fq)) * 2u;
#pragma unroll
    for (int ai = 0; ai < 2; ++ai)
#pragma unroll
      for (int m = 0; m < 4; ++m) {
        char* rowp = (char*)O + (off0 + (unsigned)(ai * HALF + m * 16) * (unsigned)ldc * 2u);
#pragma unroll
        for (int bj = 0; bj < 2; ++bj) {
          const f32x4 v0 = acc[ai][bj][m][0] * sc, v1 = acc[ai][bj][m][1] * sc;
          u32x4 w; w.x = pk2(v0[0], v0[1]); w.y = pk2(v0[2], v0[3]); w.z = pk2(v1[0], v1[1]); w.w = pk2(v1[2], v1[3]);
          *(u32x4*)(rowp + bj * HALF * 2) = w;
        }
      }
  }
};

struct EpiRawF8 {
  unsigned char* O; int ldc; float sc;
  DEVI void init(f32x4 (&acc)[2][2][4][2], const Unit&, int, int, int, int) const { acc_zero(acc); }
  DEVI void operator()(const f32x4 (&acc)[2][2][4][2], const Unit& u, int wr, int wc, int fr, int fq) const {
    const unsigned off0 = (unsigned)(u.u0 + wr * 64 + fr) * (unsigned)ldc + (unsigned)(u.u1 + wc * 32 + 8 * fq);
#pragma unroll
    for (int ai = 0; ai < 2; ++ai)
#pragma unroll
      for (int m = 0; m < 4; ++m) {
        unsigned char* rowp = O + (off0 + (unsigned)(ai * HALF + m * 16) * (unsigned)ldc);
#pragma unroll
        for (int bj = 0; bj < 2; ++bj) {
          u32x2 w;
#pragma unroll
          for (int n = 0; n < 2; ++n) {
            const f32x4 v = acc[ai][bj][m][n] * sc;
            int q = __builtin_amdgcn_cvt_pk_fp8_f32(__builtin_amdgcn_fmed3f(v[0], -448.f, 448.f), __builtin_amdgcn_fmed3f(v[1], -448.f, 448.f), 0, false);
            q = __builtin_amdgcn_cvt_pk_fp8_f32(__builtin_amdgcn_fmed3f(v[2], -448.f, 448.f), __builtin_amdgcn_fmed3f(v[3], -448.f, 448.f), q, true);
            w[n] = (unsigned)q;
          }
          *(u32x2*)(rowp + bj * HALF) = w;
        }
      }
  }
};
DEVI size_t z8_block(int pm, int branch, int cb) { return (size_t)((pm * 4 + branch) * 8 + cb) * 32768; }
struct EpiZ8 {
  unsigned char* O;
  DEVI void init(f32x4 (&acc)[2][2][4][2], const Unit&, int, int, int, int) const { acc_zero(acc); }
  DEVI void operator()(const f32x4 (&acc)[2][2][4][2], const Unit& u, int wr, int wc, int fr, int fq) const {
    const int pm = u.u0 >> 8, pn = u.u1 >> 8, n = pn >> 2, cq = pn & 3;
    const unsigned lw16 = (unsigned)((wr * 4 + wc) * 64 + fr + 16 * fq) * 16u;
#pragma unroll
    for (int bj = 0; bj < 2; ++bj) {
      unsigned char* blk = O + z8_block(pm, n, cq * 2 + bj) + lw16;
#pragma unroll
      for (int P = 0; P < 4; ++P) {
        u32x4 w;
#pragma unroll
        for (int h = 0; h < 2; ++h)
#pragma unroll
          for (int nn = 0; nn < 2; ++nn) {
            const int g = 2 * P + h;
            const f32x4 v = acc[g >> 2][bj][g & 3][nn] * (Z8_SCALE / O8_SCALE);
            int q = __builtin_amdgcn_cvt_pk_fp8_f32(__builtin_amdgcn_fmed3f(v[0], -448.f, 448.f), __builtin_amdgcn_fmed3f(v[1], -448.f, 448.f), 0, false);
            q = __builtin_amdgcn_cvt_pk_fp8_f32(__builtin_amdgcn_fmed3f(v[2], -448.f, 448.f), __builtin_amdgcn_fmed3f(v[3], -448.f, 448.f), q, true);
            w[2 * h + nn] = (unsigned)q;
          }
        *(u32x4*)(blk + P * 8192) = w;
      }
    }
  }
};
struct SchedB { const char* ws; const char* h8; int G, c;
  DEVI bool next(int i, Unit& u) const { int pm, pn; if (!tile_order(i, G, c, NTOK / 256, INP / 256, pm, pn)) return false;
    u.A = h8 + uoff((unsigned)pm * 256u * 1024u); u.B = ws + OFF_WIN + uoff((unsigned)pn * 256u * 1024u);        u.rows = nullptr; u.nvalid = 0; u.u0 = pm * 256; u.u1 = pn * 256; u.u2 = 0; u.u3 = 0; return true; } };
struct EpiB { u16* O; float* ssq;
  DEVI void init(f32x4 (&acc)[2][2][4][2], const Unit&, int, int, int, int) const { acc_zero(acc); }
  DEVI void operator()(const f32x4 (&acc)[2][2][4][2], const Unit& u, int wr, int wc, int fr, int fq) const {
    EpiRawBf16 E{O, PLD, 1.f}; E(acc, u, wr, wc, fr, fq);
    if (u.u1 < 512) {
      const bool iskv = u.u1 != 0;
#pragma unroll
      for (int ai = 0; ai < 2; ++ai)
#pragma unroll
        for (int m = 0; m < 4; ++m) {
          float ss = 0.f;
#pragma unroll
          for (int bj = 0; bj < 2; ++bj)
#pragma unroll
            for (int n = 0; n < 2; ++n)
#pragma unroll
              for (int j = 0; j < 4; ++j) { const float v = acc[ai][bj][m][n][j]; if (!(iskv && bj == 1)) ss += v * v; }
          ss += __shfl_xor(ss, 16); ss += __shfl_xor(ss, 32);
          if (fq == 0) ssq[(size_t)(u.u0 + ai * HALF + wr * 64 + m * 16 + fr) * 8 + (iskv ? 4 : 0) + wc] = ss;
        }
    }
  }
};
DEVI void phaseB2(KP p, ldsp_t lds) {
  SchedB S{(const char*)p->ws, (const char*)h8base(p), (int)gridDim.x, BIDX};
  EpiB E{wsp<u16>(p, OFF_PRAW), wsp<float>(p, OFF_SSQ)};
  gemm_phase<true, false, true>(lds, 1024, 1024, 8, S, E);
}
struct SchedC { const char* ws; int G, c;
  DEVI bool next(int i, Unit& u) const { int pm, pn; if (!tile_order(i, G, c, NTOK / 256, 4, pm, pn)) return false;
    const bool kv = pn >= 2; const int pj = pn & 1;
    u.A = ws + OFF_PRAW + uoff((unsigned)pm * 256u * (unsigned)(PLD * 2) + (kv ? 512u : 0u)); u.B = ws + (kv ? OFF_WKVB : OFF_WQB) + uoff((unsigned)pj * 256u * 512u); u.rows = nullptr; u.nvalid = 0;
    u.u0 = pm * 256; u.u1 = pj * 256; u.u2 = kv; u.u3 = 0; return true; } };
struct EpiC { u16* Oq; u16* Okv; const float* ssq;
  DEVI void init(f32x4 (&acc)[2][2][4][2], const Unit&, int, int, int, int) const { acc_zero(acc); }
  DEVI void operator()(const f32x4 (&acc)[2][2][4][2], const Unit& u, int wr, int wc, int fr, int fq) const {
    const bool kv = u.u2 != 0;
    u16* O = kv ? Okv : Oq;
    const int row0 = u.u0 + wr * 64 + fr, col0 = u.u1 + wc * 32 + 8 * fq;
    f32x4 sq[2][4];
#pragma unroll
    for (int ai = 0; ai < 2; ++ai)
#pragma unroll
      for (int m = 0; m < 4; ++m) sq[ai][m] = *(const f32x4*)(ssq + (size_t)(row0 + ai * HALF + m * 16) * 8 + (kv ? 4 : 0));
#pragma unroll
    for (int ai = 0; ai < 2; ++ai)
#pragma unroll
      for (int m = 0; m < 4; ++m) {
        const size_t r = (size_t)(row0 + ai * HALF + m * 16);
        const float tot = sq[ai][m].x + sq[ai][m].y + sq[ai][m].z + sq[ai][m].w;
        const float sc = kv ? rsqrtf(tot * (1.f / 128.f) + EPS) : rsqrtf(tot * (1.f / 256.f) + EPS) * (0.10206207261596575f * LOG2E);
        u16* rowp = O + r * 512 + col0;
#pragma unroll
        for (int bj = 0; bj < 2; ++bj) {
          const f32x4 v0 = acc[ai][bj][m][0] * sc, v1 = acc[ai][bj][m][1] * sc;
          u32x4 w; w.x = pk2(v0[0], v0[1]); w.y = pk2(v0[2], v0[3]); w.z = pk2(v1[0], v1[1]); w.w = pk2(v1[2], v1[3]);
          *(u32x4*)(rowp + bj * HALF) = w;
        }
      }
  }
};
DEVI void phaseC2(KP p, ldsp_t lds) {
  SchedC S{(const char*)p->ws, (int)gridDim.x, BIDX};
  EpiC E{wsp<u16>(p, OFF_QARAW), wsp<u16>(p, OFF_KVARAW), wsp<float>(p, OFF_SSQ)};
  int nt = 4; asm volatile("" : "+s"(nt));
  gemm_phase<true, false, false>(lds, PLD * 2, 512, nt, S, E);
}

DEVI void ld16(const u16* src, float (&v)[16]) {
  const u32x4 a = *(const u32x4*)src, b = *(const u32x4*)(src + 8);
  const unsigned w[8] = {a.x, a.y, a.z, a.w, b.x, b.y, b.z, b.w};
#pragma unroll
  for (int i = 0; i < 8; ++i) { v[2 * i] = __uint_as_float(w[i] << 16); v[2 * i + 1] = __uint_as_float(w[i] & 0xffff0000u); }
}
DEVI void st16(u16* dst, const float (&v)[16]) {
  u32x4 a, b;
  a.x = pk2(v[0], v[1]); a.y = pk2(v[2], v[3]); a.z = pk2(v[4], v[5]); a.w = pk2(v[6], v[7]);
  b.x = pk2(v[8], v[9]); b.y = pk2(v[10], v[11]); b.z = pk2(v[12], v[13]); b.w = pk2(v[14], v[15]);
  *(u32x4*)dst = a; *(u32x4*)(dst + 8) = b;
}
DEVI void rope16c(float (&v)[16], const float* cs16, int pos) {
  const f32x2* t = (const f32x2*)(cs16 + pos * 16);
#pragma unroll
  for (int i = 0; i < 8; ++i) { const f32x2 cs = t[i]; const float x1 = v[i], x2 = v[8 + i]; v[i] = x1 * cs.x - x2 * cs.y; v[8 + i] = x2 * cs.x + x1 * cs.y; }
}
DEVI void rope32c(float (&lo)[16], float (&hi)[16], const float* cs32, int pos) {
  const f32x2* t = (const f32x2*)(cs32 + pos * 32);
#pragma unroll
  for (int i = 0; i < 16; ++i) { const f32x2 cs = t[i]; const float x1 = lo[i], x2 = hi[i]; lo[i] = x1 * cs.x - x2 * cs.y; hi[i] = x2 * cs.x + x1 * cs.y; }
}
DEVI float ssq16(const float (&v)[16]) { float s = 0.f;
#pragma unroll
  for (int i = 0; i < 16; ++i) s += v[i] * v[i];
  return s; }
DEVI void scale16(float (&v)[16], float s) {
#pragma unroll
  for (int i = 0; i < 16; ++i) v[i] *= s; }
DEVI void cvt16(const u32x4 a, const u32x4 b, float (&v)[16]) {
  const unsigned w[8] = {a.x, a.y, a.z, a.w, b.x, b.y, b.z, b.w};
#pragma unroll
  for (int i = 0; i < 8; ++i) { v[2 * i] = __uint_as_float(w[i] << 16); v[2 * i + 1] = __uint_as_float(w[i] & 0xffff0000u); }
}
DEVI void phaseP2(KP p, int l, ldsp_t lds) {
  const int tid = TIDX, tk = tid >> 3, pt = tid & 7;
  u16* PR = wsp<u16>(p, OFF_PRAW);
  u16* QA = wsp<u16>(p, OFF_QARAW);
  const float* cs32 = wsp<float>(p, OFF_CS32);
  const float* cs16 = wsp<float>(p, OFF_CS16);
  const float QS = 0.125f * LOG2E;
  for (int item = BIDX; item < NTOK / 64; item += gridDim.x) {
    const int tok0 = item * 64, rr0 = tok0 % TPB;
    const bool lat = rr0 >= NCTX;
    const size_t tok = (size_t)tok0 + tk;
    const int t = rr0 + tk - NCTX, grow = (t >> 6) & 63, gcol = t & 63;
    u16* pr = PR + tok * PLD;
    u16* qar = QA + tok * 512 + 96 * (pt >> 1) + 64 + 16 * (pt & 1);
    const int g4 = pt & 3;
    u32x4 r_qa[2], r_kr[2], r_qb[4], r_kb[4], r_qd[4], r_kd[4];
#define LD8(ptr) (*(const u32x4*)(ptr))
    if (lat) {
#pragma unroll
      for (int i = 0; i < 2; ++i) { r_qa[i] = LD8(qar + 8 * i); r_kr[i] = LD8(pr + 384 + 16 * (pt & 1) + 8 * i); }
#pragma unroll
      for (int i = 0; i < 4; ++i) { r_qb[i] = LD8(pr + 512 + 32 * pt + 8 * i); r_kb[i] = LD8(pr + 768 + 32 * g4 + 8 * i); }
    }
#pragma unroll
    for (int i = 0; i < 4; ++i) { r_qd[i] = LD8(pr + 1792 + 32 * pt + 8 * i); r_kd[i] = LD8(pr + 2048 + 32 * g4 + 8 * i); }
#undef LD8
    if (lat) {
      { float v[16]; cvt16(r_qa[0], r_qa[1], v); rope16c(v, cs16, (pt & 1) ? gcol : grow); st16(qar, v); }
      if (pt < 2) { float v[16]; cvt16(r_kr[0], r_kr[1], v); rope16c(v, cs16, pt == 0 ? grow : gcol); st16(pr + 384 + 16 * pt, v); }
      { float lo[16], hi[16]; cvt16(r_qb[0], r_qb[1], lo); cvt16(r_qb[2], r_qb[3], hi); rope32c(lo, hi, cs32, (pt & 1) ? gcol : grow); st16(pr + 512 + 32 * pt, lo); st16(pr + 512 + 32 * pt + 16, hi); }
      if (pt < 4) { float lo[16], hi[16]; cvt16(r_kb[0], r_kb[1], lo); cvt16(r_kb[2], r_kb[3], hi); rope32c(lo, hi, cs32, (pt & 1) ? gcol : grow); st16(pr + 768 + 32 * pt, lo); st16(pr + 768 + 32 * pt + 16, hi); }
    }
    {
      float lo[16], hi[16]; cvt16(r_qd[0], r_qd[1], lo); cvt16(r_qd[2], r_qd[3], hi);
      float ss = ssq16(lo) + ssq16(hi); ss += __shfl_xor(ss, 1);
      const float rs = rsqrtf(ss * (1.f / 64.f) + EPS);
      const float* g = p->g_q_d + l * 64 + 32 * (pt & 1);
#pragma unroll
      for (int i = 0; i < 16; ++i) { lo[i] *= rs * g[i]; hi[i] *= rs * g[16 + i]; }
      if (lat) rope32c(lo, hi, cs32, (pt & 1) ? gcol : grow);
      scale16(lo, QS); scale16(hi, QS);
      st16(pr + 1792 + 32 * pt, lo); st16(pr + 1792 + 32 * pt + 16, hi);
    }
    {
      float lo[16], hi[16]; cvt16(r_kd[0], r_kd[1], lo); cvt16(r_kd[2], r_kd[3], hi);
      float ss = ssq16(lo) + ssq16(hi); ss += __shfl_xor(ss, 1);
      const float rs = rsqrtf(ss * (1.f / 64.f) + EPS);
      const float* g = p->g_k_d + l * 64 + 32 * (g4 & 1);
#pragma unroll
      for (int i = 0; i < 16; ++i) { lo[i] *= rs * g[i]; hi[i] *= rs * g[16 + i]; }
      if (lat) rope32c(lo, hi, cs32, (g4 & 1) ? gcol : grow);
      if (pt < 4) { st16(pr + 2048 + 32 * g4, lo); st16(pr + 2048 + 32 * g4 + 16, hi); }
    }
  }
}

DEVI void conv_load(const ConvT& c, int lane, f32x4 (&v)[8]) {
  const int kk = lane >> 3, n4 = (lane & 7) * 4;
  const float* sp = (c.src2 && n4 >= 16) ? c.src2 + (n4 - 16) : (c.src ? c.src + n4 : nullptr);
#pragma unroll
  for (int i = 0; i < 8; ++i) v[i] = sp ? *(const f32x4*)(sp + (size_t)(kk + 8 * i) * c.ld) : f32x4{0.f, 0.f, 0.f, 0.f};
}
DEVI void conv_store(const ConvT& c, LAS float* t, int lane, const f32x4 (&v)[8]) {
  const int kk = lane >> 3, n4 = (lane & 7) * 4;
#pragma unroll
  for (int i = 0; i < 8; ++i) {
    const int k = kk + 8 * i;
    const float s = (c.ks ? c.ks[k] : 1.f) * c.mul;
    t[(n4 + 0) * 65 + k] = v[i].x * s; t[(n4 + 1) * 65 + k] = v[i].y * s;
    t[(n4 + 2) * 65 + k] = v[i].z * s; t[(n4 + 3) * 65 + k] = v[i].w * s;
  }
  asm volatile("s_waitcnt lgkmcnt(0)" ::: "memory");
  const int n = lane >> 1, k0 = (lane & 1) * 32;
  const LAS float* r = t + n * 65 + k0;
  if (c.ldd < 0) {
    unsigned char* d8 = (unsigned char*)c.dst + (size_t)n * (size_t)(-c.ldd) + k0;
#pragma unroll
    for (int q = 0; q < 2; ++q) {
      u32x4 o;
#pragma unroll
      for (int w = 0; w < 4; ++w) {
        float f[4];
#pragma unroll
        for (int j = 0; j < 4; ++j) f[j] = __builtin_amdgcn_fmed3f(r[16 * q + 4 * w + j], -448.f, 448.f);
        int v = __builtin_amdgcn_cvt_pk_fp8_f32(f[0], f[1], 0, false);
        v = __builtin_amdgcn_cvt_pk_fp8_f32(f[2], f[3], v, true);
        o[w] = (unsigned)v;
      }
      *(u32x4*)(d8 + 16 * q) = o;
    }
    asm volatile("s_waitcnt lgkmcnt(0)" ::: "memory");
    return;
  }
  u16* d = c.dst + (size_t)n * c.ldd + k0;
#pragma unroll
  for (int q = 0; q < 4; ++q) {
    u32x4 o;
    o.x = pk2(r[8 * q], r[8 * q + 1]); o.y = pk2(r[8 * q + 2], r[8 * q + 3]); o.z = pk2(r[8 * q + 4], r[8 * q + 5]); o.w = pk2(r[8 * q + 6], r[8 * q + 7]);
    *(u32x4*)(d + 8 * q) = o;
  }
  asm volatile("s_waitcnt lgkmcnt(0)" ::: "memory");
}
constexpr int CONV_EARLY = 1152 + 64 + 64;
DEVI void conv_items2(KP p, int l, ldsp_t lds, int first_item, int total_items) {
  const int tid = TIDX, wave = __builtin_amdgcn_readfirstlane(tid >> 6), lane = tid & 63;
  LAS float* t = (LAS float*)(lds + wave * 8448);
  __syncthreads();
  const int stride = gridDim.x * NW;
  int item = first_item + BIDX * NW + wave;
  if (item >= total_items) return;
  ConvT c = conv_decode(p, l, item);
  f32x4 v[8];
  conv_load(c, lane, v);
  for (;;) {
    const int nitem = item + stride;
    const bool more = nitem < total_items;
    ConvT cn = c; f32x4 vn[8];
    if (more) { cn = conv_decode(p, l, nitem); conv_load(cn, lane, vn); }
    conv_store(c, t, lane, v);
    if (!more) break;
    c = cn; item = nitem;
#pragma unroll
    for (int i = 0; i < 8; ++i) v[i] = vn[i];
  }
}
template <int BR>
DEVI void attn_mask(f32x16 (&s)[2], int kt, int qlat, int qrow, int qcol, int hh, LAS float* rpb) {
  if (BR == 1) {
#pragma unroll
    for (int kb = 0; kb < 2; ++kb)
#pragma unroll
      for (int i = 0; i < 16; ++i) {
        const int kpos = kt * 64 + kb * 32 + (i & 3) + 8 * (i >> 2) + 4 * hh;
        const int d = qlat - kpos;
        if (d > 128 || d < -128) s[kb][i] = -1e30f;
      }
  } else {
    const int rs = min(max(qrow - 4, 0), 56);
    const bool row_ok = (kt >= rs) && (kt < rs + 8);
    const int cst = min(max(qcol - 8, 0), 48);
    const int dr = kt - qrow + 7;
#pragma unroll
    for (int kb = 0; kb < 2; ++kb)
#pragma unroll
      for (int i = 0; i < 16; ++i) {
        const int kc = kb * 32 + (i & 3) + 8 * (i >> 2) + 4 * hh;
        const bool ok = row_ok && (kc >= cst) && (kc < cst + 16);
        const int idx = ok ? (dr * 31 + (kc - qcol + 15)) : 0;
        const float bias = rpb[idx];
        s[kb][i] = ok ? (s[kb][i] + bias) : -1e30f;
      }
  }
}

template <int BR>
DEVI void attn_mask1(f32x16& sb, int kb, int kt, int qlat, int qrow, int qcol, int hh, LAS float* rpb) {
  if (BR == 1) {
#pragma unroll
    for (int i = 0; i < 16; ++i) {
      const int kpos = kt * 64 + kb * 32 + (i & 3) + 8 * (i >> 2) + 4 * hh;
      const int d = qlat - kpos;
      if (d > 128 || d < -128) sb[i] = -1e30f;
    }
  } else {
    const int rs = min(max(qrow - 4, 0), 56);
    const bool row_ok = (kt >= rs) && (kt < rs + 8);
    const int cst = min(max(qcol - 8, 0), 48);
    const int dr = kt - qrow + 7;
#pragma unroll
    for (int i = 0; i < 16; ++i) {
      const int kc = kb * 32 + (i & 3) + 8 * (i >> 2) + 4 * hh;
      const bool ok = row_ok && (kc >= cst) && (kc < cst + 16);
      const int idx = ok ? (dr * 31 + (kc - qcol + 15)) : 0;
      const float bias = rpb[idx];
      sb[i] = ok ? (sb[i] + bias) : -1e30f;
    }
  }
}
#define FADD(a, b) do { (a) += (b); asm("" : "+v"(a)); } while (0)
typedef short v4i16_t __attribute__((ext_vector_type(4)));
DEVI bf16x8 vtr2(ldsp_t a) {
  const v4i16_t lo = __builtin_amdgcn_ds_read_tr16_b64_v4i16((LAS v4i16_t*)a);
  const v4i16_t hi = __builtin_amdgcn_ds_read_tr16_b64_v4i16((LAS v4i16_t*)(a + 8 * 144));
  return __builtin_shufflevector(lo, hi, 0, 1, 2, 3, 4, 5, 6, 7);
}
DEVI bf16x8 vtr2s(ldsp_t a, int o0, int o1) {
  const v4i16_t lo = __builtin_amdgcn_ds_read_tr16_b64_v4i16((LAS v4i16_t*)(a + o0));
  const v4i16_t hi = __builtin_amdgcn_ds_read_tr16_b64_v4i16((LAS v4i16_t*)(a + 8 * 128 + o1));
  return __builtin_shufflevector(lo, hi, 0, 1, 2, 3, 4, 5, 6, 7);
}
template <int BR, bool FAST>
DEVI bool attn_item2(KP p, int l, int b, int hs, int qb, bool isctx, ldsp_t lds) {
  constexpr bool MLA = (BR == 0);
  constexpr bool GQA = (BR == 1 || BR == 3);
  constexpr int QBLK = GQA ? 256 : 512;
  constexpr int NKS = MLA ? 6 : 4;
  constexpr int STG = 8192 + 8192 + 4096;
  const int tid = TIDX, lane = tid & 63, wave = __builtin_amdgcn_readfirstlane(tid >> 6);
  const int r32 = lane & 31, hh = lane >> 5;
  const int hq = GQA ? (hs * 2 + (wave & 1)) : hs;
  const int woff = GQA ? 64 * (wave >> 1) : 64 * wave;
  const int q0 = (isctx ? 0 : NCTX) + qb * QBLK;
  const bool active = !isctx || (woff < NCTX);
  const size_t tokq = (size_t)b * TPB + q0 + (active ? woff : 0) + r32;
  const u16* Qp; const u16* Kp; int ldk; const u16* Vp; int ldv; int obase; int ldq;
  const u16* PR = wsp<u16>(p, OFF_PRAW);
  if (BR == 0) { Qp = wsp<u16>(p, OFF_QARAW) + tokq * 512 + hq * 96; ldq = 512; Kp = wsp<u16>(p, OFF_KVARAW) + (size_t)b * TPB * 512 + hs * 128; ldk = 512; Vp = wsp<u16>(p, OFF_KVARAW) + (size_t)b * TPB * 512 + hs * 128 + 64; ldv = 512; obase = hq * 64; }
  else if (BR == 1) { Qp = PR + tokq * PLD + 512 + hq * 64; ldq = PLD; Kp = PR + (size_t)b * TPB * PLD + 768 + hs * 64; ldk = PLD; Vp = PR + (size_t)b * TPB * PLD + 896 + hs * 64; ldv = PLD; obase = 256 + hq * 64; }
  else if (BR == 2) { Qp = PR + tokq * PLD + 1024 + hq * 64; ldq = PLD; Kp = PR + (size_t)b * TPB * PLD + 1280 + hs * 64; ldk = PLD; Vp = PR + (size_t)b * TPB * PLD + 1536 + hs * 64; ldv = PLD; obase = 512 + hq * 64; }
  else { Qp = PR + tokq * PLD + 1792 + hq * 64; ldq = PLD; Kp = PR + (size_t)b * TPB * PLD + 2048 + hs * 64; ldk = PLD; Vp = PR + (size_t)b * TPB * PLD + 2176 + hs * 64; ldv = PLD; obase = 768 + hq * 64; }
  const u16* KRp = PR + (size_t)b * TPB * PLD + 384;
  int lat_lo = 0, lat_n = 0, wlo = 0, whi = 63;
  if (!isctx) {
    if (BR == 0 || BR == 3) { lat_lo = 0; lat_n = 64; }
    else if (BR == 1) {
      const int ql = qb * QBLK; const int lo = max(0, ql - 128) >> 6, hi = min(SEQ - 1, ql + QBLK - 1 + 128) >> 6; lat_lo = lo; lat_n = hi - lo + 1;
      const int wq = ql + woff; wlo = max(0, wq - 128) >> 6; whi = min(SEQ - 1, wq + 63 + 128) >> 6;
    } else {
      const int r0 = 8 * qb; const int lo = min(max(r0 - 4, 0), 56), hi = min(max(r0 + 7 - 4, 0), 56) + 7; lat_lo = lo; lat_n = hi - lo + 1;
      const int wr_ = r0 + wave; wlo = min(max(wr_ - 4, 0), 56); whi = wlo + 7;
    }
  }
  const int NT = 4 + lat_n;
  const int qlat0 = qb * QBLK + woff + r32;
  bf16x8 qf[2][NKS];
#pragma unroll
  for (int qi = 0; qi < 2; ++qi)
#pragma unroll
    for (int ks = 0; ks < NKS; ++ks) qf[qi][ks] = *(const bf16x8*)(Qp + (size_t)qi * 32 * ldq + ks * 16 + hh * 8);
  const int drow = 8 * wave + (lane >> 3), dch = (lane & 7) ^ ((drow >> 1) & 7);
  const int rrow = 16 * (wave & 3) + (lane >> 2), rch = (lane & 3) ^ ((rrow >> 2) & 3);
  auto keytile = [&](int j) { return (j < 4) ? j : (4 + lat_lo + (j - 4)); };
#define DMA16(sbase, voff, ldsaddr) asm volatile("s_mov_b32 m0, %2\n\ts_nop 0\n\tglobal_load_lds_dwordx4 %0, %1" :: "v"(voff), "s"(sbase), "s"(ldsaddr) : "memory", "m0")
#define A_DMA(j, st) do { const int key0_ = keytile(j) * 64; const unsigned base_ = __builtin_amdgcn_readfirstlane((unsigned)(size_t)(lds + (st) * STG) + wave * 1024); \
    DMA16(Kp, (unsigned)(((key0_ + drow) * ldk + dch * 8) * 2), base_); \
    DMA16(Vp, (unsigned)(((key0_ + drow) * ldv + dch * 8) * 2), base_ + 8192u); \
    if (MLA && wave < 4) DMA16(KRp, (unsigned)(((key0_ + rrow) * PLD + rch * 8) * 2), __builtin_amdgcn_readfirstlane(base_ + 16384u)); \
  } while (0)
  LAS float* rpb = (LAS float*)(lds + 2 * STG);
  __syncthreads();
  if (FAST && tid == 0) *(LAS int*)(lds + 2 * STG + 2048) = 0;
  A_DMA(0, 0);
  if (BR == 2 && !isctx) {
    const float* src = p->rpb_c + (size_t)(l * 4 + hs) * 465;
    for (int i = tid; i < 465; i += 512) rpb[i] = src[i] * LOG2E;
  }
  asm volatile("s_waitcnt vmcnt(0)" ::: "memory");
#pragma unroll
  for (int qi = 0; qi < 2; ++qi)
#pragma unroll
    for (int ks = 0; ks < NKS; ++ks) asm volatile("" : "+v"(qf[qi][ks]));
  __syncthreads();
  f32x16 o[2][2];
#pragma unroll
  for (int qi = 0; qi < 2; ++qi)
#pragma unroll
    for (int i = 0; i < 16; ++i) { o[qi][0][i] = 0.f; o[qi][1][i] = 0.f; }
  float m_run[2], l_run[2];
#pragma unroll
  for (int qi = 0; qi < 2; ++qi) { m_run[qi] = -INFINITY; l_run[qi] = 0.f; }
  if (BR == 1) { const float sk = p->sink_b[l * 4 + hq] * LOG2E; m_run[0] = sk; m_run[1] = sk; l_run[0] = (hh == 0) ? (FAST ? __builtin_amdgcn_exp2f(sk) : 1.f) : 0.f; l_run[1] = l_run[0]; }
  float l2[2][2];
#pragma unroll
  for (int qi = 0; qi < 2; ++qi) { l2[qi][0] = l_run[qi]; l2[qi][1] = 0.f; }
  const int kkey = (r32 >> 1) & 7, rkey = (r32 >> 2) & 3;
  const ldsp_t kfb = lds + r32 * 128;
  const ldsp_t krb = lds + 16384 + r32 * 64;
  const int vq = (lane & 15) >> 2, vkey = 2 * hh + (vq >> 1);
  const int vch = 2 * ((lane >> 4) & 1) + ((lane & 3) >> 1);
  const ldsp_t vfb = lds + 8192 + (4 * hh + vq) * 128 + 8 * (lane & 1);
#define SB() __builtin_amdgcn_sched_barrier(0)
#define KLOAD(kb, ks) (((ks) < 4) ? *(const LAS bf16x8*)(kfb + st + (kb) * 4096 + (((2 * (ks) + hh) ^ kkey) << 4)) : *(const LAS bf16x8*)(krb + st + (kb) * 2048 + (((2 * ((ks) - 4) + hh) ^ rkey) << 4)))
#define VLOAD(s4, db) vtr2s(vfb + st + (s4) * 2048, ((4 * (db) + vch) ^ vkey) << 4, ((4 * (db) + vch) ^ vkey ^ 4) << 4)
#define SM_EL(kb, e) do { const int qi_ = (e) >> 4, i_ = (e) & 15; \
    const float x_ = __builtin_amdgcn_exp2f(s[qi_][kb][i_]); s[qi_][kb][i_] = x_; FADD(l2[qi_][i_ & 1], x_); \
    if (i_ & 1) pw[kb][qi_][i_ >> 3][(i_ & 7) >> 1] = pk2(s[qi_][kb][i_ - 1], x_); } while (0)
#define F_STEP(j) do { \
    const int st = ((j) & 1) * STG; \
    if ((j) + 1 < NT) A_DMA((j) + 1, ((j) + 1) & 1); \
    const int kt_ = lat_lo + (j) - 4; \
    const bool need = active && ((j) < 4 || (kt_ >= wlo && kt_ <= whi)); \
    if (need) { \
      f32x16 s[2][2]; bf16x8 kf[NKS]; bf16x8 vf[4]; u32x4 pw[2][2][2]; \
      const f32x16 zero16 = {0.f, 0.f, 0.f, 0.f, 0.f, 0.f, 0.f, 0.f, 0.f, 0.f, 0.f, 0.f, 0.f, 0.f, 0.f, 0.f}; \
      const bool domask = (BR == 1 || BR == 2) && (j) >= 4; \
      _Pragma("unroll") for (int ks = 0; ks < NKS; ++ks) kf[ks] = KLOAD(0, ks); \
      _Pragma("unroll") for (int ks = 0; ks < NKS; ++ks) { \
        s[0][0] = MFMA(kf[ks], qf[0][ks], ks == 0 ? zero16 : s[0][0]); s[1][0] = MFMA(kf[ks], qf[1][ks], ks == 0 ? zero16 : s[1][0]); \
        SB(); kf[ks] = KLOAD(1, ks); SB(); } \
      if (domask) { _Pragma("unroll") for (int qi = 0; qi < 2; ++qi) { const int ql_ = qlat0 + 32 * qi; attn_mask1<BR>(s[qi][0], 0, kt_, ql_, ql_ >> 6, ql_ & 63, hh, rpb); } } \
      _Pragma("unroll") for (int m = 0; m < 2 * NKS; ++m) { \
        s[m & 1][1] = MFMA(kf[m >> 1], qf[m & 1][m >> 1], (m >> 1) == 0 ? zero16 : s[m & 1][1]); \
        if (m < 4) vf[m] = VLOAD(m >> 1, m & 1); \
        _Pragma("unroll") for (int e = (m * 32) / (2 * NKS); e < ((m + 1) * 32) / (2 * NKS); ++e) SM_EL(0, e); \
        SB(); } \
      if (domask) { _Pragma("unroll") for (int qi = 0; qi < 2; ++qi) { const int ql_ = qlat0 + 32 * qi; attn_mask1<BR>(s[qi][1], 1, kt_, ql_, ql_ >> 6, ql_ & 63, hh, rpb); } } \
      _Pragma("unroll") for (int m = 0; m < 8; ++m) { \
        o[m & 1][(m >> 1) & 1] = MFMA(vf[m >> 1], __builtin_bit_cast(bf16x8, pw[0][m & 1][m >> 2]), o[m & 1][(m >> 1) & 1]); \
        if (m & 1) { SB(); vf[m >> 1] = VLOAD(2 + (m >> 2), (m >> 1) & 1); } \
        _Pragma("unroll") for (int e = 4 * m; e < 4 * m + 4; ++e) SM_EL(1, e); \
        SB(); } \
      _Pragma("unroll") for (int m = 0; m < 8; ++m) \
        o[m & 1][(m >> 1) & 1] = MFMA(vf[m >> 1], __builtin_bit_cast(bf16x8, pw[1][m & 1][m >> 2]), o[m & 1][(m >> 1) & 1]); \
    } \
    asm volatile("s_waitcnt vmcnt(0)" ::: "memory"); \
    __syncthreads(); \
  } while (0)
#define A_STEP(j) do { \
    const int st = ((j) & 1) * STG; \
    if ((j) + 1 < NT) A_DMA((j) + 1, ((j) + 1) & 1); \
    const int kt_ = lat_lo + (j) - 4; \
    const bool need = active && ((j) < 4 || (kt_ >= wlo && kt_ <= whi)); \
    if (need) { \
      f32x16 s[2][2]; \
      _Pragma("unroll") for (int kb = 0; kb < 2; ++kb) { \
        _Pragma("unroll") for (int ks = 0; ks < 4; ++ks) { const bf16x8 kf = *(const LAS bf16x8*)(kfb + st + kb * 4096 + (((2 * ks + hh) ^ kkey) << 4)); \
          _Pragma("unroll") for (int qi = 0; qi < 2; ++qi) { if (ks == 0) { _Pragma("unroll") for (int i = 0; i < 16; ++i) s[qi][kb][i] = 0.f; } s[qi][kb] = MFMA(kf, qf[qi][ks], s[qi][kb]); } } \
        if (MLA) { _Pragma("unroll") for (int ks = 0; ks < 2; ++ks) { const bf16x8 kf = *(const LAS bf16x8*)(krb + st + kb * 2048 + (((2 * ks + hh) ^ rkey) << 4)); \
          _Pragma("unroll") for (int qi = 0; qi < 2; ++qi) s[qi][kb] = MFMA(kf, qf[qi][NKS - 2 + ks], s[qi][kb]); } } \
      } \
      if (FAST) __builtin_amdgcn_sched_barrier(0); \
      _Pragma("unroll") for (int qi = 0; qi < 2; ++qi) { \
        if ((BR == 1 || BR == 2) && (j) >= 4) { const int ql_ = qlat0 + 32 * qi; attn_mask<BR>(s[qi], kt_, ql_, ql_ >> 6, ql_ & 63, hh, rpb); } \
        if (FAST) { \
          float ls0 = 0.f, ls1 = 0.f; \
          _Pragma("unroll") for (int i = 0; i < 16; ++i) { \
            const float e0 = __builtin_amdgcn_exp2f(s[qi][0][i]), e1 = __builtin_amdgcn_exp2f(s[qi][1][i]); \
            s[qi][0][i] = e0; s[qi][1][i] = e1; FADD(ls0, e0); FADD(ls1, e1); } \
          l_run[qi] += ls0 + ls1; \
        } else { \
        float mx = s[qi][0][0]; \
        _Pragma("unroll") for (int i = 1; i < 16; ++i) mx = fmaxf(mx, s[qi][0][i]); \
        _Pragma("unroll") for (int i = 0; i < 16; ++i) mx = fmaxf(mx, s[qi][1][i]); \
        mx = fmaxf(mx, __shfl_xor(mx, 32)); \
        const float m_new = fmaxf(m_run[qi], mx); \
        const float alpha = __builtin_amdgcn_exp2f(m_run[qi] - m_new); \
        m_run[qi] = m_new; \
        float ls0 = 0.f, ls1 = 0.f; \
        _Pragma("unroll") for (int i = 0; i < 16; ++i) { \
          const float e0 = __builtin_amdgcn_exp2f(s[qi][0][i] - m_new), e1 = __builtin_amdgcn_exp2f(s[qi][1][i] - m_new); \
          s[qi][0][i] = e0; s[qi][1][i] = e1; ls0 += e0; ls1 += e1; } \
        l_run[qi] = l_run[qi] * alpha + (ls0 + ls1); \
        if (__any(alpha != 1.f)) { _Pragma("unroll") for (int i = 0; i < 16; ++i) { o[qi][0][i] *= alpha; o[qi][1][i] *= alpha; } } \
        } \
      } \
      _Pragma("unroll") for (int s4 = 0; s4 < 4; ++s4) { \
        const int kb = s4 >> 1, rb = (s4 & 1) * 8; \
        bf16x8 pf[2]; \
        _Pragma("unroll") for (int qi = 0; qi < 2; ++qi) { u32x4 pw; \
          pw.x = pk2(s[qi][kb][rb + 0], s[qi][kb][rb + 1]); pw.y = pk2(s[qi][kb][rb + 2], s[qi][kb][rb + 3]); \
          pw.z = pk2(s[qi][kb][rb + 4], s[qi][kb][rb + 5]); pw.w = pk2(s[qi][kb][rb + 6], s[qi][kb][rb + 7]); \
          pf[qi] = __builtin_bit_cast(bf16x8, pw); } \
        _Pragma("unroll") for (int db = 0; db < 2; ++db) { const bf16x8 vf = vtr2s(vfb + st + s4 * 2048, ((4 * db + vch) ^ vkey) << 4, ((4 * db + vch) ^ vkey ^ 4) << 4); \
          o[0][db] = MFMA(vf, pf[0], o[0][db]); o[1][db] = MFMA(vf, pf[1], o[1][db]); } \
      } \
    } \
    asm volatile("s_waitcnt vmcnt(0)" ::: "memory");        \
    __syncthreads(); \
  } while (0)
  if (FAST) {
    if (wave >= 4) __builtin_amdgcn_s_setprio(1);
    for (int j = 0; j < NT; j += 2) {
      F_STEP(j);
      if (j + 1 < NT) F_STEP(j + 1);
    }
    __builtin_amdgcn_s_setprio(0);
  } else {
    for (int j = 0; j < NT; j += 2) {
      A_STEP(j);
      if (j + 1 < NT) A_STEP(j + 1);
    }
  }
#undef F_STEP
#undef SM_EL
#undef A_STEP
#undef A_DMA
#undef DMA16
  bool bad = false;
  if (active) {
#pragma unroll
    for (int qi = 0; qi < 2; ++qi) {
      if (FAST) l_run[qi] = l2[qi][0] + l2[qi][1];
      const float lt = l_run[qi] + __shfl_xor(l_run[qi], 32);
      const float inv = 1.f / lt;
      if (FAST) bad = bad || !(lt > 1e-25f && lt < 1e25f);
      unsigned char* Op = wsp<unsigned char>(p, OFF_O) + (tokq + 32 * qi) * 1024 + obase;
#pragma unroll
      for (int db = 0; db < 2; ++db)
#pragma unroll
        for (int gp = 0; gp < 2; ++gp) {
          float q[8];
#pragma unroll
          for (int j = 0; j < 8; ++j) q[j] = __builtin_amdgcn_fmed3f(o[qi][db][8 * gp + j] * (inv * O8_SCALE), -448.f, 448.f);
          int wa = __builtin_amdgcn_cvt_pk_fp8_f32(q[0], q[1], 0, false); wa = __builtin_amdgcn_cvt_pk_fp8_f32(q[2], q[3], wa, true);
          int wb = __builtin_amdgcn_cvt_pk_fp8_f32(q[4], q[5], 0, false); wb = __builtin_amdgcn_cvt_pk_fp8_f32(q[6], q[7], wb, true);
          const u32x2 sx = __builtin_amdgcn_permlane32_swap((unsigned)wa, (unsigned)wb, false, false);
          *(u32x2*)(Op + db * 32 + 16 * gp + 8 * hh) = sx;
        }
    }
  }
  if (!FAST) return false;
  LAS int* flag = (LAS int*)(lds + 2 * STG + 2048);
  if (__any(bad) && lane == 0) *flag = 1;
  __syncthreads();
  return __builtin_amdgcn_readfirstlane(*flag) != 0;
}
template <bool FAST>
DEVI bool attn_dispatch(KP p, int l, int n, int xcd, ldsp_t lds) {
  int br, s, qb; bool isctx = false;
  if (n < 32) { br = 0; s = xcd + 8 * (n >> 3); qb = n & 7; }
  else if (n < 64) { const int m = n - 32; br = 3; s = xcd + 8 * (m >> 4); qb = m & 15; }
  else if (n < 96) { const int m = n - 64; br = 2; s = xcd + 8 * (m >> 3); qb = m & 7; }
  else if (n < 128) { const int m = n - 96; br = 1; s = xcd + 8 * (m >> 4); qb = m & 15; }
  else {
    const int m = n - 128; isctx = true; qb = 0;
    if (m < 4) { br = 0; s = xcd + 8 * m; }
    else if (m < 6) { br = 3; s = xcd + 8 * (m - 4); }
    else if (m < 10) { br = 2; s = xcd + 8 * (m - 6); }
    else { br = 1; s = xcd + 8 * (m - 10); }
  }
  if (br == 0) return attn_item2<0, FAST>(p, l, s >> 2, s & 3, qb, isctx, lds);
  else if (br == 1) return attn_item2<1, FAST>(p, l, s >> 1, s & 1, qb, isctx, lds);
  else if (br == 2) return attn_item2<2, FAST>(p, l, s >> 2, s & 3, qb, isctx, lds);
  else return attn_item2<3, FAST>(p, l, s >> 1, s & 1, qb, isctx, lds);
}
DEVI void phaseD2(KP p, int l, ldsp_t lds) {
  const int G8 = gridDim.x >> 3, xcd = BIDX & 7, lb = BIDX >> 3;
  if (lb >= G8) return;
  const int NLOC = 128 + (l == 0 ? 12 : 0);
  const int nmine = (NLOC - lb + G8 - 1) / G8;
  const int cslot = min((int)(BIDX & 3), nmine - 1);
  int it = 0; unsigned redo = 0;
  for (int n = lb; n < NLOC; n += G8, ++it) {
    if (it == cslot) conv_items2(p, l, lds, CONV_EARLY, CONV_ITEMS);
    if (attn_dispatch<true>(p, l, n, xcd, lds)) redo |= 1u << it;
  }
  if (redo) {
    it = 0;
    for (int n = lb; n < NLOC; n += G8, ++it)
      if ((redo >> it) & 1) attn_dispatch<false>(p, l, n, xcd, lds);
  }
}

DEVI int pm_map(int pme, bool skipctx) { return skipctx ? (pme >> 4) * 17 + 1 + (pme & 15) : pme; }
struct SchedE1 { const char* ws; bool skipctx; int G, c;
  DEVI bool next(int i, Unit& u) const { int pm, pn; if (!tile_order(i, G, c, skipctx ? 128 : 136, 16, pm, pn)) return false;
    pm = pm_map(pm, skipctx); const int n = pn >> 2, cq = pn & 3;
    u.A = ws + OFF_O + uoff((unsigned)pm * 256u * 1024u + (unsigned)n * 256u); u.B = ws + OFF_WBR + uoff(((unsigned)n * 1024u + (unsigned)cq * 256u) * 256u); u.rows = nullptr; u.nvalid = 0;
    u.u0 = pm * 256; u.u1 = pn * 256; u.u2 = 0; u.u3 = 0; return true; } };
DEVI void phaseE1(KP p, int l, ldsp_t lds) {
  if (BIDX == 0 && TIDX < 32) wsp<int>(p, OFF_CNT)[TIDX * CNT_STRIDE] = 0;
  SchedE1 S{(const char*)p->ws, l == 1, (int)gridDim.x, BIDX};
  EpiZ8 E{wsp<unsigned char>(p, OFF_Z)};
  gemm_phase<true, false, true>(lds, 1024, 256, 2, S, E);
}
struct SchedE2 { const char* ws; const char* h8; bool skipctx; int G, c;
  DEVI bool next(int i, Unit& u) const { int pm, pn; if (!tile_order(i >> 1, G, c, skipctx ? 128 : 136, 8, pm, pn)) return false;
    pm = pm_map(pm, skipctx); const int pr = i & 1;
    u.A = h8 + uoff((unsigned)pm * 256u * 1024u); u.B = ws + OFF_WGATE + uoff((unsigned)(pr * 8 + pn) * 256u * 1024u); u.rows = nullptr; u.nvalid = 0;
    u.u0 = pm * 256; u.u1 = pn * 128; u.u2 = pr; u.u3 = 0; return true; } };
constexpr float Y8_SCALE = 16.f;
static_assert(Y8_SCALE == Z8_SCALE, "the E2 epilogue keeps its sums in Z8 units");
struct EpiE2 { const unsigned char* Z; u16* Y; unsigned char* Y8; const float* bias;
  DEVI void init(f32x4 (&acc)[2][2][4][2], const Unit& u, int wr, int wc, int fr, int fq) const {
    const int col0 = u.u1 + wc * 32 + 8 * fq;
#pragma unroll
    for (int bj = 0; bj < 2; ++bj)
#pragma unroll
      for (int nn = 0; nn < 2; ++nn) {
        const f32x4 b = *(const f32x4*)(bias + (2 * u.u2 + bj) * 1024 + col0 + 4 * nn) * -LOG2E;
#pragma unroll
        for (int a = 0; a < 2; ++a)
#pragma unroll
          for (int m = 0; m < 4; ++m) acc[a][bj][m][nn] = b;
      }
  }
  DEVI void operator()(const f32x4 (&acc)[2][2][4][2], const Unit& u, int wr, int wc, int fr, int fq) const {
    const int row0 = u.u0 + wr * 64 + fr, col0 = u.u1 + wc * 32 + 8 * fq, pr = u.u2;
    const unsigned lw16 = (unsigned)((wr * 4 + wc) * 64 + fr + 16 * fq) * 16u;
    const unsigned char* zb0 = Z + z8_block(u.u0 >> 8, 2 * pr, u.u1 >> 7) + lw16;
    char* yb = (char*)Y + (size_t)((u.u0 >> 8) * 8 + (u.u1 >> 7)) * 65536 + lw16;
    u32x4 zq[4][2], yq[4][2];
    auto ldpair = [&](int P, u32x4 (&z)[2], u32x4 (&y)[2]) {
#pragma unroll
      for (int bj = 0; bj < 2; ++bj) z[bj] = *(const u32x4*)(zb0 + (size_t)bj * 8 * 32768 + P * 8192);
#pragma unroll
      for (int h = 0; h < 2; ++h) y[h] = pr ? *(const u32x4*)(yb + (2 * P + h) * 8192) : u32x4{0u, 0u, 0u, 0u};
    };
#pragma unroll
    for (int P = 0; P < 4; ++P) ldpair(P, zq[P], yq[P]);
#pragma unroll
    for (int P = 0; P < 4; ++P) {
      const int c = P;
#pragma unroll
      for (int h = 0; h < 2; ++h) {
        const int g = 2 * P + h, ai = g >> 2, m = g & 3;
        const size_t r = (size_t)(row0 + ai * HALF + m * 16);
        float t[8];
        {
          const unsigned w[4] = {yq[c][h].x, yq[c][h].y, yq[c][h].z, yq[c][h].w};
#pragma unroll
          for (int i = 0; i < 4; ++i) { t[2 * i] = __uint_as_float(w[i] << 16); t[2 * i + 1] = __uint_as_float(w[i] & 0xffff0000u); }
        }
#pragma unroll
        for (int bj = 0; bj < 2; ++bj) {
#pragma unroll
          for (int nn = 0; nn < 2; ++nn) {
            const int zw = (int)zq[c][bj][2 * h + nn];
            const f32x2 zlo = __builtin_amdgcn_cvt_pk_f32_fp8(zw, false), zhi = __builtin_amdgcn_cvt_pk_f32_fp8(zw, true);
            const float zz4[4] = {zlo.x, zlo.y, zhi.x, zhi.y};
#pragma unroll
            for (int j = 0; j < 4; ++j) {
              const int e = 4 * nn + j;
              const float gte = __builtin_amdgcn_rcpf(1.f + __builtin_amdgcn_exp2f(acc[ai][bj][m][nn][j]));
              t[e] += gte * zz4[j];
            }
          }
        }
        if (pr == 0) {
          u32x4 o; o.x = pk2(t[0], t[1]); o.y = pk2(t[2], t[3]); o.z = pk2(t[4], t[5]); o.w = pk2(t[6], t[7]);
          *(u32x4*)(yb + g * 8192) = o;
        } else {
          u32x2 o8;
#pragma unroll
          for (int w = 0; w < 2; ++w) {
            float q[4];
#pragma unroll
            for (int j = 0; j < 4; ++j) q[j] = __builtin_amdgcn_fmed3f(t[4 * w + j], -448.f, 448.f);
            int v = __builtin_amdgcn_cvt_pk_fp8_f32(q[0], q[1], 0, false);
            v = __builtin_amdgcn_cvt_pk_fp8_f32(q[2], q[3], v, true);
            o8[w] = (unsigned)v;
          }
          *(u32x2*)(Y8 + r * 1024 + col0) = o8;
        }
      }
    }
  }
};
DEVI void phaseE2(KP p, int l, ldsp_t lds) {
  SchedE2 S{(const char*)p->ws, (const char*)h8base(p), l == 1, (int)gridDim.x, BIDX};
  EpiE2 E{wsp<unsigned char>(p, OFF_Z), wsp<u16>(p, OFF_YPRE), wsp<unsigned char>(p, OFF_Y8), p->b_gate + (size_t)l * 4 * 1024};
  gemm_phase<true, false, true>(lds, 1024, 1024, 8, S, E);
}
struct SchedF { const char* ws; bool skipctx; int G, c;
  DEVI bool next(int i, Unit& u) const { int pm, pn;
    if (skipctx || G != 256) { if (!tile_order(i, G, c, skipctx ? 128 : 136, 4, pm, pn)) return false; }
    else if (i < 2) { if (!tile_order(i, G, c, 128, 4, pm, pn)) return false; }
    else { if (i > 2 || c >= 32) return false; pm = 128 + (c >> 2); pn = c & 3; }
    pm = pm_map(pm, skipctx);
    u.A = ws + OFF_Y8 + uoff((unsigned)pm * 256u * 1024u); u.B = ws + OFF_WOUT + uoff((unsigned)pn * 256u * 1024u); u.rows = nullptr; u.nvalid = 0;
    u.u0 = pm; u.u1 = pn * 256; u.u2 = 0; u.u3 = 0; return true; } };
struct EpiF { KP p; int l;
  DEVI void init(f32x4 (&acc)[2][2][4][2], const Unit&, int, int, int, int) const { acc_zero(acc); }
  DEVI void operator()(const f32x4 (&acc)[2][2][4][2], const Unit& u, int wr, int wc, int fr, int fq) const {
    const int pm = u.u0, b = pm / 17, rr0 = (pm % 17) * 256;
    const int mrow = (rr0 < NCTX) ? 8 : b;
    const int col0 = u.u1 + wc * 32 + 8 * fq;
    const float* gt = wsp<float>(p, OFF_MOD) + ((size_t)l * 9 + mrow) * 6144 + 2048 + col0;
    const u16* xinb = (const u16*)p->out + (size_t)(b * TPB + rr0) * 1024 + col0;
    const __amdgpu_buffer_rsrc_t xrs = __builtin_amdgcn_make_buffer_rsrc((void*)wsp<u16>(p, OFF_XM), 0, NTOK * 1024 * 2, 0x00020000);
    const unsigned xoff = (unsigned)((b * TPB + rr0) * 1024 + col0) * 2u;
    f32x4 gv[2][2];
#pragma unroll
    for (int bj = 0; bj < 2; ++bj)
#pragma unroll
      for (int n = 0; n < 2; ++n) gv[bj][n] = *(const f32x4*)(gt + bj * HALF + n * 4) * (1.f / Y8_SCALE);
#pragma unroll
    for (int ai = 0; ai < 2; ++ai) {
      u32x4 xo[4][2];
#pragma unroll
      for (int m = 0; m < 4; ++m) {
        const size_t ro = (size_t)(wr * 64 + fr + ai * HALF + m * 16) * 1024;
#pragma unroll
        for (int bj = 0; bj < 2; ++bj) xo[m][bj] = *(const u32x4*)(xinb + ro + bj * HALF);
      }
#pragma unroll
      for (int mp = 0; mp < 2; ++mp) {
#pragma unroll
        for (int mm = 0; mm < 2; ++mm) {
          const int m = 2 * mp + mm;
          const size_t ro = (size_t)(wr * 64 + fr + ai * HALF + m * 16) * 1024;
#pragma unroll
          for (int bj = 0; bj < 2; ++bj) {
            const u32x4 v = xo[m][bj];
            const f32x4 x0 = f32x4{__uint_as_float(v.x << 16), __uint_as_float(v.x & 0xffff0000u), __uint_as_float(v.y << 16), __uint_as_float(v.y & 0xffff0000u)};
            const f32x4 x1 = f32x4{__uint_as_float(v.z << 16), __uint_as_float(v.z & 0xffff0000u), __uint_as_float(v.w << 16), __uint_as_float(v.w & 0xffff0000u)};
            const f32x4 r0 = x0 + gv[bj][0] * acc[ai][bj][m][0], r1 = x1 + gv[bj][1] * acc[ai][bj][m][1];
            __builtin_amdgcn_raw_buffer_store_b128(u32x4{pk2(r0.x, r0.y), pk2(r0.z, r0.w), pk2(r1.x, r1.y), pk2(r1.z, r1.w)}, xrs,
                                                   (int)(xoff + (unsigned)(ro + bj * HALF) * 2u), 0, 16);
          }
        }
      }
    }
    asm volatile("s_waitcnt vmcnt(0)" ::: "memory");
    if ((TIDX & 63) == 0) __hip_atomic_fetch_add(wsp<int>(p, OFF_DEP) + (l * 136 + pm) * DEP_STRIDE, 1, __ATOMIC_RELAXED, __HIP_MEMORY_SCOPE_AGENT);
  }
};
DEVI void phaseF2(KP p, int l, ldsp_t lds) {
  SchedF S{(const char*)p->ws, l == 1, (int)gridDim.x, BIDX};
  EpiF E{p, l};
  gemm_phase<true, false, true>(lds, 1024, 1024, 8, S, E);
}


DEVI void phase0_2(KP p, ldsp_t lds) {
  const int tid = TIDX, half = tid >> 8, htid = tid & 255;
  for (int it = BIDX * 2; it < 458; it += gridDim.x * 2) {
    const int item = it + half;
    LAS float* sc = (LAS float*)(lds + half * 16384);
    const bool ismod = item < 384;
    const int l = item / 192, rem = item % 192, cgp = rem >> 3, kc = rem & 7;
    __syncthreads();
    if (ismod) {
      for (int i = htid; i < 9 * 128; i += 256) {
        int b = i >> 7, k = i & 127;
        float v = (b < 8) ? p->c[b * 1024 + kc * 128 + k] : p->c_ctx[kc * 128 + k];
        sc[i] = v / (1.f + __expf(-v));
      }
    }
    __syncthreads();
    if (ismod) {
      float acc[9];
#pragma unroll
      for (int b = 0; b < 9; ++b) acc[b] = 0.f;
      const float* w = p->w_mod + ((size_t)l * 1024 + kc * 128) * 6144 + cgp * 256 + htid;
#pragma unroll 32
      for (int k = 0; k < 128; ++k) {
        float wv = w[(size_t)k * 6144];
#pragma unroll
        for (int b = 0; b < 9; ++b) acc[b] += sc[b * 128 + k] * wv;
      }
      float* dst = wsp<float>(p, OFF_MODP) + (size_t)((kc * 2 + l) * 9) * 6144 + cgp * 256 + htid;
#pragma unroll
      for (int b = 0; b < 9; ++b) dst[(size_t)b * 6144] = acc[b];
    } else if (item == 384) {
      float* cs32 = wsp<float>(p, OFF_CS32);
      float* cs16 = wsp<float>(p, OFF_CS16);
      for (int t = htid; t < 1024; t += 256) {
        int pos = t >> 4, i = t & 15;
        float ang = (float)pos * __builtin_amdgcn_exp2f(-(float)(2 * i) * (13.287712379549449f / 32.f));
        cs32[t * 2] = __cosf(ang); cs32[t * 2 + 1] = __sinf(ang);
      }
      for (int t = htid; t < 512; t += 256) {
        int pos = t >> 3, i = t & 7;
        float ang = (float)pos * __builtin_amdgcn_exp2f(-(float)(2 * i) * (13.287712379549449f / 16.f));
        cs16[t * 2] = __cosf(ang); cs16[t * 2 + 1] = __sinf(ang);
      }
    } else if (item < 457) {
      const int q = item - 385, ll = q / 36, o = q % 36;
      float* dst = wsp<float>(p, OFF_WRT) + ((size_t)ll * 36 + o) * 1024;
      for (int k = htid; k < 1024; k += 256)
        dst[k] = (o < 4) ? p->w_group[((size_t)ll * 1024 + k) * 4 + o] : p->w_router[((size_t)ll * 1024 + k) * 32 + (o - 4)];
    }
  }
}
DEVI void phase1_2(KP p) {
  const float* mp = wsp<float>(p, OFF_MODP);
  float* mo = wsp<float>(p, OFF_MOD);
  for (int i = BIDX * 512 + TIDX; i < 2 * 9 * 6144; i += gridDim.x * 512) {
    int l = i / (9 * 6144), o = i % 6144;
    float s = p->b_mod[l * 6144 + o];
#pragma unroll
    for (int kc = 0; kc < 8; ++kc) s += mp[(size_t)kc * 2 * 9 * 6144 + i];
    mo[i] = s;
  }
}
DEVI void phaseA2(KP p) {
  const int gw = BIDX * NW + (TIDX >> 6), nw = gridDim.x * NW;
  u16* H = wsp<u16>(p, OFF_H);
  const int per = (NTOK + nw - 1) / nw;
  const int t0 = gw * per, t1 = min(t0 + per, NTOK);
  int cur = -1; ModVec mv;
  for (int tok0 = t0; tok0 < t1; tok0 += 2) {
    float xv[2][16];
#pragma unroll
    for (int r = 0; r < 2; ++r) { const int tok = tok0 + r; if (tok < t1) load_row16(xrow_in(p, 0, tok / TPB, tok % TPB), xv[r]); }
#pragma unroll
    for (int r = 0; r < 2; ++r) {
      const int tok = tok0 + r;
      if (tok < t1) {
        const int mrow = (tok % TPB) < NCTX ? 8 : tok / TPB;
        if (mrow != cur) { load_modvec(p, 0, 0, mrow, mv); cur = mrow; }
        float hv[16]; modulate_row_store2<true, false>(mv, xv[r], nullptr, hv, h8base(p) + (size_t)tok * 1024);
        u16* xb = (u16*)p->out + (size_t)tok * 1024 + (TIDX & 63) * 4;
#pragma unroll
        for (int i = 0; i < 4; ++i) *(u32x2*)(xb + i * 256) = u32x2{pk2(xv[r][i * 4], xv[r][i * 4 + 1]), pk2(xv[r][i * 4 + 2], xv[r][i * 4 + 3])}; }
    }
  }
}
DEVI void phaseG2(KP p, int l, ldsp_t lds) {
  constexpr int RP = 2064;
  constexpr int GX = 2 * 32 * RP;
  const int tid = TIDX, lane = tid & 63, wave = __builtin_amdgcn_readfirstlane(tid >> 6);
  const int r32 = lane & 31, kh = lane >> 5, qd = lane >> 4;
  u16* H = wsp<u16>(p, OFF_H2);
  const float* WRT = wsp<float>(p, OFF_WRT) + (size_t)l * 36 * 1024;
  int* cnt = wsp<int>(p, OFF_CNT);
  int* list = wsp<int>(p, OFF_LIST);
  float* wlist = wsp<float>(p, OFF_WLIST);
  const ldsp_t hiP = lds, loP = lds + 32 * RP;
  LAS float* part = (LAS float*)lds;
  LAS int* gsel = (LAS int*)(lds + GX);
  LAS float* gwt = (LAS float*)(lds + GX + 128);
  LAS int* lcnt = (LAS int*)(lds + GX + 256);
  LAS int* gbase = lcnt + 32;
  LAS int* tinfo = lcnt + 64;
  if (tid < 32) lcnt[tid] = 0;
  int nloc = 0;
  bf16x8 whi[8], wlo[8];
  {
    const float* wr = p->w_router + (size_t)l * 1024 * 32 + r32;
#pragma unroll
    for (int s8 = 0; s8 < 8; ++s8) {
      u32x4 h, lo4;
#pragma unroll
      for (int jj = 0; jj < 4; ++jj) {
        const int k = 128 * wave + 16 * s8 + 8 * kh + 2 * jj;
        const float a = wr[(size_t)k * 32], b2 = wr[(size_t)(k + 1) * 32];
        const unsigned hp = pk2(a, b2);
        h[jj] = hp; lo4[jj] = pk2(a - __uint_as_float(hp << 16), b2 - __uint_as_float(hp & 0xffff0000u));
      }
      whi[s8] = __builtin_bit_cast(bf16x8, h); wlo[s8] = __builtin_bit_cast(bf16x8, lo4);
    }
  }
  int* tctr = wsp<int>(p, OFF_DEP) + DEP_TILECTR + l * DEP_STRIDE;
  LAS int* tnext = lcnt + 64 + 512 * 6;
  const int ntile = (l == 1) ? 8 * SEQ / 32 : NTOK / 32;
  if (tid == 0) *tnext = atomicAdd(tctr, 1);
  __syncthreads();
  for (;;) {
    const int tix = *tnext;
    if (tix >= ntile) break;
    int tclaim = 0;
    if (tid == 0) tclaim = atomicAdd(tctr, 1);
    const int tile = (l == 1) ? (tix >> 7) * 136 + 8 + (tix & 127) : tix;
    const int tok0 = tile * 32, b = tok0 / TPB, rr0 = tok0 % TPB;
    if (wave == 0) {
      const int* dep = wsp<int>(p, OFF_DEP) + (l * 136 + (tok0 >> 8)) * DEP_STRIDE;
      while (__hip_atomic_load(dep, __ATOMIC_RELAXED, __HIP_MEMORY_SCOPE_AGENT) < 32) __builtin_amdgcn_s_sleep(2);
      __builtin_amdgcn_fence(__ATOMIC_ACQUIRE, "agent");
      asm volatile("s_waitcnt vmcnt(0)" ::: "memory");
    }
    __syncthreads();
    {
      float hv[4][16], xv4[4][16];
#pragma unroll
      for (int r = 0; r < 4; ++r) load_row16_bf(wsp<u16>(p, OFF_XM) + (size_t)(tok0 + wave * 4 + r) * 1024, xv4[r]);
      ModVec mv; load_modvec(p, l, 1, (rr0 < NCTX) ? 8 : b, mv);
#pragma unroll
      for (int r = 0; r < 4; ++r) {
        modulate_row_store2<true, false>(mv, xv4[r], nullptr, hv[r], (unsigned char*)H + (size_t)(tok0 + wave * 4 + r) * 1024);
        const int ro = (wave * 4 + r) * RP + lane * 8;
#pragma unroll
        for (int i = 0; i < 4; ++i) {
          const unsigned h01 = pk2(hv[r][i * 4], hv[r][i * 4 + 1]), h23 = pk2(hv[r][i * 4 + 2], hv[r][i * 4 + 3]);
          const unsigned l01 = pk2(hv[r][i * 4] - __uint_as_float(h01 << 16), hv[r][i * 4 + 1] - __uint_as_float(h01 & 0xffff0000u));
          const unsigned l23 = pk2(hv[r][i * 4 + 2] - __uint_as_float(h23 << 16), hv[r][i * 4 + 3] - __uint_as_float(h23 & 0xffff0000u));
          *(LAS u32x2*)(hiP + ro + i * 512) = u32x2{h01, h23};
          *(LAS u32x2*)(loP + ro + i * 512) = u32x2{l01, l23};
        }
      }
      float gl[4];
#pragma unroll
      for (int o = 0; o < 4; ++o) gl[o] = router_dot(hv, WRT + (size_t)o * 1024) + p->b_group[l * 4 + o];
      int gs = 0; float best = gl[0];
#pragma unroll
      for (int j = 1; j < 4; ++j) if (gl[j] > best) { best = gl[j]; gs = j; }
      float gsum = 0.f;
#pragma unroll
      for (int j = 0; j < 4; ++j) gsum += __expf(gl[j] - best);
      if ((lane & 15) == 0) { gsel[wave * 4 + qd] = gs; gwt[wave * 4 + qd] = 1.f / gsum; }
    }
    __syncthreads();
    f32x16 acc;
#pragma unroll
    for (int i = 0; i < 16; ++i) acc[i] = 0.f;
    {
      const int ao = r32 * RP + (128 * wave + 8 * kh) * 2;
#pragma unroll
      for (int s8 = 0; s8 < 8; ++s8) {
        const bf16x8 ah = *(const LAS bf16x8*)(hiP + ao + s8 * 32), al = *(const LAS bf16x8*)(loP + ao + s8 * 32);
        acc = MFMA(ah, whi[s8], acc);
        acc = MFMA(ah, wlo[s8], acc);
        acc = MFMA(al, whi[s8], acc);
      }
    }
    __syncthreads();
#pragma unroll
    for (int i = 0; i < 16; ++i) part[(wave * 32 + (i & 3) + 8 * (i >> 2) + 4 * kh) * 33 + r32] = acc[i];
    __syncthreads();
    if (tid < 32) {
      const int gs = gsel[tid];
      const float gw_ = gwt[tid];
      float e8[8];
#pragma unroll
      for (int j = 0; j < 8; ++j) {
        float v = p->b_router[l * 32 + gs * 8 + j];
#pragma unroll
        for (int w = 0; w < 8; ++w) v += part[(w * 32 + tid) * 33 + gs * 8 + j];
        e8[j] = v;
      }
      int i0 = 0; float v0 = e8[0];
#pragma unroll
      for (int j = 1; j < 8; ++j) if (e8[j] > v0) { v0 = e8[j]; i0 = j; }
      int i1 = -1; float v1 = -INFINITY;
#pragma unroll
      for (int j = 0; j < 8; ++j) if (j != i0 && e8[j] > v1) { v1 = e8[j]; i1 = j; }
      const float ex = __expf(v1 - v0);
      const float w0 = gw_ / (1.f + ex), w1 = gw_ * ex / (1.f + ex);
      const int tok = tok0 + tid;
      const int ea = gs * 8 + i0, eb = gs * 8 + i1;
      const int ra = __hip_atomic_fetch_add(&lcnt[ea], 1, __ATOMIC_RELAXED, __HIP_MEMORY_SCOPE_WORKGROUP);
      const int rb = __hip_atomic_fetch_add(&lcnt[eb], 1, __ATOMIC_RELAXED, __HIP_MEMORY_SCOPE_WORKGROUP);
      LAS int* ti = tinfo + (nloc + tid) * 6;
      ti[0] = tok; ti[1] = ea | (eb << 8); ti[2] = ra; ti[3] = rb; ti[4] = __float_as_int(w0); ti[5] = __float_as_int(w1);
    }
    if (tid == 0) *tnext = tclaim;
    nloc += 32;
    __syncthreads();
    const bool last = *tnext >= ntile;
    if (last || nloc == 512) {
      if (tid < 32) { const int c = lcnt[tid]; gbase[tid] = c ? atomicAdd(&cnt[tid * CNT_STRIDE], c) : 0; }
      __syncthreads();
      for (int i = tid; i < nloc; i += 512) {
        const LAS int* ti = tinfo + i * 6;
        const int tok = ti[0], ea = ti[1] & 255, eb = ti[1] >> 8;
        const int sa = gbase[ea] + ti[2], sb = gbase[eb] + ti[3];
        list[(size_t)ea * NTOK + sa] = tok * 2; wlist[(size_t)ea * NTOK + sa] = __int_as_float(ti[4]);
        list[(size_t)eb * NTOK + sb] = tok * 2 + 1; wlist[(size_t)eb * NTOK + sb] = __int_as_float(ti[5]);
      }
      __syncthreads();
      if (tid < 32) lcnt[tid] = 0;
      nloc = 0;
      __syncthreads();
    }
  }
}
struct ExpInfo2 { int tiles[4], base[4], cnt[4]; };
DEVI ExpInfo2 exp_info2(KP p, int xcd) {
  const int* cnt = wsp<int>(p, OFF_CNT);
  ExpInfo2 ei;
  int before = 0;
#pragma unroll
  for (int e = 0; e < 32; ++e) {
    const int c = __builtin_amdgcn_readfirstlane(cnt[e * CNT_STRIDE]), t = (c + 255) >> 8;
    if ((e & 7) == xcd) { ei.tiles[e >> 3] = t; ei.base[e >> 3] = before; ei.cnt[e >> 3] = c; }
    before += t;
  }
  return ei;
}
template <int NN>
struct SchedX { ExpInfo2 ei; int xcd, lb, G8; const char* A; const char* W; const int* list; size_t wstride; int lda_b; int ldw_b;
  DEVI bool next(int i, Unit& u) const {
    const int tot = (ei.tiles[0] + ei.tiles[1] + ei.tiles[2] + ei.tiles[3]) * NN;
    const int n = i * G8 + lb; if (n >= tot) return false;
    int k = 0, m = n / NN; const int pn = n % NN;
    int tb = ei.base[0], ce = ei.cnt[0];
#pragma unroll
    for (int kk = 0; kk < 3; ++kk) { if (k == kk && m >= ei.tiles[kk]) { m -= ei.tiles[kk]; k = kk + 1; tb = ei.base[kk + 1]; ce = ei.cnt[kk + 1]; } }
    const int e = xcd + 8 * k;
    u.rows = list + (size_t)e * NTOK + m * 256; u.nvalid = ce - m * 256;
    u.A = A + (NN == 2 ? 0u : uoff((unsigned)(tb + m) * 256u * (unsigned)lda_b));
    u.B = W + uoff((unsigned)e * (unsigned)wstride + (unsigned)pn * 256u * (unsigned)ldw_b);
    u.u0 = (tb + m) * 256; u.u1 = pn; u.u2 = e; u.u3 = m; return true; } };
constexpr float U8_SCALE = 16.f;
struct EpiI1 { unsigned char* U;
  DEVI void init(f32x4 (&acc)[2][2][4][2], const Unit&, int, int, int, int) const { acc_zero(acc); }
  DEVI void operator()(const f32x4 (&acc)[2][2][4][2], const Unit& u, int wr, int wc, int fr, int fq) const {
#pragma unroll
    for (int ai = 0; ai < 2; ++ai)
#pragma unroll
      for (int m = 0; m < 4; ++m) {
        unsigned char* rowp = U + (size_t)(u.u0 + ai * HALF + wr * 64 + m * 16 + fr) * 256;
#pragma unroll
        for (int bj = 0; bj < 2; ++bj) {
          const int ff = 16 * (8 * u.u1 + 4 * bj + wc) + 4 * fq;
          const f32x4 g = acc[ai][bj][m][0], up = acc[ai][bj][m][1];
          float t[4];
#pragma unroll
          for (int j = 0; j < 4; ++j) t[j] = __builtin_amdgcn_fmed3f(g[j] * __builtin_amdgcn_rcpf(1.f + __builtin_amdgcn_exp2f(g[j] * -LOG2E)) * (up[j] * U8_SCALE), -448.f, 448.f);
          int o = __builtin_amdgcn_cvt_pk_fp8_f32(t[0], t[1], 0, false);
          o = __builtin_amdgcn_cvt_pk_fp8_f32(t[2], t[3], o, true);
          *(int*)(rowp + ff) = o;
        }
      }
  }
};
DEVI void phaseI1_2(KP p, ldsp_t lds) {
  const int xcd = BIDX & 7, lb = BIDX >> 3, G8 = gridDim.x >> 3;
  if (lb >= G8) return;
  SchedX<2> S{exp_info2(p, xcd), xcd, lb, G8, (const char*)wsp<u16>(p, OFF_H2), (const char*)wsp<u16>(p, OFF_W13), wsp<int>(p, OFF_LIST), (size_t)512 * 1024, 1024, 1024};
  EpiI1 E{wsp<unsigned char>(p, OFF_U)};
  int nt = 8; asm volatile("" : "+s"(nt));
  gemm_phase<false, true, true>(lds, 1024, 1024, nt, S, E);
}
constexpr float YS8_SCALE = 32.f;
struct EpiI2 { unsigned char* YS; const float* wlist; const int* list;
  DEVI void init(f32x4 (&acc)[2][2][4][2], const Unit&, int, int, int, int) const { acc_zero(acc); }
  DEVI void operator()(const f32x4 (&acc)[2][2][4][2], const Unit& u, int wr, int wc, int fr, int fq) const {
    const unsigned colb = (unsigned)(u.u1 * 256 + wc * 32 + 8 * fq);
    const float* we = wlist + (u.rows - list);
    unsigned dest[2][4]; float w[2][4];
#pragma unroll
    for (int ai = 0; ai < 2; ++ai)
#pragma unroll
      for (int m = 0; m < 4; ++m) {
        const int r = ai * HALF + wr * 64 + m * 16 + fr;
        dest[ai][m] = (r < u.nvalid) ? (unsigned)u.rows[r] : (unsigned)(2 * NTOK);
        w[ai][m] = we[r] * (YS8_SCALE / U8_SCALE);
      }
#pragma unroll
    for (int ai = 0; ai < 2; ++ai)
#pragma unroll
      for (int m = 0; m < 4; ++m) {
        unsigned char* rowp = YS + (dest[ai][m] * 1024u + colb);
#pragma unroll
        for (int bj = 0; bj < 2; ++bj) {
          u32x2 o;
#pragma unroll
          for (int nn = 0; nn < 2; ++nn) {
            const f32x4 v = acc[ai][bj][m][nn] * w[ai][m];
            int q = __builtin_amdgcn_cvt_pk_fp8_f32(__builtin_amdgcn_fmed3f(v[0], -448.f, 448.f), __builtin_amdgcn_fmed3f(v[1], -448.f, 448.f), 0, false);
            q = __builtin_amdgcn_cvt_pk_fp8_f32(__builtin_amdgcn_fmed3f(v[2], -448.f, 448.f), __builtin_amdgcn_fmed3f(v[3], -448.f, 448.f), q, true);
            o[nn] = (unsigned)q;
          }
          *(u32x2*)(rowp + bj * 128) = o;
        }
      }
  }
};
DEVI void phaseI2_2(KP p, ldsp_t lds) {
  const int xcd = BIDX & 7, lb = BIDX >> 3, G8 = gridDim.x >> 3;
  if (lb >= G8) return;
  SchedX<4> S{exp_info2(p, xcd), xcd, lb, G8, (const char*)wsp<u16>(p, OFF_U), (const char*)wsp<u16>(p, OFF_W2), wsp<int>(p, OFF_LIST), (size_t)1024 * 256, 256, 256};
  EpiI2 E{wsp<unsigned char>(p, OFF_YS), wsp<float>(p, OFF_WLIST), wsp<int>(p, OFF_LIST)};
  int nt = 2; asm volatile("" : "+s"(nt));
  gemm_phase<true, false, true>(lds, 256, 256, nt, S, E);
}
DEVI void phaseJ2(KP p, int l, ldsp_t lds) {
  const int lane = TIDX & 63;
  const int gw = BIDX * NW + (TIDX >> 6), nw = gridDim.x * NW;
  const unsigned char* YS = wsp<unsigned char>(p, OFF_YS);
  u16* H = wsp<u16>(p, OFF_H);
  const int ntot = (l == 1) ? 8 * SEQ : NTOK;
  const int per = (ntot + nw - 1) / nw;
  const int i0 = gw * per, i1 = min(i0 + per, ntot);
  int cur = -1; ModVec mv; f32x4 gtv[4];
  for (int ii = i0; ii < i1; ii += 2) {
    float xv[2][16]; int y0[2][4], y1[2][4]; bool ok[2]; int tk[2];
#pragma unroll
    for (int r = 0; r < 2; ++r) {
      const int idx = ii + r;
      const int tok = (l == 1) ? (idx / SEQ) * TPB + NCTX + idx % SEQ : idx;
      tk[r] = tok;
      ok[r] = idx < i1;
      if (ok[r]) {
        load_row16_bf(wsp<u16>(p, OFF_XM) + (size_t)tok * 1024, xv[r]);
#pragma unroll
        for (int i = 0; i < 4; ++i) {
          const int c = i * 256 + lane * 4;
          y0[r][i] = *(const int*)(YS + (size_t)(tok * 2) * 1024 + c);
          y1[r][i] = *(const int*)(YS + (size_t)(tok * 2 + 1) * 1024 + c);
        }
      }
    }
#pragma unroll
    for (int r = 0; r < 2; ++r) {
      if (!ok[r]) continue;
      const int tok = tk[r];
      const int b = tok / TPB, rr = tok % TPB;
      const int mrow = (rr < NCTX) ? 8 : b;
      if (mrow != cur) {
        cur = mrow;
        const float* gt = wsp<float>(p, OFF_MOD) + ((size_t)l * 9 + mrow) * 6144 + 5120;
#pragma unroll
        for (int i = 0; i < 4; ++i) gtv[i] = *(const f32x4*)(gt + i * 256 + lane * 4);
        if (l == 0) load_modvec(p, 1, 0, mrow, mv);
      }
#pragma unroll
      for (int i = 0; i < 4; ++i) {
        const f32x4 g = gtv[i] * (1.f / YS8_SCALE);
        const f32x2 a0 = __builtin_amdgcn_cvt_pk_f32_fp8(y0[r][i], false), a1 = __builtin_amdgcn_cvt_pk_f32_fp8(y0[r][i], true);
        const f32x2 b0 = __builtin_amdgcn_cvt_pk_f32_fp8(y1[r][i], false), b1 = __builtin_amdgcn_cvt_pk_f32_fp8(y1[r][i], true);
        xv[r][i * 4 + 0] += g.x * (a0.x + b0.x);
        xv[r][i * 4 + 1] += g.y * (a0.y + b0.y);
        xv[r][i * 4 + 2] += g.z * (a1.x + b1.x);
        xv[r][i * 4 + 3] += g.w * (a1.y + b1.y);
      }
      if (l == 0) {
        u16* xr = (u16*)p->out + (size_t)tok * 1024;
#pragma unroll
        for (int i = 0; i < 4; ++i)
          *(u32x2*)(xr + i * 256 + lane * 4) = u32x2{pk2(xv[r][i * 4], xv[r][i * 4 + 1]), pk2(xv[r][i * 4 + 2], xv[r][i * 4 + 3])};
        float hv[16];
        modulate_row_store2<true, false>(mv, xv[r], nullptr, hv, h8base(p) + (size_t)tok * 1024);
      } else {
        float ss = 0.f;
#pragma unroll
        for (int i = 0; i < 16; ++i) ss += xv[r][i] * xv[r][i];
        ss = wave_sum(ss);
        const float rstd = rsqrtf(ss * (1.f / 1024.f) + EPS);
        float* xr = p->out + ((size_t)b * SEQ + rr - NCTX) * 1024;
#pragma unroll
        for (int i = 0; i < 4; ++i) {
          const int c = i * 256 + lane * 4;
          const f32x4 g = *(const f32x4*)(p->g_final + c);
          *(f32x4*)(xr + c) = f32x4{xv[r][i * 4] * rstd * g.x, xv[r][i * 4 + 1] * rstd * g.y, xv[r][i * 4 + 2] * rstd * g.z, xv[r][i * 4 + 3] * rstd * g.w};
        }
      }
    }
  }
}

constexpr int N_PHASES = 3 + 2 * 11;
__global__ void __launch_bounds__(512, 2) fwd_v2(Params parg) {
  extern __shared__ __attribute__((aligned(16))) unsigned char dyn_lds[];
  const ldsp_t lds = (ldsp_t)dyn_lds;
  cg::grid_group grid = cg::this_grid();
  volatile LAS unsigned* xb_st = (volatile LAS unsigned*)(lds + LDS_BARW);
  if (TIDX < 4) xb_st[TIDX] = 0u;
  __syncthreads();
  if (parg.ph_end - parg.ph_begin > 1) xcd_barrier_post((unsigned*)(parg.ws + OFF_BAR));
  for (int ph = parg.ph_begin; ph < parg.ph_end; ++ph) {
    KP p = (KP)__builtin_amdgcn_kernarg_segment_ptr();
    asm volatile("" : "+s"(p));
    const int l = (ph >= 14) ? 1 : 0;
    const int k = (ph < 3) ? ph : 3 + (ph - 3) % 11;
    const int reps = (((PROBE_DUP >> k) & 1) && (!(PROBE_DUP & 0x10000) || l == 0)) ? 2 : 1;
    for (int rep = 0; rep < reps; ++rep) {
      if (rep) {
        xcd_barrier((unsigned*)(p->ws + OFF_BAR), xb_st);
        if (k == 10) { if (BIDX == 0 && TIDX < 32) wsp<int>(p, OFF_CNT)[TIDX * CNT_STRIDE] = 0; xcd_barrier((unsigned*)(p->ws + OFF_BAR), xb_st); }
      }
      switch (k) {
        case 0: phase0_2(p, lds); break;
        case 1: phase1_2(p); break;
        case 2: phaseA2(p); break;
        case 3: phaseB2(p, lds); break;
        case 4: phaseC2(p, lds); break;
        case 5: phaseP2(p, l, lds); break;
        case 6: phaseD2(p, l, lds); break;
        case 7: phaseE1(p, l, lds); break;
        case 8: phaseE2(p, l, lds); break;
        case 9: phaseF2(p, l, lds); break;
        case 10: phaseG2(p, l, lds); break;
        case 11: phaseI1_2(p, lds); break;
        case 12: phaseI2_2(p, lds); break;
        default: phaseJ2(p, l, lds); break;
      }
    }
    if (k == 0 || (k == 13 && l == 0)) conv_items2(p, k == 0 ? 0 : 1, lds, 0, CONV_EARLY);
    if (ph + 1 < parg.ph_end && k != 9) {
      if (parg.ph_begin >= 1000) grid.sync();
      else xcd_barrier((unsigned*)(p->ws + OFF_BAR), xb_st);
    }
  }
}
}

extern "C" void kernel_launch(void* const* d_in, const int* in_sizes, int n_in, void* d_out, int out_size,
                              void* d_ws, size_t ws_size, hipStream_t stream) {
  static int grid2 = 0;
  if (!grid2) {
    int dev = 0, cus = 0, per_cu = 0;
    (void)hipGetDevice(&dev);
    (void)hipDeviceGetAttribute(&cus, hipDeviceAttributeMultiprocessorCount, dev);
    (void)hipFuncSetAttribute((const void*)v2::fwd_v2, hipFuncAttributeMaxDynamicSharedMemorySize, v2::LDS_TOTAL);
    (void)hipOccupancyMaxActiveBlocksPerMultiprocessor(&per_cu, v2::fwd_v2, 512, v2::LDS_TOTAL);
    if (per_cu < 1) { fprintf(stderr, "kernel does not fit on a CU\n"); per_cu = 1; }
    grid2 = cus & ~7;
  }
  if (ws_size < WS_NEEDED) { fprintf(stderr, "workspace too small: %zu < %zu\n", ws_size, (size_t)WS_NEEDED); return; }
  Params hp{};
  const float** f = (const float**)&hp;
  for (int i = 0; i < 29; ++i) f[i] = (const float*)d_in[i];
  hp.out = (float*)d_out;
  hp.ws = (char*)d_ws;
#if N_LAUNCH_MODE == 1
  for (int ph = 0; ph < v2::N_PHASES; ++ph) {
    hp.ph_begin = ph; hp.ph_end = ph + 1;
    void* args[] = {&hp};
    hipError_t e = hipLaunchCooperativeKernel((void*)v2::fwd_v2, dim3(grid2), dim3(512), args, v2::LDS_TOTAL, stream);
    if (e != hipSuccess) fprintf(stderr, "launch failed: %s\n", hipGetErrorString(e));
  }
#else
  hp.ph_begin = 0; hp.ph_end = v2::N_PHASES;
  (void)hipMemsetAsync((char*)d_ws + OFF_BAR, 0, (size_t)(OFF_DEP - OFF_BAR) + (size_t)DEP_WORDS * 4, stream);
  void* args[] = {&hp};
  hipError_t e = hipLaunchCooperativeKernel((void*)v2::fwd_v2, dim3(grid2), dim3(512), args, v2::LDS_TOTAL, stream);
  if (e != hipSuccess) fprintf(stderr, "cooperative launch failed: %s (grid %d)\n", hipGetErrorString(e), grid2);
#endif
}
```

```cpp
#include <hip/hip_runtime.h>
#include <hip/hip_cooperative_groups.h>
#include <stdint.h>
#include <stdio.h>
namespace cg = cooperative_groups;

#ifndef N_LAUNCH_MODE
#define N_LAUNCH_MODE 0
#endif

#ifndef PROBE_DUP
#define PROBE_DUP 0
#endif
#define DEVI __device__ __forceinline__
typedef unsigned short u16;
typedef __attribute__((ext_vector_type(2))) float f32x2;
typedef __attribute__((ext_vector_type(2))) __bf16 bf16x2_t;
typedef __attribute__((ext_vector_type(8))) short bf16x8;
typedef __attribute__((ext_vector_type(16))) float f32x16;
typedef __attribute__((ext_vector_type(4))) unsigned u32x4;
typedef __attribute__((ext_vector_type(2))) unsigned u32x2;
typedef __attribute__((ext_vector_type(4))) float f32x4;
#define MFMA(a, b, c) __builtin_amdgcn_mfma_f32_32x32x16_bf16((a), (b), (c), 0, 0, 0)

constexpr int DMODEL = 1024, NBATCH = 8, SEQ = 4096, NCTX = 256;
constexpr int TPB = SEQ + NCTX;
constexpr int NTOK = NBATCH * TPB;
constexpr int MT_PER_B = TPB / 128;
constexpr int NEXP = 32;
constexpr int INP = 2304;
constexpr float EPS = 1e-6f;
constexpr float LOG2E = 1.4426950408889634f;
constexpr int SMEM_BYTES = 73728;
constexpr int UROWS = 2 * NTOK + NEXP * 256;

constexpr size_t al(size_t x) { return (x + 255) & ~(size_t)255; }
constexpr size_t OFF_WIN = 0;
constexpr size_t OFF_WQB = OFF_WIN + al((size_t)INP * 1024 * 2);
constexpr size_t OFF_WKVB = OFF_WQB + al((size_t)512 * 256 * 2);
constexpr size_t OFF_WGATE = OFF_WKVB + al((size_t)512 * 256 * 2);
constexpr size_t OFF_WBR = OFF_WGATE + al((size_t)4 * 1024 * 1024 * 2);
constexpr size_t OFF_WOUT = OFF_WBR + al((size_t)4 * 1024 * 256 * 2);
constexpr size_t OFF_W13 = OFF_WOUT + al((size_t)1024 * 1024 * 2);
constexpr size_t OFF_W2 = OFF_W13 + al((size_t)32 * 512 * 1024 * 2);
constexpr size_t OFF_MODP = OFF_W2 + al((size_t)32 * 1024 * 256 * 2);
constexpr size_t OFF_MOD = OFF_MODP + al((size_t)8 * 2 * 9 * 6144 * 4);
constexpr size_t OFF_CS32 = OFF_MOD + al((size_t)2 * 9 * 6144 * 4);
constexpr size_t OFF_CS16 = OFF_CS32 + al((size_t)64 * 16 * 2 * 4);
constexpr size_t OFF_WRT = OFF_CS16 + al((size_t)64 * 8 * 2 * 4);
constexpr size_t OFF_CNT = OFF_WRT + al((size_t)2 * 36 * 1024 * 4);
constexpr int CNT_STRIDE = 64;
constexpr size_t OFF_BAR = OFF_CNT + al(32 * CNT_STRIDE * 4);
constexpr int XCD_BAR_WORDS = 3456;
constexpr size_t OFF_CTXRES = OFF_BAR + al((size_t)XCD_BAR_WORDS * 4);
constexpr size_t OFF_DEP = OFF_CTXRES;
constexpr int DEP_STRIDE = 16, DEP_TILECTR = 2 * 136 * DEP_STRIDE, DEP_WORDS = DEP_TILECTR + 2 * DEP_STRIDE;
constexpr size_t OFF_H = OFF_CTXRES + al((size_t)8 * 256 * 1024 * 4);
constexpr size_t OFF_O = OFF_H + al((size_t)NTOK * 1024 * 2);
constexpr size_t OFF_SSQ = OFF_O + al((size_t)NTOK * 1024 * 2);
constexpr size_t OFF_LIST = OFF_SSQ + al((size_t)NTOK * 8 * 4);
constexpr size_t OFF_WLIST = OFF_LIST + al((size_t)32 * NTOK * 4);
constexpr size_t OFF_R1 = OFF_WLIST + al((size_t)32 * NTOK * 4);
constexpr int PLD = INP;
constexpr size_t OFF_PRAW = OFF_R1;
constexpr size_t OFF_QARAW = OFF_PRAW + (size_t)NTOK * INP * 2;
constexpr size_t OFF_KVARAW = OFF_QARAW + (size_t)NTOK * 512 * 2;
constexpr size_t OFF_VAT = OFF_KVARAW + (size_t)NTOK * 512 * 2;
constexpr size_t OFF_VBT = OFF_VAT + (size_t)NTOK * 256 * 2;
constexpr size_t OFF_VCT = OFF_VBT + (size_t)NTOK * 128 * 2;
constexpr size_t OFF_VDT = OFF_VCT + (size_t)NTOK * 256 * 2;
constexpr size_t OFF_END = OFF_VDT + (size_t)NTOK * 128 * 2;
constexpr size_t OFF_Z = OFF_R1;
constexpr size_t OFF_Y8 = OFF_H;
constexpr size_t OFF_H2 = OFF_O;
constexpr size_t OFF_YPRE = OFF_O;
constexpr size_t OFF_U = OFF_R1;
constexpr size_t OFF_YS = OFF_R1 + al((size_t)UROWS * 256 * 2);
constexpr size_t OFF_XM = OFF_YS + al((size_t)(2 * NTOK + 1) * 1024 * 2);
static_assert(OFF_XM + (size_t)NTOK * 1024 * 2 <= OFF_END, "alias overflow");
static_assert(OFF_Z + (size_t)NTOK * 4096 * 2 <= OFF_END, "alias overflow");
static_assert(OFF_YS + (size_t)(2 * NTOK + 1) * 1024 * 2 <= OFF_END, "alias overflow");
constexpr size_t WS_NEEDED = OFF_END;
static_assert(WS_NEEDED <= (size_t)536870912, "workspace budget (4 x largest tensor)");

struct Params {
  const float *x, *c, *ctx, *c_ctx, *w_mod, *b_mod, *g_norm_mix, *w_in, *g_q_a, *w_q_b, *g_kv_a, *w_kv_b,
      *sink_b, *rpb_c, *g_q_d, *g_k_d, *w_gate, *b_gate, *w_branch, *w_out, *g_norm_ffn, *w_group, *b_group,
      *w_router, *b_router, *w_ff1, *w_ff3, *w_ff2, *g_final;
  float* out;
  char* ws;
  int ph_begin, ph_end;
};

DEVI int tid_fresh() { int t; asm volatile("v_mov_b32 %0, %1" : "=v"(t) : "v"(__builtin_amdgcn_workitem_id_x())); return t; }
DEVI int bid_fresh() { int t; asm volatile("s_mov_b32 %0, %1" : "=s"(t) : "s"(__builtin_amdgcn_workgroup_id_x())); return t; }
#define TIDX tid_fresh()
#define BIDX bid_fresh()
typedef const __attribute__((address_space(4))) Params* KP;
DEVI unsigned pk2(float a, float b) { f32x2 v = {a, b}; bf16x2_t r = __builtin_convertvector(v, bf16x2_t); return __builtin_bit_cast(unsigned, r); }
DEVI u16 f2bf(float a) { return (u16)(pk2(a, 0.f) & 0xffffu); }
DEVI float bf2f(u16 v) { return __uint_as_float(((unsigned)v) << 16); }
DEVI float wave_sum(float v) {
#pragma unroll
  for (int m = 32; m >= 1; m >>= 1) v += __shfl_xor(v, m);
  return v;
}
template <class T> DEVI T* wsp(KP p, size_t off) { return (T*)(p->ws + off); }
DEVI const float* xrow_in(KP p, int l, int b, int rr) {
  if (l == 0) return (rr < NCTX) ? p->ctx + ((size_t)b * NCTX + rr) * 1024 : p->x + ((size_t)b * SEQ + rr - NCTX) * 1024;
  return (rr < NCTX) ? wsp<float>(p, OFF_CTXRES) + ((size_t)b * NCTX + rr) * 1024 : p->out + ((size_t)b * SEQ + rr - NCTX) * 1024;
}
DEVI float* xrow_res(KP p, int b, int rr) {
  return (rr < NCTX) ? wsp<float>(p, OFF_CTXRES) + ((size_t)b * NCTX + rr) * 1024 : p->out + ((size_t)b * SEQ + rr - NCTX) * 1024;
}
DEVI int perm16(int k) { return (k & ~12) | ((k & 4) << 1) | ((k & 8) >> 1); }

struct ConvT { const float* src; const float* src2; const float* ks; u16* dst; int ld; int ldd; float mul; };
constexpr float Z8_SCALE = 16.f, O8_SCALE = 32.f;
constexpr float F8_WSCALE = 64.f, GATE_WSCALE = F8_WSCALE;
constexpr int CONV_ITEMS = 1152 + 64 + 64 + 2048 + 512 + 512 + 8192 + 4096;
DEVI ConvT conv_decode(KP p, int l, int idx) {
  ConvT c; c.ks = nullptr; c.mul = 1.f; c.src2 = nullptr;
  if (idx < 1152) {
    int nt = idx >> 4, kt = idx & 15, n0 = nt * 32;
    int sc = (n0 < 416) ? n0 : ((n0 < 512) ? -1 : n0 - 96);
    c.ld = 2208; c.ldd = -1024;
    c.mul = F8_WSCALE;
    if ((n0 >= 512 && n0 < 768) || (n0 >= 1024 && n0 < 1280)) c.mul = 0.125f * LOG2E * F8_WSCALE;
    c.src = (sc < 0) ? nullptr : p->w_in + (size_t)l * 1024 * 2208 + (size_t)kt * 64 * 2208 + sc;
    c.dst = (u16*)(p->ws + OFF_WIN + (size_t)n0 * 1024 + kt * 64);
    return c;
  }
  idx -= 1152;
  if (idx < 64) {
    int nt = idx >> 2, kt = idx & 3;
    c.ld = 384; c.ldd = 256; c.ks = p->g_q_a + l * 256 + kt * 64;
    c.src = (nt >= 12) ? nullptr : p->w_q_b + (size_t)l * 256 * 384 + (size_t)kt * 64 * 384 + nt * 32;
    c.dst = wsp<u16>(p, OFF_WQB) + (size_t)nt * 32 * 256 + kt * 64;
    return c;
  }
  idx -= 64;
  if (idx < 64) {
    int nt = idx >> 2, kt = idx & 3;
    c.ld = 512; c.ldd = 256; c.ks = (kt < 2) ? p->g_kv_a + l * 128 + kt * 64 : nullptr;
    c.src = (kt >= 2) ? nullptr : p->w_kv_b + (size_t)l * 128 * 512 + (size_t)kt * 64 * 512 + nt * 32;
    c.dst = wsp<u16>(p, OFF_WKVB) + (size_t)nt * 32 * 256 + kt * 64;
    return c;
  }
  idx -= 64;
  if (idx < 2048) {
    int nt = idx >> 4, kt = idx & 15, R0 = nt * 32;
    int pr = R0 >> 11, cb = (R0 & 2047) >> 8, bj = (R0 & 255) >> 7, j0 = R0 & 127;
    c.ld = 1024; c.ldd = -1024; c.mul = -LOG2E * F8_WSCALE;
    c.src = p->w_gate + ((size_t)(l * 4 + 2 * pr + bj) * 1024 + kt * 64) * 1024 + cb * 128 + j0;
    c.dst = (u16*)(p->ws + OFF_WGATE + (size_t)R0 * 1024 + kt * 64);
    return c;
  }
  idx -= 2048;
  if (idx < 512) {
    int br = idx >> 7, nt = (idx >> 2) & 31, kt = idx & 3;
    c.ld = 1024; c.ldd = -256; c.mul = F8_WSCALE;
    c.src = p->w_branch + ((size_t)(l * 4 + br) * 256 + kt * 64) * 1024 + nt * 32;
    c.dst = (u16*)(p->ws + OFF_WBR + ((size_t)br * 1024 + nt * 32) * 256 + kt * 64);
    return c;
  }
  idx -= 512;
  if (idx < 512) {
    int nt = idx >> 4, kt = idx & 15;
    c.ld = 1024; c.ldd = -1024; c.mul = F8_WSCALE;
    c.src = p->w_out + ((size_t)l * 1024 + kt * 64) * 1024 + nt * 32;
    c.dst = (u16*)(p->ws + OFF_WOUT + (size_t)nt * 32 * 1024 + kt * 64);
    return c;
  }
  idx -= 512;
  if (idx < 8192) {
    int e = idx >> 8, g32 = (idx >> 4) & 15, kt = idx & 15;
    c.ld = 256; c.ldd = -1024; c.mul = F8_WSCALE;
    c.src = p->w_ff1 + ((size_t)(l * 32 + e) * 1024 + kt * 64) * 256 + g32 * 16;
    c.src2 = p->w_ff3 + ((size_t)(l * 32 + e) * 1024 + kt * 64) * 256 + g32 * 16;
    c.dst = (u16*)(p->ws + OFF_W13 + ((size_t)e * 512 + g32 * 32) * 1024 + kt * 64);
    return c;
  }
  idx -= 8192;
  {
    int e = idx >> 7, nt = (idx >> 2) & 31, kt = idx & 3;
    c.ld = 1024; c.ldd = -256; c.mul = F8_WSCALE;
    c.src = p->w_ff2 + ((size_t)(l * 32 + e) * 256 + kt * 64) * 1024 + nt * 32;
    c.dst = (u16*)(p->ws + OFF_W2 + ((size_t)e * 1024 + nt * 32) * 256 + kt * 64);
    return c;
  }
}
DEVI void modulate_row_store(KP p, int l, int which, const float (&xv)[16], int mrow, u16* hrow, float (&hv)[16]) {
  const int lane = TIDX & 63;
  float ss = 0.f;
#pragma unroll
  for (int i = 0; i < 16; ++i) ss += xv[i] * xv[i];
  ss = wave_sum(ss);
  const float rstd = rsqrtf(ss * (1.f / 1024.f) + EPS);
  const float* g = (which ? p->g_norm_ffn : p->g_norm_mix) + l * 1024;
  const float* mod = wsp<float>(p, OFF_MOD) + ((size_t)l * 9 + mrow) * 6144 + (which ? 3072 : 0);
#pragma unroll
  for (int i = 0; i < 4; ++i) {
    const int c = i * 256 + lane * 4;
    f32x4 gv = *(const f32x4*)(g + c);
    f32x4 sh = *(const f32x4*)(mod + c);
    f32x4 sc = *(const f32x4*)(mod + 1024 + c);
    hv[i * 4 + 0] = xv[i * 4 + 0] * rstd * gv.x * (1.f + sc.x) + sh.x;
    hv[i * 4 + 1] = xv[i * 4 + 1] * rstd * gv.y * (1.f + sc.y) + sh.y;
    hv[i * 4 + 2] = xv[i * 4 + 2] * rstd * gv.z * (1.f + sc.z) + sh.z;
    hv[i * 4 + 3] = xv[i * 4 + 3] * rstd * gv.w * (1.f + sc.w) + sh.w;
    u32x2 o; o.x = pk2(hv[i * 4 + 0], hv[i * 4 + 1]); o.y = pk2(hv[i * 4 + 2], hv[i * 4 + 3]);
    *(u32x2*)(hrow + c) = o;
  }
}
struct ModVec { f32x4 a[4], b[4]; };
DEVI void load_modvec(KP p, int l, int which, int mrow, ModVec& mv) {
  const int lane = TIDX & 63;
  const float* g = (which ? p->g_norm_ffn : p->g_norm_mix) + l * 1024;
  const float* mod = wsp<float>(p, OFF_MOD) + ((size_t)l * 9 + mrow) * 6144 + (which ? 3072 : 0);
#pragma unroll
  for (int i = 0; i < 4; ++i) {
    const int c = i * 256 + lane * 4;
    const f32x4 gv = *(const f32x4*)(g + c), sh = *(const f32x4*)(mod + c), sc = *(const f32x4*)(mod + 1024 + c);
    mv.a[i] = gv * (1.f + sc); mv.b[i] = sh;
  }
}
DEVI unsigned char* h8base(KP p) { return (unsigned char*)p->out + (size_t)NTOK * 2048; }
template <bool F8COPY = false, bool BF16 = true>
DEVI void modulate_row_store2(const ModVec& mv, const float (&xv)[16], u16* hrow, float (&hv)[16], unsigned char* h8row = nullptr) {
  const int lane = TIDX & 63;
  float ss = 0.f;
#pragma unroll
  for (int i = 0; i < 16; ++i) ss += xv[i] * xv[i];
  ss = wave_sum(ss);
  const float rstd = rsqrtf(ss * (1.f / 1024.f) + EPS);
#pragma unroll
  for (int i = 0; i < 4; ++i) {
    const int c = i * 256 + lane * 4;
#pragma unroll
    for (int j = 0; j < 4; ++j) hv[i * 4 + j] = xv[i * 4 + j] * rstd * mv.a[i][j] + mv.b[i][j];
    if (BF16) { u32x2 o; o.x = pk2(hv[i * 4 + 0], hv[i * 4 + 1]); o.y = pk2(hv[i * 4 + 2], hv[i * 4 + 3]);
      *(u32x2*)(hrow + c) = o; }
    if (F8COPY) {
      float q[4];
#pragma unroll
      for (int j = 0; j < 4; ++j) q[j] = __builtin_amdgcn_fmed3f(hv[i * 4 + j], -448.f, 448.f);
      int v = __builtin_amdgcn_cvt_pk_fp8_f32(q[0], q[1], 0, false);
      v = __builtin_amdgcn_cvt_pk_fp8_f32(q[2], q[3], v, true);
      *(int*)(h8row + c) = v;
    }
  }
}
DEVI void load_row16(const float* xr, float (&xv)[16]) {
  const int lane = TIDX & 63;
#pragma unroll
  for (int i = 0; i < 4; ++i) {
    f32x4 v = *(const f32x4*)(xr + i * 256 + lane * 4);
    xv[i * 4 + 0] = v.x; xv[i * 4 + 1] = v.y; xv[i * 4 + 2] = v.z; xv[i * 4 + 3] = v.w;
  }
}
DEVI void load_row16_bf(const u16* xr, float (&xv)[16]) {
  const int lane = TIDX & 63;
#pragma unroll
  for (int i = 0; i < 4; ++i) {
    const u32x2 v = *(const u32x2*)(xr + i * 256 + lane * 4);
    xv[i * 4 + 0] = __uint_as_float(v.x << 16); xv[i * 4 + 1] = __uint_as_float(v.x & 0xffff0000u);
    xv[i * 4 + 2] = __uint_as_float(v.y << 16); xv[i * 4 + 3] = __uint_as_float(v.y & 0xffff0000u);
  }
}
DEVI float router_dot(const float (&hv)[4][16], const float* wrow) {
  const int lane = TIDX & 63;
  const float* w = wrow + lane * 4;
  float pr[4] = {0.f, 0.f, 0.f, 0.f};
#pragma unroll
  for (int i = 0; i < 4; ++i) {
    const f32x4 wv = *(const f32x4*)(w + i * 256);
#pragma unroll
    for (int r = 0; r < 4; ++r)
      pr[r] += hv[r][i * 4] * wv.x + hv[r][i * 4 + 1] * wv.y + hv[r][i * 4 + 2] * wv.z + hv[r][i * 4 + 3] * wv.w;
  }
  const bool up = (lane & 32) != 0;
  float s0 = up ? pr[0] : pr[2], s1 = up ? pr[1] : pr[3];
  float k0 = up ? pr[2] : pr[0], k1 = up ? pr[3] : pr[1];
  k0 += __shfl_xor(s0, 32); k1 += __shfl_xor(s1, 32);
  const bool up2 = (lane & 16) != 0;
  float sv = up2 ? k0 : k1, kv = up2 ? k1 : k0;
  kv += __shfl_xor(sv, 16);
  kv += __shfl_xor(kv, 8); kv += __shfl_xor(kv, 4); kv += __shfl_xor(kv, 2); kv += __shfl_xor(kv, 1);
  return kv;
}
#define XB_TMO      128
#define XB_XCNT(j)  (256  + 64 * (j))
#define XB_XSUB(j)  (1280 + 64 * (j))
#define XB_XGEN(j)  (2304 + 64 * (j))
#define XB_TOP      3328
#define XB_TOPGEN   3392
#define XB_SPIN_CAP (1u << 20)
#define LAS __attribute__((address_space(3)))
DEVI unsigned xb_ld(unsigned* p) { return __hip_atomic_load(p, __ATOMIC_RELAXED, __HIP_MEMORY_SCOPE_AGENT); }
DEVI unsigned xb_add(unsigned* p, unsigned v) { return __hip_atomic_fetch_add(p, v, __ATOMIC_RELAXED, __HIP_MEMORY_SCOPE_AGENT); }
DEVI unsigned xb_xcc_id() { return (unsigned)__builtin_amdgcn_s_getreg((3 << 11) | 20) & 0xFu; }
#define XB_SPIN(cond, bar) do { unsigned _sp = 0; while (cond) { __builtin_amdgcn_s_sleep(1); \
    if ((++_sp & 255u) == 0u) { if (xb_ld(&(bar)[XB_TMO])) break; if (_sp > XB_SPIN_CAP) { atomicAdd(&(bar)[XB_TMO], 1u); break; } } } } while (0)
DEVI void xcd_barrier_post(unsigned* bar) {
  if (TIDX == 0) (void)xb_add(&bar[XB_XCNT(xb_xcc_id())], 1u);
}
DEVI void xcd_barrier_complete(unsigned* bar, unsigned x, unsigned& nloc, unsigned& nx) {
  const unsigned G = gridDim.x * gridDim.y * gridDim.z;
  unsigned sum, cnt, mine, sp = 0u;
  for (;;) {
    sum = 0u; cnt = 0u; mine = 0u;
#pragma unroll
    for (unsigned j = 0; j < 16; ++j) { const unsigned c = xb_ld(&bar[XB_XCNT(j)]); sum += c; cnt += (c > 0u) ? 1u : 0u; mine = (j == x) ? c : mine; }
    if (sum == G) break;
    __builtin_amdgcn_s_sleep(1);
    if ((++sp & 255u) == 0u) { if (xb_ld(&bar[XB_TMO])) break; if (sp > XB_SPIN_CAP) { atomicAdd(&bar[XB_TMO], 1u); break; } }
  }
  nloc = mine > 0u ? mine : 1u; nx = cnt > 0u ? cnt : 1u;
}
DEVI void xcd_barrier(unsigned* bar, volatile LAS unsigned* st) {
  asm volatile("s_waitcnt vmcnt(0)" ::: "memory");
  __syncthreads();
  if (TIDX == 0) {
    const unsigned x = xb_xcc_id();
    __builtin_amdgcn_s_waitcnt(0);
    unsigned nloc = st[0], nx = st[1];
    if (nloc == 0u) { xcd_barrier_complete(bar, x, nloc, nx); st[0] = nloc; st[1] = nx; }
    const unsigned old = xb_add(&bar[XB_XSUB(x)], 1u);
    const unsigned gen = old / nloc;
    if (old + 1u == (gen + 1u) * nloc) {
      __builtin_amdgcn_fence(__ATOMIC_RELEASE, "agent");
      asm volatile("s_waitcnt vmcnt(0)" ::: "memory");
      const unsigned og = xb_add(&bar[XB_TOP], 1u);
      const unsigned tg = og / nx;
      if (og + 1u == (tg + 1u) * nx) xb_add(&bar[XB_TOPGEN], 1u);
      else XB_SPIN(xb_ld(&bar[XB_TOPGEN]) == tg, bar);
      __builtin_amdgcn_fence(__ATOMIC_ACQUIRE, "agent");
      xb_add(&bar[XB_XGEN(x)], 1u);
      asm volatile("s_waitcnt vmcnt(0)" ::: "memory");
    } else {
      XB_SPIN(xb_ld(&bar[XB_XGEN(x)]) == gen, bar);
      __builtin_amdgcn_fence(__ATOMIC_ACQUIRE, "agent");
      asm volatile("s_waitcnt vmcnt(0)" ::: "memory");
    }
  }
  __syncthreads();
}

namespace v2 {
typedef LAS unsigned char* ldsp_t;
constexpr int BM = 256, BK = 64, HALF = 128, HTB = HALF * BK * 2, STAGE_BYTES = 8 * HTB;
constexpr int NW = 8;
constexpr int LDS_XTRA = STAGE_BYTES;
constexpr int LDS_BARW = STAGE_BYTES + 16384;
constexpr int LDS_TOTAL = LDS_BARW + 16;

DEVI int lds_byte(int r, int c) { const int st = (r >> 4) * 2 + (c >> 5), rr = r & 15, cc = c & 31, ob = rr * 64 + cc * 2; return st * 1024 + (ob ^ (((ob >> 9) & 1) << 5)); }
DEVI void stage_rc(int b, int& R, int& C) { const int st = b / 1024, sb = b % 1024, swz = sb ^ (((sb >> 9) & 1) << 5); R = (st >> 1) * 16 + swz / 64; C = (st & 1) * 32 + (swz % 64) / 2; }
DEVI int perm32(int rho) { const int n = rho >> 4, i = rho & 15; return 8 * (i >> 2) + 4 * n + (i & 3); }

DEVI void acc_zero(f32x4 (&acc)[2][2][4][2]) {
#pragma unroll
  for (int a = 0; a < 2; ++a)
#pragma unroll
    for (int b = 0; b < 2; ++b)
#pragma unroll
      for (int m = 0; m < 4; ++m)
#pragma unroll
        for (int n = 0; n < 2; ++n) acc[a][b][m][n] = (f32x4){0.f, 0.f, 0.f, 0.f};
}
struct Unit { const char* A; const char* B; const int* rows; int nvalid; int u0, u1, u2, u3; };

typedef int i32x8 __attribute__((ext_vector_type(8)));
typedef int i32x4v __attribute__((ext_vector_type(4)));
DEVI i32x8 cat8(bf16x8 lo, bf16x8 hi) { return __builtin_shufflevector(__builtin_bit_cast(i32x4v, lo), __builtin_bit_cast(i32x4v, hi), 0, 1, 2, 3, 4, 5, 6, 7); }
DEVI const char* sptr(const char* p) {
  const unsigned long long v = (unsigned long long)p;
  const unsigned lo = (unsigned)__builtin_amdgcn_readfirstlane((int)(unsigned)v), hi = (unsigned)__builtin_amdgcn_readfirstlane((int)(unsigned)(v >> 32));
  return (const char*)(((unsigned long long)hi << 32) | lo);
}
template <bool PERM, bool GATHER, bool F8, class Epi, class Sched>
DEVI void gemm_phase(ldsp_t lds, int lda_b, int ldb_b, int nt, const Sched& S, const Epi& E) {
  const int tid = TIDX, wid = __builtin_amdgcn_readfirstlane(tid >> 6), lane = tid & 63, wr = wid >> 2, wc = wid & 3, fr = lane & 15, fq = lane >> 4;
  unsigned voffA[2], voffB[2]; int RA[2], CA2[2];
#pragma unroll
  for (int i = 0; i < 2; ++i) {
    int R, C; stage_rc(tid * 16 + i * 8192, R, C);
    const int Rb = PERM ? ((R & ~31) + perm32(R & 31)) : R;
    RA[i] = R; CA2[i] = C * 2;
    voffA[i] = (unsigned)(R * lda_b + C * 2); voffB[i] = (unsigned)(Rb * ldb_b + C * 2);
  }
  const size_t kstep = (size_t)(BK * 2);
  const size_t hstepA = (size_t)HALF * lda_b, hstepB = (size_t)HALF * ldb_b;
  const unsigned ldsw = (unsigned)wid * 1024u, ldsbase = (unsigned)(size_t)lds;
  const int aoff = lds_byte(wr * 64 + fr, fq * 8), boff = lds_byte(wc * 32 + fr, fq * 8);
#define G_SA(b, h) (((b) * 2 + (h)) * HTB)
#define G_SB(b, h) ((4 + (b) * 2 + (h)) * HTB)
#define G_DMA(sbase, voff, ldsaddr) asm volatile("s_mov_b32 m0, %2\n\ts_nop 0\n\tglobal_load_lds_dwordx4 %0, %1" :: "v"(voff), "s"(sbase), "s"(ldsaddr) : "memory", "m0")
#define G_STAGE(bufoff, gbase, voff) do { const char* sb_ = sptr((const char*)(gbase)); _Pragma("unroll") for (int _i = 0; _i < 2; ++_i) \
    G_DMA(sb_, (voff)[_i], (unsigned)__builtin_amdgcn_readfirstlane((int)(ldsbase + (unsigned)(bufoff) + ldsw + (unsigned)_i * 8192u))); } while (0)
#define G_STAGE_A(bufoff, abase, go, h, koff) do { if (GATHER) { const char* sb_ = sptr((const char*)(abase) + (koff)); _Pragma("unroll") for (int _i = 0; _i < 2; ++_i) \
    G_DMA(sb_, (go)[h][_i], (unsigned)__builtin_amdgcn_readfirstlane((int)(ldsbase + (unsigned)(bufoff) + ldsw + (unsigned)_i * 8192u))); } \
    else G_STAGE(bufoff, (abase) + (h) * hstepA + (koff), voffA); } while (0)
#define G_LDA(dst, b, h) do { _Pragma("unroll") for (int m = 0; m < 4; ++m) { if (F8) dst##8[m] = cat8(*(const LAS bf16x8*)(lds + G_SA(b, h) + aoff + m * 2048), *(const LAS bf16x8*)(lds + G_SA(b, h) + aoff + m * 2048 + 1024)); \
    else { _Pragma("unroll") for (int k = 0; k < 2; ++k) dst[m][k] = *(const LAS bf16x8*)(lds + G_SA(b, h) + aoff + m * 2048 + k * 1024); } } } while (0)
#define G_LDB(dst, b, h) do { _Pragma("unroll") for (int n = 0; n < 2; ++n) { if (F8) dst##8[n] = cat8(*(const LAS bf16x8*)(lds + G_SB(b, h) + boff + n * 2048), *(const LAS bf16x8*)(lds + G_SB(b, h) + boff + n * 2048 + 1024)); \
    else { _Pragma("unroll") for (int k = 0; k < 2; ++k) dst[n][k] = *(const LAS bf16x8*)(lds + G_SB(b, h) + boff + n * 2048 + k * 1024); } } } while (0)
#define G_MMA(ai, bj, At, Bt) do { __builtin_amdgcn_s_setprio(1); _Pragma("unroll") for (int m = 0; m < 4; ++m) _Pragma("unroll") for (int n = 0; n < 2; ++n) { \
    if (F8) asm("v_mfma_scale_f32_16x16x128_f8f6f4 %0, %1, %2, %0, %3, %4 op_sel_hi:[0,0,0]" : "+v"(acc[ai][bj][m][n]) : "v"(Bt##8[n]), "v"(At##8[m]), "v"(f8wscale), "v"(f8ascale)); \
    else { _Pragma("unroll") for (int k = 0; k < 2; ++k) acc[ai][bj][m][n] = __builtin_amdgcn_mfma_f32_16x16x32_bf16(Bt[n][k], At[m][k], acc[ai][bj][m][n], 0, 0, 0); } } \
    __builtin_amdgcn_s_setprio(0); } while (0)
#define G_WAIT_V(n) asm volatile("s_waitcnt vmcnt(" #n ")" ::: "memory")
#define G_WAIT_L(n) asm volatile("s_waitcnt lgkmcnt(" #n ")" ::: "memory")
#define G_BAR __builtin_amdgcn_s_barrier()
#define G_SCHED __builtin_amdgcn_sched_barrier(0)
  Unit cur, nxt; int ui = 0;
  if (!S.next(0, cur)) return;
  f32x4 acc[2][2][4][2];
  E.init(acc, cur, wr, wc, fr, fq);
  bf16x8 At[4][2], B0[2][2], B1[2][2];
  i32x8 At8[4], B08[2], B18[2];
  const int f8wscale = 0x79797979, f8ascale = 0x7f7f7f7f;
  unsigned gcur[2][2];
  auto gather_offs = [&](const Unit& u, unsigned (&go)[2][2]) {
#pragma unroll
    for (int h = 0; h < 2; ++h)
#pragma unroll
      for (int i = 0; i < 2; ++i) {
        const int r = h * HALF + RA[i];
        const int t = (r < u.nvalid) ? (u.rows[r] >> 1) : 0;
        go[h][i] = (unsigned)t * (unsigned)lda_b + (unsigned)CA2[i];
      }
  };
  if (GATHER) gather_offs(cur, gcur);
  const char* cA = cur.A; const char* cB = cur.B;
  G_STAGE(G_SB(0, 0), cB, voffB); G_STAGE_A(G_SA(0, 0), cA, gcur, 0, 0); G_STAGE(G_SB(0, 1), cB + hstepB, voffB); G_STAGE_A(G_SA(0, 1), cA, gcur, 1, 0);
  if (wr == 1) G_BAR;
  G_WAIT_V(4); G_BAR;
  G_STAGE(G_SB(1, 0), cB + kstep, voffB); G_STAGE_A(G_SA(1, 0), cA, gcur, 0, kstep); G_STAGE(G_SB(1, 1), cB + hstepB + kstep, voffB);
  G_WAIT_V(6); G_BAR;
  for (;;) {
    const bool has_next = S.next(ui + 1, nxt);
    const char* nA = has_next ? nxt.A : cA; const char* nB = has_next ? nxt.B : cB;
#pragma clang loop unroll(disable)
    for (int t = 0; t < nt; t += 2) {
      const bool last = (t == nt - 2);
      const size_t k1 = (size_t)(t + 1) * kstep;
      const char* a2 = last ? nA : cA; const char* b2 = last ? nB : cB + (size_t)(t + 2) * kstep;
      const size_t ka2 = last ? 0 : (size_t)(t + 2) * kstep;
      const char* b3 = b2 + kstep; const size_t ka3 = ka2 + kstep;
      unsigned gN[2][2];
      if (GATHER && last) {
        if (has_next) gather_offs(nxt, gN);
        else {
#pragma unroll
          for (int h = 0; h < 2; ++h)
#pragma unroll
            for (int i = 0; i < 2; ++i) gN[h][i] = gcur[h][i];
        }
      }
#define G_STAGE_A2(bufoff, h, koff) do { if (GATHER) { if (last) G_STAGE_A(bufoff, cA, gN, h, (koff) - ka2); else G_STAGE_A(bufoff, cA, gcur, h, koff); } \
        else G_STAGE_A(bufoff, a2, gcur, h, koff); } while (0)
      G_LDB(B0, 0, 0); G_SCHED; G_LDA(At, 0, 0); G_STAGE_A(G_SA(1, 1), cA, gcur, 1, k1);
      G_WAIT_L(8); G_BAR; G_WAIT_L(0); G_MMA(0, 0, At, B0); G_BAR; G_SCHED;
      G_LDB(B1, 0, 1); G_STAGE(G_SB(0, 0), b2, voffB);
      G_BAR; G_WAIT_L(0); G_MMA(0, 1, At, B1); G_BAR;
      G_LDA(At, 0, 1); G_STAGE_A2(G_SA(0, 0), 0, ka2);
      G_BAR; G_WAIT_L(0); G_MMA(1, 0, At, B0); G_BAR; G_SCHED;
      G_STAGE(G_SB(0, 1), b2 + hstepB, voffB);
      G_WAIT_V(6); G_BAR; G_MMA(1, 1, At, B1); G_BAR;
      G_LDB(B0, 1, 0); G_SCHED; G_LDA(At, 1, 0); G_STAGE_A2(G_SA(0, 1), 1, ka2);
      G_WAIT_L(8); G_BAR; G_WAIT_L(0); G_MMA(0, 0, At, B0); G_BAR; G_SCHED;
      G_LDB(B1, 1, 1); G_STAGE(G_SB(1, 0), b3, voffB);
      G_BAR; G_WAIT_L(0); G_MMA(0, 1, At, B1); G_BAR;
      G_LDA(At, 1, 1); G_STAGE_A2(G_SA(1, 0), 0, ka3);
      G_BAR; G_WAIT_L(0); G_MMA(1, 0, At, B0); G_BAR; G_SCHED;
      G_STAGE(G_SB(1, 1), b3 + hstepB, voffB);
      G_WAIT_V(6); G_BAR; G_MMA(1, 1, At, B1); G_BAR;
      if (GATHER && last) {
#pragma unroll
        for (int h = 0; h < 2; ++h)
#pragma unroll
          for (int i = 0; i < 2; ++i) gcur[h][i] = gN[h][i];
      }
#undef G_STAGE_A2
    }
    G_SCHED;
    if (F8) {
      asm volatile("s_nop 15\n\ts_nop 15" ::: "memory");
#pragma unroll
      for (int a_ = 0; a_ < 2; ++a_)
#pragma unroll
        for (int b_ = 0; b_ < 2; ++b_)
#pragma unroll
          for (int m_ = 0; m_ < 4; ++m_)
#pragma unroll
            for (int n_ = 0; n_ < 2; ++n_) asm volatile("" : "+v"(acc[a_][b_][m_][n_]));
    }
    E(acc, cur, wr, wc, fr, fq);
    G_SCHED;
    if (!has_next) break;
    cur = nxt; cA = nA; cB = nB; ++ui;
    E.init(acc, cur, wr, wc, fr, fq);
  }
  G_WAIT_V(0);
  if (wr == 0) G_BAR;
  G_BAR;
#undef G_SA
#undef G_SB
#undef G_STAGE
#undef G_DMA
#undef G_STAGE_A
#undef G_LDA
#undef G_LDB
#undef G_MMA
#undef G_WAIT_V
#undef G_WAIT_L
#undef G_BAR
#undef G_SCHED
}

DEVI unsigned uoff(unsigned x) { return (unsigned)__builtin_amdgcn_readfirstlane((int)x); }
DEVI bool tile_order(int i, int G, int c, int nM, int nN, int& pm, int& pn) {
  const int nwg = nM * nN;
  const long L = (long)i * G + c; if (L >= nwg) return false;
  int wgid = (int)L; { const int q = nwg / 8, r = nwg % 8, xcd = wgid % 8, off = wgid / 8; wgid = (xcd < r ? xcd * (q + 1) : r * (q + 1) + (xcd - r) * q) + off; }
  const int WGM = 8;
  const int nig = WGM * nN, gid = wgid / nig, fm = gid * WGM, gsz = (nM - fm) < WGM ? (nM - fm) : WGM;
  pm = fm + ((wgid % nig) % gsz); pn = (wgid % nig) / gsz;
  pm = __builtin_amdgcn_readfirstlane(pm); pn = __builtin_amdgcn_readfirstlane(pn);
  return true;
}
struct EpiRawBf16 {
  u16* O; int ldc; float sc;
  DEVI void init(f32x4 (&acc)[2][2][4][2], const Unit&, int, int, int, int) const { acc_zero(acc); }
  DEVI void operator()(const f32x4 (&acc)[2][2][4][2], const Unit& u, int wr, int wc, int fr, int fq) const {
    const unsigned off0 = ((unsigned)(u.u0 + wr * 64 + fr) * (unsigned)ldc + (unsigned)(u.u1 + wc * 32 + 8 * fq)) * 2u;
#pragma unroll
    for (int ai = 0; ai < 2; ++ai)
#pragma unroll
      for (int m = 0; m < 4; ++m) {
        char* rowp = (char*)O + (off0 + (unsigned)(ai * HALF + m * 16) * (unsigned)ldc * 2u);
#pragma unroll
        for (int bj = 0; bj < 2; ++bj) {
          const f32x4 v0 = acc[ai][bj][m][0] * sc, v1 = acc[ai][bj][m][1] * sc;
          u32x4 w; w.x = pk2(v0[0], v0[1]); w.y = pk2(v0[2], v0[3]); w.z = pk2(v1[0], v1[1]); w.w = pk2(v1[2], v1[3]);
          *(u32x4*)(rowp + bj * HALF * 2) = w;
        }
      }
  }
};

struct EpiRawF8 {
  unsigned char* O; int ldc; float sc;
  DEVI void init(f32x4 (&acc)[2][2][4][2], const Unit&, int, int, int, int) const { acc_zero(acc); }
  DEVI void operator()(const f32x4 (&acc)[2][2][4][2], const Unit& u, int wr, int wc, int fr, int fq) const {
    const unsigned off0 = (unsigned)(u.u0 + wr * 64 + fr) * (unsigned)ldc + (unsigned)(u.u1 + wc * 32 + 8 * fq);
#pragma unroll
    for (int ai = 0; ai < 2; ++ai)
#pragma unroll
      for (int m = 0; m < 4; ++m) {
        unsigned char* rowp = O + (off0 + (unsigned)(ai * HALF + m * 16) * (unsigned)ldc);
#pragma unroll
        for (int bj = 0; bj < 2; ++bj) {
          u32x2 w;
#pragma unroll
          for (int n = 0; n < 2; ++n) {
            const f32x4 v = acc[ai][bj][m][n] * sc;
            int q = __builtin_amdgcn_cvt_pk_fp8_f32(__builtin_amdgcn_fmed3f(v[0], -448.f, 448.f), __builtin_amdgcn_fmed3f(v[1], -448.f, 448.f), 0, false);
            q = __builtin_amdgcn_cvt_pk_fp8_f32(__builtin_amdgcn_fmed3f(v[2], -448.f, 448.f), __builtin_amdgcn_fmed3f(v[3], -448.f, 448.f), q, true);
            w[n] = (unsigned)q;
          }
          *(u32x2*)(rowp + bj * HALF) = w;
        }
      }
  }
};
DEVI size_t z8_block(int pm, int branch, int cb) { return (size_t)((pm * 4 + branch) * 8 + cb) * 32768; }
struct EpiZ8 {
  unsigned char* O;
  DEVI void init(f32x4 (&acc)[2][2][4][2], const Unit&, int, int, int, int) const { acc_zero(acc); }
  DEVI void operator()(const f32x4 (&acc)[2][2][4][2], const Unit& u, int wr, int wc, int fr, int fq) const {
    const int pm = u.u0 >> 8, pn = u.u1 >> 8, n = pn >> 2, cq = pn & 3;
    const unsigned lw16 = (unsigned)((wr * 4 + wc) * 64 + fr + 16 * fq) * 16u;
#pragma unroll
    for (int bj = 0; bj < 2; ++bj) {
      unsigned char* blk = O + z8_block(pm, n, cq * 2 + bj) + lw16;
#pragma unroll
      for (int P = 0; P < 4; ++P) {
        u32x4 w;
#pragma unroll
        for (int h = 0; h < 2; ++h)
#pragma unroll
          for (int nn = 0; nn < 2; ++nn) {
            const int g = 2 * P + h;
            const f32x4 v = acc[g >> 2][bj][g & 3][nn] * (Z8_SCALE / O8_SCALE);
            int q = __builtin_amdgcn_cvt_pk_fp8_f32(__builtin_amdgcn_fmed3f(v[0], -448.f, 448.f), __builtin_amdgcn_fmed3f(v[1], -448.f, 448.f), 0, false);
            q = __builtin_amdgcn_cvt_pk_fp8_f32(__builtin_amdgcn_fmed3f(v[2], -448.f, 448.f), __builtin_amdgcn_fmed3f(v[3], -448.f, 448.f), q, true);
            w[2 * h + nn] = (unsigned)q;
          }
        *(u32x4*)(blk + P * 8192) = w;
      }
    }
  }
};
struct SchedB { const char* ws; const char* h8; int G, c;
  DEVI bool next(int i, Unit& u) const { int pm, pn; if (!tile_order(i, G, c, NTOK / 256, INP / 256, pm, pn)) return false;
    u.A = h8 + uoff((unsigned)pm * 256u * 1024u); u.B = ws + OFF_WIN + uoff((unsigned)pn * 256u * 1024u);        u.rows = nullptr; u.nvalid = 0; u.u0 = pm * 256; u.u1 = pn * 256; u.u2 = 0; u.u3 = 0; return true; } };
struct EpiB { u16* O; float* ssq;
  DEVI void init(f32x4 (&acc)[2][2][4][2], const Unit&, int, int, int, int) const { acc_zero(acc); }
  DEVI void operator()(const f32x4 (&acc)[2][2][4][2], const Unit& u, int wr, int wc, int fr, int fq) const {
    EpiRawBf16 E{O, PLD, 1.f}; E(acc, u, wr, wc, fr, fq);
    if (u.u1 < 512) {
      const bool iskv = u.u1 != 0;
#pragma unroll
      for (int ai = 0; ai < 2; ++ai)
#pragma unroll
        for (int m = 0; m < 4; ++m) {
          float ss = 0.f;
#pragma unroll
          for (int bj = 0; bj < 2; ++bj)
#pragma unroll
            for (int n = 0; n < 2; ++n)
#pragma unroll
              for (int j = 0; j < 4; ++j) { const float v = acc[ai][bj][m][n][j]; if (!(iskv && bj == 1)) ss += v * v; }
          ss += __shfl_xor(ss, 16); ss += __shfl_xor(ss, 32);
          if (fq == 0) ssq[(size_t)(u.u0 + ai * HALF + wr * 64 + m * 16 + fr) * 8 + (iskv ? 4 : 0) + wc] = ss;
        }
    }
  }
};
DEVI void phaseB2(KP p, ldsp_t lds) {
  SchedB S{(const char*)p->ws, (const char*)h8base(p), (int)gridDim.x, BIDX};
  EpiB E{wsp<u16>(p, OFF_PRAW), wsp<float>(p, OFF_SSQ)};
  gemm_phase<true, false, true>(lds, 1024, 1024, 8, S, E);
}
struct SchedC { const char* ws; int G, c;
  DEVI bool next(int i, Unit& u) const { int pm, pn; if (!tile_order(i, G, c, NTOK / 256, 4, pm, pn)) return false;
    const bool kv = pn >= 2; const int pj = pn & 1;
    u.A = ws + OFF_PRAW + uoff((unsigned)pm * 256u * (unsigned)(PLD * 2) + (kv ? 512u : 0u)); u.B = ws + (kv ? OFF_WKVB : OFF_WQB) + uoff((unsigned)pj * 256u * 512u); u.rows = nullptr; u.nvalid = 0;
    u.u0 = pm * 256; u.u1 = pj * 256; u.u2 = kv; u.u3 = 0; return true; } };
struct EpiC { u16* Oq; u16* Okv; const float* ssq;
  DEVI void init(f32x4 (&acc)[2][2][4][2], const Unit&, int, int, int, int) const { acc_zero(acc); }
  DEVI void operator()(const f32x4 (&acc)[2][2][4][2], const Unit& u, int wr, int wc, int fr, int fq) const {
    const bool kv = u.u2 != 0;
    u16* O = kv ? Okv : Oq;
    const int row0 = u.u0 + wr * 64 + fr, col0 = u.u1 + wc * 32 + 8 * fq;
    f32x4 sq[2][4];
#pragma unroll
    for (int ai = 0; ai < 2; ++ai)
#pragma unroll
      for (int m = 0; m < 4; ++m) sq[ai][m] = *(const f32x4*)(ssq + (size_t)(row0 + ai * HALF + m * 16) * 8 + (kv ? 4 : 0));
#pragma unroll
    for (int ai = 0; ai < 2; ++ai)
#pragma unroll
      for (int m = 0; m < 4; ++m) {
        const size_t r = (size_t)(row0 + ai * HALF + m * 16);
        const float tot = sq[ai][m].x + sq[ai][m].y + sq[ai][m].z + sq[ai][m].w;
        const float sc = kv ? rsqrtf(tot * (1.f / 128.f) + EPS) : rsqrtf(tot * (1.f / 256.f) + EPS) * (0.10206207261596575f * LOG2E);
        u16* rowp = O + r * 512 + col0;
#pragma unroll
        for (int bj = 0; bj < 2; ++bj) {
          const f32x4 v0 = acc[ai][bj][m][0] * sc, v1 = acc[ai][bj][m][1] * sc;
          u32x4 w; w.x = pk2(v0[0], v0[1]); w.y = pk2(v0[2], v0[3]); w.z = pk2(v1[0], v1[1]); w.w = pk2(v1[2], v1[3]);
          *(u32x4*)(rowp + bj * HALF) = w;
        }
      }
  }
};
DEVI void phaseC2(KP p, ldsp_t lds) {
  SchedC S{(const char*)p->ws, (int)gridDim.x, BIDX};
  EpiC E{wsp<u16>(p, OFF_QARAW), wsp<u16>(p, OFF_KVARAW), wsp<float>(p, OFF_SSQ)};
  int nt = 4; asm volatile("" : "+s"(nt));
  gemm_phase<true, false, false>(lds, PLD * 2, 512, nt, S, E);
}

DEVI void ld16(const u16* src, float (&v)[16]) {
  const u32x4 a = *(const u32x4*)src, b = *(const u32x4*)(src + 8);
  const unsigned w[8] = {a.x, a.y, a.z, a.w, b.x, b.y, b.z, b.w};
#pragma unroll
  for (int i = 0; i < 8; ++i) { v[2 * i] = __uint_as_float(w[i] << 16); v[2 * i + 1] = __uint_as_float(w[i] & 0xffff0000u); }
}
DEVI void st16(u16* dst, const float (&v)[16]) {
  u32x4 a, b;
  a.x = pk2(v[0], v[1]); a.y = pk2(v[2], v[3]); a.z = pk2(v[4], v[5]); a.w = pk2(v[6], v[7]);
  b.x = pk2(v[8], v[9]); b.y = pk2(v[10], v[11]); b.z = pk2(v[12], v[13]); b.w = pk2(v[14], v[15]);
  *(u32x4*)dst = a; *(u32x4*)(dst + 8) = b;
}
DEVI void rope16c(float (&v)[16], const float* cs16, int pos) {
  const f32x2* t = (const f32x2*)(cs16 + pos * 16);
#pragma unroll
  for (int i = 0; i < 8; ++i) { const f32x2 cs = t[i]; const float x1 = v[i], x2 = v[8 + i]; v[i] = x1 * cs.x - x2 * cs.y; v[8 + i] = x2 * cs.x + x1 * cs.y; }
}
DEVI void rope32c(float (&lo)[16], float (&hi)[16], const float* cs32, int pos) {
  const f32x2* t = (const f32x2*)(cs32 + pos * 32);
#pragma unroll
  for (int i = 0; i < 16; ++i) { const f32x2 cs = t[i]; const float x1 = lo[i], x2 = hi[i]; lo[i] = x1 * cs.x - x2 * cs.y; hi[i] = x2 * cs.x + x1 * cs.y; }
}
DEVI float ssq16(const float (&v)[16]) { float s = 0.f;
#pragma unroll
  for (int i = 0; i < 16; ++i) s += v[i] * v[i];
  return s; }
DEVI void scale16(float (&v)[16], float s) {
#pragma unroll
  for (int i = 0; i < 16; ++i) v[i] *= s; }
DEVI void cvt16(const u32x4 a, const u32x4 b, float (&v)[16]) {
  const unsigned w[8] = {a.x, a.y, a.z, a.w, b.x, b.y, b.z, b.w};
#pragma unroll
  for (int i = 0; i < 8; ++i) { v[2 * i] = __uint_as_float(w[i] << 16); v[2 * i + 1] = __uint_as_float(w[i] & 0xffff0000u); }
}
DEVI void phaseP2(KP p, int l, ldsp_t lds) {
  const int tid = TIDX, tk = tid >> 3, pt = tid & 7;
  u16* PR = wsp<u16>(p, OFF_PRAW);
  u16* QA = wsp<u16>(p, OFF_QARAW);
  const float* cs32 = wsp<float>(p, OFF_CS32);
  const float* cs16 = wsp<float>(p, OFF_CS16);
  const float QS = 0.125f * LOG2E;
  for (int item = BIDX; item < NTOK / 64; item += gridDim.x) {
    const int tok0 = item * 64, rr0 = tok0 % TPB;
    const bool lat = rr0 >= NCTX;
    const size_t tok = (size_t)tok0 + tk;
    const int t = rr0 + tk - NCTX, grow = (t >> 6) & 63, gcol = t & 63;
    u16* pr = PR + tok * PLD;
    u16* qar = QA + tok * 512 + 96 * (pt >> 1) + 64 + 16 * (pt & 1);
    const int g4 = pt & 3;
    u32x4 r_qa[2], r_kr[2], r_qb[4], r_kb[4], r_qd[4], r_kd[4];
#define LD8(ptr) (*(const u32x4*)(ptr))
    if (lat) {
#pragma unroll
      for (int i = 0; i < 2; ++i) { r_qa[i] = LD8(qar + 8 * i); r_kr[i] = LD8(pr + 384 + 16 * (pt & 1) + 8 * i); }
#pragma unroll
      for (int i = 0; i < 4; ++i) { r_qb[i] = LD8(pr + 512 + 32 * pt + 8 * i); r_kb[i] = LD8(pr + 768 + 32 * g4 + 8 * i); }
    }
#pragma unroll
    for (int i = 0; i < 4; ++i) { r_qd[i] = LD8(pr + 1792 + 32 * pt + 8 * i); r_kd[i] = LD8(pr + 2048 + 32 * g4 + 8 * i); }
#undef LD8
    if (lat) {
      { float v[16]; cvt16(r_qa[0], r_qa[1], v); rope16c(v, cs16, (pt & 1) ? gcol : grow); st16(qar, v); }
      if (pt < 2) { float v[16]; cvt16(r_kr[0], r_kr[1], v); rope16c(v, cs16, pt == 0 ? grow : gcol); st16(pr + 384 + 16 * pt, v); }
      { float lo[16], hi[16]; cvt16(r_qb[0], r_qb[1], lo); cvt16(r_qb[2], r_qb[3], hi); rope32c(lo, hi, cs32, (pt & 1) ? gcol : grow); st16(pr + 512 + 32 * pt, lo); st16(pr + 512 + 32 * pt + 16, hi); }
      if (pt < 4) { float lo[16], hi[16]; cvt16(r_kb[0], r_kb[1], lo); cvt16(r_kb[2], r_kb[3], hi); rope32c(lo, hi, cs32, (pt & 1) ? gcol : grow); st16(pr + 768 + 32 * pt, lo); st16(pr + 768 + 32 * pt + 16, hi); }
    }
    {
      float lo[16], hi[16]; cvt16(r_qd[0], r_qd[1], lo); cvt16(r_qd[2], r_qd[3], hi);
      float ss = ssq16(lo) + ssq16(hi); ss += __shfl_xor(ss, 1);
      const float rs = rsqrtf(ss * (1.f / 64.f) + EPS);
      const float* g = p->g_q_d + l * 64 + 32 * (pt & 1);
#pragma unroll
      for (int i = 0; i < 16; ++i) { lo[i] *= rs * g[i]; hi[i] *= rs * g[16 + i]; }
      if (lat) rope32c(lo, hi, cs32, (pt & 1) ? gcol : grow);
      scale16(lo, QS); scale16(hi, QS);
      st16(pr + 1792 + 32 * pt, lo); st16(pr + 1792 + 32 * pt + 16, hi);
    }
    {
      float lo[16], hi[16]; cvt16(r_kd[0], r_kd[1], lo); cvt16(r_kd[2], r_kd[3], hi);
      float ss = ssq16(lo) + ssq16(hi); ss += __shfl_xor(ss, 1);
      const float rs = rsqrtf(ss * (1.f / 64.f) + EPS);
      const float* g = p->g_k_d + l * 64 + 32 * (g4 & 1);
#pragma unroll
      for (int i = 0; i < 16; ++i) { lo[i] *= rs * g[i]; hi[i] *= rs * g[16 + i]; }
      if (lat) rope32c(lo, hi, cs32, (g4 & 1) ? gcol : grow);
      if (pt < 4) { st16(pr + 2048 + 32 * g4, lo); st16(pr + 2048 + 32 * g4 + 16, hi); }
    }
  }
}

DEVI void conv_load(const ConvT& c, int lane, f32x4 (&v)[8]) {
  const int kk = lane >> 3, n4 = (lane & 7) * 4;
  const float* sp = (c.src2 && n4 >= 16) ? c.src2 + (n4 - 16) : (c.src ? c.src + n4 : nullptr);
#pragma unroll
  for (int i = 0; i < 8; ++i) v[i] = sp ? *(const f32x4*)(sp + (size_t)(kk + 8 * i) * c.ld) : f32x4{0.f, 0.f, 0.f, 0.f};
}
DEVI void conv_store(const ConvT& c, LAS float* t, int lane, const f32x4 (&v)[8]) {
  const int kk = lane >> 3, n4 = (lane & 7) * 4;
#pragma unroll
  for (int i = 0; i < 8; ++i) {
    const int k = kk + 8 * i;
    const float s = (c.ks ? c.ks[k] : 1.f) * c.mul;
    t[(n4 + 0) * 65 + k] = v[i].x * s; t[(n4 + 1) * 65 + k] = v[i].y * s;
    t[(n4 + 2) * 65 + k] = v[i].z * s; t[(n4 + 3) * 65 + k] = v[i].w * s;
  }
  asm volatile("s_waitcnt lgkmcnt(0)" ::: "memory");
  const int n = lane >> 1, k0 = (lane & 1) * 32;
  const LAS float* r = t + n * 65 + k0;
  if (c.ldd < 0) {
    unsigned char* d8 = (unsigned char*)c.dst + (size_t)n * (size_t)(-c.ldd) + k0;
#pragma unroll
    for (int q = 0; q < 2; ++q) {
      u32x4 o;
#pragma unroll
      for (int w = 0; w < 4; ++w) {
        float f[4];
#pragma unroll
        for (int j = 0; j < 4; ++j) f[j] = __builtin_amdgcn_fmed3f(r[16 * q + 4 * w + j], -448.f, 448.f);
        int v = __builtin_amdgcn_cvt_pk_fp8_f32(f[0], f[1], 0, false);
        v = __builtin_amdgcn_cvt_pk_fp8_f32(f[2], f[3], v, true);
        o[w] = (unsigned)v;
      }
      *(u32x4*)(d8 + 16 * q) = o;
    }
    asm volatile("s_waitcnt lgkmcnt(0)" ::: "memory");
    return;
  }
  u16* d = c.dst + (size_t)n * c.ldd + k0;
#pragma unroll
  for (int q = 0; q < 4; ++q) {
    u32x4 o;
    o.x = pk2(r[8 * q], r[8 * q + 1]); o.y = pk2(r[8 * q + 2], r[8 * q + 3]); o.z = pk2(r[8 * q + 4], r[8 * q + 5]); o.w = pk2(r[8 * q + 6], r[8 * q + 7]);
    *(u32x4*)(d + 8 * q) = o;
  }
  asm volatile("s_waitcnt lgkmcnt(0)" ::: "memory");
}
constexpr int CONV_EARLY = 1152 + 64 + 64;
DEVI void conv_items2(KP p, int l, ldsp_t lds, int first_item, int total_items) {
  const int tid = TIDX, wave = __builtin_amdgcn_readfirstlane(tid >> 6), lane = tid & 63;
  LAS float* t = (LAS float*)(lds + wave * 8448);
  __syncthreads();
  const int stride = gridDim.x * NW;
  int item = first_item + BIDX * NW + wave;
  if (item >= total_items) return;
  ConvT c = conv_decode(p, l, item);
  f32x4 v[8];
  conv_load(c, lane, v);
  for (;;) {
    const int nitem = item + stride;
    const bool more = nitem < total_items;
    ConvT cn = c; f32x4 vn[8];
    if (more) { cn = conv_decode(p, l, nitem); conv_load(cn, lane, vn); }
    conv_store(c, t, lane, v);
    if (!more) break;
    c = cn; item = nitem;
#pragma unroll
    for (int i = 0; i < 8; ++i) v[i] = vn[i];
  }
}
template <int BR>
DEVI void attn_mask(f32x16 (&s)[2], int kt, int qlat, int qrow, int qcol, int hh, LAS float* rpb) {
  if (BR == 1) {
#pragma unroll
    for (int kb = 0; kb < 2; ++kb)
#pragma unroll
      for (int i = 0; i < 16; ++i) {
        const int kpos = kt * 64 + kb * 32 + (i & 3) + 8 * (i >> 2) + 4 * hh;
        const int d = qlat - kpos;
        if (d > 128 || d < -128) s[kb][i] = -1e30f;
      }
  } else {
    const int rs = min(max(qrow - 4, 0), 56);
    const bool row_ok = (kt >= rs) && (kt < rs + 8);
    const int cst = min(max(qcol - 8, 0), 48);
    const int dr = kt - qrow + 7;
#pragma unroll
    for (int kb = 0; kb < 2; ++kb)
#pragma unroll
      for (int i = 0; i < 16; ++i) {
        const int kc = kb * 32 + (i & 3) + 8 * (i >> 2) + 4 * hh;
        const bool ok = row_ok && (kc >= cst) && (kc < cst + 16);
        const int idx = ok ? (dr * 31 + (kc - qcol + 15)) : 0;
        const float bias = rpb[idx];
        s[kb][i] = ok ? (s[kb][i] + bias) : -1e30f;
      }
  }
}

template <int BR>
DEVI void attn_mask1(f32x16& sb, int kb, int kt, int qlat, int qrow, int qcol, int hh, LAS float* rpb) {
  if (BR == 1) {
#pragma unroll
    for (int i = 0; i < 16; ++i) {
      const int kpos = kt * 64 + kb * 32 + (i & 3) + 8 * (i >> 2) + 4 * hh;
      const int d = qlat - kpos;
      if (d > 128 || d < -128) sb[i] = -1e30f;
    }
  } else {
    const int rs = min(max(qrow - 4, 0), 56);
    const bool row_ok = (kt >= rs) && (kt < rs + 8);
    const int cst = min(max(qcol - 8, 0), 48);
    const int dr = kt - qrow + 7;
#pragma unroll
    for (int i = 0; i < 16; ++i) {
      const int kc = kb * 32 + (i & 3) + 8 * (i >> 2) + 4 * hh;
      const bool ok = row_ok && (kc >= cst) && (kc < cst + 16);
      const int idx = ok ? (dr * 31 + (kc - qcol + 15)) : 0;
      const float bias = rpb[idx];
      sb[i] = ok ? (sb[i] + bias) : -1e30f;
    }
  }
}
#define FADD(a, b) do { (a) += (b); asm("" : "+v"(a)); } while (0)
typedef short v4i16_t __attribute__((ext_vector_type(4)));
DEVI bf16x8 vtr2(ldsp_t a) {
  const v4i16_t lo = __builtin_amdgcn_ds_read_tr16_b64_v4i16((LAS v4i16_t*)a);
  const v4i16_t hi = __builtin_amdgcn_ds_read_tr16_b64_v4i16((LAS v4i16_t*)(a + 8 * 144));
  return __builtin_shufflevector(lo, hi, 0, 1, 2, 3, 4, 5, 6, 7);
}
DEVI bf16x8 vtr2s(ldsp_t a, int o0, int o1) {
  const v4i16_t lo = __builtin_amdgcn_ds_read_tr16_b64_v4i16((LAS v4i16_t*)(a + o0));
  const v4i16_t hi = __builtin_amdgcn_ds_read_tr16_b64_v4i16((LAS v4i16_t*)(a + 8 * 128 + o1));
  return __builtin_shufflevector(lo, hi, 0, 1, 2, 3, 4, 5, 6, 7);
}
template <int BR, bool FAST>
DEVI bool attn_item2(KP p, int l, int b, int hs, int qb, bool isctx, ldsp_t lds) {
  constexpr bool MLA = (BR == 0);
  constexpr bool GQA = (BR == 1 || BR == 3);
  constexpr int QBLK = GQA ? 256 : 512;
  constexpr int NKS = MLA ? 6 : 4;
  constexpr int STG = 8192 + 8192 + 4096;
  const int tid = TIDX, lane = tid & 63, wave = __builtin_amdgcn_readfirstlane(tid >> 6);
  const int r32 = lane & 31, hh = lane >> 5;
  const int hq = GQA ? (hs * 2 + (wave & 1)) : hs;
  const int woff = GQA ? 64 * (wave >> 1) : 64 * wave;
  const int q0 = (isctx ? 0 : NCTX) + qb * QBLK;
  const bool active = !isctx || (woff < NCTX);
  const size_t tokq = (size_t)b * TPB + q0 + (active ? woff : 0) + r32;
  const u16* Qp; const u16* Kp; int ldk; const u16* Vp; int ldv; int obase; int ldq;
  const u16* PR = wsp<u16>(p, OFF_PRAW);
  if (BR == 0) { Qp = wsp<u16>(p, OFF_QARAW) + tokq * 512 + hq * 96; ldq = 512; Kp = wsp<u16>(p, OFF_KVARAW) + (size_t)b * TPB * 512 + hs * 128; ldk = 512; Vp = wsp<u16>(p, OFF_KVARAW) + (size_t)b * TPB * 512 + hs * 128 + 64; ldv = 512; obase = hq * 64; }
  else if (BR == 1) { Qp = PR + tokq * PLD + 512 + hq * 64; ldq = PLD; Kp = PR + (size_t)b * TPB * PLD + 768 + hs * 64; ldk = PLD; Vp = PR + (size_t)b * TPB * PLD + 896 + hs * 64; ldv = PLD; obase = 256 + hq * 64; }
  else if (BR == 2) { Qp = PR + tokq * PLD + 1024 + hq * 64; ldq = PLD; Kp = PR + (size_t)b * TPB * PLD + 1280 + hs * 64; ldk = PLD; Vp = PR + (size_t)b * TPB * PLD + 1536 + hs * 64; ldv = PLD; obase = 512 + hq * 64; }
  else { Qp = PR + tokq * PLD + 1792 + hq * 64; ldq = PLD; Kp = PR + (size_t)b * TPB * PLD + 2048 + hs * 64; ldk = PLD; Vp = PR + (size_t)b * TPB * PLD + 2176 + hs * 64; ldv = PLD; obase = 768 + hq * 64; }
  const u16* KRp = PR + (size_t)b * TPB * PLD + 384;
  int lat_lo = 0, lat_n = 0, wlo = 0, whi = 63;
  if (!isctx) {
    if (BR == 0 || BR == 3) { lat_lo = 0; lat_n = 64; }
    else if (BR == 1) {
      const int ql = qb * QBLK; const int lo = max(0, ql - 128) >> 6, hi = min(SEQ - 1, ql + QBLK - 1 + 128) >> 6; lat_lo = lo; lat_n = hi - lo + 1;
      const int wq = ql + woff; wlo = max(0, wq - 128) >> 6; whi = min(SEQ - 1, wq + 63 + 128) >> 6;
    } else {
      const int r0 = 8 * qb; const int lo = min(max(r0 - 4, 0), 56), hi = min(max(r0 + 7 - 4, 0), 56) + 7; lat_lo = lo; lat_n = hi - lo + 1;
      const int wr_ = r0 + wave; wlo = min(max(wr_ - 4, 0), 56); whi = wlo + 7;
    }
  }
  const int NT = 4 + lat_n;
  const int qlat0 = qb * QBLK + woff + r32;
  bf16x8 qf[2][NKS];
#pragma unroll
  for (int qi = 0; qi < 2; ++qi)
#pragma unroll
    for (int ks = 0; ks < NKS; ++ks) qf[qi][ks] = *(const bf16x8*)(Qp + (size_t)qi * 32 * ldq + ks * 16 + hh * 8);
  const int drow = 8 * wave + (lane >> 3), dch = (lane & 7) ^ ((drow >> 1) & 7);
  const int rrow = 16 * (wave & 3) + (lane >> 2), rch = (lane & 3) ^ ((rrow >> 2) & 3);
  auto keytile = [&](int j) { return (j < 4) ? j : (4 + lat_lo + (j - 4)); };
#define DMA16(sbase, voff, ldsaddr) asm volatile("s_mov_b32 m0, %2\n\ts_nop 0\n\tglobal_load_lds_dwordx4 %0, %1" :: "v"(voff), "s"(sbase), "s"(ldsaddr) : "memory", "m0")
#define A_DMA(j, st) do { const int key0_ = keytile(j) * 64; const unsigned base_ = __builtin_amdgcn_readfirstlane((unsigned)(size_t)(lds + (st) * STG) + wave * 1024); \
    DMA16(Kp, (unsigned)(((key0_ + drow) * ldk + dch * 8) * 2), base_); \
    DMA16(Vp, (unsigned)(((key0_ + drow) * ldv + dch * 8) * 2), base_ + 8192u); \
    if (MLA && wave < 4) DMA16(KRp, (unsigned)(((key0_ + rrow) * PLD + rch * 8) * 2), __builtin_amdgcn_readfirstlane(base_ + 16384u)); \
  } while (0)
  LAS float* rpb = (LAS float*)(lds + 2 * STG);
  __syncthreads();
  if (FAST && tid == 0) *(LAS int*)(lds + 2 * STG + 2048) = 0;
  A_DMA(0, 0);
  if (BR == 2 && !isctx) {
    const float* src = p->rpb_c + (size_t)(l * 4 + hs) * 465;
    for (int i = tid; i < 465; i += 512) rpb[i] = src[i] * LOG2E;
  }
  asm volatile("s_waitcnt vmcnt(0)" ::: "memory");
#pragma unroll
  for (int qi = 0; qi < 2; ++qi)
#pragma unroll
    for (int ks = 0; ks < NKS; ++ks) asm volatile("" : "+v"(qf[qi][ks]));
  __syncthreads();
  f32x16 o[2][2];
#pragma unroll
  for (int qi = 0; qi < 2; ++qi)
#pragma unroll
    for (int i = 0; i < 16; ++i) { o[qi][0][i] = 0.f; o[qi][1][i] = 0.f; }
  float m_run[2], l_run[2];
#pragma unroll
  for (int qi = 0; qi < 2; ++qi) { m_run[qi] = -INFINITY; l_run[qi] = 0.f; }
  if (BR == 1) { const float sk = p->sink_b[l * 4 + hq] * LOG2E; m_run[0] = sk; m_run[1] = sk; l_run[0] = (hh == 0) ? (FAST ? __builtin_amdgcn_exp2f(sk) : 1.f) : 0.f; l_run[1] = l_run[0]; }
  float l2[2][2];
#pragma unroll
  for (int qi = 0; qi < 2; ++qi) { l2[qi][0] = l_run[qi]; l2[qi][1] = 0.f; }
  const int kkey = (r32 >> 1) & 7, rkey = (r32 >> 2) & 3;
  const ldsp_t kfb = lds + r32 * 128;
  const ldsp_t krb = lds + 16384 + r32 * 64;
  const int vq = (lane & 15) >> 2, vkey = 2 * hh + (vq >> 1);
  const int vch = 2 * ((lane >> 4) & 1) + ((lane & 3) >> 1);
  const ldsp_t vfb = lds + 8192 + (4 * hh + vq) * 128 + 8 * (lane & 1);
#define SB() __builtin_amdgcn_sched_barrier(0)
#define KLOAD(kb, ks) (((ks) < 4) ? *(const LAS bf16x8*)(kfb + st + (kb) * 4096 + (((2 * (ks) + hh) ^ kkey) << 4)) : *(const LAS bf16x8*)(krb + st + (kb) * 2048 + (((2 * ((ks) - 4) + hh) ^ rkey) << 4)))
#define VLOAD(s4, db) vtr2s(vfb + st + (s4) * 2048, ((4 * (db) + vch) ^ vkey) << 4, ((4 * (db) + vch) ^ vkey ^ 4) << 4)
#define SM_EL(kb, e) do { const int qi_ = (e) >> 4, i_ = (e) & 15; \
    const float x_ = __builtin_amdgcn_exp2f(s[qi_][kb][i_]); s[qi_][kb][i_] = x_; FADD(l2[qi_][i_ & 1], x_); \
    if (i_ & 1) pw[kb][qi_][i_ >> 3][(i_ & 7) >> 1] = pk2(s[qi_][kb][i_ - 1], x_); } while (0)
#define F_STEP(j) do { \
    const int st = ((j) & 1) * STG; \
    if ((j) + 1 < NT) A_DMA((j) + 1, ((j) + 1) & 1); \
    const int kt_ = lat_lo + (j) - 4; \
    const bool need = active && ((j) < 4 || (kt_ >= wlo && kt_ <= whi)); \
    if (need) { \
      f32x16 s[2][2]; bf16x8 kf[NKS]; bf16x8 vf[4]; u32x4 pw[2][2][2]; \
      const f32x16 zero16 = {0.f, 0.f, 0.f, 0.f, 0.f, 0.f, 0.f, 0.f, 0.f, 0.f, 0.f, 0.f, 0.f, 0.f, 0.f, 0.f}; \
      const bool domask = (BR == 1 || BR == 2) && (j) >= 4; \
      _Pragma("unroll") for (int ks = 0; ks < NKS; ++ks) kf[ks] = KLOAD(0, ks); \
      _Pragma("unroll") for (int ks = 0; ks < NKS; ++ks) { \
        s[0][0] = MFMA(kf[ks], qf[0][ks], ks == 0 ? zero16 : s[0][0]); s[1][0] = MFMA(kf[ks], qf[1][ks], ks == 0 ? zero16 : s[1][0]); \
        SB(); kf[ks] = KLOAD(1, ks); SB(); } \
      if (domask) { _Pragma("unroll") for (int qi = 0; qi < 2; ++qi) { const int ql_ = qlat0 + 32 * qi; attn_mask1<BR>(s[qi][0], 0, kt_, ql_, ql_ >> 6, ql_ & 63, hh, rpb); } } \
      _Pragma("unroll") for (int m = 0; m < 2 * NKS; ++m) { \
        s[m & 1][1] = MFMA(kf[m >> 1], qf[m & 1][m >> 1], (m >> 1) == 0 ? zero16 : s[m & 1][1]); \
        if (m < 4) vf[m] = VLOAD(m >> 1, m & 1); \
        _Pragma("unroll") for (int e = (m * 32) / (2 * NKS); e < ((m + 1) * 32) / (2 * NKS); ++e) SM_EL(0, e); \
        SB(); } \
      if (domask) { _Pragma("unroll") for (int qi = 0; qi < 2; ++qi) { const int ql_ = qlat0 + 32 * qi; attn_mask1<BR>(s[qi][1], 1, kt_, ql_, ql_ >> 6, ql_ & 63, hh, rpb); } } \
      _Pragma("unroll") for (int m = 0; m < 8; ++m) { \
        o[m & 1][(m >> 1) & 1] = MFMA(vf[m >> 1], __builtin_bit_cast(bf16x8, pw[0][m & 1][m >> 2]), o[m & 1][(m >> 1) & 1]); \
        if (m & 1) { SB(); vf[m >> 1] = VLOAD(2 + (m >> 2), (m >> 1) & 1); } \
        _Pragma("unroll") for (int e = 4 * m; e < 4 * m + 4; ++e) SM_EL(1, e); \
        SB(); } \
      _Pragma("unroll") for (int m = 0; m < 8; ++m) \
        o[m & 1][(m >> 1) & 1] = MFMA(vf[m >> 1], __builtin_bit_cast(bf16x8, pw[1][m & 1][m >> 2]), o[m & 1][(m >> 1) & 1]); \
    } \
    asm volatile("s_waitcnt vmcnt(0)" ::: "memory"); \
    __syncthreads(); \
  } while (0)
#define A_STEP(j) do { \
    const int st = ((j) & 1) * STG; \
    if ((j) + 1 < NT) A_DMA((j) + 1, ((j) + 1) & 1); \
    const int kt_ = lat_lo + (j) - 4; \
    const bool need = active && ((j) < 4 || (kt_ >= wlo && kt_ <= whi)); \
    if (need) { \
      f32x16 s[2][2]; \
      _Pragma("unroll") for (int kb = 0; kb < 2; ++kb) { \
        _Pragma("unroll") for (int ks = 0; ks < 4; ++ks) { const bf16x8 kf = *(const LAS bf16x8*)(kfb + st + kb * 4096 + (((2 * ks + hh) ^ kkey) << 4)); \
          _Pragma("unroll") for (int qi = 0; qi < 2; ++qi) { if (ks == 0) { _Pragma("unroll") for (int i = 0; i < 16; ++i) s[qi][kb][i] = 0.f; } s[qi][kb] = MFMA(kf, qf[qi][ks], s[qi][kb]); } } \
        if (MLA) { _Pragma("unroll") for (int ks = 0; ks < 2; ++ks) { const bf16x8 kf = *(const LAS bf16x8*)(krb + st + kb * 2048 + (((2 * ks + hh) ^ rkey) << 4)); \
          _Pragma("unroll") for (int qi = 0; qi < 2; ++qi) s[qi][kb] = MFMA(kf, qf[qi][NKS - 2 + ks], s[qi][kb]); } } \
      } \
      if (FAST) __builtin_amdgcn_sched_barrier(0); \
      _Pragma("unroll") for (int qi = 0; qi < 2; ++qi) { \
        if ((BR == 1 || BR == 2) && (j) >= 4) { const int ql_ = qlat0 + 32 * qi; attn_mask<BR>(s[qi], kt_, ql_, ql_ >> 6, ql_ & 63, hh, rpb); } \
        if (FAST) { \
          float ls0 = 0.f, ls1 = 0.f; \
          _Pragma("unroll") for (int i = 0; i < 16; ++i) { \
            const float e0 = __builtin_amdgcn_exp2f(s[qi][0][i]), e1 = __builtin_amdgcn_exp2f(s[qi][1][i]); \
            s[qi][0][i] = e0; s[qi][1][i] = e1; FADD(ls0, e0); FADD(ls1, e1); } \
          l_run[qi] += ls0 + ls1; \
        } else { \
        float mx = s[qi][0][0]; \
        _Pragma("unroll") for (int i = 1; i < 16; ++i) mx = fmaxf(mx, s[qi][0][i]); \
        _Pragma("unroll") for (int i = 0; i < 16; ++i) mx = fmaxf(mx, s[qi][1][i]); \
        mx = fmaxf(mx, __shfl_xor(mx, 32)); \
        const float m_new = fmaxf(m_run[qi], mx); \
        const float alpha = __builtin_amdgcn_exp2f(m_run[qi] - m_new); \
        m_run[qi] = m_new; \
        float ls0 = 0.f, ls1 = 0.f; \
        _Pragma("unroll") for (int i = 0; i < 16; ++i) { \
          const float e0 = __builtin_amdgcn_exp2f(s[qi][0][i] - m_new), e1 = __builtin_amdgcn_exp2f(s[qi][1][i] - m_new); \
          s[qi][0][i] = e0; s[qi][1][i] = e1; ls0 += e0; ls1 += e1; } \
        l_run[qi] = l_run[qi] * alpha + (ls0 + ls1); \
        if (__any(alpha != 1.f)) { _Pragma("unroll") for (int i = 0; i < 16; ++i) { o[qi][0][i] *= alpha; o[qi][1][i] *= alpha; } } \
        } \
      } \
      _Pragma("unroll") for (int s4 = 0; s4 < 4; ++s4) { \
        const int kb = s4 >> 1, rb = (s4 & 1) * 8; \
        bf16x8 pf[2]; \
        _Pragma("unroll") for (int qi = 0; qi < 2; ++qi) { u32x4 pw; \
          pw.x = pk2(s[qi][kb][rb + 0], s[qi][kb][rb + 1]); pw.y = pk2(s[qi][kb][rb + 2], s[qi][kb][rb + 3]); \
          pw.z = pk2(s[qi][kb][rb + 4], s[qi][kb][rb + 5]); pw.w = pk2(s[qi][kb][rb + 6], s[qi][kb][rb + 7]); \
          pf[qi] = __builtin_bit_cast(bf16x8, pw); } \
        _Pragma("unroll") for (int db = 0; db < 2; ++db) { const bf16x8 vf = vtr2s(vfb + st + s4 * 2048, ((4 * db + vch) ^ vkey) << 4, ((4 * db + vch) ^ vkey ^ 4) << 4); \
          o[0][db] = MFMA(vf, pf[0], o[0][db]); o[1][db] = MFMA(vf, pf[1], o[1][db]); } \
      } \
    } \
    asm volatile("s_waitcnt vmcnt(0)" ::: "memory");        \
    __syncthreads(); \
  } while (0)
  if (FAST) {
    if (wave >= 4) __builtin_amdgcn_s_setprio(1);
    for (int j = 0; j < NT; j += 2) {
      F_STEP(j);
      if (j + 1 < NT) F_STEP(j + 1);
    }
    __builtin_amdgcn_s_setprio(0);
  } else {
    for (int j = 0; j < NT; j += 2) {
      A_STEP(j);
      if (j + 1 < NT) A_STEP(j + 1);
    }
  }
#undef F_STEP
#undef SM_EL
#undef A_STEP
#undef A_DMA
#undef DMA16
  bool bad = false;
  if (active) {
#pragma unroll
    for (int qi = 0; qi < 2; ++qi) {
      if (FAST) l_run[qi] = l2[qi][0] + l2[qi][1];
      const float lt = l_run[qi] + __shfl_xor(l_run[qi], 32);
      const float inv = 1.f / lt;
      if (FAST) bad = bad || !(lt > 1e-25f && lt < 1e25f);
      unsigned char* Op = wsp<unsigned char>(p, OFF_O) + (tokq + 32 * qi) * 1024 + obase;
#pragma unroll
      for (int db = 0; db < 2; ++db)
#pragma unroll
        for (int gp = 0; gp < 2; ++gp) {
          float q[8];
#pragma unroll
          for (int j = 0; j < 8; ++j) q[j] = __builtin_amdgcn_fmed3f(o[qi][db][8 * gp + j] * (inv * O8_SCALE), -448.f, 448.f);
          int wa = __builtin_amdgcn_cvt_pk_fp8_f32(q[0], q[1], 0, false); wa = __builtin_amdgcn_cvt_pk_fp8_f32(q[2], q[3], wa, true);
          int wb = __builtin_amdgcn_cvt_pk_fp8_f32(q[4], q[5], 0, false); wb = __builtin_amdgcn_cvt_pk_fp8_f32(q[6], q[7], wb, true);
          const u32x2 sx = __builtin_amdgcn_permlane32_swap((unsigned)wa, (unsigned)wb, false, false);
          *(u32x2*)(Op + db * 32 + 16 * gp + 8 * hh) = sx;
        }
    }
  }
  if (!FAST) return false;
  LAS int* flag = (LAS int*)(lds + 2 * STG + 2048);
  if (__any(bad) && lane == 0) *flag = 1;
  __syncthreads();
  return __builtin_amdgcn_readfirstlane(*flag) != 0;
}
template <bool FAST>
DEVI bool attn_dispatch(KP p, int l, int n, int xcd, ldsp_t lds) {
  int br, s, qb; bool isctx = false;
  if (n < 32) { br = 0; s = xcd + 8 * (n >> 3); qb = n & 7; }
  else if (n < 64) { const int m = n - 32; br = 3; s = xcd + 8 * (m >> 4); qb = m & 15; }
  else if (n < 96) { const int m = n - 64; br = 2; s = xcd + 8 * (m >> 3); qb = m & 7; }
  else if (n < 128) { const int m = n - 96; br = 1; s = xcd + 8 * (m >> 4); qb = m & 15; }
  else {
    const int m = n - 128; isctx = true; qb = 0;
    if (m < 4) { br = 0; s = xcd + 8 * m; }
    else if (m < 6) { br = 3; s = xcd + 8 * (m - 4); }
    else if (m < 10) { br = 2; s = xcd + 8 * (m - 6); }
    else { br = 1; s = xcd + 8 * (m - 10); }
  }
  if (br == 0) return attn_item2<0, FAST>(p, l, s >> 2, s & 3, qb, isctx, lds);
  else if (br == 1) return attn_item2<1, FAST>(p, l, s >> 1, s & 1, qb, isctx, lds);
  else if (br == 2) return attn_item2<2, FAST>(p, l, s >> 2, s & 3, qb, isctx, lds);
  else return attn_item2<3, FAST>(p, l, s >> 1, s & 1, qb, isctx, lds);
}
DEVI void phaseD2(KP p, int l, ldsp_t lds) {
  const int G8 = gridDim.x >> 3, xcd = BIDX & 7, lb = BIDX >> 3;
  if (lb >= G8) return;
  const int NLOC = 128 + (l == 0 ? 12 : 0);
  const int nmine = (NLOC - lb + G8 - 1) / G8;
  const int cslot = min((int)(BIDX & 3), nmine - 1);
  int it = 0; unsigned redo = 0;
  for (int n = lb; n < NLOC; n += G8, ++it) {
    if (it == cslot) conv_items2(p, l, lds, CONV_EARLY, CONV_ITEMS);
    if (attn_dispatch<true>(p, l, n, xcd, lds)) redo |= 1u << it;
  }
  if (redo) {
    it = 0;
    for (int n = lb; n < NLOC; n += G8, ++it)
      if ((redo >> it) & 1) attn_dispatch<false>(p, l, n, xcd, lds);
  }
}

DEVI int pm_map(int pme, bool skipctx) { return skipctx ? (pme >> 4) * 17 + 1 + (pme & 15) : pme; }
struct SchedE1 { const char* ws; bool skipctx; int G, c;
  DEVI bool next(int i, Unit& u) const { int pm, pn; if (!tile_order(i, G, c, skipctx ? 128 : 136, 16, pm, pn)) return false;
    pm = pm_map(pm, skipctx); const int n = pn >> 2, cq = pn & 3;
    u.A = ws + OFF_O + uoff((unsigned)pm * 256u * 1024u + (unsigned)n * 256u); u.B = ws + OFF_WBR + uoff(((unsigned)n * 1024u + (unsigned)cq * 256u) * 256u); u.rows = nullptr; u.nvalid = 0;
    u.u0 = pm * 256; u.u1 = pn * 256; u.u2 = 0; u.u3 = 0; return true; } };
DEVI void phaseE1(KP p, int l, ldsp_t lds) {
  if (BIDX == 0 && TIDX < 32) wsp<int>(p, OFF_CNT)[TIDX * CNT_STRIDE] = 0;
  SchedE1 S{(const char*)p->ws, l == 1, (int)gridDim.x, BIDX};
  EpiZ8 E{wsp<unsigned char>(p, OFF_Z)};
  gemm_phase<true, false, true>(lds, 1024, 256, 2, S, E);
}
struct SchedE2 { const char* ws; const char* h8; bool skipctx; int G, c;
  DEVI bool next(int i, Unit& u) const { int pm, pn; if (!tile_order(i >> 1, G, c, skipctx ? 128 : 136, 8, pm, pn)) return false;
    pm = pm_map(pm, skipctx); const int pr = i & 1;
    u.A = h8 + uoff((unsigned)pm * 256u * 1024u); u.B = ws + OFF_WGATE + uoff((unsigned)(pr * 8 + pn) * 256u * 1024u); u.rows = nullptr; u.nvalid = 0;
    u.u0 = pm * 256; u.u1 = pn * 128; u.u2 = pr; u.u3 = 0; return true; } };
constexpr float Y8_SCALE = 16.f;
static_assert(Y8_SCALE == Z8_SCALE, "the E2 epilogue keeps its sums in Z8 units");
struct EpiE2 { const unsigned char* Z; u32x4 (&part)[8]; unsigned char* Y8; const float* bias;
  DEVI void init(f32x4 (&acc)[2][2][4][2], const Unit& u, int wr, int wc, int fr, int fq) const {
    const int col0 = u.u1 + wc * 32 + 8 * fq;
#pragma unroll
    for (int bj = 0; bj < 2; ++bj)
#pragma unroll
      for (int nn = 0; nn < 2; ++nn) {
        const f32x4 b = *(const f32x4*)(bias + (2 * u.u2 + bj) * 1024 + col0 + 4 * nn) * -LOG2E;
#pragma unroll
        for (int a = 0; a < 2; ++a)
#pragma unroll
          for (int m = 0; m < 4; ++m) acc[a][bj][m][nn] = b;
      }
  }
  DEVI void operator()(const f32x4 (&acc)[2][2][4][2], const Unit& u, int wr, int wc, int fr, int fq) const {
    const int row0 = u.u0 + wr * 64 + fr, col0 = u.u1 + wc * 32 + 8 * fq, pr = u.u2;
    const unsigned lw16 = (unsigned)((wr * 4 + wc) * 64 + fr + 16 * fq) * 16u;
    const unsigned char* zb0 = Z + z8_block(u.u0 >> 8, 2 * pr, u.u1 >> 7) + lw16;
    u32x4 zq[4][2], yq[4][2];
    auto ldpair = [&](int P, u32x4 (&z)[2], u32x4 (&y)[2]) {
#pragma unroll
      for (int bj = 0; bj < 2; ++bj) z[bj] = *(const u32x4*)(zb0 + (size_t)bj * 8 * 32768 + P * 8192);
#pragma unroll
      for (int h = 0; h < 2; ++h) y[h] = pr ? part[2 * P + h] : u32x4{0u, 0u, 0u, 0u};
    };
#pragma unroll
    for (int P = 0; P < 4; ++P) ldpair(P, zq[P], yq[P]);
#pragma unroll
    for (int P = 0; P < 4; ++P) {
      const int c = P;
#pragma unroll
      for (int h = 0; h < 2; ++h) {
        const int g = 2 * P + h, ai = g >> 2, m = g & 3;
        const size_t r = (size_t)(row0 + ai * HALF + m * 16);
        float t[8];
        {
          const unsigned w[4] = {yq[c][h].x, yq[c][h].y, yq[c][h].z, yq[c][h].w};
#pragma unroll
          for (int i = 0; i < 4; ++i) { t[2 * i] = __uint_as_float(w[i] << 16); t[2 * i + 1] = __uint_as_float(w[i] & 0xffff0000u); }
        }
#pragma unroll
        for (int bj = 0; bj < 2; ++bj) {
#pragma unroll
          for (int nn = 0; nn < 2; ++nn) {
            const int zw = (int)zq[c][bj][2 * h + nn];
            const f32x2 zlo = __builtin_amdgcn_cvt_pk_f32_fp8(zw, false), zhi = __builtin_amdgcn_cvt_pk_f32_fp8(zw, true);
            const float zz4[4] = {zlo.x, zlo.y, zhi.x, zhi.y};
#pragma unroll
            for (int j = 0; j < 4; ++j) {
              const int e = 4 * nn + j;
              const float gte = __builtin_amdgcn_rcpf(1.f + __builtin_amdgcn_exp2f(acc[ai][bj][m][nn][j]));
              t[e] += gte * zz4[j];
            }
          }
        }
        if (pr == 0) {
          u32x4 o; o.x = pk2(t[0], t[1]); o.y = pk2(t[2], t[3]); o.z = pk2(t[4], t[5]); o.w = pk2(t[6], t[7]);
          part[g] = o;
        } else {
          u32x2 o8;
#pragma unroll
          for (int w = 0; w < 2; ++w) {
            float q[4];
#pragma unroll
            for (int j = 0; j < 4; ++j) q[j] = __builtin_amdgcn_fmed3f(t[4 * w + j], -448.f, 448.f);
            int v = __builtin_amdgcn_cvt_pk_fp8_f32(q[0], q[1], 0, false);
            v = __builtin_amdgcn_cvt_pk_fp8_f32(q[2], q[3], v, true);
            o8[w] = (unsigned)v;
          }
          *(u32x2*)(Y8 + r * 1024 + col0) = o8;
        }
      }
    }
  }
};
DEVI void phaseE2(KP p, int l, ldsp_t lds) {
  SchedE2 S{(const char*)p->ws, (const char*)h8base(p), l == 1, (int)gridDim.x, BIDX};
  u32x4 part[8];
#pragma unroll
  for (int i = 0; i < 8; ++i) part[i] = u32x4{0u, 0u, 0u, 0u};
  EpiE2 E{wsp<unsigned char>(p, OFF_Z), part, wsp<unsigned char>(p, OFF_Y8), p->b_gate + (size_t)l * 4 * 1024};
  gemm_phase<true, false, true>(lds, 1024, 1024, 8, S, E);
}
struct SchedF { const char* ws; bool skipctx; int G, c;
  DEVI bool next(int i, Unit& u) const { int pm, pn;
    if (skipctx || G != 256) { if (!tile_order(i, G, c, skipctx ? 128 : 136, 4, pm, pn)) return false; }
    else if (i < 2) { if (!tile_order(i, G, c, 128, 4, pm, pn)) return false; }
    else { if (i > 2 || c >= 32) return false; pm = 128 + (c >> 2); pn = c & 3; }
    pm = pm_map(pm, skipctx);
    u.A = ws + OFF_Y8 + uoff((unsigned)pm * 256u * 1024u); u.B = ws + OFF_WOUT + uoff((unsigned)pn * 256u * 1024u); u.rows = nullptr; u.nvalid = 0;
    u.u0 = pm; u.u1 = pn * 256; u.u2 = 0; u.u3 = 0; return true; } };
struct EpiF { KP p; int l;
  DEVI void init(f32x4 (&acc)[2][2][4][2], const Unit&, int, int, int, int) const { acc_zero(acc); }
  DEVI void operator()(const f32x4 (&acc)[2][2][4][2], const Unit& u, int wr, int wc, int fr, int fq) const {
    const int pm = u.u0, b = pm / 17, rr0 = (pm % 17) * 256;
    const int mrow = (rr0 < NCTX) ? 8 : b;
    const int col0 = u.u1 + wc * 32 + 8 * fq;
    const float* gt = wsp<float>(p, OFF_MOD) + ((size_t)l * 9 + mrow) * 6144 + 2048 + col0;
    const u16* xinb = (const u16*)p->out + (size_t)(b * TPB + rr0) * 1024 + col0;
    const __amdgpu_buffer_rsrc_t xrs = __builtin_amdgcn_make_buffer_rsrc((void*)wsp<u16>(p, OFF_XM), 0, NTOK * 1024 * 2, 0x00020000);
    const unsigned xoff = (unsigned)((b * TPB + rr0) * 1024 + col0) * 2u;
    f32x4 gv[2][2];
#pragma unroll
    for (int bj = 0; bj < 2; ++bj)
#pragma unroll
      for (int n = 0; n < 2; ++n) gv[bj][n] = *(const f32x4*)(gt + bj * HALF + n * 4) * (1.f / Y8_SCALE);
#pragma unroll
    for (int ai = 0; ai < 2; ++ai) {
      u32x4 xo[4][2];
#pragma unroll
      for (int m = 0; m < 4; ++m) {
        const size_t ro = (size_t)(wr * 64 + fr + ai * HALF + m * 16) * 1024;
#pragma unroll
        for (int bj = 0; bj < 2; ++bj) xo[m][bj] = *(const u32x4*)(xinb + ro + bj * HALF);
      }
#pragma unroll
      for (int mp = 0; mp < 2; ++mp) {
#pragma unroll
        for (int mm = 0; mm < 2; ++mm) {
          const int m = 2 * mp + mm;
          const size_t ro = (size_t)(wr * 64 + fr + ai * HALF + m * 16) * 1024;
#pragma unroll
          for (int bj = 0; bj < 2; ++bj) {
            const u32x4 v = xo[m][bj];
            const f32x4 x0 = f32x4{__uint_as_float(v.x << 16), __uint_as_float(v.x & 0xffff0000u), __uint_as_float(v.y << 16), __uint_as_float(v.y & 0xffff0000u)};
            const f32x4 x1 = f32x4{__uint_as_float(v.z << 16), __uint_as_float(v.z & 0xffff0000u), __uint_as_float(v.w << 16), __uint_as_float(v.w & 0xffff0000u)};
            const f32x4 r0 = x0 + gv[bj][0] * acc[ai][bj][m][0], r1 = x1 + gv[bj][1] * acc[ai][bj][m][1];
            __builtin_amdgcn_raw_buffer_store_b128(u32x4{pk2(r0.x, r0.y), pk2(r0.z, r0.w), pk2(r1.x, r1.y), pk2(r1.z, r1.w)}, xrs,
                                                   (int)(xoff + (unsigned)(ro + bj * HALF) * 2u), 0, 16);
          }
        }
      }
    }
    asm volatile("s_waitcnt vmcnt(0)" ::: "memory");
    if ((TIDX & 63) == 0) __hip_atomic_fetch_add(wsp<int>(p, OFF_DEP) + (l * 136 + pm) * DEP_STRIDE, 1, __ATOMIC_RELAXED, __HIP_MEMORY_SCOPE_AGENT);
  }
};
DEVI void phaseF2(KP p, int l, ldsp_t lds) {
  SchedF S{(const char*)p->ws, l == 1, (int)gridDim.x, BIDX};
  EpiF E{p, l};
  gemm_phase<true, false, true>(lds, 1024, 1024, 8, S, E);
}


DEVI void phase0_2(KP p, ldsp_t lds) {
  const int tid = TIDX, half = tid >> 8, htid = tid & 255;
  for (int it = BIDX * 2; it < 458; it += gridDim.x * 2) {
    const int item = it + half;
    LAS float* sc = (LAS float*)(lds + half * 16384);
    const bool ismod = item < 384;
    const int l = item / 192, rem = item % 192, cgp = rem >> 3, kc = rem & 7;
    __syncthreads();
    if (ismod) {
      for (int i = htid; i < 9 * 128; i += 256) {
        int b = i >> 7, k = i & 127;
        float v = (b < 8) ? p->c[b * 1024 + kc * 128 + k] : p->c_ctx[kc * 128 + k];
        sc[i] = v / (1.f + __expf(-v));
      }
    }
    __syncthreads();
    if (ismod) {
      float acc[9];
#pragma unroll
      for (int b = 0; b < 9; ++b) acc[b] = 0.f;
      const float* w = p->w_mod + ((size_t)l * 1024 + kc * 128) * 6144 + cgp * 256 + htid;
#pragma unroll 32
      for (int k = 0; k < 128; ++k) {
        float wv = w[(size_t)k * 6144];
#pragma unroll
        for (int b = 0; b < 9; ++b) acc[b] += sc[b * 128 + k] * wv;
      }
      float* dst = wsp<float>(p, OFF_MODP) + (size_t)((kc * 2 + l) * 9) * 6144 + cgp * 256 + htid;
#pragma unroll
      for (int b = 0; b < 9; ++b) dst[(size_t)b * 6144] = acc[b];
    } else if (item == 384) {
      float* cs32 = wsp<float>(p, OFF_CS32);
      float* cs16 = wsp<float>(p, OFF_CS16);
      for (int t = htid; t < 1024; t += 256) {
        int pos = t >> 4, i = t & 15;
        float ang = (float)pos * __builtin_amdgcn_exp2f(-(float)(2 * i) * (13.287712379549449f / 32.f));
        cs32[t * 2] = __cosf(ang); cs32[t * 2 + 1] = __sinf(ang);
      }
      for (int t = htid; t < 512; t += 256) {
        int pos = t >> 3, i = t & 7;
        float ang = (float)pos * __builtin_amdgcn_exp2f(-(float)(2 * i) * (13.287712379549449f / 16.f));
        cs16[t * 2] = __cosf(ang); cs16[t * 2 + 1] = __sinf(ang);
      }
    } else if (item < 457) {
      const int q = item - 385, ll = q / 36, o = q % 36;
      float* dst = wsp<float>(p, OFF_WRT) + ((size_t)ll * 36 + o) * 1024;
      for (int k = htid; k < 1024; k += 256)
        dst[k] = (o < 4) ? p->w_group[((size_t)ll * 1024 + k) * 4 + o] : p->w_router[((size_t)ll * 1024 + k) * 32 + (o - 4)];
    }
  }
}
DEVI void phase1_2(KP p) {
  const float* mp = wsp<float>(p, OFF_MODP);
  float* mo = wsp<float>(p, OFF_MOD);
  for (int i = BIDX * 512 + TIDX; i < 2 * 9 * 6144; i += gridDim.x * 512) {
    int l = i / (9 * 6144), o = i % 6144;
    float s = p->b_mod[l * 6144 + o];
#pragma unroll
    for (int kc = 0; kc < 8; ++kc) s += mp[(size_t)kc * 2 * 9 * 6144 + i];
    mo[i] = s;
  }
}
DEVI void phaseA2(KP p) {
  const int gw = BIDX * NW + (TIDX >> 6), nw = gridDim.x * NW;
  u16* H = wsp<u16>(p, OFF_H);
  const int per = (NTOK + nw - 1) / nw;
  const int t0 = gw * per, t1 = min(t0 + per, NTOK);
  int cur = -1; ModVec mv;
  for (int tok0 = t0; tok0 < t1; tok0 += 2) {
    float xv[2][16];
#pragma unroll
    for (int r = 0; r < 2; ++r) { const int tok = tok0 + r; if (tok < t1) load_row16(xrow_in(p, 0, tok / TPB, tok % TPB), xv[r]); }
#pragma unroll
    for (int r = 0; r < 2; ++r) {
      const int tok = tok0 + r;
      if (tok < t1) {
        const int mrow = (tok % TPB) < NCTX ? 8 : tok / TPB;
        if (mrow != cur) { load_modvec(p, 0, 0, mrow, mv); cur = mrow; }
        float hv[16]; modulate_row_store2<true, false>(mv, xv[r], nullptr, hv, h8base(p) + (size_t)tok * 1024);
        u16* xb = (u16*)p->out + (size_t)tok * 1024 + (TIDX & 63) * 4;
#pragma unroll
        for (int i = 0; i < 4; ++i) *(u32x2*)(xb + i * 256) = u32x2{pk2(xv[r][i * 4], xv[r][i * 4 + 1]), pk2(xv[r][i * 4 + 2], xv[r][i * 4 + 3])}; }
    }
  }
}
DEVI void phaseG2(KP p, int l, ldsp_t lds) {
  constexpr int RP = 2064;
  constexpr int GX = 2 * 32 * RP;
  const int tid = TIDX, lane = tid & 63, wave = __builtin_amdgcn_readfirstlane(tid >> 6);
  const int r32 = lane & 31, kh = lane >> 5, qd = lane >> 4;
  u16* H = wsp<u16>(p, OFF_H2);
  const float* WRT = wsp<float>(p, OFF_WRT) + (size_t)l * 36 * 1024;
  int* cnt = wsp<int>(p, OFF_CNT);
  int* list = wsp<int>(p, OFF_LIST);
  float* wlist = wsp<float>(p, OFF_WLIST);
  const ldsp_t hiP = lds, loP = lds + 32 * RP;
  LAS float* part = (LAS float*)lds;
  LAS int* gsel = (LAS int*)(lds + GX);
  LAS float* gwt = (LAS float*)(lds + GX + 128);
  LAS int* lcnt = (LAS int*)(lds + GX + 256);
  LAS int* gbase = lcnt + 32;
  LAS int* tinfo = lcnt + 64;
  if (tid < 32) lcnt[tid] = 0;
  int nloc = 0;
  bf16x8 whi[8], wlo[8];
  {
    const float* wr = p->w_router + (size_t)l * 1024 * 32 + r32;
#pragma unroll
    for (int s8 = 0; s8 < 8; ++s8) {
      u32x4 h, lo4;
#pragma unroll
      for (int jj = 0; jj < 4; ++jj) {
        const int k = 128 * wave + 16 * s8 + 8 * kh + 2 * jj;
        const float a = wr[(size_t)k * 32], b2 = wr[(size_t)(k + 1) * 32];
        const unsigned hp = pk2(a, b2);
        h[jj] = hp; lo4[jj] = pk2(a - __uint_as_float(hp << 16), b2 - __uint_as_float(hp & 0xffff0000u));
      }
      whi[s8] = __builtin_bit_cast(bf16x8, h); wlo[s8] = __builtin_bit_cast(bf16x8, lo4);
    }
  }
  int* tctr = wsp<int>(p, OFF_DEP) + DEP_TILECTR + l * DEP_STRIDE;
  LAS int* tnext = lcnt + 64 + 512 * 6;
  const int ntile = (l == 1) ? 8 * SEQ / 32 : NTOK / 32;
  if (tid == 0) *tnext = atomicAdd(tctr, 1);
  __syncthreads();
  for (;;) {
    const int tix = *tnext;
    if (tix >= ntile) break;
    int tclaim = 0;
    if (tid == 0) tclaim = atomicAdd(tctr, 1);
    const int tile = (l == 1) ? (tix >> 7) * 136 + 8 + (tix & 127) : tix;
    const int tok0 = tile * 32, b = tok0 / TPB, rr0 = tok0 % TPB;
    if (wave == 0) {
      const int* dep = wsp<int>(p, OFF_DEP) + (l * 136 + (tok0 >> 8)) * DEP_STRIDE;
      while (__hip_atomic_load(dep, __ATOMIC_RELAXED, __HIP_MEMORY_SCOPE_AGENT) < 32) __builtin_amdgcn_s_sleep(2);
      __builtin_amdgcn_fence(__ATOMIC_ACQUIRE, "agent");
      asm volatile("s_waitcnt vmcnt(0)" ::: "memory");
    }
    __syncthreads();
    {
      float hv[4][16], xv4[4][16];
#pragma unroll
      for (int r = 0; r < 4; ++r) load_row16_bf(wsp<u16>(p, OFF_XM) + (size_t)(tok0 + wave * 4 + r) * 1024, xv4[r]);
      ModVec mv; load_modvec(p, l, 1, (rr0 < NCTX) ? 8 : b, mv);
#pragma unroll
      for (int r = 0; r < 4; ++r) {
        modulate_row_store2<true, false>(mv, xv4[r], nullptr, hv[r], (unsigned char*)H + (size_t)(tok0 + wave * 4 + r) * 1024);
        const int ro = (wave * 4 + r) * RP + lane * 8;
#pragma unroll
        for (int i = 0; i < 4; ++i) {
          const unsigned h01 = pk2(hv[r][i * 4], hv[r][i * 4 + 1]), h23 = pk2(hv[r][i * 4 + 2], hv[r][i * 4 + 3]);
          const unsigned l01 = pk2(hv[r][i * 4] - __uint_as_float(h01 << 16), hv[r][i * 4 + 1] - __uint_as_float(h01 & 0xffff0000u));
          const unsigned l23 = pk2(hv[r][i * 4 + 2] - __uint_as_float(h23 << 16), hv[r][i * 4 + 3] - __uint_as_float(h23 & 0xffff0000u));
          *(LAS u32x2*)(hiP + ro + i * 512) = u32x2{h01, h23};
          *(LAS u32x2*)(loP + ro + i * 512) = u32x2{l01, l23};
        }
      }
      float gl[4];
#pragma unroll
      for (int o = 0; o < 4; ++o) gl[o] = router_dot(hv, WRT + (size_t)o * 1024) + p->b_group[l * 4 + o];
      int gs = 0; float best = gl[0];
#pragma unroll
      for (int j = 1; j < 4; ++j) if (gl[j] > best) { best = gl[j]; gs = j; }
      float gsum = 0.f;
#pragma unroll
      for (int j = 0; j < 4; ++j) gsum += __expf(gl[j] - best);
      if ((lane & 15) == 0) { gsel[wave * 4 + qd] = gs; gwt[wave * 4 + qd] = 1.f / gsum; }
    }
    __syncthreads();
    f32x16 acc;
#pragma unroll
    for (int i = 0; i < 16; ++i) acc[i] = 0.f;
    {
      const int ao = r32 * RP + (128 * wave + 8 * kh) * 2;
#pragma unroll
      for (int s8 = 0; s8 < 8; ++s8) {
        const bf16x8 ah = *(const LAS bf16x8*)(hiP + ao + s8 * 32), al = *(const LAS bf16x8*)(loP + ao + s8 * 32);
        acc = MFMA(ah, whi[s8], acc);
        acc = MFMA(ah, wlo[s8], acc);
        acc = MFMA(al, whi[s8], acc);
      }
    }
    __syncthreads();
#pragma unroll
    for (int i = 0; i < 16; ++i) part[(wave * 32 + (i & 3) + 8 * (i >> 2) + 4 * kh) * 33 + r32] = acc[i];
    __syncthreads();
    if (tid < 32) {
      const int gs = gsel[tid];
      const float gw_ = gwt[tid];
      float e8[8];
#pragma unroll
      for (int j = 0; j < 8; ++j) {
        float v = p->b_router[l * 32 + gs * 8 + j];
#pragma unroll
        for (int w = 0; w < 8; ++w) v += part[(w * 32 + tid) * 33 + gs * 8 + j];
        e8[j] = v;
      }
      int i0 = 0; float v0 = e8[0];
#pragma unroll
      for (int j = 1; j < 8; ++j) if (e8[j] > v0) { v0 = e8[j]; i0 = j; }
      int i1 = -1; float v1 = -INFINITY;
#pragma unroll
      for (int j = 0; j < 8; ++j) if (j != i0 && e8[j] > v1) { v1 = e8[j]; i1 = j; }
      const float ex = __expf(v1 - v0);
      const float w0 = gw_ / (1.f + ex), w1 = gw_ * ex / (1.f + ex);
      const int tok = tok0 + tid;
      const int ea = gs * 8 + i0, eb = gs * 8 + i1;
      const int ra = __hip_atomic_fetch_add(&lcnt[ea], 1, __ATOMIC_RELAXED, __HIP_MEMORY_SCOPE_WORKGROUP);
      const int rb = __hip_atomic_fetch_add(&lcnt[eb], 1, __ATOMIC_RELAXED, __HIP_MEMORY_SCOPE_WORKGROUP);
      LAS int* ti = tinfo + (nloc + tid) * 6;
      ti[0] = tok; ti[1] = ea | (eb << 8); ti[2] = ra; ti[3] = rb; ti[4] = __float_as_int(w0); ti[5] = __float_as_int(w1);
    }
    if (tid == 0) *tnext = tclaim;
    nloc += 32;
    __syncthreads();
    const bool last = *tnext >= ntile;
    if (last || nloc == 512) {
      if (tid < 32) { const int c = lcnt[tid]; gbase[tid] = c ? atomicAdd(&cnt[tid * CNT_STRIDE], c) : 0; }
      __syncthreads();
      for (int i = tid; i < nloc; i += 512) {
        const LAS int* ti = tinfo + i * 6;
        const int tok = ti[0], ea = ti[1] & 255, eb = ti[1] >> 8;
        const int sa = gbase[ea] + ti[2], sb = gbase[eb] + ti[3];
        list[(size_t)ea * NTOK + sa] = tok * 2; wlist[(size_t)ea * NTOK + sa] = __int_as_float(ti[4]);
        list[(size_t)eb * NTOK + sb] = tok * 2 + 1; wlist[(size_t)eb * NTOK + sb] = __int_as_float(ti[5]);
      }
      __syncthreads();
      if (tid < 32) lcnt[tid] = 0;
      nloc = 0;
      __syncthreads();
    }
  }
}
struct ExpInfo2 { int tiles[4], base[4], cnt[4]; };
DEVI ExpInfo2 exp_info2(KP p, int xcd) {
  const int* cnt = wsp<int>(p, OFF_CNT);
  ExpInfo2 ei;
  int before = 0;
#pragma unroll
  for (int e = 0; e < 32; ++e) {
    const int c = __builtin_amdgcn_readfirstlane(cnt[e * CNT_STRIDE]), t = (c + 255) >> 8;
    if ((e & 7) == xcd) { ei.tiles[e >> 3] = t; ei.base[e >> 3] = before; ei.cnt[e >> 3] = c; }
    before += t;
  }
  return ei;
}
template <int NN>
struct SchedX { ExpInfo2 ei; int xcd, lb, G8; const char* A; const char* W; const int* list; size_t wstride; int lda_b; int ldw_b;
  DEVI bool next(int i, Unit& u) const {
    const int tot = (ei.tiles[0] + ei.tiles[1] + ei.tiles[2] + ei.tiles[3]) * NN;
    const int n = i * G8 + lb; if (n >= tot) return false;
    int k = 0, m = n / NN; const int pn = n % NN;
    int tb = ei.base[0], ce = ei.cnt[0];
#pragma unroll
    for (int kk = 0; kk < 3; ++kk) { if (k == kk && m >= ei.tiles[kk]) { m -= ei.tiles[kk]; k = kk + 1; tb = ei.base[kk + 1]; ce = ei.cnt[kk + 1]; } }
    const int e = xcd + 8 * k;
    u.rows = list + (size_t)e * NTOK + m * 256; u.nvalid = ce - m * 256;
    u.A = A + (NN == 2 ? 0u : uoff((unsigned)(tb + m) * 256u * (unsigned)lda_b));
    u.B = W + uoff((unsigned)e * (unsigned)wstride + (unsigned)pn * 256u * (unsigned)ldw_b);
    u.u0 = (tb + m) * 256; u.u1 = pn; u.u2 = e; u.u3 = m; return true; } };
constexpr float U8_SCALE = 16.f;
struct EpiI1 { unsigned char* U;
  DEVI void init(f32x4 (&acc)[2][2][4][2], const Unit&, int, int, int, int) const { acc_zero(acc); }
  DEVI void operator()(const f32x4 (&acc)[2][2][4][2], const Unit& u, int wr, int wc, int fr, int fq) const {
#pragma unroll
    for (int ai = 0; ai < 2; ++ai)
#pragma unroll
      for (int m = 0; m < 4; ++m) {
        unsigned char* rowp = U + (size_t)(u.u0 + ai * HALF + wr * 64 + m * 16 + fr) * 256;
#pragma unroll
        for (int bj = 0; bj < 2; ++bj) {
          const int ff = 16 * (8 * u.u1 + 4 * bj + wc) + 4 * fq;
          const f32x4 g = acc[ai][bj][m][0], up = acc[ai][bj][m][1];
          float t[4];
#pragma unroll
          for (int j = 0; j < 4; ++j) t[j] = __builtin_amdgcn_fmed3f(g[j] * __builtin_amdgcn_rcpf(1.f + __builtin_amdgcn_exp2f(g[j] * -LOG2E)) * (up[j] * U8_SCALE), -448.f, 448.f);
          int o = __builtin_amdgcn_cvt_pk_fp8_f32(t[0], t[1], 0, false);
          o = __builtin_amdgcn_cvt_pk_fp8_f32(t[2], t[3], o, true);
          *(int*)(rowp + ff) = o;
        }
      }
  }
};
DEVI void phaseI1_2(KP p, ldsp_t lds) {
  const int xcd = BIDX & 7, lb = BIDX >> 3, G8 = gridDim.x >> 3;
  if (lb >= G8) return;
  SchedX<2> S{exp_info2(p, xcd), xcd, lb, G8, (const char*)wsp<u16>(p, OFF_H2), (const char*)wsp<u16>(p, OFF_W13), wsp<int>(p, OFF_LIST), (size_t)512 * 1024, 1024, 1024};
  EpiI1 E{wsp<unsigned char>(p, OFF_U)};
  int nt = 8; asm volatile("" : "+s"(nt));
  gemm_phase<false, true, true>(lds, 1024, 1024, nt, S, E);
}
constexpr float YS8_SCALE = 32.f;
struct EpiI2 { unsigned char* YS; const float* wlist; const int* list;
  DEVI void init(f32x4 (&acc)[2][2][4][2], const Unit&, int, int, int, int) const { acc_zero(acc); }
  DEVI void operator()(const f32x4 (&acc)[2][2][4][2], const Unit& u, int wr, int wc, int fr, int fq) const {
    const unsigned colb = (unsigned)(u.u1 * 256 + wc * 32 + 8 * fq);
    const float* we = wlist + (u.rows - list);
    unsigned dest[2][4]; float w[2][4];
#pragma unroll
    for (int ai = 0; ai < 2; ++ai)
#pragma unroll
      for (int m = 0; m < 4; ++m) {
        const int r = ai * HALF + wr * 64 + m * 16 + fr;
        dest[ai][m] = (r < u.nvalid) ? (unsigned)u.rows[r] : (unsigned)(2 * NTOK);
        w[ai][m] = we[r] * (YS8_SCALE / U8_SCALE);
      }
#pragma unroll
    for (int ai = 0; ai < 2; ++ai)
#pragma unroll
      for (int m = 0; m < 4; ++m) {
        unsigned char* rowp = YS + (dest[ai][m] * 1024u + colb);
#pragma unroll
        for (int bj = 0; bj < 2; ++bj) {
          u32x2 o;
#pragma unroll
          for (int nn = 0; nn < 2; ++nn) {
            const f32x4 v = acc[ai][bj][m][nn] * w[ai][m];
            int q = __builtin_amdgcn_cvt_pk_fp8_f32(__builtin_amdgcn_fmed3f(v[0], -448.f, 448.f), __builtin_amdgcn_fmed3f(v[1], -448.f, 448.f), 0, false);
            q = __builtin_amdgcn_cvt_pk_fp8_f32(__builtin_amdgcn_fmed3f(v[2], -448.f, 448.f), __builtin_amdgcn_fmed3f(v[3], -448.f, 448.f), q, true);
            o[nn] = (unsigned)q;
          }
          *(u32x2*)(rowp + bj * 128) = o;
        }
      }
  }
};
DEVI void phaseI2_2(KP p, ldsp_t lds) {
  const int xcd = BIDX & 7, lb = BIDX >> 3, G8 = gridDim.x >> 3;
  if (lb >= G8) return;
  SchedX<4> S{exp_info2(p, xcd), xcd, lb, G8, (const char*)wsp<u16>(p, OFF_U), (const char*)wsp<u16>(p, OFF_W2), wsp<int>(p, OFF_LIST), (size_t)1024 * 256, 256, 256};
  EpiI2 E{wsp<unsigned char>(p, OFF_YS), wsp<float>(p, OFF_WLIST), wsp<int>(p, OFF_LIST)};
  int nt = 2; asm volatile("" : "+s"(nt));
  gemm_phase<true, false, true>(lds, 256, 256, nt, S, E);
}
DEVI void phaseJ2(KP p, int l, ldsp_t lds) {
  const int lane = TIDX & 63;
  const int gw = BIDX * NW + (TIDX >> 6), nw = gridDim.x * NW;
  const unsigned char* YS = wsp<unsigned char>(p, OFF_YS);
  u16* H = wsp<u16>(p, OFF_H);
  const int ntot = (l == 1) ? 8 * SEQ : NTOK;
  const int per = (ntot + nw - 1) / nw;
  const int i0 = gw * per, i1 = min(i0 + per, ntot);
  int cur = -1; ModVec mv; f32x4 gtv[4];
  for (int ii = i0; ii < i1; ii += 2) {
    float xv[2][16]; int y0[2][4], y1[2][4]; bool ok[2]; int tk[2];
#pragma unroll
    for (int r = 0; r < 2; ++r) {
      const int idx = ii + r;
      const int tok = (l == 1) ? (idx / SEQ) * TPB + NCTX + idx % SEQ : idx;
      tk[r] = tok;
      ok[r] = idx < i1;
      if (ok[r]) {
        load_row16_bf(wsp<u16>(p, OFF_XM) + (size_t)tok * 1024, xv[r]);
#pragma unroll
        for (int i = 0; i < 4; ++i) {
          const int c = i * 256 + lane * 4;
          y0[r][i] = *(const int*)(YS + (size_t)(tok * 2) * 1024 + c);
          y1[r][i] = *(const int*)(YS + (size_t)(tok * 2 + 1) * 1024 + c);
        }
      }
    }
#pragma unroll
    for (int r = 0; r < 2; ++r) {
      if (!ok[r]) continue;
      const int tok = tk[r];
      const int b = tok / TPB, rr = tok % TPB;
      const int mrow = (rr < NCTX) ? 8 : b;
      if (mrow != cur) {
        cur = mrow;
        const float* gt = wsp<float>(p, OFF_MOD) + ((size_t)l * 9 + mrow) * 6144 + 5120;
#pragma unroll
        for (int i = 0; i < 4; ++i) gtv[i] = *(const f32x4*)(gt + i * 256 + lane * 4);
        if (l == 0) load_modvec(p, 1, 0, mrow, mv);
      }
#pragma unroll
      for (int i = 0; i < 4; ++i) {
        const f32x4 g = gtv[i] * (1.f / YS8_SCALE);
        const f32x2 a0 = __builtin_amdgcn_cvt_pk_f32_fp8(y0[r][i], false), a1 = __builtin_amdgcn_cvt_pk_f32_fp8(y0[r][i], true);
        const f32x2 b0 = __builtin_amdgcn_cvt_pk_f32_fp8(y1[r][i], false), b1 = __builtin_amdgcn_cvt_pk_f32_fp8(y1[r][i], true);
        xv[r][i * 4 + 0] += g.x * (a0.x + b0.x);
        xv[r][i * 4 + 1] += g.y * (a0.y + b0.y);
        xv[r][i * 4 + 2] += g.z * (a1.x + b1.x);
        xv[r][i * 4 + 3] += g.w * (a1.y + b1.y);
      }
      if (l == 0) {
        u16* xr = (u16*)p->out + (size_t)tok * 1024;
#pragma unroll
        for (int i = 0; i < 4; ++i)
          *(u32x2*)(xr + i * 256 + lane * 4) = u32x2{pk2(xv[r][i * 4], xv[r][i * 4 + 1]), pk2(xv[r][i * 4 + 2], xv[r][i * 4 + 3])};
        float hv[16];
        modulate_row_store2<true, false>(mv, xv[r], nullptr, hv, h8base(p) + (size_t)tok * 1024);
      } else {
        float ss = 0.f;
#pragma unroll
        for (int i = 0; i < 16; ++i) ss += xv[r][i] * xv[r][i];
        ss = wave_sum(ss);
        const float rstd = rsqrtf(ss * (1.f / 1024.f) + EPS);
        float* xr = p->out + ((size_t)b * SEQ + rr - NCTX) * 1024;
#pragma unroll
        for (int i = 0; i < 4; ++i) {
          const int c = i * 256 + lane * 4;
          const f32x4 g = *(const f32x4*)(p->g_final + c);
          *(f32x4*)(xr + c) = f32x4{xv[r][i * 4] * rstd * g.x, xv[r][i * 4 + 1] * rstd * g.y, xv[r][i * 4 + 2] * rstd * g.z, xv[r][i * 4 + 3] * rstd * g.w};
        }
      }
    }
  }
}

constexpr int N_PHASES = 3 + 2 * 11;
__global__ void __launch_bounds__(512, 2) fwd_v2(Params parg) {
  extern __shared__ __attribute__((aligned(16))) unsigned char dyn_lds[];
  const ldsp_t lds = (ldsp_t)dyn_lds;
  cg::grid_group grid = cg::this_grid();
  volatile LAS unsigned* xb_st = (volatile LAS unsigned*)(lds + LDS_BARW);
  if (TIDX < 4) xb_st[TIDX] = 0u;
  __syncthreads();
  if (parg.ph_end - parg.ph_begin > 1) xcd_barrier_post((unsigned*)(parg.ws + OFF_BAR));
  for (int ph = parg.ph_begin; ph < parg.ph_end; ++ph) {
    KP p = (KP)__builtin_amdgcn_kernarg_segment_ptr();
    asm volatile("" : "+s"(p));
    const int l = (ph >= 14) ? 1 : 0;
    const int k = (ph < 3) ? ph : 3 + (ph - 3) % 11;
    const int reps = (((PROBE_DUP >> k) & 1) && (!(PROBE_DUP & 0x10000) || l == 0)) ? 2 : 1;
    for (int rep = 0; rep < reps; ++rep) {
      if (rep) {
        xcd_barrier((unsigned*)(p->ws + OFF_BAR), xb_st);
        if (k == 10) { if (BIDX == 0 && TIDX < 32) wsp<int>(p, OFF_CNT)[TIDX * CNT_STRIDE] = 0; xcd_barrier((unsigned*)(p->ws + OFF_BAR), xb_st); }
      }
      switch (k) {
        case 0: phase0_2(p, lds); break;
        case 1: phase1_2(p); break;
        case 2: phaseA2(p); break;
        case 3: phaseB2(p, lds); break;
        case 4: phaseC2(p, lds); break;
        case 5: phaseP2(p, l, lds); break;
        case 6: phaseD2(p, l, lds); break;
        case 7: phaseE1(p, l, lds); break;
        case 8: phaseE2(p, l, lds); break;
        case 9: phaseF2(p, l, lds); break;
        case 10: phaseG2(p, l, lds); break;
        case 11: phaseI1_2(p, lds); break;
        case 12: phaseI2_2(p, lds); break;
        default: phaseJ2(p, l, lds); break;
      }
    }
    if (k == 0 || (k == 13 && l == 0)) conv_items2(p, k == 0 ? 0 : 1, lds, 0, CONV_EARLY);
    if (ph + 1 < parg.ph_end && k != 9) {
      if (parg.ph_begin >= 1000) grid.sync();
      else xcd_barrier((unsigned*)(p->ws + OFF_BAR), xb_st);
    }
  }
}
}

extern "C" void kernel_launch(void* const* d_in, const int* in_sizes, int n_in, void* d_out, int out_size,
                              void* d_ws, size_t ws_size, hipStream_t stream) {
  static int grid2 = 0;
  if (!grid2) {
    int dev = 0, cus = 0, per_cu = 0;
    (void)hipGetDevice(&dev);
    (void)hipDeviceGetAttribute(&cus, hipDeviceAttributeMultiprocessorCount, dev);
    (void)hipFuncSetAttribute((const void*)v2::fwd_v2, hipFuncAttributeMaxDynamicSharedMemorySize, v2::LDS_TOTAL);
    (void)hipOccupancyMaxActiveBlocksPerMultiprocessor(&per_cu, v2::fwd_v2, 512, v2::LDS_TOTAL);
    if (per_cu < 1) { fprintf(stderr, "kernel does not fit on a CU\n"); per_cu = 1; }
    grid2 = cus & ~7;
  }
  if (ws_size < WS_NEEDED) { fprintf(stderr, "workspace too small: %zu < %zu\n", ws_size, (size_t)WS_NEEDED); return; }
  Params hp{};
  const float** f = (const float**)&hp;
  for (int i = 0; i < 29; ++i) f[i] = (const float*)d_in[i];
  hp.out = (float*)d_out;
  hp.ws = (char*)d_ws;
#if N_LAUNCH_MODE == 1
  for (int ph = 0; ph < v2::N_PHASES; ++ph) {
    hp.ph_begin = ph; hp.ph_end = ph + 1;
    void* args[] = {&hp};
    hipError_t e = hipLaunchCooperativeKernel((void*)v2::fwd_v2, dim3(grid2), dim3(512), args, v2::LDS_TOTAL, stream);
    if (e != hipSuccess) fprintf(stderr, "launch failed: %s\n", hipGetErrorString(e));
  }
#else
  hp.ph_begin = 0; hp.ph_end = v2::N_PHASES;
  (void)hipMemsetAsync((char*)d_ws + OFF_BAR, 0, (size_t)(OFF_DEP - OFF_BAR) + (size_t)DEP_WORDS * 4, stream);
  void* args[] = {&hp};
  hipError_t e = hipLaunchCooperativeKernel((void*)v2::fwd_v2, dim3(grid2), dim3(512), args, v2::LDS_TOTAL, stream);
  if (e != hipSuccess) fprintf(stderr, "cooperative launch failed: %s (grid %d)\n", hipGetErrorString(e), grid2);
#endif
}
```

```cpp
#include <hip/hip_runtime.h>
#include <hip/hip_cooperative_groups.h>
#include <stdint.h>
#include <stdio.h>
namespace cg = cooperative_groups;

#ifndef N_LAUNCH_MODE
#define N_LAUNCH_MODE 0
#endif

#ifndef PROBE_DUP
#define PROBE_DUP 0
#endif
#define DEVI __device__ __forceinline__
typedef unsigned short u16;
typedef __attribute__((ext_vector_type(2))) float f32x2;
typedef __attribute__((ext_vector_type(2))) __bf16 bf16x2_t;
typedef __attribute__((ext_vector_type(8))) short bf16x8;
typedef __attribute__((ext_vector_type(16))) float f32x16;
typedef __attribute__((ext_vector_type(4))) unsigned u32x4;
typedef __attribute__((ext_vector_type(2))) unsigned u32x2;
typedef __attribute__((ext_vector_type(4))) float f32x4;
#define MFMA(a, b, c) __builtin_amdgcn_mfma_f32_32x32x16_bf16((a), (b), (c), 0, 0, 0)

constexpr int DMODEL = 1024, NBATCH = 8, SEQ = 4096, NCTX = 256;
constexpr int TPB = SEQ + NCTX;
constexpr int NTOK = NBATCH * TPB;
constexpr int MT_PER_B = TPB / 128;
constexpr int NEXP = 32;
constexpr int INP = 2304;
constexpr float EPS = 1e-6f;
constexpr float LOG2E = 1.4426950408889634f;
constexpr int SMEM_BYTES = 73728;
constexpr int UROWS = 2 * NTOK + NEXP * 256;

constexpr size_t al(size_t x) { return (x + 255) & ~(size_t)255; }
constexpr size_t OFF_WIN = 0;
constexpr size_t OFF_WQB = OFF_WIN + al((size_t)INP * 1024 * 2);
constexpr size_t OFF_WKVB = OFF_WQB + al((size_t)512 * 256 * 2);
constexpr size_t OFF_WGATE = OFF_WKVB + al((size_t)512 * 256 * 2);
constexpr size_t OFF_WBR = OFF_WGATE + al((size_t)4 * 1024 * 1024 * 2);
constexpr size_t OFF_WOUT = OFF_WBR + al((size_t)4 * 1024 * 256 * 2);
constexpr size_t OFF_W13 = OFF_WOUT + al((size_t)1024 * 1024 * 2);
constexpr size_t OFF_W2 = OFF_W13 + al((size_t)32 * 512 * 1024 * 2);
constexpr size_t OFF_MODP = OFF_W2 + al((size_t)32 * 1024 * 256 * 2);
constexpr size_t OFF_MOD = OFF_MODP + al((size_t)8 * 2 * 9 * 6144 * 4);
constexpr size_t OFF_CS32 = OFF_MOD + al((size_t)2 * 9 * 6144 * 4);
constexpr size_t OFF_CS16 = OFF_CS32 + al((size_t)64 * 16 * 2 * 4);
constexpr size_t OFF_WRT = OFF_CS16 + al((size_t)64 * 8 * 2 * 4);
constexpr size_t OFF_CNT = OFF_WRT + al((size_t)2 * 36 * 1024 * 4);
constexpr int CNT_STRIDE = 64;
constexpr size_t OFF_BAR = OFF_CNT + al(32 * CNT_STRIDE * 4);
constexpr int XCD_BAR_WORDS = 3456;
constexpr size_t OFF_CTXRES = OFF_BAR + al((size_t)XCD_BAR_WORDS * 4);
constexpr size_t OFF_DEP = OFF_CTXRES;
constexpr int DEP_STRIDE = 16, DEP_TILECTR = 2 * 136 * DEP_STRIDE, DEP_WORDS = DEP_TILECTR + 2 * DEP_STRIDE;
constexpr size_t OFF_H = OFF_CTXRES + al((size_t)8 * 256 * 1024 * 4);
constexpr size_t OFF_O = OFF_H + al((size_t)NTOK * 1024 * 2);
constexpr size_t OFF_SSQ = OFF_O + al((size_t)NTOK * 1024 * 2);
constexpr size_t OFF_LIST = OFF_SSQ + al((size_t)NTOK * 8 * 4);
constexpr size_t OFF_WLIST = OFF_LIST + al((size_t)32 * NTOK * 4);
constexpr size_t OFF_R1 = OFF_WLIST + al((size_t)32 * NTOK * 4);
constexpr int PLD = INP;
constexpr size_t OFF_PRAW = OFF_R1;
constexpr size_t OFF_QARAW = OFF_PRAW + (size_t)NTOK * INP * 2;
constexpr size_t OFF_KVARAW = OFF_QARAW + (size_t)NTOK * 512 * 2;
constexpr size_t OFF_VAT = OFF_KVARAW + (size_t)NTOK * 512 * 2;
constexpr size_t OFF_VBT = OFF_VAT + (size_t)NTOK * 256 * 2;
constexpr size_t OFF_VCT = OFF_VBT + (size_t)NTOK * 128 * 2;
constexpr size_t OFF_VDT = OFF_VCT + (size_t)NTOK * 256 * 2;
constexpr size_t OFF_END = OFF_VDT + (size_t)NTOK * 128 * 2;
constexpr size_t OFF_Z = OFF_R1;
constexpr size_t OFF_Y8 = OFF_H;
constexpr size_t OFF_H2 = OFF_O;
constexpr size_t OFF_YPRE = OFF_O;
constexpr size_t OFF_U = OFF_R1;
constexpr size_t OFF_YS = OFF_R1 + al((size_t)UROWS * 256 * 2);
constexpr size_t OFF_XM = OFF_YS + al((size_t)(2 * NTOK + 1) * 1024 * 2);
static_assert(OFF_XM + (size_t)NTOK * 1024 * 2 <= OFF_END, "alias overflow");
static_assert(OFF_Z + (size_t)NTOK * 4096 * 2 <= OFF_END, "alias overflow");
static_assert(OFF_YS + (size_t)(2 * NTOK + 1) * 1024 * 2 <= OFF_END, "alias overflow");
constexpr size_t WS_NEEDED = OFF_END;
static_assert(WS_NEEDED <= (size_t)536870912, "workspace budget (4 x largest tensor)");

struct Params {
  const float *x, *c, *ctx, *c_ctx, *w_mod, *b_mod, *g_norm_mix, *w_in, *g_q_a, *w_q_b, *g_kv_a, *w_kv_b,
      *sink_b, *rpb_c, *g_q_d, *g_k_d, *w_gate, *b_gate, *w_branch, *w_out, *g_norm_ffn, *w_group, *b_group,
      *w_router, *b_router, *w_ff1, *w_ff3, *w_ff2, *g_final;
  float* out;
  char* ws;
  int ph_begin, ph_end;
};

DEVI int tid_fresh() { int t; asm volatile("v_mov_b32 %0, %1" : "=v"(t) : "v"(__builtin_amdgcn_workitem_id_x())); return t; }
DEVI int bid_fresh() { int t; asm volatile("s_mov_b32 %0, %1" : "=s"(t) : "s"(__builtin_amdgcn_workgroup_id_x())); return t; }
#define TIDX tid_fresh()
#define BIDX bid_fresh()
typedef const __attribute__((address_space(4))) Params* KP;
DEVI unsigned pk2(float a, float b) { f32x2 v = {a, b}; bf16x2_t r = __builtin_convertvector(v, bf16x2_t); return __builtin_bit_cast(unsigned, r); }
DEVI u16 f2bf(float a) { return (u16)(pk2(a, 0.f) & 0xffffu); }
DEVI float bf2f(u16 v) { return __uint_as_float(((unsigned)v) << 16); }
DEVI float wave_sum(float v) {
#pragma unroll
  for (int m = 32; m >= 1; m >>= 1) v += __shfl_xor(v, m);
  return v;
}
template <class T> DEVI T* wsp(KP p, size_t off) { return (T*)(p->ws + off); }
DEVI const float* xrow_in(KP p, int l, int b, int rr) {
  if (l == 0) return (rr < NCTX) ? p->ctx + ((size_t)b * NCTX + rr) * 1024 : p->x + ((size_t)b * SEQ + rr - NCTX) * 1024;
  return (rr < NCTX) ? wsp<float>(p, OFF_CTXRES) + ((size_t)b * NCTX + rr) * 1024 : p->out + ((size_t)b * SEQ + rr - NCTX) * 1024;
}
DEVI float* xrow_res(KP p, int b, int rr) {
  return (rr < NCTX) ? wsp<float>(p, OFF_CTXRES) + ((size_t)b * NCTX + rr) * 1024 : p->out + ((size_t)b * SEQ + rr - NCTX) * 1024;
}
DEVI int perm16(int k) { return (k & ~12) | ((k & 4) << 1) | ((k & 8) >> 1); }

struct ConvT { const float* src; const float* src2; const float* ks; u16* dst; int ld; int ldd; float mul; };
constexpr float Z8_SCALE = 16.f, O8_SCALE = 32.f;
constexpr float F8_WSCALE = 64.f, GATE_WSCALE = F8_WSCALE;
constexpr int CONV_ITEMS = 1152 + 64 + 64 + 2048 + 512 + 512 + 8192 + 4096;
DEVI ConvT conv_decode(KP p, int l, int idx) {
  ConvT c; c.ks = nullptr; c.mul = 1.f; c.src2 = nullptr;
  if (idx < 1152) {
    int nt = idx >> 4, kt = idx & 15, n0 = nt * 32;
    int sc = (n0 < 416) ? n0 : ((n0 < 512) ? -1 : n0 - 96);
    c.ld = 2208; c.ldd = -1024;
    c.mul = F8_WSCALE;
    if ((n0 >= 512 && n0 < 768) || (n0 >= 1024 && n0 < 1280)) c.mul = 0.125f * LOG2E * F8_WSCALE;
    c.src = (sc < 0) ? nullptr : p->w_in + (size_t)l * 1024 * 2208 + (size_t)kt * 64 * 2208 + sc;
    c.dst = (u16*)(p->ws + OFF_WIN + (size_t)n0 * 1024 + kt * 64);
    return c;
  }
  idx -= 1152;
  if (idx < 64) {
    int nt = idx >> 2, kt = idx & 3;
    c.ld = 384; c.ldd = 256; c.ks = p->g_q_a + l * 256 + kt * 64;
    c.src = (nt >= 12) ? nullptr : p->w_q_b + (size_t)l * 256 * 384 + (size_t)kt * 64 * 384 + nt * 32;
    c.dst = wsp<u16>(p, OFF_WQB) + (size_t)nt * 32 * 256 + kt * 64;
    return c;
  }
  idx -= 64;
  if (idx < 64) {
    int nt = idx >> 2, kt = idx & 3;
    c.ld = 512; c.ldd = 256; c.ks = (kt < 2) ? p->g_kv_a + l * 128 + kt * 64 : nullptr;
    c.src = (kt >= 2) ? nullptr : p->w_kv_b + (size_t)l * 128 * 512 + (size_t)kt * 64 * 512 + nt * 32;
    c.dst = wsp<u16>(p, OFF_WKVB) + (size_t)nt * 32 * 256 + kt * 64;
    return c;
  }
  idx -= 64;
  if (idx < 2048) {
    int nt = idx >> 4, kt = idx & 15, R0 = nt * 32;
    int pr = R0 >> 11, cb = (R0 & 2047) >> 8, bj = (R0 & 255) >> 7, j0 = R0 & 127;
    c.ld = 1024; c.ldd = -1024; c.mul = -LOG2E * F8_WSCALE;
    c.src = p->w_gate + ((size_t)(l * 4 + 2 * pr + bj) * 1024 + kt * 64) * 1024 + cb * 128 + j0;
    c.dst = (u16*)(p->ws + OFF_WGATE + (size_t)R0 * 1024 + kt * 64);
    return c;
  }
  idx -= 2048;
  if (idx < 512) {
    int br = idx >> 7, nt = (idx >> 2) & 31, kt = idx & 3;
    c.ld = 1024; c.ldd = -256; c.mul = F8_WSCALE * (Z8_SCALE / O8_SCALE);
    c.src = p->w_branch + ((size_t)(l * 4 + br) * 256 + kt * 64) * 1024 + nt * 32;
    c.dst = (u16*)(p->ws + OFF_WBR + ((size_t)br * 1024 + nt * 32) * 256 + kt * 64);
    return c;
  }
  idx -= 512;
  if (idx < 512) {
    int nt = idx >> 4, kt = idx & 15;
    c.ld = 1024; c.ldd = -1024; c.mul = F8_WSCALE;
    c.src = p->w_out + ((size_t)l * 1024 + kt * 64) * 1024 + nt * 32;
    c.dst = (u16*)(p->ws + OFF_WOUT + (size_t)nt * 32 * 1024 + kt * 64);
    return c;
  }
  idx -= 512;
  if (idx < 8192) {
    int e = idx >> 8, g32 = (idx >> 4) & 15, kt = idx & 15;
    c.ld = 256; c.ldd = -1024; c.mul = F8_WSCALE;
    c.src = p->w_ff1 + ((size_t)(l * 32 + e) * 1024 + kt * 64) * 256 + g32 * 16;
    c.src2 = p->w_ff3 + ((size_t)(l * 32 + e) * 1024 + kt * 64) * 256 + g32 * 16;
    c.dst = (u16*)(p->ws + OFF_W13 + ((size_t)e * 512 + g32 * 32) * 1024 + kt * 64);
    return c;
  }
  idx -= 8192;
  {
    int e = idx >> 7, nt = (idx >> 2) & 31, kt = idx & 3;
    c.ld = 1024; c.ldd = -256; c.mul = F8_WSCALE;
    c.src = p->w_ff2 + ((size_t)(l * 32 + e) * 256 + kt * 64) * 1024 + nt * 32;
    c.dst = (u16*)(p->ws + OFF_W2 + ((size_t)e * 1024 + nt * 32) * 256 + kt * 64);
    return c;
  }
}
DEVI void modulate_row_store(KP p, int l, int which, const float (&xv)[16], int mrow, u16* hrow, float (&hv)[16]) {
  const int lane = TIDX & 63;
  float ss = 0.f;
#pragma unroll
  for (int i = 0; i < 16; ++i) ss += xv[i] * xv[i];
  ss = wave_sum(ss);
  const float rstd = rsqrtf(ss * (1.f / 1024.f) + EPS);
  const float* g = (which ? p->g_norm_ffn : p->g_norm_mix) + l * 1024;
  const float* mod = wsp<float>(p, OFF_MOD) + ((size_t)l * 9 + mrow) * 6144 + (which ? 3072 : 0);
#pragma unroll
  for (int i = 0; i < 4; ++i) {
    const int c = i * 256 + lane * 4;
    f32x4 gv = *(const f32x4*)(g + c);
    f32x4 sh = *(const f32x4*)(mod + c);
    f32x4 sc = *(const f32x4*)(mod + 1024 + c);
    hv[i * 4 + 0] = xv[i * 4 + 0] * rstd * gv.x * (1.f + sc.x) + sh.x;
    hv[i * 4 + 1] = xv[i * 4 + 1] * rstd * gv.y * (1.f + sc.y) + sh.y;
    hv[i * 4 + 2] = xv[i * 4 + 2] * rstd * gv.z * (1.f + sc.z) + sh.z;
    hv[i * 4 + 3] = xv[i * 4 + 3] * rstd * gv.w * (1.f + sc.w) + sh.w;
    u32x2 o; o.x = pk2(hv[i * 4 + 0], hv[i * 4 + 1]); o.y = pk2(hv[i * 4 + 2], hv[i * 4 + 3]);
    *(u32x2*)(hrow + c) = o;
  }
}
struct ModVec { f32x4 a[4], b[4]; };
DEVI void load_modvec(KP p, int l, int which, int mrow, ModVec& mv) {
  const int lane = TIDX & 63;
  const float* g = (which ? p->g_norm_ffn : p->g_norm_mix) + l * 1024;
  const float* mod = wsp<float>(p, OFF_MOD) + ((size_t)l * 9 + mrow) * 6144 + (which ? 3072 : 0);
#pragma unroll
  for (int i = 0; i < 4; ++i) {
    const int c = i * 256 + lane * 4;
    const f32x4 gv = *(const f32x4*)(g + c), sh = *(const f32x4*)(mod + c), sc = *(const f32x4*)(mod + 1024 + c);
    mv.a[i] = gv * (1.f + sc); mv.b[i] = sh;
  }
}
DEVI unsigned char* h8base(KP p) { return (unsigned char*)p->out + (size_t)NTOK * 2048; }
template <bool F8COPY = false, bool BF16 = true>
DEVI void modulate_row_store2(const ModVec& mv, const float (&xv)[16], u16* hrow, float (&hv)[16], unsigned char* h8row = nullptr) {
  const int lane = TIDX & 63;
  float ss = 0.f;
#pragma unroll
  for (int i = 0; i < 16; ++i) ss += xv[i] * xv[i];
  ss = wave_sum(ss);
  const float rstd = rsqrtf(ss * (1.f / 1024.f) + EPS);
#pragma unroll
  for (int i = 0; i < 4; ++i) {
    const int c = i * 256 + lane * 4;
#pragma unroll
    for (int j = 0; j < 4; ++j) hv[i * 4 + j] = xv[i * 4 + j] * rstd * mv.a[i][j] + mv.b[i][j];
    if (BF16) { u32x2 o; o.x = pk2(hv[i * 4 + 0], hv[i * 4 + 1]); o.y = pk2(hv[i * 4 + 2], hv[i * 4 + 3]);
      *(u32x2*)(hrow + c) = o; }
    if (F8COPY) {
      float q[4];
#pragma unroll
      for (int j = 0; j < 4; ++j) q[j] = __builtin_amdgcn_fmed3f(hv[i * 4 + j], -448.f, 448.f);
      int v = __builtin_amdgcn_cvt_pk_fp8_f32(q[0], q[1], 0, false);
      v = __builtin_amdgcn_cvt_pk_fp8_f32(q[2], q[3], v, true);
      *(int*)(h8row + c) = v;
    }
  }
}
DEVI void load_row16(const float* xr, float (&xv)[16]) {
  const int lane = TIDX & 63;
#pragma unroll
  for (int i = 0; i < 4; ++i) {
    f32x4 v = *(const f32x4*)(xr + i * 256 + lane * 4);
    xv[i * 4 + 0] = v.x; xv[i * 4 + 1] = v.y; xv[i * 4 + 2] = v.z; xv[i * 4 + 3] = v.w;
  }
}
DEVI void load_row16_bf(const u16* xr, float (&xv)[16]) {
  const int lane = TIDX & 63;
#pragma unroll
  for (int i = 0; i < 4; ++i) {
    const u32x2 v = *(const u32x2*)(xr + i * 256 + lane * 4);
    xv[i * 4 + 0] = __uint_as_float(v.x << 16); xv[i * 4 + 1] = __uint_as_float(v.x & 0xffff0000u);
    xv[i * 4 + 2] = __uint_as_float(v.y << 16); xv[i * 4 + 3] = __uint_as_float(v.y & 0xffff0000u);
  }
}
DEVI float router_dot(const float (&hv)[4][16], const float* wrow) {
  const int lane = TIDX & 63;
  const float* w = wrow + lane * 4;
  float pr[4] = {0.f, 0.f, 0.f, 0.f};
#pragma unroll
  for (int i = 0; i < 4; ++i) {
    const f32x4 wv = *(const f32x4*)(w + i * 256);
#pragma unroll
    for (int r = 0; r < 4; ++r)
      pr[r] += hv[r][i * 4] * wv.x + hv[r][i * 4 + 1] * wv.y + hv[r][i * 4 + 2] * wv.z + hv[r][i * 4 + 3] * wv.w;
  }
  const bool up = (lane & 32) != 0;
  float s0 = up ? pr[0] : pr[2], s1 = up ? pr[1] : pr[3];
  float k0 = up ? pr[2] : pr[0], k1 = up ? pr[3] : pr[1];
  k0 += __shfl_xor(s0, 32); k1 += __shfl_xor(s1, 32);
  const bool up2 = (lane & 16) != 0;
  float sv = up2 ? k0 : k1, kv = up2 ? k1 : k0;
  kv += __shfl_xor(sv, 16);
  kv += __shfl_xor(kv, 8); kv += __shfl_xor(kv, 4); kv += __shfl_xor(kv, 2); kv += __shfl_xor(kv, 1);
  return kv;
}
#define XB_TMO      128
#define XB_XCNT(j)  (256  + 64 * (j))
#define XB_XSUB(j)  (1280 + 64 * (j))
#define XB_XGEN(j)  (2304 + 64 * (j))
#define XB_TOP      3328
#define XB_TOPGEN   3392
#define XB_SPIN_CAP (1u << 20)
#define LAS __attribute__((address_space(3)))
DEVI unsigned xb_ld(unsigned* p) { return __hip_atomic_load(p, __ATOMIC_RELAXED, __HIP_MEMORY_SCOPE_AGENT); }
DEVI unsigned xb_add(unsigned* p, unsigned v) { return __hip_atomic_fetch_add(p, v, __ATOMIC_RELAXED, __HIP_MEMORY_SCOPE_AGENT); }
DEVI unsigned xb_xcc_id() { return (unsigned)__builtin_amdgcn_s_getreg((3 << 11) | 20) & 0xFu; }
#define XB_SPIN(cond, bar) do { unsigned _sp = 0; while (cond) { __builtin_amdgcn_s_sleep(1); \
    if ((++_sp & 255u) == 0u) { if (xb_ld(&(bar)[XB_TMO])) break; if (_sp > XB_SPIN_CAP) { atomicAdd(&(bar)[XB_TMO], 1u); break; } } } } while (0)
DEVI void xcd_barrier_post(unsigned* bar) {
  if (TIDX == 0) (void)xb_add(&bar[XB_XCNT(xb_xcc_id())], 1u);
}
DEVI void xcd_barrier_complete(unsigned* bar, unsigned x, unsigned& nloc, unsigned& nx) {
  const unsigned G = gridDim.x * gridDim.y * gridDim.z;
  unsigned sum, cnt, mine, sp = 0u;
  for (;;) {
    sum = 0u; cnt = 0u; mine = 0u;
#pragma unroll
    for (unsigned j = 0; j < 16; ++j) { const unsigned c = xb_ld(&bar[XB_XCNT(j)]); sum += c; cnt += (c > 0u) ? 1u : 0u; mine = (j == x) ? c : mine; }
    if (sum == G) break;
    __builtin_amdgcn_s_sleep(1);
    if ((++sp & 255u) == 0u) { if (xb_ld(&bar[XB_TMO])) break; if (sp > XB_SPIN_CAP) { atomicAdd(&bar[XB_TMO], 1u); break; } }
  }
  nloc = mine > 0u ? mine : 1u; nx = cnt > 0u ? cnt : 1u;
}
DEVI void xcd_barrier(unsigned* bar, volatile LAS unsigned* st) {
  asm volatile("s_waitcnt vmcnt(0)" ::: "memory");
  __syncthreads();
  if (TIDX == 0) {
    const unsigned x = xb_xcc_id();
    __builtin_amdgcn_s_waitcnt(0);
    unsigned nloc = st[0], nx = st[1];
    if (nloc == 0u) { xcd_barrier_complete(bar, x, nloc, nx); st[0] = nloc; st[1] = nx; }
    const unsigned old = xb_add(&bar[XB_XSUB(x)], 1u);
    const unsigned gen = old / nloc;
    if (old + 1u == (gen + 1u) * nloc) {
      __builtin_amdgcn_fence(__ATOMIC_RELEASE, "agent");
      asm volatile("s_waitcnt vmcnt(0)" ::: "memory");
      const unsigned og = xb_add(&bar[XB_TOP], 1u);
      const unsigned tg = og / nx;
      if (og + 1u == (tg + 1u) * nx) xb_add(&bar[XB_TOPGEN], 1u);
      else XB_SPIN(xb_ld(&bar[XB_TOPGEN]) == tg, bar);
      __builtin_amdgcn_fence(__ATOMIC_ACQUIRE, "agent");
      xb_add(&bar[XB_XGEN(x)], 1u);
      asm volatile("s_waitcnt vmcnt(0)" ::: "memory");
    } else {
      XB_SPIN(xb_ld(&bar[XB_XGEN(x)]) == gen, bar);
      __builtin_amdgcn_fence(__ATOMIC_ACQUIRE, "agent");
      asm volatile("s_waitcnt vmcnt(0)" ::: "memory");
    }
  }
  __syncthreads();
}

namespace v2 {
typedef LAS unsigned char* ldsp_t;
constexpr int BM = 256, BK = 64, HALF = 128, HTB = HALF * BK * 2, STAGE_BYTES = 8 * HTB;
constexpr int NW = 8;
constexpr int LDS_XTRA = STAGE_BYTES;
constexpr int LDS_BARW = STAGE_BYTES + 16384;
constexpr int LDS_TOTAL = LDS_BARW + 16;

DEVI int lds_byte(int r, int c) { const int st = (r >> 4) * 2 + (c >> 5), rr = r & 15, cc = c & 31, ob = rr * 64 + cc * 2; return st * 1024 + (ob ^ (((ob >> 9) & 1) << 5)); }
DEVI void stage_rc(int b, int& R, int& C) { const int st = b / 1024, sb = b % 1024, swz = sb ^ (((sb >> 9) & 1) << 5); R = (st >> 1) * 16 + swz / 64; C = (st & 1) * 32 + (swz % 64) / 2; }
DEVI int perm32(int rho) { const int n = rho >> 4, i = rho & 15; return 8 * (i >> 2) + 4 * n + (i & 3); }

DEVI void acc_zero(f32x4 (&acc)[2][2][4][2]) {
#pragma unroll
  for (int a = 0; a < 2; ++a)
#pragma unroll
    for (int b = 0; b < 2; ++b)
#pragma unroll
      for (int m = 0; m < 4; ++m)
#pragma unroll
        for (int n = 0; n < 2; ++n) acc[a][b][m][n] = (f32x4){0.f, 0.f, 0.f, 0.f};
}
struct Unit { const char* A; const char* B; const int* rows; int nvalid; int u0, u1, u2, u3; };

typedef int i32x8 __attribute__((ext_vector_type(8)));
typedef int i32x4v __attribute__((ext_vector_type(4)));
DEVI i32x8 cat8(bf16x8 lo, bf16x8 hi) { return __builtin_shufflevector(__builtin_bit_cast(i32x4v, lo), __builtin_bit_cast(i32x4v, hi), 0, 1, 2, 3, 4, 5, 6, 7); }
DEVI const char* sptr(const char* p) {
  const unsigned long long v = (unsigned long long)p;
  const unsigned lo = (unsigned)__builtin_amdgcn_readfirstlane((int)(unsigned)v), hi = (unsigned)__builtin_amdgcn_readfirstlane((int)(unsigned)(v >> 32));
  return (const char*)(((unsigned long long)hi << 32) | lo);
}
template <bool PERM, bool GATHER, bool F8, class Epi, class Sched>
DEVI void gemm_phase(ldsp_t lds, int lda_b, int ldb_b, int nt, const Sched& S, const Epi& E) {
  const int tid = TIDX, wid = __builtin_amdgcn_readfirstlane(tid >> 6), lane = tid & 63, wr = wid >> 2, wc = wid & 3, fr = lane & 15, fq = lane >> 4;
  unsigned voffA[2], voffB[2]; int RA[2], CA2[2];
#pragma unroll
  for (int i = 0; i < 2; ++i) {
    int R, C; stage_rc(tid * 16 + i * 8192, R, C);
    const int Rb = PERM ? ((R & ~31) + perm32(R & 31)) : R;
    RA[i] = R; CA2[i] = C * 2;
    voffA[i] = (unsigned)(R * lda_b + C * 2); voffB[i] = (unsigned)(Rb * ldb_b + C * 2);
  }
  const size_t kstep = (size_t)(BK * 2);
  const size_t hstepA = (size_t)HALF * lda_b, hstepB = (size_t)HALF * ldb_b;
  const unsigned ldsw = (unsigned)wid * 1024u, ldsbase = (unsigned)(size_t)lds;
  const int aoff = lds_byte(wr * 64 + fr, fq * 8), boff = lds_byte(wc * 32 + fr, fq * 8);
#define G_SA(b, h) (((b) * 2 + (h)) * HTB)
#define G_SB(b, h) ((4 + (b) * 2 + (h)) * HTB)
#define G_DMA(sbase, voff, ldsaddr) asm volatile("s_mov_b32 m0, %2\n\ts_nop 0\n\tglobal_load_lds_dwordx4 %0, %1" :: "v"(voff), "s"(sbase), "s"(ldsaddr) : "memory", "m0")
#define G_STAGE(bufoff, gbase, voff) do { const char* sb_ = sptr((const char*)(gbase)); _Pragma("unroll") for (int _i = 0; _i < 2; ++_i) \
    G_DMA(sb_, (voff)[_i], (unsigned)__builtin_amdgcn_readfirstlane((int)(ldsbase + (unsigned)(bufoff) + ldsw + (unsigned)_i * 8192u))); } while (0)
#define G_STAGE_A(bufoff, abase, go, h, koff) do { if (GATHER) { const char* sb_ = sptr((const char*)(abase) + (koff)); _Pragma("unroll") for (int _i = 0; _i < 2; ++_i) \
    G_DMA(sb_, (go)[h][_i], (unsigned)__builtin_amdgcn_readfirstlane((int)(ldsbase + (unsigned)(bufoff) + ldsw + (unsigned)_i * 8192u))); } \
    else G_STAGE(bufoff, (abase) + (h) * hstepA + (koff), voffA); } while (0)
#define G_LDA(dst, b, h) do { _Pragma("unroll") for (int m = 0; m < 4; ++m) { if (F8) dst##8[m] = cat8(*(const LAS bf16x8*)(lds + G_SA(b, h) + aoff + m * 2048), *(const LAS bf16x8*)(lds + G_SA(b, h) + aoff + m * 2048 + 1024)); \
    else { _Pragma("unroll") for (int k = 0; k < 2; ++k) dst[m][k] = *(const LAS bf16x8*)(lds + G_SA(b, h) + aoff + m * 2048 + k * 1024); } } } while (0)
#define G_LDB(dst, b, h) do { _Pragma("unroll") for (int n = 0; n < 2; ++n) { if (F8) dst##8[n] = cat8(*(const LAS bf16x8*)(lds + G_SB(b, h) + boff + n * 2048), *(const LAS bf16x8*)(lds + G_SB(b, h) + boff + n * 2048 + 1024)); \
    else { _Pragma("unroll") for (int k = 0; k < 2; ++k) dst[n][k] = *(const LAS bf16x8*)(lds + G_SB(b, h) + boff + n * 2048 + k * 1024); } } } while (0)
#define G_MMA(ai, bj, At, Bt) do { __builtin_amdgcn_s_setprio(1); _Pragma("unroll") for (int m = 0; m < 4; ++m) _Pragma("unroll") for (int n = 0; n < 2; ++n) { \
    if (F8) asm("v_mfma_scale_f32_16x16x128_f8f6f4 %0, %1, %2, %0, %3, %4 op_sel_hi:[0,0,0]" : "+v"(acc[ai][bj][m][n]) : "v"(Bt##8[n]), "v"(At##8[m]), "v"(f8wscale), "v"(f8ascale)); \
    else { _Pragma("unroll") for (int k = 0; k < 2; ++k) acc[ai][bj][m][n] = __builtin_amdgcn_mfma_f32_16x16x32_bf16(Bt[n][k], At[m][k], acc[ai][bj][m][n], 0, 0, 0); } } \
    __builtin_amdgcn_s_setprio(0); } while (0)
#define G_WAIT_V(n) asm volatile("s_waitcnt vmcnt(" #n ")" ::: "memory")
#define G_WAIT_L(n) asm volatile("s_waitcnt lgkmcnt(" #n ")" ::: "memory")
#define G_BAR __builtin_amdgcn_s_barrier()
#define G_SCHED __builtin_amdgcn_sched_barrier(0)
  Unit cur, nxt; int ui = 0;
  if (!S.next(0, cur)) return;
  f32x4 acc[2][2][4][2];
  E.init(acc, cur, wr, wc, fr, fq);
  bf16x8 At[4][2], B0[2][2], B1[2][2];
  i32x8 At8[4], B08[2], B18[2];
  const int f8wscale = 0x79797979, f8ascale = 0x7f7f7f7f;
  unsigned gcur[2][2];
  auto gather_offs = [&](const Unit& u, unsigned (&go)[2][2]) {
#pragma unroll
    for (int h = 0; h < 2; ++h)
#pragma unroll
      for (int i = 0; i < 2; ++i) {
        const int r = h * HALF + RA[i];
        const int t = (r < u.nvalid) ? (u.rows[r] >> 1) : 0;
        go[h][i] = (unsigned)t * (unsigned)lda_b + (unsigned)CA2[i];
      }
  };
  if (GATHER) gather_offs(cur, gcur);
  const char* cA = cur.A; const char* cB = cur.B;
  G_STAGE(G_SB(0, 0), cB, voffB); G_STAGE_A(G_SA(0, 0), cA, gcur, 0, 0); G_STAGE(G_SB(0, 1), cB + hstepB, voffB); G_STAGE_A(G_SA(0, 1), cA, gcur, 1, 0);
  if (wr == 1) G_BAR;
  G_WAIT_V(4); G_BAR;
  G_STAGE(G_SB(1, 0), cB + kstep, voffB); G_STAGE_A(G_SA(1, 0), cA, gcur, 0, kstep); G_STAGE(G_SB(1, 1), cB + hstepB + kstep, voffB);
  G_WAIT_V(6); G_BAR;
  for (;;) {
    const bool has_next = S.next(ui + 1, nxt);
    const char* nA = has_next ? nxt.A : cA; const char* nB = has_next ? nxt.B : cB;
#pragma clang loop unroll(disable)
    for (int t = 0; t < nt; t += 2) {
      const bool last = (t == nt - 2);
      const size_t k1 = (size_t)(t + 1) * kstep;
      const char* a2 = last ? nA : cA; const char* b2 = last ? nB : cB + (size_t)(t + 2) * kstep;
      const size_t ka2 = last ? 0 : (size_t)(t + 2) * kstep;
      const char* b3 = b2 + kstep; const size_t ka3 = ka2 + kstep;
      unsigned gN[2][2];
      if (GATHER && last) {
        if (has_next) gather_offs(nxt, gN);
        else {
#pragma unroll
          for (int h = 0; h < 2; ++h)
#pragma unroll
            for (int i = 0; i < 2; ++i) gN[h][i] = gcur[h][i];
        }
      }
#define G_STAGE_A2(bufoff, h, koff) do { if (GATHER) { if (last) G_STAGE_A(bufoff, cA, gN, h, (koff) - ka2); else G_STAGE_A(bufoff, cA, gcur, h, koff); } \
        else G_STAGE_A(bufoff, a2, gcur, h, koff); } while (0)
      G_LDB(B0, 0, 0); G_SCHED; G_LDA(At, 0, 0); G_STAGE_A(G_SA(1, 1), cA, gcur, 1, k1);
      G_WAIT_L(8); G_BAR; G_WAIT_L(0); G_MMA(0, 0, At, B0); G_BAR; G_SCHED;
      G_LDB(B1, 0, 1); G_STAGE(G_SB(0, 0), b2, voffB);
      G_BAR; G_WAIT_L(0); G_MMA(0, 1, At, B1); G_BAR;
      G_LDA(At, 0, 1); G_STAGE_A2(G_SA(0, 0), 0, ka2);
      G_BAR; G_WAIT_L(0); G_MMA(1, 0, At, B0); G_BAR; G_SCHED;
      G_STAGE(G_SB(0, 1), b2 + hstepB, voffB);
      G_WAIT_V(6); G_BAR; G_MMA(1, 1, At, B1); G_BAR;
      G_LDB(B0, 1, 0); G_SCHED; G_LDA(At, 1, 0); G_STAGE_A2(G_SA(0, 1), 1, ka2);
      G_WAIT_L(8); G_BAR; G_WAIT_L(0); G_MMA(0, 0, At, B0); G_BAR; G_SCHED;
      G_LDB(B1, 1, 1); G_STAGE(G_SB(1, 0), b3, voffB);
      G_BAR; G_WAIT_L(0); G_MMA(0, 1, At, B1); G_BAR;
      G_LDA(At, 1, 1); G_STAGE_A2(G_SA(1, 0), 0, ka3);
      G_BAR; G_WAIT_L(0); G_MMA(1, 0, At, B0); G_BAR; G_SCHED;
      G_STAGE(G_SB(1, 1), b3 + hstepB, voffB);
      G_WAIT_V(6); G_BAR; G_MMA(1, 1, At, B1); G_BAR;
      if (GATHER && last) {
#pragma unroll
        for (int h = 0; h < 2; ++h)
#pragma unroll
          for (int i = 0; i < 2; ++i) gcur[h][i] = gN[h][i];
      }
#undef G_STAGE_A2
    }
    G_SCHED;
    if (F8) {
      asm volatile("s_nop 15\n\ts_nop 15" ::: "memory");
#pragma unroll
      for (int a_ = 0; a_ < 2; ++a_)
#pragma unroll
        for (int b_ = 0; b_ < 2; ++b_)
#pragma unroll
          for (int m_ = 0; m_ < 4; ++m_)
#pragma unroll
            for (int n_ = 0; n_ < 2; ++n_) asm volatile("" : "+v"(acc[a_][b_][m_][n_]));
    }
    E(acc, cur, wr, wc, fr, fq);
    G_SCHED;
    if (!has_next) break;
    cur = nxt; cA = nA; cB = nB; ++ui;
    E.init(acc, cur, wr, wc, fr, fq);
  }
  G_WAIT_V(0);
  if (wr == 0) G_BAR;
  G_BAR;
#undef G_SA
#undef G_SB
#undef G_STAGE
#undef G_DMA
#undef G_STAGE_A
#undef G_LDA
#undef G_LDB
#undef G_MMA
#undef G_WAIT_V
#undef G_WAIT_L
#undef G_BAR
#undef G_SCHED
}

DEVI unsigned uoff(unsigned x) { return (unsigned)__builtin_amdgcn_readfirstlane((int)x); }
DEVI bool tile_order(int i, int G, int c, int nM, int nN, int& pm, int& pn) {
  const int nwg = nM * nN;
  const long L = (long)i * G + c; if (L >= nwg) return false;
  int wgid = (int)L; { const int q = nwg / 8, r = nwg % 8, xcd = wgid % 8, off = wgid / 8; wgid = (xcd < r ? xcd * (q + 1) : r * (q + 1) + (xcd - r) * q) + off; }
  const int WGM = 8;
  const int nig = WGM * nN, gid = wgid / nig, fm = gid * WGM, gsz = (nM - fm) < WGM ? (nM - fm) : WGM;
  pm = fm + ((wgid % nig) % gsz); pn = (wgid % nig) / gsz;
  pm = __builtin_amdgcn_readfirstlane(pm); pn = __builtin_amdgcn_readfirstlane(pn);
  return true;
}
struct EpiRawBf16 {
  u16* O; int ldc; float sc;
  DEVI void init(f32x4 (&acc)[2][2][4][2], const Unit&, int, int, int, int) const { acc_zero(acc); }
  DEVI void operator()(const f32x4 (&acc)[2][2][4][2], const Unit& u, int wr, int wc, int fr, int fq) const {
    const unsigned off0 = ((unsigned)(u.u0 + wr * 64 + fr) * (unsigned)ldc + (unsigned)(u.u1 + wc * 32 + 8 * fq)) * 2u;
#pragma unroll
    for (int ai = 0; ai < 2; ++ai)
#pragma unroll
      for (int m = 0; m < 4; ++m) {
        char* rowp = (char*)O + (off0 + (unsigned)(ai * HALF + m * 16) * (unsigned)ldc * 2u);
#pragma unroll
        for (int bj = 0; bj < 2; ++bj) {
          const f32x4 v0 = acc[ai][bj][m][0], v1 = acc[ai][bj][m][1];
          u32x4 w; w.x = pk2(v0[0], v0[1]); w.y = pk2(v0[2], v0[3]); w.z = pk2(v1[0], v1[1]); w.w = pk2(v1[2], v1[3]);
          *(u32x4*)(rowp + bj * HALF * 2) = w;
        }
      }
  }
};

struct EpiRawF8 {
  unsigned char* O; int ldc; float sc;
  DEVI void init(f32x4 (&acc)[2][2][4][2], const Unit&, int, int, int, int) const { acc_zero(acc); }
  DEVI void operator()(const f32x4 (&acc)[2][2][4][2], const Unit& u, int wr, int wc, int fr, int fq) const {
    const unsigned off0 = (unsigned)(u.u0 + wr * 64 + fr) * (unsigned)ldc + (unsigned)(u.u1 + wc * 32 + 8 * fq);
#pragma unroll
    for (int ai = 0; ai < 2; ++ai)
#pragma unroll
      for (int m = 0; m < 4; ++m) {
        unsigned char* rowp = O + (off0 + (unsigned)(ai * HALF + m * 16) * (unsigned)ldc);
#pragma unroll
        for (int bj = 0; bj < 2; ++bj) {
          u32x2 w;
#pragma unroll
          for (int n = 0; n < 2; ++n) {
            const f32x4 v = acc[ai][bj][m][n] * sc;
            int q = __builtin_amdgcn_cvt_pk_fp8_f32(__builtin_amdgcn_fmed3f(v[0], -448.f, 448.f), __builtin_amdgcn_fmed3f(v[1], -448.f, 448.f), 0, false);
            q = __builtin_amdgcn_cvt_pk_fp8_f32(__builtin_amdgcn_fmed3f(v[2], -448.f, 448.f), __builtin_amdgcn_fmed3f(v[3], -448.f, 448.f), q, true);
            w[n] = (unsigned)q;
          }
          *(u32x2*)(rowp + bj * HALF) = w;
        }
      }
  }
};
DEVI size_t z8_block(int pm, int branch, int cb) { return (size_t)((pm * 4 + branch) * 8 + cb) * 32768; }
struct EpiZ8 {
  unsigned char* O;
  DEVI void init(f32x4 (&acc)[2][2][4][2], const Unit&, int, int, int, int) const { acc_zero(acc); }
  DEVI void operator()(const f32x4 (&acc)[2][2][4][2], const Unit& u, int wr, int wc, int fr, int fq) const {
    const int pm = u.u0 >> 8, pn = u.u1 >> 8, n = pn >> 2, cq = pn & 3;
    const unsigned lw16 = (unsigned)((wr * 4 + wc) * 64 + fr + 16 * fq) * 16u;
#pragma unroll
    for (int bj = 0; bj < 2; ++bj) {
      unsigned char* blk = O + z8_block(pm, n, cq * 2 + bj) + lw16;
#pragma unroll
      for (int P = 0; P < 4; ++P) {
        u32x4 w;
#pragma unroll
        for (int h = 0; h < 2; ++h)
#pragma unroll
          for (int nn = 0; nn < 2; ++nn) {
            const int g = 2 * P + h;
            const f32x4 v = acc[g >> 2][bj][g & 3][nn];
            int q = __builtin_amdgcn_cvt_pk_fp8_f32(__builtin_amdgcn_fmed3f(v[0], -448.f, 448.f), __builtin_amdgcn_fmed3f(v[1], -448.f, 448.f), 0, false);
            q = __builtin_amdgcn_cvt_pk_fp8_f32(__builtin_amdgcn_fmed3f(v[2], -448.f, 448.f), __builtin_amdgcn_fmed3f(v[3], -448.f, 448.f), q, true);
            w[2 * h + nn] = (unsigned)q;
          }
        *(u32x4*)(blk + P * 8192) = w;
      }
    }
  }
};
struct SchedB { const char* ws; const char* h8; int G, c;
  DEVI bool next(int i, Unit& u) const { int pm, pn; if (!tile_order(i, G, c, NTOK / 256, INP / 256, pm, pn)) return false;
    u.A = h8 + uoff((unsigned)pm * 256u * 1024u); u.B = ws + OFF_WIN + uoff((unsigned)pn * 256u * 1024u);        u.rows = nullptr; u.nvalid = 0; u.u0 = pm * 256; u.u1 = pn * 256; u.u2 = 0; u.u3 = 0; return true; } };
struct EpiB { u16* O; float* ssq;
  DEVI void init(f32x4 (&acc)[2][2][4][2], const Unit&, int, int, int, int) const { acc_zero(acc); }
  DEVI void operator()(const f32x4 (&acc)[2][2][4][2], const Unit& u, int wr, int wc, int fr, int fq) const {
    EpiRawBf16 E{O, PLD, 1.f}; E(acc, u, wr, wc, fr, fq);
    if (u.u1 < 512) {
      const bool iskv = u.u1 != 0;
#pragma unroll
      for (int ai = 0; ai < 2; ++ai)
#pragma unroll
        for (int m = 0; m < 4; ++m) {
          float ss = 0.f;
#pragma unroll
          for (int bj = 0; bj < 2; ++bj)
#pragma unroll
            for (int n = 0; n < 2; ++n)
#pragma unroll
              for (int j = 0; j < 4; ++j) { const float v = acc[ai][bj][m][n][j]; if (!(iskv && bj == 1)) ss += v * v; }
          ss += __shfl_xor(ss, 16); ss += __shfl_xor(ss, 32);
          if (fq == 0) ssq[(size_t)(u.u0 + ai * HALF + wr * 64 + m * 16 + fr) * 8 + (iskv ? 4 : 0) + wc] = ss;
        }
    }
  }
};
DEVI void phaseB2(KP p, ldsp_t lds) {
  SchedB S{(const char*)p->ws, (const char*)h8base(p), (int)gridDim.x, BIDX};
  EpiB E{wsp<u16>(p, OFF_PRAW), wsp<float>(p, OFF_SSQ)};
  gemm_phase<true, false, true>(lds, 1024, 1024, 8, S, E);
}
struct SchedC { const char* ws; int G, c;
  DEVI bool next(int i, Unit& u) const { int pm, pn; if (!tile_order(i, G, c, NTOK / 256, 4, pm, pn)) return false;
    const bool kv = pn >= 2; const int pj = pn & 1;
    u.A = ws + OFF_PRAW + uoff((unsigned)pm * 256u * (unsigned)(PLD * 2) + (kv ? 512u : 0u)); u.B = ws + (kv ? OFF_WKVB : OFF_WQB) + uoff((unsigned)pj * 256u * 512u); u.rows = nullptr; u.nvalid = 0;
    u.u0 = pm * 256; u.u1 = pj * 256; u.u2 = kv; u.u3 = 0; return true; } };
struct EpiC { u16* Oq; u16* Okv; const float* ssq;
  DEVI void init(f32x4 (&acc)[2][2][4][2], const Unit&, int, int, int, int) const { acc_zero(acc); }
  DEVI void operator()(const f32x4 (&acc)[2][2][4][2], const Unit& u, int wr, int wc, int fr, int fq) const {
    const bool kv = u.u2 != 0;
    u16* O = kv ? Okv : Oq;
    const int row0 = u.u0 + wr * 64 + fr, col0 = u.u1 + wc * 32 + 8 * fq;
    f32x4 sq[2][4];
#pragma unroll
    for (int ai = 0; ai < 2; ++ai)
#pragma unroll
      for (int m = 0; m < 4; ++m) sq[ai][m] = *(const f32x4*)(ssq + (size_t)(row0 + ai * HALF + m * 16) * 8 + (kv ? 4 : 0));
#pragma unroll
    for (int ai = 0; ai < 2; ++ai)
#pragma unroll
      for (int m = 0; m < 4; ++m) {
        const size_t r = (size_t)(row0 + ai * HALF + m * 16);
        const float tot = sq[ai][m].x + sq[ai][m].y + sq[ai][m].z + sq[ai][m].w;
        const float sc = kv ? rsqrtf(tot * (1.f / 128.f) + EPS) : rsqrtf(tot * (1.f / 256.f) + EPS) * (0.10206207261596575f * LOG2E);
        u16* rowp = O + r * 512 + col0;
#pragma unroll
        for (int bj = 0; bj < 2; ++bj) {
          const f32x4 v0 = acc[ai][bj][m][0] * sc, v1 = acc[ai][bj][m][1] * sc;
          u32x4 w; w.x = pk2(v0[0], v0[1]); w.y = pk2(v0[2], v0[3]); w.z = pk2(v1[0], v1[1]); w.w = pk2(v1[2], v1[3]);
          *(u32x4*)(rowp + bj * HALF) = w;
        }
      }
  }
};
DEVI void phaseC2(KP p, ldsp_t lds) {
  SchedC S{(const char*)p->ws, (int)gridDim.x, BIDX};
  EpiC E{wsp<u16>(p, OFF_QARAW), wsp<u16>(p, OFF_KVARAW), wsp<float>(p, OFF_SSQ)};
  int nt = 4; asm volatile("" : "+s"(nt));
  gemm_phase<true, false, false>(lds, PLD * 2, 512, nt, S, E);
}

DEVI void ld16(const u16* src, float (&v)[16]) {
  const u32x4 a = *(const u32x4*)src, b = *(const u32x4*)(src + 8);
  const unsigned w[8] = {a.x, a.y, a.z, a.w, b.x, b.y, b.z, b.w};
#pragma unroll
  for (int i = 0; i < 8; ++i) { v[2 * i] = __uint_as_float(w[i] << 16); v[2 * i + 1] = __uint_as_float(w[i] & 0xffff0000u); }
}
DEVI void st16(u16* dst, const float (&v)[16]) {
  u32x4 a, b;
  a.x = pk2(v[0], v[1]); a.y = pk2(v[2], v[3]); a.z = pk2(v[4], v[5]); a.w = pk2(v[6], v[7]);
  b.x = pk2(v[8], v[9]); b.y = pk2(v[10], v[11]); b.z = pk2(v[12], v[13]); b.w = pk2(v[14], v[15]);
  *(u32x4*)dst = a; *(u32x4*)(dst + 8) = b;
}
DEVI void rope16c(float (&v)[16], const float* cs16, int pos) {
  const f32x2* t = (const f32x2*)(cs16 + pos * 16);
#pragma unroll
  for (int i = 0; i < 8; ++i) { const f32x2 cs = t[i]; const float x1 = v[i], x2 = v[8 + i]; v[i] = x1 * cs.x - x2 * cs.y; v[8 + i] = x2 * cs.x + x1 * cs.y; }
}
DEVI void rope32c(float (&lo)[16], float (&hi)[16], const float* cs32, int pos) {
  const f32x2* t = (const f32x2*)(cs32 + pos * 32);
#pragma unroll
  for (int i = 0; i < 16; ++i) { const f32x2 cs = t[i]; const float x1 = lo[i], x2 = hi[i]; lo[i] = x1 * cs.x - x2 * cs.y; hi[i] = x2 * cs.x + x1 * cs.y; }
}
DEVI float ssq16(const float (&v)[16]) { float s = 0.f;
#pragma unroll
  for (int i = 0; i < 16; ++i) s += v[i] * v[i];
  return s; }
DEVI void scale16(float (&v)[16], float s) {
#pragma unroll
  for (int i = 0; i < 16; ++i) v[i] *= s; }
DEVI void cvt16(const u32x4 a, const u32x4 b, float (&v)[16]) {
  const unsigned w[8] = {a.x, a.y, a.z, a.w, b.x, b.y, b.z, b.w};
#pragma unroll
  for (int i = 0; i < 8; ++i) { v[2 * i] = __uint_as_float(w[i] << 16); v[2 * i + 1] = __uint_as_float(w[i] & 0xffff0000u); }
}
DEVI void phaseP2(KP p, int l, ldsp_t lds) {
  const int tid = TIDX, tk = tid >> 3, pt = tid & 7;
  u16* PR = wsp<u16>(p, OFF_PRAW);
  u16* QA = wsp<u16>(p, OFF_QARAW);
  const float* cs32 = wsp<float>(p, OFF_CS32);
  const float* cs16 = wsp<float>(p, OFF_CS16);
  const float QS = 0.125f * LOG2E;
  for (int item = BIDX; item < NTOK / 64; item += gridDim.x) {
    const int tok0 = item * 64, rr0 = tok0 % TPB;
    const bool lat = rr0 >= NCTX;
    const size_t tok = (size_t)tok0 + tk;
    const int t = rr0 + tk - NCTX, grow = (t >> 6) & 63, gcol = t & 63;
    u16* pr = PR + tok * PLD;
    u16* qar = QA + tok * 512 + 96 * (pt >> 1) + 64 + 16 * (pt & 1);
    const int g4 = pt & 3;
    u32x4 r_qa[2], r_kr[2], r_qb[4], r_kb[4], r_qd[4], r_kd[4];
#define LD8(ptr) (*(const u32x4*)(ptr))
    if (lat) {
#pragma unroll
      for (int i = 0; i < 2; ++i) { r_qa[i] = LD8(qar + 8 * i); r_kr[i] = LD8(pr + 384 + 16 * (pt & 1) + 8 * i); }
#pragma unroll
      for (int i = 0; i < 4; ++i) { r_qb[i] = LD8(pr + 512 + 32 * pt + 8 * i); r_kb[i] = LD8(pr + 768 + 32 * g4 + 8 * i); }
    }
#pragma unroll
    for (int i = 0; i < 4; ++i) { r_qd[i] = LD8(pr + 1792 + 32 * pt + 8 * i); r_kd[i] = LD8(pr + 2048 + 32 * g4 + 8 * i); }
#undef LD8
    if (lat) {
      { float v[16]; cvt16(r_qa[0], r_qa[1], v); rope16c(v, cs16, (pt & 1) ? gcol : grow); st16(qar, v); }
      if (pt < 2) { float v[16]; cvt16(r_kr[0], r_kr[1], v); rope16c(v, cs16, pt == 0 ? grow : gcol); st16(pr + 384 + 16 * pt, v); }
      { float lo[16], hi[16]; cvt16(r_qb[0], r_qb[1], lo); cvt16(r_qb[2], r_qb[3], hi); rope32c(lo, hi, cs32, (pt & 1) ? gcol : grow); st16(pr + 512 + 32 * pt, lo); st16(pr + 512 + 32 * pt + 16, hi); }
      if (pt < 4) { float lo[16], hi[16]; cvt16(r_kb[0], r_kb[1], lo); cvt16(r_kb[2], r_kb[3], hi); rope32c(lo, hi, cs32, (pt & 1) ? gcol : grow); st16(pr + 768 + 32 * pt, lo); st16(pr + 768 + 32 * pt + 16, hi); }
    }
    {
      float lo[16], hi[16]; cvt16(r_qd[0], r_qd[1], lo); cvt16(r_qd[2], r_qd[3], hi);
      float ss = ssq16(lo) + ssq16(hi); ss += __shfl_xor(ss, 1);
      const float rs = rsqrtf(ss * (1.f / 64.f) + EPS);
      const float* g = p->g_q_d + l * 64 + 32 * (pt & 1);
#pragma unroll
      for (int i = 0; i < 16; ++i) { lo[i] *= rs * g[i]; hi[i] *= rs * g[16 + i]; }
      if (lat) rope32c(lo, hi, cs32, (pt & 1) ? gcol : grow);
      scale16(lo, QS); scale16(hi, QS);
      st16(pr + 1792 + 32 * pt, lo); st16(pr + 1792 + 32 * pt + 16, hi);
    }
    {
      float lo[16], hi[16]; cvt16(r_kd[0], r_kd[1], lo); cvt16(r_kd[2], r_kd[3], hi);
      float ss = ssq16(lo) + ssq16(hi); ss += __shfl_xor(ss, 1);
      const float rs = rsqrtf(ss * (1.f / 64.f) + EPS);
      const float* g = p->g_k_d + l * 64 + 32 * (g4 & 1);
#pragma unroll
      for (int i = 0; i < 16; ++i) { lo[i] *= rs * g[i]; hi[i] *= rs * g[16 + i]; }
      if (lat) rope32c(lo, hi, cs32, (g4 & 1) ? gcol : grow);
      if (pt < 4) { st16(pr + 2048 + 32 * g4, lo); st16(pr + 2048 + 32 * g4 + 16, hi); }
    }
  }
}

DEVI void conv_load(const ConvT& c, int lane, f32x4 (&v)[8]) {
  const int kk = lane >> 3, n4 = (lane & 7) * 4;
  const float* sp = (c.src2 && n4 >= 16) ? c.src2 + (n4 - 16) : (c.src ? c.src + n4 : nullptr);
#pragma unroll
  for (int i = 0; i < 8; ++i) v[i] = sp ? *(const f32x4*)(sp + (size_t)(kk + 8 * i) * c.ld) : f32x4{0.f, 0.f, 0.f, 0.f};
}
DEVI void conv_store(const ConvT& c, LAS float* t, int lane, const f32x4 (&v)[8]) {
  const int kk = lane >> 3, n4 = (lane & 7) * 4;
#pragma unroll
  for (int i = 0; i < 8; ++i) {
    const int k = kk + 8 * i;
    const float s = (c.ks ? c.ks[k] : 1.f) * c.mul;
    t[(n4 + 0) * 65 + k] = v[i].x * s; t[(n4 + 1) * 65 + k] = v[i].y * s;
    t[(n4 + 2) * 65 + k] = v[i].z * s; t[(n4 + 3) * 65 + k] = v[i].w * s;
  }
  asm volatile("s_waitcnt lgkmcnt(0)" ::: "memory");
  const int n = lane >> 1, k0 = (lane & 1) * 32;
  const LAS float* r = t + n * 65 + k0;
  if (c.ldd < 0) {
    unsigned char* d8 = (unsigned char*)c.dst + (size_t)n * (size_t)(-c.ldd) + k0;
#pragma unroll
    for (int q = 0; q < 2; ++q) {
      u32x4 o;
#pragma unroll
      for (int w = 0; w < 4; ++w) {
        float f[4];
#pragma unroll
        for (int j = 0; j < 4; ++j) f[j] = __builtin_amdgcn_fmed3f(r[16 * q + 4 * w + j], -448.f, 448.f);
        int v = __builtin_amdgcn_cvt_pk_fp8_f32(f[0], f[1], 0, false);
        v = __builtin_amdgcn_cvt_pk_fp8_f32(f[2], f[3], v, true);
        o[w] = (unsigned)v;
      }
      *(u32x4*)(d8 + 16 * q) = o;
    }
    asm volatile("s_waitcnt lgkmcnt(0)" ::: "memory");
    return;
  }
  u16* d = c.dst + (size_t)n * c.ldd + k0;
#pragma unroll
  for (int q = 0; q < 4; ++q) {
    u32x4 o;
    o.x = pk2(r[8 * q], r[8 * q + 1]); o.y = pk2(r[8 * q + 2], r[8 * q + 3]); o.z = pk2(r[8 * q + 4], r[8 * q + 5]); o.w = pk2(r[8 * q + 6], r[8 * q + 7]);
    *(u32x4*)(d + 8 * q) = o;
  }
  asm volatile("s_waitcnt lgkmcnt(0)" ::: "memory");
}
constexpr int CONV_EARLY = 1152 + 64 + 64;
DEVI void conv_items2(KP p, int l, ldsp_t lds, int first_item, int total_items) {
  const int tid = TIDX, wave = __builtin_amdgcn_readfirstlane(tid >> 6), lane = tid & 63;
  LAS float* t = (LAS float*)(lds + wave * 8448);
  __syncthreads();
  const int stride = gridDim.x * NW;
  int item = first_item + BIDX * NW + wave;
  if (item >= total_items) return;
  ConvT c = conv_decode(p, l, item);
  f32x4 v[8];
  conv_load(c, lane, v);
  for (;;) {
    const int nitem = item + stride;
    const bool more = nitem < total_items;
    ConvT cn = c; f32x4 vn[8];
    if (more) { cn = conv_decode(p, l, nitem); conv_load(cn, lane, vn); }
    conv_store(c, t, lane, v);
    if (!more) break;
    c = cn; item = nitem;
#pragma unroll
    for (int i = 0; i < 8; ++i) v[i] = vn[i];
  }
}
template <int BR>
DEVI void attn_mask(f32x16 (&s)[2], int kt, int qlat, int qrow, int qcol, int hh, LAS float* rpb) {
  if (BR == 1) {
#pragma unroll
    for (int kb = 0; kb < 2; ++kb)
#pragma unroll
      for (int i = 0; i < 16; ++i) {
        const int kpos = kt * 64 + kb * 32 + (i & 3) + 8 * (i >> 2) + 4 * hh;
        const int d = qlat - kpos;
        if (d > 128 || d < -128) s[kb][i] = -1e30f;
      }
  } else {
    const int rs = min(max(qrow - 4, 0), 56);
    const bool row_ok = (kt >= rs) && (kt < rs + 8);
    const int cst = min(max(qcol - 8, 0), 48);
    const int dr = kt - qrow + 7;
#pragma unroll
    for (int kb = 0; kb < 2; ++kb)
#pragma unroll
      for (int i = 0; i < 16; ++i) {
        const int kc = kb * 32 + (i & 3) + 8 * (i >> 2) + 4 * hh;
        const bool ok = row_ok && (kc >= cst) && (kc < cst + 16);
        const int idx = ok ? (dr * 31 + (kc - qcol + 15)) : 0;
        const float bias = rpb[idx];
        s[kb][i] = ok ? (s[kb][i] + bias) : -1e30f;
      }
  }
}

template <int BR>
DEVI void attn_mask1(f32x16& sb, int kb, int kt, int qlat, int qrow, int qcol, int hh, LAS float* rpb) {
  if (BR == 1) {
#pragma unroll
    for (int i = 0; i < 16; ++i) {
      const int kpos = kt * 64 + kb * 32 + (i & 3) + 8 * (i >> 2) + 4 * hh;
      const int d = qlat - kpos;
      if (d > 128 || d < -128) sb[i] = -1e30f;
    }
  } else {
    const int rs = min(max(qrow - 4, 0), 56);
    const bool row_ok = (kt >= rs) && (kt < rs + 8);
    const int cst = min(max(qcol - 8, 0), 48);
    const int dr = kt - qrow + 7;
#pragma unroll
    for (int i = 0; i < 16; ++i) {
      const int kc = kb * 32 + (i & 3) + 8 * (i >> 2) + 4 * hh;
      const bool ok = row_ok && (kc >= cst) && (kc < cst + 16);
      const int idx = ok ? (dr * 31 + (kc - qcol + 15)) : 0;
      const float bias = rpb[idx];
      sb[i] = ok ? (sb[i] + bias) : -1e30f;
    }
  }
}
#define FADD(a, b) do { (a) += (b); asm("" : "+v"(a)); } while (0)
typedef short v4i16_t __attribute__((ext_vector_type(4)));
DEVI bf16x8 vtr2(ldsp_t a) {
  const v4i16_t lo = __builtin_amdgcn_ds_read_tr16_b64_v4i16((LAS v4i16_t*)a);
  const v4i16_t hi = __builtin_amdgcn_ds_read_tr16_b64_v4i16((LAS v4i16_t*)(a + 8 * 144));
  return __builtin_shufflevector(lo, hi, 0, 1, 2, 3, 4, 5, 6, 7);
}
DEVI bf16x8 vtr2s(ldsp_t a, int o0, int o1) {
  const v4i16_t lo = __builtin_amdgcn_ds_read_tr16_b64_v4i16((LAS v4i16_t*)(a + o0));
  const v4i16_t hi = __builtin_amdgcn_ds_read_tr16_b64_v4i16((LAS v4i16_t*)(a + 8 * 128 + o1));
  return __builtin_shufflevector(lo, hi, 0, 1, 2, 3, 4, 5, 6, 7);
}
template <int BR, bool FAST>
DEVI bool attn_item2(KP p, int l, int b, int hs, int qb, bool isctx, ldsp_t lds) {
  constexpr bool MLA = (BR == 0);
  constexpr bool GQA = (BR == 1 || BR == 3);
  constexpr int QBLK = GQA ? 256 : 512;
  constexpr int NKS = MLA ? 6 : 4;
  constexpr int STG = 8192 + 8192 + 4096;
  const int tid = TIDX, lane = tid & 63, wave = __builtin_amdgcn_readfirstlane(tid >> 6);
  const int r32 = lane & 31, hh = lane >> 5;
  const int hq = GQA ? (hs * 2 + (wave & 1)) : hs;
  const int woff = GQA ? 64 * (wave >> 1) : 64 * wave;
  const int q0 = (isctx ? 0 : NCTX) + qb * QBLK;
  const bool active = !isctx || (woff < NCTX);
  const size_t tokq = (size_t)b * TPB + q0 + (active ? woff : 0) + r32;
  const u16* Qp; const u16* Kp; int ldk; const u16* Vp; int ldv; int obase; int ldq;
  const u16* PR = wsp<u16>(p, OFF_PRAW);
  if (BR == 0) { Qp = wsp<u16>(p, OFF_QARAW) + tokq * 512 + hq * 96; ldq = 512; Kp = wsp<u16>(p, OFF_KVARAW) + (size_t)b * TPB * 512 + hs * 128; ldk = 512; Vp = wsp<u16>(p, OFF_KVARAW) + (size_t)b * TPB * 512 + hs * 128 + 64; ldv = 512; obase = hq * 64; }
  else if (BR == 1) { Qp = PR + tokq * PLD + 512 + hq * 64; ldq = PLD; Kp = PR + (size_t)b * TPB * PLD + 768 + hs * 64; ldk = PLD; Vp = PR + (size_t)b * TPB * PLD + 896 + hs * 64; ldv = PLD; obase = 256 + hq * 64; }
  else if (BR == 2) { Qp = PR + tokq * PLD + 1024 + hq * 64; ldq = PLD; Kp = PR + (size_t)b * TPB * PLD + 1280 + hs * 64; ldk = PLD; Vp = PR + (size_t)b * TPB * PLD + 1536 + hs * 64; ldv = PLD; obase = 512 + hq * 64; }
  else { Qp = PR + tokq * PLD + 1792 + hq * 64; ldq = PLD; Kp = PR + (size_t)b * TPB * PLD + 2048 + hs * 64; ldk = PLD; Vp = PR + (size_t)b * TPB * PLD + 2176 + hs * 64; ldv = PLD; obase = 768 + hq * 64; }
  const u16* KRp = PR + (size_t)b * TPB * PLD + 384;
  int lat_lo = 0, lat_n = 0, wlo = 0, whi = 63;
  if (!isctx) {
    if (BR == 0 || BR == 3) { lat_lo = 0; lat_n = 64; }
    else if (BR == 1) {
      const int ql = qb * QBLK; const int lo = max(0, ql - 128) >> 6, hi = min(SEQ - 1, ql + QBLK - 1 + 128) >> 6; lat_lo = lo; lat_n = hi - lo + 1;
      const int wq = ql + woff; wlo = max(0, wq - 128) >> 6; whi = min(SEQ - 1, wq + 63 + 128) >> 6;
    } else {
      const int r0 = 8 * qb; const int lo = min(max(r0 - 4, 0), 56), hi = min(max(r0 + 7 - 4, 0), 56) + 7; lat_lo = lo; lat_n = hi - lo + 1;
      const int wr_ = r0 + wave; wlo = min(max(wr_ - 4, 0), 56); whi = wlo + 7;
    }
  }
  const int NT = 4 + lat_n;
  const int qlat0 = qb * QBLK + woff + r32;
  bf16x8 qf[2][NKS];
#pragma unroll
  for (int qi = 0; qi < 2; ++qi)
#pragma unroll
    for (int ks = 0; ks < NKS; ++ks) qf[qi][ks] = *(const bf16x8*)(Qp + (size_t)qi * 32 * ldq + ks * 16 + hh * 8);
  const int drow = 8 * wave + (lane >> 3), dch = (lane & 7) ^ ((drow >> 1) & 7);
  const int rrow = 16 * (wave & 3) + (lane >> 2), rch = (lane & 3) ^ ((rrow >> 2) & 3);
  auto keytile = [&](int j) { return (j < 4) ? j : (4 + lat_lo + (j - 4)); };
#define DMA16(sbase, voff, ldsaddr) asm volatile("s_mov_b32 m0, %2\n\ts_nop 0\n\tglobal_load_lds_dwordx4 %0, %1" :: "v"(voff), "s"(sbase), "s"(ldsaddr) : "memory", "m0")
#define A_DMA(j, st) do { const int key0_ = keytile(j) * 64; const unsigned base_ = __builtin_amdgcn_readfirstlane((unsigned)(size_t)(lds + (st) * STG) + wave * 1024); \
    DMA16(Kp, (unsigned)(((key0_ + drow) * ldk + dch * 8) * 2), base_); \
    DMA16(Vp, (unsigned)(((key0_ + drow) * ldv + dch * 8) * 2), base_ + 8192u); \
    if (MLA && wave < 4) DMA16(KRp, (unsigned)(((key0_ + rrow) * PLD + rch * 8) * 2), __builtin_amdgcn_readfirstlane(base_ + 16384u)); \
  } while (0)
  LAS float* rpb = (LAS float*)(lds + 2 * STG);
  __syncthreads();
  if (FAST && tid == 0) *(LAS int*)(lds + 2 * STG + 2048) = 0;
  A_DMA(0, 0);
  if (BR == 2 && !isctx) {
    const float* src = p->rpb_c + (size_t)(l * 4 + hs) * 465;
    for (int i = tid; i < 465; i += 512) rpb[i] = src[i] * LOG2E;
  }
  asm volatile("s_waitcnt vmcnt(0)" ::: "memory");
#pragma unroll
  for (int qi = 0; qi < 2; ++qi)
#pragma unroll
    for (int ks = 0; ks < NKS; ++ks) asm volatile("" : "+v"(qf[qi][ks]));
  __syncthreads();
  f32x16 o[2][2];
#pragma unroll
  for (int qi = 0; qi < 2; ++qi)
#pragma unroll
    for (int i = 0; i < 16; ++i) { o[qi][0][i] = 0.f; o[qi][1][i] = 0.f; }
  float m_run[2], l_run[2];
#pragma unroll
  for (int qi = 0; qi < 2; ++qi) { m_run[qi] = -INFINITY; l_run[qi] = 0.f; }
  if (BR == 1) { const float sk = p->sink_b[l * 4 + hq] * LOG2E; m_run[0] = sk; m_run[1] = sk; l_run[0] = (hh == 0) ? (FAST ? __builtin_amdgcn_exp2f(sk) : 1.f) : 0.f; l_run[1] = l_run[0]; }
  float l2[2][2];
#pragma unroll
  for (int qi = 0; qi < 2; ++qi) { l2[qi][0] = l_run[qi]; l2[qi][1] = 0.f; }
  const int kkey = (r32 >> 1) & 7, rkey = (r32 >> 2) & 3;
  const ldsp_t kfb = lds + r32 * 128;
  const ldsp_t krb = lds + 16384 + r32 * 64;
  const int vq = (lane & 15) >> 2, vkey = 2 * hh + (vq >> 1);
  const int vch = 2 * ((lane >> 4) & 1) + ((lane & 3) >> 1);
  const ldsp_t vfb = lds + 8192 + (4 * hh + vq) * 128 + 8 * (lane & 1);
#define SB() __builtin_amdgcn_sched_barrier(0)
#define KLOAD(kb, ks) (((ks) < 4) ? *(const LAS bf16x8*)(kfb + st + (kb) * 4096 + (((2 * (ks) + hh) ^ kkey) << 4)) : *(const LAS bf16x8*)(krb + st + (kb) * 2048 + (((2 * ((ks) - 4) + hh) ^ rkey) << 4)))
#define VLOAD(s4, db) vtr2s(vfb + st + (s4) * 2048, ((4 * (db) + vch) ^ vkey) << 4, ((4 * (db) + vch) ^ vkey ^ 4) << 4)
#define SM_EL(kb, e) do { const int qi_ = (e) >> 4, i_ = (e) & 15; \
    const float x_ = __builtin_amdgcn_exp2f(s[qi_][kb][i_]); s[qi_][kb][i_] = x_; FADD(l2[qi_][i_ & 1], x_); \
    if (i_ & 1) pw[kb][qi_][i_ >> 3][(i_ & 7) >> 1] = pk2(s[qi_][kb][i_ - 1], x_); } while (0)
#define F_STEP(j) do { \
    const int st = ((j) & 1) * STG; \
    if ((j) + 1 < NT) A_DMA((j) + 1, ((j) + 1) & 1); \
    const int kt_ = lat_lo + (j) - 4; \
    const bool need = active && ((j) < 4 || (kt_ >= wlo && kt_ <= whi)); \
    if (need) { \
      f32x16 s[2][2]; bf16x8 kf[NKS]; bf16x8 vf[4]; u32x4 pw[2][2][2]; \
      const f32x16 zero16 = {0.f, 0.f, 0.f, 0.f, 0.f, 0.f, 0.f, 0.f, 0.f, 0.f, 0.f, 0.f, 0.f, 0.f, 0.f, 0.f}; \
      const bool domask = (BR == 1 || BR == 2) && (j) >= 4; \
      _Pragma("unroll") for (int ks = 0; ks < NKS; ++ks) kf[ks] = KLOAD(0, ks); \
      _Pragma("unroll") for (int ks = 0; ks < NKS; ++ks) { \
        s[0][0] = MFMA(kf[ks], qf[0][ks], ks == 0 ? zero16 : s[0][0]); s[1][0] = MFMA(kf[ks], qf[1][ks], ks == 0 ? zero16 : s[1][0]); \
        SB(); kf[ks] = KLOAD(1, ks); SB(); } \
      if (domask) { _Pragma("unroll") for (int qi = 0; qi < 2; ++qi) { const int ql_ = qlat0 + 32 * qi; attn_mask1<BR>(s[qi][0], 0, kt_, ql_, ql_ >> 6, ql_ & 63, hh, rpb); } } \
      _Pragma("unroll") for (int m = 0; m < 2 * NKS; ++m) { \
        s[m & 1][1] = MFMA(kf[m >> 1], qf[m & 1][m >> 1], (m >> 1) == 0 ? zero16 : s[m & 1][1]); \
        if (m < 4) vf[m] = VLOAD(m >> 1, m & 1); \
        _Pragma("unroll") for (int e = (m * 32) / (2 * NKS); e < ((m + 1) * 32) / (2 * NKS); ++e) SM_EL(0, e); \
        SB(); } \
      if (domask) { _Pragma("unroll") for (int qi = 0; qi < 2; ++qi) { const int ql_ = qlat0 + 32 * qi; attn_mask1<BR>(s[qi][1], 1, kt_, ql_, ql_ >> 6, ql_ & 63, hh, rpb); } } \
      _Pragma("unroll") for (int m = 0; m < 8; ++m) { \
        o[m & 1][(m >> 1) & 1] = MFMA(vf[m >> 1], __builtin_bit_cast(bf16x8, pw[0][m & 1][m >> 2]), o[m & 1][(m >> 1) & 1]); \
        if (m & 1) { SB(); vf[m >> 1] = VLOAD(2 + (m >> 2), (m >> 1) & 1); } \
        _Pragma("unroll") for (int e = 4 * m; e < 4 * m + 4; ++e) SM_EL(1, e); \
        SB(); } \
      _Pragma("unroll") for (int m = 0; m < 8; ++m) \
        o[m & 1][(m >> 1) & 1] = MFMA(vf[m >> 1], __builtin_bit_cast(bf16x8, pw[1][m & 1][m >> 2]), o[m & 1][(m >> 1) & 1]); \
    } \
    asm volatile("s_waitcnt vmcnt(0)" ::: "memory"); \
    __syncthreads(); \
  } while (0)
#define A_STEP(j) do { \
    const int st = ((j) & 1) * STG; \
    if ((j) + 1 < NT) A_DMA((j) + 1, ((j) + 1) & 1); \
    const int kt_ = lat_lo + (j) - 4; \
    const bool need = active && ((j) < 4 || (kt_ >= wlo && kt_ <= whi)); \
    if (need) { \
      f32x16 s[2][2]; \
      _Pragma("unroll") for (int kb = 0; kb < 2; ++kb) { \
        _Pragma("unroll") for (int ks = 0; ks < 4; ++ks) { const bf16x8 kf = *(const LAS bf16x8*)(kfb + st + kb * 4096 + (((2 * ks + hh) ^ kkey) << 4)); \
          _Pragma("unroll") for (int qi = 0; qi < 2; ++qi) { if (ks == 0) { _Pragma("unroll") for (int i = 0; i < 16; ++i) s[qi][kb][i] = 0.f; } s[qi][kb] = MFMA(kf, qf[qi][ks], s[qi][kb]); } } \
        if (MLA) { _Pragma("unroll") for (int ks = 0; ks < 2; ++ks) { const bf16x8 kf = *(const LAS bf16x8*)(krb + st + kb * 2048 + (((2 * ks + hh) ^ rkey) << 4)); \
          _Pragma("unroll") for (int qi = 0; qi < 2; ++qi) s[qi][kb] = MFMA(kf, qf[qi][NKS - 2 + ks], s[qi][kb]); } } \
      } \
      if (FAST) __builtin_amdgcn_sched_barrier(0); \
      _Pragma("unroll") for (int qi = 0; qi < 2; ++qi) { \
        if ((BR == 1 || BR == 2) && (j) >= 4) { const int ql_ = qlat0 + 32 * qi; attn_mask<BR>(s[qi], kt_, ql_, ql_ >> 6, ql_ & 63, hh, rpb); } \
        if (FAST) { \
          float ls0 = 0.f, ls1 = 0.f; \
          _Pragma("unroll") for (int i = 0; i < 16; ++i) { \
            const float e0 = __builtin_amdgcn_exp2f(s[qi][0][i]), e1 = __builtin_amdgcn_exp2f(s[qi][1][i]); \
            s[qi][0][i] = e0; s[qi][1][i] = e1; FADD(ls0, e0); FADD(ls1, e1); } \
          l_run[qi] += ls0 + ls1; \
        } else { \
        float mx = s[qi][0][0]; \
        _Pragma("unroll") for (int i = 1; i < 16; ++i) mx = fmaxf(mx, s[qi][0][i]); \
        _Pragma("unroll") for (int i = 0; i < 16; ++i) mx = fmaxf(mx, s[qi][1][i]); \
        mx = fmaxf(mx, __shfl_xor(mx, 32)); \
        const float m_new = fmaxf(m_run[qi], mx); \
        const float alpha = __builtin_amdgcn_exp2f(m_run[qi] - m_new); \
        m_run[qi] = m_new; \
        float ls0 = 0.f, ls1 = 0.f; \
        _Pragma("unroll") for (int i = 0; i < 16; ++i) { \
          const float e0 = __builtin_amdgcn_exp2f(s[qi][0][i] - m_new), e1 = __builtin_amdgcn_exp2f(s[qi][1][i] - m_new); \
          s[qi][0][i] = e0; s[qi][1][i] = e1; ls0 += e0; ls1 += e1; } \
        l_run[qi] = l_run[qi] * alpha + (ls0 + ls1); \
        if (__any(alpha != 1.f)) { _Pragma("unroll") for (int i = 0; i < 16; ++i) { o[qi][0][i] *= alpha; o[qi][1][i] *= alpha; } } \
        } \
      } \
      _Pragma("unroll") for (int s4 = 0; s4 < 4; ++s4) { \
        const int kb = s4 >> 1, rb = (s4 & 1) * 8; \
        bf16x8 pf[2]; \
        _Pragma("unroll") for (int qi = 0; qi < 2; ++qi) { u32x4 pw; \
          pw.x = pk2(s[qi][kb][rb + 0], s[qi][kb][rb + 1]); pw.y = pk2(s[qi][kb][rb + 2], s[qi][kb][rb + 3]); \
          pw.z = pk2(s[qi][kb][rb + 4], s[qi][kb][rb + 5]); pw.w = pk2(s[qi][kb][rb + 6], s[qi][kb][rb + 7]); \
          pf[qi] = __builtin_bit_cast(bf16x8, pw); } \
        _Pragma("unroll") for (int db = 0; db < 2; ++db) { const bf16x8 vf = vtr2s(vfb + st + s4 * 2048, ((4 * db + vch) ^ vkey) << 4, ((4 * db + vch) ^ vkey ^ 4) << 4); \
          o[0][db] = MFMA(vf, pf[0], o[0][db]); o[1][db] = MFMA(vf, pf[1], o[1][db]); } \
      } \
    } \
    asm volatile("s_waitcnt vmcnt(0)" ::: "memory");        \
    __syncthreads(); \
  } while (0)
  if (FAST) {
    if (wave >= 4) __builtin_amdgcn_s_setprio(1);
    for (int j = 0; j < NT; j += 2) {
      F_STEP(j);
      if (j + 1 < NT) F_STEP(j + 1);
    }
    __builtin_amdgcn_s_setprio(0);
  } else {
    for (int j = 0; j < NT; j += 2) {
      A_STEP(j);
      if (j + 1 < NT) A_STEP(j + 1);
    }
  }
#undef F_STEP
#undef SM_EL
#undef A_STEP
#undef A_DMA
#undef DMA16
  bool bad = false;
  if (active) {
#pragma unroll
    for (int qi = 0; qi < 2; ++qi) {
      if (FAST) l_run[qi] = l2[qi][0] + l2[qi][1];
      const float lt = l_run[qi] + __shfl_xor(l_run[qi], 32);
      const float inv = 1.f / lt;
      if (FAST) bad = bad || !(lt > 1e-25f && lt < 1e25f);
      unsigned char* Op = wsp<unsigned char>(p, OFF_O) + (tokq + 32 * qi) * 1024 + obase;
#pragma unroll
      for (int db = 0; db < 2; ++db)
#pragma unroll
        for (int gp = 0; gp < 2; ++gp) {
          float q[8];
#pragma unroll
          for (int j = 0; j < 8; ++j) q[j] = __builtin_amdgcn_fmed3f(o[qi][db][8 * gp + j] * (inv * O8_SCALE), -448.f, 448.f);
          int wa = __builtin_amdgcn_cvt_pk_fp8_f32(q[0], q[1], 0, false); wa = __builtin_amdgcn_cvt_pk_fp8_f32(q[2], q[3], wa, true);
          int wb = __builtin_amdgcn_cvt_pk_fp8_f32(q[4], q[5], 0, false); wb = __builtin_amdgcn_cvt_pk_fp8_f32(q[6], q[7], wb, true);
          const u32x2 sx = __builtin_amdgcn_permlane32_swap((unsigned)wa, (unsigned)wb, false, false);
          *(u32x2*)(Op + db * 32 + 16 * gp + 8 * hh) = sx;
        }
    }
  }
  if (!FAST) return false;
  LAS int* flag = (LAS int*)(lds + 2 * STG + 2048);
  if (__any(bad) && lane == 0) *flag = 1;
  __syncthreads();
  return __builtin_amdgcn_readfirstlane(*flag) != 0;
}
template <bool FAST>
DEVI bool attn_dispatch(KP p, int l, int n, int xcd, ldsp_t lds) {
  int br, s, qb; bool isctx = false;
  if (n < 32) { br = 0; s = xcd + 8 * (n >> 3); qb = n & 7; }
  else if (n < 64) { const int m = n - 32; br = 3; s = xcd + 8 * (m >> 4); qb = m & 15; }
  else if (n < 96) { const int m = n - 64; br = 2; s = xcd + 8 * (m >> 3); qb = m & 7; }
  else if (n < 128) { const int m = n - 96; br = 1; s = xcd + 8 * (m >> 4); qb = m & 15; }
  else {
    const int m = n - 128; isctx = true; qb = 0;
    if (m < 4) { br = 0; s = xcd + 8 * m; }
    else if (m < 6) { br = 3; s = xcd + 8 * (m - 4); }
    else if (m < 10) { br = 2; s = xcd + 8 * (m - 6); }
    else { br = 1; s = xcd + 8 * (m - 10); }
  }
  if (br == 0) return attn_item2<0, FAST>(p, l, s >> 2, s & 3, qb, isctx, lds);
  else if (br == 1) return attn_item2<1, FAST>(p, l, s >> 1, s & 1, qb, isctx, lds);
  else if (br == 2) return attn_item2<2, FAST>(p, l, s >> 2, s & 3, qb, isctx, lds);
  else return attn_item2<3, FAST>(p, l, s >> 1, s & 1, qb, isctx, lds);
}
DEVI void phaseD2(KP p, int l, ldsp_t lds) {
  const int G8 = gridDim.x >> 3, xcd = BIDX & 7, lb = BIDX >> 3;
  if (lb >= G8) return;
  const int NLOC = 128 + (l == 0 ? 12 : 0);
  const int nmine = (NLOC - lb + G8 - 1) / G8;
  const int cslot = min((int)(BIDX & 3), nmine - 1);
  int it = 0; unsigned redo = 0;
  for (int n = lb; n < NLOC; n += G8, ++it) {
    if (it == cslot) conv_items2(p, l, lds, CONV_EARLY, CONV_ITEMS);
    if (attn_dispatch<true>(p, l, n, xcd, lds)) redo |= 1u << it;
  }
  if (redo) {
    it = 0;
    for (int n = lb; n < NLOC; n += G8, ++it)
      if ((redo >> it) & 1) attn_dispatch<false>(p, l, n, xcd, lds);
  }
}

DEVI int pm_map(int pme, bool skipctx) { return skipctx ? (pme >> 4) * 17 + 1 + (pme & 15) : pme; }
struct SchedE1 { const char* ws; bool skipctx; int G, c;
  DEVI bool next(int i, Unit& u) const { int pm, pn; if (!tile_order(i, G, c, skipctx ? 128 : 136, 16, pm, pn)) return false;
    pm = pm_map(pm, skipctx); const int n = pn >> 2, cq = pn & 3;
    u.A = ws + OFF_O + uoff((unsigned)pm * 256u * 1024u + (unsigned)n * 256u); u.B = ws + OFF_WBR + uoff(((unsigned)n * 1024u + (unsigned)cq * 256u) * 256u); u.rows = nullptr; u.nvalid = 0;
    u.u0 = pm * 256; u.u1 = pn * 256; u.u2 = 0; u.u3 = 0; return true; } };
DEVI void phaseE1(KP p, int l, ldsp_t lds) {
  if (BIDX == 0 && TIDX < 32) wsp<int>(p, OFF_CNT)[TIDX * CNT_STRIDE] = 0;
  SchedE1 S{(const char*)p->ws, l == 1, (int)gridDim.x, BIDX};
  EpiZ8 E{wsp<unsigned char>(p, OFF_Z)};
  gemm_phase<true, false, true>(lds, 1024, 256, 2, S, E);
}
struct SchedE2 { const char* ws; const char* h8; bool skipctx; int G, c;
  DEVI bool next(int i, Unit& u) const { int pm, pn; if (!tile_order(i >> 1, G, c, skipctx ? 128 : 136, 8, pm, pn)) return false;
    pm = pm_map(pm, skipctx); const int pr = i & 1;
    u.A = h8 + uoff((unsigned)pm * 256u * 1024u); u.B = ws + OFF_WGATE + uoff((unsigned)(pr * 8 + pn) * 256u * 1024u); u.rows = nullptr; u.nvalid = 0;
    u.u0 = pm * 256; u.u1 = pn * 128; u.u2 = pr; u.u3 = 0; return true; } };
constexpr float Y8_SCALE = 16.f;
static_assert(Y8_SCALE == Z8_SCALE, "the E2 epilogue keeps its sums in Z8 units");
struct EpiE2 { const unsigned char* Z; u32x4 (&part)[8]; unsigned char* Y8; const float* bias;
  DEVI void init(f32x4 (&acc)[2][2][4][2], const Unit& u, int wr, int wc, int fr, int fq) const {
    const int col0 = u.u1 + wc * 32 + 8 * fq;
#pragma unroll
    for (int bj = 0; bj < 2; ++bj)
#pragma unroll
      for (int nn = 0; nn < 2; ++nn) {
        const f32x4 b = *(const f32x4*)(bias + (2 * u.u2 + bj) * 1024 + col0 + 4 * nn) * -LOG2E;
#pragma unroll
        for (int a = 0; a < 2; ++a)
#pragma unroll
          for (int m = 0; m < 4; ++m) acc[a][bj][m][nn] = b;
      }
  }
  DEVI void operator()(const f32x4 (&acc)[2][2][4][2], const Unit& u, int wr, int wc, int fr, int fq) const {
    const int row0 = u.u0 + wr * 64 + fr, col0 = u.u1 + wc * 32 + 8 * fq, pr = u.u2;
    const unsigned lw16 = (unsigned)((wr * 4 + wc) * 64 + fr + 16 * fq) * 16u;
    const unsigned char* zb0 = Z + z8_block(u.u0 >> 8, 2 * pr, u.u1 >> 7) + lw16;
    u32x4 zq[4][2], yq[4][2];
    auto ldpair = [&](int P, u32x4 (&z)[2], u32x4 (&y)[2]) {
#pragma unroll
      for (int bj = 0; bj < 2; ++bj) z[bj] = *(const u32x4*)(zb0 + (size_t)bj * 8 * 32768 + P * 8192);
#pragma unroll
      for (int h = 0; h < 2; ++h) y[h] = pr ? part[2 * P + h] : u32x4{0u, 0u, 0u, 0u};
    };
#pragma unroll
    for (int P = 0; P < 4; ++P) ldpair(P, zq[P], yq[P]);
#pragma unroll
    for (int P = 0; P < 4; ++P) {
      const int c = P;
#pragma unroll
      for (int h = 0; h < 2; ++h) {
        const int g = 2 * P + h, ai = g >> 2, m = g & 3;
        const size_t r = (size_t)(row0 + ai * HALF + m * 16);
        float t[8];
        {
          const unsigned w[4] = {yq[c][h].x, yq[c][h].y, yq[c][h].z, yq[c][h].w};
#pragma unroll
          for (int i = 0; i < 4; ++i) { t[2 * i] = __uint_as_float(w[i] << 16); t[2 * i + 1] = __uint_as_float(w[i] & 0xffff0000u); }
        }
#pragma unroll
        for (int bj = 0; bj < 2; ++bj) {
#pragma unroll
          for (int nn = 0; nn < 2; ++nn) {
            const int zw = (int)zq[c][bj][2 * h + nn];
            const f32x2 zlo = __builtin_amdgcn_cvt_pk_f32_fp8(zw, false), zhi = __builtin_amdgcn_cvt_pk_f32_fp8(zw, true);
            const float zz4[4] = {zlo.x, zlo.y, zhi.x, zhi.y};
#pragma unroll
            for (int j = 0; j < 4; ++j) {
              const int e = 4 * nn + j;
              const float gte = __builtin_amdgcn_rcpf(1.f + __builtin_amdgcn_exp2f(acc[ai][bj][m][nn][j]));
              t[e] += gte * zz4[j];
            }
          }
        }
        if (pr == 0) {
          u32x4 o; o.x = pk2(t[0], t[1]); o.y = pk2(t[2], t[3]); o.z = pk2(t[4], t[5]); o.w = pk2(t[6], t[7]);
          part[g] = o;
        } else {
          u32x2 o8;
#pragma unroll
          for (int w = 0; w < 2; ++w) {
            float q[4];
#pragma unroll
            for (int j = 0; j < 4; ++j) q[j] = __builtin_amdgcn_fmed3f(t[4 * w + j], -448.f, 448.f);
            int v = __builtin_amdgcn_cvt_pk_fp8_f32(q[0], q[1], 0, false);
            v = __builtin_amdgcn_cvt_pk_fp8_f32(q[2], q[3], v, true);
            o8[w] = (unsigned)v;
          }
          *(u32x2*)(Y8 + r * 1024 + col0) = o8;
        }
      }
    }
  }
};
DEVI void phaseE2(KP p, int l, ldsp_t lds) {
  SchedE2 S{(const char*)p->ws, (const char*)h8base(p), l == 1, (int)gridDim.x, BIDX};
  u32x4 part[8];
#pragma unroll
  for (int i = 0; i < 8; ++i) part[i] = u32x4{0u, 0u, 0u, 0u};
  EpiE2 E{wsp<unsigned char>(p, OFF_Z), part, wsp<unsigned char>(p, OFF_Y8), p->b_gate + (size_t)l * 4 * 1024};
  gemm_phase<true, false, true>(lds, 1024, 1024, 8, S, E);
}
struct SchedF { const char* ws; bool skipctx; int G, c;
  DEVI bool next(int i, Unit& u) const { int pm, pn;
    if (skipctx || G != 256) { if (!tile_order(i, G, c, skipctx ? 128 : 136, 4, pm, pn)) return false; }
    else if (i < 2) { if (!tile_order(i, G, c, 128, 4, pm, pn)) return false; }
    else { if (i > 2 || c >= 32) return false; pm = 128 + (c >> 2); pn = c & 3; }
    pm = pm_map(pm, skipctx);
    u.A = ws + OFF_Y8 + uoff((unsigned)pm * 256u * 1024u); u.B = ws + OFF_WOUT + uoff((unsigned)pn * 256u * 1024u); u.rows = nullptr; u.nvalid = 0;
    u.u0 = pm; u.u1 = pn * 256; u.u2 = 0; u.u3 = 0; return true; } };
struct EpiF { KP p; int l;
  DEVI void init(f32x4 (&acc)[2][2][4][2], const Unit&, int, int, int, int) const { acc_zero(acc); }
  DEVI void operator()(const f32x4 (&acc)[2][2][4][2], const Unit& u, int wr, int wc, int fr, int fq) const {
    const int pm = u.u0, b = pm / 17, rr0 = (pm % 17) * 256;
    const int mrow = (rr0 < NCTX) ? 8 : b;
    const int col0 = u.u1 + wc * 32 + 8 * fq;
    const float* gt = wsp<float>(p, OFF_MOD) + ((size_t)l * 9 + mrow) * 6144 + 2048 + col0;
    const u16* xinb = (const u16*)p->out + (size_t)(b * TPB + rr0) * 1024 + col0;
    const __amdgpu_buffer_rsrc_t xrs = __builtin_amdgcn_make_buffer_rsrc((void*)wsp<u16>(p, OFF_XM), 0, NTOK * 1024 * 2, 0x00020000);
    const unsigned xoff = (unsigned)((b * TPB + rr0) * 1024 + col0) * 2u;
    f32x4 gv[2][2];
#pragma unroll
    for (int bj = 0; bj < 2; ++bj)
#pragma unroll
      for (int n = 0; n < 2; ++n) gv[bj][n] = *(const f32x4*)(gt + bj * HALF + n * 4) * (1.f / Y8_SCALE);
#pragma unroll
    for (int ai = 0; ai < 2; ++ai) {
      u32x4 xo[4][2];
#pragma unroll
      for (int m = 0; m < 4; ++m) {
        const size_t ro = (size_t)(wr * 64 + fr + ai * HALF + m * 16) * 1024;
#pragma unroll
        for (int bj = 0; bj < 2; ++bj) xo[m][bj] = *(const u32x4*)(xinb + ro + bj * HALF);
      }
#pragma unroll
      for (int mp = 0; mp < 2; ++mp) {
#pragma unroll
        for (int mm = 0; mm < 2; ++mm) {
          const int m = 2 * mp + mm;
          const size_t ro = (size_t)(wr * 64 + fr + ai * HALF + m * 16) * 1024;
#pragma unroll
          for (int bj = 0; bj < 2; ++bj) {
            const u32x4 v = xo[m][bj];
            const f32x4 x0 = f32x4{__uint_as_float(v.x << 16), __uint_as_float(v.x & 0xffff0000u), __uint_as_float(v.y << 16), __uint_as_float(v.y & 0xffff0000u)};
            const f32x4 x1 = f32x4{__uint_as_float(v.z << 16), __uint_as_float(v.z & 0xffff0000u), __uint_as_float(v.w << 16), __uint_as_float(v.w & 0xffff0000u)};
            const f32x4 r0 = x0 + gv[bj][0] * acc[ai][bj][m][0], r1 = x1 + gv[bj][1] * acc[ai][bj][m][1];
            __builtin_amdgcn_raw_buffer_store_b128(u32x4{pk2(r0.x, r0.y), pk2(r0.z, r0.w), pk2(r1.x, r1.y), pk2(r1.z, r1.w)}, xrs,
                                                   (int)(xoff + (unsigned)(ro + bj * HALF) * 2u), 0, 16);
          }
        }
      }
    }
    asm volatile("s_waitcnt vmcnt(0)" ::: "memory");
    if ((TIDX & 63) == 0) __hip_atomic_fetch_add(wsp<int>(p, OFF_DEP) + (l * 136 + pm) * DEP_STRIDE, 1, __ATOMIC_RELAXED, __HIP_MEMORY_SCOPE_AGENT);
  }
};
DEVI void phaseF2(KP p, int l, ldsp_t lds) {
  SchedF S{(const char*)p->ws, l == 1, (int)gridDim.x, BIDX};
  EpiF E{p, l};
  gemm_phase<true, false, true>(lds, 1024, 1024, 8, S, E);
}


DEVI void phase0_2(KP p, ldsp_t lds) {
  const int tid = TIDX, half = tid >> 8, htid = tid & 255;
  for (int it = BIDX * 2; it < 458; it += gridDim.x * 2) {
    const int item = it + half;
    LAS float* sc = (LAS float*)(lds + half * 16384);
    const bool ismod = item < 384;
    const int l = item / 192, rem = item % 192, cgp = rem >> 3, kc = rem & 7;
    __syncthreads();
    if (ismod) {
      for (int i = htid; i < 9 * 128; i += 256) {
        int b = i >> 7, k = i & 127;
        float v = (b < 8) ? p->c[b * 1024 + kc * 128 + k] : p->c_ctx[kc * 128 + k];
        sc[i] = v / (1.f + __expf(-v));
      }
    }
    __syncthreads();
    if (ismod) {
      float acc[9];
#pragma unroll
      for (int b = 0; b < 9; ++b) acc[b] = 0.f;
      const float* w = p->w_mod + ((size_t)l * 1024 + kc * 128) * 6144 + cgp * 256 + htid;
#pragma unroll 32
      for (int k = 0; k < 128; ++k) {
        float wv = w[(size_t)k * 6144];
#pragma unroll
        for (int b = 0; b < 9; ++b) acc[b] += sc[b * 128 + k] * wv;
      }
      float* dst = wsp<float>(p, OFF_MODP) + (size_t)((kc * 2 + l) * 9) * 6144 + cgp * 256 + htid;
#pragma unroll
      for (int b = 0; b < 9; ++b) dst[(size_t)b * 6144] = acc[b];
    } else if (item == 384) {
      float* cs32 = wsp<float>(p, OFF_CS32);
      float* cs16 = wsp<float>(p, OFF_CS16);
      for (int t = htid; t < 1024; t += 256) {
        int pos = t >> 4, i = t & 15;
        float ang = (float)pos * __builtin_amdgcn_exp2f(-(float)(2 * i) * (13.287712379549449f / 32.f));
        cs32[t * 2] = __cosf(ang); cs32[t * 2 + 1] = __sinf(ang);
      }
      for (int t = htid; t < 512; t += 256) {
        int pos = t >> 3, i = t & 7;
        float ang = (float)pos * __builtin_amdgcn_exp2f(-(float)(2 * i) * (13.287712379549449f / 16.f));
        cs16[t * 2] = __cosf(ang); cs16[t * 2 + 1] = __sinf(ang);
      }
    } else if (item < 457) {
      const int q = item - 385, ll = q / 36, o = q % 36;
      float* dst = wsp<float>(p, OFF_WRT) + ((size_t)ll * 36 + o) * 1024;
      for (int k = htid; k < 1024; k += 256)
        dst[k] = (o < 4) ? p->w_group[((size_t)ll * 1024 + k) * 4 + o] : p->w_router[((size_t)ll * 1024 + k) * 32 + (o - 4)];
    }
  }
}
DEVI void phase1_2(KP p) {
  const float* mp = wsp<float>(p, OFF_MODP);
  float* mo = wsp<float>(p, OFF_MOD);
  for (int i = BIDX * 512 + TIDX; i < 2 * 9 * 6144; i += gridDim.x * 512) {
    int l = i / (9 * 6144), o = i % 6144;
    float s = p->b_mod[l * 6144 + o];
#pragma unroll
    for (int kc = 0; kc < 8; ++kc) s += mp[(size_t)kc * 2 * 9 * 6144 + i];
    mo[i] = s;
  }
}
DEVI void phaseA2(KP p) {
  const int gw = BIDX * NW + (TIDX >> 6), nw = gridDim.x * NW;
  u16* H = wsp<u16>(p, OFF_H);
  const int per = (NTOK + nw - 1) / nw;
  const int t0 = gw * per, t1 = min(t0 + per, NTOK);
  int cur = -1; ModVec mv;
  for (int tok0 = t0; tok0 < t1; tok0 += 2) {
    float xv[2][16];
#pragma unroll
    for (int r = 0; r < 2; ++r) { const int tok = tok0 + r; if (tok < t1) load_row16(xrow_in(p, 0, tok / TPB, tok % TPB), xv[r]); }
#pragma unroll
    for (int r = 0; r < 2; ++r) {
      const int tok = tok0 + r;
      if (tok < t1) {
        const int mrow = (tok % TPB) < NCTX ? 8 : tok / TPB;
        if (mrow != cur) { load_modvec(p, 0, 0, mrow, mv); cur = mrow; }
        float hv[16]; modulate_row_store2<true, false>(mv, xv[r], nullptr, hv, h8base(p) + (size_t)tok * 1024);
        u16* xb = (u16*)p->out + (size_t)tok * 1024 + (TIDX & 63) * 4;
#pragma unroll
        for (int i = 0; i < 4; ++i) *(u32x2*)(xb + i * 256) = u32x2{pk2(xv[r][i * 4], xv[r][i * 4 + 1]), pk2(xv[r][i * 4 + 2], xv[r][i * 4 + 3])}; }
    }
  }
}
DEVI void phaseG2(KP p, int l, ldsp_t lds) {
  constexpr int RP = 2064;
  constexpr int GX = 2 * 32 * RP;
  const int tid = TIDX, lane = tid & 63, wave = __builtin_amdgcn_readfirstlane(tid >> 6);
  const int r32 = lane & 31, kh = lane >> 5, qd = lane >> 4;
  u16* H = wsp<u16>(p, OFF_H2);
  const float* WRT = wsp<float>(p, OFF_WRT) + (size_t)l * 36 * 1024;
  int* cnt = wsp<int>(p, OFF_CNT);
  int* list = wsp<int>(p, OFF_LIST);
  float* wlist = wsp<float>(p, OFF_WLIST);
  const ldsp_t hiP = lds, loP = lds + 32 * RP;
  LAS float* part = (LAS float*)lds;
  LAS int* gsel = (LAS int*)(lds + GX);
  LAS float* gwt = (LAS float*)(lds + GX + 128);
  LAS int* lcnt = (LAS int*)(lds + GX + 256);
  LAS int* gbase = lcnt + 32;
  LAS int* tinfo = lcnt + 64;
  if (tid < 32) lcnt[tid] = 0;
  int nloc = 0;
  bf16x8 whi[8], wlo[8];
  {
    const float* wr = p->w_router + (size_t)l * 1024 * 32 + r32;
#pragma unroll
    for (int s8 = 0; s8 < 8; ++s8) {
      u32x4 h, lo4;
#pragma unroll
      for (int jj = 0; jj < 4; ++jj) {
        const int k = 128 * wave + 16 * s8 + 8 * kh + 2 * jj;
        const float a = wr[(size_t)k * 32], b2 = wr[(size_t)(k + 1) * 32];
        const unsigned hp = pk2(a, b2);
        h[jj] = hp; lo4[jj] = pk2(a - __uint_as_float(hp << 16), b2 - __uint_as_float(hp & 0xffff0000u));
      }
      whi[s8] = __builtin_bit_cast(bf16x8, h); wlo[s8] = __builtin_bit_cast(bf16x8, lo4);
    }
  }
  int* tctr = wsp<int>(p, OFF_DEP) + DEP_TILECTR + l * DEP_STRIDE;
  LAS int* tnext = lcnt + 64 + 512 * 6;
  const int ntile = (l == 1) ? 8 * SEQ / 32 : NTOK / 32;
  if (tid == 0) *tnext = atomicAdd(tctr, 1);
  __syncthreads();
  for (;;) {
    const int tix = *tnext;
    if (tix >= ntile) break;
    int tclaim = 0;
    if (tid == 0) tclaim = atomicAdd(tctr, 1);
    const int tile = (l == 1) ? (tix >> 7) * 136 + 8 + (tix & 127) : tix;
    const int tok0 = tile * 32, b = tok0 / TPB, rr0 = tok0 % TPB;
    if (wave == 0) {
      const int* dep = wsp<int>(p, OFF_DEP) + (l * 136 + (tok0 >> 8)) * DEP_STRIDE;
      while (__hip_atomic_load(dep, __ATOMIC_RELAXED, __HIP_MEMORY_SCOPE_AGENT) < 32) __builtin_amdgcn_s_sleep(2);
      __builtin_amdgcn_fence(__ATOMIC_ACQUIRE, "agent");
      asm volatile("s_waitcnt vmcnt(0)" ::: "memory");
    }
    __syncthreads();
    {
      float hv[4][16], xv4[4][16];
#pragma unroll
      for (int r = 0; r < 4; ++r) load_row16_bf(wsp<u16>(p, OFF_XM) + (size_t)(tok0 + wave * 4 + r) * 1024, xv4[r]);
      ModVec mv; load_modvec(p, l, 1, (rr0 < NCTX) ? 8 : b, mv);
#pragma unroll
      for (int r = 0; r < 4; ++r) {
        modulate_row_store2<true, false>(mv, xv4[r], nullptr, hv[r], (unsigned char*)H + (size_t)(tok0 + wave * 4 + r) * 1024);
        const int ro = (wave * 4 + r) * RP + lane * 8;
#pragma unroll
        for (int i = 0; i < 4; ++i) {
          const unsigned h01 = pk2(hv[r][i * 4], hv[r][i * 4 + 1]), h23 = pk2(hv[r][i * 4 + 2], hv[r][i * 4 + 3]);
          const unsigned l01 = pk2(hv[r][i * 4] - __uint_as_float(h01 << 16), hv[r][i * 4 + 1] - __uint_as_float(h01 & 0xffff0000u));
          const unsigned l23 = pk2(hv[r][i * 4 + 2] - __uint_as_float(h23 << 16), hv[r][i * 4 + 3] - __uint_as_float(h23 & 0xffff0000u));
          *(LAS u32x2*)(hiP + ro + i * 512) = u32x2{h01, h23};
          *(LAS u32x2*)(loP + ro + i * 512) = u32x2{l01, l23};
        }
      }
      float gl[4];
#pragma unroll
      for (int o = 0; o < 4; ++o) gl[o] = router_dot(hv, WRT + (size_t)o * 1024) + p->b_group[l * 4 + o];
      int gs = 0; float best = gl[0];
#pragma unroll
      for (int j = 1; j < 4; ++j) if (gl[j] > best) { best = gl[j]; gs = j; }
      float gsum = 0.f;
#pragma unroll
      for (int j = 0; j < 4; ++j) gsum += __expf(gl[j] - best);
      if ((lane & 15) == 0) { gsel[wave * 4 + qd] = gs; gwt[wave * 4 + qd] = 1.f / gsum; }
    }
    __syncthreads();
    f32x16 acc;
#pragma unroll
    for (int i = 0; i < 16; ++i) acc[i] = 0.f;
    {
      const int ao = r32 * RP + (128 * wave + 8 * kh) * 2;
#pragma unroll
      for (int s8 = 0; s8 < 8; ++s8) {
        const bf16x8 ah = *(const LAS bf16x8*)(hiP + ao + s8 * 32), al = *(const LAS bf16x8*)(loP + ao + s8 * 32);
        acc = MFMA(ah, whi[s8], acc);
        acc = MFMA(ah, wlo[s8], acc);
        acc = MFMA(al, whi[s8], acc);
      }
    }
    __syncthreads();
#pragma unroll
    for (int i = 0; i < 16; ++i) part[(wave * 32 + (i & 3) + 8 * (i >> 2) + 4 * kh) * 33 + r32] = acc[i];
    __syncthreads();
    if (tid < 32) {
      const int gs = gsel[tid];
      const float gw_ = gwt[tid];
      float e8[8];
#pragma unroll
      for (int j = 0; j < 8; ++j) {
        float v = p->b_router[l * 32 + gs * 8 + j];
#pragma unroll
        for (int w = 0; w < 8; ++w) v += part[(w * 32 + tid) * 33 + gs * 8 + j];
        e8[j] = v;
      }
      int i0 = 0; float v0 = e8[0];
#pragma unroll
      for (int j = 1; j < 8; ++j) if (e8[j] > v0) { v0 = e8[j]; i0 = j; }
      int i1 = -1; float v1 = -INFINITY;
#pragma unroll
      for (int j = 0; j < 8; ++j) if (j != i0 && e8[j] > v1) { v1 = e8[j]; i1 = j; }
      const float ex = __expf(v1 - v0);
      const float w0 = gw_ / (1.f + ex), w1 = gw_ * ex / (1.f + ex);
      const int tok = tok0 + tid;
      const int ea = gs * 8 + i0, eb = gs * 8 + i1;
      const int ra = __hip_atomic_fetch_add(&lcnt[ea], 1, __ATOMIC_RELAXED, __HIP_MEMORY_SCOPE_WORKGROUP);
      const int rb = __hip_atomic_fetch_add(&lcnt[eb], 1, __ATOMIC_RELAXED, __HIP_MEMORY_SCOPE_WORKGROUP);
      LAS int* ti = tinfo + (nloc + tid) * 6;
      ti[0] = tok; ti[1] = ea | (eb << 8); ti[2] = ra; ti[3] = rb; ti[4] = __float_as_int(w0); ti[5] = __float_as_int(w1);
    }
    if (tid == 0) *tnext = tclaim;
    nloc += 32;
    __syncthreads();
    const bool last = *tnext >= ntile;
    if (last || nloc == 512) {
      if (tid < 32) { const int c = lcnt[tid]; gbase[tid] = c ? atomicAdd(&cnt[tid * CNT_STRIDE], c) : 0; }
      __syncthreads();
      for (int i = tid; i < nloc; i += 512) {
        const LAS int* ti = tinfo + i * 6;
        const int tok = ti[0], ea = ti[1] & 255, eb = ti[1] >> 8;
        const int sa = gbase[ea] + ti[2], sb = gbase[eb] + ti[3];
        list[(size_t)ea * NTOK + sa] = tok * 2; wlist[(size_t)ea * NTOK + sa] = __int_as_float(ti[4]);
        list[(size_t)eb * NTOK + sb] = tok * 2 + 1; wlist[(size_t)eb * NTOK + sb] = __int_as_float(ti[5]);
      }
      __syncthreads();
      if (tid < 32) lcnt[tid] = 0;
      nloc = 0;
      __syncthreads();
    }
  }
}
struct ExpInfo2 { int tiles[4], base[4], cnt[4]; };
DEVI ExpInfo2 exp_info2(KP p, int xcd) {
  const int* cnt = wsp<int>(p, OFF_CNT);
  ExpInfo2 ei;
  int before = 0;
#pragma unroll
  for (int e = 0; e < 32; ++e) {
    const int c = __builtin_amdgcn_readfirstlane(cnt[e * CNT_STRIDE]), t = (c + 255) >> 8;
    if ((e & 7) == xcd) { ei.tiles[e >> 3] = t; ei.base[e >> 3] = before; ei.cnt[e >> 3] = c; }
    before += t;
  }
  return ei;
}
template <int NN>
struct SchedX { ExpInfo2 ei; int xcd, lb, G8; const char* A; const char* W; const int* list; size_t wstride; int lda_b; int ldw_b;
  DEVI bool next(int i, Unit& u) const {
    const int tot = (ei.tiles[0] + ei.tiles[1] + ei.tiles[2] + ei.tiles[3]) * NN;
    const int n = i * G8 + lb; if (n >= tot) return false;
    int k = 0, m = n / NN; const int pn = n % NN;
    int tb = ei.base[0], ce = ei.cnt[0];
#pragma unroll
    for (int kk = 0; kk < 3; ++kk) { if (k == kk && m >= ei.tiles[kk]) { m -= ei.tiles[kk]; k = kk + 1; tb = ei.base[kk + 1]; ce = ei.cnt[kk + 1]; } }
    const int e = xcd + 8 * k;
    u.rows = list + (size_t)e * NTOK + m * 256; u.nvalid = ce - m * 256;
    u.A = A + (NN == 2 ? 0u : uoff((unsigned)(tb + m) * 256u * (unsigned)lda_b));
    u.B = W + uoff((unsigned)e * (unsigned)wstride + (unsigned)pn * 256u * (unsigned)ldw_b);
    u.u0 = (tb + m) * 256; u.u1 = pn; u.u2 = e; u.u3 = m; return true; } };
constexpr float U8_SCALE = 16.f;
struct EpiI1 { unsigned char* U;
  DEVI void init(f32x4 (&acc)[2][2][4][2], const Unit&, int, int, int, int) const { acc_zero(acc); }
  DEVI void operator()(const f32x4 (&acc)[2][2][4][2], const Unit& u, int wr, int wc, int fr, int fq) const {
#pragma unroll
    for (int ai = 0; ai < 2; ++ai)
#pragma unroll
      for (int m = 0; m < 4; ++m) {
        unsigned char* rowp = U + (size_t)(u.u0 + ai * HALF + wr * 64 + m * 16 + fr) * 256;
#pragma unroll
        for (int bj = 0; bj < 2; ++bj) {
          const int ff = 16 * (8 * u.u1 + 4 * bj + wc) + 4 * fq;
          const f32x4 g = acc[ai][bj][m][0], up = acc[ai][bj][m][1];
          float t[4];
#pragma unroll
          for (int j = 0; j < 4; ++j) t[j] = __builtin_amdgcn_fmed3f(g[j] * __builtin_amdgcn_rcpf(1.f + __builtin_amdgcn_exp2f(g[j] * -LOG2E)) * (up[j] * U8_SCALE), -448.f, 448.f);
          int o = __builtin_amdgcn_cvt_pk_fp8_f32(t[0], t[1], 0, false);
          o = __builtin_amdgcn_cvt_pk_fp8_f32(t[2], t[3], o, true);
          *(int*)(rowp + ff) = o;
        }
      }
  }
};
DEVI void phaseI1_2(KP p, ldsp_t lds) {
  const int xcd = BIDX & 7, lb = BIDX >> 3, G8 = gridDim.x >> 3;
  if (lb >= G8) return;
  SchedX<2> S{exp_info2(p, xcd), xcd, lb, G8, (const char*)wsp<u16>(p, OFF_H2), (const char*)wsp<u16>(p, OFF_W13), wsp<int>(p, OFF_LIST), (size_t)512 * 1024, 1024, 1024};
  EpiI1 E{wsp<unsigned char>(p, OFF_U)};
  int nt = 8; asm volatile("" : "+s"(nt));
  gemm_phase<false, true, true>(lds, 1024, 1024, nt, S, E);
}
constexpr float YS8_SCALE = 32.f;
struct EpiI2 { unsigned char* YS; const float* wlist; const int* list;
  DEVI void init(f32x4 (&acc)[2][2][4][2], const Unit&, int, int, int, int) const { acc_zero(acc); }
  DEVI void operator()(const f32x4 (&acc)[2][2][4][2], const Unit& u, int wr, int wc, int fr, int fq) const {
    const unsigned colb = (unsigned)(u.u1 * 256 + wc * 32 + 8 * fq);
    const float* we = wlist + (u.rows - list);
    unsigned dest[2][4]; float w[2][4];
#pragma unroll
    for (int ai = 0; ai < 2; ++ai)
#pragma unroll
      for (int m = 0; m < 4; ++m) {
        const int r = ai * HALF + wr * 64 + m * 16 + fr;
        dest[ai][m] = (r < u.nvalid) ? (unsigned)u.rows[r] : (unsigned)(2 * NTOK);
        w[ai][m] = we[r] * (YS8_SCALE / U8_SCALE);
      }
#pragma unroll
    for (int ai = 0; ai < 2; ++ai)
#pragma unroll
      for (int m = 0; m < 4; ++m) {
        unsigned char* rowp = YS + (dest[ai][m] * 1024u + colb);
#pragma unroll
        for (int bj = 0; bj < 2; ++bj) {
          u32x2 o;
#pragma unroll
          for (int nn = 0; nn < 2; ++nn) {
            const f32x4 v = acc[ai][bj][m][nn] * w[ai][m];
            int q = __builtin_amdgcn_cvt_pk_fp8_f32(__builtin_amdgcn_fmed3f(v[0], -448.f, 448.f), __builtin_amdgcn_fmed3f(v[1], -448.f, 448.f), 0, false);
            q = __builtin_amdgcn_cvt_pk_fp8_f32(__builtin_amdgcn_fmed3f(v[2], -448.f, 448.f), __builtin_amdgcn_fmed3f(v[3], -448.f, 448.f), q, true);
            o[nn] = (unsigned)q;
          }
          *(u32x2*)(rowp + bj * 128) = o;
        }
      }
  }
};
DEVI void phaseI2_2(KP p, ldsp_t lds) {
  const int xcd = BIDX & 7, lb = BIDX >> 3, G8 = gridDim.x >> 3;
  if (lb >= G8) return;
  SchedX<4> S{exp_info2(p, xcd), xcd, lb, G8, (const char*)wsp<u16>(p, OFF_U), (const char*)wsp<u16>(p, OFF_W2), wsp<int>(p, OFF_LIST), (size_t)1024 * 256, 256, 256};
  EpiI2 E{wsp<unsigned char>(p, OFF_YS), wsp<float>(p, OFF_WLIST), wsp<int>(p, OFF_LIST)};
  int nt = 2; asm volatile("" : "+s"(nt));
  gemm_phase<true, false, true>(lds, 256, 256, nt, S, E);
}
DEVI void phaseJ2(KP p, int l, ldsp_t lds) {
  const int lane = TIDX & 63;
  const int gw = BIDX * NW + (TIDX >> 6), nw = gridDim.x * NW;
  const unsigned char* YS = wsp<unsigned char>(p, OFF_YS);
  u16* H = wsp<u16>(p, OFF_H);
  const int ntot = (l == 1) ? 8 * SEQ : NTOK;
  const int per = (ntot + nw - 1) / nw;
  const int i0 = gw * per, i1 = min(i0 + per, ntot);
  int cur = -1; ModVec mv; f32x4 gtv[4];
  for (int ii = i0; ii < i1; ii += 2) {
    float xv[2][16]; int y0[2][4], y1[2][4]; bool ok[2]; int tk[2];
#pragma unroll
    for (int r = 0; r < 2; ++r) {
      const int idx = ii + r;
      const int tok = (l == 1) ? (idx / SEQ) * TPB + NCTX + idx % SEQ : idx;
      tk[r] = tok;
      ok[r] = idx < i1;
      if (ok[r]) {
        load_row16_bf(wsp<u16>(p, OFF_XM) + (size_t)tok * 1024, xv[r]);
#pragma unroll
        for (int i = 0; i < 4; ++i) {
          const int c = i * 256 + lane * 4;
          y0[r][i] = *(const int*)(YS + (size_t)(tok * 2) * 1024 + c);
          y1[r][i] = *(const int*)(YS + (size_t)(tok * 2 + 1) * 1024 + c);
        }
      }
    }
#pragma unroll
    for (int r = 0; r < 2; ++r) {
      if (!ok[r]) continue;
      const int tok = tk[r];
      const int b = tok / TPB, rr = tok % TPB;
      const int mrow = (rr < NCTX) ? 8 : b;
      if (mrow != cur) {
        cur = mrow;
        const float* gt = wsp<float>(p, OFF_MOD) + ((size_t)l * 9 + mrow) * 6144 + 5120;
#pragma unroll
        for (int i = 0; i < 4; ++i) gtv[i] = *(const f32x4*)(gt + i * 256 + lane * 4);
        if (l == 0) load_modvec(p, 1, 0, mrow, mv);
      }
#pragma unroll
      for (int i = 0; i < 4; ++i) {
        const f32x4 g = gtv[i] * (1.f / YS8_SCALE);
        const f32x2 a0 = __builtin_amdgcn_cvt_pk_f32_fp8(y0[r][i], false), a1 = __builtin_amdgcn_cvt_pk_f32_fp8(y0[r][i], true);
        const f32x2 b0 = __builtin_amdgcn_cvt_pk_f32_fp8(y1[r][i], false), b1 = __builtin_amdgcn_cvt_pk_f32_fp8(y1[r][i], true);
        xv[r][i * 4 + 0] += g.x * (a0.x + b0.x);
        xv[r][i * 4 + 1] += g.y * (a0.y + b0.y);
        xv[r][i * 4 + 2] += g.z * (a1.x + b1.x);
        xv[r][i * 4 + 3] += g.w * (a1.y + b1.y);
      }
      if (l == 0) {
        u16* xr = (u16*)p->out + (size_t)tok * 1024;
#pragma unroll
        for (int i = 0; i < 4; ++i)
          *(u32x2*)(xr + i * 256 + lane * 4) = u32x2{pk2(xv[r][i * 4], xv[r][i * 4 + 1]), pk2(xv[r][i * 4 + 2], xv[r][i * 4 + 3])};
        float hv[16];
        modulate_row_store2<true, false>(mv, xv[r], nullptr, hv, h8base(p) + (size_t)tok * 1024);
      } else {
        float ss = 0.f;
#pragma unroll
        for (int i = 0; i < 16; ++i) ss += xv[r][i] * xv[r][i];
        ss = wave_sum(ss);
        const float rstd = rsqrtf(ss * (1.f / 1024.f) + EPS);
        float* xr = p->out + ((size_t)b * SEQ + rr - NCTX) * 1024;
#pragma unroll
        for (int i = 0; i < 4; ++i) {
          const int c = i * 256 + lane * 4;
          const f32x4 g = *(const f32x4*)(p->g_final + c);
          *(f32x4*)(xr + c) = f32x4{xv[r][i * 4] * rstd * g.x, xv[r][i * 4 + 1] * rstd * g.y, xv[r][i * 4 + 2] * rstd * g.z, xv[r][i * 4 + 3] * rstd * g.w};
        }
      }
    }
  }
}

constexpr int N_PHASES = 3 + 2 * 11;
__global__ void __launch_bounds__(512, 2) fwd_v2(Params parg) {
  extern __shared__ __attribute__((aligned(16))) unsigned char dyn_lds[];
  const ldsp_t lds = (ldsp_t)dyn_lds;
  cg::grid_group grid = cg::this_grid();
  volatile LAS unsigned* xb_st = (volatile LAS unsigned*)(lds + LDS_BARW);
  if (TIDX < 4) xb_st[TIDX] = 0u;
  __syncthreads();
  if (parg.ph_end - parg.ph_begin > 1) xcd_barrier_post((unsigned*)(parg.ws + OFF_BAR));
  for (int ph = parg.ph_begin; ph < parg.ph_end; ++ph) {
    KP p = (KP)__builtin_amdgcn_kernarg_segment_ptr();
    asm volatile("" : "+s"(p));
    const int l = (ph >= 14) ? 1 : 0;
    const int k = (ph < 3) ? ph : 3 + (ph - 3) % 11;
    const int reps = (((PROBE_DUP >> k) & 1) && (!(PROBE_DUP & 0x10000) || l == 0)) ? 2 : 1;
    for (int rep = 0; rep < reps; ++rep) {
      if (rep) {
        xcd_barrier((unsigned*)(p->ws + OFF_BAR), xb_st);
        if (k == 10) { if (BIDX == 0 && TIDX < 32) wsp<int>(p, OFF_CNT)[TIDX * CNT_STRIDE] = 0; xcd_barrier((unsigned*)(p->ws + OFF_BAR), xb_st); }
      }
      switch (k) {
        case 0: phase0_2(p, lds); break;
        case 1: phase1_2(p); break;
        case 2: phaseA2(p); break;
        case 3: phaseB2(p, lds); break;
        case 4: phaseC2(p, lds); break;
        case 5: phaseP2(p, l, lds); break;
        case 6: phaseD2(p, l, lds); break;
        case 7: phaseE1(p, l, lds); break;
        case 8: phaseE2(p, l, lds); break;
        case 9: phaseF2(p, l, lds); break;
        case 10: phaseG2(p, l, lds); break;
        case 11: phaseI1_2(p, lds); break;
        case 12: phaseI2_2(p, lds); break;
        default: phaseJ2(p, l, lds); break;
      }
    }
    if (k == 0 || (k == 13 && l == 0)) conv_items2(p, k == 0 ? 0 : 1, lds, 0, CONV_EARLY);
    if (ph + 1 < parg.ph_end && k != 9) {
      if (parg.ph_begin >= 1000) grid.sync();
      else xcd_barrier((unsigned*)(p->ws + OFF_BAR), xb_st);
    }
  }
}
}

extern "C" void kernel_launch(void* const* d_in, const int* in_sizes, int n_in, void* d_out, int out_size,
                              void* d_ws, size_t ws_size, hipStream_t stream) {
  static int grid2 = 0;
  if (!grid2) {
    int dev = 0, cus = 0, per_cu = 0;
    (void)hipGetDevice(&dev);
    (void)hipDeviceGetAttribute(&cus, hipDeviceAttributeMultiprocessorCount, dev);
    (void)hipFuncSetAttribute((const void*)v2::fwd_v2, hipFuncAttributeMaxDynamicSharedMemorySize, v2::LDS_TOTAL);
    (void)hipOccupancyMaxActiveBlocksPerMultiprocessor(&per_cu, v2::fwd_v2, 512, v2::LDS_TOTAL);
    if (per_cu < 1) { fprintf(stderr, "kernel does not fit on a CU\n"); per_cu = 1; }
    grid2 = cus & ~7;
  }
  if (ws_size < WS_NEEDED) { fprintf(stderr, "workspace too small: %zu < %zu\n", ws_size, (size_t)WS_NEEDED); return; }
  Params hp{};
  const float** f = (const float**)&hp;
  for (int i = 0; i < 29; ++i) f[i] = (const float*)d_in[i];
  hp.out = (float*)d_out;
  hp.ws = (char*)d_ws;
#if N_LAUNCH_MODE == 1
  for (int ph = 0; ph < v2::N_PHASES; ++ph) {
    hp.ph_begin = ph; hp.ph_end = ph + 1;
    void* args[] = {&hp};
    hipError_t e = hipLaunchCooperativeKernel((void*)v2::fwd_v2, dim3(grid2), dim3(512), args, v2::LDS_TOTAL, stream);
    if (e != hipSuccess) fprintf(stderr, "launch failed: %s\n", hipGetErrorString(e));
  }
#else
  hp.ph_begin = 0; hp.ph_end = v2::N_PHASES;
  (void)hipMemsetAsync((char*)d_ws + OFF_BAR, 0, (size_t)(OFF_DEP - OFF_BAR) + (size_t)DEP_WORDS * 4, stream);
  void* args[] = {&hp};
  hipError_t e = hipLaunchCooperativeKernel((void*)v2::fwd_v2, dim3(grid2), dim3(512), args, v2::LDS_TOTAL, stream);
  if (e != hipSuccess) fprintf(stderr, "cooperative launch failed: %s (grid %d)\n", hipGetErrorString(e), grid2);
#endif
}
```

```cpp
#include <hip/hip_runtime.h>
#include <hip/hip_cooperative_groups.h>
#include <stdint.h>
#include <stdio.h>
namespace cg = cooperative_groups;

#ifndef N_LAUNCH_MODE
#define N_LAUNCH_MODE 0
#endif

#ifndef PROBE_DUP
#define PROBE_DUP 0
#endif
#define DEVI __device__ __forceinline__
typedef unsigned short u16;
typedef __attribute__((ext_vector_type(2))) float f32x2;
typedef __attribute__((ext_vector_type(2))) __bf16 bf16x2_t;
typedef __attribute__((ext_vector_type(8))) short bf16x8;
typedef __attribute__((ext_vector_type(16))) float f32x16;
typedef __attribute__((ext_vector_type(4))) unsigned u32x4;
typedef __attribute__((ext_vector_type(2))) unsigned u32x2;
typedef __attribute__((ext_vector_type(4))) float f32x4;
#define MFMA(a, b, c) __builtin_amdgcn_mfma_f32_32x32x16_bf16((a), (b), (c), 0, 0, 0)

constexpr int DMODEL = 1024, NBATCH = 8, SEQ = 4096, NCTX = 256;
constexpr int TPB = SEQ + NCTX;
constexpr int NTOK = NBATCH * TPB;
constexpr int MT_PER_B = TPB / 128;
constexpr int NEXP = 32;
constexpr int INP = 2304;
constexpr float EPS = 1e-6f;
constexpr float LOG2E = 1.4426950408889634f;
constexpr int SMEM_BYTES = 73728;
constexpr int UROWS = 2 * NTOK + NEXP * 256;

constexpr size_t al(size_t x) { return (x + 255) & ~(size_t)255; }
constexpr size_t OFF_WIN = 0;
constexpr size_t OFF_WQB = OFF_WIN + al((size_t)INP * 1024 * 2);
constexpr size_t OFF_WKVB = OFF_WQB + al((size_t)512 * 256 * 2);
constexpr size_t OFF_WGATE = OFF_WKVB + al((size_t)512 * 256 * 2);
constexpr size_t OFF_WBR = OFF_WGATE + al((size_t)4 * 1024 * 1024 * 2);
constexpr size_t OFF_WOUT = OFF_WBR + al((size_t)4 * 1024 * 256 * 2);
constexpr size_t OFF_W13 = OFF_WOUT + al((size_t)1024 * 1024 * 2);
constexpr size_t OFF_W2 = OFF_W13 + al((size_t)32 * 512 * 1024 * 2);
constexpr size_t OFF_MODP = OFF_W2 + al((size_t)32 * 1024 * 256 * 2);
constexpr size_t OFF_MOD = OFF_MODP + al((size_t)8 * 2 * 9 * 6144 * 4);
constexpr size_t OFF_CS32 = OFF_MOD + al((size_t)2 * 9 * 6144 * 4);
constexpr size_t OFF_CS16 = OFF_CS32 + al((size_t)64 * 16 * 2 * 4);
constexpr size_t OFF_WRT = OFF_CS16 + al((size_t)64 * 8 * 2 * 4);
constexpr size_t OFF_CNT = OFF_WRT + al((size_t)2 * 36 * 1024 * 4);
constexpr int CNT_STRIDE = 64;
constexpr size_t OFF_BAR = OFF_CNT + al(32 * CNT_STRIDE * 4);
constexpr int XCD_BAR_WORDS = 3456;
constexpr size_t OFF_CTXRES = OFF_BAR + al((size_t)XCD_BAR_WORDS * 4);
constexpr size_t OFF_DEP = OFF_CTXRES;
constexpr int DEP_STRIDE = 16, DEP_TILECTR = 2 * 136 * DEP_STRIDE, DEP_WORDS = DEP_TILECTR + 2 * DEP_STRIDE;
constexpr size_t OFF_H = OFF_CTXRES + al((size_t)8 * 256 * 1024 * 4);
constexpr size_t OFF_O = OFF_H + al((size_t)NTOK * 1024 * 2);
constexpr size_t OFF_SSQ = OFF_O + al((size_t)NTOK * 1024 * 2);
constexpr size_t OFF_LIST = OFF_SSQ + al((size_t)NTOK * 8 * 4);
constexpr size_t OFF_WLIST = OFF_LIST + al((size_t)32 * NTOK * 4);
constexpr size_t OFF_R1 = OFF_WLIST + al((size_t)32 * NTOK * 4);
constexpr int PLD = INP;
constexpr size_t OFF_PRAW = OFF_R1;
constexpr size_t OFF_QARAW = OFF_PRAW + (size_t)NTOK * INP * 2;
constexpr size_t OFF_KVARAW = OFF_QARAW + (size_t)NTOK * 512 * 2;
constexpr size_t OFF_VAT = OFF_KVARAW + (size_t)NTOK * 512 * 2;
constexpr size_t OFF_VBT = OFF_VAT + (size_t)NTOK * 256 * 2;
constexpr size_t OFF_VCT = OFF_VBT + (size_t)NTOK * 128 * 2;
constexpr size_t OFF_VDT = OFF_VCT + (size_t)NTOK * 256 * 2;
constexpr size_t OFF_END = OFF_VDT + (size_t)NTOK * 128 * 2;
constexpr size_t OFF_Z = OFF_R1;
constexpr size_t OFF_Y8 = OFF_H;
constexpr size_t OFF_H2 = OFF_O;
constexpr size_t OFF_YPRE = OFF_O;
constexpr size_t OFF_U = OFF_R1;
constexpr size_t OFF_YS = OFF_R1 + al((size_t)UROWS * 256 * 2);
constexpr size_t OFF_XM = OFF_YS + al((size_t)(2 * NTOK + 1) * 1024 * 2);
static_assert(OFF_XM + (size_t)NTOK * 1024 * 2 <= OFF_END, "alias overflow");
static_assert(OFF_Z + (size_t)NTOK * 4096 * 2 <= OFF_END, "alias overflow");
static_assert(OFF_YS + (size_t)(2 * NTOK + 1) * 1024 * 2 <= OFF_END, "alias overflow");
constexpr size_t WS_NEEDED = OFF_END;
static_assert(WS_NEEDED <= (size_t)536870912, "workspace budget (4 x largest tensor)");

struct Params {
  const float *x, *c, *ctx, *c_ctx, *w_mod, *b_mod, *g_norm_mix, *w_in, *g_q_a, *w_q_b, *g_kv_a, *w_kv_b,
      *sink_b, *rpb_c, *g_q_d, *g_k_d, *w_gate, *b_gate, *w_branch, *w_out, *g_norm_ffn, *w_group, *b_group,
      *w_router, *b_router, *w_ff1, *w_ff3, *w_ff2, *g_final;
  float* out;
  char* ws;
  int ph_begin, ph_end;
};

DEVI int tid_fresh() { int t; asm volatile("v_mov_b32 %0, %1" : "=v"(t) : "v"(__builtin_amdgcn_workitem_id_x())); return t; }
DEVI int bid_fresh() { int t; asm volatile("s_mov_b32 %0, %1" : "=s"(t) : "s"(__builtin_amdgcn_workgroup_id_x())); return t; }
#define TIDX tid_fresh()
#define BIDX bid_fresh()
typedef const __attribute__((address_space(4))) Params* KP;
DEVI unsigned pk2(float a, float b) { f32x2 v = {a, b}; bf16x2_t r = __builtin_convertvector(v, bf16x2_t); return __builtin_bit_cast(unsigned, r); }
DEVI u16 f2bf(float a) { return (u16)(pk2(a, 0.f) & 0xffffu); }
DEVI float bf2f(u16 v) { return __uint_as_float(((unsigned)v) << 16); }
DEVI float wave_sum(float v) {
#pragma unroll
  for (int m = 32; m >= 1; m >>= 1) v += __shfl_xor(v, m);
  return v;
}
template <class T> DEVI T* wsp(KP p, size_t off) { return (T*)(p->ws + off); }
DEVI const float* xrow_in(KP p, int l, int b, int rr) {
  if (l == 0) return (rr < NCTX) ? p->ctx + ((size_t)b * NCTX + rr) * 1024 : p->x + ((size_t)b * SEQ + rr - NCTX) * 1024;
  return (rr < NCTX) ? wsp<float>(p, OFF_CTXRES) + ((size_t)b * NCTX + rr) * 1024 : p->out + ((size_t)b * SEQ + rr - NCTX) * 1024;
}
DEVI float* xrow_res(KP p, int b, int rr) {
  return (rr < NCTX) ? wsp<float>(p, OFF_CTXRES) + ((size_t)b * NCTX + rr) * 1024 : p->out + ((size_t)b * SEQ + rr - NCTX) * 1024;
}
DEVI int perm16(int k) { return (k & ~12) | ((k & 4) << 1) | ((k & 8) >> 1); }

struct ConvT { const float* src; const float* src2; const float* ks; u16* dst; int ld; int ldd; float mul; };
constexpr float Z8_SCALE = 16.f, O8_SCALE = 32.f;
constexpr float F8_WSCALE = 64.f, GATE_WSCALE = F8_WSCALE;
constexpr int CONV_ITEMS = 1152 + 64 + 64 + 2048 + 512 + 512 + 8192 + 4096;
DEVI ConvT conv_decode(KP p, int l, int idx) {
  ConvT c; c.ks = nullptr; c.mul = 1.f; c.src2 = nullptr;
  if (idx < 1152) {
    int nt = idx >> 4, kt = idx & 15, n0 = nt * 32;
    int sc = (n0 < 416) ? n0 : ((n0 < 512) ? -1 : n0 - 96);
    c.ld = 2208; c.ldd = -1024;
    c.mul = F8_WSCALE;
    if ((n0 >= 512 && n0 < 768) || (n0 >= 1024 && n0 < 1280)) c.mul = 0.125f * LOG2E * F8_WSCALE;
    c.src = (sc < 0) ? nullptr : p->w_in + (size_t)l * 1024 * 2208 + (size_t)kt * 64 * 2208 + sc;
    c.dst = (u16*)(p->ws + OFF_WIN + (size_t)n0 * 1024 + kt * 64);
    return c;
  }
  idx -= 1152;
  if (idx < 64) {
    int nt = idx >> 2, kt = idx & 3;
    c.ld = 384; c.ldd = 256; c.ks = p->g_q_a + l * 256 + kt * 64;
    c.src = (nt >= 12) ? nullptr : p->w_q_b + (size_t)l * 256 * 384 + (size_t)kt * 64 * 384 + nt * 32;
    c.dst = wsp<u16>(p, OFF_WQB) + (size_t)nt * 32 * 256 + kt * 64;
    return c;
  }
  idx -= 64;
  if (idx < 64) {
    int nt = idx >> 2, kt = idx & 3;
    c.ld = 512; c.ldd = 256; c.ks = (kt < 2) ? p->g_kv_a + l * 128 + kt * 64 : nullptr;
    c.src = (kt >= 2) ? nullptr : p->w_kv_b + (size_t)l * 128 * 512 + (size_t)kt * 64 * 512 + nt * 32;
    c.dst = wsp<u16>(p, OFF_WKVB) + (size_t)nt * 32 * 256 + kt * 64;
    return c;
  }
  idx -= 64;
  if (idx < 2048) {
    int nt = idx >> 4, kt = idx & 15, R0 = nt * 32;
    int pr = R0 >> 11, cb = (R0 & 2047) >> 8, bj = (R0 & 255) >> 7, j0 = R0 & 127;
    c.ld = 1024; c.ldd = -1024; c.mul = -LOG2E * F8_WSCALE;
    c.src = p->w_gate + ((size_t)(l * 4 + 2 * pr + bj) * 1024 + kt * 64) * 1024 + cb * 128 + j0;
    c.dst = (u16*)(p->ws + OFF_WGATE + (size_t)R0 * 1024 + kt * 64);
    return c;
  }
  idx -= 2048;
  if (idx < 512) {
    int br = idx >> 7, nt = (idx >> 2) & 31, kt = idx & 3;
    c.ld = 1024; c.ldd = -256; c.mul = F8_WSCALE * (Z8_SCALE / O8_SCALE);
    c.src = p->w_branch + ((size_t)(l * 4 + br) * 256 + kt * 64) * 1024 + nt * 32;
    c.dst = (u16*)(p->ws + OFF_WBR + ((size_t)br * 1024 + nt * 32) * 256 + kt * 64);
    return c;
  }
  idx -= 512;
  if (idx < 512) {
    int nt = idx >> 4, kt = idx & 15;
    c.ld = 1024; c.ldd = -1024; c.mul = F8_WSCALE;
    c.src = p->w_out + ((size_t)l * 1024 + kt * 64) * 1024 + nt * 32;
    c.dst = (u16*)(p->ws + OFF_WOUT + (size_t)nt * 32 * 1024 + kt * 64);
    return c;
  }
  idx -= 512;
  if (idx < 8192) {
    int e = idx >> 8, g32 = (idx >> 4) & 15, kt = idx & 15;
    c.ld = 256; c.ldd = -1024; c.mul = F8_WSCALE;
    c.src = p->w_ff1 + ((size_t)(l * 32 + e) * 1024 + kt * 64) * 256 + g32 * 16;
    c.src2 = p->w_ff3 + ((size_t)(l * 32 + e) * 1024 + kt * 64) * 256 + g32 * 16;
    c.dst = (u16*)(p->ws + OFF_W13 + ((size_t)e * 512 + g32 * 32) * 1024 + kt * 64);
    return c;
  }
  idx -= 8192;
  {
    int e = idx >> 7, nt = (idx >> 2) & 31, kt = idx & 3;
    c.ld = 1024; c.ldd = -256; c.mul = F8_WSCALE;
    c.src = p->w_ff2 + ((size_t)(l * 32 + e) * 256 + kt * 64) * 1024 + nt * 32;
    c.dst = (u16*)(p->ws + OFF_W2 + ((size_t)e * 1024 + nt * 32) * 256 + kt * 64);
    return c;
  }
}
DEVI void modulate_row_store(KP p, int l, int which, const float (&xv)[16], int mrow, u16* hrow, float (&hv)[16]) {
  const int lane = TIDX & 63;
  float ss = 0.f;
#pragma unroll
  for (int i = 0; i < 16; ++i) ss += xv[i] * xv[i];
  ss = wave_sum(ss);
  const float rstd = rsqrtf(ss * (1.f / 1024.f) + EPS);
  const float* g = (which ? p->g_norm_ffn : p->g_norm_mix) + l * 1024;
  const float* mod = wsp<float>(p, OFF_MOD) + ((size_t)l * 9 + mrow) * 6144 + (which ? 3072 : 0);
#pragma unroll
  for (int i = 0; i < 4; ++i) {
    const int c = i * 256 + lane * 4;
    f32x4 gv = *(const f32x4*)(g + c);
    f32x4 sh = *(const f32x4*)(mod + c);
    f32x4 sc = *(const f32x4*)(mod + 1024 + c);
    hv[i * 4 + 0] = xv[i * 4 + 0] * rstd * gv.x * (1.f + sc.x) + sh.x;
    hv[i * 4 + 1] = xv[i * 4 + 1] * rstd * gv.y * (1.f + sc.y) + sh.y;
    hv[i * 4 + 2] = xv[i * 4 + 2] * rstd * gv.z * (1.f + sc.z) + sh.z;
    hv[i * 4 + 3] = xv[i * 4 + 3] * rstd * gv.w * (1.f + sc.w) + sh.w;
    u32x2 o; o.x = pk2(hv[i * 4 + 0], hv[i * 4 + 1]); o.y = pk2(hv[i * 4 + 2], hv[i * 4 + 3]);
    *(u32x2*)(hrow + c) = o;
  }
}
struct ModVec { f32x4 a[4], b[4]; };
DEVI void load_modvec(KP p, int l, int which, int mrow, ModVec& mv) {
  const int lane = TIDX & 63;
  const float* g = (which ? p->g_norm_ffn : p->g_norm_mix) + l * 1024;
  const float* mod = wsp<float>(p, OFF_MOD) + ((size_t)l * 9 + mrow) * 6144 + (which ? 3072 : 0);
#pragma unroll
  for (int i = 0; i < 4; ++i) {
    const int c = i * 256 + lane * 4;
    const f32x4 gv = *(const f32x4*)(g + c), sh = *(const f32x4*)(mod + c), sc = *(const f32x4*)(mod + 1024 + c);
    mv.a[i] = gv * (1.f + sc); mv.b[i] = sh;
  }
}
DEVI unsigned char* h8base(KP p) { return (unsigned char*)p->out + (size_t)NTOK * 2048; }
template <bool F8COPY = false, bool BF16 = true>
DEVI void modulate_row_store2(const ModVec& mv, const float (&xv)[16], u16* hrow, float (&hv)[16], unsigned char* h8row = nullptr) {
  const int lane = TIDX & 63;
  float ss = 0.f;
#pragma unroll
  for (int i = 0; i < 16; ++i) ss += xv[i] * xv[i];
  ss = wave_sum(ss);
  const float rstd = rsqrtf(ss * (1.f / 1024.f) + EPS);
#pragma unroll
  for (int i = 0; i < 4; ++i) {
    const int c = i * 256 + lane * 4;
#pragma unroll
    for (int j = 0; j < 4; ++j) hv[i * 4 + j] = xv[i * 4 + j] * rstd * mv.a[i][j] + mv.b[i][j];
    if (BF16) { u32x2 o; o.x = pk2(hv[i * 4 + 0], hv[i * 4 + 1]); o.y = pk2(hv[i * 4 + 2], hv[i * 4 + 3]);
      *(u32x2*)(hrow + c) = o; }
    if (F8COPY) {
      float q[4];
#pragma unroll
      for (int j = 0; j < 4; ++j) q[j] = __builtin_amdgcn_fmed3f(hv[i * 4 + j], -448.f, 448.f);
      int v = __builtin_amdgcn_cvt_pk_fp8_f32(q[0], q[1], 0, false);
      v = __builtin_amdgcn_cvt_pk_fp8_f32(q[2], q[3], v, true);
      *(int*)(h8row + c) = v;
    }
  }
}
DEVI void load_row16(const float* xr, float (&xv)[16]) {
  const int lane = TIDX & 63;
#pragma unroll
  for (int i = 0; i < 4; ++i) {
    f32x4 v = __builtin_nontemporal_load((const f32x4*)(xr + i * 256 + lane * 4));
    xv[i * 4 + 0] = v.x; xv[i * 4 + 1] = v.y; xv[i * 4 + 2] = v.z; xv[i * 4 + 3] = v.w;
  }
}
DEVI void load_row16_bf(const u16* xr, float (&xv)[16]) {
  const int lane = TIDX & 63;
#pragma unroll
  for (int i = 0; i < 4; ++i) {
    const u32x2 v = *(const u32x2*)(xr + i * 256 + lane * 4);
    xv[i * 4 + 0] = __uint_as_float(v.x << 16); xv[i * 4 + 1] = __uint_as_float(v.x & 0xffff0000u);
    xv[i * 4 + 2] = __uint_as_float(v.y << 16); xv[i * 4 + 3] = __uint_as_float(v.y & 0xffff0000u);
  }
}
DEVI float router_dot(const float (&hv)[4][16], const float* wrow) {
  const int lane = TIDX & 63;
  const float* w = wrow + lane * 4;
  float pr[4] = {0.f, 0.f, 0.f, 0.f};
#pragma unroll
  for (int i = 0; i < 4; ++i) {
    const f32x4 wv = *(const f32x4*)(w + i * 256);
#pragma unroll
    for (int r = 0; r < 4; ++r)
      pr[r] += hv[r][i * 4] * wv.x + hv[r][i * 4 + 1] * wv.y + hv[r][i * 4 + 2] * wv.z + hv[r][i * 4 + 3] * wv.w;
  }
  const bool up = (lane & 32) != 0;
  float s0 = up ? pr[0] : pr[2], s1 = up ? pr[1] : pr[3];
  float k0 = up ? pr[2] : pr[0], k1 = up ? pr[3] : pr[1];
  k0 += __shfl_xor(s0, 32); k1 += __shfl_xor(s1, 32);
  const bool up2 = (lane & 16) != 0;
  float sv = up2 ? k0 : k1, kv = up2 ? k1 : k0;
  kv += __shfl_xor(sv, 16);
  kv += __shfl_xor(kv, 8); kv += __shfl_xor(kv, 4); kv += __shfl_xor(kv, 2); kv += __shfl_xor(kv, 1);
  return kv;
}
#define XB_TMO      128
#define XB_XCNT(j)  (256  + 64 * (j))
#define XB_XSUB(j)  (1280 + 64 * (j))
#define XB_XGEN(j)  (2304 + 64 * (j))
#define XB_TOP      3328
#define XB_TOPGEN   3392
#define XB_SPIN_CAP (1u << 20)
#define LAS __attribute__((address_space(3)))
DEVI unsigned xb_ld(unsigned* p) { return __hip_atomic_load(p, __ATOMIC_RELAXED, __HIP_MEMORY_SCOPE_AGENT); }
DEVI unsigned xb_add(unsigned* p, unsigned v) { return __hip_atomic_fetch_add(p, v, __ATOMIC_RELAXED, __HIP_MEMORY_SCOPE_AGENT); }
DEVI unsigned xb_xcc_id() { return (unsigned)__builtin_amdgcn_s_getreg((3 << 11) | 20) & 0xFu; }
#define XB_SPIN(cond, bar) do { unsigned _sp = 0; while (cond) { __builtin_amdgcn_s_sleep(1); \
    if ((++_sp & 255u) == 0u) { if (xb_ld(&(bar)[XB_TMO])) break; if (_sp > XB_SPIN_CAP) { atomicAdd(&(bar)[XB_TMO], 1u); break; } } } } while (0)
DEVI void xcd_barrier_post(unsigned* bar) {
  if (TIDX == 0) (void)xb_add(&bar[XB_XCNT(xb_xcc_id())], 1u);
}
DEVI void xcd_barrier_complete(unsigned* bar, unsigned x, unsigned& nloc, unsigned& nx) {
  const unsigned G = gridDim.x * gridDim.y * gridDim.z;
  unsigned sum, cnt, mine, sp = 0u;
  for (;;) {
    sum = 0u; cnt = 0u; mine = 0u;
#pragma unroll
    for (unsigned j = 0; j < 16; ++j) { const unsigned c = xb_ld(&bar[XB_XCNT(j)]); sum += c; cnt += (c > 0u) ? 1u : 0u; mine = (j == x) ? c : mine; }
    if (sum == G) break;
    __builtin_amdgcn_s_sleep(1);
    if ((++sp & 255u) == 0u) { if (xb_ld(&bar[XB_TMO])) break; if (sp > XB_SPIN_CAP) { atomicAdd(&bar[XB_TMO], 1u); break; } }
  }
  nloc = mine > 0u ? mine : 1u; nx = cnt > 0u ? cnt : 1u;
}
DEVI void xcd_barrier(unsigned* bar, volatile LAS unsigned* st) {
  asm volatile("s_waitcnt vmcnt(0)" ::: "memory");
  __syncthreads();
  if (TIDX == 0) {
    const unsigned x = xb_xcc_id();
    __builtin_amdgcn_s_waitcnt(0);
    unsigned nloc = st[0], nx = st[1];
    if (nloc == 0u) { xcd_barrier_complete(bar, x, nloc, nx); st[0] = nloc; st[1] = nx; }
    const unsigned old = xb_add(&bar[XB_XSUB(x)], 1u);
    const unsigned gen = old / nloc;
    if (old + 1u == (gen + 1u) * nloc) {
      __builtin_amdgcn_fence(__ATOMIC_RELEASE, "agent");
      asm volatile("s_waitcnt vmcnt(0)" ::: "memory");
      const unsigned og = xb_add(&bar[XB_TOP], 1u);
      const unsigned tg = og / nx;
      if (og + 1u == (tg + 1u) * nx) xb_add(&bar[XB_TOPGEN], 1u);
      else XB_SPIN(xb_ld(&bar[XB_TOPGEN]) == tg, bar);
      __builtin_amdgcn_fence(__ATOMIC_ACQUIRE, "agent");
      xb_add(&bar[XB_XGEN(x)], 1u);
      asm volatile("s_waitcnt vmcnt(0)" ::: "memory");
    } else {
      XB_SPIN(xb_ld(&bar[XB_XGEN(x)]) == gen, bar);
      __builtin_amdgcn_fence(__ATOMIC_ACQUIRE, "agent");
      asm volatile("s_waitcnt vmcnt(0)" ::: "memory");
    }
  }
  __syncthreads();
}

namespace v2 {
typedef LAS unsigned char* ldsp_t;
constexpr int BM = 256, BK = 64, HALF = 128, HTB = HALF * BK * 2, STAGE_BYTES = 8 * HTB;
constexpr int NW = 8;
constexpr int LDS_XTRA = STAGE_BYTES;
constexpr int LDS_BARW = STAGE_BYTES + 16384;
constexpr int LDS_TOTAL = LDS_BARW + 16;

DEVI int lds_byte(int r, int c) { const int st = (r >> 4) * 2 + (c >> 5), rr = r & 15, cc = c & 31, ob = rr * 64 + cc * 2; return st * 1024 + (ob ^ (((ob >> 9) & 1) << 5)); }
DEVI void stage_rc(int b, int& R, int& C) { const int st = b / 1024, sb = b % 1024, swz = sb ^ (((sb >> 9) & 1) << 5); R = (st >> 1) * 16 + swz / 64; C = (st & 1) * 32 + (swz % 64) / 2; }
DEVI int perm32(int rho) { const int n = rho >> 4, i = rho & 15; return 8 * (i >> 2) + 4 * n + (i & 3); }

DEVI void acc_zero(f32x4 (&acc)[2][2][4][2]) {
#pragma unroll
  for (int a = 0; a < 2; ++a)
#pragma unroll
    for (int b = 0; b < 2; ++b)
#pragma unroll
      for (int m = 0; m < 4; ++m)
#pragma unroll
        for (int n = 0; n < 2; ++n) acc[a][b][m][n] = (f32x4){0.f, 0.f, 0.f, 0.f};
}
struct Unit { const char* A; const char* B; const int* rows; int nvalid; int u0, u1, u2, u3; };

typedef int i32x8 __attribute__((ext_vector_type(8)));
typedef int i32x4v __attribute__((ext_vector_type(4)));
DEVI i32x8 cat8(bf16x8 lo, bf16x8 hi) { return __builtin_shufflevector(__builtin_bit_cast(i32x4v, lo), __builtin_bit_cast(i32x4v, hi), 0, 1, 2, 3, 4, 5, 6, 7); }
DEVI const char* sptr(const char* p) {
  const unsigned long long v = (unsigned long long)p;
  const unsigned lo = (unsigned)__builtin_amdgcn_readfirstlane((int)(unsigned)v), hi = (unsigned)__builtin_amdgcn_readfirstlane((int)(unsigned)(v >> 32));
  return (const char*)(((unsigned long long)hi << 32) | lo);
}
template <bool PERM, bool GATHER, bool F8, class Epi, class Sched>
DEVI void gemm_phase(ldsp_t lds, int lda_b, int ldb_b, int nt, const Sched& S, const Epi& E) {
  const int tid = TIDX, wid = __builtin_amdgcn_readfirstlane(tid >> 6), lane = tid & 63, wr = wid >> 2, wc = wid & 3, fr = lane & 15, fq = lane >> 4;
  unsigned voffA[2], voffB[2]; int RA[2], CA2[2];
#pragma unroll
  for (int i = 0; i < 2; ++i) {
    int R, C; stage_rc(tid * 16 + i * 8192, R, C);
    const int Rb = PERM ? ((R & ~31) + perm32(R & 31)) : R;
    RA[i] = R; CA2[i] = C * 2;
    voffA[i] = (unsigned)(R * lda_b + C * 2); voffB[i] = (unsigned)(Rb * ldb_b + C * 2);
  }
  const size_t kstep = (size_t)(BK * 2);
  const size_t hstepA = (size_t)HALF * lda_b, hstepB = (size_t)HALF * ldb_b;
  const unsigned ldsw = (unsigned)wid * 1024u, ldsbase = (unsigned)(size_t)lds;
  const int aoff = lds_byte(wr * 64 + fr, fq * 8), boff = lds_byte(wc * 32 + fr, fq * 8);
#define G_SA(b, h) (((b) * 2 + (h)) * HTB)
#define G_SB(b, h) ((4 + (b) * 2 + (h)) * HTB)
#define G_DMA(sbase, voff, ldsaddr) asm volatile("s_mov_b32 m0, %2\n\ts_nop 0\n\tglobal_load_lds_dwordx4 %0, %1" :: "v"(voff), "s"(sbase), "s"(ldsaddr) : "memory", "m0")
#define G_STAGE(bufoff, gbase, voff) do { const char* sb_ = sptr((const char*)(gbase)); _Pragma("unroll") for (int _i = 0; _i < 2; ++_i) \
    G_DMA(sb_, (voff)[_i], (unsigned)__builtin_amdgcn_readfirstlane((int)(ldsbase + (unsigned)(bufoff) + ldsw + (unsigned)_i * 8192u))); } while (0)
#define G_STAGE_A(bufoff, abase, go, h, koff) do { if (GATHER) { const char* sb_ = sptr((const char*)(abase) + (koff)); _Pragma("unroll") for (int _i = 0; _i < 2; ++_i) \
    G_DMA(sb_, (go)[h][_i], (unsigned)__builtin_amdgcn_readfirstlane((int)(ldsbase + (unsigned)(bufoff) + ldsw + (unsigned)_i * 8192u))); } \
    else G_STAGE(bufoff, (abase) + (h) * hstepA + (koff), voffA); } while (0)
#define G_LDA(dst, b, h) do { _Pragma("unroll") for (int m = 0; m < 4; ++m) { if (F8) dst##8[m] = cat8(*(const LAS bf16x8*)(lds + G_SA(b, h) + aoff + m * 2048), *(const LAS bf16x8*)(lds + G_SA(b, h) + aoff + m * 2048 + 1024)); \
    else { _Pragma("unroll") for (int k = 0; k < 2; ++k) dst[m][k] = *(const LAS bf16x8*)(lds + G_SA(b, h) + aoff + m * 2048 + k * 1024); } } } while (0)
#define G_LDB(dst, b, h) do { _Pragma("unroll") for (int n = 0; n < 2; ++n) { if (F8) dst##8[n] = cat8(*(const LAS bf16x8*)(lds + G_SB(b, h) + boff + n * 2048), *(const LAS bf16x8*)(lds + G_SB(b, h) + boff + n * 2048 + 1024)); \
    else { _Pragma("unroll") for (int k = 0; k < 2; ++k) dst[n][k] = *(const LAS bf16x8*)(lds + G_SB(b, h) + boff + n * 2048 + k * 1024); } } } while (0)
#define G_MMA(ai, bj, At, Bt) do { __builtin_amdgcn_s_setprio(1); _Pragma("unroll") for (int m = 0; m < 4; ++m) _Pragma("unroll") for (int n = 0; n < 2; ++n) { \
    if (F8) asm("v_mfma_scale_f32_16x16x128_f8f6f4 %0, %1, %2, %0, %3, %4 op_sel_hi:[0,0,0]" : "+v"(acc[ai][bj][m][n]) : "v"(Bt##8[n]), "v"(At##8[m]), "v"(f8wscale), "v"(f8ascale)); \
    else { _Pragma("unroll") for (int k = 0; k < 2; ++k) acc[ai][bj][m][n] = __builtin_amdgcn_mfma_f32_16x16x32_bf16(Bt[n][k], At[m][k], acc[ai][bj][m][n], 0, 0, 0); } } \
    __builtin_amdgcn_s_setprio(0); } while (0)
#define G_WAIT_V(n) asm volatile("s_waitcnt vmcnt(" #n ")" ::: "memory")
#define G_WAIT_L(n) asm volatile("s_waitcnt lgkmcnt(" #n ")" ::: "memory")
#define G_BAR __builtin_amdgcn_s_barrier()
#define G_SCHED __builtin_amdgcn_sched_barrier(0)
  Unit cur, nxt; int ui = 0;
  if (!S.next(0, cur)) return;
  f32x4 acc[2][2][4][2];
  E.init(acc, cur, wr, wc, fr, fq);
  bf16x8 At[4][2], B0[2][2], B1[2][2];
  i32x8 At8[4], B08[2], B18[2];
  const int f8wscale = 0x79797979, f8ascale = 0x7f7f7f7f;
  unsigned gcur[2][2];
  auto gather_offs = [&](const Unit& u, unsigned (&go)[2][2]) {
#pragma unroll
    for (int h = 0; h < 2; ++h)
#pragma unroll
      for (int i = 0; i < 2; ++i) {
        const int r = h * HALF + RA[i];
        const int t = (r < u.nvalid) ? (u.rows[r] >> 1) : 0;
        go[h][i] = (unsigned)t * (unsigned)lda_b + (unsigned)CA2[i];
      }
  };
  if (GATHER) gather_offs(cur, gcur);
  const char* cA = cur.A; const char* cB = cur.B;
  G_STAGE(G_SB(0, 0), cB, voffB); G_STAGE_A(G_SA(0, 0), cA, gcur, 0, 0); G_STAGE(G_SB(0, 1), cB + hstepB, voffB); G_STAGE_A(G_SA(0, 1), cA, gcur, 1, 0);
  if (wr == 1) G_BAR;
  G_WAIT_V(4); G_BAR;
  G_STAGE(G_SB(1, 0), cB + kstep, voffB); G_STAGE_A(G_SA(1, 0), cA, gcur, 0, kstep); G_STAGE(G_SB(1, 1), cB + hstepB + kstep, voffB);
  G_WAIT_V(6); G_BAR;
  for (;;) {
    const bool has_next = S.next(ui + 1, nxt);
    const char* nA = has_next ? nxt.A : cA; const char* nB = has_next ? nxt.B : cB;
#pragma clang loop unroll(disable)
    for (int t = 0; t < nt; t += 2) {
      const bool last = (t == nt - 2);
      const size_t k1 = (size_t)(t + 1) * kstep;
      const char* a2 = last ? nA : cA; const char* b2 = last ? nB : cB + (size_t)(t + 2) * kstep;
      const size_t ka2 = last ? 0 : (size_t)(t + 2) * kstep;
      const char* b3 = b2 + kstep; const size_t ka3 = ka2 + kstep;
      unsigned gN[2][2];
      if (GATHER && last) {
        if (has_next) gather_offs(nxt, gN);
        else {
#pragma unroll
          for (int h = 0; h < 2; ++h)
#pragma unroll
            for (int i = 0; i < 2; ++i) gN[h][i] = gcur[h][i];
        }
      }
#define G_STAGE_A2(bufoff, h, koff) do { if (GATHER) { if (last) G_STAGE_A(bufoff, cA, gN, h, (koff) - ka2); else G_STAGE_A(bufoff, cA, gcur, h, koff); } \
        else G_STAGE_A(bufoff, a2, gcur, h, koff); } while (0)
      G_LDB(B0, 0, 0); G_SCHED; G_LDA(At, 0, 0); G_STAGE_A(G_SA(1, 1), cA, gcur, 1, k1);
      G_WAIT_L(8); G_BAR; G_WAIT_L(0); G_MMA(0, 0, At, B0); G_BAR; G_SCHED;
      G_LDB(B1, 0, 1); G_STAGE(G_SB(0, 0), b2, voffB);
      G_BAR; G_WAIT_L(0); G_MMA(0, 1, At, B1); G_BAR;
      G_LDA(At, 0, 1); G_STAGE_A2(G_SA(0, 0), 0, ka2);
      G_BAR; G_WAIT_L(0); G_MMA(1, 0, At, B0); G_BAR; G_SCHED;
      G_STAGE(G_SB(0, 1), b2 + hstepB, voffB);
      G_WAIT_V(6); G_BAR; G_MMA(1, 1, At, B1); G_BAR;
      G_LDB(B0, 1, 0); G_SCHED; G_LDA(At, 1, 0); G_STAGE_A2(G_SA(0, 1), 1, ka2);
      G_WAIT_L(8); G_BAR; G_WAIT_L(0); G_MMA(0, 0, At, B0); G_BAR; G_SCHED;
      G_LDB(B1, 1, 1); G_STAGE(G_SB(1, 0), b3, voffB);
      G_BAR; G_WAIT_L(0); G_MMA(0, 1, At, B1); G_BAR;
      G_LDA(At, 1, 1); G_STAGE_A2(G_SA(1, 0), 0, ka3);
      G_BAR; G_WAIT_L(0); G_MMA(1, 0, At, B0); G_BAR; G_SCHED;
      G_STAGE(G_SB(1, 1), b3 + hstepB, voffB);
      G_WAIT_V(6); G_BAR; G_MMA(1, 1, At, B1); G_BAR;
      if (GATHER && last) {
#pragma unroll
        for (int h = 0; h < 2; ++h)
#pragma unroll
          for (int i = 0; i < 2; ++i) gcur[h][i] = gN[h][i];
      }
#undef G_STAGE_A2
    }
    G_SCHED;
    if (F8) {
      asm volatile("s_nop 15\n\ts_nop 15" ::: "memory");
#pragma unroll
      for (int a_ = 0; a_ < 2; ++a_)
#pragma unroll
        for (int b_ = 0; b_ < 2; ++b_)
#pragma unroll
          for (int m_ = 0; m_ < 4; ++m_)
#pragma unroll
            for (int n_ = 0; n_ < 2; ++n_) asm volatile("" : "+v"(acc[a_][b_][m_][n_]));
    }
    E(acc, cur, wr, wc, fr, fq);
    G_SCHED;
    if (!has_next) break;
    cur = nxt; cA = nA; cB = nB; ++ui;
    E.init(acc, cur, wr, wc, fr, fq);
  }
  G_WAIT_V(0);
  if (wr == 0) G_BAR;
  G_BAR;
#undef G_SA
#undef G_SB
#undef G_STAGE
#undef G_DMA
#undef G_STAGE_A
#undef G_LDA
#undef G_LDB
#undef G_MMA
#undef G_WAIT_V
#undef G_WAIT_L
#undef G_BAR
#undef G_SCHED
}

DEVI unsigned uoff(unsigned x) { return (unsigned)__builtin_amdgcn_readfirstlane((int)x); }
DEVI bool tile_order(int i, int G, int c, int nM, int nN, int& pm, int& pn) {
  const int nwg = nM * nN;
  const long L = (long)i * G + c; if (L >= nwg) return false;
  int wgid = (int)L; { const int q = nwg / 8, r = nwg % 8, xcd = wgid % 8, off = wgid / 8; wgid = (xcd < r ? xcd * (q + 1) : r * (q + 1) + (xcd - r) * q) + off; }
  const int WGM = 8;
  const int nig = WGM * nN, gid = wgid / nig, fm = gid * WGM, gsz = (nM - fm) < WGM ? (nM - fm) : WGM;
  pm = fm + ((wgid % nig) % gsz); pn = (wgid % nig) / gsz;
  pm = __builtin_amdgcn_readfirstlane(pm); pn = __builtin_amdgcn_readfirstlane(pn);
  return true;
}
struct EpiRawBf16 {
  u16* O; int ldc; float sc;
  DEVI void init(f32x4 (&acc)[2][2][4][2], const Unit&, int, int, int, int) const { acc_zero(acc); }
  DEVI void operator()(const f32x4 (&acc)[2][2][4][2], const Unit& u, int wr, int wc, int fr, int fq) const {
    const unsigned off0 = ((unsigned)(u.u0 + wr * 64 + fr) * (unsigned)ldc + (unsigned)(u.u1 + wc * 32 + 8 * fq)) * 2u;
#pragma unroll
    for (int ai = 0; ai < 2; ++ai)
#pragma unroll
      for (int m = 0; m < 4; ++m) {
        char* rowp = (char*)O + (off0 + (unsigned)(ai * HALF + m * 16) * (unsigned)ldc * 2u);
#pragma unroll
        for (int bj = 0; bj < 2; ++bj) {
          const f32x4 v0 = acc[ai][bj][m][0], v1 = acc[ai][bj][m][1];
          u32x4 w; w.x = pk2(v0[0], v0[1]); w.y = pk2(v0[2], v0[3]); w.z = pk2(v1[0], v1[1]); w.w = pk2(v1[2], v1[3]);
          *(u32x4*)(rowp + bj * HALF * 2) = w;
        }
      }
  }
};

struct EpiRawF8 {
  unsigned char* O; int ldc; float sc;
  DEVI void init(f32x4 (&acc)[2][2][4][2], const Unit&, int, int, int, int) const { acc_zero(acc); }
  DEVI void operator()(const f32x4 (&acc)[2][2][4][2], const Unit& u, int wr, int wc, int fr, int fq) const {
    const unsigned off0 = (unsigned)(u.u0 + wr * 64 + fr) * (unsigned)ldc + (unsigned)(u.u1 + wc * 32 + 8 * fq);
#pragma unroll
    for (int ai = 0; ai < 2; ++ai)
#pragma unroll
      for (int m = 0; m < 4; ++m) {
        unsigned char* rowp = O + (off0 + (unsigned)(ai * HALF + m * 16) * (unsigned)ldc);
#pragma unroll
        for (int bj = 0; bj < 2; ++bj) {
          u32x2 w;
#pragma unroll
          for (int n = 0; n < 2; ++n) {
            const f32x4 v = acc[ai][bj][m][n] * sc;
            int q = __builtin_amdgcn_cvt_pk_fp8_f32(__builtin_amdgcn_fmed3f(v[0], -448.f, 448.f), __builtin_amdgcn_fmed3f(v[1], -448.f, 448.f), 0, false);
            q = __builtin_amdgcn_cvt_pk_fp8_f32(__builtin_amdgcn_fmed3f(v[2], -448.f, 448.f), __builtin_amdgcn_fmed3f(v[3], -448.f, 448.f), q, true);
            w[n] = (unsigned)q;
          }
          *(u32x2*)(rowp + bj * HALF) = w;
        }
      }
  }
};
DEVI size_t z8_block(int pm, int branch, int cb) { return (size_t)((pm * 4 + branch) * 8 + cb) * 32768; }
struct EpiZ8 {
  unsigned char* O;
  DEVI void init(f32x4 (&acc)[2][2][4][2], const Unit&, int, int, int, int) const { acc_zero(acc); }
  DEVI void operator()(const f32x4 (&acc)[2][2][4][2], const Unit& u, int wr, int wc, int fr, int fq) const {
    const int pm = u.u0 >> 8, pn = u.u1 >> 8, n = pn >> 2, cq = pn & 3;
    const unsigned lw16 = (unsigned)((wr * 4 + wc) * 64 + fr + 16 * fq) * 16u;
#pragma unroll
    for (int bj = 0; bj < 2; ++bj) {
      unsigned char* blk = O + z8_block(pm, n, cq * 2 + bj) + lw16;
#pragma unroll
      for (int P = 0; P < 4; ++P) {
        u32x4 w;
#pragma unroll
        for (int h = 0; h < 2; ++h)
#pragma unroll
          for (int nn = 0; nn < 2; ++nn) {
            const int g = 2 * P + h;
            const f32x4 v = acc[g >> 2][bj][g & 3][nn];
            int q = __builtin_amdgcn_cvt_pk_fp8_f32(__builtin_amdgcn_fmed3f(v[0], -448.f, 448.f), __builtin_amdgcn_fmed3f(v[1], -448.f, 448.f), 0, false);
            q = __builtin_amdgcn_cvt_pk_fp8_f32(__builtin_amdgcn_fmed3f(v[2], -448.f, 448.f), __builtin_amdgcn_fmed3f(v[3], -448.f, 448.f), q, true);
            w[2 * h + nn] = (unsigned)q;
          }
        *(u32x4*)(blk + P * 8192) = w;
      }
    }
  }
};
struct SchedB { const char* ws; const char* h8; int G, c;
  DEVI bool next(int i, Unit& u) const { int pm, pn; if (!tile_order(i, G, c, NTOK / 256, INP / 256, pm, pn)) return false;
    u.A = h8 + uoff((unsigned)pm * 256u * 1024u); u.B = ws + OFF_WIN + uoff((unsigned)pn * 256u * 1024u);        u.rows = nullptr; u.nvalid = 0; u.u0 = pm * 256; u.u1 = pn * 256; u.u2 = 0; u.u3 = 0; return true; } };
struct EpiB { u16* O; float* ssq;
  DEVI void init(f32x4 (&acc)[2][2][4][2], const Unit&, int, int, int, int) const { acc_zero(acc); }
  DEVI void operator()(const f32x4 (&acc)[2][2][4][2], const Unit& u, int wr, int wc, int fr, int fq) const {
    EpiRawBf16 E{O, PLD, 1.f}; E(acc, u, wr, wc, fr, fq);
    if (u.u1 < 512) {
      const bool iskv = u.u1 != 0;
#pragma unroll
      for (int ai = 0; ai < 2; ++ai)
#pragma unroll
        for (int m = 0; m < 4; ++m) {
          float ss = 0.f;
#pragma unroll
          for (int bj = 0; bj < 2; ++bj)
#pragma unroll
            for (int n = 0; n < 2; ++n)
#pragma unroll
              for (int j = 0; j < 4; ++j) { const float v = acc[ai][bj][m][n][j]; if (!(iskv && bj == 1)) ss += v * v; }
          ss += __shfl_xor(ss, 16); ss += __shfl_xor(ss, 32);
          if (fq == 0) ssq[(size_t)(u.u0 + ai * HALF + wr * 64 + m * 16 + fr) * 8 + (iskv ? 4 : 0) + wc] = ss;
        }
    }
  }
};
DEVI void phaseB2(KP p, ldsp_t lds) {
  SchedB S{(const char*)p->ws, (const char*)h8base(p), (int)gridDim.x, BIDX};
  EpiB E{wsp<u16>(p, OFF_PRAW), wsp<float>(p, OFF_SSQ)};
  gemm_phase<true, false, true>(lds, 1024, 1024, 8, S, E);
}
struct SchedC { const char* ws; int G, c;
  DEVI bool next(int i, Unit& u) const { int pm, pn; if (!tile_order(i, G, c, NTOK / 256, 4, pm, pn)) return false;
    const bool kv = pn >= 2; const int pj = pn & 1;
    u.A = ws + OFF_PRAW + uoff((unsigned)pm * 256u * (unsigned)(PLD * 2) + (kv ? 512u : 0u)); u.B = ws + (kv ? OFF_WKVB : OFF_WQB) + uoff((unsigned)pj * 256u * 512u); u.rows = nullptr; u.nvalid = 0;
    u.u0 = pm * 256; u.u1 = pj * 256; u.u2 = kv; u.u3 = 0; return true; } };
struct EpiC { u16* Oq; u16* Okv; const float* ssq;
  DEVI void init(f32x4 (&acc)[2][2][4][2], const Unit&, int, int, int, int) const { acc_zero(acc); }
  DEVI void operator()(const f32x4 (&acc)[2][2][4][2], const Unit& u, int wr, int wc, int fr, int fq) const {
    const bool kv = u.u2 != 0;
    u16* O = kv ? Okv : Oq;
    const int row0 = u.u0 + wr * 64 + fr, col0 = u.u1 + wc * 32 + 8 * fq;
    f32x4 sq[2][4];
#pragma unroll
    for (int ai = 0; ai < 2; ++ai)
#pragma unroll
      for (int m = 0; m < 4; ++m) sq[ai][m] = *(const f32x4*)(ssq + (size_t)(row0 + ai * HALF + m * 16) * 8 + (kv ? 4 : 0));
#pragma unroll
    for (int ai = 0; ai < 2; ++ai)
#pragma unroll
      for (int m = 0; m < 4; ++m) {
        const size_t r = (size_t)(row0 + ai * HALF + m * 16);
        const float tot = sq[ai][m].x + sq[ai][m].y + sq[ai][m].z + sq[ai][m].w;
        const float sc = kv ? rsqrtf(tot * (1.f / 128.f) + EPS) : rsqrtf(tot * (1.f / 256.f) + EPS) * (0.10206207261596575f * LOG2E);
        u16* rowp = O + r * 512 + col0;
#pragma unroll
        for (int bj = 0; bj < 2; ++bj) {
          const f32x4 v0 = acc[ai][bj][m][0] * sc, v1 = acc[ai][bj][m][1] * sc;
          u32x4 w; w.x = pk2(v0[0], v0[1]); w.y = pk2(v0[2], v0[3]); w.z = pk2(v1[0], v1[1]); w.w = pk2(v1[2], v1[3]);
          *(u32x4*)(rowp + bj * HALF) = w;
        }
      }
  }
};
DEVI void phaseC2(KP p, ldsp_t lds) {
  SchedC S{(const char*)p->ws, (int)gridDim.x, BIDX};
  EpiC E{wsp<u16>(p, OFF_QARAW), wsp<u16>(p, OFF_KVARAW), wsp<float>(p, OFF_SSQ)};
  int nt = 4; asm volatile("" : "+s"(nt));
  gemm_phase<true, false, false>(lds, PLD * 2, 512, nt, S, E);
}

DEVI void ld16(const u16* src, float (&v)[16]) {
  const u32x4 a = *(const u32x4*)src, b = *(const u32x4*)(src + 8);
  const unsigned w[8] = {a.x, a.y, a.z, a.w, b.x, b.y, b.z, b.w};
#pragma unroll
  for (int i = 0; i < 8; ++i) { v[2 * i] = __uint_as_float(w[i] << 16); v[2 * i + 1] = __uint_as_float(w[i] & 0xffff0000u); }
}
DEVI void st16(u16* dst, const float (&v)[16]) {
  u32x4 a, b;
  a.x = pk2(v[0], v[1]); a.y = pk2(v[2], v[3]); a.z = pk2(v[4], v[5]); a.w = pk2(v[6], v[7]);
  b.x = pk2(v[8], v[9]); b.y = pk2(v[10], v[11]); b.z = pk2(v[12], v[13]); b.w = pk2(v[14], v[15]);
  *(u32x4*)dst = a; *(u32x4*)(dst + 8) = b;
}
DEVI void rope16c(float (&v)[16], const float* cs16, int pos) {
  const f32x2* t = (const f32x2*)(cs16 + pos * 16);
#pragma unroll
  for (int i = 0; i < 8; ++i) { const f32x2 cs = t[i]; const float x1 = v[i], x2 = v[8 + i]; v[i] = x1 * cs.x - x2 * cs.y; v[8 + i] = x2 * cs.x + x1 * cs.y; }
}
DEVI void rope32c(float (&lo)[16], float (&hi)[16], const float* cs32, int pos) {
  const f32x2* t = (const f32x2*)(cs32 + pos * 32);
#pragma unroll
  for (int i = 0; i < 16; ++i) { const f32x2 cs = t[i]; const float x1 = lo[i], x2 = hi[i]; lo[i] = x1 * cs.x - x2 * cs.y; hi[i] = x2 * cs.x + x1 * cs.y; }
}
DEVI float ssq16(const float (&v)[16]) { float s = 0.f;
#pragma unroll
  for (int i = 0; i < 16; ++i) s += v[i] * v[i];
  return s; }
DEVI void scale16(float (&v)[16], float s) {
#pragma unroll
  for (int i = 0; i < 16; ++i) v[i] *= s; }
DEVI void cvt16(const u32x4 a, const u32x4 b, float (&v)[16]) {
  const unsigned w[8] = {a.x, a.y, a.z, a.w, b.x, b.y, b.z, b.w};
#pragma unroll
  for (int i = 0; i < 8; ++i) { v[2 * i] = __uint_as_float(w[i] << 16); v[2 * i + 1] = __uint_as_float(w[i] & 0xffff0000u); }
}
DEVI void phaseP2(KP p, int l, ldsp_t lds) {
  const int tid = TIDX, tk = tid >> 3, pt = tid & 7;
  u16* PR = wsp<u16>(p, OFF_PRAW);
  u16* QA = wsp<u16>(p, OFF_QARAW);
  const float* cs32 = wsp<float>(p, OFF_CS32);
  const float* cs16 = wsp<float>(p, OFF_CS16);
  const float QS = 0.125f * LOG2E;
  for (int item = BIDX; item < NTOK / 64; item += gridDim.x) {
    const int tok0 = item * 64, rr0 = tok0 % TPB;
    const bool lat = rr0 >= NCTX;
    const size_t tok = (size_t)tok0 + tk;
    const int t = rr0 + tk - NCTX, grow = (t >> 6) & 63, gcol = t & 63;
    u16* pr = PR + tok * PLD;
    u16* qar = QA + tok * 512 + 96 * (pt >> 1) + 64 + 16 * (pt & 1);
    const int g4 = pt & 3;
    u32x4 r_qa[2], r_kr[2], r_qb[4], r_kb[4], r_qd[4], r_kd[4];
#define LD8(ptr) (*(const u32x4*)(ptr))
    if (lat) {
#pragma unroll
      for (int i = 0; i < 2; ++i) { r_qa[i] = LD8(qar + 8 * i); r_kr[i] = LD8(pr + 384 + 16 * (pt & 1) + 8 * i); }
#pragma unroll
      for (int i = 0; i < 4; ++i) { r_qb[i] = LD8(pr + 512 + 32 * pt + 8 * i); r_kb[i] = LD8(pr + 768 + 32 * g4 + 8 * i); }
    }
#pragma unroll
    for (int i = 0; i < 4; ++i) { r_qd[i] = LD8(pr + 1792 + 32 * pt + 8 * i); r_kd[i] = LD8(pr + 2048 + 32 * g4 + 8 * i); }
#undef LD8
    if (lat) {
      { float v[16]; cvt16(r_qa[0], r_qa[1], v); rope16c(v, cs16, (pt & 1) ? gcol : grow); st16(qar, v); }
      if (pt < 2) { float v[16]; cvt16(r_kr[0], r_kr[1], v); rope16c(v, cs16, pt == 0 ? grow : gcol); st16(pr + 384 + 16 * pt, v); }
      { float lo[16], hi[16]; cvt16(r_qb[0], r_qb[1], lo); cvt16(r_qb[2], r_qb[3], hi); rope32c(lo, hi, cs32, (pt & 1) ? gcol : grow); st16(pr + 512 + 32 * pt, lo); st16(pr + 512 + 32 * pt + 16, hi); }
      if (pt < 4) { float lo[16], hi[16]; cvt16(r_kb[0], r_kb[1], lo); cvt16(r_kb[2], r_kb[3], hi); rope32c(lo, hi, cs32, (pt & 1) ? gcol : grow); st16(pr + 768 + 32 * pt, lo); st16(pr + 768 + 32 * pt + 16, hi); }
    }
    {
      float lo[16], hi[16]; cvt16(r_qd[0], r_qd[1], lo); cvt16(r_qd[2], r_qd[3], hi);
      float ss = ssq16(lo) + ssq16(hi); ss += __shfl_xor(ss, 1);
      const float rs = rsqrtf(ss * (1.f / 64.f) + EPS);
      const float* g = p->g_q_d + l * 64 + 32 * (pt & 1);
#pragma unroll
      for (int i = 0; i < 16; ++i) { lo[i] *= rs * g[i]; hi[i] *= rs * g[16 + i]; }
      if (lat) rope32c(lo, hi, cs32, (pt & 1) ? gcol : grow);
      scale16(lo, QS); scale16(hi, QS);
      st16(pr + 1792 + 32 * pt, lo); st16(pr + 1792 + 32 * pt + 16, hi);
    }
    {
      float lo[16], hi[16]; cvt16(r_kd[0], r_kd[1], lo); cvt16(r_kd[2], r_kd[3], hi);
      float ss = ssq16(lo) + ssq16(hi); ss += __shfl_xor(ss, 1);
      const float rs = rsqrtf(ss * (1.f / 64.f) + EPS);
      const float* g = p->g_k_d + l * 64 + 32 * (g4 & 1);
#pragma unroll
      for (int i = 0; i < 16; ++i) { lo[i] *= rs * g[i]; hi[i] *= rs * g[16 + i]; }
      if (lat) rope32c(lo, hi, cs32, (g4 & 1) ? gcol : grow);
      if (pt < 4) { st16(pr + 2048 + 32 * g4, lo); st16(pr + 2048 + 32 * g4 + 16, hi); }
    }
  }
}

DEVI void conv_load(const ConvT& c, int lane, f32x4 (&v)[8]) {
  const int kk = lane >> 3, n4 = (lane & 7) * 4;
  const float* sp = (c.src2 && n4 >= 16) ? c.src2 + (n4 - 16) : (c.src ? c.src + n4 : nullptr);
#pragma unroll
  for (int i = 0; i < 8; ++i) v[i] = sp ? __builtin_nontemporal_load((const f32x4*)(sp + (size_t)(kk + 8 * i) * c.ld)) : f32x4{0.f, 0.f, 0.f, 0.f};
}
DEVI void conv_store(const ConvT& c, LAS float* t, int lane, const f32x4 (&v)[8]) {
  const int kk = lane >> 3, n4 = (lane & 7) * 4;
#pragma unroll
  for (int i = 0; i < 8; ++i) {
    const int k = kk + 8 * i;
    const float s = (c.ks ? c.ks[k] : 1.f) * c.mul;
    t[(n4 + 0) * 65 + k] = v[i].x * s; t[(n4 + 1) * 65 + k] = v[i].y * s;
    t[(n4 + 2) * 65 + k] = v[i].z * s; t[(n4 + 3) * 65 + k] = v[i].w * s;
  }
  asm volatile("s_waitcnt lgkmcnt(0)" ::: "memory");
  const int n = lane >> 1, k0 = (lane & 1) * 32;
  const LAS float* r = t + n * 65 + k0;
  if (c.ldd < 0) {
    unsigned char* d8 = (unsigned char*)c.dst + (size_t)n * (size_t)(-c.ldd) + k0;
#pragma unroll
    for (int q = 0; q < 2; ++q) {
      u32x4 o;
#pragma unroll
      for (int w = 0; w < 4; ++w) {
        float f[4];
#pragma unroll
        for (int j = 0; j < 4; ++j) f[j] = __builtin_amdgcn_fmed3f(r[16 * q + 4 * w + j], -448.f, 448.f);
        int v = __builtin_amdgcn_cvt_pk_fp8_f32(f[0], f[1], 0, false);
        v = __builtin_amdgcn_cvt_pk_fp8_f32(f[2], f[3], v, true);
        o[w] = (unsigned)v;
      }
      *(u32x4*)(d8 + 16 * q) = o;
    }
    asm volatile("s_waitcnt lgkmcnt(0)" ::: "memory");
    return;
  }
  u16* d = c.dst + (size_t)n * c.ldd + k0;
#pragma unroll
  for (int q = 0; q < 4; ++q) {
    u32x4 o;
    o.x = pk2(r[8 * q], r[8 * q + 1]); o.y = pk2(r[8 * q + 2], r[8 * q + 3]); o.z = pk2(r[8 * q + 4], r[8 * q + 5]); o.w = pk2(r[8 * q + 6], r[8 * q + 7]);
    *(u32x4*)(d + 8 * q) = o;
  }
  asm volatile("s_waitcnt lgkmcnt(0)" ::: "memory");
}
constexpr int CONV_EARLY = 1152 + 64 + 64;
DEVI void conv_items2(KP p, int l, ldsp_t lds, int first_item, int total_items) {
  const int tid = TIDX, wave = __builtin_amdgcn_readfirstlane(tid >> 6), lane = tid & 63;
  LAS float* t = (LAS float*)(lds + wave * 8448);
  __syncthreads();
  const int stride = gridDim.x * NW;
  int item = first_item + BIDX * NW + wave;
  if (item >= total_items) return;
  ConvT c = conv_decode(p, l, item);
  f32x4 v[8];
  conv_load(c, lane, v);
  for (;;) {
    const int nitem = item + stride;
    const bool more = nitem < total_items;
    ConvT cn = c; f32x4 vn[8];
    if (more) { cn = conv_decode(p, l, nitem); conv_load(cn, lane, vn); }
    conv_store(c, t, lane, v);
    if (!more) break;
    c = cn; item = nitem;
#pragma unroll
    for (int i = 0; i < 8; ++i) v[i] = vn[i];
  }
}
template <int BR>
DEVI void attn_mask(f32x16 (&s)[2], int kt, int qlat, int qrow, int qcol, int hh, LAS float* rpb) {
  if (BR == 1) {
#pragma unroll
    for (int kb = 0; kb < 2; ++kb)
#pragma unroll
      for (int i = 0; i < 16; ++i) {
        const int kpos = kt * 64 + kb * 32 + (i & 3) + 8 * (i >> 2) + 4 * hh;
        const int d = qlat - kpos;
        if (d > 128 || d < -128) s[kb][i] = -1e30f;
      }
  } else {
    const int rs = min(max(qrow - 4, 0), 56);
    const bool row_ok = (kt >= rs) && (kt < rs + 8);
    const int cst = min(max(qcol - 8, 0), 48);
    const int dr = kt - qrow + 7;
#pragma unroll
    for (int kb = 0; kb < 2; ++kb)
#pragma unroll
      for (int i = 0; i < 16; ++i) {
        const int kc = kb * 32 + (i & 3) + 8 * (i >> 2) + 4 * hh;
        const bool ok = row_ok && (kc >= cst) && (kc < cst + 16);
        const int idx = ok ? (dr * 31 + (kc - qcol + 15)) : 0;
        const float bias = rpb[idx];
        s[kb][i] = ok ? (s[kb][i] + bias) : -1e30f;
      }
  }
}

template <int BR>
DEVI void attn_mask1(f32x16& sb, int kb, int kt, int qlat, int qrow, int qcol, int hh, LAS float* rpb) {
  if (BR == 1) {
#pragma unroll
    for (int i = 0; i < 16; ++i) {
      const int kpos = kt * 64 + kb * 32 + (i & 3) + 8 * (i >> 2) + 4 * hh;
      const int d = qlat - kpos;
      if (d > 128 || d < -128) sb[i] = -1e30f;
    }
  } else {
    const int rs = min(max(qrow - 4, 0), 56);
    const bool row_ok = (kt >= rs) && (kt < rs + 8);
    const int cst = min(max(qcol - 8, 0), 48);
    const int dr = kt - qrow + 7;
#pragma unroll
    for (int i = 0; i < 16; ++i) {
      const int kc = kb * 32 + (i & 3) + 8 * (i >> 2) + 4 * hh;
      const bool ok = row_ok && (kc >= cst) && (kc < cst + 16);
      const int idx = ok ? (dr * 31 + (kc - qcol + 15)) : 0;
      const float bias = rpb[idx];
      sb[i] = ok ? (sb[i] + bias) : -1e30f;
    }
  }
}
#define FADD(a, b) do { (a) += (b); asm("" : "+v"(a)); } while (0)
typedef short v4i16_t __attribute__((ext_vector_type(4)));
DEVI bf16x8 vtr2(ldsp_t a) {
  const v4i16_t lo = __builtin_amdgcn_ds_read_tr16_b64_v4i16((LAS v4i16_t*)a);
  const v4i16_t hi = __builtin_amdgcn_ds_read_tr16_b64_v4i16((LAS v4i16_t*)(a + 8 * 144));
  return __builtin_shufflevector(lo, hi, 0, 1, 2, 3, 4, 5, 6, 7);
}
DEVI bf16x8 vtr2s(ldsp_t a, int o0, int o1) {
  const v4i16_t lo = __builtin_amdgcn_ds_read_tr16_b64_v4i16((LAS v4i16_t*)(a + o0));
  const v4i16_t hi = __builtin_amdgcn_ds_read_tr16_b64_v4i16((LAS v4i16_t*)(a + 8 * 128 + o1));
  return __builtin_shufflevector(lo, hi, 0, 1, 2, 3, 4, 5, 6, 7);
}
template <int BR, bool FAST>
DEVI bool attn_item2(KP p, int l, int b, int hs, int qb, bool isctx, ldsp_t lds) {
  constexpr bool MLA = (BR == 0);
  constexpr bool GQA = (BR == 1 || BR == 3);
  constexpr int QBLK = GQA ? 256 : 512;
  constexpr int NKS = MLA ? 6 : 4;
  constexpr int STG = 8192 + 8192 + 4096;
  const int tid = TIDX, lane = tid & 63, wave = __builtin_amdgcn_readfirstlane(tid >> 6);
  const int r32 = lane & 31, hh = lane >> 5;
  const int hq = GQA ? (hs * 2 + (wave & 1)) : hs;
  const int woff = GQA ? 64 * (wave >> 1) : 64 * wave;
  const int q0 = (isctx ? 0 : NCTX) + qb * QBLK;
  const bool active = !isctx || (woff < NCTX);
  const size_t tokq = (size_t)b * TPB + q0 + (active ? woff : 0) + r32;
  const u16* Qp; const u16* Kp; int ldk; const u16* Vp; int ldv; int obase; int ldq;
  const u16* PR = wsp<u16>(p, OFF_PRAW);
  if (BR == 0) { Qp = wsp<u16>(p, OFF_QARAW) + tokq * 512 + hq * 96; ldq = 512; Kp = wsp<u16>(p, OFF_KVARAW) + (size_t)b * TPB * 512 + hs * 128; ldk = 512; Vp = wsp<u16>(p, OFF_KVARAW) + (size_t)b * TPB * 512 + hs * 128 + 64; ldv = 512; obase = hq * 64; }
  else if (BR == 1) { Qp = PR + tokq * PLD + 512 + hq * 64; ldq = PLD; Kp = PR + (size_t)b * TPB * PLD + 768 + hs * 64; ldk = PLD; Vp = PR + (size_t)b * TPB * PLD + 896 + hs * 64; ldv = PLD; obase = 256 + hq * 64; }
  else if (BR == 2) { Qp = PR + tokq * PLD + 1024 + hq * 64; ldq = PLD; Kp = PR + (size_t)b * TPB * PLD + 1280 + hs * 64; ldk = PLD; Vp = PR + (size_t)b * TPB * PLD + 1536 + hs * 64; ldv = PLD; obase = 512 + hq * 64; }
  else { Qp = PR + tokq * PLD + 1792 + hq * 64; ldq = PLD; Kp = PR + (size_t)b * TPB * PLD + 2048 + hs * 64; ldk = PLD; Vp = PR + (size_t)b * TPB * PLD + 2176 + hs * 64; ldv = PLD; obase = 768 + hq * 64; }
  const u16* KRp = PR + (size_t)b * TPB * PLD + 384;
  int lat_lo = 0, lat_n = 0, wlo = 0, whi = 63;
  if (!isctx) {
    if (BR == 0 || BR == 3) { lat_lo = 0; lat_n = 64; }
    else if (BR == 1) {
      const int ql = qb * QBLK; const int lo = max(0, ql - 128) >> 6, hi = min(SEQ - 1, ql + QBLK - 1 + 128) >> 6; lat_lo = lo; lat_n = hi - lo + 1;
      const int wq = ql + woff; wlo = max(0, wq - 128) >> 6; whi = min(SEQ - 1, wq + 63 + 128) >> 6;
    } else {
      const int r0 = 8 * qb; const int lo = min(max(r0 - 4, 0), 56), hi = min(max(r0 + 7 - 4, 0), 56) + 7; lat_lo = lo; lat_n = hi - lo + 1;
      const int wr_ = r0 + wave; wlo = min(max(wr_ - 4, 0), 56); whi = wlo + 7;
    }
  }
  const int NT = 4 + lat_n;
  const int qlat0 = qb * QBLK + woff + r32;
  bf16x8 qf[2][NKS];
#pragma unroll
  for (int qi = 0; qi < 2; ++qi)
#pragma unroll
    for (int ks = 0; ks < NKS; ++ks) qf[qi][ks] = *(const bf16x8*)(Qp + (size_t)qi * 32 * ldq + ks * 16 + hh * 8);
  const int drow = 8 * wave + (lane >> 3), dch = (lane & 7) ^ ((drow >> 1) & 7);
  const int rrow = 16 * (wave & 3) + (lane >> 2), rch = (lane & 3) ^ ((rrow >> 2) & 3);
  auto keytile = [&](int j) { return (j < 4) ? j : (4 + lat_lo + (j - 4)); };
#define DMA16(sbase, voff, ldsaddr) asm volatile("s_mov_b32 m0, %2\n\ts_nop 0\n\tglobal_load_lds_dwordx4 %0, %1" :: "v"(voff), "s"(sbase), "s"(ldsaddr) : "memory", "m0")
#define A_DMA(j, st) do { const int key0_ = keytile(j) * 64; const unsigned base_ = __builtin_amdgcn_readfirstlane((unsigned)(size_t)(lds + (st) * STG) + wave * 1024); \
    DMA16(Kp, (unsigned)(((key0_ + drow) * ldk + dch * 8) * 2), base_); \
    DMA16(Vp, (unsigned)(((key0_ + drow) * ldv + dch * 8) * 2), base_ + 8192u); \
    if (MLA && wave < 4) DMA16(KRp, (unsigned)(((key0_ + rrow) * PLD + rch * 8) * 2), __builtin_amdgcn_readfirstlane(base_ + 16384u)); \
  } while (0)
  LAS float* rpb = (LAS float*)(lds + 2 * STG);
  __syncthreads();
  if (FAST && tid == 0) *(LAS int*)(lds + 2 * STG + 2048) = 0;
  A_DMA(0, 0);
  if (BR == 2 && !isctx) {
    const float* src = p->rpb_c + (size_t)(l * 4 + hs) * 465;
    for (int i = tid; i < 465; i += 512) rpb[i] = src[i] * LOG2E;
  }
  asm volatile("s_waitcnt vmcnt(0)" ::: "memory");
#pragma unroll
  for (int qi = 0; qi < 2; ++qi)
#pragma unroll
    for (int ks = 0; ks < NKS; ++ks) asm volatile("" : "+v"(qf[qi][ks]));
  __syncthreads();
  f32x16 o[2][2];
#pragma unroll
  for (int qi = 0; qi < 2; ++qi)
#pragma unroll
    for (int i = 0; i < 16; ++i) { o[qi][0][i] = 0.f; o[qi][1][i] = 0.f; }
  float m_run[2], l_run[2];
#pragma unroll
  for (int qi = 0; qi < 2; ++qi) { m_run[qi] = -INFINITY; l_run[qi] = 0.f; }
  if (BR == 1) { const float sk = p->sink_b[l * 4 + hq] * LOG2E; m_run[0] = sk; m_run[1] = sk; l_run[0] = (hh == 0) ? (FAST ? __builtin_amdgcn_exp2f(sk) : 1.f) : 0.f; l_run[1] = l_run[0]; }
  float l2[2][2];
#pragma unroll
  for (int qi = 0; qi < 2; ++qi) { l2[qi][0] = l_run[qi]; l2[qi][1] = 0.f; }
  const int kkey = (r32 >> 1) & 7, rkey = (r32 >> 2) & 3;
  const ldsp_t kfb = lds + r32 * 128;
  const ldsp_t krb = lds + 16384 + r32 * 64;
  const int vq = (lane & 15) >> 2, vkey = 2 * hh + (vq >> 1);
  const int vch = 2 * ((lane >> 4) & 1) + ((lane & 3) >> 1);
  const ldsp_t vfb = lds + 8192 + (4 * hh + vq) * 128 + 8 * (lane & 1);
#define SB() __builtin_amdgcn_sched_barrier(0)
#define KLOAD(kb, ks) (((ks) < 4) ? *(const LAS bf16x8*)(kfb + st + (kb) * 4096 + (((2 * (ks) + hh) ^ kkey) << 4)) : *(const LAS bf16x8*)(krb + st + (kb) * 2048 + (((2 * ((ks) - 4) + hh) ^ rkey) << 4)))
#define VLOAD(s4, db) vtr2s(vfb + st + (s4) * 2048, ((4 * (db) + vch) ^ vkey) << 4, ((4 * (db) + vch) ^ vkey ^ 4) << 4)
#define SM_EL(kb, e) do { const int qi_ = (e) >> 4, i_ = (e) & 15; \
    const float x_ = __builtin_amdgcn_exp2f(s[qi_][kb][i_]); s[qi_][kb][i_] = x_; FADD(l2[qi_][i_ & 1], x_); \
    if (i_ & 1) pw[kb][qi_][i_ >> 3][(i_ & 7) >> 1] = pk2(s[qi_][kb][i_ - 1], x_); } while (0)
#define F_STEP(j) do { \
    const int st = ((j) & 1) * STG; \
    if ((j) + 1 < NT) A_DMA((j) + 1, ((j) + 1) & 1); \
    const int kt_ = lat_lo + (j) - 4; \
    const bool need = active && ((j) < 4 || (kt_ >= wlo && kt_ <= whi)); \
    if (need) { \
      f32x16 s[2][2]; bf16x8 kf[NKS]; bf16x8 vf[4]; u32x4 pw[2][2][2]; \
      const f32x16 zero16 = {0.f, 0.f, 0.f, 0.f, 0.f, 0.f, 0.f, 0.f, 0.f, 0.f, 0.f, 0.f, 0.f, 0.f, 0.f, 0.f}; \
      const bool domask = (BR == 1 || BR == 2) && (j) >= 4; \
      _Pragma("unroll") for (int ks = 0; ks < NKS; ++ks) kf[ks] = KLOAD(0, ks); \
      _Pragma("unroll") for (int ks = 0; ks < NKS; ++ks) { \
        s[0][0] = MFMA(kf[ks], qf[0][ks], ks == 0 ? zero16 : s[0][0]); s[1][0] = MFMA(kf[ks], qf[1][ks], ks == 0 ? zero16 : s[1][0]); \
        SB(); kf[ks] = KLOAD(1, ks); SB(); } \
      if (domask) { _Pragma("unroll") for (int qi = 0; qi < 2; ++qi) { const int ql_ = qlat0 + 32 * qi; attn_mask1<BR>(s[qi][0], 0, kt_, ql_, ql_ >> 6, ql_ & 63, hh, rpb); } } \
      _Pragma("unroll") for (int m = 0; m < 2 * NKS; ++m) { \
        s[m & 1][1] = MFMA(kf[m >> 1], qf[m & 1][m >> 1], (m >> 1) == 0 ? zero16 : s[m & 1][1]); \
        if (m < 4) vf[m] = VLOAD(m >> 1, m & 1); \
        _Pragma("unroll") for (int e = (m * 32) / (2 * NKS); e < ((m + 1) * 32) / (2 * NKS); ++e) SM_EL(0, e); \
        SB(); } \
      if (domask) { _Pragma("unroll") for (int qi = 0; qi < 2; ++qi) { const int ql_ = qlat0 + 32 * qi; attn_mask1<BR>(s[qi][1], 1, kt_, ql_, ql_ >> 6, ql_ & 63, hh, rpb); } } \
      _Pragma("unroll") for (int m = 0; m < 8; ++m) { \
        o[m & 1][(m >> 1) & 1] = MFMA(vf[m >> 1], __builtin_bit_cast(bf16x8, pw[0][m & 1][m >> 2]), o[m & 1][(m >> 1) & 1]); \
        if (m & 1) { SB(); vf[m >> 1] = VLOAD(2 + (m >> 2), (m >> 1) & 1); } \
        _Pragma("unroll") for (int e = 4 * m; e < 4 * m + 4; ++e) SM_EL(1, e); \
        SB(); } \
      _Pragma("unroll") for (int m = 0; m < 8; ++m) \
        o[m & 1][(m >> 1) & 1] = MFMA(vf[m >> 1], __builtin_bit_cast(bf16x8, pw[1][m & 1][m >> 2]), o[m & 1][(m >> 1) & 1]); \
    } \
    asm volatile("s_waitcnt vmcnt(0)" ::: "memory"); \
    __syncthreads(); \
  } while (0)
#define A_STEP(j) do { \
    const int st = ((j) & 1) * STG; \
    if ((j) + 1 < NT) A_DMA((j) + 1, ((j) + 1) & 1); \
    const int kt_ = lat_lo + (j) - 4; \
    const bool need = active && ((j) < 4 || (kt_ >= wlo && kt_ <= whi)); \
    if (need) { \
      f32x16 s[2][2]; \
      _Pragma("unroll") for (int kb = 0; kb < 2; ++kb) { \
        _Pragma("unroll") for (int ks = 0; ks < 4; ++ks) { const bf16x8 kf = *(const LAS bf16x8*)(kfb + st + kb * 4096 + (((2 * ks + hh) ^ kkey) << 4)); \
          _Pragma("unroll") for (int qi = 0; qi < 2; ++qi) { if (ks == 0) { _Pragma("unroll") for (int i = 0; i < 16; ++i) s[qi][kb][i] = 0.f; } s[qi][kb] = MFMA(kf, qf[qi][ks], s[qi][kb]); } } \
        if (MLA) { _Pragma("unroll") for (int ks = 0; ks < 2; ++ks) { const bf16x8 kf = *(const LAS bf16x8*)(krb + st + kb * 2048 + (((2 * ks + hh) ^ rkey) << 4)); \
          _Pragma("unroll") for (int qi = 0; qi < 2; ++qi) s[qi][kb] = MFMA(kf, qf[qi][NKS - 2 + ks], s[qi][kb]); } } \
      } \
      if (FAST) __builtin_amdgcn_sched_barrier(0); \
      _Pragma("unroll") for (int qi = 0; qi < 2; ++qi) { \
        if ((BR == 1 || BR == 2) && (j) >= 4) { const int ql_ = qlat0 + 32 * qi; attn_mask<BR>(s[qi], kt_, ql_, ql_ >> 6, ql_ & 63, hh, rpb); } \
        if (FAST) { \
          float ls0 = 0.f, ls1 = 0.f; \
          _Pragma("unroll") for (int i = 0; i < 16; ++i) { \
            const float e0 = __builtin_amdgcn_exp2f(s[qi][0][i]), e1 = __builtin_amdgcn_exp2f(s[qi][1][i]); \
            s[qi][0][i] = e0; s[qi][1][i] = e1; FADD(ls0, e0); FADD(ls1, e1); } \
          l_run[qi] += ls0 + ls1; \
        } else { \
        float mx = s[qi][0][0]; \
        _Pragma("unroll") for (int i = 1; i < 16; ++i) mx = fmaxf(mx, s[qi][0][i]); \
        _Pragma("unroll") for (int i = 0; i < 16; ++i) mx = fmaxf(mx, s[qi][1][i]); \
        mx = fmaxf(mx, __shfl_xor(mx, 32)); \
        const float m_new = fmaxf(m_run[qi], mx); \
        const float alpha = __builtin_amdgcn_exp2f(m_run[qi] - m_new); \
        m_run[qi] = m_new; \
        float ls0 = 0.f, ls1 = 0.f; \
        _Pragma("unroll") for (int i = 0; i < 16; ++i) { \
          const float e0 = __builtin_amdgcn_exp2f(s[qi][0][i] - m_new), e1 = __builtin_amdgcn_exp2f(s[qi][1][i] - m_new); \
          s[qi][0][i] = e0; s[qi][1][i] = e1; ls0 += e0; ls1 += e1; } \
        l_run[qi] = l_run[qi] * alpha + (ls0 + ls1); \
        if (__any(alpha != 1.f)) { _Pragma("unroll") for (int i = 0; i < 16; ++i) { o[qi][0][i] *= alpha; o[qi][1][i] *= alpha; } } \
        } \
      } \
      _Pragma("unroll") for (int s4 = 0; s4 < 4; ++s4) { \
        const int kb = s4 >> 1, rb = (s4 & 1) * 8; \
        bf16x8 pf[2]; \
        _Pragma("unroll") for (int qi = 0; qi < 2; ++qi) { u32x4 pw; \
          pw.x = pk2(s[qi][kb][rb + 0], s[qi][kb][rb + 1]); pw.y = pk2(s[qi][kb][rb + 2], s[qi][kb][rb + 3]); \
          pw.z = pk2(s[qi][kb][rb + 4], s[qi][kb][rb + 5]); pw.w = pk2(s[qi][kb][rb + 6], s[qi][kb][rb + 7]); \
          pf[qi] = __builtin_bit_cast(bf16x8, pw); } \
        _Pragma("unroll") for (int db = 0; db < 2; ++db) { const bf16x8 vf = vtr2s(vfb + st + s4 * 2048, ((4 * db + vch) ^ vkey) << 4, ((4 * db + vch) ^ vkey ^ 4) << 4); \
          o[0][db] = MFMA(vf, pf[0], o[0][db]); o[1][db] = MFMA(vf, pf[1], o[1][db]); } \
      } \
    } \
    asm volatile("s_waitcnt vmcnt(0)" ::: "memory");        \
    __syncthreads(); \
  } while (0)
  if (FAST) {
    if (wave >= 4) __builtin_amdgcn_s_setprio(1);
    for (int j = 0; j < NT; j += 2) {
      F_STEP(j);
      if (j + 1 < NT) F_STEP(j + 1);
    }
    __builtin_amdgcn_s_setprio(0);
  } else {
    for (int j = 0; j < NT; j += 2) {
      A_STEP(j);
      if (j + 1 < NT) A_STEP(j + 1);
    }
  }
#undef F_STEP
#undef SM_EL
#undef A_STEP
#undef A_DMA
#undef DMA16
  bool bad = false;
  if (active) {
#pragma unroll
    for (int qi = 0; qi < 2; ++qi) {
      if (FAST) l_run[qi] = l2[qi][0] + l2[qi][1];
      const float lt = l_run[qi] + __shfl_xor(l_run[qi], 32);
      const float inv = 1.f / lt;
      if (FAST) bad = bad || !(lt > 1e-25f && lt < 1e25f);
      unsigned char* Op = wsp<unsigned char>(p, OFF_O) + (tokq + 32 * qi) * 1024 + obase;
#pragma unroll
      for (int db = 0; db < 2; ++db)
#pragma unroll
        for (int gp = 0; gp < 2; ++gp) {
          float q[8];
#pragma unroll
          for (int j = 0; j < 8; ++j) q[j] = __builtin_amdgcn_fmed3f(o[qi][db][8 * gp + j] * (inv * O8_SCALE), -448.f, 448.f);
          int wa = __builtin_amdgcn_cvt_pk_fp8_f32(q[0], q[1], 0, false); wa = __builtin_amdgcn_cvt_pk_fp8_f32(q[2], q[3], wa, true);
          int wb = __builtin_amdgcn_cvt_pk_fp8_f32(q[4], q[5], 0, false); wb = __builtin_amdgcn_cvt_pk_fp8_f32(q[6], q[7], wb, true);
          const u32x2 sx = __builtin_amdgcn_permlane32_swap((unsigned)wa, (unsigned)wb, false, false);
          *(u32x2*)(Op + db * 32 + 16 * gp + 8 * hh) = sx;
        }
    }
  }
  if (!FAST) return false;
  LAS int* flag = (LAS int*)(lds + 2 * STG + 2048);
  if (__any(bad) && lane == 0) *flag = 1;
  __syncthreads();
  return __builtin_amdgcn_readfirstlane(*flag) != 0;
}
template <bool FAST>
DEVI bool attn_dispatch(KP p, int l, int n, int xcd, ldsp_t lds) {
  int br, s, qb; bool isctx = false;
  if (n < 32) { br = 0; s = xcd + 8 * (n >> 3); qb = n & 7; }
  else if (n < 64) { const int m = n - 32; br = 3; s = xcd + 8 * (m >> 4); qb = m & 15; }
  else if (n < 96) { const int m = n - 64; br = 2; s = xcd + 8 * (m >> 3); qb = m & 7; }
  else if (n < 128) { const int m = n - 96; br = 1; s = xcd + 8 * (m >> 4); qb = m & 15; }
  else {
    const int m = n - 128; isctx = true; qb = 0;
    if (m < 4) { br = 0; s = xcd + 8 * m; }
    else if (m < 6) { br = 3; s = xcd + 8 * (m - 4); }
    else if (m < 10) { br = 2; s = xcd + 8 * (m - 6); }
    else { br = 1; s = xcd + 8 * (m - 10); }
  }
  if (br == 0) return attn_item2<0, FAST>(p, l, s >> 2, s & 3, qb, isctx, lds);
  else if (br == 1) return attn_item2<1, FAST>(p, l, s >> 1, s & 1, qb, isctx, lds);
  else if (br == 2) return attn_item2<2, FAST>(p, l, s >> 2, s & 3, qb, isctx, lds);
  else return attn_item2<3, FAST>(p, l, s >> 1, s & 1, qb, isctx, lds);
}
DEVI void phaseD2(KP p, int l, ldsp_t lds) {
  const int G8 = gridDim.x >> 3, xcd = BIDX & 7, lb = BIDX >> 3;
  if (lb >= G8) return;
  const int NLOC = 128 + (l == 0 ? 12 : 0);
  const int nmine = (NLOC - lb + G8 - 1) / G8;
  const int cslot = min((int)(BIDX & 3), nmine - 1);
  int it = 0; unsigned redo = 0;
  for (int n = lb; n < NLOC; n += G8, ++it) {
    if (it == cslot) conv_items2(p, l, lds, CONV_EARLY, CONV_ITEMS);
    if (attn_dispatch<true>(p, l, n, xcd, lds)) redo |= 1u << it;
  }
  if (redo) {
    it = 0;
    for (int n = lb; n < NLOC; n += G8, ++it)
      if ((redo >> it) & 1) attn_dispatch<false>(p, l, n, xcd, lds);
  }
}

DEVI int pm_map(int pme, bool skipctx) { return skipctx ? (pme >> 4) * 17 + 1 + (pme & 15) : pme; }
struct SchedE1 { const char* ws; bool skipctx; int G, c;
  DEVI bool next(int i, Unit& u) const { int pm, pn; if (!tile_order(i, G, c, skipctx ? 128 : 136, 16, pm, pn)) return false;
    pm = pm_map(pm, skipctx); const int n = pn >> 2, cq = pn & 3;
    u.A = ws + OFF_O + uoff((unsigned)pm * 256u * 1024u + (unsigned)n * 256u); u.B = ws + OFF_WBR + uoff(((unsigned)n * 1024u + (unsigned)cq * 256u) * 256u); u.rows = nullptr; u.nvalid = 0;
    u.u0 = pm * 256; u.u1 = pn * 256; u.u2 = 0; u.u3 = 0; return true; } };
DEVI void phaseE1(KP p, int l, ldsp_t lds) {
  if (BIDX == 0 && TIDX < 32) wsp<int>(p, OFF_CNT)[TIDX * CNT_STRIDE] = 0;
  SchedE1 S{(const char*)p->ws, l == 1, (int)gridDim.x, BIDX};
  EpiZ8 E{wsp<unsigned char>(p, OFF_Z)};
  gemm_phase<true, false, true>(lds, 1024, 256, 2, S, E);
}
struct SchedE2 { const char* ws; const char* h8; bool skipctx; int G, c;
  DEVI bool next(int i, Unit& u) const { int pm, pn; if (!tile_order(i >> 1, G, c, skipctx ? 128 : 136, 8, pm, pn)) return false;
    pm = pm_map(pm, skipctx); const int pr = i & 1;
    u.A = h8 + uoff((unsigned)pm * 256u * 1024u); u.B = ws + OFF_WGATE + uoff((unsigned)(pr * 8 + pn) * 256u * 1024u); u.rows = nullptr; u.nvalid = 0;
    u.u0 = pm * 256; u.u1 = pn * 128; u.u2 = pr; u.u3 = 0; return true; } };
constexpr float Y8_SCALE = 16.f;
static_assert(Y8_SCALE == Z8_SCALE, "the E2 epilogue keeps its sums in Z8 units");
struct EpiE2 { const unsigned char* Z; u32x4 (&part)[8]; unsigned char* Y8; const float* bias;
  DEVI void init(f32x4 (&acc)[2][2][4][2], const Unit& u, int wr, int wc, int fr, int fq) const {
    const int col0 = u.u1 + wc * 32 + 8 * fq;
#pragma unroll
    for (int bj = 0; bj < 2; ++bj)
#pragma unroll
      for (int nn = 0; nn < 2; ++nn) {
        const f32x4 b = *(const f32x4*)(bias + (2 * u.u2 + bj) * 1024 + col0 + 4 * nn) * -LOG2E;
#pragma unroll
        for (int a = 0; a < 2; ++a)
#pragma unroll
          for (int m = 0; m < 4; ++m) acc[a][bj][m][nn] = b;
      }
  }
  DEVI void operator()(const f32x4 (&acc)[2][2][4][2], const Unit& u, int wr, int wc, int fr, int fq) const {
    const int row0 = u.u0 + wr * 64 + fr, col0 = u.u1 + wc * 32 + 8 * fq, pr = u.u2;
    const unsigned lw16 = (unsigned)((wr * 4 + wc) * 64 + fr + 16 * fq) * 16u;
    const unsigned char* zb0 = Z + z8_block(u.u0 >> 8, 2 * pr, u.u1 >> 7) + lw16;
    u32x4 zq[4][2], yq[4][2];
    auto ldpair = [&](int P, u32x4 (&z)[2], u32x4 (&y)[2]) {
#pragma unroll
      for (int bj = 0; bj < 2; ++bj) z[bj] = *(const u32x4*)(zb0 + (size_t)bj * 8 * 32768 + P * 8192);
#pragma unroll
      for (int h = 0; h < 2; ++h) y[h] = pr ? part[2 * P + h] : u32x4{0u, 0u, 0u, 0u};
    };
#pragma unroll
    for (int P = 0; P < 4; ++P) ldpair(P, zq[P], yq[P]);
#pragma unroll
    for (int P = 0; P < 4; ++P) {
      const int c = P;
#pragma unroll
      for (int h = 0; h < 2; ++h) {
        const int g = 2 * P + h, ai = g >> 2, m = g & 3;
        const size_t r = (size_t)(row0 + ai * HALF + m * 16);
        float t[8];
        {
          const unsigned w[4] = {yq[c][h].x, yq[c][h].y, yq[c][h].z, yq[c][h].w};
#pragma unroll
          for (int i = 0; i < 4; ++i) { t[2 * i] = __uint_as_float(w[i] << 16); t[2 * i + 1] = __uint_as_float(w[i] & 0xffff0000u); }
        }
#pragma unroll
        for (int bj = 0; bj < 2; ++bj) {
#pragma unroll
          for (int nn = 0; nn < 2; ++nn) {
            const int zw = (int)zq[c][bj][2 * h + nn];
            const f32x2 zlo = __builtin_amdgcn_cvt_pk_f32_fp8(zw, false), zhi = __builtin_amdgcn_cvt_pk_f32_fp8(zw, true);
            const float zz4[4] = {zlo.x, zlo.y, zhi.x, zhi.y};
#pragma unroll
            for (int j = 0; j < 4; ++j) {
              const int e = 4 * nn + j;
              const float gte = __builtin_amdgcn_rcpf(1.f + __builtin_amdgcn_exp2f(acc[ai][bj][m][nn][j]));
              t[e] += gte * zz4[j];
            }
          }
        }
        if (pr == 0) {
          u32x4 o; o.x = pk2(t[0], t[1]); o.y = pk2(t[2], t[3]); o.z = pk2(t[4], t[5]); o.w = pk2(t[6], t[7]);
          part[g] = o;
        } else {
          u32x2 o8;
#pragma unroll
          for (int w = 0; w < 2; ++w) {
            float q[4];
#pragma unroll
            for (int j = 0; j < 4; ++j) q[j] = __builtin_amdgcn_fmed3f(t[4 * w + j], -448.f, 448.f);
            int v = __builtin_amdgcn_cvt_pk_fp8_f32(q[0], q[1], 0, false);
            v = __builtin_amdgcn_cvt_pk_fp8_f32(q[2], q[3], v, true);
            o8[w] = (unsigned)v;
          }
          *(u32x2*)(Y8 + r * 1024 + col0) = o8;
        }
      }
    }
  }
};
DEVI void phaseE2(KP p, int l, ldsp_t lds) {
  SchedE2 S{(const char*)p->ws, (const char*)h8base(p), l == 1, (int)gridDim.x, BIDX};
  u32x4 part[8];
#pragma unroll
  for (int i = 0; i < 8; ++i) part[i] = u32x4{0u, 0u, 0u, 0u};
  EpiE2 E{wsp<unsigned char>(p, OFF_Z), part, wsp<unsigned char>(p, OFF_Y8), p->b_gate + (size_t)l * 4 * 1024};
  gemm_phase<true, false, true>(lds, 1024, 1024, 8, S, E);
}
struct SchedF { const char* ws; bool skipctx; int G, c;
  DEVI bool next(int i, Unit& u) const { int pm, pn;
    if (skipctx || G != 256) { if (!tile_order(i, G, c, skipctx ? 128 : 136, 4, pm, pn)) return false; }
    else if (i < 2) { if (!tile_order(i, G, c, 128, 4, pm, pn)) return false; }
    else { if (i > 2 || c >= 32) return false; pm = 128 + (c >> 2); pn = c & 3; }
    pm = pm_map(pm, skipctx);
    u.A = ws + OFF_Y8 + uoff((unsigned)pm * 256u * 1024u); u.B = ws + OFF_WOUT + uoff((unsigned)pn * 256u * 1024u); u.rows = nullptr; u.nvalid = 0;
    u.u0 = pm; u.u1 = pn * 256; u.u2 = 0; u.u3 = 0; return true; } };
struct EpiF { KP p; int l;
  DEVI void init(f32x4 (&acc)[2][2][4][2], const Unit&, int, int, int, int) const { acc_zero(acc); }
  DEVI void operator()(const f32x4 (&acc)[2][2][4][2], const Unit& u, int wr, int wc, int fr, int fq) const {
    const int pm = u.u0, b = pm / 17, rr0 = (pm % 17) * 256;
    const int mrow = (rr0 < NCTX) ? 8 : b;
    const int col0 = u.u1 + wc * 32 + 8 * fq;
    const float* gt = wsp<float>(p, OFF_MOD) + ((size_t)l * 9 + mrow) * 6144 + 2048 + col0;
    const u16* xinb = (const u16*)p->out + (size_t)(b * TPB + rr0) * 1024 + col0;
    const __amdgpu_buffer_rsrc_t xrs = __builtin_amdgcn_make_buffer_rsrc((void*)wsp<u16>(p, OFF_XM), 0, NTOK * 1024 * 2, 0x00020000);
    const unsigned xoff = (unsigned)((b * TPB + rr0) * 1024 + col0) * 2u;
    f32x4 gv[2][2];
#pragma unroll
    for (int bj = 0; bj < 2; ++bj)
#pragma unroll
      for (int n = 0; n < 2; ++n) gv[bj][n] = *(const f32x4*)(gt + bj * HALF + n * 4) * (1.f / Y8_SCALE);
#pragma unroll
    for (int ai = 0; ai < 2; ++ai) {
      u32x4 xo[4][2];
#pragma unroll
      for (int m = 0; m < 4; ++m) {
        const size_t ro = (size_t)(wr * 64 + fr + ai * HALF + m * 16) * 1024;
#pragma unroll
        for (int bj = 0; bj < 2; ++bj) xo[m][bj] = *(const u32x4*)(xinb + ro + bj * HALF);
      }
#pragma unroll
      for (int mp = 0; mp < 2; ++mp) {
#pragma unroll
        for (int mm = 0; mm < 2; ++mm) {
          const int m = 2 * mp + mm;
          const size_t ro = (size_t)(wr * 64 + fr + ai * HALF + m * 16) * 1024;
#pragma unroll
          for (int bj = 0; bj < 2; ++bj) {
            const u32x4 v = xo[m][bj];
            const f32x4 x0 = f32x4{__uint_as_float(v.x << 16), __uint_as_float(v.x & 0xffff0000u), __uint_as_float(v.y << 16), __uint_as_float(v.y & 0xffff0000u)};
            const f32x4 x1 = f32x4{__uint_as_float(v.z << 16), __uint_as_float(v.z & 0xffff0000u), __uint_as_float(v.w << 16), __uint_as_float(v.w & 0xffff0000u)};
            const f32x4 r0 = x0 + gv[bj][0] * acc[ai][bj][m][0], r1 = x1 + gv[bj][1] * acc[ai][bj][m][1];
            __builtin_amdgcn_raw_buffer_store_b128(u32x4{pk2(r0.x, r0.y), pk2(r0.z, r0.w), pk2(r1.x, r1.y), pk2(r1.z, r1.w)}, xrs,
                                                   (int)(xoff + (unsigned)(ro + bj * HALF) * 2u), 0, 16);
          }
        }
      }
    }
    asm volatile("s_waitcnt vmcnt(0)" ::: "memory");
    if ((TIDX & 63) == 0) __hip_atomic_fetch_add(wsp<int>(p, OFF_DEP) + (l * 136 + pm) * DEP_STRIDE, 1, __ATOMIC_RELAXED, __HIP_MEMORY_SCOPE_AGENT);
  }
};
DEVI void phaseF2(KP p, int l, ldsp_t lds) {
  SchedF S{(const char*)p->ws, l == 1, (int)gridDim.x, BIDX};
  EpiF E{p, l};
  gemm_phase<true, false, true>(lds, 1024, 1024, 8, S, E);
}


DEVI void phase0_2(KP p, ldsp_t lds) {
  const int tid = TIDX, half = tid >> 8, htid = tid & 255;
  for (int it = BIDX * 2; it < 458; it += gridDim.x * 2) {
    const int item = it + half;
    LAS float* sc = (LAS float*)(lds + half * 16384);
    const bool ismod = item < 384;
    const int l = item / 192, rem = item % 192, cgp = rem >> 3, kc = rem & 7;
    __syncthreads();
    if (ismod) {
      for (int i = htid; i < 9 * 128; i += 256) {
        int b = i >> 7, k = i & 127;
        float v = (b < 8) ? p->c[b * 1024 + kc * 128 + k] : p->c_ctx[kc * 128 + k];
        sc[i] = v / (1.f + __expf(-v));
      }
    }
    __syncthreads();
    if (ismod) {
      float acc[9];
#pragma unroll
      for (int b = 0; b < 9; ++b) acc[b] = 0.f;
      const float* w = p->w_mod + ((size_t)l * 1024 + kc * 128) * 6144 + cgp * 256 + htid;
#pragma unroll 32
      for (int k = 0; k < 128; ++k) {
        float wv = w[(size_t)k * 6144];
#pragma unroll
        for (int b = 0; b < 9; ++b) acc[b] += sc[b * 128 + k] * wv;
      }
      float* dst = wsp<float>(p, OFF_MODP) + (size_t)((kc * 2 + l) * 9) * 6144 + cgp * 256 + htid;
#pragma unroll
      for (int b = 0; b < 9; ++b) dst[(size_t)b * 6144] = acc[b];
    } else if (item == 384) {
      float* cs32 = wsp<float>(p, OFF_CS32);
      float* cs16 = wsp<float>(p, OFF_CS16);
      for (int t = htid; t < 1024; t += 256) {
        int pos = t >> 4, i = t & 15;
        float ang = (float)pos * __builtin_amdgcn_exp2f(-(float)(2 * i) * (13.287712379549449f / 32.f));
        cs32[t * 2] = __cosf(ang); cs32[t * 2 + 1] = __sinf(ang);
      }
      for (int t = htid; t < 512; t += 256) {
        int pos = t >> 3, i = t & 7;
        float ang = (float)pos * __builtin_amdgcn_exp2f(-(float)(2 * i) * (13.287712379549449f / 16.f));
        cs16[t * 2] = __cosf(ang); cs16[t * 2 + 1] = __sinf(ang);
      }
    } else if (item < 457) {
      const int q = item - 385, ll = q / 36, o = q % 36;
      float* dst = wsp<float>(p, OFF_WRT) + ((size_t)ll * 36 + o) * 1024;
      for (int k = htid; k < 1024; k += 256)
        dst[k] = (o < 4) ? p->w_group[((size_t)ll * 1024 + k) * 4 + o] : p->w_router[((size_t)ll * 1024 + k) * 32 + (o - 4)];
    }
  }
}
DEVI void phase1_2(KP p) {
  const float* mp = wsp<float>(p, OFF_MODP);
  float* mo = wsp<float>(p, OFF_MOD);
  for (int i = BIDX * 512 + TIDX; i < 2 * 9 * 6144; i += gridDim.x * 512) {
    int l = i / (9 * 6144), o = i % 6144;
    float s = p->b_mod[l * 6144 + o];
#pragma unroll
    for (int kc = 0; kc < 8; ++kc) s += mp[(size_t)kc * 2 * 9 * 6144 + i];
    mo[i] = s;
  }
}
DEVI void phaseA2(KP p) {
  const int gw = BIDX * NW + (TIDX >> 6), nw = gridDim.x * NW;
  u16* H = wsp<u16>(p, OFF_H);
  const int per = (NTOK + nw - 1) / nw;
  const int t0 = gw * per, t1 = min(t0 + per, NTOK);
  int cur = -1; ModVec mv;
  for (int tok0 = t0; tok0 < t1; tok0 += 2) {
    float xv[2][16];
#pragma unroll
    for (int r = 0; r < 2; ++r) { const int tok = tok0 + r; if (tok < t1) load_row16(xrow_in(p, 0, tok / TPB, tok % TPB), xv[r]); }
#pragma unroll
    for (int r = 0; r < 2; ++r) {
      const int tok = tok0 + r;
      if (tok < t1) {
        const int mrow = (tok % TPB) < NCTX ? 8 : tok / TPB;
        if (mrow != cur) { load_modvec(p, 0, 0, mrow, mv); cur = mrow; }
        float hv[16]; modulate_row_store2<true, false>(mv, xv[r], nullptr, hv, h8base(p) + (size_t)tok * 1024);
        u16* xb = (u16*)p->out + (size_t)tok * 1024 + (TIDX & 63) * 4;
#pragma unroll
        for (int i = 0; i < 4; ++i) *(u32x2*)(xb + i * 256) = u32x2{pk2(xv[r][i * 4], xv[r][i * 4 + 1]), pk2(xv[r][i * 4 + 2], xv[r][i * 4 + 3])}; }
    }
  }
}
DEVI void phaseG2(KP p, int l, ldsp_t lds) {
  constexpr int RP = 2064;
  constexpr int GX = 2 * 32 * RP;
  const int tid = TIDX, lane = tid & 63, wave = __builtin_amdgcn_readfirstlane(tid >> 6);
  const int r32 = lane & 31, kh = lane >> 5, qd = lane >> 4;
  u16* H = wsp<u16>(p, OFF_H2);
  const float* WRT = wsp<float>(p, OFF_WRT) + (size_t)l * 36 * 1024;
  int* cnt = wsp<int>(p, OFF_CNT);
  int* list = wsp<int>(p, OFF_LIST);
  float* wlist = wsp<float>(p, OFF_WLIST);
  const ldsp_t hiP = lds, loP = lds + 32 * RP;
  LAS float* part = (LAS float*)lds;
  LAS int* gsel = (LAS int*)(lds + GX);
  LAS float* gwt = (LAS float*)(lds + GX + 128);
  LAS int* lcnt = (LAS int*)(lds + GX + 256);
  LAS int* gbase = lcnt + 32;
  LAS int* tinfo = lcnt + 64;
  if (tid < 32) lcnt[tid] = 0;
  int nloc = 0;
  bf16x8 whi[8], wlo[8];
  {
    const float* wr = p->w_router + (size_t)l * 1024 * 32 + r32;
#pragma unroll
    for (int s8 = 0; s8 < 8; ++s8) {
      u32x4 h, lo4;
#pragma unroll
      for (int jj = 0; jj < 4; ++jj) {
        const int k = 128 * wave + 16 * s8 + 8 * kh + 2 * jj;
        const float a = wr[(size_t)k * 32], b2 = wr[(size_t)(k + 1) * 32];
        const unsigned hp = pk2(a, b2);
        h[jj] = hp; lo4[jj] = pk2(a - __uint_as_float(hp << 16), b2 - __uint_as_float(hp & 0xffff0000u));
      }
      whi[s8] = __builtin_bit_cast(bf16x8, h); wlo[s8] = __builtin_bit_cast(bf16x8, lo4);
    }
  }
  int* tctr = wsp<int>(p, OFF_DEP) + DEP_TILECTR + l * DEP_STRIDE;
  LAS int* tnext = lcnt + 64 + 512 * 6;
  const int ntile = (l == 1) ? 8 * SEQ / 32 : NTOK / 32;
  if (tid == 0) *tnext = atomicAdd(tctr, 1);
  __syncthreads();
  for (;;) {
    const int tix = *tnext;
    if (tix >= ntile) break;
    int tclaim = 0;
    if (tid == 0) tclaim = atomicAdd(tctr, 1);
    const int tile = (l == 1) ? (tix >> 7) * 136 + 8 + (tix & 127) : tix;
    const int tok0 = tile * 32, b = tok0 / TPB, rr0 = tok0 % TPB;
    if (wave == 0) {
      const int* dep = wsp<int>(p, OFF_DEP) + (l * 136 + (tok0 >> 8)) * DEP_STRIDE;
      while (__hip_atomic_load(dep, __ATOMIC_RELAXED, __HIP_MEMORY_SCOPE_AGENT) < 32) __builtin_amdgcn_s_sleep(2);
      __builtin_amdgcn_fence(__ATOMIC_ACQUIRE, "agent");
      asm volatile("s_waitcnt vmcnt(0)" ::: "memory");
    }
    __syncthreads();
    {
      float hv[4][16], xv4[4][16];
#pragma unroll
      for (int r = 0; r < 4; ++r) load_row16_bf(wsp<u16>(p, OFF_XM) + (size_t)(tok0 + wave * 4 + r) * 1024, xv4[r]);
      ModVec mv; load_modvec(p, l, 1, (rr0 < NCTX) ? 8 : b, mv);
#pragma unroll
      for (int r = 0; r < 4; ++r) {
        modulate_row_store2<true, false>(mv, xv4[r], nullptr, hv[r], (unsigned char*)H + (size_t)(tok0 + wave * 4 + r) * 1024);
        const int ro = (wave * 4 + r) * RP + lane * 8;
#pragma unroll
        for (int i = 0; i < 4; ++i) {
          const unsigned h01 = pk2(hv[r][i * 4], hv[r][i * 4 + 1]), h23 = pk2(hv[r][i * 4 + 2], hv[r][i * 4 + 3]);
          const unsigned l01 = pk2(hv[r][i * 4] - __uint_as_float(h01 << 16), hv[r][i * 4 + 1] - __uint_as_float(h01 & 0xffff0000u));
          const unsigned l23 = pk2(hv[r][i * 4 + 2] - __uint_as_float(h23 << 16), hv[r][i * 4 + 3] - __uint_as_float(h23 & 0xffff0000u));
          *(LAS u32x2*)(hiP + ro + i * 512) = u32x2{h01, h23};
          *(LAS u32x2*)(loP + ro + i * 512) = u32x2{l01, l23};
        }
      }
      float gl[4];
#pragma unroll
      for (int o = 0; o < 4; ++o) gl[o] = router_dot(hv, WRT + (size_t)o * 1024) + p->b_group[l * 4 + o];
      int gs = 0; float best = gl[0];
#pragma unroll
      for (int j = 1; j < 4; ++j) if (gl[j] > best) { best = gl[j]; gs = j; }
      float gsum = 0.f;
#pragma unroll
      for (int j = 0; j < 4; ++j) gsum += __expf(gl[j] - best);
      if ((lane & 15) == 0) { gsel[wave * 4 + qd] = gs; gwt[wave * 4 + qd] = 1.f / gsum; }
    }
    __syncthreads();
    f32x16 acc;
#pragma unroll
    for (int i = 0; i < 16; ++i) acc[i] = 0.f;
    {
      const int ao = r32 * RP + (128 * wave + 8 * kh) * 2;
#pragma unroll
      for (int s8 = 0; s8 < 8; ++s8) {
        const bf16x8 ah = *(const LAS bf16x8*)(hiP + ao + s8 * 32), al = *(const LAS bf16x8*)(loP + ao + s8 * 32);
        acc = MFMA(ah, whi[s8], acc);
        acc = MFMA(ah, wlo[s8], acc);
        acc = MFMA(al, whi[s8], acc);
      }
    }
    __syncthreads();
#pragma unroll
    for (int i = 0; i < 16; ++i) part[(wave * 32 + (i & 3) + 8 * (i >> 2) + 4 * kh) * 33 + r32] = acc[i];
    __syncthreads();
    if (tid < 32) {
      const int gs = gsel[tid];
      const float gw_ = gwt[tid];
      float e8[8];
#pragma unroll
      for (int j = 0; j < 8; ++j) {
        float v = p->b_router[l * 32 + gs * 8 + j];
#pragma unroll
        for (int w = 0; w < 8; ++w) v += part[(w * 32 + tid) * 33 + gs * 8 + j];
        e8[j] = v;
      }
      int i0 = 0; float v0 = e8[0];
#pragma unroll
      for (int j = 1; j < 8; ++j) if (e8[j] > v0) { v0 = e8[j]; i0 = j; }
      int i1 = -1; float v1 = -INFINITY;
#pragma unroll
      for (int j = 0; j < 8; ++j) if (j != i0 && e8[j] > v1) { v1 = e8[j]; i1 = j; }
      const float ex = __expf(v1 - v0);
      const float w0 = gw_ / (1.f + ex), w1 = gw_ * ex / (1.f + ex);
      const int tok = tok0 + tid;
      const int ea = gs * 8 + i0, eb = gs * 8 + i1;
      const int ra = __hip_atomic_fetch_add(&lcnt[ea], 1, __ATOMIC_RELAXED, __HIP_MEMORY_SCOPE_WORKGROUP);
      const int rb = __hip_atomic_fetch_add(&lcnt[eb], 1, __ATOMIC_RELAXED, __HIP_MEMORY_SCOPE_WORKGROUP);
      LAS int* ti = tinfo + (nloc + tid) * 6;
      ti[0] = tok; ti[1] = ea | (eb << 8); ti[2] = ra; ti[3] = rb; ti[4] = __float_as_int(w0); ti[5] = __float_as_int(w1);
    }
    if (tid == 0) *tnext = tclaim;
    nloc += 32;
    __syncthreads();
    const bool last = *tnext >= ntile;
    if (last || nloc == 512) {
      if (tid < 32) { const int c = lcnt[tid]; gbase[tid] = c ? atomicAdd(&cnt[tid * CNT_STRIDE], c) : 0; }
      __syncthreads();
      for (int i = tid; i < nloc; i += 512) {
        const LAS int* ti = tinfo + i * 6;
        const int tok = ti[0], ea = ti[1] & 255, eb = ti[1] >> 8;
        const int sa = gbase[ea] + ti[2], sb = gbase[eb] + ti[3];
        list[(size_t)ea * NTOK + sa] = tok * 2; wlist[(size_t)ea * NTOK + sa] = __int_as_float(ti[4]);
        list[(size_t)eb * NTOK + sb] = tok * 2 + 1; wlist[(size_t)eb * NTOK + sb] = __int_as_float(ti[5]);
      }
      __syncthreads();
      if (tid < 32) lcnt[tid] = 0;
      nloc = 0;
      __syncthreads();
    }
  }
}
struct ExpInfo2 { int tiles[4], base[4], cnt[4]; };
DEVI ExpInfo2 exp_info2(KP p, int xcd) {
  const int* cnt = wsp<int>(p, OFF_CNT);
  ExpInfo2 ei;
  int before = 0;
#pragma unroll
  for (int e = 0; e < 32; ++e) {
    const int c = __builtin_amdgcn_readfirstlane(cnt[e * CNT_STRIDE]), t = (c + 255) >> 8;
    if ((e & 7) == xcd) { ei.tiles[e >> 3] = t; ei.base[e >> 3] = before; ei.cnt[e >> 3] = c; }
    before += t;
  }
  return ei;
}
template <int NN>
struct SchedX { ExpInfo2 ei; int xcd, lb, G8; const char* A; const char* W; const int* list; size_t wstride; int lda_b; int ldw_b;
  DEVI bool next(int i, Unit& u) const {
    const int tot = (ei.tiles[0] + ei.tiles[1] + ei.tiles[2] + ei.tiles[3]) * NN;
    const int n = i * G8 + lb; if (n >= tot) return false;
    int k = 0, m = n / NN; const int pn = n % NN;
    int tb = ei.base[0], ce = ei.cnt[0];
#pragma unroll
    for (int kk = 0; kk < 3; ++kk) { if (k == kk && m >= ei.tiles[kk]) { m -= ei.tiles[kk]; k = kk + 1; tb = ei.base[kk + 1]; ce = ei.cnt[kk + 1]; } }
    const int e = xcd + 8 * k;
    u.rows = list + (size_t)e * NTOK + m * 256; u.nvalid = ce - m * 256;
    u.A = A + (NN == 2 ? 0u : uoff((unsigned)(tb + m) * 256u * (unsigned)lda_b));
    u.B = W + uoff((unsigned)e * (unsigned)wstride + (unsigned)pn * 256u * (unsigned)ldw_b);
    u.u0 = (tb + m) * 256; u.u1 = pn; u.u2 = e; u.u3 = m; return true; } };
constexpr float U8_SCALE = 16.f;
struct EpiI1 { unsigned char* U;
  DEVI void init(f32x4 (&acc)[2][2][4][2], const Unit&, int, int, int, int) const { acc_zero(acc); }
  DEVI void operator()(const f32x4 (&acc)[2][2][4][2], const Unit& u, int wr, int wc, int fr, int fq) const {
#pragma unroll
    for (int ai = 0; ai < 2; ++ai)
#pragma unroll
      for (int m = 0; m < 4; ++m) {
        unsigned char* rowp = U + (size_t)(u.u0 + ai * HALF + wr * 64 + m * 16 + fr) * 256;
#pragma unroll
        for (int bj = 0; bj < 2; ++bj) {
          const int ff = 16 * (8 * u.u1 + 4 * bj + wc) + 4 * fq;
          const f32x4 g = acc[ai][bj][m][0], up = acc[ai][bj][m][1];
          float t[4];
#pragma unroll
          for (int j = 0; j < 4; ++j) t[j] = __builtin_amdgcn_fmed3f(g[j] * __builtin_amdgcn_rcpf(1.f + __builtin_amdgcn_exp2f(g[j] * -LOG2E)) * (up[j] * U8_SCALE), -448.f, 448.f);
          int o = __builtin_amdgcn_cvt_pk_fp8_f32(t[0], t[1], 0, false);
          o = __builtin_amdgcn_cvt_pk_fp8_f32(t[2], t[3], o, true);
          *(int*)(rowp + ff) = o;
        }
      }
  }
};
DEVI void phaseI1_2(KP p, ldsp_t lds) {
  const int xcd = BIDX & 7, lb = BIDX >> 3, G8 = gridDim.x >> 3;
  if (lb >= G8) return;
  SchedX<2> S{exp_info2(p, xcd), xcd, lb, G8, (const char*)wsp<u16>(p, OFF_H2), (const char*)wsp<u16>(p, OFF_W13), wsp<int>(p, OFF_LIST), (size_t)512 * 1024, 1024, 1024};
  EpiI1 E{wsp<unsigned char>(p, OFF_U)};
  int nt = 8; asm volatile("" : "+s"(nt));
  gemm_phase<false, true, true>(lds, 1024, 1024, nt, S, E);
}
constexpr float YS8_SCALE = 32.f;
struct EpiI2 { unsigned char* YS; const float* wlist; const int* list;
  DEVI void init(f32x4 (&acc)[2][2][4][2], const Unit&, int, int, int, int) const { acc_zero(acc); }
  DEVI void operator()(const f32x4 (&acc)[2][2][4][2], const Unit& u, int wr, int wc, int fr, int fq) const {
    const unsigned colb = (unsigned)(u.u1 * 256 + wc * 32 + 8 * fq);
    const float* we = wlist + (u.rows - list);
    unsigned dest[2][4]; float w[2][4];
#pragma unroll
    for (int ai = 0; ai < 2; ++ai)
#pragma unroll
      for (int m = 0; m < 4; ++m) {
        const int r = ai * HALF + wr * 64 + m * 16 + fr;
        dest[ai][m] = (r < u.nvalid) ? (unsigned)u.rows[r] : (unsigned)(2 * NTOK);
        w[ai][m] = we[r] * (YS8_SCALE / U8_SCALE);
      }
#pragma unroll
    for (int ai = 0; ai < 2; ++ai)
#pragma unroll
      for (int m = 0; m < 4; ++m) {
        unsigned char* rowp = YS + (dest[ai][m] * 1024u + colb);
#pragma unroll
        for (int bj = 0; bj < 2; ++bj) {
          u32x2 o;
#pragma unroll
          for (int nn = 0; nn < 2; ++nn) {
            const f32x4 v = acc[ai][bj][m][nn] * w[ai][m];
            int q = __builtin_amdgcn_cvt_pk_fp8_f32(__builtin_amdgcn_fmed3f(v[0], -448.f, 448.f), __builtin_amdgcn_fmed3f(v[1], -448.f, 448.f), 0, false);
            q = __builtin_amdgcn_cvt_pk_fp8_f32(__builtin_amdgcn_fmed3f(v[2], -448.f, 448.f), __builtin_amdgcn_fmed3f(v[3], -448.f, 448.f), q, true);
            o[nn] = (unsigned)q;
          }
          *(u32x2*)(rowp + bj * 128) = o;
        }
      }
  }
};
DEVI void phaseI2_2(KP p, ldsp_t lds) {
  const int xcd = BIDX & 7, lb = BIDX >> 3, G8 = gridDim.x >> 3;
  if (lb >= G8) return;
  SchedX<4> S{exp_info2(p, xcd), xcd, lb, G8, (const char*)wsp<u16>(p, OFF_U), (const char*)wsp<u16>(p, OFF_W2), wsp<int>(p, OFF_LIST), (size_t)1024 * 256, 256, 256};
  EpiI2 E{wsp<unsigned char>(p, OFF_YS), wsp<float>(p, OFF_WLIST), wsp<int>(p, OFF_LIST)};
  int nt = 2; asm volatile("" : "+s"(nt));
  gemm_phase<true, false, true>(lds, 256, 256, nt, S, E);
}
DEVI void phaseJ2(KP p, int l, ldsp_t lds) {
  const int lane = TIDX & 63;
  const int gw = BIDX * NW + (TIDX >> 6), nw = gridDim.x * NW;
  const unsigned char* YS = wsp<unsigned char>(p, OFF_YS);
  u16* H = wsp<u16>(p, OFF_H);
  const int ntot = (l == 1) ? 8 * SEQ : NTOK;
  const int per = (ntot + nw - 1) / nw;
  const int i0 = gw * per, i1 = min(i0 + per, ntot);
  int cur = -1; ModVec mv; f32x4 gtv[4];
  for (int ii = i0; ii < i1; ii += 2) {
    float xv[2][16]; int y0[2][4], y1[2][4]; bool ok[2]; int tk[2];
#pragma unroll
    for (int r = 0; r < 2; ++r) {
      const int idx = ii + r;
      const int tok = (l == 1) ? (idx / SEQ) * TPB + NCTX + idx % SEQ : idx;
      tk[r] = tok;
      ok[r] = idx < i1;
      if (ok[r]) {
        load_row16_bf(wsp<u16>(p, OFF_XM) + (size_t)tok * 1024, xv[r]);
#pragma unroll
        for (int i = 0; i < 4; ++i) {
          const int c = i * 256 + lane * 4;
          y0[r][i] = *(const int*)(YS + (size_t)(tok * 2) * 1024 + c);
          y1[r][i] = *(const int*)(YS + (size_t)(tok * 2 + 1) * 1024 + c);
        }
      }
    }
#pragma unroll
    for (int r = 0; r < 2; ++r) {
      if (!ok[r]) continue;
      const int tok = tk[r];
      const int b = tok / TPB, rr = tok % TPB;
      const int mrow = (rr < NCTX) ? 8 : b;
      if (mrow != cur) {
        cur = mrow;
        const float* gt = wsp<float>(p, OFF_MOD) + ((size_t)l * 9 + mrow) * 6144 + 5120;
#pragma unroll
        for (int i = 0; i < 4; ++i) gtv[i] = *(const f32x4*)(gt + i * 256 + lane * 4);
        if (l == 0) load_modvec(p, 1, 0, mrow, mv);
      }
#pragma unroll
      for (int i = 0; i < 4; ++i) {
        const f32x4 g = gtv[i] * (1.f / YS8_SCALE);
        const f32x2 a0 = __builtin_amdgcn_cvt_pk_f32_fp8(y0[r][i], false), a1 = __builtin_amdgcn_cvt_pk_f32_fp8(y0[r][i], true);
        const f32x2 b0 = __builtin_amdgcn_cvt_pk_f32_fp8(y1[r][i], false), b1 = __builtin_amdgcn_cvt_pk_f32_fp8(y1[r][i], true);
        xv[r][i * 4 + 0] += g.x * (a0.x + b0.x);
        xv[r][i * 4 + 1] += g.y * (a0.y + b0.y);
        xv[r][i * 4 + 2] += g.z * (a1.x + b1.x);
        xv[r][i * 4 + 3] += g.w * (a1.y + b1.y);
      }
      if (l == 0) {
        u16* xr = (u16*)p->out + (size_t)tok * 1024;
#pragma unroll
        for (int i = 0; i < 4; ++i)
          *(u32x2*)(xr + i * 256 + lane * 4) = u32x2{pk2(xv[r][i * 4], xv[r][i * 4 + 1]), pk2(xv[r][i * 4 + 2], xv[r][i * 4 + 3])};
        float hv[16];
        modulate_row_store2<true, false>(mv, xv[r], nullptr, hv, h8base(p) + (size_t)tok * 1024);
      } else {
        float ss = 0.f;
#pragma unroll
        for (int i = 0; i < 16; ++i) ss += xv[r][i] * xv[r][i];
        ss = wave_sum(ss);
        const float rstd = rsqrtf(ss * (1.f / 1024.f) + EPS);
        float* xr = p->out + ((size_t)b * SEQ + rr - NCTX) * 1024;
#pragma unroll
        for (int i = 0; i < 4; ++i) {
          const int c = i * 256 + lane * 4;
          const f32x4 g = *(const f32x4*)(p->g_final + c);
          __builtin_nontemporal_store(f32x4{xv[r][i * 4] * rstd * g.x, xv[r][i * 4 + 1] * rstd * g.y, xv[r][i * 4 + 2] * rstd * g.z, xv[r][i * 4 + 3] * rstd * g.w}, (f32x4*)(xr + c));
        }
      }
    }
  }
}

constexpr int N_PHASES = 3 + 2 * 11;
__global__ void __launch_bounds__(512, 2) fwd_v2(Params parg) {
  extern __shared__ __attribute__((aligned(16))) unsigned char dyn_lds[];
  const ldsp_t lds = (ldsp_t)dyn_lds;
  cg::grid_group grid = cg::this_grid();
  volatile LAS unsigned* xb_st = (volatile LAS unsigned*)(lds + LDS_BARW);
  if (TIDX < 4) xb_st[TIDX] = 0u;
  __syncthreads();
  if (parg.ph_end - parg.ph_begin > 1) xcd_barrier_post((unsigned*)(parg.ws + OFF_BAR));
  for (int ph = parg.ph_begin; ph < parg.ph_end; ++ph) {
    KP p = (KP)__builtin_amdgcn_kernarg_segment_ptr();
    asm volatile("" : "+s"(p));
    const int l = (ph >= 14) ? 1 : 0;
    const int k = (ph < 3) ? ph : 3 + (ph - 3) % 11;
    const int reps = (((PROBE_DUP >> k) & 1) && (!(PROBE_DUP & 0x10000) || l == 0)) ? 2 : 1;
    for (int rep = 0; rep < reps; ++rep) {
      if (rep) {
        xcd_barrier((unsigned*)(p->ws + OFF_BAR), xb_st);
        if (k == 10) { if (BIDX == 0 && TIDX < 32) wsp<int>(p, OFF_CNT)[TIDX * CNT_STRIDE] = 0; xcd_barrier((unsigned*)(p->ws + OFF_BAR), xb_st); }
      }
      switch (k) {
        case 0: phase0_2(p, lds); break;
        case 1: phase1_2(p); break;
        case 2: phaseA2(p); break;
        case 3: phaseB2(p, lds); break;
        case 4: phaseC2(p, lds); break;
        case 5: phaseP2(p, l, lds); break;
        case 6: phaseD2(p, l, lds); break;
        case 7: phaseE1(p, l, lds); break;
        case 8: phaseE2(p, l, lds); break;
        case 9: phaseF2(p, l, lds); break;
        case 10: phaseG2(p, l, lds); break;
        case 11: phaseI1_2(p, lds); break;
        case 12: phaseI2_2(p, lds); break;
        default: phaseJ2(p, l, lds); break;
      }
    }
    if (k == 0 || (k == 13 && l == 0)) conv_items2(p, k == 0 ? 0 : 1, lds, 0, CONV_EARLY);
    if (ph + 1 < parg.ph_end && k != 9) {
      if (parg.ph_begin >= 1000) grid.sync();
      else xcd_barrier((unsigned*)(p->ws + OFF_BAR), xb_st);
    }
  }
}
}

extern "C" void kernel_launch(void* const* d_in, const int* in_sizes, int n_in, void* d_out, int out_size,
                              void* d_ws, size_t ws_size, hipStream_t stream) {
  static int grid2 = 0;
  if (!grid2) {
    int dev = 0, cus = 0, per_cu = 0;
    (void)hipGetDevice(&dev);
    (void)hipDeviceGetAttribute(&cus, hipDeviceAttributeMultiprocessorCount, dev);
    (void)hipFuncSetAttribute((const void*)v2::fwd_v2, hipFuncAttributeMaxDynamicSharedMemorySize, v2::LDS_TOTAL);
    (void)hipOccupancyMaxActiveBlocksPerMultiprocessor(&per_cu, v2::fwd_v2, 512, v2::LDS_TOTAL);
    if (per_cu < 1) { fprintf(stderr, "kernel does not fit on a CU\n"); per_cu = 1; }
    grid2 = cus & ~7;
  }
  if (ws_size < WS_NEEDED) { fprintf(stderr, "workspace too small: %zu < %zu\n", ws_size, (size_t)WS_NEEDED); return; }
  Params hp{};
  const float** f = (const float**)&hp;
  for (int i = 0; i < 29; ++i) f[i] = (const float*)d_in[i];
  hp.out = (float*)d_out;
  hp.ws = (char*)d_ws;
#if N_LAUNCH_MODE == 1
  for (int ph = 0; ph < v2::N_PHASES; ++ph) {
    hp.ph_begin = ph; hp.ph_end = ph + 1;
    void* args[] = {&hp};
    hipError_t e = hipLaunchCooperativeKernel((void*)v2::fwd_v2, dim3(grid2), dim3(512), args, v2::LDS_TOTAL, stream);
    if (e != hipSuccess) fprintf(stderr, "launch failed: %s\n", hipGetErrorString(e));
  }
#else
  hp.ph_begin = 0; hp.ph_end = v2::N_PHASES;
  (void)hipMemsetAsync((char*)d_ws + OFF_BAR, 0, (size_t)(OFF_DEP - OFF_BAR) + (size_t)DEP_WORDS * 4, stream);
  void* args[] = {&hp};
  hipError_t e = hipLaunchCooperativeKernel((void*)v2::fwd_v2, dim3(grid2), dim3(512), args, v2::LDS_TOTAL, stream);
  if (e != hipSuccess) fprintf(stderr, "cooperative launch failed: %s (grid %d)\n", hipGetErrorString(e), grid2);
#endif
}
```

```cpp
#include <hip/hip_runtime.h>
#include <hip/hip_cooperative_groups.h>
#include <stdint.h>
#include <stdio.h>
namespace cg = cooperative_groups;

#ifndef N_LAUNCH_MODE
#define N_LAUNCH_MODE 0
#endif

#ifndef PROBE_DUP
#define PROBE_DUP 0
#endif
#define DEVI __device__ __forceinline__
typedef unsigned short u16;
typedef __attribute__((ext_vector_type(2))) float f32x2;
typedef __attribute__((ext_vector_type(2))) __bf16 bf16x2_t;
typedef __attribute__((ext_vector_type(8))) short bf16x8;
typedef __attribute__((ext_vector_type(16))) float f32x16;
typedef __attribute__((ext_vector_type(4))) unsigned u32x4;
typedef __attribute__((ext_vector_type(2))) unsigned u32x2;
typedef __attribute__((ext_vector_type(4))) float f32x4;
#define MFMA(a, b, c) __builtin_amdgcn_mfma_f32_32x32x16_bf16((a), (b), (c), 0, 0, 0)

constexpr int DMODEL = 1024, NBATCH = 8, SEQ = 4096, NCTX = 256;
constexpr int TPB = SEQ + NCTX;
constexpr int NTOK = NBATCH * TPB;
constexpr int MT_PER_B = TPB / 128;
constexpr int NEXP = 32;
constexpr int INP = 2304;
constexpr float EPS = 1e-6f;
constexpr float LOG2E = 1.4426950408889634f;
constexpr int SMEM_BYTES = 73728;
constexpr int UROWS = 2 * NTOK + NEXP * 256;

constexpr size_t al(size_t x) { return (x + 255) & ~(size_t)255; }
constexpr size_t OFF_WIN = 0;
constexpr size_t OFF_WQB = OFF_WIN + al((size_t)INP * 1024 * 2);
constexpr size_t OFF_WKVB = OFF_WQB + al((size_t)512 * 256 * 2);
constexpr size_t OFF_WGATE = OFF_WKVB + al((size_t)512 * 256 * 2);
constexpr size_t OFF_WBR = OFF_WGATE + al((size_t)4 * 1024 * 1024 * 2);
constexpr size_t OFF_WOUT = OFF_WBR + al((size_t)4 * 1024 * 256 * 2);
constexpr size_t OFF_W13 = OFF_WOUT + al((size_t)1024 * 1024 * 2);
constexpr size_t OFF_W2 = OFF_W13 + al((size_t)32 * 512 * 1024 * 2);
constexpr size_t OFF_MODP = OFF_W2 + al((size_t)32 * 1024 * 256 * 2);
constexpr size_t OFF_MOD = OFF_MODP + al((size_t)8 * 2 * 9 * 6144 * 4);
constexpr size_t OFF_CS32 = OFF_MOD + al((size_t)2 * 9 * 6144 * 4);
constexpr size_t OFF_CS16 = OFF_CS32 + al((size_t)64 * 16 * 2 * 4);
constexpr size_t OFF_WRT = OFF_CS16 + al((size_t)64 * 8 * 2 * 4);
constexpr size_t OFF_CNT = OFF_WRT + al((size_t)2 * 36 * 1024 * 4);
constexpr int CNT_STRIDE = 64;
constexpr size_t OFF_BAR = OFF_CNT + al(32 * CNT_STRIDE * 4);
constexpr int XCD_BAR_WORDS = 3456;
constexpr size_t OFF_CTXRES = OFF_BAR + al((size_t)XCD_BAR_WORDS * 4);
constexpr size_t OFF_DEP = OFF_CTXRES;
constexpr int DEP_STRIDE = 16, DEP_TILECTR = 2 * 136 * DEP_STRIDE, DEP_WORDS = DEP_TILECTR + 2 * DEP_STRIDE;
constexpr size_t OFF_H = OFF_CTXRES + al((size_t)8 * 256 * 1024 * 4);
constexpr size_t OFF_O = OFF_H + al((size_t)NTOK * 1024 * 2);
constexpr size_t OFF_SSQ = OFF_O + al((size_t)NTOK * 1024 * 2);
constexpr size_t OFF_LIST = OFF_SSQ + al((size_t)NTOK * 8 * 4);
constexpr size_t OFF_WLIST = OFF_LIST + al((size_t)32 * NTOK * 4);
constexpr size_t OFF_R1 = OFF_WLIST + al((size_t)32 * NTOK * 4);
constexpr int PLD = INP;
constexpr size_t OFF_PRAW = OFF_R1;
constexpr size_t OFF_QARAW = OFF_PRAW + (size_t)NTOK * INP * 2;
constexpr size_t OFF_KVARAW = OFF_QARAW + (size_t)NTOK * 512 * 2;
constexpr size_t OFF_VAT = OFF_KVARAW + (size_t)NTOK * 512 * 2;
constexpr size_t OFF_VBT = OFF_VAT + (size_t)NTOK * 256 * 2;
constexpr size_t OFF_VCT = OFF_VBT + (size_t)NTOK * 128 * 2;
constexpr size_t OFF_VDT = OFF_VCT + (size_t)NTOK * 256 * 2;
constexpr size_t OFF_END = OFF_VDT + (size_t)NTOK * 128 * 2;
constexpr size_t OFF_Z = OFF_R1;
constexpr size_t OFF_Y8 = OFF_H;
constexpr size_t OFF_H2 = OFF_O;
constexpr size_t OFF_YPRE = OFF_O;
constexpr size_t OFF_U = OFF_R1;
constexpr size_t OFF_YS = OFF_R1 + al((size_t)UROWS * 256 * 2);
constexpr size_t OFF_XM = OFF_YS + al((size_t)(2 * NTOK + 1) * 1024 * 2);
static_assert(OFF_XM + (size_t)NTOK * 1024 * 2 <= OFF_END, "alias overflow");
static_assert(OFF_Z + (size_t)NTOK * 4096 * 2 <= OFF_END, "alias overflow");
static_assert(OFF_YS + (size_t)(2 * NTOK + 1) * 1024 * 2 <= OFF_END, "alias overflow");
constexpr size_t WS_NEEDED = OFF_END;
static_assert(WS_NEEDED <= (size_t)536870912, "workspace budget (4 x largest tensor)");

struct Params {
  const float *x, *c, *ctx, *c_ctx, *w_mod, *b_mod, *g_norm_mix, *w_in, *g_q_a, *w_q_b, *g_kv_a, *w_kv_b,
      *sink_b, *rpb_c, *g_q_d, *g_k_d, *w_gate, *b_gate, *w_branch, *w_out, *g_norm_ffn, *w_group, *b_group,
      *w_router, *b_router, *w_ff1, *w_ff3, *w_ff2, *g_final;
  float* out;
  char* ws;
  int ph_begin, ph_end;
};

DEVI int tid_fresh() { int t; asm volatile("v_mov_b32 %0, %1" : "=v"(t) : "v"(__builtin_amdgcn_workitem_id_x())); return t; }
DEVI int bid_fresh() { int t; asm volatile("s_mov_b32 %0, %1" : "=s"(t) : "s"(__builtin_amdgcn_workgroup_id_x())); return t; }
#define TIDX tid_fresh()
#define BIDX bid_fresh()
typedef const __attribute__((address_space(4))) Params* KP;
DEVI unsigned pk2(float a, float b) { f32x2 v = {a, b}; bf16x2_t r = __builtin_convertvector(v, bf16x2_t); return __builtin_bit_cast(unsigned, r); }
DEVI u16 f2bf(float a) { return (u16)(pk2(a, 0.f) & 0xffffu); }
DEVI float bf2f(u16 v) { return __uint_as_float(((unsigned)v) << 16); }
DEVI float wave_sum(float v) {
#pragma unroll
  for (int m = 32; m >= 1; m >>= 1) v += __shfl_xor(v, m);
  return v;
}
template <class T> DEVI T* wsp(KP p, size_t off) { return (T*)(p->ws + off); }
DEVI const float* xrow_in(KP p, int l, int b, int rr) {
  if (l == 0) return (rr < NCTX) ? p->ctx + ((size_t)b * NCTX + rr) * 1024 : p->x + ((size_t)b * SEQ + rr - NCTX) * 1024;
  return (rr < NCTX) ? wsp<float>(p, OFF_CTXRES) + ((size_t)b * NCTX + rr) * 1024 : p->out + ((size_t)b * SEQ + rr - NCTX) * 1024;
}
DEVI float* xrow_res(KP p, int b, int rr) {
  return (rr < NCTX) ? wsp<float>(p, OFF_CTXRES) + ((size_t)b * NCTX + rr) * 1024 : p->out + ((size_t)b * SEQ + rr - NCTX) * 1024;
}
DEVI int perm16(int k) { return (k & ~12) | ((k & 4) << 1) | ((k & 8) >> 1); }

struct ConvT { const float* src; const float* src2; const float* ks; u16* dst; int ld; int ldd; float mul; };
constexpr float Z8_SCALE = 16.f, O8_SCALE = 32.f;
constexpr float F8_WSCALE = 64.f, GATE_WSCALE = F8_WSCALE;
constexpr int CONV_ITEMS = 1152 + 64 + 64 + 2048 + 512 + 512 + 8192 + 4096;
DEVI ConvT conv_decode(KP p, int l, int idx) {
  ConvT c; c.ks = nullptr; c.mul = 1.f; c.src2 = nullptr;
  if (idx < 1152) {
    int nt = idx >> 4, kt = idx & 15, n0 = nt * 32;
    int sc = (n0 < 416) ? n0 : ((n0 < 512) ? -1 : n0 - 96);
    c.ld = 2208; c.ldd = -1024;
    c.mul = F8_WSCALE;
    if ((n0 >= 512 && n0 < 768) || (n0 >= 1024 && n0 < 1280)) c.mul = 0.125f * LOG2E * F8_WSCALE;
    c.src = (sc < 0) ? nullptr : p->w_in + (size_t)l * 1024 * 2208 + (size_t)kt * 64 * 2208 + sc;
    c.dst = (u16*)(p->ws + OFF_WIN + (size_t)n0 * 1024 + kt * 64);
    return c;
  }
  idx -= 1152;
  if (idx < 64) {
    int nt = idx >> 2, kt = idx & 3;
    c.ld = 384; c.ldd = 256; c.ks = p->g_q_a + l * 256 + kt * 64;
    c.src = (nt >= 12) ? nullptr : p->w_q_b + (size_t)l * 256 * 384 + (size_t)kt * 64 * 384 + nt * 32;
    c.dst = wsp<u16>(p, OFF_WQB) + (size_t)nt * 32 * 256 + kt * 64;
    return c;
  }
  idx -= 64;
  if (idx < 64) {
    int nt = idx >> 2, kt = idx & 3;
    c.ld = 512; c.ldd = 256; c.ks = (kt < 2) ? p->g_kv_a + l * 128 + kt * 64 : nullptr;
    c.src = (kt >= 2) ? nullptr : p->w_kv_b + (size_t)l * 128 * 512 + (size_t)kt * 64 * 512 + nt * 32;
    c.dst = wsp<u16>(p, OFF_WKVB) + (size_t)nt * 32 * 256 + kt * 64;
    return c;
  }
  idx -= 64;
  if (idx < 2048) {
    int nt = idx >> 4, kt = idx & 15, R0 = nt * 32;
    int pr = R0 >> 11, cb = (R0 & 2047) >> 8, bj = (R0 & 255) >> 7, j0 = R0 & 127;
    c.ld = 1024; c.ldd = -1024; c.mul = -LOG2E * F8_WSCALE;
    c.src = p->w_gate + ((size_t)(l * 4 + 2 * pr + bj) * 1024 + kt * 64) * 1024 + cb * 128 + j0;
    c.dst = (u16*)(p->ws + OFF_WGATE + (size_t)R0 * 1024 + kt * 64);
    return c;
  }
  idx -= 2048;
  if (idx < 512) {
    int br = idx >> 7, nt = (idx >> 2) & 31, kt = idx & 3;
    c.ld = 1024; c.ldd = -256; c.mul = F8_WSCALE * (Z8_SCALE / O8_SCALE);
    c.src = p->w_branch + ((size_t)(l * 4 + br) * 256 + kt * 64) * 1024 + nt * 32;
    c.dst = (u16*)(p->ws + OFF_WBR + ((size_t)br * 1024 + nt * 32) * 256 + kt * 64);
    return c;
  }
  idx -= 512;
  if (idx < 512) {
    int nt = idx >> 4, kt = idx & 15;
    c.ld = 1024; c.ldd = -1024; c.mul = F8_WSCALE;
    c.src = p->w_out + ((size_t)l * 1024 + kt * 64) * 1024 + nt * 32;
    c.dst = (u16*)(p->ws + OFF_WOUT + (size_t)nt * 32 * 1024 + kt * 64);
    return c;
  }
  idx -= 512;
  if (idx < 8192) {
    int e = idx >> 8, g32 = (idx >> 4) & 15, kt = idx & 15;
    c.ld = 256; c.ldd = -1024; c.mul = F8_WSCALE;
    c.src = p->w_ff1 + ((size_t)(l * 32 + e) * 1024 + kt * 64) * 256 + g32 * 16;
    c.src2 = p->w_ff3 + ((size_t)(l * 32 + e) * 1024 + kt * 64) * 256 + g32 * 16;
    c.dst = (u16*)(p->ws + OFF_W13 + ((size_t)e * 512 + g32 * 32) * 1024 + kt * 64);
    return c;
  }
  idx -= 8192;
  {
    int e = idx >> 7, nt = (idx >> 2) & 31, kt = idx & 3;
    c.ld = 1024; c.ldd = -256; c.mul = F8_WSCALE;
    c.src = p->w_ff2 + ((size_t)(l * 32 + e) * 256 + kt * 64) * 1024 + nt * 32;
    c.dst = (u16*)(p->ws + OFF_W2 + ((size_t)e * 1024 + nt * 32) * 256 + kt * 64);
    return c;
  }
}
DEVI void modulate_row_store(KP p, int l, int which, const float (&xv)[16], int mrow, u16* hrow, float (&hv)[16]) {
  const int lane = TIDX & 63;
  float ss = 0.f;
#pragma unroll
  for (int i = 0; i < 16; ++i) ss += xv[i] * xv[i];
  ss = wave_sum(ss);
  const float rstd = rsqrtf(ss * (1.f / 1024.f) + EPS);
  const float* g = (which ? p->g_norm_ffn : p->g_norm_mix) + l * 1024;
  const float* mod = wsp<float>(p, OFF_MOD) + ((size_t)l * 9 + mrow) * 6144 + (which ? 3072 : 0);
#pragma unroll
  for (int i = 0; i < 4; ++i) {
    const int c = i * 256 + lane * 4;
    f32x4 gv = *(const f32x4*)(g + c);
    f32x4 sh = *(const f32x4*)(mod + c);
    f32x4 sc = *(const f32x4*)(mod + 1024 + c);
    hv[i * 4 + 0] = xv[i * 4 + 0] * rstd * gv.x * (1.f + sc.x) + sh.x;
    hv[i * 4 + 1] = xv[i * 4 + 1] * rstd * gv.y * (1.f + sc.y) + sh.y;
    hv[i * 4 + 2] = xv[i * 4 + 2] * rstd * gv.z * (1.f + sc.z) + sh.z;
    hv[i * 4 + 3] = xv[i * 4 + 3] * rstd * gv.w * (1.f + sc.w) + sh.w;
    u32x2 o; o.x = pk2(hv[i * 4 + 0], hv[i * 4 + 1]); o.y = pk2(hv[i * 4 + 2], hv[i * 4 + 3]);
    *(u32x2*)(hrow + c) = o;
  }
}
struct ModVec { f32x4 a[4], b[4]; };
DEVI void load_modvec(KP p, int l, int which, int mrow, ModVec& mv) {
  const int lane = TIDX & 63;
  const float* g = (which ? p->g_norm_ffn : p->g_norm_mix) + l * 1024;
  const float* mod = wsp<float>(p, OFF_MOD) + ((size_t)l * 9 + mrow) * 6144 + (which ? 3072 : 0);
#pragma unroll
  for (int i = 0; i < 4; ++i) {
    const int c = i * 256 + lane * 4;
    const f32x4 gv = *(const f32x4*)(g + c), sh = *(const f32x4*)(mod + c), sc = *(const f32x4*)(mod + 1024 + c);
    mv.a[i] = gv * (1.f + sc); mv.b[i] = sh;
  }
}
DEVI unsigned char* h8base(KP p) { return (unsigned char*)p->out + (size_t)NTOK * 2048; }
template <bool F8COPY = false, bool BF16 = true>
DEVI void modulate_row_store2(const ModVec& mv, const float (&xv)[16], u16* hrow, float (&hv)[16], unsigned char* h8row = nullptr) {
  const int lane = TIDX & 63;
  float ss = 0.f;
#pragma unroll
  for (int i = 0; i < 16; ++i) ss += xv[i] * xv[i];
  ss = wave_sum(ss);
  const float rstd = rsqrtf(ss * (1.f / 1024.f) + EPS);
#pragma unroll
  for (int i = 0; i < 4; ++i) {
    const int c = i * 256 + lane * 4;
#pragma unroll
    for (int j = 0; j < 4; ++j) hv[i * 4 + j] = xv[i * 4 + j] * rstd * mv.a[i][j] + mv.b[i][j];
    if (BF16) { u32x2 o; o.x = pk2(hv[i * 4 + 0], hv[i * 4 + 1]); o.y = pk2(hv[i * 4 + 2], hv[i * 4 + 3]);
      *(u32x2*)(hrow + c) = o; }
    if (F8COPY) {
      float q[4];
#pragma unroll
      for (int j = 0; j < 4; ++j) q[j] = __builtin_amdgcn_fmed3f(hv[i * 4 + j], -448.f, 448.f);
      int v = __builtin_amdgcn_cvt_pk_fp8_f32(q[0], q[1], 0, false);
      v = __builtin_amdgcn_cvt_pk_fp8_f32(q[2], q[3], v, true);
      *(int*)(h8row + c) = v;
    }
  }
}
DEVI void load_row16(const float* xr, float (&xv)[16]) {
  const int lane = TIDX & 63;
#pragma unroll
  for (int i = 0; i < 4; ++i) {
    f32x4 v = __builtin_nontemporal_load((const f32x4*)(xr + i * 256 + lane * 4));
    xv[i * 4 + 0] = v.x; xv[i * 4 + 1] = v.y; xv[i * 4 + 2] = v.z; xv[i * 4 + 3] = v.w;
  }
}
template <bool NT = false>
DEVI void load_row16_bf(const u16* xr, float (&xv)[16]) {
  const int lane = TIDX & 63;
#pragma unroll
  for (int i = 0; i < 4; ++i) {
    const u32x2 v = NT ? __builtin_nontemporal_load((const u32x2*)(xr + i * 256 + lane * 4)) : *(const u32x2*)(xr + i * 256 + lane * 4);
    xv[i * 4 + 0] = __uint_as_float(v.x << 16); xv[i * 4 + 1] = __uint_as_float(v.x & 0xffff0000u);
    xv[i * 4 + 2] = __uint_as_float(v.y << 16); xv[i * 4 + 3] = __uint_as_float(v.y & 0xffff0000u);
  }
}
DEVI float router_dot(const float (&hv)[4][16], const float* wrow) {
  const int lane = TIDX & 63;
  const float* w = wrow + lane * 4;
  float pr[4] = {0.f, 0.f, 0.f, 0.f};
#pragma unroll
  for (int i = 0; i < 4; ++i) {
    const f32x4 wv = *(const f32x4*)(w + i * 256);
#pragma unroll
    for (int r = 0; r < 4; ++r)
      pr[r] += hv[r][i * 4] * wv.x + hv[r][i * 4 + 1] * wv.y + hv[r][i * 4 + 2] * wv.z + hv[r][i * 4 + 3] * wv.w;
  }
  const bool up = (lane & 32) != 0;
  float s0 = up ? pr[0] : pr[2], s1 = up ? pr[1] : pr[3];
  float k0 = up ? pr[2] : pr[0], k1 = up ? pr[3] : pr[1];
  k0 += __shfl_xor(s0, 32); k1 += __shfl_xor(s1, 32);
  const bool up2 = (lane & 16) != 0;
  float sv = up2 ? k0 : k1, kv = up2 ? k1 : k0;
  kv += __shfl_xor(sv, 16);
  kv += __shfl_xor(kv, 8); kv += __shfl_xor(kv, 4); kv += __shfl_xor(kv, 2); kv += __shfl_xor(kv, 1);
  return kv;
}
#define XB_TMO      128
#define XB_XCNT(j)  (256  + 64 * (j))
#define XB_XSUB(j)  (1280 + 64 * (j))
#define XB_XGEN(j)  (2304 + 64 * (j))
#define XB_TOP      3328
#define XB_TOPGEN   3392
#define XB_SPIN_CAP (1u << 20)
#define LAS __attribute__((address_space(3)))
DEVI unsigned xb_ld(unsigned* p) { return __hip_atomic_load(p, __ATOMIC_RELAXED, __HIP_MEMORY_SCOPE_AGENT); }
DEVI unsigned xb_add(unsigned* p, unsigned v) { return __hip_atomic_fetch_add(p, v, __ATOMIC_RELAXED, __HIP_MEMORY_SCOPE_AGENT); }
DEVI unsigned xb_xcc_id() { return (unsigned)__builtin_amdgcn_s_getreg((3 << 11) | 20) & 0xFu; }
#define XB_SPIN(cond, bar) do { unsigned _sp = 0; while (cond) { __builtin_amdgcn_s_sleep(1); \
    if ((++_sp & 255u) == 0u) { if (xb_ld(&(bar)[XB_TMO])) break; if (_sp > XB_SPIN_CAP) { atomicAdd(&(bar)[XB_TMO], 1u); break; } } } } while (0)
DEVI void xcd_barrier_post(unsigned* bar) {
  if (TIDX == 0) (void)xb_add(&bar[XB_XCNT(xb_xcc_id())], 1u);
}
DEVI void xcd_barrier_complete(unsigned* bar, unsigned x, unsigned& nloc, unsigned& nx) {
  const unsigned G = gridDim.x * gridDim.y * gridDim.z;
  unsigned sum, cnt, mine, sp = 0u;
  for (;;) {
    sum = 0u; cnt = 0u; mine = 0u;
#pragma unroll
    for (unsigned j = 0; j < 16; ++j) { const unsigned c = xb_ld(&bar[XB_XCNT(j)]); sum += c; cnt += (c > 0u) ? 1u : 0u; mine = (j == x) ? c : mine; }
    if (sum == G) break;
    __builtin_amdgcn_s_sleep(1);
    if ((++sp & 255u) == 0u) { if (xb_ld(&bar[XB_TMO])) break; if (sp > XB_SPIN_CAP) { atomicAdd(&bar[XB_TMO], 1u); break; } }
  }
  nloc = mine > 0u ? mine : 1u; nx = cnt > 0u ? cnt : 1u;
}
DEVI void xcd_barrier(unsigned* bar, volatile LAS unsigned* st) {
  asm volatile("s_waitcnt vmcnt(0)" ::: "memory");
  __syncthreads();
  if (TIDX == 0) {
    const unsigned x = xb_xcc_id();
    __builtin_amdgcn_s_waitcnt(0);
    unsigned nloc = st[0], nx = st[1];
    if (nloc == 0u) { xcd_barrier_complete(bar, x, nloc, nx); st[0] = nloc; st[1] = nx; }
    const unsigned old = xb_add(&bar[XB_XSUB(x)], 1u);
    const unsigned gen = old / nloc;
    if (old + 1u == (gen + 1u) * nloc) {
      __builtin_amdgcn_fence(__ATOMIC_RELEASE, "agent");
      asm volatile("s_waitcnt vmcnt(0)" ::: "memory");
      const unsigned og = xb_add(&bar[XB_TOP], 1u);
      const unsigned tg = og / nx;
      if (og + 1u == (tg + 1u) * nx) xb_add(&bar[XB_TOPGEN], 1u);
      else XB_SPIN(xb_ld(&bar[XB_TOPGEN]) == tg, bar);
      __builtin_amdgcn_fence(__ATOMIC_ACQUIRE, "agent");
      xb_add(&bar[XB_XGEN(x)], 1u);
      asm volatile("s_waitcnt vmcnt(0)" ::: "memory");
    } else {
      XB_SPIN(xb_ld(&bar[XB_XGEN(x)]) == gen, bar);
      __builtin_amdgcn_fence(__ATOMIC_ACQUIRE, "agent");
      asm volatile("s_waitcnt vmcnt(0)" ::: "memory");
    }
  }
  __syncthreads();
}

namespace v2 {
typedef LAS unsigned char* ldsp_t;
constexpr int BM = 256, BK = 64, HALF = 128, HTB = HALF * BK * 2, STAGE_BYTES = 8 * HTB;
constexpr int NW = 8;
constexpr int LDS_XTRA = STAGE_BYTES;
constexpr int LDS_BARW = STAGE_BYTES + 16384;
constexpr int LDS_TOTAL = LDS_BARW + 16;

DEVI int lds_byte(int r, int c) { const int st = (r >> 4) * 2 + (c >> 5), rr = r & 15, cc = c & 31, ob = rr * 64 + cc * 2; return st * 1024 + (ob ^ (((ob >> 9) & 1) << 5)); }
DEVI void stage_rc(int b, int& R, int& C) { const int st = b / 1024, sb = b % 1024, swz = sb ^ (((sb >> 9) & 1) << 5); R = (st >> 1) * 16 + swz / 64; C = (st & 1) * 32 + (swz % 64) / 2; }
DEVI int perm32(int rho) { const int n = rho >> 4, i = rho & 15; return 8 * (i >> 2) + 4 * n + (i & 3); }

DEVI void acc_zero(f32x4 (&acc)[2][2][4][2]) {
#pragma unroll
  for (int a = 0; a < 2; ++a)
#pragma unroll
    for (int b = 0; b < 2; ++b)
#pragma unroll
      for (int m = 0; m < 4; ++m)
#pragma unroll
        for (int n = 0; n < 2; ++n) acc[a][b][m][n] = (f32x4){0.f, 0.f, 0.f, 0.f};
}
struct Unit { const char* A; const char* B; const int* rows; int nvalid; int u0, u1, u2, u3; };

typedef int i32x8 __attribute__((ext_vector_type(8)));
typedef int i32x4v __attribute__((ext_vector_type(4)));
DEVI i32x8 cat8(bf16x8 lo, bf16x8 hi) { return __builtin_shufflevector(__builtin_bit_cast(i32x4v, lo), __builtin_bit_cast(i32x4v, hi), 0, 1, 2, 3, 4, 5, 6, 7); }
DEVI const char* sptr(const char* p) {
  const unsigned long long v = (unsigned long long)p;
  const unsigned lo = (unsigned)__builtin_amdgcn_readfirstlane((int)(unsigned)v), hi = (unsigned)__builtin_amdgcn_readfirstlane((int)(unsigned)(v >> 32));
  return (const char*)(((unsigned long long)hi << 32) | lo);
}
template <bool PERM, bool GATHER, bool F8, class Epi, class Sched>
DEVI void gemm_phase(ldsp_t lds, int lda_b, int ldb_b, int nt, const Sched& S, const Epi& E) {
  const int tid = TIDX, wid = __builtin_amdgcn_readfirstlane(tid >> 6), lane = tid & 63, wr = wid >> 2, wc = wid & 3, fr = lane & 15, fq = lane >> 4;
  unsigned voffA[2], voffB[2]; int RA[2], CA2[2];
#pragma unroll
  for (int i = 0; i < 2; ++i) {
    int R, C; stage_rc(tid * 16 + i * 8192, R, C);
    const int Rb = PERM ? ((R & ~31) + perm32(R & 31)) : R;
    RA[i] = R; CA2[i] = C * 2;
    voffA[i] = (unsigned)(R * lda_b + C * 2); voffB[i] = (unsigned)(Rb * ldb_b + C * 2);
  }
  const size_t kstep = (size_t)(BK * 2);
  const size_t hstepA = (size_t)HALF * lda_b, hstepB = (size_t)HALF * ldb_b;
  const unsigned ldsw = (unsigned)wid * 1024u, ldsbase = (unsigned)(size_t)lds;
  const int aoff = lds_byte(wr * 64 + fr, fq * 8), boff = lds_byte(wc * 32 + fr, fq * 8);
#define G_SA(b, h) (((b) * 2 + (h)) * HTB)
#define G_SB(b, h) ((4 + (b) * 2 + (h)) * HTB)
#define G_DMA(sbase, voff, ldsaddr) asm volatile("s_mov_b32 m0, %2\n\ts_nop 0\n\tglobal_load_lds_dwordx4 %0, %1" :: "v"(voff), "s"(sbase), "s"(ldsaddr) : "memory", "m0")
#define G_STAGE(bufoff, gbase, voff) do { const char* sb_ = sptr((const char*)(gbase)); _Pragma("unroll") for (int _i = 0; _i < 2; ++_i) \
    G_DMA(sb_, (voff)[_i], (unsigned)__builtin_amdgcn_readfirstlane((int)(ldsbase + (unsigned)(bufoff) + ldsw + (unsigned)_i * 8192u))); } while (0)
#define G_STAGE_A(bufoff, abase, go, h, koff) do { if (GATHER) { const char* sb_ = sptr((const char*)(abase) + (koff)); _Pragma("unroll") for (int _i = 0; _i < 2; ++_i) \
    G_DMA(sb_, (go)[h][_i], (unsigned)__builtin_amdgcn_readfirstlane((int)(ldsbase + (unsigned)(bufoff) + ldsw + (unsigned)_i * 8192u))); } \
    else G_STAGE(bufoff, (abase) + (h) * hstepA + (koff), voffA); } while (0)
#define G_LDA(dst, b, h) do { _Pragma("unroll") for (int m = 0; m < 4; ++m) { if (F8) dst##8[m] = cat8(*(const LAS bf16x8*)(lds + G_SA(b, h) + aoff + m * 2048), *(const LAS bf16x8*)(lds + G_SA(b, h) + aoff + m * 2048 + 1024)); \
    else { _Pragma("unroll") for (int k = 0; k < 2; ++k) dst[m][k] = *(const LAS bf16x8*)(lds + G_SA(b, h) + aoff + m * 2048 + k * 1024); } } } while (0)
#define G_LDB(dst, b, h) do { _Pragma("unroll") for (int n = 0; n < 2; ++n) { if (F8) dst##8[n] = cat8(*(const LAS bf16x8*)(lds + G_SB(b, h) + boff + n * 2048), *(const LAS bf16x8*)(lds + G_SB(b, h) + boff + n * 2048 + 1024)); \
    else { _Pragma("unroll") for (int k = 0; k < 2; ++k) dst[n][k] = *(const LAS bf16x8*)(lds + G_SB(b, h) + boff + n * 2048 + k * 1024); } } } while (0)
#define G_MMA(ai, bj, At, Bt) do { __builtin_amdgcn_s_setprio(1); _Pragma("unroll") for (int m = 0; m < 4; ++m) _Pragma("unroll") for (int n = 0; n < 2; ++n) { \
    if (F8) asm("v_mfma_scale_f32_16x16x128_f8f6f4 %0, %1, %2, %0, %3, %4 op_sel_hi:[0,0,0]" : "+v"(acc[ai][bj][m][n]) : "v"(Bt##8[n]), "v"(At##8[m]), "v"(f8wscale), "v"(f8ascale)); \
    else { _Pragma("unroll") for (int k = 0; k < 2; ++k) acc[ai][bj][m][n] = __builtin_amdgcn_mfma_f32_16x16x32_bf16(Bt[n][k], At[m][k], acc[ai][bj][m][n], 0, 0, 0); } } \
    __builtin_amdgcn_s_setprio(0); } while (0)
#define G_WAIT_V(n) asm volatile("s_waitcnt vmcnt(" #n ")" ::: "memory")
#define G_WAIT_L(n) asm volatile("s_waitcnt lgkmcnt(" #n ")" ::: "memory")
#define G_BAR __builtin_amdgcn_s_barrier()
#define G_SCHED __builtin_amdgcn_sched_barrier(0)
  Unit cur, nxt; int ui = 0;
  if (!S.next(0, cur)) return;
  f32x4 acc[2][2][4][2];
  E.init(acc, cur, wr, wc, fr, fq);
  bf16x8 At[4][2], B0[2][2], B1[2][2];
  i32x8 At8[4], B08[2], B18[2];
  const int f8wscale = 0x79797979, f8ascale = 0x7f7f7f7f;
  unsigned gcur[2][2];
  auto gather_offs = [&](const Unit& u, unsigned (&go)[2][2]) {
#pragma unroll
    for (int h = 0; h < 2; ++h)
#pragma unroll
      for (int i = 0; i < 2; ++i) {
        const int r = h * HALF + RA[i];
        const int t = (r < u.nvalid) ? (u.rows[r] >> 1) : 0;
        go[h][i] = (unsigned)t * (unsigned)lda_b + (unsigned)CA2[i];
      }
  };
  if (GATHER) gather_offs(cur, gcur);
  const char* cA = cur.A; const char* cB = cur.B;
  G_STAGE(G_SB(0, 0), cB, voffB); G_STAGE_A(G_SA(0, 0), cA, gcur, 0, 0); G_STAGE(G_SB(0, 1), cB + hstepB, voffB); G_STAGE_A(G_SA(0, 1), cA, gcur, 1, 0);
  if (wr == 1) G_BAR;
  G_WAIT_V(4); G_BAR;
  G_STAGE(G_SB(1, 0), cB + kstep, voffB); G_STAGE_A(G_SA(1, 0), cA, gcur, 0, kstep); G_STAGE(G_SB(1, 1), cB + hstepB + kstep, voffB);
  G_WAIT_V(6); G_BAR;
  for (;;) {
    const bool has_next = S.next(ui + 1, nxt);
    const char* nA = has_next ? nxt.A : cA; const char* nB = has_next ? nxt.B : cB;
#pragma clang loop unroll(disable)
    for (int t = 0; t < nt; t += 2) {
      const bool last = (t == nt - 2);
      const size_t k1 = (size_t)(t + 1) * kstep;
      const char* a2 = last ? nA : cA; const char* b2 = last ? nB : cB + (size_t)(t + 2) * kstep;
      const size_t ka2 = last ? 0 : (size_t)(t + 2) * kstep;
      const char* b3 = b2 + kstep; const size_t ka3 = ka2 + kstep;
      unsigned gN[2][2];
      if (GATHER && last) {
        if (has_next) gather_offs(nxt, gN);
        else {
#pragma unroll
          for (int h = 0; h < 2; ++h)
#pragma unroll
            for (int i = 0; i < 2; ++i) gN[h][i] = gcur[h][i];
        }
      }
#define G_STAGE_A2(bufoff, h, koff) do { if (GATHER) { if (last) G_STAGE_A(bufoff, cA, gN, h, (koff) - ka2); else G_STAGE_A(bufoff, cA, gcur, h, koff); } \
        else G_STAGE_A(bufoff, a2, gcur, h, koff); } while (0)
      G_LDB(B0, 0, 0); G_SCHED; G_LDA(At, 0, 0); G_STAGE_A(G_SA(1, 1), cA, gcur, 1, k1);
      G_WAIT_L(8); G_BAR; G_WAIT_L(0); G_MMA(0, 0, At, B0); G_BAR; G_SCHED;
      G_LDB(B1, 0, 1); G_STAGE(G_SB(0, 0), b2, voffB);
      G_BAR; G_WAIT_L(0); G_MMA(0, 1, At, B1); G_BAR;
      G_LDA(At, 0, 1); G_STAGE_A2(G_SA(0, 0), 0, ka2);
      G_BAR; G_WAIT_L(0); G_MMA(1, 0, At, B0); G_BAR; G_SCHED;
      G_STAGE(G_SB(0, 1), b2 + hstepB, voffB);
      G_WAIT_V(6); G_BAR; G_MMA(1, 1, At, B1); G_BAR;
      G_LDB(B0, 1, 0); G_SCHED; G_LDA(At, 1, 0); G_STAGE_A2(G_SA(0, 1), 1, ka2);
      G_WAIT_L(8); G_BAR; G_WAIT_L(0); G_MMA(0, 0, At, B0); G_BAR; G_SCHED;
      G_LDB(B1, 1, 1); G_STAGE(G_SB(1, 0), b3, voffB);
      G_BAR; G_WAIT_L(0); G_MMA(0, 1, At, B1); G_BAR;
      G_LDA(At, 1, 1); G_STAGE_A2(G_SA(1, 0), 0, ka3);
      G_BAR; G_WAIT_L(0); G_MMA(1, 0, At, B0); G_BAR; G_SCHED;
      G_STAGE(G_SB(1, 1), b3 + hstepB, voffB);
      G_WAIT_V(6); G_BAR; G_MMA(1, 1, At, B1); G_BAR;
      if (GATHER && last) {
#pragma unroll
        for (int h = 0; h < 2; ++h)
#pragma unroll
          for (int i = 0; i < 2; ++i) gcur[h][i] = gN[h][i];
      }
#undef G_STAGE_A2
    }
    G_SCHED;
    if (F8) {
      asm volatile("s_nop 15\n\ts_nop 15" ::: "memory");
#pragma unroll
      for (int a_ = 0; a_ < 2; ++a_)
#pragma unroll
        for (int b_ = 0; b_ < 2; ++b_)
#pragma unroll
          for (int m_ = 0; m_ < 4; ++m_)
#pragma unroll
            for (int n_ = 0; n_ < 2; ++n_) asm volatile("" : "+v"(acc[a_][b_][m_][n_]));
    }
    E(acc, cur, wr, wc, fr, fq);
    G_SCHED;
    if (!has_next) break;
    cur = nxt; cA = nA; cB = nB; ++ui;
    E.init(acc, cur, wr, wc, fr, fq);
  }
  G_WAIT_V(0);
  if (wr == 0) G_BAR;
  G_BAR;
#undef G_SA
#undef G_SB
#undef G_STAGE
#undef G_DMA
#undef G_STAGE_A
#undef G_LDA
#undef G_LDB
#undef G_MMA
#undef G_WAIT_V
#undef G_WAIT_L
#undef G_BAR
#undef G_SCHED
}

DEVI unsigned uoff(unsigned x) { return (unsigned)__builtin_amdgcn_readfirstlane((int)x); }
DEVI bool tile_order(int i, int G, int c, int nM, int nN, int& pm, int& pn) {
  const int nwg = nM * nN;
  const long L = (long)i * G + c; if (L >= nwg) return false;
  int wgid = (int)L; { const int q = nwg / 8, r = nwg % 8, xcd = wgid % 8, off = wgid / 8; wgid = (xcd < r ? xcd * (q + 1) : r * (q + 1) + (xcd - r) * q) + off; }
  const int WGM = 8;
  const int nig = WGM * nN, gid = wgid / nig, fm = gid * WGM, gsz = (nM - fm) < WGM ? (nM - fm) : WGM;
  pm = fm + ((wgid % nig) % gsz); pn = (wgid % nig) / gsz;
  pm = __builtin_amdgcn_readfirstlane(pm); pn = __builtin_amdgcn_readfirstlane(pn);
  return true;
}
struct EpiRawBf16 {
  u16* O; int ldc; float sc;
  DEVI void init(f32x4 (&acc)[2][2][4][2], const Unit&, int, int, int, int) const { acc_zero(acc); }
  DEVI void operator()(const f32x4 (&acc)[2][2][4][2], const Unit& u, int wr, int wc, int fr, int fq) const {
    const unsigned off0 = ((unsigned)(u.u0 + wr * 64 + fr) * (unsigned)ldc + (unsigned)(u.u1 + wc * 32 + 8 * fq)) * 2u;
#pragma unroll
    for (int ai = 0; ai < 2; ++ai)
#pragma unroll
      for (int m = 0; m < 4; ++m) {
        char* rowp = (char*)O + (off0 + (unsigned)(ai * HALF + m * 16) * (unsigned)ldc * 2u);
#pragma unroll
        for (int bj = 0; bj < 2; ++bj) {
          const f32x4 v0 = acc[ai][bj][m][0], v1 = acc[ai][bj][m][1];
          u32x4 w; w.x = pk2(v0[0], v0[1]); w.y = pk2(v0[2], v0[3]); w.z = pk2(v1[0], v1[1]); w.w = pk2(v1[2], v1[3]);
          *(u32x4*)(rowp + bj * HALF * 2) = w;
        }
      }
  }
};

struct EpiRawF8 {
  unsigned char* O; int ldc; float sc;
  DEVI void init(f32x4 (&acc)[2][2][4][2], const Unit&, int, int, int, int) const { acc_zero(acc); }
  DEVI void operator()(const f32x4 (&acc)[2][2][4][2], const Unit& u, int wr, int wc, int fr, int fq) const {
    const unsigned off0 = (unsigned)(u.u0 + wr * 64 + fr) * (unsigned)ldc + (unsigned)(u.u1 + wc * 32 + 8 * fq);
#pragma unroll
    for (int ai = 0; ai < 2; ++ai)
#pragma unroll
      for (int m = 0; m < 4; ++m) {
        unsigned char* rowp = O + (off0 + (unsigned)(ai * HALF + m * 16) * (unsigned)ldc);
#pragma unroll
        for (int bj = 0; bj < 2; ++bj) {
          u32x2 w;
#pragma unroll
          for (int n = 0; n < 2; ++n) {
            const f32x4 v = acc[ai][bj][m][n] * sc;
            int q = __builtin_amdgcn_cvt_pk_fp8_f32(__builtin_amdgcn_fmed3f(v[0], -448.f, 448.f), __builtin_amdgcn_fmed3f(v[1], -448.f, 448.f), 0, false);
            q = __builtin_amdgcn_cvt_pk_fp8_f32(__builtin_amdgcn_fmed3f(v[2], -448.f, 448.f), __builtin_amdgcn_fmed3f(v[3], -448.f, 448.f), q, true);
            w[n] = (unsigned)q;
          }
          *(u32x2*)(rowp + bj * HALF) = w;
        }
      }
  }
};
DEVI size_t z8_block(int pm, int branch, int cb) { return (size_t)((pm * 4 + branch) * 8 + cb) * 32768; }
struct EpiZ8 {
  unsigned char* O;
  DEVI void init(f32x4 (&acc)[2][2][4][2], const Unit&, int, int, int, int) const { acc_zero(acc); }
  DEVI void operator()(const f32x4 (&acc)[2][2][4][2], const Unit& u, int wr, int wc, int fr, int fq) const {
    const int pm = u.u0 >> 8, pn = u.u1 >> 8, n = pn >> 2, cq = pn & 3;
    const unsigned lw16 = (unsigned)((wr * 4 + wc) * 64 + fr + 16 * fq) * 16u;
#pragma unroll
    for (int bj = 0; bj < 2; ++bj) {
      unsigned char* blk = O + z8_block(pm, n, cq * 2 + bj) + lw16;
#pragma unroll
      for (int P = 0; P < 4; ++P) {
        u32x4 w;
#pragma unroll
        for (int h = 0; h < 2; ++h)
#pragma unroll
          for (int nn = 0; nn < 2; ++nn) {
            const int g = 2 * P + h;
            const f32x4 v = acc[g >> 2][bj][g & 3][nn];
            int q = __builtin_amdgcn_cvt_pk_fp8_f32(__builtin_amdgcn_fmed3f(v[0], -448.f, 448.f), __builtin_amdgcn_fmed3f(v[1], -448.f, 448.f), 0, false);
            q = __builtin_amdgcn_cvt_pk_fp8_f32(__builtin_amdgcn_fmed3f(v[2], -448.f, 448.f), __builtin_amdgcn_fmed3f(v[3], -448.f, 448.f), q, true);
            w[2 * h + nn] = (unsigned)q;
          }
        *(u32x4*)(blk + P * 8192) = w;
      }
    }
  }
};
struct SchedB { const char* ws; const char* h8; int G, c;
  DEVI bool next(int i, Unit& u) const { int pm, pn; if (!tile_order(i, G, c, NTOK / 256, INP / 256, pm, pn)) return false;
    u.A = h8 + uoff((unsigned)pm * 256u * 1024u); u.B = ws + OFF_WIN + uoff((unsigned)pn * 256u * 1024u);        u.rows = nullptr; u.nvalid = 0; u.u0 = pm * 256; u.u1 = pn * 256; u.u2 = 0; u.u3 = 0; return true; } };
struct EpiB { u16* O; float* ssq;
  DEVI void init(f32x4 (&acc)[2][2][4][2], const Unit&, int, int, int, int) const { acc_zero(acc); }
  DEVI void operator()(const f32x4 (&acc)[2][2][4][2], const Unit& u, int wr, int wc, int fr, int fq) const {
    EpiRawBf16 E{O, PLD, 1.f}; E(acc, u, wr, wc, fr, fq);
    if (u.u1 < 512) {
      const bool iskv = u.u1 != 0;
#pragma unroll
      for (int ai = 0; ai < 2; ++ai)
#pragma unroll
        for (int m = 0; m < 4; ++m) {
          float ss = 0.f;
#pragma unroll
          for (int bj = 0; bj < 2; ++bj)
#pragma unroll
            for (int n = 0; n < 2; ++n)
#pragma unroll
              for (int j = 0; j < 4; ++j) { const float v = acc[ai][bj][m][n][j]; if (!(iskv && bj == 1)) ss += v * v; }
          ss += __shfl_xor(ss, 16); ss += __shfl_xor(ss, 32);
          if (fq == 0) ssq[(size_t)(u.u0 + ai * HALF + wr * 64 + m * 16 + fr) * 8 + (iskv ? 4 : 0) + wc] = ss;
        }
    }
  }
};
DEVI void phaseB2(KP p, ldsp_t lds) {
  SchedB S{(const char*)p->ws, (const char*)h8base(p), (int)gridDim.x, BIDX};
  EpiB E{wsp<u16>(p, OFF_PRAW), wsp<float>(p, OFF_SSQ)};
  gemm_phase<true, false, true>(lds, 1024, 1024, 8, S, E);
}
struct SchedC { const char* ws; int G, c;
  DEVI bool next(int i, Unit& u) const { int pm, pn; if (!tile_order(i, G, c, NTOK / 256, 4, pm, pn)) return false;
    const bool kv = pn >= 2; const int pj = pn & 1;
    u.A = ws + OFF_PRAW + uoff((unsigned)pm * 256u * (unsigned)(PLD * 2) + (kv ? 512u : 0u)); u.B = ws + (kv ? OFF_WKVB : OFF_WQB) + uoff((unsigned)pj * 256u * 512u); u.rows = nullptr; u.nvalid = 0;
    u.u0 = pm * 256; u.u1 = pj * 256; u.u2 = kv; u.u3 = 0; return true; } };
struct EpiC { u16* Oq; u16* Okv; const float* ssq;
  DEVI void init(f32x4 (&acc)[2][2][4][2], const Unit&, int, int, int, int) const { acc_zero(acc); }
  DEVI void operator()(const f32x4 (&acc)[2][2][4][2], const Unit& u, int wr, int wc, int fr, int fq) const {
    const bool kv = u.u2 != 0;
    u16* O = kv ? Okv : Oq;
    const int row0 = u.u0 + wr * 64 + fr, col0 = u.u1 + wc * 32 + 8 * fq;
    f32x4 sq[2][4];
#pragma unroll
    for (int ai = 0; ai < 2; ++ai)
#pragma unroll
      for (int m = 0; m < 4; ++m) sq[ai][m] = *(const f32x4*)(ssq + (size_t)(row0 + ai * HALF + m * 16) * 8 + (kv ? 4 : 0));
#pragma unroll
    for (int ai = 0; ai < 2; ++ai)
#pragma unroll
      for (int m = 0; m < 4; ++m) {
        const size_t r = (size_t)(row0 + ai * HALF + m * 16);
        const float tot = sq[ai][m].x + sq[ai][m].y + sq[ai][m].z + sq[ai][m].w;
        const float sc = kv ? rsqrtf(tot * (1.f / 128.f) + EPS) : rsqrtf(tot * (1.f / 256.f) + EPS) * (0.10206207261596575f * LOG2E);
        u16* rowp = O + r * 512 + col0;
#pragma unroll
        for (int bj = 0; bj < 2; ++bj) {
          const f32x4 v0 = acc[ai][bj][m][0] * sc, v1 = acc[ai][bj][m][1] * sc;
          u32x4 w; w.x = pk2(v0[0], v0[1]); w.y = pk2(v0[2], v0[3]); w.z = pk2(v1[0], v1[1]); w.w = pk2(v1[2], v1[3]);
          *(u32x4*)(rowp + bj * HALF) = w;
        }
      }
  }
};
DEVI void phaseC2(KP p, ldsp_t lds) {
  SchedC S{(const char*)p->ws, (int)gridDim.x, BIDX};
  EpiC E{wsp<u16>(p, OFF_QARAW), wsp<u16>(p, OFF_KVARAW), wsp<float>(p, OFF_SSQ)};
  int nt = 4; asm volatile("" : "+s"(nt));
  gemm_phase<true, false, false>(lds, PLD * 2, 512, nt, S, E);
}

DEVI void ld16(const u16* src, float (&v)[16]) {
  const u32x4 a = *(const u32x4*)src, b = *(const u32x4*)(src + 8);
  const unsigned w[8] = {a.x, a.y, a.z, a.w, b.x, b.y, b.z, b.w};
#pragma unroll
  for (int i = 0; i < 8; ++i) { v[2 * i] = __uint_as_float(w[i] << 16); v[2 * i + 1] = __uint_as_float(w[i] & 0xffff0000u); }
}
DEVI void st16(u16* dst, const float (&v)[16]) {
  u32x4 a, b;
  a.x = pk2(v[0], v[1]); a.y = pk2(v[2], v[3]); a.z = pk2(v[4], v[5]); a.w = pk2(v[6], v[7]);
  b.x = pk2(v[8], v[9]); b.y = pk2(v[10], v[11]); b.z = pk2(v[12], v[13]); b.w = pk2(v[14], v[15]);
  *(u32x4*)dst = a; *(u32x4*)(dst + 8) = b;
}
DEVI void rope16c(float (&v)[16], const float* cs16, int pos) {
  const f32x2* t = (const f32x2*)(cs16 + pos * 16);
#pragma unroll
  for (int i = 0; i < 8; ++i) { const f32x2 cs = t[i]; const float x1 = v[i], x2 = v[8 + i]; v[i] = x1 * cs.x - x2 * cs.y; v[8 + i] = x2 * cs.x + x1 * cs.y; }
}
DEVI void rope32c(float (&lo)[16], float (&hi)[16], const float* cs32, int pos) {
  const f32x2* t = (const f32x2*)(cs32 + pos * 32);
#pragma unroll
  for (int i = 0; i < 16; ++i) { const f32x2 cs = t[i]; const float x1 = lo[i], x2 = hi[i]; lo[i] = x1 * cs.x - x2 * cs.y; hi[i] = x2 * cs.x + x1 * cs.y; }
}
DEVI float ssq16(const float (&v)[16]) { float s = 0.f;
#pragma unroll
  for (int i = 0; i < 16; ++i) s += v[i] * v[i];
  return s; }
DEVI void scale16(float (&v)[16], float s) {
#pragma unroll
  for (int i = 0; i < 16; ++i) v[i] *= s; }
DEVI void cvt16(const u32x4 a, const u32x4 b, float (&v)[16]) {
  const unsigned w[8] = {a.x, a.y, a.z, a.w, b.x, b.y, b.z, b.w};
#pragma unroll
  for (int i = 0; i < 8; ++i) { v[2 * i] = __uint_as_float(w[i] << 16); v[2 * i + 1] = __uint_as_float(w[i] & 0xffff0000u); }
}
DEVI void phaseP2(KP p, int l, ldsp_t lds) {
  const int tid = TIDX, tk = tid >> 3, pt = tid & 7;
  u16* PR = wsp<u16>(p, OFF_PRAW);
  u16* QA = wsp<u16>(p, OFF_QARAW);
  const float* cs32 = wsp<float>(p, OFF_CS32);
  const float* cs16 = wsp<float>(p, OFF_CS16);
  const float QS = 0.125f * LOG2E;
  for (int item = BIDX; item < NTOK / 64; item += gridDim.x) {
    const int tok0 = item * 64, rr0 = tok0 % TPB;
    const bool lat = rr0 >= NCTX;
    const size_t tok = (size_t)tok0 + tk;
    const int t = rr0 + tk - NCTX, grow = (t >> 6) & 63, gcol = t & 63;
    u16* pr = PR + tok * PLD;
    u16* qar = QA + tok * 512 + 96 * (pt >> 1) + 64 + 16 * (pt & 1);
    const int g4 = pt & 3;
    u32x4 r_qa[2], r_kr[2], r_qb[4], r_kb[4], r_qd[4], r_kd[4];
#define LD8(ptr) (*(const u32x4*)(ptr))
    if (lat) {
#pragma unroll
      for (int i = 0; i < 2; ++i) { r_qa[i] = LD8(qar + 8 * i); r_kr[i] = LD8(pr + 384 + 16 * (pt & 1) + 8 * i); }
#pragma unroll
      for (int i = 0; i < 4; ++i) { r_qb[i] = LD8(pr + 512 + 32 * pt + 8 * i); r_kb[i] = LD8(pr + 768 + 32 * g4 + 8 * i); }
    }
#pragma unroll
    for (int i = 0; i < 4; ++i) { r_qd[i] = LD8(pr + 1792 + 32 * pt + 8 * i); r_kd[i] = LD8(pr + 2048 + 32 * g4 + 8 * i); }
#undef LD8
    if (lat) {
      { float v[16]; cvt16(r_qa[0], r_qa[1], v); rope16c(v, cs16, (pt & 1) ? gcol : grow); st16(qar, v); }
      if (pt < 2) { float v[16]; cvt16(r_kr[0], r_kr[1], v); rope16c(v, cs16, pt == 0 ? grow : gcol); st16(pr + 384 + 16 * pt, v); }
      { float lo[16], hi[16]; cvt16(r_qb[0], r_qb[1], lo); cvt16(r_qb[2], r_qb[3], hi); rope32c(lo, hi, cs32, (pt & 1) ? gcol : grow); st16(pr + 512 + 32 * pt, lo); st16(pr + 512 + 32 * pt + 16, hi); }
      if (pt < 4) { float lo[16], hi[16]; cvt16(r_kb[0], r_kb[1], lo); cvt16(r_kb[2], r_kb[3], hi); rope32c(lo, hi, cs32, (pt & 1) ? gcol : grow); st16(pr + 768 + 32 * pt, lo); st16(pr + 768 + 32 * pt + 16, hi); }
    }
    {
      float lo[16], hi[16]; cvt16(r_qd[0], r_qd[1], lo); cvt16(r_qd[2], r_qd[3], hi);
      float ss = ssq16(lo) + ssq16(hi); ss += __shfl_xor(ss, 1);
      const float rs = rsqrtf(ss * (1.f / 64.f) + EPS);
      const float* g = p->g_q_d + l * 64 + 32 * (pt & 1);
#pragma unroll
      for (int i = 0; i < 16; ++i) { lo[i] *= rs * g[i]; hi[i] *= rs * g[16 + i]; }
      if (lat) rope32c(lo, hi, cs32, (pt & 1) ? gcol : grow);
      scale16(lo, QS); scale16(hi, QS);
      st16(pr + 1792 + 32 * pt, lo); st16(pr + 1792 + 32 * pt + 16, hi);
    }
    {
      float lo[16], hi[16]; cvt16(r_kd[0], r_kd[1], lo); cvt16(r_kd[2], r_kd[3], hi);
      float ss = ssq16(lo) + ssq16(hi); ss += __shfl_xor(ss, 1);
      const float rs = rsqrtf(ss * (1.f / 64.f) + EPS);
      const float* g = p->g_k_d + l * 64 + 32 * (g4 & 1);
#pragma unroll
      for (int i = 0; i < 16; ++i) { lo[i] *= rs * g[i]; hi[i] *= rs * g[16 + i]; }
      if (lat) rope32c(lo, hi, cs32, (g4 & 1) ? gcol : grow);
      if (pt < 4) { st16(pr + 2048 + 32 * g4, lo); st16(pr + 2048 + 32 * g4 + 16, hi); }
    }
  }
}

DEVI void conv_load(const ConvT& c, int lane, f32x4 (&v)[8]) {
  const int kk = lane >> 3, n4 = (lane & 7) * 4;
  const float* sp = (c.src2 && n4 >= 16) ? c.src2 + (n4 - 16) : (c.src ? c.src + n4 : nullptr);
#pragma unroll
  for (int i = 0; i < 8; ++i) v[i] = sp ? __builtin_nontemporal_load((const f32x4*)(sp + (size_t)(kk + 8 * i) * c.ld)) : f32x4{0.f, 0.f, 0.f, 0.f};
}
DEVI void conv_store(const ConvT& c, LAS float* t, int lane, const f32x4 (&v)[8]) {
  const int kk = lane >> 3, n4 = (lane & 7) * 4;
#pragma unroll
  for (int i = 0; i < 8; ++i) {
    const int k = kk + 8 * i;
    const float s = (c.ks ? c.ks[k] : 1.f) * c.mul;
    t[(n4 + 0) * 65 + k] = v[i].x * s; t[(n4 + 1) * 65 + k] = v[i].y * s;
    t[(n4 + 2) * 65 + k] = v[i].z * s; t[(n4 + 3) * 65 + k] = v[i].w * s;
  }
  asm volatile("s_waitcnt lgkmcnt(0)" ::: "memory");
  const int n = lane >> 1, k0 = (lane & 1) * 32;
  const LAS float* r = t + n * 65 + k0;
  if (c.ldd < 0) {
    unsigned char* d8 = (unsigned char*)c.dst + (size_t)n * (size_t)(-c.ldd) + k0;
#pragma unroll
    for (int q = 0; q < 2; ++q) {
      u32x4 o;
#pragma unroll
      for (int w = 0; w < 4; ++w) {
        float f[4];
#pragma unroll
        for (int j = 0; j < 4; ++j) f[j] = __builtin_amdgcn_fmed3f(r[16 * q + 4 * w + j], -448.f, 448.f);
        int v = __builtin_amdgcn_cvt_pk_fp8_f32(f[0], f[1], 0, false);
        v = __builtin_amdgcn_cvt_pk_fp8_f32(f[2], f[3], v, true);
        o[w] = (unsigned)v;
      }
      *(u32x4*)(d8 + 16 * q) = o;
    }
    asm volatile("s_waitcnt lgkmcnt(0)" ::: "memory");
    return;
  }
  u16* d = c.dst + (size_t)n * c.ldd + k0;
#pragma unroll
  for (int q = 0; q < 4; ++q) {
    u32x4 o;
    o.x = pk2(r[8 * q], r[8 * q + 1]); o.y = pk2(r[8 * q + 2], r[8 * q + 3]); o.z = pk2(r[8 * q + 4], r[8 * q + 5]); o.w = pk2(r[8 * q + 6], r[8 * q + 7]);
    *(u32x4*)(d + 8 * q) = o;
  }
  asm volatile("s_waitcnt lgkmcnt(0)" ::: "memory");
}
constexpr int CONV_EARLY = 1152 + 64 + 64;
DEVI void conv_items2(KP p, int l, ldsp_t lds, int first_item, int total_items) {
  const int tid = TIDX, wave = __builtin_amdgcn_readfirstlane(tid >> 6), lane = tid & 63;
  LAS float* t = (LAS float*)(lds + wave * 8448);
  __syncthreads();
  const int stride = gridDim.x * NW;
  int item = first_item + BIDX * NW + wave;
  if (item >= total_items) return;
  ConvT c = conv_decode(p, l, item);
  f32x4 v[8];
  conv_load(c, lane, v);
  for (;;) {
    const int nitem = item + stride;
    const bool more = nitem < total_items;
    ConvT cn = c; f32x4 vn[8];
    if (more) { cn = conv_decode(p, l, nitem); conv_load(cn, lane, vn); }
    conv_store(c, t, lane, v);
    if (!more) break;
    c = cn; item = nitem;
#pragma unroll
    for (int i = 0; i < 8; ++i) v[i] = vn[i];
  }
}
template <int BR>
DEVI void attn_mask(f32x16 (&s)[2], int kt, int qlat, int qrow, int qcol, int hh, LAS float* rpb) {
  if (BR == 1) {
#pragma unroll
    for (int kb = 0; kb < 2; ++kb)
#pragma unroll
      for (int i = 0; i < 16; ++i) {
        const int kpos = kt * 64 + kb * 32 + (i & 3) + 8 * (i >> 2) + 4 * hh;
        const int d = qlat - kpos;
        if (d > 128 || d < -128) s[kb][i] = -1e30f;
      }
  } else {
    const int rs = min(max(qrow - 4, 0), 56);
    const bool row_ok = (kt >= rs) && (kt < rs + 8);
    const int cst = min(max(qcol - 8, 0), 48);
    const int dr = kt - qrow + 7;
#pragma unroll
    for (int kb = 0; kb < 2; ++kb)
#pragma unroll
      for (int i = 0; i < 16; ++i) {
        const int kc = kb * 32 + (i & 3) + 8 * (i >> 2) + 4 * hh;
        const bool ok = row_ok && (kc >= cst) && (kc < cst + 16);
        const int idx = ok ? (dr * 31 + (kc - qcol + 15)) : 0;
        const float bias = rpb[idx];
        s[kb][i] = ok ? (s[kb][i] + bias) : -1e30f;
      }
  }
}

template <int BR>
DEVI void attn_mask1(f32x16& sb, int kb, int kt, int qlat, int qrow, int qcol, int hh, LAS float* rpb) {
  if (BR == 1) {
#pragma unroll
    for (int i = 0; i < 16; ++i) {
      const int kpos = kt * 64 + kb * 32 + (i & 3) + 8 * (i >> 2) + 4 * hh;
      const int d = qlat - kpos;
      if (d > 128 || d < -128) sb[i] = -1e30f;
    }
  } else {
    const int rs = min(max(qrow - 4, 0), 56);
    const bool row_ok = (kt >= rs) && (kt < rs + 8);
    const int cst = min(max(qcol - 8, 0), 48);
    const int dr = kt - qrow + 7;
#pragma unroll
    for (int i = 0; i < 16; ++i) {
      const int kc = kb * 32 + (i & 3) + 8 * (i >> 2) + 4 * hh;
      const bool ok = row_ok && (kc >= cst) && (kc < cst + 16);
      const int idx = ok ? (dr * 31 + (kc - qcol + 15)) : 0;
      const float bias = rpb[idx];
      sb[i] = ok ? (sb[i] + bias) : -1e30f;
    }
  }
}
#define FADD(a, b) do { (a) += (b); asm("" : "+v"(a)); } while (0)
typedef short v4i16_t __attribute__((ext_vector_type(4)));
DEVI bf16x8 vtr2(ldsp_t a) {
  const v4i16_t lo = __builtin_amdgcn_ds_read_tr16_b64_v4i16((LAS v4i16_t*)a);
  const v4i16_t hi = __builtin_amdgcn_ds_read_tr16_b64_v4i16((LAS v4i16_t*)(a + 8 * 144));
  return __builtin_shufflevector(lo, hi, 0, 1, 2, 3, 4, 5, 6, 7);
}
DEVI bf16x8 vtr2s(ldsp_t a, int o0, int o1) {
  const v4i16_t lo = __builtin_amdgcn_ds_read_tr16_b64_v4i16((LAS v4i16_t*)(a + o0));
  const v4i16_t hi = __builtin_amdgcn_ds_read_tr16_b64_v4i16((LAS v4i16_t*)(a + 8 * 128 + o1));
  return __builtin_shufflevector(lo, hi, 0, 1, 2, 3, 4, 5, 6, 7);
}
template <int BR, bool FAST>
DEVI bool attn_item2(KP p, int l, int b, int hs, int qb, bool isctx, ldsp_t lds) {
  constexpr bool MLA = (BR == 0);
  constexpr bool GQA = (BR == 1 || BR == 3);
  constexpr int QBLK = GQA ? 256 : 512;
  constexpr int NKS = MLA ? 6 : 4;
  constexpr int STG = 8192 + 8192 + 4096;
  const int tid = TIDX, lane = tid & 63, wave = __builtin_amdgcn_readfirstlane(tid >> 6);
  const int r32 = lane & 31, hh = lane >> 5;
  const int hq = GQA ? (hs * 2 + (wave & 1)) : hs;
  const int woff = GQA ? 64 * (wave >> 1) : 64 * wave;
  const int q0 = (isctx ? 0 : NCTX) + qb * QBLK;
  const bool active = !isctx || (woff < NCTX);
  const size_t tokq = (size_t)b * TPB + q0 + (active ? woff : 0) + r32;
  const u16* Qp; const u16* Kp; int ldk; const u16* Vp; int ldv; int obase; int ldq;
  const u16* PR = wsp<u16>(p, OFF_PRAW);
  if (BR == 0) { Qp = wsp<u16>(p, OFF_QARAW) + tokq * 512 + hq * 96; ldq = 512; Kp = wsp<u16>(p, OFF_KVARAW) + (size_t)b * TPB * 512 + hs * 128; ldk = 512; Vp = wsp<u16>(p, OFF_KVARAW) + (size_t)b * TPB * 512 + hs * 128 + 64; ldv = 512; obase = hq * 64; }
  else if (BR == 1) { Qp = PR + tokq * PLD + 512 + hq * 64; ldq = PLD; Kp = PR + (size_t)b * TPB * PLD + 768 + hs * 64; ldk = PLD; Vp = PR + (size_t)b * TPB * PLD + 896 + hs * 64; ldv = PLD; obase = 256 + hq * 64; }
  else if (BR == 2) { Qp = PR + tokq * PLD + 1024 + hq * 64; ldq = PLD; Kp = PR + (size_t)b * TPB * PLD + 1280 + hs * 64; ldk = PLD; Vp = PR + (size_t)b * TPB * PLD + 1536 + hs * 64; ldv = PLD; obase = 512 + hq * 64; }
  else { Qp = PR + tokq * PLD + 1792 + hq * 64; ldq = PLD; Kp = PR + (size_t)b * TPB * PLD + 2048 + hs * 64; ldk = PLD; Vp = PR + (size_t)b * TPB * PLD + 2176 + hs * 64; ldv = PLD; obase = 768 + hq * 64; }
  const u16* KRp = PR + (size_t)b * TPB * PLD + 384;
  int lat_lo = 0, lat_n = 0, wlo = 0, whi = 63;
  if (!isctx) {
    if (BR == 0 || BR == 3) { lat_lo = 0; lat_n = 64; }
    else if (BR == 1) {
      const int ql = qb * QBLK; const int lo = max(0, ql - 128) >> 6, hi = min(SEQ - 1, ql + QBLK - 1 + 128) >> 6; lat_lo = lo; lat_n = hi - lo + 1;
      const int wq = ql + woff; wlo = max(0, wq - 128) >> 6; whi = min(SEQ - 1, wq + 63 + 128) >> 6;
    } else {
      const int r0 = 8 * qb; const int lo = min(max(r0 - 4, 0), 56), hi = min(max(r0 + 7 - 4, 0), 56) + 7; lat_lo = lo; lat_n = hi - lo + 1;
      const int wr_ = r0 + wave; wlo = min(max(wr_ - 4, 0), 56); whi = wlo + 7;
    }
  }
  const int NT = 4 + lat_n;
  const int qlat0 = qb * QBLK + woff + r32;
  bf16x8 qf[2][NKS];
#pragma unroll
  for (int qi = 0; qi < 2; ++qi)
#pragma unroll
    for (int ks = 0; ks < NKS; ++ks) qf[qi][ks] = *(const bf16x8*)(Qp + (size_t)qi * 32 * ldq + ks * 16 + hh * 8);
  const int drow = 8 * wave + (lane >> 3), dch = (lane & 7) ^ ((drow >> 1) & 7);
  const int rrow = 16 * (wave & 3) + (lane >> 2), rch = (lane & 3) ^ ((rrow >> 2) & 3);
  auto keytile = [&](int j) { return (j < 4) ? j : (4 + lat_lo + (j - 4)); };
#define DMA16(sbase, voff, ldsaddr) asm volatile("s_mov_b32 m0, %2\n\ts_nop 0\n\tglobal_load_lds_dwordx4 %0, %1" :: "v"(voff), "s"(sbase), "s"(ldsaddr) : "memory", "m0")
#define A_DMA(j, st) do { const int key0_ = keytile(j) * 64; const unsigned base_ = __builtin_amdgcn_readfirstlane((unsigned)(size_t)(lds + (st) * STG) + wave * 1024); \
    DMA16(Kp, (unsigned)(((key0_ + drow) * ldk + dch * 8) * 2), base_); \
    DMA16(Vp, (unsigned)(((key0_ + drow) * ldv + dch * 8) * 2), base_ + 8192u); \
    if (MLA && wave < 4) DMA16(KRp, (unsigned)(((key0_ + rrow) * PLD + rch * 8) * 2), __builtin_amdgcn_readfirstlane(base_ + 16384u)); \
  } while (0)
  LAS float* rpb = (LAS float*)(lds + 2 * STG);
  __syncthreads();
  if (FAST && tid == 0) *(LAS int*)(lds + 2 * STG + 2048) = 0;
  A_DMA(0, 0);
  if (BR == 2 && !isctx) {
    const float* src = p->rpb_c + (size_t)(l * 4 + hs) * 465;
    for (int i = tid; i < 465; i += 512) rpb[i] = src[i] * LOG2E;
  }
  asm volatile("s_waitcnt vmcnt(0)" ::: "memory");
#pragma unroll
  for (int qi = 0; qi < 2; ++qi)
#pragma unroll
    for (int ks = 0; ks < NKS; ++ks) asm volatile("" : "+v"(qf[qi][ks]));
  __syncthreads();
  f32x16 o[2][2];
#pragma unroll
  for (int qi = 0; qi < 2; ++qi)
#pragma unroll
    for (int i = 0; i < 16; ++i) { o[qi][0][i] = 0.f; o[qi][1][i] = 0.f; }
  float m_run[2], l_run[2];
#pragma unroll
  for (int qi = 0; qi < 2; ++qi) { m_run[qi] = -INFINITY; l_run[qi] = 0.f; }
  if (BR == 1) { const float sk = p->sink_b[l * 4 + hq] * LOG2E; m_run[0] = sk; m_run[1] = sk; l_run[0] = (hh == 0) ? (FAST ? __builtin_amdgcn_exp2f(sk) : 1.f) : 0.f; l_run[1] = l_run[0]; }
  float l2[2][2];
#pragma unroll
  for (int qi = 0; qi < 2; ++qi) { l2[qi][0] = l_run[qi]; l2[qi][1] = 0.f; }
  const int kkey = (r32 >> 1) & 7, rkey = (r32 >> 2) & 3;
  const ldsp_t kfb = lds + r32 * 128;
  const ldsp_t krb = lds + 16384 + r32 * 64;
  const int vq = (lane & 15) >> 2, vkey = 2 * hh + (vq >> 1);
  const int vch = 2 * ((lane >> 4) & 1) + ((lane & 3) >> 1);
  const ldsp_t vfb = lds + 8192 + (4 * hh + vq) * 128 + 8 * (lane & 1);
#define SB() __builtin_amdgcn_sched_barrier(0)
#define KLOAD(kb, ks) (((ks) < 4) ? *(const LAS bf16x8*)(kfb + st + (kb) * 4096 + (((2 * (ks) + hh) ^ kkey) << 4)) : *(const LAS bf16x8*)(krb + st + (kb) * 2048 + (((2 * ((ks) - 4) + hh) ^ rkey) << 4)))
#define VLOAD(s4, db) vtr2s(vfb + st + (s4) * 2048, ((4 * (db) + vch) ^ vkey) << 4, ((4 * (db) + vch) ^ vkey ^ 4) << 4)
#define SM_EL(kb, e) do { const int qi_ = (e) >> 4, i_ = (e) & 15; \
    const float x_ = __builtin_amdgcn_exp2f(s[qi_][kb][i_]); s[qi_][kb][i_] = x_; FADD(l2[qi_][i_ & 1], x_); \
    if (i_ & 1) pw[kb][qi_][i_ >> 3][(i_ & 7) >> 1] = pk2(s[qi_][kb][i_ - 1], x_); } while (0)
#define F_STEP(j) do { \
    const int st = ((j) & 1) * STG; \
    if ((j) + 1 < NT) A_DMA((j) + 1, ((j) + 1) & 1); \
    const int kt_ = lat_lo + (j) - 4; \
    const bool need = active && ((j) < 4 || (kt_ >= wlo && kt_ <= whi)); \
    if (need) { \
      f32x16 s[2][2]; bf16x8 kf[NKS]; bf16x8 vf[4]; u32x4 pw[2][2][2]; \
      const f32x16 zero16 = {0.f, 0.f, 0.f, 0.f, 0.f, 0.f, 0.f, 0.f, 0.f, 0.f, 0.f, 0.f, 0.f, 0.f, 0.f, 0.f}; \
      const bool domask = (BR == 1 || BR == 2) && (j) >= 4; \
      _Pragma("unroll") for (int ks = 0; ks < NKS; ++ks) kf[ks] = KLOAD(0, ks); \
      _Pragma("unroll") for (int ks = 0; ks < NKS; ++ks) { \
        s[0][0] = MFMA(kf[ks], qf[0][ks], ks == 0 ? zero16 : s[0][0]); s[1][0] = MFMA(kf[ks], qf[1][ks], ks == 0 ? zero16 : s[1][0]); \
        SB(); kf[ks] = KLOAD(1, ks); SB(); } \
      if (domask) { _Pragma("unroll") for (int qi = 0; qi < 2; ++qi) { const int ql_ = qlat0 + 32 * qi; attn_mask1<BR>(s[qi][0], 0, kt_, ql_, ql_ >> 6, ql_ & 63, hh, rpb); } } \
      _Pragma("unroll") for (int m = 0; m < 2 * NKS; ++m) { \
        s[m & 1][1] = MFMA(kf[m >> 1], qf[m & 1][m >> 1], (m >> 1) == 0 ? zero16 : s[m & 1][1]); \
        if (m < 4) vf[m] = VLOAD(m >> 1, m & 1); \
        _Pragma("unroll") for (int e = (m * 32) / (2 * NKS); e < ((m + 1) * 32) / (2 * NKS); ++e) SM_EL(0, e); \
        SB(); } \
      if (domask) { _Pragma("unroll") for (int qi = 0; qi < 2; ++qi) { const int ql_ = qlat0 + 32 * qi; attn_mask1<BR>(s[qi][1], 1, kt_, ql_, ql_ >> 6, ql_ & 63, hh, rpb); } } \
      _Pragma("unroll") for (int m = 0; m < 8; ++m) { \
        o[m & 1][(m >> 1) & 1] = MFMA(vf[m >> 1], __builtin_bit_cast(bf16x8, pw[0][m & 1][m >> 2]), o[m & 1][(m >> 1) & 1]); \
        if (m & 1) { SB(); vf[m >> 1] = VLOAD(2 + (m >> 2), (m >> 1) & 1); } \
        _Pragma("unroll") for (int e = 4 * m; e < 4 * m + 4; ++e) SM_EL(1, e); \
        SB(); } \
      _Pragma("unroll") for (int m = 0; m < 8; ++m) \
        o[m & 1][(m >> 1) & 1] = MFMA(vf[m >> 1], __builtin_bit_cast(bf16x8, pw[1][m & 1][m >> 2]), o[m & 1][(m >> 1) & 1]); \
    } \
    asm volatile("s_waitcnt vmcnt(0)" ::: "memory"); \
    __syncthreads(); \
  } while (0)
#define A_STEP(j) do { \
    const int st = ((j) & 1) * STG; \
    if ((j) + 1 < NT) A_DMA((j) + 1, ((j) + 1) & 1); \
    const int kt_ = lat_lo + (j) - 4; \
    const bool need = active && ((j) < 4 || (kt_ >= wlo && kt_ <= whi)); \
    if (need) { \
      f32x16 s[2][2]; \
      _Pragma("unroll") for (int kb = 0; kb < 2; ++kb) { \
        _Pragma("unroll") for (int ks = 0; ks < 4; ++ks) { const bf16x8 kf = *(const LAS bf16x8*)(kfb + st + kb * 4096 + (((2 * ks + hh) ^ kkey) << 4)); \
          _Pragma("unroll") for (int qi = 0; qi < 2; ++qi) { if (ks == 0) { _Pragma("unroll") for (int i = 0; i < 16; ++i) s[qi][kb][i] = 0.f; } s[qi][kb] = MFMA(kf, qf[qi][ks], s[qi][kb]); } } \
        if (MLA) { _Pragma("unroll") for (int ks = 0; ks < 2; ++ks) { const bf16x8 kf = *(const LAS bf16x8*)(krb + st + kb * 2048 + (((2 * ks + hh) ^ rkey) << 4)); \
          _Pragma("unroll") for (int qi = 0; qi < 2; ++qi) s[qi][kb] = MFMA(kf, qf[qi][NKS - 2 + ks], s[qi][kb]); } } \
      } \
      if (FAST) __builtin_amdgcn_sched_barrier(0); \
      _Pragma("unroll") for (int qi = 0; qi < 2; ++qi) { \
        if ((BR == 1 || BR == 2) && (j) >= 4) { const int ql_ = qlat0 + 32 * qi; attn_mask<BR>(s[qi], kt_, ql_, ql_ >> 6, ql_ & 63, hh, rpb); } \
        if (FAST) { \
          float ls0 = 0.f, ls1 = 0.f; \
          _Pragma("unroll") for (int i = 0; i < 16; ++i) { \
            const float e0 = __builtin_amdgcn_exp2f(s[qi][0][i]), e1 = __builtin_amdgcn_exp2f(s[qi][1][i]); \
            s[qi][0][i] = e0; s[qi][1][i] = e1; FADD(ls0, e0); FADD(ls1, e1); } \
          l_run[qi] += ls0 + ls1; \
        } else { \
        float mx = s[qi][0][0]; \
        _Pragma("unroll") for (int i = 1; i < 16; ++i) mx = fmaxf(mx, s[qi][0][i]); \
        _Pragma("unroll") for (int i = 0; i < 16; ++i) mx = fmaxf(mx, s[qi][1][i]); \
        mx = fmaxf(mx, __shfl_xor(mx, 32)); \
        const float m_new = fmaxf(m_run[qi], mx); \
        const float alpha = __builtin_amdgcn_exp2f(m_run[qi] - m_new); \
        m_run[qi] = m_new; \
        float ls0 = 0.f, ls1 = 0.f; \
        _Pragma("unroll") for (int i = 0; i < 16; ++i) { \
          const float e0 = __builtin_amdgcn_exp2f(s[qi][0][i] - m_new), e1 = __builtin_amdgcn_exp2f(s[qi][1][i] - m_new); \
          s[qi][0][i] = e0; s[qi][1][i] = e1; ls0 += e0; ls1 += e1; } \
        l_run[qi] = l_run[qi] * alpha + (ls0 + ls1); \
        if (__any(alpha != 1.f)) { _Pragma("unroll") for (int i = 0; i < 16; ++i) { o[qi][0][i] *= alpha; o[qi][1][i] *= alpha; } } \
        } \
      } \
      _Pragma("unroll") for (int s4 = 0; s4 < 4; ++s4) { \
        const int kb = s4 >> 1, rb = (s4 & 1) * 8; \
        bf16x8 pf[2]; \
        _Pragma("unroll") for (int qi = 0; qi < 2; ++qi) { u32x4 pw; \
          pw.x = pk2(s[qi][kb][rb + 0], s[qi][kb][rb + 1]); pw.y = pk2(s[qi][kb][rb + 2], s[qi][kb][rb + 3]); \
          pw.z = pk2(s[qi][kb][rb + 4], s[qi][kb][rb + 5]); pw.w = pk2(s[qi][kb][rb + 6], s[qi][kb][rb + 7]); \
          pf[qi] = __builtin_bit_cast(bf16x8, pw); } \
        _Pragma("unroll") for (int db = 0; db < 2; ++db) { const bf16x8 vf = vtr2s(vfb + st + s4 * 2048, ((4 * db + vch) ^ vkey) << 4, ((4 * db + vch) ^ vkey ^ 4) << 4); \
          o[0][db] = MFMA(vf, pf[0], o[0][db]); o[1][db] = MFMA(vf, pf[1], o[1][db]); } \
      } \
    } \
    asm volatile("s_waitcnt vmcnt(0)" ::: "memory");        \
    __syncthreads(); \
  } while (0)
  if (FAST) {
    if (wave >= 4) __builtin_amdgcn_s_setprio(1);
    for (int j = 0; j < NT; j += 2) {
      F_STEP(j);
      if (j + 1 < NT) F_STEP(j + 1);
    }
    __builtin_amdgcn_s_setprio(0);
  } else {
    for (int j = 0; j < NT; j += 2) {
      A_STEP(j);
      if (j + 1 < NT) A_STEP(j + 1);
    }
  }
#undef F_STEP
#undef SM_EL
#undef A_STEP
#undef A_DMA
#undef DMA16
  bool bad = false;
  if (active) {
#pragma unroll
    for (int qi = 0; qi < 2; ++qi) {
      if (FAST) l_run[qi] = l2[qi][0] + l2[qi][1];
      const float lt = l_run[qi] + __shfl_xor(l_run[qi], 32);
      const float inv = 1.f / lt;
      if (FAST) bad = bad || !(lt > 1e-25f && lt < 1e25f);
      unsigned char* Op = wsp<unsigned char>(p, OFF_O) + (tokq + 32 * qi) * 1024 + obase;
#pragma unroll
      for (int db = 0; db < 2; ++db)
#pragma unroll
        for (int gp = 0; gp < 2; ++gp) {
          float q[8];
#pragma unroll
          for (int j = 0; j < 8; ++j) q[j] = __builtin_amdgcn_fmed3f(o[qi][db][8 * gp + j] * (inv * O8_SCALE), -448.f, 448.f);
          int wa = __builtin_amdgcn_cvt_pk_fp8_f32(q[0], q[1], 0, false); wa = __builtin_amdgcn_cvt_pk_fp8_f32(q[2], q[3], wa, true);
          int wb = __builtin_amdgcn_cvt_pk_fp8_f32(q[4], q[5], 0, false); wb = __builtin_amdgcn_cvt_pk_fp8_f32(q[6], q[7], wb, true);
          const u32x2 sx = __builtin_amdgcn_permlane32_swap((unsigned)wa, (unsigned)wb, false, false);
          *(u32x2*)(Op + db * 32 + 16 * gp + 8 * hh) = sx;
        }
    }
  }
  if (!FAST) return false;
  LAS int* flag = (LAS int*)(lds + 2 * STG + 2048);
  if (__any(bad) && lane == 0) *flag = 1;
  __syncthreads();
  return __builtin_amdgcn_readfirstlane(*flag) != 0;
}
template <bool FAST>
DEVI bool attn_dispatch(KP p, int l, int n, int xcd, ldsp_t lds) {
  int br, s, qb; bool isctx = false;
  if (n < 32) { br = 0; s = xcd + 8 * (n >> 3); qb = n & 7; }
  else if (n < 64) { const int m = n - 32; br = 3; s = xcd + 8 * (m >> 4); qb = m & 15; }
  else if (n < 96) { const int m = n - 64; br = 2; s = xcd + 8 * (m >> 3); qb = m & 7; }
  else if (n < 128) { const int m = n - 96; br = 1; s = xcd + 8 * (m >> 4); qb = m & 15; }
  else {
    const int m = n - 128; isctx = true; qb = 0;
    if (m < 4) { br = 0; s = xcd + 8 * m; }
    else if (m < 6) { br = 3; s = xcd + 8 * (m - 4); }
    else if (m < 10) { br = 2; s = xcd + 8 * (m - 6); }
    else { br = 1; s = xcd + 8 * (m - 10); }
  }
  if (br == 0) return attn_item2<0, FAST>(p, l, s >> 2, s & 3, qb, isctx, lds);
  else if (br == 1) return attn_item2<1, FAST>(p, l, s >> 1, s & 1, qb, isctx, lds);
  else if (br == 2) return attn_item2<2, FAST>(p, l, s >> 2, s & 3, qb, isctx, lds);
  else return attn_item2<3, FAST>(p, l, s >> 1, s & 1, qb, isctx, lds);
}
DEVI void phaseD2(KP p, int l, ldsp_t lds) {
  const int G8 = gridDim.x >> 3, xcd = BIDX & 7, lb = BIDX >> 3;
  if (lb >= G8) return;
  const int NLOC = 128 + (l == 0 ? 12 : 0);
  const int nmine = (NLOC - lb + G8 - 1) / G8;
  const int cslot = min((int)(BIDX & 3), nmine - 1);
  int it = 0; unsigned redo = 0;
  for (int n = lb; n < NLOC; n += G8, ++it) {
    if (it == cslot) conv_items2(p, l, lds, CONV_EARLY, CONV_ITEMS);
    if (attn_dispatch<true>(p, l, n, xcd, lds)) redo |= 1u << it;
  }
  if (redo) {
    it = 0;
    for (int n = lb; n < NLOC; n += G8, ++it)
      if ((redo >> it) & 1) attn_dispatch<false>(p, l, n, xcd, lds);
  }
}

DEVI int pm_map(int pme, bool skipctx) { return skipctx ? (pme >> 4) * 17 + 1 + (pme & 15) : pme; }
struct SchedE1 { const char* ws; bool skipctx; int G, c;
  DEVI bool next(int i, Unit& u) const { int pm, pn; if (!tile_order(i, G, c, skipctx ? 128 : 136, 16, pm, pn)) return false;
    pm = pm_map(pm, skipctx); const int n = pn >> 2, cq = pn & 3;
    u.A = ws + OFF_O + uoff((unsigned)pm * 256u * 1024u + (unsigned)n * 256u); u.B = ws + OFF_WBR + uoff(((unsigned)n * 1024u + (unsigned)cq * 256u) * 256u); u.rows = nullptr; u.nvalid = 0;
    u.u0 = pm * 256; u.u1 = pn * 256; u.u2 = 0; u.u3 = 0; return true; } };
DEVI void phaseE1(KP p, int l, ldsp_t lds) {
  if (BIDX == 0 && TIDX < 32) wsp<int>(p, OFF_CNT)[TIDX * CNT_STRIDE] = 0;
  SchedE1 S{(const char*)p->ws, l == 1, (int)gridDim.x, BIDX};
  EpiZ8 E{wsp<unsigned char>(p, OFF_Z)};
  gemm_phase<true, false, true>(lds, 1024, 256, 2, S, E);
}
struct SchedE2 { const char* ws; const char* h8; bool skipctx; int G, c;
  DEVI bool next(int i, Unit& u) const { int pm, pn; if (!tile_order(i >> 1, G, c, skipctx ? 128 : 136, 8, pm, pn)) return false;
    pm = pm_map(pm, skipctx); const int pr = i & 1;
    u.A = h8 + uoff((unsigned)pm * 256u * 1024u); u.B = ws + OFF_WGATE + uoff((unsigned)(pr * 8 + pn) * 256u * 1024u); u.rows = nullptr; u.nvalid = 0;
    u.u0 = pm * 256; u.u1 = pn * 128; u.u2 = pr; u.u3 = 0; return true; } };
constexpr float Y8_SCALE = 16.f;
static_assert(Y8_SCALE == Z8_SCALE, "the E2 epilogue keeps its sums in Z8 units");
struct EpiE2 { const unsigned char* Z; u32x4 (&part)[8]; unsigned char* Y8; const float* bias;
  DEVI void init(f32x4 (&acc)[2][2][4][2], const Unit& u, int wr, int wc, int fr, int fq) const {
    const int col0 = u.u1 + wc * 32 + 8 * fq;
#pragma unroll
    for (int bj = 0; bj < 2; ++bj)
#pragma unroll
      for (int nn = 0; nn < 2; ++nn) {
        const f32x4 b = *(const f32x4*)(bias + (2 * u.u2 + bj) * 1024 + col0 + 4 * nn) * -LOG2E;
#pragma unroll
        for (int a = 0; a < 2; ++a)
#pragma unroll
          for (int m = 0; m < 4; ++m) acc[a][bj][m][nn] = b;
      }
  }
  DEVI void operator()(const f32x4 (&acc)[2][2][4][2], const Unit& u, int wr, int wc, int fr, int fq) const {
    const int row0 = u.u0 + wr * 64 + fr, col0 = u.u1 + wc * 32 + 8 * fq, pr = u.u2;
    const unsigned lw16 = (unsigned)((wr * 4 + wc) * 64 + fr + 16 * fq) * 16u;
    const unsigned char* zb0 = Z + z8_block(u.u0 >> 8, 2 * pr, u.u1 >> 7) + lw16;
    u32x4 zq[4][2], yq[4][2];
    auto ldpair = [&](int P, u32x4 (&z)[2], u32x4 (&y)[2]) {
#pragma unroll
      for (int bj = 0; bj < 2; ++bj) z[bj] = *(const u32x4*)(zb0 + (size_t)bj * 8 * 32768 + P * 8192);
#pragma unroll
      for (int h = 0; h < 2; ++h) y[h] = pr ? part[2 * P + h] : u32x4{0u, 0u, 0u, 0u};
    };
#pragma unroll
    for (int P = 0; P < 4; ++P) ldpair(P, zq[P], yq[P]);
#pragma unroll
    for (int P = 0; P < 4; ++P) {
      const int c = P;
#pragma unroll
      for (int h = 0; h < 2; ++h) {
        const int g = 2 * P + h, ai = g >> 2, m = g & 3;
        const size_t r = (size_t)(row0 + ai * HALF + m * 16);
        float t[8];
        {
          const unsigned w[4] = {yq[c][h].x, yq[c][h].y, yq[c][h].z, yq[c][h].w};
#pragma unroll
          for (int i = 0; i < 4; ++i) { t[2 * i] = __uint_as_float(w[i] << 16); t[2 * i + 1] = __uint_as_float(w[i] & 0xffff0000u); }
        }
#pragma unroll
        for (int bj = 0; bj < 2; ++bj) {
#pragma unroll
          for (int nn = 0; nn < 2; ++nn) {
            const int zw = (int)zq[c][bj][2 * h + nn];
            const f32x2 zlo = __builtin_amdgcn_cvt_pk_f32_fp8(zw, false), zhi = __builtin_amdgcn_cvt_pk_f32_fp8(zw, true);
            const float zz4[4] = {zlo.x, zlo.y, zhi.x, zhi.y};
#pragma unroll
            for (int j = 0; j < 4; ++j) {
              const int e = 4 * nn + j;
              const float gte = __builtin_amdgcn_rcpf(1.f + __builtin_amdgcn_exp2f(acc[ai][bj][m][nn][j]));
              t[e] += gte * zz4[j];
            }
          }
        }
        if (pr == 0) {
          u32x4 o; o.x = pk2(t[0], t[1]); o.y = pk2(t[2], t[3]); o.z = pk2(t[4], t[5]); o.w = pk2(t[6], t[7]);
          part[g] = o;
        } else {
          u32x2 o8;
#pragma unroll
          for (int w = 0; w < 2; ++w) {
            float q[4];
#pragma unroll
            for (int j = 0; j < 4; ++j) q[j] = __builtin_amdgcn_fmed3f(t[4 * w + j], -448.f, 448.f);
            int v = __builtin_amdgcn_cvt_pk_fp8_f32(q[0], q[1], 0, false);
            v = __builtin_amdgcn_cvt_pk_fp8_f32(q[2], q[3], v, true);
            o8[w] = (unsigned)v;
          }
          *(u32x2*)(Y8 + r * 1024 + col0) = o8;
        }
      }
    }
  }
};
DEVI void phaseE2(KP p, int l, ldsp_t lds) {
  SchedE2 S{(const char*)p->ws, (const char*)h8base(p), l == 1, (int)gridDim.x, BIDX};
  u32x4 part[8];
#pragma unroll
  for (int i = 0; i < 8; ++i) part[i] = u32x4{0u, 0u, 0u, 0u};
  EpiE2 E{wsp<unsigned char>(p, OFF_Z), part, wsp<unsigned char>(p, OFF_Y8), p->b_gate + (size_t)l * 4 * 1024};
  gemm_phase<true, false, true>(lds, 1024, 1024, 8, S, E);
}
struct SchedF { const char* ws; bool skipctx; int G, c;
  DEVI bool next(int i, Unit& u) const { int pm, pn;
    if (skipctx || G != 256) { if (!tile_order(i, G, c, skipctx ? 128 : 136, 4, pm, pn)) return false; }
    else if (i < 2) { if (!tile_order(i, G, c, 128, 4, pm, pn)) return false; }
    else { if (i > 2 || c >= 32) return false; pm = 128 + (c >> 2); pn = c & 3; }
    pm = pm_map(pm, skipctx);
    u.A = ws + OFF_Y8 + uoff((unsigned)pm * 256u * 1024u); u.B = ws + OFF_WOUT + uoff((unsigned)pn * 256u * 1024u); u.rows = nullptr; u.nvalid = 0;
    u.u0 = pm; u.u1 = pn * 256; u.u2 = 0; u.u3 = 0; return true; } };
struct EpiF { KP p; int l;
  DEVI void init(f32x4 (&acc)[2][2][4][2], const Unit&, int, int, int, int) const { acc_zero(acc); }
  DEVI void operator()(const f32x4 (&acc)[2][2][4][2], const Unit& u, int wr, int wc, int fr, int fq) const {
    const int pm = u.u0, b = pm / 17, rr0 = (pm % 17) * 256;
    const int mrow = (rr0 < NCTX) ? 8 : b;
    const int col0 = u.u1 + wc * 32 + 8 * fq;
    const float* gt = wsp<float>(p, OFF_MOD) + ((size_t)l * 9 + mrow) * 6144 + 2048 + col0;
    const u16* xinb = (const u16*)p->out + (size_t)(b * TPB + rr0) * 1024 + col0;
    const __amdgpu_buffer_rsrc_t xrs = __builtin_amdgcn_make_buffer_rsrc((void*)wsp<u16>(p, OFF_XM), 0, NTOK * 1024 * 2, 0x00020000);
    const unsigned xoff = (unsigned)((b * TPB + rr0) * 1024 + col0) * 2u;
    f32x4 gv[2][2];
#pragma unroll
    for (int bj = 0; bj < 2; ++bj)
#pragma unroll
      for (int n = 0; n < 2; ++n) gv[bj][n] = *(const f32x4*)(gt + bj * HALF + n * 4) * (1.f / Y8_SCALE);
#pragma unroll
    for (int ai = 0; ai < 2; ++ai) {
      u32x4 xo[4][2];
#pragma unroll
      for (int m = 0; m < 4; ++m) {
        const size_t ro = (size_t)(wr * 64 + fr + ai * HALF + m * 16) * 1024;
#pragma unroll
        for (int bj = 0; bj < 2; ++bj) xo[m][bj] = *(const u32x4*)(xinb + ro + bj * HALF);
      }
#pragma unroll
      for (int mp = 0; mp < 2; ++mp) {
#pragma unroll
        for (int mm = 0; mm < 2; ++mm) {
          const int m = 2 * mp + mm;
          const size_t ro = (size_t)(wr * 64 + fr + ai * HALF + m * 16) * 1024;
#pragma unroll
          for (int bj = 0; bj < 2; ++bj) {
            const u32x4 v = xo[m][bj];
            const f32x4 x0 = f32x4{__uint_as_float(v.x << 16), __uint_as_float(v.x & 0xffff0000u), __uint_as_float(v.y << 16), __uint_as_float(v.y & 0xffff0000u)};
            const f32x4 x1 = f32x4{__uint_as_float(v.z << 16), __uint_as_float(v.z & 0xffff0000u), __uint_as_float(v.w << 16), __uint_as_float(v.w & 0xffff0000u)};
            const f32x4 r0 = x0 + gv[bj][0] * acc[ai][bj][m][0], r1 = x1 + gv[bj][1] * acc[ai][bj][m][1];
            __builtin_amdgcn_raw_buffer_store_b128(u32x4{pk2(r0.x, r0.y), pk2(r0.z, r0.w), pk2(r1.x, r1.y), pk2(r1.z, r1.w)}, xrs,
                                                   (int)(xoff + (unsigned)(ro + bj * HALF) * 2u), 0, 16);
          }
        }
      }
    }
    asm volatile("s_waitcnt vmcnt(0)" ::: "memory");
    if ((TIDX & 63) == 0) __hip_atomic_fetch_add(wsp<int>(p, OFF_DEP) + (l * 136 + pm) * DEP_STRIDE, 1, __ATOMIC_RELAXED, __HIP_MEMORY_SCOPE_AGENT);
  }
};
DEVI void phaseF2(KP p, int l, ldsp_t lds) {
  SchedF S{(const char*)p->ws, l == 1, (int)gridDim.x, BIDX};
  EpiF E{p, l};
  gemm_phase<true, false, true>(lds, 1024, 1024, 8, S, E);
}


DEVI void phase0_2(KP p, ldsp_t lds) {
  const int tid = TIDX, half = tid >> 8, htid = tid & 255;
  for (int it = BIDX * 2; it < 458; it += gridDim.x * 2) {
    const int item = it + half;
    LAS float* sc = (LAS float*)(lds + half * 16384);
    const bool ismod = item < 384;
    const int l = item / 192, rem = item % 192, cgp = rem >> 3, kc = rem & 7;
    __syncthreads();
    if (ismod) {
      for (int i = htid; i < 9 * 128; i += 256) {
        int b = i >> 7, k = i & 127;
        float v = (b < 8) ? p->c[b * 1024 + kc * 128 + k] : p->c_ctx[kc * 128 + k];
        sc[i] = v / (1.f + __expf(-v));
      }
    }
    __syncthreads();
    if (ismod) {
      float acc[9];
#pragma unroll
      for (int b = 0; b < 9; ++b) acc[b] = 0.f;
      const float* w = p->w_mod + ((size_t)l * 1024 + kc * 128) * 6144 + cgp * 256 + htid;
#pragma unroll 32
      for (int k = 0; k < 128; ++k) {
        float wv = __builtin_nontemporal_load(w + (size_t)k * 6144);
#pragma unroll
        for (int b = 0; b < 9; ++b) acc[b] += sc[b * 128 + k] * wv;
      }
      float* dst = wsp<float>(p, OFF_MODP) + (size_t)((kc * 2 + l) * 9) * 6144 + cgp * 256 + htid;
#pragma unroll
      for (int b = 0; b < 9; ++b) dst[(size_t)b * 6144] = acc[b];
    } else if (item == 384) {
      float* cs32 = wsp<float>(p, OFF_CS32);
      float* cs16 = wsp<float>(p, OFF_CS16);
      for (int t = htid; t < 1024; t += 256) {
        int pos = t >> 4, i = t & 15;
        float ang = (float)pos * __builtin_amdgcn_exp2f(-(float)(2 * i) * (13.287712379549449f / 32.f));
        cs32[t * 2] = __cosf(ang); cs32[t * 2 + 1] = __sinf(ang);
      }
      for (int t = htid; t < 512; t += 256) {
        int pos = t >> 3, i = t & 7;
        float ang = (float)pos * __builtin_amdgcn_exp2f(-(float)(2 * i) * (13.287712379549449f / 16.f));
        cs16[t * 2] = __cosf(ang); cs16[t * 2 + 1] = __sinf(ang);
      }
    } else if (item < 457) {
      const int q = item - 385, ll = q / 36, o = q % 36;
      float* dst = wsp<float>(p, OFF_WRT) + ((size_t)ll * 36 + o) * 1024;
      for (int k = htid; k < 1024; k += 256)
        dst[k] = (o < 4) ? p->w_group[((size_t)ll * 1024 + k) * 4 + o] : p->w_router[((size_t)ll * 1024 + k) * 32 + (o - 4)];
    }
  }
}
DEVI void phase1_2(KP p) {
  const float* mp = wsp<float>(p, OFF_MODP);
  float* mo = wsp<float>(p, OFF_MOD);
  for (int i = BIDX * 512 + TIDX; i < 2 * 9 * 6144; i += gridDim.x * 512) {
    int l = i / (9 * 6144), o = i % 6144;
    float s = p->b_mod[l * 6144 + o];
#pragma unroll
    for (int kc = 0; kc < 8; ++kc) s += mp[(size_t)kc * 2 * 9 * 6144 + i];
    mo[i] = s;
  }
}
DEVI void phaseA2(KP p) {
  const int gw = BIDX * NW + (TIDX >> 6), nw = gridDim.x * NW;
  u16* H = wsp<u16>(p, OFF_H);
  const int per = (NTOK + nw - 1) / nw;
  const int t0 = gw * per, t1 = min(t0 + per, NTOK);
  int cur = -1; ModVec mv;
  for (int tok0 = t0; tok0 < t1; tok0 += 2) {
    float xv[2][16];
#pragma unroll
    for (int r = 0; r < 2; ++r) { const int tok = tok0 + r; if (tok < t1) load_row16(xrow_in(p, 0, tok / TPB, tok % TPB), xv[r]); }
#pragma unroll
    for (int r = 0; r < 2; ++r) {
      const int tok = tok0 + r;
      if (tok < t1) {
        const int mrow = (tok % TPB) < NCTX ? 8 : tok / TPB;
        if (mrow != cur) { load_modvec(p, 0, 0, mrow, mv); cur = mrow; }
        float hv[16]; modulate_row_store2<true, false>(mv, xv[r], nullptr, hv, h8base(p) + (size_t)tok * 1024);
        u16* xb = (u16*)p->out + (size_t)tok * 1024 + (TIDX & 63) * 4;
#pragma unroll
        for (int i = 0; i < 4; ++i) *(u32x2*)(xb + i * 256) = u32x2{pk2(xv[r][i * 4], xv[r][i * 4 + 1]), pk2(xv[r][i * 4 + 2], xv[r][i * 4 + 3])}; }
    }
  }
}
DEVI void phaseG2(KP p, int l, ldsp_t lds) {
  constexpr int RP = 2064;
  constexpr int GX = 2 * 32 * RP;
  const int tid = TIDX, lane = tid & 63, wave = __builtin_amdgcn_readfirstlane(tid >> 6);
  const int r32 = lane & 31, kh = lane >> 5, qd = lane >> 4;
  u16* H = wsp<u16>(p, OFF_H2);
  const float* WRT = wsp<float>(p, OFF_WRT) + (size_t)l * 36 * 1024;
  int* cnt = wsp<int>(p, OFF_CNT);
  int* list = wsp<int>(p, OFF_LIST);
  float* wlist = wsp<float>(p, OFF_WLIST);
  const ldsp_t hiP = lds, loP = lds + 32 * RP;
  LAS float* part = (LAS float*)lds;
  LAS int* gsel = (LAS int*)(lds + GX);
  LAS float* gwt = (LAS float*)(lds + GX + 128);
  LAS int* lcnt = (LAS int*)(lds + GX + 256);
  LAS int* gbase = lcnt + 32;
  LAS int* tinfo = lcnt + 64;
  if (tid < 32) lcnt[tid] = 0;
  int nloc = 0;
  bf16x8 whi[8], wlo[8];
  {
    const float* wr = p->w_router + (size_t)l * 1024 * 32 + r32;
#pragma unroll
    for (int s8 = 0; s8 < 8; ++s8) {
      u32x4 h, lo4;
#pragma unroll
      for (int jj = 0; jj < 4; ++jj) {
        const int k = 128 * wave + 16 * s8 + 8 * kh + 2 * jj;
        const float a = wr[(size_t)k * 32], b2 = wr[(size_t)(k + 1) * 32];
        const unsigned hp = pk2(a, b2);
        h[jj] = hp; lo4[jj] = pk2(a - __uint_as_float(hp << 16), b2 - __uint_as_float(hp & 0xffff0000u));
      }
      whi[s8] = __builtin_bit_cast(bf16x8, h); wlo[s8] = __builtin_bit_cast(bf16x8, lo4);
    }
  }
  int* tctr = wsp<int>(p, OFF_DEP) + DEP_TILECTR + l * DEP_STRIDE;
  LAS int* tnext = lcnt + 64 + 512 * 6;
  const int ntile = (l == 1) ? 8 * SEQ / 32 : NTOK / 32;
  if (tid == 0) *tnext = atomicAdd(tctr, 1);
  __syncthreads();
  for (;;) {
    const int tix = *tnext;
    if (tix >= ntile) break;
    int tclaim = 0;
    if (tid == 0) tclaim = atomicAdd(tctr, 1);
    const int tile = (l == 1) ? (tix >> 7) * 136 + 8 + (tix & 127) : tix;
    const int tok0 = tile * 32, b = tok0 / TPB, rr0 = tok0 % TPB;
    if (wave == 0) {
      const int* dep = wsp<int>(p, OFF_DEP) + (l * 136 + (tok0 >> 8)) * DEP_STRIDE;
      while (__hip_atomic_load(dep, __ATOMIC_RELAXED, __HIP_MEMORY_SCOPE_AGENT) < 32) __builtin_amdgcn_s_sleep(2);
      __builtin_amdgcn_fence(__ATOMIC_ACQUIRE, "agent");
      asm volatile("s_waitcnt vmcnt(0)" ::: "memory");
    }
    __syncthreads();
    {
      float hv[4][16], xv4[4][16];
#pragma unroll
      for (int r = 0; r < 4; ++r) load_row16_bf(wsp<u16>(p, OFF_XM) + (size_t)(tok0 + wave * 4 + r) * 1024, xv4[r]);
      ModVec mv; load_modvec(p, l, 1, (rr0 < NCTX) ? 8 : b, mv);
#pragma unroll
      for (int r = 0; r < 4; ++r) {
        modulate_row_store2<true, false>(mv, xv4[r], nullptr, hv[r], (unsigned char*)H + (size_t)(tok0 + wave * 4 + r) * 1024);
        const int ro = (wave * 4 + r) * RP + lane * 8;
#pragma unroll
        for (int i = 0; i < 4; ++i) {
          const unsigned h01 = pk2(hv[r][i * 4], hv[r][i * 4 + 1]), h23 = pk2(hv[r][i * 4 + 2], hv[r][i * 4 + 3]);
          const unsigned l01 = pk2(hv[r][i * 4] - __uint_as_float(h01 << 16), hv[r][i * 4 + 1] - __uint_as_float(h01 & 0xffff0000u));
          const unsigned l23 = pk2(hv[r][i * 4 + 2] - __uint_as_float(h23 << 16), hv[r][i * 4 + 3] - __uint_as_float(h23 & 0xffff0000u));
          *(LAS u32x2*)(hiP + ro + i * 512) = u32x2{h01, h23};
          *(LAS u32x2*)(loP + ro + i * 512) = u32x2{l01, l23};
        }
      }
      float gl[4];
#pragma unroll
      for (int o = 0; o < 4; ++o) gl[o] = router_dot(hv, WRT + (size_t)o * 1024) + p->b_group[l * 4 + o];
      int gs = 0; float best = gl[0];
#pragma unroll
      for (int j = 1; j < 4; ++j) if (gl[j] > best) { best = gl[j]; gs = j; }
      float gsum = 0.f;
#pragma unroll
      for (int j = 0; j < 4; ++j) gsum += __expf(gl[j] - best);
      if ((lane & 15) == 0) { gsel[wave * 4 + qd] = gs; gwt[wave * 4 + qd] = 1.f / gsum; }
    }
    __syncthreads();
    f32x16 acc;
#pragma unroll
    for (int i = 0; i < 16; ++i) acc[i] = 0.f;
    {
      const int ao = r32 * RP + (128 * wave + 8 * kh) * 2;
#pragma unroll
      for (int s8 = 0; s8 < 8; ++s8) {
        const bf16x8 ah = *(const LAS bf16x8*)(hiP + ao + s8 * 32), al = *(const LAS bf16x8*)(loP + ao + s8 * 32);
        acc = MFMA(ah, whi[s8], acc);
        acc = MFMA(ah, wlo[s8], acc);
        acc = MFMA(al, whi[s8], acc);
      }
    }
    __syncthreads();
#pragma unroll
    for (int i = 0; i < 16; ++i) part[(wave * 32 + (i & 3) + 8 * (i >> 2) + 4 * kh) * 33 + r32] = acc[i];
    __syncthreads();
    if (tid < 32) {
      const int gs = gsel[tid];
      const float gw_ = gwt[tid];
      float e8[8];
#pragma unroll
      for (int j = 0; j < 8; ++j) {
        float v = p->b_router[l * 32 + gs * 8 + j];
#pragma unroll
        for (int w = 0; w < 8; ++w) v += part[(w * 32 + tid) * 33 + gs * 8 + j];
        e8[j] = v;
      }
      int i0 = 0; float v0 = e8[0];
#pragma unroll
      for (int j = 1; j < 8; ++j) if (e8[j] > v0) { v0 = e8[j]; i0 = j; }
      int i1 = -1; float v1 = -INFINITY;
#pragma unroll
      for (int j = 0; j < 8; ++j) if (j != i0 && e8[j] > v1) { v1 = e8[j]; i1 = j; }
      const float ex = __expf(v1 - v0);
      const float w0 = gw_ / (1.f + ex), w1 = gw_ * ex / (1.f + ex);
      const int tok = tok0 + tid;
      const int ea = gs * 8 + i0, eb = gs * 8 + i1;
      const int ra = __hip_atomic_fetch_add(&lcnt[ea], 1, __ATOMIC_RELAXED, __HIP_MEMORY_SCOPE_WORKGROUP);
      const int rb = __hip_atomic_fetch_add(&lcnt[eb], 1, __ATOMIC_RELAXED, __HIP_MEMORY_SCOPE_WORKGROUP);
      LAS int* ti = tinfo + (nloc + tid) * 6;
      ti[0] = tok; ti[1] = ea | (eb << 8); ti[2] = ra; ti[3] = rb; ti[4] = __float_as_int(w0); ti[5] = __float_as_int(w1);
    }
    if (tid == 0) *tnext = tclaim;
    nloc += 32;
    __syncthreads();
    const bool last = *tnext >= ntile;
    if (last || nloc == 512) {
      if (tid < 32) { const int c = lcnt[tid]; gbase[tid] = c ? atomicAdd(&cnt[tid * CNT_STRIDE], c) : 0; }
      __syncthreads();
      for (int i = tid; i < nloc; i += 512) {
        const LAS int* ti = tinfo + i * 6;
        const int tok = ti[0], ea = ti[1] & 255, eb = ti[1] >> 8;
        const int sa = gbase[ea] + ti[2], sb = gbase[eb] + ti[3];
        list[(size_t)ea * NTOK + sa] = tok * 2; wlist[(size_t)ea * NTOK + sa] = __int_as_float(ti[4]);
        list[(size_t)eb * NTOK + sb] = tok * 2 + 1; wlist[(size_t)eb * NTOK + sb] = __int_as_float(ti[5]);
      }
      __syncthreads();
      if (tid < 32) lcnt[tid] = 0;
      nloc = 0;
      __syncthreads();
    }
  }
}
struct ExpInfo2 { int tiles[4], base[4], cnt[4]; };
DEVI ExpInfo2 exp_info2(KP p, int xcd) {
  const int* cnt = wsp<int>(p, OFF_CNT);
  ExpInfo2 ei;
  int before = 0;
#pragma unroll
  for (int e = 0; e < 32; ++e) {
    const int c = __builtin_amdgcn_readfirstlane(cnt[e * CNT_STRIDE]), t = (c + 255) >> 8;
    if ((e & 7) == xcd) { ei.tiles[e >> 3] = t; ei.base[e >> 3] = before; ei.cnt[e >> 3] = c; }
    before += t;
  }
  return ei;
}
template <int NN>
struct SchedX { ExpInfo2 ei; int xcd, lb, G8; const char* A; const char* W; const int* list; size_t wstride; int lda_b; int ldw_b;
  DEVI bool next(int i, Unit& u) const {
    const int tot = (ei.tiles[0] + ei.tiles[1] + ei.tiles[2] + ei.tiles[3]) * NN;
    const int n = i * G8 + lb; if (n >= tot) return false;
    int k = 0, m = n / NN; const int pn = n % NN;
    int tb = ei.base[0], ce = ei.cnt[0];
#pragma unroll
    for (int kk = 0; kk < 3; ++kk) { if (k == kk && m >= ei.tiles[kk]) { m -= ei.tiles[kk]; k = kk + 1; tb = ei.base[kk + 1]; ce = ei.cnt[kk + 1]; } }
    const int e = xcd + 8 * k;
    u.rows = list + (size_t)e * NTOK + m * 256; u.nvalid = ce - m * 256;
    u.A = A + (NN == 2 ? 0u : uoff((unsigned)(tb + m) * 256u * (unsigned)lda_b));
    u.B = W + uoff((unsigned)e * (unsigned)wstride + (unsigned)pn * 256u * (unsigned)ldw_b);
    u.u0 = (tb + m) * 256; u.u1 = pn; u.u2 = e; u.u3 = m; return true; } };
constexpr float U8_SCALE = 16.f;
struct EpiI1 { unsigned char* U;
  DEVI void init(f32x4 (&acc)[2][2][4][2], const Unit&, int, int, int, int) const { acc_zero(acc); }
  DEVI void operator()(const f32x4 (&acc)[2][2][4][2], const Unit& u, int wr, int wc, int fr, int fq) const {
#pragma unroll
    for (int ai = 0; ai < 2; ++ai)
#pragma unroll
      for (int m = 0; m < 4; ++m) {
        unsigned char* rowp = U + (size_t)(u.u0 + ai * HALF + wr * 64 + m * 16 + fr) * 256;
#pragma unroll
        for (int bj = 0; bj < 2; ++bj) {
          const int ff = 16 * (8 * u.u1 + 4 * bj + wc) + 4 * fq;
          const f32x4 g = acc[ai][bj][m][0], up = acc[ai][bj][m][1];
          float t[4];
#pragma unroll
          for (int j = 0; j < 4; ++j) t[j] = __builtin_amdgcn_fmed3f(g[j] * __builtin_amdgcn_rcpf(1.f + __builtin_amdgcn_exp2f(g[j] * -LOG2E)) * (up[j] * U8_SCALE), -448.f, 448.f);
          int o = __builtin_amdgcn_cvt_pk_fp8_f32(t[0], t[1], 0, false);
          o = __builtin_amdgcn_cvt_pk_fp8_f32(t[2], t[3], o, true);
          *(int*)(rowp + ff) = o;
        }
      }
  }
};
DEVI void phaseI1_2(KP p, ldsp_t lds) {
  const int xcd = BIDX & 7, lb = BIDX >> 3, G8 = gridDim.x >> 3;
  if (lb >= G8) return;
  SchedX<2> S{exp_info2(p, xcd), xcd, lb, G8, (const char*)wsp<u16>(p, OFF_H2), (const char*)wsp<u16>(p, OFF_W13), wsp<int>(p, OFF_LIST), (size_t)512 * 1024, 1024, 1024};
  EpiI1 E{wsp<unsigned char>(p, OFF_U)};
  int nt = 8; asm volatile("" : "+s"(nt));
  gemm_phase<false, true, true>(lds, 1024, 1024, nt, S, E);
}
constexpr float YS8_SCALE = 32.f;
struct EpiI2 { unsigned char* YS; const float* wlist; const int* list;
  DEVI void init(f32x4 (&acc)[2][2][4][2], const Unit&, int, int, int, int) const { acc_zero(acc); }
  DEVI void operator()(const f32x4 (&acc)[2][2][4][2], const Unit& u, int wr, int wc, int fr, int fq) const {
    const unsigned colb = (unsigned)(u.u1 * 256 + wc * 32 + 8 * fq);
    const float* we = wlist + (u.rows - list);
    unsigned dest[2][4]; float w[2][4];
#pragma unroll
    for (int ai = 0; ai < 2; ++ai)
#pragma unroll
      for (int m = 0; m < 4; ++m) {
        const int r = ai * HALF + wr * 64 + m * 16 + fr;
        dest[ai][m] = (r < u.nvalid) ? (unsigned)u.rows[r] : (unsigned)(2 * NTOK);
        w[ai][m] = we[r] * (YS8_SCALE / U8_SCALE);
      }
#pragma unroll
    for (int ai = 0; ai < 2; ++ai)
#pragma unroll
      for (int m = 0; m < 4; ++m) {
        unsigned char* rowp = YS + (dest[ai][m] * 1024u + colb);
#pragma unroll
        for (int bj = 0; bj < 2; ++bj) {
          u32x2 o;
#pragma unroll
          for (int nn = 0; nn < 2; ++nn) {
            const f32x4 v = acc[ai][bj][m][nn] * w[ai][m];
            int q = __builtin_amdgcn_cvt_pk_fp8_f32(__builtin_amdgcn_fmed3f(v[0], -448.f, 448.f), __builtin_amdgcn_fmed3f(v[1], -448.f, 448.f), 0, false);
            q = __builtin_amdgcn_cvt_pk_fp8_f32(__builtin_amdgcn_fmed3f(v[2], -448.f, 448.f), __builtin_amdgcn_fmed3f(v[3], -448.f, 448.f), q, true);
            o[nn] = (unsigned)q;
          }
          *(u32x2*)(rowp + bj * 128) = o;
        }
      }
  }
};
DEVI void phaseI2_2(KP p, ldsp_t lds) {
  const int xcd = BIDX & 7, lb = BIDX >> 3, G8 = gridDim.x >> 3;
  if (lb >= G8) return;
  SchedX<4> S{exp_info2(p, xcd), xcd, lb, G8, (const char*)wsp<u16>(p, OFF_U), (const char*)wsp<u16>(p, OFF_W2), wsp<int>(p, OFF_LIST), (size_t)1024 * 256, 256, 256};
  EpiI2 E{wsp<unsigned char>(p, OFF_YS), wsp<float>(p, OFF_WLIST), wsp<int>(p, OFF_LIST)};
  int nt = 2; asm volatile("" : "+s"(nt));
  gemm_phase<true, false, true>(lds, 256, 256, nt, S, E);
}
DEVI void phaseJ2(KP p, int l, ldsp_t lds) {
  const int lane = TIDX & 63;
  const int gw = BIDX * NW + (TIDX >> 6), nw = gridDim.x * NW;
  const unsigned char* YS = wsp<unsigned char>(p, OFF_YS);
  u16* H = wsp<u16>(p, OFF_H);
  const int ntot = (l == 1) ? 8 * SEQ : NTOK;
  const int per = (ntot + nw - 1) / nw;
  const int i0 = gw * per, i1 = min(i0 + per, ntot);
  int cur = -1; ModVec mv; f32x4 gtv[4];
  for (int ii = i0; ii < i1; ii += 2) {
    float xv[2][16]; int y0[2][4], y1[2][4]; bool ok[2]; int tk[2];
#pragma unroll
    for (int r = 0; r < 2; ++r) {
      const int idx = ii + r;
      const int tok = (l == 1) ? (idx / SEQ) * TPB + NCTX + idx % SEQ : idx;
      tk[r] = tok;
      ok[r] = idx < i1;
      if (ok[r]) {
        load_row16_bf<true>(wsp<u16>(p, OFF_XM) + (size_t)tok * 1024, xv[r]);
#pragma unroll
        for (int i = 0; i < 4; ++i) {
          const int c = i * 256 + lane * 4;
          y0[r][i] = *(const int*)(YS + (size_t)(tok * 2) * 1024 + c);
          y1[r][i] = *(const int*)(YS + (size_t)(tok * 2 + 1) * 1024 + c);
        }
      }
    }
#pragma unroll
    for (int r = 0; r < 2; ++r) {
      if (!ok[r]) continue;
      const int tok = tk[r];
      const int b = tok / TPB, rr = tok % TPB;
      const int mrow = (rr < NCTX) ? 8 : b;
      if (mrow != cur) {
        cur = mrow;
        const float* gt = wsp<float>(p, OFF_MOD) + ((size_t)l * 9 + mrow) * 6144 + 5120;
#pragma unroll
        for (int i = 0; i < 4; ++i) gtv[i] = *(const f32x4*)(gt + i * 256 + lane * 4);
        if (l == 0) load_modvec(p, 1, 0, mrow, mv);
      }
#pragma unroll
      for (int i = 0; i < 4; ++i) {
        const f32x4 g = gtv[i] * (1.f / YS8_SCALE);
        const f32x2 a0 = __builtin_amdgcn_cvt_pk_f32_fp8(y0[r][i], false), a1 = __builtin_amdgcn_cvt_pk_f32_fp8(y0[r][i], true);
        const f32x2 b0 = __builtin_amdgcn_cvt_pk_f32_fp8(y1[r][i], false), b1 = __builtin_amdgcn_cvt_pk_f32_fp8(y1[r][i], true);
        xv[r][i * 4 + 0] += g.x * (a0.x + b0.x);
        xv[r][i * 4 + 1] += g.y * (a0.y + b0.y);
        xv[r][i * 4 + 2] += g.z * (a1.x + b1.x);
        xv[r][i * 4 + 3] += g.w * (a1.y + b1.y);
      }
      if (l == 0) {
        u16* xr = (u16*)p->out + (size_t)tok * 1024;
#pragma unroll
        for (int i = 0; i < 4; ++i)
          *(u32x2*)(xr + i * 256 + lane * 4) = u32x2{pk2(xv[r][i * 4], xv[r][i * 4 + 1]), pk2(xv[r][i * 4 + 2], xv[r][i * 4 + 3])};
        float hv[16];
        modulate_row_store2<true, false>(mv, xv[r], nullptr, hv, h8base(p) + (size_t)tok * 1024);
      } else {
        float ss = 0.f;
#pragma unroll
        for (int i = 0; i < 16; ++i) ss += xv[r][i] * xv[r][i];
        ss = wave_sum(ss);
        const float rstd = rsqrtf(ss * (1.f / 1024.f) + EPS);
        float* xr = p->out + ((size_t)b * SEQ + rr - NCTX) * 1024;
#pragma unroll
        for (int i = 0; i < 4; ++i) {
          const int c = i * 256 + lane * 4;
          const f32x4 g = *(const f32x4*)(p->g_final + c);
          __builtin_nontemporal_store(f32x4{xv[r][i * 4] * rstd * g.x, xv[r][i * 4 + 1] * rstd * g.y, xv[r][i * 4 + 2] * rstd * g.z, xv[r][i * 4 + 3] * rstd * g.w}, (f32x4*)(xr + c));
        }
      }
    }
  }
}

constexpr int N_PHASES = 3 + 2 * 11;
__global__ void __launch_bounds__(512, 2) fwd_v2(Params parg) {
  extern __shared__ __attribute__((aligned(16))) unsigned char dyn_lds[];
  const ldsp_t lds = (ldsp_t)dyn_lds;
  cg::grid_group grid = cg::this_grid();
  volatile LAS unsigned* xb_st = (volatile LAS unsigned*)(lds + LDS_BARW);
  if (TIDX < 4) xb_st[TIDX] = 0u;
  __syncthreads();
  if (parg.ph_end - parg.ph_begin > 1) xcd_barrier_post((unsigned*)(parg.ws + OFF_BAR));
  for (int ph = parg.ph_begin; ph < parg.ph_end; ++ph) {
    KP p = (KP)__builtin_amdgcn_kernarg_segment_ptr();
    asm volatile("" : "+s"(p));
    const int l = (ph >= 14) ? 1 : 0;
    const int k = (ph < 3) ? ph : 3 + (ph - 3) % 11;
    const int reps = (((PROBE_DUP >> k) & 1) && (!(PROBE_DUP & 0x10000) || l == 0)) ? 2 : 1;
    for (int rep = 0; rep < reps; ++rep) {
      if (rep) {
        xcd_barrier((unsigned*)(p->ws + OFF_BAR), xb_st);
        if (k == 10) { if (BIDX == 0 && TIDX < 32) wsp<int>(p, OFF_CNT)[TIDX * CNT_STRIDE] = 0; xcd_barrier((unsigned*)(p->ws + OFF_BAR), xb_st); }
      }
      switch (k) {
        case 0: phase0_2(p, lds); break;
        case 1: phase1_2(p); break;
        case 2: phaseA2(p); break;
        case 3: phaseB2(p, lds); break;
        case 4: phaseC2(p, lds); break;
        case 5: phaseP2(p, l, lds); break;
        case 6: phaseD2(p, l, lds); break;
        case 7: phaseE1(p, l, lds); break;
        case 8: phaseE2(p, l, lds); break;
        case 9: phaseF2(p, l, lds); break;
        case 10: phaseG2(p, l, lds); break;
        case 11: phaseI1_2(p, lds); break;
        case 12: phaseI2_2(p, lds); break;
        default: phaseJ2(p, l, lds); break;
      }
    }
    if (k == 0 || (k == 13 && l == 0)) conv_items2(p, k == 0 ? 0 : 1, lds, 0, CONV_EARLY);
    if (ph + 1 < parg.ph_end && k != 9) {
      if (parg.ph_begin >= 1000) grid.sync();
      else xcd_barrier((unsigned*)(p->ws + OFF_BAR), xb_st);
    }
  }
}
}

extern "C" void kernel_launch(void* const* d_in, const int* in_sizes, int n_in, void* d_out, int out_size,
                              void* d_ws, size_t ws_size, hipStream_t stream) {
  static int grid2 = 0;
  if (!grid2) {
    int dev = 0, cus = 0, per_cu = 0;
    (void)hipGetDevice(&dev);
    (void)hipDeviceGetAttribute(&cus, hipDeviceAttributeMultiprocessorCount, dev);
    (void)hipFuncSetAttribute((const void*)v2::fwd_v2, hipFuncAttributeMaxDynamicSharedMemorySize, v2::LDS_TOTAL);
    (void)hipOccupancyMaxActiveBlocksPerMultiprocessor(&per_cu, v2::fwd_v2, 512, v2::LDS_TOTAL);
    if (per_cu < 1) { fprintf(stderr, "kernel does not fit on a CU\n"); per_cu = 1; }
    grid2 = cus & ~7;
  }
  if (ws_size < WS_NEEDED) { fprintf(stderr, "workspace too small: %zu < %zu\n", ws_size, (size_t)WS_NEEDED); return; }
  Params hp{};
  const float** f = (const float**)&hp;
  for (int i = 0; i < 29; ++i) f[i] = (const float*)d_in[i];
  hp.out = (float*)d_out;
  hp.ws = (char*)d_ws;
#if N_LAUNCH_MODE == 1
  for (int ph = 0; ph < v2::N_PHASES; ++ph) {
    hp.ph_begin = ph; hp.ph_end = ph + 1;
    void* args[] = {&hp};
    hipError_t e = hipLaunchCooperativeKernel((void*)v2::fwd_v2, dim3(grid2), dim3(512), args, v2::LDS_TOTAL, stream);
    if (e != hipSuccess) fprintf(stderr, "launch failed: %s\n", hipGetErrorString(e));
  }
#else
  hp.ph_begin = 0; hp.ph_end = v2::N_PHASES;
  (void)hipMemsetAsync((char*)d_ws + OFF_BAR, 0, (size_t)(OFF_DEP - OFF_BAR) + (size_t)DEP_WORDS * 4, stream);
  void* args[] = {&hp};
  hipError_t e = hipLaunchCooperativeKernel((void*)v2::fwd_v2, dim3(grid2), dim3(512), args, v2::LDS_TOTAL, stream);
  if (e != hipSuccess) fprintf(stderr, "cooperative launch failed: %s (grid %d)\n", hipGetErrorString(e), grid2);
#endif
}
```

```cpp
#include <hip/hip_runtime.h>
#include <hip/hip_cooperative_groups.h>
#include <stdint.h>
#include <stdio.h>
namespace cg = cooperative_groups;

#ifndef N_LAUNCH_MODE
#define N_LAUNCH_MODE 0
#endif

#ifndef PROBE_DUP
#define PROBE_DUP 0
#endif
#define DEVI __device__ __forceinline__
typedef unsigned short u16;
typedef __attribute__((ext_vector_type(2))) float f32x2;
typedef __attribute__((ext_vector_type(2))) __bf16 bf16x2_t;
typedef __attribute__((ext_vector_type(8))) short bf16x8;
typedef __attribute__((ext_vector_type(16))) float f32x16;
typedef __attribute__((ext_vector_type(4))) unsigned u32x4;
typedef __attribute__((ext_vector_type(2))) unsigned u32x2;
typedef __attribute__((ext_vector_type(4))) float f32x4;
#define MFMA(a, b, c) __builtin_amdgcn_mfma_f32_32x32x16_bf16((a), (b), (c), 0, 0, 0)

constexpr int DMODEL = 1024, NBATCH = 8, SEQ = 4096, NCTX = 256;
constexpr int TPB = SEQ + NCTX;
constexpr int NTOK = NBATCH * TPB;
constexpr int MT_PER_B = TPB / 128;
constexpr int NEXP = 32;
constexpr int INP = 2304;
constexpr float EPS = 1e-6f;
constexpr float LOG2E = 1.4426950408889634f;
constexpr int SMEM_BYTES = 73728;
constexpr int UROWS = 2 * NTOK + NEXP * 256;

constexpr size_t al(size_t x) { return (x + 255) & ~(size_t)255; }
constexpr size_t OFF_WIN = 0;
constexpr size_t OFF_WQB = OFF_WIN + al((size_t)INP * 1024 * 2);
constexpr size_t OFF_WKVB = OFF_WQB + al((size_t)512 * 256 * 2);
constexpr size_t OFF_WGATE = OFF_WKVB + al((size_t)512 * 256 * 2);
constexpr size_t OFF_WBR = OFF_WGATE + al((size_t)4 * 1024 * 1024 * 2);
constexpr size_t OFF_WOUT = OFF_WBR + al((size_t)4 * 1024 * 256 * 2);
constexpr size_t OFF_W13 = OFF_WOUT + al((size_t)1024 * 1024 * 2);
constexpr size_t OFF_W2 = OFF_W13 + al((size_t)32 * 512 * 1024 * 2);
constexpr size_t OFF_MODP = OFF_W2 + al((size_t)32 * 1024 * 256 * 2);
constexpr size_t OFF_MOD = OFF_MODP + al((size_t)8 * 2 * 9 * 6144 * 4);
constexpr size_t OFF_CS32 = OFF_MOD + al((size_t)2 * 9 * 6144 * 4);
constexpr size_t OFF_CS16 = OFF_CS32 + al((size_t)64 * 16 * 2 * 4);
constexpr size_t OFF_WRT = OFF_CS16 + al((size_t)64 * 8 * 2 * 4);
constexpr size_t OFF_CNT = OFF_WRT + al((size_t)2 * 36 * 1024 * 4);
constexpr int CNT_STRIDE = 64;
constexpr size_t OFF_BAR = OFF_CNT + al(32 * CNT_STRIDE * 4);
constexpr int XCD_BAR_WORDS = 3456;
constexpr size_t OFF_CTXRES = OFF_BAR + al((size_t)XCD_BAR_WORDS * 4);
constexpr size_t OFF_DEP = OFF_CTXRES;
constexpr int DEP_STRIDE = 16, DEP_TILECTR = 2 * 136 * DEP_STRIDE, DEP_WORDS = DEP_TILECTR + 2 * DEP_STRIDE;
constexpr size_t OFF_H = OFF_CTXRES + al((size_t)8 * 256 * 1024 * 4);
constexpr size_t OFF_O = OFF_H + al((size_t)NTOK * 1024 * 2);
constexpr size_t OFF_SSQ = OFF_O + al((size_t)NTOK * 1024 * 2);
constexpr size_t OFF_LIST = OFF_SSQ + al((size_t)NTOK * 8 * 4);
constexpr size_t OFF_WLIST = OFF_LIST + al((size_t)32 * NTOK * 4);
constexpr size_t OFF_R1 = OFF_WLIST + al((size_t)32 * NTOK * 4);
constexpr int PLD = INP;
constexpr size_t OFF_PRAW = OFF_R1;
constexpr size_t OFF_QARAW = OFF_PRAW + (size_t)NTOK * INP * 2;
constexpr size_t OFF_KVARAW = OFF_QARAW + (size_t)NTOK * 512 * 2;
constexpr size_t OFF_VAT = OFF_KVARAW + (size_t)NTOK * 512 * 2;
constexpr size_t OFF_VBT = OFF_VAT + (size_t)NTOK * 256 * 2;
constexpr size_t OFF_VCT = OFF_VBT + (size_t)NTOK * 128 * 2;
constexpr size_t OFF_VDT = OFF_VCT + (size_t)NTOK * 256 * 2;
constexpr size_t OFF_END = OFF_VDT + (size_t)NTOK * 128 * 2;
constexpr size_t OFF_Z = OFF_R1;
constexpr size_t OFF_Y8 = OFF_H;
constexpr size_t OFF_H2 = OFF_O;
constexpr size_t OFF_YPRE = OFF_O;
constexpr size_t OFF_U = OFF_R1;
constexpr size_t OFF_YS = OFF_R1 + al((size_t)UROWS * 256 * 2);
constexpr size_t OFF_XM = OFF_YS + al((size_t)(2 * NTOK + 1) * 1024 * 2);
static_assert(OFF_XM + (size_t)NTOK * 1024 * 2 <= OFF_END, "alias overflow");
static_assert(OFF_Z + (size_t)NTOK * 4096 * 2 <= OFF_END, "alias overflow");
static_assert(OFF_YS + (size_t)(2 * NTOK + 1) * 1024 * 2 <= OFF_END, "alias overflow");
constexpr size_t WS_NEEDED = OFF_END;
static_assert(WS_NEEDED <= (size_t)536870912, "workspace budget (4 x largest tensor)");

struct Params {
  const float *x, *c, *ctx, *c_ctx, *w_mod, *b_mod, *g_norm_mix, *w_in, *g_q_a, *w_q_b, *g_kv_a, *w_kv_b,
      *sink_b, *rpb_c, *g_q_d, *g_k_d, *w_gate, *b_gate, *w_branch, *w_out, *g_norm_ffn, *w_group, *b_group,
      *w_router, *b_router, *w_ff1, *w_ff3, *w_ff2, *g_final;
  float* out;
  char* ws;
  int ph_begin, ph_end;
};

DEVI int tid_fresh() { int t; asm volatile("v_mov_b32 %0, %1" : "=v"(t) : "v"(__builtin_amdgcn_workitem_id_x())); return t; }
DEVI int bid_fresh() { int t; asm volatile("s_mov_b32 %0, %1" : "=s"(t) : "s"(__builtin_amdgcn_workgroup_id_x())); return t; }
#define TIDX tid_fresh()
#define BIDX bid_fresh()
typedef const __attribute__((address_space(4))) Params* KP;
DEVI unsigned pk2(float a, float b) { f32x2 v = {a, b}; bf16x2_t r = __builtin_convertvector(v, bf16x2_t); return __builtin_bit_cast(unsigned, r); }
DEVI u16 f2bf(float a) { return (u16)(pk2(a, 0.f) & 0xffffu); }
DEVI float bf2f(u16 v) { return __uint_as_float(((unsigned)v) << 16); }
DEVI float wave_sum(float v) {
#pragma unroll
  for (int m = 32; m >= 1; m >>= 1) v += __shfl_xor(v, m);
  return v;
}
template <class T> DEVI T* wsp(KP p, size_t off) { return (T*)(p->ws + off); }
DEVI const float* xrow_in(KP p, int l, int b, int rr) {
  if (l == 0) return (rr < NCTX) ? p->ctx + ((size_t)b * NCTX + rr) * 1024 : p->x + ((size_t)b * SEQ + rr - NCTX) * 1024;
  return (rr < NCTX) ? wsp<float>(p, OFF_CTXRES) + ((size_t)b * NCTX + rr) * 1024 : p->out + ((size_t)b * SEQ + rr - NCTX) * 1024;
}
DEVI float* xrow_res(KP p, int b, int rr) {
  return (rr < NCTX) ? wsp<float>(p, OFF_CTXRES) + ((size_t)b * NCTX + rr) * 1024 : p->out + ((size_t)b * SEQ + rr - NCTX) * 1024;
}
DEVI int perm16(int k) { return (k & ~12) | ((k & 4) << 1) | ((k & 8) >> 1); }

struct ConvT { const float* src; const float* src2; const float* ks; u16* dst; int ld; int ldd; float mul; };
constexpr float Z8_SCALE = 16.f, O8_SCALE = 32.f;
constexpr float F8_WSCALE = 64.f, GATE_WSCALE = F8_WSCALE;
constexpr int CONV_ITEMS = 1152 + 64 + 64 + 2048 + 512 + 512 + 8192 + 4096;
DEVI ConvT conv_decode(KP p, int l, int idx) {
  ConvT c; c.ks = nullptr; c.mul = 1.f; c.src2 = nullptr;
  if (idx < 1152) {
    int nt = idx >> 4, kt = idx & 15, n0 = nt * 32;
    int sc = (n0 < 416) ? n0 : ((n0 < 512) ? -1 : n0 - 96);
    c.ld = 2208; c.ldd = -1024;
    c.mul = F8_WSCALE;
    if ((n0 >= 512 && n0 < 768) || (n0 >= 1024 && n0 < 1280)) c.mul = 0.125f * LOG2E * F8_WSCALE;
    c.src = (sc < 0) ? nullptr : p->w_in + (size_t)l * 1024 * 2208 + (size_t)kt * 64 * 2208 + sc;
    c.dst = (u16*)(p->ws + OFF_WIN + (size_t)n0 * 1024 + kt * 64);
    return c;
  }
  idx -= 1152;
  if (idx < 64) {
    int nt = idx >> 2, kt = idx & 3;
    c.ld = 384; c.ldd = 256; c.ks = p->g_q_a + l * 256 + kt * 64;
    c.src = (nt >= 12) ? nullptr : p->w_q_b + (size_t)l * 256 * 384 + (size_t)kt * 64 * 384 + nt * 32;
    c.dst = wsp<u16>(p, OFF_WQB) + (size_t)nt * 32 * 256 + kt * 64;
    return c;
  }
  idx -= 64;
  if (idx < 64) {
    int nt = idx >> 2, kt = idx & 3;
    c.ld = 512; c.ldd = 256; c.ks = (kt < 2) ? p->g_kv_a + l * 128 + kt * 64 : nullptr;
    c.src = (kt >= 2) ? nullptr : p->w_kv_b + (size_t)l * 128 * 512 + (size_t)kt * 64 * 512 + nt * 32;
    c.dst = wsp<u16>(p, OFF_WKVB) + (size_t)nt * 32 * 256 + kt * 64;
    return c;
  }
  idx -= 64;
  if (idx < 2048) {
    int nt = idx >> 4, kt = idx & 15, R0 = nt * 32;
    int pr = R0 >> 11, cb = (R0 & 2047) >> 8, bj = (R0 & 255) >> 7, j0 = R0 & 127;
    c.ld = 1024; c.ldd = -1024; c.mul = -LOG2E * F8_WSCALE;
    c.src = p->w_gate + ((size_t)(l * 4 + 2 * pr + bj) * 1024 + kt * 64) * 1024 + cb * 128 + j0;
    c.dst = (u16*)(p->ws + OFF_WGATE + (size_t)R0 * 1024 + kt * 64);
    return c;
  }
  idx -= 2048;
  if (idx < 512) {
    int br = idx >> 7, nt = (idx >> 2) & 31, kt = idx & 3;
    c.ld = 1024; c.ldd = -256; c.mul = F8_WSCALE * (Z8_SCALE / O8_SCALE);
    c.src = p->w_branch + ((size_t)(l * 4 + br) * 256 + kt * 64) * 1024 + nt * 32;
    c.dst = (u16*)(p->ws + OFF_WBR + ((size_t)br * 1024 + nt * 32) * 256 + kt * 64);
    return c;
  }
  idx -= 512;
  if (idx < 512) {
    int nt = idx >> 4, kt = idx & 15;
    c.ld = 1024; c.ldd = -1024; c.mul = F8_WSCALE;
    c.src = p->w_out + ((size_t)l * 1024 + kt * 64) * 1024 + nt * 32;
    c.dst = (u16*)(p->ws + OFF_WOUT + (size_t)nt * 32 * 1024 + kt * 64);
    return c;
  }
  idx -= 512;
  if (idx < 8192) {
    int e = idx >> 8, g32 = (idx >> 4) & 15, kt = idx & 15;
    c.ld = 256; c.ldd = -1024; c.mul = F8_WSCALE;
    c.src = p->w_ff1 + ((size_t)(l * 32 + e) * 1024 + kt * 64) * 256 + g32 * 16;
    c.src2 = p->w_ff3 + ((size_t)(l * 32 + e) * 1024 + kt * 64) * 256 + g32 * 16;
    c.dst = (u16*)(p->ws + OFF_W13 + ((size_t)e * 512 + g32 * 32) * 1024 + kt * 64);
    return c;
  }
  idx -= 8192;
  {
    int e = idx >> 7, nt = (idx >> 2) & 31, kt = idx & 3;
    c.ld = 1024; c.ldd = -256; c.mul = F8_WSCALE;
    c.src = p->w_ff2 + ((size_t)(l * 32 + e) * 256 + kt * 64) * 1024 + nt * 32;
    c.dst = (u16*)(p->ws + OFF_W2 + ((size_t)e * 1024 + nt * 32) * 256 + kt * 64);
    return c;
  }
}
DEVI void modulate_row_store(KP p, int l, int which, const float (&xv)[16], int mrow, u16* hrow, float (&hv)[16]) {
  const int lane = TIDX & 63;
  float ss = 0.f;
#pragma unroll
  for (int i = 0; i < 16; ++i) ss += xv[i] * xv[i];
  ss = wave_sum(ss);
  const float rstd = rsqrtf(ss * (1.f / 1024.f) + EPS);
  const float* g = (which ? p->g_norm_ffn : p->g_norm_mix) + l * 1024;
  const float* mod = wsp<float>(p, OFF_MOD) + ((size_t)l * 9 + mrow) * 6144 + (which ? 3072 : 0);
#pragma unroll
  for (int i = 0; i < 4; ++i) {
    const int c = i * 256 + lane * 4;
    f32x4 gv = *(const f32x4*)(g + c);
    f32x4 sh = *(const f32x4*)(mod + c);
    f32x4 sc = *(const f32x4*)(mod + 1024 + c);
    hv[i * 4 + 0] = xv[i * 4 + 0] * rstd * gv.x * (1.f + sc.x) + sh.x;
    hv[i * 4 + 1] = xv[i * 4 + 1] * rstd * gv.y * (1.f + sc.y) + sh.y;
    hv[i * 4 + 2] = xv[i * 4 + 2] * rstd * gv.z * (1.f + sc.z) + sh.z;
    hv[i * 4 + 3] = xv[i * 4 + 3] * rstd * gv.w * (1.f + sc.w) + sh.w;
    u32x2 o; o.x = pk2(hv[i * 4 + 0], hv[i * 4 + 1]); o.y = pk2(hv[i * 4 + 2], hv[i * 4 + 3]);
    *(u32x2*)(hrow + c) = o;
  }
}
struct ModVec { f32x4 a[4], b[4]; };
DEVI void load_modvec(KP p, int l, int which, int mrow, ModVec& mv) {
  const int lane = TIDX & 63;
  const float* g = (which ? p->g_norm_ffn : p->g_norm_mix) + l * 1024;
  const float* mod = wsp<float>(p, OFF_MOD) + ((size_t)l * 9 + mrow) * 6144 + (which ? 3072 : 0);
#pragma unroll
  for (int i = 0; i < 4; ++i) {
    const int c = i * 256 + lane * 4;
    const f32x4 gv = *(const f32x4*)(g + c), sh = *(const f32x4*)(mod + c), sc = *(const f32x4*)(mod + 1024 + c);
    mv.a[i] = gv * (1.f + sc); mv.b[i] = sh;
  }
}
DEVI unsigned char* h8base(KP p) { return (unsigned char*)p->out + (size_t)NTOK * 2048; }
template <bool F8COPY = false, bool BF16 = true>
DEVI void modulate_row_store2(const ModVec& mv, const float (&xv)[16], u16* hrow, float (&hv)[16], unsigned char* h8row = nullptr) {
  const int lane = TIDX & 63;
  float ss = 0.f;
#pragma unroll
  for (int i = 0; i < 16; ++i) ss += xv[i] * xv[i];
  ss = wave_sum(ss);
  const float rstd = rsqrtf(ss * (1.f / 1024.f) + EPS);
#pragma unroll
  for (int i = 0; i < 4; ++i) {
    const int c = i * 256 + lane * 4;
#pragma unroll
    for (int j = 0; j < 4; ++j) hv[i * 4 + j] = xv[i * 4 + j] * rstd * mv.a[i][j] + mv.b[i][j];
    if (BF16) { u32x2 o; o.x = pk2(hv[i * 4 + 0], hv[i * 4 + 1]); o.y = pk2(hv[i * 4 + 2], hv[i * 4 + 3]);
      *(u32x2*)(hrow + c) = o; }
    if (F8COPY) {
      float q[4];
#pragma unroll
      for (int j = 0; j < 4; ++j) q[j] = __builtin_amdgcn_fmed3f(hv[i * 4 + j], -448.f, 448.f);
      int v = __builtin_amdgcn_cvt_pk_fp8_f32(q[0], q[1], 0, false);
      v = __builtin_amdgcn_cvt_pk_fp8_f32(q[2], q[3], v, true);
      *(int*)(h8row + c) = v;
    }
  }
}
DEVI void load_row16(const float* xr, float (&xv)[16]) {
  const int lane = TIDX & 63;
#pragma unroll
  for (int i = 0; i < 4; ++i) {
    f32x4 v = __builtin_nontemporal_load((const f32x4*)(xr + i * 256 + lane * 4));
    xv[i * 4 + 0] = v.x; xv[i * 4 + 1] = v.y; xv[i * 4 + 2] = v.z; xv[i * 4 + 3] = v.w;
  }
}
template <bool NT = false>
DEVI void load_row16_bf(const u16* xr, float (&xv)[16]) {
  const int lane = TIDX & 63;
#pragma unroll
  for (int i = 0; i < 4; ++i) {
    const u32x2 v = NT ? __builtin_nontemporal_load((const u32x2*)(xr + i * 256 + lane * 4)) : *(const u32x2*)(xr + i * 256 + lane * 4);
    xv[i * 4 + 0] = __uint_as_float(v.x << 16); xv[i * 4 + 1] = __uint_as_float(v.x & 0xffff0000u);
    xv[i * 4 + 2] = __uint_as_float(v.y << 16); xv[i * 4 + 3] = __uint_as_float(v.y & 0xffff0000u);
  }
}
DEVI float router_dot(const float (&hv)[4][16], const float* wrow) {
  const int lane = TIDX & 63;
  const float* w = wrow + lane * 4;
  float pr[4] = {0.f, 0.f, 0.f, 0.f};
#pragma unroll
  for (int i = 0; i < 4; ++i) {
    const f32x4 wv = *(const f32x4*)(w + i * 256);
#pragma unroll
    for (int r = 0; r < 4; ++r)
      pr[r] += hv[r][i * 4] * wv.x + hv[r][i * 4 + 1] * wv.y + hv[r][i * 4 + 2] * wv.z + hv[r][i * 4 + 3] * wv.w;
  }
  const bool up = (lane & 32) != 0;
  float s0 = up ? pr[0] : pr[2], s1 = up ? pr[1] : pr[3];
  float k0 = up ? pr[2] : pr[0], k1 = up ? pr[3] : pr[1];
  k0 += __shfl_xor(s0, 32); k1 += __shfl_xor(s1, 32);
  const bool up2 = (lane & 16) != 0;
  float sv = up2 ? k0 : k1, kv = up2 ? k1 : k0;
  kv += __shfl_xor(sv, 16);
  kv += __shfl_xor(kv, 8); kv += __shfl_xor(kv, 4); kv += __shfl_xor(kv, 2); kv += __shfl_xor(kv, 1);
  return kv;
}
#define XB_TMO      128
#define XB_XCNT(j)  (256  + 64 * (j))
#define XB_XSUB(j)  (1280 + 64 * (j))
#define XB_XGEN(j)  (2304 + 64 * (j))
#define XB_TOP      3328
#define XB_TOPGEN   3392
#define XB_SPIN_CAP (1u << 20)
#define LAS __attribute__((address_space(3)))
DEVI unsigned xb_ld(unsigned* p) { return __hip_atomic_load(p, __ATOMIC_RELAXED, __HIP_MEMORY_SCOPE_AGENT); }
DEVI unsigned xb_add(unsigned* p, unsigned v) { return __hip_atomic_fetch_add(p, v, __ATOMIC_RELAXED, __HIP_MEMORY_SCOPE_AGENT); }
DEVI unsigned xb_xcc_id() { return (unsigned)__builtin_amdgcn_s_getreg((3 << 11) | 20) & 0xFu; }
#define XB_SPIN(cond, bar) do { unsigned _sp = 0; while (cond) { __builtin_amdgcn_s_sleep(1); \
    if ((++_sp & 255u) == 0u) { if (xb_ld(&(bar)[XB_TMO])) break; if (_sp > XB_SPIN_CAP) { atomicAdd(&(bar)[XB_TMO], 1u); break; } } } } while (0)
DEVI void xcd_barrier_post(unsigned* bar) {
  if (TIDX == 0) (void)xb_add(&bar[XB_XCNT(xb_xcc_id())], 1u);
}
DEVI void xcd_barrier_complete(unsigned* bar, unsigned x, unsigned& nloc, unsigned& nx) {
  const unsigned G = gridDim.x * gridDim.y * gridDim.z;
  unsigned sum, cnt, mine, sp = 0u;
  for (;;) {
    sum = 0u; cnt = 0u; mine = 0u;
#pragma unroll
    for (unsigned j = 0; j < 16; ++j) { const unsigned c = xb_ld(&bar[XB_XCNT(j)]); sum += c; cnt += (c > 0u) ? 1u : 0u; mine = (j == x) ? c : mine; }
    if (sum == G) break;
    __builtin_amdgcn_s_sleep(1);
    if ((++sp & 255u) == 0u) { if (xb_ld(&bar[XB_TMO])) break; if (sp > XB_SPIN_CAP) { atomicAdd(&bar[XB_TMO], 1u); break; } }
  }
  nloc = mine > 0u ? mine : 1u; nx = cnt > 0u ? cnt : 1u;
}
DEVI void xcd_barrier(unsigned* bar, volatile LAS unsigned* st) {
  asm volatile("s_waitcnt vmcnt(0)" ::: "memory");
  __syncthreads();
  if (TIDX == 0) {
    const unsigned x = xb_xcc_id();
    __builtin_amdgcn_s_waitcnt(0);
    unsigned nloc = st[0], nx = st[1];
    if (nloc == 0u) { xcd_barrier_complete(bar, x, nloc, nx); st[0] = nloc; st[1] = nx; }
    const unsigned old = xb_add(&bar[XB_XSUB(x)], 1u);
    const unsigned gen = old / nloc;
    if (old + 1u == (gen + 1u) * nloc) {
      __builtin_amdgcn_fence(__ATOMIC_RELEASE, "agent");
      asm volatile("s_waitcnt vmcnt(0)" ::: "memory");
      const unsigned og = xb_add(&bar[XB_TOP], 1u);
      const unsigned tg = og / nx;
      if (og + 1u == (tg + 1u) * nx) xb_add(&bar[XB_TOPGEN], 1u);
      else XB_SPIN(xb_ld(&bar[XB_TOPGEN]) == tg, bar);
      __builtin_amdgcn_fence(__ATOMIC_ACQUIRE, "agent");
      xb_add(&bar[XB_XGEN(x)], 1u);
      asm volatile("s_waitcnt vmcnt(0)" ::: "memory");
    } else {
      XB_SPIN(xb_ld(&bar[XB_XGEN(x)]) == gen, bar);
      __builtin_amdgcn_fence(__ATOMIC_ACQUIRE, "agent");
      asm volatile("s_waitcnt vmcnt(0)" ::: "memory");
    }
  }
  __syncthreads();
}

namespace v2 {
typedef LAS unsigned char* ldsp_t;
constexpr int BM = 256, BK = 64, HALF = 128, HTB = HALF * BK * 2, STAGE_BYTES = 8 * HTB;
constexpr int NW = 8;
constexpr int LDS_XTRA = STAGE_BYTES;
constexpr int LDS_BARW = STAGE_BYTES + 16384;
constexpr int LDS_TOTAL = LDS_BARW + 16;

DEVI int lds_byte(int r, int c) { const int st = (r >> 4) * 2 + (c >> 5), rr = r & 15, cc = c & 31, ob = rr * 64 + cc * 2; return st * 1024 + (ob ^ (((ob >> 9) & 1) << 5)); }
DEVI void stage_rc(int b, int& R, int& C) { const int st = b / 1024, sb = b % 1024, swz = sb ^ (((sb >> 9) & 1) << 5); R = (st >> 1) * 16 + swz / 64; C = (st & 1) * 32 + (swz % 64) / 2; }
DEVI int perm32(int rho) { const int n = rho >> 4, i = rho & 15; return 8 * (i >> 2) + 4 * n + (i & 3); }

DEVI void acc_zero(f32x4 (&acc)[2][2][4][2]) {
#pragma unroll
  for (int a = 0; a < 2; ++a)
#pragma unroll
    for (int b = 0; b < 2; ++b)
#pragma unroll
      for (int m = 0; m < 4; ++m)
#pragma unroll
        for (int n = 0; n < 2; ++n) acc[a][b][m][n] = (f32x4){0.f, 0.f, 0.f, 0.f};
}
struct Unit { const char* A; const char* B; const int* rows; int nvalid; int u0, u1, u2, u3; };

typedef int i32x8 __attribute__((ext_vector_type(8)));
typedef int i32x4v __attribute__((ext_vector_type(4)));
DEVI i32x8 cat8(bf16x8 lo, bf16x8 hi) { return __builtin_shufflevector(__builtin_bit_cast(i32x4v, lo), __builtin_bit_cast(i32x4v, hi), 0, 1, 2, 3, 4, 5, 6, 7); }
DEVI const char* sptr(const char* p) {
  const unsigned long long v = (unsigned long long)p;
  const unsigned lo = (unsigned)__builtin_amdgcn_readfirstlane((int)(unsigned)v), hi = (unsigned)__builtin_amdgcn_readfirstlane((int)(unsigned)(v >> 32));
  return (const char*)(((unsigned long long)hi << 32) | lo);
}
template <bool PERM, bool GATHER, bool F8, class Epi, class Sched>
DEVI void gemm_phase(ldsp_t lds, int lda_b, int ldb_b, int nt, const Sched& S, const Epi& E) {
  const int tid = TIDX, wid = __builtin_amdgcn_readfirstlane(tid >> 6), lane = tid & 63, wr = wid >> 2, wc = wid & 3, fr = lane & 15, fq = lane >> 4;
  unsigned voffA[2], voffB[2]; int RA[2], CA2[2];
#pragma unroll
  for (int i = 0; i < 2; ++i) {
    int R, C; stage_rc(tid * 16 + i * 8192, R, C);
    const int Rb = PERM ? ((R & ~31) + perm32(R & 31)) : R;
    RA[i] = R; CA2[i] = C * 2;
    voffA[i] = (unsigned)(R * lda_b + C * 2); voffB[i] = (unsigned)(Rb * ldb_b + C * 2);
  }
  const size_t kstep = (size_t)(BK * 2);
  const size_t hstepA = (size_t)HALF * lda_b, hstepB = (size_t)HALF * ldb_b;
  const unsigned ldsw = (unsigned)wid * 1024u, ldsbase = (unsigned)(size_t)lds;
  const int aoff = lds_byte(wr * 64 + fr, fq * 8), boff = lds_byte(wc * 32 + fr, fq * 8);
#define G_SA(b, h) (((b) * 2 + (h)) * HTB)
#define G_SB(b, h) ((4 + (b) * 2 + (h)) * HTB)
#define G_DMA(sbase, voff, ldsaddr) asm volatile("s_mov_b32 m0, %2\n\ts_nop 0\n\tglobal_load_lds_dwordx4 %0, %1" :: "v"(voff), "s"(sbase), "s"(ldsaddr) : "memory", "m0")
#define G_STAGE(bufoff, gbase, voff) do { const char* sb_ = sptr((const char*)(gbase)); _Pragma("unroll") for (int _i = 0; _i < 2; ++_i) \
    G_DMA(sb_, (voff)[_i], (unsigned)__builtin_amdgcn_readfirstlane((int)(ldsbase + (unsigned)(bufoff) + ldsw + (unsigned)_i * 8192u))); } while (0)
#define G_STAGE_A(bufoff, abase, go, h, koff) do { if (GATHER) { const char* sb_ = sptr((const char*)(abase) + (koff)); _Pragma("unroll") for (int _i = 0; _i < 2; ++_i) \
    G_DMA(sb_, (go)[h][_i], (unsigned)__builtin_amdgcn_readfirstlane((int)(ldsbase + (unsigned)(bufoff) + ldsw + (unsigned)_i * 8192u))); } \
    else G_STAGE(bufoff, (abase) + (h) * hstepA + (koff), voffA); } while (0)
#define G_LDA(dst, b, h) do { _Pragma("unroll") for (int m = 0; m < 4; ++m) { if (F8) dst##8[m] = cat8(*(const LAS bf16x8*)(lds + G_SA(b, h) + aoff + m * 2048), *(const LAS bf16x8*)(lds + G_SA(b, h) + aoff + m * 2048 + 1024)); \
    else { _Pragma("unroll") for (int k = 0; k < 2; ++k) dst[m][k] = *(const LAS bf16x8*)(lds + G_SA(b, h) + aoff + m * 2048 + k * 1024); } } } while (0)
#define G_LDB(dst, b, h) do { _Pragma("unroll") for (int n = 0; n < 2; ++n) { if (F8) dst##8[n] = cat8(*(const LAS bf16x8*)(lds + G_SB(b, h) + boff + n * 2048), *(const LAS bf16x8*)(lds + G_SB(b, h) + boff + n * 2048 + 1024)); \
    else { _Pragma("unroll") for (int k = 0; k < 2; ++k) dst[n][k] = *(const LAS bf16x8*)(lds + G_SB(b, h) + boff + n * 2048 + k * 1024); } } } while (0)
#define G_MMA(ai, bj, At, Bt) do { __builtin_amdgcn_s_setprio(1); _Pragma("unroll") for (int m = 0; m < 4; ++m) _Pragma("unroll") for (int n = 0; n < 2; ++n) { \
    if (F8) asm("v_mfma_scale_f32_16x16x128_f8f6f4 %0, %1, %2, %0, %3, %4 op_sel_hi:[0,0,0]" : "+v"(acc[ai][bj][m][n]) : "v"(Bt##8[n]), "v"(At##8[m]), "v"(f8wscale), "v"(f8ascale)); \
    else { _Pragma("unroll") for (int k = 0; k < 2; ++k) acc[ai][bj][m][n] = __builtin_amdgcn_mfma_f32_16x16x32_bf16(Bt[n][k], At[m][k], acc[ai][bj][m][n], 0, 0, 0); } } \
    __builtin_amdgcn_s_setprio(0); } while (0)
#define G_WAIT_V(n) asm volatile("s_waitcnt vmcnt(" #n ")" ::: "memory")
#define G_WAIT_L(n) asm volatile("s_waitcnt lgkmcnt(" #n ")" ::: "memory")
#define G_BAR __builtin_amdgcn_s_barrier()
#define G_SCHED __builtin_amdgcn_sched_barrier(0)
  Unit cur, nxt; int ui = 0;
  if (!S.next(0, cur)) return;
  f32x4 acc[2][2][4][2];
  E.init(acc, cur, wr, wc, fr, fq);
  bf16x8 At[4][2], B0[2][2], B1[2][2];
  i32x8 At8[4], B08[2], B18[2];
  const int f8wscale = 0x79797979, f8ascale = 0x7f7f7f7f;
  unsigned gcur[2][2];
  auto gather_offs = [&](const Unit& u, unsigned (&go)[2][2]) {
#pragma unroll
    for (int h = 0; h < 2; ++h)
#pragma unroll
      for (int i = 0; i < 2; ++i) {
        const int r = h * HALF + RA[i];
        const int t = (r < u.nvalid) ? (u.rows[r] >> 1) : 0;
        go[h][i] = (unsigned)t * (unsigned)lda_b + (unsigned)CA2[i];
      }
  };
  if (GATHER) gather_offs(cur, gcur);
  const char* cA = cur.A; const char* cB = cur.B;
  G_STAGE(G_SB(0, 0), cB, voffB); G_STAGE_A(G_SA(0, 0), cA, gcur, 0, 0); G_STAGE(G_SB(0, 1), cB + hstepB, voffB); G_STAGE_A(G_SA(0, 1), cA, gcur, 1, 0);
  if (wr == 1) G_BAR;
  G_WAIT_V(4); G_BAR;
  G_STAGE(G_SB(1, 0), cB + kstep, voffB); G_STAGE_A(G_SA(1, 0), cA, gcur, 0, kstep); G_STAGE(G_SB(1, 1), cB + hstepB + kstep, voffB);
  G_WAIT_V(6); G_BAR;
  for (;;) {
    const bool has_next = S.next(ui + 1, nxt);
    const char* nA = has_next ? nxt.A : cA; const char* nB = has_next ? nxt.B : cB;
#pragma clang loop unroll(disable)
    for (int t = 0; t < nt; t += 2) {
      const bool last = (t == nt - 2);
      const size_t k1 = (size_t)(t + 1) * kstep;
      const char* a2 = last ? nA : cA; const char* b2 = last ? nB : cB + (size_t)(t + 2) * kstep;
      const size_t ka2 = last ? 0 : (size_t)(t + 2) * kstep;
      const char* b3 = b2 + kstep; const size_t ka3 = ka2 + kstep;
      unsigned gN[2][2];
      if (GATHER && last) {
        if (has_next) gather_offs(nxt, gN);
        else {
#pragma unroll
          for (int h = 0; h < 2; ++h)
#pragma unroll
            for (int i = 0; i < 2; ++i) gN[h][i] = gcur[h][i];
        }
      }
#define G_STAGE_A2(bufoff, h, koff) do { if (GATHER) { if (last) G_STAGE_A(bufoff, cA, gN, h, (koff) - ka2); else G_STAGE_A(bufoff, cA, gcur, h, koff); } \
        else G_STAGE_A(bufoff, a2, gcur, h, koff); } while (0)
      G_LDB(B0, 0, 0); G_SCHED; G_LDA(At, 0, 0); G_STAGE_A(G_SA(1, 1), cA, gcur, 1, k1);
      G_WAIT_L(8); G_BAR; G_WAIT_L(0); G_MMA(0, 0, At, B0); G_BAR; G_SCHED;
      G_LDB(B1, 0, 1); G_STAGE(G_SB(0, 0), b2, voffB);
      G_BAR; G_WAIT_L(0); G_MMA(0, 1, At, B1); G_BAR;
      G_LDA(At, 0, 1); G_STAGE_A2(G_SA(0, 0), 0, ka2);
      G_BAR; G_WAIT_L(0); G_MMA(1, 0, At, B0); G_BAR; G_SCHED;
      G_STAGE(G_SB(0, 1), b2 + hstepB, voffB);
      G_WAIT_V(6); G_BAR; G_MMA(1, 1, At, B1); G_BAR;
      G_LDB(B0, 1, 0); G_SCHED; G_LDA(At, 1, 0); G_STAGE_A2(G_SA(0, 1), 1, ka2);
      G_WAIT_L(8); G_BAR; G_WAIT_L(0); G_MMA(0, 0, At, B0); G_BAR; G_SCHED;
      G_LDB(B1, 1, 1); G_STAGE(G_SB(1, 0), b3, voffB);
      G_BAR; G_WAIT_L(0); G_MMA(0, 1, At, B1); G_BAR;
      G_LDA(At, 1, 1); G_STAGE_A2(G_SA(1, 0), 0, ka3);
      G_BAR; G_WAIT_L(0); G_MMA(1, 0, At, B0); G_BAR; G_SCHED;
      G_STAGE(G_SB(1, 1), b3 + hstepB, voffB);
      G_WAIT_V(6); G_BAR; G_MMA(1, 1, At, B1); G_BAR;
      if (GATHER && last) {
#pragma unroll
        for (int h = 0; h < 2; ++h)
#pragma unroll
          for (int i = 0; i < 2; ++i) gcur[h][i] = gN[h][i];
      }
#undef G_STAGE_A2
    }
    G_SCHED;
    if (F8) {
      asm volatile("s_nop 15\n\ts_nop 15" ::: "memory");
#pragma unroll
      for (int a_ = 0; a_ < 2; ++a_)
#pragma unroll
        for (int b_ = 0; b_ < 2; ++b_)
#pragma unroll
          for (int m_ = 0; m_ < 4; ++m_)
#pragma unroll
            for (int n_ = 0; n_ < 2; ++n_) asm volatile("" : "+v"(acc[a_][b_][m_][n_]));
    }
    E(acc, cur, wr, wc, fr, fq);
    G_SCHED;
    if (!has_next) break;
    cur = nxt; cA = nA; cB = nB; ++ui;
    E.init(acc, cur, wr, wc, fr, fq);
  }
  G_WAIT_V(0);
  if (wr == 0) G_BAR;
  G_BAR;
#undef G_SA
#undef G_SB
#undef G_STAGE
#undef G_DMA
#undef G_STAGE_A
#undef G_LDA
#undef G_LDB
#undef G_MMA
#undef G_WAIT_V
#undef G_WAIT_L
#undef G_BAR
#undef G_SCHED
}

DEVI unsigned uoff(unsigned x) { return (unsigned)__builtin_amdgcn_readfirstlane((int)x); }
DEVI bool tile_order(int i, int G, int c, int nM, int nN, int& pm, int& pn) {
  const int nwg = nM * nN;
  const long L = (long)i * G + c; if (L >= nwg) return false;
  int wgid = (int)L; { const int q = nwg / 8, r = nwg % 8, xcd = wgid % 8, off = wgid / 8; wgid = (xcd < r ? xcd * (q + 1) : r * (q + 1) + (xcd - r) * q) + off; }
  const int WGM = 8;
  const int nig = WGM * nN, gid = wgid / nig, fm = gid * WGM, gsz = (nM - fm) < WGM ? (nM - fm) : WGM;
  pm = fm + ((wgid % nig) % gsz); pn = (wgid % nig) / gsz;
  pm = __builtin_amdgcn_readfirstlane(pm); pn = __builtin_amdgcn_readfirstlane(pn);
  return true;
}
struct EpiRawBf16 {
  u16* O; int ldc; float sc;
  DEVI void init(f32x4 (&acc)[2][2][4][2], const Unit&, int, int, int, int) const { acc_zero(acc); }
  DEVI void operator()(const f32x4 (&acc)[2][2][4][2], const Unit& u, int wr, int wc, int fr, int fq) const {
    const unsigned off0 = ((unsigned)(u.u0 + wr * 64 + fr) * (unsigned)ldc + (unsigned)(u.u1 + wc * 32 + 8 * fq)) * 2u;
#pragma unroll
    for (int ai = 0; ai < 2; ++ai)
#pragma unroll
      for (int m = 0; m < 4; ++m) {
        char* rowp = (char*)O + (off0 + (unsigned)(ai * HALF + m * 16) * (unsigned)ldc * 2u);
#pragma unroll
        for (int bj = 0; bj < 2; ++bj) {
          const f32x4 v0 = acc[ai][bj][m][0], v1 = acc[ai][bj][m][1];
          u32x4 w; w.x = pk2(v0[0], v0[1]); w.y = pk2(v0[2], v0[3]); w.z = pk2(v1[0], v1[1]); w.w = pk2(v1[2], v1[3]);
          *(u32x4*)(rowp + bj * HALF * 2) = w;
        }
      }
  }
};

struct EpiRawF8 {
  unsigned char* O; int ldc; float sc;
  DEVI void init(f32x4 (&acc)[2][2][4][2], const Unit&, int, int, int, int) const { acc_zero(acc); }
  DEVI void operator()(const f32x4 (&acc)[2][2][4][2], const Unit& u, int wr, int wc, int fr, int fq) const {
    const unsigned off0 = (unsigned)(u.u0 + wr * 64 + fr) * (unsigned)ldc + (unsigned)(u.u1 + wc * 32 + 8 * fq);
#pragma unroll
    for (int ai = 0; ai < 2; ++ai)
#pragma unroll
      for (int m = 0; m < 4; ++m) {
        unsigned char* rowp = O + (off0 + (unsigned)(ai * HALF + m * 16) * (unsigned)ldc);
#pragma unroll
        for (int bj = 0; bj < 2; ++bj) {
          u32x2 w;
#pragma unroll
          for (int n = 0; n < 2; ++n) {
            const f32x4 v = acc[ai][bj][m][n] * sc;
            int q = __builtin_amdgcn_cvt_pk_fp8_f32(__builtin_amdgcn_fmed3f(v[0], -448.f, 448.f), __builtin_amdgcn_fmed3f(v[1], -448.f, 448.f), 0, false);
            q = __builtin_amdgcn_cvt_pk_fp8_f32(__builtin_amdgcn_fmed3f(v[2], -448.f, 448.f), __builtin_amdgcn_fmed3f(v[3], -448.f, 448.f), q, true);
            w[n] = (unsigned)q;
          }
          *(u32x2*)(rowp + bj * HALF) = w;
        }
      }
  }
};
DEVI size_t z8_block(int pm, int branch, int cb) { return (size_t)((pm * 4 + branch) * 8 + cb) * 32768; }
struct EpiZ8 {
  unsigned char* O;
  DEVI void init(f32x4 (&acc)[2][2][4][2], const Unit&, int, int, int, int) const { acc_zero(acc); }
  DEVI void operator()(const f32x4 (&acc)[2][2][4][2], const Unit& u, int wr, int wc, int fr, int fq) const {
    const int pm = u.u0 >> 8, pn = u.u1 >> 8, n = pn >> 2, cq = pn & 3;
    const unsigned lw16 = (unsigned)((wr * 4 + wc) * 64 + fr + 16 * fq) * 16u;
#pragma unroll
    for (int bj = 0; bj < 2; ++bj) {
      unsigned char* blk = O + z8_block(pm, n, cq * 2 + bj) + lw16;
#pragma unroll
      for (int P = 0; P < 4; ++P) {
        u32x4 w;
#pragma unroll
        for (int h = 0; h < 2; ++h)
#pragma unroll
          for (int nn = 0; nn < 2; ++nn) {
            const int g = 2 * P + h;
            const f32x4 v = acc[g >> 2][bj][g & 3][nn];
            int q = __builtin_amdgcn_cvt_pk_fp8_f32(__builtin_amdgcn_fmed3f(v[0], -448.f, 448.f), __builtin_amdgcn_fmed3f(v[1], -448.f, 448.f), 0, false);
            q = __builtin_amdgcn_cvt_pk_fp8_f32(__builtin_amdgcn_fmed3f(v[2], -448.f, 448.f), __builtin_amdgcn_fmed3f(v[3], -448.f, 448.f), q, true);
            w[2 * h + nn] = (unsigned)q;
          }
        *(u32x4*)(blk + P * 8192) = w;
      }
    }
  }
};
struct SchedB { const char* ws; const char* h8; int G, c;
  DEVI bool next(int i, Unit& u) const { int pm, pn; if (!tile_order(i, G, c, NTOK / 256, INP / 256, pm, pn)) return false;
    u.A = h8 + uoff((unsigned)pm * 256u * 1024u); u.B = ws + OFF_WIN + uoff((unsigned)pn * 256u * 1024u);        u.rows = nullptr; u.nvalid = 0; u.u0 = pm * 256; u.u1 = pn * 256; u.u2 = 0; u.u3 = 0; return true; } };
struct EpiB { u16* O; float* ssq;
  DEVI void init(f32x4 (&acc)[2][2][4][2], const Unit&, int, int, int, int) const { acc_zero(acc); }
  DEVI void operator()(const f32x4 (&acc)[2][2][4][2], const Unit& u, int wr, int wc, int fr, int fq) const {
    EpiRawBf16 E{O, PLD, 1.f}; E(acc, u, wr, wc, fr, fq);
    if (u.u1 < 512) {
      const bool iskv = u.u1 != 0;
#pragma unroll
      for (int ai = 0; ai < 2; ++ai)
#pragma unroll
        for (int m = 0; m < 4; ++m) {
          float ss = 0.f;
#pragma unroll
          for (int bj = 0; bj < 2; ++bj)
#pragma unroll
            for (int n = 0; n < 2; ++n)
#pragma unroll
              for (int j = 0; j < 4; ++j) { const float v = acc[ai][bj][m][n][j]; if (!(iskv && bj == 1)) ss += v * v; }
          ss += __shfl_xor(ss, 16); ss += __shfl_xor(ss, 32);
          if (fq == 0) ssq[(size_t)(u.u0 + ai * HALF + wr * 64 + m * 16 + fr) * 8 + (iskv ? 4 : 0) + wc] = ss;
        }
    }
  }
};
DEVI void phaseB2(KP p, ldsp_t lds) {
  SchedB S{(const char*)p->ws, (const char*)h8base(p), (int)gridDim.x, BIDX};
  EpiB E{wsp<u16>(p, OFF_PRAW), wsp<float>(p, OFF_SSQ)};
  gemm_phase<true, false, true>(lds, 1024, 1024, 8, S, E);
}
struct SchedC { const char* ws; int G, c;
  DEVI bool next(int i, Unit& u) const { int pm, pn; if (!tile_order(i, G, c, NTOK / 256, 4, pm, pn)) return false;
    const bool kv = pn >= 2; const int pj = pn & 1;
    u.A = ws + OFF_PRAW + uoff((unsigned)pm * 256u * (unsigned)(PLD * 2) + (kv ? 512u : 0u)); u.B = ws + (kv ? OFF_WKVB : OFF_WQB) + uoff((unsigned)pj * 256u * 512u); u.rows = nullptr; u.nvalid = 0;
    u.u0 = pm * 256; u.u1 = pj * 256; u.u2 = kv; u.u3 = 0; return true; } };
struct EpiC { u16* Oq; u16* Okv; const float* ssq;
  DEVI void init(f32x4 (&acc)[2][2][4][2], const Unit&, int, int, int, int) const { acc_zero(acc); }
  DEVI void operator()(const f32x4 (&acc)[2][2][4][2], const Unit& u, int wr, int wc, int fr, int fq) const {
    const bool kv = u.u2 != 0;
    u16* O = kv ? Okv : Oq;
    const int row0 = u.u0 + wr * 64 + fr, col0 = u.u1 + wc * 32 + 8 * fq;
    f32x4 sq[2][4];
#pragma unroll
    for (int ai = 0; ai < 2; ++ai)
#pragma unroll
      for (int m = 0; m < 4; ++m) sq[ai][m] = *(const f32x4*)(ssq + (size_t)(row0 + ai * HALF + m * 16) * 8 + (kv ? 4 : 0));
#pragma unroll
    for (int ai = 0; ai < 2; ++ai)
#pragma unroll
      for (int m = 0; m < 4; ++m) {
        const size_t r = (size_t)(row0 + ai * HALF + m * 16);
        const float tot = sq[ai][m].x + sq[ai][m].y + sq[ai][m].z + sq[ai][m].w;
        const float sc = kv ? rsqrtf(tot * (1.f / 128.f) + EPS) : rsqrtf(tot * (1.f / 256.f) + EPS) * (0.10206207261596575f * LOG2E);
        u16* rowp = O + r * 512 + col0;
#pragma unroll
        for (int bj = 0; bj < 2; ++bj) {
          const f32x4 v0 = acc[ai][bj][m][0] * sc, v1 = acc[ai][bj][m][1] * sc;
          u32x4 w; w.x = pk2(v0[0], v0[1]); w.y = pk2(v0[2], v0[3]); w.z = pk2(v1[0], v1[1]); w.w = pk2(v1[2], v1[3]);
          *(u32x4*)(rowp + bj * HALF) = w;
        }
      }
  }
};
DEVI void phaseC2(KP p, ldsp_t lds) {
  SchedC S{(const char*)p->ws, (int)gridDim.x, BIDX};
  EpiC E{wsp<u16>(p, OFF_QARAW), wsp<u16>(p, OFF_KVARAW), wsp<float>(p, OFF_SSQ)};
  int nt = 4; asm volatile("" : "+s"(nt));
  gemm_phase<true, false, false>(lds, PLD * 2, 512, nt, S, E);
}

DEVI void ld16(const u16* src, float (&v)[16]) {
  const u32x4 a = *(const u32x4*)src, b = *(const u32x4*)(src + 8);
  const unsigned w[8] = {a.x, a.y, a.z, a.w, b.x, b.y, b.z, b.w};
#pragma unroll
  for (int i = 0; i < 8; ++i) { v[2 * i] = __uint_as_float(w[i] << 16); v[2 * i + 1] = __uint_as_float(w[i] & 0xffff0000u); }
}
DEVI void st16(u16* dst, const float (&v)[16]) {
  u32x4 a, b;
  a.x = pk2(v[0], v[1]); a.y = pk2(v[2], v[3]); a.z = pk2(v[4], v[5]); a.w = pk2(v[6], v[7]);
  b.x = pk2(v[8], v[9]); b.y = pk2(v[10], v[11]); b.z = pk2(v[12], v[13]); b.w = pk2(v[14], v[15]);
  *(u32x4*)dst = a; *(u32x4*)(dst + 8) = b;
}
DEVI void rope16c(float (&v)[16], const float* cs16, int pos) {
  const f32x2* t = (const f32x2*)(cs16 + pos * 16);
#pragma unroll
  for (int i = 0; i < 8; ++i) { const f32x2 cs = t[i]; const float x1 = v[i], x2 = v[8 + i]; v[i] = x1 * cs.x - x2 * cs.y; v[8 + i] = x2 * cs.x + x1 * cs.y; }
}
DEVI void rope32c(float (&lo)[16], float (&hi)[16], const float* cs32, int pos) {
  const f32x2* t = (const f32x2*)(cs32 + pos * 32);
#pragma unroll
  for (int i = 0; i < 16; ++i) { const f32x2 cs = t[i]; const float x1 = lo[i], x2 = hi[i]; lo[i] = x1 * cs.x - x2 * cs.y; hi[i] = x2 * cs.x + x1 * cs.y; }
}
DEVI float ssq16(const float (&v)[16]) { float s = 0.f;
#pragma unroll
  for (int i = 0; i < 16; ++i) s += v[i] * v[i];
  return s; }
DEVI void scale16(float (&v)[16], float s) {
#pragma unroll
  for (int i = 0; i < 16; ++i) v[i] *= s; }
DEVI void cvt16(const u32x4 a, const u32x4 b, float (&v)[16]) {
  const unsigned w[8] = {a.x, a.y, a.z, a.w, b.x, b.y, b.z, b.w};
#pragma unroll
  for (int i = 0; i < 8; ++i) { v[2 * i] = __uint_as_float(w[i] << 16); v[2 * i + 1] = __uint_as_float(w[i] & 0xffff0000u); }
}
DEVI void phaseP2(KP p, int l, ldsp_t lds) {
  const int tid = TIDX, tk = tid >> 3, pt = tid & 7;
  u16* PR = wsp<u16>(p, OFF_PRAW);
  u16* QA = wsp<u16>(p, OFF_QARAW);
  const float* cs32 = wsp<float>(p, OFF_CS32);
  const float* cs16 = wsp<float>(p, OFF_CS16);
  const float QS = 0.125f * LOG2E;
  for (int item = BIDX; item < NTOK / 64; item += gridDim.x) {
    const int tok0 = item * 64, rr0 = tok0 % TPB;
    const bool lat = rr0 >= NCTX;
    const size_t tok = (size_t)tok0 + tk;
    const int t = rr0 + tk - NCTX, grow = (t >> 6) & 63, gcol = t & 63;
    u16* pr = PR + tok * PLD;
    u16* qar = QA + tok * 512 + 96 * (pt >> 1) + 64 + 16 * (pt & 1);
    const int g4 = pt & 3;
    u32x4 r_qa[2], r_kr[2], r_qb[4], r_kb[4], r_qd[4], r_kd[4];
#define LD8(ptr) (*(const u32x4*)(ptr))
    if (lat) {
#pragma unroll
      for (int i = 0; i < 2; ++i) { r_qa[i] = LD8(qar + 8 * i); r_kr[i] = LD8(pr + 384 + 16 * (pt & 1) + 8 * i); }
#pragma unroll
      for (int i = 0; i < 4; ++i) { r_qb[i] = LD8(pr + 512 + 32 * pt + 8 * i); r_kb[i] = LD8(pr + 768 + 32 * g4 + 8 * i); }
    }
#pragma unroll
    for (int i = 0; i < 4; ++i) { r_qd[i] = LD8(pr + 1792 + 32 * pt + 8 * i); r_kd[i] = LD8(pr + 2048 + 32 * g4 + 8 * i); }
#undef LD8
    if (lat) {
      { float v[16]; cvt16(r_qa[0], r_qa[1], v); rope16c(v, cs16, (pt & 1) ? gcol : grow); st16(qar, v); }
      if (pt < 2) { float v[16]; cvt16(r_kr[0], r_kr[1], v); rope16c(v, cs16, pt == 0 ? grow : gcol); st16(pr + 384 + 16 * pt, v); }
      { float lo[16], hi[16]; cvt16(r_qb[0], r_qb[1], lo); cvt16(r_qb[2], r_qb[3], hi); rope32c(lo, hi, cs32, (pt & 1) ? gcol : grow); st16(pr + 512 + 32 * pt, lo); st16(pr + 512 + 32 * pt + 16, hi); }
      if (pt < 4) { float lo[16], hi[16]; cvt16(r_kb[0], r_kb[1], lo); cvt16(r_kb[2], r_kb[3], hi); rope32c(lo, hi, cs32, (pt & 1) ? gcol : grow); st16(pr + 768 + 32 * pt, lo); st16(pr + 768 + 32 * pt + 16, hi); }
    }
    {
      float lo[16], hi[16]; cvt16(r_qd[0], r_qd[1], lo); cvt16(r_qd[2], r_qd[3], hi);
      float ss = ssq16(lo) + ssq16(hi); ss += __shfl_xor(ss, 1);
      const float rs = rsqrtf(ss * (1.f / 64.f) + EPS);
      const float* g = p->g_q_d + l * 64 + 32 * (pt & 1);
#pragma unroll
      for (int i = 0; i < 16; ++i) { lo[i] *= rs * g[i]; hi[i] *= rs * g[16 + i]; }
      if (lat) rope32c(lo, hi, cs32, (pt & 1) ? gcol : grow);
      scale16(lo, QS); scale16(hi, QS);
      st16(pr + 1792 + 32 * pt, lo); st16(pr + 1792 + 32 * pt + 16, hi);
    }
    {
      float lo[16], hi[16]; cvt16(r_kd[0], r_kd[1], lo); cvt16(r_kd[2], r_kd[3], hi);
      float ss = ssq16(lo) + ssq16(hi); ss += __shfl_xor(ss, 1);
      const float rs = rsqrtf(ss * (1.f / 64.f) + EPS);
      const float* g = p->g_k_d + l * 64 + 32 * (g4 & 1);
#pragma unroll
      for (int i = 0; i < 16; ++i) { lo[i] *= rs * g[i]; hi[i] *= rs * g[16 + i]; }
      if (lat) rope32c(lo, hi, cs32, (g4 & 1) ? gcol : grow);
      if (pt < 4) { st16(pr + 2048 + 32 * g4, lo); st16(pr + 2048 + 32 * g4 + 16, hi); }
    }
  }
}

DEVI void conv_load(const ConvT& c, int lane, f32x4 (&v)[8]) {
  const int kk = lane >> 3, n4 = (lane & 7) * 4;
  const float* sp = (c.src2 && n4 >= 16) ? c.src2 + (n4 - 16) : (c.src ? c.src + n4 : nullptr);
#pragma unroll
  for (int i = 0; i < 8; ++i) v[i] = sp ? __builtin_nontemporal_load((const f32x4*)(sp + (size_t)(kk + 8 * i) * c.ld)) : f32x4{0.f, 0.f, 0.f, 0.f};
}
DEVI void conv_store(const ConvT& c, LAS float* t, int lane, const f32x4 (&v)[8]) {
  const int kk = lane >> 3, n4 = (lane & 7) * 4;
#pragma unroll
  for (int i = 0; i < 8; ++i) {
    const int k = kk + 8 * i;
    const float s = (c.ks ? c.ks[k] : 1.f) * c.mul;
    t[(n4 + 0) * 65 + k] = v[i].x * s; t[(n4 + 1) * 65 + k] = v[i].y * s;
    t[(n4 + 2) * 65 + k] = v[i].z * s; t[(n4 + 3) * 65 + k] = v[i].w * s;
  }
  asm volatile("s_waitcnt lgkmcnt(0)" ::: "memory");
  const int n = lane >> 1, k0 = (lane & 1) * 32;
  const LAS float* r = t + n * 65 + k0;
  if (c.ldd < 0) {
    unsigned char* d8 = (unsigned char*)c.dst + (size_t)n * (size_t)(-c.ldd) + k0;
#pragma unroll
    for (int q = 0; q < 2; ++q) {
      u32x4 o;
#pragma unroll
      for (int w = 0; w < 4; ++w) {
        float f[4];
#pragma unroll
        for (int j = 0; j < 4; ++j) f[j] = __builtin_amdgcn_fmed3f(r[16 * q + 4 * w + j], -448.f, 448.f);
        int v = __builtin_amdgcn_cvt_pk_fp8_f32(f[0], f[1], 0, false);
        v = __builtin_amdgcn_cvt_pk_fp8_f32(f[2], f[3], v, true);
        o[w] = (unsigned)v;
      }
      *(u32x4*)(d8 + 16 * q) = o;
    }
    asm volatile("s_waitcnt lgkmcnt(0)" ::: "memory");
    return;
  }
  u16* d = c.dst + (size_t)n * c.ldd + k0;
#pragma unroll
  for (int q = 0; q < 4; ++q) {
    u32x4 o;
    o.x = pk2(r[8 * q], r[8 * q + 1]); o.y = pk2(r[8 * q + 2], r[8 * q + 3]); o.z = pk2(r[8 * q + 4], r[8 * q + 5]); o.w = pk2(r[8 * q + 6], r[8 * q + 7]);
    *(u32x4*)(d + 8 * q) = o;
  }
  asm volatile("s_waitcnt lgkmcnt(0)" ::: "memory");
}
constexpr int CONV_EARLY = 1152 + 64 + 64;
DEVI void conv_items2(KP p, int l, ldsp_t lds, int first_item, int total_items) {
  const int tid = TIDX, wave = __builtin_amdgcn_readfirstlane(tid >> 6), lane = tid & 63;
  LAS float* t = (LAS float*)(lds + wave * 8448);
  __syncthreads();
  const int stride = gridDim.x * NW;
  int item = first_item + BIDX * NW + wave;
  if (item >= total_items) return;
  ConvT c = conv_decode(p, l, item);
  f32x4 v[8];
  conv_load(c, lane, v);
  for (;;) {
    const int nitem = item + stride;
    const bool more = nitem < total_items;
    ConvT cn = c; f32x4 vn[8];
    if (more) { cn = conv_decode(p, l, nitem); conv_load(cn, lane, vn); }
    conv_store(c, t, lane, v);
    if (!more) break;
    c = cn; item = nitem;
#pragma unroll
    for (int i = 0; i < 8; ++i) v[i] = vn[i];
  }
}
template <int BR>
DEVI void attn_mask(f32x16 (&s)[2], int kt, int qlat, int qrow, int qcol, int hh, LAS float* rpb) {
  if (BR == 1) {
#pragma unroll
    for (int kb = 0; kb < 2; ++kb)
#pragma unroll
      for (int i = 0; i < 16; ++i) {
        const int kpos = kt * 64 + kb * 32 + (i & 3) + 8 * (i >> 2) + 4 * hh;
        const int d = qlat - kpos;
        if (d > 128 || d < -128) s[kb][i] = -1e30f;
      }
  } else {
    const int rs = min(max(qrow - 4, 0), 56);
    const bool row_ok = (kt >= rs) && (kt < rs + 8);
    const int cst = min(max(qcol - 8, 0), 48);
    const int dr = kt - qrow + 7;
#pragma unroll
    for (int kb = 0; kb < 2; ++kb)
#pragma unroll
      for (int i = 0; i < 16; ++i) {
        const int kc = kb * 32 + (i & 3) + 8 * (i >> 2) + 4 * hh;
        const bool ok = row_ok && (kc >= cst) && (kc < cst + 16);
        const int idx = ok ? (dr * 31 + (kc - qcol + 15)) : 0;
        const float bias = rpb[idx];
        s[kb][i] = ok ? (s[kb][i] + bias) : -1e30f;
      }
  }
}

template <int BR>
DEVI void attn_mask1(f32x16& sb, int kb, int kt, int qlat, int qrow, int qcol, int hh, LAS float* rpb) {
  if (BR == 1) {
#pragma unroll
    for (int i = 0; i < 16; ++i) {
      const int kpos = kt * 64 + kb * 32 + (i & 3) + 8 * (i >> 2) + 4 * hh;
      const int d = qlat - kpos;
      if (d > 128 || d < -128) sb[i] = -1e30f;
    }
  } else {
    const int rs = min(max(qrow - 4, 0), 56);
    const bool row_ok = (kt >= rs) && (kt < rs + 8);
    const int cst = min(max(qcol - 8, 0), 48);
    const int dr = kt - qrow + 7;
#pragma unroll
    for (int i = 0; i < 16; ++i) {
      const int kc = kb * 32 + (i & 3) + 8 * (i >> 2) + 4 * hh;
      const bool ok = row_ok && (kc >= cst) && (kc < cst + 16);
      const int idx = ok ? (dr * 31 + (kc - qcol + 15)) : 0;
      const float bias = rpb[idx];
      sb[i] = ok ? (sb[i] + bias) : -1e30f;
    }
  }
}
#define FADD(a, b) do { (a) += (b); asm("" : "+v"(a)); } while (0)
typedef short v4i16_t __attribute__((ext_vector_type(4)));
DEVI bf16x8 vtr2(ldsp_t a) {
  const v4i16_t lo = __builtin_amdgcn_ds_read_tr16_b64_v4i16((LAS v4i16_t*)a);
  const v4i16_t hi = __builtin_amdgcn_ds_read_tr16_b64_v4i16((LAS v4i16_t*)(a + 8 * 144));
  return __builtin_shufflevector(lo, hi, 0, 1, 2, 3, 4, 5, 6, 7);
}
DEVI bf16x8 vtr2s(ldsp_t a, int o0, int o1) {
  const v4i16_t lo = __builtin_amdgcn_ds_read_tr16_b64_v4i16((LAS v4i16_t*)(a + o0));
  const v4i16_t hi = __builtin_amdgcn_ds_read_tr16_b64_v4i16((LAS v4i16_t*)(a + 8 * 128 + o1));
  return __builtin_shufflevector(lo, hi, 0, 1, 2, 3, 4, 5, 6, 7);
}
template <int BR, bool FAST>
DEVI bool attn_item2(KP p, int l, int b, int hs, int qb, bool isctx, ldsp_t lds) {
  constexpr bool MLA = (BR == 0);
  constexpr bool GQA = (BR == 1 || BR == 3);
  constexpr int QBLK = GQA ? 256 : 512;
  constexpr int NKS = MLA ? 6 : 4;
  constexpr int STG = 8192 + 8192 + 4096;
  const int tid = TIDX, lane = tid & 63, wave = __builtin_amdgcn_readfirstlane(tid >> 6);
  const int r32 = lane & 31, hh = lane >> 5;
  const int hq = GQA ? (hs * 2 + (wave & 1)) : hs;
  const int woff = GQA ? 64 * (wave >> 1) : 64 * wave;
  const int q0 = (isctx ? 0 : NCTX) + qb * QBLK;
  const bool active = !isctx || (woff < NCTX);
  const size_t tokq = (size_t)b * TPB + q0 + (active ? woff : 0) + r32;
  const u16* Qp; const u16* Kp; int ldk; const u16* Vp; int ldv; int obase; int ldq;
  const u16* PR = wsp<u16>(p, OFF_PRAW);
  if (BR == 0) { Qp = wsp<u16>(p, OFF_QARAW) + tokq * 512 + hq * 96; ldq = 512; Kp = wsp<u16>(p, OFF_KVARAW) + (size_t)b * TPB * 512 + hs * 128; ldk = 512; Vp = wsp<u16>(p, OFF_KVARAW) + (size_t)b * TPB * 512 + hs * 128 + 64; ldv = 512; obase = hq * 64; }
  else if (BR == 1) { Qp = PR + tokq * PLD + 512 + hq * 64; ldq = PLD; Kp = PR + (size_t)b * TPB * PLD + 768 + hs * 64; ldk = PLD; Vp = PR + (size_t)b * TPB * PLD + 896 + hs * 64; ldv = PLD; obase = 256 + hq * 64; }
  else if (BR == 2) { Qp = PR + tokq * PLD + 1024 + hq * 64; ldq = PLD; Kp = PR + (size_t)b * TPB * PLD + 1280 + hs * 64; ldk = PLD; Vp = PR + (size_t)b * TPB * PLD + 1536 + hs * 64; ldv = PLD; obase = 512 + hq * 64; }
  else { Qp = PR + tokq * PLD + 1792 + hq * 64; ldq = PLD; Kp = PR + (size_t)b * TPB * PLD + 2048 + hs * 64; ldk = PLD; Vp = PR + (size_t)b * TPB * PLD + 2176 + hs * 64; ldv = PLD; obase = 768 + hq * 64; }
  const u16* KRp = PR + (size_t)b * TPB * PLD + 384;
  int lat_lo = 0, lat_n = 0, wlo = 0, whi = 63;
  if (!isctx) {
    if (BR == 0 || BR == 3) { lat_lo = 0; lat_n = 64; }
    else if (BR == 1) {
      const int ql = qb * QBLK; const int lo = max(0, ql - 128) >> 6, hi = min(SEQ - 1, ql + QBLK - 1 + 128) >> 6; lat_lo = lo; lat_n = hi - lo + 1;
      const int wq = ql + woff; wlo = max(0, wq - 128) >> 6; whi = min(SEQ - 1, wq + 63 + 128) >> 6;
    } else {
      const int r0 = 8 * qb; const int lo = min(max(r0 - 4, 0), 56), hi = min(max(r0 + 7 - 4, 0), 56) + 7; lat_lo = lo; lat_n = hi - lo + 1;
      const int wr_ = r0 + wave; wlo = min(max(wr_ - 4, 0), 56); whi = wlo + 7;
    }
  }
  const int NT = 4 + lat_n;
  const int qlat0 = qb * QBLK + woff + r32;
  bf16x8 qf[2][NKS];
#pragma unroll
  for (int qi = 0; qi < 2; ++qi)
#pragma unroll
    for (int ks = 0; ks < NKS; ++ks) qf[qi][ks] = *(const bf16x8*)(Qp + (size_t)qi * 32 * ldq + ks * 16 + hh * 8);
  const int drow = 8 * wave + (lane >> 3), dch = (lane & 7) ^ ((drow >> 1) & 7);
  const int rrow = 16 * (wave & 3) + (lane >> 2), rch = (lane & 3) ^ ((rrow >> 2) & 3);
  auto keytile = [&](int j) { return (j < 4) ? j : (4 + lat_lo + (j - 4)); };
#define DMA16(sbase, voff, ldsaddr) asm volatile("s_mov_b32 m0, %2\n\ts_nop 0\n\tglobal_load_lds_dwordx4 %0, %1" :: "v"(voff), "s"(sbase), "s"(ldsaddr) : "memory", "m0")
#define A_DMA(j, st) do { const int key0_ = keytile(j) * 64; const unsigned base_ = __builtin_amdgcn_readfirstlane((unsigned)(size_t)(lds + (st) * STG) + wave * 1024); \
    DMA16(Kp, (unsigned)(((key0_ + drow) * ldk + dch * 8) * 2), base_); \
    DMA16(Vp, (unsigned)(((key0_ + drow) * ldv + dch * 8) * 2), base_ + 8192u); \
    if (MLA && wave < 4) DMA16(KRp, (unsigned)(((key0_ + rrow) * PLD + rch * 8) * 2), __builtin_amdgcn_readfirstlane(base_ + 16384u)); \
  } while (0)
  LAS float* rpb = (LAS float*)(lds + 2 * STG);
  __syncthreads();
  if (FAST && tid == 0) *(LAS int*)(lds + 2 * STG + 2048) = 0;
  A_DMA(0, 0);
  if (BR == 2 && !isctx) {
    const float* src = p->rpb_c + (size_t)(l * 4 + hs) * 465;
    for (int i = tid; i < 465; i += 512) rpb[i] = src[i] * LOG2E;
  }
  asm volatile("s_waitcnt vmcnt(0)" ::: "memory");
#pragma unroll
  for (int qi = 0; qi < 2; ++qi)
#pragma unroll
    for (int ks = 0; ks < NKS; ++ks) asm volatile("" : "+v"(qf[qi][ks]));
  __syncthreads();
  f32x16 o[2][2];
#pragma unroll
  for (int qi = 0; qi < 2; ++qi)
#pragma unroll
    for (int i = 0; i < 16; ++i) { o[qi][0][i] = 0.f; o[qi][1][i] = 0.f; }
  float m_run[2], l_run[2];
#pragma unroll
  for (int qi = 0; qi < 2; ++qi) { m_run[qi] = -INFINITY; l_run[qi] = 0.f; }
  if (BR == 1) { const float sk = p->sink_b[l * 4 + hq] * LOG2E; m_run[0] = sk; m_run[1] = sk; l_run[0] = (hh == 0) ? (FAST ? __builtin_amdgcn_exp2f(sk) : 1.f) : 0.f; l_run[1] = l_run[0]; }
  float l2[2][2];
#pragma unroll
  for (int qi = 0; qi < 2; ++qi) { l2[qi][0] = l_run[qi]; l2[qi][1] = 0.f; }
  const int kkey = (r32 >> 1) & 7, rkey = (r32 >> 2) & 3;
  const ldsp_t kfb = lds + r32 * 128;
  const ldsp_t krb = lds + 16384 + r32 * 64;
  const int vq = (lane & 15) >> 2, vkey = 2 * hh + (vq >> 1);
  const int vch = 2 * ((lane >> 4) & 1) + ((lane & 3) >> 1);
  const ldsp_t vfb = lds + 8192 + (4 * hh + vq) * 128 + 8 * (lane & 1);
#define SB() __builtin_amdgcn_sched_barrier(0)
#define KLOAD(kb, ks) (((ks) < 4) ? *(const LAS bf16x8*)(kfb + st + (kb) * 4096 + (((2 * (ks) + hh) ^ kkey) << 4)) : *(const LAS bf16x8*)(krb + st + (kb) * 2048 + (((2 * ((ks) - 4) + hh) ^ rkey) << 4)))
#define VLOAD(s4, db) vtr2s(vfb + st + (s4) * 2048, ((4 * (db) + vch) ^ vkey) << 4, ((4 * (db) + vch) ^ vkey ^ 4) << 4)
#define SM_EL(kb, e) do { const int qi_ = (e) >> 4, i_ = (e) & 15; \
    const float x_ = __builtin_amdgcn_exp2f(s[qi_][kb][i_]); s[qi_][kb][i_] = x_; FADD(l2[qi_][i_ & 1], x_); \
    if (i_ & 1) pw[kb][qi_][i_ >> 3][(i_ & 7) >> 1] = pk2(s[qi_][kb][i_ - 1], x_); } while (0)
#define F_STEP(j) do { \
    const int st = ((j) & 1) * STG; \
    if ((j) + 1 < NT) A_DMA((j) + 1, ((j) + 1) & 1); \
    const int kt_ = lat_lo + (j) - 4; \
    const bool need = active && ((j) < 4 || (kt_ >= wlo && kt_ <= whi)); \
    if (need) { \
      f32x16 s[2][2]; bf16x8 kf[NKS]; bf16x8 vf[4]; u32x4 pw[2][2][2]; \
      const f32x16 zero16 = {0.f, 0.f, 0.f, 0.f, 0.f, 0.f, 0.f, 0.f, 0.f, 0.f, 0.f, 0.f, 0.f, 0.f, 0.f, 0.f}; \
      const bool domask = (BR == 1 || BR == 2) && (j) >= 4; \
      _Pragma("unroll") for (int ks = 0; ks < NKS; ++ks) kf[ks] = KLOAD(0, ks); \
      _Pragma("unroll") for (int ks = 0; ks < NKS; ++ks) { \
        s[0][0] = MFMA(kf[ks], qf[0][ks], ks == 0 ? zero16 : s[0][0]); s[1][0] = MFMA(kf[ks], qf[1][ks], ks == 0 ? zero16 : s[1][0]); \
        SB(); kf[ks] = KLOAD(1, ks); SB(); } \
      if (domask) { _Pragma("unroll") for (int qi = 0; qi < 2; ++qi) { const int ql_ = qlat0 + 32 * qi; attn_mask1<BR>(s[qi][0], 0, kt_, ql_, ql_ >> 6, ql_ & 63, hh, rpb); } } \
      _Pragma("unroll") for (int m = 0; m < 2 * NKS; ++m) { \
        s[m & 1][1] = MFMA(kf[m >> 1], qf[m & 1][m >> 1], (m >> 1) == 0 ? zero16 : s[m & 1][1]); \
        if (m < 4) vf[m] = VLOAD(m >> 1, m & 1); \
        _Pragma("unroll") for (int e = (m * 32) / (2 * NKS); e < ((m + 1) * 32) / (2 * NKS); ++e) SM_EL(0, e); \
        SB(); } \
      if (domask) { _Pragma("unroll") for (int qi = 0; qi < 2; ++qi) { const int ql_ = qlat0 + 32 * qi; attn_mask1<BR>(s[qi][1], 1, kt_, ql_, ql_ >> 6, ql_ & 63, hh, rpb); } } \
      _Pragma("unroll") for (int m = 0; m < 8; ++m) { \
        o[m & 1][(m >> 1) & 1] = MFMA(vf[m >> 1], __builtin_bit_cast(bf16x8, pw[0][m & 1][m >> 2]), o[m & 1][(m >> 1) & 1]); \
        if (m & 1) { SB(); vf[m >> 1] = VLOAD(2 + (m >> 2), (m >> 1) & 1); } \
        _Pragma("unroll") for (int e = 4 * m; e < 4 * m + 4; ++e) SM_EL(1, e); \
        SB(); } \
      _Pragma("unroll") for (int m = 0; m < 8; ++m) \
        o[m & 1][(m >> 1) & 1] = MFMA(vf[m >> 1], __builtin_bit_cast(bf16x8, pw[1][m & 1][m >> 2]), o[m & 1][(m >> 1) & 1]); \
    } \
    asm volatile("s_waitcnt vmcnt(0)" ::: "memory"); \
    __syncthreads(); \
  } while (0)
#define A_STEP(j) do { \
    const int st = ((j) & 1) * STG; \
    if ((j) + 1 < NT) A_DMA((j) + 1, ((j) + 1) & 1); \
    const int kt_ = lat_lo + (j) - 4; \
    const bool need = active && ((j) < 4 || (kt_ >= wlo && kt_ <= whi)); \
    if (need) { \
      f32x16 s[2][2]; \
      _Pragma("unroll") for (int kb = 0; kb < 2; ++kb) { \
        _Pragma("unroll") for (int ks = 0; ks < 4; ++ks) { const bf16x8 kf = *(const LAS bf16x8*)(kfb + st + kb * 4096 + (((2 * ks + hh) ^ kkey) << 4)); \
          _Pragma("unroll") for (int qi = 0; qi < 2; ++qi) { if (ks == 0) { _Pragma("unroll") for (int i = 0; i < 16; ++i) s[qi][kb][i] = 0.f; } s[qi][kb] = MFMA(kf, qf[qi][ks], s[qi][kb]); } } \
        if (MLA) { _Pragma("unroll") for (int ks = 0; ks < 2; ++ks) { const bf16x8 kf = *(const LAS bf16x8*)(krb + st + kb * 2048 + (((2 * ks + hh) ^ rkey) << 4)); \
          _Pragma("unroll") for (int qi = 0; qi < 2; ++qi) s[qi][kb] = MFMA(kf, qf[qi][NKS - 2 + ks], s[qi][kb]); } } \
      } \
      if (FAST) __builtin_amdgcn_sched_barrier(0); \
      _Pragma("unroll") for (int qi = 0; qi < 2; ++qi) { \
        if ((BR == 1 || BR == 2) && (j) >= 4) { const int ql_ = qlat0 + 32 * qi; attn_mask<BR>(s[qi], kt_, ql_, ql_ >> 6, ql_ & 63, hh, rpb); } \
        if (FAST) { \
          float ls0 = 0.f, ls1 = 0.f; \
          _Pragma("unroll") for (int i = 0; i < 16; ++i) { \
            const float e0 = __builtin_amdgcn_exp2f(s[qi][0][i]), e1 = __builtin_amdgcn_exp2f(s[qi][1][i]); \
            s[qi][0][i] = e0; s[qi][1][i] = e1; FADD(ls0, e0); FADD(ls1, e1); } \
          l_run[qi] += ls0 + ls1; \
        } else { \
        float mx = s[qi][0][0]; \
        _Pragma("unroll") for (int i = 1; i < 16; ++i) mx = fmaxf(mx, s[qi][0][i]); \
        _Pragma("unroll") for (int i = 0; i < 16; ++i) mx = fmaxf(mx, s[qi][1][i]); \
        mx = fmaxf(mx, __shfl_xor(mx, 32)); \
        const float m_new = fmaxf(m_run[qi], mx); \
        const float alpha = __builtin_amdgcn_exp2f(m_run[qi] - m_new); \
        m_run[qi] = m_new; \
        float ls0 = 0.f, ls1 = 0.f; \
        _Pragma("unroll") for (int i = 0; i < 16; ++i) { \
          const float e0 = __builtin_amdgcn_exp2f(s[qi][0][i] - m_new), e1 = __builtin_amdgcn_exp2f(s[qi][1][i] - m_new); \
          s[qi][0][i] = e0; s[qi][1][i] = e1; ls0 += e0; ls1 += e1; } \
        l_run[qi] = l_run[qi] * alpha + (ls0 + ls1); \
        if (__any(alpha != 1.f)) { _Pragma("unroll") for (int i = 0; i < 16; ++i) { o[qi][0][i] *= alpha; o[qi][1][i] *= alpha; } } \
        } \
      } \
      _Pragma("unroll") for (int s4 = 0; s4 < 4; ++s4) { \
        const int kb = s4 >> 1, rb = (s4 & 1) * 8; \
        bf16x8 pf[2]; \
        _Pragma("unroll") for (int qi = 0; qi < 2; ++qi) { u32x4 pw; \
          pw.x = pk2(s[qi][kb][rb + 0], s[qi][kb][rb + 1]); pw.y = pk2(s[qi][kb][rb + 2], s[qi][kb][rb + 3]); \
          pw.z = pk2(s[qi][kb][rb + 4], s[qi][kb][rb + 5]); pw.w = pk2(s[qi][kb][rb + 6], s[qi][kb][rb + 7]); \
          pf[qi] = __builtin_bit_cast(bf16x8, pw); } \
        _Pragma("unroll") for (int db = 0; db < 2; ++db) { const bf16x8 vf = vtr2s(vfb + st + s4 * 2048, ((4 * db + vch) ^ vkey) << 4, ((4 * db + vch) ^ vkey ^ 4) << 4); \
          o[0][db] = MFMA(vf, pf[0], o[0][db]); o[1][db] = MFMA(vf, pf[1], o[1][db]); } \
      } \
    } \
    asm volatile("s_waitcnt vmcnt(0)" ::: "memory");        \
    __syncthreads(); \
  } while (0)
  if (FAST) {
    if (wave >= 4) __builtin_amdgcn_s_setprio(1);
    for (int j = 0; j < NT; j += 2) {
      F_STEP(j);
      if (j + 1 < NT) F_STEP(j + 1);
    }
    __builtin_amdgcn_s_setprio(0);
  } else {
    for (int j = 0; j < NT; j += 2) {
      A_STEP(j);
      if (j + 1 < NT) A_STEP(j + 1);
    }
  }
#undef F_STEP
#undef SM_EL
#undef A_STEP
#undef A_DMA
#undef DMA16
  bool bad = false;
  if (active) {
#pragma unroll
    for (int qi = 0; qi < 2; ++qi) {
      if (FAST) l_run[qi] = l2[qi][0] + l2[qi][1];
      const float lt = l_run[qi] + __shfl_xor(l_run[qi], 32);
      const float inv = 1.f / lt;
      if (FAST) bad = bad || !(lt > 1e-25f && lt < 1e25f);
      unsigned char* Op = wsp<unsigned char>(p, OFF_O) + (tokq + 32 * qi) * 1024 + obase;
#pragma unroll
      for (int db = 0; db < 2; ++db)
#pragma unroll
        for (int gp = 0; gp < 2; ++gp) {
          float q[8];
#pragma unroll
          for (int j = 0; j < 8; ++j) q[j] = __builtin_amdgcn_fmed3f(o[qi][db][8 * gp + j] * (inv * O8_SCALE), -448.f, 448.f);
          int wa = __builtin_amdgcn_cvt_pk_fp8_f32(q[0], q[1], 0, false); wa = __builtin_amdgcn_cvt_pk_fp8_f32(q[2], q[3], wa, true);
          int wb = __builtin_amdgcn_cvt_pk_fp8_f32(q[4], q[5], 0, false); wb = __builtin_amdgcn_cvt_pk_fp8_f32(q[6], q[7], wb, true);
          const u32x2 sx = __builtin_amdgcn_permlane32_swap((unsigned)wa, (unsigned)wb, false, false);
          *(u32x2*)(Op + db * 32 + 16 * gp + 8 * hh) = sx;
        }
    }
  }
  if (!FAST) return false;
  LAS int* flag = (LAS int*)(lds + 2 * STG + 2048);
  if (__any(bad) && lane == 0) *flag = 1;
  __syncthreads();
  return __builtin_amdgcn_readfirstlane(*flag) != 0;
}
template <bool FAST>
DEVI bool attn_dispatch(KP p, int l, int n, int xcd, ldsp_t lds) {
  int br, s, qb; bool isctx = false;
  if (n < 32) { br = 0; s = xcd + 8 * (n >> 3); qb = n & 7; }
  else if (n < 64) { const int m = n - 32; br = 3; s = xcd + 8 * (m >> 4); qb = m & 15; }
  else if (n < 96) { const int m = n - 64; br = 2; s = xcd + 8 * (m >> 3); qb = m & 7; }
  else if (n < 128) { const int m = n - 96; br = 1; s = xcd + 8 * (m >> 4); qb = m & 15; }
  else {
    const int m = n - 128; isctx = true; qb = 0;
    if (m < 4) { br = 0; s = xcd + 8 * m; }
    else if (m < 6) { br = 3; s = xcd + 8 * (m - 4); }
    else if (m < 10) { br = 2; s = xcd + 8 * (m - 6); }
    else { br = 1; s = xcd + 8 * (m - 10); }
  }
  if (br == 0) return attn_item2<0, FAST>(p, l, s >> 2, s & 3, qb, isctx, lds);
  else if (br == 1) return attn_item2<1, FAST>(p, l, s >> 1, s & 1, qb, isctx, lds);
  else if (br == 2) return attn_item2<2, FAST>(p, l, s >> 2, s & 3, qb, isctx, lds);
  else return attn_item2<3, FAST>(p, l, s >> 1, s & 1, qb, isctx, lds);
}
DEVI void phaseD2(KP p, int l, ldsp_t lds) {
  const int G8 = gridDim.x >> 3, xcd = BIDX & 7, lb = BIDX >> 3;
  if (lb >= G8) return;
  const int NLOC = 128 + (l == 0 ? 12 : 0);
  const int nmine = (NLOC - lb + G8 - 1) / G8;
  const int cslot = min((int)(BIDX & 3), nmine - 1);
  int it = 0; unsigned redo = 0;
  for (int n = lb; n < NLOC; n += G8, ++it) {
    if (it == cslot) conv_items2(p, l, lds, CONV_EARLY, CONV_ITEMS);
    if (attn_dispatch<true>(p, l, n, xcd, lds)) redo |= 1u << it;
  }
  if (redo) {
    it = 0;
    for (int n = lb; n < NLOC; n += G8, ++it)
      if ((redo >> it) & 1) attn_dispatch<false>(p, l, n, xcd, lds);
  }
}

DEVI int pm_map(int pme, bool skipctx) { return skipctx ? (pme >> 4) * 17 + 1 + (pme & 15) : pme; }
struct SchedE1 { const char* ws; bool skipctx; int G, c;
  DEVI bool next(int i, Unit& u) const { int pm, pn; if (!tile_order(i, G, c, skipctx ? 128 : 136, 16, pm, pn)) return false;
    pm = pm_map(pm, skipctx); const int n = pn >> 2, cq = pn & 3;
    u.A = ws + OFF_O + uoff((unsigned)pm * 256u * 1024u + (unsigned)n * 256u); u.B = ws + OFF_WBR + uoff(((unsigned)n * 1024u + (unsigned)cq * 256u) * 256u); u.rows = nullptr; u.nvalid = 0;
    u.u0 = pm * 256; u.u1 = pn * 256; u.u2 = 0; u.u3 = 0; return true; } };
DEVI void phaseE1(KP p, int l, ldsp_t lds) {
  if (BIDX == 0 && TIDX < 32) wsp<int>(p, OFF_CNT)[TIDX * CNT_STRIDE] = 0;
  SchedE1 S{(const char*)p->ws, l == 1, (int)gridDim.x, BIDX};
  EpiZ8 E{wsp<unsigned char>(p, OFF_Z)};
  gemm_phase<true, false, true>(lds, 1024, 256, 2, S, E);
}
struct SchedE2 { const char* ws; const char* h8; bool skipctx; int G, c;
  DEVI bool next(int i, Unit& u) const { int pm, pn; if (!tile_order(i >> 1, G, c, skipctx ? 128 : 136, 8, pm, pn)) return false;
    pm = pm_map(pm, skipctx); const int pr = i & 1;
    u.A = h8 + uoff((unsigned)pm * 256u * 1024u); u.B = ws + OFF_WGATE + uoff((unsigned)(pr * 8 + pn) * 256u * 1024u); u.rows = nullptr; u.nvalid = 0;
    u.u0 = pm * 256; u.u1 = pn * 128; u.u2 = pr; u.u3 = 0; return true; } };
constexpr float Y8_SCALE = 16.f;
static_assert(Y8_SCALE == Z8_SCALE, "the E2 epilogue keeps its sums in Z8 units");
struct EpiE2 { const unsigned char* Z; u32x4 (&part)[8]; unsigned char* Y8; const float* bias;
  DEVI void init(f32x4 (&acc)[2][2][4][2], const Unit& u, int wr, int wc, int fr, int fq) const {
    const int col0 = u.u1 + wc * 32 + 8 * fq;
#pragma unroll
    for (int bj = 0; bj < 2; ++bj)
#pragma unroll
      for (int nn = 0; nn < 2; ++nn) {
        const f32x4 b = *(const f32x4*)(bias + (2 * u.u2 + bj) * 1024 + col0 + 4 * nn) * -LOG2E;
#pragma unroll
        for (int a = 0; a < 2; ++a)
#pragma unroll
          for (int m = 0; m < 4; ++m) acc[a][bj][m][nn] = b;
      }
  }
  DEVI void operator()(const f32x4 (&acc)[2][2][4][2], const Unit& u, int wr, int wc, int fr, int fq) const {
    const int row0 = u.u0 + wr * 64 + fr, col0 = u.u1 + wc * 32 + 8 * fq, pr = u.u2;
    const unsigned lw16 = (unsigned)((wr * 4 + wc) * 64 + fr + 16 * fq) * 16u;
    const unsigned char* zb0 = Z + z8_block(u.u0 >> 8, 2 * pr, u.u1 >> 7) + lw16;
    u32x4 zq[4][2], yq[4][2];
    auto ldpair = [&](int P, u32x4 (&z)[2], u32x4 (&y)[2]) {
#pragma unroll
      for (int bj = 0; bj < 2; ++bj) z[bj] = *(const u32x4*)(zb0 + (size_t)bj * 8 * 32768 + P * 8192);
#pragma unroll
      for (int h = 0; h < 2; ++h) y[h] = pr ? part[2 * P + h] : u32x4{0u, 0u, 0u, 0u};
    };
#pragma unroll
    for (int P = 0; P < 4; ++P) ldpair(P, zq[P], yq[P]);
#pragma unroll
    for (int P = 0; P < 4; ++P) {
      const int c = P;
#pragma unroll
      for (int h = 0; h < 2; ++h) {
        const int g = 2 * P + h, ai = g >> 2, m = g & 3;
        const size_t r = (size_t)(row0 + ai * HALF + m * 16);
        float t[8];
        {
          const unsigned w[4] = {yq[c][h].x, yq[c][h].y, yq[c][h].z, yq[c][h].w};
#pragma unroll
          for (int i = 0; i < 4; ++i) { t[2 * i] = __uint_as_float(w[i] << 16); t[2 * i + 1] = __uint_as_float(w[i] & 0xffff0000u); }
        }
#pragma unroll
        for (int bj = 0; bj < 2; ++bj) {
#pragma unroll
          for (int nn = 0; nn < 2; ++nn) {
            const int zw = (int)zq[c][bj][2 * h + nn];
            const f32x2 zlo = __builtin_amdgcn_cvt_pk_f32_fp8(zw, false), zhi = __builtin_amdgcn_cvt_pk_f32_fp8(zw, true);
            const float zz4[4] = {zlo.x, zlo.y, zhi.x, zhi.y};
#pragma unroll
            for (int j = 0; j < 4; ++j) {
              const int e = 4 * nn + j;
              const float gte = __builtin_amdgcn_rcpf(1.f + __builtin_amdgcn_exp2f(acc[ai][bj][m][nn][j]));
              t[e] += gte * zz4[j];
            }
          }
        }
        if (pr == 0) {
          u32x4 o; o.x = pk2(t[0], t[1]); o.y = pk2(t[2], t[3]); o.z = pk2(t[4], t[5]); o.w = pk2(t[6], t[7]);
          part[g] = o;
        } else {
          u32x2 o8;
#pragma unroll
          for (int w = 0; w < 2; ++w) {
            float q[4];
#pragma unroll
            for (int j = 0; j < 4; ++j) q[j] = __builtin_amdgcn_fmed3f(t[4 * w + j], -448.f, 448.f);
            int v = __builtin_amdgcn_cvt_pk_fp8_f32(q[0], q[1], 0, false);
            v = __builtin_amdgcn_cvt_pk_fp8_f32(q[2], q[3], v, true);
            o8[w] = (unsigned)v;
          }
          *(u32x2*)(Y8 + r * 1024 + col0) = o8;
        }
      }
    }
  }
};
DEVI void phaseE2(KP p, int l, ldsp_t lds) {
  SchedE2 S{(const char*)p->ws, (const char*)h8base(p), l == 1, (int)gridDim.x, BIDX};
  u32x4 part[8];
#pragma unroll
  for (int i = 0; i < 8; ++i) part[i] = u32x4{0u, 0u, 0u, 0u};
  EpiE2 E{wsp<unsigned char>(p, OFF_Z), part, wsp<unsigned char>(p, OFF_Y8), p->b_gate + (size_t)l * 4 * 1024};
  gemm_phase<true, false, true>(lds, 1024, 1024, 8, S, E);
}
struct SchedF { const char* ws; bool skipctx; int G, c;
  DEVI bool next(int i, Unit& u) const { int pm, pn;
    if (skipctx || G != 256) { if (!tile_order(i, G, c, skipctx ? 128 : 136, 4, pm, pn)) return false; }
    else if (i < 2) { if (!tile_order(i, G, c, 128, 4, pm, pn)) return false; }
    else { if (i > 2 || c >= 32) return false; pm = 128 + (c >> 2); pn = c & 3; }
    pm = pm_map(pm, skipctx);
    u.A = ws + OFF_Y8 + uoff((unsigned)pm * 256u * 1024u); u.B = ws + OFF_WOUT + uoff((unsigned)pn * 256u * 1024u); u.rows = nullptr; u.nvalid = 0;
    u.u0 = pm; u.u1 = pn * 256; u.u2 = 0; u.u3 = 0; return true; } };
struct EpiF { KP p; int l; int& prev_pm;
  DEVI void init(f32x4 (&acc)[2][2][4][2], const Unit&, int, int, int, int) const { acc_zero(acc); }
  DEVI void operator()(const f32x4 (&acc)[2][2][4][2], const Unit& u, int wr, int wc, int fr, int fq) const {
    const int pm = u.u0, b = pm / 17, rr0 = (pm % 17) * 256;
    const int mrow = (rr0 < NCTX) ? 8 : b;
    const int col0 = u.u1 + wc * 32 + 8 * fq;
    const float* gt = wsp<float>(p, OFF_MOD) + ((size_t)l * 9 + mrow) * 6144 + 2048 + col0;
    const u16* xinb = (const u16*)p->out + (size_t)(b * TPB + rr0) * 1024 + col0;
    const __amdgpu_buffer_rsrc_t xrs = __builtin_amdgcn_make_buffer_rsrc((void*)wsp<u16>(p, OFF_XM), 0, NTOK * 1024 * 2, 0x00020000);
    const unsigned xoff = (unsigned)((b * TPB + rr0) * 1024 + col0) * 2u;
    f32x4 gv[2][2];
#pragma unroll
    for (int bj = 0; bj < 2; ++bj)
#pragma unroll
      for (int n = 0; n < 2; ++n) gv[bj][n] = *(const f32x4*)(gt + bj * HALF + n * 4) * (1.f / Y8_SCALE);
#pragma unroll
    for (int ai = 0; ai < 2; ++ai) {
      u32x4 xo[4][2];
#pragma unroll
      for (int m = 0; m < 4; ++m) {
        const size_t ro = (size_t)(wr * 64 + fr + ai * HALF + m * 16) * 1024;
#pragma unroll
        for (int bj = 0; bj < 2; ++bj) xo[m][bj] = *(const u32x4*)(xinb + ro + bj * HALF);
      }
#pragma unroll
      for (int mp = 0; mp < 2; ++mp) {
#pragma unroll
        for (int mm = 0; mm < 2; ++mm) {
          const int m = 2 * mp + mm;
          const size_t ro = (size_t)(wr * 64 + fr + ai * HALF + m * 16) * 1024;
#pragma unroll
          for (int bj = 0; bj < 2; ++bj) {
            const u32x4 v = xo[m][bj];
            const f32x4 x0 = f32x4{__uint_as_float(v.x << 16), __uint_as_float(v.x & 0xffff0000u), __uint_as_float(v.y << 16), __uint_as_float(v.y & 0xffff0000u)};
            const f32x4 x1 = f32x4{__uint_as_float(v.z << 16), __uint_as_float(v.z & 0xffff0000u), __uint_as_float(v.w << 16), __uint_as_float(v.w & 0xffff0000u)};
            const f32x4 r0 = x0 + gv[bj][0] * acc[ai][bj][m][0], r1 = x1 + gv[bj][1] * acc[ai][bj][m][1];
            __builtin_amdgcn_raw_buffer_store_b128(u32x4{pk2(r0.x, r0.y), pk2(r0.z, r0.w), pk2(r1.x, r1.y), pk2(r1.z, r1.w)}, xrs,
                                                   (int)(xoff + (unsigned)(ro + bj * HALF) * 2u), 0, 16);
          }
        }
      }
    }
    asm volatile("s_waitcnt vmcnt(16)" ::: "memory");
    if (prev_pm >= 0 && (TIDX & 63) == 0) __hip_atomic_fetch_add(wsp<int>(p, OFF_DEP) + (l * 136 + prev_pm) * DEP_STRIDE, 1, __ATOMIC_RELAXED, __HIP_MEMORY_SCOPE_AGENT);
    prev_pm = pm;
  }
};
DEVI void phaseF2(KP p, int l, ldsp_t lds) {
  SchedF S{(const char*)p->ws, l == 1, (int)gridDim.x, BIDX};
  int prev_pm = -1;
  EpiF E{p, l, prev_pm};
  gemm_phase<true, false, true>(lds, 1024, 1024, 8, S, E);
  if (prev_pm >= 0 && (TIDX & 63) == 0) __hip_atomic_fetch_add(wsp<int>(p, OFF_DEP) + (l * 136 + prev_pm) * DEP_STRIDE, 1, __ATOMIC_RELAXED, __HIP_MEMORY_SCOPE_AGENT);
}


DEVI void phase0_2(KP p, ldsp_t lds) {
  const int tid = TIDX, half = tid >> 8, htid = tid & 255;
  for (int it = BIDX * 2; it < 458; it += gridDim.x * 2) {
    const int item = it + half;
    LAS float* sc = (LAS float*)(lds + half * 16384);
    const bool ismod = item < 384;
    const int l = item / 192, rem = item % 192, cgp = rem >> 3, kc = rem & 7;
    __syncthreads();
    if (ismod) {
      for (int i = htid; i < 9 * 128; i += 256) {
        int b = i >> 7, k = i & 127;
        float v = (b < 8) ? p->c[b * 1024 + kc * 128 + k] : p->c_ctx[kc * 128 + k];
        sc[i] = v / (1.f + __expf(-v));
      }
    }
    __syncthreads();
    if (ismod) {
      float acc[9];
#pragma unroll
      for (int b = 0; b < 9; ++b) acc[b] = 0.f;
      const float* w = p->w_mod + ((size_t)l * 1024 + kc * 128) * 6144 + cgp * 256 + htid;
#pragma unroll 32
      for (int k = 0; k < 128; ++k) {
        float wv = __builtin_nontemporal_load(w + (size_t)k * 6144);
#pragma unroll
        for (int b = 0; b < 9; ++b) acc[b] += sc[b * 128 + k] * wv;
      }
      float* dst = wsp<float>(p, OFF_MODP) + (size_t)((kc * 2 + l) * 9) * 6144 + cgp * 256 + htid;
#pragma unroll
      for (int b = 0; b < 9; ++b) dst[(size_t)b * 6144] = acc[b];
    } else if (item == 384) {
      float* cs32 = wsp<float>(p, OFF_CS32);
      float* cs16 = wsp<float>(p, OFF_CS16);
      for (int t = htid; t < 1024; t += 256) {
        int pos = t >> 4, i = t & 15;
        float ang = (float)pos * __builtin_amdgcn_exp2f(-(float)(2 * i) * (13.287712379549449f / 32.f));
        cs32[t * 2] = __cosf(ang); cs32[t * 2 + 1] = __sinf(ang);
      }
      for (int t = htid; t < 512; t += 256) {
        int pos = t >> 3, i = t & 7;
        float ang = (float)pos * __builtin_amdgcn_exp2f(-(float)(2 * i) * (13.287712379549449f / 16.f));
        cs16[t * 2] = __cosf(ang); cs16[t * 2 + 1] = __sinf(ang);
      }
    } else if (item < 457) {
      const int q = item - 385, ll = q / 36, o = q % 36;
      float* dst = wsp<float>(p, OFF_WRT) + ((size_t)ll * 36 + o) * 1024;
      for (int k = htid; k < 1024; k += 256)
        dst[k] = (o < 4) ? p->w_group[((size_t)ll * 1024 + k) * 4 + o] : p->w_router[((size_t)ll * 1024 + k) * 32 + (o - 4)];
    }
  }
}
DEVI void phase1_2(KP p) {
  const float* mp = wsp<float>(p, OFF_MODP);
  float* mo = wsp<float>(p, OFF_MOD);
  for (int i = BIDX * 512 + TIDX; i < 2 * 9 * 6144; i += gridDim.x * 512) {
    int l = i / (9 * 6144), o = i % 6144;
    float s = p->b_mod[l * 6144 + o];
#pragma unroll
    for (int kc = 0; kc < 8; ++kc) s += mp[(size_t)kc * 2 * 9 * 6144 + i];
    mo[i] = s;
  }
}
DEVI void phaseA2(KP p) {
  const int gw = BIDX * NW + (TIDX >> 6), nw = gridDim.x * NW;
  u16* H = wsp<u16>(p, OFF_H);
  const int per = (NTOK + nw - 1) / nw;
  const int t0 = gw * per, t1 = min(t0 + per, NTOK);
  int cur = -1; ModVec mv;
  for (int tok0 = t0; tok0 < t1; tok0 += 2) {
    float xv[2][16];
#pragma unroll
    for (int r = 0; r < 2; ++r) { const int tok = tok0 + r; if (tok < t1) load_row16(xrow_in(p, 0, tok / TPB, tok % TPB), xv[r]); }
#pragma unroll
    for (int r = 0; r < 2; ++r) {
      const int tok = tok0 + r;
      if (tok < t1) {
        const int mrow = (tok % TPB) < NCTX ? 8 : tok / TPB;
        if (mrow != cur) { load_modvec(p, 0, 0, mrow, mv); cur = mrow; }
        float hv[16]; modulate_row_store2<true, false>(mv, xv[r], nullptr, hv, h8base(p) + (size_t)tok * 1024);
        u16* xb = (u16*)p->out + (size_t)tok * 1024 + (TIDX & 63) * 4;
#pragma unroll
        for (int i = 0; i < 4; ++i) *(u32x2*)(xb + i * 256) = u32x2{pk2(xv[r][i * 4], xv[r][i * 4 + 1]), pk2(xv[r][i * 4 + 2], xv[r][i * 4 + 3])}; }
    }
  }
}
DEVI void phaseG2(KP p, int l, ldsp_t lds) {
  constexpr int RP = 2064;
  constexpr int GX = 2 * 32 * RP;
  const int tid = TIDX, lane = tid & 63, wave = __builtin_amdgcn_readfirstlane(tid >> 6);
  const int r32 = lane & 31, kh = lane >> 5, qd = lane >> 4;
  u16* H = wsp<u16>(p, OFF_H2);
  const float* WRT = wsp<float>(p, OFF_WRT) + (size_t)l * 36 * 1024;
  int* cnt = wsp<int>(p, OFF_CNT);
  int* list = wsp<int>(p, OFF_LIST);
  float* wlist = wsp<float>(p, OFF_WLIST);
  const ldsp_t hiP = lds, loP = lds + 32 * RP;
  LAS float* part = (LAS float*)lds;
  LAS int* gsel = (LAS int*)(lds + GX);
  LAS float* gwt = (LAS float*)(lds + GX + 128);
  LAS int* lcnt = (LAS int*)(lds + GX + 256);
  LAS int* gbase = lcnt + 32;
  LAS int* tinfo = lcnt + 64;
  if (tid < 32) lcnt[tid] = 0;
  int nloc = 0;
  bf16x8 whi[8], wlo[8];
  {
    const float* wr = p->w_router + (size_t)l * 1024 * 32 + r32;
#pragma unroll
    for (int s8 = 0; s8 < 8; ++s8) {
      u32x4 h, lo4;
#pragma unroll
      for (int jj = 0; jj < 4; ++jj) {
        const int k = 128 * wave + 16 * s8 + 8 * kh + 2 * jj;
        const float a = wr[(size_t)k * 32], b2 = wr[(size_t)(k + 1) * 32];
        const unsigned hp = pk2(a, b2);
        h[jj] = hp; lo4[jj] = pk2(a - __uint_as_float(hp << 16), b2 - __uint_as_float(hp & 0xffff0000u));
      }
      whi[s8] = __builtin_bit_cast(bf16x8, h); wlo[s8] = __builtin_bit_cast(bf16x8, lo4);
    }
  }
  int* tctr = wsp<int>(p, OFF_DEP) + DEP_TILECTR + l * DEP_STRIDE;
  LAS int* tnext = lcnt + 64 + 512 * 6;
  const int ntile = (l == 1) ? 8 * SEQ / 32 : NTOK / 32;
  if (tid == 0) *tnext = atomicAdd(tctr, 1);
  __syncthreads();
  for (;;) {
    const int tix = *tnext;
    if (tix >= ntile) break;
    int tclaim = 0;
    if (tid == 0) tclaim = atomicAdd(tctr, 1);
    const int tile = (l == 1) ? (tix >> 7) * 136 + 8 + (tix & 127) : tix;
    const int tok0 = tile * 32, b = tok0 / TPB, rr0 = tok0 % TPB;
    if (wave == 0) {
      const int* dep = wsp<int>(p, OFF_DEP) + (l * 136 + (tok0 >> 8)) * DEP_STRIDE;
      while (__hip_atomic_load(dep, __ATOMIC_RELAXED, __HIP_MEMORY_SCOPE_AGENT) < 32) __builtin_amdgcn_s_sleep(2);
      __builtin_amdgcn_fence(__ATOMIC_ACQUIRE, "agent");
      asm volatile("s_waitcnt vmcnt(0)" ::: "memory");
    }
    __syncthreads();
    {
      float hv[4][16], xv4[4][16];
#pragma unroll
      for (int r = 0; r < 4; ++r) load_row16_bf(wsp<u16>(p, OFF_XM) + (size_t)(tok0 + wave * 4 + r) * 1024, xv4[r]);
      ModVec mv; load_modvec(p, l, 1, (rr0 < NCTX) ? 8 : b, mv);
#pragma unroll
      for (int r = 0; r < 4; ++r) {
        modulate_row_store2<true, false>(mv, xv4[r], nullptr, hv[r], (unsigned char*)H + (size_t)(tok0 + wave * 4 + r) * 1024);
        const int ro = (wave * 4 + r) * RP + lane * 8;
#pragma unroll
        for (int i = 0; i < 4; ++i) {
          const unsigned h01 = pk2(hv[r][i * 4], hv[r][i * 4 + 1]), h23 = pk2(hv[r][i * 4 + 2], hv[r][i * 4 + 3]);
          const unsigned l01 = pk2(hv[r][i * 4] - __uint_as_float(h01 << 16), hv[r][i * 4 + 1] - __uint_as_float(h01 & 0xffff0000u));
          const unsigned l23 = pk2(hv[r][i * 4 + 2] - __uint_as_float(h23 << 16), hv[r][i * 4 + 3] - __uint_as_float(h23 & 0xffff0000u));
          *(LAS u32x2*)(hiP + ro + i * 512) = u32x2{h01, h23};
          *(LAS u32x2*)(loP + ro + i * 512) = u32x2{l01, l23};
        }
      }
      float gl[4];
#pragma unroll
      for (int o = 0; o < 4; ++o) gl[o] = router_dot(hv, WRT + (size_t)o * 1024) + p->b_group[l * 4 + o];
      int gs = 0; float best = gl[0];
#pragma unroll
      for (int j = 1; j < 4; ++j) if (gl[j] > best) { best = gl[j]; gs = j; }
      float gsum = 0.f;
#pragma unroll
      for (int j = 0; j < 4; ++j) gsum += __expf(gl[j] - best);
      if ((lane & 15) == 0) { gsel[wave * 4 + qd] = gs; gwt[wave * 4 + qd] = 1.f / gsum; }
    }
    __syncthreads();
    f32x16 acc;
#pragma unroll
    for (int i = 0; i < 16; ++i) acc[i] = 0.f;
    {
      const int ao = r32 * RP + (128 * wave + 8 * kh) * 2;
#pragma unroll
      for (int s8 = 0; s8 < 8; ++s8) {
        const bf16x8 ah = *(const LAS bf16x8*)(hiP + ao + s8 * 32), al = *(const LAS bf16x8*)(loP + ao + s8 * 32);
        acc = MFMA(ah, whi[s8], acc);
        acc = MFMA(ah, wlo[s8], acc);
        acc = MFMA(al, whi[s8], acc);
      }
    }
    __syncthreads();
#pragma unroll
    for (int i = 0; i < 16; ++i) part[(wave * 32 + (i & 3) + 8 * (i >> 2) + 4 * kh) * 33 + r32] = acc[i];
    __syncthreads();
    if (tid < 32) {
      const int gs = gsel[tid];
      const float gw_ = gwt[tid];
      float e8[8];
#pragma unroll
      for (int j = 0; j < 8; ++j) {
        float v = p->b_router[l * 32 + gs * 8 + j];
#pragma unroll
        for (int w = 0; w < 8; ++w) v += part[(w * 32 + tid) * 33 + gs * 8 + j];
        e8[j] = v;
      }
      int i0 = 0; float v0 = e8[0];
#pragma unroll
      for (int j = 1; j < 8; ++j) if (e8[j] > v0) { v0 = e8[j]; i0 = j; }
      int i1 = -1; float v1 = -INFINITY;
#pragma unroll
      for (int j = 0; j < 8; ++j) if (j != i0 && e8[j] > v1) { v1 = e8[j]; i1 = j; }
      const float ex = __expf(v1 - v0);
      const float w0 = gw_ / (1.f + ex), w1 = gw_ * ex / (1.f + ex);
      const int tok = tok0 + tid;
      const int ea = gs * 8 + i0, eb = gs * 8 + i1;
      const int ra = __hip_atomic_fetch_add(&lcnt[ea], 1, __ATOMIC_RELAXED, __HIP_MEMORY_SCOPE_WORKGROUP);
      const int rb = __hip_atomic_fetch_add(&lcnt[eb], 1, __ATOMIC_RELAXED, __HIP_MEMORY_SCOPE_WORKGROUP);
      LAS int* ti = tinfo + (nloc + tid) * 6;
      ti[0] = tok; ti[1] = ea | (eb << 8); ti[2] = ra; ti[3] = rb; ti[4] = __float_as_int(w0); ti[5] = __float_as_int(w1);
    }
    if (tid == 0) *tnext = tclaim;
    nloc += 32;
    __syncthreads();
    const bool last = *tnext >= ntile;
    if (last || nloc == 512) {
      if (tid < 32) { const int c = lcnt[tid]; gbase[tid] = c ? atomicAdd(&cnt[tid * CNT_STRIDE], c) : 0; }
      __syncthreads();
      for (int i = tid; i < nloc; i += 512) {
        const LAS int* ti = tinfo + i * 6;
        const int tok = ti[0], ea = ti[1] & 255, eb = ti[1] >> 8;
        const int sa = gbase[ea] + ti[2], sb = gbase[eb] + ti[3];
        list[(size_t)ea * NTOK + sa] = tok * 2; wlist[(size_t)ea * NTOK + sa] = __int_as_float(ti[4]);
        list[(size_t)eb * NTOK + sb] = tok * 2 + 1; wlist[(size_t)eb * NTOK + sb] = __int_as_float(ti[5]);
      }
      __syncthreads();
      if (tid < 32) lcnt[tid] = 0;
      nloc = 0;
      __syncthreads();
    }
  }
}
struct ExpInfo2 { int tiles[4], base[4], cnt[4]; };
DEVI ExpInfo2 exp_info2(KP p, int xcd) {
  const int* cnt = wsp<int>(p, OFF_CNT);
  ExpInfo2 ei;
  int before = 0;
#pragma unroll
  for (int e = 0; e < 32; ++e) {
    const int c = __builtin_amdgcn_readfirstlane(cnt[e * CNT_STRIDE]), t = (c + 255) >> 8;
    if ((e & 7) == xcd) { ei.tiles[e >> 3] = t; ei.base[e >> 3] = before; ei.cnt[e >> 3] = c; }
    before += t;
  }
  return ei;
}
template <int NN>
struct SchedX { ExpInfo2 ei; int xcd, lb, G8; const char* A; const char* W; const int* list; size_t wstride; int lda_b; int ldw_b;
  DEVI bool next(int i, Unit& u) const {
    const int tot = (ei.tiles[0] + ei.tiles[1] + ei.tiles[2] + ei.tiles[3]) * NN;
    const int n = i * G8 + lb; if (n >= tot) return false;
    int k = 0, m = n / NN; const int pn = n % NN;
    int tb = ei.base[0], ce = ei.cnt[0];
#pragma unroll
    for (int kk = 0; kk < 3; ++kk) { if (k == kk && m >= ei.tiles[kk]) { m -= ei.tiles[kk]; k = kk + 1; tb = ei.base[kk + 1]; ce = ei.cnt[kk + 1]; } }
    const int e = xcd + 8 * k;
    u.rows = list + (size_t)e * NTOK + m * 256; u.nvalid = ce - m * 256;
    u.A = A + (NN == 2 ? 0u : uoff((unsigned)(tb + m) * 256u * (unsigned)lda_b));
    u.B = W + uoff((unsigned)e * (unsigned)wstride + (unsigned)pn * 256u * (unsigned)ldw_b);
    u.u0 = (tb + m) * 256; u.u1 = pn; u.u2 = e; u.u3 = m; return true; } };
constexpr float U8_SCALE = 16.f;
struct EpiI1 { unsigned char* U;
  DEVI void init(f32x4 (&acc)[2][2][4][2], const Unit&, int, int, int, int) const { acc_zero(acc); }
  DEVI void operator()(const f32x4 (&acc)[2][2][4][2], const Unit& u, int wr, int wc, int fr, int fq) const {
#pragma unroll
    for (int ai = 0; ai < 2; ++ai)
#pragma unroll
      for (int m = 0; m < 4; ++m) {
        unsigned char* rowp = U + (size_t)(u.u0 + ai * HALF + wr * 64 + m * 16 + fr) * 256;
#pragma unroll
        for (int bj = 0; bj < 2; ++bj) {
          const int ff = 16 * (8 * u.u1 + 4 * bj + wc) + 4 * fq;
          const f32x4 g = acc[ai][bj][m][0], up = acc[ai][bj][m][1];
          float t[4];
#pragma unroll
          for (int j = 0; j < 4; ++j) t[j] = __builtin_amdgcn_fmed3f(g[j] * __builtin_amdgcn_rcpf(1.f + __builtin_amdgcn_exp2f(g[j] * -LOG2E)) * (up[j] * U8_SCALE), -448.f, 448.f);
          int o = __builtin_amdgcn_cvt_pk_fp8_f32(t[0], t[1], 0, false);
          o = __builtin_amdgcn_cvt_pk_fp8_f32(t[2], t[3], o, true);
          *(int*)(rowp + ff) = o;
        }
      }
  }
};
DEVI void phaseI1_2(KP p, ldsp_t lds) {
  const int xcd = BIDX & 7, lb = BIDX >> 3, G8 = gridDim.x >> 3;
  if (lb >= G8) return;
  SchedX<2> S{exp_info2(p, xcd), xcd, lb, G8, (const char*)wsp<u16>(p, OFF_H2), (const char*)wsp<u16>(p, OFF_W13), wsp<int>(p, OFF_LIST), (size_t)512 * 1024, 1024, 1024};
  EpiI1 E{wsp<unsigned char>(p, OFF_U)};
  int nt = 8; asm volatile("" : "+s"(nt));
  gemm_phase<false, true, true>(lds, 1024, 1024, nt, S, E);
}
constexpr float YS8_SCALE = 32.f;
struct EpiI2 { unsigned char* YS; const float* wlist; const int* list;
  DEVI void init(f32x4 (&acc)[2][2][4][2], const Unit&, int, int, int, int) const { acc_zero(acc); }
  DEVI void operator()(const f32x4 (&acc)[2][2][4][2], const Unit& u, int wr, int wc, int fr, int fq) const {
    const unsigned colb = (unsigned)(u.u1 * 256 + wc * 32 + 8 * fq);
    const float* we = wlist + (u.rows - list);
    unsigned dest[2][4]; float w[2][4];
#pragma unroll
    for (int ai = 0; ai < 2; ++ai)
#pragma unroll
      for (int m = 0; m < 4; ++m) {
        const int r = ai * HALF + wr * 64 + m * 16 + fr;
        dest[ai][m] = (r < u.nvalid) ? (unsigned)u.rows[r] : (unsigned)(2 * NTOK);
        w[ai][m] = we[r] * (YS8_SCALE / U8_SCALE);
      }
#pragma unroll
    for (int ai = 0; ai < 2; ++ai)
#pragma unroll
      for (int m = 0; m < 4; ++m) {
        unsigned char* rowp = YS + (dest[ai][m] * 1024u + colb);
#pragma unroll
        for (int bj = 0; bj < 2; ++bj) {
          u32x2 o;
#pragma unroll
          for (int nn = 0; nn < 2; ++nn) {
            const f32x4 v = acc[ai][bj][m][nn] * w[ai][m];
            int q = __builtin_amdgcn_cvt_pk_fp8_f32(__builtin_amdgcn_fmed3f(v[0], -448.f, 448.f), __builtin_amdgcn_fmed3f(v[1], -448.f, 448.f), 0, false);
            q = __builtin_amdgcn_cvt_pk_fp8_f32(__builtin_amdgcn_fmed3f(v[2], -448.f, 448.f), __builtin_amdgcn_fmed3f(v[3], -448.f, 448.f), q, true);
            o[nn] = (unsigned)q;
          }
          *(u32x2*)(rowp + bj * 128) = o;
        }
      }
  }
};
DEVI void phaseI2_2(KP p, ldsp_t lds) {
  const int xcd = BIDX & 7, lb = BIDX >> 3, G8 = gridDim.x >> 3;
  if (lb >= G8) return;
  SchedX<4> S{exp_info2(p, xcd), xcd, lb, G8, (const char*)wsp<u16>(p, OFF_U), (const char*)wsp<u16>(p, OFF_W2), wsp<int>(p, OFF_LIST), (size_t)1024 * 256, 256, 256};
  EpiI2 E{wsp<unsigned char>(p, OFF_YS), wsp<float>(p, OFF_WLIST), wsp<int>(p, OFF_LIST)};
  int nt = 2; asm volatile("" : "+s"(nt));
  gemm_phase<true, false, true>(lds, 256, 256, nt, S, E);
}
DEVI void phaseJ2(KP p, int l, ldsp_t lds) {
  const int lane = TIDX & 63;
  const int gw = BIDX * NW + (TIDX >> 6), nw = gridDim.x * NW;
  const unsigned char* YS = wsp<unsigned char>(p, OFF_YS);
  u16* H = wsp<u16>(p, OFF_H);
  const int ntot = (l == 1) ? 8 * SEQ : NTOK;
  const int per = (ntot + nw - 1) / nw;
  const int i0 = gw * per, i1 = min(i0 + per, ntot);
  int cur = -1; ModVec mv; f32x4 gtv[4];
  for (int ii = i0; ii < i1; ii += 2) {
    float xv[2][16]; int y0[2][4], y1[2][4]; bool ok[2]; int tk[2];
#pragma unroll
    for (int r = 0; r < 2; ++r) {
      const int idx = ii + r;
      const int tok = (l == 1) ? (idx / SEQ) * TPB + NCTX + idx % SEQ : idx;
      tk[r] = tok;
      ok[r] = idx < i1;
      if (ok[r]) {
        load_row16_bf<true>(wsp<u16>(p, OFF_XM) + (size_t)tok * 1024, xv[r]);
#pragma unroll
        for (int i = 0; i < 4; ++i) {
          const int c = i * 256 + lane * 4;
          y0[r][i] = *(const int*)(YS + (size_t)(tok * 2) * 1024 + c);
          y1[r][i] = *(const int*)(YS + (size_t)(tok * 2 + 1) * 1024 + c);
        }
      }
    }
#pragma unroll
    for (int r = 0; r < 2; ++r) {
      if (!ok[r]) continue;
      const int tok = tk[r];
      const int b = tok / TPB, rr = tok % TPB;
      const int mrow = (rr < NCTX) ? 8 : b;
      if (mrow != cur) {
        cur = mrow;
        const float* gt = wsp<float>(p, OFF_MOD) + ((size_t)l * 9 + mrow) * 6144 + 5120;
#pragma unroll
        for (int i = 0; i < 4; ++i) gtv[i] = *(const f32x4*)(gt + i * 256 + lane * 4);
        if (l == 0) load_modvec(p, 1, 0, mrow, mv);
      }
#pragma unroll
      for (int i = 0; i < 4; ++i) {
        const f32x4 g = gtv[i] * (1.f / YS8_SCALE);
        const f32x2 a0 = __builtin_amdgcn_cvt_pk_f32_fp8(y0[r][i], false), a1 = __builtin_amdgcn_cvt_pk_f32_fp8(y0[r][i], true);
        const f32x2 b0 = __builtin_amdgcn_cvt_pk_f32_fp8(y1[r][i], false), b1 = __builtin_amdgcn_cvt_pk_f32_fp8(y1[r][i], true);
        xv[r][i * 4 + 0] += g.x * (a0.x + b0.x);
        xv[r][i * 4 + 1] += g.y * (a0.y + b0.y);
        xv[r][i * 4 + 2] += g.z * (a1.x + b1.x);
        xv[r][i * 4 + 3] += g.w * (a1.y + b1.y);
      }
      if (l == 0) {
        u16* xr = (u16*)p->out + (size_t)tok * 1024;
#pragma unroll
        for (int i = 0; i < 4; ++i)
          *(u32x2*)(xr + i * 256 + lane * 4) = u32x2{pk2(xv[r][i * 4], xv[r][i * 4 + 1]), pk2(xv[r][i * 4 + 2], xv[r][i * 4 + 3])};
        float hv[16];
        modulate_row_store2<true, false>(mv, xv[r], nullptr, hv, h8base(p) + (size_t)tok * 1024);
      } else {
        float ss = 0.f;
#pragma unroll
        for (int i = 0; i < 16; ++i) ss += xv[r][i] * xv[r][i];
        ss = wave_sum(ss);
        const float rstd = rsqrtf(ss * (1.f / 1024.f) + EPS);
        float* xr = p->out + ((size_t)b * SEQ + rr - NCTX) * 1024;
#pragma unroll
        for (int i = 0; i < 4; ++i) {
          const int c = i * 256 + lane * 4;
          const f32x4 g = *(const f32x4*)(p->g_final + c);
          __builtin_nontemporal_store(f32x4{xv[r][i * 4] * rstd * g.x, xv[r][i * 4 + 1] * rstd * g.y, xv[r][i * 4 + 2] * rstd * g.z, xv[r][i * 4 + 3] * rstd * g.w}, (f32x4*)(xr + c));
        }
      }
    }
  }
}

constexpr int N_PHASES = 3 + 2 * 11;
__global__ void __launch_bounds__(512, 2) fwd_v2(Params parg) {
  extern __shared__ __attribute__((aligned(16))) unsigned char dyn_lds[];
  const ldsp_t lds = (ldsp_t)dyn_lds;
  cg::grid_group grid = cg::this_grid();
  volatile LAS unsigned* xb_st = (volatile LAS unsigned*)(lds + LDS_BARW);
  if (TIDX < 4) xb_st[TIDX] = 0u;
  __syncthreads();
  if (parg.ph_end - parg.ph_begin > 1) xcd_barrier_post((unsigned*)(parg.ws + OFF_BAR));
  for (int ph = parg.ph_begin; ph < parg.ph_end; ++ph) {
    KP p = (KP)__builtin_amdgcn_kernarg_segment_ptr();
    asm volatile("" : "+s"(p));
    const int l = (ph >= 14) ? 1 : 0;
    const int k = (ph < 3) ? ph : 3 + (ph - 3) % 11;
    const int reps = (((PROBE_DUP >> k) & 1) && (!(PROBE_DUP & 0x10000) || l == 0)) ? 2 : 1;
    for (int rep = 0; rep < reps; ++rep) {
      if (rep) {
        xcd_barrier((unsigned*)(p->ws + OFF_BAR), xb_st);
        if (k == 10) { if (BIDX == 0 && TIDX < 32) wsp<int>(p, OFF_CNT)[TIDX * CNT_STRIDE] = 0; xcd_barrier((unsigned*)(p->ws + OFF_BAR), xb_st); }
      }
      switch (k) {
        case 0: phase0_2(p, lds); break;
        case 1: phase1_2(p); break;
        case 2: phaseA2(p); break;
        case 3: phaseB2(p, lds); break;
        case 4: phaseC2(p, lds); break;
        case 5: phaseP2(p, l, lds); break;
        case 6: phaseD2(p, l, lds); break;
        case 7: phaseE1(p, l, lds); break;
        case 8: phaseE2(p, l, lds); break;
        case 9: phaseF2(p, l, lds); break;
        case 10: phaseG2(p, l, lds); break;
        case 11: phaseI1_2(p, lds); break;
        case 12: phaseI2_2(p, lds); break;
        default: phaseJ2(p, l, lds); break;
      }
    }
    if (k == 0 || (k == 13 && l == 0)) conv_items2(p, k == 0 ? 0 : 1, lds, 0, CONV_EARLY);
    if (ph + 1 < parg.ph_end && k != 9) {
      if (parg.ph_begin >= 1000) grid.sync();
      else xcd_barrier((unsigned*)(p->ws + OFF_BAR), xb_st);
    }
  }
}
}

extern "C" void kernel_launch(void* const* d_in, const int* in_sizes, int n_in, void* d_out, int out_size,
                              void* d_ws, size_t ws_size, hipStream_t stream) {
  static int grid2 = 0;
  if (!grid2) {
    int dev = 0, cus = 0, per_cu = 0;
    (void)hipGetDevice(&dev);
    (void)hipDeviceGetAttribute(&cus, hipDeviceAttributeMultiprocessorCount, dev);
    (void)hipFuncSetAttribute((const void*)v2::fwd_v2, hipFuncAttributeMaxDynamicSharedMemorySize, v2::LDS_TOTAL);
    (void)hipOccupancyMaxActiveBlocksPerMultiprocessor(&per_cu, v2::fwd_v2, 512, v2::LDS_TOTAL);
    if (per_cu < 1) { fprintf(stderr, "kernel does not fit on a CU\n"); per_cu = 1; }
    grid2 = cus & ~7;
  }
  if (ws_size < WS_NEEDED) { fprintf(stderr, "workspace too small: %zu < %zu\n", ws_size, (size_t)WS_NEEDED); return; }
  Params hp{};
  const float** f = (const float**)&hp;
  for (int i = 0; i < 29; ++i) f[i] = (const float*)d_in[i];
  hp.out = (float*)d_out;
  hp.ws = (char*)d_ws;
#if N_LAUNCH_MODE == 1
  for (int ph = 0; ph < v2::N_PHASES; ++ph) {
    hp.ph_begin = ph; hp.ph_end = ph + 1;
    void* args[] = {&hp};
    hipError_t e = hipLaunchCooperativeKernel((void*)v2::fwd_v2, dim3(grid2), dim3(512), args, v2::LDS_TOTAL, stream);
    if (e != hipSuccess) fprintf(stderr, "launch failed: %s\n", hipGetErrorString(e));
  }
#else
  hp.ph_begin = 0; hp.ph_end = v2::N_PHASES;
  (void)hipMemsetAsync((char*)d_ws + OFF_BAR, 0, (size_t)(OFF_DEP - OFF_BAR) + (size_t)DEP_WORDS * 4, stream);
  void* args[] = {&hp};
  hipError_t e = hipLaunchCooperativeKernel((void*)v2::fwd_v2, dim3(grid2), dim3(512), args, v2::LDS_TOTAL, stream);
  if (e != hipSuccess) fprintf(stderr, "cooperative launch failed: %s (grid %d)\n", hipGetErrorString(e), grid2);
#endif
}
```

```cpp
#include <hip/hip_runtime.h>
#include <hip/hip_cooperative_groups.h>
#include <stdint.h>
#include <stdio.h>
namespace cg = cooperative_groups;

#ifndef N_LAUNCH_MODE
#define N_LAUNCH_MODE 0
#endif

#ifndef PROBE_DUP
#define PROBE_DUP 0
#endif
#define DEVI __device__ __forceinline__
typedef unsigned short u16;
typedef __attribute__((ext_vector_type(2))) float f32x2;
typedef __attribute__((ext_vector_type(2))) __bf16 bf16x2_t;
typedef __attribute__((ext_vector_type(8))) short bf16x8;
typedef __attribute__((ext_vector_type(16))) float f32x16;
typedef __attribute__((ext_vector_type(4))) unsigned u32x4;
typedef __attribute__((ext_vector_type(2))) unsigned u32x2;
typedef __attribute__((ext_vector_type(4))) float f32x4;
#define MFMA(a, b, c) __builtin_amdgcn_mfma_f32_32x32x16_bf16((a), (b), (c), 0, 0, 0)

constexpr int DMODEL = 1024, NBATCH = 8, SEQ = 4096, NCTX = 256;
constexpr int TPB = SEQ + NCTX;
constexpr int NTOK = NBATCH * TPB;
constexpr int MT_PER_B = TPB / 128;
constexpr int NEXP = 32;
constexpr int INP = 2304;
constexpr float EPS = 1e-6f;
constexpr float LOG2E = 1.4426950408889634f;
constexpr int SMEM_BYTES = 73728;
constexpr int UROWS = 2 * NTOK + NEXP * 256;

constexpr size_t al(size_t x) { return (x + 255) & ~(size_t)255; }
constexpr size_t OFF_WIN = 0;
constexpr size_t OFF_WQB = OFF_WIN + al((size_t)INP * 1024 * 2);
constexpr size_t OFF_WKVB = OFF_WQB + al((size_t)512 * 256 * 2);
constexpr size_t OFF_WGATE = OFF_WKVB + al((size_t)512 * 256 * 2);
constexpr size_t OFF_WBR = OFF_WGATE + al((size_t)4 * 1024 * 1024 * 2);
constexpr size_t OFF_WOUT = OFF_WBR + al((size_t)4 * 1024 * 256 * 2);
constexpr size_t OFF_W13 = OFF_WOUT + al((size_t)1024 * 1024 * 2);
constexpr size_t OFF_W2 = OFF_W13 + al((size_t)32 * 512 * 1024 * 2);
constexpr size_t OFF_MODP = OFF_W2 + al((size_t)32 * 1024 * 256 * 2);
constexpr size_t OFF_MOD = OFF_MODP + al((size_t)8 * 2 * 9 * 6144 * 4);
constexpr size_t OFF_CS32 = OFF_MOD + al((size_t)2 * 9 * 6144 * 4);
constexpr size_t OFF_CS16 = OFF_CS32 + al((size_t)64 * 16 * 2 * 4);
constexpr size_t OFF_WRT = OFF_CS16 + al((size_t)64 * 8 * 2 * 4);
constexpr size_t OFF_CNT = OFF_WRT + al((size_t)2 * 36 * 1024 * 4);
constexpr int CNT_STRIDE = 64;
constexpr size_t OFF_BAR = OFF_CNT + al(32 * CNT_STRIDE * 4);
constexpr int XCD_BAR_WORDS = 3456;
constexpr size_t OFF_CTXRES = OFF_BAR + al((size_t)XCD_BAR_WORDS * 4);
constexpr size_t OFF_DEP = OFF_CTXRES;
constexpr size_t OFF_TOKRT = OFF_CTXRES + 65536;
constexpr int DEP_STRIDE = 16, DEP_TILECTR = 2 * 136 * DEP_STRIDE, DEP_E2T = DEP_TILECTR + 2 * DEP_STRIDE, DEP_E1DONE = DEP_E2T + 64 * 8, DEP_C2DONE = DEP_E1DONE + 2 * DEP_STRIDE, DEP_WORDS = DEP_C2DONE + 2 * DEP_STRIDE;
constexpr size_t OFF_H = OFF_CTXRES + al((size_t)8 * 256 * 1024 * 4);
constexpr size_t OFF_O = OFF_H + al((size_t)NTOK * 1024 * 2);
constexpr size_t OFF_SSQ = OFF_O + al((size_t)NTOK * 1024 * 2);
constexpr size_t OFF_LIST = OFF_SSQ + al((size_t)NTOK * 8 * 4);
constexpr size_t OFF_WLIST = OFF_LIST + al((size_t)32 * NTOK * 4);
constexpr size_t OFF_R1 = OFF_WLIST + al((size_t)32 * NTOK * 4);
constexpr int PLD = INP;
constexpr size_t OFF_PRAW = OFF_R1;
constexpr size_t OFF_QARAW = OFF_PRAW + (size_t)NTOK * INP * 2;
constexpr size_t OFF_KVARAW = OFF_QARAW + (size_t)NTOK * 512 * 2;
constexpr size_t OFF_VAT = OFF_KVARAW + (size_t)NTOK * 512 * 2;
constexpr size_t OFF_VBT = OFF_VAT + (size_t)NTOK * 256 * 2;
constexpr size_t OFF_VCT = OFF_VBT + (size_t)NTOK * 128 * 2;
constexpr size_t OFF_VDT = OFF_VCT + (size_t)NTOK * 256 * 2;
constexpr size_t OFF_END = OFF_VDT + (size_t)NTOK * 128 * 2;
constexpr size_t OFF_Z = OFF_R1;
constexpr size_t OFF_Y8 = OFF_H;
constexpr size_t OFF_H2 = OFF_O;
constexpr size_t OFF_YPRE = OFF_O;
constexpr size_t OFF_U = OFF_R1;
constexpr size_t OFF_YS = OFF_R1 + al((size_t)UROWS * 256 * 2);
constexpr size_t OFF_XM = OFF_YS + al((size_t)(2 * NTOK + 1) * 1024 * 2);
static_assert(OFF_XM + (size_t)NTOK * 1024 * 2 <= OFF_END, "alias overflow");
static_assert(OFF_Z + (size_t)NTOK * 4096 * 2 <= OFF_END, "alias overflow");
static_assert(OFF_YS + (size_t)(2 * NTOK + 1) * 1024 * 2 <= OFF_END, "alias overflow");
constexpr size_t OFF_E2PART = OFF_END - (size_t)128 * 65536;
static_assert(OFF_E2PART >= OFF_Z + (size_t)NTOK * 4096, "alias overflow");
constexpr size_t WS_NEEDED = OFF_END;
static_assert(WS_NEEDED <= (size_t)536870912, "workspace budget (4 x largest tensor)");

struct Params {
  const float *x, *c, *ctx, *c_ctx, *w_mod, *b_mod, *g_norm_mix, *w_in, *g_q_a, *w_q_b, *g_kv_a, *w_kv_b,
      *sink_b, *rpb_c, *g_q_d, *g_k_d, *w_gate, *b_gate, *w_branch, *w_out, *g_norm_ffn, *w_group, *b_group,
      *w_router, *b_router, *w_ff1, *w_ff3, *w_ff2, *g_final;
  float* out;
  char* ws;
  int ph_begin, ph_end;
};

DEVI int tid_fresh() { int t; asm volatile("v_mov_b32 %0, %1" : "=v"(t) : "v"(__builtin_amdgcn_workitem_id_x())); return t; }
DEVI int bid_fresh() { int t; asm volatile("s_mov_b32 %0, %1" : "=s"(t) : "s"(__builtin_amdgcn_workgroup_id_x())); return t; }
#define TIDX tid_fresh()
#define BIDX bid_fresh()
typedef const __attribute__((address_space(4))) Params* KP;
DEVI unsigned pk2(float a, float b) { f32x2 v = {a, b}; bf16x2_t r = __builtin_convertvector(v, bf16x2_t); return __builtin_bit_cast(unsigned, r); }
DEVI u16 f2bf(float a) { return (u16)(pk2(a, 0.f) & 0xffffu); }
DEVI float bf2f(u16 v) { return __uint_as_float(((unsigned)v) << 16); }
DEVI float wave_sum(float v) {
#pragma unroll
  for (int m = 32; m >= 1; m >>= 1) v += __shfl_xor(v, m);
  return v;
}
template <class T> DEVI T* wsp(KP p, size_t off) { return (T*)(p->ws + off); }
DEVI const float* xrow_in(KP p, int l, int b, int rr) {
  if (l == 0) return (rr < NCTX) ? p->ctx + ((size_t)b * NCTX + rr) * 1024 : p->x + ((size_t)b * SEQ + rr - NCTX) * 1024;
  return (rr < NCTX) ? wsp<float>(p, OFF_CTXRES) + ((size_t)b * NCTX + rr) * 1024 : p->out + ((size_t)b * SEQ + rr - NCTX) * 1024;
}
DEVI float* xrow_res(KP p, int b, int rr) {
  return (rr < NCTX) ? wsp<float>(p, OFF_CTXRES) + ((size_t)b * NCTX + rr) * 1024 : p->out + ((size_t)b * SEQ + rr - NCTX) * 1024;
}
DEVI int perm16(int k) { return (k & ~12) | ((k & 4) << 1) | ((k & 8) >> 1); }

struct ConvT { const float* src; const float* src2; const float* ks; u16* dst; int ld; int ldd; float mul; int rp; };
constexpr float Z8_SCALE = 16.f, O8_SCALE = 32.f;
constexpr float F8_WSCALE = 64.f, GATE_WSCALE = F8_WSCALE;
constexpr int CONV_ITEMS = 1152 + 64 + 64 + 2048 + 512 + 512 + 8192 + 4096;
DEVI ConvT conv_decode(KP p, int l, int idx) {
  ConvT c; c.ks = nullptr; c.mul = 1.f; c.src2 = nullptr; c.rp = 0;
  if (idx < 1152) {
    int nt = idx >> 4, kt = idx & 15, n0 = nt * 32;
    int sc = (n0 < 416) ? n0 : ((n0 < 512) ? -1 : n0 - 96);
    c.ld = 2208; c.ldd = -1024;
    c.mul = F8_WSCALE;
    if ((n0 >= 512 && n0 < 768) || (n0 >= 1024 && n0 < 1280)) c.mul = 0.125f * LOG2E * F8_WSCALE;
    c.src = (sc < 0) ? nullptr : p->w_in + (size_t)l * 1024 * 2208 + (size_t)kt * 64 * 2208 + sc;
    c.dst = (u16*)(p->ws + OFF_WIN + (size_t)n0 * 1024 + kt * 64);
    return c;
  }
  idx -= 1152;
  if (idx < 64) {
    int nt = idx >> 2, kt = idx & 3;
    c.ld = 384; c.ldd = 256; c.ks = p->g_q_a + l * 256 + kt * 64;
    c.src = (nt >= 12) ? nullptr : p->w_q_b + (size_t)l * 256 * 384 + (size_t)kt * 64 * 384 + nt * 32;
    c.dst = wsp<u16>(p, OFF_WQB) + (size_t)nt * 32 * 256 + kt * 64;
    return c;
  }
  idx -= 64;
  if (idx < 64) {
    int nt = idx >> 2, kt = idx & 3;
    c.ld = 512; c.ldd = 256; c.ks = (kt < 2) ? p->g_kv_a + l * 128 + kt * 64 : nullptr;
    c.src = (kt >= 2) ? nullptr : p->w_kv_b + (size_t)l * 128 * 512 + (size_t)kt * 64 * 512 + nt * 32;
    c.dst = wsp<u16>(p, OFF_WKVB) + (size_t)nt * 32 * 256 + kt * 64;
    return c;
  }
  idx -= 64;
  if (idx < 2048) {
    int nt = idx >> 4, kt = idx & 15, R0 = nt * 32;
    int pr = R0 >> 11, cb = (R0 & 2047) >> 8, bj = (R0 & 255) >> 7, j0 = R0 & 127;
    c.ld = 1024; c.ldd = -1024; c.mul = -LOG2E * F8_WSCALE;
    c.src = p->w_gate + ((size_t)(l * 4 + 2 * pr + bj) * 1024 + kt * 64) * 1024 + cb * 128 + j0;
    c.dst = (u16*)(p->ws + OFF_WGATE + (size_t)R0 * 1024 + kt * 64);
    return c;
  }
  idx -= 2048;
  if (idx < 512) {
    int br = idx >> 7, nt = (idx >> 2) & 31, kt = idx & 3;
    c.ld = 1024; c.ldd = -256; c.mul = F8_WSCALE * (Z8_SCALE / O8_SCALE);
    c.src = p->w_branch + ((size_t)(l * 4 + br) * 256 + kt * 64) * 1024 + nt * 32;
    c.dst = (u16*)(p->ws + OFF_WBR + ((size_t)br * 1024 + nt * 32) * 256 + kt * 64);
    return c;
  }
  idx -= 512;
  if (idx < 512) {
    int nt = idx >> 4, kt = idx & 15;
    c.ld = 1024; c.ldd = -1024; c.mul = F8_WSCALE;
    c.src = p->w_out + ((size_t)l * 1024 + kt * 64) * 1024 + nt * 32;
    c.dst = (u16*)(p->ws + OFF_WOUT + (size_t)nt * 32 * 1024 + kt * 64);
    return c;
  }
  idx -= 512;
  if (idx < 8192) {
    int e = idx >> 8, g32 = (idx >> 4) & 15, kt = idx & 15;
    c.ld = 256; c.ldd = -1024; c.mul = F8_WSCALE;
    c.src = p->w_ff1 + ((size_t)(l * 32 + e) * 1024 + kt * 64) * 256 + g32 * 16;
    c.src2 = p->w_ff3 + ((size_t)(l * 32 + e) * 1024 + kt * 64) * 256 + g32 * 16;
    c.dst = (u16*)(p->ws + OFF_W13 + ((size_t)e * 512 + g32 * 32) * 1024 + kt * 64);
    return c;
  }
  idx -= 8192;
  {
    int e = idx >> 7, nt = (idx >> 2) & 31, kt = idx & 3;
    c.ld = 1024; c.ldd = -256; c.mul = F8_WSCALE;
    c.src = p->w_ff2 + ((size_t)(l * 32 + e) * 256 + kt * 64) * 1024 + nt * 32;
    c.rp = 1;
    c.dst = (u16*)(p->ws + OFF_W2 + ((size_t)e * 1024 + (nt >> 3) * 256 + ((nt & 7) >> 1) * 32 + (nt & 1) * 16) * 256 + kt * 64);
    return c;
  }
}
DEVI void modulate_row_store(KP p, int l, int which, const float (&xv)[16], int mrow, u16* hrow, float (&hv)[16]) {
  const int lane = TIDX & 63;
  float ss = 0.f;
#pragma unroll
  for (int i = 0; i < 16; ++i) ss += xv[i] * xv[i];
  ss = wave_sum(ss);
  const float rstd = rsqrtf(ss * (1.f / 1024.f) + EPS);
  const float* g = (which ? p->g_norm_ffn : p->g_norm_mix) + l * 1024;
  const float* mod = wsp<float>(p, OFF_MOD) + ((size_t)l * 9 + mrow) * 6144 + (which ? 3072 : 0);
#pragma unroll
  for (int i = 0; i < 4; ++i) {
    const int c = i * 256 + lane * 4;
    f32x4 gv = *(const f32x4*)(g + c);
    f32x4 sh = *(const f32x4*)(mod + c);
    f32x4 sc = *(const f32x4*)(mod + 1024 + c);
    hv[i * 4 + 0] = xv[i * 4 + 0] * rstd * gv.x * (1.f + sc.x) + sh.x;
    hv[i * 4 + 1] = xv[i * 4 + 1] * rstd * gv.y * (1.f + sc.y) + sh.y;
    hv[i * 4 + 2] = xv[i * 4 + 2] * rstd * gv.z * (1.f + sc.z) + sh.z;
    hv[i * 4 + 3] = xv[i * 4 + 3] * rstd * gv.w * (1.f + sc.w) + sh.w;
    u32x2 o; o.x = pk2(hv[i * 4 + 0], hv[i * 4 + 1]); o.y = pk2(hv[i * 4 + 2], hv[i * 4 + 3]);
    *(u32x2*)(hrow + c) = o;
  }
}
struct ModVec { f32x4 a[4], b[4]; };
DEVI void load_modvec(KP p, int l, int which, int mrow, ModVec& mv) {
  const int lane = TIDX & 63;
  const float* g = (which ? p->g_norm_ffn : p->g_norm_mix) + l * 1024;
  const float* mod = wsp<float>(p, OFF_MOD) + ((size_t)l * 9 + mrow) * 6144 + (which ? 3072 : 0);
#pragma unroll
  for (int i = 0; i < 4; ++i) {
    const int c = i * 256 + lane * 4;
    const f32x4 gv = *(const f32x4*)(g + c), sh = *(const f32x4*)(mod + c), sc = *(const f32x4*)(mod + 1024 + c);
    mv.a[i] = gv * (1.f + sc); mv.b[i] = sh;
  }
}
DEVI unsigned char* h8base(KP p) { return (unsigned char*)p->out + (size_t)NTOK * 2048; }
template <bool F8COPY = false, bool BF16 = true>
DEVI void modulate_row_store2(const ModVec& mv, const float (&xv)[16], u16* hrow, float (&hv)[16], unsigned char* h8row = nullptr) {
  const int lane = TIDX & 63;
  float ss = 0.f;
#pragma unroll
  for (int i = 0; i < 16; ++i) ss += xv[i] * xv[i];
  ss = wave_sum(ss);
  const float rstd = rsqrtf(ss * (1.f / 1024.f) + EPS);
#pragma unroll
  for (int i = 0; i < 4; ++i) {
    const int c = i * 256 + lane * 4;
#pragma unroll
    for (int j = 0; j < 4; ++j) hv[i * 4 + j] = xv[i * 4 + j] * rstd * mv.a[i][j] + mv.b[i][j];
    if (BF16) { u32x2 o; o.x = pk2(hv[i * 4 + 0], hv[i * 4 + 1]); o.y = pk2(hv[i * 4 + 2], hv[i * 4 + 3]);
      *(u32x2*)(hrow + c) = o; }
    if (F8COPY) {
      float q[4];
#pragma unroll
      for (int j = 0; j < 4; ++j) q[j] = __builtin_amdgcn_fmed3f(hv[i * 4 + j], -448.f, 448.f);
      int v = __builtin_amdgcn_cvt_pk_fp8_f32(q[0], q[1], 0, false);
      v = __builtin_amdgcn_cvt_pk_fp8_f32(q[2], q[3], v, true);
      *(int*)(h8row + c) = v;
    }
  }
}
DEVI void load_row16(const float* xr, float (&xv)[16]) {
  const int lane = TIDX & 63;
#pragma unroll
  for (int i = 0; i < 4; ++i) {
    f32x4 v = __builtin_nontemporal_load((const f32x4*)(xr + i * 256 + lane * 4));
    xv[i * 4 + 0] = v.x; xv[i * 4 + 1] = v.y; xv[i * 4 + 2] = v.z; xv[i * 4 + 3] = v.w;
  }
}
template <bool NT = false>
DEVI void load_row16_bf(const u16* xr, float (&xv)[16]) {
  const int lane = TIDX & 63;
#pragma unroll
  for (int i = 0; i < 4; ++i) {
    const u32x2 v = NT ? __builtin_nontemporal_load((const u32x2*)(xr + i * 256 + lane * 4)) : *(const u32x2*)(xr + i * 256 + lane * 4);
    xv[i * 4 + 0] = __uint_as_float(v.x << 16); xv[i * 4 + 1] = __uint_as_float(v.x & 0xffff0000u);
    xv[i * 4 + 2] = __uint_as_float(v.y << 16); xv[i * 4 + 3] = __uint_as_float(v.y & 0xffff0000u);
  }
}
DEVI float router_dot(const float (&hv)[4][16], const float* wrow) {
  const int lane = TIDX & 63;
  const float* w = wrow + lane * 4;
  float pr[4] = {0.f, 0.f, 0.f, 0.f};
#pragma unroll
  for (int i = 0; i < 4; ++i) {
    const f32x4 wv = *(const f32x4*)(w + i * 256);
#pragma unroll
    for (int r = 0; r < 4; ++r)
      pr[r] += hv[r][i * 4] * wv.x + hv[r][i * 4 + 1] * wv.y + hv[r][i * 4 + 2] * wv.z + hv[r][i * 4 + 3] * wv.w;
  }
  const bool up = (lane & 32) != 0;
  float s0 = up ? pr[0] : pr[2], s1 = up ? pr[1] : pr[3];
  float k0 = up ? pr[2] : pr[0], k1 = up ? pr[3] : pr[1];
  k0 += __shfl_xor(s0, 32); k1 += __shfl_xor(s1, 32);
  const bool up2 = (lane & 16) != 0;
  float sv = up2 ? k0 : k1, kv = up2 ? k1 : k0;
  kv += __shfl_xor(sv, 16);
  kv += __shfl_xor(kv, 8); kv += __shfl_xor(kv, 4); kv += __shfl_xor(kv, 2); kv += __shfl_xor(kv, 1);
  return kv;
}
#define XB_TMO      128
#define XB_XCNT(j)  (256  + 64 * (j))
#define XB_XSUB(j)  (1280 + 64 * (j))
#define XB_XGEN(j)  (2304 + 64 * (j))
#define XB_TOP      3328
#define XB_TOPGEN   3392
#define XB_SPIN_CAP (1u << 20)
#define LAS __attribute__((address_space(3)))
DEVI unsigned xb_ld(unsigned* p) { return __hip_atomic_load(p, __ATOMIC_RELAXED, __HIP_MEMORY_SCOPE_AGENT); }
DEVI unsigned xb_add(unsigned* p, unsigned v) { return __hip_atomic_fetch_add(p, v, __ATOMIC_RELAXED, __HIP_MEMORY_SCOPE_AGENT); }
DEVI unsigned xb_xcc_id() { return (unsigned)__builtin_amdgcn_s_getreg((3 << 11) | 20) & 0xFu; }
#define XB_SPIN(cond, bar) do { unsigned _sp = 0; while (cond) { __builtin_amdgcn_s_sleep(1); \
    if ((++_sp & 255u) == 0u) { if (xb_ld(&(bar)[XB_TMO])) break; if (_sp > XB_SPIN_CAP) { atomicAdd(&(bar)[XB_TMO], 1u); break; } } } } while (0)
DEVI void xcd_barrier_post(unsigned* bar) {
  if (TIDX == 0) (void)xb_add(&bar[XB_XCNT(xb_xcc_id())], 1u);
}
DEVI void xcd_barrier_complete(unsigned* bar, unsigned x, unsigned& nloc, unsigned& nx) {
  const unsigned G = gridDim.x * gridDim.y * gridDim.z;
  unsigned sum, cnt, mine, sp = 0u;
  for (;;) {
    sum = 0u; cnt = 0u; mine = 0u;
#pragma unroll
    for (unsigned j = 0; j < 16; ++j) { const unsigned c = xb_ld(&bar[XB_XCNT(j)]); sum += c; cnt += (c > 0u) ? 1u : 0u; mine = (j == x) ? c : mine; }
    if (sum == G) break;
    __builtin_amdgcn_s_sleep(1);
    if ((++sp & 255u) == 0u) { if (xb_ld(&bar[XB_TMO])) break; if (sp > XB_SPIN_CAP) { atomicAdd(&bar[XB_TMO], 1u); break; } }
  }
  nloc = mine > 0u ? mine : 1u; nx = cnt > 0u ? cnt : 1u;
}
DEVI void xcd_barrier(unsigned* bar, volatile LAS unsigned* st) {
  asm volatile("s_waitcnt vmcnt(0)" ::: "memory");
  __syncthreads();
  if (TIDX == 0) {
    const unsigned x = xb_xcc_id();
    __builtin_amdgcn_s_waitcnt(0);
    unsigned nloc = st[0], nx = st[1];
    if (nloc == 0u) { xcd_barrier_complete(bar, x, nloc, nx); st[0] = nloc; st[1] = nx; }
    const unsigned old = xb_add(&bar[XB_XSUB(x)], 1u);
    const unsigned gen = old / nloc;
    if (old + 1u == (gen + 1u) * nloc) {
      __builtin_amdgcn_fence(__ATOMIC_RELEASE, "agent");
      asm volatile("s_waitcnt vmcnt(0)" ::: "memory");
      asm volatile("buffer_inv sc1" ::: "memory");
      const unsigned og = xb_add(&bar[XB_TOP], 1u);
      const unsigned tg = og / nx;
      if (og + 1u != (tg + 1u) * nx) XB_SPIN(xb_ld(&bar[XB_TOP]) < (tg + 1u) * nx, bar);
      asm volatile("s_waitcnt vmcnt(0)" ::: "memory");
      xb_add(&bar[XB_XGEN(x)], 1u);
      asm volatile("s_waitcnt vmcnt(0)" ::: "memory");
    } else {
      asm volatile("buffer_inv sc1" ::: "memory");
      XB_SPIN(xb_ld(&bar[XB_XGEN(x)]) == gen, bar);
      asm volatile("s_waitcnt vmcnt(0)" ::: "memory");
    }
  }
  __syncthreads();
}

namespace v2 {
typedef LAS unsigned char* ldsp_t;
constexpr int BM = 256, BK = 64, HALF = 128, HTB = HALF * BK * 2, STAGE_BYTES = 8 * HTB;
constexpr int NW = 8;
constexpr int LDS_XTRA = STAGE_BYTES;
constexpr int LDS_BARW = STAGE_BYTES + 16384;
constexpr int LDS_TOTAL = LDS_BARW + 16;

DEVI int lds_byte(int r, int c) { const int st = (r >> 4) * 2 + (c >> 5), rr = r & 15, cc = c & 31, ob = rr * 64 + cc * 2; return st * 1024 + (ob ^ (((ob >> 9) & 1) << 5)); }
DEVI void stage_rc(int b, int& R, int& C) { const int st = b / 1024, sb = b % 1024, swz = sb ^ (((sb >> 9) & 1) << 5); R = (st >> 1) * 16 + swz / 64; C = (st & 1) * 32 + (swz % 64) / 2; }
DEVI int perm32(int rho) { const int n = rho >> 4, i = rho & 15; return 8 * (i >> 2) + 4 * n + (i & 3); }

DEVI void acc_zero(f32x4 (&acc)[2][2][4][2]) {
#pragma unroll
  for (int a = 0; a < 2; ++a)
#pragma unroll
    for (int b = 0; b < 2; ++b)
#pragma unroll
      for (int m = 0; m < 4; ++m)
#pragma unroll
        for (int n = 0; n < 2; ++n) acc[a][b][m][n] = (f32x4){0.f, 0.f, 0.f, 0.f};
}
struct Unit { const char* A; const char* B; const int* rows; int nvalid; int u0, u1, u2, u3; };

typedef int i32x8 __attribute__((ext_vector_type(8)));
typedef int i32x4v __attribute__((ext_vector_type(4)));
DEVI i32x8 cat8(bf16x8 lo, bf16x8 hi) { return __builtin_shufflevector(__builtin_bit_cast(i32x4v, lo), __builtin_bit_cast(i32x4v, hi), 0, 1, 2, 3, 4, 5, 6, 7); }
DEVI const char* sptr(const char* p) {
  const unsigned long long v = (unsigned long long)p;
  const unsigned lo = (unsigned)__builtin_amdgcn_readfirstlane((int)(unsigned)v), hi = (unsigned)__builtin_amdgcn_readfirstlane((int)(unsigned)(v >> 32));
  return (const char*)(((unsigned long long)hi << 32) | lo);
}
template <bool PERM, bool GATHER, bool F8, class Epi, class Sched>
DEVI void gemm_phase(ldsp_t lds, int lda_b, int ldb_b, int nt, const Sched& S, const Epi& E) {
  const int tid = TIDX, wid = __builtin_amdgcn_readfirstlane(tid >> 6), lane = tid & 63, wr = wid >> 2, wc = wid & 3, fr = lane & 15, fq = lane >> 4;
  unsigned voffA[2], voffB[2]; int RA[2], CA2[2];
#pragma unroll
  for (int i = 0; i < 2; ++i) {
    int R, C; stage_rc(tid * 16 + i * 8192, R, C);
    const int Rb = PERM ? ((R & ~31) + perm32(R & 31)) : R;
    RA[i] = R; CA2[i] = C * 2;
    voffA[i] = (unsigned)(R * lda_b + C * 2); voffB[i] = (unsigned)(Rb * ldb_b + C * 2);
  }
  const size_t kstep = (size_t)(BK * 2);
  const size_t hstepA = (size_t)HALF * lda_b, hstepB = (size_t)HALF * ldb_b;
  const unsigned ldsw = (unsigned)wid * 1024u, ldsbase = (unsigned)(size_t)lds;
  const int aoff = lds_byte(wr * 64 + fr, fq * 8), boff = lds_byte(wc * 32 + fr, fq * 8);
#define G_SA(b, h) (((b) * 2 + (h)) * HTB)
#define G_SB(b, h) ((4 + (b) * 2 + (h)) * HTB)
#define G_DMA(sbase, voff, ldsaddr) asm volatile("s_mov_b32 m0, %2\n\ts_nop 0\n\tglobal_load_lds_dwordx4 %0, %1" :: "v"(voff), "s"(sbase), "s"(ldsaddr) : "memory", "m0")
#define G_STAGE(bufoff, gbase, voff) do { const char* sb_ = sptr((const char*)(gbase)); _Pragma("unroll") for (int _i = 0; _i < 2; ++_i) \
    G_DMA(sb_, (voff)[_i], (unsigned)__builtin_amdgcn_readfirstlane((int)(ldsbase + (unsigned)(bufoff) + ldsw + (unsigned)_i * 8192u))); } while (0)
#define G_STAGE_A(bufoff, abase, go, h, koff) do { if (GATHER) { const char* sb_ = sptr((const char*)(abase) + (koff)); _Pragma("unroll") for (int _i = 0; _i < 2; ++_i) \
    G_DMA(sb_, (go)[h][_i], (unsigned)__builtin_amdgcn_readfirstlane((int)(ldsbase + (unsigned)(bufoff) + ldsw + (unsigned)_i * 8192u))); } \
    else G_STAGE(bufoff, (abase) + (h) * hstepA + (koff), voffA); } while (0)
#define G_LDA(dst, b, h) do { _Pragma("unroll") for (int m = 0; m < 4; ++m) { if (F8) dst##8[m] = cat8(*(const LAS bf16x8*)(lds + G_SA(b, h) + aoff + m * 2048), *(const LAS bf16x8*)(lds + G_SA(b, h) + aoff + m * 2048 + 1024)); \
    else { _Pragma("unroll") for (int k = 0; k < 2; ++k) dst[m][k] = *(const LAS bf16x8*)(lds + G_SA(b, h) + aoff + m * 2048 + k * 1024); } } } while (0)
#define G_LDB(dst, b, h) do { _Pragma("unroll") for (int n = 0; n < 2; ++n) { if (F8) dst##8[n] = cat8(*(const LAS bf16x8*)(lds + G_SB(b, h) + boff + n * 2048), *(const LAS bf16x8*)(lds + G_SB(b, h) + boff + n * 2048 + 1024)); \
    else { _Pragma("unroll") for (int k = 0; k < 2; ++k) dst[n][k] = *(const LAS bf16x8*)(lds + G_SB(b, h) + boff + n * 2048 + k * 1024); } } } while (0)
#define G_MMA(ai, bj, At, Bt) do { __builtin_amdgcn_s_setprio(1); _Pragma("unroll") for (int m = 0; m < 4; ++m) _Pragma("unroll") for (int n = 0; n < 2; ++n) { \
    if (F8) asm("v_mfma_scale_f32_16x16x128_f8f6f4 %0, %1, %2, %0, %3, %4 op_sel_hi:[0,0,0]" : "+v"(acc[ai][bj][m][n]) : "v"(Bt##8[n]), "v"(At##8[m]), "v"(f8wscale), "v"(f8ascale)); \
    else { _Pragma("unroll") for (int k = 0; k < 2; ++k) acc[ai][bj][m][n] = __builtin_amdgcn_mfma_f32_16x16x32_bf16(Bt[n][k], At[m][k], acc[ai][bj][m][n], 0, 0, 0); } } \
    __builtin_amdgcn_s_setprio(0); } while (0)
#define G_WAIT_V(n) asm volatile("s_waitcnt vmcnt(" #n ")" ::: "memory")
#define G_WAIT_L(n) asm volatile("s_waitcnt lgkmcnt(" #n ")" ::: "memory")
#define G_BAR __builtin_amdgcn_s_barrier()
#define G_SCHED __builtin_amdgcn_sched_barrier(0)
  Unit cur, nxt; int ui = 0;
  if (!S.next(0, cur)) return;
  f32x4 acc[2][2][4][2];
  E.init(acc, cur, wr, wc, fr, fq);
  bf16x8 At[4][2], B0[2][2], B1[2][2];
  i32x8 At8[4], B08[2], B18[2];
  const int f8wscale = 0x79797979, f8ascale = 0x7f7f7f7f;
  unsigned gcur[2][2];
  auto gather_offs = [&](const Unit& u, unsigned (&go)[2][2]) {
#pragma unroll
    for (int h = 0; h < 2; ++h)
#pragma unroll
      for (int i = 0; i < 2; ++i) {
        const int r = h * HALF + RA[i];
        const int t = (r < u.nvalid) ? (u.rows[r] >> 1) : 0;
        go[h][i] = (unsigned)t * (unsigned)lda_b + (unsigned)CA2[i];
      }
  };
  if (GATHER) gather_offs(cur, gcur);
  const char* cA = cur.A; const char* cB = cur.B;
  G_STAGE(G_SB(0, 0), cB, voffB); G_STAGE_A(G_SA(0, 0), cA, gcur, 0, 0); G_STAGE(G_SB(0, 1), cB + hstepB, voffB); G_STAGE_A(G_SA(0, 1), cA, gcur, 1, 0);
  if (wr == 1) G_BAR;
  G_WAIT_V(4); G_BAR;
  G_STAGE(G_SB(1, 0), cB + kstep, voffB); G_STAGE_A(G_SA(1, 0), cA, gcur, 0, kstep); G_STAGE(G_SB(1, 1), cB + hstepB + kstep, voffB);
  G_WAIT_V(6); G_BAR;
  for (;;) {
    const bool has_next = S.next(ui + 1, nxt);
    const char* nA = has_next ? nxt.A : cA; const char* nB = has_next ? nxt.B : cB;
#pragma clang loop unroll(disable)
    for (int t = 0; t < nt; t += 2) {
      const bool last = (t == nt - 2);
      const size_t k1 = (size_t)(t + 1) * kstep;
      const char* a2 = last ? nA : cA; const char* b2 = last ? nB : cB + (size_t)(t + 2) * kstep;
      const size_t ka2 = last ? 0 : (size_t)(t + 2) * kstep;
      const char* b3 = b2 + kstep; const size_t ka3 = ka2 + kstep;
      unsigned gN[2][2];
      if (GATHER && last) {
        if (has_next) gather_offs(nxt, gN);
        else {
#pragma unroll
          for (int h = 0; h < 2; ++h)
#pragma unroll
            for (int i = 0; i < 2; ++i) gN[h][i] = gcur[h][i];
        }
      }
#define G_STAGE_A2(bufoff, h, koff) do { if (GATHER) { if (last) G_STAGE_A(bufoff, cA, gN, h, (koff) - ka2); else G_STAGE_A(bufoff, cA, gcur, h, koff); } \
        else G_STAGE_A(bufoff, a2, gcur, h, koff); } while (0)
      G_LDB(B0, 0, 0); G_SCHED; G_LDA(At, 0, 0); G_STAGE_A(G_SA(1, 1), cA, gcur, 1, k1);
      G_WAIT_L(8); G_BAR; G_WAIT_L(0); G_MMA(0, 0, At, B0); G_BAR; G_SCHED;
      G_LDB(B1, 0, 1); G_STAGE(G_SB(0, 0), b2, voffB);
      G_BAR; G_WAIT_L(0); G_MMA(0, 1, At, B1); G_BAR;
      G_LDA(At, 0, 1); G_STAGE_A2(G_SA(0, 0), 0, ka2);
      G_BAR; G_WAIT_L(0); G_MMA(1, 0, At, B0); G_BAR; G_SCHED;
      G_STAGE(G_SB(0, 1), b2 + hstepB, voffB);
      G_WAIT_V(6); G_BAR; G_MMA(1, 1, At, B1); G_BAR;
      G_LDB(B0, 1, 0); G_SCHED; G_LDA(At, 1, 0); G_STAGE_A2(G_SA(0, 1), 1, ka2);
      G_WAIT_L(8); G_BAR; G_WAIT_L(0); G_MMA(0, 0, At, B0); G_BAR; G_SCHED;
      G_LDB(B1, 1, 1); G_STAGE(G_SB(1, 0), b3, voffB);
      G_BAR; G_WAIT_L(0); G_MMA(0, 1, At, B1); G_BAR;
      G_LDA(At, 1, 1); G_STAGE_A2(G_SA(1, 0), 0, ka3);
      G_BAR; G_WAIT_L(0); G_MMA(1, 0, At, B0); G_BAR; G_SCHED;
      G_STAGE(G_SB(1, 1), b3 + hstepB, voffB);
      G_WAIT_V(6); G_BAR; G_MMA(1, 1, At, B1); G_BAR;
      if (GATHER && last) {
#pragma unroll
        for (int h = 0; h < 2; ++h)
#pragma unroll
          for (int i = 0; i < 2; ++i) gcur[h][i] = gN[h][i];
      }
#undef G_STAGE_A2
    }
    G_SCHED;
    if (F8) {
      asm volatile("s_nop 15\n\ts_nop 15" ::: "memory");
#pragma unroll
      for (int a_ = 0; a_ < 2; ++a_)
#pragma unroll
        for (int b_ = 0; b_ < 2; ++b_)
#pragma unroll
          for (int m_ = 0; m_ < 4; ++m_)
#pragma unroll
            for (int n_ = 0; n_ < 2; ++n_) asm volatile("" : "+v"(acc[a_][b_][m_][n_]));
    }
    E(acc, cur, wr, wc, fr, fq);
    G_SCHED;
    if (!has_next) break;
    cur = nxt; cA = nA; cB = nB; ++ui;
    E.init(acc, cur, wr, wc, fr, fq);
  }
  G_WAIT_V(0);
  if (wr == 0) G_BAR;
  G_BAR;
#undef G_SA
#undef G_SB
#undef G_STAGE
#undef G_DMA
#undef G_STAGE_A
#undef G_LDA
#undef G_LDB
#undef G_MMA
#undef G_WAIT_V
#undef G_WAIT_L
#undef G_BAR
#undef G_SCHED
}

DEVI unsigned uoff(unsigned x) { return (unsigned)__builtin_amdgcn_readfirstlane((int)x); }
DEVI bool tile_order(int i, int G, int c, int nM, int nN, int& pm, int& pn) {
  const int nwg = nM * nN;
  const long L = (long)i * G + c; if (L >= nwg) return false;
  int wgid = (int)L; { const int q = nwg / 8, r = nwg % 8, xcd = wgid % 8, off = wgid / 8; wgid = (xcd < r ? xcd * (q + 1) : r * (q + 1) + (xcd - r) * q) + off; }
  const int WGM = 8;
  const int nig = WGM * nN, gid = wgid / nig, fm = gid * WGM, gsz = (nM - fm) < WGM ? (nM - fm) : WGM;
  pm = fm + ((wgid % nig) % gsz); pn = (wgid % nig) / gsz;
  pm = __builtin_amdgcn_readfirstlane(pm); pn = __builtin_amdgcn_readfirstlane(pn);
  return true;
}
#ifndef WT_B
#define WT_B 1
#endif
#ifndef WT_Z
#define WT_Z 1
#endif
#ifndef WT_I2
#define WT_I2 1
#endif
struct EpiRawBf16 {
  u16* O; int ldc; float sc;
  DEVI void init(f32x4 (&acc)[2][2][4][2], const Unit&, int, int, int, int) const { acc_zero(acc); }
  DEVI void operator()(const f32x4 (&acc)[2][2][4][2], const Unit& u, int wr, int wc, int fr, int fq) const {
    const unsigned off0 = ((unsigned)(u.u0 + wr * 64 + fr) * (unsigned)ldc + (unsigned)(u.u1 + wc * 32 + 8 * fq)) * 2u;
#pragma unroll
    for (int ai = 0; ai < 2; ++ai)
#pragma unroll
      for (int m = 0; m < 4; ++m) {
        char* rowp = (char*)O + (off0 + (unsigned)(ai * HALF + m * 16) * (unsigned)ldc * 2u);
#pragma unroll
        for (int bj = 0; bj < 2; ++bj) {
          const f32x4 v0 = acc[ai][bj][m][0], v1 = acc[ai][bj][m][1];
          u32x4 w; w.x = pk2(v0[0], v0[1]); w.y = pk2(v0[2], v0[3]); w.z = pk2(v1[0], v1[1]); w.w = pk2(v1[2], v1[3]);
          *(u32x4*)(rowp + bj * HALF * 2) = w;
        }
      }
  }
};

struct EpiRawF8 {
  unsigned char* O; int ldc; float sc;
  DEVI void init(f32x4 (&acc)[2][2][4][2], const Unit&, int, int, int, int) const { acc_zero(acc); }
  DEVI void operator()(const f32x4 (&acc)[2][2][4][2], const Unit& u, int wr, int wc, int fr, int fq) const {
    const unsigned off0 = (unsigned)(u.u0 + wr * 64 + fr) * (unsigned)ldc + (unsigned)(u.u1 + wc * 32 + 8 * fq);
#pragma unroll
    for (int ai = 0; ai < 2; ++ai)
#pragma unroll
      for (int m = 0; m < 4; ++m) {
        unsigned char* rowp = O + (off0 + (unsigned)(ai * HALF + m * 16) * (unsigned)ldc);
#pragma unroll
        for (int bj = 0; bj < 2; ++bj) {
          u32x2 w;
#pragma unroll
          for (int n = 0; n < 2; ++n) {
            const f32x4 v = acc[ai][bj][m][n] * sc;
            int q = __builtin_amdgcn_cvt_pk_fp8_f32(__builtin_amdgcn_fmed3f(v[0], -448.f, 448.f), __builtin_amdgcn_fmed3f(v[1], -448.f, 448.f), 0, false);
            q = __builtin_amdgcn_cvt_pk_fp8_f32(__builtin_amdgcn_fmed3f(v[2], -448.f, 448.f), __builtin_amdgcn_fmed3f(v[3], -448.f, 448.f), q, true);
            w[n] = (unsigned)q;
          }
          *(u32x2*)(rowp + bj * HALF) = w;
        }
      }
  }
};
DEVI size_t z8_block(int pm, int branch, int cb) { return (size_t)((pm * 4 + branch) * 8 + cb) * 32768; }
struct EpiZ8 {
  unsigned char* O;
  DEVI void init(f32x4 (&acc)[2][2][4][2], const Unit&, int, int, int, int) const { acc_zero(acc); }
  DEVI void operator()(const f32x4 (&acc)[2][2][4][2], const Unit& u, int wr, int wc, int fr, int fq) const {
    const int pm = u.u0 >> 8, pn = u.u1 >> 8, n = pn >> 2, cq = pn & 3;
    const unsigned lw16 = (unsigned)((wr * 4 + wc) * 64 + fr + 16 * fq) * 16u;
#pragma unroll
    for (int bj = 0; bj < 2; ++bj) {
      unsigned char* blk = O + z8_block(pm, n, cq * 2 + bj) + lw16;
#pragma unroll
      for (int P = 0; P < 4; ++P) {
        u32x4 w;
#pragma unroll
        for (int h = 0; h < 2; ++h)
#pragma unroll
          for (int nn = 0; nn < 2; ++nn) {
            const int g = 2 * P + h;
            const f32x4 v = acc[g >> 2][bj][g & 3][nn];
            int q = __builtin_amdgcn_cvt_pk_fp8_f32(__builtin_amdgcn_fmed3f(v[0], -448.f, 448.f), __builtin_amdgcn_fmed3f(v[1], -448.f, 448.f), 0, false);
            q = __builtin_amdgcn_cvt_pk_fp8_f32(__builtin_amdgcn_fmed3f(v[2], -448.f, 448.f), __builtin_amdgcn_fmed3f(v[3], -448.f, 448.f), q, true);
            w[2 * h + nn] = (unsigned)q;
          }
        if (WT_Z) asm volatile("global_store_dwordx4 %0, %1, off sc1\n\ts_nop 1" :: "v"(blk + P * 8192), "v"(w) : "memory");
        else *(u32x4*)(blk + P * 8192) = w;
      }
    }
  }
};
struct SchedB { const char* ws; const char* h8; int G, c;
  DEVI bool next(int i, Unit& u) const { int pm, pn; if (!tile_order(i, G, c, NTOK / 256, INP / 256, pm, pn)) return false;
    u.A = h8 + uoff((unsigned)pm * 256u * 1024u); u.B = ws + OFF_WIN + uoff((unsigned)pn * 256u * 1024u);        u.rows = nullptr; u.nvalid = 0; u.u0 = pm * 256; u.u1 = pn * 256; u.u2 = 0; u.u3 = 0; return true; } };
struct EpiB { u16* O; float* ssq;
  DEVI void init(f32x4 (&acc)[2][2][4][2], const Unit&, int, int, int, int) const { acc_zero(acc); }
  DEVI void operator()(const f32x4 (&acc)[2][2][4][2], const Unit& u, int wr, int wc, int fr, int fq) const {
    if (WT_B) {
      const __amdgpu_buffer_rsrc_t rs = __builtin_amdgcn_make_buffer_rsrc((void*)O, 0, NTOK * PLD * 2, 0x00020000);
      const unsigned off0 = ((unsigned)(u.u0 + wr * 64 + fr) * (unsigned)PLD + (unsigned)(u.u1 + wc * 32 + 8 * fq)) * 2u;
#pragma unroll
      for (int ai = 0; ai < 2; ++ai)
#pragma unroll
        for (int m = 0; m < 4; ++m)
#pragma unroll
          for (int bj = 0; bj < 2; ++bj) {
            const f32x4 v0 = acc[ai][bj][m][0], v1 = acc[ai][bj][m][1];
            __builtin_amdgcn_raw_buffer_store_b128(u32x4{pk2(v0[0], v0[1]), pk2(v0[2], v0[3]), pk2(v1[0], v1[1]), pk2(v1[2], v1[3])}, rs,
                                                   (int)(off0 + (unsigned)(ai * HALF + m * 16) * (unsigned)PLD * 2u + (unsigned)(bj * HALF * 2)), 0, 16);
          }
    } else { EpiRawBf16 E{O, PLD, 1.f}; E(acc, u, wr, wc, fr, fq); }
    if (u.u1 < 512) {
      const bool iskv = u.u1 != 0;
#pragma unroll
      for (int ai = 0; ai < 2; ++ai)
#pragma unroll
        for (int m = 0; m < 4; ++m) {
          float ss = 0.f;
#pragma unroll
          for (int bj = 0; bj < 2; ++bj)
#pragma unroll
            for (int n = 0; n < 2; ++n)
#pragma unroll
              for (int j = 0; j < 4; ++j) { const float v = acc[ai][bj][m][n][j]; if (!(iskv && bj == 1)) ss += v * v; }
          ss += __shfl_xor(ss, 16); ss += __shfl_xor(ss, 32);
          if (fq == 0) ssq[(size_t)(u.u0 + ai * HALF + wr * 64 + m * 16 + fr) * 8 + (iskv ? 4 : 0) + wc] = ss;
        }
    }
  }
};
DEVI void phaseB2(KP p, ldsp_t lds) {
  SchedB S{(const char*)p->ws, (const char*)h8base(p), (int)gridDim.x, BIDX};
  EpiB E{wsp<u16>(p, OFF_PRAW), wsp<float>(p, OFF_SSQ)};
  gemm_phase<true, false, true>(lds, 1024, 1024, 8, S, E);
}
struct SchedC { const char* ws; int G, c;
  DEVI bool next(int i, Unit& u) const { int pm, pn; if (!tile_order(i, G, c, NTOK / 256, 4, pm, pn)) return false;
    const bool kv = pn >= 2; const int pj = pn & 1;
    u.A = ws + OFF_PRAW + uoff((unsigned)pm * 256u * (unsigned)(PLD * 2) + (kv ? 512u : 0u)); u.B = ws + (kv ? OFF_WKVB : OFF_WQB) + uoff((unsigned)pj * 256u * 512u); u.rows = nullptr; u.nvalid = 0;
    u.u0 = pm * 256; u.u1 = pj * 256; u.u2 = kv; u.u3 = 0; return true; } };
struct EpiC { u16* Oq; u16* Okv; const float* ssq;
  DEVI void init(f32x4 (&acc)[2][2][4][2], const Unit&, int, int, int, int) const { acc_zero(acc); }
  DEVI void operator()(const f32x4 (&acc)[2][2][4][2], const Unit& u, int wr, int wc, int fr, int fq) const {
    const bool kv = u.u2 != 0;
    u16* O = kv ? Okv : Oq;
    const int row0 = u.u0 + wr * 64 + fr, col0 = u.u1 + wc * 32 + 8 * fq;
    f32x4 sq[2][4];
#pragma unroll
    for (int ai = 0; ai < 2; ++ai)
#pragma unroll
      for (int m = 0; m < 4; ++m) sq[ai][m] = *(const f32x4*)(ssq + (size_t)(row0 + ai * HALF + m * 16) * 8 + (kv ? 4 : 0));
#pragma unroll
    for (int ai = 0; ai < 2; ++ai)
#pragma unroll
      for (int m = 0; m < 4; ++m) {
        const size_t r = (size_t)(row0 + ai * HALF + m * 16);
        const float tot = sq[ai][m].x + sq[ai][m].y + sq[ai][m].z + sq[ai][m].w;
        const float sc = kv ? rsqrtf(tot * (1.f / 128.f) + EPS) : rsqrtf(tot * (1.f / 256.f) + EPS) * (0.10206207261596575f * LOG2E);
        u16* rowp = O + r * 512 + col0;
#pragma unroll
        for (int bj = 0; bj < 2; ++bj) {
          const f32x4 v0 = acc[ai][bj][m][0] * sc, v1 = acc[ai][bj][m][1] * sc;
          u32x4 w; w.x = pk2(v0[0], v0[1]); w.y = pk2(v0[2], v0[3]); w.z = pk2(v1[0], v1[1]); w.w = pk2(v1[2], v1[3]);
          asm volatile("global_store_dwordx4 %0, %1, off sc1\n\ts_nop 1" :: "v"(rowp + bj * HALF), "v"(w) : "memory");
        }
      }
  }
};
DEVI void phaseC2(KP p, int l, ldsp_t lds) {
  SchedC S{(const char*)p->ws, (int)gridDim.x, BIDX};
  EpiC E{wsp<u16>(p, OFF_QARAW), wsp<u16>(p, OFF_KVARAW), wsp<float>(p, OFF_SSQ)};
  int nt = 4; asm volatile("" : "+s"(nt));
  gemm_phase<true, false, false>(lds, PLD * 2, 512, nt, S, E);
  asm volatile("s_waitcnt vmcnt(0)" ::: "memory");
  __syncthreads();
  if (TIDX == 0) __hip_atomic_fetch_add(wsp<int>(p, OFF_DEP) + DEP_C2DONE + l * DEP_STRIDE, 1, __ATOMIC_RELAXED, __HIP_MEMORY_SCOPE_AGENT);
}

DEVI void ld16(const u16* src, float (&v)[16]) {
  const u32x4 a = *(const u32x4*)src, b = *(const u32x4*)(src + 8);
  const unsigned w[8] = {a.x, a.y, a.z, a.w, b.x, b.y, b.z, b.w};
#pragma unroll
  for (int i = 0; i < 8; ++i) { v[2 * i] = __uint_as_float(w[i] << 16); v[2 * i + 1] = __uint_as_float(w[i] & 0xffff0000u); }
}
DEVI void st16(u16* dst, const float (&v)[16]) {
  u32x4 a, b;
  a.x = pk2(v[0], v[1]); a.y = pk2(v[2], v[3]); a.z = pk2(v[4], v[5]); a.w = pk2(v[6], v[7]);
  b.x = pk2(v[8], v[9]); b.y = pk2(v[10], v[11]); b.z = pk2(v[12], v[13]); b.w = pk2(v[14], v[15]);
  *(u32x4*)dst = a; *(u32x4*)(dst + 8) = b;
}
DEVI void rope16c(float (&v)[16], const float* cs16, int pos) {
  const f32x2* t = (const f32x2*)(cs16 + pos * 16);
#pragma unroll
  for (int i = 0; i < 8; ++i) { const f32x2 cs = t[i]; const float x1 = v[i], x2 = v[8 + i]; v[i] = x1 * cs.x - x2 * cs.y; v[8 + i] = x2 * cs.x + x1 * cs.y; }
}
DEVI void rope32c(float (&lo)[16], float (&hi)[16], const float* cs32, int pos) {
  const f32x2* t = (const f32x2*)(cs32 + pos * 32);
#pragma unroll
  for (int i = 0; i < 16; ++i) { const f32x2 cs = t[i]; const float x1 = lo[i], x2 = hi[i]; lo[i] = x1 * cs.x - x2 * cs.y; hi[i] = x2 * cs.x + x1 * cs.y; }
}
DEVI float ssq16(const float (&v)[16]) { float s = 0.f;
#pragma unroll
  for (int i = 0; i < 16; ++i) s += v[i] * v[i];
  return s; }
DEVI void scale16(float (&v)[16], float s) {
#pragma unroll
  for (int i = 0; i < 16; ++i) v[i] *= s; }
DEVI void cvt16(const u32x4 a, const u32x4 b, float (&v)[16]) {
  const unsigned w[8] = {a.x, a.y, a.z, a.w, b.x, b.y, b.z, b.w};
#pragma unroll
  for (int i = 0; i < 8; ++i) { v[2 * i] = __uint_as_float(w[i] << 16); v[2 * i + 1] = __uint_as_float(w[i] & 0xffff0000u); }
}
DEVI void phaseP2(KP p, int l, ldsp_t lds) {
  const int tid = TIDX, tk = tid >> 3, pt = tid & 7;
  u16* PR = wsp<u16>(p, OFF_PRAW);
  u16* QA = wsp<u16>(p, OFF_QARAW);
  const float* cs32 = wsp<float>(p, OFF_CS32);
  const float* cs16 = wsp<float>(p, OFF_CS16);
  const float QS = 0.125f * LOG2E;
  const int b2 = (int)((BIDX + gridDim.x / 2) % gridDim.x);
  for (int item = b2; item < NTOK / 64; item += gridDim.x) {
    const int tok0 = item * 64, rr0 = tok0 % TPB;
    const bool lat = rr0 >= NCTX;
    const size_t tok = (size_t)tok0 + tk;
    const int t = rr0 + tk - NCTX, grow = (t >> 6) & 63, gcol = t & 63;
    u16* pr = PR + tok * PLD;
    const int g4 = pt & 3;
    u32x4 r_kr[2], r_qb[4], r_kb[4], r_qd[4], r_kd[4];
#define LD8(ptr) (*(const u32x4*)(ptr))
    if (lat) {
#pragma unroll
      for (int i = 0; i < 2; ++i) { r_kr[i] = LD8(pr + 384 + 16 * (pt & 1) + 8 * i); }
#pragma unroll
      for (int i = 0; i < 4; ++i) { r_qb[i] = LD8(pr + 512 + 32 * pt + 8 * i); r_kb[i] = LD8(pr + 768 + 32 * g4 + 8 * i); }
    }
#pragma unroll
    for (int i = 0; i < 4; ++i) { r_qd[i] = LD8(pr + 1792 + 32 * pt + 8 * i); r_kd[i] = LD8(pr + 2048 + 32 * g4 + 8 * i); }
#undef LD8
    if (lat) {
      if (pt < 2) { float v[16]; cvt16(r_kr[0], r_kr[1], v); rope16c(v, cs16, pt == 0 ? grow : gcol); st16(pr + 384 + 16 * pt, v); }
      { float lo[16], hi[16]; cvt16(r_qb[0], r_qb[1], lo); cvt16(r_qb[2], r_qb[3], hi); rope32c(lo, hi, cs32, (pt & 1) ? gcol : grow); st16(pr + 512 + 32 * pt, lo); st16(pr + 512 + 32 * pt + 16, hi); }
      if (pt < 4) { float lo[16], hi[16]; cvt16(r_kb[0], r_kb[1], lo); cvt16(r_kb[2], r_kb[3], hi); rope32c(lo, hi, cs32, (pt & 1) ? gcol : grow); st16(pr + 768 + 32 * pt, lo); st16(pr + 768 + 32 * pt + 16, hi); }
    }
    {
      float lo[16], hi[16]; cvt16(r_qd[0], r_qd[1], lo); cvt16(r_qd[2], r_qd[3], hi);
      float ss = ssq16(lo) + ssq16(hi); ss += __shfl_xor(ss, 1);
      const float rs = rsqrtf(ss * (1.f / 64.f) + EPS);
      const float* g = p->g_q_d + l * 64 + 32 * (pt & 1);
#pragma unroll
      for (int i = 0; i < 16; ++i) { lo[i] *= rs * g[i]; hi[i] *= rs * g[16 + i]; }
      if (lat) rope32c(lo, hi, cs32, (pt & 1) ? gcol : grow);
      scale16(lo, QS); scale16(hi, QS);
      st16(pr + 1792 + 32 * pt, lo); st16(pr + 1792 + 32 * pt + 16, hi);
    }
    {
      float lo[16], hi[16]; cvt16(r_kd[0], r_kd[1], lo); cvt16(r_kd[2], r_kd[3], hi);
      float ss = ssq16(lo) + ssq16(hi); ss += __shfl_xor(ss, 1);
      const float rs = rsqrtf(ss * (1.f / 64.f) + EPS);
      const float* g = p->g_k_d + l * 64 + 32 * (g4 & 1);
#pragma unroll
      for (int i = 0; i < 16; ++i) { lo[i] *= rs * g[i]; hi[i] *= rs * g[16 + i]; }
      if (lat) rope32c(lo, hi, cs32, (g4 & 1) ? gcol : grow);
      if (pt < 4) { st16(pr + 2048 + 32 * g4, lo); st16(pr + 2048 + 32 * g4 + 16, hi); }
    }
  }
  {
    const int* c2ctr = wsp<int>(p, OFF_DEP) + DEP_C2DONE + l * DEP_STRIDE;
    while (__hip_atomic_load(c2ctr, __ATOMIC_RELAXED, __HIP_MEMORY_SCOPE_AGENT) < (int)gridDim.x) __builtin_amdgcn_s_sleep(8);
    asm volatile("s_waitcnt vmcnt(0)" ::: "memory");
  }
  for (int item = b2; item < NTOK / 64; item += gridDim.x) {
    const int tok0 = item * 64, rr0 = tok0 % TPB;
    if (rr0 < NCTX) continue;
    const size_t tok = (size_t)tok0 + tk;
    const int t = rr0 + tk - NCTX, grow = (t >> 6) & 63, gcol = t & 63;
    u16* qar = QA + tok * 512 + 96 * (pt >> 1) + 64 + 16 * (pt & 1);
    const u32x4 q0 = *(const u32x4*)qar, q1 = *(const u32x4*)(qar + 8);
    float v[16]; cvt16(q0, q1, v); rope16c(v, cs16, (pt & 1) ? gcol : grow); st16(qar, v);
  }
}

DEVI void conv_load(const ConvT& c, int lane, f32x4 (&v)[8]) {
  const int kk = lane >> 3, n4 = (lane & 7) * 4;
  const float* sp = (c.src2 && n4 >= 16) ? c.src2 + (n4 - 16) : (c.src ? c.src + n4 : nullptr);
#pragma unroll
  for (int i = 0; i < 8; ++i) v[i] = sp ? __builtin_nontemporal_load((const f32x4*)(sp + (size_t)(kk + 8 * i) * c.ld)) : f32x4{0.f, 0.f, 0.f, 0.f};
}
DEVI void conv_store(const ConvT& c, LAS float* t, int lane, const f32x4 (&v)[8]) {
  const int kk = lane >> 3, n4 = (lane & 7) * 4;
#pragma unroll
  for (int i = 0; i < 8; ++i) {
    const int k = kk + 8 * i;
    const float s = (c.ks ? c.ks[k] : 1.f) * c.mul;
    t[(n4 + 0) * 65 + k] = v[i].x * s; t[(n4 + 1) * 65 + k] = v[i].y * s;
    t[(n4 + 2) * 65 + k] = v[i].z * s; t[(n4 + 3) * 65 + k] = v[i].w * s;
  }
  asm volatile("s_waitcnt lgkmcnt(0)" ::: "memory");
  const int n = lane >> 1, k0 = (lane & 1) * 32;
  const LAS float* r = t + n * 65 + k0;
  if (c.ldd < 0) {
    const int nr = c.rp ? (((n >> 3) & 1) * 128 + ((n >> 4) & 1) * 8 + (n & 7)) : n;
    unsigned char* d8 = (unsigned char*)c.dst + (size_t)nr * (size_t)(-c.ldd) + k0;
#pragma unroll
    for (int q = 0; q < 2; ++q) {
      u32x4 o;
#pragma unroll
      for (int w = 0; w < 4; ++w) {
        float f[4];
#pragma unroll
        for (int j = 0; j < 4; ++j) f[j] = __builtin_amdgcn_fmed3f(r[16 * q + 4 * w + j], -448.f, 448.f);
        int v = __builtin_amdgcn_cvt_pk_fp8_f32(f[0], f[1], 0, false);
        v = __builtin_amdgcn_cvt_pk_fp8_f32(f[2], f[3], v, true);
        o[w] = (unsigned)v;
      }
      *(u32x4*)(d8 + 16 * q) = o;
    }
    asm volatile("s_waitcnt lgkmcnt(0)" ::: "memory");
    return;
  }
  u16* d = c.dst + (size_t)n * c.ldd + k0;
#pragma unroll
  for (int q = 0; q < 4; ++q) {
    u32x4 o;
    o.x = pk2(r[8 * q], r[8 * q + 1]); o.y = pk2(r[8 * q + 2], r[8 * q + 3]); o.z = pk2(r[8 * q + 4], r[8 * q + 5]); o.w = pk2(r[8 * q + 6], r[8 * q + 7]);
    *(u32x4*)(d + 8 * q) = o;
  }
  asm volatile("s_waitcnt lgkmcnt(0)" ::: "memory");
}
constexpr int CONV_EARLY = 1152 + 64 + 64;
DEVI void conv_items2(KP p, int l, ldsp_t lds, int first_item, int total_items) {
  const int tid = TIDX, wave = __builtin_amdgcn_readfirstlane(tid >> 6), lane = tid & 63;
  LAS float* t = (LAS float*)(lds + wave * 8448);
  __syncthreads();
  const int stride = gridDim.x * NW;
  int item = first_item + BIDX * NW + wave;
  if (item >= total_items) return;
  ConvT c = conv_decode(p, l, item);
  f32x4 v[8];
  conv_load(c, lane, v);
  for (;;) {
    const int nitem = item + stride;
    const bool more = nitem < total_items;
    ConvT cn = c; f32x4 vn[8];
    if (more) { cn = conv_decode(p, l, nitem); conv_load(cn, lane, vn); }
    conv_store(c, t, lane, v);
    if (!more) break;
    c = cn; item = nitem;
#pragma unroll
    for (int i = 0; i < 8; ++i) v[i] = vn[i];
  }
}
template <int BR>
DEVI void attn_mask(f32x16 (&s)[2], int kt, int qlat, int qrow, int qcol, int hh, LAS float* rpb) {
  if (BR == 1) {
#pragma unroll
    for (int kb = 0; kb < 2; ++kb)
#pragma unroll
      for (int i = 0; i < 16; ++i) {
        const int kpos = kt * 64 + kb * 32 + (i & 3) + 8 * (i >> 2) + 4 * hh;
        const int d = qlat - kpos;
        if (d > 128 || d < -128) s[kb][i] = -1e30f;
      }
  } else {
    const int rs = min(max(qrow - 4, 0), 56);
    const bool row_ok = (kt >= rs) && (kt < rs + 8);
    const int cst = min(max(qcol - 8, 0), 48);
    const int dr = kt - qrow + 7;
#pragma unroll
    for (int kb = 0; kb < 2; ++kb)
#pragma unroll
      for (int i = 0; i < 16; ++i) {
        const int kc = kb * 32 + (i & 3) + 8 * (i >> 2) + 4 * hh;
        const bool ok = row_ok && (kc >= cst) && (kc < cst + 16);
        const int idx = ok ? (dr * 31 + (kc - qcol + 15)) : 0;
        const float bias = rpb[idx];
        s[kb][i] = ok ? (s[kb][i] + bias) : -1e30f;
      }
  }
}

template <int BR>
DEVI void attn_mask1(f32x16& sb, int kb, int kt, int qlat, int qrow, int qcol, int hh, LAS float* rpb) {
  if (BR == 1) {
#pragma unroll
    for (int i = 0; i < 16; ++i) {
      const int kpos = kt * 64 + kb * 32 + (i & 3) + 8 * (i >> 2) + 4 * hh;
      const int d = qlat - kpos;
      if (d > 128 || d < -128) sb[i] = -1e30f;
    }
  } else {
    const int rs = min(max(qrow - 4, 0), 56);
    const bool row_ok = (kt >= rs) && (kt < rs + 8);
    const int cst = min(max(qcol - 8, 0), 48);
    const int dr = kt - qrow + 7;
#pragma unroll
    for (int i = 0; i < 16; ++i) {
      const int kc = kb * 32 + (i & 3) + 8 * (i >> 2) + 4 * hh;
      const bool ok = row_ok && (kc >= cst) && (kc < cst + 16);
      const int idx = ok ? (dr * 31 + (kc - qcol + 15)) : 0;
      const float bias = rpb[idx];
      sb[i] = ok ? (sb[i] + bias) : -1e30f;
    }
  }
}
#define FADD(a, b) do { (a) += (b); asm("" : "+v"(a)); } while (0)
typedef short v4i16_t __attribute__((ext_vector_type(4)));
DEVI bf16x8 vtr2(ldsp_t a) {
  const v4i16_t lo = __builtin_amdgcn_ds_read_tr16_b64_v4i16((LAS v4i16_t*)a);
  const v4i16_t hi = __builtin_amdgcn_ds_read_tr16_b64_v4i16((LAS v4i16_t*)(a + 8 * 144));
  return __builtin_shufflevector(lo, hi, 0, 1, 2, 3, 4, 5, 6, 7);
}
DEVI bf16x8 vtr2s(ldsp_t a, int o0, int o1) {
  const v4i16_t lo = __builtin_amdgcn_ds_read_tr16_b64_v4i16((LAS v4i16_t*)(a + o0));
  const v4i16_t hi = __builtin_amdgcn_ds_read_tr16_b64_v4i16((LAS v4i16_t*)(a + 8 * 128 + o1));
  return __builtin_shufflevector(lo, hi, 0, 1, 2, 3, 4, 5, 6, 7);
}
template <int BR, bool FAST>
DEVI bool attn_item2(KP p, int l, int b, int hs, int qb, bool isctx, ldsp_t lds) {
  constexpr bool MLA = (BR == 0);
  constexpr bool GQA = (BR == 1 || BR == 3);
  constexpr int QBLK = GQA ? 256 : 512;
  constexpr int NKS = MLA ? 6 : 4;
  constexpr int STG = 8192 + 8192 + 4096;
  const int tid = TIDX, lane = tid & 63, wave = __builtin_amdgcn_readfirstlane(tid >> 6);
  const int r32 = lane & 31, hh = lane >> 5;
  const int hq = GQA ? (hs * 2 + (wave & 1)) : hs;
  const int woff = GQA ? 64 * (wave >> 1) : 64 * wave;
  const int q0 = (isctx ? 0 : NCTX) + qb * QBLK;
  const bool active = !isctx || (woff < NCTX);
  const size_t tokq = (size_t)b * TPB + q0 + (active ? woff : 0) + r32;
  const u16* Qp; const u16* Kp; int ldk; const u16* Vp; int ldv; int obase; int ldq;
  const u16* PR = wsp<u16>(p, OFF_PRAW);
  if (BR == 0) { Qp = wsp<u16>(p, OFF_QARAW) + tokq * 512 + hq * 96; ldq = 512; Kp = wsp<u16>(p, OFF_KVARAW) + (size_t)b * TPB * 512 + hs * 128; ldk = 512; Vp = wsp<u16>(p, OFF_KVARAW) + (size_t)b * TPB * 512 + hs * 128 + 64; ldv = 512; obase = hq * 64; }
  else if (BR == 1) { Qp = PR + tokq * PLD + 512 + hq * 64; ldq = PLD; Kp = PR + (size_t)b * TPB * PLD + 768 + hs * 64; ldk = PLD; Vp = PR + (size_t)b * TPB * PLD + 896 + hs * 64; ldv = PLD; obase = 256 + hq * 64; }
  else if (BR == 2) { Qp = PR + tokq * PLD + 1024 + hq * 64; ldq = PLD; Kp = PR + (size_t)b * TPB * PLD + 1280 + hs * 64; ldk = PLD; Vp = PR + (size_t)b * TPB * PLD + 1536 + hs * 64; ldv = PLD; obase = 512 + hq * 64; }
  else { Qp = PR + tokq * PLD + 1792 + hq * 64; ldq = PLD; Kp = PR + (size_t)b * TPB * PLD + 2048 + hs * 64; ldk = PLD; Vp = PR + (size_t)b * TPB * PLD + 2176 + hs * 64; ldv = PLD; obase = 768 + hq * 64; }
  const u16* KRp = PR + (size_t)b * TPB * PLD + 384;
  int lat_lo = 0, lat_n = 0, wlo = 0, whi = 63;
  if (!isctx) {
    if (BR == 0 || BR == 3) { lat_lo = 0; lat_n = 64; }
    else if (BR == 1) {
      const int ql = qb * QBLK; const int lo = max(0, ql - 128) >> 6, hi = min(SEQ - 1, ql + QBLK - 1 + 128) >> 6; lat_lo = lo; lat_n = hi - lo + 1;
      const int wq = ql + woff; wlo = max(0, wq - 128) >> 6; whi = min(SEQ - 1, wq + 63 + 128) >> 6;
    } else {
      const int r0 = 8 * qb; const int lo = min(max(r0 - 4, 0), 56), hi = min(max(r0 + 7 - 4, 0), 56) + 7; lat_lo = lo; lat_n = hi - lo + 1;
      const int wr_ = r0 + wave; wlo = min(max(wr_ - 4, 0), 56); whi = wlo + 7;
    }
  }
  const int NT = 4 + lat_n;
  const int qlat0 = qb * QBLK + woff + r32;
  bf16x8 qf[2][NKS];
#pragma unroll
  for (int qi = 0; qi < 2; ++qi)
#pragma unroll
    for (int ks = 0; ks < NKS; ++ks) qf[qi][ks] = *(const bf16x8*)(Qp + (size_t)qi * 32 * ldq + ks * 16 + hh * 8);
  const int drow = 8 * wave + (lane >> 3), dch = (lane & 7) ^ ((drow >> 1) & 7);
  const int rrow = 16 * (wave & 3) + (lane >> 2), rch = (lane & 3) ^ ((rrow >> 2) & 3);
  auto keytile = [&](int j) { return (j < 4) ? j : (4 + lat_lo + (j - 4)); };
#define DMA16(sbase, voff, ldsaddr) asm volatile("s_mov_b32 m0, %2\n\ts_nop 0\n\tglobal_load_lds_dwordx4 %0, %1" :: "v"(voff), "s"(sbase), "s"(ldsaddr) : "memory", "m0")
#define A_DMA(j, st) do { const int key0_ = keytile(j) * 64; const unsigned base_ = __builtin_amdgcn_readfirstlane((unsigned)(size_t)(lds + (st) * STG) + wave * 1024); \
    DMA16(Kp, (unsigned)(((key0_ + drow) * ldk + dch * 8) * 2), base_); \
    DMA16(Vp, (unsigned)(((key0_ + drow) * ldv + dch * 8) * 2), base_ + 8192u); \
    if (MLA && wave < 4) DMA16(KRp, (unsigned)(((key0_ + rrow) * PLD + rch * 8) * 2), __builtin_amdgcn_readfirstlane(base_ + 16384u)); \
  } while (0)
  LAS float* rpb = (LAS float*)(lds + 2 * STG);
  __syncthreads();
  if (FAST && tid == 0) *(LAS int*)(lds + 2 * STG + 2048) = 0;
  A_DMA(0, 0);
  if (BR == 2 && !isctx) {
    const float* src = p->rpb_c + (size_t)(l * 4 + hs) * 465;
    for (int i = tid; i < 465; i += 512) rpb[i] = src[i] * LOG2E;
  }
  asm volatile("s_waitcnt vmcnt(0)" ::: "memory");
#pragma unroll
  for (int qi = 0; qi < 2; ++qi)
#pragma unroll
    for (int ks = 0; ks < NKS; ++ks) asm volatile("" : "+v"(qf[qi][ks]));
  __syncthreads();
  f32x16 o[2][2];
#pragma unroll
  for (int qi = 0; qi < 2; ++qi)
#pragma unroll
    for (int i = 0; i < 16; ++i) { o[qi][0][i] = 0.f; o[qi][1][i] = 0.f; }
  float m_run[2], l_run[2];
#pragma unroll
  for (int qi = 0; qi < 2; ++qi) { m_run[qi] = -INFINITY; l_run[qi] = 0.f; }
  if (BR == 1) { const float sk = p->sink_b[l * 4 + hq] * LOG2E; m_run[0] = sk; m_run[1] = sk; l_run[0] = (hh == 0) ? (FAST ? __builtin_amdgcn_exp2f(sk) : 1.f) : 0.f; l_run[1] = l_run[0]; }
  float l2[2][2];
#pragma unroll
  for (int qi = 0; qi < 2; ++qi) { l2[qi][0] = l_run[qi]; l2[qi][1] = 0.f; }
  const int kkey = (r32 >> 1) & 7, rkey = (r32 >> 2) & 3;
  const ldsp_t kfb = lds + r32 * 128;
  const ldsp_t krb = lds + 16384 + r32 * 64;
  const int vq = (lane & 15) >> 2, vkey = 2 * hh + (vq >> 1);
  const int vch = 2 * ((lane >> 4) & 1) + ((lane & 3) >> 1);
  const ldsp_t vfb = lds + 8192 + (4 * hh + vq) * 128 + 8 * (lane & 1);
#define SB() __builtin_amdgcn_sched_barrier(0)
#define KLOAD(kb, ks) (((ks) < 4) ? *(const LAS bf16x8*)(kfb + st + (kb) * 4096 + (((2 * (ks) + hh) ^ kkey) << 4)) : *(const LAS bf16x8*)(krb + st + (kb) * 2048 + (((2 * ((ks) - 4) + hh) ^ rkey) << 4)))
#define VLOAD(s4, db) vtr2s(vfb + st + (s4) * 2048, ((4 * (db) + vch) ^ vkey) << 4, ((4 * (db) + vch) ^ vkey ^ 4) << 4)
#define SM_EL(kb, e) do { const int qi_ = (e) >> 4, i_ = (e) & 15; \
    const float x_ = __builtin_amdgcn_exp2f(s[qi_][kb][i_]); s[qi_][kb][i_] = x_; FADD(l2[qi_][i_ & 1], x_); \
    if (i_ & 1) pw[kb][qi_][i_ >> 3][(i_ & 7) >> 1] = pk2(s[qi_][kb][i_ - 1], x_); } while (0)
#define F_STEP(j) do { \
    const int st = ((j) & 1) * STG; \
    if ((j) + 1 < NT) A_DMA((j) + 1, ((j) + 1) & 1); \
    const int kt_ = lat_lo + (j) - 4; \
    const bool need = active && ((j) < 4 || (kt_ >= wlo && kt_ <= whi)); \
    if (need) { \
      f32x16 s[2][2]; bf16x8 kf[NKS]; bf16x8 vf[4]; u32x4 pw[2][2][2]; \
      const f32x16 zero16 = {0.f, 0.f, 0.f, 0.f, 0.f, 0.f, 0.f, 0.f, 0.f, 0.f, 0.f, 0.f, 0.f, 0.f, 0.f, 0.f}; \
      const bool domask = (BR == 1 || BR == 2) && (j) >= 4; \
      _Pragma("unroll") for (int ks = 0; ks < NKS; ++ks) kf[ks] = KLOAD(0, ks); \
      _Pragma("unroll") for (int ks = 0; ks < NKS; ++ks) { \
        s[0][0] = MFMA(kf[ks], qf[0][ks], ks == 0 ? zero16 : s[0][0]); s[1][0] = MFMA(kf[ks], qf[1][ks], ks == 0 ? zero16 : s[1][0]); \
        SB(); kf[ks] = KLOAD(1, ks); SB(); } \
      if (domask) { _Pragma("unroll") for (int qi = 0; qi < 2; ++qi) { const int ql_ = qlat0 + 32 * qi; attn_mask1<BR>(s[qi][0], 0, kt_, ql_, ql_ >> 6, ql_ & 63, hh, rpb); } } \
      _Pragma("unroll") for (int m = 0; m < 2 * NKS; ++m) { \
        s[m & 1][1] = MFMA(kf[m >> 1], qf[m & 1][m >> 1], (m >> 1) == 0 ? zero16 : s[m & 1][1]); \
        if (m < 4) vf[m] = VLOAD(m >> 1, m & 1); \
        _Pragma("unroll") for (int e = (m * 32) / (2 * NKS); e < ((m + 1) * 32) / (2 * NKS); ++e) SM_EL(0, e); \
        SB(); } \
      if (domask) { _Pragma("unroll") for (int qi = 0; qi < 2; ++qi) { const int ql_ = qlat0 + 32 * qi; attn_mask1<BR>(s[qi][1], 1, kt_, ql_, ql_ >> 6, ql_ & 63, hh, rpb); } } \
      _Pragma("unroll") for (int m = 0; m < 8; ++m) { \
        o[m & 1][(m >> 1) & 1] = MFMA(vf[m >> 1], __builtin_bit_cast(bf16x8, pw[0][m & 1][m >> 2]), o[m & 1][(m >> 1) & 1]); \
        if (m & 1) { SB(); vf[m >> 1] = VLOAD(2 + (m >> 2), (m >> 1) & 1); } \
        _Pragma("unroll") for (int e = 4 * m; e < 4 * m + 4; ++e) SM_EL(1, e); \
        SB(); } \
      _Pragma("unroll") for (int m = 0; m < 8; ++m) \
        o[m & 1][(m >> 1) & 1] = MFMA(vf[m >> 1], __builtin_bit_cast(bf16x8, pw[1][m & 1][m >> 2]), o[m & 1][(m >> 1) & 1]); \
    } \
    asm volatile("s_waitcnt vmcnt(0)" ::: "memory"); \
    __syncthreads(); \
  } while (0)
#define A_STEP(j) do { \
    const int st = ((j) & 1) * STG; \
    if ((j) + 1 < NT) A_DMA((j) + 1, ((j) + 1) & 1); \
    const int kt_ = lat_lo + (j) - 4; \
    const bool need = active && ((j) < 4 || (kt_ >= wlo && kt_ <= whi)); \
    if (need) { \
      f32x16 s[2][2]; \
      _Pragma("unroll") for (int kb = 0; kb < 2; ++kb) { \
        _Pragma("unroll") for (int ks = 0; ks < 4; ++ks) { const bf16x8 kf = *(const LAS bf16x8*)(kfb + st + kb * 4096 + (((2 * ks + hh) ^ kkey) << 4)); \
          _Pragma("unroll") for (int qi = 0; qi < 2; ++qi) { if (ks == 0) { _Pragma("unroll") for (int i = 0; i < 16; ++i) s[qi][kb][i] = 0.f; } s[qi][kb] = MFMA(kf, qf[qi][ks], s[qi][kb]); } } \
        if (MLA) { _Pragma("unroll") for (int ks = 0; ks < 2; ++ks) { const bf16x8 kf = *(const LAS bf16x8*)(krb + st + kb * 2048 + (((2 * ks + hh) ^ rkey) << 4)); \
          _Pragma("unroll") for (int qi = 0; qi < 2; ++qi) s[qi][kb] = MFMA(kf, qf[qi][NKS - 2 + ks], s[qi][kb]); } } \
      } \
      if (FAST) __builtin_amdgcn_sched_barrier(0); \
      _Pragma("unroll") for (int qi = 0; qi < 2; ++qi) { \
        if ((BR == 1 || BR == 2) && (j) >= 4) { const int ql_ = qlat0 + 32 * qi; attn_mask<BR>(s[qi], kt_, ql_, ql_ >> 6, ql_ & 63, hh, rpb); } \
        if (FAST) { \
          float ls0 = 0.f, ls1 = 0.f; \
          _Pragma("unroll") for (int i = 0; i < 16; ++i) { \
            const float e0 = __builtin_amdgcn_exp2f(s[qi][0][i]), e1 = __builtin_amdgcn_exp2f(s[qi][1][i]); \
            s[qi][0][i] = e0; s[qi][1][i] = e1; FADD(ls0, e0); FADD(ls1, e1); } \
          l_run[qi] += ls0 + ls1; \
        } else { \
        float mx = s[qi][0][0]; \
        _Pragma("unroll") for (int i = 1; i < 16; ++i) mx = fmaxf(mx, s[qi][0][i]); \
        _Pragma("unroll") for (int i = 0; i < 16; ++i) mx = fmaxf(mx, s[qi][1][i]); \
        mx = fmaxf(mx, __shfl_xor(mx, 32)); \
        const float m_new = fmaxf(m_run[qi], mx); \
        const float alpha = __builtin_amdgcn_exp2f(m_run[qi] - m_new); \
        m_run[qi] = m_new; \
        float ls0 = 0.f, ls1 = 0.f; \
        _Pragma("unroll") for (int i = 0; i < 16; ++i) { \
          const float e0 = __builtin_amdgcn_exp2f(s[qi][0][i] - m_new), e1 = __builtin_amdgcn_exp2f(s[qi][1][i] - m_new); \
          s[qi][0][i] = e0; s[qi][1][i] = e1; ls0 += e0; ls1 += e1; } \
        l_run[qi] = l_run[qi] * alpha + (ls0 + ls1); \
        if (__any(alpha != 1.f)) { _Pragma("unroll") for (int i = 0; i < 16; ++i) { o[qi][0][i] *= alpha; o[qi][1][i] *= alpha; } } \
        } \
      } \
      _Pragma("unroll") for (int s4 = 0; s4 < 4; ++s4) { \
        const int kb = s4 >> 1, rb = (s4 & 1) * 8; \
        bf16x8 pf[2]; \
        _Pragma("unroll") for (int qi = 0; qi < 2; ++qi) { u32x4 pw; \
          pw.x = pk2(s[qi][kb][rb + 0], s[qi][kb][rb + 1]); pw.y = pk2(s[qi][kb][rb + 2], s[qi][kb][rb + 3]); \
          pw.z = pk2(s[qi][kb][rb + 4], s[qi][kb][rb + 5]); pw.w = pk2(s[qi][kb][rb + 6], s[qi][kb][rb + 7]); \
          pf[qi] = __builtin_bit_cast(bf16x8, pw); } \
        _Pragma("unroll") for (int db = 0; db < 2; ++db) { const bf16x8 vf = vtr2s(vfb + st + s4 * 2048, ((4 * db + vch) ^ vkey) << 4, ((4 * db + vch) ^ vkey ^ 4) << 4); \
          o[0][db] = MFMA(vf, pf[0], o[0][db]); o[1][db] = MFMA(vf, pf[1], o[1][db]); } \
      } \
    } \
    asm volatile("s_waitcnt vmcnt(0)" ::: "memory");        \
    __syncthreads(); \
  } while (0)
  if (FAST) {
    if (wave >= 4) __builtin_amdgcn_s_setprio(1);
    for (int j = 0; j < NT; j += 2) {
      F_STEP(j);
      if (j + 1 < NT) F_STEP(j + 1);
    }
    __builtin_amdgcn_s_setprio(0);
  } else {
    for (int j = 0; j < NT; j += 2) {
      A_STEP(j);
      if (j + 1 < NT) A_STEP(j + 1);
    }
  }
#undef F_STEP
#undef SM_EL
#undef A_STEP
#undef A_DMA
#undef DMA16
  bool bad = false;
  if (active) {
#pragma unroll
    for (int qi = 0; qi < 2; ++qi) {
      if (FAST) l_run[qi] = l2[qi][0] + l2[qi][1];
      const float lt = l_run[qi] + __shfl_xor(l_run[qi], 32);
      const float inv = 1.f / lt;
      if (FAST) bad = bad || !(lt > 1e-25f && lt < 1e25f);
      unsigned char* Op = wsp<unsigned char>(p, OFF_O) + (tokq + 32 * qi) * 1024 + obase;
#pragma unroll
      for (int db = 0; db < 2; ++db)
#pragma unroll
        for (int gp = 0; gp < 2; ++gp) {
          float q[8];
#pragma unroll
          for (int j = 0; j < 8; ++j) q[j] = __builtin_amdgcn_fmed3f(o[qi][db][8 * gp + j] * (inv * O8_SCALE), -448.f, 448.f);
          int wa = __builtin_amdgcn_cvt_pk_fp8_f32(q[0], q[1], 0, false); wa = __builtin_amdgcn_cvt_pk_fp8_f32(q[2], q[3], wa, true);
          int wb = __builtin_amdgcn_cvt_pk_fp8_f32(q[4], q[5], 0, false); wb = __builtin_amdgcn_cvt_pk_fp8_f32(q[6], q[7], wb, true);
          const u32x2 sx = __builtin_amdgcn_permlane32_swap((unsigned)wa, (unsigned)wb, false, false);
          *(u32x2*)(Op + db * 32 + 16 * gp + 8 * hh) = sx;
        }
    }
  }
  if (!FAST) return false;
  LAS int* flag = (LAS int*)(lds + 2 * STG + 2048);
  if (__any(bad) && lane == 0) *flag = 1;
  __syncthreads();
  return __builtin_amdgcn_readfirstlane(*flag) != 0;
}
template <bool FAST>
DEVI bool attn_dispatch(KP p, int l, int n, int xcd, ldsp_t lds) {
  int br, s, qb; bool isctx = false;
  if (n < 32) { br = 0; s = xcd + 8 * (n >> 3); qb = n & 7; }
  else if (n < 64) { const int m = n - 32; br = 3; s = xcd + 8 * (m >> 4); qb = m & 15; }
  else if (n < 96) { const int m = n - 64; br = 2; s = xcd + 8 * (m >> 3); qb = m & 7; }
  else if (n < 128) { const int m = n - 96; br = 1; s = xcd + 8 * (m >> 4); qb = m & 15; }
  else {
    const int m = n - 128; isctx = true; qb = 0;
    if (m < 4) { br = 0; s = xcd + 8 * m; }
    else if (m < 6) { br = 3; s = xcd + 8 * (m - 4); }
    else if (m < 10) { br = 2; s = xcd + 8 * (m - 6); }
    else { br = 1; s = xcd + 8 * (m - 10); }
  }
  if (br == 0) return attn_item2<0, FAST>(p, l, s >> 2, s & 3, qb, isctx, lds);
  else if (br == 1) return attn_item2<1, FAST>(p, l, s >> 1, s & 1, qb, isctx, lds);
  else if (br == 2) return attn_item2<2, FAST>(p, l, s >> 2, s & 3, qb, isctx, lds);
  else return attn_item2<3, FAST>(p, l, s >> 1, s & 1, qb, isctx, lds);
}
DEVI void phaseD2(KP p, int l, ldsp_t lds) {
  const int G8 = gridDim.x >> 3, xcd = BIDX & 7, lb = BIDX >> 3;
  if (lb >= G8) return;
  const int NLOC = 128 + (l == 0 ? 12 : 0);
  const int nmine = (NLOC - lb + G8 - 1) / G8;
  const int cslot = min((int)(BIDX & 3), nmine - 1);
  int it = 0; unsigned redo = 0;
  for (int n = lb; n < NLOC; n += G8, ++it) {
    if (it == cslot) conv_items2(p, l, lds, CONV_EARLY, CONV_ITEMS);
    if (attn_dispatch<true>(p, l, n, xcd, lds)) redo |= 1u << it;
  }
  if (redo) {
    it = 0;
    for (int n = lb; n < NLOC; n += G8, ++it)
      if ((redo >> it) & 1) attn_dispatch<false>(p, l, n, xcd, lds);
  }
}

DEVI int pm_map(int pme, bool skipctx) { return skipctx ? (pme >> 4) * 17 + 1 + (pme & 15) : pme; }
struct SchedE1 { const char* ws; bool skipctx; int G, c;
  DEVI bool next(int i, Unit& u) const { int pm, pn; if (!tile_order(i, G, c, skipctx ? 128 : 136, 16, pm, pn)) return false;
    pm = pm_map(pm, skipctx); const int n = pn >> 2, cq = pn & 3;
    u.A = ws + OFF_O + uoff((unsigned)pm * 256u * 1024u + (unsigned)n * 256u); u.B = ws + OFF_WBR + uoff(((unsigned)n * 1024u + (unsigned)cq * 256u) * 256u); u.rows = nullptr; u.nvalid = 0;
    u.u0 = pm * 256; u.u1 = pn * 256; u.u2 = 0; u.u3 = 0; return true; } };
DEVI void phaseE1(KP p, int l, ldsp_t lds) {
  if (BIDX == 0 && TIDX < 32) wsp<int>(p, OFF_CNT)[TIDX * CNT_STRIDE] = 0;
  SchedE1 S{(const char*)p->ws, l == 1, (int)gridDim.x, BIDX};
  EpiZ8 E{wsp<unsigned char>(p, OFF_Z)};
  gemm_phase<true, false, true>(lds, 1024, 256, 2, S, E);
  asm volatile("s_waitcnt vmcnt(0)" ::: "memory");
  __syncthreads();
  if (TIDX == 0) __hip_atomic_fetch_add(wsp<int>(p, OFF_DEP) + DEP_E1DONE + l * DEP_STRIDE, 1, __ATOMIC_RELAXED, __HIP_MEMORY_SCOPE_AGENT);
}
struct SchedE2 { const char* ws; const char* h8; bool skipctx; int G, c;
  DEVI bool next(int i, Unit& u) const { int pm, pn; int pr = i & 1, tl = 0;
    if (!skipctx && G == 256 && i >= 8) { if (i > 8 || c >= 128) return false; tile_order(4, G, c >> 1, 136, 8, pm, pn); pr = c & 1; tl = 1 + (c >> 1); }
    else if (!tile_order(i >> 1, G, c, skipctx ? 128 : 136, 8, pm, pn)) return false;
    pm = pm_map(pm, skipctx);
    u.A = h8 + uoff((unsigned)pm * 256u * 1024u); u.B = ws + OFF_WGATE + uoff((unsigned)(pr * 8 + pn) * 256u * 1024u); u.rows = nullptr; u.nvalid = 0;
    u.u0 = pm * 256; u.u1 = pn * 128; u.u2 = pr; u.u3 = tl; return true; } };
constexpr float Y8_SCALE = 16.f;
static_assert(Y8_SCALE == Z8_SCALE, "the E2 epilogue keeps its sums in Z8 units");
struct EpiE2 { const unsigned char* Z; u32x4 (&part)[8]; unsigned char* Y8; const float* bias; char* ws; int& e1done; const int* e1ctr;
  DEVI void init(f32x4 (&acc)[2][2][4][2], const Unit& u, int wr, int wc, int fr, int fq) const {
    const int col0 = u.u1 + wc * 32 + 8 * fq;
#pragma unroll
    for (int bj = 0; bj < 2; ++bj)
#pragma unroll
      for (int nn = 0; nn < 2; ++nn) {
        const f32x4 b = *(const f32x4*)(bias + (2 * u.u2 + bj) * 1024 + col0 + 4 * nn) * -LOG2E;
#pragma unroll
        for (int a = 0; a < 2; ++a)
#pragma unroll
          for (int m = 0; m < 4; ++m) acc[a][bj][m][nn] = b;
      }
  }
  DEVI void operator()(const f32x4 (&acc)[2][2][4][2], const Unit& u, int wr, int wc, int fr, int fq) const {
    const int row0 = u.u0 + wr * 64 + fr, col0 = u.u1 + wc * 32 + 8 * fq, pr = u.u2;
    const unsigned lw16 = (unsigned)((wr * 4 + wc) * 64 + fr + 16 * fq) * 16u;
    const unsigned char* zb0 = Z + z8_block(u.u0 >> 8, 2 * pr, u.u1 >> 7) + lw16;
    const bool second = pr != 0 && u.u3 == 0;
    if (!e1done) {
      while (__hip_atomic_load(e1ctr, __ATOMIC_RELAXED, __HIP_MEMORY_SCOPE_AGENT) < (int)gridDim.x) __builtin_amdgcn_s_sleep(8);
      asm volatile("s_waitcnt vmcnt(0)" ::: "memory");
      e1done = 1;
    }
    u32x4 zq[4][2], yq[4][2];
    auto ldpair = [&](int P, u32x4 (&z)[2], u32x4 (&y)[2]) {
#pragma unroll
      for (int bj = 0; bj < 2; ++bj) z[bj] = *(const u32x4*)(zb0 + (size_t)bj * 8 * 32768 + P * 8192);
#pragma unroll
      for (int h = 0; h < 2; ++h) y[h] = second ? part[2 * P + h] : u32x4{0u, 0u, 0u, 0u};
    };
#pragma unroll
    for (int P = 0; P < 4; ++P) ldpair(P, zq[P], yq[P]);
#pragma unroll
    for (int P = 0; P < 4; ++P) {
      const int c = P;
#pragma unroll
      for (int h = 0; h < 2; ++h) {
        const int g = 2 * P + h, ai = g >> 2, m = g & 3;
        const size_t r = (size_t)(row0 + ai * HALF + m * 16);
        float t[8];
        {
          const unsigned w[4] = {yq[c][h].x, yq[c][h].y, yq[c][h].z, yq[c][h].w};
#pragma unroll
          for (int i = 0; i < 4; ++i) { t[2 * i] = __uint_as_float(w[i] << 16); t[2 * i + 1] = __uint_as_float(w[i] & 0xffff0000u); }
        }
#pragma unroll
        for (int bj = 0; bj < 2; ++bj) {
#pragma unroll
          for (int nn = 0; nn < 2; ++nn) {
            const int zw = (int)zq[c][bj][2 * h + nn];
            const f32x2 zlo = __builtin_amdgcn_cvt_pk_f32_fp8(zw, false), zhi = __builtin_amdgcn_cvt_pk_f32_fp8(zw, true);
            const float zz4[4] = {zlo.x, zlo.y, zhi.x, zhi.y};
#pragma unroll
            for (int j = 0; j < 4; ++j) {
              const int e = 4 * nn + j;
              const float gte = __builtin_amdgcn_rcpf(1.f + __builtin_amdgcn_exp2f(acc[ai][bj][m][nn][j]));
              t[e] += gte * zz4[j];
            }
          }
        }
        if (!second) {
          u32x4 o; o.x = pk2(t[0], t[1]); o.y = pk2(t[2], t[3]); o.z = pk2(t[4], t[5]); o.w = pk2(t[6], t[7]);
          part[g] = o;
        } else {
          u32x2 o8;
#pragma unroll
          for (int w = 0; w < 2; ++w) {
            float q[4];
#pragma unroll
            for (int j = 0; j < 4; ++j) q[j] = __builtin_amdgcn_fmed3f(t[4 * w + j], -448.f, 448.f);
            int v = __builtin_amdgcn_cvt_pk_fp8_f32(q[0], q[1], 0, false);
            v = __builtin_amdgcn_cvt_pk_fp8_f32(q[2], q[3], v, true);
            o8[w] = (unsigned)v;
          }
          *(u32x2*)(Y8 + r * 1024 + col0) = o8;
        }
      }
    }
    if (u.u3) {
      const int tl = u.u3 - 1, wv = wr * 4 + wc;
      const __amdgpu_buffer_rsrc_t prs = __builtin_amdgcn_make_buffer_rsrc((void*)(ws + OFF_E2PART), 0, 128 * 65536, 0x00020000);
#pragma unroll
      for (int g = 0; g < 8; ++g) __builtin_amdgcn_raw_buffer_store_b128(part[g], prs, (int)((unsigned)(tl * 2 + pr) * 65536u + (unsigned)g * 8192u + lw16), 0, 16);
      asm volatile("s_waitcnt vmcnt(0)" ::: "memory");
      int old = 0;
      if ((fr | fq) == 0) old = __hip_atomic_fetch_add((int*)(ws + OFF_DEP) + DEP_E2T + tl * 8 + wv, 1, __ATOMIC_RELAXED, __HIP_MEMORY_SCOPE_AGENT);
      old = __builtin_amdgcn_readfirstlane(old);
      if (old == 1) {
        __builtin_amdgcn_fence(__ATOMIC_ACQUIRE, "agent");
        u32x4 oth[8];
#pragma unroll
        for (int g = 0; g < 8; ++g) oth[g] = __builtin_amdgcn_raw_buffer_load_b128(prs, (int)((unsigned)(tl * 2 + (pr ^ 1)) * 65536u + (unsigned)g * 8192u + lw16), 0, 16);
#pragma unroll
        for (int g = 0; g < 8; ++g) {
          const int ai = g >> 2, m = g & 3;
          const size_t r = (size_t)(row0 + ai * HALF + m * 16);
          u32x2 o8;
#pragma unroll
          for (int w = 0; w < 2; ++w) {
            float q[4];
#pragma unroll
            for (int j = 0; j < 2; ++j) {
              const unsigned a = part[g][2 * w + j], b2 = oth[g][2 * w + j];
              q[2 * j] = __builtin_amdgcn_fmed3f(__uint_as_float(a << 16) + __uint_as_float(b2 << 16), -448.f, 448.f);
              q[2 * j + 1] = __builtin_amdgcn_fmed3f(__uint_as_float(a & 0xffff0000u) + __uint_as_float(b2 & 0xffff0000u), -448.f, 448.f);
            }
            int v = __builtin_amdgcn_cvt_pk_fp8_f32(q[0], q[1], 0, false);
            v = __builtin_amdgcn_cvt_pk_fp8_f32(q[2], q[3], v, true);
            o8[w] = (unsigned)v;
          }
          *(u32x2*)(Y8 + r * 1024 + col0) = o8;
        }
      }
    }
  }
};
DEVI void phaseE2(KP p, int l, ldsp_t lds) {
  SchedE2 S{(const char*)p->ws, (const char*)h8base(p), l == 1, (int)gridDim.x, BIDX};
  u32x4 part[8];
#pragma unroll
  for (int i = 0; i < 8; ++i) part[i] = u32x4{0u, 0u, 0u, 0u};
  int e1done = 0;
  EpiE2 E{wsp<unsigned char>(p, OFF_Z), part, wsp<unsigned char>(p, OFF_Y8), p->b_gate + (size_t)l * 4 * 1024, p->ws, e1done, wsp<int>(p, OFF_DEP) + DEP_E1DONE + l * DEP_STRIDE};
  gemm_phase<true, false, true>(lds, 1024, 1024, 8, S, E);
}
struct SchedF { const char* ws; bool skipctx; int G, c;
  DEVI bool next(int i, Unit& u) const { int pm, pn;
    if (skipctx || G != 256) { if (!tile_order(i, G, c, skipctx ? 128 : 136, 4, pm, pn)) return false; }
    else if (i < 2) { if (!tile_order(i, G, c, 128, 4, pm, pn)) return false; }
    else { if (i > 2 || c >= 32) return false; pm = 128 + (c >> 2); pn = c & 3; }
    pm = pm_map(pm, skipctx);
    u.A = ws + OFF_Y8 + uoff((unsigned)pm * 256u * 1024u); u.B = ws + OFF_WOUT + uoff((unsigned)pn * 256u * 1024u); u.rows = nullptr; u.nvalid = 0;
    u.u0 = pm; u.u1 = pn * 256; u.u2 = 0; u.u3 = 0; return true; } };
struct EpiF { KP p; int l;
  DEVI void init(f32x4 (&acc)[2][2][4][2], const Unit&, int, int, int, int) const { acc_zero(acc); }
  DEVI void operator()(const f32x4 (&acc)[2][2][4][2], const Unit& u, int wr, int wc, int fr, int fq) const {
    const int pm = u.u0, b = pm / 17, rr0 = (pm % 17) * 256;
    const int mrow = (rr0 < NCTX) ? 8 : b;
    const int col0 = u.u1 + wc * 32 + 8 * fq;
    const float* gt = wsp<float>(p, OFF_MOD) + ((size_t)l * 9 + mrow) * 6144 + 2048 + col0;
    const u16* xinb = (const u16*)p->out + (size_t)(b * TPB + rr0) * 1024 + col0;
    const __amdgpu_buffer_rsrc_t xrs = __builtin_amdgcn_make_buffer_rsrc((void*)wsp<u16>(p, OFF_XM), 0, NTOK * 1024 * 2, 0x00020000);
    const unsigned xoff = (unsigned)((b * TPB + rr0) * 1024 + col0) * 2u;
    f32x4 gv[2][2];
#pragma unroll
    for (int bj = 0; bj < 2; ++bj)
#pragma unroll
      for (int n = 0; n < 2; ++n) gv[bj][n] = *(const f32x4*)(gt + bj * HALF + n * 4) * (1.f / Y8_SCALE);
#pragma unroll
    for (int ai = 0; ai < 2; ++ai) {
      u32x4 xo[4][2];
#pragma unroll
      for (int m = 0; m < 4; ++m) {
        const size_t ro = (size_t)(wr * 64 + fr + ai * HALF + m * 16) * 1024;
#pragma unroll
        for (int bj = 0; bj < 2; ++bj) xo[m][bj] = *(const u32x4*)(xinb + ro + bj * HALF);
      }
#pragma unroll
      for (int mp = 0; mp < 2; ++mp) {
#pragma unroll
        for (int mm = 0; mm < 2; ++mm) {
          const int m = 2 * mp + mm;
          const size_t ro = (size_t)(wr * 64 + fr + ai * HALF + m * 16) * 1024;
#pragma unroll
          for (int bj = 0; bj < 2; ++bj) {
            const u32x4 v = xo[m][bj];
            const f32x4 x0 = f32x4{__uint_as_float(v.x << 16), __uint_as_float(v.x & 0xffff0000u), __uint_as_float(v.y << 16), __uint_as_float(v.y & 0xffff0000u)};
            const f32x4 x1 = f32x4{__uint_as_float(v.z << 16), __uint_as_float(v.z & 0xffff0000u), __uint_as_float(v.w << 16), __uint_as_float(v.w & 0xffff0000u)};
            const f32x4 r0 = x0 + gv[bj][0] * acc[ai][bj][m][0], r1 = x1 + gv[bj][1] * acc[ai][bj][m][1];
            __builtin_amdgcn_raw_buffer_store_b128(u32x4{pk2(r0.x, r0.y), pk2(r0.z, r0.w), pk2(r1.x, r1.y), pk2(r1.z, r1.w)}, xrs,
                                                   (int)(xoff + (unsigned)(ro + bj * HALF) * 2u), 0, 16);
          }
        }
      }
    }
    asm volatile("s_waitcnt vmcnt(0)" ::: "memory");
    if ((TIDX & 63) == 0) __hip_atomic_fetch_add(wsp<int>(p, OFF_DEP) + (l * 136 + pm) * DEP_STRIDE, 1, __ATOMIC_RELAXED, __HIP_MEMORY_SCOPE_AGENT);
  }
};
DEVI void phaseF2(KP p, int l, ldsp_t lds) {
  SchedF S{(const char*)p->ws, l == 1, (int)gridDim.x, BIDX};
  EpiF E{p, l};
  gemm_phase<true, false, true>(lds, 1024, 1024, 8, S, E);
}


DEVI void phase0_2(KP p, ldsp_t lds) {
  const int tid = TIDX, half = tid >> 8, htid = tid & 255;
  for (int it = BIDX * 2; it < 458; it += gridDim.x * 2) {
    const int item = it + half;
    LAS float* sc = (LAS float*)(lds + half * 16384);
    const bool ismod = item < 384;
    const int l = item / 192, rem = item % 192, cgp = rem >> 3, kc = rem & 7;
    __syncthreads();
    if (ismod) {
      for (int i = htid; i < 9 * 128; i += 256) {
        int b = i >> 7, k = i & 127;
        float v = (b < 8) ? p->c[b * 1024 + kc * 128 + k] : p->c_ctx[kc * 128 + k];
        sc[i] = v / (1.f + __expf(-v));
      }
    }
    __syncthreads();
    if (ismod) {
      float acc[9];
#pragma unroll
      for (int b = 0; b < 9; ++b) acc[b] = 0.f;
      const float* w = p->w_mod + ((size_t)l * 1024 + kc * 128) * 6144 + cgp * 256 + htid;
#pragma unroll 1
      for (int k0 = 0; k0 < 128; k0 += 64) {
        float wv[64];
#pragma unroll
        for (int j = 0; j < 64; ++j) wv[j] = __builtin_nontemporal_load(w + (size_t)(k0 + j) * 6144);
        __builtin_amdgcn_sched_barrier(0);
#pragma unroll
        for (int j = 0; j < 64; ++j)
#pragma unroll
          for (int b = 0; b < 9; ++b) acc[b] += sc[b * 128 + k0 + j] * wv[j];
      }
      float* dst = wsp<float>(p, OFF_MODP) + (size_t)((kc * 2 + l) * 9) * 6144 + cgp * 256 + htid;
#pragma unroll
      for (int b = 0; b < 9; ++b) dst[(size_t)b * 6144] = acc[b];
    } else if (item == 384) {
      float* cs32 = wsp<float>(p, OFF_CS32);
      float* cs16 = wsp<float>(p, OFF_CS16);
      for (int t = htid; t < 1024; t += 256) {
        int pos = t >> 4, i = t & 15;
        float ang = (float)pos * __builtin_amdgcn_exp2f(-(float)(2 * i) * (13.287712379549449f / 32.f));
        cs32[t * 2] = __cosf(ang); cs32[t * 2 + 1] = __sinf(ang);
      }
      for (int t = htid; t < 512; t += 256) {
        int pos = t >> 3, i = t & 7;
        float ang = (float)pos * __builtin_amdgcn_exp2f(-(float)(2 * i) * (13.287712379549449f / 16.f));
        cs16[t * 2] = __cosf(ang); cs16[t * 2 + 1] = __sinf(ang);
      }
    } else if (item < 457) {
      const int q = item - 385, ll = q / 36, o = q % 36;
      float* dst = wsp<float>(p, OFF_WRT) + ((size_t)ll * 36 + o) * 1024;
      for (int k = htid; k < 1024; k += 256)
        dst[k] = (o < 4) ? p->w_group[((size_t)ll * 1024 + k) * 4 + o] : p->w_router[((size_t)ll * 1024 + k) * 32 + (o - 4)];
    }
  }
}
DEVI void phase1_2(KP p) {
  const float* mp = wsp<float>(p, OFF_MODP);
  float* mo = wsp<float>(p, OFF_MOD);
  for (int i = BIDX * 512 + TIDX; i < 2 * 9 * 6144; i += gridDim.x * 512) {
    int l = i / (9 * 6144), o = i % 6144;
    float s = p->b_mod[l * 6144 + o];
#pragma unroll
    for (int kc = 0; kc < 8; ++kc) s += mp[(size_t)kc * 2 * 9 * 6144 + i];
    mo[i] = s;
  }
}
DEVI void phaseA2(KP p) {
  const int gw = BIDX * NW + (TIDX >> 6), nw = gridDim.x * NW;
  u16* H = wsp<u16>(p, OFF_H);
  const int per = (NTOK + nw - 1) / nw;
  const int t0 = gw * per, t1 = min(t0 + per, NTOK);
  int cur = -1; ModVec mv;
  for (int tok0 = t0; tok0 < t1; tok0 += 2) {
    float xv[2][16];
#pragma unroll
    for (int r = 0; r < 2; ++r) { const int tok = tok0 + r; if (tok < t1) load_row16(xrow_in(p, 0, tok / TPB, tok % TPB), xv[r]); }
#pragma unroll
    for (int r = 0; r < 2; ++r) {
      const int tok = tok0 + r;
      if (tok < t1) {
        const int mrow = (tok % TPB) < NCTX ? 8 : tok / TPB;
        if (mrow != cur) { load_modvec(p, 0, 0, mrow, mv); cur = mrow; }
        float hv[16]; modulate_row_store2<true, false>(mv, xv[r], nullptr, hv, h8base(p) + (size_t)tok * 1024);
        u16* xb = (u16*)p->out + (size_t)tok * 1024 + (TIDX & 63) * 4;
#pragma unroll
        for (int i = 0; i < 4; ++i) *(u32x2*)(xb + i * 256) = u32x2{pk2(xv[r][i * 4], xv[r][i * 4 + 1]), pk2(xv[r][i * 4 + 2], xv[r][i * 4 + 3])}; }
    }
  }
}
DEVI void phaseG2(KP p, int l, ldsp_t lds) {
  constexpr int RP = 2064;
  constexpr int GX = 2 * 32 * RP;
  const int tid = TIDX, lane = tid & 63, wave = __builtin_amdgcn_readfirstlane(tid >> 6);
  const int r32 = lane & 31, kh = lane >> 5, qd = lane >> 4;
  u16* H = wsp<u16>(p, OFF_H2);
  const float* WRT = wsp<float>(p, OFF_WRT) + (size_t)l * 36 * 1024;
  int* cnt = wsp<int>(p, OFF_CNT);
  int* list = wsp<int>(p, OFF_LIST);
  float* wlist = wsp<float>(p, OFF_WLIST);
  const ldsp_t hiP = lds, loP = lds + 32 * RP;
  LAS float* part = (LAS float*)lds;
  LAS int* gsel = (LAS int*)(lds + GX);
  LAS float* gwt = (LAS float*)(lds + GX + 128);
  LAS int* lcnt = (LAS int*)(lds + GX + 256);
  LAS int* gbase = lcnt + 32;
  LAS int* tinfo = lcnt + 64;
  if (tid < 32) lcnt[tid] = 0;
  int nloc = 0;
  bf16x8 whi[8], wlo[8];
  {
    const float* wr = p->w_router + (size_t)l * 1024 * 32 + r32;
#pragma unroll
    for (int s8 = 0; s8 < 8; ++s8) {
      u32x4 h, lo4;
#pragma unroll
      for (int jj = 0; jj < 4; ++jj) {
        const int k = 128 * wave + 16 * s8 + 8 * kh + 2 * jj;
        const float a = wr[(size_t)k * 32], b2 = wr[(size_t)(k + 1) * 32];
        const unsigned hp = pk2(a, b2);
        h[jj] = hp; lo4[jj] = pk2(a - __uint_as_float(hp << 16), b2 - __uint_as_float(hp & 0xffff0000u));
      }
      whi[s8] = __builtin_bit_cast(bf16x8, h); wlo[s8] = __builtin_bit_cast(bf16x8, lo4);
    }
  }
  int* tctr = wsp<int>(p, OFF_DEP) + DEP_TILECTR + l * DEP_STRIDE;
  LAS int* tnext = lcnt + 64 + 512 * 6;
  const int ntile = (l == 1) ? 8 * SEQ / 32 : NTOK / 32;
  if (tid == 0) *tnext = atomicAdd(tctr, 1);
  __syncthreads();
  for (;;) {
    const int tix = *tnext;
    if (tix >= ntile) break;
    int tclaim = 0;
    if (tid == 0) tclaim = atomicAdd(tctr, 1);
    const int tile = (l == 1) ? (tix >> 7) * 136 + 8 + (tix & 127) : tix;
    const int tok0 = tile * 32, b = tok0 / TPB, rr0 = tok0 % TPB;
    if (wave == 0) {
      const int* dep = wsp<int>(p, OFF_DEP) + (l * 136 + (tok0 >> 8)) * DEP_STRIDE;
      while (__hip_atomic_load(dep, __ATOMIC_RELAXED, __HIP_MEMORY_SCOPE_AGENT) < 32) __builtin_amdgcn_s_sleep(2);
      asm volatile("s_waitcnt vmcnt(0)" ::: "memory");
    }
    __syncthreads();
    {
      float hv[4][16], xv4[4][16];
#pragma unroll
      for (int r = 0; r < 4; ++r) load_row16_bf(wsp<u16>(p, OFF_XM) + (size_t)(tok0 + wave * 4 + r) * 1024, xv4[r]);
      ModVec mv; load_modvec(p, l, 1, (rr0 < NCTX) ? 8 : b, mv);
#pragma unroll
      for (int r = 0; r < 4; ++r) {
        modulate_row_store2<true, false>(mv, xv4[r], nullptr, hv[r], (unsigned char*)H + (size_t)(tok0 + wave * 4 + r) * 1024);
        const int ro = (wave * 4 + r) * RP + lane * 8;
#pragma unroll
        for (int i = 0; i < 4; ++i) {
          const unsigned h01 = pk2(hv[r][i * 4], hv[r][i * 4 + 1]), h23 = pk2(hv[r][i * 4 + 2], hv[r][i * 4 + 3]);
          const unsigned l01 = pk2(hv[r][i * 4] - __uint_as_float(h01 << 16), hv[r][i * 4 + 1] - __uint_as_float(h01 & 0xffff0000u));
          const unsigned l23 = pk2(hv[r][i * 4 + 2] - __uint_as_float(h23 << 16), hv[r][i * 4 + 3] - __uint_as_float(h23 & 0xffff0000u));
          *(LAS u32x2*)(hiP + ro + i * 512) = u32x2{h01, h23};
          *(LAS u32x2*)(loP + ro + i * 512) = u32x2{l01, l23};
        }
      }
      float gl[4];
#pragma unroll
      for (int o = 0; o < 4; ++o) gl[o] = router_dot(hv, WRT + (size_t)o * 1024) + p->b_group[l * 4 + o];
      int gs = 0; float best = gl[0];
#pragma unroll
      for (int j = 1; j < 4; ++j) if (gl[j] > best) { best = gl[j]; gs = j; }
      float gsum = 0.f;
#pragma unroll
      for (int j = 0; j < 4; ++j) gsum += __expf(gl[j] - best);
      if ((lane & 15) == 0) { gsel[wave * 4 + qd] = gs; gwt[wave * 4 + qd] = 1.f / gsum; }
    }
    __syncthreads();
    f32x16 acc;
#pragma unroll
    for (int i = 0; i < 16; ++i) acc[i] = 0.f;
    {
      const int ao = r32 * RP + (128 * wave + 8 * kh) * 2;
#pragma unroll
      for (int s8 = 0; s8 < 8; ++s8) {
        const bf16x8 ah = *(const LAS bf16x8*)(hiP + ao + s8 * 32), al = *(const LAS bf16x8*)(loP + ao + s8 * 32);
        acc = MFMA(ah, whi[s8], acc);
        acc = MFMA(ah, wlo[s8], acc);
        acc = MFMA(al, whi[s8], acc);
      }
    }
    __syncthreads();
#pragma unroll
    for (int i = 0; i < 16; ++i) part[(wave * 32 + (i & 3) + 8 * (i >> 2) + 4 * kh) * 33 + r32] = acc[i];
    __syncthreads();
    if (tid < 32) {
      const int gs = gsel[tid];
      const float gw_ = gwt[tid];
      float e8[8];
#pragma unroll
      for (int j = 0; j < 8; ++j) {
        float v = p->b_router[l * 32 + gs * 8 + j];
#pragma unroll
        for (int w = 0; w < 8; ++w) v += part[(w * 32 + tid) * 33 + gs * 8 + j];
        e8[j] = v;
      }
      int i0 = 0; float v0 = e8[0];
#pragma unroll
      for (int j = 1; j < 8; ++j) if (e8[j] > v0) { v0 = e8[j]; i0 = j; }
      int i1 = -1; float v1 = -INFINITY;
#pragma unroll
      for (int j = 0; j < 8; ++j) if (j != i0 && e8[j] > v1) { v1 = e8[j]; i1 = j; }
      const float ex = __expf(v1 - v0);
      const float w0 = gw_ / (1.f + ex), w1 = gw_ * ex / (1.f + ex);
      const int tok = tok0 + tid;
      const int ea = gs * 8 + i0, eb = gs * 8 + i1;
      const int ra = __hip_atomic_fetch_add(&lcnt[ea], 1, __ATOMIC_RELAXED, __HIP_MEMORY_SCOPE_WORKGROUP);
      const int rb = __hip_atomic_fetch_add(&lcnt[eb], 1, __ATOMIC_RELAXED, __HIP_MEMORY_SCOPE_WORKGROUP);
      LAS int* ti = tinfo + (nloc + tid) * 6;
      ti[0] = tok; ti[1] = ea | (eb << 8); ti[2] = ra; ti[3] = rb; ti[4] = __float_as_int(w0); ti[5] = __float_as_int(w1);
    }
    if (tid == 0) *tnext = tclaim;
    nloc += 32;
    __syncthreads();
    const bool last = *tnext >= ntile;
    if (last || nloc == 512) {
      if (tid < 32) { const int c = lcnt[tid]; gbase[tid] = c ? atomicAdd(&cnt[tid * CNT_STRIDE], c) : 0; }
      __syncthreads();
      for (int i = tid; i < nloc; i += 512) {
        const LAS int* ti = tinfo + i * 6;
        const int tok = ti[0], ea = ti[1] & 255, eb = ti[1] >> 8;
        const int sa = gbase[ea] + ti[2], sb = gbase[eb] + ti[3];
        list[(size_t)ea * NTOK + sa] = tok * 2;
        list[(size_t)eb * NTOK + sb] = tok * 2 + 1;
        *(u32x4*)(wsp<unsigned>(p, OFF_TOKRT) + (size_t)tok * 4) = u32x4{(unsigned)ea | ((unsigned)sa << 8), (unsigned)ti[4], (unsigned)eb | ((unsigned)sb << 8), (unsigned)ti[5]};
      }
      __syncthreads();
      if (tid < 32) lcnt[tid] = 0;
      nloc = 0;
      __syncthreads();
    }
  }
}
struct ExpInfo2 { int tiles[4], base[4], cnt[4]; };
DEVI ExpInfo2 exp_info2(KP p, int xcd) {
  const int* cnt = wsp<int>(p, OFF_CNT);
  ExpInfo2 ei;
  int before = 0;
#pragma unroll
  for (int e = 0; e < 32; ++e) {
    const int c = __builtin_amdgcn_readfirstlane(cnt[e * CNT_STRIDE]), t = (c + 255) >> 8;
    if ((e & 7) == xcd) { ei.tiles[e >> 3] = t; ei.base[e >> 3] = before; ei.cnt[e >> 3] = c; }
    before += t;
  }
  return ei;
}
template <int NN>
struct SchedX { ExpInfo2 ei; int xcd, lb, G8; const char* A; const char* W; const int* list; size_t wstride; int lda_b; int ldw_b;
  DEVI bool next(int i, Unit& u) const {
    const int tot = (ei.tiles[0] + ei.tiles[1] + ei.tiles[2] + ei.tiles[3]) * NN;
    const int n = i * G8 + lb; if (n >= tot) return false;
    int k = 0, m = n / NN; const int pn = n % NN;
    int tb = ei.base[0], ce = ei.cnt[0];
#pragma unroll
    for (int kk = 0; kk < 3; ++kk) { if (k == kk && m >= ei.tiles[kk]) { m -= ei.tiles[kk]; k = kk + 1; tb = ei.base[kk + 1]; ce = ei.cnt[kk + 1]; } }
    const int e = xcd + 8 * k;
    u.rows = list + (size_t)e * NTOK + m * 256; u.nvalid = ce - m * 256;
    u.A = A + (NN == 2 ? 0u : uoff((unsigned)(tb + m) * 256u * (unsigned)lda_b));
    u.B = W + uoff((unsigned)e * (unsigned)wstride + (unsigned)pn * 256u * (unsigned)ldw_b);
    u.u0 = (tb + m) * 256; u.u1 = pn; u.u2 = e; u.u3 = m; return true; } };
constexpr float U8_SCALE = 16.f;
struct EpiI1 { unsigned char* U;
  DEVI void init(f32x4 (&acc)[2][2][4][2], const Unit&, int, int, int, int) const { acc_zero(acc); }
  DEVI void operator()(const f32x4 (&acc)[2][2][4][2], const Unit& u, int wr, int wc, int fr, int fq) const {
#pragma unroll
    for (int ai = 0; ai < 2; ++ai)
#pragma unroll
      for (int m = 0; m < 4; ++m) {
        unsigned char* rowp = U + (size_t)(u.u0 + ai * HALF + wr * 64 + m * 16 + fr) * 256;
#pragma unroll
        for (int bj = 0; bj < 2; ++bj) {
          const int ff = 16 * (8 * u.u1 + 4 * bj + wc) + 4 * fq;
          const f32x4 g = acc[ai][bj][m][0], up = acc[ai][bj][m][1];
          float t[4];
#pragma unroll
          for (int j = 0; j < 4; ++j) t[j] = __builtin_amdgcn_fmed3f(g[j] * __builtin_amdgcn_rcpf(1.f + __builtin_amdgcn_exp2f(g[j] * -LOG2E)) * (up[j] * U8_SCALE), -448.f, 448.f);
          int o = __builtin_amdgcn_cvt_pk_fp8_f32(t[0], t[1], 0, false);
          o = __builtin_amdgcn_cvt_pk_fp8_f32(t[2], t[3], o, true);
          *(int*)(rowp + ff) = o;
        }
      }
  }
};
DEVI void phaseI1_2(KP p, ldsp_t lds) {
  const int xcd = BIDX & 7, lb = BIDX >> 3, G8 = gridDim.x >> 3;
  if (lb >= G8) return;
  SchedX<2> S{exp_info2(p, xcd), xcd, lb, G8, (const char*)wsp<u16>(p, OFF_H2), (const char*)wsp<u16>(p, OFF_W13), wsp<int>(p, OFF_LIST), (size_t)512 * 1024, 1024, 1024};
  EpiI1 E{wsp<unsigned char>(p, OFF_U)};
  int nt = 8; asm volatile("" : "+s"(nt));
  gemm_phase<false, true, true>(lds, 1024, 1024, nt, S, E);
}
constexpr float YS8_SCALE = 32.f;
struct EpiI2 { unsigned char* YS;
  DEVI void init(f32x4 (&acc)[2][2][4][2], const Unit&, int, int, int, int) const { acc_zero(acc); }
  DEVI void operator()(const f32x4 (&acc)[2][2][4][2], const Unit& u, int wr, int wc, int fr, int fq) const {
    unsigned char* base = YS + ((size_t)(u.u0 + wr * 64 + fr) * 1024u + (unsigned)(u.u1 * 256 + wc * 64 + 16 * fq));
#pragma unroll
    for (int ai = 0; ai < 2; ++ai)
#pragma unroll
      for (int m = 0; m < 4; ++m) {
        u32x4 o;
#pragma unroll
        for (int bj = 0; bj < 2; ++bj) {
#pragma unroll
          for (int nn = 0; nn < 2; ++nn) {
            const f32x4 v = acc[ai][bj][m][nn] * (YS8_SCALE / U8_SCALE);
            int q = __builtin_amdgcn_cvt_pk_fp8_f32(__builtin_amdgcn_fmed3f(v[0], -448.f, 448.f), __builtin_amdgcn_fmed3f(v[1], -448.f, 448.f), 0, false);
            q = __builtin_amdgcn_cvt_pk_fp8_f32(__builtin_amdgcn_fmed3f(v[2], -448.f, 448.f), __builtin_amdgcn_fmed3f(v[3], -448.f, 448.f), q, true);
            o[2 * bj + nn] = (unsigned)q;
          }
        }
        if (WT_I2) asm volatile("global_store_dwordx4 %0, %1, off sc1\n\ts_nop 1" :: "v"(base + (size_t)(ai * HALF + m * 16) * 1024u), "v"(o) : "memory");
        else *(u32x4*)(base + (size_t)(ai * HALF + m * 16) * 1024u) = o;
      }
  }
};
DEVI void phaseI2_2(KP p, ldsp_t lds) {
  const int xcd = BIDX & 7, lb = BIDX >> 3, G8 = gridDim.x >> 3;
  if (lb >= G8) return;
  SchedX<4> S{exp_info2(p, xcd), xcd, lb, G8, (const char*)wsp<u16>(p, OFF_U), (const char*)wsp<u16>(p, OFF_W2), wsp<int>(p, OFF_LIST), (size_t)1024 * 256, 256, 256};
  EpiI2 E{wsp<unsigned char>(p, OFF_YS)};
  int nt = 2; asm volatile("" : "+s"(nt));
  gemm_phase<true, false, true>(lds, 256, 256, nt, S, E);
}
DEVI void phaseJ2(KP p, int l, ldsp_t lds) {
  const int lane = TIDX & 63;
  const int gw = BIDX * NW + (TIDX >> 6), nw = gridDim.x * NW;
  const unsigned char* YS = wsp<unsigned char>(p, OFF_YS);
  u16* H = wsp<u16>(p, OFF_H);
  const int ntot = (l == 1) ? 8 * SEQ : NTOK;
  const int per = (ntot + nw - 1) / nw;
  const int i0 = gw * per, i1 = min(i0 + per, ntot);
  int cur = -1; ModVec mv; f32x4 gtv[4];
  int vbefore;
  {
    const int vt = (lane < 32) ? ((wsp<int>(p, OFF_CNT)[lane * CNT_STRIDE] + 255) >> 8) : 0;
    int inc = vt;
#pragma unroll
    for (int d = 1; d < 32; d <<= 1) { const int t = __shfl_up(inc, d); if (lane >= d) inc += t; }
    vbefore = inc - vt;
  }
  u32x4 rt = u32x4{0u, 0u, 0u, 0u};
  {
    const int idx = i0 + lane;
    if (idx < i1) { const int tok = (l == 1) ? (idx / SEQ) * TPB + NCTX + idx % SEQ : idx; rt = *(const u32x4*)(wsp<unsigned>(p, OFF_TOKRT) + (size_t)tok * 4); }
  }
  f32x4 gfin[4];
  if (l == 1) {
#pragma unroll
    for (int i = 0; i < 4; ++i) gfin[i] = *(const f32x4*)(p->g_final + i * 256 + lane * 4);
  }
#define J_ISSUE(II, X, YA, YB, WA, WB, TK, OK) do { \
    _Pragma("unroll") for (int r = 0; r < 2; ++r) { \
      const int idx = (II) + r; \
      const int tok = (l == 1) ? (idx / SEQ) * TPB + NCTX + idx % SEQ : idx; \
      TK[r] = tok; OK[r] = idx < i1; \
      if (OK[r]) { \
        const u16* xp = wsp<u16>(p, OFF_XM) + (size_t)tok * 1024 + lane * 4; \
        _Pragma("unroll") for (int i = 0; i < 4; ++i) X[r][i] = __builtin_nontemporal_load((const u32x2*)(xp + i * 256));        \
        const int j = idx - i0; \
        const unsigned ra = (unsigned)__builtin_amdgcn_readlane((int)rt.x, j), rb = (unsigned)__builtin_amdgcn_readlane((int)rt.z, j); \
        WA[r] = __int_as_float(__builtin_amdgcn_readlane((int)rt.y, j)); WB[r] = __int_as_float(__builtin_amdgcn_readlane((int)rt.w, j)); \
        const size_t rowa = (size_t)(__builtin_amdgcn_readlane(vbefore, (int)(ra & 255u)) * 256 + (int)(ra >> 8)); \
        const size_t rowb = (size_t)(__builtin_amdgcn_readlane(vbefore, (int)(rb & 255u)) * 256 + (int)(rb >> 8)); \
        _Pragma("unroll") for (int i = 0; i < 4; ++i) { \
          const int c = i * 256 + lane * 4; \
          YA[r][i] = *(const int*)(YS + rowa * 1024 + c); \
          YB[r][i] = *(const int*)(YS + rowb * 1024 + c); \
        } \
      } \
    } } while (0)
  u32x2 cx[2][4], nx[2][4]; int y0[2][4], y1[2][4], ny0[2][4], ny1[2][4]; bool ok[2], nok[2]; int tk[2], ntk[2]; float wa[2], wb[2], nwa[2], nwb[2];
  if (i0 < i1) J_ISSUE(i0, cx, y0, y1, wa, wb, tk, ok);
  for (int ii = i0; ii < i1; ii += 2) {
    const bool more = ii + 2 < i1;
    if (more) J_ISSUE(ii + 2, nx, ny0, ny1, nwa, nwb, ntk, nok);
    float xv[2][16];
#pragma unroll
    for (int r = 0; r < 2; ++r) {
      if (!ok[r]) continue;
#pragma unroll
      for (int i = 0; i < 4; ++i) {
        xv[r][i * 4 + 0] = __uint_as_float(cx[r][i].x << 16); xv[r][i * 4 + 1] = __uint_as_float(cx[r][i].x & 0xffff0000u);
        xv[r][i * 4 + 2] = __uint_as_float(cx[r][i].y << 16); xv[r][i * 4 + 3] = __uint_as_float(cx[r][i].y & 0xffff0000u);
      }
      const int tok = tk[r];
      const int b = tok / TPB, rr = tok % TPB;
      const int mrow = (rr < NCTX) ? 8 : b;
      if (mrow != cur) {
        cur = mrow;
        const float* gt = wsp<float>(p, OFF_MOD) + ((size_t)l * 9 + mrow) * 6144 + 5120;
#pragma unroll
        for (int i = 0; i < 4; ++i) gtv[i] = *(const f32x4*)(gt + i * 256 + lane * 4);
        if (l == 0) load_modvec(p, 1, 0, mrow, mv);
      }
#pragma unroll
      for (int i = 0; i < 4; ++i) {
        const f32x4 g = gtv[i] * (1.f / YS8_SCALE);
        const f32x2 a0 = __builtin_amdgcn_cvt_pk_f32_fp8(y0[r][i], false), a1 = __builtin_amdgcn_cvt_pk_f32_fp8(y0[r][i], true);
        const f32x2 b0 = __builtin_amdgcn_cvt_pk_f32_fp8(y1[r][i], false), b1 = __builtin_amdgcn_cvt_pk_f32_fp8(y1[r][i], true);
        xv[r][i * 4 + 0] += g.x * (wa[r] * a0.x + wb[r] * b0.x);
        xv[r][i * 4 + 1] += g.y * (wa[r] * a0.y + wb[r] * b0.y);
        xv[r][i * 4 + 2] += g.z * (wa[r] * a1.x + wb[r] * b1.x);
        xv[r][i * 4 + 3] += g.w * (wa[r] * a1.y + wb[r] * b1.y);
      }
      if (l == 0) {
        u16* xr = (u16*)p->out + (size_t)tok * 1024;
#pragma unroll
        for (int i = 0; i < 4; ++i)
          *(u32x2*)(xr + i * 256 + lane * 4) = u32x2{pk2(xv[r][i * 4], xv[r][i * 4 + 1]), pk2(xv[r][i * 4 + 2], xv[r][i * 4 + 3])};
        float hv[16];
        modulate_row_store2<true, false>(mv, xv[r], nullptr, hv, h8base(p) + (size_t)tok * 1024);
      } else {
        float ss = 0.f;
#pragma unroll
        for (int i = 0; i < 16; ++i) ss += xv[r][i] * xv[r][i];
        ss = wave_sum(ss);
        const float rstd = rsqrtf(ss * (1.f / 1024.f) + EPS);
        float* xr = p->out + ((size_t)b * SEQ + rr - NCTX) * 1024;
#pragma unroll
        for (int i = 0; i < 4; ++i) {
          const int c = i * 256 + lane * 4;
          const f32x4 g = gfin[i];
          __builtin_nontemporal_store(f32x4{xv[r][i * 4] * rstd * g.x, xv[r][i * 4 + 1] * rstd * g.y, xv[r][i * 4 + 2] * rstd * g.z, xv[r][i * 4 + 3] * rstd * g.w}, (f32x4*)(xr + c));
        }
      }
    }
    if (!more) break;
#pragma unroll
    for (int r = 0; r < 2; ++r) {
      ok[r] = nok[r]; tk[r] = ntk[r]; wa[r] = nwa[r]; wb[r] = nwb[r];
#pragma unroll
      for (int i = 0; i < 4; ++i) { cx[r][i] = nx[r][i]; y0[r][i] = ny0[r][i]; y1[r][i] = ny1[r][i]; }
    }
  }
#undef J_ISSUE
}

constexpr int N_PHASES = 3 + 2 * 11;
__global__ void __launch_bounds__(512, 2) fwd_v2(Params parg) {
  extern __shared__ __attribute__((aligned(16))) unsigned char dyn_lds[];
  const ldsp_t lds = (ldsp_t)dyn_lds;
  cg::grid_group grid = cg::this_grid();
  volatile LAS unsigned* xb_st = (volatile LAS unsigned*)(lds + LDS_BARW);
  if (TIDX < 4) xb_st[TIDX] = 0u;
  __syncthreads();
  if (parg.ph_end - parg.ph_begin > 1) xcd_barrier_post((unsigned*)(parg.ws + OFF_BAR));
  for (int ph = parg.ph_begin; ph < parg.ph_end; ++ph) {
    KP p = (KP)__builtin_amdgcn_kernarg_segment_ptr();
    asm volatile("" : "+s"(p));
    const int l = (ph >= 14) ? 1 : 0;
    const int k = (ph < 3) ? ph : 3 + (ph - 3) % 11;
    const int reps = (((PROBE_DUP >> k) & 1) && (!(PROBE_DUP & 0x10000) || l == 0)) ? 2 : 1;
    for (int rep = 0; rep < reps; ++rep) {
      if (rep) {
        xcd_barrier((unsigned*)(p->ws + OFF_BAR), xb_st);
        if (k == 10) { if (BIDX == 0 && TIDX < 32) wsp<int>(p, OFF_CNT)[TIDX * CNT_STRIDE] = 0; xcd_barrier((unsigned*)(p->ws + OFF_BAR), xb_st); }
      }
      switch (k) {
        case 0: phase0_2(p, lds); break;
        case 1: phase1_2(p); break;
        case 2: phaseA2(p); break;
        case 3: phaseB2(p, lds); break;
        case 4: phaseC2(p, l, lds); break;
        case 5: phaseP2(p, l, lds); break;
        case 6: phaseD2(p, l, lds); break;
        case 7: phaseE1(p, l, lds); break;
        case 8: phaseE2(p, l, lds); break;
        case 9: phaseF2(p, l, lds); break;
        case 10: phaseG2(p, l, lds); break;
        case 11: phaseI1_2(p, lds); break;
        case 12: phaseI2_2(p, lds); break;
        default: phaseJ2(p, l, lds); break;
      }
    }
    if (k == 0 || (k == 13 && l == 0)) conv_items2(p, k == 0 ? 0 : 1, lds, 0, CONV_EARLY);
    if (ph + 1 < parg.ph_end && k != 9 && k != 7 && k != 4) {
      if (parg.ph_begin >= 1000) grid.sync();
      else xcd_barrier((unsigned*)(p->ws + OFF_BAR), xb_st);
    }
  }
}
}

extern "C" void kernel_launch(void* const* d_in, const int* in_sizes, int n_in, void* d_out, int out_size,
                              void* d_ws, size_t ws_size, hipStream_t stream) {
  static int grid2 = 0;
  if (!grid2) {
    int dev = 0, cus = 0, per_cu = 0;
    (void)hipGetDevice(&dev);
    (void)hipDeviceGetAttribute(&cus, hipDeviceAttributeMultiprocessorCount, dev);
    (void)hipFuncSetAttribute((const void*)v2::fwd_v2, hipFuncAttributeMaxDynamicSharedMemorySize, v2::LDS_TOTAL);
    (void)hipOccupancyMaxActiveBlocksPerMultiprocessor(&per_cu, v2::fwd_v2, 512, v2::LDS_TOTAL);
    if (per_cu < 1) { fprintf(stderr, "kernel does not fit on a CU\n"); per_cu = 1; }
    grid2 = cus & ~7;
  }
  if (ws_size < WS_NEEDED) { fprintf(stderr, "workspace too small: %zu < %zu\n", ws_size, (size_t)WS_NEEDED); return; }
  Params hp{};
  const float** f = (const float**)&hp;
  for (int i = 0; i < 29; ++i) f[i] = (const float*)d_in[i];
  hp.out = (float*)d_out;
  hp.ws = (char*)d_ws;
#if N_LAUNCH_MODE == 1
  for (int ph = 0; ph < v2::N_PHASES; ++ph) {
    hp.ph_begin = ph; hp.ph_end = ph + 1;
    void* args[] = {&hp};
    hipError_t e = hipLaunchCooperativeKernel((void*)v2::fwd_v2, dim3(grid2), dim3(512), args, v2::LDS_TOTAL, stream);
    if (e != hipSuccess) fprintf(stderr, "launch failed: %s\n", hipGetErrorString(e));
  }
#else
  hp.ph_begin = 0; hp.ph_end = v2::N_PHASES;
  (void)hipMemsetAsync((char*)d_ws + OFF_BAR, 0, (size_t)(OFF_DEP - OFF_BAR) + (size_t)DEP_WORDS * 4, stream);
  void* args[] = {&hp};
  hipError_t e = hipLaunchCooperativeKernel((void*)v2::fwd_v2, dim3(grid2), dim3(512), args, v2::LDS_TOTAL, stream);
  if (e != hipSuccess) fprintf(stderr, "cooperative launch failed: %s (grid %d)\n", hipGetErrorString(e), grid2);
#endif
}
```
